# Optimizing an MI355X kernel written in HIP

```python
import jax, jax.numpy as jnp
from jax import lax
import numpy as np

D_MODEL = 1024
BATCH = 2
SEQ = 8192
DEPTH = 2

D_MIX = D_MODEL
RW_HEADS = 8
RW_HEAD_DIM = 64
RW_WIDTH = RW_HEADS * RW_HEAD_DIM
DECAY_LORA = 64
AAA_LORA = 64
GATE_LORA = 128
N_DIR = 2
MLA_HEADS = 8
QK_NOPE = 64
QK_ROPE = 32
V_HEAD = 64
Q_LORA = 256
KV_LORA = 128
MLA_WIDTH = MLA_HEADS * V_HEAD
ROPE_THETA = 10000.0
Q_BLOCK = 128
N_EXPERTS = 16
EC_FACTOR = 2
D_EXPERT = 1024
D_PLE = 256
NORM_EPS = 1e-6
GN_EPS = 64e-5

RW_COLS = 3 * RW_WIDTH + N_DIR * DECAY_LORA + N_DIR * AAA_LORA + GATE_LORA
MLA_COLS = Q_LORA + KV_LORA + QK_ROPE
IN_COLS = RW_COLS + MLA_COLS

kernel_name = 'hybrid_rwkv7_mla_expert_choice_encoder'


def rmsnorm(x, g, eps=NORM_EPS):
    xf = x.astype(jnp.float32)
    y = xf * lax.rsqrt(jnp.mean(xf * xf, axis=-1, keepdims=True) + eps)
    return (y * g.astype(jnp.float32)).astype(x.dtype)


def centred_shift_mix(z, mu):
    zp = jnp.pad(z, ((0, 0), (1, 1), (0, 0)))
    nb = 0.5 * (zp[:, :-2] + zp[:, 2:])
    return z + mu * (nb - z)


def rwkv7_scan(r, w, k, v, kk, a, reverse):
    b, _, h, n = r.shape
    xs = tuple(jnp.moveaxis(t, 1, 0) for t in (r, w, k, v, kk, a))
    s0 = jnp.zeros((b, h, n, n), jnp.float32)

    def step(s, inp):
        r_t, w_t, k_t, v_t, kk_t, a_t = inp
        sa = jnp.einsum('bhvk,bhk->bhv', s, -kk_t)
        s = (s * w_t[:, :, None, :] + sa[..., None] * (kk_t * a_t)[:, :, None, :]
             + v_t[..., None] * k_t[:, :, None, :])
        return s, jnp.einsum('bhvk,bhk->bhv', s, r_t)

    _, out = lax.scan(step, s0, xs, reverse=reverse)
    return jnp.moveaxis(out, 0, 1)


def rwkv7_group(z, mu, w0, w_up, a0, a_up, g_up, k_k, k_a, r_k, lnx_w, lnx_b):
    z = centred_shift_mix(z, mu).astype(jnp.float32)
    b, t, _ = z.shape
    o1 = RW_WIDTH
    o2 = 2 * RW_WIDTH
    o3 = 3 * RW_WIDTH
    o4 = o3 + N_DIR * DECAY_LORA
    o5 = o4 + N_DIR * AAA_LORA
    r = z[..., :o1]
    k = z[..., o1:o2]
    v = z[..., o2:o3]
    wd = z[..., o3:o4].reshape(b, t, N_DIR, DECAY_LORA)
    ad = z[..., o4:o5].reshape(b, t, N_DIR, AAA_LORA)
    gd = z[..., o5:]
    w_logit = w0 + jnp.einsum('btdl,dlc->btdc', jnp.tanh(wd), w_up)
    decay = jnp.exp(-jnp.exp(-jax.nn.softplus(-w_logit) - 0.5))
    a = jax.nn.sigmoid(a0 + jnp.einsum('btdl,dlc->btdc', ad, a_up))
    g = jax.nn.sigmoid(gd) @ g_up

    def hs(u):
        return u.reshape(u.shape[:-1] + (RW_HEADS, RW_HEAD_DIM))

    kk = hs(k * k_k)
    kk = kk / jnp.maximum(jnp.sqrt(jnp.sum(kk * kk, axis=-1, keepdims=True)), 1e-12)
    k_dir = k[:, :, None, :] * (1.0 + (a - 1.0) * k_a)
    r_h = hs(r)
    v_h = hs(v)
    o_fwd = rwkv7_scan(r_h, hs(decay[:, :, 0]), hs(k_dir[:, :, 0]), v_h, kk, hs(a[:, :, 0]), False)
    o_bwd = rwkv7_scan(r_h, hs(decay[:, :, 1]), hs(k_dir[:, :, 1]), v_h, kk, hs(a[:, :, 1]), True)
    o = o_fwd + o_bwd
    mean = jnp.mean(o, axis=-1, keepdims=True)
    var = jnp.mean(jnp.square(o - mean), axis=-1, keepdims=True)
    o = ((o - mean) * lax.rsqrt(var + GN_EPS)).reshape(b, t, RW_WIDTH) * lnx_w + lnx_b
    k_bonus = hs(0.5 * (k_dir[:, :, 0] + k_dir[:, :, 1]))
    bonus = (jnp.sum(r_h * k_bonus * r_k, axis=-1, keepdims=True) * v_h).reshape(b, t, RW_WIDTH)
    return (o + bonus) * g


def rope_angles(positions):
    inv = ROPE_THETA ** (-jnp.arange(0, QK_ROPE, 2, dtype=jnp.float32) / QK_ROPE)
    ang = positions.astype(jnp.float32)[..., None] * inv
    return jnp.cos(ang), jnp.sin(ang)


def apply_rope(u, cos, sin):
    half = QK_ROPE // 2
    u1 = u[..., :half]
    u2 = u[..., half:]
    return jnp.concatenate([u1 * cos - u2 * sin, u1 * sin + u2 * cos], axis=-1)


def mla_group(z, cos, sin, q_norm, q_up, kv_norm, kv_up, o_norm):
    b, t, _ = z.shape
    qd = z[..., :Q_LORA]
    kvd = z[..., Q_LORA:Q_LORA + KV_LORA]
    kr = z[..., Q_LORA + KV_LORA:]
    q = (rmsnorm(qd, q_norm) @ q_up).reshape(b, t, MLA_HEADS, QK_NOPE + QK_ROPE)
    q_nope = q[..., :QK_NOPE]
    q_rope = apply_rope(q[..., QK_NOPE:], cos[:, :, None, :], sin[:, :, None, :])
    kv = (rmsnorm(kvd, kv_norm) @ kv_up).reshape(b, t, MLA_HEADS, QK_NOPE + V_HEAD)
    k_nope = kv[..., :QK_NOPE]
    v = kv[..., QK_NOPE:]
    k_rope = apply_rope(kr, cos, sin)
    scale = (QK_NOPE + QK_ROPE) ** -0.5
    nblk = t // Q_BLOCK

    def to_blocks(u):
        return jnp.moveaxis(u.reshape((b, nblk, Q_BLOCK) + u.shape[2:]), 1, 0)

    def attend(qs):
        qn, qr = qs
        s = (jnp.einsum('bqhd,bkhd->bhqk', qn, k_nope).astype(jnp.float32)
             + jnp.einsum('bqhr,bkr->bhqk', qr, k_rope).astype(jnp.float32)) * scale
        pr = jax.nn.softmax(s, axis=-1).astype(v.dtype)
        return jnp.einsum('bhqk,bkhd->bqhd', pr, v)

    o = lax.map(attend, (to_blocks(q_nope), to_blocks(q_rope)))
    o = jnp.moveaxis(o, 0, 1).reshape(b, t, MLA_WIDTH)
    return rmsnorm(o, o_norm)


def expert_choice_ffn(h, router, w_gate, w_up, w_down):
    b, t, _ = h.shape
    cap = EC_FACTOR * t // N_EXPERTS
    aff = jax.nn.softmax((h @ router).astype(jnp.float32), axis=-1)
    gate, idx = lax.top_k(jnp.swapaxes(aff, 1, 2), cap)
    b_idx = jnp.arange(b)[:, None, None]
    xe = h[b_idx, idx]
    hid = (jax.nn.silu(jnp.einsum('becd,edf->becf', xe, w_gate))
           * jnp.einsum('becd,edf->becf', xe, w_up))
    ye = jnp.einsum('becf,efd->becd', hid, w_down) * gate[..., None].astype(h.dtype)
    return jnp.zeros_like(h).at[b_idx, idx].add(ye.astype(h.dtype))


def setup_inputs(seed: int = 0) -> dict:
    key = jax.random.key(seed)
    ks = jax.random.split(key, 40)
    f32 = jnp.float32

    def nrm(k, shape, scale):
        return jax.random.normal(k, shape, f32) * scale

    def gain(k, shape):
        return 1.0 + 0.02 * jax.random.normal(k, shape, f32)

    offsets = jax.random.randint(ks[2], (BATCH, 1), 0, 1024, dtype=jnp.int32)
    positions = jnp.arange(SEQ, dtype=jnp.int32)[None, :] + offsets
    return {
        'x': nrm(ks[0], (BATCH, SEQ, D_MODEL), 1.0),
        'p': nrm(ks[1], (DEPTH, BATCH, SEQ, D_PLE), 1.0),
        'positions': positions,
        'attn_norm': gain(ks[3], (DEPTH, D_MODEL)),
        'w_in': nrm(ks[4], (DEPTH, D_MODEL, IN_COLS), D_MODEL ** -0.5),
        'rw_mu': jax.random.uniform(ks[5], (DEPTH, RW_COLS), f32),
        'rw_w0': jax.random.uniform(ks[6], (DEPTH, N_DIR, RW_WIDTH), f32, -5.0, 1.0),
        'rw_w_up': nrm(ks[7], (DEPTH, N_DIR, DECAY_LORA, RW_WIDTH), 0.5 * DECAY_LORA ** -0.5),
        'rw_a0': nrm(ks[8], (DEPTH, N_DIR, RW_WIDTH), 0.5),
        'rw_a_up': nrm(ks[9], (DEPTH, N_DIR, AAA_LORA, RW_WIDTH), AAA_LORA ** -0.5),
        'rw_g_up': nrm(ks[10], (DEPTH, GATE_LORA, RW_WIDTH), GATE_LORA ** -0.5),
        'rw_k_k': 0.85 + 0.1 * jax.random.normal(ks[11], (DEPTH, RW_WIDTH), f32),
        'rw_k_a': 1.0 + 0.1 * jax.random.normal(ks[12], (DEPTH, RW_WIDTH), f32),
        'rw_r_k': nrm(ks[13], (DEPTH, RW_HEADS, RW_HEAD_DIM), 0.1),
        'rw_lnx_w': gain(ks[14], (DEPTH, RW_WIDTH)),
        'rw_lnx_b': nrm(ks[15], (DEPTH, RW_WIDTH), 0.02),
        'mla_q_norm': gain(ks[16], (DEPTH, Q_LORA)),
        'mla_q_up': nrm(ks[17], (DEPTH, Q_LORA, MLA_HEADS * (QK_NOPE + QK_ROPE)), Q_LORA ** -0.5),
        'mla_kv_norm': gain(ks[18], (DEPTH, KV_LORA)),
        'mla_kv_up': nrm(ks[19], (DEPTH, KV_LORA, MLA_HEADS * (QK_NOPE + V_HEAD)), KV_LORA ** -0.5),
        'mla_o_norm': gain(ks[20], (DEPTH, MLA_WIDTH)),
        'w_out': nrm(ks[21], (DEPTH, D_MIX, D_MODEL), D_MIX ** -0.5),
        'ffn_norm': gain(ks[22], (DEPTH, D_MODEL)),
        'router': nrm(ks[23], (DEPTH, D_MODEL, N_EXPERTS), D_MODEL ** -0.5),
        'exp_w_gate': nrm(ks[24], (DEPTH, N_EXPERTS, D_MODEL, D_EXPERT), D_MODEL ** -0.5),
        'exp_w_up': nrm(ks[25], (DEPTH, N_EXPERTS, D_MODEL, D_EXPERT), D_MODEL ** -0.5),
        'exp_w_down': nrm(ks[26], (DEPTH, N_EXPERTS, D_EXPERT, D_MODEL), D_EXPERT ** -0.5),
        'ple_norm': gain(ks[27], (DEPTH, D_MODEL)),
        'ple_proj': nrm(ks[28], (DEPTH, D_PLE, D_MODEL), D_PLE ** -0.5),
        'ple_gate': nrm(ks[29], (DEPTH, D_MODEL, D_MODEL), D_MODEL ** -0.5),
        'final_norm': gain(ks[30], (D_MODEL,)),
    }


def reference(x, p, positions, attn_norm, w_in, rw_mu, rw_w0, rw_w_up, rw_a0, rw_a_up,
              rw_g_up, rw_k_k, rw_k_a, rw_r_k, rw_lnx_w, rw_lnx_b, mla_q_norm, mla_q_up,
              mla_kv_norm, mla_kv_up, mla_o_norm, w_out, ffn_norm, router, exp_w_gate,
              exp_w_up, exp_w_down, ple_norm, ple_proj, ple_gate, final_norm):
    cos, sin = rope_angles(positions)
    for i in range(DEPTH):
        h = rmsnorm(x, attn_norm[i])
        z = h @ w_in[i]
        y_rw = rwkv7_group(z[..., :RW_COLS], rw_mu[i], rw_w0[i], rw_w_up[i], rw_a0[i],
                           rw_a_up[i], rw_g_up[i], rw_k_k[i], rw_k_a[i], rw_r_k[i],
                           rw_lnx_w[i], rw_lnx_b[i])
        y_mla = mla_group(z[..., RW_COLS:], cos, sin, mla_q_norm[i], mla_q_up[i],
                          mla_kv_norm[i], mla_kv_up[i], mla_o_norm[i])
        y = jnp.concatenate([y_rw.astype(x.dtype), y_mla.astype(x.dtype)], axis=-1)
        x = x + (y @ w_out[i]).astype(x.dtype)
        x = x + expert_choice_ffn(rmsnorm(x, ffn_norm[i]), router[i], exp_w_gate[i],
                                  exp_w_up[i], exp_w_down[i])
        ple = (p[i] @ ple_proj[i]) * jax.nn.sigmoid(rmsnorm(x, ple_norm[i]) @ ple_gate[i])
        x = x + ple.astype(x.dtype)
    return rmsnorm(x, final_norm)
```

```cpp
#include <hip/hip_runtime.h>
#include <hip/hip_bf16.h>
#include <cstdio>
#include <cstdint>

#define DI __device__ __forceinline__
#define LAS __attribute__((address_space(3)))

constexpr int NB = 2, T = 8192, NTOK = NB * T, DM = 1024, NL = 2;
constexpr int RWW = 512, RWC = 1920, INC = 2336;
constexpr int NH = 8;
constexpr int NE = 16, CAP = 1024;
constexpr int DPLE = 256;
constexpr int NTH = 512;
constexpr float NORM_EPS = 1e-6f, GN_EPS = 64e-5f;

using bf16x8 = __attribute__((ext_vector_type(8))) short;
using s16x4  = __attribute__((ext_vector_type(4))) short;
using f32x4  = __attribute__((ext_vector_type(4))) float;
using u32x4  = __attribute__((ext_vector_type(4))) unsigned;
using u32x2  = __attribute__((ext_vector_type(2))) unsigned;
typedef __bf16 bf2_t __attribute__((ext_vector_type(2)));
typedef unsigned short u16;

DI unsigned pk2(float a, float b) { bf2_t v = {(__bf16)a, (__bf16)b}; return __builtin_bit_cast(unsigned, v); }
DI u16 f2bf(float a) { return (u16)(pk2(a, 0.f) & 0xffffu); }
DI float bf2f(u16 u) { return __uint_as_float(((unsigned)u) << 16); }
DI float wave_sum(float v) {
#pragma unroll
  for (int o = 32; o >= 1; o >>= 1) v += __shfl_xor(v, o);
  return v;
}
DI float sigmoidf_(float x) { return 1.f / (1.f + __expf(-x)); }
DI s16x4 tr_read(const short* p) {
  return __builtin_amdgcn_ds_read_tr16_b64_v4i16((LAS s16x4*)(p));
}

struct P {
  const float* x; const float* p; const int* pos;
  const float* attn_norm; const float* w_in; const float* rw_mu; const float* rw_w0; const float* rw_w_up;
  const float* rw_a0; const float* rw_a_up; const float* rw_g_up; const float* rw_k_k; const float* rw_k_a;
  const float* rw_r_k; const float* rw_lnx_w; const float* rw_lnx_b; const float* mla_q_norm; const float* mla_q_up;
  const float* mla_kv_norm; const float* mla_kv_up; const float* mla_o_norm; const float* w_out; const float* ffn_norm;
  const float* router; const float* exp_w_gate; const float* exp_w_up; const float* exp_w_down; const float* ple_norm;
  const float* ple_proj; const float* ple_gate; const float* final_norm;
  float* out;
  float* Z;
  float* LW;
  float* AA;
  u16*   G;
  u16*   HID;
  float* R; float* K; float* V;
  float* PG;
  float* QRAW;
  float* KVRAW;
  float* AO;
  float* O2;
  u16* TWD; u16* AD; u16* SGD; u16* QDN; u16* KVDN; float* KR;
  u16* Q; u16* Kc; u16* Vv;
  u16* H;
  float* AFF;
  int* IDX;
  float* GATE;
};

constexpr int GBM = 256, GBN = 128, GBK = 64;
constexpr int AS_STRIDE = 72, BS_STRIDE = 136;
constexpr int AS_BYTES = GBM * AS_STRIDE * 2;
constexpr int BS_BYTES = GBK * BS_STRIDE * 2;
constexpr int SMEM_BYTES = 57344;

template <bool A_F32, int MODE, class ARow, class Epi>
DI void gemm_tile(ARow arow, const float* __restrict__ B, const float* __restrict__ B2, int ldb, int K, int n0, int Nvalid,
                  char* smem, Epi epi) {
  short* As = (short*)smem;
  short* Bs = (short*)(smem + AS_BYTES);
  const int tid = threadIdx.x, lane = tid & 63, w = tid >> 6;
  const int wm = w >> 1, wn = w & 1;
  const int l15 = lane & 15, lq = lane >> 4;

  const char* ap[4];
#pragma unroll
  for (int i = 0; i < 4; ++i) {
    int u = tid + i * NTH; int row = u >> 3, kc = u & 7;
    ap[i] = (const char*)arow(row) + (size_t)kc * 8 * (A_F32 ? 4 : 2);
  }
  const float* bp[4]; bool bok[4];
#pragma unroll
  for (int i = 0; i < 4; ++i) {
    int u = tid + i * NTH; int k = u >> 5, nq = u & 31;
    int col; const float* base;
    if (MODE == 0) { col = n0 + nq * 4; base = B; }
    else { col = n0 + (nq & 15) * 4; base = (nq < 16) ? B : B2; }
    bok[i] = col < Nvalid;
    bp[i] = base + (size_t)k * ldb + (bok[i] ? col : 0);
  }

  f32x4 acc[4][4];
#pragma unroll
  for (int i = 0; i < 4; ++i)
#pragma unroll
    for (int j = 0; j < 4; ++j) acc[i][j] = f32x4{0.f, 0.f, 0.f, 0.f};

  u32x4 areg[4]; f32x4 breg[4];
#define GLOAD(kt_)                                                                                   \
  {                                                                                                  \
    _Pragma("unroll") for (int i = 0; i < 4; ++i) {                                                  \
      if (A_F32) {                                                                                   \
        const float4* q = (const float4*)(ap[i] + (size_t)(kt_) * GBK * 4);                          \
        float4 v0 = q[0], v1 = q[1];                                                                 \
        areg[i] = u32x4{pk2(v0.x, v0.y), pk2(v0.z, v0.w), pk2(v1.x, v1.y), pk2(v1.z, v1.w)};         \
      } else {                                                                                       \
        areg[i] = *(const u32x4*)(ap[i] + (size_t)(kt_) * GBK * 2);                                  \
      }                                                                                              \
    }                                                                                                \
    _Pragma("unroll") for (int i = 0; i < 4; ++i) {                                                  \
      if (bok[i]) breg[i] = *(const f32x4*)(bp[i] + (size_t)(kt_) * GBK * ldb);                      \
      else breg[i] = f32x4{0.f, 0.f, 0.f, 0.f};                                                      \
    }                                                                                                \
  }
  const int nk = K / GBK;
  GLOAD(0)
  for (int kt = 0; kt < nk; ++kt) {
    __syncthreads();
#pragma unroll
    for (int i = 0; i < 4; ++i) {
      int u = tid + i * NTH; int row = u >> 3, kc = u & 7;
      *(u32x4*)(As + row * AS_STRIDE + kc * 8) = areg[i];
    }
#pragma unroll
    for (int i = 0; i < 4; ++i) {
      int u = tid + i * NTH; int k = u >> 5, nq = u & 31;
      u32x2 v = u32x2{pk2(breg[i][0], breg[i][1]), pk2(breg[i][2], breg[i][3])};
      *(u32x2*)(Bs + k * BS_STRIDE + nq * 4) = v;
    }
    __syncthreads();
    if (kt + 1 < nk) GLOAD(kt + 1)
#pragma unroll
    for (int ks = 0; ks < 2; ++ks) {
      bf16x8 a[4], b[4];
#pragma unroll
      for (int mi = 0; mi < 4; ++mi)
        a[mi] = *(const bf16x8*)(As + (wm * 64 + mi * 16 + l15) * AS_STRIDE + ks * 32 + 8 * lq);
#pragma unroll
      for (int ni = 0; ni < 4; ++ni) {
        int col0 = (MODE == 0) ? (wn * 64 + ni * 16) : ((ni < 2) ? (wn * 32 + ni * 16) : (64 + wn * 32 + (ni - 2) * 16));
        int kb = ks * 32 + 8 * lq; int q = l15 >> 2, pp = l15 & 3;
        s16x4 lo = tr_read(Bs + (kb + q) * BS_STRIDE + col0 + 4 * pp);
        s16x4 hi = tr_read(Bs + (kb + 4 + q) * BS_STRIDE + col0 + 4 * pp);
        b[ni] = __builtin_shufflevector(lo, hi, 0, 1, 2, 3, 4, 5, 6, 7);
      }
#pragma unroll
      for (int mi = 0; mi < 4; ++mi)
#pragma unroll
        for (int ni = 0; ni < 4; ++ni)
          acc[mi][ni] = __builtin_amdgcn_mfma_f32_16x16x32_bf16(a[mi], b[ni], acc[mi][ni], 0, 0, 0);
    }
  }
#pragma unroll
  for (int mi = 0; mi < 4; ++mi)
#pragma unroll
    for (int r = 0; r < 4; ++r) {
      int row = wm * 64 + mi * 16 + lq * 4 + r;
      if (MODE == 0) {
#pragma unroll
        for (int ni = 0; ni < 4; ++ni) {
          int col = n0 + wn * 64 + ni * 16 + l15;
          if (col < Nvalid) epi(row, col, acc[mi][ni][r], 0.f);
        }
      } else {
#pragma unroll
        for (int ni = 0; ni < 2; ++ni) {
          int col = n0 + wn * 32 + ni * 16 + l15;
          epi(row, col, acc[mi][ni][r], acc[mi][ni + 2][r]);
        }
      }
    }
}

DI void ph_norm(const float* __restrict__ X, const float* __restrict__ g, u16* __restrict__ Hout) {
  const int lane = threadIdx.x & 63, w = threadIdx.x >> 6;
  for (int tok = blockIdx.x * 8 + w; tok < NTOK; tok += gridDim.x * 8) {
    const float4* xr = (const float4*)(X + (size_t)tok * DM);
    float4 v[4]; float ss = 0.f;
#pragma unroll
    for (int j = 0; j < 4; ++j) { v[j] = xr[lane + 64 * j]; ss += v[j].x * v[j].x + v[j].y * v[j].y + v[j].z * v[j].z + v[j].w * v[j].w; }
    ss = wave_sum(ss);
    float rstd = rsqrtf(ss * (1.f / DM) + NORM_EPS);
#pragma unroll
    for (int j = 0; j < 4; ++j) {
      float4 gg = ((const float4*)g)[lane + 64 * j];
      uint2 o = uint2{pk2(v[j].x * rstd * gg.x, v[j].y * rstd * gg.y), pk2(v[j].z * rstd * gg.z, v[j].w * rstd * gg.w)};
      *(uint2*)(Hout + (size_t)tok * DM + (lane + 64 * j) * 4) = o;
    }
  }
}

DI void ph_final_norm(float* __restrict__ X, const float* __restrict__ g) {
  const int lane = threadIdx.x & 63, w = threadIdx.x >> 6;
  for (int tok = blockIdx.x * 8 + w; tok < NTOK; tok += gridDim.x * 8) {
    float4* xr = (float4*)(X + (size_t)tok * DM);
    float4 v[4]; float ss = 0.f;
#pragma unroll
    for (int j = 0; j < 4; ++j) { v[j] = xr[lane + 64 * j]; ss += v[j].x * v[j].x + v[j].y * v[j].y + v[j].z * v[j].z + v[j].w * v[j].w; }
    ss = wave_sum(ss);
    float rstd = rsqrtf(ss * (1.f / DM) + NORM_EPS);
#pragma unroll
    for (int j = 0; j < 4; ++j) {
      float4 gg = ((const float4*)g)[lane + 64 * j];
      xr[lane + 64 * j] = float4{v[j].x * rstd * gg.x, v[j].y * rstd * gg.y, v[j].z * rstd * gg.z, v[j].w * rstd * gg.w};
    }
  }
}

template <bool A_F32, class Epi>
DI void ph_gemm(const void* A, int lda, const float* B, int ldb, int M, int N, int K, char* smem, Epi epi) {
  const int ntn = (N + GBN - 1) / GBN, ntm = M / GBM;
  for (int t = blockIdx.x; t < ntm * ntn; t += gridDim.x) {
    int tm = t / ntn, tn = t % ntn;
    int m0 = tm * GBM, n0 = tn * GBN;
    auto arow = [&](int r) -> const void* { return (const char*)A + (size_t)(m0 + r) * lda * (A_F32 ? 4 : 2); };
    gemm_tile<A_F32, 0>(arow, B, nullptr, ldb, K, n0, N, smem, [&](int row, int col, float v, float) { epi(m0 + row, col, v); });
    __syncthreads();
  }
}

DI void ph_rwshift(const P& p, int layer) {
  const float* mu = p.rw_mu + layer * RWC;
  const int total = NTOK * (RWC / 4);
  for (int i = blockIdx.x * NTH + threadIdx.x; i < total; i += gridDim.x * NTH) {
    int tok = i / (RWC / 4), c = (i % (RWC / 4)) * 4;
    int t = tok % T;
    const float* zr = p.Z + (size_t)tok * INC + c;
    float4 z = *(const float4*)zr;
    float4 zm = (t > 0) ? *(const float4*)(zr - INC) : float4{0.f, 0.f, 0.f, 0.f};
    float4 zp = (t < T - 1) ? *(const float4*)(zr + INC) : float4{0.f, 0.f, 0.f, 0.f};
    float4 m = *(const float4*)(mu + c);
    float4 o;
    o.x = z.x + m.x * (0.5f * (zm.x + zp.x) - z.x);
    o.y = z.y + m.y * (0.5f * (zm.y + zp.y) - z.y);
    o.z = z.z + m.z * (0.5f * (zm.z + zp.z) - z.z);
    o.w = z.w + m.w * (0.5f * (zm.w + zp.w) - z.w);
    if (c < 512) *(float4*)(p.R + (size_t)tok * RWW + c) = o;
    else if (c < 1024) *(float4*)(p.K + (size_t)tok * RWW + (c - 512)) = o;
    else if (c < 1536) *(float4*)(p.V + (size_t)tok * RWW + (c - 1024)) = o;
    else if (c < 1664) {
      int d = (c - 1536) >> 6, l = (c - 1536) & 63;
      *(uint2*)(p.TWD + ((size_t)d * NTOK + tok) * 64 + l) = uint2{pk2(tanhf(o.x), tanhf(o.y)), pk2(tanhf(o.z), tanhf(o.w))};
    } else if (c < 1792) {
      int d = (c - 1664) >> 6, l = (c - 1664) & 63;
      *(uint2*)(p.AD + ((size_t)d * NTOK + tok) * 64 + l) = uint2{pk2(o.x, o.y), pk2(o.z, o.w)};
    } else {
      int l = c - 1792;
      *(uint2*)(p.SGD + (size_t)tok * 128 + l) = uint2{pk2(sigmoidf_(o.x), sigmoidf_(o.y)), pk2(sigmoidf_(o.z), sigmoidf_(o.w))};
    }
  }
}

DI void rope_cs(int pos, int i, float& cs, float& sn) {
  const int i3 = i & 3, i2 = i >> 2;
  const float c4 = (i3 == 0) ? 1.0f : (i3 == 1) ? 0.5623413251903491f : (i3 == 2) ? 0.31622776601683794f : 0.1778279410038923f;
  const float p10 = (i2 == 0) ? 1.0f : (i2 == 1) ? 0.1f : (i2 == 2) ? 0.01f : 0.001f;
  float inv = c4 * p10;
  float ang = (float)pos * inv;
  double rev = (double)ang * 0.15915494309189535;
  rev -= floor(rev);
  float rf = (float)rev;
  sn = __builtin_amdgcn_sinf(rf);
  cs = __builtin_amdgcn_cosf(rf);
}

DI void ph_mlaprep1(const P& p, int layer) {
  const int lane = threadIdx.x & 63, w = threadIdx.x >> 6;
  const float* qn = p.mla_q_norm + layer * 256;
  const float* kvn = p.mla_kv_norm + layer * 128;
  for (int tok = blockIdx.x * 8 + w; tok < NTOK; tok += gridDim.x * 8) {
    const float* zr = p.Z + (size_t)tok * INC + RWC;
    float4 q = *(const float4*)(zr + lane * 4);
    float ss = wave_sum(q.x * q.x + q.y * q.y + q.z * q.z + q.w * q.w);
    float rstd = rsqrtf(ss * (1.f / 256) + NORM_EPS);
    float4 g = *(const float4*)(qn + lane * 4);
    *(uint2*)(p.QDN + (size_t)tok * 256 + lane * 4) = uint2{pk2(q.x * rstd * g.x, q.y * rstd * g.y), pk2(q.z * rstd * g.z, q.w * rstd * g.w)};
    float2 kv = *(const float2*)(zr + 256 + lane * 2);
    float ss2 = wave_sum(kv.x * kv.x + kv.y * kv.y);
    float rstd2 = rsqrtf(ss2 * (1.f / 128) + NORM_EPS);
    float2 g2 = *(const float2*)(kvn + lane * 2);
    *(unsigned*)(p.KVDN + (size_t)tok * 128 + lane * 2) = pk2(kv.x * rstd2 * g2.x, kv.y * rstd2 * g2.y);
    if (lane < 16) {
      float u1 = zr[384 + lane], u2 = zr[384 + 16 + lane];
      float cs, sn; rope_cs(p.pos[tok], lane, cs, sn);
      p.KR[(size_t)tok * 32 + lane] = u1 * cs - u2 * sn;
      p.KR[(size_t)tok * 32 + 16 + lane] = u1 * sn + u2 * cs;
    }
  }
}

DI void ph_mlafinish(const P& p) {
  const int lane = threadIdx.x & 63, w = threadIdx.x >> 6;
  const float qs = 0.10206207261596577f * 1.4426950408889634f;
  for (int tok = blockIdx.x * 8 + w; tok < NTOK; tok += gridDim.x * 8) {
    int b = tok / T, t = tok % T;
    float cs = 0.f, sn = 0.f;
    if (lane < 16) rope_cs(p.pos[tok], lane, cs, sn);
    const float* qr = p.QRAW + (size_t)tok * 768;
    const float* kvr = p.KVRAW + (size_t)tok * 1024;
    const float* kr = p.KR + (size_t)tok * 32;
#pragma unroll
    for (int h = 0; h < NH; ++h) {
      size_t row = ((size_t)(b * NH + h) * T + t);
      u16* qo = p.Q + row * 96; u16* ko = p.Kc + row * 96; u16* vo = p.Vv + row * 64;
      qo[lane] = f2bf(qr[h * 96 + lane] * qs);
      ko[lane] = f2bf(kvr[h * 128 + lane]);
      vo[lane] = f2bf(kvr[h * 128 + 64 + lane]);
      if (lane < 16) {
        float u1 = qr[h * 96 + 64 + lane], u2 = qr[h * 96 + 80 + lane];
        qo[64 + lane] = f2bf((u1 * cs - u2 * sn) * qs);
        qo[80 + lane] = f2bf((u1 * sn + u2 * cs) * qs);
      }
      if (lane < 32) ko[64 + lane] = f2bf(kr[lane]);
    }
  }
}

constexpr int KS_STRIDE = 104, VS_STRIDE = 72, PS_STRIDE = 72;
DI void ph_attn(const P& p, char* smem) {
  short* Ks = (short*)smem;
  short* Vs = (short*)(smem + 64 * KS_STRIDE * 2);
  short* Ps = (short*)(smem + 64 * KS_STRIDE * 2 + 64 * VS_STRIDE * 2);
  const int tid = threadIdx.x, lane = tid & 63, w = tid >> 6;
  const int l15 = lane & 15, lq = lane >> 4;
  short* Pw = Ps + w * 16 * PS_STRIDE;
  for (int item = blockIdx.x; item < NB * NH * (T / 128); item += gridDim.x) {
    int bh = item / (T / 128), qt = item % (T / 128);
    const u16* Qb = p.Q + (size_t)bh * T * 96;
    const u16* Kb = p.Kc + (size_t)bh * T * 96;
    const u16* Vb = p.Vv + (size_t)bh * T * 64;
    int qrow = qt * 128 + w * 16 + l15;
    bf16x8 qf[3];
#pragma unroll
    for (int ks = 0; ks < 3; ++ks) qf[ks] = *(const bf16x8*)(Qb + (size_t)qrow * 96 + ks * 32 + 8 * lq);
    float m[4], ls[4]; f32x4 o[4];
#pragma unroll
    for (int r = 0; r < 4; ++r) { m[r] = -INFINITY; ls[r] = 0.f; }
#pragma unroll
    for (int ni = 0; ni < 4; ++ni) o[ni] = f32x4{0.f, 0.f, 0.f, 0.f};

    uint4 kreg0, kreg1, vreg;
    auto gl = [&](int kt) {
      const u16* kp = Kb + (size_t)kt * 64 * 96;
      kreg0 = *(const uint4*)(kp + (size_t)tid * 8);
      if (tid < 256) kreg1 = *(const uint4*)(kp + (size_t)(tid + 512) * 8);
      vreg = *(const uint4*)(Vb + (size_t)kt * 64 * 64 + (size_t)tid * 8);
    };
    gl(0);
    for (int kt = 0; kt < T / 64; ++kt) {
      __syncthreads();
      { int c = tid; int row = c / 12, cc = c % 12; *(uint4*)(Ks + row * KS_STRIDE + cc * 8) = kreg0; }
      if (tid < 256) { int c = tid + 512; int row = c / 12, cc = c % 12; *(uint4*)(Ks + row * KS_STRIDE + cc * 8) = kreg1; }
      { int row = tid >> 3, cc = tid & 7; *(uint4*)(Vs + row * VS_STRIDE + cc * 8) = vreg; }
      __syncthreads();
      if (kt + 1 < T / 64) gl(kt + 1);
      f32x4 s[4];
#pragma unroll
      for (int nt = 0; nt < 4; ++nt) {
        s[nt] = f32x4{0.f, 0.f, 0.f, 0.f};
#pragma unroll
        for (int ks = 0; ks < 3; ++ks) {
          bf16x8 kb = *(const bf16x8*)(Ks + (nt * 16 + l15) * KS_STRIDE + ks * 32 + 8 * lq);
          s[nt] = __builtin_amdgcn_mfma_f32_16x16x32_bf16(qf[ks], kb, s[nt], 0, 0, 0);
        }
      }
#pragma unroll
      for (int r = 0; r < 4; ++r) {
        float mx = fmaxf(fmaxf(s[0][r], s[1][r]), fmaxf(s[2][r], s[3][r]));
        mx = fmaxf(mx, __shfl_xor(mx, 1)); mx = fmaxf(mx, __shfl_xor(mx, 2));
        mx = fmaxf(mx, __shfl_xor(mx, 4)); mx = fmaxf(mx, __shfl_xor(mx, 8));
        float mn = fmaxf(m[r], mx);
        float alpha = __builtin_amdgcn_exp2f(m[r] - mn);
        m[r] = mn;
        float ps = 0.f;
#pragma unroll
        for (int nt = 0; nt < 4; ++nt) {
          float pv = __builtin_amdgcn_exp2f(s[nt][r] - mn);
          ps += pv;
          Pw[(lq * 4 + r) * PS_STRIDE + nt * 16 + l15] = (short)f2bf(pv);
        }
        ls[r] = ls[r] * alpha + ps;
#pragma unroll
        for (int ni = 0; ni < 4; ++ni) o[ni][r] *= alpha;
      }
      __syncthreads();
#pragma unroll
      for (int kk = 0; kk < 2; ++kk) {
        bf16x8 a = *(const bf16x8*)(Pw + l15 * PS_STRIDE + kk * 32 + 8 * lq);
        int kb = kk * 32 + 8 * lq; int q = l15 >> 2, pp = l15 & 3;
#pragma unroll
        for (int ni = 0; ni < 4; ++ni) {
          s16x4 lo = tr_read(Vs + (kb + q) * VS_STRIDE + ni * 16 + 4 * pp);
          s16x4 hi = tr_read(Vs + (kb + 4 + q) * VS_STRIDE + ni * 16 + 4 * pp);
          bf16x8 vb = __builtin_shufflevector(lo, hi, 0, 1, 2, 3, 4, 5, 6, 7);
          o[ni] = __builtin_amdgcn_mfma_f32_16x16x32_bf16(a, vb, o[ni], 0, 0, 0);
        }
      }
    }
    int b = bh / NH, h = bh % NH;
#pragma unroll
    for (int r = 0; r < 4; ++r) {
      float l = ls[r];
      l += __shfl_xor(l, 1); l += __shfl_xor(l, 2); l += __shfl_xor(l, 4); l += __shfl_xor(l, 8);
      float inv = 1.f / l;
      int t = qt * 128 + w * 16 + lq * 4 + r;
      float* orow = p.AO + ((size_t)(b * T + t)) * 512 + h * 64;
#pragma unroll
      for (int ni = 0; ni < 4; ++ni) orow[ni * 16 + l15] = o[ni][r] * inv;
    }
    __syncthreads();
  }
}

DI void ph_scan(const P& p, int layer, char* smem) {
  float* sw = (float*)smem; float* skk = sw + 1024; float* sba = skk + 1024; float* skd = sba + 1024;
  float* sr = skd + 1024; float* sv = sr + 1024; float* so = sv + 1024;
  const int tid = threadIdx.x, lane = tid & 63, w = tid >> 6;
  const int v = tid >> 3, kq = tid & 7;
  for (int item = blockIdx.x; item < NB * NH * 2; item += gridDim.x) {
    int d = item & 1, h = (item >> 1) % NH, b = item / (2 * NH);
    const float* LWd = p.LW + (size_t)d * NTOK * RWW;
    const float* AAd = p.AA + (size_t)d * NTOK * RWW;
    float* Od = p.O2 + (size_t)d * NTOK * RWW;
    const int ch = h * 64 + lane;
    const float kkc = p.rw_k_k[layer * RWW + ch], kac = p.rw_k_a[layer * RWW + ch];
    float S[8];
#pragma unroll
    for (int i = 0; i < 8; ++i) S[i] = 0.f;
    for (int c = 0; c < T / 16; ++c) {
      int t0 = (d == 0) ? c * 16 : T - 16 * (c + 1);
      __syncthreads();
#pragma unroll
      for (int jj = 0; jj < 2; ++jj) {
        int j = w + 8 * jj; size_t off = ((size_t)(b * T + t0 + j)) * RWW + ch;
        float kv = p.K[off];
        float kx = kv * kkc;
        float nrm = sqrtf(wave_sum(kx * kx));
        float kkv = kx / fmaxf(nrm, 1e-12f);
        float a = AAd[off];
        sw[j * 64 + lane] = __expf(LWd[off]);
        skk[j * 64 + lane] = kkv;
        sba[j * 64 + lane] = a * kkv;
        skd[j * 64 + lane] = kv * (1.f + (a - 1.f) * kac);
        sr[j * 64 + lane] = p.R[off];
        sv[j * 64 + lane] = p.V[off];
      }
      __syncthreads();
      for (int jj = 0; jj < 16; ++jj) {
        int j = (d == 0) ? jj : 15 - jj;
        const float4* w4 = (const float4*)(sw + j * 64 + kq * 8);
        const float4* k4 = (const float4*)(skk + j * 64 + kq * 8);
        const float4* b4 = (const float4*)(sba + j * 64 + kq * 8);
        const float4* d4 = (const float4*)(skd + j * 64 + kq * 8);
        const float4* r4 = (const float4*)(sr + j * 64 + kq * 8);
        float4 wa = w4[0], wb = w4[1], ka = k4[0], kb = k4[1], ba = b4[0], bb = b4[1], da = d4[0], db = d4[1], ra = r4[0], rb = r4[1];
        float wv[8] = {wa.x, wa.y, wa.z, wa.w, wb.x, wb.y, wb.z, wb.w};
        float kv8[8] = {ka.x, ka.y, ka.z, ka.w, kb.x, kb.y, kb.z, kb.w};
        float bv[8] = {ba.x, ba.y, ba.z, ba.w, bb.x, bb.y, bb.z, bb.w};
        float dv[8] = {da.x, da.y, da.z, da.w, db.x, db.y, db.z, db.w};
        float rv[8] = {ra.x, ra.y, ra.z, ra.w, rb.x, rb.y, rb.z, rb.w};
        float vv = sv[j * 64 + v];
        float sa = 0.f;
#pragma unroll
        for (int i = 0; i < 8; ++i) sa -= S[i] * kv8[i];
        sa += __shfl_xor(sa, 1); sa += __shfl_xor(sa, 2); sa += __shfl_xor(sa, 4);
        float oo = 0.f;
#pragma unroll
        for (int i = 0; i < 8; ++i) { S[i] = S[i] * wv[i] + sa * bv[i] + vv * dv[i]; oo += S[i] * rv[i]; }
        oo += __shfl_xor(oo, 1); oo += __shfl_xor(oo, 2); oo += __shfl_xor(oo, 4);
        if (kq == 0) so[j * 64 + v] = oo;
      }
      __syncthreads();
#pragma unroll
      for (int jj = 0; jj < 2; ++jj) {
        int j = w + 8 * jj;
        Od[((size_t)(b * T + t0 + j)) * RWW + ch] = so[j * 64 + lane];
      }
    }
    __syncthreads();
  }
}

DI void ph_mixfinish(const P& p, int layer) {
  const int lane = threadIdx.x & 63, w = threadIdx.x >> 6;
  const float* lw = p.rw_lnx_w + layer * RWW; const float* lb = p.rw_lnx_b + layer * RWW;
  const float* kac = p.rw_k_a + layer * RWW; const float* rk = p.rw_r_k + layer * RWW;
  const float* on = p.mla_o_norm + layer * 512;
  for (int tok = blockIdx.x * 8 + w; tok < NTOK; tok += gridDim.x * 8) {
#pragma unroll
    for (int h = 0; h < NH; ++h) {
      int c = h * 64 + lane; size_t off = (size_t)tok * RWW + c;
      float o = p.O2[off] + p.O2[(size_t)NTOK * RWW + off];
      float mean = wave_sum(o) * (1.f / 64);
      float dv = o - mean;
      float var = wave_sum(dv * dv) * (1.f / 64);
      float on_ = dv * rsqrtf(var + GN_EPS) * lw[c] + lb[c];
      float k = p.K[off], r = p.R[off], vv = p.V[off];
      float a0 = p.AA[off], a1 = p.AA[(size_t)NTOK * RWW + off];
      float kb = 0.5f * (k * (1.f + (a0 - 1.f) * kac[c]) + k * (1.f + (a1 - 1.f) * kac[c]));
      float s = wave_sum(r * kb * rk[c]);
      float y = (on_ + s * vv) * bf2f(p.G[off]);
      p.H[(size_t)tok * DM + c] = f2bf(y);
    }
    const float* ao = p.AO + (size_t)tok * 512;
    float4 v0 = *(const float4*)(ao + lane * 4), v1 = *(const float4*)(ao + 256 + lane * 4);
    float ss = wave_sum(v0.x * v0.x + v0.y * v0.y + v0.z * v0.z + v0.w * v0.w + v1.x * v1.x + v1.y * v1.y + v1.z * v1.z + v1.w * v1.w);
    float rstd = rsqrtf(ss * (1.f / 512) + NORM_EPS);
    float4 g0 = *(const float4*)(on + lane * 4), g1 = *(const float4*)(on + 256 + lane * 4);
    *(uint2*)(p.H + (size_t)tok * DM + 512 + lane * 4) = uint2{pk2(v0.x * rstd * g0.x, v0.y * rstd * g0.y), pk2(v0.z * rstd * g0.z, v0.w * rstd * g0.w)};
    *(uint2*)(p.H + (size_t)tok * DM + 768 + lane * 4) = uint2{pk2(v1.x * rstd * g1.x, v1.y * rstd * g1.y), pk2(v1.z * rstd * g1.z, v1.w * rstd * g1.w)};
  }
}

DI void ph_norm_router(const P& p, int layer) {
  const int lane = threadIdx.x & 63, w = threadIdx.x >> 6;
  const float* g = p.ffn_norm + layer * DM;
  const float* rt = p.router + (size_t)layer * DM * NE;
  for (int tok = blockIdx.x * 8 + w; tok < NTOK; tok += gridDim.x * 8) {
    const float4* xr = (const float4*)(p.out + (size_t)tok * DM);
    float4 v[4]; float ss = 0.f;
#pragma unroll
    for (int j = 0; j < 4; ++j) { v[j] = xr[lane + 64 * j]; ss += v[j].x * v[j].x + v[j].y * v[j].y + v[j].z * v[j].z + v[j].w * v[j].w; }
    ss = wave_sum(ss);
    float rstd = rsqrtf(ss * (1.f / DM) + NORM_EPS);
    float lg[NE];
#pragma unroll
    for (int e = 0; e < NE; ++e) lg[e] = 0.f;
#pragma unroll
    for (int j = 0; j < 4; ++j) {
      int c0 = (lane + 64 * j) * 4;
      float4 gg = *(const float4*)(g + c0);
      float hv[4] = {v[j].x * rstd * gg.x, v[j].y * rstd * gg.y, v[j].z * rstd * gg.z, v[j].w * rstd * gg.w};
      *(uint2*)(p.H + (size_t)tok * DM + c0) = uint2{pk2(hv[0], hv[1]), pk2(hv[2], hv[3])};
#pragma unroll
      for (int q = 0; q < 4; ++q) {
        const float4* rr = (const float4*)(rt + (size_t)(c0 + q) * NE);
        float4 r0 = rr[0], r1 = rr[1], r2 = rr[2], r3 = rr[3];
        lg[0] += hv[q] * r0.x; lg[1] += hv[q] * r0.y; lg[2] += hv[q] * r0.z; lg[3] += hv[q] * r0.w;
        lg[4] += hv[q] * r1.x; lg[5] += hv[q] * r1.y; lg[6] += hv[q] * r1.z; lg[7] += hv[q] * r1.w;
        lg[8] += hv[q] * r2.x; lg[9] += hv[q] * r2.y; lg[10] += hv[q] * r2.z; lg[11] += hv[q] * r2.w;
        lg[12] += hv[q] * r3.x; lg[13] += hv[q] * r3.y; lg[14] += hv[q] * r3.z; lg[15] += hv[q] * r3.w;
      }
    }
    float mx = -INFINITY;
#pragma unroll
    for (int e = 0; e < NE; ++e) { lg[e] = wave_sum(lg[e]); mx = fmaxf(mx, lg[e]); }
    float se = 0.f;
#pragma unroll
    for (int e = 0; e < NE; ++e) { lg[e] = expf(lg[e] - mx); se += lg[e]; }
    float inv = 1.f / se;
    int b = tok / T, t = tok % T;
    float mine = 0.f;
#pragma unroll
    for (int e = 0; e < NE; ++e) mine = (lane == e) ? lg[e] * inv : mine;
    if (lane < NE) p.AFF[((size_t)(b * NE + lane)) * T + t] = mine;
  }
}

DI void ph_topk(const P& p, char* smem) {
  unsigned* hist = (unsigned*)smem;
  unsigned* sc = hist + 256;
  unsigned* bc = sc + 2048;
  const int tid = threadIdx.x;
  for (int item = blockIdx.x; item < NB * NE; item += gridDim.x) {
    const float* a = p.AFF + (size_t)item * T;
    unsigned key[16];
#pragma unroll
    for (int i = 0; i < 4; ++i) {
      uint4 v = *(const uint4*)(a + tid * 16 + i * 4);
      key[i * 4 + 0] = v.x; key[i * 4 + 1] = v.y; key[i * 4 + 2] = v.z; key[i * 4 + 3] = v.w;
    }
    unsigned prefix = 0, mask = 0, need = CAP;
    for (int pass = 0; pass < 4; ++pass) {
      int shift = 24 - 8 * pass;
      __syncthreads();
      if (tid < 256) hist[tid] = 0;
      __syncthreads();
#pragma unroll
      for (int i = 0; i < 16; ++i)
        if ((key[i] & mask) == prefix) atomicAdd(&hist[(key[i] >> shift) & 255u], 1u);
      __syncthreads();
      if (tid == 0) {
        unsigned cum = 0; int bsel = 0; unsigned nd = need;
        for (int bb = 255; bb >= 0; --bb) {
          unsigned hc = hist[bb];
          if (cum + hc >= need) { bsel = bb; nd = need - cum; break; }
          cum += hc;
        }
        bc[0] = prefix | ((unsigned)bsel << shift); bc[1] = nd;
      }
      __syncthreads();
      prefix = bc[0]; need = bc[1]; mask |= (255u << shift);
    }
    unsigned ngt = 0, neq = 0;
#pragma unroll
    for (int i = 0; i < 16; ++i) { ngt += key[i] > prefix; neq += key[i] == prefix; }
    __syncthreads();
    unsigned* sA = sc; unsigned* sB = sc + 512; unsigned* eA = sc + 1024; unsigned* eB = sc + 1536;
    sA[tid] = ngt; eA[tid] = neq;
    __syncthreads();
    for (int off = 1; off < NTH; off <<= 1) {
      unsigned x = sA[tid] + ((tid >= off) ? sA[tid - off] : 0u);
      unsigned y = eA[tid] + ((tid >= off) ? eA[tid - off] : 0u);
      sB[tid] = x; eB[tid] = y;
      __syncthreads();
      unsigned* tmp = sA; sA = sB; sB = tmp; tmp = eA; eA = eB; eB = tmp;
    }
    unsigned gt_excl = sA[tid] - ngt, eq_excl = eA[tid] - neq;
    unsigned gt_total = sA[NTH - 1];
    int* idx = p.IDX + (size_t)item * CAP; float* gate = p.GATE + (size_t)item * CAP;
#pragma unroll
    for (int i = 0; i < 16; ++i) {
      if (key[i] > prefix) { idx[gt_excl] = tid * 16 + i; gate[gt_excl] = __uint_as_float(key[i]); ++gt_excl; }
      else if (key[i] == prefix) {
        if (eq_excl < need) { idx[gt_total + eq_excl] = tid * 16 + i; gate[gt_total + eq_excl] = __uint_as_float(key[i]); }
        ++eq_excl;
      }
    }
    __syncthreads();
  }
}

DI void ph_exp1(const P& p, int layer, char* smem) {
  for (int t = blockIdx.x; t < 32 * 4 * 16; t += gridDim.x) {
    int grp = t / 64, r = t % 64, tm = r / 16, tn = r % 16;
    int b = grp / NE, e = grp % NE;
    const int* gi = p.IDX + (size_t)grp * CAP + tm * GBM;
    const u16* Hb = p.H + (size_t)b * T * DM;
    const float* Wg = p.exp_w_gate + ((size_t)layer * NE + e) * DM * 1024;
    const float* Wu = p.exp_w_up + ((size_t)layer * NE + e) * DM * 1024;
    u16* hid = p.HID + ((size_t)grp * CAP + tm * GBM) * 1024;
    auto arow = [&](int row) -> const void* { return Hb + (size_t)gi[row] * DM; };
    gemm_tile<false, 1>(arow, Wg, Wu, 1024, DM, tn * 64, 1024, smem, [&](int row, int col, float g, float u) {
      float sv = g / (1.f + __expf(-g));
      hid[(size_t)row * 1024 + col] = f2bf(sv * u);
    });
    __syncthreads();
  }
}
DI void ph_exp2(const P& p, int layer, char* smem) {
  for (int t = blockIdx.x; t < 32 * 4 * 8; t += gridDim.x) {
    int grp = t / 32, r = t % 32, tm = r / 8, tn = r % 8;
    int b = grp / NE, e = grp % NE;
    const int* gi = p.IDX + (size_t)grp * CAP + tm * GBM;
    const float* gt = p.GATE + (size_t)grp * CAP + tm * GBM;
    const u16* hid = p.HID + ((size_t)grp * CAP + tm * GBM) * 1024;
    const float* Wd = p.exp_w_down + ((size_t)layer * NE + e) * 1024 * DM;
    float* xb = p.out + (size_t)b * T * DM;
    auto arow = [&](int row) -> const void* { return hid + (size_t)row * 1024; };
    gemm_tile<false, 0>(arow, Wd, nullptr, DM, 1024, tn * GBN, DM, smem, [&](int row, int col, float v, float) {
      unsafeAtomicAdd(xb + (size_t)gi[row] * DM + col, v * gt[row]);
    });
    __syncthreads();
  }
}

#define KDEF(name, ...) __global__ void __launch_bounds__(NTH) name(P p, int layer) { __shared__ __attribute__((aligned(16))) char smem[SMEM_BYTES]; (void)smem; (void)layer; __VA_ARGS__ }

KDEF(k_norm_attn, { ph_norm(layer == 0 ? p.x : p.out, p.attn_norm + layer * DM, p.H); })
KDEF(k_inproj, {
  float* Z = p.Z;
  ph_gemm<false>(p.H, DM, p.w_in + (size_t)layer * DM * INC, INC, NTOK, INC, DM, smem,
                 [&](int row, int col, float v) { Z[(size_t)row * INC + col] = v; });
})
KDEF(k_rwshift, { ph_rwshift(p, layer); })
KDEF(k_mlaprep1, { ph_mlaprep1(p, layer); })
KDEF(k_lora_w, {
  for (int d = 0; d < 2; ++d) {
    float* LW = p.LW + (size_t)d * NTOK * RWW; const float* w0 = p.rw_w0 + (layer * 2 + d) * RWW;
    ph_gemm<false>(p.TWD + (size_t)d * NTOK * 64, 64, p.rw_w_up + ((size_t)(layer * 2 + d)) * 64 * RWW, RWW, NTOK, RWW, 64, smem,
                   [&](int row, int col, float v) { LW[(size_t)row * RWW + col] = -0.6065306597126334f * sigmoidf_(v + w0[col]); });
  }
})
KDEF(k_lora_a, {
  for (int d = 0; d < 2; ++d) {
    float* AA = p.AA + (size_t)d * NTOK * RWW; const float* a0 = p.rw_a0 + (layer * 2 + d) * RWW;
    ph_gemm<false>(p.AD + (size_t)d * NTOK * 64, 64, p.rw_a_up + ((size_t)(layer * 2 + d)) * 64 * RWW, RWW, NTOK, RWW, 64, smem,
                   [&](int row, int col, float v) { AA[(size_t)row * RWW + col] = sigmoidf_(v + a0[col]); });
  }
})
KDEF(k_lora_g, {
  u16* G = p.G;
  ph_gemm<false>(p.SGD, 128, p.rw_g_up + (size_t)layer * 128 * RWW, RWW, NTOK, RWW, 128, smem,
                 [&](int row, int col, float v) { G[(size_t)row * RWW + col] = f2bf(v); });
})
KDEF(k_qup, {
  float* Q = p.QRAW;
  ph_gemm<false>(p.QDN, 256, p.mla_q_up + (size_t)layer * 256 * 768, 768, NTOK, 768, 256, smem,
                 [&](int row, int col, float v) { Q[(size_t)row * 768 + col] = v; });
})
KDEF(k_kvup, {
  float* KV = p.KVRAW;
  ph_gemm<false>(p.KVDN, 128, p.mla_kv_up + (size_t)layer * 128 * 1024, 1024, NTOK, 1024, 128, smem,
                 [&](int row, int col, float v) { KV[(size_t)row * 1024 + col] = v; });
})
KDEF(k_mlafinish, { ph_mlafinish(p); })
KDEF(k_attn, { ph_attn(p, smem); })
KDEF(k_scan, { ph_scan(p, layer, smem); })
KDEF(k_mixfinish, { ph_mixfinish(p, layer); })
KDEF(k_outproj, {
  const float* xs = (layer == 0) ? p.x : p.out; float* xo = p.out;
  ph_gemm<false>(p.H, DM, p.w_out + (size_t)layer * DM * DM, DM, NTOK, DM, DM, smem,
                 [&](int row, int col, float v) { xo[(size_t)row * DM + col] = xs[(size_t)row * DM + col] + v; });
})
KDEF(k_norm_router, { ph_norm_router(p, layer); })
KDEF(k_topk, { ph_topk(p, smem); })
KDEF(k_exp1, { ph_exp1(p, layer, smem); })
KDEF(k_exp2, { ph_exp2(p, layer, smem); })
KDEF(k_norm_ple, { ph_norm(p.out, p.ple_norm + layer * DM, p.H); })
KDEF(k_plegate, {
  float* PG = p.PG;
  ph_gemm<false>(p.H, DM, p.ple_gate + (size_t)layer * DM * DM, DM, NTOK, DM, DM, smem,
                 [&](int row, int col, float v) { PG[(size_t)row * DM + col] = sigmoidf_(v); });
})
KDEF(k_pleproj, {
  float* xo = p.out; const float* PG = p.PG;
  ph_gemm<true>(p.p + (size_t)layer * NTOK * DPLE, DPLE, p.ple_proj + (size_t)layer * DPLE * DM, DM, NTOK, DM, DPLE, smem,
                [&](int row, int col, float v) { xo[(size_t)row * DM + col] += v * PG[(size_t)row * DM + col]; });
})
KDEF(k_final, { ph_final_norm(p.out, p.final_norm); })

extern "C" void kernel_launch(void* const* d_in, const int* in_sizes, int n_in, void* d_out, int out_size, void* d_ws,
                              size_t ws_size, hipStream_t stream) {
  (void)in_sizes; (void)n_in; (void)out_size;
  P p{};
  p.x = (const float*)d_in[0]; p.p = (const float*)d_in[1]; p.pos = (const int*)d_in[2];
  p.attn_norm = (const float*)d_in[3]; p.w_in = (const float*)d_in[4]; p.rw_mu = (const float*)d_in[5];
  p.rw_w0 = (const float*)d_in[6]; p.rw_w_up = (const float*)d_in[7]; p.rw_a0 = (const float*)d_in[8];
  p.rw_a_up = (const float*)d_in[9]; p.rw_g_up = (const float*)d_in[10]; p.rw_k_k = (const float*)d_in[11];
  p.rw_k_a = (const float*)d_in[12]; p.rw_r_k = (const float*)d_in[13]; p.rw_lnx_w = (const float*)d_in[14];
  p.rw_lnx_b = (const float*)d_in[15]; p.mla_q_norm = (const float*)d_in[16]; p.mla_q_up = (const float*)d_in[17];
  p.mla_kv_norm = (const float*)d_in[18]; p.mla_kv_up = (const float*)d_in[19]; p.mla_o_norm = (const float*)d_in[20];
  p.w_out = (const float*)d_in[21]; p.ffn_norm = (const float*)d_in[22]; p.router = (const float*)d_in[23];
  p.exp_w_gate = (const float*)d_in[24]; p.exp_w_up = (const float*)d_in[25]; p.exp_w_down = (const float*)d_in[26];
  p.ple_norm = (const float*)d_in[27]; p.ple_proj = (const float*)d_in[28]; p.ple_gate = (const float*)d_in[29];
  p.final_norm = (const float*)d_in[30];
  p.out = (float*)d_out;

  char* ws = (char*)d_ws; size_t off = 0;
  auto take = [&](size_t bytes) { char* r = ws + off; off += (bytes + 255) & ~(size_t)255; return r; };
  char* regA = take((size_t)NTOK * INC * 4);
  p.Z = (float*)regA;
  p.LW = (float*)regA; p.AA = (float*)(regA + (size_t)2 * NTOK * RWW * 4); p.G = (u16*)(regA + (size_t)4 * NTOK * RWW * 4);
  p.HID = (u16*)regA;
  char* regB = take((size_t)3 * NTOK * RWW * 4);
  p.R = (float*)regB; p.K = p.R + (size_t)NTOK * RWW; p.V = p.K + (size_t)NTOK * RWW;
  p.PG = (float*)regB;
  char* regC = take((size_t)NTOK * (768 + 1024) * 4);
  p.QRAW = (float*)regC; p.KVRAW = p.QRAW + (size_t)NTOK * 768;
  p.AO = (float*)regC; p.O2 = p.AO + (size_t)NTOK * 512;
  p.TWD = (u16*)take((size_t)2 * NTOK * 64 * 2); p.AD = (u16*)take((size_t)2 * NTOK * 64 * 2);
  p.SGD = (u16*)take((size_t)NTOK * 128 * 2); p.QDN = (u16*)take((size_t)NTOK * 256 * 2);
  p.KVDN = (u16*)take((size_t)NTOK * 128 * 2); p.KR = (float*)take((size_t)NTOK * 32 * 4);
  p.Q = (u16*)take((size_t)NTOK * NH * 96 * 2); p.Kc = (u16*)take((size_t)NTOK * NH * 96 * 2);
  p.Vv = (u16*)take((size_t)NTOK * NH * 64 * 2);
  p.H = (u16*)take((size_t)NTOK * DM * 2);
  p.AFF = (float*)take((size_t)NB * NE * T * 4);
  p.IDX = (int*)take((size_t)NB * NE * CAP * 4);
  p.GATE = (float*)take((size_t)NB * NE * CAP * 4);
  if (off > ws_size) { fprintf(stderr, "workspace too small: need %zu have %zu\n", off, ws_size); return; }

  const dim3 blk(NTH);
  const int G1 = 1024, G2 = 2048;
  for (int layer = 0; layer < NL; ++layer) {
    hipLaunchKernelGGL(k_norm_attn, dim3(G2), blk, 0, stream, p, layer);
    hipLaunchKernelGGL(k_inproj, dim3(G1), blk, 0, stream, p, layer);
    hipLaunchKernelGGL(k_rwshift, dim3(G2), blk, 0, stream, p, layer);
    hipLaunchKernelGGL(k_mlaprep1, dim3(G2), blk, 0, stream, p, layer);
    hipLaunchKernelGGL(k_lora_w, dim3(G1), blk, 0, stream, p, layer);
    hipLaunchKernelGGL(k_lora_a, dim3(G1), blk, 0, stream, p, layer);
    hipLaunchKernelGGL(k_lora_g, dim3(G1), blk, 0, stream, p, layer);
    hipLaunchKernelGGL(k_qup, dim3(G1), blk, 0, stream, p, layer);
    hipLaunchKernelGGL(k_kvup, dim3(G1), blk, 0, stream, p, layer);
    hipLaunchKernelGGL(k_mlafinish, dim3(G2), blk, 0, stream, p, layer);
    hipLaunchKernelGGL(k_attn, dim3(1024), blk, 0, stream, p, layer);
    hipLaunchKernelGGL(k_scan, dim3(32), blk, 0, stream, p, layer);
    hipLaunchKernelGGL(k_mixfinish, dim3(G2), blk, 0, stream, p, layer);
    hipLaunchKernelGGL(k_outproj, dim3(G1), blk, 0, stream, p, layer);
    hipLaunchKernelGGL(k_norm_router, dim3(G2), blk, 0, stream, p, layer);
    hipLaunchKernelGGL(k_topk, dim3(32), blk, 0, stream, p, layer);
    hipLaunchKernelGGL(k_exp1, dim3(G2), blk, 0, stream, p, layer);
    hipLaunchKernelGGL(k_exp2, dim3(G1), blk, 0, stream, p, layer);
    hipLaunchKernelGGL(k_norm_ple, dim3(G2), blk, 0, stream, p, layer);
    hipLaunchKernelGGL(k_plegate, dim3(G1), blk, 0, stream, p, layer);
    hipLaunchKernelGGL(k_pleproj, dim3(G1), blk, 0, stream, p, layer);
  }
  hipLaunchKernelGGL(k_final, dim3(G2), blk, 0, stream, p, 0);
}
```

```cpp
#include <hip/hip_runtime.h>
#include <hip/hip_bf16.h>
#include <cstdio>
#include <cstdint>
#include <hip/hip_cooperative_groups.h>
namespace cg = cooperative_groups;

#define DI __device__ __forceinline__
#define LAS __attribute__((address_space(3)))

constexpr int NB = 2, T = 8192, NTOK = NB * T, DM = 1024, NL = 2;
constexpr int RWW = 512, RWC = 1920, INC = 2336;
constexpr int NH = 8;
constexpr int NE = 16, CAP = 1024;
constexpr int DPLE = 256;
constexpr int NTH = 512;
constexpr float NORM_EPS = 1e-6f, GN_EPS = 64e-5f;

using bf16x8 = __attribute__((ext_vector_type(8))) short;
using s16x4  = __attribute__((ext_vector_type(4))) short;
using f32x4  = __attribute__((ext_vector_type(4))) float;
using u32x4  = __attribute__((ext_vector_type(4))) unsigned;
using u32x2  = __attribute__((ext_vector_type(2))) unsigned;
typedef __bf16 bf2_t __attribute__((ext_vector_type(2)));
typedef unsigned short u16;

DI unsigned pk2(float a, float b) { bf2_t v = {(__bf16)a, (__bf16)b}; return __builtin_bit_cast(unsigned, v); }
DI u16 f2bf(float a) { return (u16)(pk2(a, 0.f) & 0xffffu); }
DI float bf2f(u16 u) { return __uint_as_float(((unsigned)u) << 16); }
DI int tidx() { int t = threadIdx.x; asm volatile("" : "+v"(t)); return t; }
DI int bidx() { int b = blockIdx.x; asm volatile("" : "+s"(b)); return b; }
DI float wave_sum(float v) {
#pragma unroll
  for (int o = 32; o >= 1; o >>= 1) v += __shfl_xor(v, o);
  return v;
}
DI float sigmoidf_(float x) { return 1.f / (1.f + __expf(-x)); }
DI s16x4 tr_read(const short* p) {
  return __builtin_amdgcn_ds_read_tr16_b64_v4i16((LAS s16x4*)(p));
}

struct P {
  const float* x; const float* p; const int* pos;
  const float* attn_norm; const float* w_in; const float* rw_mu; const float* rw_w0; const float* rw_w_up;
  const float* rw_a0; const float* rw_a_up; const float* rw_g_up; const float* rw_k_k; const float* rw_k_a;
  const float* rw_r_k; const float* rw_lnx_w; const float* rw_lnx_b; const float* mla_q_norm; const float* mla_q_up;
  const float* mla_kv_norm; const float* mla_kv_up; const float* mla_o_norm; const float* w_out; const float* ffn_norm;
  const float* router; const float* exp_w_gate; const float* exp_w_up; const float* exp_w_down; const float* ple_norm;
  const float* ple_proj; const float* ple_gate; const float* final_norm;
  float* out;
  float* Z;
  float* LW;
  float* AA;
  u16*   G;
  u16*   HID;
  float* R; float* K; float* V;
  float* PG;
  float* QRAW;
  float* KVRAW;
  float* AO;
  float* O2;
  u16* TWD; u16* AD; u16* SGD; u16* QDN; u16* KVDN; float* KR;
  u16* Q; u16* Kc; u16* Vv;
  u16* H;
  float* AFF;
  int* IDX;
  float* GATE;
  unsigned* CTR;
};

constexpr int GBM = 256, GBN = 128, GBK = 64;
constexpr int AS_STRIDE = 72, BS_STRIDE = 136;
constexpr int AS_BYTES = GBM * AS_STRIDE * 2;
constexpr int BS_BYTES = GBK * BS_STRIDE * 2;
constexpr int SMEM_BYTES = 57344;

template <bool A_F32, int MODE, class ARow, class Epi>
DI void gemm_tile(ARow arow, const float* __restrict__ B, const float* __restrict__ B2, int ldb, int K, int n0, int Nvalid,
                  char* smem, Epi epi) {
  short* As = (short*)smem;
  short* Bs = (short*)(smem + AS_BYTES);
  const int tid = tidx(), lane = tid & 63, w = tid >> 6;
  const int wm = w >> 1, wn = w & 1;
  const int l15 = lane & 15, lq = lane >> 4;

  const char* ap[4];
#pragma unroll
  for (int i = 0; i < 4; ++i) {
    int u = tid + i * NTH; int row = u >> 3, kc = u & 7;
    ap[i] = (const char*)arow(row) + (size_t)kc * 8 * (A_F32 ? 4 : 2);
  }
  const float* bp[4]; bool bok[4];
#pragma unroll
  for (int i = 0; i < 4; ++i) {
    int u = tid + i * NTH; int k = u >> 5, nq = u & 31;
    int col; const float* base;
    if (MODE == 0) { col = n0 + nq * 4; base = B; }
    else { col = n0 + (nq & 15) * 4; base = (nq < 16) ? B : B2; }
    bok[i] = col < Nvalid;
    bp[i] = base + (size_t)k * ldb + (bok[i] ? col : 0);
  }

  f32x4 acc[4][4];
#pragma unroll
  for (int i = 0; i < 4; ++i)
#pragma unroll
    for (int j = 0; j < 4; ++j) acc[i][j] = f32x4{0.f, 0.f, 0.f, 0.f};

  u32x4 areg[4]; f32x4 breg[4];
#define GLOAD(kt_)                                                                                   \
  {                                                                                                  \
    _Pragma("unroll") for (int i = 0; i < 4; ++i) {                                                  \
      if (A_F32) {                                                                                   \
        const float4* q = (const float4*)(ap[i] + (size_t)(kt_) * GBK * 4);                          \
        float4 v0 = q[0], v1 = q[1];                                                                 \
        areg[i] = u32x4{pk2(v0.x, v0.y), pk2(v0.z, v0.w), pk2(v1.x, v1.y), pk2(v1.z, v1.w)};         \
      } else {                                                                                       \
        areg[i] = *(const u32x4*)(ap[i] + (size_t)(kt_) * GBK * 2);                                  \
      }                                                                                              \
    }                                                                                                \
    _Pragma("unroll") for (int i = 0; i < 4; ++i) {                                                  \
      if (bok[i]) breg[i] = *(const f32x4*)(bp[i] + (size_t)(kt_) * GBK * ldb);                      \
      else breg[i] = f32x4{0.f, 0.f, 0.f, 0.f};                                                      \
    }                                                                                                \
  }
  const int nk = K / GBK;
  GLOAD(0)
  for (int kt = 0; kt < nk; ++kt) {
    __syncthreads();
#pragma unroll
    for (int i = 0; i < 4; ++i) {
      int u = tid + i * NTH; int row = u >> 3, kc = u & 7;
      *(u32x4*)(As + row * AS_STRIDE + kc * 8) = areg[i];
    }
#pragma unroll
    for (int i = 0; i < 4; ++i) {
      int u = tid + i * NTH; int k = u >> 5, nq = u & 31;
      u32x2 v = u32x2{pk2(breg[i][0], breg[i][1]), pk2(breg[i][2], breg[i][3])};
      *(u32x2*)(Bs + k * BS_STRIDE + nq * 4) = v;
    }
    __syncthreads();
    if (kt + 1 < nk) GLOAD(kt + 1)
#pragma unroll
    for (int ks = 0; ks < 2; ++ks) {
      bf16x8 a[4], b[4];
#pragma unroll
      for (int mi = 0; mi < 4; ++mi)
        a[mi] = *(const bf16x8*)(As + (wm * 64 + mi * 16 + l15) * AS_STRIDE + ks * 32 + 8 * lq);
#pragma unroll
      for (int ni = 0; ni < 4; ++ni) {
        int col0 = (MODE == 0) ? (wn * 64 + ni * 16) : ((ni < 2) ? (wn * 32 + ni * 16) : (64 + wn * 32 + (ni - 2) * 16));
        int kb = ks * 32 + 8 * lq; int q = l15 >> 2, pp = l15 & 3;
        s16x4 lo = tr_read(Bs + (kb + q) * BS_STRIDE + col0 + 4 * pp);
        s16x4 hi = tr_read(Bs + (kb + 4 + q) * BS_STRIDE + col0 + 4 * pp);
        b[ni] = __builtin_shufflevector(lo, hi, 0, 1, 2, 3, 4, 5, 6, 7);
      }
#pragma unroll
      for (int mi = 0; mi < 4; ++mi)
#pragma unroll
        for (int ni = 0; ni < 4; ++ni)
          acc[mi][ni] = __builtin_amdgcn_mfma_f32_16x16x32_bf16(a[mi], b[ni], acc[mi][ni], 0, 0, 0);
    }
  }
#pragma unroll
  for (int mi = 0; mi < 4; ++mi)
#pragma unroll
    for (int r = 0; r < 4; ++r) {
      int row = wm * 64 + mi * 16 + lq * 4 + r;
      if (MODE == 0) {
#pragma unroll
        for (int ni = 0; ni < 4; ++ni) {
          int col = n0 + wn * 64 + ni * 16 + l15;
          if (col < Nvalid) epi(row, col, acc[mi][ni][r], 0.f);
        }
      } else {
#pragma unroll
        for (int ni = 0; ni < 2; ++ni) {
          int col = n0 + wn * 32 + ni * 16 + l15;
          epi(row, col, acc[mi][ni][r], acc[mi][ni + 2][r]);
        }
      }
    }
}

DI void ph_norm(const float* __restrict__ X, const float* __restrict__ g, u16* __restrict__ Hout) {
  const int tid_ = tidx(); const int lane = tid_ & 63, w = tid_ >> 6;
  for (int tok = blockIdx.x * 8 + w; tok < NTOK; tok += gridDim.x * 8) {
    const float4* xr = (const float4*)(X + (size_t)tok * DM);
    float4 v[4]; float ss = 0.f;
#pragma unroll
    for (int j = 0; j < 4; ++j) { v[j] = xr[lane + 64 * j]; ss += v[j].x * v[j].x + v[j].y * v[j].y + v[j].z * v[j].z + v[j].w * v[j].w; }
    ss = wave_sum(ss);
    float rstd = rsqrtf(ss * (1.f / DM) + NORM_EPS);
#pragma unroll
    for (int j = 0; j < 4; ++j) {
      float4 gg = ((const float4*)g)[lane + 64 * j];
      uint2 o = uint2{pk2(v[j].x * rstd * gg.x, v[j].y * rstd * gg.y), pk2(v[j].z * rstd * gg.z, v[j].w * rstd * gg.w)};
      *(uint2*)(Hout + (size_t)tok * DM + (lane + 64 * j) * 4) = o;
    }
  }
}

DI void ph_final_norm(float* __restrict__ X, const float* __restrict__ g) {
  const int tid_ = tidx(); const int lane = tid_ & 63, w = tid_ >> 6;
  for (int tok = blockIdx.x * 8 + w; tok < NTOK; tok += gridDim.x * 8) {
    float4* xr = (float4*)(X + (size_t)tok * DM);
    float4 v[4]; float ss = 0.f;
#pragma unroll
    for (int j = 0; j < 4; ++j) { v[j] = xr[lane + 64 * j]; ss += v[j].x * v[j].x + v[j].y * v[j].y + v[j].z * v[j].z + v[j].w * v[j].w; }
    ss = wave_sum(ss);
    float rstd = rsqrtf(ss * (1.f / DM) + NORM_EPS);
#pragma unroll
    for (int j = 0; j < 4; ++j) {
      float4 gg = ((const float4*)g)[lane + 64 * j];
      xr[lane + 64 * j] = float4{v[j].x * rstd * gg.x, v[j].y * rstd * gg.y, v[j].z * rstd * gg.z, v[j].w * rstd * gg.w};
    }
  }
}

template <bool A_F32, class Epi>
DI void ph_gemm(const void* A, int lda, const float* B, int ldb, int M, int N, int K, char* smem, Epi epi) {
  const int ntn = (N + GBN - 1) / GBN, ntm = M / GBM;
  for (int t = blockIdx.x; t < ntm * ntn; t += gridDim.x) {
    int tm = t / ntn, tn = t % ntn;
    int m0 = tm * GBM, n0 = tn * GBN;
    auto arow = [&](int r) -> const void* { return (const char*)A + (size_t)(m0 + r) * lda * (A_F32 ? 4 : 2); };
    gemm_tile<A_F32, 0>(arow, B, nullptr, ldb, K, n0, N, smem, [&](int row, int col, float v, float) { epi(m0 + row, col, v); });
    __syncthreads();
  }
}

DI void ph_rwshift(const P& p, int layer) {
  const float* mu = p.rw_mu + layer * RWC;
  const int total = NTOK * (RWC / 4);
  const int tid_ = tidx();
  for (int i = blockIdx.x * NTH + tid_; i < total; i += gridDim.x * NTH) {
    int tok = i / (RWC / 4), c = (i % (RWC / 4)) * 4;
    int t = tok % T;
    const float* zr = p.Z + (size_t)tok * INC + c;
    float4 z = *(const float4*)zr;
    float4 zm = (t > 0) ? *(const float4*)(zr - INC) : float4{0.f, 0.f, 0.f, 0.f};
    float4 zp = (t < T - 1) ? *(const float4*)(zr + INC) : float4{0.f, 0.f, 0.f, 0.f};
    float4 m = *(const float4*)(mu + c);
    float4 o;
    o.x = z.x + m.x * (0.5f * (zm.x + zp.x) - z.x);
    o.y = z.y + m.y * (0.5f * (zm.y + zp.y) - z.y);
    o.z = z.z + m.z * (0.5f * (zm.z + zp.z) - z.z);
    o.w = z.w + m.w * (0.5f * (zm.w + zp.w) - z.w);
    if (c < 512) *(float4*)(p.R + (size_t)tok * RWW + c) = o;
    else if (c < 1024) *(float4*)(p.K + (size_t)tok * RWW + (c - 512)) = o;
    else if (c < 1536) *(float4*)(p.V + (size_t)tok * RWW + (c - 1024)) = o;
    else if (c < 1664) {
      int d = (c - 1536) >> 6, l = (c - 1536) & 63;
      *(uint2*)(p.TWD + ((size_t)d * NTOK + tok) * 64 + l) = uint2{pk2(tanhf(o.x), tanhf(o.y)), pk2(tanhf(o.z), tanhf(o.w))};
    } else if (c < 1792) {
      int d = (c - 1664) >> 6, l = (c - 1664) & 63;
      *(uint2*)(p.AD + ((size_t)d * NTOK + tok) * 64 + l) = uint2{pk2(o.x, o.y), pk2(o.z, o.w)};
    } else {
      int l = c - 1792;
      *(uint2*)(p.SGD + (size_t)tok * 128 + l) = uint2{pk2(sigmoidf_(o.x), sigmoidf_(o.y)), pk2(sigmoidf_(o.z), sigmoidf_(o.w))};
    }
  }
}

DI void rope_cs(int pos, int i, float& cs, float& sn) {
  const int i3 = i & 3, i2 = i >> 2;
  const float c4 = (i3 == 0) ? 1.0f : (i3 == 1) ? 0.5623413251903491f : (i3 == 2) ? 0.31622776601683794f : 0.1778279410038923f;
  const float p10 = (i2 == 0) ? 1.0f : (i2 == 1) ? 0.1f : (i2 == 2) ? 0.01f : 0.001f;
  float inv = c4 * p10;
  float ang = (float)pos * inv;
  double rev = (double)ang * 0.15915494309189535;
  rev -= floor(rev);
  float rf = (float)rev;
  sn = __builtin_amdgcn_sinf(rf);
  cs = __builtin_amdgcn_cosf(rf);
}

DI void ph_mlaprep1(const P& p, int layer) {
  const int tid_ = tidx(); const int lane = tid_ & 63, w = tid_ >> 6;
  const float* qn = p.mla_q_norm + layer * 256;
  const float* kvn = p.mla_kv_norm + layer * 128;
  for (int tok = blockIdx.x * 8 + w; tok < NTOK; tok += gridDim.x * 8) {
    const float* zr = p.Z + (size_t)tok * INC + RWC;
    float4 q = *(const float4*)(zr + lane * 4);
    float ss = wave_sum(q.x * q.x + q.y * q.y + q.z * q.z + q.w * q.w);
    float rstd = rsqrtf(ss * (1.f / 256) + NORM_EPS);
    float4 g = *(const float4*)(qn + lane * 4);
    *(uint2*)(p.QDN + (size_t)tok * 256 + lane * 4) = uint2{pk2(q.x * rstd * g.x, q.y * rstd * g.y), pk2(q.z * rstd * g.z, q.w * rstd * g.w)};
    float2 kv = *(const float2*)(zr + 256 + lane * 2);
    float ss2 = wave_sum(kv.x * kv.x + kv.y * kv.y);
    float rstd2 = rsqrtf(ss2 * (1.f / 128) + NORM_EPS);
    float2 g2 = *(const float2*)(kvn + lane * 2);
    *(unsigned*)(p.KVDN + (size_t)tok * 128 + lane * 2) = pk2(kv.x * rstd2 * g2.x, kv.y * rstd2 * g2.y);
    if (lane < 16) {
      float u1 = zr[384 + lane], u2 = zr[384 + 16 + lane];
      float cs, sn; rope_cs(p.pos[tok], lane, cs, sn);
      p.KR[(size_t)tok * 32 + lane] = u1 * cs - u2 * sn;
      p.KR[(size_t)tok * 32 + 16 + lane] = u1 * sn + u2 * cs;
    }
  }
}

DI void ph_mlafinish(const P& p) {
  const int tid_ = tidx(); const int lane = tid_ & 63, w = tid_ >> 6;
  const float qs = 0.10206207261596577f * 1.4426950408889634f;
  for (int tok = blockIdx.x * 8 + w; tok < NTOK; tok += gridDim.x * 8) {
    int b = tok / T, t = tok % T;
    float cs = 0.f, sn = 0.f;
    if (lane < 16) rope_cs(p.pos[tok], lane, cs, sn);
    const float* qr = p.QRAW + (size_t)tok * 768;
    const float* kvr = p.KVRAW + (size_t)tok * 1024;
    const float* kr = p.KR + (size_t)tok * 32;
#pragma unroll
    for (int h = 0; h < NH; ++h) {
      size_t row = ((size_t)(b * NH + h) * T + t);
      u16* qo = p.Q + row * 96; u16* ko = p.Kc + row * 96; u16* vo = p.Vv + row * 64;
      qo[lane] = f2bf(qr[h * 96 + lane] * qs);
      ko[lane] = f2bf(kvr[h * 128 + lane]);
      vo[lane] = f2bf(kvr[h * 128 + 64 + lane]);
      if (lane < 16) {
        float u1 = qr[h * 96 + 64 + lane], u2 = qr[h * 96 + 80 + lane];
        qo[64 + lane] = f2bf((u1 * cs - u2 * sn) * qs);
        qo[80 + lane] = f2bf((u1 * sn + u2 * cs) * qs);
      }
      if (lane < 32) ko[64 + lane] = f2bf(kr[lane]);
    }
  }
}

constexpr int KS_STRIDE = 104, VS_STRIDE = 72, PS_STRIDE = 72;
DI void ph_attn(const P& p, char* smem, unsigned* ctr) {
  short* Ks = (short*)smem;
  short* Vs = (short*)(smem + 64 * KS_STRIDE * 2);
  short* Ps = (short*)(smem + 64 * KS_STRIDE * 2 + 64 * VS_STRIDE * 2);
  const int tid = tidx(), lane = tid & 63, w = tid >> 6;
  const int l15 = lane & 15, lq = lane >> 4;
  short* Pw = Ps + w * 16 * PS_STRIDE;
  int* sitem = (int*)(smem + SMEM_BYTES - 16);
  for (;;) {
    __syncthreads();
    if (tid == 0) *sitem = (int)atomicAdd(ctr, 1u);
    __syncthreads();
    const int item = *sitem;
    if (item >= NB * NH * (T / 128)) break;
    int bh = item / (T / 128), qt = item % (T / 128);
    const u16* Qb = p.Q + (size_t)bh * T * 96;
    const u16* Kb = p.Kc + (size_t)bh * T * 96;
    const u16* Vb = p.Vv + (size_t)bh * T * 64;
    int qrow = qt * 128 + w * 16 + l15;
    bf16x8 qf[3];
#pragma unroll
    for (int ks = 0; ks < 3; ++ks) qf[ks] = *(const bf16x8*)(Qb + (size_t)qrow * 96 + ks * 32 + 8 * lq);
    float m[4], ls[4]; f32x4 o[4];
#pragma unroll
    for (int r = 0; r < 4; ++r) { m[r] = -INFINITY; ls[r] = 0.f; }
#pragma unroll
    for (int ni = 0; ni < 4; ++ni) o[ni] = f32x4{0.f, 0.f, 0.f, 0.f};

    uint4 kreg0, kreg1, vreg;
    auto gl = [&](int kt) {
      const u16* kp = Kb + (size_t)kt * 64 * 96;
      kreg0 = *(const uint4*)(kp + (size_t)tid * 8);
      if (tid < 256) kreg1 = *(const uint4*)(kp + (size_t)(tid + 512) * 8);
      vreg = *(const uint4*)(Vb + (size_t)kt * 64 * 64 + (size_t)tid * 8);
    };
    gl(0);
    for (int kt = 0; kt < T / 64; ++kt) {
      __syncthreads();
      { int c = tid; int row = c / 12, cc = c % 12; *(uint4*)(Ks + row * KS_STRIDE + cc * 8) = kreg0; }
      if (tid < 256) { int c = tid + 512; int row = c / 12, cc = c % 12; *(uint4*)(Ks + row * KS_STRIDE + cc * 8) = kreg1; }
      { int row = tid >> 3, cc = tid & 7; *(uint4*)(Vs + row * VS_STRIDE + cc * 8) = vreg; }
      __syncthreads();
      if (kt + 1 < T / 64) gl(kt + 1);
      f32x4 s[4];
#pragma unroll
      for (int nt = 0; nt < 4; ++nt) {
        s[nt] = f32x4{0.f, 0.f, 0.f, 0.f};
#pragma unroll
        for (int ks = 0; ks < 3; ++ks) {
          bf16x8 kb = *(const bf16x8*)(Ks + (nt * 16 + l15) * KS_STRIDE + ks * 32 + 8 * lq);
          s[nt] = __builtin_amdgcn_mfma_f32_16x16x32_bf16(qf[ks], kb, s[nt], 0, 0, 0);
        }
      }
#pragma unroll
      for (int r = 0; r < 4; ++r) {
        float mx = fmaxf(fmaxf(s[0][r], s[1][r]), fmaxf(s[2][r], s[3][r]));
        mx = fmaxf(mx, __shfl_xor(mx, 1)); mx = fmaxf(mx, __shfl_xor(mx, 2));
        mx = fmaxf(mx, __shfl_xor(mx, 4)); mx = fmaxf(mx, __shfl_xor(mx, 8));
        float mn = fmaxf(m[r], mx);
        float alpha = __builtin_amdgcn_exp2f(m[r] - mn);
        m[r] = mn;
        float ps = 0.f;
#pragma unroll
        for (int nt = 0; nt < 4; ++nt) {
          float pv = __builtin_amdgcn_exp2f(s[nt][r] - mn);
          ps += pv;
          Pw[(lq * 4 + r) * PS_STRIDE + nt * 16 + l15] = (short)f2bf(pv);
        }
        ls[r] = ls[r] * alpha + ps;
#pragma unroll
        for (int ni = 0; ni < 4; ++ni) o[ni][r] *= alpha;
      }
      __syncthreads();
#pragma unroll
      for (int kk = 0; kk < 2; ++kk) {
        bf16x8 a = *(const bf16x8*)(Pw + l15 * PS_STRIDE + kk * 32 + 8 * lq);
        int kb = kk * 32 + 8 * lq; int q = l15 >> 2, pp = l15 & 3;
#pragma unroll
        for (int ni = 0; ni < 4; ++ni) {
          s16x4 lo = tr_read(Vs + (kb + q) * VS_STRIDE + ni * 16 + 4 * pp);
          s16x4 hi = tr_read(Vs + (kb + 4 + q) * VS_STRIDE + ni * 16 + 4 * pp);
          bf16x8 vb = __builtin_shufflevector(lo, hi, 0, 1, 2, 3, 4, 5, 6, 7);
          o[ni] = __builtin_amdgcn_mfma_f32_16x16x32_bf16(a, vb, o[ni], 0, 0, 0);
        }
      }
    }
    int b = bh / NH, h = bh % NH;
#pragma unroll
    for (int r = 0; r < 4; ++r) {
      float l = ls[r];
      l += __shfl_xor(l, 1); l += __shfl_xor(l, 2); l += __shfl_xor(l, 4); l += __shfl_xor(l, 8);
      float inv = 1.f / l;
      int t = qt * 128 + w * 16 + lq * 4 + r;
      float* orow = p.AO + ((size_t)(b * T + t)) * 512 + h * 64;
#pragma unroll
      for (int ni = 0; ni < 4; ++ni) orow[ni * 16 + l15] = o[ni][r] * inv;
    }
    __syncthreads();
  }
}

DI void ph_scan(const P& p, int layer, char* smem) {
  float* sw = (float*)smem; float* skk = sw + 1024; float* sba = skk + 1024; float* skd = sba + 1024;
  float* sr = skd + 1024; float* sv = sr + 1024; float* so = sv + 1024;
  const int tid = tidx(), lane = tid & 63, w = tid >> 6;
  const int v = tid >> 3, kq = tid & 7;
  for (int item = blockIdx.x; item < NB * NH * 2; item += gridDim.x) {
    int d = item & 1, h = (item >> 1) % NH, b = item / (2 * NH);
    const float* LWd = p.LW + (size_t)d * NTOK * RWW;
    const float* AAd = p.AA + (size_t)d * NTOK * RWW;
    float* Od = p.O2 + (size_t)d * NTOK * RWW;
    const int ch = h * 64 + lane;
    const float kkc = p.rw_k_k[layer * RWW + ch], kac = p.rw_k_a[layer * RWW + ch];
    float S[8];
#pragma unroll
    for (int i = 0; i < 8; ++i) S[i] = 0.f;
    for (int c = 0; c < T / 16; ++c) {
      int t0 = (d == 0) ? c * 16 : T - 16 * (c + 1);
      __syncthreads();
#pragma unroll
      for (int jj = 0; jj < 2; ++jj) {
        int j = w + 8 * jj; size_t off = ((size_t)(b * T + t0 + j)) * RWW + ch;
        float kv = p.K[off];
        float kx = kv * kkc;
        float nrm = sqrtf(wave_sum(kx * kx));
        float kkv = kx / fmaxf(nrm, 1e-12f);
        float a = AAd[off];
        sw[j * 64 + lane] = __expf(LWd[off]);
        skk[j * 64 + lane] = kkv;
        sba[j * 64 + lane] = a * kkv;
        skd[j * 64 + lane] = kv * (1.f + (a - 1.f) * kac);
        sr[j * 64 + lane] = p.R[off];
        sv[j * 64 + lane] = p.V[off];
      }
      __syncthreads();
      for (int jj = 0; jj < 16; ++jj) {
        int j = (d == 0) ? jj : 15 - jj;
        const float4* w4 = (const float4*)(sw + j * 64 + kq * 8);
        const float4* k4 = (const float4*)(skk + j * 64 + kq * 8);
        const float4* b4 = (const float4*)(sba + j * 64 + kq * 8);
        const float4* d4 = (const float4*)(skd + j * 64 + kq * 8);
        const float4* r4 = (const float4*)(sr + j * 64 + kq * 8);
        float4 wa = w4[0], wb = w4[1], ka = k4[0], kb = k4[1], ba = b4[0], bb = b4[1], da = d4[0], db = d4[1], ra = r4[0], rb = r4[1];
        float wv[8] = {wa.x, wa.y, wa.z, wa.w, wb.x, wb.y, wb.z, wb.w};
        float kv8[8] = {ka.x, ka.y, ka.z, ka.w, kb.x, kb.y, kb.z, kb.w};
        float bv[8] = {ba.x, ba.y, ba.z, ba.w, bb.x, bb.y, bb.z, bb.w};
        float dv[8] = {da.x, da.y, da.z, da.w, db.x, db.y, db.z, db.w};
        float rv[8] = {ra.x, ra.y, ra.z, ra.w, rb.x, rb.y, rb.z, rb.w};
        float vv = sv[j * 64 + v];
        float sa = 0.f;
#pragma unroll
        for (int i = 0; i < 8; ++i) sa -= S[i] * kv8[i];
        sa += __shfl_xor(sa, 1); sa += __shfl_xor(sa, 2); sa += __shfl_xor(sa, 4);
        float oo = 0.f;
#pragma unroll
        for (int i = 0; i < 8; ++i) { S[i] = S[i] * wv[i] + sa * bv[i] + vv * dv[i]; oo += S[i] * rv[i]; }
        oo += __shfl_xor(oo, 1); oo += __shfl_xor(oo, 2); oo += __shfl_xor(oo, 4);
        if (kq == 0) so[j * 64 + v] = oo;
      }
      __syncthreads();
#pragma unroll
      for (int jj = 0; jj < 2; ++jj) {
        int j = w + 8 * jj;
        Od[((size_t)(b * T + t0 + j)) * RWW + ch] = so[j * 64 + lane];
      }
    }
    __syncthreads();
  }
}

DI void ph_mixfinish(const P& p, int layer) {
  const int tid_ = tidx(); const int lane = tid_ & 63, w = tid_ >> 6;
  const float* lw = p.rw_lnx_w + layer * RWW; const float* lb = p.rw_lnx_b + layer * RWW;
  const float* kac = p.rw_k_a + layer * RWW; const float* rk = p.rw_r_k + layer * RWW;
  const float* on = p.mla_o_norm + layer * 512;
  for (int tok = blockIdx.x * 8 + w; tok < NTOK; tok += gridDim.x * 8) {
#pragma unroll
    for (int h = 0; h < NH; ++h) {
      int c = h * 64 + lane; size_t off = (size_t)tok * RWW + c;
      float o = p.O2[off] + p.O2[(size_t)NTOK * RWW + off];
      float mean = wave_sum(o) * (1.f / 64);
      float dv = o - mean;
      float var = wave_sum(dv * dv) * (1.f / 64);
      float on_ = dv * rsqrtf(var + GN_EPS) * lw[c] + lb[c];
      float k = p.K[off], r = p.R[off], vv = p.V[off];
      float a0 = p.AA[off], a1 = p.AA[(size_t)NTOK * RWW + off];
      float kb = 0.5f * (k * (1.f + (a0 - 1.f) * kac[c]) + k * (1.f + (a1 - 1.f) * kac[c]));
      float s = wave_sum(r * kb * rk[c]);
      float y = (on_ + s * vv) * bf2f(p.G[off]);
      p.H[(size_t)tok * DM + c] = f2bf(y);
    }
    const float* ao = p.AO + (size_t)tok * 512;
    float4 v0 = *(const float4*)(ao + lane * 4), v1 = *(const float4*)(ao + 256 + lane * 4);
    float ss = wave_sum(v0.x * v0.x + v0.y * v0.y + v0.z * v0.z + v0.w * v0.w + v1.x * v1.x + v1.y * v1.y + v1.z * v1.z + v1.w * v1.w);
    float rstd = rsqrtf(ss * (1.f / 512) + NORM_EPS);
    float4 g0 = *(const float4*)(on + lane * 4), g1 = *(const float4*)(on + 256 + lane * 4);
    *(uint2*)(p.H + (size_t)tok * DM + 512 + lane * 4) = uint2{pk2(v0.x * rstd * g0.x, v0.y * rstd * g0.y), pk2(v0.z * rstd * g0.z, v0.w * rstd * g0.w)};
    *(uint2*)(p.H + (size_t)tok * DM + 768 + lane * 4) = uint2{pk2(v1.x * rstd * g1.x, v1.y * rstd * g1.y), pk2(v1.z * rstd * g1.z, v1.w * rstd * g1.w)};
  }
}

DI void ph_norm_router(const P& p, int layer) {
  const int tid_ = tidx(); const int lane = tid_ & 63, w = tid_ >> 6;
  const float* g = p.ffn_norm + layer * DM;
  const float* rt = p.router + (size_t)layer * DM * NE;
  for (int tok = blockIdx.x * 8 + w; tok < NTOK; tok += gridDim.x * 8) {
    const float4* xr = (const float4*)(p.out + (size_t)tok * DM);
    float4 v[4]; float ss = 0.f;
#pragma unroll
    for (int j = 0; j < 4; ++j) { v[j] = xr[lane + 64 * j]; ss += v[j].x * v[j].x + v[j].y * v[j].y + v[j].z * v[j].z + v[j].w * v[j].w; }
    ss = wave_sum(ss);
    float rstd = rsqrtf(ss * (1.f / DM) + NORM_EPS);
    float lg[NE];
#pragma unroll
    for (int e = 0; e < NE; ++e) lg[e] = 0.f;
#pragma unroll
    for (int j = 0; j < 4; ++j) {
      int c0 = (lane + 64 * j) * 4;
      float4 gg = *(const float4*)(g + c0);
      float hv[4] = {v[j].x * rstd * gg.x, v[j].y * rstd * gg.y, v[j].z * rstd * gg.z, v[j].w * rstd * gg.w};
      *(uint2*)(p.H + (size_t)tok * DM + c0) = uint2{pk2(hv[0], hv[1]), pk2(hv[2], hv[3])};
#pragma unroll
      for (int q = 0; q < 4; ++q) {
        const float4* rr = (const float4*)(rt + (size_t)(c0 + q) * NE);
        float4 r0 = rr[0], r1 = rr[1], r2 = rr[2], r3 = rr[3];
        lg[0] += hv[q] * r0.x; lg[1] += hv[q] * r0.y; lg[2] += hv[q] * r0.z; lg[3] += hv[q] * r0.w;
        lg[4] += hv[q] * r1.x; lg[5] += hv[q] * r1.y; lg[6] += hv[q] * r1.z; lg[7] += hv[q] * r1.w;
        lg[8] += hv[q] * r2.x; lg[9] += hv[q] * r2.y; lg[10] += hv[q] * r2.z; lg[11] += hv[q] * r2.w;
        lg[12] += hv[q] * r3.x; lg[13] += hv[q] * r3.y; lg[14] += hv[q] * r3.z; lg[15] += hv[q] * r3.w;
      }
    }
    float mx = -INFINITY;
#pragma unroll
    for (int e = 0; e < NE; ++e) { lg[e] = wave_sum(lg[e]); mx = fmaxf(mx, lg[e]); }
    float se = 0.f;
#pragma unroll
    for (int e = 0; e < NE; ++e) { lg[e] = expf(lg[e] - mx); se += lg[e]; }
    float inv = 1.f / se;
    int b = tok / T, t = tok % T;
    float mine = 0.f;
#pragma unroll
    for (int e = 0; e < NE; ++e) mine = (lane == e) ? lg[e] * inv : mine;
    if (lane < NE) p.AFF[((size_t)(b * NE + lane)) * T + t] = mine;
  }
}

DI void ph_topk(const P& p, char* smem) {
  unsigned* hist = (unsigned*)smem;
  unsigned* sc = hist + 256;
  unsigned* bc = sc + 2048;
  const int tid = tidx();
  for (int item = blockIdx.x; item < NB * NE; item += gridDim.x) {
    const float* a = p.AFF + (size_t)item * T;
    unsigned key[16];
#pragma unroll
    for (int i = 0; i < 4; ++i) {
      uint4 v = *(const uint4*)(a + tid * 16 + i * 4);
      key[i * 4 + 0] = v.x; key[i * 4 + 1] = v.y; key[i * 4 + 2] = v.z; key[i * 4 + 3] = v.w;
    }
    unsigned prefix = 0, mask = 0, need = CAP;
    for (int pass = 0; pass < 4; ++pass) {
      int shift = 24 - 8 * pass;
      __syncthreads();
      if (tid < 256) hist[tid] = 0;
      __syncthreads();
#pragma unroll
      for (int i = 0; i < 16; ++i)
        if ((key[i] & mask) == prefix) atomicAdd(&hist[(key[i] >> shift) & 255u], 1u);
      __syncthreads();
      if (tid == 0) {
        unsigned cum = 0; int bsel = 0; unsigned nd = need;
        for (int bb = 255; bb >= 0; --bb) {
          unsigned hc = hist[bb];
          if (cum + hc >= need) { bsel = bb; nd = need - cum; break; }
          cum += hc;
        }
        bc[0] = prefix | ((unsigned)bsel << shift); bc[1] = nd;
      }
      __syncthreads();
      prefix = bc[0]; need = bc[1]; mask |= (255u << shift);
    }
    unsigned ngt = 0, neq = 0;
#pragma unroll
    for (int i = 0; i < 16; ++i) { ngt += key[i] > prefix; neq += key[i] == prefix; }
    __syncthreads();
    unsigned* sA = sc; unsigned* sB = sc + 512; unsigned* eA = sc + 1024; unsigned* eB = sc + 1536;
    sA[tid] = ngt; eA[tid] = neq;
    __syncthreads();
    for (int off = 1; off < NTH; off <<= 1) {
      unsigned x = sA[tid] + ((tid >= off) ? sA[tid - off] : 0u);
      unsigned y = eA[tid] + ((tid >= off) ? eA[tid - off] : 0u);
      sB[tid] = x; eB[tid] = y;
      __syncthreads();
      unsigned* tmp = sA; sA = sB; sB = tmp; tmp = eA; eA = eB; eB = tmp;
    }
    unsigned gt_excl = sA[tid] - ngt, eq_excl = eA[tid] - neq;
    unsigned gt_total = sA[NTH - 1];
    int* idx = p.IDX + (size_t)item * CAP; float* gate = p.GATE + (size_t)item * CAP;
#pragma unroll
    for (int i = 0; i < 16; ++i) {
      if (key[i] > prefix) { idx[gt_excl] = tid * 16 + i; gate[gt_excl] = __uint_as_float(key[i]); ++gt_excl; }
      else if (key[i] == prefix) {
        if (eq_excl < need) { idx[gt_total + eq_excl] = tid * 16 + i; gate[gt_total + eq_excl] = __uint_as_float(key[i]); }
        ++eq_excl;
      }
    }
    __syncthreads();
  }
}

DI void ph_exp1(const P& p, int layer, char* smem) {
  for (int t = blockIdx.x; t < 32 * 4 * 16; t += gridDim.x) {
    int grp = t / 64, r = t % 64, tm = r / 16, tn = r % 16;
    int b = grp / NE, e = grp % NE;
    const int* gi = p.IDX + (size_t)grp * CAP + tm * GBM;
    const u16* Hb = p.H + (size_t)b * T * DM;
    const float* Wg = p.exp_w_gate + ((size_t)layer * NE + e) * DM * 1024;
    const float* Wu = p.exp_w_up + ((size_t)layer * NE + e) * DM * 1024;
    u16* hid = p.HID + ((size_t)grp * CAP + tm * GBM) * 1024;
    auto arow = [&](int row) -> const void* { return Hb + (size_t)gi[row] * DM; };
    gemm_tile<false, 1>(arow, Wg, Wu, 1024, DM, tn * 64, 1024, smem, [&](int row, int col, float g, float u) {
      float sv = g / (1.f + __expf(-g));
      hid[(size_t)row * 1024 + col] = f2bf(sv * u);
    });
    __syncthreads();
  }
}
DI void ph_exp2(const P& p, int layer, char* smem) {
  for (int t = blockIdx.x; t < 32 * 4 * 8; t += gridDim.x) {
    int grp = t / 32, r = t % 32, tm = r / 8, tn = r % 8;
    int b = grp / NE, e = grp % NE;
    const int* gi = p.IDX + (size_t)grp * CAP + tm * GBM;
    const float* gt = p.GATE + (size_t)grp * CAP + tm * GBM;
    const u16* hid = p.HID + ((size_t)grp * CAP + tm * GBM) * 1024;
    const float* Wd = p.exp_w_down + ((size_t)layer * NE + e) * 1024 * DM;
    float* xb = p.out + (size_t)b * T * DM;
    auto arow = [&](int row) -> const void* { return hid + (size_t)row * 1024; };
    gemm_tile<false, 0>(arow, Wd, nullptr, DM, 1024, tn * GBN, DM, smem, [&](int row, int col, float v, float) {
      unsafeAtomicAdd(xb + (size_t)gi[row] * DM + col, v * gt[row]);
    });
    __syncthreads();
  }
}

__global__ void __launch_bounds__(NTH) mega(P p) {
  __shared__ __attribute__((aligned(16))) char smem[SMEM_BYTES];
  cg::grid_group grid = cg::this_grid();
  if (blockIdx.x == 0 && threadIdx.x < 16) p.CTR[threadIdx.x] = 0u;
  for (int layer = 0; layer < NL; ++layer) {
    ph_norm(layer == 0 ? p.x : p.out, p.attn_norm + layer * DM, p.H);
    grid.sync();
    {
      float* Z = p.Z;
      ph_gemm<false>(p.H, DM, p.w_in + (size_t)layer * DM * INC, INC, NTOK, INC, DM, smem,
                     [&](int row, int col, float v) { Z[(size_t)row * INC + col] = v; });
    }
    grid.sync();
    ph_rwshift(p, layer);
    ph_mlaprep1(p, layer);
    grid.sync();
    for (int d = 0; d < 2; ++d) {
      float* LW = p.LW + (size_t)d * NTOK * RWW; const float* w0 = p.rw_w0 + (layer * 2 + d) * RWW;
      ph_gemm<false>(p.TWD + (size_t)d * NTOK * 64, 64, p.rw_w_up + ((size_t)(layer * 2 + d)) * 64 * RWW, RWW, NTOK, RWW, 64, smem,
                     [&](int row, int col, float v) { LW[(size_t)row * RWW + col] = -0.6065306597126334f * sigmoidf_(v + w0[col]); });
      float* AA = p.AA + (size_t)d * NTOK * RWW; const float* a0 = p.rw_a0 + (layer * 2 + d) * RWW;
      ph_gemm<false>(p.AD + (size_t)d * NTOK * 64, 64, p.rw_a_up + ((size_t)(layer * 2 + d)) * 64 * RWW, RWW, NTOK, RWW, 64, smem,
                     [&](int row, int col, float v) { AA[(size_t)row * RWW + col] = sigmoidf_(v + a0[col]); });
    }
    {
      u16* G = p.G;
      ph_gemm<false>(p.SGD, 128, p.rw_g_up + (size_t)layer * 128 * RWW, RWW, NTOK, RWW, 128, smem,
                     [&](int row, int col, float v) { G[(size_t)row * RWW + col] = f2bf(v); });
      float* Q = p.QRAW;
      ph_gemm<false>(p.QDN, 256, p.mla_q_up + (size_t)layer * 256 * 768, 768, NTOK, 768, 256, smem,
                     [&](int row, int col, float v) { Q[(size_t)row * 768 + col] = v; });
      float* KV = p.KVRAW;
      ph_gemm<false>(p.KVDN, 128, p.mla_kv_up + (size_t)layer * 128 * 1024, 1024, NTOK, 1024, 128, smem,
                     [&](int row, int col, float v) { KV[(size_t)row * 1024 + col] = v; });
    }
    grid.sync();
    ph_mlafinish(p);
    grid.sync();
    ph_scan(p, layer, smem);
    ph_attn(p, smem, p.CTR + layer);
    grid.sync();
    ph_mixfinish(p, layer);
    grid.sync();
    {
      const float* xs = (layer == 0) ? p.x : p.out; float* xo = p.out;
      ph_gemm<false>(p.H, DM, p.w_out + (size_t)layer * DM * DM, DM, NTOK, DM, DM, smem,
                     [&](int row, int col, float v) { xo[(size_t)row * DM + col] = xs[(size_t)row * DM + col] + v; });
    }
    grid.sync();
    ph_norm_router(p, layer);
    grid.sync();
    ph_topk(p, smem);
    grid.sync();
    ph_exp1(p, layer, smem);
    grid.sync();
    ph_exp2(p, layer, smem);
    grid.sync();
    ph_norm(p.out, p.ple_norm + layer * DM, p.H);
    grid.sync();
    {
      float* PG = p.PG;
      ph_gemm<false>(p.H, DM, p.ple_gate + (size_t)layer * DM * DM, DM, NTOK, DM, DM, smem,
                     [&](int row, int col, float v) { PG[(size_t)row * DM + col] = sigmoidf_(v); });
    }
    grid.sync();
    {
      float* xo = p.out; const float* PG = p.PG;
      ph_gemm<true>(p.p + (size_t)layer * NTOK * DPLE, DPLE, p.ple_proj + (size_t)layer * DPLE * DM, DM, NTOK, DM, DPLE, smem,
                    [&](int row, int col, float v) { xo[(size_t)row * DM + col] += v * PG[(size_t)row * DM + col]; });
    }
    grid.sync();
  }
  ph_final_norm(p.out, p.final_norm);
}

extern "C" void kernel_launch(void* const* d_in, const int* in_sizes, int n_in, void* d_out, int out_size, void* d_ws,
                              size_t ws_size, hipStream_t stream) {
  (void)in_sizes; (void)n_in; (void)out_size;
  P p{};
  p.x = (const float*)d_in[0]; p.p = (const float*)d_in[1]; p.pos = (const int*)d_in[2];
  p.attn_norm = (const float*)d_in[3]; p.w_in = (const float*)d_in[4]; p.rw_mu = (const float*)d_in[5];
  p.rw_w0 = (const float*)d_in[6]; p.rw_w_up = (const float*)d_in[7]; p.rw_a0 = (const float*)d_in[8];
  p.rw_a_up = (const float*)d_in[9]; p.rw_g_up = (const float*)d_in[10]; p.rw_k_k = (const float*)d_in[11];
  p.rw_k_a = (const float*)d_in[12]; p.rw_r_k = (const float*)d_in[13]; p.rw_lnx_w = (const float*)d_in[14];
  p.rw_lnx_b = (const float*)d_in[15]; p.mla_q_norm = (const float*)d_in[16]; p.mla_q_up = (const float*)d_in[17];
  p.mla_kv_norm = (const float*)d_in[18]; p.mla_kv_up = (const float*)d_in[19]; p.mla_o_norm = (const float*)d_in[20];
  p.w_out = (const float*)d_in[21]; p.ffn_norm = (const float*)d_in[22]; p.router = (const float*)d_in[23];
  p.exp_w_gate = (const float*)d_in[24]; p.exp_w_up = (const float*)d_in[25]; p.exp_w_down = (const float*)d_in[26];
  p.ple_norm = (const float*)d_in[27]; p.ple_proj = (const float*)d_in[28]; p.ple_gate = (const float*)d_in[29];
  p.final_norm = (const float*)d_in[30];
  p.out = (float*)d_out;

  char* ws = (char*)d_ws; size_t off = 0;
  auto take = [&](size_t bytes) { char* r = ws + off; off += (bytes + 255) & ~(size_t)255; return r; };
  char* regA = take((size_t)NTOK * INC * 4);
  p.Z = (float*)regA;
  p.LW = (float*)regA; p.AA = (float*)(regA + (size_t)2 * NTOK * RWW * 4); p.G = (u16*)(regA + (size_t)4 * NTOK * RWW * 4);
  p.HID = (u16*)regA;
  char* regB = take((size_t)3 * NTOK * RWW * 4);
  p.R = (float*)regB; p.K = p.R + (size_t)NTOK * RWW; p.V = p.K + (size_t)NTOK * RWW;
  p.PG = (float*)regB;
  char* regC = take((size_t)NTOK * (768 + 1024) * 4);
  p.QRAW = (float*)regC; p.KVRAW = p.QRAW + (size_t)NTOK * 768;
  p.AO = (float*)regC; p.O2 = p.AO + (size_t)NTOK * 512;
  p.TWD = (u16*)take((size_t)2 * NTOK * 64 * 2); p.AD = (u16*)take((size_t)2 * NTOK * 64 * 2);
  p.SGD = (u16*)take((size_t)NTOK * 128 * 2); p.QDN = (u16*)take((size_t)NTOK * 256 * 2);
  p.KVDN = (u16*)take((size_t)NTOK * 128 * 2); p.KR = (float*)take((size_t)NTOK * 32 * 4);
  p.Q = (u16*)take((size_t)NTOK * NH * 96 * 2); p.Kc = (u16*)take((size_t)NTOK * NH * 96 * 2);
  p.Vv = (u16*)take((size_t)NTOK * NH * 64 * 2);
  p.H = (u16*)take((size_t)NTOK * DM * 2);
  p.AFF = (float*)take((size_t)NB * NE * T * 4);
  p.IDX = (int*)take((size_t)NB * NE * CAP * 4);
  p.GATE = (float*)take((size_t)NB * NE * CAP * 4);

  p.CTR = (unsigned*)take(256);
  if (off > ws_size) { fprintf(stderr, "workspace too small: need %zu have %zu\n", off, ws_size); return; }
  static int grid_blocks = 0;
  if (!grid_blocks) {
    int dev = 0, cus = 0, per_cu = 0;
    hipGetDevice(&dev);
    hipDeviceGetAttribute(&cus, hipDeviceAttributeMultiprocessorCount, dev);
    hipOccupancyMaxActiveBlocksPerMultiprocessor(&per_cu, mega, NTH, 0);
    if (per_cu > 1) per_cu = 1;
    grid_blocks = cus * per_cu;
  }
  void* args[] = {&p};
  hipError_t e = hipLaunchCooperativeKernel((void*)mega, dim3(grid_blocks), dim3(NTH), args, 0, stream);
  if (e != hipSuccess) fprintf(stderr, "cooperative launch failed: %s (grid %d)\n", hipGetErrorString(e), grid_blocks);
}
```

```cpp
#include <hip/hip_runtime.h>
#include <hip/hip_bf16.h>
#include <cstdio>
#include <cstdint>
#include <hip/hip_cooperative_groups.h>
namespace cg = cooperative_groups;

#define DI __device__ __forceinline__
#define LAS __attribute__((address_space(3)))

constexpr int NB = 2, T = 8192, NTOK = NB * T, DM = 1024, NL = 2;
constexpr int RWW = 512, RWC = 1920, INC = 2336;
constexpr int NH = 8;
constexpr int NE = 16, CAP = 1024;
constexpr int DPLE = 256;
constexpr int NTH = 512;
constexpr float NORM_EPS = 1e-6f, GN_EPS = 64e-5f;

using bf16x8 = __attribute__((ext_vector_type(8))) short;
using s16x4  = __attribute__((ext_vector_type(4))) short;
using f32x4  = __attribute__((ext_vector_type(4))) float;
using u32x4  = __attribute__((ext_vector_type(4))) unsigned;
using u32x2  = __attribute__((ext_vector_type(2))) unsigned;
typedef __bf16 bf2_t __attribute__((ext_vector_type(2)));
typedef unsigned short u16;

DI unsigned pk2(float a, float b) { bf2_t v = {(__bf16)a, (__bf16)b}; return __builtin_bit_cast(unsigned, v); }
DI u16 f2bf(float a) { return (u16)(pk2(a, 0.f) & 0xffffu); }
DI float bf2f(u16 u) { return __uint_as_float(((unsigned)u) << 16); }
DI int tidx() { int t = threadIdx.x; asm volatile("" : "+v"(t)); return t; }
DI int bidx() { int b = blockIdx.x; asm volatile("" : "+s"(b)); return b; }
DI float wave_sum(float v) {
#pragma unroll
  for (int o = 32; o >= 1; o >>= 1) v += __shfl_xor(v, o);
  return v;
}
DI float sigmoidf_(float x) { return 1.f / (1.f + __expf(-x)); }
DI s16x4 tr_read(const short* p) {
  return __builtin_amdgcn_ds_read_tr16_b64_v4i16((LAS s16x4*)(p));
}

struct P {
  const float* x; const float* p; const int* pos;
  const float* attn_norm; const float* w_in; const float* rw_mu; const float* rw_w0; const float* rw_w_up;
  const float* rw_a0; const float* rw_a_up; const float* rw_g_up; const float* rw_k_k; const float* rw_k_a;
  const float* rw_r_k; const float* rw_lnx_w; const float* rw_lnx_b; const float* mla_q_norm; const float* mla_q_up;
  const float* mla_kv_norm; const float* mla_kv_up; const float* mla_o_norm; const float* w_out; const float* ffn_norm;
  const float* router; const float* exp_w_gate; const float* exp_w_up; const float* exp_w_down; const float* ple_norm;
  const float* ple_proj; const float* ple_gate; const float* final_norm;
  float* out;
  float* Z;
  float* LW;
  float* AA;
  u16*   G;
  u16*   HID;
  float* R; float* K; float* V;
  float* PG;
  float* QRAW;
  float* KVRAW;
  float* AO;
  float* O2;
  u16* TWD; u16* AD; u16* SGD; u16* QDN; u16* KVDN; float* KR;
  u16* Q; u16* Kc; u16* Vv;
  u16* H;
  float* AFF;
  int* IDX;
  float* GATE;
  unsigned* CTR;
  unsigned* BAR;
};

constexpr int GBM = 256, GBN = 128, GBK = 64;
constexpr int AS_STRIDE = 72, BS_STRIDE = 136;
constexpr int AS_BYTES = GBM * AS_STRIDE * 2;
constexpr int BS_BYTES = GBK * BS_STRIDE * 2;
constexpr int SMEM_BYTES = 57344;

template <bool A_F32, int MODE, class ARow, class Epi>
DI void gemm_tile(ARow arow, const float* __restrict__ B, const float* __restrict__ B2, int ldb, int K, int n0, int Nvalid,
                  char* smem, Epi epi) {
  short* As = (short*)smem;
  short* Bs = (short*)(smem + AS_BYTES);
  const int tid = tidx(), lane = tid & 63, w = tid >> 6;
  const int wm = w >> 1, wn = w & 1;
  const int l15 = lane & 15, lq = lane >> 4;

  const char* ap[4];
#pragma unroll
  for (int i = 0; i < 4; ++i) {
    int u = tid + i * NTH; int row = u >> 3, kc = u & 7;
    ap[i] = (const char*)arow(row) + (size_t)kc * 8 * (A_F32 ? 4 : 2);
  }
  const float* bp[4]; bool bok[4];
#pragma unroll
  for (int i = 0; i < 4; ++i) {
    int u = tid + i * NTH; int k = u >> 5, nq = u & 31;
    int col; const float* base;
    if (MODE == 0) { col = n0 + nq * 4; base = B; }
    else { col = n0 + (nq & 15) * 4; base = (nq < 16) ? B : B2; }
    bok[i] = col < Nvalid;
    bp[i] = base + (size_t)k * ldb + (bok[i] ? col : 0);
  }

  f32x4 acc[4][4];
#pragma unroll
  for (int i = 0; i < 4; ++i)
#pragma unroll
    for (int j = 0; j < 4; ++j) acc[i][j] = f32x4{0.f, 0.f, 0.f, 0.f};

  u32x4 areg[4]; f32x4 breg[4];
#define GLOAD(kt_)                                                                                   \
  {                                                                                                  \
    _Pragma("unroll") for (int i = 0; i < 4; ++i) {                                                  \
      if (A_F32) {                                                                                   \
        const float4* q = (const float4*)(ap[i] + (size_t)(kt_) * GBK * 4);                          \
        float4 v0 = q[0], v1 = q[1];                                                                 \
        areg[i] = u32x4{pk2(v0.x, v0.y), pk2(v0.z, v0.w), pk2(v1.x, v1.y), pk2(v1.z, v1.w)};         \
      } else {                                                                                       \
        areg[i] = *(const u32x4*)(ap[i] + (size_t)(kt_) * GBK * 2);                                  \
      }                                                                                              \
    }                                                                                                \
    _Pragma("unroll") for (int i = 0; i < 4; ++i) {                                                  \
      if (bok[i]) breg[i] = *(const f32x4*)(bp[i] + (size_t)(kt_) * GBK * ldb);                      \
      else breg[i] = f32x4{0.f, 0.f, 0.f, 0.f};                                                      \
    }                                                                                                \
  }
  const int nk = K / GBK;
  GLOAD(0)
  for (int kt = 0; kt < nk; ++kt) {
    __syncthreads();
#pragma unroll
    for (int i = 0; i < 4; ++i) {
      int u = tid + i * NTH; int row = u >> 3, kc = u & 7;
      *(u32x4*)(As + row * AS_STRIDE + kc * 8) = areg[i];
    }
#pragma unroll
    for (int i = 0; i < 4; ++i) {
      int u = tid + i * NTH; int k = u >> 5, nq = u & 31;
      u32x2 v = u32x2{pk2(breg[i][0], breg[i][1]), pk2(breg[i][2], breg[i][3])};
      *(u32x2*)(Bs + k * BS_STRIDE + nq * 4) = v;
    }
    __syncthreads();
    if (kt + 1 < nk) GLOAD(kt + 1)
#pragma unroll
    for (int ks = 0; ks < 2; ++ks) {
      bf16x8 a[4], b[4];
#pragma unroll
      for (int mi = 0; mi < 4; ++mi)
        a[mi] = *(const bf16x8*)(As + (wm * 64 + mi * 16 + l15) * AS_STRIDE + ks * 32 + 8 * lq);
#pragma unroll
      for (int ni = 0; ni < 4; ++ni) {
        int col0 = (MODE == 0) ? (wn * 64 + ni * 16) : ((ni < 2) ? (wn * 32 + ni * 16) : (64 + wn * 32 + (ni - 2) * 16));
        int kb = ks * 32 + 8 * lq; int q = l15 >> 2, pp = l15 & 3;
        s16x4 lo = tr_read(Bs + (kb + q) * BS_STRIDE + col0 + 4 * pp);
        s16x4 hi = tr_read(Bs + (kb + 4 + q) * BS_STRIDE + col0 + 4 * pp);
        b[ni] = __builtin_shufflevector(lo, hi, 0, 1, 2, 3, 4, 5, 6, 7);
      }
#pragma unroll
      for (int mi = 0; mi < 4; ++mi)
#pragma unroll
        for (int ni = 0; ni < 4; ++ni)
          acc[mi][ni] = __builtin_amdgcn_mfma_f32_16x16x32_bf16(a[mi], b[ni], acc[mi][ni], 0, 0, 0);
    }
  }
#pragma unroll
  for (int mi = 0; mi < 4; ++mi)
#pragma unroll
    for (int r = 0; r < 4; ++r) {
      int row = wm * 64 + mi * 16 + lq * 4 + r;
      if (MODE == 0) {
#pragma unroll
        for (int ni = 0; ni < 4; ++ni) {
          int col = n0 + wn * 64 + ni * 16 + l15;
          if (col < Nvalid) epi(row, col, acc[mi][ni][r], 0.f);
        }
      } else {
#pragma unroll
        for (int ni = 0; ni < 2; ++ni) {
          int col = n0 + wn * 32 + ni * 16 + l15;
          epi(row, col, acc[mi][ni][r], acc[mi][ni + 2][r]);
        }
      }
    }
}

DI void ph_norm(const float* __restrict__ X, const float* __restrict__ g, u16* __restrict__ Hout) {
  const int tid_ = tidx(); const int lane = tid_ & 63, w = tid_ >> 6;
  for (int tok = blockIdx.x * 8 + w; tok < NTOK; tok += gridDim.x * 8) {
    const float4* xr = (const float4*)(X + (size_t)tok * DM);
    float4 v[4]; float ss = 0.f;
#pragma unroll
    for (int j = 0; j < 4; ++j) { v[j] = xr[lane + 64 * j]; ss += v[j].x * v[j].x + v[j].y * v[j].y + v[j].z * v[j].z + v[j].w * v[j].w; }
    ss = wave_sum(ss);
    float rstd = rsqrtf(ss * (1.f / DM) + NORM_EPS);
#pragma unroll
    for (int j = 0; j < 4; ++j) {
      float4 gg = ((const float4*)g)[lane + 64 * j];
      uint2 o = uint2{pk2(v[j].x * rstd * gg.x, v[j].y * rstd * gg.y), pk2(v[j].z * rstd * gg.z, v[j].w * rstd * gg.w)};
      *(uint2*)(Hout + (size_t)tok * DM + (lane + 64 * j) * 4) = o;
    }
  }
}

DI void ph_final_norm(float* __restrict__ X, const float* __restrict__ g) {
  const int tid_ = tidx(); const int lane = tid_ & 63, w = tid_ >> 6;
  for (int tok = blockIdx.x * 8 + w; tok < NTOK; tok += gridDim.x * 8) {
    float4* xr = (float4*)(X + (size_t)tok * DM);
    float4 v[4]; float ss = 0.f;
#pragma unroll
    for (int j = 0; j < 4; ++j) { v[j] = xr[lane + 64 * j]; ss += v[j].x * v[j].x + v[j].y * v[j].y + v[j].z * v[j].z + v[j].w * v[j].w; }
    ss = wave_sum(ss);
    float rstd = rsqrtf(ss * (1.f / DM) + NORM_EPS);
#pragma unroll
    for (int j = 0; j < 4; ++j) {
      float4 gg = ((const float4*)g)[lane + 64 * j];
      xr[lane + 64 * j] = float4{v[j].x * rstd * gg.x, v[j].y * rstd * gg.y, v[j].z * rstd * gg.z, v[j].w * rstd * gg.w};
    }
  }
}

template <bool A_F32, class Epi>
DI void ph_gemm(const void* A, int lda, const float* B, int ldb, int M, int N, int K, char* smem, Epi epi) {
  const int ntn = (N + GBN - 1) / GBN, ntm = M / GBM;
  for (int t = blockIdx.x; t < ntm * ntn; t += gridDim.x) {
    int tm = t / ntn, tn = t % ntn;
    int m0 = tm * GBM, n0 = tn * GBN;
    auto arow = [&](int r) -> const void* { return (const char*)A + (size_t)(m0 + r) * lda * (A_F32 ? 4 : 2); };
    gemm_tile<A_F32, 0>(arow, B, nullptr, ldb, K, n0, N, smem, [&](int row, int col, float v, float) { epi(m0 + row, col, v); });
    __syncthreads();
  }
}

DI void ph_rwshift(const P& p, int layer) {
  const float* mu = p.rw_mu + layer * RWC;
  const int total = NTOK * (RWC / 4);
  const int tid_ = tidx();
  for (int i = blockIdx.x * NTH + tid_; i < total; i += gridDim.x * NTH) {
    int tok = i / (RWC / 4), c = (i % (RWC / 4)) * 4;
    int t = tok % T;
    const float* zr = p.Z + (size_t)tok * INC + c;
    float4 z = *(const float4*)zr;
    float4 zm = (t > 0) ? *(const float4*)(zr - INC) : float4{0.f, 0.f, 0.f, 0.f};
    float4 zp = (t < T - 1) ? *(const float4*)(zr + INC) : float4{0.f, 0.f, 0.f, 0.f};
    float4 m = *(const float4*)(mu + c);
    float4 o;
    o.x = z.x + m.x * (0.5f * (zm.x + zp.x) - z.x);
    o.y = z.y + m.y * (0.5f * (zm.y + zp.y) - z.y);
    o.z = z.z + m.z * (0.5f * (zm.z + zp.z) - z.z);
    o.w = z.w + m.w * (0.5f * (zm.w + zp.w) - z.w);
    if (c < 512) *(float4*)(p.R + (size_t)tok * RWW + c) = o;
    else if (c < 1024) *(float4*)(p.K + (size_t)tok * RWW + (c - 512)) = o;
    else if (c < 1536) *(float4*)(p.V + (size_t)tok * RWW + (c - 1024)) = o;
    else if (c < 1664) {
      int d = (c - 1536) >> 6, l = (c - 1536) & 63;
      *(uint2*)(p.TWD + ((size_t)d * NTOK + tok) * 64 + l) = uint2{pk2(tanhf(o.x), tanhf(o.y)), pk2(tanhf(o.z), tanhf(o.w))};
    } else if (c < 1792) {
      int d = (c - 1664) >> 6, l = (c - 1664) & 63;
      *(uint2*)(p.AD + ((size_t)d * NTOK + tok) * 64 + l) = uint2{pk2(o.x, o.y), pk2(o.z, o.w)};
    } else {
      int l = c - 1792;
      *(uint2*)(p.SGD + (size_t)tok * 128 + l) = uint2{pk2(sigmoidf_(o.x), sigmoidf_(o.y)), pk2(sigmoidf_(o.z), sigmoidf_(o.w))};
    }
  }
}

DI void rope_cs(int pos, int i, float& cs, float& sn) {
  const int i3 = i & 3, i2 = i >> 2;
  const float c4 = (i3 == 0) ? 1.0f : (i3 == 1) ? 0.5623413251903491f : (i3 == 2) ? 0.31622776601683794f : 0.1778279410038923f;
  const float p10 = (i2 == 0) ? 1.0f : (i2 == 1) ? 0.1f : (i2 == 2) ? 0.01f : 0.001f;
  float inv = c4 * p10;
  float ang = (float)pos * inv;
  double rev = (double)ang * 0.15915494309189535;
  rev -= floor(rev);
  float rf = (float)rev;
  sn = __builtin_amdgcn_sinf(rf);
  cs = __builtin_amdgcn_cosf(rf);
}

DI void ph_mlaprep1(const P& p, int layer) {
  const int tid_ = tidx(); const int lane = tid_ & 63, w = tid_ >> 6;
  const float* qn = p.mla_q_norm + layer * 256;
  const float* kvn = p.mla_kv_norm + layer * 128;
  for (int tok = blockIdx.x * 8 + w; tok < NTOK; tok += gridDim.x * 8) {
    const float* zr = p.Z + (size_t)tok * INC + RWC;
    float4 q = *(const float4*)(zr + lane * 4);
    float ss = wave_sum(q.x * q.x + q.y * q.y + q.z * q.z + q.w * q.w);
    float rstd = rsqrtf(ss * (1.f / 256) + NORM_EPS);
    float4 g = *(const float4*)(qn + lane * 4);
    *(uint2*)(p.QDN + (size_t)tok * 256 + lane * 4) = uint2{pk2(q.x * rstd * g.x, q.y * rstd * g.y), pk2(q.z * rstd * g.z, q.w * rstd * g.w)};
    float2 kv = *(const float2*)(zr + 256 + lane * 2);
    float ss2 = wave_sum(kv.x * kv.x + kv.y * kv.y);
    float rstd2 = rsqrtf(ss2 * (1.f / 128) + NORM_EPS);
    float2 g2 = *(const float2*)(kvn + lane * 2);
    *(unsigned*)(p.KVDN + (size_t)tok * 128 + lane * 2) = pk2(kv.x * rstd2 * g2.x, kv.y * rstd2 * g2.y);
    if (lane < 16) {
      float u1 = zr[384 + lane], u2 = zr[384 + 16 + lane];
      float cs, sn; rope_cs(p.pos[tok], lane, cs, sn);
      p.KR[(size_t)tok * 32 + lane] = u1 * cs - u2 * sn;
      p.KR[(size_t)tok * 32 + 16 + lane] = u1 * sn + u2 * cs;
    }
  }
}

DI void ph_mlafinish(const P& p) {
  const int tid_ = tidx(); const int lane = tid_ & 63, w = tid_ >> 6;
  const float qs = 0.10206207261596577f * 1.4426950408889634f;
  for (int tok = blockIdx.x * 8 + w; tok < NTOK; tok += gridDim.x * 8) {
    int b = tok / T, t = tok % T;
    float cs = 0.f, sn = 0.f;
    if (lane < 16) rope_cs(p.pos[tok], lane, cs, sn);
    const float* qr = p.QRAW + (size_t)tok * 768;
    const float* kvr = p.KVRAW + (size_t)tok * 1024;
    const float* kr = p.KR + (size_t)tok * 32;
#pragma unroll
    for (int h = 0; h < NH; ++h) {
      size_t row = ((size_t)(b * NH + h) * T + t);
      u16* qo = p.Q + row * 96; u16* ko = p.Kc + row * 96; u16* vo = p.Vv + row * 64;
      qo[lane] = f2bf(qr[h * 96 + lane] * qs);
      ko[lane] = f2bf(kvr[h * 128 + lane]);
      vo[lane] = f2bf(kvr[h * 128 + 64 + lane]);
      if (lane < 16) {
        float u1 = qr[h * 96 + 64 + lane], u2 = qr[h * 96 + 80 + lane];
        qo[64 + lane] = f2bf((u1 * cs - u2 * sn) * qs);
        qo[80 + lane] = f2bf((u1 * sn + u2 * cs) * qs);
      }
      if (lane < 32) ko[64 + lane] = f2bf(kr[lane]);
    }
  }
}

constexpr int KS_STRIDE = 104, VS_STRIDE = 72, PS_STRIDE = 72;
DI void ph_attn(const P& p, char* smem, unsigned* ctr) {
  short* Ks = (short*)smem;
  short* Vs = (short*)(smem + 64 * KS_STRIDE * 2);
  short* Ps = (short*)(smem + 64 * KS_STRIDE * 2 + 64 * VS_STRIDE * 2);
  const int tid = tidx(), lane = tid & 63, w = tid >> 6;
  const int l15 = lane & 15, lq = lane >> 4;
  short* Pw = Ps + w * 16 * PS_STRIDE;
  int* sitem = (int*)(smem + SMEM_BYTES - 16);
  for (;;) {
    __syncthreads();
    if (tid == 0) *sitem = (int)atomicAdd(ctr, 1u);
    __syncthreads();
    const int item = *sitem;
    if (item >= NB * NH * (T / 128)) break;
    int bh = item / (T / 128), qt = item % (T / 128);
    const u16* Qb = p.Q + (size_t)bh * T * 96;
    const u16* Kb = p.Kc + (size_t)bh * T * 96;
    const u16* Vb = p.Vv + (size_t)bh * T * 64;
    int qrow = qt * 128 + w * 16 + l15;
    bf16x8 qf[3];
#pragma unroll
    for (int ks = 0; ks < 3; ++ks) qf[ks] = *(const bf16x8*)(Qb + (size_t)qrow * 96 + ks * 32 + 8 * lq);
    float m[4], ls[4]; f32x4 o[4];
#pragma unroll
    for (int r = 0; r < 4; ++r) { m[r] = -INFINITY; ls[r] = 0.f; }
#pragma unroll
    for (int ni = 0; ni < 4; ++ni) o[ni] = f32x4{0.f, 0.f, 0.f, 0.f};

    uint4 kreg0, kreg1, vreg;
    auto gl = [&](int kt) {
      const u16* kp = Kb + (size_t)kt * 64 * 96;
      kreg0 = *(const uint4*)(kp + (size_t)tid * 8);
      if (tid < 256) kreg1 = *(const uint4*)(kp + (size_t)(tid + 512) * 8);
      vreg = *(const uint4*)(Vb + (size_t)kt * 64 * 64 + (size_t)tid * 8);
    };
    gl(0);
    for (int kt = 0; kt < T / 64; ++kt) {
      __syncthreads();
      { int c = tid; int row = c / 12, cc = c % 12; *(uint4*)(Ks + row * KS_STRIDE + cc * 8) = kreg0; }
      if (tid < 256) { int c = tid + 512; int row = c / 12, cc = c % 12; *(uint4*)(Ks + row * KS_STRIDE + cc * 8) = kreg1; }
      { int row = tid >> 3, cc = tid & 7; *(uint4*)(Vs + row * VS_STRIDE + cc * 8) = vreg; }
      __syncthreads();
      if (kt + 1 < T / 64) gl(kt + 1);
      f32x4 s[4];
#pragma unroll
      for (int nt = 0; nt < 4; ++nt) {
        s[nt] = f32x4{0.f, 0.f, 0.f, 0.f};
#pragma unroll
        for (int ks = 0; ks < 3; ++ks) {
          bf16x8 kb = *(const bf16x8*)(Ks + (nt * 16 + l15) * KS_STRIDE + ks * 32 + 8 * lq);
          s[nt] = __builtin_amdgcn_mfma_f32_16x16x32_bf16(qf[ks], kb, s[nt], 0, 0, 0);
        }
      }
#pragma unroll
      for (int r = 0; r < 4; ++r) {
        float mx = fmaxf(fmaxf(s[0][r], s[1][r]), fmaxf(s[2][r], s[3][r]));
        mx = fmaxf(mx, __shfl_xor(mx, 1)); mx = fmaxf(mx, __shfl_xor(mx, 2));
        mx = fmaxf(mx, __shfl_xor(mx, 4)); mx = fmaxf(mx, __shfl_xor(mx, 8));
        float mn = fmaxf(m[r], mx);
        float alpha = __builtin_amdgcn_exp2f(m[r] - mn);
        m[r] = mn;
        float ps = 0.f;
#pragma unroll
        for (int nt = 0; nt < 4; ++nt) {
          float pv = __builtin_amdgcn_exp2f(s[nt][r] - mn);
          ps += pv;
          Pw[(lq * 4 + r) * PS_STRIDE + nt * 16 + l15] = (short)f2bf(pv);
        }
        ls[r] = ls[r] * alpha + ps;
#pragma unroll
        for (int ni = 0; ni < 4; ++ni) o[ni][r] *= alpha;
      }
      __syncthreads();
#pragma unroll
      for (int kk = 0; kk < 2; ++kk) {
        bf16x8 a = *(const bf16x8*)(Pw + l15 * PS_STRIDE + kk * 32 + 8 * lq);
        int kb = kk * 32 + 8 * lq; int q = l15 >> 2, pp = l15 & 3;
#pragma unroll
        for (int ni = 0; ni < 4; ++ni) {
          s16x4 lo = tr_read(Vs + (kb + q) * VS_STRIDE + ni * 16 + 4 * pp);
          s16x4 hi = tr_read(Vs + (kb + 4 + q) * VS_STRIDE + ni * 16 + 4 * pp);
          bf16x8 vb = __builtin_shufflevector(lo, hi, 0, 1, 2, 3, 4, 5, 6, 7);
          o[ni] = __builtin_amdgcn_mfma_f32_16x16x32_bf16(a, vb, o[ni], 0, 0, 0);
        }
      }
    }
    int b = bh / NH, h = bh % NH;
#pragma unroll
    for (int r = 0; r < 4; ++r) {
      float l = ls[r];
      l += __shfl_xor(l, 1); l += __shfl_xor(l, 2); l += __shfl_xor(l, 4); l += __shfl_xor(l, 8);
      float inv = 1.f / l;
      int t = qt * 128 + w * 16 + lq * 4 + r;
      float* orow = p.AO + ((size_t)(b * T + t)) * 512 + h * 64;
#pragma unroll
      for (int ni = 0; ni < 4; ++ni) orow[ni * 16 + l15] = o[ni][r] * inv;
    }
    __syncthreads();
  }
}

DI void ph_scan(const P& p, int layer, char* smem) {
  float* sw = (float*)smem; float* skk = sw + 1024; float* sba = skk + 1024; float* skd = sba + 1024;
  float* sr = skd + 1024; float* sv = sr + 1024; float* so = sv + 1024;
  const int tid = tidx(), lane = tid & 63, w = tid >> 6;
  const int v = tid >> 3, kq = tid & 7;
  for (int item = blockIdx.x; item < NB * NH * 2; item += gridDim.x) {
    int d = item & 1, h = (item >> 1) % NH, b = item / (2 * NH);
    const float* LWd = p.LW + (size_t)d * NTOK * RWW;
    const float* AAd = p.AA + (size_t)d * NTOK * RWW;
    float* Od = p.O2 + (size_t)d * NTOK * RWW;
    const int ch = h * 64 + lane;
    const float kkc = p.rw_k_k[layer * RWW + ch], kac = p.rw_k_a[layer * RWW + ch];
    float S[8];
#pragma unroll
    for (int i = 0; i < 8; ++i) S[i] = 0.f;
    for (int c = 0; c < T / 16; ++c) {
      int t0 = (d == 0) ? c * 16 : T - 16 * (c + 1);
      __syncthreads();
#pragma unroll
      for (int jj = 0; jj < 2; ++jj) {
        int j = w + 8 * jj; size_t off = ((size_t)(b * T + t0 + j)) * RWW + ch;
        float kv = p.K[off];
        float kx = kv * kkc;
        float nrm = sqrtf(wave_sum(kx * kx));
        float kkv = kx / fmaxf(nrm, 1e-12f);
        float a = AAd[off];
        sw[j * 64 + lane] = __expf(LWd[off]);
        skk[j * 64 + lane] = kkv;
        sba[j * 64 + lane] = a * kkv;
        skd[j * 64 + lane] = kv * (1.f + (a - 1.f) * kac);
        sr[j * 64 + lane] = p.R[off];
        sv[j * 64 + lane] = p.V[off];
      }
      __syncthreads();
      for (int jj = 0; jj < 16; ++jj) {
        int j = (d == 0) ? jj : 15 - jj;
        const float4* w4 = (const float4*)(sw + j * 64 + kq * 8);
        const float4* k4 = (const float4*)(skk + j * 64 + kq * 8);
        const float4* b4 = (const float4*)(sba + j * 64 + kq * 8);
        const float4* d4 = (const float4*)(skd + j * 64 + kq * 8);
        const float4* r4 = (const float4*)(sr + j * 64 + kq * 8);
        float4 wa = w4[0], wb = w4[1], ka = k4[0], kb = k4[1], ba = b4[0], bb = b4[1], da = d4[0], db = d4[1], ra = r4[0], rb = r4[1];
        float wv[8] = {wa.x, wa.y, wa.z, wa.w, wb.x, wb.y, wb.z, wb.w};
        float kv8[8] = {ka.x, ka.y, ka.z, ka.w, kb.x, kb.y, kb.z, kb.w};
        float bv[8] = {ba.x, ba.y, ba.z, ba.w, bb.x, bb.y, bb.z, bb.w};
        float dv[8] = {da.x, da.y, da.z, da.w, db.x, db.y, db.z, db.w};
        float rv[8] = {ra.x, ra.y, ra.z, ra.w, rb.x, rb.y, rb.z, rb.w};
        float vv = sv[j * 64 + v];
        float sa = 0.f;
#pragma unroll
        for (int i = 0; i < 8; ++i) sa -= S[i] * kv8[i];
        sa += __shfl_xor(sa, 1); sa += __shfl_xor(sa, 2); sa += __shfl_xor(sa, 4);
        float oo = 0.f;
#pragma unroll
        for (int i = 0; i < 8; ++i) { S[i] = S[i] * wv[i] + sa * bv[i] + vv * dv[i]; oo += S[i] * rv[i]; }
        oo += __shfl_xor(oo, 1); oo += __shfl_xor(oo, 2); oo += __shfl_xor(oo, 4);
        if (kq == 0) so[j * 64 + v] = oo;
      }
      __syncthreads();
#pragma unroll
      for (int jj = 0; jj < 2; ++jj) {
        int j = w + 8 * jj;
        Od[((size_t)(b * T + t0 + j)) * RWW + ch] = so[j * 64 + lane];
      }
    }
    __syncthreads();
  }
}

DI void ph_mixfinish(const P& p, int layer) {
  const int tid_ = tidx(); const int lane = tid_ & 63, w = tid_ >> 6;
  const float* lw = p.rw_lnx_w + layer * RWW; const float* lb = p.rw_lnx_b + layer * RWW;
  const float* kac = p.rw_k_a + layer * RWW; const float* rk = p.rw_r_k + layer * RWW;
  const float* on = p.mla_o_norm + layer * 512;
  for (int tok = blockIdx.x * 8 + w; tok < NTOK; tok += gridDim.x * 8) {
#pragma unroll
    for (int h = 0; h < NH; ++h) {
      int c = h * 64 + lane; size_t off = (size_t)tok * RWW + c;
      float o = p.O2[off] + p.O2[(size_t)NTOK * RWW + off];
      float mean = wave_sum(o) * (1.f / 64);
      float dv = o - mean;
      float var = wave_sum(dv * dv) * (1.f / 64);
      float on_ = dv * rsqrtf(var + GN_EPS) * lw[c] + lb[c];
      float k = p.K[off], r = p.R[off], vv = p.V[off];
      float a0 = p.AA[off], a1 = p.AA[(size_t)NTOK * RWW + off];
      float kb = 0.5f * (k * (1.f + (a0 - 1.f) * kac[c]) + k * (1.f + (a1 - 1.f) * kac[c]));
      float s = wave_sum(r * kb * rk[c]);
      float y = (on_ + s * vv) * bf2f(p.G[off]);
      p.H[(size_t)tok * DM + c] = f2bf(y);
    }
    const float* ao = p.AO + (size_t)tok * 512;
    float4 v0 = *(const float4*)(ao + lane * 4), v1 = *(const float4*)(ao + 256 + lane * 4);
    float ss = wave_sum(v0.x * v0.x + v0.y * v0.y + v0.z * v0.z + v0.w * v0.w + v1.x * v1.x + v1.y * v1.y + v1.z * v1.z + v1.w * v1.w);
    float rstd = rsqrtf(ss * (1.f / 512) + NORM_EPS);
    float4 g0 = *(const float4*)(on + lane * 4), g1 = *(const float4*)(on + 256 + lane * 4);
    *(uint2*)(p.H + (size_t)tok * DM + 512 + lane * 4) = uint2{pk2(v0.x * rstd * g0.x, v0.y * rstd * g0.y), pk2(v0.z * rstd * g0.z, v0.w * rstd * g0.w)};
    *(uint2*)(p.H + (size_t)tok * DM + 768 + lane * 4) = uint2{pk2(v1.x * rstd * g1.x, v1.y * rstd * g1.y), pk2(v1.z * rstd * g1.z, v1.w * rstd * g1.w)};
  }
}

DI void ph_norm_router(const P& p, int layer) {
  const int tid_ = tidx(); const int lane = tid_ & 63, w = tid_ >> 6;
  const float* g = p.ffn_norm + layer * DM;
  const float* rt = p.router + (size_t)layer * DM * NE;
  for (int tok = blockIdx.x * 8 + w; tok < NTOK; tok += gridDim.x * 8) {
    const float4* xr = (const float4*)(p.out + (size_t)tok * DM);
    float4 v[4]; float ss = 0.f;
#pragma unroll
    for (int j = 0; j < 4; ++j) { v[j] = xr[lane + 64 * j]; ss += v[j].x * v[j].x + v[j].y * v[j].y + v[j].z * v[j].z + v[j].w * v[j].w; }
    ss = wave_sum(ss);
    float rstd = rsqrtf(ss * (1.f / DM) + NORM_EPS);
    float lg[NE];
#pragma unroll
    for (int e = 0; e < NE; ++e) lg[e] = 0.f;
#pragma unroll
    for (int j = 0; j < 4; ++j) {
      int c0 = (lane + 64 * j) * 4;
      float4 gg = *(const float4*)(g + c0);
      float hv[4] = {v[j].x * rstd * gg.x, v[j].y * rstd * gg.y, v[j].z * rstd * gg.z, v[j].w * rstd * gg.w};
      *(uint2*)(p.H + (size_t)tok * DM + c0) = uint2{pk2(hv[0], hv[1]), pk2(hv[2], hv[3])};
#pragma unroll
      for (int q = 0; q < 4; ++q) {
        const float4* rr = (const float4*)(rt + (size_t)(c0 + q) * NE);
        float4 r0 = rr[0], r1 = rr[1], r2 = rr[2], r3 = rr[3];
        lg[0] += hv[q] * r0.x; lg[1] += hv[q] * r0.y; lg[2] += hv[q] * r0.z; lg[3] += hv[q] * r0.w;
        lg[4] += hv[q] * r1.x; lg[5] += hv[q] * r1.y; lg[6] += hv[q] * r1.z; lg[7] += hv[q] * r1.w;
        lg[8] += hv[q] * r2.x; lg[9] += hv[q] * r2.y; lg[10] += hv[q] * r2.z; lg[11] += hv[q] * r2.w;
        lg[12] += hv[q] * r3.x; lg[13] += hv[q] * r3.y; lg[14] += hv[q] * r3.z; lg[15] += hv[q] * r3.w;
      }
    }
    float mx = -INFINITY;
#pragma unroll
    for (int e = 0; e < NE; ++e) { lg[e] = wave_sum(lg[e]); mx = fmaxf(mx, lg[e]); }
    float se = 0.f;
#pragma unroll
    for (int e = 0; e < NE; ++e) { lg[e] = expf(lg[e] - mx); se += lg[e]; }
    float inv = 1.f / se;
    int b = tok / T, t = tok % T;
    float mine = 0.f;
#pragma unroll
    for (int e = 0; e < NE; ++e) mine = (lane == e) ? lg[e] * inv : mine;
    if (lane < NE) p.AFF[((size_t)(b * NE + lane)) * T + t] = mine;
  }
}

DI void ph_topk(const P& p, char* smem) {
  unsigned* hist = (unsigned*)smem;
  unsigned* sc = hist + 256;
  unsigned* bc = sc + 2048;
  const int tid = tidx();
  for (int item = blockIdx.x; item < NB * NE; item += gridDim.x) {
    const float* a = p.AFF + (size_t)item * T;
    unsigned key[16];
#pragma unroll
    for (int i = 0; i < 4; ++i) {
      uint4 v = *(const uint4*)(a + tid * 16 + i * 4);
      key[i * 4 + 0] = v.x; key[i * 4 + 1] = v.y; key[i * 4 + 2] = v.z; key[i * 4 + 3] = v.w;
    }
    unsigned prefix = 0, mask = 0, need = CAP;
    for (int pass = 0; pass < 4; ++pass) {
      int shift = 24 - 8 * pass;
      __syncthreads();
      if (tid < 256) hist[tid] = 0;
      __syncthreads();
#pragma unroll
      for (int i = 0; i < 16; ++i)
        if ((key[i] & mask) == prefix) atomicAdd(&hist[(key[i] >> shift) & 255u], 1u);
      __syncthreads();
      if (tid == 0) {
        unsigned cum = 0; int bsel = 0; unsigned nd = need;
        for (int bb = 255; bb >= 0; --bb) {
          unsigned hc = hist[bb];
          if (cum + hc >= need) { bsel = bb; nd = need - cum; break; }
          cum += hc;
        }
        bc[0] = prefix | ((unsigned)bsel << shift); bc[1] = nd;
      }
      __syncthreads();
      prefix = bc[0]; need = bc[1]; mask |= (255u << shift);
    }
    unsigned ngt = 0, neq = 0;
#pragma unroll
    for (int i = 0; i < 16; ++i) { ngt += key[i] > prefix; neq += key[i] == prefix; }
    __syncthreads();
    unsigned* sA = sc; unsigned* sB = sc + 512; unsigned* eA = sc + 1024; unsigned* eB = sc + 1536;
    sA[tid] = ngt; eA[tid] = neq;
    __syncthreads();
    for (int off = 1; off < NTH; off <<= 1) {
      unsigned x = sA[tid] + ((tid >= off) ? sA[tid - off] : 0u);
      unsigned y = eA[tid] + ((tid >= off) ? eA[tid - off] : 0u);
      sB[tid] = x; eB[tid] = y;
      __syncthreads();
      unsigned* tmp = sA; sA = sB; sB = tmp; tmp = eA; eA = eB; eB = tmp;
    }
    unsigned gt_excl = sA[tid] - ngt, eq_excl = eA[tid] - neq;
    unsigned gt_total = sA[NTH - 1];
    int* idx = p.IDX + (size_t)item * CAP; float* gate = p.GATE + (size_t)item * CAP;
#pragma unroll
    for (int i = 0; i < 16; ++i) {
      if (key[i] > prefix) { idx[gt_excl] = tid * 16 + i; gate[gt_excl] = __uint_as_float(key[i]); ++gt_excl; }
      else if (key[i] == prefix) {
        if (eq_excl < need) { idx[gt_total + eq_excl] = tid * 16 + i; gate[gt_total + eq_excl] = __uint_as_float(key[i]); }
        ++eq_excl;
      }
    }
    __syncthreads();
  }
}

DI void ph_exp1(const P& p, int layer, char* smem) {
  for (int t = blockIdx.x; t < 32 * 4 * 16; t += gridDim.x) {
    int grp = t / 64, r = t % 64, tm = r / 16, tn = r % 16;
    int b = grp / NE, e = grp % NE;
    const int* gi = p.IDX + (size_t)grp * CAP + tm * GBM;
    const u16* Hb = p.H + (size_t)b * T * DM;
    const float* Wg = p.exp_w_gate + ((size_t)layer * NE + e) * DM * 1024;
    const float* Wu = p.exp_w_up + ((size_t)layer * NE + e) * DM * 1024;
    u16* hid = p.HID + ((size_t)grp * CAP + tm * GBM) * 1024;
    auto arow = [&](int row) -> const void* { return Hb + (size_t)gi[row] * DM; };
    gemm_tile<false, 1>(arow, Wg, Wu, 1024, DM, tn * 64, 1024, smem, [&](int row, int col, float g, float u) {
      float sv = g / (1.f + __expf(-g));
      hid[(size_t)row * 1024 + col] = f2bf(sv * u);
    });
    __syncthreads();
  }
}
DI void ph_exp2(const P& p, int layer, char* smem) {
  for (int t = blockIdx.x; t < 32 * 4 * 8; t += gridDim.x) {
    int grp = t / 32, r = t % 32, tm = r / 8, tn = r % 8;
    int b = grp / NE, e = grp % NE;
    const int* gi = p.IDX + (size_t)grp * CAP + tm * GBM;
    const float* gt = p.GATE + (size_t)grp * CAP + tm * GBM;
    const u16* hid = p.HID + ((size_t)grp * CAP + tm * GBM) * 1024;
    const float* Wd = p.exp_w_down + ((size_t)layer * NE + e) * 1024 * DM;
    float* xb = p.out + (size_t)b * T * DM;
    auto arow = [&](int row) -> const void* { return hid + (size_t)row * 1024; };
    gemm_tile<false, 0>(arow, Wd, nullptr, DM, 1024, tn * GBN, DM, smem, [&](int row, int col, float v, float) {
      unsafeAtomicAdd(xb + (size_t)gi[row] * DM + col, v * gt[row]);
    });
    __syncthreads();
  }
}

#define XB_TMO      128
#define XB_XCNT(j)  (256  + 64 * (j))
#define XB_XSUB(j)  (1280 + 64 * (j))
#define XB_XGEN(j)  (2304 + 64 * (j))
#define XB_TOP      3328
#define XB_TOPGEN   3392
#define XCD_BAR_WORDS 3456
#define XB_SPIN_CAP (1u << 20)
DI unsigned xb_ld(unsigned* p) { return __hip_atomic_load(p, __ATOMIC_RELAXED, __HIP_MEMORY_SCOPE_AGENT); }
DI unsigned xb_add(unsigned* p, unsigned v) { return __hip_atomic_fetch_add(p, v, __ATOMIC_RELAXED, __HIP_MEMORY_SCOPE_AGENT); }
DI unsigned xb_xcc_id() { return (unsigned)__builtin_amdgcn_s_getreg((3 << 11) | 20) & 0xFu; }
#define XB_SPIN(cond, bar) do { unsigned _sp = 0; while (cond) { __builtin_amdgcn_s_sleep(1); \
    if ((++_sp & 255u) == 0u) { if (xb_ld(&(bar)[XB_TMO])) break; if (_sp > XB_SPIN_CAP) { atomicAdd(&(bar)[XB_TMO], 1u); break; } } } } while (0)
struct XcdBarrier { unsigned* bar; unsigned x; volatile LAS unsigned* st; };
DI XcdBarrier xcd_barrier_post(unsigned* bar, volatile LAS unsigned* st) {
  XcdBarrier b; b.bar = bar; b.x = xb_xcc_id(); b.st = st;
  if (threadIdx.x == 0) (void)xb_add(&bar[XB_XCNT(b.x)], 1u);
  return b;
}
DI void xcd_barrier_complete(unsigned* bar, unsigned x, unsigned& nloc, unsigned& nx) {
  const unsigned G = gridDim.x * gridDim.y * gridDim.z;
  unsigned sum, cnt, mine, sp = 0u;
  for (;;) {
    sum = 0u; cnt = 0u; mine = 0u;
#pragma unroll
    for (unsigned j = 0; j < 16; ++j) { const unsigned c = xb_ld(&bar[XB_XCNT(j)]); sum += c; cnt += (c > 0u) ? 1u : 0u; mine = (j == x) ? c : mine; }
    if (sum == G) break;
    __builtin_amdgcn_s_sleep(1);
    if ((++sp & 255u) == 0u) { if (xb_ld(&bar[XB_TMO])) break; if (sp > XB_SPIN_CAP) { atomicAdd(&bar[XB_TMO], 1u); break; } }
  }
  nloc = mine > 0u ? mine : 1u; nx = cnt > 0u ? cnt : 1u;
}
DI void xcd_barrier(const XcdBarrier& b) {
  asm volatile("s_waitcnt vmcnt(0)" ::: "memory");
  __syncthreads();
  if (threadIdx.x == 0) {
    unsigned* bar = b.bar;
    __builtin_amdgcn_s_waitcnt(0);
    unsigned nloc = b.st[0], nx = b.st[1];
    if (nloc == 0u) { xcd_barrier_complete(bar, b.x, nloc, nx); b.st[0] = nloc; b.st[1] = nx; }
    const unsigned old = xb_add(&bar[XB_XSUB(b.x)], 1u);
    const unsigned gen = old / nloc;
    if (old + 1u == (gen + 1u) * nloc) {
      __builtin_amdgcn_fence(__ATOMIC_RELEASE, "agent");
      asm volatile("s_waitcnt vmcnt(0)" ::: "memory");
      const unsigned og = xb_add(&bar[XB_TOP], 1u);
      const unsigned tg = og / nx;
      if (og + 1u == (tg + 1u) * nx) xb_add(&bar[XB_TOPGEN], 1u);
      else XB_SPIN(xb_ld(&bar[XB_TOPGEN]) == tg, bar);
      __builtin_amdgcn_fence(__ATOMIC_ACQUIRE, "agent");
      xb_add(&bar[XB_XGEN(b.x)], 1u);
      asm volatile("s_waitcnt vmcnt(0)" ::: "memory");
    } else {
      XB_SPIN(xb_ld(&bar[XB_XGEN(b.x)]) == gen, bar);
      __builtin_amdgcn_fence(__ATOMIC_ACQUIRE, "agent");
      asm volatile("s_waitcnt vmcnt(0)" ::: "memory");
    }
  }
  __syncthreads();
}

__global__ void __launch_bounds__(NTH) mega(P p) {
  __shared__ __attribute__((aligned(16))) char smem[SMEM_BYTES];
  __shared__ uint4 xb_words;
  cg::grid_group grid = cg::this_grid();
  if (threadIdx.x == 0) xb_words = make_uint4(0u, 0u, 0u, 0u);
  if (blockIdx.x == 0) {
    if (threadIdx.x < 16) p.CTR[threadIdx.x] = 0u;
    for (int i = threadIdx.x; i < XCD_BAR_WORDS; i += NTH) p.BAR[i] = 0u;
  }
  grid.sync();
  const XcdBarrier xb = xcd_barrier_post(p.BAR, (volatile LAS unsigned*)&xb_words);
#define GSYNC() xcd_barrier(xb)
  for (int layer = 0; layer < NL; ++layer) {
    ph_norm(layer == 0 ? p.x : p.out, p.attn_norm + layer * DM, p.H);
    GSYNC();
    {
      float* Z = p.Z;
      ph_gemm<false>(p.H, DM, p.w_in + (size_t)layer * DM * INC, INC, NTOK, INC, DM, smem,
                     [&](int row, int col, float v) { Z[(size_t)row * INC + col] = v; });
    }
    GSYNC();
    ph_rwshift(p, layer);
    ph_mlaprep1(p, layer);
    GSYNC();
    for (int d = 0; d < 2; ++d) {
      float* LW = p.LW + (size_t)d * NTOK * RWW; const float* w0 = p.rw_w0 + (layer * 2 + d) * RWW;
      ph_gemm<false>(p.TWD + (size_t)d * NTOK * 64, 64, p.rw_w_up + ((size_t)(layer * 2 + d)) * 64 * RWW, RWW, NTOK, RWW, 64, smem,
                     [&](int row, int col, float v) { LW[(size_t)row * RWW + col] = -0.6065306597126334f * sigmoidf_(v + w0[col]); });
      float* AA = p.AA + (size_t)d * NTOK * RWW; const float* a0 = p.rw_a0 + (layer * 2 + d) * RWW;
      ph_gemm<false>(p.AD + (size_t)d * NTOK * 64, 64, p.rw_a_up + ((size_t)(layer * 2 + d)) * 64 * RWW, RWW, NTOK, RWW, 64, smem,
                     [&](int row, int col, float v) { AA[(size_t)row * RWW + col] = sigmoidf_(v + a0[col]); });
    }
    {
      u16* G = p.G;
      ph_gemm<false>(p.SGD, 128, p.rw_g_up + (size_t)layer * 128 * RWW, RWW, NTOK, RWW, 128, smem,
                     [&](int row, int col, float v) { G[(size_t)row * RWW + col] = f2bf(v); });
      float* Q = p.QRAW;
      ph_gemm<false>(p.QDN, 256, p.mla_q_up + (size_t)layer * 256 * 768, 768, NTOK, 768, 256, smem,
                     [&](int row, int col, float v) { Q[(size_t)row * 768 + col] = v; });
      float* KV = p.KVRAW;
      ph_gemm<false>(p.KVDN, 128, p.mla_kv_up + (size_t)layer * 128 * 1024, 1024, NTOK, 1024, 128, smem,
                     [&](int row, int col, float v) { KV[(size_t)row * 1024 + col] = v; });
    }
    GSYNC();
    ph_mlafinish(p);
    GSYNC();
    ph_scan(p, layer, smem);
    ph_attn(p, smem, p.CTR + layer);
    GSYNC();
    ph_mixfinish(p, layer);
    GSYNC();
    {
      const float* xs = (layer == 0) ? p.x : p.out; float* xo = p.out;
      ph_gemm<false>(p.H, DM, p.w_out + (size_t)layer * DM * DM, DM, NTOK, DM, DM, smem,
                     [&](int row, int col, float v) { xo[(size_t)row * DM + col] = xs[(size_t)row * DM + col] + v; });
    }
    GSYNC();
    ph_norm_router(p, layer);
    GSYNC();
    ph_topk(p, smem);
    GSYNC();
    ph_exp1(p, layer, smem);
    GSYNC();
    ph_exp2(p, layer, smem);
    GSYNC();
    ph_norm(p.out, p.ple_norm + layer * DM, p.H);
    GSYNC();
    {
      float* PG = p.PG;
      ph_gemm<false>(p.H, DM, p.ple_gate + (size_t)layer * DM * DM, DM, NTOK, DM, DM, smem,
                     [&](int row, int col, float v) { PG[(size_t)row * DM + col] = sigmoidf_(v); });
    }
    GSYNC();
    {
      float* xo = p.out; const float* PG = p.PG;
      ph_gemm<true>(p.p + (size_t)layer * NTOK * DPLE, DPLE, p.ple_proj + (size_t)layer * DPLE * DM, DM, NTOK, DM, DPLE, smem,
                    [&](int row, int col, float v) { xo[(size_t)row * DM + col] += v * PG[(size_t)row * DM + col]; });
    }
    GSYNC();
  }
  ph_final_norm(p.out, p.final_norm);
}

extern "C" void kernel_launch(void* const* d_in, const int* in_sizes, int n_in, void* d_out, int out_size, void* d_ws,
                              size_t ws_size, hipStream_t stream) {
  (void)in_sizes; (void)n_in; (void)out_size;
  P p{};
  p.x = (const float*)d_in[0]; p.p = (const float*)d_in[1]; p.pos = (const int*)d_in[2];
  p.attn_norm = (const float*)d_in[3]; p.w_in = (const float*)d_in[4]; p.rw_mu = (const float*)d_in[5];
  p.rw_w0 = (const float*)d_in[6]; p.rw_w_up = (const float*)d_in[7]; p.rw_a0 = (const float*)d_in[8];
  p.rw_a_up = (const float*)d_in[9]; p.rw_g_up = (const float*)d_in[10]; p.rw_k_k = (const float*)d_in[11];
  p.rw_k_a = (const float*)d_in[12]; p.rw_r_k = (const float*)d_in[13]; p.rw_lnx_w = (const float*)d_in[14];
  p.rw_lnx_b = (const float*)d_in[15]; p.mla_q_norm = (const float*)d_in[16]; p.mla_q_up = (const float*)d_in[17];
  p.mla_kv_norm = (const float*)d_in[18]; p.mla_kv_up = (const float*)d_in[19]; p.mla_o_norm = (const float*)d_in[20];
  p.w_out = (const float*)d_in[21]; p.ffn_norm = (const float*)d_in[22]; p.router = (const float*)d_in[23];
  p.exp_w_gate = (const float*)d_in[24]; p.exp_w_up = (const float*)d_in[25]; p.exp_w_down = (const float*)d_in[26];
  p.ple_norm = (const float*)d_in[27]; p.ple_proj = (const float*)d_in[28]; p.ple_gate = (const float*)d_in[29];
  p.final_norm = (const float*)d_in[30];
  p.out = (float*)d_out;

  char* ws = (char*)d_ws; size_t off = 0;
  auto take = [&](size_t bytes) { char* r = ws + off; off += (bytes + 255) & ~(size_t)255; return r; };
  char* regA = take((size_t)NTOK * INC * 4);
  p.Z = (float*)regA;
  p.LW = (float*)regA; p.AA = (float*)(regA + (size_t)2 * NTOK * RWW * 4); p.G = (u16*)(regA + (size_t)4 * NTOK * RWW * 4);
  p.HID = (u16*)regA;
  char* regB = take((size_t)3 * NTOK * RWW * 4);
  p.R = (float*)regB; p.K = p.R + (size_t)NTOK * RWW; p.V = p.K + (size_t)NTOK * RWW;
  p.PG = (float*)regB;
  char* regC = take((size_t)NTOK * (768 + 1024) * 4);
  p.QRAW = (float*)regC; p.KVRAW = p.QRAW + (size_t)NTOK * 768;
  p.AO = (float*)regC; p.O2 = p.AO + (size_t)NTOK * 512;
  p.TWD = (u16*)take((size_t)2 * NTOK * 64 * 2); p.AD = (u16*)take((size_t)2 * NTOK * 64 * 2);
  p.SGD = (u16*)take((size_t)NTOK * 128 * 2); p.QDN = (u16*)take((size_t)NTOK * 256 * 2);
  p.KVDN = (u16*)take((size_t)NTOK * 128 * 2); p.KR = (float*)take((size_t)NTOK * 32 * 4);
  p.Q = (u16*)take((size_t)NTOK * NH * 96 * 2); p.Kc = (u16*)take((size_t)NTOK * NH * 96 * 2);
  p.Vv = (u16*)take((size_t)NTOK * NH * 64 * 2);
  p.H = (u16*)take((size_t)NTOK * DM * 2);
  p.AFF = (float*)take((size_t)NB * NE * T * 4);
  p.IDX = (int*)take((size_t)NB * NE * CAP * 4);
  p.GATE = (float*)take((size_t)NB * NE * CAP * 4);

  p.CTR = (unsigned*)take(256);
  p.BAR = (unsigned*)take(XCD_BAR_WORDS * 4);
  if (off > ws_size) { fprintf(stderr, "workspace too small: need %zu have %zu\n", off, ws_size); return; }
  static int grid_blocks = 0;
  if (!grid_blocks) {
    int dev = 0, cus = 0, per_cu = 0;
    hipGetDevice(&dev);
    hipDeviceGetAttribute(&cus, hipDeviceAttributeMultiprocessorCount, dev);
    hipOccupancyMaxActiveBlocksPerMultiprocessor(&per_cu, mega, NTH, 0);
    if (per_cu > 1) per_cu = 1;
    grid_blocks = cus * per_cu;
  }
  void* args[] = {&p};
  hipError_t e = hipLaunchCooperativeKernel((void*)mega, dim3(grid_blocks), dim3(NTH), args, 0, stream);
  if (e != hipSuccess) fprintf(stderr, "cooperative launch failed: %s (grid %d)\n", hipGetErrorString(e), grid_blocks);
}
```

```cpp
#include <hip/hip_runtime.h>
#include <hip/hip_bf16.h>
#include <cstdio>
#include <cstdint>
#include <hip/hip_cooperative_groups.h>
namespace cg = cooperative_groups;

#define DI __device__ __forceinline__
#define LAS __attribute__((address_space(3)))

constexpr int NB = 2, T = 8192, NTOK = NB * T, DM = 1024, NL = 2;
constexpr int RWW = 512, RWC = 1920, INC = 2336;
constexpr int NH = 8;
constexpr int NE = 16, CAP = 1024;
constexpr int DPLE = 256;
constexpr int NTH = 512;
constexpr float NORM_EPS = 1e-6f, GN_EPS = 64e-5f;

using bf16x8 = __attribute__((ext_vector_type(8))) short;
using s16x4  = __attribute__((ext_vector_type(4))) short;
using f32x4  = __attribute__((ext_vector_type(4))) float;
using u32x4  = __attribute__((ext_vector_type(4))) unsigned;
using u32x2  = __attribute__((ext_vector_type(2))) unsigned;
typedef __bf16 bf2_t __attribute__((ext_vector_type(2)));
typedef unsigned short u16;

DI unsigned pk2(float a, float b) { bf2_t v = {(__bf16)a, (__bf16)b}; return __builtin_bit_cast(unsigned, v); }
DI u16 f2bf(float a) { return (u16)(pk2(a, 0.f) & 0xffffu); }
DI float bf2f(u16 u) { return __uint_as_float(((unsigned)u) << 16); }
DI int tidx() { int t = threadIdx.x; asm volatile("" : "+v"(t)); return t; }
DI int bidx() { int b = blockIdx.x; asm volatile("" : "+s"(b)); return b; }
DI float wave_sum(float v) {
#pragma unroll
  for (int o = 32; o >= 1; o >>= 1) v += __shfl_xor(v, o);
  return v;
}
DI float sigmoidf_(float x) { return 1.f / (1.f + __expf(-x)); }
DI s16x4 tr_read(const short* p) {
  return __builtin_amdgcn_ds_read_tr16_b64_v4i16((LAS s16x4*)(p));
}

struct P {
  const float* x; const float* p; const int* pos;
  const float* attn_norm; const float* w_in; const float* rw_mu; const float* rw_w0; const float* rw_w_up;
  const float* rw_a0; const float* rw_a_up; const float* rw_g_up; const float* rw_k_k; const float* rw_k_a;
  const float* rw_r_k; const float* rw_lnx_w; const float* rw_lnx_b; const float* mla_q_norm; const float* mla_q_up;
  const float* mla_kv_norm; const float* mla_kv_up; const float* mla_o_norm; const float* w_out; const float* ffn_norm;
  const float* router; const float* exp_w_gate; const float* exp_w_up; const float* exp_w_down; const float* ple_norm;
  const float* ple_proj; const float* ple_gate; const float* final_norm;
  float* out;
  float* Z;
  u16* LW;
  u16* AA;
  float* MC; float* NC;
  float* SS;
  u16*   G;
  u16*   HID;
  float* R; float* K; float* V;
  float* PG;
  float* QRAW;
  float* KVRAW;
  float* AO;
  u16* O2;
  u16* TWD; u16* AD; u16* SGD; u16* QDN; u16* KVDN; float* KR;
  u16* Q; u16* Kc; u16* Vv;
  u16* H;
  float* AFF;
  int* IDX;
  float* GATE;
  unsigned* CTR;
  unsigned* BAR;
};

constexpr int GBM = 256, GBN = 128, GBK = 64;
constexpr int AS_STRIDE = 72, BS_STRIDE = 136;
constexpr int AS_BYTES = GBM * AS_STRIDE * 2;
constexpr int BS_BYTES = GBK * BS_STRIDE * 2;
constexpr int SMEM_BYTES = 57344;

template <bool A_F32, int MODE, class ARow, class Epi>
DI void gemm_tile(ARow arow, const float* __restrict__ B, const float* __restrict__ B2, int ldb, int K, int n0, int Nvalid,
                  char* smem, Epi epi) {
  short* As = (short*)smem;
  short* Bs = (short*)(smem + AS_BYTES);
  const int tid = tidx(), lane = tid & 63, w = tid >> 6;
  const int wm = w >> 1, wn = w & 1;
  const int l15 = lane & 15, lq = lane >> 4;

  const char* ap[4];
#pragma unroll
  for (int i = 0; i < 4; ++i) {
    int u = tid + i * NTH; int row = u >> 3, kc = u & 7;
    ap[i] = (const char*)arow(row) + (size_t)kc * 8 * (A_F32 ? 4 : 2);
  }
  const float* bp[4]; bool bok[4];
#pragma unroll
  for (int i = 0; i < 4; ++i) {
    int u = tid + i * NTH; int k = u >> 5, nq = u & 31;
    int col; const float* base;
    if (MODE == 0) { col = n0 + nq * 4; base = B; }
    else { col = n0 + (nq & 15) * 4; base = (nq < 16) ? B : B2; }
    bok[i] = col < Nvalid;
    bp[i] = base + (size_t)k * ldb + (bok[i] ? col : 0);
  }

  f32x4 acc[4][4];
#pragma unroll
  for (int i = 0; i < 4; ++i)
#pragma unroll
    for (int j = 0; j < 4; ++j) acc[i][j] = f32x4{0.f, 0.f, 0.f, 0.f};

  u32x4 areg[4]; f32x4 breg[4];
#define GLOAD(kt_)                                                                                   \
  {                                                                                                  \
    _Pragma("unroll") for (int i = 0; i < 4; ++i) {                                                  \
      if (A_F32) {                                                                                   \
        const float4* q = (const float4*)(ap[i] + (size_t)(kt_) * GBK * 4);                          \
        float4 v0 = q[0], v1 = q[1];                                                                 \
        areg[i] = u32x4{pk2(v0.x, v0.y), pk2(v0.z, v0.w), pk2(v1.x, v1.y), pk2(v1.z, v1.w)};         \
      } else {                                                                                       \
        areg[i] = *(const u32x4*)(ap[i] + (size_t)(kt_) * GBK * 2);                                  \
      }                                                                                              \
    }                                                                                                \
    _Pragma("unroll") for (int i = 0; i < 4; ++i) {                                                  \
      if (bok[i]) breg[i] = *(const f32x4*)(bp[i] + (size_t)(kt_) * GBK * ldb);                      \
      else breg[i] = f32x4{0.f, 0.f, 0.f, 0.f};                                                      \
    }                                                                                                \
  }
  const int nk = K / GBK;
  GLOAD(0)
  for (int kt = 0; kt < nk; ++kt) {
    __syncthreads();
#pragma unroll
    for (int i = 0; i < 4; ++i) {
      int u = tid + i * NTH; int row = u >> 3, kc = u & 7;
      *(u32x4*)(As + row * AS_STRIDE + kc * 8) = areg[i];
    }
#pragma unroll
    for (int i = 0; i < 4; ++i) {
      int u = tid + i * NTH; int k = u >> 5, nq = u & 31;
      u32x2 v = u32x2{pk2(breg[i][0], breg[i][1]), pk2(breg[i][2], breg[i][3])};
      *(u32x2*)(Bs + k * BS_STRIDE + nq * 4) = v;
    }
    __syncthreads();
    if (kt + 1 < nk) GLOAD(kt + 1)
#pragma unroll
    for (int ks = 0; ks < 2; ++ks) {
      bf16x8 a[4], b[4];
#pragma unroll
      for (int mi = 0; mi < 4; ++mi)
        a[mi] = *(const bf16x8*)(As + (wm * 64 + mi * 16 + l15) * AS_STRIDE + ks * 32 + 8 * lq);
#pragma unroll
      for (int ni = 0; ni < 4; ++ni) {
        int col0 = (MODE == 0) ? (wn * 64 + ni * 16) : ((ni < 2) ? (wn * 32 + ni * 16) : (64 + wn * 32 + (ni - 2) * 16));
        int kb = ks * 32 + 8 * lq; int q = l15 >> 2, pp = l15 & 3;
        s16x4 lo = tr_read(Bs + (kb + q) * BS_STRIDE + col0 + 4 * pp);
        s16x4 hi = tr_read(Bs + (kb + 4 + q) * BS_STRIDE + col0 + 4 * pp);
        b[ni] = __builtin_shufflevector(lo, hi, 0, 1, 2, 3, 4, 5, 6, 7);
      }
#pragma unroll
      for (int mi = 0; mi < 4; ++mi)
#pragma unroll
        for (int ni = 0; ni < 4; ++ni)
          acc[mi][ni] = __builtin_amdgcn_mfma_f32_16x16x32_bf16(a[mi], b[ni], acc[mi][ni], 0, 0, 0);
    }
  }
#pragma unroll
  for (int mi = 0; mi < 4; ++mi)
#pragma unroll
    for (int r = 0; r < 4; ++r) {
      int row = wm * 64 + mi * 16 + lq * 4 + r;
      if (MODE == 0) {
#pragma unroll
        for (int ni = 0; ni < 4; ++ni) {
          int col = n0 + wn * 64 + ni * 16 + l15;
          if (col < Nvalid) epi(row, col, acc[mi][ni][r], 0.f);
        }
      } else {
#pragma unroll
        for (int ni = 0; ni < 2; ++ni) {
          int col = n0 + wn * 32 + ni * 16 + l15;
          epi(row, col, acc[mi][ni][r], acc[mi][ni + 2][r]);
        }
      }
    }
}

DI void ph_norm(const float* __restrict__ X, const float* __restrict__ g, u16* __restrict__ Hout) {
  const int tid_ = tidx(); const int lane = tid_ & 63, w = tid_ >> 6;
  for (int tok = blockIdx.x * 8 + w; tok < NTOK; tok += gridDim.x * 8) {
    const float4* xr = (const float4*)(X + (size_t)tok * DM);
    float4 v[4]; float ss = 0.f;
#pragma unroll
    for (int j = 0; j < 4; ++j) { v[j] = xr[lane + 64 * j]; ss += v[j].x * v[j].x + v[j].y * v[j].y + v[j].z * v[j].z + v[j].w * v[j].w; }
    ss = wave_sum(ss);
    float rstd = rsqrtf(ss * (1.f / DM) + NORM_EPS);
#pragma unroll
    for (int j = 0; j < 4; ++j) {
      float4 gg = ((const float4*)g)[lane + 64 * j];
      uint2 o = uint2{pk2(v[j].x * rstd * gg.x, v[j].y * rstd * gg.y), pk2(v[j].z * rstd * gg.z, v[j].w * rstd * gg.w)};
      *(uint2*)(Hout + (size_t)tok * DM + (lane + 64 * j) * 4) = o;
    }
  }
}

DI void ph_final_norm(float* __restrict__ X, const float* __restrict__ g) {
  const int tid_ = tidx(); const int lane = tid_ & 63, w = tid_ >> 6;
  for (int tok = blockIdx.x * 8 + w; tok < NTOK; tok += gridDim.x * 8) {
    float4* xr = (float4*)(X + (size_t)tok * DM);
    float4 v[4]; float ss = 0.f;
#pragma unroll
    for (int j = 0; j < 4; ++j) { v[j] = xr[lane + 64 * j]; ss += v[j].x * v[j].x + v[j].y * v[j].y + v[j].z * v[j].z + v[j].w * v[j].w; }
    ss = wave_sum(ss);
    float rstd = rsqrtf(ss * (1.f / DM) + NORM_EPS);
#pragma unroll
    for (int j = 0; j < 4; ++j) {
      float4 gg = ((const float4*)g)[lane + 64 * j];
      xr[lane + 64 * j] = float4{v[j].x * rstd * gg.x, v[j].y * rstd * gg.y, v[j].z * rstd * gg.z, v[j].w * rstd * gg.w};
    }
  }
}

template <bool A_F32, class Epi>
DI void ph_gemm(const void* A, int lda, const float* B, int ldb, int M, int N, int K, char* smem, Epi epi) {
  const int ntn = (N + GBN - 1) / GBN, ntm = M / GBM;
  for (int t = blockIdx.x; t < ntm * ntn; t += gridDim.x) {
    int tm = t / ntn, tn = t % ntn;
    int m0 = tm * GBM, n0 = tn * GBN;
    auto arow = [&](int r) -> const void* { return (const char*)A + (size_t)(m0 + r) * lda * (A_F32 ? 4 : 2); };
    gemm_tile<A_F32, 0>(arow, B, nullptr, ldb, K, n0, N, smem, [&](int row, int col, float v, float) { epi(m0 + row, col, v); });
    __syncthreads();
  }
}

DI void ph_rwshift(const P& p, int layer) {
  const float* mu = p.rw_mu + layer * RWC;
  const int total = NTOK * (RWC / 4);
  const int tid_ = tidx();
  for (int i = blockIdx.x * NTH + tid_; i < total; i += gridDim.x * NTH) {
    int tok = i / (RWC / 4), c = (i % (RWC / 4)) * 4;
    int t = tok % T;
    const float* zr = p.Z + (size_t)tok * INC + c;
    float4 z = *(const float4*)zr;
    float4 zm = (t > 0) ? *(const float4*)(zr - INC) : float4{0.f, 0.f, 0.f, 0.f};
    float4 zp = (t < T - 1) ? *(const float4*)(zr + INC) : float4{0.f, 0.f, 0.f, 0.f};
    float4 m = *(const float4*)(mu + c);
    float4 o;
    o.x = z.x + m.x * (0.5f * (zm.x + zp.x) - z.x);
    o.y = z.y + m.y * (0.5f * (zm.y + zp.y) - z.y);
    o.z = z.z + m.z * (0.5f * (zm.z + zp.z) - z.z);
    o.w = z.w + m.w * (0.5f * (zm.w + zp.w) - z.w);
    if (c < 512) *(float4*)(p.R + (size_t)tok * RWW + c) = o;
    else if (c < 1024) *(float4*)(p.K + (size_t)tok * RWW + (c - 512)) = o;
    else if (c < 1536) *(float4*)(p.V + (size_t)tok * RWW + (c - 1024)) = o;
    else if (c < 1664) {
      int d = (c - 1536) >> 6, l = (c - 1536) & 63;
      *(uint2*)(p.TWD + ((size_t)d * NTOK + tok) * 64 + l) = uint2{pk2(tanhf(o.x), tanhf(o.y)), pk2(tanhf(o.z), tanhf(o.w))};
    } else if (c < 1792) {
      int d = (c - 1664) >> 6, l = (c - 1664) & 63;
      *(uint2*)(p.AD + ((size_t)d * NTOK + tok) * 64 + l) = uint2{pk2(o.x, o.y), pk2(o.z, o.w)};
    } else {
      int l = c - 1792;
      *(uint2*)(p.SGD + (size_t)tok * 128 + l) = uint2{pk2(sigmoidf_(o.x), sigmoidf_(o.y)), pk2(sigmoidf_(o.z), sigmoidf_(o.w))};
    }
  }
}

DI void rope_cs(int pos, int i, float& cs, float& sn) {
  const int i3 = i & 3, i2 = i >> 2;
  const float c4 = (i3 == 0) ? 1.0f : (i3 == 1) ? 0.5623413251903491f : (i3 == 2) ? 0.31622776601683794f : 0.1778279410038923f;
  const float p10 = (i2 == 0) ? 1.0f : (i2 == 1) ? 0.1f : (i2 == 2) ? 0.01f : 0.001f;
  float inv = c4 * p10;
  float ang = (float)pos * inv;
  double rev = (double)ang * 0.15915494309189535;
  rev -= floor(rev);
  float rf = (float)rev;
  sn = __builtin_amdgcn_sinf(rf);
  cs = __builtin_amdgcn_cosf(rf);
}

DI void ph_mlaprep1(const P& p, int layer) {
  const int tid_ = tidx(); const int lane = tid_ & 63, w = tid_ >> 6;
  const float* qn = p.mla_q_norm + layer * 256;
  const float* kvn = p.mla_kv_norm + layer * 128;
  for (int tok = blockIdx.x * 8 + w; tok < NTOK; tok += gridDim.x * 8) {
    const float* zr = p.Z + (size_t)tok * INC + RWC;
    float4 q = *(const float4*)(zr + lane * 4);
    float ss = wave_sum(q.x * q.x + q.y * q.y + q.z * q.z + q.w * q.w);
    float rstd = rsqrtf(ss * (1.f / 256) + NORM_EPS);
    float4 g = *(const float4*)(qn + lane * 4);
    *(uint2*)(p.QDN + (size_t)tok * 256 + lane * 4) = uint2{pk2(q.x * rstd * g.x, q.y * rstd * g.y), pk2(q.z * rstd * g.z, q.w * rstd * g.w)};
    float2 kv = *(const float2*)(zr + 256 + lane * 2);
    float ss2 = wave_sum(kv.x * kv.x + kv.y * kv.y);
    float rstd2 = rsqrtf(ss2 * (1.f / 128) + NORM_EPS);
    float2 g2 = *(const float2*)(kvn + lane * 2);
    *(unsigned*)(p.KVDN + (size_t)tok * 128 + lane * 2) = pk2(kv.x * rstd2 * g2.x, kv.y * rstd2 * g2.y);
    if (lane < 16) {
      float u1 = zr[384 + lane], u2 = zr[384 + 16 + lane];
      float cs, sn; rope_cs(p.pos[tok], lane, cs, sn);
      p.KR[(size_t)tok * 32 + lane] = u1 * cs - u2 * sn;
      p.KR[(size_t)tok * 32 + 16 + lane] = u1 * sn + u2 * cs;
    }
  }
}

DI void ph_mlafinish(const P& p) {
  const int tid_ = tidx(); const int lane = tid_ & 63, w = tid_ >> 6;
  const float qs = 0.10206207261596577f * 1.4426950408889634f;
  for (int tok = blockIdx.x * 8 + w; tok < NTOK; tok += gridDim.x * 8) {
    int b = tok / T, t = tok % T;
    float cs = 0.f, sn = 0.f;
    if (lane < 16) rope_cs(p.pos[tok], lane, cs, sn);
    const float* qr = p.QRAW + (size_t)tok * 768;
    const float* kvr = p.KVRAW + (size_t)tok * 1024;
    const float* kr = p.KR + (size_t)tok * 32;
#pragma unroll
    for (int h = 0; h < NH; ++h) {
      size_t row = ((size_t)(b * NH + h) * T + t);
      u16* qo = p.Q + row * 96; u16* ko = p.Kc + row * 96; u16* vo = p.Vv + row * 64;
      qo[lane] = f2bf(qr[h * 96 + lane] * qs);
      ko[lane] = f2bf(kvr[h * 128 + lane]);
      vo[lane] = f2bf(kvr[h * 128 + 64 + lane]);
      if (lane < 16) {
        float u1 = qr[h * 96 + 64 + lane], u2 = qr[h * 96 + 80 + lane];
        qo[64 + lane] = f2bf((u1 * cs - u2 * sn) * qs);
        qo[80 + lane] = f2bf((u1 * sn + u2 * cs) * qs);
      }
      if (lane < 32) ko[64 + lane] = f2bf(kr[lane]);
    }
  }
}

constexpr int KS_STRIDE = 104, VS_STRIDE = 72, PS_STRIDE = 72;
DI void ph_attn(const P& p, char* smem, unsigned* ctr) {
  short* Ks = (short*)smem;
  short* Vs = (short*)(smem + 64 * KS_STRIDE * 2);
  short* Ps = (short*)(smem + 64 * KS_STRIDE * 2 + 64 * VS_STRIDE * 2);
  const int tid = tidx(), lane = tid & 63, w = tid >> 6;
  const int l15 = lane & 15, lq = lane >> 4;
  short* Pw = Ps + w * 16 * PS_STRIDE;
  int* sitem = (int*)(smem + SMEM_BYTES - 16);
  for (;;) {
    __syncthreads();
    if (tid == 0) *sitem = (int)atomicAdd(ctr, 1u);
    __syncthreads();
    const int item = *sitem;
    if (item >= NB * NH * (T / 128)) break;
    int bh = item / (T / 128), qt = item % (T / 128);
    const u16* Qb = p.Q + (size_t)bh * T * 96;
    const u16* Kb = p.Kc + (size_t)bh * T * 96;
    const u16* Vb = p.Vv + (size_t)bh * T * 64;
    int qrow = qt * 128 + w * 16 + l15;
    bf16x8 qf[3];
#pragma unroll
    for (int ks = 0; ks < 3; ++ks) qf[ks] = *(const bf16x8*)(Qb + (size_t)qrow * 96 + ks * 32 + 8 * lq);
    float m[4], ls[4]; f32x4 o[4];
#pragma unroll
    for (int r = 0; r < 4; ++r) { m[r] = -INFINITY; ls[r] = 0.f; }
#pragma unroll
    for (int ni = 0; ni < 4; ++ni) o[ni] = f32x4{0.f, 0.f, 0.f, 0.f};

    uint4 kreg0, kreg1, vreg;
    auto gl = [&](int kt) {
      const u16* kp = Kb + (size_t)kt * 64 * 96;
      kreg0 = *(const uint4*)(kp + (size_t)tid * 8);
      if (tid < 256) kreg1 = *(const uint4*)(kp + (size_t)(tid + 512) * 8);
      vreg = *(const uint4*)(Vb + (size_t)kt * 64 * 64 + (size_t)tid * 8);
    };
    gl(0);
    for (int kt = 0; kt < T / 64; ++kt) {
      __syncthreads();
      { int c = tid; int row = c / 12, cc = c % 12; *(uint4*)(Ks + row * KS_STRIDE + cc * 8) = kreg0; }
      if (tid < 256) { int c = tid + 512; int row = c / 12, cc = c % 12; *(uint4*)(Ks + row * KS_STRIDE + cc * 8) = kreg1; }
      { int row = tid >> 3, cc = tid & 7; *(uint4*)(Vs + row * VS_STRIDE + cc * 8) = vreg; }
      __syncthreads();
      if (kt + 1 < T / 64) gl(kt + 1);
      f32x4 s[4];
#pragma unroll
      for (int nt = 0; nt < 4; ++nt) {
        s[nt] = f32x4{0.f, 0.f, 0.f, 0.f};
#pragma unroll
        for (int ks = 0; ks < 3; ++ks) {
          bf16x8 kb = *(const bf16x8*)(Ks + (nt * 16 + l15) * KS_STRIDE + ks * 32 + 8 * lq);
          s[nt] = __builtin_amdgcn_mfma_f32_16x16x32_bf16(qf[ks], kb, s[nt], 0, 0, 0);
        }
      }
#pragma unroll
      for (int r = 0; r < 4; ++r) {
        float mx = fmaxf(fmaxf(s[0][r], s[1][r]), fmaxf(s[2][r], s[3][r]));
        mx = fmaxf(mx, __shfl_xor(mx, 1)); mx = fmaxf(mx, __shfl_xor(mx, 2));
        mx = fmaxf(mx, __shfl_xor(mx, 4)); mx = fmaxf(mx, __shfl_xor(mx, 8));
        float mn = fmaxf(m[r], mx);
        float alpha = __builtin_amdgcn_exp2f(m[r] - mn);
        m[r] = mn;
        float ps = 0.f;
#pragma unroll
        for (int nt = 0; nt < 4; ++nt) {
          float pv = __builtin_amdgcn_exp2f(s[nt][r] - mn);
          ps += pv;
          Pw[(lq * 4 + r) * PS_STRIDE + nt * 16 + l15] = (short)f2bf(pv);
        }
        ls[r] = ls[r] * alpha + ps;
#pragma unroll
        for (int ni = 0; ni < 4; ++ni) o[ni][r] *= alpha;
      }
      __syncthreads();
#pragma unroll
      for (int kk = 0; kk < 2; ++kk) {
        bf16x8 a = *(const bf16x8*)(Pw + l15 * PS_STRIDE + kk * 32 + 8 * lq);
        int kb = kk * 32 + 8 * lq; int q = l15 >> 2, pp = l15 & 3;
#pragma unroll
        for (int ni = 0; ni < 4; ++ni) {
          s16x4 lo = tr_read(Vs + (kb + q) * VS_STRIDE + ni * 16 + 4 * pp);
          s16x4 hi = tr_read(Vs + (kb + 4 + q) * VS_STRIDE + ni * 16 + 4 * pp);
          bf16x8 vb = __builtin_shufflevector(lo, hi, 0, 1, 2, 3, 4, 5, 6, 7);
          o[ni] = __builtin_amdgcn_mfma_f32_16x16x32_bf16(a, vb, o[ni], 0, 0, 0);
        }
      }
    }
    int b = bh / NH, h = bh % NH;
#pragma unroll
    for (int r = 0; r < 4; ++r) {
      float l = ls[r];
      l += __shfl_xor(l, 1); l += __shfl_xor(l, 2); l += __shfl_xor(l, 4); l += __shfl_xor(l, 8);
      float inv = 1.f / l;
      int t = qt * 128 + w * 16 + lq * 4 + r;
      float* orow = p.AO + ((size_t)(b * T + t)) * 512 + h * 64;
#pragma unroll
      for (int ni = 0; ni < 4; ++ni) orow[ni * 16 + l15] = o[ni][r] * inv;
    }
    __syncthreads();
  }
}

constexpr int SC = 128, NCH = T / SC;
DI void scan_stage(const P& p, int b, int h, int d, int n0, float kkc, float kac, float* sm, int lane, int w) {
  float* sw = sm; float* skk = sw + 1024; float* sba = skk + 1024; float* skd = sba + 1024; float* sr = skd + 1024; float* sv = sr + 1024;
  const u16* LWd = p.LW + (size_t)d * NTOK * RWW;
  const u16* AAd = p.AA + (size_t)d * NTOK * RWW;
  const int ch = h * 64 + lane;
#pragma unroll
  for (int jj = 0; jj < 2; ++jj) {
    int j = w + 8 * jj; int n = n0 + j; int t = d ? (T - 1 - n) : n;
    size_t off = ((size_t)(b * T + t)) * RWW + ch;
    float kv = p.K[off];
    float kx = kv * kkc;
    float nrm = sqrtf(wave_sum(kx * kx));
    float kkv = kx / fmaxf(nrm, 1e-12f);
    float a = bf2f(AAd[off]);
    sw[j * 64 + lane] = __expf(bf2f(LWd[off]));
    skk[j * 64 + lane] = kkv;
    sba[j * 64 + lane] = a * kkv;
    skd[j * 64 + lane] = kv * (1.f + (a - 1.f) * kac);
    sr[j * 64 + lane] = p.R[off];
    sv[j * 64 + lane] = p.V[off];
  }
}

DI void ph_scan1(const P& p, int layer, char* smem) {
  float* sm = (float*)smem;
  const int tid = tidx(), lane = tid & 63, w = tid >> 6;
  const int row = tid >> 2, kq = tid & 3;
  for (int item = blockIdx.x; item < 32 * NCH; item += gridDim.x) {
    int scan = item / NCH, c = item % NCH;
    int d = scan & 1, h = (scan >> 1) % NH, b = scan / (2 * NH);
    const float kkc = p.rw_k_k[layer * RWW + h * 64 + lane], kac = p.rw_k_a[layer * RWW + h * 64 + lane];
    float S[16];
#pragma unroll
    for (int i = 0; i < 16; ++i) S[i] = (row == kq * 16 + i) ? 1.f : 0.f;
    for (int sub = 0; sub < SC / 16; ++sub) {
      __syncthreads();
      scan_stage(p, b, h, d, c * SC + sub * 16, kkc, kac, sm, lane, w);
      __syncthreads();
      for (int j = 0; j < 16; ++j) {
        const f32x4* w4 = (const f32x4*)(sm + j * 64 + kq * 16);
        const f32x4* k4 = (const f32x4*)(sm + 1024 + j * 64 + kq * 16);
        const f32x4* b4 = (const f32x4*)(sm + 2048 + j * 64 + kq * 16);
        const f32x4* d4 = (const f32x4*)(sm + 3072 + j * 64 + kq * 16);
        float vv = (row >= 64) ? sm[5120 + j * 64 + (row - 64)] : 0.f;
        f32x4 kk[4];
        float sa = 0.f;
#pragma unroll
        for (int q = 0; q < 4; ++q) { kk[q] = k4[q];
#pragma unroll
          for (int e = 0; e < 4; ++e) sa -= S[q * 4 + e] * kk[q][e]; }
        sa += __shfl_xor(sa, 1); sa += __shfl_xor(sa, 2);
#pragma unroll
        for (int q = 0; q < 4; ++q) { f32x4 ww = w4[q], bb = b4[q], dd = d4[q];
#pragma unroll
          for (int e = 0; e < 4; ++e) S[q * 4 + e] = S[q * 4 + e] * ww[e] + sa * bb[e] + vv * dd[e]; }
      }
    }
    float* dst = ((row < 64) ? p.MC : p.NC) + (((size_t)scan * NCH + c) * 64 + (row & 63)) * 64 + kq * 16;
#pragma unroll
    for (int q = 0; q < 4; ++q) *(f32x4*)(dst + q * 4) = f32x4{S[q * 4], S[q * 4 + 1], S[q * 4 + 2], S[q * 4 + 3]};
  }
}

DI void ph_scan2(const P& p, char* smem) {
  float* Ssm = (float*)smem;
  float* Msm = Ssm + 64 * 68;
  const int tid = tidx();
  const int v = tid >> 3, kq = tid & 7;
  for (int scan = blockIdx.x; scan < 32; scan += gridDim.x) {
    float S[8];
#pragma unroll
    for (int i = 0; i < 8; ++i) S[i] = 0.f;
    const float* Mg = p.MC + (size_t)scan * NCH * 4096;
    const float* Ng = p.NC + (size_t)scan * NCH * 4096;
    float* Sg = p.SS + (size_t)scan * NCH * 4096;
    f32x4 m0 = *(const f32x4*)(Mg + tid * 8), m1 = *(const f32x4*)(Mg + tid * 8 + 4);
    f32x4 n0 = *(const f32x4*)(Ng + tid * 8), n1 = *(const f32x4*)(Ng + tid * 8 + 4);
    for (int c = 0; c < NCH; ++c) {
      __syncthreads();
      *(f32x4*)(Sg + (size_t)c * 4096 + tid * 8) = f32x4{S[0], S[1], S[2], S[3]};
      *(f32x4*)(Sg + (size_t)c * 4096 + tid * 8 + 4) = f32x4{S[4], S[5], S[6], S[7]};
      *(f32x4*)(Ssm + v * 68 + kq * 8) = f32x4{S[0], S[1], S[2], S[3]};
      *(f32x4*)(Ssm + v * 68 + kq * 8 + 4) = f32x4{S[4], S[5], S[6], S[7]};
      *(f32x4*)(Msm + tid * 8) = m0; *(f32x4*)(Msm + tid * 8 + 4) = m1;
      float acc[8] = {n0[0], n0[1], n0[2], n0[3], n1[0], n1[1], n1[2], n1[3]};
      __syncthreads();
      if (c + 1 < NCH) {
        m0 = *(const f32x4*)(Mg + (size_t)(c + 1) * 4096 + tid * 8); m1 = *(const f32x4*)(Mg + (size_t)(c + 1) * 4096 + tid * 8 + 4);
        n0 = *(const f32x4*)(Ng + (size_t)(c + 1) * 4096 + tid * 8); n1 = *(const f32x4*)(Ng + (size_t)(c + 1) * 4096 + tid * 8 + 4);
      }
#pragma unroll 4
      for (int jq = 0; jq < 16; ++jq) {
        f32x4 sv = *(const f32x4*)(Ssm + v * 68 + jq * 4);
#pragma unroll
        for (int e = 0; e < 4; ++e) {
          f32x4 ma = *(const f32x4*)(Msm + (jq * 4 + e) * 64 + kq * 8), mb = *(const f32x4*)(Msm + (jq * 4 + e) * 64 + kq * 8 + 4);
          acc[0] += sv[e] * ma[0]; acc[1] += sv[e] * ma[1]; acc[2] += sv[e] * ma[2]; acc[3] += sv[e] * ma[3];
          acc[4] += sv[e] * mb[0]; acc[5] += sv[e] * mb[1]; acc[6] += sv[e] * mb[2]; acc[7] += sv[e] * mb[3];
        }
      }
#pragma unroll
      for (int i = 0; i < 8; ++i) S[i] = acc[i];
    }
    __syncthreads();
  }
}

DI void ph_scan3(const P& p, int layer, char* smem) {
  float* sm = (float*)smem; float* so = sm + 6144;
  const int tid = tidx(), lane = tid & 63, w = tid >> 6;
  const int v = tid >> 3, kq = tid & 7;
  for (int item = blockIdx.x; item < 32 * NCH; item += gridDim.x) {
    int scan = item / NCH, c = item % NCH;
    int d = scan & 1, h = (scan >> 1) % NH, b = scan / (2 * NH);
    const float kkc = p.rw_k_k[layer * RWW + h * 64 + lane], kac = p.rw_k_a[layer * RWW + h * 64 + lane];
    u16* Od = p.O2 + (size_t)d * NTOK * RWW;
    float S[8];
    {
      const float* Sg = p.SS + ((size_t)scan * NCH + c) * 4096 + tid * 8;
      f32x4 s0 = *(const f32x4*)Sg, s1 = *(const f32x4*)(Sg + 4);
      S[0] = s0[0]; S[1] = s0[1]; S[2] = s0[2]; S[3] = s0[3]; S[4] = s1[0]; S[5] = s1[1]; S[6] = s1[2]; S[7] = s1[3];
    }
    for (int sub = 0; sub < SC / 16; ++sub) {
      const int n0 = c * SC + sub * 16;
      __syncthreads();
      scan_stage(p, b, h, d, n0, kkc, kac, sm, lane, w);
      __syncthreads();
      for (int j = 0; j < 16; ++j) {
        const f32x4* w4 = (const f32x4*)(sm + j * 64 + kq * 8);
        const f32x4* k4 = (const f32x4*)(sm + 1024 + j * 64 + kq * 8);
        const f32x4* b4 = (const f32x4*)(sm + 2048 + j * 64 + kq * 8);
        const f32x4* d4 = (const f32x4*)(sm + 3072 + j * 64 + kq * 8);
        const f32x4* r4 = (const f32x4*)(sm + 4096 + j * 64 + kq * 8);
        float vv = sm[5120 + j * 64 + v];
        float sa = 0.f;
#pragma unroll
        for (int q = 0; q < 2; ++q) { f32x4 kk = k4[q];
#pragma unroll
          for (int e = 0; e < 4; ++e) sa -= S[q * 4 + e] * kk[e]; }
        sa += __shfl_xor(sa, 1); sa += __shfl_xor(sa, 2); sa += __shfl_xor(sa, 4);
        float oo = 0.f;
#pragma unroll
        for (int q = 0; q < 2; ++q) { f32x4 ww = w4[q], bb = b4[q], dd = d4[q], rr = r4[q];
#pragma unroll
          for (int e = 0; e < 4; ++e) { S[q * 4 + e] = S[q * 4 + e] * ww[e] + sa * bb[e] + vv * dd[e]; oo += S[q * 4 + e] * rr[e]; } }
        oo += __shfl_xor(oo, 1); oo += __shfl_xor(oo, 2); oo += __shfl_xor(oo, 4);
        if (kq == 0) so[j * 64 + v] = oo;
      }
      __syncthreads();
#pragma unroll
      for (int jj = 0; jj < 2; ++jj) {
        int j = w + 8 * jj; int n = n0 + j; int t = d ? (T - 1 - n) : n;
        Od[((size_t)(b * T + t)) * RWW + h * 64 + lane] = f2bf(so[j * 64 + lane]);
      }
    }
  }
}

DI void ph_mixfinish(const P& p, int layer) {
  const int tid_ = tidx(); const int lane = tid_ & 63, w = tid_ >> 6;
  const float* lw = p.rw_lnx_w + layer * RWW; const float* lb = p.rw_lnx_b + layer * RWW;
  const float* kac = p.rw_k_a + layer * RWW; const float* rk = p.rw_r_k + layer * RWW;
  const float* on = p.mla_o_norm + layer * 512;
  for (int tok = blockIdx.x * 8 + w; tok < NTOK; tok += gridDim.x * 8) {
#pragma unroll
    for (int h = 0; h < NH; ++h) {
      int c = h * 64 + lane; size_t off = (size_t)tok * RWW + c;
      float o = bf2f(p.O2[off]) + bf2f(p.O2[(size_t)NTOK * RWW + off]);
      float mean = wave_sum(o) * (1.f / 64);
      float dv = o - mean;
      float var = wave_sum(dv * dv) * (1.f / 64);
      float on_ = dv * rsqrtf(var + GN_EPS) * lw[c] + lb[c];
      float k = p.K[off], r = p.R[off], vv = p.V[off];
      float a0 = bf2f(p.AA[off]), a1 = bf2f(p.AA[(size_t)NTOK * RWW + off]);
      float kb = 0.5f * (k * (1.f + (a0 - 1.f) * kac[c]) + k * (1.f + (a1 - 1.f) * kac[c]));
      float s = wave_sum(r * kb * rk[c]);
      float y = (on_ + s * vv) * bf2f(p.G[off]);
      p.H[(size_t)tok * DM + c] = f2bf(y);
    }
    const float* ao = p.AO + (size_t)tok * 512;
    float4 v0 = *(const float4*)(ao + lane * 4), v1 = *(const float4*)(ao + 256 + lane * 4);
    float ss = wave_sum(v0.x * v0.x + v0.y * v0.y + v0.z * v0.z + v0.w * v0.w + v1.x * v1.x + v1.y * v1.y + v1.z * v1.z + v1.w * v1.w);
    float rstd = rsqrtf(ss * (1.f / 512) + NORM_EPS);
    float4 g0 = *(const float4*)(on + lane * 4), g1 = *(const float4*)(on + 256 + lane * 4);
    *(uint2*)(p.H + (size_t)tok * DM + 512 + lane * 4) = uint2{pk2(v0.x * rstd * g0.x, v0.y * rstd * g0.y), pk2(v0.z * rstd * g0.z, v0.w * rstd * g0.w)};
    *(uint2*)(p.H + (size_t)tok * DM + 768 + lane * 4) = uint2{pk2(v1.x * rstd * g1.x, v1.y * rstd * g1.y), pk2(v1.z * rstd * g1.z, v1.w * rstd * g1.w)};
  }
}

DI void ph_norm_router(const P& p, int layer) {
  const int tid_ = tidx(); const int lane = tid_ & 63, w = tid_ >> 6;
  const float* g = p.ffn_norm + layer * DM;
  const float* rt = p.router + (size_t)layer * DM * NE;
  for (int tok = blockIdx.x * 8 + w; tok < NTOK; tok += gridDim.x * 8) {
    const float4* xr = (const float4*)(p.out + (size_t)tok * DM);
    float4 v[4]; float ss = 0.f;
#pragma unroll
    for (int j = 0; j < 4; ++j) { v[j] = xr[lane + 64 * j]; ss += v[j].x * v[j].x + v[j].y * v[j].y + v[j].z * v[j].z + v[j].w * v[j].w; }
    ss = wave_sum(ss);
    float rstd = rsqrtf(ss * (1.f / DM) + NORM_EPS);
    float lg[NE];
#pragma unroll
    for (int e = 0; e < NE; ++e) lg[e] = 0.f;
#pragma unroll
    for (int j = 0; j < 4; ++j) {
      int c0 = (lane + 64 * j) * 4;
      float4 gg = *(const float4*)(g + c0);
      float hv[4] = {v[j].x * rstd * gg.x, v[j].y * rstd * gg.y, v[j].z * rstd * gg.z, v[j].w * rstd * gg.w};
      *(uint2*)(p.H + (size_t)tok * DM + c0) = uint2{pk2(hv[0], hv[1]), pk2(hv[2], hv[3])};
#pragma unroll
      for (int q = 0; q < 4; ++q) {
        const float4* rr = (const float4*)(rt + (size_t)(c0 + q) * NE);
        float4 r0 = rr[0], r1 = rr[1], r2 = rr[2], r3 = rr[3];
        lg[0] += hv[q] * r0.x; lg[1] += hv[q] * r0.y; lg[2] += hv[q] * r0.z; lg[3] += hv[q] * r0.w;
        lg[4] += hv[q] * r1.x; lg[5] += hv[q] * r1.y; lg[6] += hv[q] * r1.z; lg[7] += hv[q] * r1.w;
        lg[8] += hv[q] * r2.x; lg[9] += hv[q] * r2.y; lg[10] += hv[q] * r2.z; lg[11] += hv[q] * r2.w;
        lg[12] += hv[q] * r3.x; lg[13] += hv[q] * r3.y; lg[14] += hv[q] * r3.z; lg[15] += hv[q] * r3.w;
      }
    }
    float mx = -INFINITY;
#pragma unroll
    for (int e = 0; e < NE; ++e) { lg[e] = wave_sum(lg[e]); mx = fmaxf(mx, lg[e]); }
    float se = 0.f;
#pragma unroll
    for (int e = 0; e < NE; ++e) { lg[e] = expf(lg[e] - mx); se += lg[e]; }
    float inv = 1.f / se;
    int b = tok / T, t = tok % T;
    float mine = 0.f;
#pragma unroll
    for (int e = 0; e < NE; ++e) mine = (lane == e) ? lg[e] * inv : mine;
    if (lane < NE) p.AFF[((size_t)(b * NE + lane)) * T + t] = mine;
  }
}

DI void ph_topk(const P& p, char* smem) {
  unsigned* hist = (unsigned*)smem;
  unsigned* sc = hist + 256;
  unsigned* bc = sc + 2048;
  const int tid = tidx();
  for (int item = blockIdx.x; item < NB * NE; item += gridDim.x) {
    const float* a = p.AFF + (size_t)item * T;
    unsigned key[16];
#pragma unroll
    for (int i = 0; i < 4; ++i) {
      uint4 v = *(const uint4*)(a + tid * 16 + i * 4);
      key[i * 4 + 0] = v.x; key[i * 4 + 1] = v.y; key[i * 4 + 2] = v.z; key[i * 4 + 3] = v.w;
    }
    unsigned prefix = 0, mask = 0, need = CAP;
    for (int pass = 0; pass < 4; ++pass) {
      int shift = 24 - 8 * pass;
      __syncthreads();
      if (tid < 256) hist[tid] = 0;
      __syncthreads();
#pragma unroll
      for (int i = 0; i < 16; ++i)
        if ((key[i] & mask) == prefix) atomicAdd(&hist[(key[i] >> shift) & 255u], 1u);
      __syncthreads();
      if (tid == 0) {
        unsigned cum = 0; int bsel = 0; unsigned nd = need;
        for (int bb = 255; bb >= 0; --bb) {
          unsigned hc = hist[bb];
          if (cum + hc >= need) { bsel = bb; nd = need - cum; break; }
          cum += hc;
        }
        bc[0] = prefix | ((unsigned)bsel << shift); bc[1] = nd;
      }
      __syncthreads();
      prefix = bc[0]; need = bc[1]; mask |= (255u << shift);
    }
    unsigned ngt = 0, neq = 0;
#pragma unroll
    for (int i = 0; i < 16; ++i) { ngt += key[i] > prefix; neq += key[i] == prefix; }
    __syncthreads();
    unsigned* sA = sc; unsigned* sB = sc + 512; unsigned* eA = sc + 1024; unsigned* eB = sc + 1536;
    sA[tid] = ngt; eA[tid] = neq;
    __syncthreads();
    for (int off = 1; off < NTH; off <<= 1) {
      unsigned x = sA[tid] + ((tid >= off) ? sA[tid - off] : 0u);
      unsigned y = eA[tid] + ((tid >= off) ? eA[tid - off] : 0u);
      sB[tid] = x; eB[tid] = y;
      __syncthreads();
      unsigned* tmp = sA; sA = sB; sB = tmp; tmp = eA; eA = eB; eB = tmp;
    }
    unsigned gt_excl = sA[tid] - ngt, eq_excl = eA[tid] - neq;
    unsigned gt_total = sA[NTH - 1];
    int* idx = p.IDX + (size_t)item * CAP; float* gate = p.GATE + (size_t)item * CAP;
#pragma unroll
    for (int i = 0; i < 16; ++i) {
      if (key[i] > prefix) { idx[gt_excl] = tid * 16 + i; gate[gt_excl] = __uint_as_float(key[i]); ++gt_excl; }
      else if (key[i] == prefix) {
        if (eq_excl < need) { idx[gt_total + eq_excl] = tid * 16 + i; gate[gt_total + eq_excl] = __uint_as_float(key[i]); }
        ++eq_excl;
      }
    }
    __syncthreads();
  }
}

DI void ph_exp1(const P& p, int layer, char* smem) {
  for (int t = blockIdx.x; t < 32 * 4 * 16; t += gridDim.x) {
    int grp = t / 64, r = t % 64, tm = r / 16, tn = r % 16;
    int b = grp / NE, e = grp % NE;
    const int* gi = p.IDX + (size_t)grp * CAP + tm * GBM;
    const u16* Hb = p.H + (size_t)b * T * DM;
    const float* Wg = p.exp_w_gate + ((size_t)layer * NE + e) * DM * 1024;
    const float* Wu = p.exp_w_up + ((size_t)layer * NE + e) * DM * 1024;
    u16* hid = p.HID + ((size_t)grp * CAP + tm * GBM) * 1024;
    auto arow = [&](int row) -> const void* { return Hb + (size_t)gi[row] * DM; };
    gemm_tile<false, 1>(arow, Wg, Wu, 1024, DM, tn * 64, 1024, smem, [&](int row, int col, float g, float u) {
      float sv = g / (1.f + __expf(-g));
      hid[(size_t)row * 1024 + col] = f2bf(sv * u);
    });
    __syncthreads();
  }
}
DI void ph_exp2(const P& p, int layer, char* smem) {
  for (int t = blockIdx.x; t < 32 * 4 * 8; t += gridDim.x) {
    int grp = t / 32, r = t % 32, tm = r / 8, tn = r % 8;
    int b = grp / NE, e = grp % NE;
    const int* gi = p.IDX + (size_t)grp * CAP + tm * GBM;
    const float* gt = p.GATE + (size_t)grp * CAP + tm * GBM;
    const u16* hid = p.HID + ((size_t)grp * CAP + tm * GBM) * 1024;
    const float* Wd = p.exp_w_down + ((size_t)layer * NE + e) * 1024 * DM;
    float* xb = p.out + (size_t)b * T * DM;
    auto arow = [&](int row) -> const void* { return hid + (size_t)row * 1024; };
    gemm_tile<false, 0>(arow, Wd, nullptr, DM, 1024, tn * GBN, DM, smem, [&](int row, int col, float v, float) {
      unsafeAtomicAdd(xb + (size_t)gi[row] * DM + col, v * gt[row]);
    });
    __syncthreads();
  }
}

#define XB_TMO      128
#define XB_XCNT(j)  (256  + 64 * (j))
#define XB_XSUB(j)  (1280 + 64 * (j))
#define XB_XGEN(j)  (2304 + 64 * (j))
#define XB_TOP      3328
#define XB_TOPGEN   3392
#define XCD_BAR_WORDS 3456
#define XB_SPIN_CAP (1u << 20)
DI unsigned xb_ld(unsigned* p) { return __hip_atomic_load(p, __ATOMIC_RELAXED, __HIP_MEMORY_SCOPE_AGENT); }
DI unsigned xb_add(unsigned* p, unsigned v) { return __hip_atomic_fetch_add(p, v, __ATOMIC_RELAXED, __HIP_MEMORY_SCOPE_AGENT); }
DI unsigned xb_xcc_id() { return (unsigned)__builtin_amdgcn_s_getreg((3 << 11) | 20) & 0xFu; }
#define XB_SPIN(cond, bar) do { unsigned _sp = 0; while (cond) { __builtin_amdgcn_s_sleep(1); \
    if ((++_sp & 255u) == 0u) { if (xb_ld(&(bar)[XB_TMO])) break; if (_sp > XB_SPIN_CAP) { atomicAdd(&(bar)[XB_TMO], 1u); break; } } } } while (0)
struct XcdBarrier { unsigned* bar; unsigned x; volatile LAS unsigned* st; };
DI XcdBarrier xcd_barrier_post(unsigned* bar, volatile LAS unsigned* st) {
  XcdBarrier b; b.bar = bar; b.x = xb_xcc_id(); b.st = st;
  if (threadIdx.x == 0) (void)xb_add(&bar[XB_XCNT(b.x)], 1u);
  return b;
}
DI void xcd_barrier_complete(unsigned* bar, unsigned x, unsigned& nloc, unsigned& nx) {
  const unsigned G = gridDim.x * gridDim.y * gridDim.z;
  unsigned sum, cnt, mine, sp = 0u;
  for (;;) {
    sum = 0u; cnt = 0u; mine = 0u;
#pragma unroll
    for (unsigned j = 0; j < 16; ++j) { const unsigned c = xb_ld(&bar[XB_XCNT(j)]); sum += c; cnt += (c > 0u) ? 1u : 0u; mine = (j == x) ? c : mine; }
    if (sum == G) break;
    __builtin_amdgcn_s_sleep(1);
    if ((++sp & 255u) == 0u) { if (xb_ld(&bar[XB_TMO])) break; if (sp > XB_SPIN_CAP) { atomicAdd(&bar[XB_TMO], 1u); break; } }
  }
  nloc = mine > 0u ? mine : 1u; nx = cnt > 0u ? cnt : 1u;
}
DI void xcd_barrier(const XcdBarrier& b) {
  asm volatile("s_waitcnt vmcnt(0)" ::: "memory");
  __syncthreads();
  if (threadIdx.x == 0) {
    unsigned* bar = b.bar;
    __builtin_amdgcn_s_waitcnt(0);
    unsigned nloc = b.st[0], nx = b.st[1];
    if (nloc == 0u) { xcd_barrier_complete(bar, b.x, nloc, nx); b.st[0] = nloc; b.st[1] = nx; }
    const unsigned old = xb_add(&bar[XB_XSUB(b.x)], 1u);
    const unsigned gen = old / nloc;
    if (old + 1u == (gen + 1u) * nloc) {
      __builtin_amdgcn_fence(__ATOMIC_RELEASE, "agent");
      asm volatile("s_waitcnt vmcnt(0)" ::: "memory");
      const unsigned og = xb_add(&bar[XB_TOP], 1u);
      const unsigned tg = og / nx;
      if (og + 1u == (tg + 1u) * nx) xb_add(&bar[XB_TOPGEN], 1u);
      else XB_SPIN(xb_ld(&bar[XB_TOPGEN]) == tg, bar);
      __builtin_amdgcn_fence(__ATOMIC_ACQUIRE, "agent");
      xb_add(&bar[XB_XGEN(b.x)], 1u);
      asm volatile("s_waitcnt vmcnt(0)" ::: "memory");
    } else {
      XB_SPIN(xb_ld(&bar[XB_XGEN(b.x)]) == gen, bar);
      __builtin_amdgcn_fence(__ATOMIC_ACQUIRE, "agent");
      asm volatile("s_waitcnt vmcnt(0)" ::: "memory");
    }
  }
  __syncthreads();
}

__global__ void __launch_bounds__(NTH) mega(P p) {
  __shared__ __attribute__((aligned(16))) char smem[SMEM_BYTES];
  __shared__ uint4 xb_words;
  cg::grid_group grid = cg::this_grid();
  if (threadIdx.x == 0) xb_words = make_uint4(0u, 0u, 0u, 0u);
  if (blockIdx.x == 0) {
    if (threadIdx.x < 16) p.CTR[threadIdx.x] = 0u;
    for (int i = threadIdx.x; i < XCD_BAR_WORDS; i += NTH) p.BAR[i] = 0u;
  }
  grid.sync();
  const XcdBarrier xb = xcd_barrier_post(p.BAR, (volatile LAS unsigned*)&xb_words);
#define GSYNC() xcd_barrier(xb)
  for (int layer = 0; layer < NL; ++layer) {
    ph_norm(layer == 0 ? p.x : p.out, p.attn_norm + layer * DM, p.H);
    GSYNC();
    {
      float* Z = p.Z;
      ph_gemm<false>(p.H, DM, p.w_in + (size_t)layer * DM * INC, INC, NTOK, INC, DM, smem,
                     [&](int row, int col, float v) { Z[(size_t)row * INC + col] = v; });
    }
    GSYNC();
    ph_rwshift(p, layer);
    ph_mlaprep1(p, layer);
    GSYNC();
    for (int d = 0; d < 2; ++d) {
      u16* LW = p.LW + (size_t)d * NTOK * RWW; const float* w0 = p.rw_w0 + (layer * 2 + d) * RWW;
      ph_gemm<false>(p.TWD + (size_t)d * NTOK * 64, 64, p.rw_w_up + ((size_t)(layer * 2 + d)) * 64 * RWW, RWW, NTOK, RWW, 64, smem,
                     [&](int row, int col, float v) { LW[(size_t)row * RWW + col] = f2bf(-0.6065306597126334f * sigmoidf_(v + w0[col])); });
      u16* AA = p.AA + (size_t)d * NTOK * RWW; const float* a0 = p.rw_a0 + (layer * 2 + d) * RWW;
      ph_gemm<false>(p.AD + (size_t)d * NTOK * 64, 64, p.rw_a_up + ((size_t)(layer * 2 + d)) * 64 * RWW, RWW, NTOK, RWW, 64, smem,
                     [&](int row, int col, float v) { AA[(size_t)row * RWW + col] = f2bf(sigmoidf_(v + a0[col])); });
    }
    {
      u16* G = p.G;
      ph_gemm<false>(p.SGD, 128, p.rw_g_up + (size_t)layer * 128 * RWW, RWW, NTOK, RWW, 128, smem,
                     [&](int row, int col, float v) { G[(size_t)row * RWW + col] = f2bf(v); });
      float* Q = p.QRAW;
      ph_gemm<false>(p.QDN, 256, p.mla_q_up + (size_t)layer * 256 * 768, 768, NTOK, 768, 256, smem,
                     [&](int row, int col, float v) { Q[(size_t)row * 768 + col] = v; });
      float* KV = p.KVRAW;
      ph_gemm<false>(p.KVDN, 128, p.mla_kv_up + (size_t)layer * 128 * 1024, 1024, NTOK, 1024, 128, smem,
                     [&](int row, int col, float v) { KV[(size_t)row * 1024 + col] = v; });
    }
    GSYNC();
    ph_mlafinish(p);
    ph_scan1(p, layer, smem);
    GSYNC();
    ph_scan2(p, smem);
    ph_attn(p, smem, p.CTR + layer);
    GSYNC();
    ph_scan3(p, layer, smem);
    GSYNC();
    ph_mixfinish(p, layer);
    GSYNC();
    {
      const float* xs = (layer == 0) ? p.x : p.out; float* xo = p.out;
      ph_gemm<false>(p.H, DM, p.w_out + (size_t)layer * DM * DM, DM, NTOK, DM, DM, smem,
                     [&](int row, int col, float v) { xo[(size_t)row * DM + col] = xs[(size_t)row * DM + col] + v; });
    }
    GSYNC();
    ph_norm_router(p, layer);
    GSYNC();
    ph_topk(p, smem);
    GSYNC();
    ph_exp1(p, layer, smem);
    GSYNC();
    ph_exp2(p, layer, smem);
    GSYNC();
    ph_norm(p.out, p.ple_norm + layer * DM, p.H);
    GSYNC();
    {
      float* PG = p.PG;
      ph_gemm<false>(p.H, DM, p.ple_gate + (size_t)layer * DM * DM, DM, NTOK, DM, DM, smem,
                     [&](int row, int col, float v) { PG[(size_t)row * DM + col] = sigmoidf_(v); });
    }
    GSYNC();
    {
      float* xo = p.out; const float* PG = p.PG;
      ph_gemm<true>(p.p + (size_t)layer * NTOK * DPLE, DPLE, p.ple_proj + (size_t)layer * DPLE * DM, DM, NTOK, DM, DPLE, smem,
                    [&](int row, int col, float v) { xo[(size_t)row * DM + col] += v * PG[(size_t)row * DM + col]; });
    }
    GSYNC();
  }
  ph_final_norm(p.out, p.final_norm);
}

extern "C" void kernel_launch(void* const* d_in, const int* in_sizes, int n_in, void* d_out, int out_size, void* d_ws,
                              size_t ws_size, hipStream_t stream) {
  (void)in_sizes; (void)n_in; (void)out_size;
  P p{};
  p.x = (const float*)d_in[0]; p.p = (const float*)d_in[1]; p.pos = (const int*)d_in[2];
  p.attn_norm = (const float*)d_in[3]; p.w_in = (const float*)d_in[4]; p.rw_mu = (const float*)d_in[5];
  p.rw_w0 = (const float*)d_in[6]; p.rw_w_up = (const float*)d_in[7]; p.rw_a0 = (const float*)d_in[8];
  p.rw_a_up = (const float*)d_in[9]; p.rw_g_up = (const float*)d_in[10]; p.rw_k_k = (const float*)d_in[11];
  p.rw_k_a = (const float*)d_in[12]; p.rw_r_k = (const float*)d_in[13]; p.rw_lnx_w = (const float*)d_in[14];
  p.rw_lnx_b = (const float*)d_in[15]; p.mla_q_norm = (const float*)d_in[16]; p.mla_q_up = (const float*)d_in[17];
  p.mla_kv_norm = (const float*)d_in[18]; p.mla_kv_up = (const float*)d_in[19]; p.mla_o_norm = (const float*)d_in[20];
  p.w_out = (const float*)d_in[21]; p.ffn_norm = (const float*)d_in[22]; p.router = (const float*)d_in[23];
  p.exp_w_gate = (const float*)d_in[24]; p.exp_w_up = (const float*)d_in[25]; p.exp_w_down = (const float*)d_in[26];
  p.ple_norm = (const float*)d_in[27]; p.ple_proj = (const float*)d_in[28]; p.ple_gate = (const float*)d_in[29];
  p.final_norm = (const float*)d_in[30];
  p.out = (float*)d_out;

  char* ws = (char*)d_ws; size_t off = 0;
  auto take = [&](size_t bytes) { char* r = ws + off; off += (bytes + 255) & ~(size_t)255; return r; };
  char* regA = take((size_t)NTOK * INC * 4);
  p.Z = (float*)regA;
  p.LW = (u16*)regA; p.AA = (u16*)(regA + (size_t)2 * NTOK * RWW * 2); p.G = (u16*)(regA + (size_t)4 * NTOK * RWW * 2);
  p.MC = (float*)(regA + (size_t)5 * NTOK * RWW * 2); p.NC = p.MC + (size_t)32 * NCH * 4096;
  p.HID = (u16*)regA;
  char* regB = take((size_t)3 * NTOK * RWW * 4);
  p.R = (float*)regB; p.K = p.R + (size_t)NTOK * RWW; p.V = p.K + (size_t)NTOK * RWW;
  p.PG = (float*)regB;
  char* regC = take((size_t)NTOK * (768 + 1024) * 4);
  p.QRAW = (float*)regC; p.KVRAW = p.QRAW + (size_t)NTOK * 768;
  p.AO = (float*)regC; p.O2 = (u16*)(p.AO + (size_t)NTOK * 512); p.SS = (float*)(p.O2 + (size_t)2 * NTOK * 512);
  p.TWD = (u16*)take((size_t)2 * NTOK * 64 * 2); p.AD = (u16*)take((size_t)2 * NTOK * 64 * 2);
  p.SGD = (u16*)take((size_t)NTOK * 128 * 2); p.QDN = (u16*)take((size_t)NTOK * 256 * 2);
  p.KVDN = (u16*)take((size_t)NTOK * 128 * 2); p.KR = (float*)take((size_t)NTOK * 32 * 4);
  p.Q = (u16*)take((size_t)NTOK * NH * 96 * 2); p.Kc = (u16*)take((size_t)NTOK * NH * 96 * 2);
  p.Vv = (u16*)take((size_t)NTOK * NH * 64 * 2);
  p.H = (u16*)take((size_t)NTOK * DM * 2);
  p.AFF = (float*)take((size_t)NB * NE * T * 4);
  p.IDX = (int*)take((size_t)NB * NE * CAP * 4);
  p.GATE = (float*)take((size_t)NB * NE * CAP * 4);

  p.CTR = (unsigned*)take(256);
  p.BAR = (unsigned*)take(XCD_BAR_WORDS * 4);
  if (off > ws_size) { fprintf(stderr, "workspace too small: need %zu have %zu\n", off, ws_size); return; }
  static int grid_blocks = 0;
  if (!grid_blocks) {
    int dev = 0, cus = 0, per_cu = 0;
    hipGetDevice(&dev);
    hipDeviceGetAttribute(&cus, hipDeviceAttributeMultiprocessorCount, dev);
    hipOccupancyMaxActiveBlocksPerMultiprocessor(&per_cu, mega, NTH, 0);
    if (per_cu > 1) per_cu = 1;
    grid_blocks = cus * per_cu;
  }
  void* args[] = {&p};
  hipError_t e = hipLaunchCooperativeKernel((void*)mega, dim3(grid_blocks), dim3(NTH), args, 0, stream);
  if (e != hipSuccess) fprintf(stderr, "cooperative launch failed: %s (grid %d)\n", hipGetErrorString(e), grid_blocks);
}
```

```cpp
#include <hip/hip_runtime.h>
#include <hip/hip_bf16.h>
#include <cstdio>
#include <cstdint>
#include <hip/hip_cooperative_groups.h>
namespace cg = cooperative_groups;

#define DI __device__ __forceinline__
#define LAS __attribute__((address_space(3)))

constexpr int NB = 2, T = 8192, NTOK = NB * T, DM = 1024, NL = 2;
constexpr int RWW = 512, RWC = 1920, INC = 2336;
constexpr int NH = 8;
constexpr int NE = 16, CAP = 1024;
constexpr int DPLE = 256;
constexpr int NTH = 512;
constexpr float NORM_EPS = 1e-6f, GN_EPS = 64e-5f;

using bf16x8 = __attribute__((ext_vector_type(8))) short;
using s16x4  = __attribute__((ext_vector_type(4))) short;
using f32x4  = __attribute__((ext_vector_type(4))) float;
using u32x4  = __attribute__((ext_vector_type(4))) unsigned;
using u32x2  = __attribute__((ext_vector_type(2))) unsigned;
typedef __bf16 bf2_t __attribute__((ext_vector_type(2)));
typedef unsigned short u16;

DI unsigned pk2(float a, float b) { bf2_t v = {(__bf16)a, (__bf16)b}; return __builtin_bit_cast(unsigned, v); }
DI u16 f2bf(float a) { return (u16)(pk2(a, 0.f) & 0xffffu); }
DI float bf2f(u16 u) { return __uint_as_float(((unsigned)u) << 16); }
DI int tidx() { int t = threadIdx.x; asm volatile("" : "+v"(t)); return t; }
DI int bidx() { int b = blockIdx.x; asm volatile("" : "+s"(b)); return b; }
DI float wave_sum(float v) {
#pragma unroll
  for (int o = 32; o >= 1; o >>= 1) v += __shfl_xor(v, o);
  return v;
}
DI float sigmoidf_(float x) { return 1.f / (1.f + __expf(-x)); }
DI s16x4 tr_read(const short* p) {
  return __builtin_amdgcn_ds_read_tr16_b64_v4i16((LAS s16x4*)(p));
}

struct P {
  const float* x; const float* p; const int* pos;
  const float* attn_norm; const float* w_in; const float* rw_mu; const float* rw_w0; const float* rw_w_up;
  const float* rw_a0; const float* rw_a_up; const float* rw_g_up; const float* rw_k_k; const float* rw_k_a;
  const float* rw_r_k; const float* rw_lnx_w; const float* rw_lnx_b; const float* mla_q_norm; const float* mla_q_up;
  const float* mla_kv_norm; const float* mla_kv_up; const float* mla_o_norm; const float* w_out; const float* ffn_norm;
  const float* router; const float* exp_w_gate; const float* exp_w_up; const float* exp_w_down; const float* ple_norm;
  const float* ple_proj; const float* ple_gate; const float* final_norm;
  float* out;
  float* Z;
  u16* LW;
  u16* AA;
  float* MC; float* NC;
  float* SS;
  u16*   G;
  u16*   HID;
  float* R; float* K; float* V;
  float* PG;
  float* QRAW;
  float* KVRAW;
  float* AO;
  u16* O2;
  u16* TWD; u16* AD; u16* SGD; u16* QDN; u16* KVDN; float* KR;
  u16* Q; u16* Kc; u16* Vv;
  u16* H;
  float* AFF;
  int* IDX;
  float* GATE;
  unsigned* CTR;
  unsigned* BAR;
};

constexpr int GBM = 256, GBN = 128, GBK = 64;
constexpr int AS_STRIDE = 72, BS_STRIDE = 136;
constexpr int AS_BYTES = GBM * AS_STRIDE * 2;
constexpr int BS_BYTES = GBK * BS_STRIDE * 2;
constexpr int SMEM_BYTES = 57344;

template <bool A_F32, int MODE, class ARow, class Epi>
DI void gemm_tile(ARow arow, const float* __restrict__ B, const float* __restrict__ B2, int ldb, int K, int n0, int Nvalid,
                  char* smem, Epi epi) {
  short* As = (short*)smem;
  short* Bs = (short*)(smem + AS_BYTES);
  const int tid = tidx(), lane = tid & 63, w = tid >> 6;
  const int wm = w >> 1, wn = w & 1;
  const int l15 = lane & 15, lq = lane >> 4;

  const char* ap[4];
#pragma unroll
  for (int i = 0; i < 4; ++i) {
    int u = tid + i * NTH; int row = u >> 3, kc = u & 7;
    ap[i] = (const char*)arow(row) + (size_t)kc * 8 * (A_F32 ? 4 : 2);
  }
  const float* bp[4]; bool bok[4];
#pragma unroll
  for (int i = 0; i < 4; ++i) {
    int u = tid + i * NTH; int k = u >> 5, nq = u & 31;
    int col; const float* base;
    if (MODE == 0) { col = n0 + nq * 4; base = B; }
    else { col = n0 + (nq & 15) * 4; base = (nq < 16) ? B : B2; }
    bok[i] = col < Nvalid;
    bp[i] = base + (size_t)k * ldb + (bok[i] ? col : 0);
  }

  f32x4 acc[4][4];
#pragma unroll
  for (int i = 0; i < 4; ++i)
#pragma unroll
    for (int j = 0; j < 4; ++j) acc[i][j] = f32x4{0.f, 0.f, 0.f, 0.f};

  u32x4 areg[4]; f32x4 breg[4];
#define GLOAD(kt_)                                                                                   \
  {                                                                                                  \
    _Pragma("unroll") for (int i = 0; i < 4; ++i) {                                                  \
      if (A_F32) {                                                                                   \
        const float4* q = (const float4*)(ap[i] + (size_t)(kt_) * GBK * 4);                          \
        float4 v0 = q[0], v1 = q[1];                                                                 \
        areg[i] = u32x4{pk2(v0.x, v0.y), pk2(v0.z, v0.w), pk2(v1.x, v1.y), pk2(v1.z, v1.w)};         \
      } else {                                                                                       \
        areg[i] = *(const u32x4*)(ap[i] + (size_t)(kt_) * GBK * 2);                                  \
      }                                                                                              \
    }                                                                                                \
    _Pragma("unroll") for (int i = 0; i < 4; ++i) {                                                  \
      if (bok[i]) breg[i] = *(const f32x4*)(bp[i] + (size_t)(kt_) * GBK * ldb);                      \
      else breg[i] = f32x4{0.f, 0.f, 0.f, 0.f};                                                      \
    }                                                                                                \
  }
  const int nk = K / GBK;
  GLOAD(0)
  for (int kt = 0; kt < nk; ++kt) {
    __syncthreads();
#pragma unroll
    for (int i = 0; i < 4; ++i) {
      int u = tid + i * NTH; int row = u >> 3, kc = u & 7;
      *(u32x4*)(As + row * AS_STRIDE + kc * 8) = areg[i];
    }
#pragma unroll
    for (int i = 0; i < 4; ++i) {
      int u = tid + i * NTH; int k = u >> 5, nq = u & 31;
      u32x2 v = u32x2{pk2(breg[i][0], breg[i][1]), pk2(breg[i][2], breg[i][3])};
      *(u32x2*)(Bs + k * BS_STRIDE + nq * 4) = v;
    }
    __syncthreads();
    if (kt + 1 < nk) GLOAD(kt + 1)
#pragma unroll
    for (int ks = 0; ks < 2; ++ks) {
      bf16x8 a[4], b[4];
#pragma unroll
      for (int mi = 0; mi < 4; ++mi)
        a[mi] = *(const bf16x8*)(As + (wm * 64 + mi * 16 + l15) * AS_STRIDE + ks * 32 + 8 * lq);
#pragma unroll
      for (int ni = 0; ni < 4; ++ni) {
        int col0 = (MODE == 0) ? (wn * 64 + ni * 16) : ((ni < 2) ? (wn * 32 + ni * 16) : (64 + wn * 32 + (ni - 2) * 16));
        int kb = ks * 32 + 8 * lq; int q = l15 >> 2, pp = l15 & 3;
        s16x4 lo = tr_read(Bs + (kb + q) * BS_STRIDE + col0 + 4 * pp);
        s16x4 hi = tr_read(Bs + (kb + 4 + q) * BS_STRIDE + col0 + 4 * pp);
        b[ni] = __builtin_shufflevector(lo, hi, 0, 1, 2, 3, 4, 5, 6, 7);
      }
#pragma unroll
      for (int mi = 0; mi < 4; ++mi)
#pragma unroll
        for (int ni = 0; ni < 4; ++ni)
          acc[mi][ni] = __builtin_amdgcn_mfma_f32_16x16x32_bf16(a[mi], b[ni], acc[mi][ni], 0, 0, 0);
    }
  }
#pragma unroll
  for (int mi = 0; mi < 4; ++mi)
#pragma unroll
    for (int r = 0; r < 4; ++r) {
      int row = wm * 64 + mi * 16 + lq * 4 + r;
      if (MODE == 0) {
#pragma unroll
        for (int ni = 0; ni < 4; ++ni) {
          int col = n0 + wn * 64 + ni * 16 + l15;
          if (col < Nvalid) epi(row, col, acc[mi][ni][r], 0.f);
        }
      } else {
#pragma unroll
        for (int ni = 0; ni < 2; ++ni) {
          int col = n0 + wn * 32 + ni * 16 + l15;
          epi(row, col, acc[mi][ni][r], acc[mi][ni + 2][r]);
        }
      }
    }
}

DI void ph_norm(const float* __restrict__ X, const float* __restrict__ g, u16* __restrict__ Hout) {
  const int tid_ = tidx(); const int lane = tid_ & 63, w = tid_ >> 6;
  for (int tok = blockIdx.x * 8 + w; tok < NTOK; tok += gridDim.x * 8) {
    const float4* xr = (const float4*)(X + (size_t)tok * DM);
    float4 v[4]; float ss = 0.f;
#pragma unroll
    for (int j = 0; j < 4; ++j) { v[j] = xr[lane + 64 * j]; ss += v[j].x * v[j].x + v[j].y * v[j].y + v[j].z * v[j].z + v[j].w * v[j].w; }
    ss = wave_sum(ss);
    float rstd = rsqrtf(ss * (1.f / DM) + NORM_EPS);
#pragma unroll
    for (int j = 0; j < 4; ++j) {
      float4 gg = ((const float4*)g)[lane + 64 * j];
      uint2 o = uint2{pk2(v[j].x * rstd * gg.x, v[j].y * rstd * gg.y), pk2(v[j].z * rstd * gg.z, v[j].w * rstd * gg.w)};
      *(uint2*)(Hout + (size_t)tok * DM + (lane + 64 * j) * 4) = o;
    }
  }
}

DI void ph_final_norm(float* __restrict__ X, const float* __restrict__ g) {
  const int tid_ = tidx(); const int lane = tid_ & 63, w = tid_ >> 6;
  for (int tok = blockIdx.x * 8 + w; tok < NTOK; tok += gridDim.x * 8) {
    float4* xr = (float4*)(X + (size_t)tok * DM);
    float4 v[4]; float ss = 0.f;
#pragma unroll
    for (int j = 0; j < 4; ++j) { v[j] = xr[lane + 64 * j]; ss += v[j].x * v[j].x + v[j].y * v[j].y + v[j].z * v[j].z + v[j].w * v[j].w; }
    ss = wave_sum(ss);
    float rstd = rsqrtf(ss * (1.f / DM) + NORM_EPS);
#pragma unroll
    for (int j = 0; j < 4; ++j) {
      float4 gg = ((const float4*)g)[lane + 64 * j];
      xr[lane + 64 * j] = float4{v[j].x * rstd * gg.x, v[j].y * rstd * gg.y, v[j].z * rstd * gg.z, v[j].w * rstd * gg.w};
    }
  }
}

template <bool A_F32, class Epi>
DI void ph_gemm(const void* A, int lda, const float* B, int ldb, int M, int N, int K, char* smem, Epi epi) {
  const int ntn = (N + GBN - 1) / GBN, ntm = M / GBM;
  for (int t = blockIdx.x; t < ntm * ntn; t += gridDim.x) {
    int tm = t / ntn, tn = t % ntn;
    int m0 = tm * GBM, n0 = tn * GBN;
    auto arow = [&](int r) -> const void* { return (const char*)A + (size_t)(m0 + r) * lda * (A_F32 ? 4 : 2); };
    gemm_tile<A_F32, 0>(arow, B, nullptr, ldb, K, n0, N, smem, [&](int row, int col, float v, float) { epi(m0 + row, col, v); });
    __syncthreads();
  }
}

DI void ph_rwshift(const P& p, int layer) {
  const float* mu = p.rw_mu + layer * RWC;
  const int total = NTOK * (RWC / 4);
  const int tid_ = tidx();
  for (int i = blockIdx.x * NTH + tid_; i < total; i += gridDim.x * NTH) {
    int tok = i / (RWC / 4), c = (i % (RWC / 4)) * 4;
    int t = tok % T;
    const float* zr = p.Z + (size_t)tok * INC + c;
    float4 z = *(const float4*)zr;
    float4 zm = (t > 0) ? *(const float4*)(zr - INC) : float4{0.f, 0.f, 0.f, 0.f};
    float4 zp = (t < T - 1) ? *(const float4*)(zr + INC) : float4{0.f, 0.f, 0.f, 0.f};
    float4 m = *(const float4*)(mu + c);
    float4 o;
    o.x = z.x + m.x * (0.5f * (zm.x + zp.x) - z.x);
    o.y = z.y + m.y * (0.5f * (zm.y + zp.y) - z.y);
    o.z = z.z + m.z * (0.5f * (zm.z + zp.z) - z.z);
    o.w = z.w + m.w * (0.5f * (zm.w + zp.w) - z.w);
    if (c < 512) *(float4*)(p.R + (size_t)tok * RWW + c) = o;
    else if (c < 1024) *(float4*)(p.K + (size_t)tok * RWW + (c - 512)) = o;
    else if (c < 1536) *(float4*)(p.V + (size_t)tok * RWW + (c - 1024)) = o;
    else if (c < 1664) {
      int d = (c - 1536) >> 6, l = (c - 1536) & 63;
      *(uint2*)(p.TWD + ((size_t)d * NTOK + tok) * 64 + l) = uint2{pk2(tanhf(o.x), tanhf(o.y)), pk2(tanhf(o.z), tanhf(o.w))};
    } else if (c < 1792) {
      int d = (c - 1664) >> 6, l = (c - 1664) & 63;
      *(uint2*)(p.AD + ((size_t)d * NTOK + tok) * 64 + l) = uint2{pk2(o.x, o.y), pk2(o.z, o.w)};
    } else {
      int l = c - 1792;
      *(uint2*)(p.SGD + (size_t)tok * 128 + l) = uint2{pk2(sigmoidf_(o.x), sigmoidf_(o.y)), pk2(sigmoidf_(o.z), sigmoidf_(o.w))};
    }
  }
}

DI void rope_cs(int pos, int i, float& cs, float& sn) {
  const int i3 = i & 3, i2 = i >> 2;
  const float c4 = (i3 == 0) ? 1.0f : (i3 == 1) ? 0.5623413251903491f : (i3 == 2) ? 0.31622776601683794f : 0.1778279410038923f;
  const float p10 = (i2 == 0) ? 1.0f : (i2 == 1) ? 0.1f : (i2 == 2) ? 0.01f : 0.001f;
  float inv = c4 * p10;
  float ang = (float)pos * inv;
  double rev = (double)ang * 0.15915494309189535;
  rev -= floor(rev);
  float rf = (float)rev;
  sn = __builtin_amdgcn_sinf(rf);
  cs = __builtin_amdgcn_cosf(rf);
}

DI void ph_mlaprep1(const P& p, int layer) {
  const int tid_ = tidx(); const int lane = tid_ & 63, w = tid_ >> 6;
  const float* qn = p.mla_q_norm + layer * 256;
  const float* kvn = p.mla_kv_norm + layer * 128;
  for (int tok = blockIdx.x * 8 + w; tok < NTOK; tok += gridDim.x * 8) {
    const float* zr = p.Z + (size_t)tok * INC + RWC;
    float4 q = *(const float4*)(zr + lane * 4);
    float ss = wave_sum(q.x * q.x + q.y * q.y + q.z * q.z + q.w * q.w);
    float rstd = rsqrtf(ss * (1.f / 256) + NORM_EPS);
    float4 g = *(const float4*)(qn + lane * 4);
    *(uint2*)(p.QDN + (size_t)tok * 256 + lane * 4) = uint2{pk2(q.x * rstd * g.x, q.y * rstd * g.y), pk2(q.z * rstd * g.z, q.w * rstd * g.w)};
    float2 kv = *(const float2*)(zr + 256 + lane * 2);
    float ss2 = wave_sum(kv.x * kv.x + kv.y * kv.y);
    float rstd2 = rsqrtf(ss2 * (1.f / 128) + NORM_EPS);
    float2 g2 = *(const float2*)(kvn + lane * 2);
    *(unsigned*)(p.KVDN + (size_t)tok * 128 + lane * 2) = pk2(kv.x * rstd2 * g2.x, kv.y * rstd2 * g2.y);
    if (lane < 16) {
      float u1 = zr[384 + lane], u2 = zr[384 + 16 + lane];
      float cs, sn; rope_cs(p.pos[tok], lane, cs, sn);
      p.KR[(size_t)tok * 32 + lane] = u1 * cs - u2 * sn;
      p.KR[(size_t)tok * 32 + 16 + lane] = u1 * sn + u2 * cs;
    }
  }
}

DI void ph_mlafinish(const P& p) {
  const int tid_ = tidx(); const int lane = tid_ & 63, w = tid_ >> 6;
  const float qs = 0.10206207261596577f * 1.4426950408889634f;
  for (int tok = blockIdx.x * 8 + w; tok < NTOK; tok += gridDim.x * 8) {
    int b = tok / T, t = tok % T;
    float cs = 0.f, sn = 0.f;
    if (lane < 16) rope_cs(p.pos[tok], lane, cs, sn);
    const float* qr = p.QRAW + (size_t)tok * 768;
    const float* kvr = p.KVRAW + (size_t)tok * 1024;
    const float* kr = p.KR + (size_t)tok * 32;
#pragma unroll
    for (int h = 0; h < NH; ++h) {
      size_t row = ((size_t)(b * NH + h) * T + t);
      u16* qo = p.Q + row * 96; u16* ko = p.Kc + row * 96; u16* vo = p.Vv + row * 64;
      qo[lane] = f2bf(qr[h * 96 + lane] * qs);
      ko[lane] = f2bf(kvr[h * 128 + lane]);
      vo[lane] = f2bf(kvr[h * 128 + 64 + lane]);
      if (lane < 16) {
        float u1 = qr[h * 96 + 64 + lane], u2 = qr[h * 96 + 80 + lane];
        qo[64 + lane] = f2bf((u1 * cs - u2 * sn) * qs);
        qo[80 + lane] = f2bf((u1 * sn + u2 * cs) * qs);
      }
      if (lane < 32) ko[64 + lane] = f2bf(kr[lane]);
    }
  }
}

using f32x16 = __attribute__((ext_vector_type(16))) float;
#define SBAR() __builtin_amdgcn_sched_barrier(0)
constexpr int AT_KSTR = 104;
constexpr int AT_KBYTES = 64 * AT_KSTR * 2;
constexpr int AT_VBYTES = 64 * 64 * 2;
constexpr float AT_THR = 8.f;
DI int crow(int r, int hi) { return (r & 3) + 8 * (r >> 2) + 4 * hi; }
DI int v_st(int k, int c) { const int kk = (k & ~0xC) | ((k & 4) << 1) | ((k & 8) >> 1); return ((kk >> 3) * 2 + (c >> 5)) * 512 + ((kk & 7) * 32 + (c & 31)) * 2; }
DI int v_rd_base(int lane) { return ((lane & 3) << 3) | (((lane >> 2) & 3) << 6) | (((lane >> 4) & 1) << 5) | (((lane >> 5) & 1) << 8); }
constexpr int v_rd_off(int d0, int ks, int half) { return d0 * 512 + ks * 2048 + half * 1024; }

DI void at_partialSM(f32x16& p0, f32x16& p1, float& m_reg, float& mn, float& alpha) {
  float pmax = p0[0];
#pragma unroll
  for (int r = 1; r < 16; ++r) pmax = fmaxf(pmax, p0[r]);
#pragma unroll
  for (int r = 0; r < 16; ++r) pmax = fmaxf(pmax, p1[r]);
  { auto rr = __builtin_amdgcn_permlane32_swap(__float_as_uint(pmax), __float_as_uint(pmax), false, false);
    pmax = fmaxf(__uint_as_float(rr[0]), __uint_as_float(rr[1])); }
  if (__builtin_expect(__all(pmax - m_reg <= AT_THR), 1)) { mn = m_reg; alpha = 1.f; }
  else { mn = fmaxf(m_reg, pmax); alpha = __builtin_amdgcn_exp2f(m_reg - mn); m_reg = mn; }
#pragma unroll
  for (int r = 0; r < 16; ++r) { p0[r] = p0[r] - mn; p1[r] = p1[r] - mn; }
#pragma unroll
  for (int r = 0; r < 16; ++r) p0[r] = __builtin_amdgcn_exp2f(p0[r]);
}
DI void at_finishSM(f32x16& p0, f32x16& p1, float alpha, float& l_reg, bf16x8& pa0, bf16x8& pa1, bf16x8& pa2, bf16x8& pa3) {
#pragma unroll
  for (int r = 0; r < 16; ++r) p1[r] = __builtin_amdgcn_exp2f(p1[r]);
  float ps = 0;
#pragma unroll
  for (int r = 0; r < 16; ++r) ps += p0[r];
#pragma unroll
  for (int r = 0; r < 16; ++r) ps += p1[r];
  { auto rr = __builtin_amdgcn_permlane32_swap(__float_as_uint(ps), __float_as_uint(ps), false, false);
    ps = __uint_as_float(rr[0]) + __uint_as_float(rr[1]); }
  l_reg = l_reg * alpha + ps;
#define PK4(PP, BASE, OUT) do { unsigned a0 = pk2(PP[BASE + 0], PP[BASE + 1]), a1 = pk2(PP[BASE + 2], PP[BASE + 3]);   \
    unsigned b0 = pk2(PP[BASE + 4], PP[BASE + 5]), b1 = pk2(PP[BASE + 6], PP[BASE + 7]);                              \
    auto r0 = __builtin_amdgcn_permlane32_swap(a0, b0, false, false); auto r1 = __builtin_amdgcn_permlane32_swap(a1, b1, false, false); \
    u32x4 wv = {r0[0], r1[0], r0[1], r1[1]}; OUT = __builtin_bit_cast(bf16x8, wv); } while (0)
  PK4(p0, 0, pa0); PK4(p0, 8, pa1); PK4(p1, 0, pa2); PK4(p1, 8, pa3);
#undef PK4
}
DI void at_qkt(f32x16& p0, f32x16& p1, const char* Kb, const bf16x8* qr, int r32, int hi) {
#pragma unroll
  for (int r = 0; r < 16; ++r) { p0[r] = 0.f; p1[r] = 0.f; }
#pragma unroll
  for (int d0 = 0; d0 < 6; ++d0) {
    bf16x8 b0 = *(const bf16x8*)(Kb + (r32 * AT_KSTR + d0 * 16 + hi * 8) * 2);
    bf16x8 b1 = *(const bf16x8*)(Kb + ((32 + r32) * AT_KSTR + d0 * 16 + hi * 8) * 2);
    p0 = __builtin_amdgcn_mfma_f32_32x32x16_bf16(b0, qr[d0], p0, 0, 0, 0);
    p1 = __builtin_amdgcn_mfma_f32_32x32x16_bf16(b1, qr[d0], p1, 0, 0, 0);
  }
}
template <int D0> DI void at_pv_one(f32x16& od, const char* vb, bf16x8 pa0, bf16x8 pa1, bf16x8 pa2, bf16x8 pa3) {
#define TRR(ks, half) tr_read((const short*)(vb + v_rd_off(D0, ks, half)))
  const s16x4 l0 = TRR(0, 0), h0 = TRR(0, 1), l1 = TRR(1, 0), h1 = TRR(1, 1), l2 = TRR(2, 0), h2 = TRR(2, 1), l3 = TRR(3, 0), h3 = TRR(3, 1);
#undef TRR
#define PKV(L, H) __builtin_shufflevector(L, H, 0, 1, 2, 3, 4, 5, 6, 7)
  od = __builtin_amdgcn_mfma_f32_32x32x16_bf16(pa0, PKV(l0, h0), od, 0, 0, 0);
  od = __builtin_amdgcn_mfma_f32_32x32x16_bf16(pa1, PKV(l1, h1), od, 0, 0, 0);
  od = __builtin_amdgcn_mfma_f32_32x32x16_bf16(pa2, PKV(l2, h2), od, 0, 0, 0);
  od = __builtin_amdgcn_mfma_f32_32x32x16_bf16(pa3, PKV(l3, h3), od, 0, 0, 0);
#undef PKV
}
DI void at_pv(f32x16* o, const char* vb, bf16x8 pa0, bf16x8 pa1, bf16x8 pa2, bf16x8 pa3) {
  at_pv_one<0>(o[0], vb, pa0, pa1, pa2, pa3); at_pv_one<1>(o[1], vb, pa0, pa1, pa2, pa3);
}

DI void attn_body(const u16* __restrict__ Qb, const u16* __restrict__ Kh, const u16* __restrict__ Vh, float* __restrict__ Ob, char* lds, int tid) {
  const int wid = tid >> 6, lane = tid & 63, r32 = lane & 31, hi = lane >> 5;
  char* V_lds = lds; char* K_lds = lds + 2 * AT_VBYTES;
  float* wsp = (float*)(lds + 2 * AT_VBYTES + 2 * AT_KBYTES) + wid * 64; float* li_l = wsp; float* al_l = wsp + 32;
  float m_reg = -1e30f, l_reg = 0.f; f32x16 o[2]; bf16x8 qr[6];
#pragma unroll
  for (int r = 0; r < 16; ++r) { o[0][r] = 0.f; o[1][r] = 0.f; }
  const u16* Qw = Qb + (size_t)(wid * 32 + r32) * 96 + hi * 8;
#pragma unroll
  for (int d0 = 0; d0 < 6; ++d0) qr[d0] = *(const bf16x8*)(Qw + d0 * 16);
  const int kid1 = (tid < 256) ? tid + 512 : tid;
  const int kst0 = ((tid / 12) * AT_KSTR + (tid % 12) * 8) * 2, kst1 = ((kid1 / 12) * AT_KSTR + (kid1 % 12) * 8) * 2;
  const int vst = v_st(tid >> 3, (tid & 7) * 8);
  const char* vb0 = V_lds + v_rd_base(lane);
  u32x4 sk0[2], sk1[2], sv0[2];
#define SLOAD(i, k0) do { sk0[i] = *(const u32x4*)(Kh + (size_t)(k0) * 96 + tid * 8); sk1[i] = *(const u32x4*)(Kh + (size_t)(k0) * 96 + kid1 * 8); \
    sv0[i] = *(const u32x4*)(Vh + (size_t)(k0) * 64 + tid * 8); } while (0)
#define SWRITE(b, i) do { *(u32x4*)(K_lds + (b) * AT_KBYTES + kst0) = sk0[i]; if (tid < 256) *(u32x4*)(K_lds + (b) * AT_KBYTES + kst1) = sk1[i]; \
    *(u32x4*)(V_lds + (b) * AT_VBYTES + vst) = sv0[i]; } while (0)
#define SWAIT() asm volatile("s_waitcnt vmcnt(3)" ::: "memory")
#define RESC(a) do { if (__any((a) < 1.f)) { if (hi == 0) al_l[r32] = (a); asm volatile("s_waitcnt lgkmcnt(0)" ::: "memory"); \
    _Pragma("unroll") for (int r = 0; r < 16; ++r) { float al = al_l[crow(r, hi)]; o[0][r] *= al; o[1][r] *= al; } } } while (0)
  f32x16 pA0, pA1, pB0, pB1; float mnA, mnB, alA, alB; bf16x8 pa0, pa1, pa2, pa3; constexpr int NT = T / 64;
  SLOAD(0, 0); SWRITE(0, 0); __syncthreads();
  at_qkt(pA0, pA1, K_lds, qr, r32, hi); at_partialSM(pA0, pA1, m_reg, mnA, alA);
  SLOAD(1, 64); SLOAD(0, 128);
  SWAIT(); SWRITE(1, 1); __syncthreads();
  for (int j = 1; j + 1 < NT; j += 2) {
    SBAR(); at_qkt(pB0, pB1, K_lds + AT_KBYTES, qr, r32, hi);
    at_finishSM(pA0, pA1, alA, l_reg, pa0, pa1, pa2, pa3); SBAR();
    SLOAD(1, (j + 2) * 64); SBAR();
    at_pv(o, vb0, pa0, pa1, pa2, pa3); at_partialSM(pB0, pB1, m_reg, mnB, alB);
    __syncthreads(); SWAIT(); SWRITE(0, 0);
    RESC(alB); __syncthreads();
    SBAR(); at_qkt(pA0, pA1, K_lds, qr, r32, hi);
    at_finishSM(pB0, pB1, alB, l_reg, pa0, pa1, pa2, pa3); SBAR();
    if (j + 3 < NT) SLOAD(0, (j + 3) * 64); SBAR();
    at_pv(o, vb0 + AT_VBYTES, pa0, pa1, pa2, pa3); at_partialSM(pA0, pA1, m_reg, mnA, alA);
    __syncthreads(); SWAIT(); SWRITE(1, 1);
    RESC(alA); __syncthreads();
  }
  SBAR(); at_qkt(pB0, pB1, K_lds + AT_KBYTES, qr, r32, hi);
  at_finishSM(pA0, pA1, alA, l_reg, pa0, pa1, pa2, pa3); SBAR();
  at_pv(o, vb0, pa0, pa1, pa2, pa3); at_partialSM(pB0, pB1, m_reg, mnB, alB);
  __syncthreads(); RESC(alB);
  at_finishSM(pB0, pB1, alB, l_reg, pa0, pa1, pa2, pa3); SBAR();
  at_pv(o, vb0 + AT_VBYTES, pa0, pa1, pa2, pa3);
  if (hi == 0) li_l[r32] = l_reg;
  asm volatile("s_waitcnt lgkmcnt(0)" ::: "memory");
  float* Ow = Ob + (size_t)(wid * 32) * 512;
#pragma unroll
  for (int r = 0; r < 16; ++r) {
    int orow = crow(r, hi); float rl = __builtin_amdgcn_rcpf(li_l[orow]);
    Ow[(size_t)orow * 512 + r32] = o[0][r] * rl; Ow[(size_t)orow * 512 + 32 + r32] = o[1][r] * rl;
  }
#undef SLOAD
#undef SWRITE
#undef SWAIT
#undef RESC
}

DI void ph_attn(const P& p, char* smem, unsigned* ctr) {
  const int tid = tidx();
  int* sitem = (int*)(smem + SMEM_BYTES - 16);
  for (;;) {
    __syncthreads();
    if (tid == 0) *sitem = (int)atomicAdd(ctr, 1u);
    __syncthreads();
    const int item = *sitem;
    if (item >= NB * NH * (T / 256)) break;
    const int bh = item / (T / 256), qb = item % (T / 256);
    const int b = bh / NH, h = bh % NH;
    attn_body(p.Q + ((size_t)bh * T + qb * 256) * 96, p.Kc + (size_t)bh * T * 96, p.Vv + (size_t)bh * T * 64,
              p.AO + ((size_t)(b * T + qb * 256)) * 512 + h * 64, smem, tid);
  }
}

constexpr int SC = 128, NCH = T / SC;
DI void scan_stage(const P& p, int b, int h, int d, int n0, float kkc, float kac, float* sm, int lane, int w) {
  float* sw = sm; float* skk = sw + 1024; float* sba = skk + 1024; float* skd = sba + 1024; float* sr = skd + 1024; float* sv = sr + 1024;
  const u16* LWd = p.LW + (size_t)d * NTOK * RWW;
  const u16* AAd = p.AA + (size_t)d * NTOK * RWW;
  const int ch = h * 64 + lane;
#pragma unroll
  for (int jj = 0; jj < 2; ++jj) {
    int j = w + 8 * jj; int n = n0 + j; int t = d ? (T - 1 - n) : n;
    size_t off = ((size_t)(b * T + t)) * RWW + ch;
    float kv = p.K[off];
    float kx = kv * kkc;
    float nrm = sqrtf(wave_sum(kx * kx));
    float kkv = kx / fmaxf(nrm, 1e-12f);
    float a = bf2f(AAd[off]);
    sw[j * 64 + lane] = __expf(bf2f(LWd[off]));
    skk[j * 64 + lane] = kkv;
    sba[j * 64 + lane] = a * kkv;
    skd[j * 64 + lane] = kv * (1.f + (a - 1.f) * kac);
    sr[j * 64 + lane] = p.R[off];
    sv[j * 64 + lane] = p.V[off];
  }
}

DI void ph_scan1(const P& p, int layer, char* smem) {
  float* sm = (float*)smem;
  const int tid = tidx(), lane = tid & 63, w = tid >> 6;
  const int row = tid >> 2, kq = tid & 3;
  for (int item = blockIdx.x; item < 32 * NCH; item += gridDim.x) {
    int scan = item / NCH, c = item % NCH;
    int d = scan & 1, h = (scan >> 1) % NH, b = scan / (2 * NH);
    const float kkc = p.rw_k_k[layer * RWW + h * 64 + lane], kac = p.rw_k_a[layer * RWW + h * 64 + lane];
    float S[16];
#pragma unroll
    for (int i = 0; i < 16; ++i) S[i] = (row == kq * 16 + i) ? 1.f : 0.f;
    for (int sub = 0; sub < SC / 16; ++sub) {
      __syncthreads();
      scan_stage(p, b, h, d, c * SC + sub * 16, kkc, kac, sm, lane, w);
      __syncthreads();
      for (int j = 0; j < 16; ++j) {
        const f32x4* w4 = (const f32x4*)(sm + j * 64 + kq * 16);
        const f32x4* k4 = (const f32x4*)(sm + 1024 + j * 64 + kq * 16);
        const f32x4* b4 = (const f32x4*)(sm + 2048 + j * 64 + kq * 16);
        const f32x4* d4 = (const f32x4*)(sm + 3072 + j * 64 + kq * 16);
        float vv = (row >= 64) ? sm[5120 + j * 64 + (row - 64)] : 0.f;
        f32x4 kk[4];
        float sa = 0.f;
#pragma unroll
        for (int q = 0; q < 4; ++q) { kk[q] = k4[q];
#pragma unroll
          for (int e = 0; e < 4; ++e) sa -= S[q * 4 + e] * kk[q][e]; }
        sa += __shfl_xor(sa, 1); sa += __shfl_xor(sa, 2);
#pragma unroll
        for (int q = 0; q < 4; ++q) { f32x4 ww = w4[q], bb = b4[q], dd = d4[q];
#pragma unroll
          for (int e = 0; e < 4; ++e) S[q * 4 + e] = S[q * 4 + e] * ww[e] + sa * bb[e] + vv * dd[e]; }
      }
    }
    float* dst = ((row < 64) ? p.MC : p.NC) + (((size_t)scan * NCH + c) * 64 + (row & 63)) * 64 + kq * 16;
#pragma unroll
    for (int q = 0; q < 4; ++q) *(f32x4*)(dst + q * 4) = f32x4{S[q * 4], S[q * 4 + 1], S[q * 4 + 2], S[q * 4 + 3]};
  }
}

DI void ph_scan2(const P& p, char* smem) {
  float* Ssm = (float*)smem;
  float* Msm = Ssm + 64 * 68;
  const int tid = tidx();
  const int v = tid >> 3, kq = tid & 7;
  for (int scan = blockIdx.x; scan < 32; scan += gridDim.x) {
    float S[8];
#pragma unroll
    for (int i = 0; i < 8; ++i) S[i] = 0.f;
    const float* Mg = p.MC + (size_t)scan * NCH * 4096;
    const float* Ng = p.NC + (size_t)scan * NCH * 4096;
    float* Sg = p.SS + (size_t)scan * NCH * 4096;
    f32x4 m0 = *(const f32x4*)(Mg + tid * 8), m1 = *(const f32x4*)(Mg + tid * 8 + 4);
    f32x4 n0 = *(const f32x4*)(Ng + tid * 8), n1 = *(const f32x4*)(Ng + tid * 8 + 4);
    for (int c = 0; c < NCH; ++c) {
      __syncthreads();
      *(f32x4*)(Sg + (size_t)c * 4096 + tid * 8) = f32x4{S[0], S[1], S[2], S[3]};
      *(f32x4*)(Sg + (size_t)c * 4096 + tid * 8 + 4) = f32x4{S[4], S[5], S[6], S[7]};
      *(f32x4*)(Ssm + v * 68 + kq * 8) = f32x4{S[0], S[1], S[2], S[3]};
      *(f32x4*)(Ssm + v * 68 + kq * 8 + 4) = f32x4{S[4], S[5], S[6], S[7]};
      *(f32x4*)(Msm + tid * 8) = m0; *(f32x4*)(Msm + tid * 8 + 4) = m1;
      float acc[8] = {n0[0], n0[1], n0[2], n0[3], n1[0], n1[1], n1[2], n1[3]};
      __syncthreads();
      if (c + 1 < NCH) {
        m0 = *(const f32x4*)(Mg + (size_t)(c + 1) * 4096 + tid * 8); m1 = *(const f32x4*)(Mg + (size_t)(c + 1) * 4096 + tid * 8 + 4);
        n0 = *(const f32x4*)(Ng + (size_t)(c + 1) * 4096 + tid * 8); n1 = *(const f32x4*)(Ng + (size_t)(c + 1) * 4096 + tid * 8 + 4);
      }
#pragma unroll 4
      for (int jq = 0; jq < 16; ++jq) {
        f32x4 sv = *(const f32x4*)(Ssm + v * 68 + jq * 4);
#pragma unroll
        for (int e = 0; e < 4; ++e) {
          f32x4 ma = *(const f32x4*)(Msm + (jq * 4 + e) * 64 + kq * 8), mb = *(const f32x4*)(Msm + (jq * 4 + e) * 64 + kq * 8 + 4);
          acc[0] += sv[e] * ma[0]; acc[1] += sv[e] * ma[1]; acc[2] += sv[e] * ma[2]; acc[3] += sv[e] * ma[3];
          acc[4] += sv[e] * mb[0]; acc[5] += sv[e] * mb[1]; acc[6] += sv[e] * mb[2]; acc[7] += sv[e] * mb[3];
        }
      }
#pragma unroll
      for (int i = 0; i < 8; ++i) S[i] = acc[i];
    }
    __syncthreads();
  }
}

DI void ph_scan3(const P& p, int layer, char* smem) {
  float* sm = (float*)smem; float* so = sm + 6144;
  const int tid = tidx(), lane = tid & 63, w = tid >> 6;
  const int v = tid >> 3, kq = tid & 7;
  for (int item = blockIdx.x; item < 32 * NCH; item += gridDim.x) {
    int scan = item / NCH, c = item % NCH;
    int d = scan & 1, h = (scan >> 1) % NH, b = scan / (2 * NH);
    const float kkc = p.rw_k_k[layer * RWW + h * 64 + lane], kac = p.rw_k_a[layer * RWW + h * 64 + lane];
    u16* Od = p.O2 + (size_t)d * NTOK * RWW;
    float S[8];
    {
      const float* Sg = p.SS + ((size_t)scan * NCH + c) * 4096 + tid * 8;
      f32x4 s0 = *(const f32x4*)Sg, s1 = *(const f32x4*)(Sg + 4);
      S[0] = s0[0]; S[1] = s0[1]; S[2] = s0[2]; S[3] = s0[3]; S[4] = s1[0]; S[5] = s1[1]; S[6] = s1[2]; S[7] = s1[3];
    }
    for (int sub = 0; sub < SC / 16; ++sub) {
      const int n0 = c * SC + sub * 16;
      __syncthreads();
      scan_stage(p, b, h, d, n0, kkc, kac, sm, lane, w);
      __syncthreads();
      for (int j = 0; j < 16; ++j) {
        const f32x4* w4 = (const f32x4*)(sm + j * 64 + kq * 8);
        const f32x4* k4 = (const f32x4*)(sm + 1024 + j * 64 + kq * 8);
        const f32x4* b4 = (const f32x4*)(sm + 2048 + j * 64 + kq * 8);
        const f32x4* d4 = (const f32x4*)(sm + 3072 + j * 64 + kq * 8);
        const f32x4* r4 = (const f32x4*)(sm + 4096 + j * 64 + kq * 8);
        float vv = sm[5120 + j * 64 + v];
        float sa = 0.f;
#pragma unroll
        for (int q = 0; q < 2; ++q) { f32x4 kk = k4[q];
#pragma unroll
          for (int e = 0; e < 4; ++e) sa -= S[q * 4 + e] * kk[e]; }
        sa += __shfl_xor(sa, 1); sa += __shfl_xor(sa, 2); sa += __shfl_xor(sa, 4);
        float oo = 0.f;
#pragma unroll
        for (int q = 0; q < 2; ++q) { f32x4 ww = w4[q], bb = b4[q], dd = d4[q], rr = r4[q];
#pragma unroll
          for (int e = 0; e < 4; ++e) { S[q * 4 + e] = S[q * 4 + e] * ww[e] + sa * bb[e] + vv * dd[e]; oo += S[q * 4 + e] * rr[e]; } }
        oo += __shfl_xor(oo, 1); oo += __shfl_xor(oo, 2); oo += __shfl_xor(oo, 4);
        if (kq == 0) so[j * 64 + v] = oo;
      }
      __syncthreads();
#pragma unroll
      for (int jj = 0; jj < 2; ++jj) {
        int j = w + 8 * jj; int n = n0 + j; int t = d ? (T - 1 - n) : n;
        Od[((size_t)(b * T + t)) * RWW + h * 64 + lane] = f2bf(so[j * 64 + lane]);
      }
    }
  }
}

DI void ph_mixfinish(const P& p, int layer) {
  const int tid_ = tidx(); const int lane = tid_ & 63, w = tid_ >> 6;
  const float* lw = p.rw_lnx_w + layer * RWW; const float* lb = p.rw_lnx_b + layer * RWW;
  const float* kac = p.rw_k_a + layer * RWW; const float* rk = p.rw_r_k + layer * RWW;
  const float* on = p.mla_o_norm + layer * 512;
  for (int tok = blockIdx.x * 8 + w; tok < NTOK; tok += gridDim.x * 8) {
#pragma unroll
    for (int h = 0; h < NH; ++h) {
      int c = h * 64 + lane; size_t off = (size_t)tok * RWW + c;
      float o = bf2f(p.O2[off]) + bf2f(p.O2[(size_t)NTOK * RWW + off]);
      float mean = wave_sum(o) * (1.f / 64);
      float dv = o - mean;
      float var = wave_sum(dv * dv) * (1.f / 64);
      float on_ = dv * rsqrtf(var + GN_EPS) * lw[c] + lb[c];
      float k = p.K[off], r = p.R[off], vv = p.V[off];
      float a0 = bf2f(p.AA[off]), a1 = bf2f(p.AA[(size_t)NTOK * RWW + off]);
      float kb = 0.5f * (k * (1.f + (a0 - 1.f) * kac[c]) + k * (1.f + (a1 - 1.f) * kac[c]));
      float s = wave_sum(r * kb * rk[c]);
      float y = (on_ + s * vv) * bf2f(p.G[off]);
      p.H[(size_t)tok * DM + c] = f2bf(y);
    }
    const float* ao = p.AO + (size_t)tok * 512;
    float4 v0 = *(const float4*)(ao + lane * 4), v1 = *(const float4*)(ao + 256 + lane * 4);
    float ss = wave_sum(v0.x * v0.x + v0.y * v0.y + v0.z * v0.z + v0.w * v0.w + v1.x * v1.x + v1.y * v1.y + v1.z * v1.z + v1.w * v1.w);
    float rstd = rsqrtf(ss * (1.f / 512) + NORM_EPS);
    float4 g0 = *(const float4*)(on + lane * 4), g1 = *(const float4*)(on + 256 + lane * 4);
    *(uint2*)(p.H + (size_t)tok * DM + 512 + lane * 4) = uint2{pk2(v0.x * rstd * g0.x, v0.y * rstd * g0.y), pk2(v0.z * rstd * g0.z, v0.w * rstd * g0.w)};
    *(uint2*)(p.H + (size_t)tok * DM + 768 + lane * 4) = uint2{pk2(v1.x * rstd * g1.x, v1.y * rstd * g1.y), pk2(v1.z * rstd * g1.z, v1.w * rstd * g1.w)};
  }
}

DI void ph_norm_router(const P& p, int layer) {
  const int tid_ = tidx(); const int lane = tid_ & 63, w = tid_ >> 6;
  const float* g = p.ffn_norm + layer * DM;
  const float* rt = p.router + (size_t)layer * DM * NE;
  for (int tok = blockIdx.x * 8 + w; tok < NTOK; tok += gridDim.x * 8) {
    const float4* xr = (const float4*)(p.out + (size_t)tok * DM);
    float4 v[4]; float ss = 0.f;
#pragma unroll
    for (int j = 0; j < 4; ++j) { v[j] = xr[lane + 64 * j]; ss += v[j].x * v[j].x + v[j].y * v[j].y + v[j].z * v[j].z + v[j].w * v[j].w; }
    ss = wave_sum(ss);
    float rstd = rsqrtf(ss * (1.f / DM) + NORM_EPS);
    float lg[NE];
#pragma unroll
    for (int e = 0; e < NE; ++e) lg[e] = 0.f;
#pragma unroll
    for (int j = 0; j < 4; ++j) {
      int c0 = (lane + 64 * j) * 4;
      float4 gg = *(const float4*)(g + c0);
      float hv[4] = {v[j].x * rstd * gg.x, v[j].y * rstd * gg.y, v[j].z * rstd * gg.z, v[j].w * rstd * gg.w};
      *(uint2*)(p.H + (size_t)tok * DM + c0) = uint2{pk2(hv[0], hv[1]), pk2(hv[2], hv[3])};
#pragma unroll
      for (int q = 0; q < 4; ++q) {
        const float4* rr = (const float4*)(rt + (size_t)(c0 + q) * NE);
        float4 r0 = rr[0], r1 = rr[1], r2 = rr[2], r3 = rr[3];
        lg[0] += hv[q] * r0.x; lg[1] += hv[q] * r0.y; lg[2] += hv[q] * r0.z; lg[3] += hv[q] * r0.w;
        lg[4] += hv[q] * r1.x; lg[5] += hv[q] * r1.y; lg[6] += hv[q] * r1.z; lg[7] += hv[q] * r1.w;
        lg[8] += hv[q] * r2.x; lg[9] += hv[q] * r2.y; lg[10] += hv[q] * r2.z; lg[11] += hv[q] * r2.w;
        lg[12] += hv[q] * r3.x; lg[13] += hv[q] * r3.y; lg[14] += hv[q] * r3.z; lg[15] += hv[q] * r3.w;
      }
    }
    float mx = -INFINITY;
#pragma unroll
    for (int e = 0; e < NE; ++e) { lg[e] = wave_sum(lg[e]); mx = fmaxf(mx, lg[e]); }
    float se = 0.f;
#pragma unroll
    for (int e = 0; e < NE; ++e) { lg[e] = expf(lg[e] - mx); se += lg[e]; }
    float inv = 1.f / se;
    int b = tok / T, t = tok % T;
    float mine = 0.f;
#pragma unroll
    for (int e = 0; e < NE; ++e) mine = (lane == e) ? lg[e] * inv : mine;
    if (lane < NE) p.AFF[((size_t)(b * NE + lane)) * T + t] = mine;
  }
}

DI void ph_topk(const P& p, char* smem) {
  unsigned* hist = (unsigned*)smem;
  unsigned* sc = hist + 256;
  unsigned* bc = sc + 2048;
  const int tid = tidx();
  for (int item = blockIdx.x; item < NB * NE; item += gridDim.x) {
    const float* a = p.AFF + (size_t)item * T;
    unsigned key[16];
#pragma unroll
    for (int i = 0; i < 4; ++i) {
      uint4 v = *(const uint4*)(a + tid * 16 + i * 4);
      key[i * 4 + 0] = v.x; key[i * 4 + 1] = v.y; key[i * 4 + 2] = v.z; key[i * 4 + 3] = v.w;
    }
    unsigned prefix = 0, mask = 0, need = CAP;
    for (int pass = 0; pass < 4; ++pass) {
      int shift = 24 - 8 * pass;
      __syncthreads();
      if (tid < 256) hist[tid] = 0;
      __syncthreads();
#pragma unroll
      for (int i = 0; i < 16; ++i)
        if ((key[i] & mask) == prefix) atomicAdd(&hist[(key[i] >> shift) & 255u], 1u);
      __syncthreads();
      if (tid == 0) {
        unsigned cum = 0; int bsel = 0; unsigned nd = need;
        for (int bb = 255; bb >= 0; --bb) {
          unsigned hc = hist[bb];
          if (cum + hc >= need) { bsel = bb; nd = need - cum; break; }
          cum += hc;
        }
        bc[0] = prefix | ((unsigned)bsel << shift); bc[1] = nd;
      }
      __syncthreads();
      prefix = bc[0]; need = bc[1]; mask |= (255u << shift);
    }
    unsigned ngt = 0, neq = 0;
#pragma unroll
    for (int i = 0; i < 16; ++i) { ngt += key[i] > prefix; neq += key[i] == prefix; }
    __syncthreads();
    unsigned* sA = sc; unsigned* sB = sc + 512; unsigned* eA = sc + 1024; unsigned* eB = sc + 1536;
    sA[tid] = ngt; eA[tid] = neq;
    __syncthreads();
    for (int off = 1; off < NTH; off <<= 1) {
      unsigned x = sA[tid] + ((tid >= off) ? sA[tid - off] : 0u);
      unsigned y = eA[tid] + ((tid >= off) ? eA[tid - off] : 0u);
      sB[tid] = x; eB[tid] = y;
      __syncthreads();
      unsigned* tmp = sA; sA = sB; sB = tmp; tmp = eA; eA = eB; eB = tmp;
    }
    unsigned gt_excl = sA[tid] - ngt, eq_excl = eA[tid] - neq;
    unsigned gt_total = sA[NTH - 1];
    int* idx = p.IDX + (size_t)item * CAP; float* gate = p.GATE + (size_t)item * CAP;
#pragma unroll
    for (int i = 0; i < 16; ++i) {
      if (key[i] > prefix) { idx[gt_excl] = tid * 16 + i; gate[gt_excl] = __uint_as_float(key[i]); ++gt_excl; }
      else if (key[i] == prefix) {
        if (eq_excl < need) { idx[gt_total + eq_excl] = tid * 16 + i; gate[gt_total + eq_excl] = __uint_as_float(key[i]); }
        ++eq_excl;
      }
    }
    __syncthreads();
  }
}

DI void ph_exp1(const P& p, int layer, char* smem) {
  for (int t = blockIdx.x; t < 32 * 4 * 16; t += gridDim.x) {
    int grp = t / 64, r = t % 64, tm = r / 16, tn = r % 16;
    int b = grp / NE, e = grp % NE;
    const int* gi = p.IDX + (size_t)grp * CAP + tm * GBM;
    const u16* Hb = p.H + (size_t)b * T * DM;
    const float* Wg = p.exp_w_gate + ((size_t)layer * NE + e) * DM * 1024;
    const float* Wu = p.exp_w_up + ((size_t)layer * NE + e) * DM * 1024;
    u16* hid = p.HID + ((size_t)grp * CAP + tm * GBM) * 1024;
    auto arow = [&](int row) -> const void* { return Hb + (size_t)gi[row] * DM; };
    gemm_tile<false, 1>(arow, Wg, Wu, 1024, DM, tn * 64, 1024, smem, [&](int row, int col, float g, float u) {
      float sv = g / (1.f + __expf(-g));
      hid[(size_t)row * 1024 + col] = f2bf(sv * u);
    });
    __syncthreads();
  }
}
DI void ph_exp2(const P& p, int layer, char* smem) {
  for (int t = blockIdx.x; t < 32 * 4 * 8; t += gridDim.x) {
    int grp = t / 32, r = t % 32, tm = r / 8, tn = r % 8;
    int b = grp / NE, e = grp % NE;
    const int* gi = p.IDX + (size_t)grp * CAP + tm * GBM;
    const float* gt = p.GATE + (size_t)grp * CAP + tm * GBM;
    const u16* hid = p.HID + ((size_t)grp * CAP + tm * GBM) * 1024;
    const float* Wd = p.exp_w_down + ((size_t)layer * NE + e) * 1024 * DM;
    float* xb = p.out + (size_t)b * T * DM;
    auto arow = [&](int row) -> const void* { return hid + (size_t)row * 1024; };
    gemm_tile<false, 0>(arow, Wd, nullptr, DM, 1024, tn * GBN, DM, smem, [&](int row, int col, float v, float) {
      unsafeAtomicAdd(xb + (size_t)gi[row] * DM + col, v * gt[row]);
    });
    __syncthreads();
  }
}

#define XB_TMO      128
#define XB_XCNT(j)  (256  + 64 * (j))
#define XB_XSUB(j)  (1280 + 64 * (j))
#define XB_XGEN(j)  (2304 + 64 * (j))
#define XB_TOP      3328
#define XB_TOPGEN   3392
#define XCD_BAR_WORDS 3456
#define XB_SPIN_CAP (1u << 20)
DI unsigned xb_ld(unsigned* p) { return __hip_atomic_load(p, __ATOMIC_RELAXED, __HIP_MEMORY_SCOPE_AGENT); }
DI unsigned xb_add(unsigned* p, unsigned v) { return __hip_atomic_fetch_add(p, v, __ATOMIC_RELAXED, __HIP_MEMORY_SCOPE_AGENT); }
DI unsigned xb_xcc_id() { return (unsigned)__builtin_amdgcn_s_getreg((3 << 11) | 20) & 0xFu; }
#define XB_SPIN(cond, bar) do { unsigned _sp = 0; while (cond) { __builtin_amdgcn_s_sleep(1); \
    if ((++_sp & 255u) == 0u) { if (xb_ld(&(bar)[XB_TMO])) break; if (_sp > XB_SPIN_CAP) { atomicAdd(&(bar)[XB_TMO], 1u); break; } } } } while (0)
struct XcdBarrier { unsigned* bar; unsigned x; volatile LAS unsigned* st; };
DI XcdBarrier xcd_barrier_post(unsigned* bar, volatile LAS unsigned* st) {
  XcdBarrier b; b.bar = bar; b.x = xb_xcc_id(); b.st = st;
  if (threadIdx.x == 0) (void)xb_add(&bar[XB_XCNT(b.x)], 1u);
  return b;
}
DI void xcd_barrier_complete(unsigned* bar, unsigned x, unsigned& nloc, unsigned& nx) {
  const unsigned G = gridDim.x * gridDim.y * gridDim.z;
  unsigned sum, cnt, mine, sp = 0u;
  for (;;) {
    sum = 0u; cnt = 0u; mine = 0u;
#pragma unroll
    for (unsigned j = 0; j < 16; ++j) { const unsigned c = xb_ld(&bar[XB_XCNT(j)]); sum += c; cnt += (c > 0u) ? 1u : 0u; mine = (j == x) ? c : mine; }
    if (sum == G) break;
    __builtin_amdgcn_s_sleep(1);
    if ((++sp & 255u) == 0u) { if (xb_ld(&bar[XB_TMO])) break; if (sp > XB_SPIN_CAP) { atomicAdd(&bar[XB_TMO], 1u); break; } }
  }
  nloc = mine > 0u ? mine : 1u; nx = cnt > 0u ? cnt : 1u;
}
DI void xcd_barrier(const XcdBarrier& b) {
  asm volatile("s_waitcnt vmcnt(0)" ::: "memory");
  __syncthreads();
  if (threadIdx.x == 0) {
    unsigned* bar = b.bar;
    __builtin_amdgcn_s_waitcnt(0);
    unsigned nloc = b.st[0], nx = b.st[1];
    if (nloc == 0u) { xcd_barrier_complete(bar, b.x, nloc, nx); b.st[0] = nloc; b.st[1] = nx; }
    const unsigned old = xb_add(&bar[XB_XSUB(b.x)], 1u);
    const unsigned gen = old / nloc;
    if (old + 1u == (gen + 1u) * nloc) {
      __builtin_amdgcn_fence(__ATOMIC_RELEASE, "agent");
      asm volatile("s_waitcnt vmcnt(0)" ::: "memory");
      const unsigned og = xb_add(&bar[XB_TOP], 1u);
      const unsigned tg = og / nx;
      if (og + 1u == (tg + 1u) * nx) xb_add(&bar[XB_TOPGEN], 1u);
      else XB_SPIN(xb_ld(&bar[XB_TOPGEN]) == tg, bar);
      __builtin_amdgcn_fence(__ATOMIC_ACQUIRE, "agent");
      xb_add(&bar[XB_XGEN(b.x)], 1u);
      asm volatile("s_waitcnt vmcnt(0)" ::: "memory");
    } else {
      XB_SPIN(xb_ld(&bar[XB_XGEN(b.x)]) == gen, bar);
      __builtin_amdgcn_fence(__ATOMIC_ACQUIRE, "agent");
      asm volatile("s_waitcnt vmcnt(0)" ::: "memory");
    }
  }
  __syncthreads();
}

__global__ void __launch_bounds__(NTH) mega(P p) {
  __shared__ __attribute__((aligned(16))) char smem[SMEM_BYTES];
  __shared__ uint4 xb_words;
  cg::grid_group grid = cg::this_grid();
  if (threadIdx.x == 0) xb_words = make_uint4(0u, 0u, 0u, 0u);
  if (blockIdx.x == 0) {
    if (threadIdx.x < 16) p.CTR[threadIdx.x] = 0u;
    for (int i = threadIdx.x; i < XCD_BAR_WORDS; i += NTH) p.BAR[i] = 0u;
  }
  grid.sync();
  const XcdBarrier xb = xcd_barrier_post(p.BAR, (volatile LAS unsigned*)&xb_words);
#define GSYNC() xcd_barrier(xb)
  for (int layer = 0; layer < NL; ++layer) {
    ph_norm(layer == 0 ? p.x : p.out, p.attn_norm + layer * DM, p.H);
    GSYNC();
    {
      float* Z = p.Z;
      ph_gemm<false>(p.H, DM, p.w_in + (size_t)layer * DM * INC, INC, NTOK, INC, DM, smem,
                     [&](int row, int col, float v) { Z[(size_t)row * INC + col] = v; });
    }
    GSYNC();
    ph_rwshift(p, layer);
    ph_mlaprep1(p, layer);
    GSYNC();
    for (int d = 0; d < 2; ++d) {
      u16* LW = p.LW + (size_t)d * NTOK * RWW; const float* w0 = p.rw_w0 + (layer * 2 + d) * RWW;
      ph_gemm<false>(p.TWD + (size_t)d * NTOK * 64, 64, p.rw_w_up + ((size_t)(layer * 2 + d)) * 64 * RWW, RWW, NTOK, RWW, 64, smem,
                     [&](int row, int col, float v) { LW[(size_t)row * RWW + col] = f2bf(-0.6065306597126334f * sigmoidf_(v + w0[col])); });
      u16* AA = p.AA + (size_t)d * NTOK * RWW; const float* a0 = p.rw_a0 + (layer * 2 + d) * RWW;
      ph_gemm<false>(p.AD + (size_t)d * NTOK * 64, 64, p.rw_a_up + ((size_t)(layer * 2 + d)) * 64 * RWW, RWW, NTOK, RWW, 64, smem,
                     [&](int row, int col, float v) { AA[(size_t)row * RWW + col] = f2bf(sigmoidf_(v + a0[col])); });
    }
    {
      u16* G = p.G;
      ph_gemm<false>(p.SGD, 128, p.rw_g_up + (size_t)layer * 128 * RWW, RWW, NTOK, RWW, 128, smem,
                     [&](int row, int col, float v) { G[(size_t)row * RWW + col] = f2bf(v); });
      float* Q = p.QRAW;
      ph_gemm<false>(p.QDN, 256, p.mla_q_up + (size_t)layer * 256 * 768, 768, NTOK, 768, 256, smem,
                     [&](int row, int col, float v) { Q[(size_t)row * 768 + col] = v; });
      float* KV = p.KVRAW;
      ph_gemm<false>(p.KVDN, 128, p.mla_kv_up + (size_t)layer * 128 * 1024, 1024, NTOK, 1024, 128, smem,
                     [&](int row, int col, float v) { KV[(size_t)row * 1024 + col] = v; });
    }
    GSYNC();
    ph_mlafinish(p);
    ph_scan1(p, layer, smem);
    GSYNC();
    ph_scan2(p, smem);
    ph_attn(p, smem, p.CTR + layer);
    GSYNC();
    ph_scan3(p, layer, smem);
    GSYNC();
    ph_mixfinish(p, layer);
    GSYNC();
    {
      const float* xs = (layer == 0) ? p.x : p.out; float* xo = p.out;
      ph_gemm<false>(p.H, DM, p.w_out + (size_t)layer * DM * DM, DM, NTOK, DM, DM, smem,
                     [&](int row, int col, float v) { xo[(size_t)row * DM + col] = xs[(size_t)row * DM + col] + v; });
    }
    GSYNC();
    ph_norm_router(p, layer);
    GSYNC();
    ph_topk(p, smem);
    GSYNC();
    ph_exp1(p, layer, smem);
    GSYNC();
    ph_exp2(p, layer, smem);
    GSYNC();
    ph_norm(p.out, p.ple_norm + layer * DM, p.H);
    GSYNC();
    {
      float* PG = p.PG;
      ph_gemm<false>(p.H, DM, p.ple_gate + (size_t)layer * DM * DM, DM, NTOK, DM, DM, smem,
                     [&](int row, int col, float v) { PG[(size_t)row * DM + col] = sigmoidf_(v); });
    }
    GSYNC();
    {
      float* xo = p.out; const float* PG = p.PG;
      ph_gemm<true>(p.p + (size_t)layer * NTOK * DPLE, DPLE, p.ple_proj + (size_t)layer * DPLE * DM, DM, NTOK, DM, DPLE, smem,
                    [&](int row, int col, float v) { xo[(size_t)row * DM + col] += v * PG[(size_t)row * DM + col]; });
    }
    GSYNC();
  }
  ph_final_norm(p.out, p.final_norm);
}

extern "C" void kernel_launch(void* const* d_in, const int* in_sizes, int n_in, void* d_out, int out_size, void* d_ws,
                              size_t ws_size, hipStream_t stream) {
  (void)in_sizes; (void)n_in; (void)out_size;
  P p{};
  p.x = (const float*)d_in[0]; p.p = (const float*)d_in[1]; p.pos = (const int*)d_in[2];
  p.attn_norm = (const float*)d_in[3]; p.w_in = (const float*)d_in[4]; p.rw_mu = (const float*)d_in[5];
  p.rw_w0 = (const float*)d_in[6]; p.rw_w_up = (const float*)d_in[7]; p.rw_a0 = (const float*)d_in[8];
  p.rw_a_up = (const float*)d_in[9]; p.rw_g_up = (const float*)d_in[10]; p.rw_k_k = (const float*)d_in[11];
  p.rw_k_a = (const float*)d_in[12]; p.rw_r_k = (const float*)d_in[13]; p.rw_lnx_w = (const float*)d_in[14];
  p.rw_lnx_b = (const float*)d_in[15]; p.mla_q_norm = (const float*)d_in[16]; p.mla_q_up = (const float*)d_in[17];
  p.mla_kv_norm = (const float*)d_in[18]; p.mla_kv_up = (const float*)d_in[19]; p.mla_o_norm = (const float*)d_in[20];
  p.w_out = (const float*)d_in[21]; p.ffn_norm = (const float*)d_in[22]; p.router = (const float*)d_in[23];
  p.exp_w_gate = (const float*)d_in[24]; p.exp_w_up = (const float*)d_in[25]; p.exp_w_down = (const float*)d_in[26];
  p.ple_norm = (const float*)d_in[27]; p.ple_proj = (const float*)d_in[28]; p.ple_gate = (const float*)d_in[29];
  p.final_norm = (const float*)d_in[30];
  p.out = (float*)d_out;

  char* ws = (char*)d_ws; size_t off = 0;
  auto take = [&](size_t bytes) { char* r = ws + off; off += (bytes + 255) & ~(size_t)255; return r; };
  char* regA = take((size_t)NTOK * INC * 4);
  p.Z = (float*)regA;
  p.LW = (u16*)regA; p.AA = (u16*)(regA + (size_t)2 * NTOK * RWW * 2); p.G = (u16*)(regA + (size_t)4 * NTOK * RWW * 2);
  p.MC = (float*)(regA + (size_t)5 * NTOK * RWW * 2); p.NC = p.MC + (size_t)32 * NCH * 4096;
  p.HID = (u16*)regA;
  char* regB = take((size_t)3 * NTOK * RWW * 4);
  p.R = (float*)regB; p.K = p.R + (size_t)NTOK * RWW; p.V = p.K + (size_t)NTOK * RWW;
  p.PG = (float*)regB;
  char* regC = take((size_t)NTOK * (768 + 1024) * 4);
  p.QRAW = (float*)regC; p.KVRAW = p.QRAW + (size_t)NTOK * 768;
  p.AO = (float*)regC; p.O2 = (u16*)(p.AO + (size_t)NTOK * 512); p.SS = (float*)(p.O2 + (size_t)2 * NTOK * 512);
  p.TWD = (u16*)take((size_t)2 * NTOK * 64 * 2); p.AD = (u16*)take((size_t)2 * NTOK * 64 * 2);
  p.SGD = (u16*)take((size_t)NTOK * 128 * 2); p.QDN = (u16*)take((size_t)NTOK * 256 * 2);
  p.KVDN = (u16*)take((size_t)NTOK * 128 * 2); p.KR = (float*)take((size_t)NTOK * 32 * 4);
  p.Q = (u16*)take((size_t)NTOK * NH * 96 * 2); p.Kc = (u16*)take((size_t)NTOK * NH * 96 * 2);
  p.Vv = (u16*)take((size_t)NTOK * NH * 64 * 2);
  p.H = (u16*)take((size_t)NTOK * DM * 2);
  p.AFF = (float*)take((size_t)NB * NE * T * 4);
  p.IDX = (int*)take((size_t)NB * NE * CAP * 4);
  p.GATE = (float*)take((size_t)NB * NE * CAP * 4);

  p.CTR = (unsigned*)take(256);
  p.BAR = (unsigned*)take(XCD_BAR_WORDS * 4);
  if (off > ws_size) { fprintf(stderr, "workspace too small: need %zu have %zu\n", off, ws_size); return; }
  static int grid_blocks = 0;
  if (!grid_blocks) {
    int dev = 0, cus = 0, per_cu = 0;
    hipGetDevice(&dev);
    hipDeviceGetAttribute(&cus, hipDeviceAttributeMultiprocessorCount, dev);
    hipOccupancyMaxActiveBlocksPerMultiprocessor(&per_cu, mega, NTH, 0);
    if (per_cu > 1) per_cu = 1;
    grid_blocks = cus * per_cu;
  }
  void* args[] = {&p};
  hipError_t e = hipLaunchCooperativeKernel((void*)mega, dim3(grid_blocks), dim3(NTH), args, 0, stream);
  if (e != hipSuccess) fprintf(stderr, "cooperative launch failed: %s (grid %d)\n", hipGetErrorString(e), grid_blocks);
}
```

```cpp
#include <hip/hip_runtime.h>
#include <hip/hip_bf16.h>
#include <cstdio>
#include <cstdint>
#include <hip/hip_cooperative_groups.h>
namespace cg = cooperative_groups;

#define DI __device__ __forceinline__
#define LAS __attribute__((address_space(3)))

constexpr int NB = 2, T = 8192, NTOK = NB * T, DM = 1024, NL = 2;
constexpr int RWW = 512, RWC = 1920, INC = 2336;
constexpr int NH = 8;
constexpr int NE = 16, CAP = 1024;
constexpr int DPLE = 256;
constexpr int NTH = 512;
constexpr float NORM_EPS = 1e-6f, GN_EPS = 64e-5f;

using bf16x8 = __attribute__((ext_vector_type(8))) short;
using s16x4  = __attribute__((ext_vector_type(4))) short;
using f32x4  = __attribute__((ext_vector_type(4))) float;
using u32x4  = __attribute__((ext_vector_type(4))) unsigned;
using f32x2  = __attribute__((ext_vector_type(2))) float;
using u32x2  = __attribute__((ext_vector_type(2))) unsigned;
typedef __bf16 bf2_t __attribute__((ext_vector_type(2)));
typedef unsigned short u16;

DI unsigned pk2(float a, float b) { bf2_t v = {(__bf16)a, (__bf16)b}; return __builtin_bit_cast(unsigned, v); }
DI u16 f2bf(float a) { return (u16)(pk2(a, 0.f) & 0xffffu); }
DI float bf2f(u16 u) { return __uint_as_float(((unsigned)u) << 16); }
DI const void* uni_ptr(const void* q) {
  unsigned long long v = (unsigned long long)q;
  unsigned lo = __builtin_amdgcn_readfirstlane((unsigned)v), hi = __builtin_amdgcn_readfirstlane((unsigned)(v >> 32));
  return (const void*)(((unsigned long long)hi << 32) | lo);
}
DI int tidx() { int t = threadIdx.x; asm volatile("" : "+v"(t)); return t; }
DI int bidx() { int b = blockIdx.x; asm volatile("" : "+s"(b)); return b; }
template <int CTRL> DI float dpp_f(float v) {
  return __int_as_float(__builtin_amdgcn_update_dpp(__float_as_int(v), __float_as_int(v), CTRL, 0xF, 0xF, true));
}
DI float red_x1(float v) { return v + dpp_f<0xB1>(v); }
DI float red_x2(float v) { return v + dpp_f<0x4E>(v); }
DI float red_x4(float v) { return v + dpp_f<0x141>(v); }
DI float red_x8(float v) { return v + dpp_f<0x140>(v); }
DI float red_x16(float v) { auto r = __builtin_amdgcn_permlane16_swap(__float_as_uint(v), __float_as_uint(v), false, false); return __uint_as_float(r[0]) + __uint_as_float(r[1]); }
DI float red_x32(float v) { auto r = __builtin_amdgcn_permlane32_swap(__float_as_uint(v), __float_as_uint(v), false, false); return __uint_as_float(r[0]) + __uint_as_float(r[1]); }
DI float red16(float v) { return red_x8(red_x4(red_x2(red_x1(v)))); }
DI float wave_sum(float v) { return red_x32(red_x16(red16(v))); }
DI float frcp(float x) { return __builtin_amdgcn_rcpf(x); }
DI float frsq(float x) { return __builtin_amdgcn_rsqf(x); }
DI float fexp(float x) { return __builtin_amdgcn_exp2f(x * 1.4426950408889634f); }
DI float sigmoidf_(float x) { return frcp(1.f + fexp(-x)); }
DI float ftanh(float x) { return 1.f - 2.f * frcp(1.f + fexp(2.f * x)); }
DI s16x4 tr_read(const short* p) {
  return __builtin_amdgcn_ds_read_tr16_b64_v4i16((LAS s16x4*)(p));
}

struct P {
  const float* x; const float* p; const int* pos;
  const float* attn_norm; const float* w_in; const float* rw_mu; const float* rw_w0; const float* rw_w_up;
  const float* rw_a0; const float* rw_a_up; const float* rw_g_up; const float* rw_k_k; const float* rw_k_a;
  const float* rw_r_k; const float* rw_lnx_w; const float* rw_lnx_b; const float* mla_q_norm; const float* mla_q_up;
  const float* mla_kv_norm; const float* mla_kv_up; const float* mla_o_norm; const float* w_out; const float* ffn_norm;
  const float* router; const float* exp_w_gate; const float* exp_w_up; const float* exp_w_down; const float* ple_norm;
  const float* ple_proj; const float* ple_gate; const float* final_norm;
  float* out;
  float* Z;
  u16* LW;
  u16* AA;
  float* MC; float* NC;
  float* SS;
  u16*   G;
  u16*   HID;
  float* R; float* K; float* V;
  float* PG;
  float* QRAW;
  float* KVRAW;
  float* AO;
  u16* O2;
  u16* TWD; u16* AD; u16* SGD; u16* QDN; u16* KVDN; float* KR;
  float* ROPE;
  u16* Q; u16* Kc; u16* Vv;
  u16* H;
  float* AFF;
  int* IDX;
  float* GATE;
  u16* WIN; u16* WOUT; u16* WPG; u16* WPP; u16* PB;
  u16* PGb;
  u16* EW1; u16* EW2;
  u16* XE; u16* YE;
  int* TCNT; int* TLIST;
  unsigned* CTR;
  unsigned* BAR;
};

constexpr int GBM = 256, GBN = 128, GBK = 64;
constexpr int AS_STRIDE = 72, BS_STRIDE = 136;
constexpr int AS_BYTES = GBM * AS_STRIDE * 2;
constexpr int BS_BYTES = GBK * BS_STRIDE * 2;
constexpr int SMEM_BYTES = 57344;

template <bool A_F32, int MODE, class ARow, class Epi>
DI void gemm_tile(ARow arow, const float* __restrict__ B, const float* __restrict__ B2, int ldb, int K, int n0, int Nvalid,
                  char* smem, Epi epi) {
  short* As = (short*)smem;
  short* Bs = (short*)(smem + AS_BYTES);
  const int tid = tidx(), lane = tid & 63, w = tid >> 6;
  const int wm = w >> 1, wn = w & 1;
  const int l15 = lane & 15, lq = lane >> 4;

  const char* ap[4];
#pragma unroll
  for (int i = 0; i < 4; ++i) {
    int u = tid + i * NTH; int row = u >> 3, kc = u & 7;
    ap[i] = (const char*)arow(row) + (size_t)kc * 8 * (A_F32 ? 4 : 2);
  }
  const float* bp[4]; bool bok[4];
#pragma unroll
  for (int i = 0; i < 4; ++i) {
    int u = tid + i * NTH; int k = u >> 5, nq = u & 31;
    int col; const float* base;
    if (MODE != 1) { col = n0 + nq * 4; base = B; }
    else { col = n0 + (nq & 15) * 4; base = (nq < 16) ? B : B2; }
    bok[i] = col < Nvalid;
    bp[i] = base + (size_t)k * ldb + (bok[i] ? col : 0);
  }

  f32x4 acc[4][4];
#pragma unroll
  for (int i = 0; i < 4; ++i)
#pragma unroll
    for (int j = 0; j < 4; ++j) acc[i][j] = f32x4{0.f, 0.f, 0.f, 0.f};

  u32x4 areg[4]; f32x4 breg[4];
#define GLOAD(kt_)                                                                                   \
  {                                                                                                  \
    _Pragma("unroll") for (int i = 0; i < 4; ++i) {                                                  \
      if (A_F32) {                                                                                   \
        const float4* q = (const float4*)(ap[i] + (size_t)(kt_) * GBK * 4);                          \
        float4 v0 = q[0], v1 = q[1];                                                                 \
        areg[i] = u32x4{pk2(v0.x, v0.y), pk2(v0.z, v0.w), pk2(v1.x, v1.y), pk2(v1.z, v1.w)};         \
      } else {                                                                                       \
        areg[i] = *(const u32x4*)(ap[i] + (size_t)(kt_) * GBK * 2);                                  \
      }                                                                                              \
    }                                                                                                \
    _Pragma("unroll") for (int i = 0; i < 4; ++i) {                                                  \
      if (bok[i]) breg[i] = *(const f32x4*)(bp[i] + (size_t)(kt_) * GBK * ldb);                      \
      else breg[i] = f32x4{0.f, 0.f, 0.f, 0.f};                                                      \
    }                                                                                                \
  }
  const int nk = K / GBK;
  GLOAD(0)
  for (int kt = 0; kt < nk; ++kt) {
    __syncthreads();
#pragma unroll
    for (int i = 0; i < 4; ++i) {
      int u = tid + i * NTH; int row = u >> 3, kc = u & 7;
      *(u32x4*)(As + row * AS_STRIDE + kc * 8) = areg[i];
    }
#pragma unroll
    for (int i = 0; i < 4; ++i) {
      int u = tid + i * NTH; int k = u >> 5, nq = u & 31;
      u32x2 v = u32x2{pk2(breg[i][0], breg[i][1]), pk2(breg[i][2], breg[i][3])};
      *(u32x2*)(Bs + k * BS_STRIDE + nq * 4) = v;
    }
    __syncthreads();
    if (kt + 1 < nk) GLOAD(kt + 1)
#pragma unroll
    for (int ks = 0; ks < 2; ++ks) {
      bf16x8 a[4], b[4];
#pragma unroll
      for (int mi = 0; mi < 4; ++mi)
        a[mi] = *(const bf16x8*)(As + (wm * 64 + mi * 16 + l15) * AS_STRIDE + ks * 32 + 8 * lq);
#pragma unroll
      for (int ni = 0; ni < 4; ++ni) {
        int col0 = (MODE != 1) ? (wn * 64 + ni * 16) : ((ni < 2) ? (wn * 32 + ni * 16) : (64 + wn * 32 + (ni - 2) * 16));
        int kb = ks * 32 + 8 * lq; int q = l15 >> 2, pp = l15 & 3;
        s16x4 lo = tr_read(Bs + (kb + q) * BS_STRIDE + col0 + 4 * pp);
        s16x4 hi = tr_read(Bs + (kb + 4 + q) * BS_STRIDE + col0 + 4 * pp);
        b[ni] = __builtin_shufflevector(lo, hi, 0, 1, 2, 3, 4, 5, 6, 7);
      }
#pragma unroll
      for (int mi = 0; mi < 4; ++mi)
#pragma unroll
        for (int ni = 0; ni < 4; ++ni)
          acc[mi][ni] = __builtin_amdgcn_mfma_f32_16x16x32_bf16(a[mi], b[ni], acc[mi][ni], 0, 0, 0);
    }
  }
  if constexpr (MODE == 2) { epi(acc, wm, wn, lq, l15); return; }
  else {
#pragma unroll
  for (int mi = 0; mi < 4; ++mi)
#pragma unroll
    for (int r = 0; r < 4; ++r) {
      int row = wm * 64 + mi * 16 + lq * 4 + r;
      if (MODE == 0) {
#pragma unroll
        for (int ni = 0; ni < 4; ++ni) {
          int col = n0 + wn * 64 + ni * 16 + l15;
          if (col < Nvalid) epi(row, col, acc[mi][ni][r], 0.f);
        }
      } else {
#pragma unroll
        for (int ni = 0; ni < 2; ++ni) {
          int col = n0 + wn * 32 + ni * 16 + l15;
          epi(row, col, acc[mi][ni][r], acc[mi][ni + 2][r]);
        }
      }
    }
  }
}

DI void ph_norm(const float* __restrict__ X, const float* __restrict__ g, u16* __restrict__ Hout) {
  const int tid_ = tidx(); const int lane = tid_ & 63, w = tid_ >> 6;
  for (int tok = blockIdx.x * 8 + w; tok < NTOK; tok += gridDim.x * 8) {
    const float4* xr = (const float4*)(X + (size_t)tok * DM);
    float4 v[4]; float ss = 0.f;
#pragma unroll
    for (int j = 0; j < 4; ++j) { v[j] = xr[lane + 64 * j]; ss += v[j].x * v[j].x + v[j].y * v[j].y + v[j].z * v[j].z + v[j].w * v[j].w; }
    ss = wave_sum(ss);
    float rstd = frsq(ss * (1.f / DM) + NORM_EPS);
#pragma unroll
    for (int j = 0; j < 4; ++j) {
      float4 gg = ((const float4*)g)[lane + 64 * j];
      uint2 o = uint2{pk2(v[j].x * rstd * gg.x, v[j].y * rstd * gg.y), pk2(v[j].z * rstd * gg.z, v[j].w * rstd * gg.w)};
      *(uint2*)(Hout + (size_t)tok * DM + (lane + 64 * j) * 4) = o;
    }
  }
}

DI void ph_final_norm(float* __restrict__ X, const float* __restrict__ g) {
  const int tid_ = tidx(); const int lane = tid_ & 63, w = tid_ >> 6;
  for (int tok = blockIdx.x * 8 + w; tok < NTOK; tok += gridDim.x * 8) {
    float4* xr = (float4*)(X + (size_t)tok * DM);
    float4 v[4]; float ss = 0.f;
#pragma unroll
    for (int j = 0; j < 4; ++j) { v[j] = xr[lane + 64 * j]; ss += v[j].x * v[j].x + v[j].y * v[j].y + v[j].z * v[j].z + v[j].w * v[j].w; }
    ss = wave_sum(ss);
    float rstd = frsq(ss * (1.f / DM) + NORM_EPS);
#pragma unroll
    for (int j = 0; j < 4; ++j) {
      float4 gg = ((const float4*)g)[lane + 64 * j];
      xr[lane + 64 * j] = float4{v[j].x * rstd * gg.x, v[j].y * rstd * gg.y, v[j].z * rstd * gg.z, v[j].w * rstd * gg.w};
    }
  }
}

template <bool A_F32, class Epi>
DI void ph_gemm(const void* A, int lda, const float* B, int ldb, int M, int N, int K, char* smem, Epi epi) {
  const int ntn = (N + GBN - 1) / GBN, ntm = M / GBM;
  for (int t = blockIdx.x; t < ntm * ntn; t += gridDim.x) {
    int tm = t / ntn, tn = t % ntn;
    int m0 = tm * GBM, n0 = tn * GBN;
    auto arow = [&](int r) -> const void* { return (const char*)A + (size_t)(m0 + r) * lda * (A_F32 ? 4 : 2); };
    gemm_tile<A_F32, 0>(arow, B, nullptr, ldb, K, n0, N, smem, [&](int row, int col, float v, float) { epi(m0 + row, col, v); });
    __syncthreads();
  }
}

template <class Epi>
DI void ph_gemm_t(const void* A, int lda, const float* B, int ldb, int M, int N, int K, char* smem, Epi epi) {
  const int ntn = (N + GBN - 1) / GBN, ntm = M / GBM;
  for (int t = blockIdx.x; t < ntm * ntn; t += gridDim.x) {
    int tm = t / ntn, tn = t % ntn;
    int m0 = tm * GBM, n0 = tn * GBN;
    auto arow = [&](int r) -> const void* { return (const char*)A + (size_t)(m0 + r) * lda * 2; };
    gemm_tile<false, 2>(arow, B, nullptr, ldb, K, n0, N, smem,
                        [&](const f32x4 (&acc)[4][4], int wm, int wn, int lq, int l15) { epi(acc, m0, n0, wm, wn, lq, l15); });
    __syncthreads();
  }
}

DI void ph_rwshift(const P& p, int layer) {
  const float* mu = p.rw_mu + layer * RWC;
  const int total = NTOK * (RWC / 4);
  const int tid_ = tidx();
  for (int i = blockIdx.x * NTH + tid_; i < total; i += gridDim.x * NTH) {
    int tok = i / (RWC / 4), c = (i % (RWC / 4)) * 4;
    int t = tok % T;
    const float* zr = p.Z + (size_t)tok * INC + c;
    float4 z = *(const float4*)zr;
    float4 zm = (t > 0) ? *(const float4*)(zr - INC) : float4{0.f, 0.f, 0.f, 0.f};
    float4 zp = (t < T - 1) ? *(const float4*)(zr + INC) : float4{0.f, 0.f, 0.f, 0.f};
    float4 m = *(const float4*)(mu + c);
    float4 o;
    o.x = z.x + m.x * (0.5f * (zm.x + zp.x) - z.x);
    o.y = z.y + m.y * (0.5f * (zm.y + zp.y) - z.y);
    o.z = z.z + m.z * (0.5f * (zm.z + zp.z) - z.z);
    o.w = z.w + m.w * (0.5f * (zm.w + zp.w) - z.w);
    if (c < 512) *(float4*)(p.R + (size_t)tok * RWW + c) = o;
    else if (c < 1024) *(float4*)(p.K + (size_t)tok * RWW + (c - 512)) = o;
    else if (c < 1536) *(float4*)(p.V + (size_t)tok * RWW + (c - 1024)) = o;
    else if (c < 1664) {
      int d = (c - 1536) >> 6, l = (c - 1536) & 63;
      *(uint2*)(p.TWD + ((size_t)d * NTOK + tok) * 64 + l) = uint2{pk2(ftanh(o.x), ftanh(o.y)), pk2(ftanh(o.z), ftanh(o.w))};
    } else if (c < 1792) {
      int d = (c - 1664) >> 6, l = (c - 1664) & 63;
      *(uint2*)(p.AD + ((size_t)d * NTOK + tok) * 64 + l) = uint2{pk2(o.x, o.y), pk2(o.z, o.w)};
    } else {
      int l = c - 1792;
      *(uint2*)(p.SGD + (size_t)tok * 128 + l) = uint2{pk2(sigmoidf_(o.x), sigmoidf_(o.y)), pk2(sigmoidf_(o.z), sigmoidf_(o.w))};
    }
  }
}

DI void rope_cs(int pos, int i, float& cs, float& sn) {
  const int i3 = i & 3, i2 = i >> 2;
  const float c4 = (i3 == 0) ? 1.0f : (i3 == 1) ? 0.5623413251903491f : (i3 == 2) ? 0.31622776601683794f : 0.1778279410038923f;
  const float p10 = (i2 == 0) ? 1.0f : (i2 == 1) ? 0.1f : (i2 == 2) ? 0.01f : 0.001f;
  float inv = c4 * p10;
  float ang = (float)pos * inv;
  double rev = (double)ang * 0.15915494309189535;
  rev -= floor(rev);
  float rf = (float)rev;
  sn = __builtin_amdgcn_sinf(rf);
  cs = __builtin_amdgcn_cosf(rf);
}

DI void ph_rope_table(const P& p) {
  for (int i = blockIdx.x * NTH + tidx(); i < NTOK * 16; i += gridDim.x * NTH) {
    float cs, sn; rope_cs(p.pos[i >> 4], i & 15, cs, sn);
    *(f32x2*)(p.ROPE + (size_t)i * 2) = f32x2{cs, sn};
  }
}
DI void ph_mlaprep1(const P& p, int layer) {
  const int tid_ = tidx(); const int lane = tid_ & 63, w = tid_ >> 6;
  const float* qn = p.mla_q_norm + layer * 256;
  const float* kvn = p.mla_kv_norm + layer * 128;
  for (int tok = blockIdx.x * 8 + w; tok < NTOK; tok += gridDim.x * 8) {
    const float* zr = p.Z + (size_t)tok * INC + RWC;
    float4 q = *(const float4*)(zr + lane * 4);
    float ss = wave_sum(q.x * q.x + q.y * q.y + q.z * q.z + q.w * q.w);
    float rstd = frsq(ss * (1.f / 256) + NORM_EPS);
    float4 g = *(const float4*)(qn + lane * 4);
    *(uint2*)(p.QDN + (size_t)tok * 256 + lane * 4) = uint2{pk2(q.x * rstd * g.x, q.y * rstd * g.y), pk2(q.z * rstd * g.z, q.w * rstd * g.w)};
    float2 kv = *(const float2*)(zr + 256 + lane * 2);
    float ss2 = wave_sum(kv.x * kv.x + kv.y * kv.y);
    float rstd2 = frsq(ss2 * (1.f / 128) + NORM_EPS);
    float2 g2 = *(const float2*)(kvn + lane * 2);
    *(unsigned*)(p.KVDN + (size_t)tok * 128 + lane * 2) = pk2(kv.x * rstd2 * g2.x, kv.y * rstd2 * g2.y);
    if (lane < 16) {
      float u1 = zr[384 + lane], u2 = zr[384 + 16 + lane];
      const f32x2 csn = *(const f32x2*)(p.ROPE + (size_t)tok * 32 + lane * 2);
      const u16 k1 = f2bf(u1 * csn[0] - u2 * csn[1]), k2 = f2bf(u1 * csn[1] + u2 * csn[0]);
      const int bb = tok / T, tt = tok % T;
#pragma unroll
      for (int h = 0; h < NH; ++h) {
        u16* ko = p.Kc + ((size_t)(bb * NH + h) * T + tt) * 96 + 64;
        ko[lane] = k1; ko[16 + lane] = k2;
      }
    }
  }
}

DI void ph_mlafinish(const P& p) {
  const int tid_ = tidx(); const int lane = tid_ & 63, w = tid_ >> 6;
  const float qs = 0.10206207261596577f * 1.4426950408889634f;
  for (int tok = blockIdx.x * 8 + w; tok < NTOK; tok += gridDim.x * 8) {
    int b = tok / T, t = tok % T;
    float cs = 0.f, sn = 0.f;
    if (lane < 16) rope_cs(p.pos[tok], lane, cs, sn);
    const float* qr = p.QRAW + (size_t)tok * 768;
    const float* kvr = p.KVRAW + (size_t)tok * 1024;
    const float* kr = p.KR + (size_t)tok * 32;
#pragma unroll
    for (int h = 0; h < NH; ++h) {
      size_t row = ((size_t)(b * NH + h) * T + t);
      u16* qo = p.Q + row * 96; u16* ko = p.Kc + row * 96; u16* vo = p.Vv + row * 64;
      qo[lane] = f2bf(qr[h * 96 + lane] * qs);
      ko[lane] = f2bf(kvr[h * 128 + lane]);
      vo[lane] = f2bf(kvr[h * 128 + 64 + lane]);
      if (lane < 16) {
        float u1 = qr[h * 96 + 64 + lane], u2 = qr[h * 96 + 80 + lane];
        qo[64 + lane] = f2bf((u1 * cs - u2 * sn) * qs);
        qo[80 + lane] = f2bf((u1 * sn + u2 * cs) * qs);
      }
      if (lane < 32) ko[64 + lane] = f2bf(kr[lane]);
    }
  }
}

using f32x16 = __attribute__((ext_vector_type(16))) float;
#define SBAR() __builtin_amdgcn_sched_barrier(0)
constexpr int AT_KSTR = 104;
constexpr int AT_KBYTES = 64 * AT_KSTR * 2;
constexpr int AT_VBYTES = 64 * 64 * 2;
constexpr float AT_THR = 8.f;
DI int crow(int r, int hi) { return (r & 3) + 8 * (r >> 2) + 4 * hi; }
DI int v_st(int k, int c) { const int kk = (k & ~0xC) | ((k & 4) << 1) | ((k & 8) >> 1); return ((kk >> 3) * 2 + (c >> 5)) * 512 + ((kk & 7) * 32 + (c & 31)) * 2; }
DI int v_rd_base(int lane) { return ((lane & 3) << 3) | (((lane >> 2) & 3) << 6) | (((lane >> 4) & 1) << 5) | (((lane >> 5) & 1) << 8); }
constexpr int v_rd_off(int d0, int ks, int half) { return d0 * 512 + ks * 2048 + half * 1024; }

DI void at_partialSM(f32x16& p0, f32x16& p1, float& m_reg, float& mn, float& alpha) {
  float pmax = p0[0];
#pragma unroll
  for (int r = 1; r < 16; ++r) pmax = fmaxf(pmax, p0[r]);
#pragma unroll
  for (int r = 0; r < 16; ++r) pmax = fmaxf(pmax, p1[r]);
  { auto rr = __builtin_amdgcn_permlane32_swap(__float_as_uint(pmax), __float_as_uint(pmax), false, false);
    pmax = fmaxf(__uint_as_float(rr[0]), __uint_as_float(rr[1])); }
  if (__builtin_expect(__all(pmax - m_reg <= AT_THR), 1)) { mn = m_reg; alpha = 1.f; }
  else { mn = fmaxf(m_reg, pmax); alpha = __builtin_amdgcn_exp2f(m_reg - mn); m_reg = mn; }
#pragma unroll
  for (int r = 0; r < 16; ++r) { p0[r] = p0[r] - mn; p1[r] = p1[r] - mn; }
#pragma unroll
  for (int r = 0; r < 16; ++r) p0[r] = __builtin_amdgcn_exp2f(p0[r]);
}
DI void at_finishSM(f32x16& p0, f32x16& p1, float alpha, float& l_reg, bf16x8& pa0, bf16x8& pa1, bf16x8& pa2, bf16x8& pa3) {
#pragma unroll
  for (int r = 0; r < 16; ++r) p1[r] = __builtin_amdgcn_exp2f(p1[r]);
  float ps = 0;
#pragma unroll
  for (int r = 0; r < 16; ++r) ps += p0[r];
#pragma unroll
  for (int r = 0; r < 16; ++r) ps += p1[r];
  { auto rr = __builtin_amdgcn_permlane32_swap(__float_as_uint(ps), __float_as_uint(ps), false, false);
    ps = __uint_as_float(rr[0]) + __uint_as_float(rr[1]); }
  l_reg = l_reg * alpha + ps;
#define PK4(PP, BASE, OUT) do { unsigned a0 = pk2(PP[BASE + 0], PP[BASE + 1]), a1 = pk2(PP[BASE + 2], PP[BASE + 3]);   \
    unsigned b0 = pk2(PP[BASE + 4], PP[BASE + 5]), b1 = pk2(PP[BASE + 6], PP[BASE + 7]);                              \
    auto r0 = __builtin_amdgcn_permlane32_swap(a0, b0, false, false); auto r1 = __builtin_amdgcn_permlane32_swap(a1, b1, false, false); \
    u32x4 wv = {r0[0], r1[0], r0[1], r1[1]}; OUT = __builtin_bit_cast(bf16x8, wv); } while (0)
  PK4(p0, 0, pa0); PK4(p0, 8, pa1); PK4(p1, 0, pa2); PK4(p1, 8, pa3);
#undef PK4
}
DI void at_qkt(f32x16& p0, f32x16& p1, const char* Kb, const bf16x8* qr, int r32, int hi) {
#pragma unroll
  for (int r = 0; r < 16; ++r) { p0[r] = 0.f; p1[r] = 0.f; }
#pragma unroll
  for (int d0 = 0; d0 < 6; ++d0) {
    bf16x8 b0 = *(const bf16x8*)(Kb + (r32 * AT_KSTR + d0 * 16 + hi * 8) * 2);
    bf16x8 b1 = *(const bf16x8*)(Kb + ((32 + r32) * AT_KSTR + d0 * 16 + hi * 8) * 2);
    __builtin_amdgcn_s_setprio(1);
    p0 = __builtin_amdgcn_mfma_f32_32x32x16_bf16(b0, qr[d0], p0, 0, 0, 0);
    p1 = __builtin_amdgcn_mfma_f32_32x32x16_bf16(b1, qr[d0], p1, 0, 0, 0);
    __builtin_amdgcn_s_setprio(0);
  }
}
template <int D0> DI void at_pv_one(f32x16& od, const char* vb, bf16x8 pa0, bf16x8 pa1, bf16x8 pa2, bf16x8 pa3) {
#define TRR(ks, half) tr_read((const short*)(vb + v_rd_off(D0, ks, half)))
  const s16x4 l0 = TRR(0, 0), h0 = TRR(0, 1), l1 = TRR(1, 0), h1 = TRR(1, 1), l2 = TRR(2, 0), h2 = TRR(2, 1), l3 = TRR(3, 0), h3 = TRR(3, 1);
#undef TRR
#define PKV(L, H) __builtin_shufflevector(L, H, 0, 1, 2, 3, 4, 5, 6, 7)
  __builtin_amdgcn_s_setprio(1);
  od = __builtin_amdgcn_mfma_f32_32x32x16_bf16(pa0, PKV(l0, h0), od, 0, 0, 0);
  od = __builtin_amdgcn_mfma_f32_32x32x16_bf16(pa1, PKV(l1, h1), od, 0, 0, 0);
  od = __builtin_amdgcn_mfma_f32_32x32x16_bf16(pa2, PKV(l2, h2), od, 0, 0, 0);
  od = __builtin_amdgcn_mfma_f32_32x32x16_bf16(pa3, PKV(l3, h3), od, 0, 0, 0);
  __builtin_amdgcn_s_setprio(0);
#undef PKV
}
DI void at_pv(f32x16* o, const char* vb, bf16x8 pa0, bf16x8 pa1, bf16x8 pa2, bf16x8 pa3) {
  at_pv_one<0>(o[0], vb, pa0, pa1, pa2, pa3); at_pv_one<1>(o[1], vb, pa0, pa1, pa2, pa3);
}

DI void attn_body(const u16* __restrict__ Qb, const u16* __restrict__ Kh, const u16* __restrict__ Vh, float* __restrict__ Ob, char* lds, int tid) {
  const int wid = tid >> 6, lane = tid & 63, r32 = lane & 31, hi = lane >> 5;
  char* V_lds = lds; char* K_lds = lds + 2 * AT_VBYTES;
  float* wsp = (float*)(lds + 2 * AT_VBYTES + 2 * AT_KBYTES) + wid * 64; float* li_l = wsp; float* al_l = wsp + 32;
  float m_reg = -1e30f, l_reg = 0.f; f32x16 o[2]; bf16x8 qr[6];
#pragma unroll
  for (int r = 0; r < 16; ++r) { o[0][r] = 0.f; o[1][r] = 0.f; }
  const u16* Qw = Qb + (size_t)(wid * 32 + r32) * 96 + hi * 8;
#pragma unroll
  for (int d0 = 0; d0 < 6; ++d0) qr[d0] = *(const bf16x8*)(Qw + d0 * 16);
  const int kid1 = (tid < 256) ? tid + 512 : tid;
  const int kst0 = ((tid / 12) * AT_KSTR + (tid % 12) * 8) * 2, kst1 = ((kid1 / 12) * AT_KSTR + (kid1 % 12) * 8) * 2;
  const int vst = v_st(tid >> 3, (tid & 7) * 8);
  const char* vb0 = V_lds + v_rd_base(lane);
  u32x4 sk0[2], sk1[2], sv0[2];
#define SLOAD(i, k0) do { sk0[i] = *(const u32x4*)(Kh + (size_t)(k0) * 96 + tid * 8); sk1[i] = *(const u32x4*)(Kh + (size_t)(k0) * 96 + kid1 * 8); \
    sv0[i] = *(const u32x4*)(Vh + (size_t)(k0) * 64 + tid * 8); } while (0)
#define SWRITE(b, i) do { *(u32x4*)(K_lds + (b) * AT_KBYTES + kst0) = sk0[i]; if (tid < 256) *(u32x4*)(K_lds + (b) * AT_KBYTES + kst1) = sk1[i]; \
    *(u32x4*)(V_lds + (b) * AT_VBYTES + vst) = sv0[i]; } while (0)
#define SWAIT() asm volatile("s_waitcnt vmcnt(3)" ::: "memory")
#define RESC(a) do { if (__any((a) < 1.f)) { if (hi == 0) al_l[r32] = (a); asm volatile("s_waitcnt lgkmcnt(0)" ::: "memory"); \
    _Pragma("unroll") for (int r = 0; r < 16; ++r) { float al = al_l[crow(r, hi)]; o[0][r] *= al; o[1][r] *= al; } } } while (0)
  f32x16 pA0, pA1, pB0, pB1; float mnA, mnB, alA, alB; bf16x8 pa0, pa1, pa2, pa3; constexpr int NT = T / 64;
  SLOAD(0, 0); SWRITE(0, 0); __syncthreads();
  at_qkt(pA0, pA1, K_lds, qr, r32, hi); at_partialSM(pA0, pA1, m_reg, mnA, alA);
  SLOAD(1, 64); SLOAD(0, 128);
  SWAIT(); SWRITE(1, 1); __syncthreads();
  for (int j = 1; j + 1 < NT; j += 2) {
    SBAR(); at_qkt(pB0, pB1, K_lds + AT_KBYTES, qr, r32, hi);
    at_finishSM(pA0, pA1, alA, l_reg, pa0, pa1, pa2, pa3); SBAR();
    SLOAD(1, (j + 2) * 64); SBAR();
    at_pv(o, vb0, pa0, pa1, pa2, pa3); at_partialSM(pB0, pB1, m_reg, mnB, alB);
    __syncthreads(); SWAIT(); SWRITE(0, 0);
    RESC(alB); __syncthreads();
    SBAR(); at_qkt(pA0, pA1, K_lds, qr, r32, hi);
    at_finishSM(pB0, pB1, alB, l_reg, pa0, pa1, pa2, pa3); SBAR();
    if (j + 3 < NT) SLOAD(0, (j + 3) * 64); SBAR();
    at_pv(o, vb0 + AT_VBYTES, pa0, pa1, pa2, pa3); at_partialSM(pA0, pA1, m_reg, mnA, alA);
    __syncthreads(); SWAIT(); SWRITE(1, 1);
    RESC(alA); __syncthreads();
  }
  SBAR(); at_qkt(pB0, pB1, K_lds + AT_KBYTES, qr, r32, hi);
  at_finishSM(pA0, pA1, alA, l_reg, pa0, pa1, pa2, pa3); SBAR();
  at_pv(o, vb0, pa0, pa1, pa2, pa3); at_partialSM(pB0, pB1, m_reg, mnB, alB);
  __syncthreads(); RESC(alB);
  at_finishSM(pB0, pB1, alB, l_reg, pa0, pa1, pa2, pa3); SBAR();
  at_pv(o, vb0 + AT_VBYTES, pa0, pa1, pa2, pa3);
  if (hi == 0) li_l[r32] = l_reg;
  asm volatile("s_waitcnt lgkmcnt(0)" ::: "memory");
  float* Ow = Ob + (size_t)(wid * 32) * 512;
#pragma unroll
  for (int r = 0; r < 16; ++r) {
    int orow = crow(r, hi); float rl = __builtin_amdgcn_rcpf(li_l[orow]);
    Ow[(size_t)orow * 512 + r32] = o[0][r] * rl; Ow[(size_t)orow * 512 + 32 + r32] = o[1][r] * rl;
  }
#undef SLOAD
#undef SWRITE
#undef SWAIT
#undef RESC
}

DI void ph_attn(const P& p, char* smem, unsigned* ctr) {
  const int tid = tidx();
  int* sitem = (int*)(smem + SMEM_BYTES - 16);
  for (;;) {
    __syncthreads();
    if (tid == 0) *sitem = (int)atomicAdd(ctr, 1u);
    __syncthreads();
    const int item = *sitem;
    if (item >= NB * NH * (T / 256)) break;
    const int bh = item / (T / 256), qb = item % (T / 256);
    const int b = bh / NH, h = bh % NH;
    attn_body(p.Q + ((size_t)bh * T + qb * 256) * 96, p.Kc + (size_t)bh * T * 96, p.Vv + (size_t)bh * T * 64,
              p.AO + ((size_t)(b * T + qb * 256)) * 512 + h * 64, smem, tid);
  }
}

constexpr int SC = 128, NCH = T / SC;
constexpr int SBUF = 5184;
template <int NI> struct ScanRegsN { float k[2 * NI], r[2 * NI], v[2 * NI]; u16 lw[2 * NI], a[2 * NI]; };
template <int NI>
DI void scan_load_n(const P& p, int b, int h, int d, int n0, int lane, int ws, ScanRegsN<NI>& g) {
  constexpr int WPI = 8 / NI;
  const u16* LWd = p.LW + (size_t)d * NTOK * RWW;
  const u16* AAd = p.AA + (size_t)d * NTOK * RWW;
  const int ch = h * 64 + lane;
#pragma unroll
  for (int jj = 0; jj < 2 * NI; ++jj) {
    int n = n0 + ws + WPI * jj; int t = d ? (T - 1 - n) : n;
    size_t off = ((size_t)(b * T + t)) * RWW + ch;
    g.k[jj] = p.K[off]; g.r[jj] = p.R[off]; g.v[jj] = p.V[off]; g.lw[jj] = LWd[off]; g.a[jj] = AAd[off];
  }
}
template <int NI>
DI void scan_put_n(const ScanRegsN<NI>& g, float kkc, float kac, float* sm, float* slw, int lane, int ws) {
  constexpr int WPI = 8 / NI;
#pragma unroll
  for (int jj = 0; jj < 2 * NI; ++jj) slw[(ws + WPI * jj) * 64 + lane] = bf2f(g.lw[jj]);
  __syncthreads();
  float Lj[2 * NI];
#pragma unroll
  for (int jj = 0; jj < 2 * NI; ++jj) Lj[jj] = 0.f;
#pragma unroll
  for (int i = 0; i < 16; ++i) {
    const float x = slw[i * 64 + lane];
#pragma unroll
    for (int jj = 0; jj < 2 * NI; ++jj) Lj[jj] += (i <= ws + WPI * jj) ? x : 0.f;
  }
#pragma unroll
  for (int jj = 0; jj < 2 * NI; ++jj) {
    const int j = ws + WPI * jj;
    const float L = Lj[jj], lwj = bf2f(g.lw[jj]);
    const float Pt = fexp(L), Pm = fexp(L - lwj), iP = fexp(-L);
    const float kv = g.k[jj];
    const float kx = kv * kkc;
    const float nrm = __builtin_amdgcn_sqrtf(wave_sum(kx * kx));
    const float kkv = kx * frcp(fmaxf(nrm, 1e-12f));
    const float a = bf2f(g.a[jj]);
    sm[j * 64 + lane] = -kkv * Pm;
    sm[1024 + j * 64 + lane] = a * kkv * iP;
    sm[2048 + j * 64 + lane] = kv * (1.f + (a - 1.f) * kac) * iP;
    sm[3072 + j * 64 + lane] = g.r[jj] * Pt;
    sm[4096 + j * 64 + lane] = g.v[jj];
    if (j == 15) sm[5120 + lane] = Pt;
  }
}
using f32x16s = __attribute__((ext_vector_type(16))) float;
DI float scan_dot(const f32x16s (&acc)[2], const float* vec, int hi) {
  float p0 = 0.f, p1 = 0.f, p2 = 0.f, p3 = 0.f;
#pragma unroll
  for (int tk = 0; tk < 2; ++tk)
#pragma unroll
    for (int q = 0; q < 4; ++q) {
      const f32x4 kv = *(const f32x4*)(vec + 32 * tk + 8 * q + 4 * hi);
      p0 += acc[tk][4 * q + 0] * kv[0]; p1 += acc[tk][4 * q + 1] * kv[1]; p2 += acc[tk][4 * q + 2] * kv[2]; p3 += acc[tk][4 * q + 3] * kv[3];
    }
  return red_x32((p0 + p1) + (p2 + p3));
}

DI void ph_scan1(const P& p, int layer, char* smem) {
  constexpr int NI = 2;
  const int tid = tidx(), lane = tid & 63, w = tid >> 6;
  const int jl = lane & 31, hi = lane >> 5;
  const int it = w >> 2, vt = w & 3, ws = w & 3;
  float* smi = (float*)smem + it * (2 * SBUF + 1024);
  float* slw = smi + 2 * SBUF;
  for (int pair = blockIdx.x; pair < 32 * NCH / 2; pair += gridDim.x) {
    const int item = pair * 2 + it; const int scan = item / NCH, c = item % NCH;
    const int d = scan & 1, h = (scan >> 1) % NH, b = scan / (2 * NH);
    const float kkc = p.rw_k_k[layer * RWW + h * 64 + lane], kac = p.rw_k_a[layer * RWW + h * 64 + lane];
    f32x16s acc[2];
#pragma unroll
    for (int tk = 0; tk < 2; ++tk)
#pragma unroll
      for (int r = 0; r < 16; ++r) acc[tk][r] = (32 * tk + (r & 3) + 8 * (r >> 2) + 4 * hi == 32 * vt + jl) ? 1.f : 0.f;
    ScanRegsN<NI> g;
    scan_load_n<NI>(p, b, h, d, c * SC, lane, ws, g);
    __syncthreads();
    scan_put_n<NI>(g, kkc, kac, smi, slw, lane, ws);
    __syncthreads();
    for (int sub = 0; sub < SC / 16; ++sub) {
      const float* sm = smi + (sub & 1) * SBUF;
      if (sub + 1 < SC / 16) scan_load_n<NI>(p, b, h, d, c * SC + (sub + 1) * 16, lane, ws, g);
#pragma unroll 4
      for (int j = 0; j < 16; ++j) {
        const float sa = scan_dot(acc, sm + j * 64, hi);
        const float vvv = (vt >= 2) ? sm[4096 + j * 64 + 32 * (vt - 2) + jl] : 0.f;
        const float bop = hi ? vvv : sa;
#pragma unroll
        for (int tk = 0; tk < 2; ++tk) {
          const float aop = sm[1024 + hi * 1024 + j * 64 + 32 * tk + jl];
          acc[tk] = __builtin_amdgcn_mfma_f32_32x32x2f32(aop, bop, acc[tk], 0, 0, 0);
        }
      }
#pragma unroll
      for (int tk = 0; tk < 2; ++tk)
#pragma unroll
        for (int q = 0; q < 4; ++q) {
          const f32x4 pv = *(const f32x4*)(sm + 5120 + 32 * tk + 8 * q + 4 * hi);
#pragma unroll
          for (int e = 0; e < 4; ++e) acc[tk][4 * q + e] *= pv[e];
        }
      if (sub + 1 < SC / 16) scan_put_n<NI>(g, kkc, kac, smi + ((sub + 1) & 1) * SBUF, slw, lane, ws);
      __syncthreads();
    }
    {
      const int v = 32 * vt + jl;
      float* dst = ((v < 64) ? p.MC : p.NC) + (((size_t)scan * NCH + c) * 64 + (v & 63)) * 64;
#pragma unroll
      for (int tk = 0; tk < 2; ++tk)
#pragma unroll
        for (int q = 0; q < 4; ++q)
          *(f32x4*)(dst + 32 * tk + 8 * q + 4 * hi) = f32x4{acc[tk][4 * q], acc[tk][4 * q + 1], acc[tk][4 * q + 2], acc[tk][4 * q + 3]};
    }
  }
}


using f32x4v = __attribute__((ext_vector_type(4))) float;
DI void ph_scan2(const P& p, char* smem) {
  float* Ssm = (float*)smem;
  float* Msm = Ssm + 64 * 68;
  const int tid = tidx(), lane = tid & 63, w = tid >> 6;
  const int l15 = lane & 15, lq = lane >> 4;
  const int ti = w >> 1, tj0 = (w & 1) * 2;
  for (int scan = blockIdx.x; scan < 32; scan += gridDim.x) {
    const float* Mg = p.MC + (size_t)scan * NCH * 4096;
    const float* Ng = p.NC + (size_t)scan * NCH * 4096;
    float* Sg = p.SS + (size_t)scan * NCH * 4096;
    f32x4 m0 = *(const f32x4*)(Mg + tid * 8), m1 = *(const f32x4*)(Mg + tid * 8 + 4);
    f32x4 sacc[2];
    f32x4 nacc[2];
#pragma unroll
    for (int q = 0; q < 2; ++q) {
      sacc[q] = f32x4{0.f, 0.f, 0.f, 0.f};
#pragma unroll
      for (int r = 0; r < 4; ++r) nacc[q][r] = Ng[(ti * 16 + lq * 4 + r) * 64 + (tj0 + q) * 16 + l15];
    }
    for (int c = 0; c < NCH; ++c) {
      __syncthreads();
#pragma unroll
      for (int q = 0; q < 2; ++q)
#pragma unroll
        for (int r = 0; r < 4; ++r) {
          const int row = ti * 16 + lq * 4 + r, col = (tj0 + q) * 16 + l15;
          Sg[(size_t)c * 4096 + row * 64 + col] = sacc[q][r];
          Ssm[row * 68 + col] = sacc[q][r];
        }
      { const int mr = tid >> 3, mc = (tid & 7) * 8; *(f32x4*)(Msm + mr * 68 + mc) = m0; *(f32x4*)(Msm + mr * 68 + mc + 4) = m1; }
      f32x4 acc[2] = {nacc[0], nacc[1]};
      __syncthreads();
      if (c + 1 < NCH) {
        m0 = *(const f32x4*)(Mg + (size_t)(c + 1) * 4096 + tid * 8); m1 = *(const f32x4*)(Mg + (size_t)(c + 1) * 4096 + tid * 8 + 4);
#pragma unroll
        for (int q = 0; q < 2; ++q)
#pragma unroll
          for (int r = 0; r < 4; ++r) nacc[q][r] = Ng[(size_t)(c + 1) * 4096 + (ti * 16 + lq * 4 + r) * 64 + (tj0 + q) * 16 + l15];
      }
#pragma unroll
      for (int kk = 0; kk < 16; ++kk) {
        const float a = Ssm[(ti * 16 + l15) * 68 + kk * 4 + lq];
        const float b0 = Msm[(kk * 4 + lq) * 68 + tj0 * 16 + l15], b1 = Msm[(kk * 4 + lq) * 68 + (tj0 + 1) * 16 + l15];
        acc[0] = __builtin_amdgcn_mfma_f32_16x16x4f32(a, b0, acc[0], 0, 0, 0);
        acc[1] = __builtin_amdgcn_mfma_f32_16x16x4f32(a, b1, acc[1], 0, 0, 0);
      }
      sacc[0] = acc[0]; sacc[1] = acc[1];
    }
    __syncthreads();
  }
}

DI void ph_scan3(const P& p, int layer, char* smem) {
  constexpr int NI = 4;
  const int tid = tidx(), lane = tid & 63, w = tid >> 6;
  const int jl = lane & 31, hi = lane >> 5;
  const int it = w >> 1, vt = w & 1, ws = w & 1;
  float* sm = (float*)smem + it * (SBUF + 2048);
  float* slw = sm + SBUF; float* so = slw + 1024;
  for (int quad = blockIdx.x; quad < 32 * NCH / 4; quad += gridDim.x) {
    const int item = quad * 4 + it; const int scan = item / NCH, c = item % NCH;
    const int d = scan & 1, h = (scan >> 1) % NH, b = scan / (2 * NH);
    const float kkc = p.rw_k_k[layer * RWW + h * 64 + lane], kac = p.rw_k_a[layer * RWW + h * 64 + lane];
    u16* Od = p.O2 + (size_t)d * NTOK * RWW;
    f32x16s acc[2];
    {
      const float* Sg = p.SS + ((size_t)scan * NCH + c) * 4096 + (size_t)(32 * vt + jl) * 64;
#pragma unroll
      for (int tk = 0; tk < 2; ++tk)
#pragma unroll
        for (int q = 0; q < 4; ++q) {
          const f32x4 sv = *(const f32x4*)(Sg + 32 * tk + 8 * q + 4 * hi);
#pragma unroll
          for (int e = 0; e < 4; ++e) acc[tk][4 * q + e] = sv[e];
        }
    }
    ScanRegsN<NI> g;
    scan_load_n<NI>(p, b, h, d, c * SC, lane, ws, g);
    for (int sub = 0; sub < SC / 16; ++sub) {
      const int n0 = c * SC + sub * 16;
      __syncthreads();
      scan_put_n<NI>(g, kkc, kac, sm, slw, lane, ws);
      __syncthreads();
      if (sub + 1 < SC / 16) scan_load_n<NI>(p, b, h, d, n0 + 16, lane, ws, g);
#pragma unroll 4
      for (int j = 0; j < 16; ++j) {
        const float sa = scan_dot(acc, sm + j * 64, hi);
        const float vvv = sm[4096 + j * 64 + 32 * vt + jl];
        const float bop = hi ? vvv : sa;
#pragma unroll
        for (int tk = 0; tk < 2; ++tk) {
          const float aop = sm[1024 + hi * 1024 + j * 64 + 32 * tk + jl];
          acc[tk] = __builtin_amdgcn_mfma_f32_32x32x2f32(aop, bop, acc[tk], 0, 0, 0);
        }
        const float o = scan_dot(acc, sm + 3072 + j * 64, hi);
        if (hi == 0) so[j * 64 + 32 * vt + jl] = o;
      }
#pragma unroll
      for (int tk = 0; tk < 2; ++tk)
#pragma unroll
        for (int q = 0; q < 4; ++q) {
          const f32x4 pv = *(const f32x4*)(sm + 5120 + 32 * tk + 8 * q + 4 * hi);
#pragma unroll
          for (int e = 0; e < 4; ++e) acc[tk][4 * q + e] *= pv[e];
        }
      __syncthreads();
#pragma unroll
      for (int jj = 0; jj < 8; ++jj) {
        const int j = ws + 2 * jj; const int n = n0 + j; const int t = d ? (T - 1 - n) : n;
        Od[((size_t)(b * T + t)) * RWW + h * 64 + lane] = f2bf(so[j * 64 + lane]);
      }
    }
  }
}


DI void ph_mixfinish(const P& p, int layer) {
  const int tid_ = tidx(); const int lane = tid_ & 63, w = tid_ >> 6;
  const float* lw = p.rw_lnx_w + layer * RWW; const float* lb = p.rw_lnx_b + layer * RWW;
  const float* kac = p.rw_k_a + layer * RWW; const float* rk = p.rw_r_k + layer * RWW;
  const float* on = p.mla_o_norm + layer * 512;
  float plw[8], plb[8], pka[8], prk[8];
#pragma unroll
  for (int h = 0; h < NH; ++h) { int c = h * 64 + lane; plw[h] = lw[c]; plb[h] = lb[c]; pka[h] = kac[c]; prk[h] = rk[c]; }
  const f32x4 g0 = *(const f32x4*)(on + lane * 4), g1 = *(const f32x4*)(on + 256 + lane * 4);
  for (int tok = blockIdx.x * 8 + w; tok < NTOK; tok += gridDim.x * 8) {
    float o[8], k[8], r[8], vv[8], a0[8], a1[8], gg[8];
#pragma unroll
    for (int h = 0; h < NH; ++h) {
      size_t off = (size_t)tok * RWW + h * 64 + lane;
      o[h] = bf2f(p.O2[off]) + bf2f(p.O2[(size_t)NTOK * RWW + off]);
      k[h] = p.K[off]; r[h] = p.R[off]; vv[h] = p.V[off];
      a0[h] = bf2f(p.AA[off]); a1[h] = bf2f(p.AA[(size_t)NTOK * RWW + off]); gg[h] = bf2f(p.G[off]);
    }
    const float* ao = p.AO + (size_t)tok * 512;
    const f32x4 v0 = *(const f32x4*)(ao + lane * 4), v1 = *(const f32x4*)(ao + 256 + lane * 4);
    float mean[8], var[8], sb[8];
#pragma unroll
    for (int h = 0; h < NH; ++h) mean[h] = wave_sum(o[h]) * (1.f / 64);
#pragma unroll
    for (int h = 0; h < NH; ++h) { float dv = o[h] - mean[h]; o[h] = dv; var[h] = wave_sum(dv * dv) * (1.f / 64); }
#pragma unroll
    for (int h = 0; h < NH; ++h) {
      float kb = 0.5f * (k[h] * (1.f + (a0[h] - 1.f) * pka[h]) + k[h] * (1.f + (a1[h] - 1.f) * pka[h]));
      sb[h] = wave_sum(r[h] * kb * prk[h]);
    }
#pragma unroll
    for (int h = 0; h < NH; ++h) {
      float on_ = o[h] * frsq(var[h] + GN_EPS) * plw[h] + plb[h];
      float y = (on_ + sb[h] * vv[h]) * gg[h];
      p.H[(size_t)tok * DM + h * 64 + lane] = f2bf(y);
    }
    float ss = v0[0] * v0[0] + v0[1] * v0[1] + v0[2] * v0[2] + v0[3] * v0[3] + v1[0] * v1[0] + v1[1] * v1[1] + v1[2] * v1[2] + v1[3] * v1[3];
    ss = wave_sum(ss);
    float rstd = frsq(ss * (1.f / 512) + NORM_EPS);
    *(u32x2*)(p.H + (size_t)tok * DM + 512 + lane * 4) = u32x2{pk2(v0[0] * rstd * g0[0], v0[1] * rstd * g0[1]), pk2(v0[2] * rstd * g0[2], v0[3] * rstd * g0[3])};
    *(u32x2*)(p.H + (size_t)tok * DM + 768 + lane * 4) = u32x2{pk2(v1[0] * rstd * g1[0], v1[1] * rstd * g1[1]), pk2(v1[2] * rstd * g1[2], v1[3] * rstd * g1[3])};
  }
}

DI void ph_norm_router(const P& p, int layer, char* smem) {
  const int tid_ = tidx(); const int lane = tid_ & 63, w = tid_ >> 6;
  float* rtl = (float*)smem;
  float* hl = (float*)(smem + 65536) + w * 1024;
  const float* g = p.ffn_norm + layer * DM;
  const float* rt = p.router + (size_t)layer * DM * NE;
  __syncthreads();
#pragma unroll
  for (int i = 0; i < 8; ++i) *(f32x4*)(rtl + (tid_ + i * NTH) * 4) = *(const f32x4*)(rt + (tid_ + i * NTH) * 4);
  __syncthreads();
  const int cg = lane >> 2, eq = lane & 3;
  for (int tok = blockIdx.x * 8 + w; tok < NTOK; tok += gridDim.x * 8) {
    const f32x4* xr = (const f32x4*)(p.out + (size_t)tok * DM);
    f32x4 v[4]; float ss = 0.f;
#pragma unroll
    for (int j = 0; j < 4; ++j) { v[j] = xr[lane + 64 * j]; ss += v[j][0] * v[j][0] + v[j][1] * v[j][1] + v[j][2] * v[j][2] + v[j][3] * v[j][3]; }
    ss = wave_sum(ss);
    const float rstd = frsq(ss * (1.f / DM) + NORM_EPS);
#pragma unroll
    for (int j = 0; j < 4; ++j) {
      const int c0 = (lane + 64 * j) * 4;
      const f32x4 gg = *(const f32x4*)(g + c0);
      const f32x4 hv = v[j] * rstd * gg;
      *(u32x2*)(p.H + (size_t)tok * DM + c0) = u32x2{pk2(hv[0], hv[1]), pk2(hv[2], hv[3])};
      *(f32x4*)(hl + c0) = hv;
    }
    f32x4 acc = f32x4{0.f, 0.f, 0.f, 0.f};
#pragma unroll 16
    for (int i = 0; i < 64; ++i) {
      const float hv = hl[cg + 16 * i];
      const f32x4 r4 = *(const f32x4*)(rtl + (cg + 16 * i) * 16 + eq * 4);
      acc += hv * r4;
    }
#pragma unroll
    for (int e = 0; e < 4; ++e) {
      float a = acc[e];
      a += dpp_f<0x124>(a); a += dpp_f<0x128>(a);
      a = red_x32(red_x16(a));
      acc[e] = a;
    }
    float mx = fmaxf(fmaxf(acc[0], acc[1]), fmaxf(acc[2], acc[3]));
    mx = fmaxf(mx, dpp_f<0xB1>(mx)); mx = fmaxf(mx, dpp_f<0x4E>(mx));
    f32x4 ex; float se = 0.f;
#pragma unroll
    for (int e = 0; e < 4; ++e) { ex[e] = fexp(acc[e] - mx); se += ex[e]; }
    se = red_x2(red_x1(se));
    const float inv = frcp(se);
    const int b = tok / T, t = tok % T;
    if (lane < 4) {
#pragma unroll
      for (int e = 0; e < 4; ++e) p.AFF[((size_t)(b * NE + eq * 4 + e)) * T + t] = ex[e] * inv;
    }
  }
}

DI void ph_topk(const P& p, char* smem) {
  unsigned* hist = (unsigned*)smem;
  unsigned* sc = hist + 256;
  unsigned* bc = sc + 2048;
  const int tid = tidx();
  for (int item = blockIdx.x; item < NB * NE; item += gridDim.x) {
    const float* a = p.AFF + (size_t)item * T;
    unsigned key[16];
#pragma unroll
    for (int i = 0; i < 4; ++i) {
      uint4 v = *(const uint4*)(a + tid * 16 + i * 4);
      key[i * 4 + 0] = v.x; key[i * 4 + 1] = v.y; key[i * 4 + 2] = v.z; key[i * 4 + 3] = v.w;
    }
    unsigned prefix = 0, mask = 0, need = CAP;
    for (int pass = 0; pass < 4; ++pass) {
      int shift = 24 - 8 * pass;
      __syncthreads();
      if (tid < 256) hist[tid] = 0;
      __syncthreads();
#pragma unroll
      for (int i = 0; i < 16; ++i)
        if ((key[i] & mask) == prefix) atomicAdd(&hist[(key[i] >> shift) & 255u], 1u);
      __syncthreads();
      if (tid == 0) {
        unsigned cum = 0; int bsel = 0; unsigned nd = need;
        for (int bb = 255; bb >= 0; --bb) {
          unsigned hc = hist[bb];
          if (cum + hc >= need) { bsel = bb; nd = need - cum; break; }
          cum += hc;
        }
        bc[0] = prefix | ((unsigned)bsel << shift); bc[1] = nd;
      }
      __syncthreads();
      prefix = bc[0]; need = bc[1]; mask |= (255u << shift);
    }
    unsigned ngt = 0, neq = 0;
#pragma unroll
    for (int i = 0; i < 16; ++i) { ngt += key[i] > prefix; neq += key[i] == prefix; }
    __syncthreads();
    unsigned* sA = sc; unsigned* sB = sc + 512; unsigned* eA = sc + 1024; unsigned* eB = sc + 1536;
    sA[tid] = ngt; eA[tid] = neq;
    __syncthreads();
    for (int off = 1; off < NTH; off <<= 1) {
      unsigned x = sA[tid] + ((tid >= off) ? sA[tid - off] : 0u);
      unsigned y = eA[tid] + ((tid >= off) ? eA[tid - off] : 0u);
      sB[tid] = x; eB[tid] = y;
      __syncthreads();
      unsigned* tmp = sA; sA = sB; sB = tmp; tmp = eA; eA = eB; eB = tmp;
    }
    unsigned gt_excl = sA[tid] - ngt, eq_excl = eA[tid] - neq;
    unsigned gt_total = sA[NTH - 1];
    int* idx = p.IDX + (size_t)item * CAP; float* gate = p.GATE + (size_t)item * CAP;
#pragma unroll
    for (int i = 0; i < 16; ++i) {
      int slot = -1;
      if (key[i] > prefix) { slot = (int)gt_excl; ++gt_excl; }
      else if (key[i] == prefix) { if (eq_excl < need) slot = (int)(gt_total + eq_excl); ++eq_excl; }
      if (slot >= 0) {
        const int tokl = tid * 16 + i;
        idx[slot] = tokl; gate[slot] = __uint_as_float(key[i]);
        const int tokg = (item / NE) * T + tokl;
        const int pos = atomicAdd(&p.TCNT[tokg], 1);
        p.TLIST[(size_t)tokg * 16 + pos] = item * CAP + slot;
      }
    }
    __syncthreads();
  }
}

DI void ph_exp1(const P& p, int layer, char* smem) {
  for (int t = blockIdx.x; t < 32 * 4 * 16; t += gridDim.x) {
    int grp = t / 64, r = t % 64, tm = r / 16, tn = r % 16;
    int b = grp / NE, e = grp % NE;
    const int* gi = p.IDX + (size_t)grp * CAP + tm * GBM;
    const u16* Hb = p.H + (size_t)b * T * DM;
    const float* Wg = p.exp_w_gate + ((size_t)layer * NE + e) * DM * 1024;
    const float* Wu = p.exp_w_up + ((size_t)layer * NE + e) * DM * 1024;
    u16* hid = p.HID + ((size_t)grp * CAP + tm * GBM) * 1024;
    auto arow = [&](int row) -> const void* { return Hb + (size_t)gi[row] * DM; };
    gemm_tile<false, 1>(arow, Wg, Wu, 1024, DM, tn * 64, 1024, smem, [&](int row, int col, float g, float u) {
      float sv = g * frcp(1.f + fexp(-g));
      hid[(size_t)row * 1024 + col] = f2bf(sv * u);
    });
    __syncthreads();
  }
}
DI void ph_exp2(const P& p, int layer, char* smem) {
  for (int t = blockIdx.x; t < 32 * 4 * 8; t += gridDim.x) {
    int grp = t / 32, r = t % 32, tm = r / 8, tn = r % 8;
    int b = grp / NE, e = grp % NE;
    const int* gi = p.IDX + (size_t)grp * CAP + tm * GBM;
    const float* gt = p.GATE + (size_t)grp * CAP + tm * GBM;
    const u16* hid = p.HID + ((size_t)grp * CAP + tm * GBM) * 1024;
    const float* Wd = p.exp_w_down + ((size_t)layer * NE + e) * 1024 * DM;
    float* xb = p.out + (size_t)b * T * DM;
    auto arow = [&](int row) -> const void* { return hid + (size_t)row * 1024; };
    gemm_tile<false, 0>(arow, Wd, nullptr, DM, 1024, tn * GBN, DM, smem, [&](int row, int col, float v, float) {
      unsafeAtomicAdd(xb + (size_t)gi[row] * DM + col, v * gt[row]);
    });
    __syncthreads();
  }
}

namespace g8 {
constexpr int BM = 256, BK = 64, HALF = 128, HTB = HALF * BK * 2, STAGE_BYTES = 8 * HTB, NXCD = 8, WGM = 8;
DI int lds_byte(int r, int c) { const int st = (r >> 4) * 2 + (c >> 5), rr = r & 15, cc = c & 31, ob = rr * 64 + cc * 2; return st * 1024 + (ob ^ (((ob >> 9) & 1) << 5)); }
DI void stage_rc(int b, int& R, int& C) { const int st = b / 1024, sb = b % 1024, swz = sb ^ (((sb >> 9) & 1) << 5); R = (st >> 1) * 16 + swz / 64; C = (st & 1) * 32 + (swz % 64) / 2; }
DI int perm32(int rho) { const int n = rho >> 4, i = rho & 15; return 8 * (i >> 2) + 4 * n + (i & 3); }
struct Unit { int pm, pn; };
struct Sched {
  int nM, nN, nwg, G, c;
  const char* A; const char* Bt; size_t a_tstep, b_tstep; int gdiv, gmod; size_t gstride;
  DI void init(int nM_, int nN_, int G_, int c_, const void* A_, const void* Bt_, int K) {
    nM = nM_; nN = nN_; nwg = nM * nN; G = G_; c = c_; A = (const char*)uni_ptr(A_); Bt = (const char*)uni_ptr(Bt_);
    a_tstep = (size_t)BM * K * 2; b_tstep = (size_t)BM * K * 2; gdiv = 1 << 30; gmod = 1; gstride = 0;
  }
  DI void group(int gdiv_, int gmod_, size_t gstride_) { gdiv = gdiv_; gmod = gmod_; gstride = gstride_; }
  DI bool next(int i, Unit& u) const {
    const long L = (long)i * G + c; if (L >= nwg) return false;
    int wgid = (int)L; { const int q = nwg / NXCD, r = nwg % NXCD, xcd = wgid % NXCD, off = wgid / NXCD; wgid = (xcd < r ? xcd * (q + 1) : r * (q + 1) + (xcd - r) * q) + off; }
    const int nig = WGM * nN, gid = wgid / nig, fm = gid * WGM, gsz = (nM - fm) < WGM ? (nM - fm) : WGM;
    u.pm = fm + ((wgid % nig) % gsz); u.pn = (wgid % nig) / gsz; return true;
  }
  DI const char* a_ptr(const Unit& u) const { return A + (size_t)u.pm * a_tstep; }
  DI const char* b_ptr(const Unit& u) const { return Bt + (size_t)((u.pm / gdiv) % gmod) * gstride + (size_t)u.pn * b_tstep; }
};
using Acc = f32x4[2][2][4][2];

template <class Epi>
DI void gemm_phase(LAS unsigned char* lds, const int K, const Sched& S, const Epi& E) {
  const int tid = tidx(), wid = __builtin_amdgcn_readfirstlane(tid >> 6), lane = tid & 63, wr = wid >> 2, wc = wid & 3, fr = lane & 15, fq = lane >> 4;
  const int nt = K / BK;
  unsigned voffA[2], voffB[2];
#pragma unroll
  for (int i = 0; i < 2; ++i) { int R, C; stage_rc(tid * 16 + i * 8192, R, C); const int Rb = Epi::PERM ? ((R & ~31) + perm32(R & 31)) : R;
    voffA[i] = (unsigned)(R * K + C) * 2u; voffB[i] = (unsigned)(Rb * K + C) * 2u; }
  const size_t kstep = (size_t)(BK * 2);
  const size_t hstep = (size_t)HALF * K * 2;
  const unsigned ldsw = (unsigned)wid * 1024u;
  const int aoff = lds_byte(wr * 64 + fr, fq * 8), boff = lds_byte(wc * 32 + fr, fq * 8);
#define G8_SA(b, h) (((b) * 2 + (h)) * HTB)
#define G8_SB(b, h) ((4 + (b) * 2 + (h)) * HTB)
#define G8_STAGE(bufoff, gbase, voff) do { _Pragma("unroll") for (int _i = 0; _i < 2; ++_i) \
    __builtin_amdgcn_global_load_lds((const unsigned*)((const char*)(gbase) + (voff)[_i]), (LAS unsigned*)(lds + (bufoff) + ldsw + _i * 8192), 16, 0, 0); } while (0)
#define G8_LDA(dst, b, h) do { _Pragma("unroll") for (int m = 0; m < 4; ++m) _Pragma("unroll") for (int k = 0; k < 2; ++k) dst[m][k] = *(const LAS bf16x8*)(lds + G8_SA(b, h) + aoff + m * 2048 + k * 1024); } while (0)
#define G8_LDB(dst, b, h) do { _Pragma("unroll") for (int n = 0; n < 2; ++n) _Pragma("unroll") for (int k = 0; k < 2; ++k) dst[n][k] = *(const LAS bf16x8*)(lds + G8_SB(b, h) + boff + n * 2048 + k * 1024); } while (0)
#define G8_MMA(ai, bj, At, Bt) do { __builtin_amdgcn_s_setprio(1); _Pragma("unroll") for (int m = 0; m < 4; ++m) _Pragma("unroll") for (int n = 0; n < 2; ++n) _Pragma("unroll") for (int k = 0; k < 2; ++k) \
    acc[ai][bj][m][n] = __builtin_amdgcn_mfma_f32_16x16x32_bf16(Bt[n][k], At[m][k], acc[ai][bj][m][n], 0, 0, 0); __builtin_amdgcn_s_setprio(0); } while (0)
#define G8_WAIT_V(n) asm volatile("s_waitcnt vmcnt(" #n ")" ::: "memory")
#define G8_WAIT_L(n) asm volatile("s_waitcnt lgkmcnt(" #n ")" ::: "memory")
#define G8_BAR __builtin_amdgcn_s_barrier()
#define G8_SCHED __builtin_amdgcn_sched_barrier(0)
  Unit cur, nxt; int ui = 0;
  if (!S.next(0, cur)) return;
  f32x4 acc[2][2][4][2];
#pragma unroll
  for (int a = 0; a < 2; ++a)
#pragma unroll
    for (int b = 0; b < 2; ++b)
#pragma unroll
      for (int m = 0; m < 4; ++m)
#pragma unroll
        for (int n = 0; n < 2; ++n) acc[a][b][m][n] = (f32x4){0.f, 0.f, 0.f, 0.f};
  bf16x8 At[4][2], B0[2][2], B1[2][2];
  const char* cA = S.a_ptr(cur); const char* cB = S.b_ptr(cur);
  G8_STAGE(G8_SB(0, 0), cB, voffB); G8_STAGE(G8_SA(0, 0), cA, voffA); G8_STAGE(G8_SB(0, 1), cB + hstep, voffB); G8_STAGE(G8_SA(0, 1), cA + hstep, voffA);
  if (wr == 1) G8_BAR;
  G8_WAIT_V(4); G8_BAR;
  G8_STAGE(G8_SB(1, 0), cB + kstep, voffB); G8_STAGE(G8_SA(1, 0), cA + kstep, voffA); G8_STAGE(G8_SB(1, 1), cB + hstep + kstep, voffB);
  G8_WAIT_V(6); G8_BAR;
  for (;;) {
    const bool has_next = S.next(ui + 1, nxt);
    const char* nA = has_next ? S.a_ptr(nxt) : cA; const char* nB = has_next ? S.b_ptr(nxt) : cB;
    for (int t = 0; t < nt; t += 2) {
      const bool last = (t == nt - 2);
      const char* a1 = cA + (size_t)(t + 1) * kstep;
      const char* a2 = last ? nA : cA + (size_t)(t + 2) * kstep; const char* b2 = last ? nB : cB + (size_t)(t + 2) * kstep;
      const char* a3 = a2 + kstep; const char* b3 = b2 + kstep;
      G8_LDB(B0, 0, 0); G8_SCHED; G8_LDA(At, 0, 0); G8_STAGE(G8_SA(1, 1), a1 + hstep, voffA);
      G8_WAIT_L(8); G8_BAR; G8_WAIT_L(0); G8_MMA(0, 0, At, B0); G8_BAR; G8_SCHED;
      G8_LDB(B1, 0, 1); G8_STAGE(G8_SB(0, 0), b2, voffB);
      G8_BAR; G8_WAIT_L(0); G8_MMA(0, 1, At, B1); G8_BAR;
      G8_LDA(At, 0, 1); G8_STAGE(G8_SA(0, 0), a2, voffA);
      G8_BAR; G8_WAIT_L(0); G8_MMA(1, 0, At, B0); G8_BAR; G8_SCHED;
      G8_STAGE(G8_SB(0, 1), b2 + hstep, voffB);
      G8_WAIT_V(6); G8_BAR; G8_MMA(1, 1, At, B1); G8_BAR;
      G8_LDB(B0, 1, 0); G8_SCHED; G8_LDA(At, 1, 0); G8_STAGE(G8_SA(0, 1), a2 + hstep, voffA);
      G8_WAIT_L(8); G8_BAR; G8_WAIT_L(0); G8_MMA(0, 0, At, B0); G8_BAR; G8_SCHED;
      G8_LDB(B1, 1, 1); G8_STAGE(G8_SB(1, 0), b3, voffB);
      G8_BAR; G8_WAIT_L(0); G8_MMA(0, 1, At, B1); G8_BAR;
      G8_LDA(At, 1, 1); G8_STAGE(G8_SA(1, 0), a3, voffA);
      G8_BAR; G8_WAIT_L(0); G8_MMA(1, 0, At, B0); G8_BAR; G8_SCHED;
      G8_STAGE(G8_SB(1, 1), b3 + hstep, voffB);
      G8_WAIT_V(6); G8_BAR; G8_MMA(1, 1, At, B1); G8_BAR;
    }
    {
      const int t2 = tidx(); const int w2 = __builtin_amdgcn_readfirstlane(t2 >> 6), l2 = t2 & 63;
      E(acc, cur, w2 >> 2, w2 & 3, l2 & 15, l2 >> 4);
    }
    if (!has_next) break;
#pragma unroll
    for (int a = 0; a < 2; ++a)
#pragma unroll
      for (int b = 0; b < 2; ++b)
#pragma unroll
        for (int m = 0; m < 4; ++m)
#pragma unroll
          for (int n = 0; n < 2; ++n) acc[a][b][m][n] = (f32x4){0.f, 0.f, 0.f, 0.f};
    cur = nxt; cA = nA; cB = nB; ++ui;
  }
  G8_WAIT_V(0);
  if (wr == 0) G8_BAR;
  G8_BAR;
#undef G8_SA
#undef G8_SB
#undef G8_STAGE
#undef G8_LDA
#undef G8_LDB
#undef G8_MMA
#undef G8_WAIT_V
#undef G8_WAIT_L
#undef G8_BAR
#undef G8_SCHED
}

struct EpiZ {
  static constexpr bool PERM = false; float* Z;
  DI void operator()(const Acc& acc, const Unit& u, int wr, int wc, int fr, int fq) const {
    const int row0 = u.pm * BM + wr * 64 + fr, col0 = u.pn * BM + wc * 32 + 4 * fq;
#pragma unroll
    for (int ai = 0; ai < 2; ++ai)
#pragma unroll
      for (int m = 0; m < 4; ++m) { float* rowp = Z + (size_t)(row0 + ai * HALF + m * 16) * INC;
#pragma unroll
        for (int bj = 0; bj < 2; ++bj)
#pragma unroll
          for (int n = 0; n < 2; ++n) { const int col = col0 + bj * HALF + n * 16; if (col < INC) *(f32x4*)(rowp + col) = acc[ai][bj][m][n]; } }
  }
};
struct EpiRes {
  static constexpr bool PERM = false; const float* xs; float* xo;
  DI void operator()(const Acc& acc, const Unit& u, int wr, int wc, int fr, int fq) const {
    const int row0 = u.pm * BM + wr * 64 + fr, col0 = u.pn * BM + wc * 32 + 4 * fq;
#pragma unroll
    for (int ai = 0; ai < 2; ++ai)
#pragma unroll
      for (int m = 0; m < 4; ++m) { const size_t ro = (size_t)(row0 + ai * HALF + m * 16) * DM + col0;
#pragma unroll
        for (int bj = 0; bj < 2; ++bj)
#pragma unroll
          for (int n = 0; n < 2; ++n) { const size_t o = ro + bj * HALF + n * 16; *(f32x4*)(xo + o) = *(const f32x4*)(xs + o) + acc[ai][bj][m][n]; } }
  }
};
struct EpiSig {
  static constexpr bool PERM = true; u16* PG;
  DI void operator()(const Acc& acc, const Unit& u, int wr, int wc, int fr, int fq) const {
    const int row0 = u.pm * BM + wr * 64 + fr, col0 = u.pn * BM + wc * 32 + 8 * fq;
#pragma unroll
    for (int ai = 0; ai < 2; ++ai)
#pragma unroll
      for (int m = 0; m < 4; ++m) { u16* rowp = PG + (size_t)(row0 + ai * HALF + m * 16) * DM + col0;
#pragma unroll
        for (int bj = 0; bj < 2; ++bj) { const f32x4 v0 = acc[ai][bj][m][0], v1 = acc[ai][bj][m][1];
          u32x4 wv = {pk2(sigmoidf_(v0[0]), sigmoidf_(v0[1])), pk2(sigmoidf_(v0[2]), sigmoidf_(v0[3])), pk2(sigmoidf_(v1[0]), sigmoidf_(v1[1])), pk2(sigmoidf_(v1[2]), sigmoidf_(v1[3]))};
          *(u32x4*)(rowp + bj * HALF) = wv; } }
  }
};
struct EpiPle {
  static constexpr bool PERM = false; float* xo; const u16* PG;
  DI void operator()(const Acc& acc, const Unit& u, int wr, int wc, int fr, int fq) const {
    const int row0 = u.pm * BM + wr * 64 + fr, col0 = u.pn * BM + wc * 32 + 4 * fq;
#pragma unroll
    for (int ai = 0; ai < 2; ++ai)
#pragma unroll
      for (int m = 0; m < 4; ++m) { const size_t ro = (size_t)(row0 + ai * HALF + m * 16) * DM + col0;
#pragma unroll
        for (int bj = 0; bj < 2; ++bj)
#pragma unroll
          for (int n = 0; n < 2; ++n) { const size_t o = ro + bj * HALF + n * 16; const u32x2 g = *(const u32x2*)(PG + o);
            f32x4 gv = {__uint_as_float(g[0] << 16), __uint_as_float(g[0] & 0xffff0000u), __uint_as_float(g[1] << 16), __uint_as_float(g[1] & 0xffff0000u)};
            *(f32x4*)(xo + o) = *(const f32x4*)(xo + o) + acc[ai][bj][m][n] * gv; } }
  }
};
struct EpiSwi {
  static constexpr bool PERM = true; u16* HID;
  DI void operator()(const Acc& acc, const Unit& u, int wr, int wc, int fr, int fq) const {
    const int row0 = u.pm * BM + wr * 64 + fr, col0 = u.pn * HALF + wc * 32 + 8 * fq;
#pragma unroll
    for (int ai = 0; ai < 2; ++ai)
#pragma unroll
      for (int m = 0; m < 4; ++m) { u16* rowp = HID + (size_t)(row0 + ai * HALF + m * 16) * 1024 + col0;
        float h[8];
#pragma unroll
        for (int n = 0; n < 2; ++n)
#pragma unroll
          for (int j = 0; j < 4; ++j) { const float gt = acc[ai][0][m][n][j], up = acc[ai][1][m][n][j]; h[n * 4 + j] = gt * frcp(1.f + fexp(-gt)) * up; }
        *(u32x4*)rowp = u32x4{pk2(h[0], h[1]), pk2(h[2], h[3]), pk2(h[4], h[5]), pk2(h[6], h[7])}; }
  }
};
struct EpiYE {
  static constexpr bool PERM = true; u16* YE; const float* GATE;
  DI void operator()(const Acc& acc, const Unit& u, int wr, int wc, int fr, int fq) const {
    const int row0 = u.pm * BM + wr * 64 + fr, col0 = u.pn * BM + wc * 32 + 8 * fq;
#pragma unroll
    for (int ai = 0; ai < 2; ++ai)
#pragma unroll
      for (int m = 0; m < 4; ++m) { const int row = row0 + ai * HALF + m * 16; const float gt = GATE[row]; u16* rowp = YE + (size_t)row * 1024 + col0;
#pragma unroll
        for (int bj = 0; bj < 2; ++bj) { const f32x4 v0 = acc[ai][bj][m][0] * gt, v1 = acc[ai][bj][m][1] * gt;
          *(u32x4*)(rowp + bj * HALF) = u32x4{pk2(v0[0], v0[1]), pk2(v0[2], v0[3]), pk2(v1[0], v1[1]), pk2(v1[2], v1[3])}; } }
  }
};
}

DI void cvt_tile_T(const float* __restrict__ src, int ldsrc, int N, int K, u16* __restrict__ dst, int k0, int n0, int drow0, char* smem, int tid) {
  short* tl = (short*)smem;
  __syncthreads();
#pragma unroll
  for (int i = 0; i < 2; ++i) {
    int u = tid + i * NTH; int kr = u >> 4, nq = u & 15; int n = n0 + nq * 4;
    f32x4 v = f32x4{0.f, 0.f, 0.f, 0.f};
    if (n < N) v = *(const f32x4*)(src + (size_t)(k0 + kr) * ldsrc + n);
#pragma unroll
    for (int e = 0; e < 4; ++e) tl[(nq * 4 + e) * 72 + kr] = (short)f2bf(v[e]);
  }
  __syncthreads();
  { int n = tid >> 3, kc = tid & 7;
    *(u32x4*)(dst + (size_t)(drow0 + n) * K + k0 + kc * 8) = *(const u32x4*)(tl + n * 72 + kc * 8); }
}
constexpr int WIN_PAD = 2560;
DI void ph_cvt_small(const P& p, int layer, char* smem) {
  const int tid = tidx();
  const int t0 = 16 * 40, t1 = t0 + 256, t2 = t1 + 256, t3 = t2 + 64;
  for (int t = blockIdx.x; t < t3; t += gridDim.x) {
    if (t < t0) cvt_tile_T(p.w_in + (size_t)layer * DM * INC, INC, INC, DM, p.WIN, (t / 40) * 64, (t % 40) * 64, (t % 40) * 64, smem, tid);
    else if (t < t1) { int q = t - t0; cvt_tile_T(p.w_out + (size_t)layer * DM * DM, DM, DM, DM, p.WOUT, (q / 16) * 64, (q % 16) * 64, (q % 16) * 64, smem, tid); }
    else if (t < t2) { int q = t - t1; cvt_tile_T(p.ple_gate + (size_t)layer * DM * DM, DM, DM, DM, p.WPG, (q / 16) * 64, (q % 16) * 64, (q % 16) * 64, smem, tid); }
    else { int q = t - t2; cvt_tile_T(p.ple_proj + (size_t)layer * DPLE * DM, DM, DM, DPLE, p.WPP, (q / 16) * 64, (q % 16) * 64, (q % 16) * 64, smem, tid); }
  }
  const float* ps = p.p + (size_t)layer * NTOK * DPLE;
  for (int i = blockIdx.x * NTH + tid; i < NTOK * DPLE / 8; i += gridDim.x * NTH) {
    f32x4 a = *(const f32x4*)(ps + (size_t)i * 8), b = *(const f32x4*)(ps + (size_t)i * 8 + 4);
    *(u32x4*)(p.PB + (size_t)i * 8) = u32x4{pk2(a[0], a[1]), pk2(a[2], a[3]), pk2(b[0], b[1]), pk2(b[2], b[3])};
  }
}

struct CvtJob { const float* src; u16* dst; int k0, n0, drow0; };
DI bool cvt_job(const P& p, int layer, int t, CvtJob& j) {
  if (t >= NE * 3 * 128) return false;
  const int e = t / 384, r = t % 384, mat = r / 128, q = r % 128;
  j.k0 = (q / 8) * 64; j.n0 = (q % 8) * 128;
  const size_t eo = ((size_t)layer * NE + e) * 1024 * 1024;
  if (mat == 0) { j.src = p.exp_w_gate + eo; j.dst = p.EW1 + (size_t)e * 2048 * 1024; j.drow0 = (j.n0 >> 7) * 256; }
  else if (mat == 1) { j.src = p.exp_w_up + eo; j.dst = p.EW1 + (size_t)e * 2048 * 1024; j.drow0 = (j.n0 >> 7) * 256 + 128; }
  else { j.src = p.exp_w_down + eo; j.dst = p.EW2 + (size_t)e * 1024 * 1024; j.drow0 = j.n0; }
  return true;
}
DI void ph_cvt_experts(const P& p, int layer, char* smem, unsigned* ctr) {
  const int tid = tidx();
  short* tl = (short*)smem;
  int* sitem = (int*)(smem + 32768);
  __syncthreads();
  if (tid == 0) sitem[0] = (int)atomicAdd(ctr, 1u);
  __syncthreads();
  CvtJob cur; bool has = cvt_job(p, layer, sitem[0], cur);
  f32x4 v[4];
  const int kr = tid >> 5, nq = tid & 31;
  if (has) {
#pragma unroll
    for (int i = 0; i < 4; ++i) v[i] = *(const f32x4*)(cur.src + (size_t)(cur.k0 + kr + 16 * i) * 1024 + cur.n0 + nq * 4);
  }
  int par = 0;
  while (has) {
    if (tid == 0) sitem[1 + par] = (int)atomicAdd(ctr, 1u);
    __syncthreads();
#pragma unroll
    for (int i = 0; i < 4; ++i)
#pragma unroll
      for (int e = 0; e < 4; ++e) tl[(nq * 4 + e) * 72 + kr + 16 * i] = (short)f2bf(v[i][e]);
    __syncthreads();
    CvtJob nxt; const bool hn = cvt_job(p, layer, sitem[1 + par], nxt);
    if (hn) {
#pragma unroll
      for (int i = 0; i < 4; ++i) v[i] = *(const f32x4*)(nxt.src + (size_t)(nxt.k0 + kr + 16 * i) * 1024 + nxt.n0 + nq * 4);
    }
#pragma unroll
    for (int i = 0; i < 2; ++i) {
      int u = tid + i * NTH; int n = u >> 3, kc = u & 7;
      *(u32x4*)(cur.dst + (size_t)(cur.drow0 + n) * 1024 + cur.k0 + kc * 8) = *(const u32x4*)(tl + n * 72 + kc * 8);
    }
    cur = nxt; has = hn; par ^= 1;
  }
}
DI void ph_gather(const P& p) {
  const int tid_ = tidx(); const int lane = tid_ & 63, w = tid_ >> 6;
  for (int row = blockIdx.x * 8 + w; row < NB * NE * CAP; row += gridDim.x * 8) {
    const int b = row / (NE * CAP);
    const int tok = b * T + p.IDX[row];
    const u32x4* src = (const u32x4*)(p.H + (size_t)tok * DM);
    u32x4* dst = (u32x4*)(p.XE + (size_t)row * DM);
    u32x4 a = src[lane], c = src[lane + 64];
    dst[lane] = a; dst[lane + 64] = c;
  }
}
DI void ph_combine_norm(const P& p, int layer) {
  const int tid_ = tidx(); const int lane = tid_ & 63, w = tid_ >> 6;
  const float* g = p.ple_norm + layer * DM;
  for (int tok = blockIdx.x * 8 + w; tok < NTOK; tok += gridDim.x * 8) {
    f32x4* xr = (f32x4*)(p.out + (size_t)tok * DM);
    f32x4 v[4];
#pragma unroll
    for (int j = 0; j < 4; ++j) v[j] = xr[lane * 4 + j];
    const int cnt = p.TCNT[tok];
    for (int q = 0; q < cnt; ++q) {
      const int yrow = p.TLIST[(size_t)tok * 16 + q];
      const u32x4* yr = (const u32x4*)(p.YE + (size_t)yrow * DM + lane * 16);
      u32x4 a = yr[0], c = yr[1];
#pragma unroll
      for (int e = 0; e < 4; ++e) {
        v[e >> 1][(e & 1) * 2] += __uint_as_float(a[e] << 16); v[e >> 1][(e & 1) * 2 + 1] += __uint_as_float(a[e] & 0xffff0000u);
        v[2 + (e >> 1)][(e & 1) * 2] += __uint_as_float(c[e] << 16); v[2 + (e >> 1)][(e & 1) * 2 + 1] += __uint_as_float(c[e] & 0xffff0000u);
      }
    }
    float ss = 0.f;
#pragma unroll
    for (int j = 0; j < 4; ++j) { xr[lane * 4 + j] = v[j]; ss += v[j][0] * v[j][0] + v[j][1] * v[j][1] + v[j][2] * v[j][2] + v[j][3] * v[j][3]; }
    ss = wave_sum(ss);
    const float rstd = frsq(ss * (1.f / DM) + NORM_EPS);
    u32x4 o0, o1;
#pragma unroll
    for (int j = 0; j < 4; ++j) {
      f32x4 gg = *(const f32x4*)(g + lane * 16 + j * 4);
      unsigned lo = pk2(v[j][0] * rstd * gg[0], v[j][1] * rstd * gg[1]), hi = pk2(v[j][2] * rstd * gg[2], v[j][3] * rstd * gg[3]);
      if (j < 2) { o0[j * 2] = lo; o0[j * 2 + 1] = hi; } else { o1[(j - 2) * 2] = lo; o1[(j - 2) * 2 + 1] = hi; }
    }
    *(u32x4*)(p.H + (size_t)tok * DM + lane * 16) = o0; *(u32x4*)(p.H + (size_t)tok * DM + lane * 16 + 8) = o1;
  }
}

#define XB_TMO      128
#define XB_XCNT(j)  (256  + 64 * (j))
#define XB_XSUB(j)  (1280 + 64 * (j))
#define XB_XGEN(j)  (2304 + 64 * (j))
#define XB_TOP      3328
#define XB_TOPGEN   3392
#define XCD_BAR_WORDS 3456
#define XB_SPIN_CAP (1u << 20)
DI unsigned xb_ld(unsigned* p) { return __hip_atomic_load(p, __ATOMIC_RELAXED, __HIP_MEMORY_SCOPE_AGENT); }
DI unsigned xb_add(unsigned* p, unsigned v) { return __hip_atomic_fetch_add(p, v, __ATOMIC_RELAXED, __HIP_MEMORY_SCOPE_AGENT); }
DI unsigned xb_xcc_id() { return (unsigned)__builtin_amdgcn_s_getreg((3 << 11) | 20) & 0xFu; }
#define XB_SPIN(cond, bar) do { unsigned _sp = 0; while (cond) { __builtin_amdgcn_s_sleep(1); \
    if ((++_sp & 255u) == 0u) { if (xb_ld(&(bar)[XB_TMO])) break; if (_sp > XB_SPIN_CAP) { atomicAdd(&(bar)[XB_TMO], 1u); break; } } } } while (0)
struct XcdBarrier { unsigned* bar; unsigned x; volatile LAS unsigned* st; };
DI XcdBarrier xcd_barrier_post(unsigned* bar, volatile LAS unsigned* st) {
  XcdBarrier b; b.bar = bar; b.x = xb_xcc_id(); b.st = st;
  if (threadIdx.x == 0) (void)xb_add(&bar[XB_XCNT(b.x)], 1u);
  return b;
}
DI void xcd_barrier_complete(unsigned* bar, unsigned x, unsigned& nloc, unsigned& nx) {
  const unsigned G = gridDim.x * gridDim.y * gridDim.z;
  unsigned sum, cnt, mine, sp = 0u;
  for (;;) {
    sum = 0u; cnt = 0u; mine = 0u;
#pragma unroll
    for (unsigned j = 0; j < 16; ++j) { const unsigned c = xb_ld(&bar[XB_XCNT(j)]); sum += c; cnt += (c > 0u) ? 1u : 0u; mine = (j == x) ? c : mine; }
    if (sum == G) break;
    __builtin_amdgcn_s_sleep(1);
    if ((++sp & 255u) == 0u) { if (xb_ld(&bar[XB_TMO])) break; if (sp > XB_SPIN_CAP) { atomicAdd(&bar[XB_TMO], 1u); break; } }
  }
  nloc = mine > 0u ? mine : 1u; nx = cnt > 0u ? cnt : 1u;
}
DI void xcd_barrier(const XcdBarrier& b) {
  asm volatile("s_waitcnt vmcnt(0)" ::: "memory");
  __syncthreads();
  if (threadIdx.x == 0) {
    unsigned* bar = b.bar;
    __builtin_amdgcn_s_waitcnt(0);
    unsigned nloc = b.st[0], nx = b.st[1];
    if (nloc == 0u) { xcd_barrier_complete(bar, b.x, nloc, nx); b.st[0] = nloc; b.st[1] = nx; }
    const unsigned old = xb_add(&bar[XB_XSUB(b.x)], 1u);
    const unsigned gen = old / nloc;
    if (old + 1u == (gen + 1u) * nloc) {
      __builtin_amdgcn_fence(__ATOMIC_RELEASE, "agent");
      asm volatile("s_waitcnt vmcnt(0)" ::: "memory");
      const unsigned og = xb_add(&bar[XB_TOP], 1u);
      const unsigned tg = og / nx;
      if (og + 1u == (tg + 1u) * nx) xb_add(&bar[XB_TOPGEN], 1u);
      else XB_SPIN(xb_ld(&bar[XB_TOPGEN]) == tg, bar);
      __builtin_amdgcn_fence(__ATOMIC_ACQUIRE, "agent");
      xb_add(&bar[XB_XGEN(b.x)], 1u);
      asm volatile("s_waitcnt vmcnt(0)" ::: "memory");
    } else {
      XB_SPIN(xb_ld(&bar[XB_XGEN(b.x)]) == gen, bar);
      __builtin_amdgcn_fence(__ATOMIC_ACQUIRE, "agent");
      asm volatile("s_waitcnt vmcnt(0)" ::: "memory");
    }
  }
  __syncthreads();
}

#define TAKE(bytes) (ws + off); off += (((size_t)(bytes)) + 255) & ~(size_t)255
__host__ __device__ inline size_t fill_ws(P& p, char* ws) {
  size_t off = 0;
  char* regA = TAKE((size_t)NTOK * INC * 4);
  p.Z = (float*)regA;
  p.LW = (u16*)regA; p.AA = (u16*)(regA + (size_t)2 * NTOK * RWW * 2); p.G = (u16*)(regA + (size_t)4 * NTOK * RWW * 2);
  p.MC = (float*)(regA + (size_t)5 * NTOK * RWW * 2); p.NC = p.MC + (size_t)32 * NCH * 4096;
  p.HID = (u16*)regA;
  char* regB = TAKE((size_t)3 * NTOK * RWW * 4);
  p.R = (float*)regB; p.K = p.R + (size_t)NTOK * RWW; p.V = p.K + (size_t)NTOK * RWW;
  p.PG = (float*)regB;
  char* regC = TAKE((size_t)NTOK * (768 + 1024) * 4);
  p.QRAW = (float*)regC; p.KVRAW = p.QRAW + (size_t)NTOK * 768;
  p.AO = (float*)regC; p.O2 = (u16*)(p.AO + (size_t)NTOK * 512); p.SS = (float*)(p.O2 + (size_t)2 * NTOK * 512);
  p.TWD = (u16*)TAKE((size_t)2 * NTOK * 64 * 2); p.AD = (u16*)TAKE((size_t)2 * NTOK * 64 * 2);
  p.SGD = (u16*)TAKE((size_t)NTOK * 128 * 2); p.QDN = (u16*)TAKE((size_t)NTOK * 256 * 2);
  p.KVDN = (u16*)TAKE((size_t)NTOK * 128 * 2); p.KR = (float*)TAKE((size_t)NTOK * 32 * 4);
  p.ROPE = (float*)TAKE((size_t)NTOK * 32 * 4);
  p.Q = (u16*)TAKE((size_t)NTOK * NH * 96 * 2); p.Kc = (u16*)TAKE((size_t)NTOK * NH * 96 * 2);
  p.Vv = (u16*)TAKE((size_t)NTOK * NH * 64 * 2);
  p.H = (u16*)TAKE((size_t)NTOK * DM * 2);
  p.AFF = (float*)TAKE((size_t)NB * NE * T * 4);
  p.IDX = (int*)TAKE((size_t)NB * NE * CAP * 4);
  p.GATE = (float*)TAKE((size_t)NB * NE * CAP * 4);

  p.WIN = (u16*)TAKE((size_t)WIN_PAD * DM * 2); p.WOUT = (u16*)TAKE((size_t)DM * DM * 2); p.WPG = (u16*)TAKE((size_t)DM * DM * 2);
  p.WPP = (u16*)TAKE((size_t)DM * DPLE * 2); p.PB = (u16*)TAKE((size_t)NTOK * DPLE * 2);
  p.PGb = (u16*)regB;
  p.EW1 = (u16*)regB; p.EW2 = p.EW1 + (size_t)NE * 2048 * 1024;
  p.XE = (u16*)regA; p.HID = (u16*)(regA + (size_t)32 * 1024 * 1024 * 2);
  p.YE = (u16*)regC;
  p.TCNT = (int*)TAKE((size_t)NTOK * 4); p.TLIST = (int*)TAKE((size_t)NTOK * 16 * 4);
  p.CTR = (unsigned*)TAKE(256);
  p.BAR = (unsigned*)TAKE(XCD_BAR_WORDS * 4);
  return off;
}
#undef TAKE
constexpr int DSM_BYTES = g8::STAGE_BYTES + 64;
extern __shared__ __attribute__((aligned(16))) char dsm[];
struct PK { const void* in[31]; float* out; char* ws; };
DI void build_params(P& p, const PK& k) {
  p.x = (const float*)k.in[0]; p.p = (const float*)k.in[1]; p.pos = (const int*)k.in[2];
  p.attn_norm = (const float*)k.in[3]; p.w_in = (const float*)k.in[4]; p.rw_mu = (const float*)k.in[5];
  p.rw_w0 = (const float*)k.in[6]; p.rw_w_up = (const float*)k.in[7]; p.rw_a0 = (const float*)k.in[8];
  p.rw_a_up = (const float*)k.in[9]; p.rw_g_up = (const float*)k.in[10]; p.rw_k_k = (const float*)k.in[11];
  p.rw_k_a = (const float*)k.in[12]; p.rw_r_k = (const float*)k.in[13]; p.rw_lnx_w = (const float*)k.in[14];
  p.rw_lnx_b = (const float*)k.in[15]; p.mla_q_norm = (const float*)k.in[16]; p.mla_q_up = (const float*)k.in[17];
  p.mla_kv_norm = (const float*)k.in[18]; p.mla_kv_up = (const float*)k.in[19]; p.mla_o_norm = (const float*)k.in[20];
  p.w_out = (const float*)k.in[21]; p.ffn_norm = (const float*)k.in[22]; p.router = (const float*)k.in[23];
  p.exp_w_gate = (const float*)k.in[24]; p.exp_w_up = (const float*)k.in[25]; p.exp_w_down = (const float*)k.in[26];
  p.ple_norm = (const float*)k.in[27]; p.ple_proj = (const float*)k.in[28]; p.ple_gate = (const float*)k.in[29];
  p.final_norm = (const float*)k.in[30];
  p.out = k.out;
  (void)fill_ws(p, k.ws);
}
__global__ void __launch_bounds__(NTH) mega(PK pk) {
  P p; build_params(p, pk);
  char* smem = dsm;
  LAS unsigned char* glds = (LAS unsigned char*)dsm;
  uint4* xbw = (uint4*)(dsm + g8::STAGE_BYTES);
  cg::grid_group grid = cg::this_grid();
  if (threadIdx.x == 0) *xbw = make_uint4(0u, 0u, 0u, 0u);
  if (blockIdx.x == 0) {
    if (threadIdx.x < 16) p.CTR[threadIdx.x] = 0u;
    for (int i = threadIdx.x; i < XCD_BAR_WORDS; i += NTH) p.BAR[i] = 0u;
  }
  grid.sync();
  const XcdBarrier xb = xcd_barrier_post(p.BAR, (volatile LAS unsigned*)xbw);
#define GSYNC() xcd_barrier(xb)
#ifndef PROBE_MASK
#define PROBE_MASK 0u
#endif
#if PROBE_MASK
  unsigned long long pt0 = __builtin_amdgcn_s_memrealtime();
#define PSYNC(id) do { GSYNC(); if (PROBE_MASK & (1u << (id))) { unsigned long long t1_ = __builtin_amdgcn_s_memrealtime(); unsigned long long dt_ = t1_ - pt0; \
    while (__builtin_amdgcn_s_memrealtime() - t1_ < dt_) __builtin_amdgcn_s_sleep(8); } pt0 = __builtin_amdgcn_s_memrealtime(); } while (0)
#else
#define PSYNC(id) GSYNC()
#endif
  for (int layer_ = 0; layer_ < NL; ++layer_) {
    int layer = layer_; asm volatile("" : "+s"(layer));
    if (layer_ == 0) ph_rope_table(p);
    ph_cvt_small(p, layer, smem);
    ph_norm(layer == 0 ? p.x : p.out, p.attn_norm + layer * DM, p.H);
    PSYNC(0);
    {
      g8::Sched S; S.init(NTOK / 256, WIN_PAD / 256, gridDim.x, bidx(), p.H, p.WIN, DM);
      g8::EpiZ E{p.Z};
      g8::gemm_phase(glds, DM, S, E);
    }
    PSYNC(1);
    ph_rwshift(p, layer);
    ph_mlaprep1(p, layer);
    PSYNC(2);
    for (int d = 0; d < 2; ++d) {
      u16* LW = p.LW + (size_t)d * NTOK * RWW; const float* w0 = p.rw_w0 + (layer * 2 + d) * RWW;
      ph_gemm<false>(p.TWD + (size_t)d * NTOK * 64, 64, p.rw_w_up + ((size_t)(layer * 2 + d)) * 64 * RWW, RWW, NTOK, RWW, 64, smem,
                     [&](int row, int col, float v) { LW[(size_t)row * RWW + col] = f2bf(-0.6065306597126334f * sigmoidf_(v + w0[col])); });
      u16* AA = p.AA + (size_t)d * NTOK * RWW; const float* a0 = p.rw_a0 + (layer * 2 + d) * RWW;
      ph_gemm<false>(p.AD + (size_t)d * NTOK * 64, 64, p.rw_a_up + ((size_t)(layer * 2 + d)) * 64 * RWW, RWW, NTOK, RWW, 64, smem,
                     [&](int row, int col, float v) { AA[(size_t)row * RWW + col] = f2bf(sigmoidf_(v + a0[col])); });
    }
    {
      u16* G = p.G;
      ph_gemm<false>(p.SGD, 128, p.rw_g_up + (size_t)layer * 128 * RWW, RWW, NTOK, RWW, 128, smem,
                     [&](int row, int col, float v) { G[(size_t)row * RWW + col] = f2bf(v); });
      {
        u16* Qo = p.Q; const float* rope = p.ROPE;
        ph_gemm_t(p.QDN, 256, p.mla_q_up + (size_t)layer * 256 * 768, 768, NTOK, 768, 256, smem,
                  [&](const f32x4 (&acc)[4][4], int m0, int n0, int wm, int wn, int lq, int l15) {
          const float qs = 0.10206207261596577f * 1.4426950408889634f;
#pragma unroll
          for (int mi = 0; mi < 4; ++mi)
#pragma unroll
            for (int r = 0; r < 4; ++r) {
              const int tok = m0 + wm * 64 + mi * 16 + lq * 4 + r; const int b = tok / T, t = tok % T;
#pragma unroll
              for (int ni = 0; ni < 4; ++ni) {
                const int col0 = n0 + wn * 64 + ni * 16; const int h = col0 / 96, c0 = col0 % 96;
                u16* qo = Qo + ((size_t)(b * NH + h) * T + t) * 96;
                if (c0 < 64) qo[c0 + l15] = f2bf(acc[mi][ni][r] * qs);
                else if (c0 == 64) {
                  const f32x2 csn = *(const f32x2*)(rope + (size_t)tok * 32 + l15 * 2);
                  const float u1 = acc[mi][ni][r], u2 = acc[mi][(ni + 1) & 3][r];
                  qo[64 + l15] = f2bf((u1 * csn[0] - u2 * csn[1]) * qs);
                  qo[80 + l15] = f2bf((u1 * csn[1] + u2 * csn[0]) * qs);
                }
              }
            }
        });
      }
      {
        u16* Ko = p.Kc; u16* Vo = p.Vv;
        ph_gemm_t(p.KVDN, 128, p.mla_kv_up + (size_t)layer * 128 * 1024, 1024, NTOK, 1024, 128, smem,
                  [&](const f32x4 (&acc)[4][4], int m0, int n0, int wm, int wn, int lq, int l15) {
#pragma unroll
          for (int mi = 0; mi < 4; ++mi)
#pragma unroll
            for (int r = 0; r < 4; ++r) {
              const int tok = m0 + wm * 64 + mi * 16 + lq * 4 + r; const int b = tok / T, t = tok % T;
#pragma unroll
              for (int ni = 0; ni < 4; ++ni) {
                const int col0 = n0 + wn * 64 + ni * 16; const int h = col0 >> 7, c0 = col0 & 127;
                const size_t rowi = (size_t)(b * NH + h) * T + t;
                if (c0 < 64) Ko[rowi * 96 + c0 + l15] = f2bf(acc[mi][ni][r]);
                else Vo[rowi * 64 + (c0 - 64) + l15] = f2bf(acc[mi][ni][r]);
              }
            }
        });
      }
    }
    PSYNC(3);
    ph_scan1(p, layer, smem);
    PSYNC(4);
    ph_scan2(p, smem);
    ph_attn(p, smem, p.CTR + layer);
    PSYNC(5);
    ph_scan3(p, layer, smem);
    PSYNC(6);
    ph_mixfinish(p, layer);
    PSYNC(7);
    {
      for (int i = blockIdx.x * NTH + tidx(); i < NTOK; i += gridDim.x * NTH) p.TCNT[i] = 0;
      g8::Sched S; S.init(NTOK / 256, DM / 256, gridDim.x, bidx(), p.H, p.WOUT, DM);
      g8::EpiRes E{(layer == 0) ? p.x : p.out, p.out};
      g8::gemm_phase(glds, DM, S, E);
    }
    PSYNC(8);
    ph_norm_router(p, layer, smem);
    PSYNC(9);
    ph_topk(p, smem);
    ph_cvt_experts(p, layer, smem, p.CTR + 4 + layer);
    PSYNC(10);
    ph_gather(p);
    PSYNC(11);
    {
      g8::Sched S; S.init(NB * NE * CAP / 256, 2048 / 256, gridDim.x, bidx(), p.XE, p.EW1, DM);
      S.group(4, NE, (size_t)2048 * 1024 * 2);
      g8::EpiSwi E{p.HID};
      g8::gemm_phase(glds, DM, S, E);
    }
    PSYNC(12);
    {
      g8::Sched S; S.init(NB * NE * CAP / 256, DM / 256, gridDim.x, bidx(), p.HID, p.EW2, 1024);
      S.group(4, NE, (size_t)1024 * 1024 * 2);
      g8::EpiYE E{p.YE, p.GATE};
      g8::gemm_phase(glds, 1024, S, E);
    }
    PSYNC(13);
    ph_combine_norm(p, layer);
    PSYNC(16);
    {
      g8::Sched S; S.init(NTOK / 256, DM / 256, gridDim.x, bidx(), p.H, p.WPG, DM);
      g8::EpiSig E{p.PGb};
      g8::gemm_phase(glds, DM, S, E);
    }
    {
      g8::Sched S; S.init(NTOK / 256, DM / 256, gridDim.x, bidx(), p.PB, p.WPP, DPLE);
      g8::EpiPle E{p.out, p.PGb};
      g8::gemm_phase(glds, DPLE, S, E);
    }
    PSYNC(15);
  }
  ph_final_norm(p.out, p.final_norm);
}

extern "C" void kernel_launch(void* const* d_in, const int* in_sizes, int n_in, void* d_out, int out_size, void* d_ws,
                              size_t ws_size, hipStream_t stream) {
  (void)in_sizes; (void)n_in; (void)out_size;
  PK pk{};
  for (int i = 0; i < 31; ++i) pk.in[i] = d_in[i];
  pk.out = (float*)d_out; pk.ws = (char*)d_ws;
  P p{};
  const size_t off = fill_ws(p, (char*)d_ws);
  if (off > ws_size) { fprintf(stderr, "workspace too small: need %zu have %zu\n", off, ws_size); return; }
  static int grid_blocks = 0;
  if (!grid_blocks) {
    int dev = 0, cus = 0, per_cu = 0;
    hipGetDevice(&dev);
    hipDeviceGetAttribute(&cus, hipDeviceAttributeMultiprocessorCount, dev);
    hipFuncSetAttribute((const void*)mega, hipFuncAttributeMaxDynamicSharedMemorySize, DSM_BYTES);
    hipOccupancyMaxActiveBlocksPerMultiprocessor(&per_cu, mega, NTH, DSM_BYTES);
    if (per_cu > 1) per_cu = 1;
    grid_blocks = cus * per_cu;
  }
  void* args[] = {&pk};
  hipError_t e = hipLaunchCooperativeKernel((void*)mega, dim3(grid_blocks), dim3(NTH), args, DSM_BYTES, stream);
  if (e != hipSuccess) fprintf(stderr, "cooperative launch failed: %s (grid %d)\n", hipGetErrorString(e), grid_blocks);
}
```

```cpp
#include <hip/hip_runtime.h>
#include <hip/hip_bf16.h>
#include <cstdio>
#include <cstdint>
#include <hip/hip_cooperative_groups.h>
namespace cg = cooperative_groups;

#define DI __device__ __forceinline__
#define LAS __attribute__((address_space(3)))

constexpr int NB = 2, T = 8192, NTOK = NB * T, DM = 1024, NL = 2;
constexpr int RWW = 512, RWC = 1920, INC = 2336;
constexpr int NH = 8;
constexpr int NE = 16, CAP = 1024;
constexpr int DPLE = 256;
constexpr int NTH = 512;
constexpr float NORM_EPS = 1e-6f, GN_EPS = 64e-5f;

using bf16x8 = __attribute__((ext_vector_type(8))) short;
using s16x4  = __attribute__((ext_vector_type(4))) short;
using f32x4  = __attribute__((ext_vector_type(4))) float;
using u32x4  = __attribute__((ext_vector_type(4))) unsigned;
using f32x2  = __attribute__((ext_vector_type(2))) float;
using u32x2  = __attribute__((ext_vector_type(2))) unsigned;
typedef __bf16 bf2_t __attribute__((ext_vector_type(2)));
typedef unsigned short u16;

DI unsigned pk2(float a, float b) { bf2_t v = {(__bf16)a, (__bf16)b}; return __builtin_bit_cast(unsigned, v); }
DI u16 f2bf(float a) { return (u16)(pk2(a, 0.f) & 0xffffu); }
DI float bf2f(u16 u) { return __uint_as_float(((unsigned)u) << 16); }
DI const void* uni_ptr(const void* q) {
  unsigned long long v = (unsigned long long)q;
  unsigned lo = __builtin_amdgcn_readfirstlane((unsigned)v), hi = __builtin_amdgcn_readfirstlane((unsigned)(v >> 32));
  return (const void*)(((unsigned long long)hi << 32) | lo);
}
DI int tidx() { int t = threadIdx.x; asm volatile("" : "+v"(t)); return t; }
DI int bidx() { int b = blockIdx.x; asm volatile("" : "+s"(b)); return b; }
template <int CTRL> DI float dpp_f(float v) {
  return __int_as_float(__builtin_amdgcn_update_dpp(__float_as_int(v), __float_as_int(v), CTRL, 0xF, 0xF, true));
}
DI float red_x1(float v) { return v + dpp_f<0xB1>(v); }
DI float red_x2(float v) { return v + dpp_f<0x4E>(v); }
DI float red_x4(float v) { return v + dpp_f<0x141>(v); }
DI float red_x8(float v) { return v + dpp_f<0x140>(v); }
DI float red_x16(float v) { auto r = __builtin_amdgcn_permlane16_swap(__float_as_uint(v), __float_as_uint(v), false, false); return __uint_as_float(r[0]) + __uint_as_float(r[1]); }
DI float red_x32(float v) { auto r = __builtin_amdgcn_permlane32_swap(__float_as_uint(v), __float_as_uint(v), false, false); return __uint_as_float(r[0]) + __uint_as_float(r[1]); }
DI float red16(float v) { return red_x8(red_x4(red_x2(red_x1(v)))); }
DI float wave_sum(float v) { return red_x32(red_x16(red16(v))); }
DI float frcp(float x) { return __builtin_amdgcn_rcpf(x); }
DI float frsq(float x) { return __builtin_amdgcn_rsqf(x); }
DI float fexp(float x) { return __builtin_amdgcn_exp2f(x * 1.4426950408889634f); }
DI float sigmoidf_(float x) { return frcp(1.f + fexp(-x)); }
DI float ftanh(float x) { return 1.f - 2.f * frcp(1.f + fexp(2.f * x)); }
DI s16x4 tr_read(const short* p) {
  return __builtin_amdgcn_ds_read_tr16_b64_v4i16((LAS s16x4*)(p));
}

struct P {
  const float* x; const float* p; const int* pos;
  const float* attn_norm; const float* w_in; const float* rw_mu; const float* rw_w0; const float* rw_w_up;
  const float* rw_a0; const float* rw_a_up; const float* rw_g_up; const float* rw_k_k; const float* rw_k_a;
  const float* rw_r_k; const float* rw_lnx_w; const float* rw_lnx_b; const float* mla_q_norm; const float* mla_q_up;
  const float* mla_kv_norm; const float* mla_kv_up; const float* mla_o_norm; const float* w_out; const float* ffn_norm;
  const float* router; const float* exp_w_gate; const float* exp_w_up; const float* exp_w_down; const float* ple_norm;
  const float* ple_proj; const float* ple_gate; const float* final_norm;
  float* out;
  float* Z;
  u16* LW;
  u16* AA;
  float* MC; float* NC;
  float* SS;
  u16*   G;
  u16*   HID;
  float* R; float* K; float* V;
  float* PG;
  float* QRAW;
  float* KVRAW;
  float* AO;
  u16* O2;
  u16* TWD; u16* AD; u16* SGD; u16* QDN; u16* KVDN; float* KR;
  float* ROPE;
  u16* Q; u16* Kc; u16* Vv;
  u16* H;
  float* AFF;
  int* IDX;
  float* GATE;
  u16* WIN; u16* WOUT; u16* WPG; u16* WPP; u16* PB;
  u16* PGb;
  u16* EW1; u16* EW2;
  u16* XE; u16* YE;
  int* TCNT; int* TLIST;
  unsigned* CTR;
  unsigned* BAR;
};

constexpr int GBM = 256, GBN = 128, GBK = 64;
constexpr int AS_STRIDE = 72, BS_STRIDE = 136;
constexpr int AS_BYTES = GBM * AS_STRIDE * 2;
constexpr int BS_BYTES = GBK * BS_STRIDE * 2;
constexpr int SMEM_BYTES = 57344;

template <bool A_F32, int MODE, class ARow, class Epi>
DI void gemm_tile(ARow arow, const float* __restrict__ B, const float* __restrict__ B2, int ldb, int K, int n0, int Nvalid,
                  char* smem, Epi epi) {
  short* As = (short*)smem;
  short* Bs = (short*)(smem + AS_BYTES);
  const int tid = tidx(), lane = tid & 63, w = tid >> 6;
  const int wm = w >> 1, wn = w & 1;
  const int l15 = lane & 15, lq = lane >> 4;

  const char* ap[4];
#pragma unroll
  for (int i = 0; i < 4; ++i) {
    int u = tid + i * NTH; int row = u >> 3, kc = u & 7;
    ap[i] = (const char*)arow(row) + (size_t)kc * 8 * (A_F32 ? 4 : 2);
  }
  const float* bp[4]; bool bok[4];
#pragma unroll
  for (int i = 0; i < 4; ++i) {
    int u = tid + i * NTH; int k = u >> 5, nq = u & 31;
    int col; const float* base;
    if (MODE != 1) { col = n0 + nq * 4; base = B; }
    else { col = n0 + (nq & 15) * 4; base = (nq < 16) ? B : B2; }
    bok[i] = col < Nvalid;
    bp[i] = base + (size_t)k * ldb + (bok[i] ? col : 0);
  }

  f32x4 acc[4][4];
#pragma unroll
  for (int i = 0; i < 4; ++i)
#pragma unroll
    for (int j = 0; j < 4; ++j) acc[i][j] = f32x4{0.f, 0.f, 0.f, 0.f};

  u32x4 areg[4]; f32x4 breg[4];
#define GLOAD(kt_)                                                                                   \
  {                                                                                                  \
    _Pragma("unroll") for (int i = 0; i < 4; ++i) {                                                  \
      if (A_F32) {                                                                                   \
        const float4* q = (const float4*)(ap[i] + (size_t)(kt_) * GBK * 4);                          \
        float4 v0 = q[0], v1 = q[1];                                                                 \
        areg[i] = u32x4{pk2(v0.x, v0.y), pk2(v0.z, v0.w), pk2(v1.x, v1.y), pk2(v1.z, v1.w)};         \
      } else {                                                                                       \
        areg[i] = *(const u32x4*)(ap[i] + (size_t)(kt_) * GBK * 2);                                  \
      }                                                                                              \
    }                                                                                                \
    _Pragma("unroll") for (int i = 0; i < 4; ++i) {                                                  \
      if (bok[i]) breg[i] = *(const f32x4*)(bp[i] + (size_t)(kt_) * GBK * ldb);                      \
      else breg[i] = f32x4{0.f, 0.f, 0.f, 0.f};                                                      \
    }                                                                                                \
  }
  const int nk = K / GBK;
  GLOAD(0)
  for (int kt = 0; kt < nk; ++kt) {
    __syncthreads();
#pragma unroll
    for (int i = 0; i < 4; ++i) {
      int u = tid + i * NTH; int row = u >> 3, kc = u & 7;
      *(u32x4*)(As + row * AS_STRIDE + kc * 8) = areg[i];
    }
#pragma unroll
    for (int i = 0; i < 4; ++i) {
      int u = tid + i * NTH; int k = u >> 5, nq = u & 31;
      u32x2 v = u32x2{pk2(breg[i][0], breg[i][1]), pk2(breg[i][2], breg[i][3])};
      *(u32x2*)(Bs + k * BS_STRIDE + nq * 4) = v;
    }
    __syncthreads();
    if (kt + 1 < nk) GLOAD(kt + 1)
#pragma unroll
    for (int ks = 0; ks < 2; ++ks) {
      bf16x8 a[4], b[4];
#pragma unroll
      for (int mi = 0; mi < 4; ++mi)
        a[mi] = *(const bf16x8*)(As + (wm * 64 + mi * 16 + l15) * AS_STRIDE + ks * 32 + 8 * lq);
#pragma unroll
      for (int ni = 0; ni < 4; ++ni) {
        int col0 = (MODE != 1) ? (wn * 64 + ni * 16) : ((ni < 2) ? (wn * 32 + ni * 16) : (64 + wn * 32 + (ni - 2) * 16));
        int kb = ks * 32 + 8 * lq; int q = l15 >> 2, pp = l15 & 3;
        s16x4 lo = tr_read(Bs + (kb + q) * BS_STRIDE + col0 + 4 * pp);
        s16x4 hi = tr_read(Bs + (kb + 4 + q) * BS_STRIDE + col0 + 4 * pp);
        b[ni] = __builtin_shufflevector(lo, hi, 0, 1, 2, 3, 4, 5, 6, 7);
      }
#pragma unroll
      for (int mi = 0; mi < 4; ++mi)
#pragma unroll
        for (int ni = 0; ni < 4; ++ni)
          acc[mi][ni] = __builtin_amdgcn_mfma_f32_16x16x32_bf16(a[mi], b[ni], acc[mi][ni], 0, 0, 0);
    }
  }
  if constexpr (MODE == 2) { epi(acc, wm, wn, lq, l15); return; }
  else {
#pragma unroll
  for (int mi = 0; mi < 4; ++mi)
#pragma unroll
    for (int r = 0; r < 4; ++r) {
      int row = wm * 64 + mi * 16 + lq * 4 + r;
      if (MODE == 0) {
#pragma unroll
        for (int ni = 0; ni < 4; ++ni) {
          int col = n0 + wn * 64 + ni * 16 + l15;
          if (col < Nvalid) epi(row, col, acc[mi][ni][r], 0.f);
        }
      } else {
#pragma unroll
        for (int ni = 0; ni < 2; ++ni) {
          int col = n0 + wn * 32 + ni * 16 + l15;
          epi(row, col, acc[mi][ni][r], acc[mi][ni + 2][r]);
        }
      }
    }
  }
}

DI void ph_norm(const float* __restrict__ X, const float* __restrict__ g, u16* __restrict__ Hout) {
  const int tid_ = tidx(); const int lane = tid_ & 63, w = tid_ >> 6;
  for (int tok = blockIdx.x * 8 + w; tok < NTOK; tok += gridDim.x * 8) {
    const float4* xr = (const float4*)(X + (size_t)tok * DM);
    float4 v[4]; float ss = 0.f;
#pragma unroll
    for (int j = 0; j < 4; ++j) { v[j] = xr[lane + 64 * j]; ss += v[j].x * v[j].x + v[j].y * v[j].y + v[j].z * v[j].z + v[j].w * v[j].w; }
    ss = wave_sum(ss);
    float rstd = frsq(ss * (1.f / DM) + NORM_EPS);
#pragma unroll
    for (int j = 0; j < 4; ++j) {
      float4 gg = ((const float4*)g)[lane + 64 * j];
      uint2 o = uint2{pk2(v[j].x * rstd * gg.x, v[j].y * rstd * gg.y), pk2(v[j].z * rstd * gg.z, v[j].w * rstd * gg.w)};
      *(uint2*)(Hout + (size_t)tok * DM + (lane + 64 * j) * 4) = o;
    }
  }
}

DI void ph_final_norm(float* __restrict__ X, const float* __restrict__ g) {
  const int tid_ = tidx(); const int lane = tid_ & 63, w = tid_ >> 6;
  for (int tok = blockIdx.x * 8 + w; tok < NTOK; tok += gridDim.x * 8) {
    float4* xr = (float4*)(X + (size_t)tok * DM);
    float4 v[4]; float ss = 0.f;
#pragma unroll
    for (int j = 0; j < 4; ++j) { v[j] = xr[lane + 64 * j]; ss += v[j].x * v[j].x + v[j].y * v[j].y + v[j].z * v[j].z + v[j].w * v[j].w; }
    ss = wave_sum(ss);
    float rstd = frsq(ss * (1.f / DM) + NORM_EPS);
#pragma unroll
    for (int j = 0; j < 4; ++j) {
      float4 gg = ((const float4*)g)[lane + 64 * j];
      xr[lane + 64 * j] = float4{v[j].x * rstd * gg.x, v[j].y * rstd * gg.y, v[j].z * rstd * gg.z, v[j].w * rstd * gg.w};
    }
  }
}

template <bool A_F32, class Epi>
DI void ph_gemm(const void* A, int lda, const float* B, int ldb, int M, int N, int K, char* smem, Epi epi) {
  const int ntn = (N + GBN - 1) / GBN, ntm = M / GBM;
  for (int t = blockIdx.x; t < ntm * ntn; t += gridDim.x) {
    int tm = t / ntn, tn = t % ntn;
    int m0 = tm * GBM, n0 = tn * GBN;
    auto arow = [&](int r) -> const void* { return (const char*)A + (size_t)(m0 + r) * lda * (A_F32 ? 4 : 2); };
    gemm_tile<A_F32, 0>(arow, B, nullptr, ldb, K, n0, N, smem, [&](int row, int col, float v, float) { epi(m0 + row, col, v); });
    __syncthreads();
  }
}

template <class Epi>
DI void ph_gemm_t(const void* A, int lda, const float* B, int ldb, int M, int N, int K, char* smem, Epi epi) {
  const int ntn = (N + GBN - 1) / GBN, ntm = M / GBM;
  for (int t = blockIdx.x; t < ntm * ntn; t += gridDim.x) {
    int tm = t / ntn, tn = t % ntn;
    int m0 = tm * GBM, n0 = tn * GBN;
    auto arow = [&](int r) -> const void* { return (const char*)A + (size_t)(m0 + r) * lda * 2; };
    gemm_tile<false, 2>(arow, B, nullptr, ldb, K, n0, N, smem,
                        [&](const f32x4 (&acc)[4][4], int wm, int wn, int lq, int l15) { epi(acc, m0, n0, wm, wn, lq, l15); });
    __syncthreads();
  }
}

DI void ph_rwshift(const P& p, int layer) {
  const float* mu = p.rw_mu + layer * RWC;
  const int total = NTOK * (RWC / 4);
  const int tid_ = tidx();
  for (int i = blockIdx.x * NTH + tid_; i < total; i += gridDim.x * NTH) {
    int tok = i / (RWC / 4), c = (i % (RWC / 4)) * 4;
    int t = tok % T;
    const float* zr = p.Z + (size_t)tok * INC + c;
    float4 z = *(const float4*)zr;
    float4 zm = (t > 0) ? *(const float4*)(zr - INC) : float4{0.f, 0.f, 0.f, 0.f};
    float4 zp = (t < T - 1) ? *(const float4*)(zr + INC) : float4{0.f, 0.f, 0.f, 0.f};
    float4 m = *(const float4*)(mu + c);
    float4 o;
    o.x = z.x + m.x * (0.5f * (zm.x + zp.x) - z.x);
    o.y = z.y + m.y * (0.5f * (zm.y + zp.y) - z.y);
    o.z = z.z + m.z * (0.5f * (zm.z + zp.z) - z.z);
    o.w = z.w + m.w * (0.5f * (zm.w + zp.w) - z.w);
    if (c < 512) *(float4*)(p.R + (size_t)tok * RWW + c) = o;
    else if (c < 1024) *(float4*)(p.K + (size_t)tok * RWW + (c - 512)) = o;
    else if (c < 1536) *(float4*)(p.V + (size_t)tok * RWW + (c - 1024)) = o;
    else if (c < 1664) {
      int d = (c - 1536) >> 6, l = (c - 1536) & 63;
      *(uint2*)(p.TWD + ((size_t)d * NTOK + tok) * 64 + l) = uint2{pk2(ftanh(o.x), ftanh(o.y)), pk2(ftanh(o.z), ftanh(o.w))};
    } else if (c < 1792) {
      int d = (c - 1664) >> 6, l = (c - 1664) & 63;
      *(uint2*)(p.AD + ((size_t)d * NTOK + tok) * 64 + l) = uint2{pk2(o.x, o.y), pk2(o.z, o.w)};
    } else {
      int l = c - 1792;
      *(uint2*)(p.SGD + (size_t)tok * 128 + l) = uint2{pk2(sigmoidf_(o.x), sigmoidf_(o.y)), pk2(sigmoidf_(o.z), sigmoidf_(o.w))};
    }
  }
}

DI void rope_cs(int pos, int i, float& cs, float& sn) {
  const int i3 = i & 3, i2 = i >> 2;
  const float c4 = (i3 == 0) ? 1.0f : (i3 == 1) ? 0.5623413251903491f : (i3 == 2) ? 0.31622776601683794f : 0.1778279410038923f;
  const float p10 = (i2 == 0) ? 1.0f : (i2 == 1) ? 0.1f : (i2 == 2) ? 0.01f : 0.001f;
  float inv = c4 * p10;
  float ang = (float)pos * inv;
  double rev = (double)ang * 0.15915494309189535;
  rev -= floor(rev);
  float rf = (float)rev;
  sn = __builtin_amdgcn_sinf(rf);
  cs = __builtin_amdgcn_cosf(rf);
}

DI void ph_rope_table(const P& p) {
  for (int i = blockIdx.x * NTH + tidx(); i < NTOK * 16; i += gridDim.x * NTH) {
    float cs, sn; rope_cs(p.pos[i >> 4], i & 15, cs, sn);
    *(f32x2*)(p.ROPE + (size_t)i * 2) = f32x2{cs, sn};
  }
}
DI void ph_mlaprep1(const P& p, int layer) {
  const int tid_ = tidx(); const int lane = tid_ & 63, w = tid_ >> 6;
  const float* qn = p.mla_q_norm + layer * 256;
  const float* kvn = p.mla_kv_norm + layer * 128;
  for (int tok = blockIdx.x * 8 + w; tok < NTOK; tok += gridDim.x * 8) {
    const float* zr = p.Z + (size_t)tok * INC + RWC;
    float4 q = *(const float4*)(zr + lane * 4);
    float ss = wave_sum(q.x * q.x + q.y * q.y + q.z * q.z + q.w * q.w);
    float rstd = frsq(ss * (1.f / 256) + NORM_EPS);
    float4 g = *(const float4*)(qn + lane * 4);
    *(uint2*)(p.QDN + (size_t)tok * 256 + lane * 4) = uint2{pk2(q.x * rstd * g.x, q.y * rstd * g.y), pk2(q.z * rstd * g.z, q.w * rstd * g.w)};
    float2 kv = *(const float2*)(zr + 256 + lane * 2);
    float ss2 = wave_sum(kv.x * kv.x + kv.y * kv.y);
    float rstd2 = frsq(ss2 * (1.f / 128) + NORM_EPS);
    float2 g2 = *(const float2*)(kvn + lane * 2);
    *(unsigned*)(p.KVDN + (size_t)tok * 128 + lane * 2) = pk2(kv.x * rstd2 * g2.x, kv.y * rstd2 * g2.y);
    if (lane < 16) {
      float u1 = zr[384 + lane], u2 = zr[384 + 16 + lane];
      const f32x2 csn = *(const f32x2*)(p.ROPE + (size_t)tok * 32 + lane * 2);
      const u16 k1 = f2bf(u1 * csn[0] - u2 * csn[1]), k2 = f2bf(u1 * csn[1] + u2 * csn[0]);
      const int bb = tok / T, tt = tok % T;
#pragma unroll
      for (int h = 0; h < NH; ++h) {
        u16* ko = p.Kc + ((size_t)(bb * NH + h) * T + tt) * 96 + 64;
        ko[lane] = k1; ko[16 + lane] = k2;
      }
    }
  }
}

DI void ph_mlafinish(const P& p) {
  const int tid_ = tidx(); const int lane = tid_ & 63, w = tid_ >> 6;
  const float qs = 0.10206207261596577f * 1.4426950408889634f;
  for (int tok = blockIdx.x * 8 + w; tok < NTOK; tok += gridDim.x * 8) {
    int b = tok / T, t = tok % T;
    float cs = 0.f, sn = 0.f;
    if (lane < 16) rope_cs(p.pos[tok], lane, cs, sn);
    const float* qr = p.QRAW + (size_t)tok * 768;
    const float* kvr = p.KVRAW + (size_t)tok * 1024;
    const float* kr = p.KR + (size_t)tok * 32;
#pragma unroll
    for (int h = 0; h < NH; ++h) {
      size_t row = ((size_t)(b * NH + h) * T + t);
      u16* qo = p.Q + row * 96; u16* ko = p.Kc + row * 96; u16* vo = p.Vv + row * 64;
      qo[lane] = f2bf(qr[h * 96 + lane] * qs);
      ko[lane] = f2bf(kvr[h * 128 + lane]);
      vo[lane] = f2bf(kvr[h * 128 + 64 + lane]);
      if (lane < 16) {
        float u1 = qr[h * 96 + 64 + lane], u2 = qr[h * 96 + 80 + lane];
        qo[64 + lane] = f2bf((u1 * cs - u2 * sn) * qs);
        qo[80 + lane] = f2bf((u1 * sn + u2 * cs) * qs);
      }
      if (lane < 32) ko[64 + lane] = f2bf(kr[lane]);
    }
  }
}

using f32x16 = __attribute__((ext_vector_type(16))) float;
#define SBAR() __builtin_amdgcn_sched_barrier(0)
constexpr int AT_KSTR = 104;
constexpr int AT_KBYTES = 64 * AT_KSTR * 2;
constexpr int AT_VBYTES = 64 * 64 * 2;
constexpr float AT_THR = 8.f;
DI int crow(int r, int hi) { return (r & 3) + 8 * (r >> 2) + 4 * hi; }
DI int v_st(int k, int c) { const int kk = (k & ~0xC) | ((k & 4) << 1) | ((k & 8) >> 1); return ((kk >> 3) * 2 + (c >> 5)) * 512 + ((kk & 7) * 32 + (c & 31)) * 2; }
DI int v_rd_base(int lane) { return ((lane & 3) << 3) | (((lane >> 2) & 3) << 6) | (((lane >> 4) & 1) << 5) | (((lane >> 5) & 1) << 8); }
constexpr int v_rd_off(int d0, int ks, int half) { return d0 * 512 + ks * 2048 + half * 1024; }

DI void at_partialSM(f32x16& p0, f32x16& p1, float& m_reg, float& mn, float& alpha) {
  float pmax = p0[0];
#pragma unroll
  for (int r = 1; r < 16; ++r) pmax = fmaxf(pmax, p0[r]);
#pragma unroll
  for (int r = 0; r < 16; ++r) pmax = fmaxf(pmax, p1[r]);
  { auto rr = __builtin_amdgcn_permlane32_swap(__float_as_uint(pmax), __float_as_uint(pmax), false, false);
    pmax = fmaxf(__uint_as_float(rr[0]), __uint_as_float(rr[1])); }
  if (__builtin_expect(__all(pmax - m_reg <= AT_THR), 1)) { mn = m_reg; alpha = 1.f; }
  else { mn = fmaxf(m_reg, pmax); alpha = __builtin_amdgcn_exp2f(m_reg - mn); m_reg = mn; }
#pragma unroll
  for (int r = 0; r < 16; ++r) { p0[r] = p0[r] - mn; p1[r] = p1[r] - mn; }
#pragma unroll
  for (int r = 0; r < 16; ++r) p0[r] = __builtin_amdgcn_exp2f(p0[r]);
}
DI void at_finishSM(f32x16& p0, f32x16& p1, float alpha, float& l_reg, bf16x8& pa0, bf16x8& pa1, bf16x8& pa2, bf16x8& pa3) {
#pragma unroll
  for (int r = 0; r < 16; ++r) p1[r] = __builtin_amdgcn_exp2f(p1[r]);
  float ps = 0;
#pragma unroll
  for (int r = 0; r < 16; ++r) ps += p0[r];
#pragma unroll
  for (int r = 0; r < 16; ++r) ps += p1[r];
  { auto rr = __builtin_amdgcn_permlane32_swap(__float_as_uint(ps), __float_as_uint(ps), false, false);
    ps = __uint_as_float(rr[0]) + __uint_as_float(rr[1]); }
  l_reg = l_reg * alpha + ps;
#define PK4(PP, BASE, OUT) do { unsigned a0 = pk2(PP[BASE + 0], PP[BASE + 1]), a1 = pk2(PP[BASE + 2], PP[BASE + 3]);   \
    unsigned b0 = pk2(PP[BASE + 4], PP[BASE + 5]), b1 = pk2(PP[BASE + 6], PP[BASE + 7]);                              \
    auto r0 = __builtin_amdgcn_permlane32_swap(a0, b0, false, false); auto r1 = __builtin_amdgcn_permlane32_swap(a1, b1, false, false); \
    u32x4 wv = {r0[0], r1[0], r0[1], r1[1]}; OUT = __builtin_bit_cast(bf16x8, wv); } while (0)
  PK4(p0, 0, pa0); PK4(p0, 8, pa1); PK4(p1, 0, pa2); PK4(p1, 8, pa3);
#undef PK4
}
DI void at_qkt(f32x16& p0, f32x16& p1, const char* Kb, const bf16x8* qr, int r32, int hi) {
#pragma unroll
  for (int r = 0; r < 16; ++r) { p0[r] = 0.f; p1[r] = 0.f; }
#pragma unroll
  for (int d0 = 0; d0 < 6; ++d0) {
    bf16x8 b0 = *(const bf16x8*)(Kb + (r32 * AT_KSTR + d0 * 16 + hi * 8) * 2);
    bf16x8 b1 = *(const bf16x8*)(Kb + ((32 + r32) * AT_KSTR + d0 * 16 + hi * 8) * 2);
    __builtin_amdgcn_s_setprio(1);
    p0 = __builtin_amdgcn_mfma_f32_32x32x16_bf16(b0, qr[d0], p0, 0, 0, 0);
    p1 = __builtin_amdgcn_mfma_f32_32x32x16_bf16(b1, qr[d0], p1, 0, 0, 0);
    __builtin_amdgcn_s_setprio(0);
  }
}
template <int D0> DI void at_pv_one(f32x16& od, const char* vb, bf16x8 pa0, bf16x8 pa1, bf16x8 pa2, bf16x8 pa3) {
#define TRR(ks, half) tr_read((const short*)(vb + v_rd_off(D0, ks, half)))
  const s16x4 l0 = TRR(0, 0), h0 = TRR(0, 1), l1 = TRR(1, 0), h1 = TRR(1, 1), l2 = TRR(2, 0), h2 = TRR(2, 1), l3 = TRR(3, 0), h3 = TRR(3, 1);
#undef TRR
#define PKV(L, H) __builtin_shufflevector(L, H, 0, 1, 2, 3, 4, 5, 6, 7)
  __builtin_amdgcn_s_setprio(1);
  od = __builtin_amdgcn_mfma_f32_32x32x16_bf16(pa0, PKV(l0, h0), od, 0, 0, 0);
  od = __builtin_amdgcn_mfma_f32_32x32x16_bf16(pa1, PKV(l1, h1), od, 0, 0, 0);
  od = __builtin_amdgcn_mfma_f32_32x32x16_bf16(pa2, PKV(l2, h2), od, 0, 0, 0);
  od = __builtin_amdgcn_mfma_f32_32x32x16_bf16(pa3, PKV(l3, h3), od, 0, 0, 0);
  __builtin_amdgcn_s_setprio(0);
#undef PKV
}
DI void at_pv(f32x16* o, const char* vb, bf16x8 pa0, bf16x8 pa1, bf16x8 pa2, bf16x8 pa3) {
  at_pv_one<0>(o[0], vb, pa0, pa1, pa2, pa3); at_pv_one<1>(o[1], vb, pa0, pa1, pa2, pa3);
}

DI void attn_body(const u16* __restrict__ Qb, const u16* __restrict__ Kh, const u16* __restrict__ Vh, float* __restrict__ Ob, char* lds, int tid) {
  const int wid = tid >> 6, lane = tid & 63, r32 = lane & 31, hi = lane >> 5;
  char* V_lds = lds; char* K_lds = lds + 2 * AT_VBYTES;
  float* wsp = (float*)(lds + 2 * AT_VBYTES + 2 * AT_KBYTES) + wid * 64; float* li_l = wsp; float* al_l = wsp + 32;
  float m_reg = -1e30f, l_reg = 0.f; f32x16 o[2]; bf16x8 qr[6];
#pragma unroll
  for (int r = 0; r < 16; ++r) { o[0][r] = 0.f; o[1][r] = 0.f; }
  const u16* Qw = Qb + (size_t)(wid * 32 + r32) * 96 + hi * 8;
#pragma unroll
  for (int d0 = 0; d0 < 6; ++d0) qr[d0] = *(const bf16x8*)(Qw + d0 * 16);
  const int kid1 = (tid < 256) ? tid + 512 : tid;
  const int kst0 = ((tid / 12) * AT_KSTR + (tid % 12) * 8) * 2, kst1 = ((kid1 / 12) * AT_KSTR + (kid1 % 12) * 8) * 2;
  const int vst = v_st(tid >> 3, (tid & 7) * 8);
  const char* vb0 = V_lds + v_rd_base(lane);
  u32x4 sk0[2], sk1[2], sv0[2];
#define SLOAD(i, k0) do { sk0[i] = *(const u32x4*)(Kh + (size_t)(k0) * 96 + tid * 8); sk1[i] = *(const u32x4*)(Kh + (size_t)(k0) * 96 + kid1 * 8); \
    sv0[i] = *(const u32x4*)(Vh + (size_t)(k0) * 64 + tid * 8); } while (0)
#define SWRITE(b, i) do { *(u32x4*)(K_lds + (b) * AT_KBYTES + kst0) = sk0[i]; if (tid < 256) *(u32x4*)(K_lds + (b) * AT_KBYTES + kst1) = sk1[i]; \
    *(u32x4*)(V_lds + (b) * AT_VBYTES + vst) = sv0[i]; } while (0)
#define SWAIT() asm volatile("s_waitcnt vmcnt(3)" ::: "memory")
#define RESC(a) do { if (__any((a) < 1.f)) { if (hi == 0) al_l[r32] = (a); asm volatile("s_waitcnt lgkmcnt(0)" ::: "memory"); \
    _Pragma("unroll") for (int r = 0; r < 16; ++r) { float al = al_l[crow(r, hi)]; o[0][r] *= al; o[1][r] *= al; } } } while (0)
  f32x16 pA0, pA1, pB0, pB1; float mnA, mnB, alA, alB; bf16x8 pa0, pa1, pa2, pa3; constexpr int NT = T / 64;
  SLOAD(0, 0); SWRITE(0, 0); __syncthreads();
  at_qkt(pA0, pA1, K_lds, qr, r32, hi); at_partialSM(pA0, pA1, m_reg, mnA, alA);
  SLOAD(1, 64); SLOAD(0, 128);
  SWAIT(); SWRITE(1, 1); __syncthreads();
  for (int j = 1; j + 1 < NT; j += 2) {
    SBAR(); at_qkt(pB0, pB1, K_lds + AT_KBYTES, qr, r32, hi);
    at_finishSM(pA0, pA1, alA, l_reg, pa0, pa1, pa2, pa3); SBAR();
    SLOAD(1, (j + 2) * 64); SBAR();
    at_pv(o, vb0, pa0, pa1, pa2, pa3); at_partialSM(pB0, pB1, m_reg, mnB, alB);
    __syncthreads(); SWAIT(); SWRITE(0, 0);
    RESC(alB); __syncthreads();
    SBAR(); at_qkt(pA0, pA1, K_lds, qr, r32, hi);
    at_finishSM(pB0, pB1, alB, l_reg, pa0, pa1, pa2, pa3); SBAR();
    if (j + 3 < NT) SLOAD(0, (j + 3) * 64); SBAR();
    at_pv(o, vb0 + AT_VBYTES, pa0, pa1, pa2, pa3); at_partialSM(pA0, pA1, m_reg, mnA, alA);
    __syncthreads(); SWAIT(); SWRITE(1, 1);
    RESC(alA); __syncthreads();
  }
  SBAR(); at_qkt(pB0, pB1, K_lds + AT_KBYTES, qr, r32, hi);
  at_finishSM(pA0, pA1, alA, l_reg, pa0, pa1, pa2, pa3); SBAR();
  at_pv(o, vb0, pa0, pa1, pa2, pa3); at_partialSM(pB0, pB1, m_reg, mnB, alB);
  __syncthreads(); RESC(alB);
  at_finishSM(pB0, pB1, alB, l_reg, pa0, pa1, pa2, pa3); SBAR();
  at_pv(o, vb0 + AT_VBYTES, pa0, pa1, pa2, pa3);
  if (hi == 0) li_l[r32] = l_reg;
  asm volatile("s_waitcnt lgkmcnt(0)" ::: "memory");
  float* Ow = Ob + (size_t)(wid * 32) * 512;
#pragma unroll
  for (int r = 0; r < 16; ++r) {
    int orow = crow(r, hi); float rl = __builtin_amdgcn_rcpf(li_l[orow]);
    Ow[(size_t)orow * 512 + r32] = o[0][r] * rl; Ow[(size_t)orow * 512 + 32 + r32] = o[1][r] * rl;
  }
#undef SLOAD
#undef SWRITE
#undef SWAIT
#undef RESC
}

DI void ph_attn(const P& p, char* smem, unsigned* ctr) {
  const int tid = tidx();
  int* sitem = (int*)(smem + SMEM_BYTES - 16);
  for (;;) {
    __syncthreads();
    if (tid == 0) *sitem = (int)atomicAdd(ctr, 1u);
    __syncthreads();
    const int item = *sitem;
    if (item >= NB * NH * (T / 256)) break;
    const int bh = item / (T / 256), qb = item % (T / 256);
    const int b = bh / NH, h = bh % NH;
    attn_body(p.Q + ((size_t)bh * T + qb * 256) * 96, p.Kc + (size_t)bh * T * 96, p.Vv + (size_t)bh * T * 64,
              p.AO + ((size_t)(b * T + qb * 256)) * 512 + h * 64, smem, tid);
  }
}

constexpr int SC = 128, NCH = T / SC;
constexpr int SBUF = 5184;
template <int NI> struct ScanRegsN { float k[2 * NI], r[2 * NI], v[2 * NI]; u16 lw[2 * NI], a[2 * NI]; };
template <int NI>
DI void scan_load_n(const P& p, int b, int h, int d, int n0, int lane, int ws, ScanRegsN<NI>& g) {
  constexpr int WPI = 8 / NI;
  const u16* LWd = p.LW + (size_t)d * NTOK * RWW;
  const u16* AAd = p.AA + (size_t)d * NTOK * RWW;
  const int ch = h * 64 + lane;
#pragma unroll
  for (int jj = 0; jj < 2 * NI; ++jj) {
    int n = n0 + ws + WPI * jj; int t = d ? (T - 1 - n) : n;
    size_t off = ((size_t)(b * T + t)) * RWW + ch;
    g.k[jj] = p.K[off]; g.r[jj] = p.R[off]; g.v[jj] = p.V[off]; g.lw[jj] = LWd[off]; g.a[jj] = AAd[off];
  }
}
template <int NI>
DI void scan_put_n(const ScanRegsN<NI>& g, float kkc, float kac, float* sm, float* slw, int lane, int ws) {
  constexpr int WPI = 8 / NI;
#pragma unroll
  for (int jj = 0; jj < 2 * NI; ++jj) slw[(ws + WPI * jj) * 64 + lane] = bf2f(g.lw[jj]);
  __syncthreads();
  float Lj[2 * NI];
#pragma unroll
  for (int jj = 0; jj < 2 * NI; ++jj) Lj[jj] = 0.f;
#pragma unroll
  for (int i = 0; i < 16; ++i) {
    const float x = slw[i * 64 + lane];
#pragma unroll
    for (int jj = 0; jj < 2 * NI; ++jj) Lj[jj] += (i <= ws + WPI * jj) ? x : 0.f;
  }
#pragma unroll
  for (int jj = 0; jj < 2 * NI; ++jj) {
    const int j = ws + WPI * jj;
    const float L = Lj[jj], lwj = bf2f(g.lw[jj]);
    const float Pt = fexp(L), Pm = fexp(L - lwj), iP = fexp(-L);
    const float kv = g.k[jj];
    const float kx = kv * kkc;
    const float nrm = __builtin_amdgcn_sqrtf(wave_sum(kx * kx));
    const float kkv = kx * frcp(fmaxf(nrm, 1e-12f));
    const float a = bf2f(g.a[jj]);
    sm[j * 64 + lane] = -kkv * Pm;
    sm[1024 + j * 64 + lane] = a * kkv * iP;
    sm[2048 + j * 64 + lane] = kv * (1.f + (a - 1.f) * kac) * iP;
    sm[3072 + j * 64 + lane] = g.r[jj] * Pt;
    sm[4096 + j * 64 + lane] = g.v[jj];
    if (j == 15) sm[5120 + lane] = Pt;
  }
}
using f32x16s = __attribute__((ext_vector_type(16))) float;
DI void scan_ld8(f32x4 (&kv)[8], const float* vec, int hi) {
#pragma unroll
  for (int tk = 0; tk < 2; ++tk)
#pragma unroll
    for (int q = 0; q < 4; ++q) kv[tk * 4 + q] = *(const f32x4*)(vec + 32 * tk + 8 * q + 4 * hi);
}
DI float scan_dot8(const f32x16s (&acc)[2], const f32x4 (&kv)[8]) {
  float pq[4] = {0.f, 0.f, 0.f, 0.f};
#pragma unroll
  for (int tk = 0; tk < 2; ++tk)
#pragma unroll
    for (int e = 0; e < 4; ++e)
#pragma unroll
      for (int q = 0; q < 4; ++q) { pq[q] = __builtin_fmaf(acc[tk][4 * q + e], kv[tk * 4 + q][e], pq[q]); asm("" : "+v"(pq[q])); }
  return red_x32((pq[0] + pq[1]) + (pq[2] + pq[3]));
}

DI void ph_scan1(const P& p, int layer, char* smem) {
  constexpr int NI = 2;
  const int tid = tidx(), lane = tid & 63, w = tid >> 6;
  const int jl = lane & 31, hi = lane >> 5;
  const int it = w >> 2, vt = w & 3, ws = w & 3;
  float* smi = (float*)smem + it * (2 * SBUF + 1024);
  float* slw = smi + 2 * SBUF;
  for (int pair = blockIdx.x; pair < 32 * NCH / 2; pair += gridDim.x) {
    const int item = pair * 2 + it; const int scan = item / NCH, c = item % NCH;
    const int d = scan & 1, h = (scan >> 1) % NH, b = scan / (2 * NH);
    const float kkc = p.rw_k_k[layer * RWW + h * 64 + lane], kac = p.rw_k_a[layer * RWW + h * 64 + lane];
    f32x16s acc[2];
#pragma unroll
    for (int tk = 0; tk < 2; ++tk)
#pragma unroll
      for (int r = 0; r < 16; ++r) acc[tk][r] = (32 * tk + (r & 3) + 8 * (r >> 2) + 4 * hi == 32 * vt + jl) ? 1.f : 0.f;
    ScanRegsN<NI> g;
    scan_load_n<NI>(p, b, h, d, c * SC, lane, ws, g);
    __syncthreads();
    scan_put_n<NI>(g, kkc, kac, smi, slw, lane, ws);
    __syncthreads();
    for (int sub = 0; sub < SC / 16; ++sub) {
      const float* sm = smi + (sub & 1) * SBUF;
      if (sub + 1 < SC / 16) scan_load_n<NI>(p, b, h, d, c * SC + (sub + 1) * 16, lane, ws, g);
      const float* vrow = sm + 4096 + ((vt >= 2) ? 32 * (vt - 2) : 0) + jl;
      f32x4 kc[8]; scan_ld8(kc, sm, hi);
      float a0 = sm[1024 + hi * 1024 + jl], a1 = sm[1024 + hi * 1024 + 32 + jl], vc = vrow[0];
#pragma unroll 2
      for (int j = 0; j < 16; ++j) {
        const int jn = (j + 1) & 15;
        f32x4 kn[8]; scan_ld8(kn, sm + jn * 64, hi);
        const float an0 = sm[1024 + hi * 1024 + jn * 64 + jl], an1 = sm[1024 + hi * 1024 + jn * 64 + 32 + jl], vn = vrow[jn * 64];
        SBAR();
        const float sa = scan_dot8(acc, kc);
        const float bop = hi ? ((vt >= 2) ? vc : 0.f) : sa;
        acc[0] = __builtin_amdgcn_mfma_f32_32x32x2f32(a0, bop, acc[0], 0, 0, 0);
        acc[1] = __builtin_amdgcn_mfma_f32_32x32x2f32(a1, bop, acc[1], 0, 0, 0);
        SBAR();
#pragma unroll
        for (int i = 0; i < 8; ++i) kc[i] = kn[i];
        a0 = an0; a1 = an1; vc = vn;
      }
#pragma unroll
      for (int tk = 0; tk < 2; ++tk)
#pragma unroll
        for (int q = 0; q < 4; ++q) {
          const f32x4 pv = *(const f32x4*)(sm + 5120 + 32 * tk + 8 * q + 4 * hi);
#pragma unroll
          for (int e = 0; e < 4; ++e) acc[tk][4 * q + e] *= pv[e];
        }
      if (sub + 1 < SC / 16) scan_put_n<NI>(g, kkc, kac, smi + ((sub + 1) & 1) * SBUF, slw, lane, ws);
      __syncthreads();
    }
    {
      const int v = 32 * vt + jl;
      float* dst = ((v < 64) ? p.MC : p.NC) + (((size_t)scan * NCH + c) * 64 + (v & 63)) * 64;
#pragma unroll
      for (int tk = 0; tk < 2; ++tk)
#pragma unroll
        for (int q = 0; q < 4; ++q)
          *(f32x4*)(dst + 32 * tk + 8 * q + 4 * hi) = f32x4{acc[tk][4 * q], acc[tk][4 * q + 1], acc[tk][4 * q + 2], acc[tk][4 * q + 3]};
    }
  }
}


using f32x4v = __attribute__((ext_vector_type(4))) float;
DI void ph_scan2(const P& p, char* smem) {
  float* Ssm = (float*)smem;
  float* Msm = Ssm + 64 * 68;
  const int tid = tidx(), lane = tid & 63, w = tid >> 6;
  const int l15 = lane & 15, lq = lane >> 4;
  const int ti = w >> 1, tj0 = (w & 1) * 2;
  for (int scan = blockIdx.x; scan < 32; scan += gridDim.x) {
    const float* Mg = p.MC + (size_t)scan * NCH * 4096;
    const float* Ng = p.NC + (size_t)scan * NCH * 4096;
    float* Sg = p.SS + (size_t)scan * NCH * 4096;
    f32x4 m0 = *(const f32x4*)(Mg + tid * 8), m1 = *(const f32x4*)(Mg + tid * 8 + 4);
    f32x4 sacc[2];
    f32x4 nacc[2];
#pragma unroll
    for (int q = 0; q < 2; ++q) {
      sacc[q] = f32x4{0.f, 0.f, 0.f, 0.f};
#pragma unroll
      for (int r = 0; r < 4; ++r) nacc[q][r] = Ng[(ti * 16 + lq * 4 + r) * 64 + (tj0 + q) * 16 + l15];
    }
    for (int c = 0; c < NCH; ++c) {
      __syncthreads();
#pragma unroll
      for (int q = 0; q < 2; ++q)
#pragma unroll
        for (int r = 0; r < 4; ++r) {
          const int row = ti * 16 + lq * 4 + r, col = (tj0 + q) * 16 + l15;
          Sg[(size_t)c * 4096 + row * 64 + col] = sacc[q][r];
          Ssm[row * 68 + col] = sacc[q][r];
        }
      { const int mr = tid >> 3, mc = (tid & 7) * 8; *(f32x4*)(Msm + mr * 68 + mc) = m0; *(f32x4*)(Msm + mr * 68 + mc + 4) = m1; }
      f32x4 acc[2] = {nacc[0], nacc[1]};
      __syncthreads();
      if (c + 1 < NCH) {
        m0 = *(const f32x4*)(Mg + (size_t)(c + 1) * 4096 + tid * 8); m1 = *(const f32x4*)(Mg + (size_t)(c + 1) * 4096 + tid * 8 + 4);
#pragma unroll
        for (int q = 0; q < 2; ++q)
#pragma unroll
          for (int r = 0; r < 4; ++r) nacc[q][r] = Ng[(size_t)(c + 1) * 4096 + (ti * 16 + lq * 4 + r) * 64 + (tj0 + q) * 16 + l15];
      }
#pragma unroll
      for (int kk = 0; kk < 16; ++kk) {
        const float a = Ssm[(ti * 16 + l15) * 68 + kk * 4 + lq];
        const float b0 = Msm[(kk * 4 + lq) * 68 + tj0 * 16 + l15], b1 = Msm[(kk * 4 + lq) * 68 + (tj0 + 1) * 16 + l15];
        acc[0] = __builtin_amdgcn_mfma_f32_16x16x4f32(a, b0, acc[0], 0, 0, 0);
        acc[1] = __builtin_amdgcn_mfma_f32_16x16x4f32(a, b1, acc[1], 0, 0, 0);
      }
      sacc[0] = acc[0]; sacc[1] = acc[1];
    }
    __syncthreads();
  }
}

DI void ph_scan3(const P& p, int layer, char* smem) {
  constexpr int NI = 4;
  const int tid = tidx(), lane = tid & 63, w = tid >> 6;
  const int jl = lane & 31, hi = lane >> 5;
  const int it = w >> 1, vt = w & 1, ws = w & 1;
  float* sm = (float*)smem + it * (SBUF + 2048);
  float* slw = sm + SBUF; float* so = slw + 1024;
  for (int quad = blockIdx.x; quad < 32 * NCH / 4; quad += gridDim.x) {
    const int item = quad * 4 + it; const int scan = item / NCH, c = item % NCH;
    const int d = scan & 1, h = (scan >> 1) % NH, b = scan / (2 * NH);
    const float kkc = p.rw_k_k[layer * RWW + h * 64 + lane], kac = p.rw_k_a[layer * RWW + h * 64 + lane];
    u16* Od = p.O2 + (size_t)d * NTOK * RWW;
    f32x16s acc[2];
    {
      const float* Sg = p.SS + ((size_t)scan * NCH + c) * 4096 + (size_t)(32 * vt + jl) * 64;
#pragma unroll
      for (int tk = 0; tk < 2; ++tk)
#pragma unroll
        for (int q = 0; q < 4; ++q) {
          const f32x4 sv = *(const f32x4*)(Sg + 32 * tk + 8 * q + 4 * hi);
#pragma unroll
          for (int e = 0; e < 4; ++e) acc[tk][4 * q + e] = sv[e];
        }
    }
    ScanRegsN<NI> g;
    scan_load_n<NI>(p, b, h, d, c * SC, lane, ws, g);
    for (int sub = 0; sub < SC / 16; ++sub) {
      const int n0 = c * SC + sub * 16;
      __syncthreads();
      scan_put_n<NI>(g, kkc, kac, sm, slw, lane, ws);
      __syncthreads();
      if (sub + 1 < SC / 16) scan_load_n<NI>(p, b, h, d, n0 + 16, lane, ws, g);
      const float* vrow = sm + 4096 + 32 * vt + jl;
      f32x4 kc[8]; scan_ld8(kc, sm, hi);
      float a0 = sm[1024 + hi * 1024 + jl], a1 = sm[1024 + hi * 1024 + 32 + jl], vc = vrow[0];
#pragma unroll 2
      for (int j = 0; j < 16; ++j) {
        const int jn = (j + 1) & 15;
        f32x4 kn[8]; scan_ld8(kn, sm + jn * 64, hi);
        const float an0 = sm[1024 + hi * 1024 + jn * 64 + jl], an1 = sm[1024 + hi * 1024 + jn * 64 + 32 + jl], vn = vrow[jn * 64];
        SBAR();
        const float sa = scan_dot8(acc, kc);
        const float bop = hi ? vc : sa;
        acc[0] = __builtin_amdgcn_mfma_f32_32x32x2f32(a0, bop, acc[0], 0, 0, 0);
        acc[1] = __builtin_amdgcn_mfma_f32_32x32x2f32(a1, bop, acc[1], 0, 0, 0);
        f32x4 rc[8]; scan_ld8(rc, sm + 3072 + j * 64, hi);
        SBAR();
        const float o = scan_dot8(acc, rc);
        if (hi == 0) so[j * 64 + 32 * vt + jl] = o;
        SBAR();
#pragma unroll
        for (int i = 0; i < 8; ++i) kc[i] = kn[i];
        a0 = an0; a1 = an1; vc = vn;
      }
#pragma unroll
      for (int tk = 0; tk < 2; ++tk)
#pragma unroll
        for (int q = 0; q < 4; ++q) {
          const f32x4 pv = *(const f32x4*)(sm + 5120 + 32 * tk + 8 * q + 4 * hi);
#pragma unroll
          for (int e = 0; e < 4; ++e) acc[tk][4 * q + e] *= pv[e];
        }
      __syncthreads();
#pragma unroll
      for (int jj = 0; jj < 8; ++jj) {
        const int j = ws + 2 * jj; const int n = n0 + j; const int t = d ? (T - 1 - n) : n;
        Od[((size_t)(b * T + t)) * RWW + h * 64 + lane] = f2bf(so[j * 64 + lane]);
      }
    }
  }
}


DI void ph_mixfinish(const P& p, int layer) {
  const int tid_ = tidx(); const int lane = tid_ & 63, w = tid_ >> 6;
  const float* lw = p.rw_lnx_w + layer * RWW; const float* lb = p.rw_lnx_b + layer * RWW;
  const float* kac = p.rw_k_a + layer * RWW; const float* rk = p.rw_r_k + layer * RWW;
  const float* on = p.mla_o_norm + layer * 512;
  float plw[8], plb[8], pka[8], prk[8];
#pragma unroll
  for (int h = 0; h < NH; ++h) { int c = h * 64 + lane; plw[h] = lw[c]; plb[h] = lb[c]; pka[h] = kac[c]; prk[h] = rk[c]; }
  const f32x4 g0 = *(const f32x4*)(on + lane * 4), g1 = *(const f32x4*)(on + 256 + lane * 4);
  for (int tok = blockIdx.x * 8 + w; tok < NTOK; tok += gridDim.x * 8) {
    float o[8], k[8], r[8], vv[8], a0[8], a1[8], gg[8];
#pragma unroll
    for (int h = 0; h < NH; ++h) {
      size_t off = (size_t)tok * RWW + h * 64 + lane;
      o[h] = bf2f(p.O2[off]) + bf2f(p.O2[(size_t)NTOK * RWW + off]);
      k[h] = p.K[off]; r[h] = p.R[off]; vv[h] = p.V[off];
      a0[h] = bf2f(p.AA[off]); a1[h] = bf2f(p.AA[(size_t)NTOK * RWW + off]); gg[h] = bf2f(p.G[off]);
    }
    const float* ao = p.AO + (size_t)tok * 512;
    const f32x4 v0 = *(const f32x4*)(ao + lane * 4), v1 = *(const f32x4*)(ao + 256 + lane * 4);
    float mean[8], var[8], sb[8];
#pragma unroll
    for (int h = 0; h < NH; ++h) mean[h] = wave_sum(o[h]) * (1.f / 64);
#pragma unroll
    for (int h = 0; h < NH; ++h) { float dv = o[h] - mean[h]; o[h] = dv; var[h] = wave_sum(dv * dv) * (1.f / 64); }
#pragma unroll
    for (int h = 0; h < NH; ++h) {
      float kb = 0.5f * (k[h] * (1.f + (a0[h] - 1.f) * pka[h]) + k[h] * (1.f + (a1[h] - 1.f) * pka[h]));
      sb[h] = wave_sum(r[h] * kb * prk[h]);
    }
#pragma unroll
    for (int h = 0; h < NH; ++h) {
      float on_ = o[h] * frsq(var[h] + GN_EPS) * plw[h] + plb[h];
      float y = (on_ + sb[h] * vv[h]) * gg[h];
      p.H[(size_t)tok * DM + h * 64 + lane] = f2bf(y);
    }
    float ss = v0[0] * v0[0] + v0[1] * v0[1] + v0[2] * v0[2] + v0[3] * v0[3] + v1[0] * v1[0] + v1[1] * v1[1] + v1[2] * v1[2] + v1[3] * v1[3];
    ss = wave_sum(ss);
    float rstd = frsq(ss * (1.f / 512) + NORM_EPS);
    *(u32x2*)(p.H + (size_t)tok * DM + 512 + lane * 4) = u32x2{pk2(v0[0] * rstd * g0[0], v0[1] * rstd * g0[1]), pk2(v0[2] * rstd * g0[2], v0[3] * rstd * g0[3])};
    *(u32x2*)(p.H + (size_t)tok * DM + 768 + lane * 4) = u32x2{pk2(v1[0] * rstd * g1[0], v1[1] * rstd * g1[1]), pk2(v1[2] * rstd * g1[2], v1[3] * rstd * g1[3])};
  }
}

DI void ph_norm_router(const P& p, int layer, char* smem) {
  const int tid_ = tidx(); const int lane = tid_ & 63, w = tid_ >> 6;
  float* rtl = (float*)smem;
  float* hl = (float*)(smem + 65536) + w * 1024;
  const float* g = p.ffn_norm + layer * DM;
  const float* rt = p.router + (size_t)layer * DM * NE;
  __syncthreads();
#pragma unroll
  for (int i = 0; i < 8; ++i) *(f32x4*)(rtl + (tid_ + i * NTH) * 4) = *(const f32x4*)(rt + (tid_ + i * NTH) * 4);
  __syncthreads();
  const int cg = lane >> 2, eq = lane & 3;
  for (int tok = blockIdx.x * 8 + w; tok < NTOK; tok += gridDim.x * 8) {
    const f32x4* xr = (const f32x4*)(p.out + (size_t)tok * DM);
    f32x4 v[4]; float ss = 0.f;
#pragma unroll
    for (int j = 0; j < 4; ++j) { v[j] = xr[lane + 64 * j]; ss += v[j][0] * v[j][0] + v[j][1] * v[j][1] + v[j][2] * v[j][2] + v[j][3] * v[j][3]; }
    ss = wave_sum(ss);
    const float rstd = frsq(ss * (1.f / DM) + NORM_EPS);
#pragma unroll
    for (int j = 0; j < 4; ++j) {
      const int c0 = (lane + 64 * j) * 4;
      const f32x4 gg = *(const f32x4*)(g + c0);
      const f32x4 hv = v[j] * rstd * gg;
      *(u32x2*)(p.H + (size_t)tok * DM + c0) = u32x2{pk2(hv[0], hv[1]), pk2(hv[2], hv[3])};
      *(f32x4*)(hl + c0) = hv;
    }
    f32x4 acc = f32x4{0.f, 0.f, 0.f, 0.f};
#pragma unroll 16
    for (int i = 0; i < 64; ++i) {
      const float hv = hl[cg + 16 * i];
      const f32x4 r4 = *(const f32x4*)(rtl + (cg + 16 * i) * 16 + eq * 4);
      acc += hv * r4;
    }
#pragma unroll
    for (int e = 0; e < 4; ++e) {
      float a = acc[e];
      a += dpp_f<0x124>(a); a += dpp_f<0x128>(a);
      a = red_x32(red_x16(a));
      acc[e] = a;
    }
    float mx = fmaxf(fmaxf(acc[0], acc[1]), fmaxf(acc[2], acc[3]));
    mx = fmaxf(mx, dpp_f<0xB1>(mx)); mx = fmaxf(mx, dpp_f<0x4E>(mx));
    f32x4 ex; float se = 0.f;
#pragma unroll
    for (int e = 0; e < 4; ++e) { ex[e] = fexp(acc[e] - mx); se += ex[e]; }
    se = red_x2(red_x1(se));
    const float inv = frcp(se);
    const int b = tok / T, t = tok % T;
    if (lane < 4) {
#pragma unroll
      for (int e = 0; e < 4; ++e) p.AFF[((size_t)(b * NE + eq * 4 + e)) * T + t] = ex[e] * inv;
    }
  }
}

DI void ph_topk(const P& p, char* smem) {
  unsigned* hist = (unsigned*)smem;
  unsigned* sc = hist + 256;
  unsigned* bc = sc + 2048;
  const int tid = tidx();
  for (int item = blockIdx.x; item < NB * NE; item += gridDim.x) {
    const float* a = p.AFF + (size_t)item * T;
    unsigned key[16];
#pragma unroll
    for (int i = 0; i < 4; ++i) {
      uint4 v = *(const uint4*)(a + tid * 16 + i * 4);
      key[i * 4 + 0] = v.x; key[i * 4 + 1] = v.y; key[i * 4 + 2] = v.z; key[i * 4 + 3] = v.w;
    }
    unsigned prefix = 0, mask = 0, need = CAP;
    for (int pass = 0; pass < 4; ++pass) {
      int shift = 24 - 8 * pass;
      __syncthreads();
      if (tid < 256) hist[tid] = 0;
      __syncthreads();
#pragma unroll
      for (int i = 0; i < 16; ++i)
        if ((key[i] & mask) == prefix) atomicAdd(&hist[(key[i] >> shift) & 255u], 1u);
      __syncthreads();
      if (tid == 0) {
        unsigned cum = 0; int bsel = 0; unsigned nd = need;
        for (int bb = 255; bb >= 0; --bb) {
          unsigned hc = hist[bb];
          if (cum + hc >= need) { bsel = bb; nd = need - cum; break; }
          cum += hc;
        }
        bc[0] = prefix | ((unsigned)bsel << shift); bc[1] = nd;
      }
      __syncthreads();
      prefix = bc[0]; need = bc[1]; mask |= (255u << shift);
    }
    unsigned ngt = 0, neq = 0;
#pragma unroll
    for (int i = 0; i < 16; ++i) { ngt += key[i] > prefix; neq += key[i] == prefix; }
    __syncthreads();
    unsigned* sA = sc; unsigned* sB = sc + 512; unsigned* eA = sc + 1024; unsigned* eB = sc + 1536;
    sA[tid] = ngt; eA[tid] = neq;
    __syncthreads();
    for (int off = 1; off < NTH; off <<= 1) {
      unsigned x = sA[tid] + ((tid >= off) ? sA[tid - off] : 0u);
      unsigned y = eA[tid] + ((tid >= off) ? eA[tid - off] : 0u);
      sB[tid] = x; eB[tid] = y;
      __syncthreads();
      unsigned* tmp = sA; sA = sB; sB = tmp; tmp = eA; eA = eB; eB = tmp;
    }
    unsigned gt_excl = sA[tid] - ngt, eq_excl = eA[tid] - neq;
    unsigned gt_total = sA[NTH - 1];
    int* idx = p.IDX + (size_t)item * CAP; float* gate = p.GATE + (size_t)item * CAP;
#pragma unroll
    for (int i = 0; i < 16; ++i) {
      int slot = -1;
      if (key[i] > prefix) { slot = (int)gt_excl; ++gt_excl; }
      else if (key[i] == prefix) { if (eq_excl < need) slot = (int)(gt_total + eq_excl); ++eq_excl; }
      if (slot >= 0) {
        const int tokl = tid * 16 + i;
        idx[slot] = tokl; gate[slot] = __uint_as_float(key[i]);
        const int tokg = (item / NE) * T + tokl;
        const int pos = atomicAdd(&p.TCNT[tokg], 1);
        p.TLIST[(size_t)tokg * 16 + pos] = item * CAP + slot;
      }
    }
    __syncthreads();
  }
}

DI void ph_exp1(const P& p, int layer, char* smem) {
  for (int t = blockIdx.x; t < 32 * 4 * 16; t += gridDim.x) {
    int grp = t / 64, r = t % 64, tm = r / 16, tn = r % 16;
    int b = grp / NE, e = grp % NE;
    const int* gi = p.IDX + (size_t)grp * CAP + tm * GBM;
    const u16* Hb = p.H + (size_t)b * T * DM;
    const float* Wg = p.exp_w_gate + ((size_t)layer * NE + e) * DM * 1024;
    const float* Wu = p.exp_w_up + ((size_t)layer * NE + e) * DM * 1024;
    u16* hid = p.HID + ((size_t)grp * CAP + tm * GBM) * 1024;
    auto arow = [&](int row) -> const void* { return Hb + (size_t)gi[row] * DM; };
    gemm_tile<false, 1>(arow, Wg, Wu, 1024, DM, tn * 64, 1024, smem, [&](int row, int col, float g, float u) {
      float sv = g * frcp(1.f + fexp(-g));
      hid[(size_t)row * 1024 + col] = f2bf(sv * u);
    });
    __syncthreads();
  }
}
DI void ph_exp2(const P& p, int layer, char* smem) {
  for (int t = blockIdx.x; t < 32 * 4 * 8; t += gridDim.x) {
    int grp = t / 32, r = t % 32, tm = r / 8, tn = r % 8;
    int b = grp / NE, e = grp % NE;
    const int* gi = p.IDX + (size_t)grp * CAP + tm * GBM;
    const float* gt = p.GATE + (size_t)grp * CAP + tm * GBM;
    const u16* hid = p.HID + ((size_t)grp * CAP + tm * GBM) * 1024;
    const float* Wd = p.exp_w_down + ((size_t)layer * NE + e) * 1024 * DM;
    float* xb = p.out + (size_t)b * T * DM;
    auto arow = [&](int row) -> const void* { return hid + (size_t)row * 1024; };
    gemm_tile<false, 0>(arow, Wd, nullptr, DM, 1024, tn * GBN, DM, smem, [&](int row, int col, float v, float) {
      unsafeAtomicAdd(xb + (size_t)gi[row] * DM + col, v * gt[row]);
    });
    __syncthreads();
  }
}

namespace g8 {
constexpr int BM = 256, BK = 64, HALF = 128, HTB = HALF * BK * 2, STAGE_BYTES = 8 * HTB, NXCD = 8, WGM = 8;
DI int lds_byte(int r, int c) { const int st = (r >> 4) * 2 + (c >> 5), rr = r & 15, cc = c & 31, ob = rr * 64 + cc * 2; return st * 1024 + (ob ^ (((ob >> 9) & 1) << 5)); }
DI void stage_rc(int b, int& R, int& C) { const int st = b / 1024, sb = b % 1024, swz = sb ^ (((sb >> 9) & 1) << 5); R = (st >> 1) * 16 + swz / 64; C = (st & 1) * 32 + (swz % 64) / 2; }
DI int perm32(int rho) { const int n = rho >> 4, i = rho & 15; return 8 * (i >> 2) + 4 * n + (i & 3); }
struct Unit { int pm, pn; };
struct Sched {
  int nM, nN, nwg, G, c;
  const char* A; const char* Bt; size_t a_tstep, b_tstep; int gdiv, gmod; size_t gstride;
  DI void init(int nM_, int nN_, int G_, int c_, const void* A_, const void* Bt_, int K) {
    nM = nM_; nN = nN_; nwg = nM * nN; G = G_; c = c_; A = (const char*)uni_ptr(A_); Bt = (const char*)uni_ptr(Bt_);
    a_tstep = (size_t)BM * K * 2; b_tstep = (size_t)BM * K * 2; gdiv = 1 << 30; gmod = 1; gstride = 0;
  }
  DI void group(int gdiv_, int gmod_, size_t gstride_) { gdiv = gdiv_; gmod = gmod_; gstride = gstride_; }
  DI bool next(int i, Unit& u) const {
    const long L = (long)i * G + c; if (L >= nwg) return false;
    int wgid = (int)L; { const int q = nwg / NXCD, r = nwg % NXCD, xcd = wgid % NXCD, off = wgid / NXCD; wgid = (xcd < r ? xcd * (q + 1) : r * (q + 1) + (xcd - r) * q) + off; }
    const int nig = WGM * nN, gid = wgid / nig, fm = gid * WGM, gsz = (nM - fm) < WGM ? (nM - fm) : WGM;
    u.pm = fm + ((wgid % nig) % gsz); u.pn = (wgid % nig) / gsz; return true;
  }
  DI const char* a_ptr(const Unit& u) const { return A + (size_t)u.pm * a_tstep; }
  DI const char* b_ptr(const Unit& u) const { return Bt + (size_t)((u.pm / gdiv) % gmod) * gstride + (size_t)u.pn * b_tstep; }
};
using Acc = f32x4[2][2][4][2];

template <class Epi>
DI void gemm_phase(LAS unsigned char* lds, const int K, const Sched& S, const Epi& E) {
  const int tid = tidx(), wid = __builtin_amdgcn_readfirstlane(tid >> 6), lane = tid & 63, wr = wid >> 2, wc = wid & 3, fr = lane & 15, fq = lane >> 4;
  const int nt = K / BK;
  unsigned voffA[2], voffB[2];
#pragma unroll
  for (int i = 0; i < 2; ++i) { int R, C; stage_rc(tid * 16 + i * 8192, R, C); const int Rb = Epi::PERM ? ((R & ~31) + perm32(R & 31)) : R;
    voffA[i] = (unsigned)(R * K + C) * 2u; voffB[i] = (unsigned)(Rb * K + C) * 2u; }
  const size_t kstep = (size_t)(BK * 2);
  const size_t hstep = (size_t)HALF * K * 2;
  const unsigned ldsw = (unsigned)wid * 1024u;
  const int aoff = lds_byte(wr * 64 + fr, fq * 8), boff = lds_byte(wc * 32 + fr, fq * 8);
#define G8_SA(b, h) (((b) * 2 + (h)) * HTB)
#define G8_SB(b, h) ((4 + (b) * 2 + (h)) * HTB)
#define G8_STAGE(bufoff, gbase, voff) do { _Pragma("unroll") for (int _i = 0; _i < 2; ++_i) \
    __builtin_amdgcn_global_load_lds((const unsigned*)((const char*)(gbase) + (voff)[_i]), (LAS unsigned*)(lds + (bufoff) + ldsw + _i * 8192), 16, 0, 0); } while (0)
#define G8_LDA(dst, b, h) do { _Pragma("unroll") for (int m = 0; m < 4; ++m) _Pragma("unroll") for (int k = 0; k < 2; ++k) dst[m][k] = *(const LAS bf16x8*)(lds + G8_SA(b, h) + aoff + m * 2048 + k * 1024); } while (0)
#define G8_LDB(dst, b, h) do { _Pragma("unroll") for (int n = 0; n < 2; ++n) _Pragma("unroll") for (int k = 0; k < 2; ++k) dst[n][k] = *(const LAS bf16x8*)(lds + G8_SB(b, h) + boff + n * 2048 + k * 1024); } while (0)
#define G8_MMA(ai, bj, At, Bt) do { __builtin_amdgcn_s_setprio(1); _Pragma("unroll") for (int m = 0; m < 4; ++m) _Pragma("unroll") for (int n = 0; n < 2; ++n) _Pragma("unroll") for (int k = 0; k < 2; ++k) \
    acc[ai][bj][m][n] = __builtin_amdgcn_mfma_f32_16x16x32_bf16(Bt[n][k], At[m][k], acc[ai][bj][m][n], 0, 0, 0); __builtin_amdgcn_s_setprio(0); } while (0)
#define G8_WAIT_V(n) asm volatile("s_waitcnt vmcnt(" #n ")" ::: "memory")
#define G8_WAIT_L(n) asm volatile("s_waitcnt lgkmcnt(" #n ")" ::: "memory")
#define G8_BAR __builtin_amdgcn_s_barrier()
#define G8_SCHED __builtin_amdgcn_sched_barrier(0)
  Unit cur, nxt; int ui = 0;
  if (!S.next(0, cur)) return;
  f32x4 acc[2][2][4][2];
#pragma unroll
  for (int a = 0; a < 2; ++a)
#pragma unroll
    for (int b = 0; b < 2; ++b)
#pragma unroll
      for (int m = 0; m < 4; ++m)
#pragma unroll
        for (int n = 0; n < 2; ++n) acc[a][b][m][n] = (f32x4){0.f, 0.f, 0.f, 0.f};
  bf16x8 At[4][2], B0[2][2], B1[2][2];
  const char* cA = S.a_ptr(cur); const char* cB = S.b_ptr(cur);
  G8_STAGE(G8_SB(0, 0), cB, voffB); G8_STAGE(G8_SA(0, 0), cA, voffA); G8_STAGE(G8_SB(0, 1), cB + hstep, voffB); G8_STAGE(G8_SA(0, 1), cA + hstep, voffA);
  if (wr == 1) G8_BAR;
  G8_WAIT_V(4); G8_BAR;
  G8_STAGE(G8_SB(1, 0), cB + kstep, voffB); G8_STAGE(G8_SA(1, 0), cA + kstep, voffA); G8_STAGE(G8_SB(1, 1), cB + hstep + kstep, voffB);
  G8_WAIT_V(6); G8_BAR;
  for (;;) {
    const bool has_next = S.next(ui + 1, nxt);
    const char* nA = has_next ? S.a_ptr(nxt) : cA; const char* nB = has_next ? S.b_ptr(nxt) : cB;
    for (int t = 0; t < nt; t += 2) {
      const bool last = (t == nt - 2);
      const char* a1 = cA + (size_t)(t + 1) * kstep;
      const char* a2 = last ? nA : cA + (size_t)(t + 2) * kstep; const char* b2 = last ? nB : cB + (size_t)(t + 2) * kstep;
      const char* a3 = a2 + kstep; const char* b3 = b2 + kstep;
      G8_LDB(B0, 0, 0); G8_SCHED; G8_LDA(At, 0, 0); G8_STAGE(G8_SA(1, 1), a1 + hstep, voffA);
      G8_WAIT_L(8); G8_BAR; G8_WAIT_L(0); G8_MMA(0, 0, At, B0); G8_BAR; G8_SCHED;
      G8_LDB(B1, 0, 1); G8_STAGE(G8_SB(0, 0), b2, voffB);
      G8_BAR; G8_WAIT_L(0); G8_MMA(0, 1, At, B1); G8_BAR;
      G8_LDA(At, 0, 1); G8_STAGE(G8_SA(0, 0), a2, voffA);
      G8_BAR; G8_WAIT_L(0); G8_MMA(1, 0, At, B0); G8_BAR; G8_SCHED;
      G8_STAGE(G8_SB(0, 1), b2 + hstep, voffB);
      G8_WAIT_V(6); G8_BAR; G8_MMA(1, 1, At, B1); G8_BAR;
      G8_LDB(B0, 1, 0); G8_SCHED; G8_LDA(At, 1, 0); G8_STAGE(G8_SA(0, 1), a2 + hstep, voffA);
      G8_WAIT_L(8); G8_BAR; G8_WAIT_L(0); G8_MMA(0, 0, At, B0); G8_BAR; G8_SCHED;
      G8_LDB(B1, 1, 1); G8_STAGE(G8_SB(1, 0), b3, voffB);
      G8_BAR; G8_WAIT_L(0); G8_MMA(0, 1, At, B1); G8_BAR;
      G8_LDA(At, 1, 1); G8_STAGE(G8_SA(1, 0), a3, voffA);
      G8_BAR; G8_WAIT_L(0); G8_MMA(1, 0, At, B0); G8_BAR; G8_SCHED;
      G8_STAGE(G8_SB(1, 1), b3 + hstep, voffB);
      G8_WAIT_V(6); G8_BAR; G8_MMA(1, 1, At, B1); G8_BAR;
    }
    {
      const int t2 = tidx(); const int w2 = __builtin_amdgcn_readfirstlane(t2 >> 6), l2 = t2 & 63;
      E(acc, cur, w2 >> 2, w2 & 3, l2 & 15, l2 >> 4);
    }
    if (!has_next) break;
#pragma unroll
    for (int a = 0; a < 2; ++a)
#pragma unroll
      for (int b = 0; b < 2; ++b)
#pragma unroll
        for (int m = 0; m < 4; ++m)
#pragma unroll
          for (int n = 0; n < 2; ++n) acc[a][b][m][n] = (f32x4){0.f, 0.f, 0.f, 0.f};
    cur = nxt; cA = nA; cB = nB; ++ui;
  }
  G8_WAIT_V(0);
  if (wr == 0) G8_BAR;
  G8_BAR;
#undef G8_SA
#undef G8_SB
#undef G8_STAGE
#undef G8_LDA
#undef G8_LDB
#undef G8_MMA
#undef G8_WAIT_V
#undef G8_WAIT_L
#undef G8_BAR
#undef G8_SCHED
}

struct EpiZ {
  static constexpr bool PERM = false; float* Z;
  DI void operator()(const Acc& acc, const Unit& u, int wr, int wc, int fr, int fq) const {
    const int row0 = u.pm * BM + wr * 64 + fr, col0 = u.pn * BM + wc * 32 + 4 * fq;
#pragma unroll
    for (int ai = 0; ai < 2; ++ai)
#pragma unroll
      for (int m = 0; m < 4; ++m) { float* rowp = Z + (size_t)(row0 + ai * HALF + m * 16) * INC;
#pragma unroll
        for (int bj = 0; bj < 2; ++bj)
#pragma unroll
          for (int n = 0; n < 2; ++n) { const int col = col0 + bj * HALF + n * 16; if (col < INC) *(f32x4*)(rowp + col) = acc[ai][bj][m][n]; } }
  }
};
struct EpiRes {
  static constexpr bool PERM = false; const float* xs; float* xo;
  DI void operator()(const Acc& acc, const Unit& u, int wr, int wc, int fr, int fq) const {
    const int row0 = u.pm * BM + wr * 64 + fr, col0 = u.pn * BM + wc * 32 + 4 * fq;
#pragma unroll
    for (int ai = 0; ai < 2; ++ai)
#pragma unroll
      for (int m = 0; m < 4; ++m) { const size_t ro = (size_t)(row0 + ai * HALF + m * 16) * DM + col0;
#pragma unroll
        for (int bj = 0; bj < 2; ++bj)
#pragma unroll
          for (int n = 0; n < 2; ++n) { const size_t o = ro + bj * HALF + n * 16; *(f32x4*)(xo + o) = *(const f32x4*)(xs + o) + acc[ai][bj][m][n]; } }
  }
};
struct EpiSig {
  static constexpr bool PERM = true; u16* PG;
  DI void operator()(const Acc& acc, const Unit& u, int wr, int wc, int fr, int fq) const {
    const int row0 = u.pm * BM + wr * 64 + fr, col0 = u.pn * BM + wc * 32 + 8 * fq;
#pragma unroll
    for (int ai = 0; ai < 2; ++ai)
#pragma unroll
      for (int m = 0; m < 4; ++m) { u16* rowp = PG + (size_t)(row0 + ai * HALF + m * 16) * DM + col0;
#pragma unroll
        for (int bj = 0; bj < 2; ++bj) { const f32x4 v0 = acc[ai][bj][m][0], v1 = acc[ai][bj][m][1];
          u32x4 wv = {pk2(sigmoidf_(v0[0]), sigmoidf_(v0[1])), pk2(sigmoidf_(v0[2]), sigmoidf_(v0[3])), pk2(sigmoidf_(v1[0]), sigmoidf_(v1[1])), pk2(sigmoidf_(v1[2]), sigmoidf_(v1[3]))};
          *(u32x4*)(rowp + bj * HALF) = wv; } }
  }
};
struct EpiPle {
  static constexpr bool PERM = false; float* xo; const u16* PG;
  DI void operator()(const Acc& acc, const Unit& u, int wr, int wc, int fr, int fq) const {
    const int row0 = u.pm * BM + wr * 64 + fr, col0 = u.pn * BM + wc * 32 + 4 * fq;
#pragma unroll
    for (int ai = 0; ai < 2; ++ai)
#pragma unroll
      for (int m = 0; m < 4; ++m) { const size_t ro = (size_t)(row0 + ai * HALF + m * 16) * DM + col0;
#pragma unroll
        for (int bj = 0; bj < 2; ++bj)
#pragma unroll
          for (int n = 0; n < 2; ++n) { const size_t o = ro + bj * HALF + n * 16; const u32x2 g = *(const u32x2*)(PG + o);
            f32x4 gv = {__uint_as_float(g[0] << 16), __uint_as_float(g[0] & 0xffff0000u), __uint_as_float(g[1] << 16), __uint_as_float(g[1] & 0xffff0000u)};
            *(f32x4*)(xo + o) = *(const f32x4*)(xo + o) + acc[ai][bj][m][n] * gv; } }
  }
};
struct EpiSwi {
  static constexpr bool PERM = true; u16* HID;
  DI void operator()(const Acc& acc, const Unit& u, int wr, int wc, int fr, int fq) const {
    const int row0 = u.pm * BM + wr * 64 + fr, col0 = u.pn * HALF + wc * 32 + 8 * fq;
#pragma unroll
    for (int ai = 0; ai < 2; ++ai)
#pragma unroll
      for (int m = 0; m < 4; ++m) { u16* rowp = HID + (size_t)(row0 + ai * HALF + m * 16) * 1024 + col0;
        float h[8];
#pragma unroll
        for (int n = 0; n < 2; ++n)
#pragma unroll
          for (int j = 0; j < 4; ++j) { const float gt = acc[ai][0][m][n][j], up = acc[ai][1][m][n][j]; h[n * 4 + j] = gt * frcp(1.f + fexp(-gt)) * up; }
        *(u32x4*)rowp = u32x4{pk2(h[0], h[1]), pk2(h[2], h[3]), pk2(h[4], h[5]), pk2(h[6], h[7])}; }
  }
};
struct EpiYE {
  static constexpr bool PERM = true; u16* YE; const float* GATE;
  DI void operator()(const Acc& acc, const Unit& u, int wr, int wc, int fr, int fq) const {
    const int row0 = u.pm * BM + wr * 64 + fr, col0 = u.pn * BM + wc * 32 + 8 * fq;
#pragma unroll
    for (int ai = 0; ai < 2; ++ai)
#pragma unroll
      for (int m = 0; m < 4; ++m) { const int row = row0 + ai * HALF + m * 16; const float gt = GATE[row]; u16* rowp = YE + (size_t)row * 1024 + col0;
#pragma unroll
        for (int bj = 0; bj < 2; ++bj) { const f32x4 v0 = acc[ai][bj][m][0] * gt, v1 = acc[ai][bj][m][1] * gt;
          *(u32x4*)(rowp + bj * HALF) = u32x4{pk2(v0[0], v0[1]), pk2(v0[2], v0[3]), pk2(v1[0], v1[1]), pk2(v1[2], v1[3])}; } }
  }
};
}

DI void cvt_tile_T(const float* __restrict__ src, int ldsrc, int N, int K, u16* __restrict__ dst, int k0, int n0, int drow0, char* smem, int tid) {
  short* tl = (short*)smem;
  __syncthreads();
#pragma unroll
  for (int i = 0; i < 2; ++i) {
    int u = tid + i * NTH; int kr = u >> 4, nq = u & 15; int n = n0 + nq * 4;
    f32x4 v = f32x4{0.f, 0.f, 0.f, 0.f};
    if (n < N) v = *(const f32x4*)(src + (size_t)(k0 + kr) * ldsrc + n);
#pragma unroll
    for (int e = 0; e < 4; ++e) tl[(nq * 4 + e) * 72 + kr] = (short)f2bf(v[e]);
  }
  __syncthreads();
  { int n = tid >> 3, kc = tid & 7;
    *(u32x4*)(dst + (size_t)(drow0 + n) * K + k0 + kc * 8) = *(const u32x4*)(tl + n * 72 + kc * 8); }
}
constexpr int WIN_PAD = 2560;
DI void ph_cvt_small(const P& p, int layer, char* smem) {
  const int tid = tidx();
  const int t0 = 16 * 40, t1 = t0 + 256, t2 = t1 + 256, t3 = t2 + 64;
  for (int t = blockIdx.x; t < t3; t += gridDim.x) {
    if (t < t0) cvt_tile_T(p.w_in + (size_t)layer * DM * INC, INC, INC, DM, p.WIN, (t / 40) * 64, (t % 40) * 64, (t % 40) * 64, smem, tid);
    else if (t < t1) { int q = t - t0; cvt_tile_T(p.w_out + (size_t)layer * DM * DM, DM, DM, DM, p.WOUT, (q / 16) * 64, (q % 16) * 64, (q % 16) * 64, smem, tid); }
    else if (t < t2) { int q = t - t1; cvt_tile_T(p.ple_gate + (size_t)layer * DM * DM, DM, DM, DM, p.WPG, (q / 16) * 64, (q % 16) * 64, (q % 16) * 64, smem, tid); }
    else { int q = t - t2; cvt_tile_T(p.ple_proj + (size_t)layer * DPLE * DM, DM, DM, DPLE, p.WPP, (q / 16) * 64, (q % 16) * 64, (q % 16) * 64, smem, tid); }
  }
  const float* ps = p.p + (size_t)layer * NTOK * DPLE;
  for (int i = blockIdx.x * NTH + tid; i < NTOK * DPLE / 8; i += gridDim.x * NTH) {
    f32x4 a = *(const f32x4*)(ps + (size_t)i * 8), b = *(const f32x4*)(ps + (size_t)i * 8 + 4);
    *(u32x4*)(p.PB + (size_t)i * 8) = u32x4{pk2(a[0], a[1]), pk2(a[2], a[3]), pk2(b[0], b[1]), pk2(b[2], b[3])};
  }
}

struct CvtJob { const float* src; u16* dst; int k0, n0, drow0; };
DI bool cvt_job(const P& p, int layer, int t, CvtJob& j) {
  if (t >= NE * 3 * 128) return false;
  const int e = t / 384, r = t % 384, mat = r / 128, q = r % 128;
  j.k0 = (q / 8) * 64; j.n0 = (q % 8) * 128;
  const size_t eo = ((size_t)layer * NE + e) * 1024 * 1024;
  if (mat == 0) { j.src = p.exp_w_gate + eo; j.dst = p.EW1 + (size_t)e * 2048 * 1024; j.drow0 = (j.n0 >> 7) * 256; }
  else if (mat == 1) { j.src = p.exp_w_up + eo; j.dst = p.EW1 + (size_t)e * 2048 * 1024; j.drow0 = (j.n0 >> 7) * 256 + 128; }
  else { j.src = p.exp_w_down + eo; j.dst = p.EW2 + (size_t)e * 1024 * 1024; j.drow0 = j.n0; }
  return true;
}
DI void ph_cvt_experts(const P& p, int layer, char* smem, unsigned* ctr) {
  const int tid = tidx();
  short* tl = (short*)smem;
  int* sitem = (int*)(smem + 32768);
  __syncthreads();
  if (tid == 0) sitem[0] = (int)atomicAdd(ctr, 1u);
  __syncthreads();
  CvtJob cur; bool has = cvt_job(p, layer, sitem[0], cur);
  f32x4 v[4];
  const int kr = tid >> 5, nq = tid & 31;
  if (has) {
#pragma unroll
    for (int i = 0; i < 4; ++i) v[i] = *(const f32x4*)(cur.src + (size_t)(cur.k0 + kr + 16 * i) * 1024 + cur.n0 + nq * 4);
  }
  int par = 0;
  while (has) {
    if (tid == 0) sitem[1 + par] = (int)atomicAdd(ctr, 1u);
    __syncthreads();
#pragma unroll
    for (int i = 0; i < 4; ++i)
#pragma unroll
      for (int e = 0; e < 4; ++e) tl[(nq * 4 + e) * 72 + kr + 16 * i] = (short)f2bf(v[i][e]);
    __syncthreads();
    CvtJob nxt; const bool hn = cvt_job(p, layer, sitem[1 + par], nxt);
    if (hn) {
#pragma unroll
      for (int i = 0; i < 4; ++i) v[i] = *(const f32x4*)(nxt.src + (size_t)(nxt.k0 + kr + 16 * i) * 1024 + nxt.n0 + nq * 4);
    }
#pragma unroll
    for (int i = 0; i < 2; ++i) {
      int u = tid + i * NTH; int n = u >> 3, kc = u & 7;
      *(u32x4*)(cur.dst + (size_t)(cur.drow0 + n) * 1024 + cur.k0 + kc * 8) = *(const u32x4*)(tl + n * 72 + kc * 8);
    }
    cur = nxt; has = hn; par ^= 1;
  }
}
DI void ph_gather(const P& p) {
  const int tid_ = tidx(); const int lane = tid_ & 63, w = tid_ >> 6;
  for (int row = blockIdx.x * 8 + w; row < NB * NE * CAP; row += gridDim.x * 8) {
    const int b = row / (NE * CAP);
    const int tok = b * T + p.IDX[row];
    const u32x4* src = (const u32x4*)(p.H + (size_t)tok * DM);
    u32x4* dst = (u32x4*)(p.XE + (size_t)row * DM);
    u32x4 a = src[lane], c = src[lane + 64];
    dst[lane] = a; dst[lane + 64] = c;
  }
}
DI void ph_combine_norm(const P& p, int layer) {
  const int tid_ = tidx(); const int lane = tid_ & 63, w = tid_ >> 6;
  const float* g = p.ple_norm + layer * DM;
  for (int tok = blockIdx.x * 8 + w; tok < NTOK; tok += gridDim.x * 8) {
    f32x4* xr = (f32x4*)(p.out + (size_t)tok * DM);
    f32x4 v[4];
#pragma unroll
    for (int j = 0; j < 4; ++j) v[j] = xr[lane * 4 + j];
    const int cnt = p.TCNT[tok];
    for (int q = 0; q < cnt; ++q) {
      const int yrow = p.TLIST[(size_t)tok * 16 + q];
      const u32x4* yr = (const u32x4*)(p.YE + (size_t)yrow * DM + lane * 16);
      u32x4 a = yr[0], c = yr[1];
#pragma unroll
      for (int e = 0; e < 4; ++e) {
        v[e >> 1][(e & 1) * 2] += __uint_as_float(a[e] << 16); v[e >> 1][(e & 1) * 2 + 1] += __uint_as_float(a[e] & 0xffff0000u);
        v[2 + (e >> 1)][(e & 1) * 2] += __uint_as_float(c[e] << 16); v[2 + (e >> 1)][(e & 1) * 2 + 1] += __uint_as_float(c[e] & 0xffff0000u);
      }
    }
    float ss = 0.f;
#pragma unroll
    for (int j = 0; j < 4; ++j) { xr[lane * 4 + j] = v[j]; ss += v[j][0] * v[j][0] + v[j][1] * v[j][1] + v[j][2] * v[j][2] + v[j][3] * v[j][3]; }
    ss = wave_sum(ss);
    const float rstd = frsq(ss * (1.f / DM) + NORM_EPS);
    u32x4 o0, o1;
#pragma unroll
    for (int j = 0; j < 4; ++j) {
      f32x4 gg = *(const f32x4*)(g + lane * 16 + j * 4);
      unsigned lo = pk2(v[j][0] * rstd * gg[0], v[j][1] * rstd * gg[1]), hi = pk2(v[j][2] * rstd * gg[2], v[j][3] * rstd * gg[3]);
      if (j < 2) { o0[j * 2] = lo; o0[j * 2 + 1] = hi; } else { o1[(j - 2) * 2] = lo; o1[(j - 2) * 2 + 1] = hi; }
    }
    *(u32x4*)(p.H + (size_t)tok * DM + lane * 16) = o0; *(u32x4*)(p.H + (size_t)tok * DM + lane * 16 + 8) = o1;
  }
}

#define XB_TMO      128
#define XB_XCNT(j)  (256  + 64 * (j))
#define XB_XSUB(j)  (1280 + 64 * (j))
#define XB_XGEN(j)  (2304 + 64 * (j))
#define XB_TOP      3328
#define XB_TOPGEN   3392
#define XCD_BAR_WORDS 3456
#define XB_SPIN_CAP (1u << 20)
DI unsigned xb_ld(unsigned* p) { return __hip_atomic_load(p, __ATOMIC_RELAXED, __HIP_MEMORY_SCOPE_AGENT); }
DI unsigned xb_add(unsigned* p, unsigned v) { return __hip_atomic_fetch_add(p, v, __ATOMIC_RELAXED, __HIP_MEMORY_SCOPE_AGENT); }
DI unsigned xb_xcc_id() { return (unsigned)__builtin_amdgcn_s_getreg((3 << 11) | 20) & 0xFu; }
#define XB_SPIN(cond, bar) do { unsigned _sp = 0; while (cond) { __builtin_amdgcn_s_sleep(1); \
    if ((++_sp & 255u) == 0u) { if (xb_ld(&(bar)[XB_TMO])) break; if (_sp > XB_SPIN_CAP) { atomicAdd(&(bar)[XB_TMO], 1u); break; } } } } while (0)
struct XcdBarrier { unsigned* bar; unsigned x; volatile LAS unsigned* st; };
DI XcdBarrier xcd_barrier_post(unsigned* bar, volatile LAS unsigned* st) {
  XcdBarrier b; b.bar = bar; b.x = xb_xcc_id(); b.st = st;
  if (threadIdx.x == 0) (void)xb_add(&bar[XB_XCNT(b.x)], 1u);
  return b;
}
DI void xcd_barrier_complete(unsigned* bar, unsigned x, unsigned& nloc, unsigned& nx) {
  const unsigned G = gridDim.x * gridDim.y * gridDim.z;
  unsigned sum, cnt, mine, sp = 0u;
  for (;;) {
    sum = 0u; cnt = 0u; mine = 0u;
#pragma unroll
    for (unsigned j = 0; j < 16; ++j) { const unsigned c = xb_ld(&bar[XB_XCNT(j)]); sum += c; cnt += (c > 0u) ? 1u : 0u; mine = (j == x) ? c : mine; }
    if (sum == G) break;
    __builtin_amdgcn_s_sleep(1);
    if ((++sp & 255u) == 0u) { if (xb_ld(&bar[XB_TMO])) break; if (sp > XB_SPIN_CAP) { atomicAdd(&bar[XB_TMO], 1u); break; } }
  }
  nloc = mine > 0u ? mine : 1u; nx = cnt > 0u ? cnt : 1u;
}
DI void xcd_barrier(const XcdBarrier& b) {
  asm volatile("s_waitcnt vmcnt(0)" ::: "memory");
  __syncthreads();
  if (threadIdx.x == 0) {
    unsigned* bar = b.bar;
    __builtin_amdgcn_s_waitcnt(0);
    unsigned nloc = b.st[0], nx = b.st[1];
    if (nloc == 0u) { xcd_barrier_complete(bar, b.x, nloc, nx); b.st[0] = nloc; b.st[1] = nx; }
    const unsigned old = xb_add(&bar[XB_XSUB(b.x)], 1u);
    const unsigned gen = old / nloc;
    if (old + 1u == (gen + 1u) * nloc) {
      __builtin_amdgcn_fence(__ATOMIC_RELEASE, "agent");
      asm volatile("s_waitcnt vmcnt(0)" ::: "memory");
      const unsigned og = xb_add(&bar[XB_TOP], 1u);
      const unsigned tg = og / nx;
      if (og + 1u == (tg + 1u) * nx) xb_add(&bar[XB_TOPGEN], 1u);
      else XB_SPIN(xb_ld(&bar[XB_TOPGEN]) == tg, bar);
      __builtin_amdgcn_fence(__ATOMIC_ACQUIRE, "agent");
      xb_add(&bar[XB_XGEN(b.x)], 1u);
      asm volatile("s_waitcnt vmcnt(0)" ::: "memory");
    } else {
      XB_SPIN(xb_ld(&bar[XB_XGEN(b.x)]) == gen, bar);
      __builtin_amdgcn_fence(__ATOMIC_ACQUIRE, "agent");
      asm volatile("s_waitcnt vmcnt(0)" ::: "memory");
    }
  }
  __syncthreads();
}

#define TAKE(bytes) (ws + off); off += (((size_t)(bytes)) + 255) & ~(size_t)255
__host__ __device__ inline size_t fill_ws(P& p, char* ws) {
  size_t off = 0;
  char* regA = TAKE((size_t)NTOK * INC * 4);
  p.Z = (float*)regA;
  p.LW = (u16*)regA; p.AA = (u16*)(regA + (size_t)2 * NTOK * RWW * 2); p.G = (u16*)(regA + (size_t)4 * NTOK * RWW * 2);
  p.MC = (float*)(regA + (size_t)5 * NTOK * RWW * 2); p.NC = p.MC + (size_t)32 * NCH * 4096;
  p.HID = (u16*)regA;
  char* regB = TAKE((size_t)3 * NTOK * RWW * 4);
  p.R = (float*)regB; p.K = p.R + (size_t)NTOK * RWW; p.V = p.K + (size_t)NTOK * RWW;
  p.PG = (float*)regB;
  char* regC = TAKE((size_t)NTOK * (768 + 1024) * 4);
  p.QRAW = (float*)regC; p.KVRAW = p.QRAW + (size_t)NTOK * 768;
  p.AO = (float*)regC; p.O2 = (u16*)(p.AO + (size_t)NTOK * 512); p.SS = (float*)(p.O2 + (size_t)2 * NTOK * 512);
  p.TWD = (u16*)TAKE((size_t)2 * NTOK * 64 * 2); p.AD = (u16*)TAKE((size_t)2 * NTOK * 64 * 2);
  p.SGD = (u16*)TAKE((size_t)NTOK * 128 * 2); p.QDN = (u16*)TAKE((size_t)NTOK * 256 * 2);
  p.KVDN = (u16*)TAKE((size_t)NTOK * 128 * 2); p.KR = (float*)TAKE((size_t)NTOK * 32 * 4);
  p.ROPE = (float*)TAKE((size_t)NTOK * 32 * 4);
  p.Q = (u16*)TAKE((size_t)NTOK * NH * 96 * 2); p.Kc = (u16*)TAKE((size_t)NTOK * NH * 96 * 2);
  p.Vv = (u16*)TAKE((size_t)NTOK * NH * 64 * 2);
  p.H = (u16*)TAKE((size_t)NTOK * DM * 2);
  p.AFF = (float*)TAKE((size_t)NB * NE * T * 4);
  p.IDX = (int*)TAKE((size_t)NB * NE * CAP * 4);
  p.GATE = (float*)TAKE((size_t)NB * NE * CAP * 4);

  p.WIN = (u16*)TAKE((size_t)WIN_PAD * DM * 2); p.WOUT = (u16*)TAKE((size_t)DM * DM * 2); p.WPG = (u16*)TAKE((size_t)DM * DM * 2);
  p.WPP = (u16*)TAKE((size_t)DM * DPLE * 2); p.PB = (u16*)TAKE((size_t)NTOK * DPLE * 2);
  p.PGb = (u16*)regB;
  p.EW1 = (u16*)regB; p.EW2 = p.EW1 + (size_t)NE * 2048 * 1024;
  p.XE = (u16*)regA; p.HID = (u16*)(regA + (size_t)32 * 1024 * 1024 * 2);
  p.YE = (u16*)regC;
  p.TCNT = (int*)TAKE((size_t)NTOK * 4); p.TLIST = (int*)TAKE((size_t)NTOK * 16 * 4);
  p.CTR = (unsigned*)TAKE(256);
  p.BAR = (unsigned*)TAKE(XCD_BAR_WORDS * 4);
  return off;
}
#undef TAKE
constexpr int DSM_BYTES = g8::STAGE_BYTES + 64;
extern __shared__ __attribute__((aligned(16))) char dsm[];
struct PK { const void* in[31]; float* out; char* ws; };
DI void build_params(P& p, const PK& k) {
  p.x = (const float*)k.in[0]; p.p = (const float*)k.in[1]; p.pos = (const int*)k.in[2];
  p.attn_norm = (const float*)k.in[3]; p.w_in = (const float*)k.in[4]; p.rw_mu = (const float*)k.in[5];
  p.rw_w0 = (const float*)k.in[6]; p.rw_w_up = (const float*)k.in[7]; p.rw_a0 = (const float*)k.in[8];
  p.rw_a_up = (const float*)k.in[9]; p.rw_g_up = (const float*)k.in[10]; p.rw_k_k = (const float*)k.in[11];
  p.rw_k_a = (const float*)k.in[12]; p.rw_r_k = (const float*)k.in[13]; p.rw_lnx_w = (const float*)k.in[14];
  p.rw_lnx_b = (const float*)k.in[15]; p.mla_q_norm = (const float*)k.in[16]; p.mla_q_up = (const float*)k.in[17];
  p.mla_kv_norm = (const float*)k.in[18]; p.mla_kv_up = (const float*)k.in[19]; p.mla_o_norm = (const float*)k.in[20];
  p.w_out = (const float*)k.in[21]; p.ffn_norm = (const float*)k.in[22]; p.router = (const float*)k.in[23];
  p.exp_w_gate = (const float*)k.in[24]; p.exp_w_up = (const float*)k.in[25]; p.exp_w_down = (const float*)k.in[26];
  p.ple_norm = (const float*)k.in[27]; p.ple_proj = (const float*)k.in[28]; p.ple_gate = (const float*)k.in[29];
  p.final_norm = (const float*)k.in[30];
  p.out = k.out;
  (void)fill_ws(p, k.ws);
}
__global__ void __launch_bounds__(NTH) mega(PK pk) {
  P p; build_params(p, pk);
  char* smem = dsm;
  LAS unsigned char* glds = (LAS unsigned char*)dsm;
  uint4* xbw = (uint4*)(dsm + g8::STAGE_BYTES);
  cg::grid_group grid = cg::this_grid();
  if (threadIdx.x == 0) *xbw = make_uint4(0u, 0u, 0u, 0u);
  if (blockIdx.x == 0) {
    if (threadIdx.x < 16) p.CTR[threadIdx.x] = 0u;
    for (int i = threadIdx.x; i < XCD_BAR_WORDS; i += NTH) p.BAR[i] = 0u;
  }
  grid.sync();
  const XcdBarrier xb = xcd_barrier_post(p.BAR, (volatile LAS unsigned*)xbw);
#define GSYNC() xcd_barrier(xb)
#ifndef PROBE_MASK
#define PROBE_MASK 0u
#endif
#if PROBE_MASK
  unsigned long long pt0 = __builtin_amdgcn_s_memrealtime();
#define PSYNC(id) do { GSYNC(); if (PROBE_MASK & (1u << (id))) { unsigned long long t1_ = __builtin_amdgcn_s_memrealtime(); unsigned long long dt_ = t1_ - pt0; \
    while (__builtin_amdgcn_s_memrealtime() - t1_ < dt_) __builtin_amdgcn_s_sleep(8); } pt0 = __builtin_amdgcn_s_memrealtime(); } while (0)
#else
#define PSYNC(id) GSYNC()
#endif
  for (int layer_ = 0; layer_ < NL; ++layer_) {
    int layer = layer_; asm volatile("" : "+s"(layer));
    if (layer_ == 0) ph_rope_table(p);
    ph_cvt_small(p, layer, smem);
    ph_norm(layer == 0 ? p.x : p.out, p.attn_norm + layer * DM, p.H);
    PSYNC(0);
    {
      g8::Sched S; S.init(NTOK / 256, WIN_PAD / 256, gridDim.x, bidx(), p.H, p.WIN, DM);
      g8::EpiZ E{p.Z};
      g8::gemm_phase(glds, DM, S, E);
    }
    PSYNC(1);
    ph_rwshift(p, layer);
    ph_mlaprep1(p, layer);
    PSYNC(2);
    for (int d = 0; d < 2; ++d) {
      u16* LW = p.LW + (size_t)d * NTOK * RWW; const float* w0 = p.rw_w0 + (layer * 2 + d) * RWW;
      ph_gemm<false>(p.TWD + (size_t)d * NTOK * 64, 64, p.rw_w_up + ((size_t)(layer * 2 + d)) * 64 * RWW, RWW, NTOK, RWW, 64, smem,
                     [&](int row, int col, float v) { LW[(size_t)row * RWW + col] = f2bf(-0.6065306597126334f * sigmoidf_(v + w0[col])); });
      u16* AA = p.AA + (size_t)d * NTOK * RWW; const float* a0 = p.rw_a0 + (layer * 2 + d) * RWW;
      ph_gemm<false>(p.AD + (size_t)d * NTOK * 64, 64, p.rw_a_up + ((size_t)(layer * 2 + d)) * 64 * RWW, RWW, NTOK, RWW, 64, smem,
                     [&](int row, int col, float v) { AA[(size_t)row * RWW + col] = f2bf(sigmoidf_(v + a0[col])); });
    }
    {
      u16* G = p.G;
      ph_gemm<false>(p.SGD, 128, p.rw_g_up + (size_t)layer * 128 * RWW, RWW, NTOK, RWW, 128, smem,
                     [&](int row, int col, float v) { G[(size_t)row * RWW + col] = f2bf(v); });
      {
        u16* Qo = p.Q; const float* rope = p.ROPE;
        ph_gemm_t(p.QDN, 256, p.mla_q_up + (size_t)layer * 256 * 768, 768, NTOK, 768, 256, smem,
                  [&](const f32x4 (&acc)[4][4], int m0, int n0, int wm, int wn, int lq, int l15) {
          const float qs = 0.10206207261596577f * 1.4426950408889634f;
#pragma unroll
          for (int mi = 0; mi < 4; ++mi)
#pragma unroll
            for (int r = 0; r < 4; ++r) {
              const int tok = m0 + wm * 64 + mi * 16 + lq * 4 + r; const int b = tok / T, t = tok % T;
#pragma unroll
              for (int ni = 0; ni < 4; ++ni) {
                const int col0 = n0 + wn * 64 + ni * 16; const int h = col0 / 96, c0 = col0 % 96;
                u16* qo = Qo + ((size_t)(b * NH + h) * T + t) * 96;
                if (c0 < 64) qo[c0 + l15] = f2bf(acc[mi][ni][r] * qs);
                else if (c0 == 64) {
                  const f32x2 csn = *(const f32x2*)(rope + (size_t)tok * 32 + l15 * 2);
                  const float u1 = acc[mi][ni][r], u2 = acc[mi][(ni + 1) & 3][r];
                  qo[64 + l15] = f2bf((u1 * csn[0] - u2 * csn[1]) * qs);
                  qo[80 + l15] = f2bf((u1 * csn[1] + u2 * csn[0]) * qs);
                }
              }
            }
        });
      }
      {
        u16* Ko = p.Kc; u16* Vo = p.Vv;
        ph_gemm_t(p.KVDN, 128, p.mla_kv_up + (size_t)layer * 128 * 1024, 1024, NTOK, 1024, 128, smem,
                  [&](const f32x4 (&acc)[4][4], int m0, int n0, int wm, int wn, int lq, int l15) {
#pragma unroll
          for (int mi = 0; mi < 4; ++mi)
#pragma unroll
            for (int r = 0; r < 4; ++r) {
              const int tok = m0 + wm * 64 + mi * 16 + lq * 4 + r; const int b = tok / T, t = tok % T;
#pragma unroll
              for (int ni = 0; ni < 4; ++ni) {
                const int col0 = n0 + wn * 64 + ni * 16; const int h = col0 >> 7, c0 = col0 & 127;
                const size_t rowi = (size_t)(b * NH + h) * T + t;
                if (c0 < 64) Ko[rowi * 96 + c0 + l15] = f2bf(acc[mi][ni][r]);
                else Vo[rowi * 64 + (c0 - 64) + l15] = f2bf(acc[mi][ni][r]);
              }
            }
        });
      }
    }
    PSYNC(3);
    ph_scan1(p, layer, smem);
    PSYNC(4);
    ph_scan2(p, smem);
    ph_attn(p, smem, p.CTR + layer);
    PSYNC(5);
    ph_scan3(p, layer, smem);
    PSYNC(6);
    ph_mixfinish(p, layer);
    PSYNC(7);
    {
      for (int i = blockIdx.x * NTH + tidx(); i < NTOK; i += gridDim.x * NTH) p.TCNT[i] = 0;
      g8::Sched S; S.init(NTOK / 256, DM / 256, gridDim.x, bidx(), p.H, p.WOUT, DM);
      g8::EpiRes E{(layer == 0) ? p.x : p.out, p.out};
      g8::gemm_phase(glds, DM, S, E);
    }
    PSYNC(8);
    ph_norm_router(p, layer, smem);
    PSYNC(9);
    ph_topk(p, smem);
    ph_cvt_experts(p, layer, smem, p.CTR + 4 + layer);
    PSYNC(10);
    ph_gather(p);
    PSYNC(11);
    {
      g8::Sched S; S.init(NB * NE * CAP / 256, 2048 / 256, gridDim.x, bidx(), p.XE, p.EW1, DM);
      S.group(4, NE, (size_t)2048 * 1024 * 2);
      g8::EpiSwi E{p.HID};
      g8::gemm_phase(glds, DM, S, E);
    }
    PSYNC(12);
    {
      g8::Sched S; S.init(NB * NE * CAP / 256, DM / 256, gridDim.x, bidx(), p.HID, p.EW2, 1024);
      S.group(4, NE, (size_t)1024 * 1024 * 2);
      g8::EpiYE E{p.YE, p.GATE};
      g8::gemm_phase(glds, 1024, S, E);
    }
    PSYNC(13);
    ph_combine_norm(p, layer);
    PSYNC(16);
    {
      g8::Sched S; S.init(NTOK / 256, DM / 256, gridDim.x, bidx(), p.H, p.WPG, DM);
      g8::EpiSig E{p.PGb};
      g8::gemm_phase(glds, DM, S, E);
    }
    {
      g8::Sched S; S.init(NTOK / 256, DM / 256, gridDim.x, bidx(), p.PB, p.WPP, DPLE);
      g8::EpiPle E{p.out, p.PGb};
      g8::gemm_phase(glds, DPLE, S, E);
    }
    PSYNC(15);
  }
  ph_final_norm(p.out, p.final_norm);
}

extern "C" void kernel_launch(void* const* d_in, const int* in_sizes, int n_in, void* d_out, int out_size, void* d_ws,
                              size_t ws_size, hipStream_t stream) {
  (void)in_sizes; (void)n_in; (void)out_size;
  PK pk{};
  for (int i = 0; i < 31; ++i) pk.in[i] = d_in[i];
  pk.out = (float*)d_out; pk.ws = (char*)d_ws;
  P p{};
  const size_t off = fill_ws(p, (char*)d_ws);
  if (off > ws_size) { fprintf(stderr, "workspace too small: need %zu have %zu\n", off, ws_size); return; }
  static int grid_blocks = 0;
  if (!grid_blocks) {
    int dev = 0, cus = 0, per_cu = 0;
    hipGetDevice(&dev);
    hipDeviceGetAttribute(&cus, hipDeviceAttributeMultiprocessorCount, dev);
    hipFuncSetAttribute((const void*)mega, hipFuncAttributeMaxDynamicSharedMemorySize, DSM_BYTES);
    hipOccupancyMaxActiveBlocksPerMultiprocessor(&per_cu, mega, NTH, DSM_BYTES);
    if (per_cu > 1) per_cu = 1;
    grid_blocks = cus * per_cu;
  }
  void* args[] = {&pk};
  hipError_t e = hipLaunchCooperativeKernel((void*)mega, dim3(grid_blocks), dim3(NTH), args, DSM_BYTES, stream);
  if (e != hipSuccess) fprintf(stderr, "cooperative launch failed: %s (grid %d)\n", hipGetErrorString(e), grid_blocks);
}
```

```cpp
#include <hip/hip_runtime.h>
#include <hip/hip_bf16.h>
#include <cstdio>
#include <cstdint>
#include <hip/hip_cooperative_groups.h>
namespace cg = cooperative_groups;

#define DI __device__ __forceinline__
#define LAS __attribute__((address_space(3)))

constexpr int NB = 2, T = 8192, NTOK = NB * T, DM = 1024, NL = 2;
constexpr int RWW = 512, RWC = 1920, INC = 2336;
constexpr int NH = 8;
constexpr int NE = 16, CAP = 1024;
constexpr int DPLE = 256;
constexpr int NTH = 512;
constexpr float NORM_EPS = 1e-6f, GN_EPS = 64e-5f;

using bf16x8 = __attribute__((ext_vector_type(8))) short;
using s16x4  = __attribute__((ext_vector_type(4))) short;
using f32x4  = __attribute__((ext_vector_type(4))) float;
using u32x4  = __attribute__((ext_vector_type(4))) unsigned;
using f32x2  = __attribute__((ext_vector_type(2))) float;
using u32x2  = __attribute__((ext_vector_type(2))) unsigned;
typedef __bf16 bf2_t __attribute__((ext_vector_type(2)));
typedef unsigned short u16;

DI unsigned pk2(float a, float b) { bf2_t v = {(__bf16)a, (__bf16)b}; return __builtin_bit_cast(unsigned, v); }
DI u16 f2bf(float a) { return (u16)(pk2(a, 0.f) & 0xffffu); }
DI float bf2f(u16 u) { return __uint_as_float(((unsigned)u) << 16); }
DI const void* uni_ptr(const void* q) {
  unsigned long long v = (unsigned long long)q;
  unsigned lo = __builtin_amdgcn_readfirstlane((unsigned)v), hi = __builtin_amdgcn_readfirstlane((unsigned)(v >> 32));
  return (const void*)(((unsigned long long)hi << 32) | lo);
}
DI int tidx() { int t = threadIdx.x; asm volatile("" : "+v"(t)); return t; }
DI int bidx() { int b = blockIdx.x; asm volatile("" : "+s"(b)); return b; }
template <int CTRL> DI float dpp_f(float v) {
  return __int_as_float(__builtin_amdgcn_update_dpp(__float_as_int(v), __float_as_int(v), CTRL, 0xF, 0xF, true));
}
DI float red_x1(float v) { return v + dpp_f<0xB1>(v); }
DI float red_x2(float v) { return v + dpp_f<0x4E>(v); }
DI float red_x4(float v) { return v + dpp_f<0x141>(v); }
DI float red_x8(float v) { return v + dpp_f<0x140>(v); }
DI float red_x16(float v) { auto r = __builtin_amdgcn_permlane16_swap(__float_as_uint(v), __float_as_uint(v), false, false); return __uint_as_float(r[0]) + __uint_as_float(r[1]); }
DI float red_x32(float v) { auto r = __builtin_amdgcn_permlane32_swap(__float_as_uint(v), __float_as_uint(v), false, false); return __uint_as_float(r[0]) + __uint_as_float(r[1]); }
DI float red16(float v) { return red_x8(red_x4(red_x2(red_x1(v)))); }
DI float wave_sum(float v) { return red_x32(red_x16(red16(v))); }
DI float frcp(float x) { return __builtin_amdgcn_rcpf(x); }
DI float frsq(float x) { return __builtin_amdgcn_rsqf(x); }
DI float fexp(float x) { return __builtin_amdgcn_exp2f(x * 1.4426950408889634f); }
DI float sigmoidf_(float x) { return frcp(1.f + fexp(-x)); }
DI float ftanh(float x) { return 1.f - 2.f * frcp(1.f + fexp(2.f * x)); }
DI s16x4 tr_read(const short* p) {
  return __builtin_amdgcn_ds_read_tr16_b64_v4i16((LAS s16x4*)(p));
}

struct P {
  const float* x; const float* p; const int* pos;
  const float* attn_norm; const float* w_in; const float* rw_mu; const float* rw_w0; const float* rw_w_up;
  const float* rw_a0; const float* rw_a_up; const float* rw_g_up; const float* rw_k_k; const float* rw_k_a;
  const float* rw_r_k; const float* rw_lnx_w; const float* rw_lnx_b; const float* mla_q_norm; const float* mla_q_up;
  const float* mla_kv_norm; const float* mla_kv_up; const float* mla_o_norm; const float* w_out; const float* ffn_norm;
  const float* router; const float* exp_w_gate; const float* exp_w_up; const float* exp_w_down; const float* ple_norm;
  const float* ple_proj; const float* ple_gate; const float* final_norm;
  float* out;
  float* Z;
  u16* LW;
  u16* AA;
  float* MC; float* NC;
  float* SS;
  u16*   G;
  u16*   HID;
  float* R; float* K; float* V;
  float* PG;
  float* QRAW;
  float* KVRAW;
  float* AO;
  u16* O2;
  u16* TWD; u16* AD; u16* SGD; u16* QDN; u16* KVDN; float* KR;
  float* ROPE;
  u16* Q; u16* Kc; u16* Vv;
  u16* H;
  float* AFF;
  int* IDX;
  float* GATE;
  u16* WIN; u16* WOUT; u16* WPG; u16* WPP; u16* PB;
  u16* PGb;
  u16* EW1; u16* EW2;
  u16* XE; u16* YE;
  int* TCNT; int* TLIST;
  unsigned* CTR;
  unsigned* BAR;
};

constexpr int GBM = 256, GBN = 128, GBK = 64;
constexpr int AS_STRIDE = 72, BS_STRIDE = 136;
constexpr int AS_BYTES = GBM * AS_STRIDE * 2;
constexpr int BS_BYTES = GBK * BS_STRIDE * 2;
constexpr int SMEM_BYTES = 57344;

template <bool A_F32, int MODE, class ARow, class Epi>
DI void gemm_tile(ARow arow, const float* __restrict__ B, const float* __restrict__ B2, int ldb, int K, int n0, int Nvalid,
                  char* smem, Epi epi) {
  short* As = (short*)smem;
  short* Bs = (short*)(smem + AS_BYTES);
  const int tid = tidx(), lane = tid & 63, w = tid >> 6;
  const int wm = w >> 1, wn = w & 1;
  const int l15 = lane & 15, lq = lane >> 4;

  const char* ap[4];
#pragma unroll
  for (int i = 0; i < 4; ++i) {
    int u = tid + i * NTH; int row = u >> 3, kc = u & 7;
    ap[i] = (const char*)arow(row) + (size_t)kc * 8 * (A_F32 ? 4 : 2);
  }
  const float* bp[4]; bool bok[4];
#pragma unroll
  for (int i = 0; i < 4; ++i) {
    int u = tid + i * NTH; int k = u >> 5, nq = u & 31;
    int col; const float* base;
    if (MODE != 1) { col = n0 + nq * 4; base = B; }
    else { col = n0 + (nq & 15) * 4; base = (nq < 16) ? B : B2; }
    bok[i] = col < Nvalid;
    bp[i] = base + (size_t)k * ldb + (bok[i] ? col : 0);
  }

  f32x4 acc[4][4];
#pragma unroll
  for (int i = 0; i < 4; ++i)
#pragma unroll
    for (int j = 0; j < 4; ++j) acc[i][j] = f32x4{0.f, 0.f, 0.f, 0.f};

  u32x4 areg[4]; f32x4 breg[4];
#define GLOAD(kt_)                                                                                   \
  {                                                                                                  \
    _Pragma("unroll") for (int i = 0; i < 4; ++i) {                                                  \
      if (A_F32) {                                                                                   \
        const float4* q = (const float4*)(ap[i] + (size_t)(kt_) * GBK * 4);                          \
        float4 v0 = q[0], v1 = q[1];                                                                 \
        areg[i] = u32x4{pk2(v0.x, v0.y), pk2(v0.z, v0.w), pk2(v1.x, v1.y), pk2(v1.z, v1.w)};         \
      } else {                                                                                       \
        areg[i] = *(const u32x4*)(ap[i] + (size_t)(kt_) * GBK * 2);                                  \
      }                                                                                              \
    }                                                                                                \
    _Pragma("unroll") for (int i = 0; i < 4; ++i) {                                                  \
      if (bok[i]) breg[i] = *(const f32x4*)(bp[i] + (size_t)(kt_) * GBK * ldb);                      \
      else breg[i] = f32x4{0.f, 0.f, 0.f, 0.f};                                                      \
    }                                                                                                \
  }
  const int nk = K / GBK;
  GLOAD(0)
  for (int kt = 0; kt < nk; ++kt) {
    __syncthreads();
#pragma unroll
    for (int i = 0; i < 4; ++i) {
      int u = tid + i * NTH; int row = u >> 3, kc = u & 7;
      *(u32x4*)(As + row * AS_STRIDE + kc * 8) = areg[i];
    }
#pragma unroll
    for (int i = 0; i < 4; ++i) {
      int u = tid + i * NTH; int k = u >> 5, nq = u & 31;
      u32x2 v = u32x2{pk2(breg[i][0], breg[i][1]), pk2(breg[i][2], breg[i][3])};
      *(u32x2*)(Bs + k * BS_STRIDE + nq * 4) = v;
    }
    __syncthreads();
    if (kt + 1 < nk) GLOAD(kt + 1)
#pragma unroll
    for (int ks = 0; ks < 2; ++ks) {
      bf16x8 a[4], b[4];
#pragma unroll
      for (int mi = 0; mi < 4; ++mi)
        a[mi] = *(const bf16x8*)(As + (wm * 64 + mi * 16 + l15) * AS_STRIDE + ks * 32 + 8 * lq);
#pragma unroll
      for (int ni = 0; ni < 4; ++ni) {
        int col0 = (MODE != 1) ? (wn * 64 + ni * 16) : ((ni < 2) ? (wn * 32 + ni * 16) : (64 + wn * 32 + (ni - 2) * 16));
        int kb = ks * 32 + 8 * lq; int q = l15 >> 2, pp = l15 & 3;
        s16x4 lo = tr_read(Bs + (kb + q) * BS_STRIDE + col0 + 4 * pp);
        s16x4 hi = tr_read(Bs + (kb + 4 + q) * BS_STRIDE + col0 + 4 * pp);
        b[ni] = __builtin_shufflevector(lo, hi, 0, 1, 2, 3, 4, 5, 6, 7);
      }
#pragma unroll
      for (int mi = 0; mi < 4; ++mi)
#pragma unroll
        for (int ni = 0; ni < 4; ++ni)
          acc[mi][ni] = __builtin_amdgcn_mfma_f32_16x16x32_bf16(a[mi], b[ni], acc[mi][ni], 0, 0, 0);
    }
  }
  if constexpr (MODE == 2) { epi(acc, wm, wn, lq, l15); return; }
  else {
#pragma unroll
  for (int mi = 0; mi < 4; ++mi)
#pragma unroll
    for (int r = 0; r < 4; ++r) {
      int row = wm * 64 + mi * 16 + lq * 4 + r;
      if (MODE == 0) {
#pragma unroll
        for (int ni = 0; ni < 4; ++ni) {
          int col = n0 + wn * 64 + ni * 16 + l15;
          if (col < Nvalid) epi(row, col, acc[mi][ni][r], 0.f);
        }
      } else {
#pragma unroll
        for (int ni = 0; ni < 2; ++ni) {
          int col = n0 + wn * 32 + ni * 16 + l15;
          epi(row, col, acc[mi][ni][r], acc[mi][ni + 2][r]);
        }
      }
    }
  }
}

DI void ph_norm(const float* __restrict__ X, const float* __restrict__ g, u16* __restrict__ Hout) {
  const int tid_ = tidx(); const int lane = tid_ & 63, w = tid_ >> 6;
  for (int tok = blockIdx.x * 8 + w; tok < NTOK; tok += gridDim.x * 8) {
    const float4* xr = (const float4*)(X + (size_t)tok * DM);
    float4 v[4]; float ss = 0.f;
#pragma unroll
    for (int j = 0; j < 4; ++j) { v[j] = xr[lane + 64 * j]; ss += v[j].x * v[j].x + v[j].y * v[j].y + v[j].z * v[j].z + v[j].w * v[j].w; }
    ss = wave_sum(ss);
    float rstd = frsq(ss * (1.f / DM) + NORM_EPS);
#pragma unroll
    for (int j = 0; j < 4; ++j) {
      float4 gg = ((const float4*)g)[lane + 64 * j];
      uint2 o = uint2{pk2(v[j].x * rstd * gg.x, v[j].y * rstd * gg.y), pk2(v[j].z * rstd * gg.z, v[j].w * rstd * gg.w)};
      *(uint2*)(Hout + (size_t)tok * DM + (lane + 64 * j) * 4) = o;
    }
  }
}

DI void ph_final_norm(float* __restrict__ X, const float* __restrict__ g) {
  const int tid_ = tidx(); const int lane = tid_ & 63, w = tid_ >> 6;
  for (int tok = blockIdx.x * 8 + w; tok < NTOK; tok += gridDim.x * 8) {
    float4* xr = (float4*)(X + (size_t)tok * DM);
    float4 v[4]; float ss = 0.f;
#pragma unroll
    for (int j = 0; j < 4; ++j) { v[j] = xr[lane + 64 * j]; ss += v[j].x * v[j].x + v[j].y * v[j].y + v[j].z * v[j].z + v[j].w * v[j].w; }
    ss = wave_sum(ss);
    float rstd = frsq(ss * (1.f / DM) + NORM_EPS);
#pragma unroll
    for (int j = 0; j < 4; ++j) {
      float4 gg = ((const float4*)g)[lane + 64 * j];
      xr[lane + 64 * j] = float4{v[j].x * rstd * gg.x, v[j].y * rstd * gg.y, v[j].z * rstd * gg.z, v[j].w * rstd * gg.w};
    }
  }
}

template <bool A_F32, class Epi>
DI void ph_gemm(const void* A, int lda, const float* B, int ldb, int M, int N, int K, char* smem, Epi epi) {
  const int ntn = (N + GBN - 1) / GBN, ntm = M / GBM;
  for (int t = blockIdx.x; t < ntm * ntn; t += gridDim.x) {
    int tm = t / ntn, tn = t % ntn;
    int m0 = tm * GBM, n0 = tn * GBN;
    auto arow = [&](int r) -> const void* { return (const char*)A + (size_t)(m0 + r) * lda * (A_F32 ? 4 : 2); };
    gemm_tile<A_F32, 0>(arow, B, nullptr, ldb, K, n0, N, smem, [&](int row, int col, float v, float) { epi(m0 + row, col, v); });
    __syncthreads();
  }
}

template <class Epi>
DI void ph_gemm_t(const void* A, int lda, const float* B, int ldb, int M, int N, int K, char* smem, Epi epi) {
  const int ntn = (N + GBN - 1) / GBN, ntm = M / GBM;
  for (int t = blockIdx.x; t < ntm * ntn; t += gridDim.x) {
    int tm = t / ntn, tn = t % ntn;
    int m0 = tm * GBM, n0 = tn * GBN;
    auto arow = [&](int r) -> const void* { return (const char*)A + (size_t)(m0 + r) * lda * 2; };
    gemm_tile<false, 2>(arow, B, nullptr, ldb, K, n0, N, smem,
                        [&](const f32x4 (&acc)[4][4], int wm, int wn, int lq, int l15) { epi(acc, m0, n0, wm, wn, lq, l15); });
    __syncthreads();
  }
}

DI void ph_rwshift(const P& p, int layer) {
  const float* mu = p.rw_mu + layer * RWC;
  const int total = NTOK * (RWC / 4);
  const int tid_ = tidx();
  for (int i = blockIdx.x * NTH + tid_; i < total; i += gridDim.x * NTH) {
    int tok = i / (RWC / 4), c = (i % (RWC / 4)) * 4;
    int t = tok % T;
    const float* zr = p.Z + (size_t)tok * INC + c;
    float4 z = *(const float4*)zr;
    float4 zm = (t > 0) ? *(const float4*)(zr - INC) : float4{0.f, 0.f, 0.f, 0.f};
    float4 zp = (t < T - 1) ? *(const float4*)(zr + INC) : float4{0.f, 0.f, 0.f, 0.f};
    float4 m = *(const float4*)(mu + c);
    float4 o;
    o.x = z.x + m.x * (0.5f * (zm.x + zp.x) - z.x);
    o.y = z.y + m.y * (0.5f * (zm.y + zp.y) - z.y);
    o.z = z.z + m.z * (0.5f * (zm.z + zp.z) - z.z);
    o.w = z.w + m.w * (0.5f * (zm.w + zp.w) - z.w);
    if (c < 512) *(float4*)(p.R + (size_t)tok * RWW + c) = o;
    else if (c < 1024) *(float4*)(p.K + (size_t)tok * RWW + (c - 512)) = o;
    else if (c < 1536) *(float4*)(p.V + (size_t)tok * RWW + (c - 1024)) = o;
    else if (c < 1664) {
      int d = (c - 1536) >> 6, l = (c - 1536) & 63;
      *(uint2*)(p.TWD + ((size_t)d * NTOK + tok) * 64 + l) = uint2{pk2(ftanh(o.x), ftanh(o.y)), pk2(ftanh(o.z), ftanh(o.w))};
    } else if (c < 1792) {
      int d = (c - 1664) >> 6, l = (c - 1664) & 63;
      *(uint2*)(p.AD + ((size_t)d * NTOK + tok) * 64 + l) = uint2{pk2(o.x, o.y), pk2(o.z, o.w)};
    } else {
      int l = c - 1792;
      *(uint2*)(p.SGD + (size_t)tok * 128 + l) = uint2{pk2(sigmoidf_(o.x), sigmoidf_(o.y)), pk2(sigmoidf_(o.z), sigmoidf_(o.w))};
    }
  }
}

DI void rope_cs(int pos, int i, float& cs, float& sn) {
  const int i3 = i & 3, i2 = i >> 2;
  const float c4 = (i3 == 0) ? 1.0f : (i3 == 1) ? 0.5623413251903491f : (i3 == 2) ? 0.31622776601683794f : 0.1778279410038923f;
  const float p10 = (i2 == 0) ? 1.0f : (i2 == 1) ? 0.1f : (i2 == 2) ? 0.01f : 0.001f;
  float inv = c4 * p10;
  float ang = (float)pos * inv;
  double rev = (double)ang * 0.15915494309189535;
  rev -= floor(rev);
  float rf = (float)rev;
  sn = __builtin_amdgcn_sinf(rf);
  cs = __builtin_amdgcn_cosf(rf);
}

DI void ph_rope_table(const P& p) {
  for (int i = blockIdx.x * NTH + tidx(); i < NTOK * 16; i += gridDim.x * NTH) {
    float cs, sn; rope_cs(p.pos[i >> 4], i & 15, cs, sn);
    *(f32x2*)(p.ROPE + (size_t)i * 2) = f32x2{cs, sn};
  }
}
DI void ph_mlaprep1(const P& p, int layer) {
  const int tid_ = tidx(); const int lane = tid_ & 63, w = tid_ >> 6;
  const float* qn = p.mla_q_norm + layer * 256;
  const float* kvn = p.mla_kv_norm + layer * 128;
  for (int tok = blockIdx.x * 8 + w; tok < NTOK; tok += gridDim.x * 8) {
    const float* zr = p.Z + (size_t)tok * INC + RWC;
    float4 q = *(const float4*)(zr + lane * 4);
    float ss = wave_sum(q.x * q.x + q.y * q.y + q.z * q.z + q.w * q.w);
    float rstd = frsq(ss * (1.f / 256) + NORM_EPS);
    float4 g = *(const float4*)(qn + lane * 4);
    *(uint2*)(p.QDN + (size_t)tok * 256 + lane * 4) = uint2{pk2(q.x * rstd * g.x, q.y * rstd * g.y), pk2(q.z * rstd * g.z, q.w * rstd * g.w)};
    float2 kv = *(const float2*)(zr + 256 + lane * 2);
    float ss2 = wave_sum(kv.x * kv.x + kv.y * kv.y);
    float rstd2 = frsq(ss2 * (1.f / 128) + NORM_EPS);
    float2 g2 = *(const float2*)(kvn + lane * 2);
    *(unsigned*)(p.KVDN + (size_t)tok * 128 + lane * 2) = pk2(kv.x * rstd2 * g2.x, kv.y * rstd2 * g2.y);
    if (lane < 16) {
      float u1 = zr[384 + lane], u2 = zr[384 + 16 + lane];
      const f32x2 csn = *(const f32x2*)(p.ROPE + (size_t)tok * 32 + lane * 2);
      const u16 k1 = f2bf(u1 * csn[0] - u2 * csn[1]), k2 = f2bf(u1 * csn[1] + u2 * csn[0]);
      const int bb = tok / T, tt = tok % T;
#pragma unroll
      for (int h = 0; h < NH; ++h) {
        u16* ko = p.Kc + ((size_t)(bb * NH + h) * T + tt) * 96 + 64;
        ko[lane] = k1; ko[16 + lane] = k2;
      }
    }
  }
}

DI void ph_mlafinish(const P& p) {
  const int tid_ = tidx(); const int lane = tid_ & 63, w = tid_ >> 6;
  const float qs = 0.10206207261596577f * 1.4426950408889634f;
  for (int tok = blockIdx.x * 8 + w; tok < NTOK; tok += gridDim.x * 8) {
    int b = tok / T, t = tok % T;
    float cs = 0.f, sn = 0.f;
    if (lane < 16) rope_cs(p.pos[tok], lane, cs, sn);
    const float* qr = p.QRAW + (size_t)tok * 768;
    const float* kvr = p.KVRAW + (size_t)tok * 1024;
    const float* kr = p.KR + (size_t)tok * 32;
#pragma unroll
    for (int h = 0; h < NH; ++h) {
      size_t row = ((size_t)(b * NH + h) * T + t);
      u16* qo = p.Q + row * 96; u16* ko = p.Kc + row * 96; u16* vo = p.Vv + row * 64;
      qo[lane] = f2bf(qr[h * 96 + lane] * qs);
      ko[lane] = f2bf(kvr[h * 128 + lane]);
      vo[lane] = f2bf(kvr[h * 128 + 64 + lane]);
      if (lane < 16) {
        float u1 = qr[h * 96 + 64 + lane], u2 = qr[h * 96 + 80 + lane];
        qo[64 + lane] = f2bf((u1 * cs - u2 * sn) * qs);
        qo[80 + lane] = f2bf((u1 * sn + u2 * cs) * qs);
      }
      if (lane < 32) ko[64 + lane] = f2bf(kr[lane]);
    }
  }
}

using f32x16 = __attribute__((ext_vector_type(16))) float;
#define SBAR() __builtin_amdgcn_sched_barrier(0)
constexpr int AT_KSTR = 104;
constexpr int AT_KBYTES = 64 * AT_KSTR * 2;
constexpr int AT_VBYTES = 64 * 64 * 2;
constexpr float AT_THR = 8.f;
DI int crow(int r, int hi) { return (r & 3) + 8 * (r >> 2) + 4 * hi; }
DI int v_st(int k, int c) { const int kk = (k & ~0xC) | ((k & 4) << 1) | ((k & 8) >> 1); return ((kk >> 3) * 2 + (c >> 5)) * 512 + ((kk & 7) * 32 + (c & 31)) * 2; }
DI int v_rd_base(int lane) { return ((lane & 3) << 3) | (((lane >> 2) & 3) << 6) | (((lane >> 4) & 1) << 5) | (((lane >> 5) & 1) << 8); }
constexpr int v_rd_off(int d0, int ks, int half) { return d0 * 512 + ks * 2048 + half * 1024; }

DI void at_partialSM(f32x16& p0, f32x16& p1, float& m_reg, float& mn, float& alpha) {
  float pmax = p0[0];
#pragma unroll
  for (int r = 1; r < 16; ++r) pmax = fmaxf(pmax, p0[r]);
#pragma unroll
  for (int r = 0; r < 16; ++r) pmax = fmaxf(pmax, p1[r]);
  { auto rr = __builtin_amdgcn_permlane32_swap(__float_as_uint(pmax), __float_as_uint(pmax), false, false);
    pmax = fmaxf(__uint_as_float(rr[0]), __uint_as_float(rr[1])); }
  if (__builtin_expect(__all(pmax - m_reg <= AT_THR), 1)) { mn = m_reg; alpha = 1.f; }
  else { mn = fmaxf(m_reg, pmax); alpha = __builtin_amdgcn_exp2f(m_reg - mn); m_reg = mn; }
#pragma unroll
  for (int r = 0; r < 16; ++r) { p0[r] = p0[r] - mn; p1[r] = p1[r] - mn; }
#pragma unroll
  for (int r = 0; r < 16; ++r) p0[r] = __builtin_amdgcn_exp2f(p0[r]);
}
DI void at_finishSM(f32x16& p0, f32x16& p1, float alpha, float& l_reg, bf16x8& pa0, bf16x8& pa1, bf16x8& pa2, bf16x8& pa3) {
#pragma unroll
  for (int r = 0; r < 16; ++r) p1[r] = __builtin_amdgcn_exp2f(p1[r]);
  float ps = 0;
#pragma unroll
  for (int r = 0; r < 16; ++r) ps += p0[r];
#pragma unroll
  for (int r = 0; r < 16; ++r) ps += p1[r];
  { auto rr = __builtin_amdgcn_permlane32_swap(__float_as_uint(ps), __float_as_uint(ps), false, false);
    ps = __uint_as_float(rr[0]) + __uint_as_float(rr[1]); }
  l_reg = l_reg * alpha + ps;
#define PK4(PP, BASE, OUT) do { unsigned a0 = pk2(PP[BASE + 0], PP[BASE + 1]), a1 = pk2(PP[BASE + 2], PP[BASE + 3]);   \
    unsigned b0 = pk2(PP[BASE + 4], PP[BASE + 5]), b1 = pk2(PP[BASE + 6], PP[BASE + 7]);                              \
    auto r0 = __builtin_amdgcn_permlane32_swap(a0, b0, false, false); auto r1 = __builtin_amdgcn_permlane32_swap(a1, b1, false, false); \
    u32x4 wv = {r0[0], r1[0], r0[1], r1[1]}; OUT = __builtin_bit_cast(bf16x8, wv); } while (0)
  PK4(p0, 0, pa0); PK4(p0, 8, pa1); PK4(p1, 0, pa2); PK4(p1, 8, pa3);
#undef PK4
}
DI void at_qkt(f32x16& p0, f32x16& p1, const char* Kb, const bf16x8* qr, int r32, int hi) {
#pragma unroll
  for (int r = 0; r < 16; ++r) { p0[r] = 0.f; p1[r] = 0.f; }
#pragma unroll
  for (int d0 = 0; d0 < 6; ++d0) {
    bf16x8 b0 = *(const bf16x8*)(Kb + (r32 * AT_KSTR + d0 * 16 + hi * 8) * 2);
    bf16x8 b1 = *(const bf16x8*)(Kb + ((32 + r32) * AT_KSTR + d0 * 16 + hi * 8) * 2);
    __builtin_amdgcn_s_setprio(1);
    p0 = __builtin_amdgcn_mfma_f32_32x32x16_bf16(b0, qr[d0], p0, 0, 0, 0);
    p1 = __builtin_amdgcn_mfma_f32_32x32x16_bf16(b1, qr[d0], p1, 0, 0, 0);
    __builtin_amdgcn_s_setprio(0);
  }
}
template <int D0> DI void at_pv_one(f32x16& od, const char* vb, bf16x8 pa0, bf16x8 pa1, bf16x8 pa2, bf16x8 pa3) {
#define TRR(ks, half) tr_read((const short*)(vb + v_rd_off(D0, ks, half)))
  const s16x4 l0 = TRR(0, 0), h0 = TRR(0, 1), l1 = TRR(1, 0), h1 = TRR(1, 1), l2 = TRR(2, 0), h2 = TRR(2, 1), l3 = TRR(3, 0), h3 = TRR(3, 1);
#undef TRR
#define PKV(L, H) __builtin_shufflevector(L, H, 0, 1, 2, 3, 4, 5, 6, 7)
  __builtin_amdgcn_s_setprio(1);
  od = __builtin_amdgcn_mfma_f32_32x32x16_bf16(pa0, PKV(l0, h0), od, 0, 0, 0);
  od = __builtin_amdgcn_mfma_f32_32x32x16_bf16(pa1, PKV(l1, h1), od, 0, 0, 0);
  od = __builtin_amdgcn_mfma_f32_32x32x16_bf16(pa2, PKV(l2, h2), od, 0, 0, 0);
  od = __builtin_amdgcn_mfma_f32_32x32x16_bf16(pa3, PKV(l3, h3), od, 0, 0, 0);
  __builtin_amdgcn_s_setprio(0);
#undef PKV
}
DI void at_pv(f32x16* o, const char* vb, bf16x8 pa0, bf16x8 pa1, bf16x8 pa2, bf16x8 pa3) {
  at_pv_one<0>(o[0], vb, pa0, pa1, pa2, pa3); at_pv_one<1>(o[1], vb, pa0, pa1, pa2, pa3);
}

DI void attn_body(const u16* __restrict__ Qb, const u16* __restrict__ Kh, const u16* __restrict__ Vh, float* __restrict__ Ob, char* lds, int tid) {
  const int wid = tid >> 6, lane = tid & 63, r32 = lane & 31, hi = lane >> 5;
  char* V_lds = lds; char* K_lds = lds + 2 * AT_VBYTES;
  float* wsp = (float*)(lds + 2 * AT_VBYTES + 2 * AT_KBYTES) + wid * 64; float* li_l = wsp; float* al_l = wsp + 32;
  float m_reg = -1e30f, l_reg = 0.f; f32x16 o[2]; bf16x8 qr[6];
#pragma unroll
  for (int r = 0; r < 16; ++r) { o[0][r] = 0.f; o[1][r] = 0.f; }
  const u16* Qw = Qb + (size_t)(wid * 32 + r32) * 96 + hi * 8;
#pragma unroll
  for (int d0 = 0; d0 < 6; ++d0) qr[d0] = *(const bf16x8*)(Qw + d0 * 16);
  const int kid1 = (tid < 256) ? tid + 512 : tid;
  const int kst0 = ((tid / 12) * AT_KSTR + (tid % 12) * 8) * 2, kst1 = ((kid1 / 12) * AT_KSTR + (kid1 % 12) * 8) * 2;
  const int vst = v_st(tid >> 3, (tid & 7) * 8);
  const char* vb0 = V_lds + v_rd_base(lane);
  u32x4 sk0[2], sk1[2], sv0[2];
#define SLOAD(i, k0) do { sk0[i] = *(const u32x4*)(Kh + (size_t)(k0) * 96 + tid * 8); sk1[i] = *(const u32x4*)(Kh + (size_t)(k0) * 96 + kid1 * 8); \
    sv0[i] = *(const u32x4*)(Vh + (size_t)(k0) * 64 + tid * 8); } while (0)
#define SWRITE(b, i) do { *(u32x4*)(K_lds + (b) * AT_KBYTES + kst0) = sk0[i]; if (tid < 256) *(u32x4*)(K_lds + (b) * AT_KBYTES + kst1) = sk1[i]; \
    *(u32x4*)(V_lds + (b) * AT_VBYTES + vst) = sv0[i]; } while (0)
#define SWAIT() asm volatile("s_waitcnt vmcnt(3)" ::: "memory")
#define RESC(a) do { if (__any((a) < 1.f)) { if (hi == 0) al_l[r32] = (a); asm volatile("s_waitcnt lgkmcnt(0)" ::: "memory"); \
    _Pragma("unroll") for (int r = 0; r < 16; ++r) { float al = al_l[crow(r, hi)]; o[0][r] *= al; o[1][r] *= al; } } } while (0)
  f32x16 pA0, pA1, pB0, pB1; float mnA, mnB, alA, alB; bf16x8 pa0, pa1, pa2, pa3; constexpr int NT = T / 64;
  SLOAD(0, 0); SWRITE(0, 0); __syncthreads();
  at_qkt(pA0, pA1, K_lds, qr, r32, hi); at_partialSM(pA0, pA1, m_reg, mnA, alA);
  SLOAD(1, 64); SLOAD(0, 128);
  SWAIT(); SWRITE(1, 1); __syncthreads();
  for (int j = 1; j + 1 < NT; j += 2) {
    SBAR(); at_qkt(pB0, pB1, K_lds + AT_KBYTES, qr, r32, hi);
    at_finishSM(pA0, pA1, alA, l_reg, pa0, pa1, pa2, pa3); SBAR();
    SLOAD(1, (j + 2) * 64); SBAR();
    at_pv(o, vb0, pa0, pa1, pa2, pa3); at_partialSM(pB0, pB1, m_reg, mnB, alB);
    __syncthreads(); SWAIT(); SWRITE(0, 0);
    RESC(alB); __syncthreads();
    SBAR(); at_qkt(pA0, pA1, K_lds, qr, r32, hi);
    at_finishSM(pB0, pB1, alB, l_reg, pa0, pa1, pa2, pa3); SBAR();
    if (j + 3 < NT) SLOAD(0, (j + 3) * 64); SBAR();
    at_pv(o, vb0 + AT_VBYTES, pa0, pa1, pa2, pa3); at_partialSM(pA0, pA1, m_reg, mnA, alA);
    __syncthreads(); SWAIT(); SWRITE(1, 1);
    RESC(alA); __syncthreads();
  }
  SBAR(); at_qkt(pB0, pB1, K_lds + AT_KBYTES, qr, r32, hi);
  at_finishSM(pA0, pA1, alA, l_reg, pa0, pa1, pa2, pa3); SBAR();
  at_pv(o, vb0, pa0, pa1, pa2, pa3); at_partialSM(pB0, pB1, m_reg, mnB, alB);
  __syncthreads(); RESC(alB);
  at_finishSM(pB0, pB1, alB, l_reg, pa0, pa1, pa2, pa3); SBAR();
  at_pv(o, vb0 + AT_VBYTES, pa0, pa1, pa2, pa3);
  if (hi == 0) li_l[r32] = l_reg;
  asm volatile("s_waitcnt lgkmcnt(0)" ::: "memory");
  float* Ow = Ob + (size_t)(wid * 32) * 512;
#pragma unroll
  for (int r = 0; r < 16; ++r) {
    int orow = crow(r, hi); float rl = __builtin_amdgcn_rcpf(li_l[orow]);
    Ow[(size_t)orow * 512 + r32] = o[0][r] * rl; Ow[(size_t)orow * 512 + 32 + r32] = o[1][r] * rl;
  }
#undef SLOAD
#undef SWRITE
#undef SWAIT
#undef RESC
}

DI void ph_attn(const P& p, char* smem, unsigned* ctr) {
  const int tid = tidx();
  int* sitem = (int*)(smem + SMEM_BYTES - 16);
  for (;;) {
    __syncthreads();
    if (tid == 0) *sitem = (int)atomicAdd(ctr, 1u);
    __syncthreads();
    const int item = *sitem;
    if (item >= NB * NH * (T / 256)) break;
    const int bh = item / (T / 256), qb = item % (T / 256);
    const int b = bh / NH, h = bh % NH;
    attn_body(p.Q + ((size_t)bh * T + qb * 256) * 96, p.Kc + (size_t)bh * T * 96, p.Vv + (size_t)bh * T * 64,
              p.AO + ((size_t)(b * T + qb * 256)) * 512 + h * 64, smem, tid);
  }
}

constexpr int SC = 128, NCH = T / SC;
constexpr int SBUF = 5184;
template <int NI> struct ScanRegsN { float k[2 * NI], r[2 * NI], v[2 * NI]; u16 lw[2 * NI], a[2 * NI]; };
template <int NI>
DI void scan_load_n(const P& p, int b, int h, int d, int n0, int lane, int ws, ScanRegsN<NI>& g) {
  constexpr int WPI = 8 / NI;
  const u16* LWd = p.LW + (size_t)d * NTOK * RWW;
  const u16* AAd = p.AA + (size_t)d * NTOK * RWW;
  const int ch = h * 64 + lane;
#pragma unroll
  for (int jj = 0; jj < 2 * NI; ++jj) {
    int n = n0 + ws + WPI * jj; int t = d ? (T - 1 - n) : n;
    size_t off = ((size_t)(b * T + t)) * RWW + ch;
    g.k[jj] = p.K[off]; g.r[jj] = p.R[off]; g.v[jj] = p.V[off]; g.lw[jj] = LWd[off]; g.a[jj] = AAd[off];
  }
}
template <int NI>
DI void scan_put_n(const ScanRegsN<NI>& g, float kkc, float kac, float* sm, float* slw, int lane, int ws) {
  constexpr int WPI = 8 / NI;
#pragma unroll
  for (int jj = 0; jj < 2 * NI; ++jj) slw[(ws + WPI * jj) * 64 + lane] = bf2f(g.lw[jj]);
  __syncthreads();
  float Lj[2 * NI];
#pragma unroll
  for (int jj = 0; jj < 2 * NI; ++jj) Lj[jj] = 0.f;
#pragma unroll
  for (int i = 0; i < 16; ++i) {
    const float x = slw[i * 64 + lane];
#pragma unroll
    for (int jj = 0; jj < 2 * NI; ++jj) Lj[jj] += (i <= ws + WPI * jj) ? x : 0.f;
  }
#pragma unroll
  for (int jj = 0; jj < 2 * NI; ++jj) {
    const int j = ws + WPI * jj;
    const float L = Lj[jj], lwj = bf2f(g.lw[jj]);
    const float Pt = fexp(L), Pm = fexp(L - lwj), iP = fexp(-L);
    const float kv = g.k[jj];
    const float kx = kv * kkc;
    const float nrm = __builtin_amdgcn_sqrtf(wave_sum(kx * kx));
    const float kkv = kx * frcp(fmaxf(nrm, 1e-12f));
    const float a = bf2f(g.a[jj]);
    sm[j * 64 + lane] = -kkv * Pm;
    sm[1024 + j * 64 + lane] = a * kkv * iP;
    sm[2048 + j * 64 + lane] = kv * (1.f + (a - 1.f) * kac) * iP;
    sm[3072 + j * 64 + lane] = g.r[jj] * Pt;
    sm[4096 + j * 64 + lane] = g.v[jj];
    if (j == 15) sm[5120 + lane] = Pt;
  }
}
using f32x16s = __attribute__((ext_vector_type(16))) float;
DI void scan_ld8(f32x4 (&kv)[8], const float* vec, int hi) {
#pragma unroll
  for (int tk = 0; tk < 2; ++tk)
#pragma unroll
    for (int q = 0; q < 4; ++q) kv[tk * 4 + q] = *(const f32x4*)(vec + 32 * tk + 8 * q + 4 * hi);
}
DI float scan_dot8(const f32x16s (&acc)[2], const f32x4 (&kv)[8]) {
  float pq[4] = {0.f, 0.f, 0.f, 0.f};
#pragma unroll
  for (int tk = 0; tk < 2; ++tk)
#pragma unroll
    for (int e = 0; e < 4; ++e)
#pragma unroll
      for (int q = 0; q < 4; ++q) { pq[q] = __builtin_fmaf(acc[tk][4 * q + e], kv[tk * 4 + q][e], pq[q]); asm("" : "+v"(pq[q])); }
  return red_x32((pq[0] + pq[1]) + (pq[2] + pq[3]));
}

DI void ph_scan1(const P& p, int layer, char* smem) {
  constexpr int NI = 2;
  const int tid = tidx(), lane = tid & 63, w = tid >> 6;
  const int jl = lane & 31, hi = lane >> 5;
  const int it = w >> 2, vt = w & 3, ws = w & 3;
  float* smi = (float*)smem + it * (2 * SBUF + 1024);
  float* slw = smi + 2 * SBUF;
  for (int pair = blockIdx.x; pair < 32 * NCH / 2; pair += gridDim.x) {
    const int item = pair * 2 + it; const int scan = item / NCH, c = item % NCH;
    const int d = scan & 1, h = (scan >> 1) % NH, b = scan / (2 * NH);
    const float kkc = p.rw_k_k[layer * RWW + h * 64 + lane], kac = p.rw_k_a[layer * RWW + h * 64 + lane];
    f32x16s acc[2];
#pragma unroll
    for (int tk = 0; tk < 2; ++tk)
#pragma unroll
      for (int r = 0; r < 16; ++r) acc[tk][r] = (32 * tk + (r & 3) + 8 * (r >> 2) + 4 * hi == 32 * vt + jl) ? 1.f : 0.f;
    ScanRegsN<NI> g;
    scan_load_n<NI>(p, b, h, d, c * SC, lane, ws, g);
    __syncthreads();
    scan_put_n<NI>(g, kkc, kac, smi, slw, lane, ws);
    __syncthreads();
    for (int sub = 0; sub < SC / 16; ++sub) {
      const float* sm = smi + (sub & 1) * SBUF;
      if (sub + 1 < SC / 16) scan_load_n<NI>(p, b, h, d, c * SC + (sub + 1) * 16, lane, ws, g);
      const float* vrow = sm + 4096 + ((vt >= 2) ? 32 * (vt - 2) : 0) + jl;
      f32x4 kc[8]; scan_ld8(kc, sm, hi);
      float a0 = sm[1024 + hi * 1024 + jl], a1 = sm[1024 + hi * 1024 + 32 + jl], vc = vrow[0];
#pragma unroll 4
      for (int j = 0; j < 16; ++j) {
        const int jn = (j + 1) & 15;
        f32x4 kn[8]; scan_ld8(kn, sm + jn * 64, hi);
        const float an0 = sm[1024 + hi * 1024 + jn * 64 + jl], an1 = sm[1024 + hi * 1024 + jn * 64 + 32 + jl], vn = vrow[jn * 64];
        SBAR();
        const float sa = scan_dot8(acc, kc);
        const float bop = hi ? ((vt >= 2) ? vc : 0.f) : sa;
        acc[0] = __builtin_amdgcn_mfma_f32_32x32x2f32(a0, bop, acc[0], 0, 0, 0);
        acc[1] = __builtin_amdgcn_mfma_f32_32x32x2f32(a1, bop, acc[1], 0, 0, 0);
        SBAR();
#pragma unroll
        for (int i = 0; i < 8; ++i) kc[i] = kn[i];
        a0 = an0; a1 = an1; vc = vn;
      }
#pragma unroll
      for (int tk = 0; tk < 2; ++tk)
#pragma unroll
        for (int q = 0; q < 4; ++q) {
          const f32x4 pv = *(const f32x4*)(sm + 5120 + 32 * tk + 8 * q + 4 * hi);
#pragma unroll
          for (int e = 0; e < 4; ++e) acc[tk][4 * q + e] *= pv[e];
        }
      if (sub + 1 < SC / 16) scan_put_n<NI>(g, kkc, kac, smi + ((sub + 1) & 1) * SBUF, slw, lane, ws);
      __syncthreads();
    }
    {
      const int v = 32 * vt + jl;
      float* dst = ((v < 64) ? p.MC : p.NC) + (((size_t)scan * NCH + c) * 64 + (v & 63)) * 64;
#pragma unroll
      for (int tk = 0; tk < 2; ++tk)
#pragma unroll
        for (int q = 0; q < 4; ++q)
          *(f32x4*)(dst + 32 * tk + 8 * q + 4 * hi) = f32x4{acc[tk][4 * q], acc[tk][4 * q + 1], acc[tk][4 * q + 2], acc[tk][4 * q + 3]};
    }
  }
}


using f32x4v = __attribute__((ext_vector_type(4))) float;
DI void ph_scan2(const P& p, char* smem) {
  float* Ssm = (float*)smem;
  float* Msm = Ssm + 64 * 68;
  const int tid = tidx(), lane = tid & 63, w = tid >> 6;
  const int l15 = lane & 15, lq = lane >> 4;
  const int ti = w >> 1, tj0 = (w & 1) * 2;
  for (int scan = blockIdx.x; scan < 32; scan += gridDim.x) {
    const float* Mg = p.MC + (size_t)scan * NCH * 4096;
    const float* Ng = p.NC + (size_t)scan * NCH * 4096;
    float* Sg = p.SS + (size_t)scan * NCH * 4096;
    f32x4 m0 = *(const f32x4*)(Mg + tid * 8), m1 = *(const f32x4*)(Mg + tid * 8 + 4);
    f32x4 sacc[2];
    f32x4 nacc[2];
#pragma unroll
    for (int q = 0; q < 2; ++q) {
      sacc[q] = f32x4{0.f, 0.f, 0.f, 0.f};
#pragma unroll
      for (int r = 0; r < 4; ++r) nacc[q][r] = Ng[(ti * 16 + lq * 4 + r) * 64 + (tj0 + q) * 16 + l15];
    }
    for (int c = 0; c < NCH; ++c) {
      __syncthreads();
#pragma unroll
      for (int q = 0; q < 2; ++q)
#pragma unroll
        for (int r = 0; r < 4; ++r) {
          const int row = ti * 16 + lq * 4 + r, col = (tj0 + q) * 16 + l15;
          Sg[(size_t)c * 4096 + row * 64 + col] = sacc[q][r];
          Ssm[row * 68 + col] = sacc[q][r];
        }
      { const int mr = tid >> 3, mc = (tid & 7) * 8; *(f32x4*)(Msm + mr * 68 + mc) = m0; *(f32x4*)(Msm + mr * 68 + mc + 4) = m1; }
      f32x4 acc[2] = {nacc[0], nacc[1]};
      __syncthreads();
      if (c + 1 < NCH) {
        m0 = *(const f32x4*)(Mg + (size_t)(c + 1) * 4096 + tid * 8); m1 = *(const f32x4*)(Mg + (size_t)(c + 1) * 4096 + tid * 8 + 4);
#pragma unroll
        for (int q = 0; q < 2; ++q)
#pragma unroll
          for (int r = 0; r < 4; ++r) nacc[q][r] = Ng[(size_t)(c + 1) * 4096 + (ti * 16 + lq * 4 + r) * 64 + (tj0 + q) * 16 + l15];
      }
#pragma unroll
      for (int kk = 0; kk < 16; ++kk) {
        const float a = Ssm[(ti * 16 + l15) * 68 + kk * 4 + lq];
        const float b0 = Msm[(kk * 4 + lq) * 68 + tj0 * 16 + l15], b1 = Msm[(kk * 4 + lq) * 68 + (tj0 + 1) * 16 + l15];
        acc[0] = __builtin_amdgcn_mfma_f32_16x16x4f32(a, b0, acc[0], 0, 0, 0);
        acc[1] = __builtin_amdgcn_mfma_f32_16x16x4f32(a, b1, acc[1], 0, 0, 0);
      }
      sacc[0] = acc[0]; sacc[1] = acc[1];
    }
    __syncthreads();
  }
}

DI void ph_scan3(const P& p, int layer, char* smem) {
  constexpr int NI = 4;
  const int tid = tidx(), lane = tid & 63, w = tid >> 6;
  const int jl = lane & 31, hi = lane >> 5;
  const int it = w >> 1, vt = w & 1, ws = w & 1;
  float* sm = (float*)smem + it * (SBUF + 2048);
  float* slw = sm + SBUF; float* so = slw + 1024;
  for (int quad = blockIdx.x; quad < 32 * NCH / 4; quad += gridDim.x) {
    const int item = quad * 4 + it; const int scan = item / NCH, c = item % NCH;
    const int d = scan & 1, h = (scan >> 1) % NH, b = scan / (2 * NH);
    const float kkc = p.rw_k_k[layer * RWW + h * 64 + lane], kac = p.rw_k_a[layer * RWW + h * 64 + lane];
    u16* Od = p.O2 + (size_t)d * NTOK * RWW;
    f32x16s acc[2];
    {
      const float* Sg = p.SS + ((size_t)scan * NCH + c) * 4096 + (size_t)(32 * vt + jl) * 64;
#pragma unroll
      for (int tk = 0; tk < 2; ++tk)
#pragma unroll
        for (int q = 0; q < 4; ++q) {
          const f32x4 sv = *(const f32x4*)(Sg + 32 * tk + 8 * q + 4 * hi);
#pragma unroll
          for (int e = 0; e < 4; ++e) acc[tk][4 * q + e] = sv[e];
        }
    }
    ScanRegsN<NI> g;
    scan_load_n<NI>(p, b, h, d, c * SC, lane, ws, g);
    for (int sub = 0; sub < SC / 16; ++sub) {
      const int n0 = c * SC + sub * 16;
      __syncthreads();
      scan_put_n<NI>(g, kkc, kac, sm, slw, lane, ws);
      __syncthreads();
      if (sub + 1 < SC / 16) scan_load_n<NI>(p, b, h, d, n0 + 16, lane, ws, g);
      const float* vrow = sm + 4096 + 32 * vt + jl;
      f32x4 kc[8]; scan_ld8(kc, sm, hi);
      float a0 = sm[1024 + hi * 1024 + jl], a1 = sm[1024 + hi * 1024 + 32 + jl], vc = vrow[0];
#pragma unroll 4
      for (int j = 0; j < 16; ++j) {
        const int jn = (j + 1) & 15;
        f32x4 kn[8]; scan_ld8(kn, sm + jn * 64, hi);
        const float an0 = sm[1024 + hi * 1024 + jn * 64 + jl], an1 = sm[1024 + hi * 1024 + jn * 64 + 32 + jl], vn = vrow[jn * 64];
        SBAR();
        const float sa = scan_dot8(acc, kc);
        const float bop = hi ? vc : sa;
        acc[0] = __builtin_amdgcn_mfma_f32_32x32x2f32(a0, bop, acc[0], 0, 0, 0);
        acc[1] = __builtin_amdgcn_mfma_f32_32x32x2f32(a1, bop, acc[1], 0, 0, 0);
        f32x4 rc[8]; scan_ld8(rc, sm + 3072 + j * 64, hi);
        SBAR();
        const float o = scan_dot8(acc, rc);
        if (hi == 0) so[j * 64 + 32 * vt + jl] = o;
        SBAR();
#pragma unroll
        for (int i = 0; i < 8; ++i) kc[i] = kn[i];
        a0 = an0; a1 = an1; vc = vn;
      }
#pragma unroll
      for (int tk = 0; tk < 2; ++tk)
#pragma unroll
        for (int q = 0; q < 4; ++q) {
          const f32x4 pv = *(const f32x4*)(sm + 5120 + 32 * tk + 8 * q + 4 * hi);
#pragma unroll
          for (int e = 0; e < 4; ++e) acc[tk][4 * q + e] *= pv[e];
        }
      __syncthreads();
#pragma unroll
      for (int jj = 0; jj < 8; ++jj) {
        const int j = ws + 2 * jj; const int n = n0 + j; const int t = d ? (T - 1 - n) : n;
        Od[((size_t)(b * T + t)) * RWW + h * 64 + lane] = f2bf(so[j * 64 + lane]);
      }
    }
  }
}


DI void ph_mixfinish(const P& p, int layer) {
  const int tid_ = tidx(); const int lane = tid_ & 63, w = tid_ >> 6;
  const float* lw = p.rw_lnx_w + layer * RWW; const float* lb = p.rw_lnx_b + layer * RWW;
  const float* kac = p.rw_k_a + layer * RWW; const float* rk = p.rw_r_k + layer * RWW;
  const float* on = p.mla_o_norm + layer * 512;
  float plw[8], plb[8], pka[8], prk[8];
#pragma unroll
  for (int h = 0; h < NH; ++h) { int c = h * 64 + lane; plw[h] = lw[c]; plb[h] = lb[c]; pka[h] = kac[c]; prk[h] = rk[c]; }
  const f32x4 g0 = *(const f32x4*)(on + lane * 4), g1 = *(const f32x4*)(on + 256 + lane * 4);
  for (int tok = blockIdx.x * 8 + w; tok < NTOK; tok += gridDim.x * 8) {
    float o[8], k[8], r[8], vv[8], a0[8], a1[8], gg[8];
#pragma unroll
    for (int h = 0; h < NH; ++h) {
      size_t off = (size_t)tok * RWW + h * 64 + lane;
      o[h] = bf2f(p.O2[off]) + bf2f(p.O2[(size_t)NTOK * RWW + off]);
      k[h] = p.K[off]; r[h] = p.R[off]; vv[h] = p.V[off];
      a0[h] = bf2f(p.AA[off]); a1[h] = bf2f(p.AA[(size_t)NTOK * RWW + off]); gg[h] = bf2f(p.G[off]);
    }
    const float* ao = p.AO + (size_t)tok * 512;
    const f32x4 v0 = *(const f32x4*)(ao + lane * 4), v1 = *(const f32x4*)(ao + 256 + lane * 4);
    float mean[8], var[8], sb[8];
#pragma unroll
    for (int h = 0; h < NH; ++h) mean[h] = wave_sum(o[h]) * (1.f / 64);
#pragma unroll
    for (int h = 0; h < NH; ++h) { float dv = o[h] - mean[h]; o[h] = dv; var[h] = wave_sum(dv * dv) * (1.f / 64); }
#pragma unroll
    for (int h = 0; h < NH; ++h) {
      float kb = 0.5f * (k[h] * (1.f + (a0[h] - 1.f) * pka[h]) + k[h] * (1.f + (a1[h] - 1.f) * pka[h]));
      sb[h] = wave_sum(r[h] * kb * prk[h]);
    }
#pragma unroll
    for (int h = 0; h < NH; ++h) {
      float on_ = o[h] * frsq(var[h] + GN_EPS) * plw[h] + plb[h];
      float y = (on_ + sb[h] * vv[h]) * gg[h];
      p.H[(size_t)tok * DM + h * 64 + lane] = f2bf(y);
    }
    float ss = v0[0] * v0[0] + v0[1] * v0[1] + v0[2] * v0[2] + v0[3] * v0[3] + v1[0] * v1[0] + v1[1] * v1[1] + v1[2] * v1[2] + v1[3] * v1[3];
    ss = wave_sum(ss);
    float rstd = frsq(ss * (1.f / 512) + NORM_EPS);
    *(u32x2*)(p.H + (size_t)tok * DM + 512 + lane * 4) = u32x2{pk2(v0[0] * rstd * g0[0], v0[1] * rstd * g0[1]), pk2(v0[2] * rstd * g0[2], v0[3] * rstd * g0[3])};
    *(u32x2*)(p.H + (size_t)tok * DM + 768 + lane * 4) = u32x2{pk2(v1[0] * rstd * g1[0], v1[1] * rstd * g1[1]), pk2(v1[2] * rstd * g1[2], v1[3] * rstd * g1[3])};
  }
}

DI void ph_norm_router(const P& p, int layer, char* smem) {
  const int tid_ = tidx(); const int lane = tid_ & 63, w = tid_ >> 6;
  float* rtl = (float*)smem;
  float* hl = (float*)(smem + 65536) + w * 1024;
  const float* g = p.ffn_norm + layer * DM;
  const float* rt = p.router + (size_t)layer * DM * NE;
  __syncthreads();
#pragma unroll
  for (int i = 0; i < 8; ++i) *(f32x4*)(rtl + (tid_ + i * NTH) * 4) = *(const f32x4*)(rt + (tid_ + i * NTH) * 4);
  __syncthreads();
  const int cg = lane >> 2, eq = lane & 3;
  for (int tok = blockIdx.x * 8 + w; tok < NTOK; tok += gridDim.x * 8) {
    const f32x4* xr = (const f32x4*)(p.out + (size_t)tok * DM);
    f32x4 v[4]; float ss = 0.f;
#pragma unroll
    for (int j = 0; j < 4; ++j) { v[j] = xr[lane + 64 * j]; ss += v[j][0] * v[j][0] + v[j][1] * v[j][1] + v[j][2] * v[j][2] + v[j][3] * v[j][3]; }
    ss = wave_sum(ss);
    const float rstd = frsq(ss * (1.f / DM) + NORM_EPS);
#pragma unroll
    for (int j = 0; j < 4; ++j) {
      const int c0 = (lane + 64 * j) * 4;
      const f32x4 gg = *(const f32x4*)(g + c0);
      const f32x4 hv = v[j] * rstd * gg;
      *(u32x2*)(p.H + (size_t)tok * DM + c0) = u32x2{pk2(hv[0], hv[1]), pk2(hv[2], hv[3])};
      *(f32x4*)(hl + c0) = hv;
    }
    f32x4 acc = f32x4{0.f, 0.f, 0.f, 0.f};
#pragma unroll 16
    for (int i = 0; i < 64; ++i) {
      const float hv = hl[cg + 16 * i];
      const f32x4 r4 = *(const f32x4*)(rtl + (cg + 16 * i) * 16 + eq * 4);
      acc += hv * r4;
    }
#pragma unroll
    for (int e = 0; e < 4; ++e) {
      float a = acc[e];
      a += dpp_f<0x124>(a); a += dpp_f<0x128>(a);
      a = red_x32(red_x16(a));
      acc[e] = a;
    }
    float mx = fmaxf(fmaxf(acc[0], acc[1]), fmaxf(acc[2], acc[3]));
    mx = fmaxf(mx, dpp_f<0xB1>(mx)); mx = fmaxf(mx, dpp_f<0x4E>(mx));
    f32x4 ex; float se = 0.f;
#pragma unroll
    for (int e = 0; e < 4; ++e) { ex[e] = fexp(acc[e] - mx); se += ex[e]; }
    se = red_x2(red_x1(se));
    const float inv = frcp(se);
    const int b = tok / T, t = tok % T;
    if (lane < 4) {
#pragma unroll
      for (int e = 0; e < 4; ++e) p.AFF[((size_t)(b * NE + eq * 4 + e)) * T + t] = ex[e] * inv;
    }
  }
}

DI void ph_topk(const P& p, char* smem) {
  unsigned* hist = (unsigned*)smem;
  unsigned* sc = hist + 256;
  unsigned* bc = sc + 2048;
  const int tid = tidx();
  for (int item = blockIdx.x; item < NB * NE; item += gridDim.x) {
    const float* a = p.AFF + (size_t)item * T;
    unsigned key[16];
#pragma unroll
    for (int i = 0; i < 4; ++i) {
      uint4 v = *(const uint4*)(a + tid * 16 + i * 4);
      key[i * 4 + 0] = v.x; key[i * 4 + 1] = v.y; key[i * 4 + 2] = v.z; key[i * 4 + 3] = v.w;
    }
    unsigned prefix = 0, mask = 0, need = CAP;
    for (int pass = 0; pass < 4; ++pass) {
      int shift = 24 - 8 * pass;
      __syncthreads();
      if (tid < 256) hist[tid] = 0;
      __syncthreads();
#pragma unroll
      for (int i = 0; i < 16; ++i)
        if ((key[i] & mask) == prefix) atomicAdd(&hist[(key[i] >> shift) & 255u], 1u);
      __syncthreads();
      if (tid == 0) {
        unsigned cum = 0; int bsel = 0; unsigned nd = need;
        for (int bb = 255; bb >= 0; --bb) {
          unsigned hc = hist[bb];
          if (cum + hc >= need) { bsel = bb; nd = need - cum; break; }
          cum += hc;
        }
        bc[0] = prefix | ((unsigned)bsel << shift); bc[1] = nd;
      }
      __syncthreads();
      prefix = bc[0]; need = bc[1]; mask |= (255u << shift);
    }
    unsigned ngt = 0, neq = 0;
#pragma unroll
    for (int i = 0; i < 16; ++i) { ngt += key[i] > prefix; neq += key[i] == prefix; }
    __syncthreads();
    unsigned* sA = sc; unsigned* sB = sc + 512; unsigned* eA = sc + 1024; unsigned* eB = sc + 1536;
    sA[tid] = ngt; eA[tid] = neq;
    __syncthreads();
    for (int off = 1; off < NTH; off <<= 1) {
      unsigned x = sA[tid] + ((tid >= off) ? sA[tid - off] : 0u);
      unsigned y = eA[tid] + ((tid >= off) ? eA[tid - off] : 0u);
      sB[tid] = x; eB[tid] = y;
      __syncthreads();
      unsigned* tmp = sA; sA = sB; sB = tmp; tmp = eA; eA = eB; eB = tmp;
    }
    unsigned gt_excl = sA[tid] - ngt, eq_excl = eA[tid] - neq;
    unsigned gt_total = sA[NTH - 1];
    int* idx = p.IDX + (size_t)item * CAP; float* gate = p.GATE + (size_t)item * CAP;
#pragma unroll
    for (int i = 0; i < 16; ++i) {
      int slot = -1;
      if (key[i] > prefix) { slot = (int)gt_excl; ++gt_excl; }
      else if (key[i] == prefix) { if (eq_excl < need) slot = (int)(gt_total + eq_excl); ++eq_excl; }
      if (slot >= 0) {
        const int tokl = tid * 16 + i;
        idx[slot] = tokl; gate[slot] = __uint_as_float(key[i]);
        const int tokg = (item / NE) * T + tokl;
        const int pos = atomicAdd(&p.TCNT[tokg], 1);
        p.TLIST[(size_t)tokg * 16 + pos] = item * CAP + slot;
      }
    }
    __syncthreads();
  }
}

DI void ph_exp1(const P& p, int layer, char* smem) {
  for (int t = blockIdx.x; t < 32 * 4 * 16; t += gridDim.x) {
    int grp = t / 64, r = t % 64, tm = r / 16, tn = r % 16;
    int b = grp / NE, e = grp % NE;
    const int* gi = p.IDX + (size_t)grp * CAP + tm * GBM;
    const u16* Hb = p.H + (size_t)b * T * DM;
    const float* Wg = p.exp_w_gate + ((size_t)layer * NE + e) * DM * 1024;
    const float* Wu = p.exp_w_up + ((size_t)layer * NE + e) * DM * 1024;
    u16* hid = p.HID + ((size_t)grp * CAP + tm * GBM) * 1024;
    auto arow = [&](int row) -> const void* { return Hb + (size_t)gi[row] * DM; };
    gemm_tile<false, 1>(arow, Wg, Wu, 1024, DM, tn * 64, 1024, smem, [&](int row, int col, float g, float u) {
      float sv = g * frcp(1.f + fexp(-g));
      hid[(size_t)row * 1024 + col] = f2bf(sv * u);
    });
    __syncthreads();
  }
}
DI void ph_exp2(const P& p, int layer, char* smem) {
  for (int t = blockIdx.x; t < 32 * 4 * 8; t += gridDim.x) {
    int grp = t / 32, r = t % 32, tm = r / 8, tn = r % 8;
    int b = grp / NE, e = grp % NE;
    const int* gi = p.IDX + (size_t)grp * CAP + tm * GBM;
    const float* gt = p.GATE + (size_t)grp * CAP + tm * GBM;
    const u16* hid = p.HID + ((size_t)grp * CAP + tm * GBM) * 1024;
    const float* Wd = p.exp_w_down + ((size_t)layer * NE + e) * 1024 * DM;
    float* xb = p.out + (size_t)b * T * DM;
    auto arow = [&](int row) -> const void* { return hid + (size_t)row * 1024; };
    gemm_tile<false, 0>(arow, Wd, nullptr, DM, 1024, tn * GBN, DM, smem, [&](int row, int col, float v, float) {
      unsafeAtomicAdd(xb + (size_t)gi[row] * DM + col, v * gt[row]);
    });
    __syncthreads();
  }
}

namespace g8 {
constexpr int BM = 256, BK = 64, HALF = 128, HTB = HALF * BK * 2, STAGE_BYTES = 8 * HTB, NXCD = 8, WGM = 8;
DI int lds_byte(int r, int c) { const int st = (r >> 4) * 2 + (c >> 5), rr = r & 15, cc = c & 31, ob = rr * 64 + cc * 2; return st * 1024 + (ob ^ (((ob >> 9) & 1) << 5)); }
DI void stage_rc(int b, int& R, int& C) { const int st = b / 1024, sb = b % 1024, swz = sb ^ (((sb >> 9) & 1) << 5); R = (st >> 1) * 16 + swz / 64; C = (st & 1) * 32 + (swz % 64) / 2; }
DI int perm32(int rho) { const int n = rho >> 4, i = rho & 15; return 8 * (i >> 2) + 4 * n + (i & 3); }
struct Unit { int pm, pn; };
struct Sched {
  int nM, nN, nwg, G, c;
  const char* A; const char* Bt; size_t a_tstep, b_tstep; int gdiv, gmod; size_t gstride;
  DI void init(int nM_, int nN_, int G_, int c_, const void* A_, const void* Bt_, int K) {
    nM = nM_; nN = nN_; nwg = nM * nN; G = G_; c = c_; A = (const char*)uni_ptr(A_); Bt = (const char*)uni_ptr(Bt_);
    a_tstep = (size_t)BM * K * 2; b_tstep = (size_t)BM * K * 2; gdiv = 1 << 30; gmod = 1; gstride = 0;
  }
  DI void group(int gdiv_, int gmod_, size_t gstride_) { gdiv = gdiv_; gmod = gmod_; gstride = gstride_; }
  DI bool next(int i, Unit& u) const {
    const long L = (long)i * G + c; if (L >= nwg) return false;
    int wgid = (int)L; { const int q = nwg / NXCD, r = nwg % NXCD, xcd = wgid % NXCD, off = wgid / NXCD; wgid = (xcd < r ? xcd * (q + 1) : r * (q + 1) + (xcd - r) * q) + off; }
    const int nig = WGM * nN, gid = wgid / nig, fm = gid * WGM, gsz = (nM - fm) < WGM ? (nM - fm) : WGM;
    u.pm = fm + ((wgid % nig) % gsz); u.pn = (wgid % nig) / gsz; return true;
  }
  DI const char* a_ptr(const Unit& u) const { return A + (size_t)u.pm * a_tstep; }
  DI const char* b_ptr(const Unit& u) const { return Bt + (size_t)((u.pm / gdiv) % gmod) * gstride + (size_t)u.pn * b_tstep; }
};
using Acc = f32x4[2][2][4][2];

template <class Epi>
DI void gemm_phase(LAS unsigned char* lds, const int K, const Sched& S, const Epi& E) {
  const int tid = tidx(), wid = __builtin_amdgcn_readfirstlane(tid >> 6), lane = tid & 63, wr = wid >> 2, wc = wid & 3, fr = lane & 15, fq = lane >> 4;
  const int nt = K / BK;
  unsigned voffA[2], voffB[2];
#pragma unroll
  for (int i = 0; i < 2; ++i) { int R, C; stage_rc(tid * 16 + i * 8192, R, C); const int Rb = Epi::PERM ? ((R & ~31) + perm32(R & 31)) : R;
    voffA[i] = (unsigned)(R * K + C) * 2u; voffB[i] = (unsigned)(Rb * K + C) * 2u; }
  const size_t kstep = (size_t)(BK * 2);
  const size_t hstep = (size_t)HALF * K * 2;
  const unsigned ldsw = (unsigned)wid * 1024u;
  const int aoff = lds_byte(wr * 64 + fr, fq * 8), boff = lds_byte(wc * 32 + fr, fq * 8);
#define G8_SA(b, h) (((b) * 2 + (h)) * HTB)
#define G8_SB(b, h) ((4 + (b) * 2 + (h)) * HTB)
#define G8_STAGE(bufoff, gbase, voff) do { _Pragma("unroll") for (int _i = 0; _i < 2; ++_i) \
    __builtin_amdgcn_global_load_lds((const unsigned*)((const char*)(gbase) + (voff)[_i]), (LAS unsigned*)(lds + (bufoff) + ldsw + _i * 8192), 16, 0, 0); } while (0)
#define G8_LDA(dst, b, h) do { _Pragma("unroll") for (int m = 0; m < 4; ++m) _Pragma("unroll") for (int k = 0; k < 2; ++k) dst[m][k] = *(const LAS bf16x8*)(lds + G8_SA(b, h) + aoff + m * 2048 + k * 1024); } while (0)
#define G8_LDB(dst, b, h) do { _Pragma("unroll") for (int n = 0; n < 2; ++n) _Pragma("unroll") for (int k = 0; k < 2; ++k) dst[n][k] = *(const LAS bf16x8*)(lds + G8_SB(b, h) + boff + n * 2048 + k * 1024); } while (0)
#define G8_MMA(ai, bj, At, Bt) do { __builtin_amdgcn_s_setprio(1); _Pragma("unroll") for (int m = 0; m < 4; ++m) _Pragma("unroll") for (int n = 0; n < 2; ++n) _Pragma("unroll") for (int k = 0; k < 2; ++k) \
    acc[ai][bj][m][n] = __builtin_amdgcn_mfma_f32_16x16x32_bf16(Bt[n][k], At[m][k], acc[ai][bj][m][n], 0, 0, 0); __builtin_amdgcn_s_setprio(0); } while (0)
#define G8_WAIT_V(n) asm volatile("s_waitcnt vmcnt(" #n ")" ::: "memory")
#define G8_WAIT_L(n) asm volatile("s_waitcnt lgkmcnt(" #n ")" ::: "memory")
#define G8_BAR __builtin_amdgcn_s_barrier()
#define G8_SCHED __builtin_amdgcn_sched_barrier(0)
  Unit cur, nxt; int ui = 0;
  if (!S.next(0, cur)) return;
  f32x4 acc[2][2][4][2];
#pragma unroll
  for (int a = 0; a < 2; ++a)
#pragma unroll
    for (int b = 0; b < 2; ++b)
#pragma unroll
      for (int m = 0; m < 4; ++m)
#pragma unroll
        for (int n = 0; n < 2; ++n) acc[a][b][m][n] = (f32x4){0.f, 0.f, 0.f, 0.f};
  bf16x8 At[4][2], B0[2][2], B1[2][2];
  const char* cA = S.a_ptr(cur); const char* cB = S.b_ptr(cur);
  G8_STAGE(G8_SB(0, 0), cB, voffB); G8_STAGE(G8_SA(0, 0), cA, voffA); G8_STAGE(G8_SB(0, 1), cB + hstep, voffB); G8_STAGE(G8_SA(0, 1), cA + hstep, voffA);
  if (wr == 1) G8_BAR;
  G8_WAIT_V(4); G8_BAR;
  G8_STAGE(G8_SB(1, 0), cB + kstep, voffB); G8_STAGE(G8_SA(1, 0), cA + kstep, voffA); G8_STAGE(G8_SB(1, 1), cB + hstep + kstep, voffB);
  G8_WAIT_V(6); G8_BAR;
  for (;;) {
    const bool has_next = S.next(ui + 1, nxt);
    const char* nA = has_next ? S.a_ptr(nxt) : cA; const char* nB = has_next ? S.b_ptr(nxt) : cB;
    for (int t = 0; t < nt; t += 2) {
      const bool last = (t == nt - 2);
      const char* a1 = cA + (size_t)(t + 1) * kstep;
      const char* a2 = last ? nA : cA + (size_t)(t + 2) * kstep; const char* b2 = last ? nB : cB + (size_t)(t + 2) * kstep;
      const char* a3 = a2 + kstep; const char* b3 = b2 + kstep;
      G8_LDB(B0, 0, 0); G8_SCHED; G8_LDA(At, 0, 0); G8_STAGE(G8_SA(1, 1), a1 + hstep, voffA);
      G8_WAIT_L(8); G8_BAR; G8_WAIT_L(0); G8_MMA(0, 0, At, B0); G8_BAR; G8_SCHED;
      G8_LDB(B1, 0, 1); G8_STAGE(G8_SB(0, 0), b2, voffB);
      G8_BAR; G8_WAIT_L(0); G8_MMA(0, 1, At, B1); G8_BAR;
      G8_LDA(At, 0, 1); G8_STAGE(G8_SA(0, 0), a2, voffA);
      G8_BAR; G8_WAIT_L(0); G8_MMA(1, 0, At, B0); G8_BAR; G8_SCHED;
      G8_STAGE(G8_SB(0, 1), b2 + hstep, voffB);
      G8_WAIT_V(6); G8_BAR; G8_MMA(1, 1, At, B1); G8_BAR;
      G8_LDB(B0, 1, 0); G8_SCHED; G8_LDA(At, 1, 0); G8_STAGE(G8_SA(0, 1), a2 + hstep, voffA);
      G8_WAIT_L(8); G8_BAR; G8_WAIT_L(0); G8_MMA(0, 0, At, B0); G8_BAR; G8_SCHED;
      G8_LDB(B1, 1, 1); G8_STAGE(G8_SB(1, 0), b3, voffB);
      G8_BAR; G8_WAIT_L(0); G8_MMA(0, 1, At, B1); G8_BAR;
      G8_LDA(At, 1, 1); G8_STAGE(G8_SA(1, 0), a3, voffA);
      G8_BAR; G8_WAIT_L(0); G8_MMA(1, 0, At, B0); G8_BAR; G8_SCHED;
      G8_STAGE(G8_SB(1, 1), b3 + hstep, voffB);
      G8_WAIT_V(6); G8_BAR; G8_MMA(1, 1, At, B1); G8_BAR;
    }
    {
      const int t2 = tidx(); const int w2 = __builtin_amdgcn_readfirstlane(t2 >> 6), l2 = t2 & 63;
      E(acc, cur, w2 >> 2, w2 & 3, l2 & 15, l2 >> 4);
    }
    if (!has_next) break;
#pragma unroll
    for (int a = 0; a < 2; ++a)
#pragma unroll
      for (int b = 0; b < 2; ++b)
#pragma unroll
        for (int m = 0; m < 4; ++m)
#pragma unroll
          for (int n = 0; n < 2; ++n) acc[a][b][m][n] = (f32x4){0.f, 0.f, 0.f, 0.f};
    cur = nxt; cA = nA; cB = nB; ++ui;
  }
  G8_WAIT_V(0);
  if (wr == 0) G8_BAR;
  G8_BAR;
#undef G8_SA
#undef G8_SB
#undef G8_STAGE
#undef G8_LDA
#undef G8_LDB
#undef G8_MMA
#undef G8_WAIT_V
#undef G8_WAIT_L
#undef G8_BAR
#undef G8_SCHED
}

struct EpiZ {
  static constexpr bool PERM = false; float* Z;
  DI void operator()(const Acc& acc, const Unit& u, int wr, int wc, int fr, int fq) const {
    const int row0 = u.pm * BM + wr * 64 + fr, col0 = u.pn * BM + wc * 32 + 4 * fq;
#pragma unroll
    for (int ai = 0; ai < 2; ++ai)
#pragma unroll
      for (int m = 0; m < 4; ++m) { float* rowp = Z + (size_t)(row0 + ai * HALF + m * 16) * INC;
#pragma unroll
        for (int bj = 0; bj < 2; ++bj)
#pragma unroll
          for (int n = 0; n < 2; ++n) { const int col = col0 + bj * HALF + n * 16; if (col < INC) *(f32x4*)(rowp + col) = acc[ai][bj][m][n]; } }
  }
};
struct EpiRes {
  static constexpr bool PERM = false; const float* xs; float* xo;
  DI void operator()(const Acc& acc, const Unit& u, int wr, int wc, int fr, int fq) const {
    const int row0 = u.pm * BM + wr * 64 + fr, col0 = u.pn * BM + wc * 32 + 4 * fq;
#pragma unroll
    for (int ai = 0; ai < 2; ++ai)
#pragma unroll
      for (int m = 0; m < 4; ++m) { const size_t ro = (size_t)(row0 + ai * HALF + m * 16) * DM + col0;
#pragma unroll
        for (int bj = 0; bj < 2; ++bj)
#pragma unroll
          for (int n = 0; n < 2; ++n) { const size_t o = ro + bj * HALF + n * 16; *(f32x4*)(xo + o) = *(const f32x4*)(xs + o) + acc[ai][bj][m][n]; } }
  }
};
struct EpiSig {
  static constexpr bool PERM = true; u16* PG;
  DI void operator()(const Acc& acc, const Unit& u, int wr, int wc, int fr, int fq) const {
    const int row0 = u.pm * BM + wr * 64 + fr, col0 = u.pn * BM + wc * 32 + 8 * fq;
#pragma unroll
    for (int ai = 0; ai < 2; ++ai)
#pragma unroll
      for (int m = 0; m < 4; ++m) { u16* rowp = PG + (size_t)(row0 + ai * HALF + m * 16) * DM + col0;
#pragma unroll
        for (int bj = 0; bj < 2; ++bj) { const f32x4 v0 = acc[ai][bj][m][0], v1 = acc[ai][bj][m][1];
          u32x4 wv = {pk2(sigmoidf_(v0[0]), sigmoidf_(v0[1])), pk2(sigmoidf_(v0[2]), sigmoidf_(v0[3])), pk2(sigmoidf_(v1[0]), sigmoidf_(v1[1])), pk2(sigmoidf_(v1[2]), sigmoidf_(v1[3]))};
          *(u32x4*)(rowp + bj * HALF) = wv; } }
  }
};
struct EpiPle {
  static constexpr bool PERM = false; float* xo; const u16* PG;
  DI void operator()(const Acc& acc, const Unit& u, int wr, int wc, int fr, int fq) const {
    const int row0 = u.pm * BM + wr * 64 + fr, col0 = u.pn * BM + wc * 32 + 4 * fq;
#pragma unroll
    for (int ai = 0; ai < 2; ++ai)
#pragma unroll
      for (int m = 0; m < 4; ++m) { const size_t ro = (size_t)(row0 + ai * HALF + m * 16) * DM + col0;
#pragma unroll
        for (int bj = 0; bj < 2; ++bj)
#pragma unroll
          for (int n = 0; n < 2; ++n) { const size_t o = ro + bj * HALF + n * 16; const u32x2 g = *(const u32x2*)(PG + o);
            f32x4 gv = {__uint_as_float(g[0] << 16), __uint_as_float(g[0] & 0xffff0000u), __uint_as_float(g[1] << 16), __uint_as_float(g[1] & 0xffff0000u)};
            *(f32x4*)(xo + o) = *(const f32x4*)(xo + o) + acc[ai][bj][m][n] * gv; } }
  }
};
struct EpiSwi {
  static constexpr bool PERM = true; u16* HID;
  DI void operator()(const Acc& acc, const Unit& u, int wr, int wc, int fr, int fq) const {
    const int row0 = u.pm * BM + wr * 64 + fr, col0 = u.pn * HALF + wc * 32 + 8 * fq;
#pragma unroll
    for (int ai = 0; ai < 2; ++ai)
#pragma unroll
      for (int m = 0; m < 4; ++m) { u16* rowp = HID + (size_t)(row0 + ai * HALF + m * 16) * 1024 + col0;
        float h[8];
#pragma unroll
        for (int n = 0; n < 2; ++n)
#pragma unroll
          for (int j = 0; j < 4; ++j) { const float gt = acc[ai][0][m][n][j], up = acc[ai][1][m][n][j]; h[n * 4 + j] = gt * frcp(1.f + fexp(-gt)) * up; }
        *(u32x4*)rowp = u32x4{pk2(h[0], h[1]), pk2(h[2], h[3]), pk2(h[4], h[5]), pk2(h[6], h[7])}; }
  }
};
struct EpiYE {
  static constexpr bool PERM = true; u16* YE; const float* GATE;
  DI void operator()(const Acc& acc, const Unit& u, int wr, int wc, int fr, int fq) const {
    const int row0 = u.pm * BM + wr * 64 + fr, col0 = u.pn * BM + wc * 32 + 8 * fq;
#pragma unroll
    for (int ai = 0; ai < 2; ++ai)
#pragma unroll
      for (int m = 0; m < 4; ++m) { const int row = row0 + ai * HALF + m * 16; const float gt = GATE[row]; u16* rowp = YE + (size_t)row * 1024 + col0;
#pragma unroll
        for (int bj = 0; bj < 2; ++bj) { const f32x4 v0 = acc[ai][bj][m][0] * gt, v1 = acc[ai][bj][m][1] * gt;
          *(u32x4*)(rowp + bj * HALF) = u32x4{pk2(v0[0], v0[1]), pk2(v0[2], v0[3]), pk2(v1[0], v1[1]), pk2(v1[2], v1[3])}; } }
  }
};
}

DI void cvt_tile_T(const float* __restrict__ src, int ldsrc, int N, int K, u16* __restrict__ dst, int k0, int n0, int drow0, char* smem, int tid) {
  short* tl = (short*)smem;
  __syncthreads();
#pragma unroll
  for (int i = 0; i < 2; ++i) {
    int u = tid + i * NTH; int kr = u >> 4, nq = u & 15; int n = n0 + nq * 4;
    f32x4 v = f32x4{0.f, 0.f, 0.f, 0.f};
    if (n < N) v = *(const f32x4*)(src + (size_t)(k0 + kr) * ldsrc + n);
#pragma unroll
    for (int e = 0; e < 4; ++e) tl[(nq * 4 + e) * 72 + kr] = (short)f2bf(v[e]);
  }
  __syncthreads();
  { int n = tid >> 3, kc = tid & 7;
    *(u32x4*)(dst + (size_t)(drow0 + n) * K + k0 + kc * 8) = *(const u32x4*)(tl + n * 72 + kc * 8); }
}
constexpr int WIN_PAD = 2560;
DI void ph_cvt_small(const P& p, int layer, char* smem) {
  const int tid = tidx();
  const int t0 = 16 * 40, t1 = t0 + 256, t2 = t1 + 256, t3 = t2 + 64;
  for (int t = blockIdx.x; t < t3; t += gridDim.x) {
    if (t < t0) cvt_tile_T(p.w_in + (size_t)layer * DM * INC, INC, INC, DM, p.WIN, (t / 40) * 64, (t % 40) * 64, (t % 40) * 64, smem, tid);
    else if (t < t1) { int q = t - t0; cvt_tile_T(p.w_out + (size_t)layer * DM * DM, DM, DM, DM, p.WOUT, (q / 16) * 64, (q % 16) * 64, (q % 16) * 64, smem, tid); }
    else if (t < t2) { int q = t - t1; cvt_tile_T(p.ple_gate + (size_t)layer * DM * DM, DM, DM, DM, p.WPG, (q / 16) * 64, (q % 16) * 64, (q % 16) * 64, smem, tid); }
    else { int q = t - t2; cvt_tile_T(p.ple_proj + (size_t)layer * DPLE * DM, DM, DM, DPLE, p.WPP, (q / 16) * 64, (q % 16) * 64, (q % 16) * 64, smem, tid); }
  }
  const float* ps = p.p + (size_t)layer * NTOK * DPLE;
  for (int i = blockIdx.x * NTH + tid; i < NTOK * DPLE / 8; i += gridDim.x * NTH) {
    f32x4 a = *(const f32x4*)(ps + (size_t)i * 8), b = *(const f32x4*)(ps + (size_t)i * 8 + 4);
    *(u32x4*)(p.PB + (size_t)i * 8) = u32x4{pk2(a[0], a[1]), pk2(a[2], a[3]), pk2(b[0], b[1]), pk2(b[2], b[3])};
  }
}

struct CvtJob { const float* src; u16* dst; int k0, n0, drow0; };
DI bool cvt_job(const P& p, int layer, int t, CvtJob& j) {
  if (t >= NE * 3 * 128) return false;
  const int e = t / 384, r = t % 384, mat = r / 128, q = r % 128;
  j.k0 = (q / 8) * 64; j.n0 = (q % 8) * 128;
  const size_t eo = ((size_t)layer * NE + e) * 1024 * 1024;
  if (mat == 0) { j.src = p.exp_w_gate + eo; j.dst = p.EW1 + (size_t)e * 2048 * 1024; j.drow0 = (j.n0 >> 7) * 256; }
  else if (mat == 1) { j.src = p.exp_w_up + eo; j.dst = p.EW1 + (size_t)e * 2048 * 1024; j.drow0 = (j.n0 >> 7) * 256 + 128; }
  else { j.src = p.exp_w_down + eo; j.dst = p.EW2 + (size_t)e * 1024 * 1024; j.drow0 = j.n0; }
  return true;
}
DI void ph_cvt_experts(const P& p, int layer, char* smem, unsigned* ctr) {
  const int tid = tidx();
  short* tl = (short*)smem;
  int* sitem = (int*)(smem + 32768);
  __syncthreads();
  if (tid == 0) sitem[0] = (int)atomicAdd(ctr, 1u);
  __syncthreads();
  CvtJob cur; bool has = cvt_job(p, layer, sitem[0], cur);
  f32x4 v[4];
  const int kr = tid >> 5, nq = tid & 31;
  if (has) {
#pragma unroll
    for (int i = 0; i < 4; ++i) v[i] = *(const f32x4*)(cur.src + (size_t)(cur.k0 + kr + 16 * i) * 1024 + cur.n0 + nq * 4);
  }
  int par = 0;
  while (has) {
    if (tid == 0) sitem[1 + par] = (int)atomicAdd(ctr, 1u);
    __syncthreads();
#pragma unroll
    for (int i = 0; i < 4; ++i)
#pragma unroll
      for (int e = 0; e < 4; ++e) tl[(nq * 4 + e) * 72 + kr + 16 * i] = (short)f2bf(v[i][e]);
    __syncthreads();
    CvtJob nxt; const bool hn = cvt_job(p, layer, sitem[1 + par], nxt);
    if (hn) {
#pragma unroll
      for (int i = 0; i < 4; ++i) v[i] = *(const f32x4*)(nxt.src + (size_t)(nxt.k0 + kr + 16 * i) * 1024 + nxt.n0 + nq * 4);
    }
#pragma unroll
    for (int i = 0; i < 2; ++i) {
      int u = tid + i * NTH; int n = u >> 3, kc = u & 7;
      *(u32x4*)(cur.dst + (size_t)(cur.drow0 + n) * 1024 + cur.k0 + kc * 8) = *(const u32x4*)(tl + n * 72 + kc * 8);
    }
    cur = nxt; has = hn; par ^= 1;
  }
}
DI void ph_gather(const P& p) {
  const int tid_ = tidx(); const int lane = tid_ & 63, w = tid_ >> 6;
  for (int row = blockIdx.x * 8 + w; row < NB * NE * CAP; row += gridDim.x * 8) {
    const int b = row / (NE * CAP);
    const int tok = b * T + p.IDX[row];
    const u32x4* src = (const u32x4*)(p.H + (size_t)tok * DM);
    u32x4* dst = (u32x4*)(p.XE + (size_t)row * DM);
    u32x4 a = src[lane], c = src[lane + 64];
    dst[lane] = a; dst[lane + 64] = c;
  }
}
DI void ph_combine_norm(const P& p, int layer) {
  const int tid_ = tidx(); const int lane = tid_ & 63, w = tid_ >> 6;
  const float* g = p.ple_norm + layer * DM;
  for (int tok = blockIdx.x * 8 + w; tok < NTOK; tok += gridDim.x * 8) {
    f32x4* xr = (f32x4*)(p.out + (size_t)tok * DM);
    f32x4 v[4];
#pragma unroll
    for (int j = 0; j < 4; ++j) v[j] = xr[lane * 4 + j];
    const int cnt = p.TCNT[tok];
    for (int q = 0; q < cnt; ++q) {
      const int yrow = p.TLIST[(size_t)tok * 16 + q];
      const u32x4* yr = (const u32x4*)(p.YE + (size_t)yrow * DM + lane * 16);
      u32x4 a = yr[0], c = yr[1];
#pragma unroll
      for (int e = 0; e < 4; ++e) {
        v[e >> 1][(e & 1) * 2] += __uint_as_float(a[e] << 16); v[e >> 1][(e & 1) * 2 + 1] += __uint_as_float(a[e] & 0xffff0000u);
        v[2 + (e >> 1)][(e & 1) * 2] += __uint_as_float(c[e] << 16); v[2 + (e >> 1)][(e & 1) * 2 + 1] += __uint_as_float(c[e] & 0xffff0000u);
      }
    }
    float ss = 0.f;
#pragma unroll
    for (int j = 0; j < 4; ++j) { xr[lane * 4 + j] = v[j]; ss += v[j][0] * v[j][0] + v[j][1] * v[j][1] + v[j][2] * v[j][2] + v[j][3] * v[j][3]; }
    ss = wave_sum(ss);
    const float rstd = frsq(ss * (1.f / DM) + NORM_EPS);
    u32x4 o0, o1;
#pragma unroll
    for (int j = 0; j < 4; ++j) {
      f32x4 gg = *(const f32x4*)(g + lane * 16 + j * 4);
      unsigned lo = pk2(v[j][0] * rstd * gg[0], v[j][1] * rstd * gg[1]), hi = pk2(v[j][2] * rstd * gg[2], v[j][3] * rstd * gg[3]);
      if (j < 2) { o0[j * 2] = lo; o0[j * 2 + 1] = hi; } else { o1[(j - 2) * 2] = lo; o1[(j - 2) * 2 + 1] = hi; }
    }
    *(u32x4*)(p.H + (size_t)tok * DM + lane * 16) = o0; *(u32x4*)(p.H + (size_t)tok * DM + lane * 16 + 8) = o1;
  }
}

#define XB_TMO      128
#define XB_XCNT(j)  (256  + 64 * (j))
#define XB_XSUB(j)  (1280 + 64 * (j))
#define XB_XGEN(j)  (2304 + 64 * (j))
#define XB_TOP      3328
#define XB_TOPGEN   3392
#define XCD_BAR_WORDS 3456
#define XB_SPIN_CAP (1u << 20)
DI unsigned xb_ld(unsigned* p) { return __hip_atomic_load(p, __ATOMIC_RELAXED, __HIP_MEMORY_SCOPE_AGENT); }
DI unsigned xb_add(unsigned* p, unsigned v) { return __hip_atomic_fetch_add(p, v, __ATOMIC_RELAXED, __HIP_MEMORY_SCOPE_AGENT); }
DI unsigned xb_xcc_id() { return (unsigned)__builtin_amdgcn_s_getreg((3 << 11) | 20) & 0xFu; }
#define XB_SPIN(cond, bar) do { unsigned _sp = 0; while (cond) { __builtin_amdgcn_s_sleep(1); \
    if ((++_sp & 255u) == 0u) { if (xb_ld(&(bar)[XB_TMO])) break; if (_sp > XB_SPIN_CAP) { atomicAdd(&(bar)[XB_TMO], 1u); break; } } } } while (0)
struct XcdBarrier { unsigned* bar; unsigned x; volatile LAS unsigned* st; };
DI XcdBarrier xcd_barrier_post(unsigned* bar, volatile LAS unsigned* st) {
  XcdBarrier b; b.bar = bar; b.x = xb_xcc_id(); b.st = st;
  if (threadIdx.x == 0) (void)xb_add(&bar[XB_XCNT(b.x)], 1u);
  return b;
}
DI void xcd_barrier_complete(unsigned* bar, unsigned x, unsigned& nloc, unsigned& nx) {
  const unsigned G = gridDim.x * gridDim.y * gridDim.z;
  unsigned sum, cnt, mine, sp = 0u;
  for (;;) {
    sum = 0u; cnt = 0u; mine = 0u;
#pragma unroll
    for (unsigned j = 0; j < 16; ++j) { const unsigned c = xb_ld(&bar[XB_XCNT(j)]); sum += c; cnt += (c > 0u) ? 1u : 0u; mine = (j == x) ? c : mine; }
    if (sum == G) break;
    __builtin_amdgcn_s_sleep(1);
    if ((++sp & 255u) == 0u) { if (xb_ld(&bar[XB_TMO])) break; if (sp > XB_SPIN_CAP) { atomicAdd(&bar[XB_TMO], 1u); break; } }
  }
  nloc = mine > 0u ? mine : 1u; nx = cnt > 0u ? cnt : 1u;
}
DI void xcd_barrier(const XcdBarrier& b) {
  asm volatile("s_waitcnt vmcnt(0)" ::: "memory");
  __syncthreads();
  if (threadIdx.x == 0) {
    unsigned* bar = b.bar;
    __builtin_amdgcn_s_waitcnt(0);
    unsigned nloc = b.st[0], nx = b.st[1];
    if (nloc == 0u) { xcd_barrier_complete(bar, b.x, nloc, nx); b.st[0] = nloc; b.st[1] = nx; }
    const unsigned old = xb_add(&bar[XB_XSUB(b.x)], 1u);
    const unsigned gen = old / nloc;
    if (old + 1u == (gen + 1u) * nloc) {
      __builtin_amdgcn_fence(__ATOMIC_RELEASE, "agent");
      asm volatile("s_waitcnt vmcnt(0)" ::: "memory");
      const unsigned og = xb_add(&bar[XB_TOP], 1u);
      const unsigned tg = og / nx;
      if (og + 1u == (tg + 1u) * nx) xb_add(&bar[XB_TOPGEN], 1u);
      else XB_SPIN(xb_ld(&bar[XB_TOPGEN]) == tg, bar);
      __builtin_amdgcn_fence(__ATOMIC_ACQUIRE, "agent");
      xb_add(&bar[XB_XGEN(b.x)], 1u);
      asm volatile("s_waitcnt vmcnt(0)" ::: "memory");
    } else {
      XB_SPIN(xb_ld(&bar[XB_XGEN(b.x)]) == gen, bar);
      __builtin_amdgcn_fence(__ATOMIC_ACQUIRE, "agent");
      asm volatile("s_waitcnt vmcnt(0)" ::: "memory");
    }
  }
  __syncthreads();
}

#define TAKE(bytes) (ws + off); off += (((size_t)(bytes)) + 255) & ~(size_t)255
__host__ __device__ inline size_t fill_ws(P& p, char* ws) {
  size_t off = 0;
  char* regA = TAKE((size_t)NTOK * INC * 4);
  p.Z = (float*)regA;
  p.LW = (u16*)regA; p.AA = (u16*)(regA + (size_t)2 * NTOK * RWW * 2); p.G = (u16*)(regA + (size_t)4 * NTOK * RWW * 2);
  p.MC = (float*)(regA + (size_t)5 * NTOK * RWW * 2); p.NC = p.MC + (size_t)32 * NCH * 4096;
  p.HID = (u16*)regA;
  char* regB = TAKE((size_t)3 * NTOK * RWW * 4);
  p.R = (float*)regB; p.K = p.R + (size_t)NTOK * RWW; p.V = p.K + (size_t)NTOK * RWW;
  p.PG = (float*)regB;
  char* regC = TAKE((size_t)NTOK * (768 + 1024) * 4);
  p.QRAW = (float*)regC; p.KVRAW = p.QRAW + (size_t)NTOK * 768;
  p.AO = (float*)regC; p.O2 = (u16*)(p.AO + (size_t)NTOK * 512); p.SS = (float*)(p.O2 + (size_t)2 * NTOK * 512);
  p.TWD = (u16*)TAKE((size_t)2 * NTOK * 64 * 2); p.AD = (u16*)TAKE((size_t)2 * NTOK * 64 * 2);
  p.SGD = (u16*)TAKE((size_t)NTOK * 128 * 2); p.QDN = (u16*)TAKE((size_t)NTOK * 256 * 2);
  p.KVDN = (u16*)TAKE((size_t)NTOK * 128 * 2); p.KR = (float*)TAKE((size_t)NTOK * 32 * 4);
  p.ROPE = (float*)TAKE((size_t)NTOK * 32 * 4);
  p.Q = (u16*)TAKE((size_t)NTOK * NH * 96 * 2); p.Kc = (u16*)TAKE((size_t)NTOK * NH * 96 * 2);
  p.Vv = (u16*)TAKE((size_t)NTOK * NH * 64 * 2);
  p.H = (u16*)TAKE((size_t)NTOK * DM * 2);
  p.AFF = (float*)TAKE((size_t)NB * NE * T * 4);
  p.IDX = (int*)TAKE((size_t)NB * NE * CAP * 4);
  p.GATE = (float*)TAKE((size_t)NB * NE * CAP * 4);

  p.WIN = (u16*)TAKE((size_t)WIN_PAD * DM * 2); p.WOUT = (u16*)TAKE((size_t)DM * DM * 2); p.WPG = (u16*)TAKE((size_t)DM * DM * 2);
  p.WPP = (u16*)TAKE((size_t)DM * DPLE * 2); p.PB = (u16*)TAKE((size_t)NTOK * DPLE * 2);
  p.PGb = (u16*)regB;
  p.EW1 = (u16*)regB; p.EW2 = p.EW1 + (size_t)NE * 2048 * 1024;
  p.XE = (u16*)regA; p.HID = (u16*)(regA + (size_t)32 * 1024 * 1024 * 2);
  p.YE = (u16*)regC;
  p.TCNT = (int*)TAKE((size_t)NTOK * 4); p.TLIST = (int*)TAKE((size_t)NTOK * 16 * 4);
  p.CTR = (unsigned*)TAKE(256);
  p.BAR = (unsigned*)TAKE(XCD_BAR_WORDS * 4);
  return off;
}
#undef TAKE
constexpr int DSM_BYTES = g8::STAGE_BYTES + 64;
extern __shared__ __attribute__((aligned(16))) char dsm[];
struct PK { const void* in[31]; float* out; char* ws; };
DI void build_params(P& p, const PK& k) {
  p.x = (const float*)k.in[0]; p.p = (const float*)k.in[1]; p.pos = (const int*)k.in[2];
  p.attn_norm = (const float*)k.in[3]; p.w_in = (const float*)k.in[4]; p.rw_mu = (const float*)k.in[5];
  p.rw_w0 = (const float*)k.in[6]; p.rw_w_up = (const float*)k.in[7]; p.rw_a0 = (const float*)k.in[8];
  p.rw_a_up = (const float*)k.in[9]; p.rw_g_up = (const float*)k.in[10]; p.rw_k_k = (const float*)k.in[11];
  p.rw_k_a = (const float*)k.in[12]; p.rw_r_k = (const float*)k.in[13]; p.rw_lnx_w = (const float*)k.in[14];
  p.rw_lnx_b = (const float*)k.in[15]; p.mla_q_norm = (const float*)k.in[16]; p.mla_q_up = (const float*)k.in[17];
  p.mla_kv_norm = (const float*)k.in[18]; p.mla_kv_up = (const float*)k.in[19]; p.mla_o_norm = (const float*)k.in[20];
  p.w_out = (const float*)k.in[21]; p.ffn_norm = (const float*)k.in[22]; p.router = (const float*)k.in[23];
  p.exp_w_gate = (const float*)k.in[24]; p.exp_w_up = (const float*)k.in[25]; p.exp_w_down = (const float*)k.in[26];
  p.ple_norm = (const float*)k.in[27]; p.ple_proj = (const float*)k.in[28]; p.ple_gate = (const float*)k.in[29];
  p.final_norm = (const float*)k.in[30];
  p.out = k.out;
  (void)fill_ws(p, k.ws);
}
__global__ void __launch_bounds__(NTH) mega(PK pk) {
  P p; build_params(p, pk);
  char* smem = dsm;
  LAS unsigned char* glds = (LAS unsigned char*)dsm;
  uint4* xbw = (uint4*)(dsm + g8::STAGE_BYTES);
  cg::grid_group grid = cg::this_grid();
  if (threadIdx.x == 0) *xbw = make_uint4(0u, 0u, 0u, 0u);
  if (blockIdx.x == 0) {
    if (threadIdx.x < 16) p.CTR[threadIdx.x] = 0u;
    for (int i = threadIdx.x; i < XCD_BAR_WORDS; i += NTH) p.BAR[i] = 0u;
  }
  grid.sync();
  const XcdBarrier xb = xcd_barrier_post(p.BAR, (volatile LAS unsigned*)xbw);
#define GSYNC() xcd_barrier(xb)
#ifndef PROBE_MASK
#define PROBE_MASK 0u
#endif
#if PROBE_MASK
  unsigned long long pt0 = __builtin_amdgcn_s_memrealtime();
#define PSYNC(id) do { GSYNC(); if (PROBE_MASK & (1u << (id))) { unsigned long long t1_ = __builtin_amdgcn_s_memrealtime(); unsigned long long dt_ = t1_ - pt0; \
    while (__builtin_amdgcn_s_memrealtime() - t1_ < dt_) __builtin_amdgcn_s_sleep(8); } pt0 = __builtin_amdgcn_s_memrealtime(); } while (0)
#else
#define PSYNC(id) GSYNC()
#endif
  for (int layer_ = 0; layer_ < NL; ++layer_) {
    int layer = layer_; asm volatile("" : "+s"(layer));
    if (layer_ == 0) ph_rope_table(p);
    ph_cvt_small(p, layer, smem);
    ph_norm(layer == 0 ? p.x : p.out, p.attn_norm + layer * DM, p.H);
    PSYNC(0);
    {
      g8::Sched S; S.init(NTOK / 256, WIN_PAD / 256, gridDim.x, bidx(), p.H, p.WIN, DM);
      g8::EpiZ E{p.Z};
      g8::gemm_phase(glds, DM, S, E);
    }
    PSYNC(1);
    ph_rwshift(p, layer);
    ph_mlaprep1(p, layer);
    PSYNC(2);
    for (int d = 0; d < 2; ++d) {
      u16* LW = p.LW + (size_t)d * NTOK * RWW; const float* w0 = p.rw_w0 + (layer * 2 + d) * RWW;
      ph_gemm<false>(p.TWD + (size_t)d * NTOK * 64, 64, p.rw_w_up + ((size_t)(layer * 2 + d)) * 64 * RWW, RWW, NTOK, RWW, 64, smem,
                     [&](int row, int col, float v) { LW[(size_t)row * RWW + col] = f2bf(-0.6065306597126334f * sigmoidf_(v + w0[col])); });
      u16* AA = p.AA + (size_t)d * NTOK * RWW; const float* a0 = p.rw_a0 + (layer * 2 + d) * RWW;
      ph_gemm<false>(p.AD + (size_t)d * NTOK * 64, 64, p.rw_a_up + ((size_t)(layer * 2 + d)) * 64 * RWW, RWW, NTOK, RWW, 64, smem,
                     [&](int row, int col, float v) { AA[(size_t)row * RWW + col] = f2bf(sigmoidf_(v + a0[col])); });
    }
    {
      u16* G = p.G;
      ph_gemm<false>(p.SGD, 128, p.rw_g_up + (size_t)layer * 128 * RWW, RWW, NTOK, RWW, 128, smem,
                     [&](int row, int col, float v) { G[(size_t)row * RWW + col] = f2bf(v); });
      {
        u16* Qo = p.Q; const float* rope = p.ROPE;
        ph_gemm_t(p.QDN, 256, p.mla_q_up + (size_t)layer * 256 * 768, 768, NTOK, 768, 256, smem,
                  [&](const f32x4 (&acc)[4][4], int m0, int n0, int wm, int wn, int lq, int l15) {
          const float qs = 0.10206207261596577f * 1.4426950408889634f;
#pragma unroll
          for (int mi = 0; mi < 4; ++mi)
#pragma unroll
            for (int r = 0; r < 4; ++r) {
              const int tok = m0 + wm * 64 + mi * 16 + lq * 4 + r; const int b = tok / T, t = tok % T;
#pragma unroll
              for (int ni = 0; ni < 4; ++ni) {
                const int col0 = n0 + wn * 64 + ni * 16; const int h = col0 / 96, c0 = col0 % 96;
                u16* qo = Qo + ((size_t)(b * NH + h) * T + t) * 96;
                if (c0 < 64) qo[c0 + l15] = f2bf(acc[mi][ni][r] * qs);
                else if (c0 == 64) {
                  const f32x2 csn = *(const f32x2*)(rope + (size_t)tok * 32 + l15 * 2);
                  const float u1 = acc[mi][ni][r], u2 = acc[mi][(ni + 1) & 3][r];
                  qo[64 + l15] = f2bf((u1 * csn[0] - u2 * csn[1]) * qs);
                  qo[80 + l15] = f2bf((u1 * csn[1] + u2 * csn[0]) * qs);
                }
              }
            }
        });
      }
      {
        u16* Ko = p.Kc; u16* Vo = p.Vv;
        ph_gemm_t(p.KVDN, 128, p.mla_kv_up + (size_t)layer * 128 * 1024, 1024, NTOK, 1024, 128, smem,
                  [&](const f32x4 (&acc)[4][4], int m0, int n0, int wm, int wn, int lq, int l15) {
#pragma unroll
          for (int mi = 0; mi < 4; ++mi)
#pragma unroll
            for (int r = 0; r < 4; ++r) {
              const int tok = m0 + wm * 64 + mi * 16 + lq * 4 + r; const int b = tok / T, t = tok % T;
#pragma unroll
              for (int ni = 0; ni < 4; ++ni) {
                const int col0 = n0 + wn * 64 + ni * 16; const int h = col0 >> 7, c0 = col0 & 127;
                const size_t rowi = (size_t)(b * NH + h) * T + t;
                if (c0 < 64) Ko[rowi * 96 + c0 + l15] = f2bf(acc[mi][ni][r]);
                else Vo[rowi * 64 + (c0 - 64) + l15] = f2bf(acc[mi][ni][r]);
              }
            }
        });
      }
    }
    PSYNC(3);
    ph_scan1(p, layer, smem);
    PSYNC(4);
    ph_scan2(p, smem);
    ph_attn(p, smem, p.CTR + layer);
    PSYNC(5);
    ph_scan3(p, layer, smem);
    PSYNC(6);
    ph_mixfinish(p, layer);
    PSYNC(7);
    {
      for (int i = blockIdx.x * NTH + tidx(); i < NTOK; i += gridDim.x * NTH) p.TCNT[i] = 0;
      g8::Sched S; S.init(NTOK / 256, DM / 256, gridDim.x, bidx(), p.H, p.WOUT, DM);
      g8::EpiRes E{(layer == 0) ? p.x : p.out, p.out};
      g8::gemm_phase(glds, DM, S, E);
    }
    PSYNC(8);
    ph_norm_router(p, layer, smem);
    PSYNC(9);
    ph_topk(p, smem);
    ph_cvt_experts(p, layer, smem, p.CTR + 4 + layer);
    PSYNC(10);
    ph_gather(p);
    PSYNC(11);
    {
      g8::Sched S; S.init(NB * NE * CAP / 256, 2048 / 256, gridDim.x, bidx(), p.XE, p.EW1, DM);
      S.group(4, NE, (size_t)2048 * 1024 * 2);
      g8::EpiSwi E{p.HID};
      g8::gemm_phase(glds, DM, S, E);
    }
    PSYNC(12);
    {
      g8::Sched S; S.init(NB * NE * CAP / 256, DM / 256, gridDim.x, bidx(), p.HID, p.EW2, 1024);
      S.group(4, NE, (size_t)1024 * 1024 * 2);
      g8::EpiYE E{p.YE, p.GATE};
      g8::gemm_phase(glds, 1024, S, E);
    }
    PSYNC(13);
    ph_combine_norm(p, layer);
    PSYNC(16);
    {
      g8::Sched S; S.init(NTOK / 256, DM / 256, gridDim.x, bidx(), p.H, p.WPG, DM);
      g8::EpiSig E{p.PGb};
      g8::gemm_phase(glds, DM, S, E);
    }
    {
      g8::Sched S; S.init(NTOK / 256, DM / 256, gridDim.x, bidx(), p.PB, p.WPP, DPLE);
      g8::EpiPle E{p.out, p.PGb};
      g8::gemm_phase(glds, DPLE, S, E);
    }
    PSYNC(15);
  }
  ph_final_norm(p.out, p.final_norm);
}

extern "C" void kernel_launch(void* const* d_in, const int* in_sizes, int n_in, void* d_out, int out_size, void* d_ws,
                              size_t ws_size, hipStream_t stream) {
  (void)in_sizes; (void)n_in; (void)out_size;
  PK pk{};
  for (int i = 0; i < 31; ++i) pk.in[i] = d_in[i];
  pk.out = (float*)d_out; pk.ws = (char*)d_ws;
  P p{};
  const size_t off = fill_ws(p, (char*)d_ws);
  if (off > ws_size) { fprintf(stderr, "workspace too small: need %zu have %zu\n", off, ws_size); return; }
  static int grid_blocks = 0;
  if (!grid_blocks) {
    int dev = 0, cus = 0, per_cu = 0;
    hipGetDevice(&dev);
    hipDeviceGetAttribute(&cus, hipDeviceAttributeMultiprocessorCount, dev);
    hipFuncSetAttribute((const void*)mega, hipFuncAttributeMaxDynamicSharedMemorySize, DSM_BYTES);
    hipOccupancyMaxActiveBlocksPerMultiprocessor(&per_cu, mega, NTH, DSM_BYTES);
    if (per_cu > 1) per_cu = 1;
    grid_blocks = cus * per_cu;
  }
  void* args[] = {&pk};
  hipError_t e = hipLaunchCooperativeKernel((void*)mega, dim3(grid_blocks), dim3(NTH), args, DSM_BYTES, stream);
  if (e != hipSuccess) fprintf(stderr, "cooperative launch failed: %s (grid %d)\n", hipGetErrorString(e), grid_blocks);
}
```

```cpp
#include <hip/hip_runtime.h>
#include <hip/hip_bf16.h>
#include <cstdio>
#include <cstdint>
#include <hip/hip_cooperative_groups.h>
namespace cg = cooperative_groups;

#define DI __device__ __forceinline__
#define LAS __attribute__((address_space(3)))

constexpr int NB = 2, T = 8192, NTOK = NB * T, DM = 1024, NL = 2;
constexpr int RWW = 512, RWC = 1920, INC = 2336;
constexpr int NH = 8;
constexpr int NE = 16, CAP = 1024;
constexpr int DPLE = 256;
constexpr int NTH = 512;
constexpr float NORM_EPS = 1e-6f, GN_EPS = 64e-5f;

using bf16x8 = __attribute__((ext_vector_type(8))) short;
using s16x4  = __attribute__((ext_vector_type(4))) short;
using f32x4  = __attribute__((ext_vector_type(4))) float;
using u32x4  = __attribute__((ext_vector_type(4))) unsigned;
using f32x2  = __attribute__((ext_vector_type(2))) float;
using u32x2  = __attribute__((ext_vector_type(2))) unsigned;
typedef __bf16 bf2_t __attribute__((ext_vector_type(2)));
typedef unsigned short u16;

DI unsigned pk2(float a, float b) { bf2_t v = {(__bf16)a, (__bf16)b}; return __builtin_bit_cast(unsigned, v); }
DI u16 f2bf(float a) { return (u16)(pk2(a, 0.f) & 0xffffu); }
DI float bf2f(u16 u) { return __uint_as_float(((unsigned)u) << 16); }
DI const void* uni_ptr(const void* q) {
  unsigned long long v = (unsigned long long)q;
  unsigned lo = __builtin_amdgcn_readfirstlane((unsigned)v), hi = __builtin_amdgcn_readfirstlane((unsigned)(v >> 32));
  return (const void*)(((unsigned long long)hi << 32) | lo);
}
DI int tidx() { int t = threadIdx.x; asm volatile("" : "+v"(t)); return t; }
DI int bidx() { int b = blockIdx.x; asm volatile("" : "+s"(b)); return b; }
template <int CTRL> DI float dpp_f(float v) {
  return __int_as_float(__builtin_amdgcn_update_dpp(__float_as_int(v), __float_as_int(v), CTRL, 0xF, 0xF, true));
}
DI float red_x1(float v) { return v + dpp_f<0xB1>(v); }
DI float red_x2(float v) { return v + dpp_f<0x4E>(v); }
DI float red_x4(float v) { return v + dpp_f<0x141>(v); }
DI float red_x8(float v) { return v + dpp_f<0x140>(v); }
DI float red_x16(float v) { auto r = __builtin_amdgcn_permlane16_swap(__float_as_uint(v), __float_as_uint(v), false, false); return __uint_as_float(r[0]) + __uint_as_float(r[1]); }
DI float red_x32(float v) { auto r = __builtin_amdgcn_permlane32_swap(__float_as_uint(v), __float_as_uint(v), false, false); return __uint_as_float(r[0]) + __uint_as_float(r[1]); }
DI float red16(float v) { return red_x8(red_x4(red_x2(red_x1(v)))); }
DI float wave_sum(float v) { return red_x32(red_x16(red16(v))); }
DI float frcp(float x) { return __builtin_amdgcn_rcpf(x); }
DI float frsq(float x) { return __builtin_amdgcn_rsqf(x); }
DI float fexp(float x) { return __builtin_amdgcn_exp2f(x * 1.4426950408889634f); }
DI float sigmoidf_(float x) { return frcp(1.f + fexp(-x)); }
DI float ftanh(float x) { return 1.f - 2.f * frcp(1.f + fexp(2.f * x)); }
DI s16x4 tr_read(const short* p) {
  return __builtin_amdgcn_ds_read_tr16_b64_v4i16((LAS s16x4*)(p));
}

struct P {
  const float* x; const float* p; const int* pos;
  const float* attn_norm; const float* w_in; const float* rw_mu; const float* rw_w0; const float* rw_w_up;
  const float* rw_a0; const float* rw_a_up; const float* rw_g_up; const float* rw_k_k; const float* rw_k_a;
  const float* rw_r_k; const float* rw_lnx_w; const float* rw_lnx_b; const float* mla_q_norm; const float* mla_q_up;
  const float* mla_kv_norm; const float* mla_kv_up; const float* mla_o_norm; const float* w_out; const float* ffn_norm;
  const float* router; const float* exp_w_gate; const float* exp_w_up; const float* exp_w_down; const float* ple_norm;
  const float* ple_proj; const float* ple_gate; const float* final_norm;
  float* out;
  float* Z;
  u16* LW;
  u16* AA;
  float* MC; float* NC;
  float* SS;
  u16*   G;
  u16*   HID;
  float* R; float* K; float* V;
  float* PG;
  float* QRAW;
  float* KVRAW;
  float* AO;
  u16* O2;
  u16* TWD; u16* AD; u16* SGD; u16* QDN; u16* KVDN; float* KR;
  float* ROPE;
  u16* Q; u16* Kc; u16* Vv;
  u16* H;
  float* AFF;
  int* IDX;
  float* GATE;
  u16* WIN; u16* WOUT; u16* WPG; u16* WPP; u16* PB;
  u16* PGb;
  u16* EW1; u16* EW2;
  u16* XE; u16* YE;
  int* TCNT; int* TLIST;
  unsigned* CTR;
  unsigned* BAR;
};

constexpr int GBM = 256, GBN = 128, GBK = 64;
constexpr int AS_STRIDE = 72, BS_STRIDE = 136;
constexpr int AS_BYTES = GBM * AS_STRIDE * 2;
constexpr int BS_BYTES = GBK * BS_STRIDE * 2;
constexpr int SMEM_BYTES = 57344;

template <bool A_F32, int MODE, class ARow, class Epi>
DI void gemm_tile(ARow arow, const float* __restrict__ B, const float* __restrict__ B2, int ldb, int K, int n0, int Nvalid,
                  char* smem, Epi epi) {
  short* As = (short*)smem;
  short* Bs = (short*)(smem + AS_BYTES);
  const int tid = tidx(), lane = tid & 63, w = tid >> 6;
  const int wm = w >> 1, wn = w & 1;
  const int l15 = lane & 15, lq = lane >> 4;

  const char* ap[4];
#pragma unroll
  for (int i = 0; i < 4; ++i) {
    int u = tid + i * NTH; int row = u >> 3, kc = u & 7;
    ap[i] = (const char*)arow(row) + (size_t)kc * 8 * (A_F32 ? 4 : 2);
  }
  const float* bp[4]; bool bok[4];
#pragma unroll
  for (int i = 0; i < 4; ++i) {
    int u = tid + i * NTH; int k = u >> 5, nq = u & 31;
    int col; const float* base;
    if (MODE != 1) { col = n0 + nq * 4; base = B; }
    else { col = n0 + (nq & 15) * 4; base = (nq < 16) ? B : B2; }
    bok[i] = col < Nvalid;
    bp[i] = base + (size_t)k * ldb + (bok[i] ? col : 0);
  }

  f32x4 acc[4][4];
#pragma unroll
  for (int i = 0; i < 4; ++i)
#pragma unroll
    for (int j = 0; j < 4; ++j) acc[i][j] = f32x4{0.f, 0.f, 0.f, 0.f};

  u32x4 areg[4]; f32x4 breg[4];
#define GLOAD(kt_)                                                                                   \
  {                                                                                                  \
    _Pragma("unroll") for (int i = 0; i < 4; ++i) {                                                  \
      if (A_F32) {                                                                                   \
        const float4* q = (const float4*)(ap[i] + (size_t)(kt_) * GBK * 4);                          \
        float4 v0 = q[0], v1 = q[1];                                                                 \
        areg[i] = u32x4{pk2(v0.x, v0.y), pk2(v0.z, v0.w), pk2(v1.x, v1.y), pk2(v1.z, v1.w)};         \
      } else {                                                                                       \
        areg[i] = *(const u32x4*)(ap[i] + (size_t)(kt_) * GBK * 2);                                  \
      }                                                                                              \
    }                                                                                                \
    _Pragma("unroll") for (int i = 0; i < 4; ++i) {                                                  \
      if (bok[i]) breg[i] = *(const f32x4*)(bp[i] + (size_t)(kt_) * GBK * ldb);                      \
      else breg[i] = f32x4{0.f, 0.f, 0.f, 0.f};                                                      \
    }                                                                                                \
  }
  const int nk = K / GBK;
  GLOAD(0)
  for (int kt = 0; kt < nk; ++kt) {
    __syncthreads();
#pragma unroll
    for (int i = 0; i < 4; ++i) {
      int u = tid + i * NTH; int row = u >> 3, kc = u & 7;
      *(u32x4*)(As + row * AS_STRIDE + kc * 8) = areg[i];
    }
#pragma unroll
    for (int i = 0; i < 4; ++i) {
      int u = tid + i * NTH; int k = u >> 5, nq = u & 31;
      u32x2 v = u32x2{pk2(breg[i][0], breg[i][1]), pk2(breg[i][2], breg[i][3])};
      *(u32x2*)(Bs + k * BS_STRIDE + nq * 4) = v;
    }
    __syncthreads();
    if (kt + 1 < nk) GLOAD(kt + 1)
#pragma unroll
    for (int ks = 0; ks < 2; ++ks) {
      bf16x8 a[4], b[4];
#pragma unroll
      for (int mi = 0; mi < 4; ++mi)
        a[mi] = *(const bf16x8*)(As + (wm * 64 + mi * 16 + l15) * AS_STRIDE + ks * 32 + 8 * lq);
#pragma unroll
      for (int ni = 0; ni < 4; ++ni) {
        int col0 = (MODE != 1) ? (wn * 64 + ni * 16) : ((ni < 2) ? (wn * 32 + ni * 16) : (64 + wn * 32 + (ni - 2) * 16));
        int kb = ks * 32 + 8 * lq; int q = l15 >> 2, pp = l15 & 3;
        s16x4 lo = tr_read(Bs + (kb + q) * BS_STRIDE + col0 + 4 * pp);
        s16x4 hi = tr_read(Bs + (kb + 4 + q) * BS_STRIDE + col0 + 4 * pp);
        b[ni] = __builtin_shufflevector(lo, hi, 0, 1, 2, 3, 4, 5, 6, 7);
      }
#pragma unroll
      for (int mi = 0; mi < 4; ++mi)
#pragma unroll
        for (int ni = 0; ni < 4; ++ni)
          acc[mi][ni] = __builtin_amdgcn_mfma_f32_16x16x32_bf16(a[mi], b[ni], acc[mi][ni], 0, 0, 0);
    }
  }
  if constexpr (MODE == 2) { epi(acc, wm, wn, lq, l15); return; }
  else {
#pragma unroll
  for (int mi = 0; mi < 4; ++mi)
#pragma unroll
    for (int r = 0; r < 4; ++r) {
      int row = wm * 64 + mi * 16 + lq * 4 + r;
      if (MODE == 0) {
#pragma unroll
        for (int ni = 0; ni < 4; ++ni) {
          int col = n0 + wn * 64 + ni * 16 + l15;
          if (col < Nvalid) epi(row, col, acc[mi][ni][r], 0.f);
        }
      } else {
#pragma unroll
        for (int ni = 0; ni < 2; ++ni) {
          int col = n0 + wn * 32 + ni * 16 + l15;
          epi(row, col, acc[mi][ni][r], acc[mi][ni + 2][r]);
        }
      }
    }
  }
}

DI void ph_norm(const float* __restrict__ X, const float* __restrict__ g, u16* __restrict__ Hout) {
  const int tid_ = tidx(); const int lane = tid_ & 63, w = tid_ >> 6;
  for (int tok = blockIdx.x * 8 + w; tok < NTOK; tok += gridDim.x * 8) {
    const float4* xr = (const float4*)(X + (size_t)tok * DM);
    float4 v[4]; float ss = 0.f;
#pragma unroll
    for (int j = 0; j < 4; ++j) { v[j] = xr[lane + 64 * j]; ss += v[j].x * v[j].x + v[j].y * v[j].y + v[j].z * v[j].z + v[j].w * v[j].w; }
    ss = wave_sum(ss);
    float rstd = frsq(ss * (1.f / DM) + NORM_EPS);
#pragma unroll
    for (int j = 0; j < 4; ++j) {
      float4 gg = ((const float4*)g)[lane + 64 * j];
      uint2 o = uint2{pk2(v[j].x * rstd * gg.x, v[j].y * rstd * gg.y), pk2(v[j].z * rstd * gg.z, v[j].w * rstd * gg.w)};
      *(uint2*)(Hout + (size_t)tok * DM + (lane + 64 * j) * 4) = o;
    }
  }
}

DI void ph_final_norm(float* __restrict__ X, const float* __restrict__ g) {
  const int tid_ = tidx(); const int lane = tid_ & 63, w = tid_ >> 6;
  for (int tok = blockIdx.x * 8 + w; tok < NTOK; tok += gridDim.x * 8) {
    float4* xr = (float4*)(X + (size_t)tok * DM);
    float4 v[4]; float ss = 0.f;
#pragma unroll
    for (int j = 0; j < 4; ++j) { v[j] = xr[lane + 64 * j]; ss += v[j].x * v[j].x + v[j].y * v[j].y + v[j].z * v[j].z + v[j].w * v[j].w; }
    ss = wave_sum(ss);
    float rstd = frsq(ss * (1.f / DM) + NORM_EPS);
#pragma unroll
    for (int j = 0; j < 4; ++j) {
      float4 gg = ((const float4*)g)[lane + 64 * j];
      xr[lane + 64 * j] = float4{v[j].x * rstd * gg.x, v[j].y * rstd * gg.y, v[j].z * rstd * gg.z, v[j].w * rstd * gg.w};
    }
  }
}

template <bool A_F32, class Epi>
DI void ph_gemm(const void* A, int lda, const float* B, int ldb, int M, int N, int K, char* smem, Epi epi) {
  const int ntn = (N + GBN - 1) / GBN, ntm = M / GBM;
  for (int t = blockIdx.x; t < ntm * ntn; t += gridDim.x) {
    int tm = t / ntn, tn = t % ntn;
    int m0 = tm * GBM, n0 = tn * GBN;
    auto arow = [&](int r) -> const void* { return (const char*)A + (size_t)(m0 + r) * lda * (A_F32 ? 4 : 2); };
    gemm_tile<A_F32, 0>(arow, B, nullptr, ldb, K, n0, N, smem, [&](int row, int col, float v, float) { epi(m0 + row, col, v); });
    __syncthreads();
  }
}

template <class Epi>
DI void ph_gemm_t(const void* A, int lda, const float* B, int ldb, int M, int N, int K, char* smem, Epi epi) {
  const int ntn = (N + GBN - 1) / GBN, ntm = M / GBM;
  for (int t = blockIdx.x; t < ntm * ntn; t += gridDim.x) {
    int tm = t / ntn, tn = t % ntn;
    int m0 = tm * GBM, n0 = tn * GBN;
    auto arow = [&](int r) -> const void* { return (const char*)A + (size_t)(m0 + r) * lda * 2; };
    gemm_tile<false, 2>(arow, B, nullptr, ldb, K, n0, N, smem,
                        [&](const f32x4 (&acc)[4][4], int wm, int wn, int lq, int l15) { epi(acc, m0, n0, wm, wn, lq, l15); });
    __syncthreads();
  }
}

DI void ph_rwshift(const P& p, int layer) {
  const float* mu = p.rw_mu + layer * RWC;
  const int total = NTOK * (RWC / 4);
  const int tid_ = tidx();
  for (int i = blockIdx.x * NTH + tid_; i < total; i += gridDim.x * NTH) {
    int tok = i / (RWC / 4), c = (i % (RWC / 4)) * 4;
    int t = tok % T;
    const float* zr = p.Z + (size_t)tok * INC + c;
    float4 z = *(const float4*)zr;
    float4 zm = (t > 0) ? *(const float4*)(zr - INC) : float4{0.f, 0.f, 0.f, 0.f};
    float4 zp = (t < T - 1) ? *(const float4*)(zr + INC) : float4{0.f, 0.f, 0.f, 0.f};
    float4 m = *(const float4*)(mu + c);
    float4 o;
    o.x = z.x + m.x * (0.5f * (zm.x + zp.x) - z.x);
    o.y = z.y + m.y * (0.5f * (zm.y + zp.y) - z.y);
    o.z = z.z + m.z * (0.5f * (zm.z + zp.z) - z.z);
    o.w = z.w + m.w * (0.5f * (zm.w + zp.w) - z.w);
    if (c < 512) *(float4*)(p.R + (size_t)tok * RWW + c) = o;
    else if (c < 1024) *(float4*)(p.K + (size_t)tok * RWW + (c - 512)) = o;
    else if (c < 1536) *(float4*)(p.V + (size_t)tok * RWW + (c - 1024)) = o;
    else if (c < 1664) {
      int d = (c - 1536) >> 6, l = (c - 1536) & 63;
      *(uint2*)(p.TWD + ((size_t)d * NTOK + tok) * 64 + l) = uint2{pk2(ftanh(o.x), ftanh(o.y)), pk2(ftanh(o.z), ftanh(o.w))};
    } else if (c < 1792) {
      int d = (c - 1664) >> 6, l = (c - 1664) & 63;
      *(uint2*)(p.AD + ((size_t)d * NTOK + tok) * 64 + l) = uint2{pk2(o.x, o.y), pk2(o.z, o.w)};
    } else {
      int l = c - 1792;
      *(uint2*)(p.SGD + (size_t)tok * 128 + l) = uint2{pk2(sigmoidf_(o.x), sigmoidf_(o.y)), pk2(sigmoidf_(o.z), sigmoidf_(o.w))};
    }
  }
}

DI void rope_cs(int pos, int i, float& cs, float& sn) {
  const int i3 = i & 3, i2 = i >> 2;
  const float c4 = (i3 == 0) ? 1.0f : (i3 == 1) ? 0.5623413251903491f : (i3 == 2) ? 0.31622776601683794f : 0.1778279410038923f;
  const float p10 = (i2 == 0) ? 1.0f : (i2 == 1) ? 0.1f : (i2 == 2) ? 0.01f : 0.001f;
  float inv = c4 * p10;
  float ang = (float)pos * inv;
  double rev = (double)ang * 0.15915494309189535;
  rev -= floor(rev);
  float rf = (float)rev;
  sn = __builtin_amdgcn_sinf(rf);
  cs = __builtin_amdgcn_cosf(rf);
}

DI void ph_rope_table(const P& p) {
  for (int i = blockIdx.x * NTH + tidx(); i < NTOK * 16; i += gridDim.x * NTH) {
    float cs, sn; rope_cs(p.pos[i >> 4], i & 15, cs, sn);
    *(f32x2*)(p.ROPE + (size_t)i * 2) = f32x2{cs, sn};
  }
}
DI void ph_mlaprep1(const P& p, int layer) {
  const int tid_ = tidx(); const int lane = tid_ & 63, w = tid_ >> 6;
  const float* qn = p.mla_q_norm + layer * 256;
  const float* kvn = p.mla_kv_norm + layer * 128;
  for (int tok = blockIdx.x * 8 + w; tok < NTOK; tok += gridDim.x * 8) {
    const float* zr = p.Z + (size_t)tok * INC + RWC;
    float4 q = *(const float4*)(zr + lane * 4);
    float ss = wave_sum(q.x * q.x + q.y * q.y + q.z * q.z + q.w * q.w);
    float rstd = frsq(ss * (1.f / 256) + NORM_EPS);
    float4 g = *(const float4*)(qn + lane * 4);
    *(uint2*)(p.QDN + (size_t)tok * 256 + lane * 4) = uint2{pk2(q.x * rstd * g.x, q.y * rstd * g.y), pk2(q.z * rstd * g.z, q.w * rstd * g.w)};
    float2 kv = *(const float2*)(zr + 256 + lane * 2);
    float ss2 = wave_sum(kv.x * kv.x + kv.y * kv.y);
    float rstd2 = frsq(ss2 * (1.f / 128) + NORM_EPS);
    float2 g2 = *(const float2*)(kvn + lane * 2);
    *(unsigned*)(p.KVDN + (size_t)tok * 128 + lane * 2) = pk2(kv.x * rstd2 * g2.x, kv.y * rstd2 * g2.y);
    if (lane < 16) {
      float u1 = zr[384 + lane], u2 = zr[384 + 16 + lane];
      const f32x2 csn = *(const f32x2*)(p.ROPE + (size_t)tok * 32 + lane * 2);
      const u16 k1 = f2bf(u1 * csn[0] - u2 * csn[1]), k2 = f2bf(u1 * csn[1] + u2 * csn[0]);
      const int bb = tok / T, tt = tok % T;
#pragma unroll
      for (int h = 0; h < NH; ++h) {
        u16* ko = p.Kc + ((size_t)(bb * NH + h) * T + tt) * 96 + 64;
        ko[lane] = k1; ko[16 + lane] = k2;
      }
    }
  }
}

DI void ph_mlafinish(const P& p) {
  const int tid_ = tidx(); const int lane = tid_ & 63, w = tid_ >> 6;
  const float qs = 0.10206207261596577f * 1.4426950408889634f;
  for (int tok = blockIdx.x * 8 + w; tok < NTOK; tok += gridDim.x * 8) {
    int b = tok / T, t = tok % T;
    float cs = 0.f, sn = 0.f;
    if (lane < 16) rope_cs(p.pos[tok], lane, cs, sn);
    const float* qr = p.QRAW + (size_t)tok * 768;
    const float* kvr = p.KVRAW + (size_t)tok * 1024;
    const float* kr = p.KR + (size_t)tok * 32;
#pragma unroll
    for (int h = 0; h < NH; ++h) {
      size_t row = ((size_t)(b * NH + h) * T + t);
      u16* qo = p.Q + row * 96; u16* ko = p.Kc + row * 96; u16* vo = p.Vv + row * 64;
      qo[lane] = f2bf(qr[h * 96 + lane] * qs);
      ko[lane] = f2bf(kvr[h * 128 + lane]);
      vo[lane] = f2bf(kvr[h * 128 + 64 + lane]);
      if (lane < 16) {
        float u1 = qr[h * 96 + 64 + lane], u2 = qr[h * 96 + 80 + lane];
        qo[64 + lane] = f2bf((u1 * cs - u2 * sn) * qs);
        qo[80 + lane] = f2bf((u1 * sn + u2 * cs) * qs);
      }
      if (lane < 32) ko[64 + lane] = f2bf(kr[lane]);
    }
  }
}

using f32x16 = __attribute__((ext_vector_type(16))) float;
#define SBAR() __builtin_amdgcn_sched_barrier(0)
constexpr int AT_KSTR = 104;
constexpr int AT_KBYTES = 64 * AT_KSTR * 2;
constexpr int AT_VBYTES = 64 * 64 * 2;
constexpr float AT_THR = 8.f;
DI int crow(int r, int hi) { return (r & 3) + 8 * (r >> 2) + 4 * hi; }
DI int v_st(int k, int c) { const int kk = (k & ~0xC) | ((k & 4) << 1) | ((k & 8) >> 1); return ((kk >> 3) * 2 + (c >> 5)) * 512 + ((kk & 7) * 32 + (c & 31)) * 2; }
DI int v_rd_base(int lane) { return ((lane & 3) << 3) | (((lane >> 2) & 3) << 6) | (((lane >> 4) & 1) << 5) | (((lane >> 5) & 1) << 8); }
constexpr int v_rd_off(int d0, int ks, int half) { return d0 * 512 + ks * 2048 + half * 1024; }

DI void at_partialSM(f32x16& p0, f32x16& p1, float& m_reg, float& mn, float& alpha) {
  float pmax = p0[0];
#pragma unroll
  for (int r = 1; r < 16; ++r) pmax = fmaxf(pmax, p0[r]);
#pragma unroll
  for (int r = 0; r < 16; ++r) pmax = fmaxf(pmax, p1[r]);
  { auto rr = __builtin_amdgcn_permlane32_swap(__float_as_uint(pmax), __float_as_uint(pmax), false, false);
    pmax = fmaxf(__uint_as_float(rr[0]), __uint_as_float(rr[1])); }
  if (__builtin_expect(__all(pmax - m_reg <= AT_THR), 1)) { mn = m_reg; alpha = 1.f; }
  else { mn = fmaxf(m_reg, pmax); alpha = __builtin_amdgcn_exp2f(m_reg - mn); m_reg = mn; }
#pragma unroll
  for (int r = 0; r < 16; ++r) { p0[r] = p0[r] - mn; p1[r] = p1[r] - mn; }
#pragma unroll
  for (int r = 0; r < 16; ++r) p0[r] = __builtin_amdgcn_exp2f(p0[r]);
}
DI void at_finishSM(f32x16& p0, f32x16& p1, float alpha, float& l_reg, bf16x8& pa0, bf16x8& pa1, bf16x8& pa2, bf16x8& pa3) {
#pragma unroll
  for (int r = 0; r < 16; ++r) p1[r] = __builtin_amdgcn_exp2f(p1[r]);
  float ps = 0;
#pragma unroll
  for (int r = 0; r < 16; ++r) ps += p0[r];
#pragma unroll
  for (int r = 0; r < 16; ++r) ps += p1[r];
  { auto rr = __builtin_amdgcn_permlane32_swap(__float_as_uint(ps), __float_as_uint(ps), false, false);
    ps = __uint_as_float(rr[0]) + __uint_as_float(rr[1]); }
  l_reg = l_reg * alpha + ps;
#define PK4(PP, BASE, OUT) do { unsigned a0 = pk2(PP[BASE + 0], PP[BASE + 1]), a1 = pk2(PP[BASE + 2], PP[BASE + 3]);   \
    unsigned b0 = pk2(PP[BASE + 4], PP[BASE + 5]), b1 = pk2(PP[BASE + 6], PP[BASE + 7]);                              \
    auto r0 = __builtin_amdgcn_permlane32_swap(a0, b0, false, false); auto r1 = __builtin_amdgcn_permlane32_swap(a1, b1, false, false); \
    u32x4 wv = {r0[0], r1[0], r0[1], r1[1]}; OUT = __builtin_bit_cast(bf16x8, wv); } while (0)
  PK4(p0, 0, pa0); PK4(p0, 8, pa1); PK4(p1, 0, pa2); PK4(p1, 8, pa3);
#undef PK4
}
DI void at_qkt(f32x16& p0, f32x16& p1, const char* Kb, const bf16x8* qr, int r32, int hi) {
#pragma unroll
  for (int r = 0; r < 16; ++r) { p0[r] = 0.f; p1[r] = 0.f; }
#pragma unroll
  for (int d0 = 0; d0 < 6; ++d0) {
    bf16x8 b0 = *(const bf16x8*)(Kb + (r32 * AT_KSTR + d0 * 16 + hi * 8) * 2);
    bf16x8 b1 = *(const bf16x8*)(Kb + ((32 + r32) * AT_KSTR + d0 * 16 + hi * 8) * 2);
    __builtin_amdgcn_s_setprio(1);
    p0 = __builtin_amdgcn_mfma_f32_32x32x16_bf16(b0, qr[d0], p0, 0, 0, 0);
    p1 = __builtin_amdgcn_mfma_f32_32x32x16_bf16(b1, qr[d0], p1, 0, 0, 0);
    __builtin_amdgcn_s_setprio(0);
  }
}
template <int D0> DI void at_pv_one(f32x16& od, const char* vb, bf16x8 pa0, bf16x8 pa1, bf16x8 pa2, bf16x8 pa3) {
#define TRR(ks, half) tr_read((const short*)(vb + v_rd_off(D0, ks, half)))
  const s16x4 l0 = TRR(0, 0), h0 = TRR(0, 1), l1 = TRR(1, 0), h1 = TRR(1, 1), l2 = TRR(2, 0), h2 = TRR(2, 1), l3 = TRR(3, 0), h3 = TRR(3, 1);
#undef TRR
#define PKV(L, H) __builtin_shufflevector(L, H, 0, 1, 2, 3, 4, 5, 6, 7)
  __builtin_amdgcn_s_setprio(1);
  od = __builtin_amdgcn_mfma_f32_32x32x16_bf16(pa0, PKV(l0, h0), od, 0, 0, 0);
  od = __builtin_amdgcn_mfma_f32_32x32x16_bf16(pa1, PKV(l1, h1), od, 0, 0, 0);
  od = __builtin_amdgcn_mfma_f32_32x32x16_bf16(pa2, PKV(l2, h2), od, 0, 0, 0);
  od = __builtin_amdgcn_mfma_f32_32x32x16_bf16(pa3, PKV(l3, h3), od, 0, 0, 0);
  __builtin_amdgcn_s_setprio(0);
#undef PKV
}
DI void at_pv(f32x16* o, const char* vb, bf16x8 pa0, bf16x8 pa1, bf16x8 pa2, bf16x8 pa3) {
  at_pv_one<0>(o[0], vb, pa0, pa1, pa2, pa3); at_pv_one<1>(o[1], vb, pa0, pa1, pa2, pa3);
}

DI void attn_body(const u16* __restrict__ Qb, const u16* __restrict__ Kh, const u16* __restrict__ Vh, float* __restrict__ Ob, char* lds, int tid) {
  const int wid = tid >> 6, lane = tid & 63, r32 = lane & 31, hi = lane >> 5;
  char* V_lds = lds; char* K_lds = lds + 2 * AT_VBYTES;
  float* wsp = (float*)(lds + 2 * AT_VBYTES + 2 * AT_KBYTES) + wid * 64; float* li_l = wsp; float* al_l = wsp + 32;
  float m_reg = -1e30f, l_reg = 0.f; f32x16 o[2]; bf16x8 qr[6];
#pragma unroll
  for (int r = 0; r < 16; ++r) { o[0][r] = 0.f; o[1][r] = 0.f; }
  const u16* Qw = Qb + (size_t)(wid * 32 + r32) * 96 + hi * 8;
#pragma unroll
  for (int d0 = 0; d0 < 6; ++d0) qr[d0] = *(const bf16x8*)(Qw + d0 * 16);
  const int kid1 = (tid < 256) ? tid + 512 : tid;
  const int kst0 = ((tid / 12) * AT_KSTR + (tid % 12) * 8) * 2, kst1 = ((kid1 / 12) * AT_KSTR + (kid1 % 12) * 8) * 2;
  const int vst = v_st(tid >> 3, (tid & 7) * 8);
  const char* vb0 = V_lds + v_rd_base(lane);
  u32x4 sk0[2], sk1[2], sv0[2];
#define SLOAD(i, k0) do { sk0[i] = *(const u32x4*)(Kh + (size_t)(k0) * 96 + tid * 8); sk1[i] = *(const u32x4*)(Kh + (size_t)(k0) * 96 + kid1 * 8); \
    sv0[i] = *(const u32x4*)(Vh + (size_t)(k0) * 64 + tid * 8); } while (0)
#define SWRITE(b, i) do { *(u32x4*)(K_lds + (b) * AT_KBYTES + kst0) = sk0[i]; if (tid < 256) *(u32x4*)(K_lds + (b) * AT_KBYTES + kst1) = sk1[i]; \
    *(u32x4*)(V_lds + (b) * AT_VBYTES + vst) = sv0[i]; } while (0)
#define SWAIT() asm volatile("s_waitcnt vmcnt(3)" ::: "memory")
#define RESC(a) do { if (__any((a) < 1.f)) { if (hi == 0) al_l[r32] = (a); asm volatile("s_waitcnt lgkmcnt(0)" ::: "memory"); \
    _Pragma("unroll") for (int r = 0; r < 16; ++r) { float al = al_l[crow(r, hi)]; o[0][r] *= al; o[1][r] *= al; } } } while (0)
  f32x16 pA0, pA1, pB0, pB1; float mnA, mnB, alA, alB; bf16x8 pa0, pa1, pa2, pa3; constexpr int NT = T / 64;
  SLOAD(0, 0); SWRITE(0, 0); __syncthreads();
  at_qkt(pA0, pA1, K_lds, qr, r32, hi); at_partialSM(pA0, pA1, m_reg, mnA, alA);
  SLOAD(1, 64); SLOAD(0, 128);
  SWAIT(); SWRITE(1, 1); __syncthreads();
  for (int j = 1; j + 1 < NT; j += 2) {
    SBAR(); at_qkt(pB0, pB1, K_lds + AT_KBYTES, qr, r32, hi);
    at_finishSM(pA0, pA1, alA, l_reg, pa0, pa1, pa2, pa3); SBAR();
    SLOAD(1, (j + 2) * 64); SBAR();
    at_pv(o, vb0, pa0, pa1, pa2, pa3); at_partialSM(pB0, pB1, m_reg, mnB, alB);
    __syncthreads(); SWAIT(); SWRITE(0, 0);
    RESC(alB); __syncthreads();
    SBAR(); at_qkt(pA0, pA1, K_lds, qr, r32, hi);
    at_finishSM(pB0, pB1, alB, l_reg, pa0, pa1, pa2, pa3); SBAR();
    if (j + 3 < NT) SLOAD(0, (j + 3) * 64); SBAR();
    at_pv(o, vb0 + AT_VBYTES, pa0, pa1, pa2, pa3); at_partialSM(pA0, pA1, m_reg, mnA, alA);
    __syncthreads(); SWAIT(); SWRITE(1, 1);
    RESC(alA); __syncthreads();
  }
  SBAR(); at_qkt(pB0, pB1, K_lds + AT_KBYTES, qr, r32, hi);
  at_finishSM(pA0, pA1, alA, l_reg, pa0, pa1, pa2, pa3); SBAR();
  at_pv(o, vb0, pa0, pa1, pa2, pa3); at_partialSM(pB0, pB1, m_reg, mnB, alB);
  __syncthreads(); RESC(alB);
  at_finishSM(pB0, pB1, alB, l_reg, pa0, pa1, pa2, pa3); SBAR();
  at_pv(o, vb0 + AT_VBYTES, pa0, pa1, pa2, pa3);
  if (hi == 0) li_l[r32] = l_reg;
  asm volatile("s_waitcnt lgkmcnt(0)" ::: "memory");
  float* Ow = Ob + (size_t)(wid * 32) * 512;
#pragma unroll
  for (int r = 0; r < 16; ++r) {
    int orow = crow(r, hi); float rl = __builtin_amdgcn_rcpf(li_l[orow]);
    Ow[(size_t)orow * 512 + r32] = o[0][r] * rl; Ow[(size_t)orow * 512 + 32 + r32] = o[1][r] * rl;
  }
#undef SLOAD
#undef SWRITE
#undef SWAIT
#undef RESC
}

DI void ph_attn(const P& p, char* smem, unsigned* ctr) {
  const int tid = tidx();
  int* sitem = (int*)(smem + SMEM_BYTES - 16);
  for (;;) {
    __syncthreads();
    if (tid == 0) *sitem = (int)atomicAdd(ctr, 1u);
    __syncthreads();
    const int item = *sitem;
    if (item >= NB * NH * (T / 256)) break;
    const int bh = item / (T / 256), qb = item % (T / 256);
    const int b = bh / NH, h = bh % NH;
    attn_body(p.Q + ((size_t)bh * T + qb * 256) * 96, p.Kc + (size_t)bh * T * 96, p.Vv + (size_t)bh * T * 64,
              p.AO + ((size_t)(b * T + qb * 256)) * 512 + h * 64, smem, tid);
  }
}

constexpr int SC = 128, NCH = T / SC;
constexpr int SBUF = 5184;
template <int NI> struct ScanRegsN { float k[2 * NI], r[2 * NI], v[2 * NI]; u16 lw[2 * NI], a[2 * NI]; };
template <int NI>
DI void scan_load_n(const P& p, int b, int h, int d, int n0, int lane, int ws, ScanRegsN<NI>& g) {
  constexpr int WPI = 8 / NI;
  const u16* LWd = p.LW + (size_t)d * NTOK * RWW;
  const u16* AAd = p.AA + (size_t)d * NTOK * RWW;
  const int ch = h * 64 + lane;
#pragma unroll
  for (int jj = 0; jj < 2 * NI; ++jj) {
    int n = n0 + ws + WPI * jj; int t = d ? (T - 1 - n) : n;
    size_t off = ((size_t)(b * T + t)) * RWW + ch;
    g.k[jj] = p.K[off]; g.r[jj] = p.R[off]; g.v[jj] = p.V[off]; g.lw[jj] = LWd[off]; g.a[jj] = AAd[off];
  }
}
template <int NI>
DI void scan_put_n(const ScanRegsN<NI>& g, float kkc, float kac, float* sm, float* slw, int lane, int ws) {
  constexpr int WPI = 8 / NI;
#pragma unroll
  for (int jj = 0; jj < 2 * NI; ++jj) slw[(ws + WPI * jj) * 64 + lane] = bf2f(g.lw[jj]);
  __syncthreads();
  float Lj[2 * NI];
#pragma unroll
  for (int jj = 0; jj < 2 * NI; ++jj) Lj[jj] = 0.f;
#pragma unroll
  for (int i = 0; i < 16; ++i) {
    const float x = slw[i * 64 + lane];
#pragma unroll
    for (int jj = 0; jj < 2 * NI; ++jj) Lj[jj] += (i <= ws + WPI * jj) ? x : 0.f;
  }
#pragma unroll
  for (int jj = 0; jj < 2 * NI; ++jj) {
    const int j = ws + WPI * jj;
    const float L = Lj[jj], lwj = bf2f(g.lw[jj]);
    const float Pt = fexp(L), Pm = fexp(L - lwj), iP = fexp(-L);
    const float kv = g.k[jj];
    const float kx = kv * kkc;
    const float nrm = __builtin_amdgcn_sqrtf(wave_sum(kx * kx));
    const float kkv = kx * frcp(fmaxf(nrm, 1e-12f));
    const float a = bf2f(g.a[jj]);
    sm[j * 64 + lane] = -kkv * Pm;
    sm[1024 + j * 64 + lane] = a * kkv * iP;
    sm[2048 + j * 64 + lane] = kv * (1.f + (a - 1.f) * kac) * iP;
    sm[3072 + j * 64 + lane] = g.r[jj] * Pt;
    sm[4096 + j * 64 + lane] = g.v[jj];
    if (j == 15) sm[5120 + lane] = Pt;
  }
}
using f32x16s = __attribute__((ext_vector_type(16))) float;
DI void scan_ld8(f32x4 (&kv)[8], const float* vec, int hi) {
#pragma unroll
  for (int tk = 0; tk < 2; ++tk)
#pragma unroll
    for (int q = 0; q < 4; ++q) kv[tk * 4 + q] = *(const f32x4*)(vec + 32 * tk + 8 * q + 4 * hi);
}
DI float scan_dot8(const f32x16s (&acc)[2], const f32x4 (&kv)[8]) {
  float pq[4] = {0.f, 0.f, 0.f, 0.f};
#pragma unroll
  for (int tk = 0; tk < 2; ++tk)
#pragma unroll
    for (int e = 0; e < 4; ++e)
#pragma unroll
      for (int q = 0; q < 4; ++q) { pq[q] = __builtin_fmaf(acc[tk][4 * q + e], kv[tk * 4 + q][e], pq[q]); asm("" : "+v"(pq[q])); }
  return red_x32((pq[0] + pq[1]) + (pq[2] + pq[3]));
}

DI void ph_scan1(const P& p, int layer, char* smem) {
  constexpr int NI = 2;
  const int tid = tidx(), lane = tid & 63, w = tid >> 6;
  const int jl = lane & 31, hi = lane >> 5;
  const int it = w >> 2, vt = w & 3, ws = w & 3;
  float* smi = (float*)smem + it * (2 * SBUF + 1024);
  float* slw = smi + 2 * SBUF;
  for (int pair = blockIdx.x; pair < 32 * NCH / 2; pair += gridDim.x) {
    const int item = pair * 2 + it; const int scan = item / NCH, c = item % NCH;
    const int d = scan & 1, h = (scan >> 1) % NH, b = scan / (2 * NH);
    const float kkc = p.rw_k_k[layer * RWW + h * 64 + lane], kac = p.rw_k_a[layer * RWW + h * 64 + lane];
    f32x16s acc[2];
#pragma unroll
    for (int tk = 0; tk < 2; ++tk)
#pragma unroll
      for (int r = 0; r < 16; ++r) acc[tk][r] = (32 * tk + (r & 3) + 8 * (r >> 2) + 4 * hi == 32 * vt + jl) ? 1.f : 0.f;
    ScanRegsN<NI> g;
    scan_load_n<NI>(p, b, h, d, c * SC, lane, ws, g);
    __syncthreads();
    scan_put_n<NI>(g, kkc, kac, smi, slw, lane, ws);
    __syncthreads();
    for (int sub = 0; sub < SC / 16; ++sub) {
      const float* sm = smi + (sub & 1) * SBUF;
      if (sub + 1 < SC / 16) scan_load_n<NI>(p, b, h, d, c * SC + (sub + 1) * 16, lane, ws, g);
      const float* vrow = sm + 4096 + ((vt >= 2) ? 32 * (vt - 2) : 0) + jl;
      f32x4 kc[8]; scan_ld8(kc, sm, hi);
      float a0 = sm[1024 + hi * 1024 + jl], a1 = sm[1024 + hi * 1024 + 32 + jl], vc = vrow[0];
#pragma unroll 4
      for (int j = 0; j < 16; ++j) {
        const int jn = (j + 1) & 15;
        f32x4 kn[8]; scan_ld8(kn, sm + jn * 64, hi);
        const float an0 = sm[1024 + hi * 1024 + jn * 64 + jl], an1 = sm[1024 + hi * 1024 + jn * 64 + 32 + jl], vn = vrow[jn * 64];
        SBAR();
        const float sa = scan_dot8(acc, kc);
        const float bop = hi ? ((vt >= 2) ? vc : 0.f) : sa;
        acc[0] = __builtin_amdgcn_mfma_f32_32x32x2f32(a0, bop, acc[0], 0, 0, 0);
        acc[1] = __builtin_amdgcn_mfma_f32_32x32x2f32(a1, bop, acc[1], 0, 0, 0);
        SBAR();
#pragma unroll
        for (int i = 0; i < 8; ++i) kc[i] = kn[i];
        a0 = an0; a1 = an1; vc = vn;
      }
#pragma unroll
      for (int tk = 0; tk < 2; ++tk)
#pragma unroll
        for (int q = 0; q < 4; ++q) {
          const f32x4 pv = *(const f32x4*)(sm + 5120 + 32 * tk + 8 * q + 4 * hi);
#pragma unroll
          for (int e = 0; e < 4; ++e) acc[tk][4 * q + e] *= pv[e];
        }
      if (sub + 1 < SC / 16) scan_put_n<NI>(g, kkc, kac, smi + ((sub + 1) & 1) * SBUF, slw, lane, ws);
      __syncthreads();
    }
    {
      const int v = 32 * vt + jl;
      float* dst = ((v < 64) ? p.MC : p.NC) + (((size_t)scan * NCH + c) * 64 + (v & 63)) * 64;
#pragma unroll
      for (int tk = 0; tk < 2; ++tk)
#pragma unroll
        for (int q = 0; q < 4; ++q)
          *(f32x4*)(dst + 32 * tk + 8 * q + 4 * hi) = f32x4{acc[tk][4 * q], acc[tk][4 * q + 1], acc[tk][4 * q + 2], acc[tk][4 * q + 3]};
    }
  }
}


DI void ph_scan2(const P& p, char* smem) {
  constexpr int LS = 72;
  u16* Sh = (u16*)smem; u16* Sl = Sh + 64 * LS; u16* Mh = Sl + 64 * LS; u16* Ml = Mh + 64 * LS;
  const int tid = tidx(), lane = tid & 63, w = tid >> 6;
  const int l15 = lane & 15, lq = lane >> 4;
  const int ti = w >> 1, tj0 = (w & 1) * 2;
  for (int scan = blockIdx.x; scan < 32; scan += gridDim.x) {
    const float* Mg = p.MC + (size_t)scan * NCH * 4096;
    const float* Ng = p.NC + (size_t)scan * NCH * 4096;
    float* Sg = p.SS + (size_t)scan * NCH * 4096;
    struct MN { f32x4 m0, m1, n[2]; };
    auto ldmn = [&](MN& r, int c) {
      const int cc = (c < NCH) ? c : (NCH - 1);
      r.m0 = *(const f32x4*)(Mg + (size_t)cc * 4096 + tid * 8); r.m1 = *(const f32x4*)(Mg + (size_t)cc * 4096 + tid * 8 + 4);
#pragma unroll
      for (int q = 0; q < 2; ++q)
#pragma unroll
        for (int r4 = 0; r4 < 4; ++r4) r.n[q][r4] = Ng[(size_t)cc * 4096 + (ti * 16 + lq * 4 + r4) * 64 + (tj0 + q) * 16 + l15];
    };
    f32x4 sacc[2];
    sacc[0] = f32x4{0.f, 0.f, 0.f, 0.f}; sacc[1] = sacc[0];
    auto step = [&](int c, const MN& r) {
      __syncthreads();
#pragma unroll
      for (int q = 0; q < 2; ++q)
#pragma unroll
        for (int r4 = 0; r4 < 4; ++r4) {
          const int row = ti * 16 + lq * 4 + r4, col = (tj0 + q) * 16 + l15;
          const float x = sacc[q][r4];
          Sg[(size_t)c * 4096 + row * 64 + col] = x;
          const u16 h = f2bf(x); Sh[row * LS + col] = h; Sl[row * LS + col] = f2bf(x - bf2f(h));
        }
      {
        const int mr = tid >> 3, mc = (tid & 7) * 8;
        float xh[8], xl[8];
#pragma unroll
        for (int i = 0; i < 8; ++i) { const float x = (i < 4) ? r.m0[i & 3] : r.m1[i & 3]; const float h = bf2f(f2bf(x)); xh[i] = h; xl[i] = x - h; }
        *(u32x4*)(Mh + mr * LS + mc) = u32x4{pk2(xh[0], xh[1]), pk2(xh[2], xh[3]), pk2(xh[4], xh[5]), pk2(xh[6], xh[7])};
        *(u32x4*)(Ml + mr * LS + mc) = u32x4{pk2(xl[0], xl[1]), pk2(xl[2], xl[3]), pk2(xl[4], xl[5]), pk2(xl[6], xl[7])};
      }
      f32x4 acc[2] = {r.n[0], r.n[1]};
      __syncthreads();
#pragma unroll
      for (int ks = 0; ks < 2; ++ks) {
        const bf16x8 ah = *(const bf16x8*)(Sh + (ti * 16 + l15) * LS + ks * 32 + 8 * lq);
        const bf16x8 al = *(const bf16x8*)(Sl + (ti * 16 + l15) * LS + ks * 32 + 8 * lq);
#pragma unroll
        for (int q = 0; q < 2; ++q) {
          const int kb = ks * 32 + 8 * lq, tq = l15 >> 2, tp = l15 & 3, co = (tj0 + q) * 16 + 4 * tp;
          const bf16x8 bh = __builtin_shufflevector(tr_read((const short*)Mh + (kb + tq) * LS + co), tr_read((const short*)Mh + (kb + 4 + tq) * LS + co), 0, 1, 2, 3, 4, 5, 6, 7);
          const bf16x8 bl = __builtin_shufflevector(tr_read((const short*)Ml + (kb + tq) * LS + co), tr_read((const short*)Ml + (kb + 4 + tq) * LS + co), 0, 1, 2, 3, 4, 5, 6, 7);
          acc[q] = __builtin_amdgcn_mfma_f32_16x16x32_bf16(ah, bh, acc[q], 0, 0, 0);
          acc[q] = __builtin_amdgcn_mfma_f32_16x16x32_bf16(ah, bl, acc[q], 0, 0, 0);
          acc[q] = __builtin_amdgcn_mfma_f32_16x16x32_bf16(al, bh, acc[q], 0, 0, 0);
        }
      }
      sacc[0] = acc[0]; sacc[1] = acc[1];
    };
    MN r0, r1, r2, r3;
    ldmn(r0, 0); ldmn(r1, 1); ldmn(r2, 2);
    for (int c = 0; c < NCH; c += 4) {
      ldmn(r3, c + 3); step(c, r0);
      ldmn(r0, c + 4); step(c + 1, r1);
      ldmn(r1, c + 5); step(c + 2, r2);
      ldmn(r2, c + 6); step(c + 3, r3);
    }
    __syncthreads();
  }
}

DI void ph_scan3(const P& p, int layer, char* smem) {
  constexpr int NI = 4;
  const int tid = tidx(), lane = tid & 63, w = tid >> 6;
  const int jl = lane & 31, hi = lane >> 5;
  const int it = w >> 1, vt = w & 1, ws = w & 1;
  float* sm = (float*)smem + it * (SBUF + 2048);
  float* slw = sm + SBUF; float* so = slw + 1024;
  for (int quad = blockIdx.x; quad < 32 * NCH / 4; quad += gridDim.x) {
    const int item = quad * 4 + it; const int scan = item / NCH, c = item % NCH;
    const int d = scan & 1, h = (scan >> 1) % NH, b = scan / (2 * NH);
    const float kkc = p.rw_k_k[layer * RWW + h * 64 + lane], kac = p.rw_k_a[layer * RWW + h * 64 + lane];
    u16* Od = p.O2 + (size_t)d * NTOK * RWW;
    f32x16s acc[2];
    {
      const float* Sg = p.SS + ((size_t)scan * NCH + c) * 4096 + (size_t)(32 * vt + jl) * 64;
#pragma unroll
      for (int tk = 0; tk < 2; ++tk)
#pragma unroll
        for (int q = 0; q < 4; ++q) {
          const f32x4 sv = *(const f32x4*)(Sg + 32 * tk + 8 * q + 4 * hi);
#pragma unroll
          for (int e = 0; e < 4; ++e) acc[tk][4 * q + e] = sv[e];
        }
    }
    ScanRegsN<NI> g;
    scan_load_n<NI>(p, b, h, d, c * SC, lane, ws, g);
    for (int sub = 0; sub < SC / 16; ++sub) {
      const int n0 = c * SC + sub * 16;
      __syncthreads();
      scan_put_n<NI>(g, kkc, kac, sm, slw, lane, ws);
      __syncthreads();
      if (sub + 1 < SC / 16) scan_load_n<NI>(p, b, h, d, n0 + 16, lane, ws, g);
      const float* vrow = sm + 4096 + 32 * vt + jl;
      f32x4 kc[8]; scan_ld8(kc, sm, hi);
      float a0 = sm[1024 + hi * 1024 + jl], a1 = sm[1024 + hi * 1024 + 32 + jl], vc = vrow[0];
#pragma unroll 4
      for (int j = 0; j < 16; ++j) {
        const int jn = (j + 1) & 15;
        f32x4 kn[8]; scan_ld8(kn, sm + jn * 64, hi);
        const float an0 = sm[1024 + hi * 1024 + jn * 64 + jl], an1 = sm[1024 + hi * 1024 + jn * 64 + 32 + jl], vn = vrow[jn * 64];
        SBAR();
        const float sa = scan_dot8(acc, kc);
        const float bop = hi ? vc : sa;
        acc[0] = __builtin_amdgcn_mfma_f32_32x32x2f32(a0, bop, acc[0], 0, 0, 0);
        acc[1] = __builtin_amdgcn_mfma_f32_32x32x2f32(a1, bop, acc[1], 0, 0, 0);
        f32x4 rc[8]; scan_ld8(rc, sm + 3072 + j * 64, hi);
        SBAR();
        const float o = scan_dot8(acc, rc);
        if (hi == 0) so[j * 64 + 32 * vt + jl] = o;
        SBAR();
#pragma unroll
        for (int i = 0; i < 8; ++i) kc[i] = kn[i];
        a0 = an0; a1 = an1; vc = vn;
      }
#pragma unroll
      for (int tk = 0; tk < 2; ++tk)
#pragma unroll
        for (int q = 0; q < 4; ++q) {
          const f32x4 pv = *(const f32x4*)(sm + 5120 + 32 * tk + 8 * q + 4 * hi);
#pragma unroll
          for (int e = 0; e < 4; ++e) acc[tk][4 * q + e] *= pv[e];
        }
      __syncthreads();
#pragma unroll
      for (int jj = 0; jj < 8; ++jj) {
        const int j = ws + 2 * jj; const int n = n0 + j; const int t = d ? (T - 1 - n) : n;
        Od[((size_t)(b * T + t)) * RWW + h * 64 + lane] = f2bf(so[j * 64 + lane]);
      }
    }
  }
}


DI void ph_mixfinish(const P& p, int layer) {
  const int tid_ = tidx(); const int lane = tid_ & 63, w = tid_ >> 6;
  const float* lw = p.rw_lnx_w + layer * RWW; const float* lb = p.rw_lnx_b + layer * RWW;
  const float* kac = p.rw_k_a + layer * RWW; const float* rk = p.rw_r_k + layer * RWW;
  const float* on = p.mla_o_norm + layer * 512;
  float plw[8], plb[8], pka[8], prk[8];
#pragma unroll
  for (int h = 0; h < NH; ++h) { int c = h * 64 + lane; plw[h] = lw[c]; plb[h] = lb[c]; pka[h] = kac[c]; prk[h] = rk[c]; }
  const f32x4 g0 = *(const f32x4*)(on + lane * 4), g1 = *(const f32x4*)(on + 256 + lane * 4);
  for (int tok = blockIdx.x * 8 + w; tok < NTOK; tok += gridDim.x * 8) {
    float o[8], k[8], r[8], vv[8], a0[8], a1[8], gg[8];
#pragma unroll
    for (int h = 0; h < NH; ++h) {
      size_t off = (size_t)tok * RWW + h * 64 + lane;
      o[h] = bf2f(p.O2[off]) + bf2f(p.O2[(size_t)NTOK * RWW + off]);
      k[h] = p.K[off]; r[h] = p.R[off]; vv[h] = p.V[off];
      a0[h] = bf2f(p.AA[off]); a1[h] = bf2f(p.AA[(size_t)NTOK * RWW + off]); gg[h] = bf2f(p.G[off]);
    }
    const float* ao = p.AO + (size_t)tok * 512;
    const f32x4 v0 = *(const f32x4*)(ao + lane * 4), v1 = *(const f32x4*)(ao + 256 + lane * 4);
    float mean[8], var[8], sb[8];
#pragma unroll
    for (int h = 0; h < NH; ++h) mean[h] = wave_sum(o[h]) * (1.f / 64);
#pragma unroll
    for (int h = 0; h < NH; ++h) { float dv = o[h] - mean[h]; o[h] = dv; var[h] = wave_sum(dv * dv) * (1.f / 64); }
#pragma unroll
    for (int h = 0; h < NH; ++h) {
      float kb = 0.5f * (k[h] * (1.f + (a0[h] - 1.f) * pka[h]) + k[h] * (1.f + (a1[h] - 1.f) * pka[h]));
      sb[h] = wave_sum(r[h] * kb * prk[h]);
    }
#pragma unroll
    for (int h = 0; h < NH; ++h) {
      float on_ = o[h] * frsq(var[h] + GN_EPS) * plw[h] + plb[h];
      float y = (on_ + sb[h] * vv[h]) * gg[h];
      p.H[(size_t)tok * DM + h * 64 + lane] = f2bf(y);
    }
    float ss = v0[0] * v0[0] + v0[1] * v0[1] + v0[2] * v0[2] + v0[3] * v0[3] + v1[0] * v1[0] + v1[1] * v1[1] + v1[2] * v1[2] + v1[3] * v1[3];
    ss = wave_sum(ss);
    float rstd = frsq(ss * (1.f / 512) + NORM_EPS);
    *(u32x2*)(p.H + (size_t)tok * DM + 512 + lane * 4) = u32x2{pk2(v0[0] * rstd * g0[0], v0[1] * rstd * g0[1]), pk2(v0[2] * rstd * g0[2], v0[3] * rstd * g0[3])};
    *(u32x2*)(p.H + (size_t)tok * DM + 768 + lane * 4) = u32x2{pk2(v1[0] * rstd * g1[0], v1[1] * rstd * g1[1]), pk2(v1[2] * rstd * g1[2], v1[3] * rstd * g1[3])};
  }
}

DI void ph_norm_router(const P& p, int layer, char* smem) {
  const int tid_ = tidx(); const int lane = tid_ & 63, w = tid_ >> 6;
  float* rtl = (float*)smem;
  float* hl = (float*)(smem + 65536) + w * 1024;
  const float* g = p.ffn_norm + layer * DM;
  const float* rt = p.router + (size_t)layer * DM * NE;
  __syncthreads();
#pragma unroll
  for (int i = 0; i < 8; ++i) *(f32x4*)(rtl + (tid_ + i * NTH) * 4) = *(const f32x4*)(rt + (tid_ + i * NTH) * 4);
  __syncthreads();
  const int cg = lane >> 2, eq = lane & 3;
  for (int tok = blockIdx.x * 8 + w; tok < NTOK; tok += gridDim.x * 8) {
    const f32x4* xr = (const f32x4*)(p.out + (size_t)tok * DM);
    f32x4 v[4]; float ss = 0.f;
#pragma unroll
    for (int j = 0; j < 4; ++j) { v[j] = xr[lane + 64 * j]; ss += v[j][0] * v[j][0] + v[j][1] * v[j][1] + v[j][2] * v[j][2] + v[j][3] * v[j][3]; }
    ss = wave_sum(ss);
    const float rstd = frsq(ss * (1.f / DM) + NORM_EPS);
#pragma unroll
    for (int j = 0; j < 4; ++j) {
      const int c0 = (lane + 64 * j) * 4;
      const f32x4 gg = *(const f32x4*)(g + c0);
      const f32x4 hv = v[j] * rstd * gg;
      *(u32x2*)(p.H + (size_t)tok * DM + c0) = u32x2{pk2(hv[0], hv[1]), pk2(hv[2], hv[3])};
      *(f32x4*)(hl + c0) = hv;
    }
    f32x4 acc = f32x4{0.f, 0.f, 0.f, 0.f};
#pragma unroll 16
    for (int i = 0; i < 64; ++i) {
      const float hv = hl[cg + 16 * i];
      const f32x4 r4 = *(const f32x4*)(rtl + (cg + 16 * i) * 16 + eq * 4);
      acc += hv * r4;
    }
#pragma unroll
    for (int e = 0; e < 4; ++e) {
      float a = acc[e];
      a += dpp_f<0x124>(a); a += dpp_f<0x128>(a);
      a = red_x32(red_x16(a));
      acc[e] = a;
    }
    float mx = fmaxf(fmaxf(acc[0], acc[1]), fmaxf(acc[2], acc[3]));
    mx = fmaxf(mx, dpp_f<0xB1>(mx)); mx = fmaxf(mx, dpp_f<0x4E>(mx));
    f32x4 ex; float se = 0.f;
#pragma unroll
    for (int e = 0; e < 4; ++e) { ex[e] = fexp(acc[e] - mx); se += ex[e]; }
    se = red_x2(red_x1(se));
    const float inv = frcp(se);
    const int b = tok / T, t = tok % T;
    if (lane < 4) {
#pragma unroll
      for (int e = 0; e < 4; ++e) p.AFF[((size_t)(b * NE + eq * 4 + e)) * T + t] = ex[e] * inv;
    }
  }
}

DI void ph_topk(const P& p, char* smem) {
  unsigned* hist = (unsigned*)smem;
  unsigned* sc = hist + 256;
  unsigned* bc = sc + 2048;
  const int tid = tidx();
  for (int item = blockIdx.x; item < NB * NE; item += gridDim.x) {
    const float* a = p.AFF + (size_t)item * T;
    unsigned key[16];
#pragma unroll
    for (int i = 0; i < 4; ++i) {
      uint4 v = *(const uint4*)(a + tid * 16 + i * 4);
      key[i * 4 + 0] = v.x; key[i * 4 + 1] = v.y; key[i * 4 + 2] = v.z; key[i * 4 + 3] = v.w;
    }
    unsigned prefix = 0, mask = 0, need = CAP;
    for (int pass = 0; pass < 4; ++pass) {
      int shift = 24 - 8 * pass;
      __syncthreads();
      if (tid < 256) hist[tid] = 0;
      __syncthreads();
#pragma unroll
      for (int i = 0; i < 16; ++i)
        if ((key[i] & mask) == prefix) atomicAdd(&hist[(key[i] >> shift) & 255u], 1u);
      __syncthreads();
      if (tid == 0) {
        unsigned cum = 0; int bsel = 0; unsigned nd = need;
        for (int bb = 255; bb >= 0; --bb) {
          unsigned hc = hist[bb];
          if (cum + hc >= need) { bsel = bb; nd = need - cum; break; }
          cum += hc;
        }
        bc[0] = prefix | ((unsigned)bsel << shift); bc[1] = nd;
      }
      __syncthreads();
      prefix = bc[0]; need = bc[1]; mask |= (255u << shift);
    }
    unsigned ngt = 0, neq = 0;
#pragma unroll
    for (int i = 0; i < 16; ++i) { ngt += key[i] > prefix; neq += key[i] == prefix; }
    __syncthreads();
    unsigned* sA = sc; unsigned* sB = sc + 512; unsigned* eA = sc + 1024; unsigned* eB = sc + 1536;
    sA[tid] = ngt; eA[tid] = neq;
    __syncthreads();
    for (int off = 1; off < NTH; off <<= 1) {
      unsigned x = sA[tid] + ((tid >= off) ? sA[tid - off] : 0u);
      unsigned y = eA[tid] + ((tid >= off) ? eA[tid - off] : 0u);
      sB[tid] = x; eB[tid] = y;
      __syncthreads();
      unsigned* tmp = sA; sA = sB; sB = tmp; tmp = eA; eA = eB; eB = tmp;
    }
    unsigned gt_excl = sA[tid] - ngt, eq_excl = eA[tid] - neq;
    unsigned gt_total = sA[NTH - 1];
    int* idx = p.IDX + (size_t)item * CAP; float* gate = p.GATE + (size_t)item * CAP;
#pragma unroll
    for (int i = 0; i < 16; ++i) {
      int slot = -1;
      if (key[i] > prefix) { slot = (int)gt_excl; ++gt_excl; }
      else if (key[i] == prefix) { if (eq_excl < need) slot = (int)(gt_total + eq_excl); ++eq_excl; }
      if (slot >= 0) {
        const int tokl = tid * 16 + i;
        idx[slot] = tokl; gate[slot] = __uint_as_float(key[i]);
        const int tokg = (item / NE) * T + tokl;
        const int pos = atomicAdd(&p.TCNT[tokg], 1);
        p.TLIST[(size_t)tokg * 16 + pos] = item * CAP + slot;
      }
    }
    __syncthreads();
  }
}

DI void ph_exp1(const P& p, int layer, char* smem) {
  for (int t = blockIdx.x; t < 32 * 4 * 16; t += gridDim.x) {
    int grp = t / 64, r = t % 64, tm = r / 16, tn = r % 16;
    int b = grp / NE, e = grp % NE;
    const int* gi = p.IDX + (size_t)grp * CAP + tm * GBM;
    const u16* Hb = p.H + (size_t)b * T * DM;
    const float* Wg = p.exp_w_gate + ((size_t)layer * NE + e) * DM * 1024;
    const float* Wu = p.exp_w_up + ((size_t)layer * NE + e) * DM * 1024;
    u16* hid = p.HID + ((size_t)grp * CAP + tm * GBM) * 1024;
    auto arow = [&](int row) -> const void* { return Hb + (size_t)gi[row] * DM; };
    gemm_tile<false, 1>(arow, Wg, Wu, 1024, DM, tn * 64, 1024, smem, [&](int row, int col, float g, float u) {
      float sv = g * frcp(1.f + fexp(-g));
      hid[(size_t)row * 1024 + col] = f2bf(sv * u);
    });
    __syncthreads();
  }
}
DI void ph_exp2(const P& p, int layer, char* smem) {
  for (int t = blockIdx.x; t < 32 * 4 * 8; t += gridDim.x) {
    int grp = t / 32, r = t % 32, tm = r / 8, tn = r % 8;
    int b = grp / NE, e = grp % NE;
    const int* gi = p.IDX + (size_t)grp * CAP + tm * GBM;
    const float* gt = p.GATE + (size_t)grp * CAP + tm * GBM;
    const u16* hid = p.HID + ((size_t)grp * CAP + tm * GBM) * 1024;
    const float* Wd = p.exp_w_down + ((size_t)layer * NE + e) * 1024 * DM;
    float* xb = p.out + (size_t)b * T * DM;
    auto arow = [&](int row) -> const void* { return hid + (size_t)row * 1024; };
    gemm_tile<false, 0>(arow, Wd, nullptr, DM, 1024, tn * GBN, DM, smem, [&](int row, int col, float v, float) {
      unsafeAtomicAdd(xb + (size_t)gi[row] * DM + col, v * gt[row]);
    });
    __syncthreads();
  }
}

namespace g8 {
constexpr int BM = 256, BK = 64, HALF = 128, HTB = HALF * BK * 2, STAGE_BYTES = 8 * HTB, NXCD = 8, WGM = 8;
DI int lds_byte(int r, int c) { const int st = (r >> 4) * 2 + (c >> 5), rr = r & 15, cc = c & 31, ob = rr * 64 + cc * 2; return st * 1024 + (ob ^ (((ob >> 9) & 1) << 5)); }
DI void stage_rc(int b, int& R, int& C) { const int st = b / 1024, sb = b % 1024, swz = sb ^ (((sb >> 9) & 1) << 5); R = (st >> 1) * 16 + swz / 64; C = (st & 1) * 32 + (swz % 64) / 2; }
DI int perm32(int rho) { const int n = rho >> 4, i = rho & 15; return 8 * (i >> 2) + 4 * n + (i & 3); }
struct Unit { int pm, pn; };
struct Sched {
  int nM, nN, nwg, G, c;
  const char* A; const char* Bt; size_t a_tstep, b_tstep; int gdiv, gmod; size_t gstride;
  DI void init(int nM_, int nN_, int G_, int c_, const void* A_, const void* Bt_, int K) {
    nM = nM_; nN = nN_; nwg = nM * nN; G = G_; c = c_; A = (const char*)uni_ptr(A_); Bt = (const char*)uni_ptr(Bt_);
    a_tstep = (size_t)BM * K * 2; b_tstep = (size_t)BM * K * 2; gdiv = 1 << 30; gmod = 1; gstride = 0;
  }
  DI void group(int gdiv_, int gmod_, size_t gstride_) { gdiv = gdiv_; gmod = gmod_; gstride = gstride_; }
  DI bool next(int i, Unit& u) const {
    const long L = (long)i * G + c; if (L >= nwg) return false;
    int wgid = (int)L; { const int q = nwg / NXCD, r = nwg % NXCD, xcd = wgid % NXCD, off = wgid / NXCD; wgid = (xcd < r ? xcd * (q + 1) : r * (q + 1) + (xcd - r) * q) + off; }
    const int nig = WGM * nN, gid = wgid / nig, fm = gid * WGM, gsz = (nM - fm) < WGM ? (nM - fm) : WGM;
    u.pm = fm + ((wgid % nig) % gsz); u.pn = (wgid % nig) / gsz; return true;
  }
  DI const char* a_ptr(const Unit& u) const { return A + (size_t)u.pm * a_tstep; }
  DI const char* b_ptr(const Unit& u) const { return Bt + (size_t)((u.pm / gdiv) % gmod) * gstride + (size_t)u.pn * b_tstep; }
};
using Acc = f32x4[2][2][4][2];

template <class Epi>
DI void gemm_phase(LAS unsigned char* lds, const int K, const Sched& S, const Epi& E) {
  const int tid = tidx(), wid = __builtin_amdgcn_readfirstlane(tid >> 6), lane = tid & 63, wr = wid >> 2, wc = wid & 3, fr = lane & 15, fq = lane >> 4;
  const int nt = K / BK;
  unsigned voffA[2], voffB[2];
#pragma unroll
  for (int i = 0; i < 2; ++i) { int R, C; stage_rc(tid * 16 + i * 8192, R, C); const int Rb = Epi::PERM ? ((R & ~31) + perm32(R & 31)) : R;
    voffA[i] = (unsigned)(R * K + C) * 2u; voffB[i] = (unsigned)(Rb * K + C) * 2u; }
  const size_t kstep = (size_t)(BK * 2);
  const size_t hstep = (size_t)HALF * K * 2;
  const unsigned ldsw = (unsigned)wid * 1024u;
  const int aoff = lds_byte(wr * 64 + fr, fq * 8), boff = lds_byte(wc * 32 + fr, fq * 8);
#define G8_SA(b, h) (((b) * 2 + (h)) * HTB)
#define G8_SB(b, h) ((4 + (b) * 2 + (h)) * HTB)
#define G8_STAGE(bufoff, gbase, voff) do { _Pragma("unroll") for (int _i = 0; _i < 2; ++_i) \
    __builtin_amdgcn_global_load_lds((const unsigned*)((const char*)(gbase) + (voff)[_i]), (LAS unsigned*)(lds + (bufoff) + ldsw + _i * 8192), 16, 0, 0); } while (0)
#define G8_LDA(dst, b, h) do { _Pragma("unroll") for (int m = 0; m < 4; ++m) _Pragma("unroll") for (int k = 0; k < 2; ++k) dst[m][k] = *(const LAS bf16x8*)(lds + G8_SA(b, h) + aoff + m * 2048 + k * 1024); } while (0)
#define G8_LDB(dst, b, h) do { _Pragma("unroll") for (int n = 0; n < 2; ++n) _Pragma("unroll") for (int k = 0; k < 2; ++k) dst[n][k] = *(const LAS bf16x8*)(lds + G8_SB(b, h) + boff + n * 2048 + k * 1024); } while (0)
#define G8_MMA(ai, bj, At, Bt) do { __builtin_amdgcn_s_setprio(1); _Pragma("unroll") for (int m = 0; m < 4; ++m) _Pragma("unroll") for (int n = 0; n < 2; ++n) _Pragma("unroll") for (int k = 0; k < 2; ++k) \
    acc[ai][bj][m][n] = __builtin_amdgcn_mfma_f32_16x16x32_bf16(Bt[n][k], At[m][k], acc[ai][bj][m][n], 0, 0, 0); __builtin_amdgcn_s_setprio(0); } while (0)
#define G8_WAIT_V(n) asm volatile("s_waitcnt vmcnt(" #n ")" ::: "memory")
#define G8_WAIT_L(n) asm volatile("s_waitcnt lgkmcnt(" #n ")" ::: "memory")
#define G8_BAR __builtin_amdgcn_s_barrier()
#define G8_SCHED __builtin_amdgcn_sched_barrier(0)
  Unit cur, nxt; int ui = 0;
  if (!S.next(0, cur)) return;
  f32x4 acc[2][2][4][2];
#pragma unroll
  for (int a = 0; a < 2; ++a)
#pragma unroll
    for (int b = 0; b < 2; ++b)
#pragma unroll
      for (int m = 0; m < 4; ++m)
#pragma unroll
        for (int n = 0; n < 2; ++n) acc[a][b][m][n] = (f32x4){0.f, 0.f, 0.f, 0.f};
  bf16x8 At[4][2], B0[2][2], B1[2][2];
  const char* cA = S.a_ptr(cur); const char* cB = S.b_ptr(cur);
  G8_STAGE(G8_SB(0, 0), cB, voffB); G8_STAGE(G8_SA(0, 0), cA, voffA); G8_STAGE(G8_SB(0, 1), cB + hstep, voffB); G8_STAGE(G8_SA(0, 1), cA + hstep, voffA);
  if (wr == 1) G8_BAR;
  G8_WAIT_V(4); G8_BAR;
  G8_STAGE(G8_SB(1, 0), cB + kstep, voffB); G8_STAGE(G8_SA(1, 0), cA + kstep, voffA); G8_STAGE(G8_SB(1, 1), cB + hstep + kstep, voffB);
  G8_WAIT_V(6); G8_BAR;
  for (;;) {
    const bool has_next = S.next(ui + 1, nxt);
    const char* nA = has_next ? S.a_ptr(nxt) : cA; const char* nB = has_next ? S.b_ptr(nxt) : cB;
    for (int t = 0; t < nt; t += 2) {
      const bool last = (t == nt - 2);
      const char* a1 = cA + (size_t)(t + 1) * kstep;
      const char* a2 = last ? nA : cA + (size_t)(t + 2) * kstep; const char* b2 = last ? nB : cB + (size_t)(t + 2) * kstep;
      const char* a3 = a2 + kstep; const char* b3 = b2 + kstep;
      G8_LDB(B0, 0, 0); G8_SCHED; G8_LDA(At, 0, 0); G8_STAGE(G8_SA(1, 1), a1 + hstep, voffA);
      G8_WAIT_L(8); G8_BAR; G8_WAIT_L(0); G8_MMA(0, 0, At, B0); G8_BAR; G8_SCHED;
      G8_LDB(B1, 0, 1); G8_STAGE(G8_SB(0, 0), b2, voffB);
      G8_BAR; G8_WAIT_L(0); G8_MMA(0, 1, At, B1); G8_BAR;
      G8_LDA(At, 0, 1); G8_STAGE(G8_SA(0, 0), a2, voffA);
      G8_BAR; G8_WAIT_L(0); G8_MMA(1, 0, At, B0); G8_BAR; G8_SCHED;
      G8_STAGE(G8_SB(0, 1), b2 + hstep, voffB);
      G8_WAIT_V(6); G8_BAR; G8_MMA(1, 1, At, B1); G8_BAR;
      G8_LDB(B0, 1, 0); G8_SCHED; G8_LDA(At, 1, 0); G8_STAGE(G8_SA(0, 1), a2 + hstep, voffA);
      G8_WAIT_L(8); G8_BAR; G8_WAIT_L(0); G8_MMA(0, 0, At, B0); G8_BAR; G8_SCHED;
      G8_LDB(B1, 1, 1); G8_STAGE(G8_SB(1, 0), b3, voffB);
      G8_BAR; G8_WAIT_L(0); G8_MMA(0, 1, At, B1); G8_BAR;
      G8_LDA(At, 1, 1); G8_STAGE(G8_SA(1, 0), a3, voffA);
      G8_BAR; G8_WAIT_L(0); G8_MMA(1, 0, At, B0); G8_BAR; G8_SCHED;
      G8_STAGE(G8_SB(1, 1), b3 + hstep, voffB);
      G8_WAIT_V(6); G8_BAR; G8_MMA(1, 1, At, B1); G8_BAR;
    }
    {
      const int t2 = tidx(); const int w2 = __builtin_amdgcn_readfirstlane(t2 >> 6), l2 = t2 & 63;
      E(acc, cur, w2 >> 2, w2 & 3, l2 & 15, l2 >> 4);
    }
    if (!has_next) break;
#pragma unroll
    for (int a = 0; a < 2; ++a)
#pragma unroll
      for (int b = 0; b < 2; ++b)
#pragma unroll
        for (int m = 0; m < 4; ++m)
#pragma unroll
          for (int n = 0; n < 2; ++n) acc[a][b][m][n] = (f32x4){0.f, 0.f, 0.f, 0.f};
    cur = nxt; cA = nA; cB = nB; ++ui;
  }
  G8_WAIT_V(0);
  if (wr == 0) G8_BAR;
  G8_BAR;
#undef G8_SA
#undef G8_SB
#undef G8_STAGE
#undef G8_LDA
#undef G8_LDB
#undef G8_MMA
#undef G8_WAIT_V
#undef G8_WAIT_L
#undef G8_BAR
#undef G8_SCHED
}

struct EpiZ {
  static constexpr bool PERM = false; float* Z;
  DI void operator()(const Acc& acc, const Unit& u, int wr, int wc, int fr, int fq) const {
    const int row0 = u.pm * BM + wr * 64 + fr, col0 = u.pn * BM + wc * 32 + 4 * fq;
#pragma unroll
    for (int ai = 0; ai < 2; ++ai)
#pragma unroll
      for (int m = 0; m < 4; ++m) { float* rowp = Z + (size_t)(row0 + ai * HALF + m * 16) * INC;
#pragma unroll
        for (int bj = 0; bj < 2; ++bj)
#pragma unroll
          for (int n = 0; n < 2; ++n) { const int col = col0 + bj * HALF + n * 16; if (col < INC) *(f32x4*)(rowp + col) = acc[ai][bj][m][n]; } }
  }
};
struct EpiRes {
  static constexpr bool PERM = false; const float* xs; float* xo;
  DI void operator()(const Acc& acc, const Unit& u, int wr, int wc, int fr, int fq) const {
    const int row0 = u.pm * BM + wr * 64 + fr, col0 = u.pn * BM + wc * 32 + 4 * fq;
#pragma unroll
    for (int ai = 0; ai < 2; ++ai)
#pragma unroll
      for (int m = 0; m < 4; ++m) { const size_t ro = (size_t)(row0 + ai * HALF + m * 16) * DM + col0;
#pragma unroll
        for (int bj = 0; bj < 2; ++bj)
#pragma unroll
          for (int n = 0; n < 2; ++n) { const size_t o = ro + bj * HALF + n * 16; *(f32x4*)(xo + o) = *(const f32x4*)(xs + o) + acc[ai][bj][m][n]; } }
  }
};
struct EpiSig {
  static constexpr bool PERM = true; u16* PG;
  DI void operator()(const Acc& acc, const Unit& u, int wr, int wc, int fr, int fq) const {
    const int row0 = u.pm * BM + wr * 64 + fr, col0 = u.pn * BM + wc * 32 + 8 * fq;
#pragma unroll
    for (int ai = 0; ai < 2; ++ai)
#pragma unroll
      for (int m = 0; m < 4; ++m) { u16* rowp = PG + (size_t)(row0 + ai * HALF + m * 16) * DM + col0;
#pragma unroll
        for (int bj = 0; bj < 2; ++bj) { const f32x4 v0 = acc[ai][bj][m][0], v1 = acc[ai][bj][m][1];
          u32x4 wv = {pk2(sigmoidf_(v0[0]), sigmoidf_(v0[1])), pk2(sigmoidf_(v0[2]), sigmoidf_(v0[3])), pk2(sigmoidf_(v1[0]), sigmoidf_(v1[1])), pk2(sigmoidf_(v1[2]), sigmoidf_(v1[3]))};
          *(u32x4*)(rowp + bj * HALF) = wv; } }
  }
};
struct EpiPle {
  static constexpr bool PERM = false; float* xo; const u16* PG;
  DI void operator()(const Acc& acc, const Unit& u, int wr, int wc, int fr, int fq) const {
    const int row0 = u.pm * BM + wr * 64 + fr, col0 = u.pn * BM + wc * 32 + 4 * fq;
#pragma unroll
    for (int ai = 0; ai < 2; ++ai)
#pragma unroll
      for (int m = 0; m < 4; ++m) { const size_t ro = (size_t)(row0 + ai * HALF + m * 16) * DM + col0;
#pragma unroll
        for (int bj = 0; bj < 2; ++bj)
#pragma unroll
          for (int n = 0; n < 2; ++n) { const size_t o = ro + bj * HALF + n * 16; const u32x2 g = *(const u32x2*)(PG + o);
            f32x4 gv = {__uint_as_float(g[0] << 16), __uint_as_float(g[0] & 0xffff0000u), __uint_as_float(g[1] << 16), __uint_as_float(g[1] & 0xffff0000u)};
            *(f32x4*)(xo + o) = *(const f32x4*)(xo + o) + acc[ai][bj][m][n] * gv; } }
  }
};
struct EpiSwi {
  static constexpr bool PERM = true; u16* HID;
  DI void operator()(const Acc& acc, const Unit& u, int wr, int wc, int fr, int fq) const {
    const int row0 = u.pm * BM + wr * 64 + fr, col0 = u.pn * HALF + wc * 32 + 8 * fq;
#pragma unroll
    for (int ai = 0; ai < 2; ++ai)
#pragma unroll
      for (int m = 0; m < 4; ++m) { u16* rowp = HID + (size_t)(row0 + ai * HALF + m * 16) * 1024 + col0;
        float h[8];
#pragma unroll
        for (int n = 0; n < 2; ++n)
#pragma unroll
          for (int j = 0; j < 4; ++j) { const float gt = acc[ai][0][m][n][j], up = acc[ai][1][m][n][j]; h[n * 4 + j] = gt * frcp(1.f + fexp(-gt)) * up; }
        *(u32x4*)rowp = u32x4{pk2(h[0], h[1]), pk2(h[2], h[3]), pk2(h[4], h[5]), pk2(h[6], h[7])}; }
  }
};
struct EpiYE {
  static constexpr bool PERM = true; u16* YE; const float* GATE;
  DI void operator()(const Acc& acc, const Unit& u, int wr, int wc, int fr, int fq) const {
    const int row0 = u.pm * BM + wr * 64 + fr, col0 = u.pn * BM + wc * 32 + 8 * fq;
#pragma unroll
    for (int ai = 0; ai < 2; ++ai)
#pragma unroll
      for (int m = 0; m < 4; ++m) { const int row = row0 + ai * HALF + m * 16; const float gt = GATE[row]; u16* rowp = YE + (size_t)row * 1024 + col0;
#pragma unroll
        for (int bj = 0; bj < 2; ++bj) { const f32x4 v0 = acc[ai][bj][m][0] * gt, v1 = acc[ai][bj][m][1] * gt;
          *(u32x4*)(rowp + bj * HALF) = u32x4{pk2(v0[0], v0[1]), pk2(v0[2], v0[3]), pk2(v1[0], v1[1]), pk2(v1[2], v1[3])}; } }
  }
};
}

DI void cvt_tile_T(const float* __restrict__ src, int ldsrc, int N, int K, u16* __restrict__ dst, int k0, int n0, int drow0, char* smem, int tid) {
  short* tl = (short*)smem;
  __syncthreads();
#pragma unroll
  for (int i = 0; i < 2; ++i) {
    int u = tid + i * NTH; int kr = u >> 4, nq = u & 15; int n = n0 + nq * 4;
    f32x4 v = f32x4{0.f, 0.f, 0.f, 0.f};
    if (n < N) v = *(const f32x4*)(src + (size_t)(k0 + kr) * ldsrc + n);
#pragma unroll
    for (int e = 0; e < 4; ++e) tl[(nq * 4 + e) * 72 + kr] = (short)f2bf(v[e]);
  }
  __syncthreads();
  { int n = tid >> 3, kc = tid & 7;
    *(u32x4*)(dst + (size_t)(drow0 + n) * K + k0 + kc * 8) = *(const u32x4*)(tl + n * 72 + kc * 8); }
}
constexpr int WIN_PAD = 2560;
DI void ph_cvt_small(const P& p, int layer, char* smem) {
  const int tid = tidx();
  const int t0 = 16 * 40, t1 = t0 + 256, t2 = t1 + 256, t3 = t2 + 64;
  for (int t = blockIdx.x; t < t3; t += gridDim.x) {
    if (t < t0) cvt_tile_T(p.w_in + (size_t)layer * DM * INC, INC, INC, DM, p.WIN, (t / 40) * 64, (t % 40) * 64, (t % 40) * 64, smem, tid);
    else if (t < t1) { int q = t - t0; cvt_tile_T(p.w_out + (size_t)layer * DM * DM, DM, DM, DM, p.WOUT, (q / 16) * 64, (q % 16) * 64, (q % 16) * 64, smem, tid); }
    else if (t < t2) { int q = t - t1; cvt_tile_T(p.ple_gate + (size_t)layer * DM * DM, DM, DM, DM, p.WPG, (q / 16) * 64, (q % 16) * 64, (q % 16) * 64, smem, tid); }
    else { int q = t - t2; cvt_tile_T(p.ple_proj + (size_t)layer * DPLE * DM, DM, DM, DPLE, p.WPP, (q / 16) * 64, (q % 16) * 64, (q % 16) * 64, smem, tid); }
  }
  const float* ps = p.p + (size_t)layer * NTOK * DPLE;
  for (int i = blockIdx.x * NTH + tid; i < NTOK * DPLE / 8; i += gridDim.x * NTH) {
    f32x4 a = *(const f32x4*)(ps + (size_t)i * 8), b = *(const f32x4*)(ps + (size_t)i * 8 + 4);
    *(u32x4*)(p.PB + (size_t)i * 8) = u32x4{pk2(a[0], a[1]), pk2(a[2], a[3]), pk2(b[0], b[1]), pk2(b[2], b[3])};
  }
}

struct CvtJob { const float* src; u16* dst; int k0, n0, drow0; };
DI bool cvt_job(const P& p, int layer, int t, CvtJob& j) {
  if (t >= NE * 3 * 128) return false;
  const int e = t / 384, r = t % 384, mat = r / 128, q = r % 128;
  j.k0 = (q / 8) * 64; j.n0 = (q % 8) * 128;
  const size_t eo = ((size_t)layer * NE + e) * 1024 * 1024;
  if (mat == 0) { j.src = p.exp_w_gate + eo; j.dst = p.EW1 + (size_t)e * 2048 * 1024; j.drow0 = (j.n0 >> 7) * 256; }
  else if (mat == 1) { j.src = p.exp_w_up + eo; j.dst = p.EW1 + (size_t)e * 2048 * 1024; j.drow0 = (j.n0 >> 7) * 256 + 128; }
  else { j.src = p.exp_w_down + eo; j.dst = p.EW2 + (size_t)e * 1024 * 1024; j.drow0 = j.n0; }
  return true;
}
DI void ph_cvt_experts(const P& p, int layer, char* smem, unsigned* ctr) {
  const int tid = tidx();
  short* tl = (short*)smem;
  int* sitem = (int*)(smem + 32768);
  __syncthreads();
  if (tid == 0) sitem[0] = (int)atomicAdd(ctr, 1u);
  __syncthreads();
  CvtJob cur; bool has = cvt_job(p, layer, sitem[0], cur);
  f32x4 v[4];
  const int kr = tid >> 5, nq = tid & 31;
  if (has) {
#pragma unroll
    for (int i = 0; i < 4; ++i) v[i] = *(const f32x4*)(cur.src + (size_t)(cur.k0 + kr + 16 * i) * 1024 + cur.n0 + nq * 4);
  }
  int par = 0;
  while (has) {
    if (tid == 0) sitem[1 + par] = (int)atomicAdd(ctr, 1u);
    __syncthreads();
#pragma unroll
    for (int i = 0; i < 4; ++i)
#pragma unroll
      for (int e = 0; e < 4; ++e) tl[(nq * 4 + e) * 72 + kr + 16 * i] = (short)f2bf(v[i][e]);
    __syncthreads();
    CvtJob nxt; const bool hn = cvt_job(p, layer, sitem[1 + par], nxt);
    if (hn) {
#pragma unroll
      for (int i = 0; i < 4; ++i) v[i] = *(const f32x4*)(nxt.src + (size_t)(nxt.k0 + kr + 16 * i) * 1024 + nxt.n0 + nq * 4);
    }
#pragma unroll
    for (int i = 0; i < 2; ++i) {
      int u = tid + i * NTH; int n = u >> 3, kc = u & 7;
      *(u32x4*)(cur.dst + (size_t)(cur.drow0 + n) * 1024 + cur.k0 + kc * 8) = *(const u32x4*)(tl + n * 72 + kc * 8);
    }
    cur = nxt; has = hn; par ^= 1;
  }
}
DI void ph_gather(const P& p) {
  const int tid_ = tidx(); const int lane = tid_ & 63, w = tid_ >> 6;
  for (int row = blockIdx.x * 8 + w; row < NB * NE * CAP; row += gridDim.x * 8) {
    const int b = row / (NE * CAP);
    const int tok = b * T + p.IDX[row];
    const u32x4* src = (const u32x4*)(p.H + (size_t)tok * DM);
    u32x4* dst = (u32x4*)(p.XE + (size_t)row * DM);
    u32x4 a = src[lane], c = src[lane + 64];
    dst[lane] = a; dst[lane + 64] = c;
  }
}
DI void ph_combine_norm(const P& p, int layer) {
  const int tid_ = tidx(); const int lane = tid_ & 63, w = tid_ >> 6;
  const float* g = p.ple_norm + layer * DM;
  for (int tok = blockIdx.x * 8 + w; tok < NTOK; tok += gridDim.x * 8) {
    f32x4* xr = (f32x4*)(p.out + (size_t)tok * DM);
    f32x4 v[4];
#pragma unroll
    for (int j = 0; j < 4; ++j) v[j] = xr[lane * 4 + j];
    const int cnt = p.TCNT[tok];
    for (int q = 0; q < cnt; ++q) {
      const int yrow = p.TLIST[(size_t)tok * 16 + q];
      const u32x4* yr = (const u32x4*)(p.YE + (size_t)yrow * DM + lane * 16);
      u32x4 a = yr[0], c = yr[1];
#pragma unroll
      for (int e = 0; e < 4; ++e) {
        v[e >> 1][(e & 1) * 2] += __uint_as_float(a[e] << 16); v[e >> 1][(e & 1) * 2 + 1] += __uint_as_float(a[e] & 0xffff0000u);
        v[2 + (e >> 1)][(e & 1) * 2] += __uint_as_float(c[e] << 16); v[2 + (e >> 1)][(e & 1) * 2 + 1] += __uint_as_float(c[e] & 0xffff0000u);
      }
    }
    float ss = 0.f;
#pragma unroll
    for (int j = 0; j < 4; ++j) { xr[lane * 4 + j] = v[j]; ss += v[j][0] * v[j][0] + v[j][1] * v[j][1] + v[j][2] * v[j][2] + v[j][3] * v[j][3]; }
    ss = wave_sum(ss);
    const float rstd = frsq(ss * (1.f / DM) + NORM_EPS);
    u32x4 o0, o1;
#pragma unroll
    for (int j = 0; j < 4; ++j) {
      f32x4 gg = *(const f32x4*)(g + lane * 16 + j * 4);
      unsigned lo = pk2(v[j][0] * rstd * gg[0], v[j][1] * rstd * gg[1]), hi = pk2(v[j][2] * rstd * gg[2], v[j][3] * rstd * gg[3]);
      if (j < 2) { o0[j * 2] = lo; o0[j * 2 + 1] = hi; } else { o1[(j - 2) * 2] = lo; o1[(j - 2) * 2 + 1] = hi; }
    }
    *(u32x4*)(p.H + (size_t)tok * DM + lane * 16) = o0; *(u32x4*)(p.H + (size_t)tok * DM + lane * 16 + 8) = o1;
  }
}

#define XB_TMO      128
#define XB_XCNT(j)  (256  + 64 * (j))
#define XB_XSUB(j)  (1280 + 64 * (j))
#define XB_XGEN(j)  (2304 + 64 * (j))
#define XB_TOP      3328
#define XB_TOPGEN   3392
#define XCD_BAR_WORDS 3456
#define XB_SPIN_CAP (1u << 20)
DI unsigned xb_ld(unsigned* p) { return __hip_atomic_load(p, __ATOMIC_RELAXED, __HIP_MEMORY_SCOPE_AGENT); }
DI unsigned xb_add(unsigned* p, unsigned v) { return __hip_atomic_fetch_add(p, v, __ATOMIC_RELAXED, __HIP_MEMORY_SCOPE_AGENT); }
DI unsigned xb_xcc_id() { return (unsigned)__builtin_amdgcn_s_getreg((3 << 11) | 20) & 0xFu; }
#define XB_SPIN(cond, bar) do { unsigned _sp = 0; while (cond) { __builtin_amdgcn_s_sleep(1); \
    if ((++_sp & 255u) == 0u) { if (xb_ld(&(bar)[XB_TMO])) break; if (_sp > XB_SPIN_CAP) { atomicAdd(&(bar)[XB_TMO], 1u); break; } } } } while (0)
struct XcdBarrier { unsigned* bar; unsigned x; volatile LAS unsigned* st; };
DI XcdBarrier xcd_barrier_post(unsigned* bar, volatile LAS unsigned* st) {
  XcdBarrier b; b.bar = bar; b.x = xb_xcc_id(); b.st = st;
  if (threadIdx.x == 0) (void)xb_add(&bar[XB_XCNT(b.x)], 1u);
  return b;
}
DI void xcd_barrier_complete(unsigned* bar, unsigned x, unsigned& nloc, unsigned& nx) {
  const unsigned G = gridDim.x * gridDim.y * gridDim.z;
  unsigned sum, cnt, mine, sp = 0u;
  for (;;) {
    sum = 0u; cnt = 0u; mine = 0u;
#pragma unroll
    for (unsigned j = 0; j < 16; ++j) { const unsigned c = xb_ld(&bar[XB_XCNT(j)]); sum += c; cnt += (c > 0u) ? 1u : 0u; mine = (j == x) ? c : mine; }
    if (sum == G) break;
    __builtin_amdgcn_s_sleep(1);
    if ((++sp & 255u) == 0u) { if (xb_ld(&bar[XB_TMO])) break; if (sp > XB_SPIN_CAP) { atomicAdd(&bar[XB_TMO], 1u); break; } }
  }
  nloc = mine > 0u ? mine : 1u; nx = cnt > 0u ? cnt : 1u;
}
DI void xcd_barrier(const XcdBarrier& b) {
  asm volatile("s_waitcnt vmcnt(0)" ::: "memory");
  __syncthreads();
  if (threadIdx.x == 0) {
    unsigned* bar = b.bar;
    __builtin_amdgcn_s_waitcnt(0);
    unsigned nloc = b.st[0], nx = b.st[1];
    if (nloc == 0u) { xcd_barrier_complete(bar, b.x, nloc, nx); b.st[0] = nloc; b.st[1] = nx; }
    const unsigned old = xb_add(&bar[XB_XSUB(b.x)], 1u);
    const unsigned gen = old / nloc;
    if (old + 1u == (gen + 1u) * nloc) {
      __builtin_amdgcn_fence(__ATOMIC_RELEASE, "agent");
      asm volatile("s_waitcnt vmcnt(0)" ::: "memory");
      const unsigned og = xb_add(&bar[XB_TOP], 1u);
      const unsigned tg = og / nx;
      if (og + 1u == (tg + 1u) * nx) xb_add(&bar[XB_TOPGEN], 1u);
      else XB_SPIN(xb_ld(&bar[XB_TOPGEN]) == tg, bar);
      __builtin_amdgcn_fence(__ATOMIC_ACQUIRE, "agent");
      xb_add(&bar[XB_XGEN(b.x)], 1u);
      asm volatile("s_waitcnt vmcnt(0)" ::: "memory");
    } else {
      XB_SPIN(xb_ld(&bar[XB_XGEN(b.x)]) == gen, bar);
      __builtin_amdgcn_fence(__ATOMIC_ACQUIRE, "agent");
      asm volatile("s_waitcnt vmcnt(0)" ::: "memory");
    }
  }
  __syncthreads();
}

#define TAKE(bytes) (ws + off); off += (((size_t)(bytes)) + 255) & ~(size_t)255
__host__ __device__ inline size_t fill_ws(P& p, char* ws) {
  size_t off = 0;
  char* regA = TAKE((size_t)NTOK * INC * 4);
  p.Z = (float*)regA;
  p.LW = (u16*)regA; p.AA = (u16*)(regA + (size_t)2 * NTOK * RWW * 2); p.G = (u16*)(regA + (size_t)4 * NTOK * RWW * 2);
  p.MC = (float*)(regA + (size_t)5 * NTOK * RWW * 2); p.NC = p.MC + (size_t)32 * NCH * 4096;
  p.HID = (u16*)regA;
  char* regB = TAKE((size_t)3 * NTOK * RWW * 4);
  p.R = (float*)regB; p.K = p.R + (size_t)NTOK * RWW; p.V = p.K + (size_t)NTOK * RWW;
  p.PG = (float*)regB;
  char* regC = TAKE((size_t)NTOK * (768 + 1024) * 4);
  p.QRAW = (float*)regC; p.KVRAW = p.QRAW + (size_t)NTOK * 768;
  p.AO = (float*)regC; p.O2 = (u16*)(p.AO + (size_t)NTOK * 512); p.SS = (float*)(p.O2 + (size_t)2 * NTOK * 512);
  p.TWD = (u16*)TAKE((size_t)2 * NTOK * 64 * 2); p.AD = (u16*)TAKE((size_t)2 * NTOK * 64 * 2);
  p.SGD = (u16*)TAKE((size_t)NTOK * 128 * 2); p.QDN = (u16*)TAKE((size_t)NTOK * 256 * 2);
  p.KVDN = (u16*)TAKE((size_t)NTOK * 128 * 2); p.KR = (float*)TAKE((size_t)NTOK * 32 * 4);
  p.ROPE = (float*)TAKE((size_t)NTOK * 32 * 4);
  p.Q = (u16*)TAKE((size_t)NTOK * NH * 96 * 2); p.Kc = (u16*)TAKE((size_t)NTOK * NH * 96 * 2);
  p.Vv = (u16*)TAKE((size_t)NTOK * NH * 64 * 2);
  p.H = (u16*)TAKE((size_t)NTOK * DM * 2);
  p.AFF = (float*)TAKE((size_t)NB * NE * T * 4);
  p.IDX = (int*)TAKE((size_t)NB * NE * CAP * 4);
  p.GATE = (float*)TAKE((size_t)NB * NE * CAP * 4);

  p.WIN = (u16*)TAKE((size_t)WIN_PAD * DM * 2); p.WOUT = (u16*)TAKE((size_t)DM * DM * 2); p.WPG = (u16*)TAKE((size_t)DM * DM * 2);
  p.WPP = (u16*)TAKE((size_t)DM * DPLE * 2); p.PB = (u16*)TAKE((size_t)NTOK * DPLE * 2);
  p.PGb = (u16*)regB;
  p.EW1 = (u16*)regB; p.EW2 = p.EW1 + (size_t)NE * 2048 * 1024;
  p.XE = (u16*)regA; p.HID = (u16*)(regA + (size_t)32 * 1024 * 1024 * 2);
  p.YE = (u16*)regC;
  p.TCNT = (int*)TAKE((size_t)NTOK * 4); p.TLIST = (int*)TAKE((size_t)NTOK * 16 * 4);
  p.CTR = (unsigned*)TAKE(256);
  p.BAR = (unsigned*)TAKE(XCD_BAR_WORDS * 4);
  return off;
}
#undef TAKE
constexpr int DSM_BYTES = g8::STAGE_BYTES + 64;
extern __shared__ __attribute__((aligned(16))) char dsm[];
struct PK { const void* in[31]; float* out; char* ws; };
DI void build_params(P& p, const PK& k) {
  p.x = (const float*)k.in[0]; p.p = (const float*)k.in[1]; p.pos = (const int*)k.in[2];
  p.attn_norm = (const float*)k.in[3]; p.w_in = (const float*)k.in[4]; p.rw_mu = (const float*)k.in[5];
  p.rw_w0 = (const float*)k.in[6]; p.rw_w_up = (const float*)k.in[7]; p.rw_a0 = (const float*)k.in[8];
  p.rw_a_up = (const float*)k.in[9]; p.rw_g_up = (const float*)k.in[10]; p.rw_k_k = (const float*)k.in[11];
  p.rw_k_a = (const float*)k.in[12]; p.rw_r_k = (const float*)k.in[13]; p.rw_lnx_w = (const float*)k.in[14];
  p.rw_lnx_b = (const float*)k.in[15]; p.mla_q_norm = (const float*)k.in[16]; p.mla_q_up = (const float*)k.in[17];
  p.mla_kv_norm = (const float*)k.in[18]; p.mla_kv_up = (const float*)k.in[19]; p.mla_o_norm = (const float*)k.in[20];
  p.w_out = (const float*)k.in[21]; p.ffn_norm = (const float*)k.in[22]; p.router = (const float*)k.in[23];
  p.exp_w_gate = (const float*)k.in[24]; p.exp_w_up = (const float*)k.in[25]; p.exp_w_down = (const float*)k.in[26];
  p.ple_norm = (const float*)k.in[27]; p.ple_proj = (const float*)k.in[28]; p.ple_gate = (const float*)k.in[29];
  p.final_norm = (const float*)k.in[30];
  p.out = k.out;
  (void)fill_ws(p, k.ws);
}
__global__ void __launch_bounds__(NTH) mega(PK pk) {
  P p; build_params(p, pk);
  char* smem = dsm;
  LAS unsigned char* glds = (LAS unsigned char*)dsm;
  uint4* xbw = (uint4*)(dsm + g8::STAGE_BYTES);
  cg::grid_group grid = cg::this_grid();
  if (threadIdx.x == 0) *xbw = make_uint4(0u, 0u, 0u, 0u);
  if (blockIdx.x == 0) {
    if (threadIdx.x < 16) p.CTR[threadIdx.x] = 0u;
    for (int i = threadIdx.x; i < XCD_BAR_WORDS; i += NTH) p.BAR[i] = 0u;
  }
  grid.sync();
  const XcdBarrier xb = xcd_barrier_post(p.BAR, (volatile LAS unsigned*)xbw);
#define GSYNC() xcd_barrier(xb)
#ifndef PROBE_MASK
#define PROBE_MASK 0u
#endif
#if PROBE_MASK
  unsigned long long pt0 = __builtin_amdgcn_s_memrealtime();
#define PSYNC(id) do { GSYNC(); if (PROBE_MASK & (1u << (id))) { unsigned long long t1_ = __builtin_amdgcn_s_memrealtime(); unsigned long long dt_ = t1_ - pt0; \
    while (__builtin_amdgcn_s_memrealtime() - t1_ < dt_) __builtin_amdgcn_s_sleep(8); } pt0 = __builtin_amdgcn_s_memrealtime(); } while (0)
#else
#define PSYNC(id) GSYNC()
#endif
  for (int layer_ = 0; layer_ < NL; ++layer_) {
    int layer = layer_; asm volatile("" : "+s"(layer));
    if (layer_ == 0) ph_rope_table(p);
    ph_cvt_small(p, layer, smem);
    ph_norm(layer == 0 ? p.x : p.out, p.attn_norm + layer * DM, p.H);
    PSYNC(0);
    {
      g8::Sched S; S.init(NTOK / 256, WIN_PAD / 256, gridDim.x, bidx(), p.H, p.WIN, DM);
      g8::EpiZ E{p.Z};
      g8::gemm_phase(glds, DM, S, E);
    }
    PSYNC(1);
    ph_rwshift(p, layer);
    ph_mlaprep1(p, layer);
    PSYNC(2);
    for (int d = 0; d < 2; ++d) {
      u16* LW = p.LW + (size_t)d * NTOK * RWW; const float* w0 = p.rw_w0 + (layer * 2 + d) * RWW;
      ph_gemm<false>(p.TWD + (size_t)d * NTOK * 64, 64, p.rw_w_up + ((size_t)(layer * 2 + d)) * 64 * RWW, RWW, NTOK, RWW, 64, smem,
                     [&](int row, int col, float v) { LW[(size_t)row * RWW + col] = f2bf(-0.6065306597126334f * sigmoidf_(v + w0[col])); });
      u16* AA = p.AA + (size_t)d * NTOK * RWW; const float* a0 = p.rw_a0 + (layer * 2 + d) * RWW;
      ph_gemm<false>(p.AD + (size_t)d * NTOK * 64, 64, p.rw_a_up + ((size_t)(layer * 2 + d)) * 64 * RWW, RWW, NTOK, RWW, 64, smem,
                     [&](int row, int col, float v) { AA[(size_t)row * RWW + col] = f2bf(sigmoidf_(v + a0[col])); });
    }
    {
      u16* G = p.G;
      ph_gemm<false>(p.SGD, 128, p.rw_g_up + (size_t)layer * 128 * RWW, RWW, NTOK, RWW, 128, smem,
                     [&](int row, int col, float v) { G[(size_t)row * RWW + col] = f2bf(v); });
      {
        u16* Qo = p.Q; const float* rope = p.ROPE;
        ph_gemm_t(p.QDN, 256, p.mla_q_up + (size_t)layer * 256 * 768, 768, NTOK, 768, 256, smem,
                  [&](const f32x4 (&acc)[4][4], int m0, int n0, int wm, int wn, int lq, int l15) {
          const float qs = 0.10206207261596577f * 1.4426950408889634f;
#pragma unroll
          for (int mi = 0; mi < 4; ++mi)
#pragma unroll
            for (int r = 0; r < 4; ++r) {
              const int tok = m0 + wm * 64 + mi * 16 + lq * 4 + r; const int b = tok / T, t = tok % T;
#pragma unroll
              for (int ni = 0; ni < 4; ++ni) {
                const int col0 = n0 + wn * 64 + ni * 16; const int h = col0 / 96, c0 = col0 % 96;
                u16* qo = Qo + ((size_t)(b * NH + h) * T + t) * 96;
                if (c0 < 64) qo[c0 + l15] = f2bf(acc[mi][ni][r] * qs);
                else if (c0 == 64) {
                  const f32x2 csn = *(const f32x2*)(rope + (size_t)tok * 32 + l15 * 2);
                  const float u1 = acc[mi][ni][r], u2 = acc[mi][(ni + 1) & 3][r];
                  qo[64 + l15] = f2bf((u1 * csn[0] - u2 * csn[1]) * qs);
                  qo[80 + l15] = f2bf((u1 * csn[1] + u2 * csn[0]) * qs);
                }
              }
            }
        });
      }
      {
        u16* Ko = p.Kc; u16* Vo = p.Vv;
        ph_gemm_t(p.KVDN, 128, p.mla_kv_up + (size_t)layer * 128 * 1024, 1024, NTOK, 1024, 128, smem,
                  [&](const f32x4 (&acc)[4][4], int m0, int n0, int wm, int wn, int lq, int l15) {
#pragma unroll
          for (int mi = 0; mi < 4; ++mi)
#pragma unroll
            for (int r = 0; r < 4; ++r) {
              const int tok = m0 + wm * 64 + mi * 16 + lq * 4 + r; const int b = tok / T, t = tok % T;
#pragma unroll
              for (int ni = 0; ni < 4; ++ni) {
                const int col0 = n0 + wn * 64 + ni * 16; const int h = col0 >> 7, c0 = col0 & 127;
                const size_t rowi = (size_t)(b * NH + h) * T + t;
                if (c0 < 64) Ko[rowi * 96 + c0 + l15] = f2bf(acc[mi][ni][r]);
                else Vo[rowi * 64 + (c0 - 64) + l15] = f2bf(acc[mi][ni][r]);
              }
            }
        });
      }
    }
    PSYNC(3);
    ph_scan1(p, layer, smem);
    PSYNC(4);
    ph_scan2(p, smem);
    ph_attn(p, smem, p.CTR + layer);
    PSYNC(5);
    ph_scan3(p, layer, smem);
    PSYNC(6);
    ph_mixfinish(p, layer);
    PSYNC(7);
    {
      for (int i = blockIdx.x * NTH + tidx(); i < NTOK; i += gridDim.x * NTH) p.TCNT[i] = 0;
      g8::Sched S; S.init(NTOK / 256, DM / 256, gridDim.x, bidx(), p.H, p.WOUT, DM);
      g8::EpiRes E{(layer == 0) ? p.x : p.out, p.out};
      g8::gemm_phase(glds, DM, S, E);
    }
    PSYNC(8);
    ph_norm_router(p, layer, smem);
    PSYNC(9);
    ph_topk(p, smem);
    ph_cvt_experts(p, layer, smem, p.CTR + 4 + layer);
    PSYNC(10);
    ph_gather(p);
    PSYNC(11);
    {
      g8::Sched S; S.init(NB * NE * CAP / 256, 2048 / 256, gridDim.x, bidx(), p.XE, p.EW1, DM);
      S.group(4, NE, (size_t)2048 * 1024 * 2);
      g8::EpiSwi E{p.HID};
      g8::gemm_phase(glds, DM, S, E);
    }
    PSYNC(12);
    {
      g8::Sched S; S.init(NB * NE * CAP / 256, DM / 256, gridDim.x, bidx(), p.HID, p.EW2, 1024);
      S.group(4, NE, (size_t)1024 * 1024 * 2);
      g8::EpiYE E{p.YE, p.GATE};
      g8::gemm_phase(glds, 1024, S, E);
    }
    PSYNC(13);
    ph_combine_norm(p, layer);
    PSYNC(16);
    {
      g8::Sched S; S.init(NTOK / 256, DM / 256, gridDim.x, bidx(), p.H, p.WPG, DM);
      g8::EpiSig E{p.PGb};
      g8::gemm_phase(glds, DM, S, E);
    }
    {
      g8::Sched S; S.init(NTOK / 256, DM / 256, gridDim.x, bidx(), p.PB, p.WPP, DPLE);
      g8::EpiPle E{p.out, p.PGb};
      g8::gemm_phase(glds, DPLE, S, E);
    }
    PSYNC(15);
  }
  ph_final_norm(p.out, p.final_norm);
}

extern "C" void kernel_launch(void* const* d_in, const int* in_sizes, int n_in, void* d_out, int out_size, void* d_ws,
                              size_t ws_size, hipStream_t stream) {
  (void)in_sizes; (void)n_in; (void)out_size;
  PK pk{};
  for (int i = 0; i < 31; ++i) pk.in[i] = d_in[i];
  pk.out = (float*)d_out; pk.ws = (char*)d_ws;
  P p{};
  const size_t off = fill_ws(p, (char*)d_ws);
  if (off > ws_size) { fprintf(stderr, "workspace too small: need %zu have %zu\n", off, ws_size); return; }
  static int grid_blocks = 0;
  if (!grid_blocks) {
    int dev = 0, cus = 0, per_cu = 0;
    hipGetDevice(&dev);
    hipDeviceGetAttribute(&cus, hipDeviceAttributeMultiprocessorCount, dev);
    hipFuncSetAttribute((const void*)mega, hipFuncAttributeMaxDynamicSharedMemorySize, DSM_BYTES);
    hipOccupancyMaxActiveBlocksPerMultiprocessor(&per_cu, mega, NTH, DSM_BYTES);
    if (per_cu > 1) per_cu = 1;
    grid_blocks = cus * per_cu;
  }
  void* args[] = {&pk};
  hipError_t e = hipLaunchCooperativeKernel((void*)mega, dim3(grid_blocks), dim3(NTH), args, DSM_BYTES, stream);
  if (e != hipSuccess) fprintf(stderr, "cooperative launch failed: %s (grid %d)\n", hipGetErrorString(e), grid_blocks);
}
```

```cpp
#include <hip/hip_runtime.h>
#include <hip/hip_bf16.h>
#include <cstdio>
#include <cstdint>
#include <hip/hip_cooperative_groups.h>
namespace cg = cooperative_groups;

#define DI __device__ __forceinline__
#define LAS __attribute__((address_space(3)))

constexpr int NB = 2, T = 8192, NTOK = NB * T, DM = 1024, NL = 2;
constexpr int RWW = 512, RWC = 1920, INC = 2336;
constexpr int NH = 8;
constexpr int NE = 16, CAP = 1024;
constexpr int DPLE = 256;
constexpr int NTH = 512;
constexpr float NORM_EPS = 1e-6f, GN_EPS = 64e-5f;

using bf16x8 = __attribute__((ext_vector_type(8))) short;
using s16x4  = __attribute__((ext_vector_type(4))) short;
using f32x4  = __attribute__((ext_vector_type(4))) float;
using u32x4  = __attribute__((ext_vector_type(4))) unsigned;
using f32x2  = __attribute__((ext_vector_type(2))) float;
using u32x2  = __attribute__((ext_vector_type(2))) unsigned;
typedef __bf16 bf2_t __attribute__((ext_vector_type(2)));
typedef unsigned short u16;

DI unsigned pk2(float a, float b) { bf2_t v = {(__bf16)a, (__bf16)b}; return __builtin_bit_cast(unsigned, v); }
DI u16 f2bf(float a) { return (u16)(pk2(a, 0.f) & 0xffffu); }
DI float bf2f(u16 u) { return __uint_as_float(((unsigned)u) << 16); }
DI const void* uni_ptr(const void* q) {
  unsigned long long v = (unsigned long long)q;
  unsigned lo = __builtin_amdgcn_readfirstlane((unsigned)v), hi = __builtin_amdgcn_readfirstlane((unsigned)(v >> 32));
  return (const void*)(((unsigned long long)hi << 32) | lo);
}
DI int tidx() { int t = threadIdx.x; asm volatile("" : "+v"(t)); return t; }
DI int bidx() { int b = blockIdx.x; asm volatile("" : "+s"(b)); return b; }
template <int CTRL> DI float dpp_f(float v) {
  return __int_as_float(__builtin_amdgcn_update_dpp(__float_as_int(v), __float_as_int(v), CTRL, 0xF, 0xF, true));
}
DI float red_x1(float v) { return v + dpp_f<0xB1>(v); }
DI float red_x2(float v) { return v + dpp_f<0x4E>(v); }
DI float red_x4(float v) { return v + dpp_f<0x141>(v); }
DI float red_x8(float v) { return v + dpp_f<0x140>(v); }
DI float red_x16(float v) { auto r = __builtin_amdgcn_permlane16_swap(__float_as_uint(v), __float_as_uint(v), false, false); return __uint_as_float(r[0]) + __uint_as_float(r[1]); }
DI float red_x32(float v) { auto r = __builtin_amdgcn_permlane32_swap(__float_as_uint(v), __float_as_uint(v), false, false); return __uint_as_float(r[0]) + __uint_as_float(r[1]); }
DI float red16(float v) { return red_x8(red_x4(red_x2(red_x1(v)))); }
DI float wave_sum(float v) { return red_x32(red_x16(red16(v))); }
DI float frcp(float x) { return __builtin_amdgcn_rcpf(x); }
DI float frsq(float x) { return __builtin_amdgcn_rsqf(x); }
DI float fexp(float x) { return __builtin_amdgcn_exp2f(x * 1.4426950408889634f); }
DI float sigmoidf_(float x) { return frcp(1.f + fexp(-x)); }
DI float ftanh(float x) { return 1.f - 2.f * frcp(1.f + fexp(2.f * x)); }
DI s16x4 tr_read(const short* p) {
  return __builtin_amdgcn_ds_read_tr16_b64_v4i16((LAS s16x4*)(p));
}

struct P {
  const float* x; const float* p; const int* pos;
  const float* attn_norm; const float* w_in; const float* rw_mu; const float* rw_w0; const float* rw_w_up;
  const float* rw_a0; const float* rw_a_up; const float* rw_g_up; const float* rw_k_k; const float* rw_k_a;
  const float* rw_r_k; const float* rw_lnx_w; const float* rw_lnx_b; const float* mla_q_norm; const float* mla_q_up;
  const float* mla_kv_norm; const float* mla_kv_up; const float* mla_o_norm; const float* w_out; const float* ffn_norm;
  const float* router; const float* exp_w_gate; const float* exp_w_up; const float* exp_w_down; const float* ple_norm;
  const float* ple_proj; const float* ple_gate; const float* final_norm;
  float* out;
  float* Z;
  u16* LW;
  u16* AA;
  float* MC; float* NC;
  float* SS;
  u16*   G;
  u16*   HID;
  float* R; float* K; float* V;
  float* PG;
  float* QRAW;
  float* KVRAW;
  float* AO;
  u16* O2;
  u16* TWD; u16* AD; u16* SGD; u16* QDN; u16* KVDN; float* KR;
  float* ROPE;
  u16* Q; u16* Kc; u16* Vv;
  u16* H;
  float* AFF;
  int* IDX;
  float* GATE;
  u16* WIN; u16* WOUT; u16* WPG; u16* WPP; u16* PB;
  u16* PGb;
  u16* EW1; u16* EW2;
  u16* XE; u16* YE;
  int* TCNT; int* TLIST;
  unsigned* CTR;
  unsigned* BAR;
};

constexpr int GBM = 256, GBN = 128, GBK = 64;
constexpr int AS_STRIDE = 72, BS_STRIDE = 136;
constexpr int AS_BYTES = GBM * AS_STRIDE * 2;
constexpr int BS_BYTES = GBK * BS_STRIDE * 2;
constexpr int SMEM_BYTES = 57344;

template <bool A_F32, int MODE, class ARow, class Epi>
DI void gemm_tile(ARow arow, const float* __restrict__ B, const float* __restrict__ B2, int ldb, int K, int n0, int Nvalid,
                  char* smem, Epi epi) {
  short* As = (short*)smem;
  short* Bs = (short*)(smem + AS_BYTES);
  const int tid = tidx(), lane = tid & 63, w = tid >> 6;
  const int wm = w >> 1, wn = w & 1;
  const int l15 = lane & 15, lq = lane >> 4;

  const char* ap[4];
#pragma unroll
  for (int i = 0; i < 4; ++i) {
    int u = tid + i * NTH; int row = u >> 3, kc = u & 7;
    ap[i] = (const char*)arow(row) + (size_t)kc * 8 * (A_F32 ? 4 : 2);
  }
  const float* bp[4]; bool bok[4];
#pragma unroll
  for (int i = 0; i < 4; ++i) {
    int u = tid + i * NTH; int k = u >> 5, nq = u & 31;
    int col; const float* base;
    if (MODE != 1) { col = n0 + nq * 4; base = B; }
    else { col = n0 + (nq & 15) * 4; base = (nq < 16) ? B : B2; }
    bok[i] = col < Nvalid;
    bp[i] = base + (size_t)k * ldb + (bok[i] ? col : 0);
  }

  f32x4 acc[4][4];
#pragma unroll
  for (int i = 0; i < 4; ++i)
#pragma unroll
    for (int j = 0; j < 4; ++j) acc[i][j] = f32x4{0.f, 0.f, 0.f, 0.f};

  u32x4 areg[4]; f32x4 breg[4];
#define GLOAD(kt_)                                                                                   \
  {                                                                                                  \
    _Pragma("unroll") for (int i = 0; i < 4; ++i) {                                                  \
      if (A_F32) {                                                                                   \
        const float4* q = (const float4*)(ap[i] + (size_t)(kt_) * GBK * 4);                          \
        float4 v0 = q[0], v1 = q[1];                                                                 \
        areg[i] = u32x4{pk2(v0.x, v0.y), pk2(v0.z, v0.w), pk2(v1.x, v1.y), pk2(v1.z, v1.w)};         \
      } else {                                                                                       \
        areg[i] = *(const u32x4*)(ap[i] + (size_t)(kt_) * GBK * 2);                                  \
      }                                                                                              \
    }                                                                                                \
    _Pragma("unroll") for (int i = 0; i < 4; ++i) {                                                  \
      if (bok[i]) breg[i] = *(const f32x4*)(bp[i] + (size_t)(kt_) * GBK * ldb);                      \
      else breg[i] = f32x4{0.f, 0.f, 0.f, 0.f};                                                      \
    }                                                                                                \
  }
  const int nk = K / GBK;
  GLOAD(0)
  for (int kt = 0; kt < nk; ++kt) {
    __syncthreads();
#pragma unroll
    for (int i = 0; i < 4; ++i) {
      int u = tid + i * NTH; int row = u >> 3, kc = u & 7;
      *(u32x4*)(As + row * AS_STRIDE + kc * 8) = areg[i];
    }
#pragma unroll
    for (int i = 0; i < 4; ++i) {
      int u = tid + i * NTH; int k = u >> 5, nq = u & 31;
      u32x2 v = u32x2{pk2(breg[i][0], breg[i][1]), pk2(breg[i][2], breg[i][3])};
      *(u32x2*)(Bs + k * BS_STRIDE + nq * 4) = v;
    }
    __syncthreads();
    if (kt + 1 < nk) GLOAD(kt + 1)
#pragma unroll
    for (int ks = 0; ks < 2; ++ks) {
      bf16x8 a[4], b[4];
#pragma unroll
      for (int mi = 0; mi < 4; ++mi)
        a[mi] = *(const bf16x8*)(As + (wm * 64 + mi * 16 + l15) * AS_STRIDE + ks * 32 + 8 * lq);
#pragma unroll
      for (int ni = 0; ni < 4; ++ni) {
        int col0 = (MODE != 1) ? (wn * 64 + ni * 16) : ((ni < 2) ? (wn * 32 + ni * 16) : (64 + wn * 32 + (ni - 2) * 16));
        int kb = ks * 32 + 8 * lq; int q = l15 >> 2, pp = l15 & 3;
        s16x4 lo = tr_read(Bs + (kb + q) * BS_STRIDE + col0 + 4 * pp);
        s16x4 hi = tr_read(Bs + (kb + 4 + q) * BS_STRIDE + col0 + 4 * pp);
        b[ni] = __builtin_shufflevector(lo, hi, 0, 1, 2, 3, 4, 5, 6, 7);
      }
#pragma unroll
      for (int mi = 0; mi < 4; ++mi)
#pragma unroll
        for (int ni = 0; ni < 4; ++ni)
          acc[mi][ni] = __builtin_amdgcn_mfma_f32_16x16x32_bf16(a[mi], b[ni], acc[mi][ni], 0, 0, 0);
    }
  }
  if constexpr (MODE == 2) { epi(acc, wm, wn, lq, l15); return; }
  else {
#pragma unroll
  for (int mi = 0; mi < 4; ++mi)
#pragma unroll
    for (int r = 0; r < 4; ++r) {
      int row = wm * 64 + mi * 16 + lq * 4 + r;
      if (MODE == 0) {
#pragma unroll
        for (int ni = 0; ni < 4; ++ni) {
          int col = n0 + wn * 64 + ni * 16 + l15;
          if (col < Nvalid) epi(row, col, acc[mi][ni][r], 0.f);
        }
      } else {
#pragma unroll
        for (int ni = 0; ni < 2; ++ni) {
          int col = n0 + wn * 32 + ni * 16 + l15;
          epi(row, col, acc[mi][ni][r], acc[mi][ni + 2][r]);
        }
      }
    }
  }
}

DI void ph_norm(const float* __restrict__ X, const float* __restrict__ g, u16* __restrict__ Hout) {
  const int tid_ = tidx(); const int lane = tid_ & 63, w = tid_ >> 6;
  for (int tok = blockIdx.x * 8 + w; tok < NTOK; tok += gridDim.x * 8) {
    const float4* xr = (const float4*)(X + (size_t)tok * DM);
    float4 v[4]; float ss = 0.f;
#pragma unroll
    for (int j = 0; j < 4; ++j) { v[j] = xr[lane + 64 * j]; ss += v[j].x * v[j].x + v[j].y * v[j].y + v[j].z * v[j].z + v[j].w * v[j].w; }
    ss = wave_sum(ss);
    float rstd = frsq(ss * (1.f / DM) + NORM_EPS);
#pragma unroll
    for (int j = 0; j < 4; ++j) {
      float4 gg = ((const float4*)g)[lane + 64 * j];
      uint2 o = uint2{pk2(v[j].x * rstd * gg.x, v[j].y * rstd * gg.y), pk2(v[j].z * rstd * gg.z, v[j].w * rstd * gg.w)};
      *(uint2*)(Hout + (size_t)tok * DM + (lane + 64 * j) * 4) = o;
    }
  }
}

DI void ph_final_norm(float* __restrict__ X, const float* __restrict__ g) {
  const int tid_ = tidx(); const int lane = tid_ & 63, w = tid_ >> 6;
  for (int tok = blockIdx.x * 8 + w; tok < NTOK; tok += gridDim.x * 8) {
    float4* xr = (float4*)(X + (size_t)tok * DM);
    float4 v[4]; float ss = 0.f;
#pragma unroll
    for (int j = 0; j < 4; ++j) { v[j] = xr[lane + 64 * j]; ss += v[j].x * v[j].x + v[j].y * v[j].y + v[j].z * v[j].z + v[j].w * v[j].w; }
    ss = wave_sum(ss);
    float rstd = frsq(ss * (1.f / DM) + NORM_EPS);
#pragma unroll
    for (int j = 0; j < 4; ++j) {
      float4 gg = ((const float4*)g)[lane + 64 * j];
      xr[lane + 64 * j] = float4{v[j].x * rstd * gg.x, v[j].y * rstd * gg.y, v[j].z * rstd * gg.z, v[j].w * rstd * gg.w};
    }
  }
}

template <bool A_F32, class Epi>
DI void ph_gemm(const void* A, int lda, const float* B, int ldb, int M, int N, int K, char* smem, Epi epi) {
  const int ntn = (N + GBN - 1) / GBN, ntm = M / GBM;
  for (int t = blockIdx.x; t < ntm * ntn; t += gridDim.x) {
    int tm = t / ntn, tn = t % ntn;
    int m0 = tm * GBM, n0 = tn * GBN;
    auto arow = [&](int r) -> const void* { return (const char*)A + (size_t)(m0 + r) * lda * (A_F32 ? 4 : 2); };
    gemm_tile<A_F32, 0>(arow, B, nullptr, ldb, K, n0, N, smem, [&](int row, int col, float v, float) { epi(m0 + row, col, v); });
    __syncthreads();
  }
}

template <class Epi>
DI void ph_gemm_t(const void* A, int lda, const float* B, int ldb, int M, int N, int K, char* smem, Epi epi) {
  const int ntn = (N + GBN - 1) / GBN, ntm = M / GBM;
  for (int t = blockIdx.x; t < ntm * ntn; t += gridDim.x) {
    int tm = t / ntn, tn = t % ntn;
    int m0 = tm * GBM, n0 = tn * GBN;
    auto arow = [&](int r) -> const void* { return (const char*)A + (size_t)(m0 + r) * lda * 2; };
    gemm_tile<false, 2>(arow, B, nullptr, ldb, K, n0, N, smem,
                        [&](const f32x4 (&acc)[4][4], int wm, int wn, int lq, int l15) { epi(acc, m0, n0, wm, wn, lq, l15); });
    __syncthreads();
  }
}

DI void ph_rwshift(const P& p, int layer) {
  const float* mu = p.rw_mu + layer * RWC;
  const int total = NTOK * (RWC / 4);
  const int tid_ = tidx();
  for (int i = blockIdx.x * NTH + tid_; i < total; i += gridDim.x * NTH) {
    int tok = i / (RWC / 4), c = (i % (RWC / 4)) * 4;
    int t = tok % T;
    const float* zr = p.Z + (size_t)tok * INC + c;
    float4 z = *(const float4*)zr;
    float4 zm = (t > 0) ? *(const float4*)(zr - INC) : float4{0.f, 0.f, 0.f, 0.f};
    float4 zp = (t < T - 1) ? *(const float4*)(zr + INC) : float4{0.f, 0.f, 0.f, 0.f};
    float4 m = *(const float4*)(mu + c);
    float4 o;
    o.x = z.x + m.x * (0.5f * (zm.x + zp.x) - z.x);
    o.y = z.y + m.y * (0.5f * (zm.y + zp.y) - z.y);
    o.z = z.z + m.z * (0.5f * (zm.z + zp.z) - z.z);
    o.w = z.w + m.w * (0.5f * (zm.w + zp.w) - z.w);
    if (c < 512) *(float4*)(p.R + (size_t)tok * RWW + c) = o;
    else if (c < 1024) *(float4*)(p.K + (size_t)tok * RWW + (c - 512)) = o;
    else if (c < 1536) *(float4*)(p.V + (size_t)tok * RWW + (c - 1024)) = o;
    else if (c < 1664) {
      int d = (c - 1536) >> 6, l = (c - 1536) & 63;
      *(uint2*)(p.TWD + ((size_t)d * NTOK + tok) * 64 + l) = uint2{pk2(ftanh(o.x), ftanh(o.y)), pk2(ftanh(o.z), ftanh(o.w))};
    } else if (c < 1792) {
      int d = (c - 1664) >> 6, l = (c - 1664) & 63;
      *(uint2*)(p.AD + ((size_t)d * NTOK + tok) * 64 + l) = uint2{pk2(o.x, o.y), pk2(o.z, o.w)};
    } else {
      int l = c - 1792;
      *(uint2*)(p.SGD + (size_t)tok * 128 + l) = uint2{pk2(sigmoidf_(o.x), sigmoidf_(o.y)), pk2(sigmoidf_(o.z), sigmoidf_(o.w))};
    }
  }
}

DI void rope_cs(int pos, int i, float& cs, float& sn) {
  const int i3 = i & 3, i2 = i >> 2;
  const float c4 = (i3 == 0) ? 1.0f : (i3 == 1) ? 0.5623413251903491f : (i3 == 2) ? 0.31622776601683794f : 0.1778279410038923f;
  const float p10 = (i2 == 0) ? 1.0f : (i2 == 1) ? 0.1f : (i2 == 2) ? 0.01f : 0.001f;
  float inv = c4 * p10;
  float ang = (float)pos * inv;
  double rev = (double)ang * 0.15915494309189535;
  rev -= floor(rev);
  float rf = (float)rev;
  sn = __builtin_amdgcn_sinf(rf);
  cs = __builtin_amdgcn_cosf(rf);
}

DI void ph_rope_table(const P& p) {
  for (int i = blockIdx.x * NTH + tidx(); i < NTOK * 16; i += gridDim.x * NTH) {
    float cs, sn; rope_cs(p.pos[i >> 4], i & 15, cs, sn);
    *(f32x2*)(p.ROPE + (size_t)i * 2) = f32x2{cs, sn};
  }
}
DI void ph_mlaprep1(const P& p, int layer) {
  const int tid_ = tidx(); const int lane = tid_ & 63, w = tid_ >> 6;
  const float* qn = p.mla_q_norm + layer * 256;
  const float* kvn = p.mla_kv_norm + layer * 128;
  for (int tok = blockIdx.x * 8 + w; tok < NTOK; tok += gridDim.x * 8) {
    const float* zr = p.Z + (size_t)tok * INC + RWC;
    float4 q = *(const float4*)(zr + lane * 4);
    float ss = wave_sum(q.x * q.x + q.y * q.y + q.z * q.z + q.w * q.w);
    float rstd = frsq(ss * (1.f / 256) + NORM_EPS);
    float4 g = *(const float4*)(qn + lane * 4);
    *(uint2*)(p.QDN + (size_t)tok * 256 + lane * 4) = uint2{pk2(q.x * rstd * g.x, q.y * rstd * g.y), pk2(q.z * rstd * g.z, q.w * rstd * g.w)};
    float2 kv = *(const float2*)(zr + 256 + lane * 2);
    float ss2 = wave_sum(kv.x * kv.x + kv.y * kv.y);
    float rstd2 = frsq(ss2 * (1.f / 128) + NORM_EPS);
    float2 g2 = *(const float2*)(kvn + lane * 2);
    *(unsigned*)(p.KVDN + (size_t)tok * 128 + lane * 2) = pk2(kv.x * rstd2 * g2.x, kv.y * rstd2 * g2.y);
    if (lane < 16) {
      float u1 = zr[384 + lane], u2 = zr[384 + 16 + lane];
      const f32x2 csn = *(const f32x2*)(p.ROPE + (size_t)tok * 32 + lane * 2);
      const u16 k1 = f2bf(u1 * csn[0] - u2 * csn[1]), k2 = f2bf(u1 * csn[1] + u2 * csn[0]);
      const int bb = tok / T, tt = tok % T;
#pragma unroll
      for (int h = 0; h < NH; ++h) {
        u16* ko = p.Kc + ((size_t)(bb * NH + h) * T + tt) * 96 + 64;
        ko[lane] = k1; ko[16 + lane] = k2;
      }
    }
  }
}

DI void ph_mlafinish(const P& p) {
  const int tid_ = tidx(); const int lane = tid_ & 63, w = tid_ >> 6;
  const float qs = 0.10206207261596577f * 1.4426950408889634f;
  for (int tok = blockIdx.x * 8 + w; tok < NTOK; tok += gridDim.x * 8) {
    int b = tok / T, t = tok % T;
    float cs = 0.f, sn = 0.f;
    if (lane < 16) rope_cs(p.pos[tok], lane, cs, sn);
    const float* qr = p.QRAW + (size_t)tok * 768;
    const float* kvr = p.KVRAW + (size_t)tok * 1024;
    const float* kr = p.KR + (size_t)tok * 32;
#pragma unroll
    for (int h = 0; h < NH; ++h) {
      size_t row = ((size_t)(b * NH + h) * T + t);
      u16* qo = p.Q + row * 96; u16* ko = p.Kc + row * 96; u16* vo = p.Vv + row * 64;
      qo[lane] = f2bf(qr[h * 96 + lane] * qs);
      ko[lane] = f2bf(kvr[h * 128 + lane]);
      vo[lane] = f2bf(kvr[h * 128 + 64 + lane]);
      if (lane < 16) {
        float u1 = qr[h * 96 + 64 + lane], u2 = qr[h * 96 + 80 + lane];
        qo[64 + lane] = f2bf((u1 * cs - u2 * sn) * qs);
        qo[80 + lane] = f2bf((u1 * sn + u2 * cs) * qs);
      }
      if (lane < 32) ko[64 + lane] = f2bf(kr[lane]);
    }
  }
}

using f32x16 = __attribute__((ext_vector_type(16))) float;
#define SBAR() __builtin_amdgcn_sched_barrier(0)
constexpr int AT_KSTR = 104;
constexpr int AT_KBYTES = 64 * AT_KSTR * 2;
constexpr int AT_VBYTES = 64 * 64 * 2;
constexpr float AT_THR = 8.f;
DI int crow(int r, int hi) { return (r & 3) + 8 * (r >> 2) + 4 * hi; }
DI int v_st(int k, int c) { const int kk = (k & ~0xC) | ((k & 4) << 1) | ((k & 8) >> 1); return ((kk >> 3) * 2 + (c >> 5)) * 512 + ((kk & 7) * 32 + (c & 31)) * 2; }
DI int v_rd_base(int lane) { return ((lane & 3) << 3) | (((lane >> 2) & 3) << 6) | (((lane >> 4) & 1) << 5) | (((lane >> 5) & 1) << 8); }
constexpr int v_rd_off(int d0, int ks, int half) { return d0 * 512 + ks * 2048 + half * 1024; }

DI void at_partialSM(f32x16& p0, f32x16& p1, float& m_reg, float& mn, float& alpha) {
  float pmax = p0[0];
#pragma unroll
  for (int r = 1; r < 16; ++r) pmax = fmaxf(pmax, p0[r]);
#pragma unroll
  for (int r = 0; r < 16; ++r) pmax = fmaxf(pmax, p1[r]);
  { auto rr = __builtin_amdgcn_permlane32_swap(__float_as_uint(pmax), __float_as_uint(pmax), false, false);
    pmax = fmaxf(__uint_as_float(rr[0]), __uint_as_float(rr[1])); }
  if (__builtin_expect(__all(pmax - m_reg <= AT_THR), 1)) { mn = m_reg; alpha = 1.f; }
  else { mn = fmaxf(m_reg, pmax); alpha = __builtin_amdgcn_exp2f(m_reg - mn); m_reg = mn; }
#pragma unroll
  for (int r = 0; r < 16; ++r) { p0[r] = p0[r] - mn; p1[r] = p1[r] - mn; }
#pragma unroll
  for (int r = 0; r < 16; ++r) p0[r] = __builtin_amdgcn_exp2f(p0[r]);
}
DI void at_finishSM(f32x16& p0, f32x16& p1, float alpha, float& l_reg, bf16x8& pa0, bf16x8& pa1, bf16x8& pa2, bf16x8& pa3) {
#pragma unroll
  for (int r = 0; r < 16; ++r) p1[r] = __builtin_amdgcn_exp2f(p1[r]);
  float ps = 0;
#pragma unroll
  for (int r = 0; r < 16; ++r) ps += p0[r];
#pragma unroll
  for (int r = 0; r < 16; ++r) ps += p1[r];
  { auto rr = __builtin_amdgcn_permlane32_swap(__float_as_uint(ps), __float_as_uint(ps), false, false);
    ps = __uint_as_float(rr[0]) + __uint_as_float(rr[1]); }
  l_reg = l_reg * alpha + ps;
#define PK4(PP, BASE, OUT) do { unsigned a0 = pk2(PP[BASE + 0], PP[BASE + 1]), a1 = pk2(PP[BASE + 2], PP[BASE + 3]);   \
    unsigned b0 = pk2(PP[BASE + 4], PP[BASE + 5]), b1 = pk2(PP[BASE + 6], PP[BASE + 7]);                              \
    auto r0 = __builtin_amdgcn_permlane32_swap(a0, b0, false, false); auto r1 = __builtin_amdgcn_permlane32_swap(a1, b1, false, false); \
    u32x4 wv = {r0[0], r1[0], r0[1], r1[1]}; OUT = __builtin_bit_cast(bf16x8, wv); } while (0)
  PK4(p0, 0, pa0); PK4(p0, 8, pa1); PK4(p1, 0, pa2); PK4(p1, 8, pa3);
#undef PK4
}
DI void at_qkt(f32x16& p0, f32x16& p1, const char* Kb, const bf16x8* qr, int r32, int hi) {
#pragma unroll
  for (int r = 0; r < 16; ++r) { p0[r] = 0.f; p1[r] = 0.f; }
#pragma unroll
  for (int d0 = 0; d0 < 6; ++d0) {
    bf16x8 b0 = *(const bf16x8*)(Kb + (r32 * AT_KSTR + d0 * 16 + hi * 8) * 2);
    bf16x8 b1 = *(const bf16x8*)(Kb + ((32 + r32) * AT_KSTR + d0 * 16 + hi * 8) * 2);
    __builtin_amdgcn_s_setprio(1);
    p0 = __builtin_amdgcn_mfma_f32_32x32x16_bf16(b0, qr[d0], p0, 0, 0, 0);
    p1 = __builtin_amdgcn_mfma_f32_32x32x16_bf16(b1, qr[d0], p1, 0, 0, 0);
    __builtin_amdgcn_s_setprio(0);
  }
}
template <int D0> DI void at_pv_one(f32x16& od, const char* vb, bf16x8 pa0, bf16x8 pa1, bf16x8 pa2, bf16x8 pa3) {
#define TRR(ks, half) tr_read((const short*)(vb + v_rd_off(D0, ks, half)))
  const s16x4 l0 = TRR(0, 0), h0 = TRR(0, 1), l1 = TRR(1, 0), h1 = TRR(1, 1), l2 = TRR(2, 0), h2 = TRR(2, 1), l3 = TRR(3, 0), h3 = TRR(3, 1);
#undef TRR
#define PKV(L, H) __builtin_shufflevector(L, H, 0, 1, 2, 3, 4, 5, 6, 7)
  __builtin_amdgcn_s_setprio(1);
  od = __builtin_amdgcn_mfma_f32_32x32x16_bf16(pa0, PKV(l0, h0), od, 0, 0, 0);
  od = __builtin_amdgcn_mfma_f32_32x32x16_bf16(pa1, PKV(l1, h1), od, 0, 0, 0);
  od = __builtin_amdgcn_mfma_f32_32x32x16_bf16(pa2, PKV(l2, h2), od, 0, 0, 0);
  od = __builtin_amdgcn_mfma_f32_32x32x16_bf16(pa3, PKV(l3, h3), od, 0, 0, 0);
  __builtin_amdgcn_s_setprio(0);
#undef PKV
}
DI void at_pv(f32x16* o, const char* vb, bf16x8 pa0, bf16x8 pa1, bf16x8 pa2, bf16x8 pa3) {
  at_pv_one<0>(o[0], vb, pa0, pa1, pa2, pa3); at_pv_one<1>(o[1], vb, pa0, pa1, pa2, pa3);
}

DI void attn_body(const u16* __restrict__ Qb, const u16* __restrict__ Kh, const u16* __restrict__ Vh, float* __restrict__ Ob, char* lds, int tid) {
  const int wid = tid >> 6, lane = tid & 63, r32 = lane & 31, hi = lane >> 5;
  char* V_lds = lds; char* K_lds = lds + 2 * AT_VBYTES;
  float* wsp = (float*)(lds + 2 * AT_VBYTES + 2 * AT_KBYTES) + wid * 64; float* li_l = wsp; float* al_l = wsp + 32;
  float m_reg = -1e30f, l_reg = 0.f; f32x16 o[2]; bf16x8 qr[6];
#pragma unroll
  for (int r = 0; r < 16; ++r) { o[0][r] = 0.f; o[1][r] = 0.f; }
  const u16* Qw = Qb + (size_t)(wid * 32 + r32) * 96 + hi * 8;
#pragma unroll
  for (int d0 = 0; d0 < 6; ++d0) qr[d0] = *(const bf16x8*)(Qw + d0 * 16);
  const int kid1 = (tid < 256) ? tid + 512 : tid;
  const int kst0 = ((tid / 12) * AT_KSTR + (tid % 12) * 8) * 2, kst1 = ((kid1 / 12) * AT_KSTR + (kid1 % 12) * 8) * 2;
  const int vst = v_st(tid >> 3, (tid & 7) * 8);
  const char* vb0 = V_lds + v_rd_base(lane);
  u32x4 sk0[2], sk1[2], sv0[2];
#define SLOAD(i, k0) do { sk0[i] = *(const u32x4*)(Kh + (size_t)(k0) * 96 + tid * 8); sk1[i] = *(const u32x4*)(Kh + (size_t)(k0) * 96 + kid1 * 8); \
    sv0[i] = *(const u32x4*)(Vh + (size_t)(k0) * 64 + tid * 8); } while (0)
#define SWRITE(b, i) do { *(u32x4*)(K_lds + (b) * AT_KBYTES + kst0) = sk0[i]; if (tid < 256) *(u32x4*)(K_lds + (b) * AT_KBYTES + kst1) = sk1[i]; \
    *(u32x4*)(V_lds + (b) * AT_VBYTES + vst) = sv0[i]; } while (0)
#define SWAIT() asm volatile("s_waitcnt vmcnt(3)" ::: "memory")
#define RESC(a) do { if (__any((a) < 1.f)) { if (hi == 0) al_l[r32] = (a); asm volatile("s_waitcnt lgkmcnt(0)" ::: "memory"); \
    _Pragma("unroll") for (int r = 0; r < 16; ++r) { float al = al_l[crow(r, hi)]; o[0][r] *= al; o[1][r] *= al; } } } while (0)
  f32x16 pA0, pA1, pB0, pB1; float mnA, mnB, alA, alB; bf16x8 pa0, pa1, pa2, pa3; constexpr int NT = T / 64;
  SLOAD(0, 0); SWRITE(0, 0); __syncthreads();
  at_qkt(pA0, pA1, K_lds, qr, r32, hi); at_partialSM(pA0, pA1, m_reg, mnA, alA);
  SLOAD(1, 64); SLOAD(0, 128);
  SWAIT(); SWRITE(1, 1); __syncthreads();
  for (int j = 1; j + 1 < NT; j += 2) {
    SBAR(); at_qkt(pB0, pB1, K_lds + AT_KBYTES, qr, r32, hi);
    at_finishSM(pA0, pA1, alA, l_reg, pa0, pa1, pa2, pa3); SBAR();
    SLOAD(1, (j + 2) * 64); SBAR();
    at_pv(o, vb0, pa0, pa1, pa2, pa3); at_partialSM(pB0, pB1, m_reg, mnB, alB);
    __syncthreads(); SWAIT(); SWRITE(0, 0);
    RESC(alB); __syncthreads();
    SBAR(); at_qkt(pA0, pA1, K_lds, qr, r32, hi);
    at_finishSM(pB0, pB1, alB, l_reg, pa0, pa1, pa2, pa3); SBAR();
    if (j + 3 < NT) SLOAD(0, (j + 3) * 64); SBAR();
    at_pv(o, vb0 + AT_VBYTES, pa0, pa1, pa2, pa3); at_partialSM(pA0, pA1, m_reg, mnA, alA);
    __syncthreads(); SWAIT(); SWRITE(1, 1);
    RESC(alA); __syncthreads();
  }
  SBAR(); at_qkt(pB0, pB1, K_lds + AT_KBYTES, qr, r32, hi);
  at_finishSM(pA0, pA1, alA, l_reg, pa0, pa1, pa2, pa3); SBAR();
  at_pv(o, vb0, pa0, pa1, pa2, pa3); at_partialSM(pB0, pB1, m_reg, mnB, alB);
  __syncthreads(); RESC(alB);
  at_finishSM(pB0, pB1, alB, l_reg, pa0, pa1, pa2, pa3); SBAR();
  at_pv(o, vb0 + AT_VBYTES, pa0, pa1, pa2, pa3);
  if (hi == 0) li_l[r32] = l_reg;
  asm volatile("s_waitcnt lgkmcnt(0)" ::: "memory");
  float* Ow = Ob + (size_t)(wid * 32) * 512;
#pragma unroll
  for (int r = 0; r < 16; ++r) {
    int orow = crow(r, hi); float rl = __builtin_amdgcn_rcpf(li_l[orow]);
    Ow[(size_t)orow * 512 + r32] = o[0][r] * rl; Ow[(size_t)orow * 512 + 32 + r32] = o[1][r] * rl;
  }
#undef SLOAD
#undef SWRITE
#undef SWAIT
#undef RESC
}

DI void ph_attn(const P& p, char* smem, unsigned* ctr) {
  const int tid = tidx();
  int* sitem = (int*)(smem + SMEM_BYTES - 16);
  for (;;) {
    __syncthreads();
    if (tid == 0) *sitem = (int)atomicAdd(ctr, 1u);
    __syncthreads();
    const int item = *sitem;
    if (item >= NB * NH * (T / 256)) break;
    const int bh = item / (T / 256), qb = item % (T / 256);
    const int b = bh / NH, h = bh % NH;
    attn_body(p.Q + ((size_t)bh * T + qb * 256) * 96, p.Kc + (size_t)bh * T * 96, p.Vv + (size_t)bh * T * 64,
              p.AO + ((size_t)(b * T + qb * 256)) * 512 + h * 64, smem, tid);
  }
}

constexpr int SC = 128, NCH = T / SC;
constexpr int SBUF = 5184;
template <int NI> struct ScanRegsN { float k[2 * NI], r[2 * NI], v[2 * NI]; u16 lw[2 * NI], a[2 * NI]; };
template <int NI>
DI void scan_load_n(const P& p, int b, int h, int d, int n0, int lane, int ws, ScanRegsN<NI>& g) {
  constexpr int WPI = 8 / NI;
  const u16* LWd = p.LW + (size_t)d * NTOK * RWW;
  const u16* AAd = p.AA + (size_t)d * NTOK * RWW;
  const int ch = h * 64 + lane;
#pragma unroll
  for (int jj = 0; jj < 2 * NI; ++jj) {
    int n = n0 + ws + WPI * jj; int t = d ? (T - 1 - n) : n;
    size_t off = ((size_t)(b * T + t)) * RWW + ch;
    g.k[jj] = p.K[off]; g.r[jj] = p.R[off]; g.v[jj] = p.V[off]; g.lw[jj] = LWd[off]; g.a[jj] = AAd[off];
  }
}
template <int NI>
DI void scan_put_n(const ScanRegsN<NI>& g, float kkc, float kac, float* sm, float* slw, int lane, int ws) {
  constexpr int WPI = 8 / NI;
#pragma unroll
  for (int jj = 0; jj < 2 * NI; ++jj) slw[(ws + WPI * jj) * 64 + lane] = bf2f(g.lw[jj]);
  __syncthreads();
  float Lj[2 * NI];
#pragma unroll
  for (int jj = 0; jj < 2 * NI; ++jj) Lj[jj] = 0.f;
#pragma unroll
  for (int i = 0; i < 16; ++i) {
    const float x = slw[i * 64 + lane];
#pragma unroll
    for (int jj = 0; jj < 2 * NI; ++jj) Lj[jj] += (i <= ws + WPI * jj) ? x : 0.f;
  }
#pragma unroll
  for (int jj = 0; jj < 2 * NI; ++jj) {
    const int j = ws + WPI * jj;
    const float L = Lj[jj], lwj = bf2f(g.lw[jj]);
    const float Pt = fexp(L), Pm = fexp(L - lwj), iP = fexp(-L);
    const float kv = g.k[jj];
    const float kx = kv * kkc;
    const float nrm = __builtin_amdgcn_sqrtf(wave_sum(kx * kx));
    const float kkv = kx * frcp(fmaxf(nrm, 1e-12f));
    const float a = bf2f(g.a[jj]);
    sm[j * 64 + lane] = -kkv * Pm;
    sm[1024 + j * 64 + lane] = a * kkv * iP;
    sm[2048 + j * 64 + lane] = kv * (1.f + (a - 1.f) * kac) * iP;
    sm[3072 + j * 64 + lane] = g.r[jj] * Pt;
    sm[4096 + j * 64 + lane] = g.v[jj];
    if (j == 15) sm[5120 + lane] = Pt;
  }
}
using f32x16s = __attribute__((ext_vector_type(16))) float;
DI void scan_ld8(f32x4 (&kv)[8], const float* vec, int hi) {
#pragma unroll
  for (int tk = 0; tk < 2; ++tk)
#pragma unroll
    for (int q = 0; q < 4; ++q) kv[tk * 4 + q] = *(const f32x4*)(vec + 32 * tk + 8 * q + 4 * hi);
}
DI float scan_dot8(const f32x16s (&acc)[2], const f32x4 (&kv)[8]) {
  float pq[4] = {0.f, 0.f, 0.f, 0.f};
#pragma unroll
  for (int tk = 0; tk < 2; ++tk)
#pragma unroll
    for (int e = 0; e < 4; ++e)
#pragma unroll
      for (int q = 0; q < 4; ++q) { pq[q] = __builtin_fmaf(acc[tk][4 * q + e], kv[tk * 4 + q][e], pq[q]); asm("" : "+v"(pq[q])); }
  return red_x32((pq[0] + pq[1]) + (pq[2] + pq[3]));
}

DI void ph_scan1(const P& p, int layer, char* smem) {
  constexpr int NI = 2;
  const int tid = tidx(), lane = tid & 63, w = tid >> 6;
  const int jl = lane & 31, hi = lane >> 5;
  const int it = w >> 2, vt = w & 3, ws = w & 3;
  float* smi = (float*)smem + it * (2 * SBUF + 1024);
  float* slw = smi + 2 * SBUF;
  for (int pair = blockIdx.x; pair < 32 * NCH / 2; pair += gridDim.x) {
    const int item = pair * 2 + it; const int scan = item / NCH, c = item % NCH;
    const int d = scan & 1, h = (scan >> 1) % NH, b = scan / (2 * NH);
    const float kkc = p.rw_k_k[layer * RWW + h * 64 + lane], kac = p.rw_k_a[layer * RWW + h * 64 + lane];
    f32x16s acc[2];
#pragma unroll
    for (int tk = 0; tk < 2; ++tk)
#pragma unroll
      for (int r = 0; r < 16; ++r) acc[tk][r] = (32 * tk + (r & 3) + 8 * (r >> 2) + 4 * hi == 32 * vt + jl) ? 1.f : 0.f;
    ScanRegsN<NI> g;
    scan_load_n<NI>(p, b, h, d, c * SC, lane, ws, g);
    __syncthreads();
    scan_put_n<NI>(g, kkc, kac, smi, slw, lane, ws);
    __syncthreads();
    for (int sub = 0; sub < SC / 16; ++sub) {
      const float* sm = smi + (sub & 1) * SBUF;
      if (sub + 1 < SC / 16) scan_load_n<NI>(p, b, h, d, c * SC + (sub + 1) * 16, lane, ws, g);
      const float* vrow = sm + 4096 + ((vt >= 2) ? 32 * (vt - 2) : 0) + jl;
      f32x4 kc[8]; scan_ld8(kc, sm, hi);
      float a0 = sm[1024 + hi * 1024 + jl], a1 = sm[1024 + hi * 1024 + 32 + jl], vc = vrow[0];
#pragma unroll 4
      for (int j = 0; j < 16; ++j) {
        const int jn = (j + 1) & 15;
        f32x4 kn[8]; scan_ld8(kn, sm + jn * 64, hi);
        const float an0 = sm[1024 + hi * 1024 + jn * 64 + jl], an1 = sm[1024 + hi * 1024 + jn * 64 + 32 + jl], vn = vrow[jn * 64];
        SBAR();
        const float sa = scan_dot8(acc, kc);
        const float bop = hi ? ((vt >= 2) ? vc : 0.f) : sa;
        acc[0] = __builtin_amdgcn_mfma_f32_32x32x2f32(a0, bop, acc[0], 0, 0, 0);
        acc[1] = __builtin_amdgcn_mfma_f32_32x32x2f32(a1, bop, acc[1], 0, 0, 0);
        SBAR();
#pragma unroll
        for (int i = 0; i < 8; ++i) kc[i] = kn[i];
        a0 = an0; a1 = an1; vc = vn;
      }
#pragma unroll
      for (int tk = 0; tk < 2; ++tk)
#pragma unroll
        for (int q = 0; q < 4; ++q) {
          const f32x4 pv = *(const f32x4*)(sm + 5120 + 32 * tk + 8 * q + 4 * hi);
#pragma unroll
          for (int e = 0; e < 4; ++e) acc[tk][4 * q + e] *= pv[e];
        }
      if (sub + 1 < SC / 16) scan_put_n<NI>(g, kkc, kac, smi + ((sub + 1) & 1) * SBUF, slw, lane, ws);
      __syncthreads();
    }
    {
      const int v = 32 * vt + jl;
      float* dst = ((v < 64) ? p.MC : p.NC) + (((size_t)scan * NCH + c) * 64 + (v & 63)) * 64;
#pragma unroll
      for (int tk = 0; tk < 2; ++tk)
#pragma unroll
        for (int q = 0; q < 4; ++q)
          *(f32x4*)(dst + 32 * tk + 8 * q + 4 * hi) = f32x4{acc[tk][4 * q], acc[tk][4 * q + 1], acc[tk][4 * q + 2], acc[tk][4 * q + 3]};
    }
  }
}


DI void ph_scan2(const P& p, char* smem) {
  constexpr int LS = 72;
  u16* Sh = (u16*)smem; u16* Sl = Sh + 64 * LS; u16* Mh = Sl + 64 * LS; u16* Ml = Mh + 64 * LS;
  const int tid = tidx(), lane = tid & 63, w = tid >> 6;
  const int l15 = lane & 15, lq = lane >> 4;
  const int ti = w >> 1, tj0 = (w & 1) * 2;
  for (int scan = blockIdx.x; scan < 32; scan += gridDim.x) {
    const float* Mg = p.MC + (size_t)scan * NCH * 4096;
    const float* Ng = p.NC + (size_t)scan * NCH * 4096;
    float* Sg = p.SS + (size_t)scan * NCH * 4096;
    struct MN { f32x4 m0, m1, n[2]; };
    auto ldmn = [&](MN& r, int c) {
      const int cc = (c < NCH) ? c : (NCH - 1);
      r.m0 = *(const f32x4*)(Mg + (size_t)cc * 4096 + tid * 8); r.m1 = *(const f32x4*)(Mg + (size_t)cc * 4096 + tid * 8 + 4);
#pragma unroll
      for (int q = 0; q < 2; ++q)
#pragma unroll
        for (int r4 = 0; r4 < 4; ++r4) r.n[q][r4] = Ng[(size_t)cc * 4096 + (ti * 16 + lq * 4 + r4) * 64 + (tj0 + q) * 16 + l15];
    };
    f32x4 sacc[2];
    sacc[0] = f32x4{0.f, 0.f, 0.f, 0.f}; sacc[1] = sacc[0];
    auto step = [&](int c, const MN& r) {
      __syncthreads();
#pragma unroll
      for (int q = 0; q < 2; ++q)
#pragma unroll
        for (int r4 = 0; r4 < 4; ++r4) {
          const int row = ti * 16 + lq * 4 + r4, col = (tj0 + q) * 16 + l15;
          const float x = sacc[q][r4];
          Sg[(size_t)c * 4096 + row * 64 + col] = x;
          const u16 h = f2bf(x); Sh[row * LS + col] = h; Sl[row * LS + col] = f2bf(x - bf2f(h));
        }
      {
        const int mr = tid >> 3, mc = (tid & 7) * 8;
        float xh[8], xl[8];
#pragma unroll
        for (int i = 0; i < 8; ++i) { const float x = (i < 4) ? r.m0[i & 3] : r.m1[i & 3]; const float h = bf2f(f2bf(x)); xh[i] = h; xl[i] = x - h; }
        *(u32x4*)(Mh + mr * LS + mc) = u32x4{pk2(xh[0], xh[1]), pk2(xh[2], xh[3]), pk2(xh[4], xh[5]), pk2(xh[6], xh[7])};
        *(u32x4*)(Ml + mr * LS + mc) = u32x4{pk2(xl[0], xl[1]), pk2(xl[2], xl[3]), pk2(xl[4], xl[5]), pk2(xl[6], xl[7])};
      }
      f32x4 acc[2] = {r.n[0], r.n[1]};
      __syncthreads();
#pragma unroll
      for (int ks = 0; ks < 2; ++ks) {
        const bf16x8 ah = *(const bf16x8*)(Sh + (ti * 16 + l15) * LS + ks * 32 + 8 * lq);
        const bf16x8 al = *(const bf16x8*)(Sl + (ti * 16 + l15) * LS + ks * 32 + 8 * lq);
#pragma unroll
        for (int q = 0; q < 2; ++q) {
          const int kb = ks * 32 + 8 * lq, tq = l15 >> 2, tp = l15 & 3, co = (tj0 + q) * 16 + 4 * tp;
          const bf16x8 bh = __builtin_shufflevector(tr_read((const short*)Mh + (kb + tq) * LS + co), tr_read((const short*)Mh + (kb + 4 + tq) * LS + co), 0, 1, 2, 3, 4, 5, 6, 7);
          const bf16x8 bl = __builtin_shufflevector(tr_read((const short*)Ml + (kb + tq) * LS + co), tr_read((const short*)Ml + (kb + 4 + tq) * LS + co), 0, 1, 2, 3, 4, 5, 6, 7);
          acc[q] = __builtin_amdgcn_mfma_f32_16x16x32_bf16(ah, bh, acc[q], 0, 0, 0);
          acc[q] = __builtin_amdgcn_mfma_f32_16x16x32_bf16(ah, bl, acc[q], 0, 0, 0);
          acc[q] = __builtin_amdgcn_mfma_f32_16x16x32_bf16(al, bh, acc[q], 0, 0, 0);
        }
      }
      sacc[0] = acc[0]; sacc[1] = acc[1];
    };
    MN r0, r1, r2, r3;
    ldmn(r0, 0); ldmn(r1, 1); ldmn(r2, 2);
    for (int c = 0; c < NCH; c += 4) {
      ldmn(r3, c + 3); step(c, r0);
      ldmn(r0, c + 4); step(c + 1, r1);
      ldmn(r1, c + 5); step(c + 2, r2);
      ldmn(r2, c + 6); step(c + 3, r3);
    }
    __syncthreads();
  }
}

DI void ph_scan3(const P& p, int layer, char* smem) {
  constexpr int NI = 4;
  const int tid = tidx(), lane = tid & 63, w = tid >> 6;
  const int jl = lane & 31, hi = lane >> 5;
  const int it = w >> 1, vt = w & 1, ws = w & 1;
  float* sm = (float*)smem + it * (SBUF + 2048);
  float* slw = sm + SBUF; float* so = slw + 1024;
  const float* lwp = p.rw_lnx_w + layer * RWW; const float* lbp = p.rw_lnx_b + layer * RWW; const float* rkp = p.rw_r_k + layer * RWW;
  for (int quad = blockIdx.x; quad < NB * NH * (T / 256); quad += gridDim.x) {
    const int bh = quad / (T / 256), tb = quad % (T / 256);
    const int d = it >> 1, kch = 2 * tb + (it & 1), c = d ? (NCH - 1 - kch) : kch;
    const int h = bh % NH, b = bh / NH, scan = bh * 2 + d;
    const float kkc = p.rw_k_k[layer * RWW + h * 64 + lane], kac = p.rw_k_a[layer * RWW + h * 64 + lane];
    u16* Od = p.O2 + (size_t)d * NTOK * RWW;
    f32x16s acc[2];
    {
      const float* Sg = p.SS + ((size_t)scan * NCH + c) * 4096 + (size_t)(32 * vt + jl) * 64;
#pragma unroll
      for (int tk = 0; tk < 2; ++tk)
#pragma unroll
        for (int q = 0; q < 4; ++q) {
          const f32x4 sv = *(const f32x4*)(Sg + 32 * tk + 8 * q + 4 * hi);
#pragma unroll
          for (int e = 0; e < 4; ++e) acc[tk][4 * q + e] = sv[e];
        }
    }
    ScanRegsN<NI> g;
    scan_load_n<NI>(p, b, h, d, c * SC, lane, ws, g);
    for (int sub = 0; sub < SC / 16; ++sub) {
      const int n0 = c * SC + sub * 16;
      __syncthreads();
      scan_put_n<NI>(g, kkc, kac, sm, slw, lane, ws);
      __syncthreads();
      if (sub + 1 < SC / 16) scan_load_n<NI>(p, b, h, d, n0 + 16, lane, ws, g);
      const float* vrow = sm + 4096 + 32 * vt + jl;
      f32x4 kc[8]; scan_ld8(kc, sm, hi);
      float a0 = sm[1024 + hi * 1024 + jl], a1 = sm[1024 + hi * 1024 + 32 + jl], vc = vrow[0];
#pragma unroll 4
      for (int j = 0; j < 16; ++j) {
        const int jn = (j + 1) & 15;
        f32x4 kn[8]; scan_ld8(kn, sm + jn * 64, hi);
        const float an0 = sm[1024 + hi * 1024 + jn * 64 + jl], an1 = sm[1024 + hi * 1024 + jn * 64 + 32 + jl], vn = vrow[jn * 64];
        SBAR();
        const float sa = scan_dot8(acc, kc);
        const float bop = hi ? vc : sa;
        acc[0] = __builtin_amdgcn_mfma_f32_32x32x2f32(a0, bop, acc[0], 0, 0, 0);
        acc[1] = __builtin_amdgcn_mfma_f32_32x32x2f32(a1, bop, acc[1], 0, 0, 0);
        f32x4 rc[8]; scan_ld8(rc, sm + 3072 + j * 64, hi);
        SBAR();
        const float o = scan_dot8(acc, rc);
        if (hi == 0) so[j * 64 + 32 * vt + jl] = o;
        SBAR();
#pragma unroll
        for (int i = 0; i < 8; ++i) kc[i] = kn[i];
        a0 = an0; a1 = an1; vc = vn;
      }
#pragma unroll
      for (int tk = 0; tk < 2; ++tk)
#pragma unroll
        for (int q = 0; q < 4; ++q) {
          const f32x4 pv = *(const f32x4*)(sm + 5120 + 32 * tk + 8 * q + 4 * hi);
#pragma unroll
          for (int e = 0; e < 4; ++e) acc[tk][4 * q + e] *= pv[e];
        }
      __syncthreads();
#pragma unroll
      for (int jj = 0; jj < 8; ++jj) {
        const int j = ws + 2 * jj; const int n = n0 + j; const int t = d ? (T - 1 - n) : n;
        Od[((size_t)(b * T + t)) * RWW + h * 64 + lane] = f2bf(so[j * 64 + lane]);
      }
    }
    asm volatile("s_waitcnt vmcnt(0)" ::: "memory");
    __syncthreads();
    {
      const int ch = h * 64 + lane;
      const float plw = lwp[ch], plb = lbp[ch], prk = rkp[ch];
      for (int i0 = 0; i0 < 32; i0 += 2) {
        float o[2], k[2], r[2], vv[2], a0[2], a1[2], gg[2];
#pragma unroll
        for (int u = 0; u < 2; ++u) {
          const size_t off = (size_t)(b * T + tb * 256 + w * 32 + i0 + u) * RWW + ch;
          o[u] = bf2f(p.O2[off]) + bf2f(p.O2[(size_t)NTOK * RWW + off]);
          k[u] = p.K[off]; r[u] = p.R[off]; vv[u] = p.V[off];
          a0[u] = bf2f(p.AA[off]); a1[u] = bf2f(p.AA[(size_t)NTOK * RWW + off]); gg[u] = bf2f(p.G[off]);
        }
#pragma unroll
        for (int u = 0; u < 2; ++u) {
          const float mean = wave_sum(o[u]) * (1.f / 64);
          const float dv = o[u] - mean;
          const float var = wave_sum(dv * dv) * (1.f / 64);
          const float kb = 0.5f * (k[u] * (1.f + (a0[u] - 1.f) * kac) + k[u] * (1.f + (a1[u] - 1.f) * kac));
          const float sb = wave_sum(r[u] * kb * prk);
          const float on_ = dv * frsq(var + GN_EPS) * plw + plb;
          p.H[(size_t)(b * T + tb * 256 + w * 32 + i0 + u) * DM + ch] = f2bf((on_ + sb * vv[u]) * gg[u]);
        }
      }
    }
  }
}
DI void ph_mla_norm(const P& p, int layer) {
  const int tid_ = tidx(); const int lane = tid_ & 63, w = tid_ >> 6;
  const float* on = p.mla_o_norm + layer * 512;
  const f32x4 g0 = *(const f32x4*)(on + lane * 4), g1 = *(const f32x4*)(on + 256 + lane * 4);
  for (int tok = blockIdx.x * 8 + w; tok < NTOK; tok += gridDim.x * 8) {
    const float* ao = p.AO + (size_t)tok * 512;
    const f32x4 v0 = *(const f32x4*)(ao + lane * 4), v1 = *(const f32x4*)(ao + 256 + lane * 4);
    float ss = v0[0] * v0[0] + v0[1] * v0[1] + v0[2] * v0[2] + v0[3] * v0[3] + v1[0] * v1[0] + v1[1] * v1[1] + v1[2] * v1[2] + v1[3] * v1[3];
    ss = wave_sum(ss);
    const float rstd = frsq(ss * (1.f / 512) + NORM_EPS);
    *(u32x2*)(p.H + (size_t)tok * DM + 512 + lane * 4) = u32x2{pk2(v0[0] * rstd * g0[0], v0[1] * rstd * g0[1]), pk2(v0[2] * rstd * g0[2], v0[3] * rstd * g0[3])};
    *(u32x2*)(p.H + (size_t)tok * DM + 768 + lane * 4) = u32x2{pk2(v1[0] * rstd * g1[0], v1[1] * rstd * g1[1]), pk2(v1[2] * rstd * g1[2], v1[3] * rstd * g1[3])};
  }
}


DI void ph_mixfinish(const P& p, int layer) {
  const int tid_ = tidx(); const int lane = tid_ & 63, w = tid_ >> 6;
  const float* lw = p.rw_lnx_w + layer * RWW; const float* lb = p.rw_lnx_b + layer * RWW;
  const float* kac = p.rw_k_a + layer * RWW; const float* rk = p.rw_r_k + layer * RWW;
  const float* on = p.mla_o_norm + layer * 512;
  float plw[8], plb[8], pka[8], prk[8];
#pragma unroll
  for (int h = 0; h < NH; ++h) { int c = h * 64 + lane; plw[h] = lw[c]; plb[h] = lb[c]; pka[h] = kac[c]; prk[h] = rk[c]; }
  const f32x4 g0 = *(const f32x4*)(on + lane * 4), g1 = *(const f32x4*)(on + 256 + lane * 4);
  for (int tok = blockIdx.x * 8 + w; tok < NTOK; tok += gridDim.x * 8) {
    float o[8], k[8], r[8], vv[8], a0[8], a1[8], gg[8];
#pragma unroll
    for (int h = 0; h < NH; ++h) {
      size_t off = (size_t)tok * RWW + h * 64 + lane;
      o[h] = bf2f(p.O2[off]) + bf2f(p.O2[(size_t)NTOK * RWW + off]);
      k[h] = p.K[off]; r[h] = p.R[off]; vv[h] = p.V[off];
      a0[h] = bf2f(p.AA[off]); a1[h] = bf2f(p.AA[(size_t)NTOK * RWW + off]); gg[h] = bf2f(p.G[off]);
    }
    const float* ao = p.AO + (size_t)tok * 512;
    const f32x4 v0 = *(const f32x4*)(ao + lane * 4), v1 = *(const f32x4*)(ao + 256 + lane * 4);
    float mean[8], var[8], sb[8];
#pragma unroll
    for (int h = 0; h < NH; ++h) mean[h] = wave_sum(o[h]) * (1.f / 64);
#pragma unroll
    for (int h = 0; h < NH; ++h) { float dv = o[h] - mean[h]; o[h] = dv; var[h] = wave_sum(dv * dv) * (1.f / 64); }
#pragma unroll
    for (int h = 0; h < NH; ++h) {
      float kb = 0.5f * (k[h] * (1.f + (a0[h] - 1.f) * pka[h]) + k[h] * (1.f + (a1[h] - 1.f) * pka[h]));
      sb[h] = wave_sum(r[h] * kb * prk[h]);
    }
#pragma unroll
    for (int h = 0; h < NH; ++h) {
      float on_ = o[h] * frsq(var[h] + GN_EPS) * plw[h] + plb[h];
      float y = (on_ + sb[h] * vv[h]) * gg[h];
      p.H[(size_t)tok * DM + h * 64 + lane] = f2bf(y);
    }
    float ss = v0[0] * v0[0] + v0[1] * v0[1] + v0[2] * v0[2] + v0[3] * v0[3] + v1[0] * v1[0] + v1[1] * v1[1] + v1[2] * v1[2] + v1[3] * v1[3];
    ss = wave_sum(ss);
    float rstd = frsq(ss * (1.f / 512) + NORM_EPS);
    *(u32x2*)(p.H + (size_t)tok * DM + 512 + lane * 4) = u32x2{pk2(v0[0] * rstd * g0[0], v0[1] * rstd * g0[1]), pk2(v0[2] * rstd * g0[2], v0[3] * rstd * g0[3])};
    *(u32x2*)(p.H + (size_t)tok * DM + 768 + lane * 4) = u32x2{pk2(v1[0] * rstd * g1[0], v1[1] * rstd * g1[1]), pk2(v1[2] * rstd * g1[2], v1[3] * rstd * g1[3])};
  }
}

DI void ph_norm_router(const P& p, int layer, char* smem) {
  const int tid_ = tidx(); const int lane = tid_ & 63, w = tid_ >> 6;
  float* rtl = (float*)smem;
  float* hl = (float*)(smem + 65536) + w * 1024;
  const float* g = p.ffn_norm + layer * DM;
  const float* rt = p.router + (size_t)layer * DM * NE;
  __syncthreads();
#pragma unroll
  for (int i = 0; i < 8; ++i) *(f32x4*)(rtl + (tid_ + i * NTH) * 4) = *(const f32x4*)(rt + (tid_ + i * NTH) * 4);
  __syncthreads();
  const int cg = lane >> 2, eq = lane & 3;
  for (int tok = blockIdx.x * 8 + w; tok < NTOK; tok += gridDim.x * 8) {
    const f32x4* xr = (const f32x4*)(p.out + (size_t)tok * DM);
    f32x4 v[4]; float ss = 0.f;
#pragma unroll
    for (int j = 0; j < 4; ++j) { v[j] = xr[lane + 64 * j]; ss += v[j][0] * v[j][0] + v[j][1] * v[j][1] + v[j][2] * v[j][2] + v[j][3] * v[j][3]; }
    ss = wave_sum(ss);
    const float rstd = frsq(ss * (1.f / DM) + NORM_EPS);
#pragma unroll
    for (int j = 0; j < 4; ++j) {
      const int c0 = (lane + 64 * j) * 4;
      const f32x4 gg = *(const f32x4*)(g + c0);
      const f32x4 hv = v[j] * rstd * gg;
      *(u32x2*)(p.H + (size_t)tok * DM + c0) = u32x2{pk2(hv[0], hv[1]), pk2(hv[2], hv[3])};
      *(f32x4*)(hl + c0) = hv;
    }
    f32x4 acc = f32x4{0.f, 0.f, 0.f, 0.f};
#pragma unroll 16
    for (int i = 0; i < 64; ++i) {
      const float hv = hl[cg + 16 * i];
      const f32x4 r4 = *(const f32x4*)(rtl + (cg + 16 * i) * 16 + eq * 4);
      acc += hv * r4;
    }
#pragma unroll
    for (int e = 0; e < 4; ++e) {
      float a = acc[e];
      a += dpp_f<0x124>(a); a += dpp_f<0x128>(a);
      a = red_x32(red_x16(a));
      acc[e] = a;
    }
    float mx = fmaxf(fmaxf(acc[0], acc[1]), fmaxf(acc[2], acc[3]));
    mx = fmaxf(mx, dpp_f<0xB1>(mx)); mx = fmaxf(mx, dpp_f<0x4E>(mx));
    f32x4 ex; float se = 0.f;
#pragma unroll
    for (int e = 0; e < 4; ++e) { ex[e] = fexp(acc[e] - mx); se += ex[e]; }
    se = red_x2(red_x1(se));
    const float inv = frcp(se);
    const int b = tok / T, t = tok % T;
    if (lane < 4) {
#pragma unroll
      for (int e = 0; e < 4; ++e) p.AFF[((size_t)(b * NE + eq * 4 + e)) * T + t] = ex[e] * inv;
    }
  }
}

DI void ph_topk(const P& p, char* smem) {
  unsigned* hist = (unsigned*)smem;
  unsigned* sc = hist + 256;
  unsigned* bc = sc + 2048;
  const int tid = tidx();
  for (int item = blockIdx.x; item < NB * NE; item += gridDim.x) {
    const float* a = p.AFF + (size_t)item * T;
    unsigned key[16];
#pragma unroll
    for (int i = 0; i < 4; ++i) {
      uint4 v = *(const uint4*)(a + tid * 16 + i * 4);
      key[i * 4 + 0] = v.x; key[i * 4 + 1] = v.y; key[i * 4 + 2] = v.z; key[i * 4 + 3] = v.w;
    }
    unsigned prefix = 0, mask = 0, need = CAP;
    for (int pass = 0; pass < 4; ++pass) {
      int shift = 24 - 8 * pass;
      __syncthreads();
      if (tid < 256) hist[tid] = 0;
      __syncthreads();
#pragma unroll
      for (int i = 0; i < 16; ++i)
        if ((key[i] & mask) == prefix) atomicAdd(&hist[(key[i] >> shift) & 255u], 1u);
      __syncthreads();
      if (tid == 0) {
        unsigned cum = 0; int bsel = 0; unsigned nd = need;
        for (int bb = 255; bb >= 0; --bb) {
          unsigned hc = hist[bb];
          if (cum + hc >= need) { bsel = bb; nd = need - cum; break; }
          cum += hc;
        }
        bc[0] = prefix | ((unsigned)bsel << shift); bc[1] = nd;
      }
      __syncthreads();
      prefix = bc[0]; need = bc[1]; mask |= (255u << shift);
    }
    unsigned ngt = 0, neq = 0;
#pragma unroll
    for (int i = 0; i < 16; ++i) { ngt += key[i] > prefix; neq += key[i] == prefix; }
    __syncthreads();
    unsigned* sA = sc; unsigned* sB = sc + 512; unsigned* eA = sc + 1024; unsigned* eB = sc + 1536;
    sA[tid] = ngt; eA[tid] = neq;
    __syncthreads();
    for (int off = 1; off < NTH; off <<= 1) {
      unsigned x = sA[tid] + ((tid >= off) ? sA[tid - off] : 0u);
      unsigned y = eA[tid] + ((tid >= off) ? eA[tid - off] : 0u);
      sB[tid] = x; eB[tid] = y;
      __syncthreads();
      unsigned* tmp = sA; sA = sB; sB = tmp; tmp = eA; eA = eB; eB = tmp;
    }
    unsigned gt_excl = sA[tid] - ngt, eq_excl = eA[tid] - neq;
    unsigned gt_total = sA[NTH - 1];
    int* idx = p.IDX + (size_t)item * CAP; float* gate = p.GATE + (size_t)item * CAP;
#pragma unroll
    for (int i = 0; i < 16; ++i) {
      int slot = -1;
      if (key[i] > prefix) { slot = (int)gt_excl; ++gt_excl; }
      else if (key[i] == prefix) { if (eq_excl < need) slot = (int)(gt_total + eq_excl); ++eq_excl; }
      if (slot >= 0) {
        const int tokl = tid * 16 + i;
        idx[slot] = tokl; gate[slot] = __uint_as_float(key[i]);
        const int tokg = (item / NE) * T + tokl;
        const int pos = atomicAdd(&p.TCNT[tokg], 1);
        p.TLIST[(size_t)tokg * 16 + pos] = item * CAP + slot;
      }
    }
    __syncthreads();
  }
}

DI void ph_exp1(const P& p, int layer, char* smem) {
  for (int t = blockIdx.x; t < 32 * 4 * 16; t += gridDim.x) {
    int grp = t / 64, r = t % 64, tm = r / 16, tn = r % 16;
    int b = grp / NE, e = grp % NE;
    const int* gi = p.IDX + (size_t)grp * CAP + tm * GBM;
    const u16* Hb = p.H + (size_t)b * T * DM;
    const float* Wg = p.exp_w_gate + ((size_t)layer * NE + e) * DM * 1024;
    const float* Wu = p.exp_w_up + ((size_t)layer * NE + e) * DM * 1024;
    u16* hid = p.HID + ((size_t)grp * CAP + tm * GBM) * 1024;
    auto arow = [&](int row) -> const void* { return Hb + (size_t)gi[row] * DM; };
    gemm_tile<false, 1>(arow, Wg, Wu, 1024, DM, tn * 64, 1024, smem, [&](int row, int col, float g, float u) {
      float sv = g * frcp(1.f + fexp(-g));
      hid[(size_t)row * 1024 + col] = f2bf(sv * u);
    });
    __syncthreads();
  }
}
DI void ph_exp2(const P& p, int layer, char* smem) {
  for (int t = blockIdx.x; t < 32 * 4 * 8; t += gridDim.x) {
    int grp = t / 32, r = t % 32, tm = r / 8, tn = r % 8;
    int b = grp / NE, e = grp % NE;
    const int* gi = p.IDX + (size_t)grp * CAP + tm * GBM;
    const float* gt = p.GATE + (size_t)grp * CAP + tm * GBM;
    const u16* hid = p.HID + ((size_t)grp * CAP + tm * GBM) * 1024;
    const float* Wd = p.exp_w_down + ((size_t)layer * NE + e) * 1024 * DM;
    float* xb = p.out + (size_t)b * T * DM;
    auto arow = [&](int row) -> const void* { return hid + (size_t)row * 1024; };
    gemm_tile<false, 0>(arow, Wd, nullptr, DM, 1024, tn * GBN, DM, smem, [&](int row, int col, float v, float) {
      unsafeAtomicAdd(xb + (size_t)gi[row] * DM + col, v * gt[row]);
    });
    __syncthreads();
  }
}

namespace g8 {
constexpr int BM = 256, BK = 64, HALF = 128, HTB = HALF * BK * 2, STAGE_BYTES = 8 * HTB, NXCD = 8, WGM = 8;
DI int lds_byte(int r, int c) { const int st = (r >> 4) * 2 + (c >> 5), rr = r & 15, cc = c & 31, ob = rr * 64 + cc * 2; return st * 1024 + (ob ^ (((ob >> 9) & 1) << 5)); }
DI void stage_rc(int b, int& R, int& C) { const int st = b / 1024, sb = b % 1024, swz = sb ^ (((sb >> 9) & 1) << 5); R = (st >> 1) * 16 + swz / 64; C = (st & 1) * 32 + (swz % 64) / 2; }
DI int perm32(int rho) { const int n = rho >> 4, i = rho & 15; return 8 * (i >> 2) + 4 * n + (i & 3); }
struct Unit { int pm, pn; };
struct Sched {
  int nM, nN, nwg, G, c;
  const char* A; const char* Bt; size_t a_tstep, b_tstep; int gdiv, gmod; size_t gstride;
  DI void init(int nM_, int nN_, int G_, int c_, const void* A_, const void* Bt_, int K) {
    nM = nM_; nN = nN_; nwg = nM * nN; G = G_; c = c_; A = (const char*)uni_ptr(A_); Bt = (const char*)uni_ptr(Bt_);
    a_tstep = (size_t)BM * K * 2; b_tstep = (size_t)BM * K * 2; gdiv = 1 << 30; gmod = 1; gstride = 0;
  }
  DI void group(int gdiv_, int gmod_, size_t gstride_) { gdiv = gdiv_; gmod = gmod_; gstride = gstride_; }
  DI bool next(int i, Unit& u) const {
    const long L = (long)i * G + c; if (L >= nwg) return false;
    int wgid = (int)L; { const int q = nwg / NXCD, r = nwg % NXCD, xcd = wgid % NXCD, off = wgid / NXCD; wgid = (xcd < r ? xcd * (q + 1) : r * (q + 1) + (xcd - r) * q) + off; }
    const int nig = WGM * nN, gid = wgid / nig, fm = gid * WGM, gsz = (nM - fm) < WGM ? (nM - fm) : WGM;
    u.pm = fm + ((wgid % nig) % gsz); u.pn = (wgid % nig) / gsz; return true;
  }
  DI const char* a_ptr(const Unit& u) const { return A + (size_t)u.pm * a_tstep; }
  DI const char* b_ptr(const Unit& u) const { return Bt + (size_t)((u.pm / gdiv) % gmod) * gstride + (size_t)u.pn * b_tstep; }
};
using Acc = f32x4[2][2][4][2];

template <class Epi>
DI void gemm_phase(LAS unsigned char* lds, const int K, const Sched& S, const Epi& E) {
  const int tid = tidx(), wid = __builtin_amdgcn_readfirstlane(tid >> 6), lane = tid & 63, wr = wid >> 2, wc = wid & 3, fr = lane & 15, fq = lane >> 4;
  const int nt = K / BK;
  unsigned voffA[2], voffB[2];
#pragma unroll
  for (int i = 0; i < 2; ++i) { int R, C; stage_rc(tid * 16 + i * 8192, R, C); const int Rb = Epi::PERM ? ((R & ~31) + perm32(R & 31)) : R;
    voffA[i] = (unsigned)(R * K + C) * 2u; voffB[i] = (unsigned)(Rb * K + C) * 2u; }
  const size_t kstep = (size_t)(BK * 2);
  const size_t hstep = (size_t)HALF * K * 2;
  const unsigned ldsw = (unsigned)wid * 1024u;
  const int aoff = lds_byte(wr * 64 + fr, fq * 8), boff = lds_byte(wc * 32 + fr, fq * 8);
#define G8_SA(b, h) (((b) * 2 + (h)) * HTB)
#define G8_SB(b, h) ((4 + (b) * 2 + (h)) * HTB)
#define G8_STAGE(bufoff, gbase, voff) do { _Pragma("unroll") for (int _i = 0; _i < 2; ++_i) \
    __builtin_amdgcn_global_load_lds((const unsigned*)((const char*)(gbase) + (voff)[_i]), (LAS unsigned*)(lds + (bufoff) + ldsw + _i * 8192), 16, 0, 0); } while (0)
#define G8_LDA(dst, b, h) do { _Pragma("unroll") for (int m = 0; m < 4; ++m) _Pragma("unroll") for (int k = 0; k < 2; ++k) dst[m][k] = *(const LAS bf16x8*)(lds + G8_SA(b, h) + aoff + m * 2048 + k * 1024); } while (0)
#define G8_LDB(dst, b, h) do { _Pragma("unroll") for (int n = 0; n < 2; ++n) _Pragma("unroll") for (int k = 0; k < 2; ++k) dst[n][k] = *(const LAS bf16x8*)(lds + G8_SB(b, h) + boff + n * 2048 + k * 1024); } while (0)
#define G8_MMA(ai, bj, At, Bt) do { __builtin_amdgcn_s_setprio(1); _Pragma("unroll") for (int m = 0; m < 4; ++m) _Pragma("unroll") for (int n = 0; n < 2; ++n) _Pragma("unroll") for (int k = 0; k < 2; ++k) \
    acc[ai][bj][m][n] = __builtin_amdgcn_mfma_f32_16x16x32_bf16(Bt[n][k], At[m][k], acc[ai][bj][m][n], 0, 0, 0); __builtin_amdgcn_s_setprio(0); } while (0)
#define G8_WAIT_V(n) asm volatile("s_waitcnt vmcnt(" #n ")" ::: "memory")
#define G8_WAIT_L(n) asm volatile("s_waitcnt lgkmcnt(" #n ")" ::: "memory")
#define G8_BAR __builtin_amdgcn_s_barrier()
#define G8_SCHED __builtin_amdgcn_sched_barrier(0)
  Unit cur, nxt; int ui = 0;
  if (!S.next(0, cur)) return;
  f32x4 acc[2][2][4][2];
#pragma unroll
  for (int a = 0; a < 2; ++a)
#pragma unroll
    for (int b = 0; b < 2; ++b)
#pragma unroll
      for (int m = 0; m < 4; ++m)
#pragma unroll
        for (int n = 0; n < 2; ++n) acc[a][b][m][n] = (f32x4){0.f, 0.f, 0.f, 0.f};
  bf16x8 At[4][2], B0[2][2], B1[2][2];
  const char* cA = S.a_ptr(cur); const char* cB = S.b_ptr(cur);
  G8_STAGE(G8_SB(0, 0), cB, voffB); G8_STAGE(G8_SA(0, 0), cA, voffA); G8_STAGE(G8_SB(0, 1), cB + hstep, voffB); G8_STAGE(G8_SA(0, 1), cA + hstep, voffA);
  if (wr == 1) G8_BAR;
  G8_WAIT_V(4); G8_BAR;
  G8_STAGE(G8_SB(1, 0), cB + kstep, voffB); G8_STAGE(G8_SA(1, 0), cA + kstep, voffA); G8_STAGE(G8_SB(1, 1), cB + hstep + kstep, voffB);
  G8_WAIT_V(6); G8_BAR;
  for (;;) {
    const bool has_next = S.next(ui + 1, nxt);
    const char* nA = has_next ? S.a_ptr(nxt) : cA; const char* nB = has_next ? S.b_ptr(nxt) : cB;
    for (int t = 0; t < nt; t += 2) {
      const bool last = (t == nt - 2);
      const char* a1 = cA + (size_t)(t + 1) * kstep;
      const char* a2 = last ? nA : cA + (size_t)(t + 2) * kstep; const char* b2 = last ? nB : cB + (size_t)(t + 2) * kstep;
      const char* a3 = a2 + kstep; const char* b3 = b2 + kstep;
      G8_LDB(B0, 0, 0); G8_SCHED; G8_LDA(At, 0, 0); G8_STAGE(G8_SA(1, 1), a1 + hstep, voffA);
      G8_WAIT_L(8); G8_BAR; G8_WAIT_L(0); G8_MMA(0, 0, At, B0); G8_BAR; G8_SCHED;
      G8_LDB(B1, 0, 1); G8_STAGE(G8_SB(0, 0), b2, voffB);
      G8_BAR; G8_WAIT_L(0); G8_MMA(0, 1, At, B1); G8_BAR;
      G8_LDA(At, 0, 1); G8_STAGE(G8_SA(0, 0), a2, voffA);
      G8_BAR; G8_WAIT_L(0); G8_MMA(1, 0, At, B0); G8_BAR; G8_SCHED;
      G8_STAGE(G8_SB(0, 1), b2 + hstep, voffB);
      G8_WAIT_V(6); G8_BAR; G8_MMA(1, 1, At, B1); G8_BAR;
      G8_LDB(B0, 1, 0); G8_SCHED; G8_LDA(At, 1, 0); G8_STAGE(G8_SA(0, 1), a2 + hstep, voffA);
      G8_WAIT_L(8); G8_BAR; G8_WAIT_L(0); G8_MMA(0, 0, At, B0); G8_BAR; G8_SCHED;
      G8_LDB(B1, 1, 1); G8_STAGE(G8_SB(1, 0), b3, voffB);
      G8_BAR; G8_WAIT_L(0); G8_MMA(0, 1, At, B1); G8_BAR;
      G8_LDA(At, 1, 1); G8_STAGE(G8_SA(1, 0), a3, voffA);
      G8_BAR; G8_WAIT_L(0); G8_MMA(1, 0, At, B0); G8_BAR; G8_SCHED;
      G8_STAGE(G8_SB(1, 1), b3 + hstep, voffB);
      G8_WAIT_V(6); G8_BAR; G8_MMA(1, 1, At, B1); G8_BAR;
    }
    {
      const int t2 = tidx(); const int w2 = __builtin_amdgcn_readfirstlane(t2 >> 6), l2 = t2 & 63;
      E(acc, cur, w2 >> 2, w2 & 3, l2 & 15, l2 >> 4);
    }
    if (!has_next) break;
#pragma unroll
    for (int a = 0; a < 2; ++a)
#pragma unroll
      for (int b = 0; b < 2; ++b)
#pragma unroll
        for (int m = 0; m < 4; ++m)
#pragma unroll
          for (int n = 0; n < 2; ++n) acc[a][b][m][n] = (f32x4){0.f, 0.f, 0.f, 0.f};
    cur = nxt; cA = nA; cB = nB; ++ui;
  }
  G8_WAIT_V(0);
  if (wr == 0) G8_BAR;
  G8_BAR;
#undef G8_SA
#undef G8_SB
#undef G8_STAGE
#undef G8_LDA
#undef G8_LDB
#undef G8_MMA
#undef G8_WAIT_V
#undef G8_WAIT_L
#undef G8_BAR
#undef G8_SCHED
}

struct EpiZ {
  static constexpr bool PERM = false; float* Z;
  DI void operator()(const Acc& acc, const Unit& u, int wr, int wc, int fr, int fq) const {
    const int row0 = u.pm * BM + wr * 64 + fr, col0 = u.pn * BM + wc * 32 + 4 * fq;
#pragma unroll
    for (int ai = 0; ai < 2; ++ai)
#pragma unroll
      for (int m = 0; m < 4; ++m) { float* rowp = Z + (size_t)(row0 + ai * HALF + m * 16) * INC;
#pragma unroll
        for (int bj = 0; bj < 2; ++bj)
#pragma unroll
          for (int n = 0; n < 2; ++n) { const int col = col0 + bj * HALF + n * 16; if (col < INC) *(f32x4*)(rowp + col) = acc[ai][bj][m][n]; } }
  }
};
struct EpiRes {
  static constexpr bool PERM = false; const float* xs; float* xo;
  DI void operator()(const Acc& acc, const Unit& u, int wr, int wc, int fr, int fq) const {
    const int row0 = u.pm * BM + wr * 64 + fr, col0 = u.pn * BM + wc * 32 + 4 * fq;
#pragma unroll
    for (int ai = 0; ai < 2; ++ai)
#pragma unroll
      for (int m = 0; m < 4; ++m) { const size_t ro = (size_t)(row0 + ai * HALF + m * 16) * DM + col0;
#pragma unroll
        for (int bj = 0; bj < 2; ++bj)
#pragma unroll
          for (int n = 0; n < 2; ++n) { const size_t o = ro + bj * HALF + n * 16; *(f32x4*)(xo + o) = *(const f32x4*)(xs + o) + acc[ai][bj][m][n]; } }
  }
};
struct EpiSig {
  static constexpr bool PERM = true; u16* PG;
  DI void operator()(const Acc& acc, const Unit& u, int wr, int wc, int fr, int fq) const {
    const int row0 = u.pm * BM + wr * 64 + fr, col0 = u.pn * BM + wc * 32 + 8 * fq;
#pragma unroll
    for (int ai = 0; ai < 2; ++ai)
#pragma unroll
      for (int m = 0; m < 4; ++m) { u16* rowp = PG + (size_t)(row0 + ai * HALF + m * 16) * DM + col0;
#pragma unroll
        for (int bj = 0; bj < 2; ++bj) { const f32x4 v0 = acc[ai][bj][m][0], v1 = acc[ai][bj][m][1];
          u32x4 wv = {pk2(sigmoidf_(v0[0]), sigmoidf_(v0[1])), pk2(sigmoidf_(v0[2]), sigmoidf_(v0[3])), pk2(sigmoidf_(v1[0]), sigmoidf_(v1[1])), pk2(sigmoidf_(v1[2]), sigmoidf_(v1[3]))};
          *(u32x4*)(rowp + bj * HALF) = wv; } }
  }
};
struct EpiPle {
  static constexpr bool PERM = false; float* xo; const u16* PG;
  DI void operator()(const Acc& acc, const Unit& u, int wr, int wc, int fr, int fq) const {
    const int row0 = u.pm * BM + wr * 64 + fr, col0 = u.pn * BM + wc * 32 + 4 * fq;
#pragma unroll
    for (int ai = 0; ai < 2; ++ai)
#pragma unroll
      for (int m = 0; m < 4; ++m) { const size_t ro = (size_t)(row0 + ai * HALF + m * 16) * DM + col0;
#pragma unroll
        for (int bj = 0; bj < 2; ++bj)
#pragma unroll
          for (int n = 0; n < 2; ++n) { const size_t o = ro + bj * HALF + n * 16; const u32x2 g = *(const u32x2*)(PG + o);
            f32x4 gv = {__uint_as_float(g[0] << 16), __uint_as_float(g[0] & 0xffff0000u), __uint_as_float(g[1] << 16), __uint_as_float(g[1] & 0xffff0000u)};
            *(f32x4*)(xo + o) = *(const f32x4*)(xo + o) + acc[ai][bj][m][n] * gv; } }
  }
};
struct EpiSwi {
  static constexpr bool PERM = true; u16* HID;
  DI void operator()(const Acc& acc, const Unit& u, int wr, int wc, int fr, int fq) const {
    const int row0 = u.pm * BM + wr * 64 + fr, col0 = u.pn * HALF + wc * 32 + 8 * fq;
#pragma unroll
    for (int ai = 0; ai < 2; ++ai)
#pragma unroll
      for (int m = 0; m < 4; ++m) { u16* rowp = HID + (size_t)(row0 + ai * HALF + m * 16) * 1024 + col0;
        float h[8];
#pragma unroll
        for (int n = 0; n < 2; ++n)
#pragma unroll
          for (int j = 0; j < 4; ++j) { const float gt = acc[ai][0][m][n][j], up = acc[ai][1][m][n][j]; h[n * 4 + j] = gt * frcp(1.f + fexp(-gt)) * up; }
        *(u32x4*)rowp = u32x4{pk2(h[0], h[1]), pk2(h[2], h[3]), pk2(h[4], h[5]), pk2(h[6], h[7])}; }
  }
};
struct EpiYE {
  static constexpr bool PERM = true; u16* YE; const float* GATE;
  DI void operator()(const Acc& acc, const Unit& u, int wr, int wc, int fr, int fq) const {
    const int row0 = u.pm * BM + wr * 64 + fr, col0 = u.pn * BM + wc * 32 + 8 * fq;
#pragma unroll
    for (int ai = 0; ai < 2; ++ai)
#pragma unroll
      for (int m = 0; m < 4; ++m) { const int row = row0 + ai * HALF + m * 16; const float gt = GATE[row]; u16* rowp = YE + (size_t)row * 1024 + col0;
#pragma unroll
        for (int bj = 0; bj < 2; ++bj) { const f32x4 v0 = acc[ai][bj][m][0] * gt, v1 = acc[ai][bj][m][1] * gt;
          *(u32x4*)(rowp + bj * HALF) = u32x4{pk2(v0[0], v0[1]), pk2(v0[2], v0[3]), pk2(v1[0], v1[1]), pk2(v1[2], v1[3])}; } }
  }
};
}

DI void cvt_tile_T(const float* __restrict__ src, int ldsrc, int N, int K, u16* __restrict__ dst, int k0, int n0, int drow0, char* smem, int tid) {
  short* tl = (short*)smem;
  __syncthreads();
#pragma unroll
  for (int i = 0; i < 2; ++i) {
    int u = tid + i * NTH; int kr = u >> 4, nq = u & 15; int n = n0 + nq * 4;
    f32x4 v = f32x4{0.f, 0.f, 0.f, 0.f};
    if (n < N) v = *(const f32x4*)(src + (size_t)(k0 + kr) * ldsrc + n);
#pragma unroll
    for (int e = 0; e < 4; ++e) tl[(nq * 4 + e) * 72 + kr] = (short)f2bf(v[e]);
  }
  __syncthreads();
  { int n = tid >> 3, kc = tid & 7;
    *(u32x4*)(dst + (size_t)(drow0 + n) * K + k0 + kc * 8) = *(const u32x4*)(tl + n * 72 + kc * 8); }
}
constexpr int WIN_PAD = 2560;
DI void ph_cvt_small(const P& p, int layer, char* smem) {
  const int tid = tidx();
  const int t0 = 16 * 40, t1 = t0 + 256, t2 = t1 + 256, t3 = t2 + 64;
  for (int t = blockIdx.x; t < t3; t += gridDim.x) {
    if (t < t0) cvt_tile_T(p.w_in + (size_t)layer * DM * INC, INC, INC, DM, p.WIN, (t / 40) * 64, (t % 40) * 64, (t % 40) * 64, smem, tid);
    else if (t < t1) { int q = t - t0; cvt_tile_T(p.w_out + (size_t)layer * DM * DM, DM, DM, DM, p.WOUT, (q / 16) * 64, (q % 16) * 64, (q % 16) * 64, smem, tid); }
    else if (t < t2) { int q = t - t1; cvt_tile_T(p.ple_gate + (size_t)layer * DM * DM, DM, DM, DM, p.WPG, (q / 16) * 64, (q % 16) * 64, (q % 16) * 64, smem, tid); }
    else { int q = t - t2; cvt_tile_T(p.ple_proj + (size_t)layer * DPLE * DM, DM, DM, DPLE, p.WPP, (q / 16) * 64, (q % 16) * 64, (q % 16) * 64, smem, tid); }
  }
  const float* ps = p.p + (size_t)layer * NTOK * DPLE;
  for (int i = blockIdx.x * NTH + tid; i < NTOK * DPLE / 8; i += gridDim.x * NTH) {
    f32x4 a = *(const f32x4*)(ps + (size_t)i * 8), b = *(const f32x4*)(ps + (size_t)i * 8 + 4);
    *(u32x4*)(p.PB + (size_t)i * 8) = u32x4{pk2(a[0], a[1]), pk2(a[2], a[3]), pk2(b[0], b[1]), pk2(b[2], b[3])};
  }
}

struct CvtJob { const float* src; u16* dst; int k0, n0, drow0; };
DI bool cvt_job(const P& p, int layer, int t, CvtJob& j) {
  if (t >= NE * 3 * 128) return false;
  const int e = t / 384, r = t % 384, mat = r / 128, q = r % 128;
  j.k0 = (q / 8) * 64; j.n0 = (q % 8) * 128;
  const size_t eo = ((size_t)layer * NE + e) * 1024 * 1024;
  if (mat == 0) { j.src = p.exp_w_gate + eo; j.dst = p.EW1 + (size_t)e * 2048 * 1024; j.drow0 = (j.n0 >> 7) * 256; }
  else if (mat == 1) { j.src = p.exp_w_up + eo; j.dst = p.EW1 + (size_t)e * 2048 * 1024; j.drow0 = (j.n0 >> 7) * 256 + 128; }
  else { j.src = p.exp_w_down + eo; j.dst = p.EW2 + (size_t)e * 1024 * 1024; j.drow0 = j.n0; }
  return true;
}
DI void ph_cvt_experts(const P& p, int layer, char* smem, unsigned* ctr) {
  const int tid = tidx();
  short* tl = (short*)smem;
  int* sitem = (int*)(smem + 32768);
  __syncthreads();
  if (tid == 0) sitem[0] = (int)atomicAdd(ctr, 1u);
  __syncthreads();
  CvtJob cur; bool has = cvt_job(p, layer, sitem[0], cur);
  f32x4 v[4];
  const int kr = tid >> 5, nq = tid & 31;
  if (has) {
#pragma unroll
    for (int i = 0; i < 4; ++i) v[i] = *(const f32x4*)(cur.src + (size_t)(cur.k0 + kr + 16 * i) * 1024 + cur.n0 + nq * 4);
  }
  int par = 0;
  while (has) {
    if (tid == 0) sitem[1 + par] = (int)atomicAdd(ctr, 1u);
    __syncthreads();
#pragma unroll
    for (int i = 0; i < 4; ++i)
#pragma unroll
      for (int e = 0; e < 4; ++e) tl[(nq * 4 + e) * 72 + kr + 16 * i] = (short)f2bf(v[i][e]);
    __syncthreads();
    CvtJob nxt; const bool hn = cvt_job(p, layer, sitem[1 + par], nxt);
    if (hn) {
#pragma unroll
      for (int i = 0; i < 4; ++i) v[i] = *(const f32x4*)(nxt.src + (size_t)(nxt.k0 + kr + 16 * i) * 1024 + nxt.n0 + nq * 4);
    }
#pragma unroll
    for (int i = 0; i < 2; ++i) {
      int u = tid + i * NTH; int n = u >> 3, kc = u & 7;
      *(u32x4*)(cur.dst + (size_t)(cur.drow0 + n) * 1024 + cur.k0 + kc * 8) = *(const u32x4*)(tl + n * 72 + kc * 8);
    }
    cur = nxt; has = hn; par ^= 1;
  }
}
DI void ph_gather(const P& p) {
  const int tid_ = tidx(); const int lane = tid_ & 63, w = tid_ >> 6;
  for (int row = blockIdx.x * 8 + w; row < NB * NE * CAP; row += gridDim.x * 8) {
    const int b = row / (NE * CAP);
    const int tok = b * T + p.IDX[row];
    const u32x4* src = (const u32x4*)(p.H + (size_t)tok * DM);
    u32x4* dst = (u32x4*)(p.XE + (size_t)row * DM);
    u32x4 a = src[lane], c = src[lane + 64];
    dst[lane] = a; dst[lane + 64] = c;
  }
}
DI void ph_combine_norm(const P& p, int layer) {
  const int tid_ = tidx(); const int lane = tid_ & 63, w = tid_ >> 6;
  const float* g = p.ple_norm + layer * DM;
  for (int tok = blockIdx.x * 8 + w; tok < NTOK; tok += gridDim.x * 8) {
    f32x4* xr = (f32x4*)(p.out + (size_t)tok * DM);
    f32x4 v[4];
#pragma unroll
    for (int j = 0; j < 4; ++j) v[j] = xr[lane * 4 + j];
    const int cnt = p.TCNT[tok];
    for (int q = 0; q < cnt; ++q) {
      const int yrow = p.TLIST[(size_t)tok * 16 + q];
      const u32x4* yr = (const u32x4*)(p.YE + (size_t)yrow * DM + lane * 16);
      u32x4 a = yr[0], c = yr[1];
#pragma unroll
      for (int e = 0; e < 4; ++e) {
        v[e >> 1][(e & 1) * 2] += __uint_as_float(a[e] << 16); v[e >> 1][(e & 1) * 2 + 1] += __uint_as_float(a[e] & 0xffff0000u);
        v[2 + (e >> 1)][(e & 1) * 2] += __uint_as_float(c[e] << 16); v[2 + (e >> 1)][(e & 1) * 2 + 1] += __uint_as_float(c[e] & 0xffff0000u);
      }
    }
    float ss = 0.f;
#pragma unroll
    for (int j = 0; j < 4; ++j) { xr[lane * 4 + j] = v[j]; ss += v[j][0] * v[j][0] + v[j][1] * v[j][1] + v[j][2] * v[j][2] + v[j][3] * v[j][3]; }
    ss = wave_sum(ss);
    const float rstd = frsq(ss * (1.f / DM) + NORM_EPS);
    u32x4 o0, o1;
#pragma unroll
    for (int j = 0; j < 4; ++j) {
      f32x4 gg = *(const f32x4*)(g + lane * 16 + j * 4);
      unsigned lo = pk2(v[j][0] * rstd * gg[0], v[j][1] * rstd * gg[1]), hi = pk2(v[j][2] * rstd * gg[2], v[j][3] * rstd * gg[3]);
      if (j < 2) { o0[j * 2] = lo; o0[j * 2 + 1] = hi; } else { o1[(j - 2) * 2] = lo; o1[(j - 2) * 2 + 1] = hi; }
    }
    *(u32x4*)(p.H + (size_t)tok * DM + lane * 16) = o0; *(u32x4*)(p.H + (size_t)tok * DM + lane * 16 + 8) = o1;
  }
}

#define XB_TMO      128
#define XB_XCNT(j)  (256  + 64 * (j))
#define XB_XSUB(j)  (1280 + 64 * (j))
#define XB_XGEN(j)  (2304 + 64 * (j))
#define XB_TOP      3328
#define XB_TOPGEN   3392
#define XCD_BAR_WORDS 3456
#define XB_SPIN_CAP (1u << 20)
DI unsigned xb_ld(unsigned* p) { return __hip_atomic_load(p, __ATOMIC_RELAXED, __HIP_MEMORY_SCOPE_AGENT); }
DI unsigned xb_add(unsigned* p, unsigned v) { return __hip_atomic_fetch_add(p, v, __ATOMIC_RELAXED, __HIP_MEMORY_SCOPE_AGENT); }
DI unsigned xb_xcc_id() { return (unsigned)__builtin_amdgcn_s_getreg((3 << 11) | 20) & 0xFu; }
#define XB_SPIN(cond, bar) do { unsigned _sp = 0; while (cond) { __builtin_amdgcn_s_sleep(1); \
    if ((++_sp & 255u) == 0u) { if (xb_ld(&(bar)[XB_TMO])) break; if (_sp > XB_SPIN_CAP) { atomicAdd(&(bar)[XB_TMO], 1u); break; } } } } while (0)
struct XcdBarrier { unsigned* bar; unsigned x; volatile LAS unsigned* st; };
DI XcdBarrier xcd_barrier_post(unsigned* bar, volatile LAS unsigned* st) {
  XcdBarrier b; b.bar = bar; b.x = xb_xcc_id(); b.st = st;
  if (threadIdx.x == 0) (void)xb_add(&bar[XB_XCNT(b.x)], 1u);
  return b;
}
DI void xcd_barrier_complete(unsigned* bar, unsigned x, unsigned& nloc, unsigned& nx) {
  const unsigned G = gridDim.x * gridDim.y * gridDim.z;
  unsigned sum, cnt, mine, sp = 0u;
  for (;;) {
    sum = 0u; cnt = 0u; mine = 0u;
#pragma unroll
    for (unsigned j = 0; j < 16; ++j) { const unsigned c = xb_ld(&bar[XB_XCNT(j)]); sum += c; cnt += (c > 0u) ? 1u : 0u; mine = (j == x) ? c : mine; }
    if (sum == G) break;
    __builtin_amdgcn_s_sleep(1);
    if ((++sp & 255u) == 0u) { if (xb_ld(&bar[XB_TMO])) break; if (sp > XB_SPIN_CAP) { atomicAdd(&bar[XB_TMO], 1u); break; } }
  }
  nloc = mine > 0u ? mine : 1u; nx = cnt > 0u ? cnt : 1u;
}
DI void xcd_barrier(const XcdBarrier& b) {
  asm volatile("s_waitcnt vmcnt(0)" ::: "memory");
  __syncthreads();
  if (threadIdx.x == 0) {
    unsigned* bar = b.bar;
    __builtin_amdgcn_s_waitcnt(0);
    unsigned nloc = b.st[0], nx = b.st[1];
    if (nloc == 0u) { xcd_barrier_complete(bar, b.x, nloc, nx); b.st[0] = nloc; b.st[1] = nx; }
    const unsigned old = xb_add(&bar[XB_XSUB(b.x)], 1u);
    const unsigned gen = old / nloc;
    if (old + 1u == (gen + 1u) * nloc) {
      __builtin_amdgcn_fence(__ATOMIC_RELEASE, "agent");
      asm volatile("s_waitcnt vmcnt(0)" ::: "memory");
      const unsigned og = xb_add(&bar[XB_TOP], 1u);
      const unsigned tg = og / nx;
      if (og + 1u == (tg + 1u) * nx) xb_add(&bar[XB_TOPGEN], 1u);
      else XB_SPIN(xb_ld(&bar[XB_TOPGEN]) == tg, bar);
      __builtin_amdgcn_fence(__ATOMIC_ACQUIRE, "agent");
      xb_add(&bar[XB_XGEN(b.x)], 1u);
      asm volatile("s_waitcnt vmcnt(0)" ::: "memory");
    } else {
      XB_SPIN(xb_ld(&bar[XB_XGEN(b.x)]) == gen, bar);
      __builtin_amdgcn_fence(__ATOMIC_ACQUIRE, "agent");
      asm volatile("s_waitcnt vmcnt(0)" ::: "memory");
    }
  }
  __syncthreads();
}

#define TAKE(bytes) (ws + off); off += (((size_t)(bytes)) + 255) & ~(size_t)255
__host__ __device__ inline size_t fill_ws(P& p, char* ws) {
  size_t off = 0;
  char* regA = TAKE((size_t)NTOK * INC * 4);
  p.Z = (float*)regA;
  p.LW = (u16*)regA; p.AA = (u16*)(regA + (size_t)2 * NTOK * RWW * 2); p.G = (u16*)(regA + (size_t)4 * NTOK * RWW * 2);
  p.MC = (float*)(regA + (size_t)5 * NTOK * RWW * 2); p.NC = p.MC + (size_t)32 * NCH * 4096;
  p.HID = (u16*)regA;
  char* regB = TAKE((size_t)3 * NTOK * RWW * 4);
  p.R = (float*)regB; p.K = p.R + (size_t)NTOK * RWW; p.V = p.K + (size_t)NTOK * RWW;
  p.PG = (float*)regB;
  char* regC = TAKE((size_t)NTOK * (768 + 1024) * 4);
  p.QRAW = (float*)regC; p.KVRAW = p.QRAW + (size_t)NTOK * 768;
  p.AO = (float*)regC; p.O2 = (u16*)(p.AO + (size_t)NTOK * 512); p.SS = (float*)(p.O2 + (size_t)2 * NTOK * 512);
  p.TWD = (u16*)TAKE((size_t)2 * NTOK * 64 * 2); p.AD = (u16*)TAKE((size_t)2 * NTOK * 64 * 2);
  p.SGD = (u16*)TAKE((size_t)NTOK * 128 * 2); p.QDN = (u16*)TAKE((size_t)NTOK * 256 * 2);
  p.KVDN = (u16*)TAKE((size_t)NTOK * 128 * 2); p.KR = (float*)TAKE((size_t)NTOK * 32 * 4);
  p.ROPE = (float*)TAKE((size_t)NTOK * 32 * 4);
  p.Q = (u16*)TAKE((size_t)NTOK * NH * 96 * 2); p.Kc = (u16*)TAKE((size_t)NTOK * NH * 96 * 2);
  p.Vv = (u16*)TAKE((size_t)NTOK * NH * 64 * 2);
  p.H = (u16*)TAKE((size_t)NTOK * DM * 2);
  p.AFF = (float*)TAKE((size_t)NB * NE * T * 4);
  p.IDX = (int*)TAKE((size_t)NB * NE * CAP * 4);
  p.GATE = (float*)TAKE((size_t)NB * NE * CAP * 4);

  p.WIN = (u16*)TAKE((size_t)WIN_PAD * DM * 2); p.WOUT = (u16*)TAKE((size_t)DM * DM * 2); p.WPG = (u16*)TAKE((size_t)DM * DM * 2);
  p.WPP = (u16*)TAKE((size_t)DM * DPLE * 2); p.PB = (u16*)TAKE((size_t)NTOK * DPLE * 2);
  p.PGb = (u16*)regB;
  p.EW1 = (u16*)regB; p.EW2 = p.EW1 + (size_t)NE * 2048 * 1024;
  p.XE = (u16*)regA; p.HID = (u16*)(regA + (size_t)32 * 1024 * 1024 * 2);
  p.YE = (u16*)regC;
  p.TCNT = (int*)TAKE((size_t)NTOK * 4); p.TLIST = (int*)TAKE((size_t)NTOK * 16 * 4);
  p.CTR = (unsigned*)TAKE(256);
  p.BAR = (unsigned*)TAKE(XCD_BAR_WORDS * 4);
  return off;
}
#undef TAKE
constexpr int DSM_BYTES = g8::STAGE_BYTES + 64;
extern __shared__ __attribute__((aligned(16))) char dsm[];
struct PK { const void* in[31]; float* out; char* ws; };
DI void build_params(P& p, const PK& k) {
  p.x = (const float*)k.in[0]; p.p = (const float*)k.in[1]; p.pos = (const int*)k.in[2];
  p.attn_norm = (const float*)k.in[3]; p.w_in = (const float*)k.in[4]; p.rw_mu = (const float*)k.in[5];
  p.rw_w0 = (const float*)k.in[6]; p.rw_w_up = (const float*)k.in[7]; p.rw_a0 = (const float*)k.in[8];
  p.rw_a_up = (const float*)k.in[9]; p.rw_g_up = (const float*)k.in[10]; p.rw_k_k = (const float*)k.in[11];
  p.rw_k_a = (const float*)k.in[12]; p.rw_r_k = (const float*)k.in[13]; p.rw_lnx_w = (const float*)k.in[14];
  p.rw_lnx_b = (const float*)k.in[15]; p.mla_q_norm = (const float*)k.in[16]; p.mla_q_up = (const float*)k.in[17];
  p.mla_kv_norm = (const float*)k.in[18]; p.mla_kv_up = (const float*)k.in[19]; p.mla_o_norm = (const float*)k.in[20];
  p.w_out = (const float*)k.in[21]; p.ffn_norm = (const float*)k.in[22]; p.router = (const float*)k.in[23];
  p.exp_w_gate = (const float*)k.in[24]; p.exp_w_up = (const float*)k.in[25]; p.exp_w_down = (const float*)k.in[26];
  p.ple_norm = (const float*)k.in[27]; p.ple_proj = (const float*)k.in[28]; p.ple_gate = (const float*)k.in[29];
  p.final_norm = (const float*)k.in[30];
  p.out = k.out;
  (void)fill_ws(p, k.ws);
}
__global__ void __launch_bounds__(NTH) mega(PK pk) {
  P p; build_params(p, pk);
  char* smem = dsm;
  LAS unsigned char* glds = (LAS unsigned char*)dsm;
  uint4* xbw = (uint4*)(dsm + g8::STAGE_BYTES);
  cg::grid_group grid = cg::this_grid();
  if (threadIdx.x == 0) *xbw = make_uint4(0u, 0u, 0u, 0u);
  if (blockIdx.x == 0) {
    if (threadIdx.x < 16) p.CTR[threadIdx.x] = 0u;
    for (int i = threadIdx.x; i < XCD_BAR_WORDS; i += NTH) p.BAR[i] = 0u;
  }
  grid.sync();
  const XcdBarrier xb = xcd_barrier_post(p.BAR, (volatile LAS unsigned*)xbw);
#define GSYNC() xcd_barrier(xb)
#ifndef PROBE_MASK
#define PROBE_MASK 0u
#endif
#if PROBE_MASK
  unsigned long long pt0 = __builtin_amdgcn_s_memrealtime();
#define PSYNC(id) do { GSYNC(); if (PROBE_MASK & (1u << (id))) { unsigned long long t1_ = __builtin_amdgcn_s_memrealtime(); unsigned long long dt_ = t1_ - pt0; \
    while (__builtin_amdgcn_s_memrealtime() - t1_ < dt_) __builtin_amdgcn_s_sleep(8); } pt0 = __builtin_amdgcn_s_memrealtime(); } while (0)
#else
#define PSYNC(id) GSYNC()
#endif
  for (int layer_ = 0; layer_ < NL; ++layer_) {
    int layer = layer_; asm volatile("" : "+s"(layer));
    if (layer_ == 0) ph_rope_table(p);
    ph_cvt_small(p, layer, smem);
    ph_norm(layer == 0 ? p.x : p.out, p.attn_norm + layer * DM, p.H);
    PSYNC(0);
    {
      g8::Sched S; S.init(NTOK / 256, WIN_PAD / 256, gridDim.x, bidx(), p.H, p.WIN, DM);
      g8::EpiZ E{p.Z};
      g8::gemm_phase(glds, DM, S, E);
    }
    PSYNC(1);
    ph_rwshift(p, layer);
    ph_mlaprep1(p, layer);
    PSYNC(2);
    for (int d = 0; d < 2; ++d) {
      u16* LW = p.LW + (size_t)d * NTOK * RWW; const float* w0 = p.rw_w0 + (layer * 2 + d) * RWW;
      ph_gemm<false>(p.TWD + (size_t)d * NTOK * 64, 64, p.rw_w_up + ((size_t)(layer * 2 + d)) * 64 * RWW, RWW, NTOK, RWW, 64, smem,
                     [&](int row, int col, float v) { LW[(size_t)row * RWW + col] = f2bf(-0.6065306597126334f * sigmoidf_(v + w0[col])); });
      u16* AA = p.AA + (size_t)d * NTOK * RWW; const float* a0 = p.rw_a0 + (layer * 2 + d) * RWW;
      ph_gemm<false>(p.AD + (size_t)d * NTOK * 64, 64, p.rw_a_up + ((size_t)(layer * 2 + d)) * 64 * RWW, RWW, NTOK, RWW, 64, smem,
                     [&](int row, int col, float v) { AA[(size_t)row * RWW + col] = f2bf(sigmoidf_(v + a0[col])); });
    }
    {
      u16* G = p.G;
      ph_gemm<false>(p.SGD, 128, p.rw_g_up + (size_t)layer * 128 * RWW, RWW, NTOK, RWW, 128, smem,
                     [&](int row, int col, float v) { G[(size_t)row * RWW + col] = f2bf(v); });
      {
        u16* Qo = p.Q; const float* rope = p.ROPE;
        ph_gemm_t(p.QDN, 256, p.mla_q_up + (size_t)layer * 256 * 768, 768, NTOK, 768, 256, smem,
                  [&](const f32x4 (&acc)[4][4], int m0, int n0, int wm, int wn, int lq, int l15) {
          const float qs = 0.10206207261596577f * 1.4426950408889634f;
#pragma unroll
          for (int mi = 0; mi < 4; ++mi)
#pragma unroll
            for (int r = 0; r < 4; ++r) {
              const int tok = m0 + wm * 64 + mi * 16 + lq * 4 + r; const int b = tok / T, t = tok % T;
#pragma unroll
              for (int ni = 0; ni < 4; ++ni) {
                const int col0 = n0 + wn * 64 + ni * 16; const int h = col0 / 96, c0 = col0 % 96;
                u16* qo = Qo + ((size_t)(b * NH + h) * T + t) * 96;
                if (c0 < 64) qo[c0 + l15] = f2bf(acc[mi][ni][r] * qs);
                else if (c0 == 64) {
                  const f32x2 csn = *(const f32x2*)(rope + (size_t)tok * 32 + l15 * 2);
                  const float u1 = acc[mi][ni][r], u2 = acc[mi][(ni + 1) & 3][r];
                  qo[64 + l15] = f2bf((u1 * csn[0] - u2 * csn[1]) * qs);
                  qo[80 + l15] = f2bf((u1 * csn[1] + u2 * csn[0]) * qs);
                }
              }
            }
        });
      }
      {
        u16* Ko = p.Kc; u16* Vo = p.Vv;
        ph_gemm_t(p.KVDN, 128, p.mla_kv_up + (size_t)layer * 128 * 1024, 1024, NTOK, 1024, 128, smem,
                  [&](const f32x4 (&acc)[4][4], int m0, int n0, int wm, int wn, int lq, int l15) {
#pragma unroll
          for (int mi = 0; mi < 4; ++mi)
#pragma unroll
            for (int r = 0; r < 4; ++r) {
              const int tok = m0 + wm * 64 + mi * 16 + lq * 4 + r; const int b = tok / T, t = tok % T;
#pragma unroll
              for (int ni = 0; ni < 4; ++ni) {
                const int col0 = n0 + wn * 64 + ni * 16; const int h = col0 >> 7, c0 = col0 & 127;
                const size_t rowi = (size_t)(b * NH + h) * T + t;
                if (c0 < 64) Ko[rowi * 96 + c0 + l15] = f2bf(acc[mi][ni][r]);
                else Vo[rowi * 64 + (c0 - 64) + l15] = f2bf(acc[mi][ni][r]);
              }
            }
        });
      }
    }
    PSYNC(3);
    ph_scan1(p, layer, smem);
    PSYNC(4);
    ph_scan2(p, smem);
    ph_attn(p, smem, p.CTR + layer);
    PSYNC(5);
    ph_mla_norm(p, layer);
    ph_scan3(p, layer, smem);
    PSYNC(6);
    {
      for (int i = blockIdx.x * NTH + tidx(); i < NTOK; i += gridDim.x * NTH) p.TCNT[i] = 0;
      g8::Sched S; S.init(NTOK / 256, DM / 256, gridDim.x, bidx(), p.H, p.WOUT, DM);
      g8::EpiRes E{(layer == 0) ? p.x : p.out, p.out};
      g8::gemm_phase(glds, DM, S, E);
    }
    PSYNC(8);
    ph_norm_router(p, layer, smem);
    PSYNC(9);
    ph_topk(p, smem);
    ph_cvt_experts(p, layer, smem, p.CTR + 4 + layer);
    PSYNC(10);
    ph_gather(p);
    PSYNC(11);
    {
      g8::Sched S; S.init(NB * NE * CAP / 256, 2048 / 256, gridDim.x, bidx(), p.XE, p.EW1, DM);
      S.group(4, NE, (size_t)2048 * 1024 * 2);
      g8::EpiSwi E{p.HID};
      g8::gemm_phase(glds, DM, S, E);
    }
    PSYNC(12);
    {
      g8::Sched S; S.init(NB * NE * CAP / 256, DM / 256, gridDim.x, bidx(), p.HID, p.EW2, 1024);
      S.group(4, NE, (size_t)1024 * 1024 * 2);
      g8::EpiYE E{p.YE, p.GATE};
      g8::gemm_phase(glds, 1024, S, E);
    }
    PSYNC(13);
    ph_combine_norm(p, layer);
    PSYNC(16);
    {
      g8::Sched S; S.init(NTOK / 256, DM / 256, gridDim.x, bidx(), p.H, p.WPG, DM);
      g8::EpiSig E{p.PGb};
      g8::gemm_phase(glds, DM, S, E);
    }
    {
      g8::Sched S; S.init(NTOK / 256, DM / 256, gridDim.x, bidx(), p.PB, p.WPP, DPLE);
      g8::EpiPle E{p.out, p.PGb};
      g8::gemm_phase(glds, DPLE, S, E);
    }
    PSYNC(15);
  }
  ph_final_norm(p.out, p.final_norm);
}

extern "C" void kernel_launch(void* const* d_in, const int* in_sizes, int n_in, void* d_out, int out_size, void* d_ws,
                              size_t ws_size, hipStream_t stream) {
  (void)in_sizes; (void)n_in; (void)out_size;
  PK pk{};
  for (int i = 0; i < 31; ++i) pk.in[i] = d_in[i];
  pk.out = (float*)d_out; pk.ws = (char*)d_ws;
  P p{};
  const size_t off = fill_ws(p, (char*)d_ws);
  if (off > ws_size) { fprintf(stderr, "workspace too small: need %zu have %zu\n", off, ws_size); return; }
  static int grid_blocks = 0;
  if (!grid_blocks) {
    int dev = 0, cus = 0, per_cu = 0;
    hipGetDevice(&dev);
    hipDeviceGetAttribute(&cus, hipDeviceAttributeMultiprocessorCount, dev);
    hipFuncSetAttribute((const void*)mega, hipFuncAttributeMaxDynamicSharedMemorySize, DSM_BYTES);
    hipOccupancyMaxActiveBlocksPerMultiprocessor(&per_cu, mega, NTH, DSM_BYTES);
    if (per_cu > 1) per_cu = 1;
    grid_blocks = cus * per_cu;
  }
  void* args[] = {&pk};
  hipError_t e = hipLaunchCooperativeKernel((void*)mega, dim3(grid_blocks), dim3(NTH), args, DSM_BYTES, stream);
  if (e != hipSuccess) fprintf(stderr, "cooperative launch failed: %s (grid %d)\n", hipGetErrorString(e), grid_blocks);
}
```

```cpp
#include <hip/hip_runtime.h>
#include <hip/hip_bf16.h>
#include <cstdio>
#include <cstdint>
#include <hip/hip_cooperative_groups.h>
namespace cg = cooperative_groups;

#define DI __device__ __forceinline__
#define LAS __attribute__((address_space(3)))

constexpr int NB = 2, T = 8192, NTOK = NB * T, DM = 1024, NL = 2;
constexpr int RWW = 512, RWC = 1920, INC = 2336;
constexpr int NH = 8;
constexpr int NE = 16, CAP = 1024;
constexpr int DPLE = 256;
constexpr int NTH = 512;
constexpr float NORM_EPS = 1e-6f, GN_EPS = 64e-5f;

using bf16x8 = __attribute__((ext_vector_type(8))) short;
using s16x4  = __attribute__((ext_vector_type(4))) short;
using f32x4  = __attribute__((ext_vector_type(4))) float;
using u32x4  = __attribute__((ext_vector_type(4))) unsigned;
using f32x2  = __attribute__((ext_vector_type(2))) float;
using u32x2  = __attribute__((ext_vector_type(2))) unsigned;
typedef __bf16 bf2_t __attribute__((ext_vector_type(2)));
typedef unsigned short u16;

DI unsigned pk2(float a, float b) { bf2_t v = {(__bf16)a, (__bf16)b}; return __builtin_bit_cast(unsigned, v); }
DI u16 f2bf(float a) { return (u16)(pk2(a, 0.f) & 0xffffu); }
DI float bf2f(u16 u) { return __uint_as_float(((unsigned)u) << 16); }
DI const void* uni_ptr(const void* q) {
  unsigned long long v = (unsigned long long)q;
  unsigned lo = __builtin_amdgcn_readfirstlane((unsigned)v), hi = __builtin_amdgcn_readfirstlane((unsigned)(v >> 32));
  return (const void*)(((unsigned long long)hi << 32) | lo);
}
DI int tidx() { int t = threadIdx.x; asm volatile("" : "+v"(t)); return t; }
DI int bidx() { int b = blockIdx.x; asm volatile("" : "+s"(b)); return b; }
template <int CTRL> DI float dpp_f(float v) {
  return __int_as_float(__builtin_amdgcn_update_dpp(__float_as_int(v), __float_as_int(v), CTRL, 0xF, 0xF, true));
}
DI float red_x1(float v) { return v + dpp_f<0xB1>(v); }
DI float red_x2(float v) { return v + dpp_f<0x4E>(v); }
DI float red_x4(float v) { return v + dpp_f<0x141>(v); }
DI float red_x8(float v) { return v + dpp_f<0x140>(v); }
DI float red_x16(float v) { auto r = __builtin_amdgcn_permlane16_swap(__float_as_uint(v), __float_as_uint(v), false, false); return __uint_as_float(r[0]) + __uint_as_float(r[1]); }
DI float red_x32(float v) { auto r = __builtin_amdgcn_permlane32_swap(__float_as_uint(v), __float_as_uint(v), false, false); return __uint_as_float(r[0]) + __uint_as_float(r[1]); }
DI float red16(float v) { return red_x8(red_x4(red_x2(red_x1(v)))); }
DI float wave_sum(float v) { return red_x32(red_x16(red16(v))); }
DI float frcp(float x) { return __builtin_amdgcn_rcpf(x); }
DI float frsq(float x) { return __builtin_amdgcn_rsqf(x); }
DI float fexp(float x) { return __builtin_amdgcn_exp2f(x * 1.4426950408889634f); }
DI float sigmoidf_(float x) { return frcp(1.f + fexp(-x)); }
DI float ftanh(float x) { return 1.f - 2.f * frcp(1.f + fexp(2.f * x)); }
DI s16x4 tr_read(const short* p) {
  return __builtin_amdgcn_ds_read_tr16_b64_v4i16((LAS s16x4*)(p));
}

struct P {
  const float* x; const float* p; const int* pos;
  const float* attn_norm; const float* w_in; const float* rw_mu; const float* rw_w0; const float* rw_w_up;
  const float* rw_a0; const float* rw_a_up; const float* rw_g_up; const float* rw_k_k; const float* rw_k_a;
  const float* rw_r_k; const float* rw_lnx_w; const float* rw_lnx_b; const float* mla_q_norm; const float* mla_q_up;
  const float* mla_kv_norm; const float* mla_kv_up; const float* mla_o_norm; const float* w_out; const float* ffn_norm;
  const float* router; const float* exp_w_gate; const float* exp_w_up; const float* exp_w_down; const float* ple_norm;
  const float* ple_proj; const float* ple_gate; const float* final_norm;
  float* out;
  float* Z;
  u16* LW;
  u16* AA;
  float* MC; float* NC;
  float* SS;
  u16*   G;
  u16*   HID;
  float* R; float* K; float* V;
  float* PG;
  float* QRAW;
  float* KVRAW;
  float* AO;
  u16* O2;
  u16* TWD; u16* AD; u16* SGD; u16* QDN; u16* KVDN; float* KR;
  float* ROPE;
  u16* Q; u16* Kc; u16* Vv;
  u16* H;
  float* AFF;
  int* IDX;
  float* GATE;
  u16* WIN; u16* WOUT; u16* WPG; u16* WPP; u16* PB;
  u16* PGb;
  u16* EW1; u16* EW2;
  u16* XE; u16* YE;
  int* TCNT; int* TLIST;
  unsigned* CTR;
  unsigned* BAR;
};

constexpr int GBM = 256, GBN = 128, GBK = 64;
constexpr int AS_STRIDE = 72, BS_STRIDE = 136;
constexpr int AS_BYTES = GBM * AS_STRIDE * 2;
constexpr int BS_BYTES = GBK * BS_STRIDE * 2;
constexpr int SMEM_BYTES = 57344;

template <bool A_F32, int MODE, class ARow, class Epi>
DI void gemm_tile(ARow arow, const float* __restrict__ B, const float* __restrict__ B2, int ldb, int K, int n0, int Nvalid,
                  char* smem, Epi epi) {
  short* As = (short*)smem;
  short* Bs = (short*)(smem + AS_BYTES);
  const int tid = tidx(), lane = tid & 63, w = tid >> 6;
  const int wm = w >> 1, wn = w & 1;
  const int l15 = lane & 15, lq = lane >> 4;

  const char* ap[4];
#pragma unroll
  for (int i = 0; i < 4; ++i) {
    int u = tid + i * NTH; int row = u >> 3, kc = u & 7;
    ap[i] = (const char*)arow(row) + (size_t)kc * 8 * (A_F32 ? 4 : 2);
  }
  const float* bp[4]; bool bok[4];
#pragma unroll
  for (int i = 0; i < 4; ++i) {
    int u = tid + i * NTH; int k = u >> 5, nq = u & 31;
    int col; const float* base;
    if (MODE != 1) { col = n0 + nq * 4; base = B; }
    else { col = n0 + (nq & 15) * 4; base = (nq < 16) ? B : B2; }
    bok[i] = col < Nvalid;
    bp[i] = base + (size_t)k * ldb + (bok[i] ? col : 0);
  }

  f32x4 acc[4][4];
#pragma unroll
  for (int i = 0; i < 4; ++i)
#pragma unroll
    for (int j = 0; j < 4; ++j) acc[i][j] = f32x4{0.f, 0.f, 0.f, 0.f};

  u32x4 areg[4]; f32x4 breg[4];
#define GLOAD(kt_)                                                                                   \
  {                                                                                                  \
    _Pragma("unroll") for (int i = 0; i < 4; ++i) {                                                  \
      if (A_F32) {                                                                                   \
        const float4* q = (const float4*)(ap[i] + (size_t)(kt_) * GBK * 4);                          \
        float4 v0 = q[0], v1 = q[1];                                                                 \
        areg[i] = u32x4{pk2(v0.x, v0.y), pk2(v0.z, v0.w), pk2(v1.x, v1.y), pk2(v1.z, v1.w)};         \
      } else {                                                                                       \
        areg[i] = *(const u32x4*)(ap[i] + (size_t)(kt_) * GBK * 2);                                  \
      }                                                                                              \
    }                                                                                                \
    _Pragma("unroll") for (int i = 0; i < 4; ++i) {                                                  \
      if (bok[i]) breg[i] = *(const f32x4*)(bp[i] + (size_t)(kt_) * GBK * ldb);                      \
      else breg[i] = f32x4{0.f, 0.f, 0.f, 0.f};                                                      \
    }                                                                                                \
  }
  const int nk = K / GBK;
  GLOAD(0)
  for (int kt = 0; kt < nk; ++kt) {
    __syncthreads();
#pragma unroll
    for (int i = 0; i < 4; ++i) {
      int u = tid + i * NTH; int row = u >> 3, kc = u & 7;
      *(u32x4*)(As + row * AS_STRIDE + kc * 8) = areg[i];
    }
#pragma unroll
    for (int i = 0; i < 4; ++i) {
      int u = tid + i * NTH; int k = u >> 5, nq = u & 31;
      u32x2 v = u32x2{pk2(breg[i][0], breg[i][1]), pk2(breg[i][2], breg[i][3])};
      *(u32x2*)(Bs + k * BS_STRIDE + nq * 4) = v;
    }
    __syncthreads();
    if (kt + 1 < nk) GLOAD(kt + 1)
#pragma unroll
    for (int ks = 0; ks < 2; ++ks) {
      bf16x8 a[4], b[4];
#pragma unroll
      for (int mi = 0; mi < 4; ++mi)
        a[mi] = *(const bf16x8*)(As + (wm * 64 + mi * 16 + l15) * AS_STRIDE + ks * 32 + 8 * lq);
#pragma unroll
      for (int ni = 0; ni < 4; ++ni) {
        int col0 = (MODE != 1) ? (wn * 64 + ni * 16) : ((ni < 2) ? (wn * 32 + ni * 16) : (64 + wn * 32 + (ni - 2) * 16));
        int kb = ks * 32 + 8 * lq; int q = l15 >> 2, pp = l15 & 3;
        s16x4 lo = tr_read(Bs + (kb + q) * BS_STRIDE + col0 + 4 * pp);
        s16x4 hi = tr_read(Bs + (kb + 4 + q) * BS_STRIDE + col0 + 4 * pp);
        b[ni] = __builtin_shufflevector(lo, hi, 0, 1, 2, 3, 4, 5, 6, 7);
      }
#pragma unroll
      for (int mi = 0; mi < 4; ++mi)
#pragma unroll
        for (int ni = 0; ni < 4; ++ni)
          acc[mi][ni] = __builtin_amdgcn_mfma_f32_16x16x32_bf16(a[mi], b[ni], acc[mi][ni], 0, 0, 0);
    }
  }
  if constexpr (MODE == 2) { epi(acc, wm, wn, lq, l15); return; }
  else {
#pragma unroll
  for (int mi = 0; mi < 4; ++mi)
#pragma unroll
    for (int r = 0; r < 4; ++r) {
      int row = wm * 64 + mi * 16 + lq * 4 + r;
      if (MODE == 0) {
#pragma unroll
        for (int ni = 0; ni < 4; ++ni) {
          int col = n0 + wn * 64 + ni * 16 + l15;
          if (col < Nvalid) epi(row, col, acc[mi][ni][r], 0.f);
        }
      } else {
#pragma unroll
        for (int ni = 0; ni < 2; ++ni) {
          int col = n0 + wn * 32 + ni * 16 + l15;
          epi(row, col, acc[mi][ni][r], acc[mi][ni + 2][r]);
        }
      }
    }
  }
}

DI void ph_norm(const float* __restrict__ X, const float* __restrict__ g, u16* __restrict__ Hout) {
  const int tid_ = tidx(); const int lane = tid_ & 63, w = tid_ >> 6;
  for (int tok = blockIdx.x * 8 + w; tok < NTOK; tok += gridDim.x * 8) {
    const float4* xr = (const float4*)(X + (size_t)tok * DM);
    float4 v[4]; float ss = 0.f;
#pragma unroll
    for (int j = 0; j < 4; ++j) { v[j] = xr[lane + 64 * j]; ss += v[j].x * v[j].x + v[j].y * v[j].y + v[j].z * v[j].z + v[j].w * v[j].w; }
    ss = wave_sum(ss);
    float rstd = frsq(ss * (1.f / DM) + NORM_EPS);
#pragma unroll
    for (int j = 0; j < 4; ++j) {
      float4 gg = ((const float4*)g)[lane + 64 * j];
      uint2 o = uint2{pk2(v[j].x * rstd * gg.x, v[j].y * rstd * gg.y), pk2(v[j].z * rstd * gg.z, v[j].w * rstd * gg.w)};
      *(uint2*)(Hout + (size_t)tok * DM + (lane + 64 * j) * 4) = o;
    }
  }
}

DI void ph_final_norm(float* __restrict__ X, const float* __restrict__ g) {
  const int tid_ = tidx(); const int lane = tid_ & 63, w = tid_ >> 6;
  for (int tok = blockIdx.x * 8 + w; tok < NTOK; tok += gridDim.x * 8) {
    float4* xr = (float4*)(X + (size_t)tok * DM);
    float4 v[4]; float ss = 0.f;
#pragma unroll
    for (int j = 0; j < 4; ++j) { v[j] = xr[lane + 64 * j]; ss += v[j].x * v[j].x + v[j].y * v[j].y + v[j].z * v[j].z + v[j].w * v[j].w; }
    ss = wave_sum(ss);
    float rstd = frsq(ss * (1.f / DM) + NORM_EPS);
#pragma unroll
    for (int j = 0; j < 4; ++j) {
      float4 gg = ((const float4*)g)[lane + 64 * j];
      xr[lane + 64 * j] = float4{v[j].x * rstd * gg.x, v[j].y * rstd * gg.y, v[j].z * rstd * gg.z, v[j].w * rstd * gg.w};
    }
  }
}

template <bool A_F32, class Epi>
DI void ph_gemm(const void* A, int lda, const float* B, int ldb, int M, int N, int K, char* smem, Epi epi) {
  const int ntn = (N + GBN - 1) / GBN, ntm = M / GBM;
  for (int t = blockIdx.x; t < ntm * ntn; t += gridDim.x) {
    int tm = t / ntn, tn = t % ntn;
    int m0 = tm * GBM, n0 = tn * GBN;
    auto arow = [&](int r) -> const void* { return (const char*)A + (size_t)(m0 + r) * lda * (A_F32 ? 4 : 2); };
    gemm_tile<A_F32, 0>(arow, B, nullptr, ldb, K, n0, N, smem, [&](int row, int col, float v, float) { epi(m0 + row, col, v); });
    __syncthreads();
  }
}

template <class Epi>
DI void ph_gemm_t(const void* A, int lda, const float* B, int ldb, int M, int N, int K, char* smem, Epi epi) {
  const int ntn = (N + GBN - 1) / GBN, ntm = M / GBM;
  for (int t = blockIdx.x; t < ntm * ntn; t += gridDim.x) {
    int tm = t / ntn, tn = t % ntn;
    int m0 = tm * GBM, n0 = tn * GBN;
    auto arow = [&](int r) -> const void* { return (const char*)A + (size_t)(m0 + r) * lda * 2; };
    gemm_tile<false, 2>(arow, B, nullptr, ldb, K, n0, N, smem,
                        [&](const f32x4 (&acc)[4][4], int wm, int wn, int lq, int l15) { epi(acc, m0, n0, wm, wn, lq, l15); });
    __syncthreads();
  }
}

DI void ph_rwshift(const P& p, int layer) {
  const float* mu = p.rw_mu + layer * RWC;
  const int total = NTOK * (RWC / 4);
  const int tid_ = tidx();
  for (int i = blockIdx.x * NTH + tid_; i < total; i += gridDim.x * NTH) {
    int tok = i / (RWC / 4), c = (i % (RWC / 4)) * 4;
    int t = tok % T;
    const float* zr = p.Z + (size_t)tok * INC + c;
    float4 z = *(const float4*)zr;
    float4 zm = (t > 0) ? *(const float4*)(zr - INC) : float4{0.f, 0.f, 0.f, 0.f};
    float4 zp = (t < T - 1) ? *(const float4*)(zr + INC) : float4{0.f, 0.f, 0.f, 0.f};
    float4 m = *(const float4*)(mu + c);
    float4 o;
    o.x = z.x + m.x * (0.5f * (zm.x + zp.x) - z.x);
    o.y = z.y + m.y * (0.5f * (zm.y + zp.y) - z.y);
    o.z = z.z + m.z * (0.5f * (zm.z + zp.z) - z.z);
    o.w = z.w + m.w * (0.5f * (zm.w + zp.w) - z.w);
    if (c < 512) *(float4*)(p.R + (size_t)tok * RWW + c) = o;
    else if (c < 1024) *(float4*)(p.K + (size_t)tok * RWW + (c - 512)) = o;
    else if (c < 1536) *(float4*)(p.V + (size_t)tok * RWW + (c - 1024)) = o;
    else if (c < 1664) {
      int d = (c - 1536) >> 6, l = (c - 1536) & 63;
      *(uint2*)(p.TWD + ((size_t)d * NTOK + tok) * 64 + l) = uint2{pk2(ftanh(o.x), ftanh(o.y)), pk2(ftanh(o.z), ftanh(o.w))};
    } else if (c < 1792) {
      int d = (c - 1664) >> 6, l = (c - 1664) & 63;
      *(uint2*)(p.AD + ((size_t)d * NTOK + tok) * 64 + l) = uint2{pk2(o.x, o.y), pk2(o.z, o.w)};
    } else {
      int l = c - 1792;
      *(uint2*)(p.SGD + (size_t)tok * 128 + l) = uint2{pk2(sigmoidf_(o.x), sigmoidf_(o.y)), pk2(sigmoidf_(o.z), sigmoidf_(o.w))};
    }
  }
}

DI void rope_cs(int pos, int i, float& cs, float& sn) {
  const int i3 = i & 3, i2 = i >> 2;
  const float c4 = (i3 == 0) ? 1.0f : (i3 == 1) ? 0.5623413251903491f : (i3 == 2) ? 0.31622776601683794f : 0.1778279410038923f;
  const float p10 = (i2 == 0) ? 1.0f : (i2 == 1) ? 0.1f : (i2 == 2) ? 0.01f : 0.001f;
  float inv = c4 * p10;
  float ang = (float)pos * inv;
  double rev = (double)ang * 0.15915494309189535;
  rev -= floor(rev);
  float rf = (float)rev;
  sn = __builtin_amdgcn_sinf(rf);
  cs = __builtin_amdgcn_cosf(rf);
}

DI void ph_rope_table(const P& p) {
  for (int i = blockIdx.x * NTH + tidx(); i < NTOK * 16; i += gridDim.x * NTH) {
    float cs, sn; rope_cs(p.pos[i >> 4], i & 15, cs, sn);
    *(f32x2*)(p.ROPE + (size_t)i * 2) = f32x2{cs, sn};
  }
}
DI void ph_mlaprep1(const P& p, int layer) {
  const int tid_ = tidx(); const int lane = tid_ & 63, w = tid_ >> 6;
  const float* qn = p.mla_q_norm + layer * 256;
  const float* kvn = p.mla_kv_norm + layer * 128;
  for (int tok = blockIdx.x * 8 + w; tok < NTOK; tok += gridDim.x * 8) {
    const float* zr = p.Z + (size_t)tok * INC + RWC;
    float4 q = *(const float4*)(zr + lane * 4);
    float ss = wave_sum(q.x * q.x + q.y * q.y + q.z * q.z + q.w * q.w);
    float rstd = frsq(ss * (1.f / 256) + NORM_EPS);
    float4 g = *(const float4*)(qn + lane * 4);
    *(uint2*)(p.QDN + (size_t)tok * 256 + lane * 4) = uint2{pk2(q.x * rstd * g.x, q.y * rstd * g.y), pk2(q.z * rstd * g.z, q.w * rstd * g.w)};
    float2 kv = *(const float2*)(zr + 256 + lane * 2);
    float ss2 = wave_sum(kv.x * kv.x + kv.y * kv.y);
    float rstd2 = frsq(ss2 * (1.f / 128) + NORM_EPS);
    float2 g2 = *(const float2*)(kvn + lane * 2);
    *(unsigned*)(p.KVDN + (size_t)tok * 128 + lane * 2) = pk2(kv.x * rstd2 * g2.x, kv.y * rstd2 * g2.y);
    if (lane < 16) {
      float u1 = zr[384 + lane], u2 = zr[384 + 16 + lane];
      const f32x2 csn = *(const f32x2*)(p.ROPE + (size_t)tok * 32 + lane * 2);
      const u16 k1 = f2bf(u1 * csn[0] - u2 * csn[1]), k2 = f2bf(u1 * csn[1] + u2 * csn[0]);
      const int bb = tok / T, tt = tok % T;
#pragma unroll
      for (int h = 0; h < NH; ++h) {
        u16* ko = p.Kc + ((size_t)(bb * NH + h) * T + tt) * 96 + 64;
        ko[lane] = k1; ko[16 + lane] = k2;
      }
    }
  }
}

DI void ph_mlafinish(const P& p) {
  const int tid_ = tidx(); const int lane = tid_ & 63, w = tid_ >> 6;
  const float qs = 0.10206207261596577f * 1.4426950408889634f;
  for (int tok = blockIdx.x * 8 + w; tok < NTOK; tok += gridDim.x * 8) {
    int b = tok / T, t = tok % T;
    float cs = 0.f, sn = 0.f;
    if (lane < 16) rope_cs(p.pos[tok], lane, cs, sn);
    const float* qr = p.QRAW + (size_t)tok * 768;
    const float* kvr = p.KVRAW + (size_t)tok * 1024;
    const float* kr = p.KR + (size_t)tok * 32;
#pragma unroll
    for (int h = 0; h < NH; ++h) {
      size_t row = ((size_t)(b * NH + h) * T + t);
      u16* qo = p.Q + row * 96; u16* ko = p.Kc + row * 96; u16* vo = p.Vv + row * 64;
      qo[lane] = f2bf(qr[h * 96 + lane] * qs);
      ko[lane] = f2bf(kvr[h * 128 + lane]);
      vo[lane] = f2bf(kvr[h * 128 + 64 + lane]);
      if (lane < 16) {
        float u1 = qr[h * 96 + 64 + lane], u2 = qr[h * 96 + 80 + lane];
        qo[64 + lane] = f2bf((u1 * cs - u2 * sn) * qs);
        qo[80 + lane] = f2bf((u1 * sn + u2 * cs) * qs);
      }
      if (lane < 32) ko[64 + lane] = f2bf(kr[lane]);
    }
  }
}

using f32x16 = __attribute__((ext_vector_type(16))) float;
#define SBAR() __builtin_amdgcn_sched_barrier(0)
constexpr int AT_KSTR = 104;
constexpr int AT_KBYTES = 64 * AT_KSTR * 2;
constexpr int AT_VBYTES = 64 * 64 * 2;
constexpr float AT_THR = 8.f;
DI int crow(int r, int hi) { return (r & 3) + 8 * (r >> 2) + 4 * hi; }
DI int v_st(int k, int c) { const int kk = (k & ~0xC) | ((k & 4) << 1) | ((k & 8) >> 1); return ((kk >> 3) * 2 + (c >> 5)) * 512 + ((kk & 7) * 32 + (c & 31)) * 2; }
DI int v_rd_base(int lane) { return ((lane & 3) << 3) | (((lane >> 2) & 3) << 6) | (((lane >> 4) & 1) << 5) | (((lane >> 5) & 1) << 8); }
constexpr int v_rd_off(int d0, int ks, int half) { return d0 * 512 + ks * 2048 + half * 1024; }

DI void at_partialSM(f32x16& p0, f32x16& p1, float& m_reg, float& mn, float& alpha) {
  float pmax = p0[0];
#pragma unroll
  for (int r = 1; r < 16; ++r) pmax = fmaxf(pmax, p0[r]);
#pragma unroll
  for (int r = 0; r < 16; ++r) pmax = fmaxf(pmax, p1[r]);
  { auto rr = __builtin_amdgcn_permlane32_swap(__float_as_uint(pmax), __float_as_uint(pmax), false, false);
    pmax = fmaxf(__uint_as_float(rr[0]), __uint_as_float(rr[1])); }
  if (__builtin_expect(__all(pmax - m_reg <= AT_THR), 1)) { mn = m_reg; alpha = 1.f; }
  else { mn = fmaxf(m_reg, pmax); alpha = __builtin_amdgcn_exp2f(m_reg - mn); m_reg = mn; }
#pragma unroll
  for (int r = 0; r < 16; ++r) { p0[r] = p0[r] - mn; p1[r] = p1[r] - mn; }
#pragma unroll
  for (int r = 0; r < 16; ++r) p0[r] = __builtin_amdgcn_exp2f(p0[r]);
}
DI void at_finishSM(f32x16& p0, f32x16& p1, float alpha, float& l_reg, bf16x8& pa0, bf16x8& pa1, bf16x8& pa2, bf16x8& pa3) {
#pragma unroll
  for (int r = 0; r < 16; ++r) p1[r] = __builtin_amdgcn_exp2f(p1[r]);
  float ps = 0;
#pragma unroll
  for (int r = 0; r < 16; ++r) ps += p0[r];
#pragma unroll
  for (int r = 0; r < 16; ++r) ps += p1[r];
  { auto rr = __builtin_amdgcn_permlane32_swap(__float_as_uint(ps), __float_as_uint(ps), false, false);
    ps = __uint_as_float(rr[0]) + __uint_as_float(rr[1]); }
  l_reg = l_reg * alpha + ps;
#define PK4(PP, BASE, OUT) do { unsigned a0 = pk2(PP[BASE + 0], PP[BASE + 1]), a1 = pk2(PP[BASE + 2], PP[BASE + 3]);   \
    unsigned b0 = pk2(PP[BASE + 4], PP[BASE + 5]), b1 = pk2(PP[BASE + 6], PP[BASE + 7]);                              \
    auto r0 = __builtin_amdgcn_permlane32_swap(a0, b0, false, false); auto r1 = __builtin_amdgcn_permlane32_swap(a1, b1, false, false); \
    u32x4 wv = {r0[0], r1[0], r0[1], r1[1]}; OUT = __builtin_bit_cast(bf16x8, wv); } while (0)
  PK4(p0, 0, pa0); PK4(p0, 8, pa1); PK4(p1, 0, pa2); PK4(p1, 8, pa3);
#undef PK4
}
DI void at_qkt(f32x16& p0, f32x16& p1, const char* Kb, const bf16x8* qr, int r32, int hi) {
#pragma unroll
  for (int r = 0; r < 16; ++r) { p0[r] = 0.f; p1[r] = 0.f; }
#pragma unroll
  for (int d0 = 0; d0 < 6; ++d0) {
    bf16x8 b0 = *(const bf16x8*)(Kb + (r32 * AT_KSTR + d0 * 16 + hi * 8) * 2);
    bf16x8 b1 = *(const bf16x8*)(Kb + ((32 + r32) * AT_KSTR + d0 * 16 + hi * 8) * 2);
    __builtin_amdgcn_s_setprio(1);
    p0 = __builtin_amdgcn_mfma_f32_32x32x16_bf16(b0, qr[d0], p0, 0, 0, 0);
    p1 = __builtin_amdgcn_mfma_f32_32x32x16_bf16(b1, qr[d0], p1, 0, 0, 0);
    __builtin_amdgcn_s_setprio(0);
  }
}
template <int D0> DI void at_pv_one(f32x16& od, const char* vb, bf16x8 pa0, bf16x8 pa1, bf16x8 pa2, bf16x8 pa3) {
#define TRR(ks, half) tr_read((const short*)(vb + v_rd_off(D0, ks, half)))
  const s16x4 l0 = TRR(0, 0), h0 = TRR(0, 1), l1 = TRR(1, 0), h1 = TRR(1, 1), l2 = TRR(2, 0), h2 = TRR(2, 1), l3 = TRR(3, 0), h3 = TRR(3, 1);
#undef TRR
#define PKV(L, H) __builtin_shufflevector(L, H, 0, 1, 2, 3, 4, 5, 6, 7)
  __builtin_amdgcn_s_setprio(1);
  od = __builtin_amdgcn_mfma_f32_32x32x16_bf16(pa0, PKV(l0, h0), od, 0, 0, 0);
  od = __builtin_amdgcn_mfma_f32_32x32x16_bf16(pa1, PKV(l1, h1), od, 0, 0, 0);
  od = __builtin_amdgcn_mfma_f32_32x32x16_bf16(pa2, PKV(l2, h2), od, 0, 0, 0);
  od = __builtin_amdgcn_mfma_f32_32x32x16_bf16(pa3, PKV(l3, h3), od, 0, 0, 0);
  __builtin_amdgcn_s_setprio(0);
#undef PKV
}
DI void at_pv(f32x16* o, const char* vb, bf16x8 pa0, bf16x8 pa1, bf16x8 pa2, bf16x8 pa3) {
  at_pv_one<0>(o[0], vb, pa0, pa1, pa2, pa3); at_pv_one<1>(o[1], vb, pa0, pa1, pa2, pa3);
}

DI void attn_body(const u16* __restrict__ Qb, const u16* __restrict__ Kh, const u16* __restrict__ Vh, float* __restrict__ Ob, char* lds, int tid) {
  const int wid = tid >> 6, lane = tid & 63, r32 = lane & 31, hi = lane >> 5;
  char* V_lds = lds; char* K_lds = lds + 2 * AT_VBYTES;
  float* wsp = (float*)(lds + 2 * AT_VBYTES + 2 * AT_KBYTES) + wid * 64; float* li_l = wsp; float* al_l = wsp + 32;
  float m_reg = -1e30f, l_reg = 0.f; f32x16 o[2]; bf16x8 qr[6];
#pragma unroll
  for (int r = 0; r < 16; ++r) { o[0][r] = 0.f; o[1][r] = 0.f; }
  const u16* Qw = Qb + (size_t)(wid * 32 + r32) * 96 + hi * 8;
#pragma unroll
  for (int d0 = 0; d0 < 6; ++d0) qr[d0] = *(const bf16x8*)(Qw + d0 * 16);
  const int kid1 = (tid < 256) ? tid + 512 : tid;
  const int kst0 = ((tid / 12) * AT_KSTR + (tid % 12) * 8) * 2, kst1 = ((kid1 / 12) * AT_KSTR + (kid1 % 12) * 8) * 2;
  const int vst = v_st(tid >> 3, (tid & 7) * 8);
  const char* vb0 = V_lds + v_rd_base(lane);
  u32x4 sk0[2], sk1[2], sv0[2];
#define SLOAD(i, k0) do { sk0[i] = *(const u32x4*)(Kh + (size_t)(k0) * 96 + tid * 8); sk1[i] = *(const u32x4*)(Kh + (size_t)(k0) * 96 + kid1 * 8); \
    sv0[i] = *(const u32x4*)(Vh + (size_t)(k0) * 64 + tid * 8); } while (0)
#define SWRITE(b, i) do { *(u32x4*)(K_lds + (b) * AT_KBYTES + kst0) = sk0[i]; if (tid < 256) *(u32x4*)(K_lds + (b) * AT_KBYTES + kst1) = sk1[i]; \
    *(u32x4*)(V_lds + (b) * AT_VBYTES + vst) = sv0[i]; } while (0)
#define SWAIT() asm volatile("s_waitcnt vmcnt(3)" ::: "memory")
#define RESC(a) do { if (__any((a) < 1.f)) { if (hi == 0) al_l[r32] = (a); asm volatile("s_waitcnt lgkmcnt(0)" ::: "memory"); \
    _Pragma("unroll") for (int r = 0; r < 16; ++r) { float al = al_l[crow(r, hi)]; o[0][r] *= al; o[1][r] *= al; } } } while (0)
  f32x16 pA0, pA1, pB0, pB1; float mnA, mnB, alA, alB; bf16x8 pa0, pa1, pa2, pa3; constexpr int NT = T / 64;
  SLOAD(0, 0); SWRITE(0, 0); __syncthreads();
  at_qkt(pA0, pA1, K_lds, qr, r32, hi); at_partialSM(pA0, pA1, m_reg, mnA, alA);
  SLOAD(1, 64); SLOAD(0, 128);
  SWAIT(); SWRITE(1, 1); __syncthreads();
  for (int j = 1; j + 1 < NT; j += 2) {
    SBAR(); at_qkt(pB0, pB1, K_lds + AT_KBYTES, qr, r32, hi);
    at_finishSM(pA0, pA1, alA, l_reg, pa0, pa1, pa2, pa3); SBAR();
    SLOAD(1, (j + 2) * 64); SBAR();
    at_pv(o, vb0, pa0, pa1, pa2, pa3); at_partialSM(pB0, pB1, m_reg, mnB, alB);
    __syncthreads(); SWAIT(); SWRITE(0, 0);
    RESC(alB); __syncthreads();
    SBAR(); at_qkt(pA0, pA1, K_lds, qr, r32, hi);
    at_finishSM(pB0, pB1, alB, l_reg, pa0, pa1, pa2, pa3); SBAR();
    if (j + 3 < NT) SLOAD(0, (j + 3) * 64); SBAR();
    at_pv(o, vb0 + AT_VBYTES, pa0, pa1, pa2, pa3); at_partialSM(pA0, pA1, m_reg, mnA, alA);
    __syncthreads(); SWAIT(); SWRITE(1, 1);
    RESC(alA); __syncthreads();
  }
  SBAR(); at_qkt(pB0, pB1, K_lds + AT_KBYTES, qr, r32, hi);
  at_finishSM(pA0, pA1, alA, l_reg, pa0, pa1, pa2, pa3); SBAR();
  at_pv(o, vb0, pa0, pa1, pa2, pa3); at_partialSM(pB0, pB1, m_reg, mnB, alB);
  __syncthreads(); RESC(alB);
  at_finishSM(pB0, pB1, alB, l_reg, pa0, pa1, pa2, pa3); SBAR();
  at_pv(o, vb0 + AT_VBYTES, pa0, pa1, pa2, pa3);
  if (hi == 0) li_l[r32] = l_reg;
  asm volatile("s_waitcnt lgkmcnt(0)" ::: "memory");
  float* Ow = Ob + (size_t)(wid * 32) * 512;
#pragma unroll
  for (int r = 0; r < 16; ++r) {
    int orow = crow(r, hi); float rl = __builtin_amdgcn_rcpf(li_l[orow]);
    Ow[(size_t)orow * 512 + r32] = o[0][r] * rl; Ow[(size_t)orow * 512 + 32 + r32] = o[1][r] * rl;
  }
#undef SLOAD
#undef SWRITE
#undef SWAIT
#undef RESC
}

DI void ph_attn(const P& p, char* smem, unsigned* ctr) {
  const int tid = tidx();
  int* sitem = (int*)(smem + SMEM_BYTES - 16);
  for (;;) {
    __syncthreads();
    if (tid == 0) *sitem = (int)atomicAdd(ctr, 1u);
    __syncthreads();
    const int item = *sitem;
    if (item >= NB * NH * (T / 256)) break;
    const int bh = item / (T / 256), qb = item % (T / 256);
    const int b = bh / NH, h = bh % NH;
    attn_body(p.Q + ((size_t)bh * T + qb * 256) * 96, p.Kc + (size_t)bh * T * 96, p.Vv + (size_t)bh * T * 64,
              p.AO + ((size_t)(b * T + qb * 256)) * 512 + h * 64, smem, tid);
  }
}

constexpr int SC = 256, NCH = T / SC;
constexpr int SBUF = 5184;
template <int NI> struct ScanRegsN { float k[2 * NI], r[2 * NI], v[2 * NI]; u16 lw[2 * NI], a[2 * NI]; };
template <int NI>
DI void scan_load_n(const P& p, int b, int h, int d, int n0, int lane, int ws, ScanRegsN<NI>& g) {
  constexpr int WPI = 8 / NI;
  const u16* LWd = p.LW + (size_t)d * NTOK * RWW;
  const u16* AAd = p.AA + (size_t)d * NTOK * RWW;
  const int ch = h * 64 + lane;
#pragma unroll
  for (int jj = 0; jj < 2 * NI; ++jj) {
    int n = n0 + ws + WPI * jj; int t = d ? (T - 1 - n) : n;
    size_t off = ((size_t)(b * T + t)) * RWW + ch;
    g.k[jj] = p.K[off]; g.r[jj] = p.R[off]; g.v[jj] = p.V[off]; g.lw[jj] = LWd[off]; g.a[jj] = AAd[off];
  }
}
template <int NI>
DI void scan_put_n(const ScanRegsN<NI>& g, float kkc, float kac, float* sm, float* slw, int lane, int ws) {
  constexpr int WPI = 8 / NI;
#pragma unroll
  for (int jj = 0; jj < 2 * NI; ++jj) slw[(ws + WPI * jj) * 64 + lane] = bf2f(g.lw[jj]);
  __syncthreads();
  float Lj[2 * NI];
#pragma unroll
  for (int jj = 0; jj < 2 * NI; ++jj) Lj[jj] = 0.f;
#pragma unroll
  for (int i = 0; i < 16; ++i) {
    const float x = slw[i * 64 + lane];
#pragma unroll
    for (int jj = 0; jj < 2 * NI; ++jj) Lj[jj] += (i <= ws + WPI * jj) ? x : 0.f;
  }
#pragma unroll
  for (int jj = 0; jj < 2 * NI; ++jj) {
    const int j = ws + WPI * jj;
    const float L = Lj[jj], lwj = bf2f(g.lw[jj]);
    const float Pt = fexp(L), Pm = fexp(L - lwj), iP = fexp(-L);
    const float kv = g.k[jj];
    const float kx = kv * kkc;
    const float nrm = __builtin_amdgcn_sqrtf(wave_sum(kx * kx));
    const float kkv = kx * frcp(fmaxf(nrm, 1e-12f));
    const float a = bf2f(g.a[jj]);
    sm[j * 64 + lane] = -kkv * Pm;
    sm[1024 + j * 64 + lane] = a * kkv * iP;
    sm[2048 + j * 64 + lane] = kv * (1.f + (a - 1.f) * kac) * iP;
    sm[3072 + j * 64 + lane] = g.r[jj] * Pt;
    sm[4096 + j * 64 + lane] = g.v[jj];
    if (j == 15) sm[5120 + lane] = Pt;
  }
}
using f32x16s = __attribute__((ext_vector_type(16))) float;
DI void scan_ld8(f32x4 (&kv)[8], const float* vec, int hi) {
#pragma unroll
  for (int tk = 0; tk < 2; ++tk)
#pragma unroll
    for (int q = 0; q < 4; ++q) kv[tk * 4 + q] = *(const f32x4*)(vec + 32 * tk + 8 * q + 4 * hi);
}
DI float scan_dot8(const f32x16s (&acc)[2], const f32x4 (&kv)[8]) {
  float pq[4] = {0.f, 0.f, 0.f, 0.f};
#pragma unroll
  for (int tk = 0; tk < 2; ++tk)
#pragma unroll
    for (int e = 0; e < 4; ++e)
#pragma unroll
      for (int q = 0; q < 4; ++q) { pq[q] = __builtin_fmaf(acc[tk][4 * q + e], kv[tk * 4 + q][e], pq[q]); asm("" : "+v"(pq[q])); }
  return red_x32((pq[0] + pq[1]) + (pq[2] + pq[3]));
}

DI void ph_scan1(const P& p, int layer, char* smem) {
  constexpr int NI = 2;
  const int tid = tidx(), lane = tid & 63, w = tid >> 6;
  const int jl = lane & 31, hi = lane >> 5;
  const int it = w >> 2, vt = w & 3, ws = w & 3;
  float* smi = (float*)smem + it * (2 * SBUF + 1024);
  float* slw = smi + 2 * SBUF;
  for (int pair = blockIdx.x; pair < 32 * NCH / 2; pair += gridDim.x) {
    const int item = pair * 2 + it; const int scan = item / NCH, c = item % NCH;
    const int d = scan & 1, h = (scan >> 1) % NH, b = scan / (2 * NH);
    const float kkc = p.rw_k_k[layer * RWW + h * 64 + lane], kac = p.rw_k_a[layer * RWW + h * 64 + lane];
    f32x16s acc[2];
#pragma unroll
    for (int tk = 0; tk < 2; ++tk)
#pragma unroll
      for (int r = 0; r < 16; ++r) acc[tk][r] = (32 * tk + (r & 3) + 8 * (r >> 2) + 4 * hi == 32 * vt + jl) ? 1.f : 0.f;
    ScanRegsN<NI> g;
    scan_load_n<NI>(p, b, h, d, c * SC, lane, ws, g);
    __syncthreads();
    scan_put_n<NI>(g, kkc, kac, smi, slw, lane, ws);
    __syncthreads();
    for (int sub = 0; sub < SC / 16; ++sub) {
      const float* sm = smi + (sub & 1) * SBUF;
      if (sub + 1 < SC / 16) scan_load_n<NI>(p, b, h, d, c * SC + (sub + 1) * 16, lane, ws, g);
      const float* vrow = sm + 4096 + ((vt >= 2) ? 32 * (vt - 2) : 0) + jl;
      f32x4 kc[8]; scan_ld8(kc, sm, hi);
      float a0 = sm[1024 + hi * 1024 + jl], a1 = sm[1024 + hi * 1024 + 32 + jl], vc = vrow[0];
#pragma unroll 4
      for (int j = 0; j < 16; ++j) {
        const int jn = (j + 1) & 15;
        f32x4 kn[8]; scan_ld8(kn, sm + jn * 64, hi);
        const float an0 = sm[1024 + hi * 1024 + jn * 64 + jl], an1 = sm[1024 + hi * 1024 + jn * 64 + 32 + jl], vn = vrow[jn * 64];
        SBAR();
        const float sa = scan_dot8(acc, kc);
        const float bop = hi ? ((vt >= 2) ? vc : 0.f) : sa;
        acc[0] = __builtin_amdgcn_mfma_f32_32x32x2f32(a0, bop, acc[0], 0, 0, 0);
        acc[1] = __builtin_amdgcn_mfma_f32_32x32x2f32(a1, bop, acc[1], 0, 0, 0);
        SBAR();
#pragma unroll
        for (int i = 0; i < 8; ++i) kc[i] = kn[i];
        a0 = an0; a1 = an1; vc = vn;
      }
#pragma unroll
      for (int tk = 0; tk < 2; ++tk)
#pragma unroll
        for (int q = 0; q < 4; ++q) {
          const f32x4 pv = *(const f32x4*)(sm + 5120 + 32 * tk + 8 * q + 4 * hi);
#pragma unroll
          for (int e = 0; e < 4; ++e) acc[tk][4 * q + e] *= pv[e];
        }
      if (sub + 1 < SC / 16) scan_put_n<NI>(g, kkc, kac, smi + ((sub + 1) & 1) * SBUF, slw, lane, ws);
      __syncthreads();
    }
    {
      const int v = 32 * vt + jl;
      float* dst = ((v < 64) ? p.MC : p.NC) + (((size_t)scan * NCH + c) * 64 + (v & 63)) * 64;
#pragma unroll
      for (int tk = 0; tk < 2; ++tk)
#pragma unroll
        for (int q = 0; q < 4; ++q)
          *(f32x4*)(dst + 32 * tk + 8 * q + 4 * hi) = f32x4{acc[tk][4 * q], acc[tk][4 * q + 1], acc[tk][4 * q + 2], acc[tk][4 * q + 3]};
    }
  }
}


DI void ph_scan2(const P& p, char* smem) {
  constexpr int LS = 72;
  u16* Sh = (u16*)smem; u16* Sl = Sh + 64 * LS; u16* Mh = Sl + 64 * LS; u16* Ml = Mh + 64 * LS;
  const int tid = tidx(), lane = tid & 63, w = tid >> 6;
  const int l15 = lane & 15, lq = lane >> 4;
  const int ti = w >> 1, tj0 = (w & 1) * 2;
  for (int scan = blockIdx.x; scan < 32; scan += gridDim.x) {
    const float* Mg = p.MC + (size_t)scan * NCH * 4096;
    const float* Ng = p.NC + (size_t)scan * NCH * 4096;
    float* Sg = p.SS + (size_t)scan * NCH * 4096;
    struct MN { f32x4 m0, m1, n[2]; };
    auto ldmn = [&](MN& r, int c) {
      const int cc = (c < NCH) ? c : (NCH - 1);
      r.m0 = *(const f32x4*)(Mg + (size_t)cc * 4096 + tid * 8); r.m1 = *(const f32x4*)(Mg + (size_t)cc * 4096 + tid * 8 + 4);
#pragma unroll
      for (int q = 0; q < 2; ++q)
#pragma unroll
        for (int r4 = 0; r4 < 4; ++r4) r.n[q][r4] = Ng[(size_t)cc * 4096 + (ti * 16 + lq * 4 + r4) * 64 + (tj0 + q) * 16 + l15];
    };
    f32x4 sacc[2];
    sacc[0] = f32x4{0.f, 0.f, 0.f, 0.f}; sacc[1] = sacc[0];
    auto step = [&](int c, const MN& r) {
      __syncthreads();
#pragma unroll
      for (int q = 0; q < 2; ++q)
#pragma unroll
        for (int r4 = 0; r4 < 4; ++r4) {
          const int row = ti * 16 + lq * 4 + r4, col = (tj0 + q) * 16 + l15;
          const float x = sacc[q][r4];
          Sg[(size_t)c * 4096 + row * 64 + col] = x;
          const u16 h = f2bf(x); Sh[row * LS + col] = h; Sl[row * LS + col] = f2bf(x - bf2f(h));
        }
      {
        const int mr = tid >> 3, mc = (tid & 7) * 8;
        float xh[8], xl[8];
#pragma unroll
        for (int i = 0; i < 8; ++i) { const float x = (i < 4) ? r.m0[i & 3] : r.m1[i & 3]; const float h = bf2f(f2bf(x)); xh[i] = h; xl[i] = x - h; }
        *(u32x4*)(Mh + mr * LS + mc) = u32x4{pk2(xh[0], xh[1]), pk2(xh[2], xh[3]), pk2(xh[4], xh[5]), pk2(xh[6], xh[7])};
        *(u32x4*)(Ml + mr * LS + mc) = u32x4{pk2(xl[0], xl[1]), pk2(xl[2], xl[3]), pk2(xl[4], xl[5]), pk2(xl[6], xl[7])};
      }
      f32x4 acc[2] = {r.n[0], r.n[1]};
      __syncthreads();
#pragma unroll
      for (int ks = 0; ks < 2; ++ks) {
        const bf16x8 ah = *(const bf16x8*)(Sh + (ti * 16 + l15) * LS + ks * 32 + 8 * lq);
        const bf16x8 al = *(const bf16x8*)(Sl + (ti * 16 + l15) * LS + ks * 32 + 8 * lq);
#pragma unroll
        for (int q = 0; q < 2; ++q) {
          const int kb = ks * 32 + 8 * lq, tq = l15 >> 2, tp = l15 & 3, co = (tj0 + q) * 16 + 4 * tp;
          const bf16x8 bh = __builtin_shufflevector(tr_read((const short*)Mh + (kb + tq) * LS + co), tr_read((const short*)Mh + (kb + 4 + tq) * LS + co), 0, 1, 2, 3, 4, 5, 6, 7);
          const bf16x8 bl = __builtin_shufflevector(tr_read((const short*)Ml + (kb + tq) * LS + co), tr_read((const short*)Ml + (kb + 4 + tq) * LS + co), 0, 1, 2, 3, 4, 5, 6, 7);
          acc[q] = __builtin_amdgcn_mfma_f32_16x16x32_bf16(ah, bh, acc[q], 0, 0, 0);
          acc[q] = __builtin_amdgcn_mfma_f32_16x16x32_bf16(ah, bl, acc[q], 0, 0, 0);
          acc[q] = __builtin_amdgcn_mfma_f32_16x16x32_bf16(al, bh, acc[q], 0, 0, 0);
        }
      }
      sacc[0] = acc[0]; sacc[1] = acc[1];
    };
    MN r0, r1, r2, r3;
    ldmn(r0, 0); ldmn(r1, 1); ldmn(r2, 2);
    for (int c = 0; c < NCH; c += 4) {
      ldmn(r3, c + 3); step(c, r0);
      ldmn(r0, c + 4); step(c + 1, r1);
      ldmn(r1, c + 5); step(c + 2, r2);
      ldmn(r2, c + 6); step(c + 3, r3);
    }
    __syncthreads();
  }
}

DI void ph_scan3(const P& p, int layer, char* smem) {
  constexpr int NI = 4;
  const int tid = tidx(), lane = tid & 63, w = tid >> 6;
  const int jl = lane & 31, hi = lane >> 5;
  const int it = w >> 1, vt = w & 1, ws = w & 1;
  float* sm = (float*)smem + it * (SBUF + 2048);
  float* slw = sm + SBUF; float* so = slw + 1024;
  const float* lwp = p.rw_lnx_w + layer * RWW; const float* lbp = p.rw_lnx_b + layer * RWW; const float* rkp = p.rw_r_k + layer * RWW;
  constexpr int TQ = 2 * SC;
  for (int quad = blockIdx.x; quad < NB * NH * (T / TQ); quad += gridDim.x) {
    const int bh = quad / (T / TQ), tb = quad % (T / TQ);
    const int d = it >> 1, kch = 2 * tb + (it & 1), c = d ? (NCH - 1 - kch) : kch;
    const int h = bh % NH, b = bh / NH, scan = bh * 2 + d;
    const float kkc = p.rw_k_k[layer * RWW + h * 64 + lane], kac = p.rw_k_a[layer * RWW + h * 64 + lane];
    u16* Od = p.O2 + (size_t)d * NTOK * RWW;
    f32x16s acc[2];
    {
      const float* Sg = p.SS + ((size_t)scan * NCH + c) * 4096 + (size_t)(32 * vt + jl) * 64;
#pragma unroll
      for (int tk = 0; tk < 2; ++tk)
#pragma unroll
        for (int q = 0; q < 4; ++q) {
          const f32x4 sv = *(const f32x4*)(Sg + 32 * tk + 8 * q + 4 * hi);
#pragma unroll
          for (int e = 0; e < 4; ++e) acc[tk][4 * q + e] = sv[e];
        }
    }
    ScanRegsN<NI> g;
    scan_load_n<NI>(p, b, h, d, c * SC, lane, ws, g);
    for (int sub = 0; sub < SC / 16; ++sub) {
      const int n0 = c * SC + sub * 16;
      __syncthreads();
      scan_put_n<NI>(g, kkc, kac, sm, slw, lane, ws);
      __syncthreads();
      if (sub + 1 < SC / 16) scan_load_n<NI>(p, b, h, d, n0 + 16, lane, ws, g);
      const float* vrow = sm + 4096 + 32 * vt + jl;
      f32x4 kc[8]; scan_ld8(kc, sm, hi);
      float a0 = sm[1024 + hi * 1024 + jl], a1 = sm[1024 + hi * 1024 + 32 + jl], vc = vrow[0];
#pragma unroll 4
      for (int j = 0; j < 16; ++j) {
        const int jn = (j + 1) & 15;
        f32x4 kn[8]; scan_ld8(kn, sm + jn * 64, hi);
        const float an0 = sm[1024 + hi * 1024 + jn * 64 + jl], an1 = sm[1024 + hi * 1024 + jn * 64 + 32 + jl], vn = vrow[jn * 64];
        SBAR();
        const float sa = scan_dot8(acc, kc);
        const float bop = hi ? vc : sa;
        acc[0] = __builtin_amdgcn_mfma_f32_32x32x2f32(a0, bop, acc[0], 0, 0, 0);
        acc[1] = __builtin_amdgcn_mfma_f32_32x32x2f32(a1, bop, acc[1], 0, 0, 0);
        f32x4 rc[8]; scan_ld8(rc, sm + 3072 + j * 64, hi);
        SBAR();
        const float o = scan_dot8(acc, rc);
        if (hi == 0) so[j * 64 + 32 * vt + jl] = o;
        SBAR();
#pragma unroll
        for (int i = 0; i < 8; ++i) kc[i] = kn[i];
        a0 = an0; a1 = an1; vc = vn;
      }
#pragma unroll
      for (int tk = 0; tk < 2; ++tk)
#pragma unroll
        for (int q = 0; q < 4; ++q) {
          const f32x4 pv = *(const f32x4*)(sm + 5120 + 32 * tk + 8 * q + 4 * hi);
#pragma unroll
          for (int e = 0; e < 4; ++e) acc[tk][4 * q + e] *= pv[e];
        }
      __syncthreads();
#pragma unroll
      for (int jj = 0; jj < 8; ++jj) {
        const int j = ws + 2 * jj; const int n = n0 + j; const int t = d ? (T - 1 - n) : n;
        Od[((size_t)(b * T + t)) * RWW + h * 64 + lane] = f2bf(so[j * 64 + lane]);
      }
    }
    asm volatile("s_waitcnt vmcnt(0)" ::: "memory");
    __syncthreads();
    {
      const int ch = h * 64 + lane;
      const float plw = lwp[ch], plb = lbp[ch], prk = rkp[ch];
      for (int i0 = 0; i0 < TQ / 8; i0 += 2) {
        float o[2], k[2], r[2], vv[2], a0[2], a1[2], gg[2];
#pragma unroll
        for (int u = 0; u < 2; ++u) {
          const size_t off = (size_t)(b * T + tb * TQ + w * (TQ / 8) + i0 + u) * RWW + ch;
          o[u] = bf2f(p.O2[off]) + bf2f(p.O2[(size_t)NTOK * RWW + off]);
          k[u] = p.K[off]; r[u] = p.R[off]; vv[u] = p.V[off];
          a0[u] = bf2f(p.AA[off]); a1[u] = bf2f(p.AA[(size_t)NTOK * RWW + off]); gg[u] = bf2f(p.G[off]);
        }
#pragma unroll
        for (int u = 0; u < 2; ++u) {
          const float mean = wave_sum(o[u]) * (1.f / 64);
          const float dv = o[u] - mean;
          const float var = wave_sum(dv * dv) * (1.f / 64);
          const float kb = 0.5f * (k[u] * (1.f + (a0[u] - 1.f) * kac) + k[u] * (1.f + (a1[u] - 1.f) * kac));
          const float sb = wave_sum(r[u] * kb * prk);
          const float on_ = dv * frsq(var + GN_EPS) * plw + plb;
          p.H[(size_t)(b * T + tb * TQ + w * (TQ / 8) + i0 + u) * DM + ch] = f2bf((on_ + sb * vv[u]) * gg[u]);
        }
      }
    }
  }
}
DI void ph_mla_norm(const P& p, int layer) {
  const int tid_ = tidx(); const int lane = tid_ & 63, w = tid_ >> 6;
  const float* on = p.mla_o_norm + layer * 512;
  const f32x4 g0 = *(const f32x4*)(on + lane * 4), g1 = *(const f32x4*)(on + 256 + lane * 4);
  for (int tok = blockIdx.x * 8 + w; tok < NTOK; tok += gridDim.x * 8) {
    const float* ao = p.AO + (size_t)tok * 512;
    const f32x4 v0 = *(const f32x4*)(ao + lane * 4), v1 = *(const f32x4*)(ao + 256 + lane * 4);
    float ss = v0[0] * v0[0] + v0[1] * v0[1] + v0[2] * v0[2] + v0[3] * v0[3] + v1[0] * v1[0] + v1[1] * v1[1] + v1[2] * v1[2] + v1[3] * v1[3];
    ss = wave_sum(ss);
    const float rstd = frsq(ss * (1.f / 512) + NORM_EPS);
    *(u32x2*)(p.H + (size_t)tok * DM + 512 + lane * 4) = u32x2{pk2(v0[0] * rstd * g0[0], v0[1] * rstd * g0[1]), pk2(v0[2] * rstd * g0[2], v0[3] * rstd * g0[3])};
    *(u32x2*)(p.H + (size_t)tok * DM + 768 + lane * 4) = u32x2{pk2(v1[0] * rstd * g1[0], v1[1] * rstd * g1[1]), pk2(v1[2] * rstd * g1[2], v1[3] * rstd * g1[3])};
  }
}


DI void ph_mixfinish(const P& p, int layer) {
  const int tid_ = tidx(); const int lane = tid_ & 63, w = tid_ >> 6;
  const float* lw = p.rw_lnx_w + layer * RWW; const float* lb = p.rw_lnx_b + layer * RWW;
  const float* kac = p.rw_k_a + layer * RWW; const float* rk = p.rw_r_k + layer * RWW;
  const float* on = p.mla_o_norm + layer * 512;
  float plw[8], plb[8], pka[8], prk[8];
#pragma unroll
  for (int h = 0; h < NH; ++h) { int c = h * 64 + lane; plw[h] = lw[c]; plb[h] = lb[c]; pka[h] = kac[c]; prk[h] = rk[c]; }
  const f32x4 g0 = *(const f32x4*)(on + lane * 4), g1 = *(const f32x4*)(on + 256 + lane * 4);
  for (int tok = blockIdx.x * 8 + w; tok < NTOK; tok += gridDim.x * 8) {
    float o[8], k[8], r[8], vv[8], a0[8], a1[8], gg[8];
#pragma unroll
    for (int h = 0; h < NH; ++h) {
      size_t off = (size_t)tok * RWW + h * 64 + lane;
      o[h] = bf2f(p.O2[off]) + bf2f(p.O2[(size_t)NTOK * RWW + off]);
      k[h] = p.K[off]; r[h] = p.R[off]; vv[h] = p.V[off];
      a0[h] = bf2f(p.AA[off]); a1[h] = bf2f(p.AA[(size_t)NTOK * RWW + off]); gg[h] = bf2f(p.G[off]);
    }
    const float* ao = p.AO + (size_t)tok * 512;
    const f32x4 v0 = *(const f32x4*)(ao + lane * 4), v1 = *(const f32x4*)(ao + 256 + lane * 4);
    float mean[8], var[8], sb[8];
#pragma unroll
    for (int h = 0; h < NH; ++h) mean[h] = wave_sum(o[h]) * (1.f / 64);
#pragma unroll
    for (int h = 0; h < NH; ++h) { float dv = o[h] - mean[h]; o[h] = dv; var[h] = wave_sum(dv * dv) * (1.f / 64); }
#pragma unroll
    for (int h = 0; h < NH; ++h) {
      float kb = 0.5f * (k[h] * (1.f + (a0[h] - 1.f) * pka[h]) + k[h] * (1.f + (a1[h] - 1.f) * pka[h]));
      sb[h] = wave_sum(r[h] * kb * prk[h]);
    }
#pragma unroll
    for (int h = 0; h < NH; ++h) {
      float on_ = o[h] * frsq(var[h] + GN_EPS) * plw[h] + plb[h];
      float y = (on_ + sb[h] * vv[h]) * gg[h];
      p.H[(size_t)tok * DM + h * 64 + lane] = f2bf(y);
    }
    float ss = v0[0] * v0[0] + v0[1] * v0[1] + v0[2] * v0[2] + v0[3] * v0[3] + v1[0] * v1[0] + v1[1] * v1[1] + v1[2] * v1[2] + v1[3] * v1[3];
    ss = wave_sum(ss);
    float rstd = frsq(ss * (1.f / 512) + NORM_EPS);
    *(u32x2*)(p.H + (size_t)tok * DM + 512 + lane * 4) = u32x2{pk2(v0[0] * rstd * g0[0], v0[1] * rstd * g0[1]), pk2(v0[2] * rstd * g0[2], v0[3] * rstd * g0[3])};
    *(u32x2*)(p.H + (size_t)tok * DM + 768 + lane * 4) = u32x2{pk2(v1[0] * rstd * g1[0], v1[1] * rstd * g1[1]), pk2(v1[2] * rstd * g1[2], v1[3] * rstd * g1[3])};
  }
}

DI void ph_norm_router(const P& p, int layer, char* smem) {
  const int tid_ = tidx(); const int lane = tid_ & 63, w = tid_ >> 6;
  float* rtl = (float*)smem;
  float* hl = (float*)(smem + 65536) + w * 1024;
  const float* g = p.ffn_norm + layer * DM;
  const float* rt = p.router + (size_t)layer * DM * NE;
  __syncthreads();
#pragma unroll
  for (int i = 0; i < 8; ++i) *(f32x4*)(rtl + (tid_ + i * NTH) * 4) = *(const f32x4*)(rt + (tid_ + i * NTH) * 4);
  __syncthreads();
  const int cg = lane >> 2, eq = lane & 3;
  for (int tok = blockIdx.x * 8 + w; tok < NTOK; tok += gridDim.x * 8) {
    const f32x4* xr = (const f32x4*)(p.out + (size_t)tok * DM);
    f32x4 v[4]; float ss = 0.f;
#pragma unroll
    for (int j = 0; j < 4; ++j) { v[j] = xr[lane + 64 * j]; ss += v[j][0] * v[j][0] + v[j][1] * v[j][1] + v[j][2] * v[j][2] + v[j][3] * v[j][3]; }
    ss = wave_sum(ss);
    const float rstd = frsq(ss * (1.f / DM) + NORM_EPS);
#pragma unroll
    for (int j = 0; j < 4; ++j) {
      const int c0 = (lane + 64 * j) * 4;
      const f32x4 gg = *(const f32x4*)(g + c0);
      const f32x4 hv = v[j] * rstd * gg;
      *(u32x2*)(p.H + (size_t)tok * DM + c0) = u32x2{pk2(hv[0], hv[1]), pk2(hv[2], hv[3])};
      *(f32x4*)(hl + c0) = hv;
    }
    f32x4 acc = f32x4{0.f, 0.f, 0.f, 0.f};
#pragma unroll 16
    for (int i = 0; i < 64; ++i) {
      const float hv = hl[cg + 16 * i];
      const f32x4 r4 = *(const f32x4*)(rtl + (cg + 16 * i) * 16 + eq * 4);
      acc += hv * r4;
    }
#pragma unroll
    for (int e = 0; e < 4; ++e) {
      float a = acc[e];
      a += dpp_f<0x124>(a); a += dpp_f<0x128>(a);
      a = red_x32(red_x16(a));
      acc[e] = a;
    }
    float mx = fmaxf(fmaxf(acc[0], acc[1]), fmaxf(acc[2], acc[3]));
    mx = fmaxf(mx, dpp_f<0xB1>(mx)); mx = fmaxf(mx, dpp_f<0x4E>(mx));
    f32x4 ex; float se = 0.f;
#pragma unroll
    for (int e = 0; e < 4; ++e) { ex[e] = fexp(acc[e] - mx); se += ex[e]; }
    se = red_x2(red_x1(se));
    const float inv = frcp(se);
    const int b = tok / T, t = tok % T;
    if (lane < 4) {
#pragma unroll
      for (int e = 0; e < 4; ++e) p.AFF[((size_t)(b * NE + eq * 4 + e)) * T + t] = ex[e] * inv;
    }
  }
}

DI void ph_topk(const P& p, char* smem) {
  unsigned* hist = (unsigned*)smem;
  unsigned* sc = hist + 256;
  unsigned* bc = sc + 2048;
  const int tid = tidx();
  for (int item = blockIdx.x; item < NB * NE; item += gridDim.x) {
    const float* a = p.AFF + (size_t)item * T;
    unsigned key[16];
#pragma unroll
    for (int i = 0; i < 4; ++i) {
      uint4 v = *(const uint4*)(a + tid * 16 + i * 4);
      key[i * 4 + 0] = v.x; key[i * 4 + 1] = v.y; key[i * 4 + 2] = v.z; key[i * 4 + 3] = v.w;
    }
    unsigned prefix = 0, mask = 0, need = CAP;
    for (int pass = 0; pass < 4; ++pass) {
      int shift = 24 - 8 * pass;
      __syncthreads();
      if (tid < 256) hist[tid] = 0;
      __syncthreads();
#pragma unroll
      for (int i = 0; i < 16; ++i)
        if ((key[i] & mask) == prefix) atomicAdd(&hist[(key[i] >> shift) & 255u], 1u);
      __syncthreads();
      if (tid == 0) {
        unsigned cum = 0; int bsel = 0; unsigned nd = need;
        for (int bb = 255; bb >= 0; --bb) {
          unsigned hc = hist[bb];
          if (cum + hc >= need) { bsel = bb; nd = need - cum; break; }
          cum += hc;
        }
        bc[0] = prefix | ((unsigned)bsel << shift); bc[1] = nd;
      }
      __syncthreads();
      prefix = bc[0]; need = bc[1]; mask |= (255u << shift);
    }
    unsigned ngt = 0, neq = 0;
#pragma unroll
    for (int i = 0; i < 16; ++i) { ngt += key[i] > prefix; neq += key[i] == prefix; }
    __syncthreads();
    unsigned* sA = sc; unsigned* sB = sc + 512; unsigned* eA = sc + 1024; unsigned* eB = sc + 1536;
    sA[tid] = ngt; eA[tid] = neq;
    __syncthreads();
    for (int off = 1; off < NTH; off <<= 1) {
      unsigned x = sA[tid] + ((tid >= off) ? sA[tid - off] : 0u);
      unsigned y = eA[tid] + ((tid >= off) ? eA[tid - off] : 0u);
      sB[tid] = x; eB[tid] = y;
      __syncthreads();
      unsigned* tmp = sA; sA = sB; sB = tmp; tmp = eA; eA = eB; eB = tmp;
    }
    unsigned gt_excl = sA[tid] - ngt, eq_excl = eA[tid] - neq;
    unsigned gt_total = sA[NTH - 1];
    int* idx = p.IDX + (size_t)item * CAP; float* gate = p.GATE + (size_t)item * CAP;
#pragma unroll
    for (int i = 0; i < 16; ++i) {
      int slot = -1;
      if (key[i] > prefix) { slot = (int)gt_excl; ++gt_excl; }
      else if (key[i] == prefix) { if (eq_excl < need) slot = (int)(gt_total + eq_excl); ++eq_excl; }
      if (slot >= 0) {
        const int tokl = tid * 16 + i;
        idx[slot] = tokl; gate[slot] = __uint_as_float(key[i]);
        const int tokg = (item / NE) * T + tokl;
        const int pos = atomicAdd(&p.TCNT[tokg], 1);
        p.TLIST[(size_t)tokg * 16 + pos] = item * CAP + slot;
      }
    }
    __syncthreads();
  }
}

DI void ph_exp1(const P& p, int layer, char* smem) {
  for (int t = blockIdx.x; t < 32 * 4 * 16; t += gridDim.x) {
    int grp = t / 64, r = t % 64, tm = r / 16, tn = r % 16;
    int b = grp / NE, e = grp % NE;
    const int* gi = p.IDX + (size_t)grp * CAP + tm * GBM;
    const u16* Hb = p.H + (size_t)b * T * DM;
    const float* Wg = p.exp_w_gate + ((size_t)layer * NE + e) * DM * 1024;
    const float* Wu = p.exp_w_up + ((size_t)layer * NE + e) * DM * 1024;
    u16* hid = p.HID + ((size_t)grp * CAP + tm * GBM) * 1024;
    auto arow = [&](int row) -> const void* { return Hb + (size_t)gi[row] * DM; };
    gemm_tile<false, 1>(arow, Wg, Wu, 1024, DM, tn * 64, 1024, smem, [&](int row, int col, float g, float u) {
      float sv = g * frcp(1.f + fexp(-g));
      hid[(size_t)row * 1024 + col] = f2bf(sv * u);
    });
    __syncthreads();
  }
}
DI void ph_exp2(const P& p, int layer, char* smem) {
  for (int t = blockIdx.x; t < 32 * 4 * 8; t += gridDim.x) {
    int grp = t / 32, r = t % 32, tm = r / 8, tn = r % 8;
    int b = grp / NE, e = grp % NE;
    const int* gi = p.IDX + (size_t)grp * CAP + tm * GBM;
    const float* gt = p.GATE + (size_t)grp * CAP + tm * GBM;
    const u16* hid = p.HID + ((size_t)grp * CAP + tm * GBM) * 1024;
    const float* Wd = p.exp_w_down + ((size_t)layer * NE + e) * 1024 * DM;
    float* xb = p.out + (size_t)b * T * DM;
    auto arow = [&](int row) -> const void* { return hid + (size_t)row * 1024; };
    gemm_tile<false, 0>(arow, Wd, nullptr, DM, 1024, tn * GBN, DM, smem, [&](int row, int col, float v, float) {
      unsafeAtomicAdd(xb + (size_t)gi[row] * DM + col, v * gt[row]);
    });
    __syncthreads();
  }
}

namespace g8 {
constexpr int BM = 256, BK = 64, HALF = 128, HTB = HALF * BK * 2, STAGE_BYTES = 8 * HTB, NXCD = 8, WGM = 8;
DI int lds_byte(int r, int c) { const int st = (r >> 4) * 2 + (c >> 5), rr = r & 15, cc = c & 31, ob = rr * 64 + cc * 2; return st * 1024 + (ob ^ (((ob >> 9) & 1) << 5)); }
DI void stage_rc(int b, int& R, int& C) { const int st = b / 1024, sb = b % 1024, swz = sb ^ (((sb >> 9) & 1) << 5); R = (st >> 1) * 16 + swz / 64; C = (st & 1) * 32 + (swz % 64) / 2; }
DI int perm32(int rho) { const int n = rho >> 4, i = rho & 15; return 8 * (i >> 2) + 4 * n + (i & 3); }
struct Unit { int pm, pn; };
struct Sched {
  int nM, nN, nwg, G, c;
  const char* A; const char* Bt; size_t a_tstep, b_tstep; int gdiv, gmod; size_t gstride;
  DI void init(int nM_, int nN_, int G_, int c_, const void* A_, const void* Bt_, int K) {
    nM = nM_; nN = nN_; nwg = nM * nN; G = G_; c = c_; A = (const char*)uni_ptr(A_); Bt = (const char*)uni_ptr(Bt_);
    a_tstep = (size_t)BM * K * 2; b_tstep = (size_t)BM * K * 2; gdiv = 1 << 30; gmod = 1; gstride = 0;
  }
  DI void group(int gdiv_, int gmod_, size_t gstride_) { gdiv = gdiv_; gmod = gmod_; gstride = gstride_; }
  DI bool next(int i, Unit& u) const {
    const long L = (long)i * G + c; if (L >= nwg) return false;
    int wgid = (int)L; { const int q = nwg / NXCD, r = nwg % NXCD, xcd = wgid % NXCD, off = wgid / NXCD; wgid = (xcd < r ? xcd * (q + 1) : r * (q + 1) + (xcd - r) * q) + off; }
    const int nig = WGM * nN, gid = wgid / nig, fm = gid * WGM, gsz = (nM - fm) < WGM ? (nM - fm) : WGM;
    u.pm = fm + ((wgid % nig) % gsz); u.pn = (wgid % nig) / gsz; return true;
  }
  DI const char* a_ptr(const Unit& u) const { return A + (size_t)u.pm * a_tstep; }
  DI const char* b_ptr(const Unit& u) const { return Bt + (size_t)((u.pm / gdiv) % gmod) * gstride + (size_t)u.pn * b_tstep; }
};
using Acc = f32x4[2][2][4][2];

template <class Epi>
DI void gemm_phase(LAS unsigned char* lds, const int K, const Sched& S, const Epi& E) {
  const int tid = tidx(), wid = __builtin_amdgcn_readfirstlane(tid >> 6), lane = tid & 63, wr = wid >> 2, wc = wid & 3, fr = lane & 15, fq = lane >> 4;
  const int nt = K / BK;
  unsigned voffA[2], voffB[2];
#pragma unroll
  for (int i = 0; i < 2; ++i) { int R, C; stage_rc(tid * 16 + i * 8192, R, C); const int Rb = Epi::PERM ? ((R & ~31) + perm32(R & 31)) : R;
    voffA[i] = (unsigned)(R * K + C) * 2u; voffB[i] = (unsigned)(Rb * K + C) * 2u; }
  const size_t kstep = (size_t)(BK * 2);
  const size_t hstep = (size_t)HALF * K * 2;
  const unsigned ldsw = (unsigned)wid * 1024u;
  const int aoff = lds_byte(wr * 64 + fr, fq * 8), boff = lds_byte(wc * 32 + fr, fq * 8);
#define G8_SA(b, h) (((b) * 2 + (h)) * HTB)
#define G8_SB(b, h) ((4 + (b) * 2 + (h)) * HTB)
#define G8_STAGE(bufoff, gbase, voff) do { _Pragma("unroll") for (int _i = 0; _i < 2; ++_i) \
    __builtin_amdgcn_global_load_lds((const unsigned*)((const char*)(gbase) + (voff)[_i]), (LAS unsigned*)(lds + (bufoff) + ldsw + _i * 8192), 16, 0, 0); } while (0)
#define G8_LDA(dst, b, h) do { _Pragma("unroll") for (int m = 0; m < 4; ++m) _Pragma("unroll") for (int k = 0; k < 2; ++k) dst[m][k] = *(const LAS bf16x8*)(lds + G8_SA(b, h) + aoff + m * 2048 + k * 1024); } while (0)
#define G8_LDB(dst, b, h) do { _Pragma("unroll") for (int n = 0; n < 2; ++n) _Pragma("unroll") for (int k = 0; k < 2; ++k) dst[n][k] = *(const LAS bf16x8*)(lds + G8_SB(b, h) + boff + n * 2048 + k * 1024); } while (0)
#define G8_MMA(ai, bj, At, Bt) do { __builtin_amdgcn_s_setprio(1); _Pragma("unroll") for (int m = 0; m < 4; ++m) _Pragma("unroll") for (int n = 0; n < 2; ++n) _Pragma("unroll") for (int k = 0; k < 2; ++k) \
    acc[ai][bj][m][n] = __builtin_amdgcn_mfma_f32_16x16x32_bf16(Bt[n][k], At[m][k], acc[ai][bj][m][n], 0, 0, 0); __builtin_amdgcn_s_setprio(0); } while (0)
#define G8_WAIT_V(n) asm volatile("s_waitcnt vmcnt(" #n ")" ::: "memory")
#define G8_WAIT_L(n) asm volatile("s_waitcnt lgkmcnt(" #n ")" ::: "memory")
#define G8_BAR __builtin_amdgcn_s_barrier()
#define G8_SCHED __builtin_amdgcn_sched_barrier(0)
  Unit cur, nxt; int ui = 0;
  if (!S.next(0, cur)) return;
  f32x4 acc[2][2][4][2];
#pragma unroll
  for (int a = 0; a < 2; ++a)
#pragma unroll
    for (int b = 0; b < 2; ++b)
#pragma unroll
      for (int m = 0; m < 4; ++m)
#pragma unroll
        for (int n = 0; n < 2; ++n) acc[a][b][m][n] = (f32x4){0.f, 0.f, 0.f, 0.f};
  bf16x8 At[4][2], B0[2][2], B1[2][2];
  const char* cA = S.a_ptr(cur); const char* cB = S.b_ptr(cur);
  G8_STAGE(G8_SB(0, 0), cB, voffB); G8_STAGE(G8_SA(0, 0), cA, voffA); G8_STAGE(G8_SB(0, 1), cB + hstep, voffB); G8_STAGE(G8_SA(0, 1), cA + hstep, voffA);
  if (wr == 1) G8_BAR;
  G8_WAIT_V(4); G8_BAR;
  G8_STAGE(G8_SB(1, 0), cB + kstep, voffB); G8_STAGE(G8_SA(1, 0), cA + kstep, voffA); G8_STAGE(G8_SB(1, 1), cB + hstep + kstep, voffB);
  G8_WAIT_V(6); G8_BAR;
  for (;;) {
    const bool has_next = S.next(ui + 1, nxt);
    const char* nA = has_next ? S.a_ptr(nxt) : cA; const char* nB = has_next ? S.b_ptr(nxt) : cB;
    for (int t = 0; t < nt; t += 2) {
      const bool last = (t == nt - 2);
      const char* a1 = cA + (size_t)(t + 1) * kstep;
      const char* a2 = last ? nA : cA + (size_t)(t + 2) * kstep; const char* b2 = last ? nB : cB + (size_t)(t + 2) * kstep;
      const char* a3 = a2 + kstep; const char* b3 = b2 + kstep;
      G8_LDB(B0, 0, 0); G8_SCHED; G8_LDA(At, 0, 0); G8_STAGE(G8_SA(1, 1), a1 + hstep, voffA);
      G8_WAIT_L(8); G8_BAR; G8_WAIT_L(0); G8_MMA(0, 0, At, B0); G8_BAR; G8_SCHED;
      G8_LDB(B1, 0, 1); G8_STAGE(G8_SB(0, 0), b2, voffB);
      G8_BAR; G8_WAIT_L(0); G8_MMA(0, 1, At, B1); G8_BAR;
      G8_LDA(At, 0, 1); G8_STAGE(G8_SA(0, 0), a2, voffA);
      G8_BAR; G8_WAIT_L(0); G8_MMA(1, 0, At, B0); G8_BAR; G8_SCHED;
      G8_STAGE(G8_SB(0, 1), b2 + hstep, voffB);
      G8_WAIT_V(6); G8_BAR; G8_MMA(1, 1, At, B1); G8_BAR;
      G8_LDB(B0, 1, 0); G8_SCHED; G8_LDA(At, 1, 0); G8_STAGE(G8_SA(0, 1), a2 + hstep, voffA);
      G8_WAIT_L(8); G8_BAR; G8_WAIT_L(0); G8_MMA(0, 0, At, B0); G8_BAR; G8_SCHED;
      G8_LDB(B1, 1, 1); G8_STAGE(G8_SB(1, 0), b3, voffB);
      G8_BAR; G8_WAIT_L(0); G8_MMA(0, 1, At, B1); G8_BAR;
      G8_LDA(At, 1, 1); G8_STAGE(G8_SA(1, 0), a3, voffA);
      G8_BAR; G8_WAIT_L(0); G8_MMA(1, 0, At, B0); G8_BAR; G8_SCHED;
      G8_STAGE(G8_SB(1, 1), b3 + hstep, voffB);
      G8_WAIT_V(6); G8_BAR; G8_MMA(1, 1, At, B1); G8_BAR;
    }
    {
      const int t2 = tidx(); const int w2 = __builtin_amdgcn_readfirstlane(t2 >> 6), l2 = t2 & 63;
      E(acc, cur, w2 >> 2, w2 & 3, l2 & 15, l2 >> 4);
    }
    if (!has_next) break;
#pragma unroll
    for (int a = 0; a < 2; ++a)
#pragma unroll
      for (int b = 0; b < 2; ++b)
#pragma unroll
        for (int m = 0; m < 4; ++m)
#pragma unroll
          for (int n = 0; n < 2; ++n) acc[a][b][m][n] = (f32x4){0.f, 0.f, 0.f, 0.f};
    cur = nxt; cA = nA; cB = nB; ++ui;
  }
  G8_WAIT_V(0);
  if (wr == 0) G8_BAR;
  G8_BAR;
#undef G8_SA
#undef G8_SB
#undef G8_STAGE
#undef G8_LDA
#undef G8_LDB
#undef G8_MMA
#undef G8_WAIT_V
#undef G8_WAIT_L
#undef G8_BAR
#undef G8_SCHED
}

struct EpiZ {
  static constexpr bool PERM = false; float* Z;
  DI void operator()(const Acc& acc, const Unit& u, int wr, int wc, int fr, int fq) const {
    const int row0 = u.pm * BM + wr * 64 + fr, col0 = u.pn * BM + wc * 32 + 4 * fq;
#pragma unroll
    for (int ai = 0; ai < 2; ++ai)
#pragma unroll
      for (int m = 0; m < 4; ++m) { float* rowp = Z + (size_t)(row0 + ai * HALF + m * 16) * INC;
#pragma unroll
        for (int bj = 0; bj < 2; ++bj)
#pragma unroll
          for (int n = 0; n < 2; ++n) { const int col = col0 + bj * HALF + n * 16; if (col < INC) *(f32x4*)(rowp + col) = acc[ai][bj][m][n]; } }
  }
};
struct EpiRes {
  static constexpr bool PERM = false; const float* xs; float* xo;
  DI void operator()(const Acc& acc, const Unit& u, int wr, int wc, int fr, int fq) const {
    const int row0 = u.pm * BM + wr * 64 + fr, col0 = u.pn * BM + wc * 32 + 4 * fq;
#pragma unroll
    for (int ai = 0; ai < 2; ++ai)
#pragma unroll
      for (int m = 0; m < 4; ++m) { const size_t ro = (size_t)(row0 + ai * HALF + m * 16) * DM + col0;
#pragma unroll
        for (int bj = 0; bj < 2; ++bj)
#pragma unroll
          for (int n = 0; n < 2; ++n) { const size_t o = ro + bj * HALF + n * 16; *(f32x4*)(xo + o) = *(const f32x4*)(xs + o) + acc[ai][bj][m][n]; } }
  }
};
struct EpiSig {
  static constexpr bool PERM = true; u16* PG;
  DI void operator()(const Acc& acc, const Unit& u, int wr, int wc, int fr, int fq) const {
    const int row0 = u.pm * BM + wr * 64 + fr, col0 = u.pn * BM + wc * 32 + 8 * fq;
#pragma unroll
    for (int ai = 0; ai < 2; ++ai)
#pragma unroll
      for (int m = 0; m < 4; ++m) { u16* rowp = PG + (size_t)(row0 + ai * HALF + m * 16) * DM + col0;
#pragma unroll
        for (int bj = 0; bj < 2; ++bj) { const f32x4 v0 = acc[ai][bj][m][0], v1 = acc[ai][bj][m][1];
          u32x4 wv = {pk2(sigmoidf_(v0[0]), sigmoidf_(v0[1])), pk2(sigmoidf_(v0[2]), sigmoidf_(v0[3])), pk2(sigmoidf_(v1[0]), sigmoidf_(v1[1])), pk2(sigmoidf_(v1[2]), sigmoidf_(v1[3]))};
          *(u32x4*)(rowp + bj * HALF) = wv; } }
  }
};
struct EpiPle {
  static constexpr bool PERM = false; float* xo; const u16* PG;
  DI void operator()(const Acc& acc, const Unit& u, int wr, int wc, int fr, int fq) const {
    const int row0 = u.pm * BM + wr * 64 + fr, col0 = u.pn * BM + wc * 32 + 4 * fq;
#pragma unroll
    for (int ai = 0; ai < 2; ++ai)
#pragma unroll
      for (int m = 0; m < 4; ++m) { const size_t ro = (size_t)(row0 + ai * HALF + m * 16) * DM + col0;
#pragma unroll
        for (int bj = 0; bj < 2; ++bj)
#pragma unroll
          for (int n = 0; n < 2; ++n) { const size_t o = ro + bj * HALF + n * 16; const u32x2 g = *(const u32x2*)(PG + o);
            f32x4 gv = {__uint_as_float(g[0] << 16), __uint_as_float(g[0] & 0xffff0000u), __uint_as_float(g[1] << 16), __uint_as_float(g[1] & 0xffff0000u)};
            *(f32x4*)(xo + o) = *(const f32x4*)(xo + o) + acc[ai][bj][m][n] * gv; } }
  }
};
struct EpiSwi {
  static constexpr bool PERM = true; u16* HID;
  DI void operator()(const Acc& acc, const Unit& u, int wr, int wc, int fr, int fq) const {
    const int row0 = u.pm * BM + wr * 64 + fr, col0 = u.pn * HALF + wc * 32 + 8 * fq;
#pragma unroll
    for (int ai = 0; ai < 2; ++ai)
#pragma unroll
      for (int m = 0; m < 4; ++m) { u16* rowp = HID + (size_t)(row0 + ai * HALF + m * 16) * 1024 + col0;
        float h[8];
#pragma unroll
        for (int n = 0; n < 2; ++n)
#pragma unroll
          for (int j = 0; j < 4; ++j) { const float gt = acc[ai][0][m][n][j], up = acc[ai][1][m][n][j]; h[n * 4 + j] = gt * frcp(1.f + fexp(-gt)) * up; }
        *(u32x4*)rowp = u32x4{pk2(h[0], h[1]), pk2(h[2], h[3]), pk2(h[4], h[5]), pk2(h[6], h[7])}; }
  }
};
struct EpiYE {
  static constexpr bool PERM = true; u16* YE; const float* GATE;
  DI void operator()(const Acc& acc, const Unit& u, int wr, int wc, int fr, int fq) const {
    const int row0 = u.pm * BM + wr * 64 + fr, col0 = u.pn * BM + wc * 32 + 8 * fq;
#pragma unroll
    for (int ai = 0; ai < 2; ++ai)
#pragma unroll
      for (int m = 0; m < 4; ++m) { const int row = row0 + ai * HALF + m * 16; const float gt = GATE[row]; u16* rowp = YE + (size_t)row * 1024 + col0;
#pragma unroll
        for (int bj = 0; bj < 2; ++bj) { const f32x4 v0 = acc[ai][bj][m][0] * gt, v1 = acc[ai][bj][m][1] * gt;
          *(u32x4*)(rowp + bj * HALF) = u32x4{pk2(v0[0], v0[1]), pk2(v0[2], v0[3]), pk2(v1[0], v1[1]), pk2(v1[2], v1[3])}; } }
  }
};
}

DI void cvt_tile_T(const float* __restrict__ src, int ldsrc, int N, int K, u16* __restrict__ dst, int k0, int n0, int drow0, char* smem, int tid) {
  short* tl = (short*)smem;
  __syncthreads();
#pragma unroll
  for (int i = 0; i < 2; ++i) {
    int u = tid + i * NTH; int kr = u >> 4, nq = u & 15; int n = n0 + nq * 4;
    f32x4 v = f32x4{0.f, 0.f, 0.f, 0.f};
    if (n < N) v = *(const f32x4*)(src + (size_t)(k0 + kr) * ldsrc + n);
#pragma unroll
    for (int e = 0; e < 4; ++e) tl[(nq * 4 + e) * 72 + kr] = (short)f2bf(v[e]);
  }
  __syncthreads();
  { int n = tid >> 3, kc = tid & 7;
    *(u32x4*)(dst + (size_t)(drow0 + n) * K + k0 + kc * 8) = *(const u32x4*)(tl + n * 72 + kc * 8); }
}
constexpr int WIN_PAD = 2560;
DI void ph_cvt_small(const P& p, int layer, char* smem) {
  const int tid = tidx();
  const int t0 = 16 * 40, t1 = t0 + 256, t2 = t1 + 256, t3 = t2 + 64;
  for (int t = blockIdx.x; t < t3; t += gridDim.x) {
    if (t < t0) cvt_tile_T(p.w_in + (size_t)layer * DM * INC, INC, INC, DM, p.WIN, (t / 40) * 64, (t % 40) * 64, (t % 40) * 64, smem, tid);
    else if (t < t1) { int q = t - t0; cvt_tile_T(p.w_out + (size_t)layer * DM * DM, DM, DM, DM, p.WOUT, (q / 16) * 64, (q % 16) * 64, (q % 16) * 64, smem, tid); }
    else if (t < t2) { int q = t - t1; cvt_tile_T(p.ple_gate + (size_t)layer * DM * DM, DM, DM, DM, p.WPG, (q / 16) * 64, (q % 16) * 64, (q % 16) * 64, smem, tid); }
    else { int q = t - t2; cvt_tile_T(p.ple_proj + (size_t)layer * DPLE * DM, DM, DM, DPLE, p.WPP, (q / 16) * 64, (q % 16) * 64, (q % 16) * 64, smem, tid); }
  }
  const float* ps = p.p + (size_t)layer * NTOK * DPLE;
  for (int i = blockIdx.x * NTH + tid; i < NTOK * DPLE / 8; i += gridDim.x * NTH) {
    f32x4 a = *(const f32x4*)(ps + (size_t)i * 8), b = *(const f32x4*)(ps + (size_t)i * 8 + 4);
    *(u32x4*)(p.PB + (size_t)i * 8) = u32x4{pk2(a[0], a[1]), pk2(a[2], a[3]), pk2(b[0], b[1]), pk2(b[2], b[3])};
  }
}

struct CvtJob { const float* src; u16* dst; int k0, n0, drow0; };
DI bool cvt_job(const P& p, int layer, int t, CvtJob& j) {
  if (t >= NE * 3 * 128) return false;
  const int e = t / 384, r = t % 384, mat = r / 128, q = r % 128;
  j.k0 = (q / 8) * 64; j.n0 = (q % 8) * 128;
  const size_t eo = ((size_t)layer * NE + e) * 1024 * 1024;
  if (mat == 0) { j.src = p.exp_w_gate + eo; j.dst = p.EW1 + (size_t)e * 2048 * 1024; j.drow0 = (j.n0 >> 7) * 256; }
  else if (mat == 1) { j.src = p.exp_w_up + eo; j.dst = p.EW1 + (size_t)e * 2048 * 1024; j.drow0 = (j.n0 >> 7) * 256 + 128; }
  else { j.src = p.exp_w_down + eo; j.dst = p.EW2 + (size_t)e * 1024 * 1024; j.drow0 = j.n0; }
  return true;
}
DI void ph_cvt_experts(const P& p, int layer, char* smem, unsigned* ctr) {
  const int tid = tidx();
  short* tl = (short*)smem;
  int* sitem = (int*)(smem + 32768);
  __syncthreads();
  if (tid == 0) sitem[0] = (int)atomicAdd(ctr, 1u);
  __syncthreads();
  CvtJob cur; bool has = cvt_job(p, layer, sitem[0], cur);
  f32x4 v[4];
  const int kr = tid >> 5, nq = tid & 31;
  if (has) {
#pragma unroll
    for (int i = 0; i < 4; ++i) v[i] = *(const f32x4*)(cur.src + (size_t)(cur.k0 + kr + 16 * i) * 1024 + cur.n0 + nq * 4);
  }
  int par = 0;
  while (has) {
    if (tid == 0) sitem[1 + par] = (int)atomicAdd(ctr, 1u);
    __syncthreads();
#pragma unroll
    for (int i = 0; i < 4; ++i)
#pragma unroll
      for (int e = 0; e < 4; ++e) tl[(nq * 4 + e) * 72 + kr + 16 * i] = (short)f2bf(v[i][e]);
    __syncthreads();
    CvtJob nxt; const bool hn = cvt_job(p, layer, sitem[1 + par], nxt);
    if (hn) {
#pragma unroll
      for (int i = 0; i < 4; ++i) v[i] = *(const f32x4*)(nxt.src + (size_t)(nxt.k0 + kr + 16 * i) * 1024 + nxt.n0 + nq * 4);
    }
#pragma unroll
    for (int i = 0; i < 2; ++i) {
      int u = tid + i * NTH; int n = u >> 3, kc = u & 7;
      *(u32x4*)(cur.dst + (size_t)(cur.drow0 + n) * 1024 + cur.k0 + kc * 8) = *(const u32x4*)(tl + n * 72 + kc * 8);
    }
    cur = nxt; has = hn; par ^= 1;
  }
}
DI void ph_gather(const P& p) {
  const int tid_ = tidx(); const int lane = tid_ & 63, w = tid_ >> 6;
  for (int row = blockIdx.x * 8 + w; row < NB * NE * CAP; row += gridDim.x * 8) {
    const int b = row / (NE * CAP);
    const int tok = b * T + p.IDX[row];
    const u32x4* src = (const u32x4*)(p.H + (size_t)tok * DM);
    u32x4* dst = (u32x4*)(p.XE + (size_t)row * DM);
    u32x4 a = src[lane], c = src[lane + 64];
    dst[lane] = a; dst[lane + 64] = c;
  }
}
DI void ph_combine_norm(const P& p, int layer) {
  const int tid_ = tidx(); const int lane = tid_ & 63, w = tid_ >> 6;
  const float* g = p.ple_norm + layer * DM;
  for (int tok = blockIdx.x * 8 + w; tok < NTOK; tok += gridDim.x * 8) {
    f32x4* xr = (f32x4*)(p.out + (size_t)tok * DM);
    f32x4 v[4];
#pragma unroll
    for (int j = 0; j < 4; ++j) v[j] = xr[lane * 4 + j];
    const int cnt = p.TCNT[tok];
    for (int q = 0; q < cnt; ++q) {
      const int yrow = p.TLIST[(size_t)tok * 16 + q];
      const u32x4* yr = (const u32x4*)(p.YE + (size_t)yrow * DM + lane * 16);
      u32x4 a = yr[0], c = yr[1];
#pragma unroll
      for (int e = 0; e < 4; ++e) {
        v[e >> 1][(e & 1) * 2] += __uint_as_float(a[e] << 16); v[e >> 1][(e & 1) * 2 + 1] += __uint_as_float(a[e] & 0xffff0000u);
        v[2 + (e >> 1)][(e & 1) * 2] += __uint_as_float(c[e] << 16); v[2 + (e >> 1)][(e & 1) * 2 + 1] += __uint_as_float(c[e] & 0xffff0000u);
      }
    }
    float ss = 0.f;
#pragma unroll
    for (int j = 0; j < 4; ++j) { xr[lane * 4 + j] = v[j]; ss += v[j][0] * v[j][0] + v[j][1] * v[j][1] + v[j][2] * v[j][2] + v[j][3] * v[j][3]; }
    ss = wave_sum(ss);
    const float rstd = frsq(ss * (1.f / DM) + NORM_EPS);
    u32x4 o0, o1;
#pragma unroll
    for (int j = 0; j < 4; ++j) {
      f32x4 gg = *(const f32x4*)(g + lane * 16 + j * 4);
      unsigned lo = pk2(v[j][0] * rstd * gg[0], v[j][1] * rstd * gg[1]), hi = pk2(v[j][2] * rstd * gg[2], v[j][3] * rstd * gg[3]);
      if (j < 2) { o0[j * 2] = lo; o0[j * 2 + 1] = hi; } else { o1[(j - 2) * 2] = lo; o1[(j - 2) * 2 + 1] = hi; }
    }
    *(u32x4*)(p.H + (size_t)tok * DM + lane * 16) = o0; *(u32x4*)(p.H + (size_t)tok * DM + lane * 16 + 8) = o1;
  }
}

#define XB_TMO      128
#define XB_XCNT(j)  (256  + 64 * (j))
#define XB_XSUB(j)  (1280 + 64 * (j))
#define XB_XGEN(j)  (2304 + 64 * (j))
#define XB_TOP      3328
#define XB_TOPGEN   3392
#define XCD_BAR_WORDS 3456
#define XB_SPIN_CAP (1u << 20)
DI unsigned xb_ld(unsigned* p) { return __hip_atomic_load(p, __ATOMIC_RELAXED, __HIP_MEMORY_SCOPE_AGENT); }
DI unsigned xb_add(unsigned* p, unsigned v) { return __hip_atomic_fetch_add(p, v, __ATOMIC_RELAXED, __HIP_MEMORY_SCOPE_AGENT); }
DI unsigned xb_xcc_id() { return (unsigned)__builtin_amdgcn_s_getreg((3 << 11) | 20) & 0xFu; }
#define XB_SPIN(cond, bar) do { unsigned _sp = 0; while (cond) { __builtin_amdgcn_s_sleep(1); \
    if ((++_sp & 255u) == 0u) { if (xb_ld(&(bar)[XB_TMO])) break; if (_sp > XB_SPIN_CAP) { atomicAdd(&(bar)[XB_TMO], 1u); break; } } } } while (0)
struct XcdBarrier { unsigned* bar; unsigned x; volatile LAS unsigned* st; };
DI XcdBarrier xcd_barrier_post(unsigned* bar, volatile LAS unsigned* st) {
  XcdBarrier b; b.bar = bar; b.x = xb_xcc_id(); b.st = st;
  if (threadIdx.x == 0) (void)xb_add(&bar[XB_XCNT(b.x)], 1u);
  return b;
}
DI void xcd_barrier_complete(unsigned* bar, unsigned x, unsigned& nloc, unsigned& nx) {
  const unsigned G = gridDim.x * gridDim.y * gridDim.z;
  unsigned sum, cnt, mine, sp = 0u;
  for (;;) {
    sum = 0u; cnt = 0u; mine = 0u;
#pragma unroll
    for (unsigned j = 0; j < 16; ++j) { const unsigned c = xb_ld(&bar[XB_XCNT(j)]); sum += c; cnt += (c > 0u) ? 1u : 0u; mine = (j == x) ? c : mine; }
    if (sum == G) break;
    __builtin_amdgcn_s_sleep(1);
    if ((++sp & 255u) == 0u) { if (xb_ld(&bar[XB_TMO])) break; if (sp > XB_SPIN_CAP) { atomicAdd(&bar[XB_TMO], 1u); break; } }
  }
  nloc = mine > 0u ? mine : 1u; nx = cnt > 0u ? cnt : 1u;
}
DI void xcd_barrier(const XcdBarrier& b) {
  asm volatile("s_waitcnt vmcnt(0)" ::: "memory");
  __syncthreads();
  if (threadIdx.x == 0) {
    unsigned* bar = b.bar;
    __builtin_amdgcn_s_waitcnt(0);
    unsigned nloc = b.st[0], nx = b.st[1];
    if (nloc == 0u) { xcd_barrier_complete(bar, b.x, nloc, nx); b.st[0] = nloc; b.st[1] = nx; }
    const unsigned old = xb_add(&bar[XB_XSUB(b.x)], 1u);
    const unsigned gen = old / nloc;
    if (old + 1u == (gen + 1u) * nloc) {
      __builtin_amdgcn_fence(__ATOMIC_RELEASE, "agent");
      asm volatile("s_waitcnt vmcnt(0)" ::: "memory");
      const unsigned og = xb_add(&bar[XB_TOP], 1u);
      const unsigned tg = og / nx;
      if (og + 1u == (tg + 1u) * nx) xb_add(&bar[XB_TOPGEN], 1u);
      else XB_SPIN(xb_ld(&bar[XB_TOPGEN]) == tg, bar);
      __builtin_amdgcn_fence(__ATOMIC_ACQUIRE, "agent");
      xb_add(&bar[XB_XGEN(b.x)], 1u);
      asm volatile("s_waitcnt vmcnt(0)" ::: "memory");
    } else {
      XB_SPIN(xb_ld(&bar[XB_XGEN(b.x)]) == gen, bar);
      __builtin_amdgcn_fence(__ATOMIC_ACQUIRE, "agent");
      asm volatile("s_waitcnt vmcnt(0)" ::: "memory");
    }
  }
  __syncthreads();
}

#define TAKE(bytes) (ws + off); off += (((size_t)(bytes)) + 255) & ~(size_t)255
__host__ __device__ inline size_t fill_ws(P& p, char* ws) {
  size_t off = 0;
  char* regA = TAKE((size_t)NTOK * INC * 4);
  p.Z = (float*)regA;
  p.LW = (u16*)regA; p.AA = (u16*)(regA + (size_t)2 * NTOK * RWW * 2); p.G = (u16*)(regA + (size_t)4 * NTOK * RWW * 2);
  p.MC = (float*)(regA + (size_t)5 * NTOK * RWW * 2); p.NC = p.MC + (size_t)32 * NCH * 4096;
  p.HID = (u16*)regA;
  char* regB = TAKE((size_t)3 * NTOK * RWW * 4);
  p.R = (float*)regB; p.K = p.R + (size_t)NTOK * RWW; p.V = p.K + (size_t)NTOK * RWW;
  p.PG = (float*)regB;
  char* regC = TAKE((size_t)NTOK * (768 + 1024) * 4);
  p.QRAW = (float*)regC; p.KVRAW = p.QRAW + (size_t)NTOK * 768;
  p.AO = (float*)regC; p.O2 = (u16*)(p.AO + (size_t)NTOK * 512); p.SS = (float*)(p.O2 + (size_t)2 * NTOK * 512);
  p.TWD = (u16*)TAKE((size_t)2 * NTOK * 64 * 2); p.AD = (u16*)TAKE((size_t)2 * NTOK * 64 * 2);
  p.SGD = (u16*)TAKE((size_t)NTOK * 128 * 2); p.QDN = (u16*)TAKE((size_t)NTOK * 256 * 2);
  p.KVDN = (u16*)TAKE((size_t)NTOK * 128 * 2); p.KR = (float*)TAKE((size_t)NTOK * 32 * 4);
  p.ROPE = (float*)TAKE((size_t)NTOK * 32 * 4);
  p.Q = (u16*)TAKE((size_t)NTOK * NH * 96 * 2); p.Kc = (u16*)TAKE((size_t)NTOK * NH * 96 * 2);
  p.Vv = (u16*)TAKE((size_t)NTOK * NH * 64 * 2);
  p.H = (u16*)TAKE((size_t)NTOK * DM * 2);
  p.AFF = (float*)TAKE((size_t)NB * NE * T * 4);
  p.IDX = (int*)TAKE((size_t)NB * NE * CAP * 4);
  p.GATE = (float*)TAKE((size_t)NB * NE * CAP * 4);

  p.WIN = (u16*)TAKE((size_t)WIN_PAD * DM * 2); p.WOUT = (u16*)TAKE((size_t)DM * DM * 2); p.WPG = (u16*)TAKE((size_t)DM * DM * 2);
  p.WPP = (u16*)TAKE((size_t)DM * DPLE * 2); p.PB = (u16*)TAKE((size_t)NTOK * DPLE * 2);
  p.PGb = (u16*)regB;
  p.EW1 = (u16*)regB; p.EW2 = p.EW1 + (size_t)NE * 2048 * 1024;
  p.XE = (u16*)regA; p.HID = (u16*)(regA + (size_t)32 * 1024 * 1024 * 2);
  p.YE = (u16*)regC;
  p.TCNT = (int*)TAKE((size_t)NTOK * 4); p.TLIST = (int*)TAKE((size_t)NTOK * 16 * 4);
  p.CTR = (unsigned*)TAKE(256);
  p.BAR = (unsigned*)TAKE(XCD_BAR_WORDS * 4);
  return off;
}
#undef TAKE
constexpr int DSM_BYTES = g8::STAGE_BYTES + 64;
extern __shared__ __attribute__((aligned(16))) char dsm[];
struct PK { const void* in[31]; float* out; char* ws; };
DI void build_params(P& p, const PK& k) {
  p.x = (const float*)k.in[0]; p.p = (const float*)k.in[1]; p.pos = (const int*)k.in[2];
  p.attn_norm = (const float*)k.in[3]; p.w_in = (const float*)k.in[4]; p.rw_mu = (const float*)k.in[5];
  p.rw_w0 = (const float*)k.in[6]; p.rw_w_up = (const float*)k.in[7]; p.rw_a0 = (const float*)k.in[8];
  p.rw_a_up = (const float*)k.in[9]; p.rw_g_up = (const float*)k.in[10]; p.rw_k_k = (const float*)k.in[11];
  p.rw_k_a = (const float*)k.in[12]; p.rw_r_k = (const float*)k.in[13]; p.rw_lnx_w = (const float*)k.in[14];
  p.rw_lnx_b = (const float*)k.in[15]; p.mla_q_norm = (const float*)k.in[16]; p.mla_q_up = (const float*)k.in[17];
  p.mla_kv_norm = (const float*)k.in[18]; p.mla_kv_up = (const float*)k.in[19]; p.mla_o_norm = (const float*)k.in[20];
  p.w_out = (const float*)k.in[21]; p.ffn_norm = (const float*)k.in[22]; p.router = (const float*)k.in[23];
  p.exp_w_gate = (const float*)k.in[24]; p.exp_w_up = (const float*)k.in[25]; p.exp_w_down = (const float*)k.in[26];
  p.ple_norm = (const float*)k.in[27]; p.ple_proj = (const float*)k.in[28]; p.ple_gate = (const float*)k.in[29];
  p.final_norm = (const float*)k.in[30];
  p.out = k.out;
  (void)fill_ws(p, k.ws);
}
__global__ void __launch_bounds__(NTH) mega(PK pk) {
  P p; build_params(p, pk);
  char* smem = dsm;
  LAS unsigned char* glds = (LAS unsigned char*)dsm;
  uint4* xbw = (uint4*)(dsm + g8::STAGE_BYTES);
  cg::grid_group grid = cg::this_grid();
  if (threadIdx.x == 0) *xbw = make_uint4(0u, 0u, 0u, 0u);
  if (blockIdx.x == 0) {
    if (threadIdx.x < 16) p.CTR[threadIdx.x] = 0u;
    for (int i = threadIdx.x; i < XCD_BAR_WORDS; i += NTH) p.BAR[i] = 0u;
  }
  grid.sync();
  const XcdBarrier xb = xcd_barrier_post(p.BAR, (volatile LAS unsigned*)xbw);
#define GSYNC() xcd_barrier(xb)
#ifndef PROBE_MASK
#define PROBE_MASK 0u
#endif
#if PROBE_MASK
  unsigned long long pt0 = __builtin_amdgcn_s_memrealtime();
#define PSYNC(id) do { GSYNC(); if (PROBE_MASK & (1u << (id))) { unsigned long long t1_ = __builtin_amdgcn_s_memrealtime(); unsigned long long dt_ = t1_ - pt0; \
    while (__builtin_amdgcn_s_memrealtime() - t1_ < dt_) __builtin_amdgcn_s_sleep(8); } pt0 = __builtin_amdgcn_s_memrealtime(); } while (0)
#else
#define PSYNC(id) GSYNC()
#endif
  for (int layer_ = 0; layer_ < NL; ++layer_) {
    int layer = layer_; asm volatile("" : "+s"(layer));
    if (layer_ == 0) ph_rope_table(p);
    ph_cvt_small(p, layer, smem);
    ph_norm(layer == 0 ? p.x : p.out, p.attn_norm + layer * DM, p.H);
    PSYNC(0);
    {
      g8::Sched S; S.init(NTOK / 256, WIN_PAD / 256, gridDim.x, bidx(), p.H, p.WIN, DM);
      g8::EpiZ E{p.Z};
      g8::gemm_phase(glds, DM, S, E);
    }
    PSYNC(1);
    ph_rwshift(p, layer);
    ph_mlaprep1(p, layer);
    PSYNC(2);
    for (int d = 0; d < 2; ++d) {
      u16* LW = p.LW + (size_t)d * NTOK * RWW; const float* w0 = p.rw_w0 + (layer * 2 + d) * RWW;
      ph_gemm<false>(p.TWD + (size_t)d * NTOK * 64, 64, p.rw_w_up + ((size_t)(layer * 2 + d)) * 64 * RWW, RWW, NTOK, RWW, 64, smem,
                     [&](int row, int col, float v) { LW[(size_t)row * RWW + col] = f2bf(-0.6065306597126334f * sigmoidf_(v + w0[col])); });
      u16* AA = p.AA + (size_t)d * NTOK * RWW; const float* a0 = p.rw_a0 + (layer * 2 + d) * RWW;
      ph_gemm<false>(p.AD + (size_t)d * NTOK * 64, 64, p.rw_a_up + ((size_t)(layer * 2 + d)) * 64 * RWW, RWW, NTOK, RWW, 64, smem,
                     [&](int row, int col, float v) { AA[(size_t)row * RWW + col] = f2bf(sigmoidf_(v + a0[col])); });
    }
    {
      u16* G = p.G;
      ph_gemm<false>(p.SGD, 128, p.rw_g_up + (size_t)layer * 128 * RWW, RWW, NTOK, RWW, 128, smem,
                     [&](int row, int col, float v) { G[(size_t)row * RWW + col] = f2bf(v); });
      {
        u16* Qo = p.Q; const float* rope = p.ROPE;
        ph_gemm_t(p.QDN, 256, p.mla_q_up + (size_t)layer * 256 * 768, 768, NTOK, 768, 256, smem,
                  [&](const f32x4 (&acc)[4][4], int m0, int n0, int wm, int wn, int lq, int l15) {
          const float qs = 0.10206207261596577f * 1.4426950408889634f;
#pragma unroll
          for (int mi = 0; mi < 4; ++mi)
#pragma unroll
            for (int r = 0; r < 4; ++r) {
              const int tok = m0 + wm * 64 + mi * 16 + lq * 4 + r; const int b = tok / T, t = tok % T;
#pragma unroll
              for (int ni = 0; ni < 4; ++ni) {
                const int col0 = n0 + wn * 64 + ni * 16; const int h = col0 / 96, c0 = col0 % 96;
                u16* qo = Qo + ((size_t)(b * NH + h) * T + t) * 96;
                if (c0 < 64) qo[c0 + l15] = f2bf(acc[mi][ni][r] * qs);
                else if (c0 == 64) {
                  const f32x2 csn = *(const f32x2*)(rope + (size_t)tok * 32 + l15 * 2);
                  const float u1 = acc[mi][ni][r], u2 = acc[mi][(ni + 1) & 3][r];
                  qo[64 + l15] = f2bf((u1 * csn[0] - u2 * csn[1]) * qs);
                  qo[80 + l15] = f2bf((u1 * csn[1] + u2 * csn[0]) * qs);
                }
              }
            }
        });
      }
      {
        u16* Ko = p.Kc; u16* Vo = p.Vv;
        ph_gemm_t(p.KVDN, 128, p.mla_kv_up + (size_t)layer * 128 * 1024, 1024, NTOK, 1024, 128, smem,
                  [&](const f32x4 (&acc)[4][4], int m0, int n0, int wm, int wn, int lq, int l15) {
#pragma unroll
          for (int mi = 0; mi < 4; ++mi)
#pragma unroll
            for (int r = 0; r < 4; ++r) {
              const int tok = m0 + wm * 64 + mi * 16 + lq * 4 + r; const int b = tok / T, t = tok % T;
#pragma unroll
              for (int ni = 0; ni < 4; ++ni) {
                const int col0 = n0 + wn * 64 + ni * 16; const int h = col0 >> 7, c0 = col0 & 127;
                const size_t rowi = (size_t)(b * NH + h) * T + t;
                if (c0 < 64) Ko[rowi * 96 + c0 + l15] = f2bf(acc[mi][ni][r]);
                else Vo[rowi * 64 + (c0 - 64) + l15] = f2bf(acc[mi][ni][r]);
              }
            }
        });
      }
    }
    PSYNC(3);
    ph_scan1(p, layer, smem);
    PSYNC(4);
    ph_scan2(p, smem);
    ph_attn(p, smem, p.CTR + layer);
    PSYNC(5);
    ph_mla_norm(p, layer);
    ph_scan3(p, layer, smem);
    PSYNC(6);
    {
      for (int i = blockIdx.x * NTH + tidx(); i < NTOK; i += gridDim.x * NTH) p.TCNT[i] = 0;
      g8::Sched S; S.init(NTOK / 256, DM / 256, gridDim.x, bidx(), p.H, p.WOUT, DM);
      g8::EpiRes E{(layer == 0) ? p.x : p.out, p.out};
      g8::gemm_phase(glds, DM, S, E);
    }
    PSYNC(8);
    ph_norm_router(p, layer, smem);
    PSYNC(9);
    ph_topk(p, smem);
    ph_cvt_experts(p, layer, smem, p.CTR + 4 + layer);
    PSYNC(10);
    ph_gather(p);
    PSYNC(11);
    {
      g8::Sched S; S.init(NB * NE * CAP / 256, 2048 / 256, gridDim.x, bidx(), p.XE, p.EW1, DM);
      S.group(4, NE, (size_t)2048 * 1024 * 2);
      g8::EpiSwi E{p.HID};
      g8::gemm_phase(glds, DM, S, E);
    }
    PSYNC(12);
    {
      g8::Sched S; S.init(NB * NE * CAP / 256, DM / 256, gridDim.x, bidx(), p.HID, p.EW2, 1024);
      S.group(4, NE, (size_t)1024 * 1024 * 2);
      g8::EpiYE E{p.YE, p.GATE};
      g8::gemm_phase(glds, 1024, S, E);
    }
    PSYNC(13);
    ph_combine_norm(p, layer);
    PSYNC(16);
    {
      g8::Sched S; S.init(NTOK / 256, DM / 256, gridDim.x, bidx(), p.H, p.WPG, DM);
      g8::EpiSig E{p.PGb};
      g8::gemm_phase(glds, DM, S, E);
    }
    {
      g8::Sched S; S.init(NTOK / 256, DM / 256, gridDim.x, bidx(), p.PB, p.WPP, DPLE);
      g8::EpiPle E{p.out, p.PGb};
      g8::gemm_phase(glds, DPLE, S, E);
    }
    PSYNC(15);
  }
  ph_final_norm(p.out, p.final_norm);
}

extern "C" void kernel_launch(void* const* d_in, const int* in_sizes, int n_in, void* d_out, int out_size, void* d_ws,
                              size_t ws_size, hipStream_t stream) {
  (void)in_sizes; (void)n_in; (void)out_size;
  PK pk{};
  for (int i = 0; i < 31; ++i) pk.in[i] = d_in[i];
  pk.out = (float*)d_out; pk.ws = (char*)d_ws;
  P p{};
  const size_t off = fill_ws(p, (char*)d_ws);
  if (off > ws_size) { fprintf(stderr, "workspace too small: need %zu have %zu\n", off, ws_size); return; }
  static int grid_blocks = 0;
  if (!grid_blocks) {
    int dev = 0, cus = 0, per_cu = 0;
    hipGetDevice(&dev);
    hipDeviceGetAttribute(&cus, hipDeviceAttributeMultiprocessorCount, dev);
    hipFuncSetAttribute((const void*)mega, hipFuncAttributeMaxDynamicSharedMemorySize, DSM_BYTES);
    hipOccupancyMaxActiveBlocksPerMultiprocessor(&per_cu, mega, NTH, DSM_BYTES);
    if (per_cu > 1) per_cu = 1;
    grid_blocks = cus * per_cu;
  }
  void* args[] = {&pk};
  hipError_t e = hipLaunchCooperativeKernel((void*)mega, dim3(grid_blocks), dim3(NTH), args, DSM_BYTES, stream);
  if (e != hipSuccess) fprintf(stderr, "cooperative launch failed: %s (grid %d)\n", hipGetErrorString(e), grid_blocks);
}
```

```cpp
#include <hip/hip_runtime.h>
#include <hip/hip_bf16.h>
#include <cstdio>
#include <cstdint>
#include <hip/hip_cooperative_groups.h>
namespace cg = cooperative_groups;

#define DI __device__ __forceinline__
#define LAS __attribute__((address_space(3)))

constexpr int NB = 2, T = 8192, NTOK = NB * T, DM = 1024, NL = 2;
constexpr int RWW = 512, RWC = 1920, INC = 2336;
constexpr int NH = 8;
constexpr int NE = 16, CAP = 1024;
constexpr int DPLE = 256;
constexpr int NTH = 512;
constexpr float NORM_EPS = 1e-6f, GN_EPS = 64e-5f;

using bf16x8 = __attribute__((ext_vector_type(8))) short;
using s16x4  = __attribute__((ext_vector_type(4))) short;
using f32x4  = __attribute__((ext_vector_type(4))) float;
using u32x4  = __attribute__((ext_vector_type(4))) unsigned;
using f32x2  = __attribute__((ext_vector_type(2))) float;
using u32x2  = __attribute__((ext_vector_type(2))) unsigned;
typedef __bf16 bf2_t __attribute__((ext_vector_type(2)));
typedef unsigned short u16;

DI unsigned pk2(float a, float b) { bf2_t v = {(__bf16)a, (__bf16)b}; return __builtin_bit_cast(unsigned, v); }
DI u16 f2bf(float a) { return (u16)(pk2(a, 0.f) & 0xffffu); }
DI float bf2f(u16 u) { return __uint_as_float(((unsigned)u) << 16); }
DI const void* uni_ptr(const void* q) {
  unsigned long long v = (unsigned long long)q;
  unsigned lo = __builtin_amdgcn_readfirstlane((unsigned)v), hi = __builtin_amdgcn_readfirstlane((unsigned)(v >> 32));
  return (const void*)(((unsigned long long)hi << 32) | lo);
}
DI int tidx() { int t = threadIdx.x; asm volatile("" : "+v"(t)); return t; }
DI int bidx() { int b = blockIdx.x; asm volatile("" : "+s"(b)); return b; }
template <int CTRL> DI float dpp_f(float v) {
  return __int_as_float(__builtin_amdgcn_update_dpp(__float_as_int(v), __float_as_int(v), CTRL, 0xF, 0xF, true));
}
DI float red_x1(float v) { return v + dpp_f<0xB1>(v); }
DI float red_x2(float v) { return v + dpp_f<0x4E>(v); }
DI float red_x4(float v) { return v + dpp_f<0x141>(v); }
DI float red_x8(float v) { return v + dpp_f<0x140>(v); }
DI float red_x16(float v) { auto r = __builtin_amdgcn_permlane16_swap(__float_as_uint(v), __float_as_uint(v), false, false); return __uint_as_float(r[0]) + __uint_as_float(r[1]); }
DI float red_x32(float v) { auto r = __builtin_amdgcn_permlane32_swap(__float_as_uint(v), __float_as_uint(v), false, false); return __uint_as_float(r[0]) + __uint_as_float(r[1]); }
DI float red16(float v) { return red_x8(red_x4(red_x2(red_x1(v)))); }
DI float wave_sum(float v) { return red_x32(red_x16(red16(v))); }
DI float frcp(float x) { return __builtin_amdgcn_rcpf(x); }
DI float frsq(float x) { return __builtin_amdgcn_rsqf(x); }
DI float fexp(float x) { return __builtin_amdgcn_exp2f(x * 1.4426950408889634f); }
DI float sigmoidf_(float x) { return frcp(1.f + fexp(-x)); }
DI float ftanh(float x) { return 1.f - 2.f * frcp(1.f + fexp(2.f * x)); }
DI s16x4 tr_read(const short* p) {
  return __builtin_amdgcn_ds_read_tr16_b64_v4i16((LAS s16x4*)(p));
}

struct P {
  const float* x; const float* p; const int* pos;
  const float* attn_norm; const float* w_in; const float* rw_mu; const float* rw_w0; const float* rw_w_up;
  const float* rw_a0; const float* rw_a_up; const float* rw_g_up; const float* rw_k_k; const float* rw_k_a;
  const float* rw_r_k; const float* rw_lnx_w; const float* rw_lnx_b; const float* mla_q_norm; const float* mla_q_up;
  const float* mla_kv_norm; const float* mla_kv_up; const float* mla_o_norm; const float* w_out; const float* ffn_norm;
  const float* router; const float* exp_w_gate; const float* exp_w_up; const float* exp_w_down; const float* ple_norm;
  const float* ple_proj; const float* ple_gate; const float* final_norm;
  float* out;
  float* Z;
  u16* LW;
  u16* AA;
  float* MC; float* NC;
  float* SS;
  u16*   G;
  u16*   HID;
  float* R; float* K; float* V;
  float* PG;
  float* QRAW;
  float* KVRAW;
  float* AO;
  u16* O2;
  u16* TWD; u16* AD; u16* SGD; u16* QDN; u16* KVDN; float* KR;
  float* ROPE;
  u16* Q; u16* Kc; u16* Vv;
  u16* H;
  float* AFF;
  int* IDX;
  float* GATE;
  u16* WIN; u16* WOUT; u16* WPG; u16* WPP; u16* PB;
  u16* PGb;
  u16* EW1; u16* EW2;
  u16* XE; u16* YE;
  int* TCNT; int* TLIST;
  unsigned* CTR;
  unsigned* BAR;
};

constexpr int GBM = 256, GBN = 128, GBK = 64;
constexpr int AS_STRIDE = 72, BS_STRIDE = 136;
constexpr int AS_BYTES = GBM * AS_STRIDE * 2;
constexpr int BS_BYTES = GBK * BS_STRIDE * 2;
constexpr int SMEM_BYTES = 57344;

template <bool A_F32, int MODE, class ARow, class Epi>
DI void gemm_tile(ARow arow, const float* __restrict__ B, const float* __restrict__ B2, int ldb, int K, int n0, int Nvalid,
                  char* smem, Epi epi) {
  short* As = (short*)smem;
  short* Bs = (short*)(smem + AS_BYTES);
  const int tid = tidx(), lane = tid & 63, w = tid >> 6;
  const int wm = w >> 1, wn = w & 1;
  const int l15 = lane & 15, lq = lane >> 4;

  const char* ap[4];
#pragma unroll
  for (int i = 0; i < 4; ++i) {
    int u = tid + i * NTH; int row = u >> 3, kc = u & 7;
    ap[i] = (const char*)arow(row) + (size_t)kc * 8 * (A_F32 ? 4 : 2);
  }
  const float* bp[4]; bool bok[4];
#pragma unroll
  for (int i = 0; i < 4; ++i) {
    int u = tid + i * NTH; int k = u >> 5, nq = u & 31;
    int col; const float* base;
    if (MODE != 1) { col = n0 + nq * 4; base = B; }
    else { col = n0 + (nq & 15) * 4; base = (nq < 16) ? B : B2; }
    bok[i] = col < Nvalid;
    bp[i] = base + (size_t)k * ldb + (bok[i] ? col : 0);
  }

  f32x4 acc[4][4];
#pragma unroll
  for (int i = 0; i < 4; ++i)
#pragma unroll
    for (int j = 0; j < 4; ++j) acc[i][j] = f32x4{0.f, 0.f, 0.f, 0.f};

  u32x4 areg[4]; f32x4 breg[4];
#define GLOAD(kt_)                                                                                   \
  {                                                                                                  \
    _Pragma("unroll") for (int i = 0; i < 4; ++i) {                                                  \
      if (A_F32) {                                                                                   \
        const float4* q = (const float4*)(ap[i] + (size_t)(kt_) * GBK * 4);                          \
        float4 v0 = q[0], v1 = q[1];                                                                 \
        areg[i] = u32x4{pk2(v0.x, v0.y), pk2(v0.z, v0.w), pk2(v1.x, v1.y), pk2(v1.z, v1.w)};         \
      } else {                                                                                       \
        areg[i] = *(const u32x4*)(ap[i] + (size_t)(kt_) * GBK * 2);                                  \
      }                                                                                              \
    }                                                                                                \
    _Pragma("unroll") for (int i = 0; i < 4; ++i) {                                                  \
      if (bok[i]) breg[i] = *(const f32x4*)(bp[i] + (size_t)(kt_) * GBK * ldb);                      \
      else breg[i] = f32x4{0.f, 0.f, 0.f, 0.f};                                                      \
    }                                                                                                \
  }
  const int nk = K / GBK;
  GLOAD(0)
  for (int kt = 0; kt < nk; ++kt) {
    __syncthreads();
#pragma unroll
    for (int i = 0; i < 4; ++i) {
      int u = tid + i * NTH; int row = u >> 3, kc = u & 7;
      *(u32x4*)(As + row * AS_STRIDE + kc * 8) = areg[i];
    }
#pragma unroll
    for (int i = 0; i < 4; ++i) {
      int u = tid + i * NTH; int k = u >> 5, nq = u & 31;
      u32x2 v = u32x2{pk2(breg[i][0], breg[i][1]), pk2(breg[i][2], breg[i][3])};
      *(u32x2*)(Bs + k * BS_STRIDE + nq * 4) = v;
    }
    __syncthreads();
    if (kt + 1 < nk) GLOAD(kt + 1)
#pragma unroll
    for (int ks = 0; ks < 2; ++ks) {
      bf16x8 a[4], b[4];
#pragma unroll
      for (int mi = 0; mi < 4; ++mi)
        a[mi] = *(const bf16x8*)(As + (wm * 64 + mi * 16 + l15) * AS_STRIDE + ks * 32 + 8 * lq);
#pragma unroll
      for (int ni = 0; ni < 4; ++ni) {
        int col0 = (MODE != 1) ? (wn * 64 + ni * 16) : ((ni < 2) ? (wn * 32 + ni * 16) : (64 + wn * 32 + (ni - 2) * 16));
        int kb = ks * 32 + 8 * lq; int q = l15 >> 2, pp = l15 & 3;
        s16x4 lo = tr_read(Bs + (kb + q) * BS_STRIDE + col0 + 4 * pp);
        s16x4 hi = tr_read(Bs + (kb + 4 + q) * BS_STRIDE + col0 + 4 * pp);
        b[ni] = __builtin_shufflevector(lo, hi, 0, 1, 2, 3, 4, 5, 6, 7);
      }
#pragma unroll
      for (int mi = 0; mi < 4; ++mi)
#pragma unroll
        for (int ni = 0; ni < 4; ++ni)
          acc[mi][ni] = __builtin_amdgcn_mfma_f32_16x16x32_bf16(a[mi], b[ni], acc[mi][ni], 0, 0, 0);
    }
  }
  if constexpr (MODE == 2) { epi(acc, wm, wn, lq, l15); return; }
  else {
#pragma unroll
  for (int mi = 0; mi < 4; ++mi)
#pragma unroll
    for (int r = 0; r < 4; ++r) {
      int row = wm * 64 + mi * 16 + lq * 4 + r;
      if (MODE == 0) {
#pragma unroll
        for (int ni = 0; ni < 4; ++ni) {
          int col = n0 + wn * 64 + ni * 16 + l15;
          if (col < Nvalid) epi(row, col, acc[mi][ni][r], 0.f);
        }
      } else {
#pragma unroll
        for (int ni = 0; ni < 2; ++ni) {
          int col = n0 + wn * 32 + ni * 16 + l15;
          epi(row, col, acc[mi][ni][r], acc[mi][ni + 2][r]);
        }
      }
    }
  }
}

DI void ph_norm(const float* __restrict__ X, const float* __restrict__ g, u16* __restrict__ Hout) {
  const int tid_ = tidx(); const int lane = tid_ & 63, w = tid_ >> 6;
  for (int tok = blockIdx.x * 8 + w; tok < NTOK; tok += gridDim.x * 8) {
    const float4* xr = (const float4*)(X + (size_t)tok * DM);
    float4 v[4]; float ss = 0.f;
#pragma unroll
    for (int j = 0; j < 4; ++j) { v[j] = xr[lane + 64 * j]; ss += v[j].x * v[j].x + v[j].y * v[j].y + v[j].z * v[j].z + v[j].w * v[j].w; }
    ss = wave_sum(ss);
    float rstd = frsq(ss * (1.f / DM) + NORM_EPS);
#pragma unroll
    for (int j = 0; j < 4; ++j) {
      float4 gg = ((const float4*)g)[lane + 64 * j];
      uint2 o = uint2{pk2(v[j].x * rstd * gg.x, v[j].y * rstd * gg.y), pk2(v[j].z * rstd * gg.z, v[j].w * rstd * gg.w)};
      *(uint2*)(Hout + (size_t)tok * DM + (lane + 64 * j) * 4) = o;
    }
  }
}

DI void ph_final_norm(float* __restrict__ X, const float* __restrict__ g) {
  const int tid_ = tidx(); const int lane = tid_ & 63, w = tid_ >> 6;
  for (int tok = blockIdx.x * 8 + w; tok < NTOK; tok += gridDim.x * 8) {
    float4* xr = (float4*)(X + (size_t)tok * DM);
    float4 v[4]; float ss = 0.f;
#pragma unroll
    for (int j = 0; j < 4; ++j) { v[j] = xr[lane + 64 * j]; ss += v[j].x * v[j].x + v[j].y * v[j].y + v[j].z * v[j].z + v[j].w * v[j].w; }
    ss = wave_sum(ss);
    float rstd = frsq(ss * (1.f / DM) + NORM_EPS);
#pragma unroll
    for (int j = 0; j < 4; ++j) {
      float4 gg = ((const float4*)g)[lane + 64 * j];
      xr[lane + 64 * j] = float4{v[j].x * rstd * gg.x, v[j].y * rstd * gg.y, v[j].z * rstd * gg.z, v[j].w * rstd * gg.w};
    }
  }
}

template <bool A_F32, class Epi>
DI void ph_gemm(const void* A, int lda, const float* B, int ldb, int M, int N, int K, char* smem, Epi epi) {
  const int ntn = (N + GBN - 1) / GBN, ntm = M / GBM;
  for (int t = blockIdx.x; t < ntm * ntn; t += gridDim.x) {
    int tm = t / ntn, tn = t % ntn;
    int m0 = tm * GBM, n0 = tn * GBN;
    auto arow = [&](int r) -> const void* { return (const char*)A + (size_t)(m0 + r) * lda * (A_F32 ? 4 : 2); };
    gemm_tile<A_F32, 0>(arow, B, nullptr, ldb, K, n0, N, smem, [&](int row, int col, float v, float) { epi(m0 + row, col, v); });
    __syncthreads();
  }
}

template <class Epi>
DI void ph_gemm_t(const void* A, int lda, const float* B, int ldb, int M, int N, int K, char* smem, Epi epi) {
  const int ntn = (N + GBN - 1) / GBN, ntm = M / GBM;
  for (int t = blockIdx.x; t < ntm * ntn; t += gridDim.x) {
    int tm = t / ntn, tn = t % ntn;
    int m0 = tm * GBM, n0 = tn * GBN;
    auto arow = [&](int r) -> const void* { return (const char*)A + (size_t)(m0 + r) * lda * 2; };
    gemm_tile<false, 2>(arow, B, nullptr, ldb, K, n0, N, smem,
                        [&](const f32x4 (&acc)[4][4], int wm, int wn, int lq, int l15) { epi(acc, m0, n0, wm, wn, lq, l15); });
    __syncthreads();
  }
}

DI void ph_rwshift(const P& p, int layer) {
  const float* mu = p.rw_mu + layer * RWC;
  const int total = NTOK * (RWC / 4);
  const int tid_ = tidx();
  for (int i = blockIdx.x * NTH + tid_; i < total; i += gridDim.x * NTH) {
    int tok = i / (RWC / 4), c = (i % (RWC / 4)) * 4;
    int t = tok % T;
    const float* zr = p.Z + (size_t)tok * INC + c;
    float4 z = *(const float4*)zr;
    float4 zm = (t > 0) ? *(const float4*)(zr - INC) : float4{0.f, 0.f, 0.f, 0.f};
    float4 zp = (t < T - 1) ? *(const float4*)(zr + INC) : float4{0.f, 0.f, 0.f, 0.f};
    float4 m = *(const float4*)(mu + c);
    float4 o;
    o.x = z.x + m.x * (0.5f * (zm.x + zp.x) - z.x);
    o.y = z.y + m.y * (0.5f * (zm.y + zp.y) - z.y);
    o.z = z.z + m.z * (0.5f * (zm.z + zp.z) - z.z);
    o.w = z.w + m.w * (0.5f * (zm.w + zp.w) - z.w);
    if (c < 512) *(float4*)(p.R + (size_t)tok * RWW + c) = o;
    else if (c < 1024) *(float4*)(p.K + (size_t)tok * RWW + (c - 512)) = o;
    else if (c < 1536) *(float4*)(p.V + (size_t)tok * RWW + (c - 1024)) = o;
    else if (c < 1664) {
      int d = (c - 1536) >> 6, l = (c - 1536) & 63;
      *(uint2*)(p.TWD + ((size_t)d * NTOK + tok) * 64 + l) = uint2{pk2(ftanh(o.x), ftanh(o.y)), pk2(ftanh(o.z), ftanh(o.w))};
    } else if (c < 1792) {
      int d = (c - 1664) >> 6, l = (c - 1664) & 63;
      *(uint2*)(p.AD + ((size_t)d * NTOK + tok) * 64 + l) = uint2{pk2(o.x, o.y), pk2(o.z, o.w)};
    } else {
      int l = c - 1792;
      *(uint2*)(p.SGD + (size_t)tok * 128 + l) = uint2{pk2(sigmoidf_(o.x), sigmoidf_(o.y)), pk2(sigmoidf_(o.z), sigmoidf_(o.w))};
    }
  }
}

DI void rope_cs(int pos, int i, float& cs, float& sn) {
  const int i3 = i & 3, i2 = i >> 2;
  const float c4 = (i3 == 0) ? 1.0f : (i3 == 1) ? 0.5623413251903491f : (i3 == 2) ? 0.31622776601683794f : 0.1778279410038923f;
  const float p10 = (i2 == 0) ? 1.0f : (i2 == 1) ? 0.1f : (i2 == 2) ? 0.01f : 0.001f;
  float inv = c4 * p10;
  float ang = (float)pos * inv;
  double rev = (double)ang * 0.15915494309189535;
  rev -= floor(rev);
  float rf = (float)rev;
  sn = __builtin_amdgcn_sinf(rf);
  cs = __builtin_amdgcn_cosf(rf);
}

DI void ph_rope_table(const P& p) {
  for (int i = blockIdx.x * NTH + tidx(); i < NTOK * 16; i += gridDim.x * NTH) {
    float cs, sn; rope_cs(p.pos[i >> 4], i & 15, cs, sn);
    *(f32x2*)(p.ROPE + (size_t)i * 2) = f32x2{cs, sn};
  }
}
DI void ph_mlaprep1(const P& p, int layer) {
  const int tid_ = tidx(); const int lane = tid_ & 63, w = tid_ >> 6;
  const float* qn = p.mla_q_norm + layer * 256;
  const float* kvn = p.mla_kv_norm + layer * 128;
  for (int tok = blockIdx.x * 8 + w; tok < NTOK; tok += gridDim.x * 8) {
    const float* zr = p.Z + (size_t)tok * INC + RWC;
    float4 q = *(const float4*)(zr + lane * 4);
    float ss = wave_sum(q.x * q.x + q.y * q.y + q.z * q.z + q.w * q.w);
    float rstd = frsq(ss * (1.f / 256) + NORM_EPS);
    float4 g = *(const float4*)(qn + lane * 4);
    *(uint2*)(p.QDN + (size_t)tok * 256 + lane * 4) = uint2{pk2(q.x * rstd * g.x, q.y * rstd * g.y), pk2(q.z * rstd * g.z, q.w * rstd * g.w)};
    float2 kv = *(const float2*)(zr + 256 + lane * 2);
    float ss2 = wave_sum(kv.x * kv.x + kv.y * kv.y);
    float rstd2 = frsq(ss2 * (1.f / 128) + NORM_EPS);
    float2 g2 = *(const float2*)(kvn + lane * 2);
    *(unsigned*)(p.KVDN + (size_t)tok * 128 + lane * 2) = pk2(kv.x * rstd2 * g2.x, kv.y * rstd2 * g2.y);
    if (lane < 16) {
      float u1 = zr[384 + lane], u2 = zr[384 + 16 + lane];
      const f32x2 csn = *(const f32x2*)(p.ROPE + (size_t)tok * 32 + lane * 2);
      const u16 k1 = f2bf(u1 * csn[0] - u2 * csn[1]), k2 = f2bf(u1 * csn[1] + u2 * csn[0]);
      const int bb = tok / T, tt = tok % T;
#pragma unroll
      for (int h = 0; h < NH; ++h) {
        u16* ko = p.Kc + ((size_t)(bb * NH + h) * T + tt) * 96 + 64;
        ko[lane] = k1; ko[16 + lane] = k2;
      }
    }
  }
}

DI void ph_mlafinish(const P& p) {
  const int tid_ = tidx(); const int lane = tid_ & 63, w = tid_ >> 6;
  const float qs = 0.10206207261596577f * 1.4426950408889634f;
  for (int tok = blockIdx.x * 8 + w; tok < NTOK; tok += gridDim.x * 8) {
    int b = tok / T, t = tok % T;
    float cs = 0.f, sn = 0.f;
    if (lane < 16) rope_cs(p.pos[tok], lane, cs, sn);
    const float* qr = p.QRAW + (size_t)tok * 768;
    const float* kvr = p.KVRAW + (size_t)tok * 1024;
    const float* kr = p.KR + (size_t)tok * 32;
#pragma unroll
    for (int h = 0; h < NH; ++h) {
      size_t row = ((size_t)(b * NH + h) * T + t);
      u16* qo = p.Q + row * 96; u16* ko = p.Kc + row * 96; u16* vo = p.Vv + row * 64;
      qo[lane] = f2bf(qr[h * 96 + lane] * qs);
      ko[lane] = f2bf(kvr[h * 128 + lane]);
      vo[lane] = f2bf(kvr[h * 128 + 64 + lane]);
      if (lane < 16) {
        float u1 = qr[h * 96 + 64 + lane], u2 = qr[h * 96 + 80 + lane];
        qo[64 + lane] = f2bf((u1 * cs - u2 * sn) * qs);
        qo[80 + lane] = f2bf((u1 * sn + u2 * cs) * qs);
      }
      if (lane < 32) ko[64 + lane] = f2bf(kr[lane]);
    }
  }
}

using f32x16 = __attribute__((ext_vector_type(16))) float;
#define SBAR() __builtin_amdgcn_sched_barrier(0)
constexpr int AT_KSTR = 104;
constexpr int AT_KBYTES = 64 * AT_KSTR * 2;
constexpr int AT_VBYTES = 64 * 64 * 2;
constexpr float AT_THR = 8.f;
DI int crow(int r, int hi) { return (r & 3) + 8 * (r >> 2) + 4 * hi; }
DI int v_st(int k, int c) { const int kk = (k & ~0xC) | ((k & 4) << 1) | ((k & 8) >> 1); return ((kk >> 3) * 2 + (c >> 5)) * 512 + ((kk & 7) * 32 + (c & 31)) * 2; }
DI int v_rd_base(int lane) { return ((lane & 3) << 3) | (((lane >> 2) & 3) << 6) | (((lane >> 4) & 1) << 5) | (((lane >> 5) & 1) << 8); }
constexpr int v_rd_off(int d0, int ks, int half) { return d0 * 512 + ks * 2048 + half * 1024; }

DI void at_partialSM(f32x16& p0, f32x16& p1, float& m_reg, float& mn, float& alpha) {
  float pmax = p0[0];
#pragma unroll
  for (int r = 1; r < 16; ++r) pmax = fmaxf(pmax, p0[r]);
#pragma unroll
  for (int r = 0; r < 16; ++r) pmax = fmaxf(pmax, p1[r]);
  { auto rr = __builtin_amdgcn_permlane32_swap(__float_as_uint(pmax), __float_as_uint(pmax), false, false);
    pmax = fmaxf(__uint_as_float(rr[0]), __uint_as_float(rr[1])); }
  if (__builtin_expect(__all(pmax - m_reg <= AT_THR), 1)) { mn = m_reg; alpha = 1.f; }
  else { mn = fmaxf(m_reg, pmax); alpha = __builtin_amdgcn_exp2f(m_reg - mn); m_reg = mn; }
#pragma unroll
  for (int r = 0; r < 16; ++r) { p0[r] = p0[r] - mn; p1[r] = p1[r] - mn; }
#pragma unroll
  for (int r = 0; r < 16; ++r) p0[r] = __builtin_amdgcn_exp2f(p0[r]);
}
DI void at_finishSM(f32x16& p0, f32x16& p1, float alpha, float& l_reg, bf16x8& pa0, bf16x8& pa1, bf16x8& pa2, bf16x8& pa3) {
#pragma unroll
  for (int r = 0; r < 16; ++r) p1[r] = __builtin_amdgcn_exp2f(p1[r]);
  float ps = 0;
#pragma unroll
  for (int r = 0; r < 16; ++r) ps += p0[r];
#pragma unroll
  for (int r = 0; r < 16; ++r) ps += p1[r];
  { auto rr = __builtin_amdgcn_permlane32_swap(__float_as_uint(ps), __float_as_uint(ps), false, false);
    ps = __uint_as_float(rr[0]) + __uint_as_float(rr[1]); }
  l_reg = l_reg * alpha + ps;
#define PK4(PP, BASE, OUT) do { unsigned a0 = pk2(PP[BASE + 0], PP[BASE + 1]), a1 = pk2(PP[BASE + 2], PP[BASE + 3]);   \
    unsigned b0 = pk2(PP[BASE + 4], PP[BASE + 5]), b1 = pk2(PP[BASE + 6], PP[BASE + 7]);                              \
    auto r0 = __builtin_amdgcn_permlane32_swap(a0, b0, false, false); auto r1 = __builtin_amdgcn_permlane32_swap(a1, b1, false, false); \
    u32x4 wv = {r0[0], r1[0], r0[1], r1[1]}; OUT = __builtin_bit_cast(bf16x8, wv); } while (0)
  PK4(p0, 0, pa0); PK4(p0, 8, pa1); PK4(p1, 0, pa2); PK4(p1, 8, pa3);
#undef PK4
}
DI void at_qkt(f32x16& p0, f32x16& p1, const char* Kb, const bf16x8* qr, int r32, int hi) {
#pragma unroll
  for (int r = 0; r < 16; ++r) { p0[r] = 0.f; p1[r] = 0.f; }
#pragma unroll
  for (int d0 = 0; d0 < 6; ++d0) {
    bf16x8 b0 = *(const bf16x8*)(Kb + (r32 * AT_KSTR + d0 * 16 + hi * 8) * 2);
    bf16x8 b1 = *(const bf16x8*)(Kb + ((32 + r32) * AT_KSTR + d0 * 16 + hi * 8) * 2);
    __builtin_amdgcn_s_setprio(1);
    p0 = __builtin_amdgcn_mfma_f32_32x32x16_bf16(b0, qr[d0], p0, 0, 0, 0);
    p1 = __builtin_amdgcn_mfma_f32_32x32x16_bf16(b1, qr[d0], p1, 0, 0, 0);
    __builtin_amdgcn_s_setprio(0);
  }
}
template <int D0> DI void at_pv_one(f32x16& od, const char* vb, bf16x8 pa0, bf16x8 pa1, bf16x8 pa2, bf16x8 pa3) {
#define TRR(ks, half) tr_read((const short*)(vb + v_rd_off(D0, ks, half)))
  const s16x4 l0 = TRR(0, 0), h0 = TRR(0, 1), l1 = TRR(1, 0), h1 = TRR(1, 1), l2 = TRR(2, 0), h2 = TRR(2, 1), l3 = TRR(3, 0), h3 = TRR(3, 1);
#undef TRR
#define PKV(L, H) __builtin_shufflevector(L, H, 0, 1, 2, 3, 4, 5, 6, 7)
  __builtin_amdgcn_s_setprio(1);
  od = __builtin_amdgcn_mfma_f32_32x32x16_bf16(pa0, PKV(l0, h0), od, 0, 0, 0);
  od = __builtin_amdgcn_mfma_f32_32x32x16_bf16(pa1, PKV(l1, h1), od, 0, 0, 0);
  od = __builtin_amdgcn_mfma_f32_32x32x16_bf16(pa2, PKV(l2, h2), od, 0, 0, 0);
  od = __builtin_amdgcn_mfma_f32_32x32x16_bf16(pa3, PKV(l3, h3), od, 0, 0, 0);
  __builtin_amdgcn_s_setprio(0);
#undef PKV
}
DI void at_pv(f32x16* o, const char* vb, bf16x8 pa0, bf16x8 pa1, bf16x8 pa2, bf16x8 pa3) {
  at_pv_one<0>(o[0], vb, pa0, pa1, pa2, pa3); at_pv_one<1>(o[1], vb, pa0, pa1, pa2, pa3);
}

DI void attn_body(const u16* __restrict__ Qb, const u16* __restrict__ Kh, const u16* __restrict__ Vh, float* __restrict__ Ob, char* lds, int tid) {
  const int wid = tid >> 6, lane = tid & 63, r32 = lane & 31, hi = lane >> 5;
  char* V_lds = lds; char* K_lds = lds + 2 * AT_VBYTES;
  float* wsp = (float*)(lds + 2 * AT_VBYTES + 2 * AT_KBYTES) + wid * 64; float* li_l = wsp; float* al_l = wsp + 32;
  float m_reg = -1e30f, l_reg = 0.f; f32x16 o[2]; bf16x8 qr[6];
#pragma unroll
  for (int r = 0; r < 16; ++r) { o[0][r] = 0.f; o[1][r] = 0.f; }
  const u16* Qw = Qb + (size_t)(wid * 32 + r32) * 96 + hi * 8;
#pragma unroll
  for (int d0 = 0; d0 < 6; ++d0) qr[d0] = *(const bf16x8*)(Qw + d0 * 16);
  const int kid1 = (tid < 256) ? tid + 512 : tid;
  const int kst0 = ((tid / 12) * AT_KSTR + (tid % 12) * 8) * 2, kst1 = ((kid1 / 12) * AT_KSTR + (kid1 % 12) * 8) * 2;
  const int vst = v_st(tid >> 3, (tid & 7) * 8);
  const char* vb0 = V_lds + v_rd_base(lane);
  u32x4 sk0[2], sk1[2], sv0[2];
#define SLOAD(i, k0) do { sk0[i] = *(const u32x4*)(Kh + (size_t)(k0) * 96 + tid * 8); sk1[i] = *(const u32x4*)(Kh + (size_t)(k0) * 96 + kid1 * 8); \
    sv0[i] = *(const u32x4*)(Vh + (size_t)(k0) * 64 + tid * 8); } while (0)
#define SWRITE(b, i) do { *(u32x4*)(K_lds + (b) * AT_KBYTES + kst0) = sk0[i]; if (tid < 256) *(u32x4*)(K_lds + (b) * AT_KBYTES + kst1) = sk1[i]; \
    *(u32x4*)(V_lds + (b) * AT_VBYTES + vst) = sv0[i]; } while (0)
#define SWAIT() asm volatile("s_waitcnt vmcnt(3)" ::: "memory")
#define RESC(a) do { if (__any((a) < 1.f)) { if (hi == 0) al_l[r32] = (a); asm volatile("s_waitcnt lgkmcnt(0)" ::: "memory"); \
    _Pragma("unroll") for (int r = 0; r < 16; ++r) { float al = al_l[crow(r, hi)]; o[0][r] *= al; o[1][r] *= al; } } } while (0)
  f32x16 pA0, pA1, pB0, pB1; float mnA, mnB, alA, alB; bf16x8 pa0, pa1, pa2, pa3; constexpr int NT = T / 64;
  SLOAD(0, 0); SWRITE(0, 0); __syncthreads();
  at_qkt(pA0, pA1, K_lds, qr, r32, hi); at_partialSM(pA0, pA1, m_reg, mnA, alA);
  SLOAD(1, 64); SLOAD(0, 128);
  SWAIT(); SWRITE(1, 1); __syncthreads();
  for (int j = 1; j + 1 < NT; j += 2) {
    SBAR(); at_qkt(pB0, pB1, K_lds + AT_KBYTES, qr, r32, hi);
    at_finishSM(pA0, pA1, alA, l_reg, pa0, pa1, pa2, pa3); SBAR();
    SLOAD(1, (j + 2) * 64); SBAR();
    at_pv(o, vb0, pa0, pa1, pa2, pa3); at_partialSM(pB0, pB1, m_reg, mnB, alB);
    __syncthreads(); SWAIT(); SWRITE(0, 0);
    RESC(alB); __syncthreads();
    SBAR(); at_qkt(pA0, pA1, K_lds, qr, r32, hi);
    at_finishSM(pB0, pB1, alB, l_reg, pa0, pa1, pa2, pa3); SBAR();
    if (j + 3 < NT) SLOAD(0, (j + 3) * 64); SBAR();
    at_pv(o, vb0 + AT_VBYTES, pa0, pa1, pa2, pa3); at_partialSM(pA0, pA1, m_reg, mnA, alA);
    __syncthreads(); SWAIT(); SWRITE(1, 1);
    RESC(alA); __syncthreads();
  }
  SBAR(); at_qkt(pB0, pB1, K_lds + AT_KBYTES, qr, r32, hi);
  at_finishSM(pA0, pA1, alA, l_reg, pa0, pa1, pa2, pa3); SBAR();
  at_pv(o, vb0, pa0, pa1, pa2, pa3); at_partialSM(pB0, pB1, m_reg, mnB, alB);
  __syncthreads(); RESC(alB);
  at_finishSM(pB0, pB1, alB, l_reg, pa0, pa1, pa2, pa3); SBAR();
  at_pv(o, vb0 + AT_VBYTES, pa0, pa1, pa2, pa3);
  if (hi == 0) li_l[r32] = l_reg;
  asm volatile("s_waitcnt lgkmcnt(0)" ::: "memory");
  float* Ow = Ob + (size_t)(wid * 32) * 512;
#pragma unroll
  for (int r = 0; r < 16; ++r) {
    int orow = crow(r, hi); float rl = __builtin_amdgcn_rcpf(li_l[orow]);
    Ow[(size_t)orow * 512 + r32] = o[0][r] * rl; Ow[(size_t)orow * 512 + 32 + r32] = o[1][r] * rl;
  }
#undef SLOAD
#undef SWRITE
#undef SWAIT
#undef RESC
}

DI void ph_attn(const P& p, char* smem, unsigned* ctr) {
  const int tid = tidx();
  int* sitem = (int*)(smem + SMEM_BYTES - 16);
  for (;;) {
    __syncthreads();
    if (tid == 0) *sitem = (int)atomicAdd(ctr, 1u);
    __syncthreads();
    const int item = *sitem;
    if (item >= NB * NH * (T / 256)) break;
    const int bh = item / (T / 256), qb = item % (T / 256);
    const int b = bh / NH, h = bh % NH;
    attn_body(p.Q + ((size_t)bh * T + qb * 256) * 96, p.Kc + (size_t)bh * T * 96, p.Vv + (size_t)bh * T * 64,
              p.AO + ((size_t)(b * T + qb * 256)) * 512 + h * 64, smem, tid);
  }
}

constexpr int SC = 256, NCH = T / SC;
constexpr int SBUF = 5184;
template <int NI> struct ScanRegsN { float k[2 * NI], r[2 * NI], v[2 * NI]; u16 lw[2 * NI], a[2 * NI]; };
template <int NI>
DI void scan_load_n(const P& p, int b, int h, int d, int n0, int lane, int ws, ScanRegsN<NI>& g) {
  constexpr int WPI = 8 / NI;
  const u16* LWd = p.LW + (size_t)d * NTOK * RWW;
  const u16* AAd = p.AA + (size_t)d * NTOK * RWW;
  const int ch = h * 64 + lane;
#pragma unroll
  for (int jj = 0; jj < 2 * NI; ++jj) {
    int n = n0 + ws + WPI * jj; int t = d ? (T - 1 - n) : n;
    size_t off = ((size_t)(b * T + t)) * RWW + ch;
    g.k[jj] = p.K[off]; g.r[jj] = p.R[off]; g.v[jj] = p.V[off]; g.lw[jj] = LWd[off]; g.a[jj] = AAd[off];
  }
}
template <int NI>
DI void scan_put_n(const ScanRegsN<NI>& g, float kkc, float kac, float* sm, float* slw, int lane, int ws) {
  constexpr int WPI = 8 / NI;
#pragma unroll
  for (int jj = 0; jj < 2 * NI; ++jj) slw[(ws + WPI * jj) * 64 + lane] = bf2f(g.lw[jj]);
  __syncthreads();
  float Lj[2 * NI];
#pragma unroll
  for (int jj = 0; jj < 2 * NI; ++jj) Lj[jj] = 0.f;
#pragma unroll
  for (int i = 0; i < 16; ++i) {
    const float x = slw[i * 64 + lane];
#pragma unroll
    for (int jj = 0; jj < 2 * NI; ++jj) Lj[jj] += (i <= ws + WPI * jj) ? x : 0.f;
  }
#pragma unroll
  for (int jj = 0; jj < 2 * NI; ++jj) {
    const int j = ws + WPI * jj;
    const float L = Lj[jj], lwj = bf2f(g.lw[jj]);
    const float Pt = fexp(L), Pm = fexp(L - lwj), iP = fexp(-L);
    const float kv = g.k[jj];
    const float kx = kv * kkc;
    const float nrm = __builtin_amdgcn_sqrtf(wave_sum(kx * kx));
    const float kkv = kx * frcp(fmaxf(nrm, 1e-12f));
    const float a = bf2f(g.a[jj]);
    sm[j * 64 + lane] = -kkv * Pm;
    sm[1024 + j * 64 + lane] = a * kkv * iP;
    sm[2048 + j * 64 + lane] = kv * (1.f + (a - 1.f) * kac) * iP;
    sm[3072 + j * 64 + lane] = g.r[jj] * Pt;
    sm[4096 + j * 64 + lane] = g.v[jj];
    if (j == 15) sm[5120 + lane] = Pt;
  }
}
using f32x16s = __attribute__((ext_vector_type(16))) float;
DI void scan_ld8(f32x4 (&kv)[8], const float* vec, int hi) {
#pragma unroll
  for (int tk = 0; tk < 2; ++tk)
#pragma unroll
    for (int q = 0; q < 4; ++q) kv[tk * 4 + q] = *(const f32x4*)(vec + 32 * tk + 8 * q + 4 * hi);
}
DI float scan_dot8(const f32x16s (&acc)[2], const f32x4 (&kv)[8]) {
  float pq[4] = {0.f, 0.f, 0.f, 0.f};
#pragma unroll
  for (int tk = 0; tk < 2; ++tk)
#pragma unroll
    for (int e = 0; e < 4; ++e)
#pragma unroll
      for (int q = 0; q < 4; ++q) { pq[q] = __builtin_fmaf(acc[tk][4 * q + e], kv[tk * 4 + q][e], pq[q]); asm("" : "+v"(pq[q])); }
  return red_x32((pq[0] + pq[1]) + (pq[2] + pq[3]));
}

DI void ph_scan1(const P& p, int layer, char* smem) {
  constexpr int NI = 2;
  const int tid = tidx(), lane = tid & 63, w = tid >> 6;
  const int jl = lane & 31, hi = lane >> 5;
  const int it = w >> 2, vt = w & 3, ws = w & 3;
  float* smi = (float*)smem + it * (2 * SBUF + 1024);
  float* slw = smi + 2 * SBUF;
  for (int pair = blockIdx.x; pair < 32 * NCH / 2; pair += gridDim.x) {
    const int item = pair * 2 + it; const int scan = item / NCH, c = item % NCH;
    const int d = scan & 1, h = (scan >> 1) % NH, b = scan / (2 * NH);
    const float kkc = p.rw_k_k[layer * RWW + h * 64 + lane], kac = p.rw_k_a[layer * RWW + h * 64 + lane];
    f32x16s acc[2];
#pragma unroll
    for (int tk = 0; tk < 2; ++tk)
#pragma unroll
      for (int r = 0; r < 16; ++r) acc[tk][r] = (32 * tk + (r & 3) + 8 * (r >> 2) + 4 * hi == 32 * vt + jl) ? 1.f : 0.f;
    ScanRegsN<NI> g;
    scan_load_n<NI>(p, b, h, d, c * SC, lane, ws, g);
    __syncthreads();
    scan_put_n<NI>(g, kkc, kac, smi, slw, lane, ws);
    __syncthreads();
    for (int sub = 0; sub < SC / 16; ++sub) {
      const float* sm = smi + (sub & 1) * SBUF;
      if (sub + 1 < SC / 16) scan_load_n<NI>(p, b, h, d, c * SC + (sub + 1) * 16, lane, ws, g);
      const float* vrow = sm + 4096 + ((vt >= 2) ? 32 * (vt - 2) : 0) + jl;
      f32x4 kc[8]; scan_ld8(kc, sm, hi);
      float a0 = sm[1024 + hi * 1024 + jl], a1 = sm[1024 + hi * 1024 + 32 + jl], vc = vrow[0];
#pragma unroll 4
      for (int j = 0; j < 16; ++j) {
        const int jn = (j + 1) & 15;
        f32x4 kn[8]; scan_ld8(kn, sm + jn * 64, hi);
        const float an0 = sm[1024 + hi * 1024 + jn * 64 + jl], an1 = sm[1024 + hi * 1024 + jn * 64 + 32 + jl], vn = vrow[jn * 64];
        SBAR();
        const float sa = scan_dot8(acc, kc);
        const float bop = hi ? ((vt >= 2) ? vc : 0.f) : sa;
        acc[0] = __builtin_amdgcn_mfma_f32_32x32x2f32(a0, bop, acc[0], 0, 0, 0);
        acc[1] = __builtin_amdgcn_mfma_f32_32x32x2f32(a1, bop, acc[1], 0, 0, 0);
        SBAR();
#pragma unroll
        for (int i = 0; i < 8; ++i) kc[i] = kn[i];
        a0 = an0; a1 = an1; vc = vn;
      }
#pragma unroll
      for (int tk = 0; tk < 2; ++tk)
#pragma unroll
        for (int q = 0; q < 4; ++q) {
          const f32x4 pv = *(const f32x4*)(sm + 5120 + 32 * tk + 8 * q + 4 * hi);
#pragma unroll
          for (int e = 0; e < 4; ++e) acc[tk][4 * q + e] *= pv[e];
        }
      if (sub + 1 < SC / 16) scan_put_n<NI>(g, kkc, kac, smi + ((sub + 1) & 1) * SBUF, slw, lane, ws);
      __syncthreads();
    }
    {
      const int v = 32 * vt + jl;
      float* dst = ((v < 64) ? p.MC : p.NC) + (((size_t)scan * NCH + c) * 64 + (v & 63)) * 64;
#pragma unroll
      for (int tk = 0; tk < 2; ++tk)
#pragma unroll
        for (int q = 0; q < 4; ++q)
          *(f32x4*)(dst + 32 * tk + 8 * q + 4 * hi) = f32x4{acc[tk][4 * q], acc[tk][4 * q + 1], acc[tk][4 * q + 2], acc[tk][4 * q + 3]};
    }
  }
}


DI void ph_scan2(const P& p, char* smem) {
  constexpr int LS = 72;
  u16* Sh = (u16*)smem; u16* Sl = Sh + 64 * LS; u16* Mh = Sl + 64 * LS; u16* Ml = Mh + 64 * LS;
  const int tid = tidx(), lane = tid & 63, w = tid >> 6;
  const int l15 = lane & 15, lq = lane >> 4;
  const int ti = w >> 1, tj0 = (w & 1) * 2;
  for (int scan = blockIdx.x; scan < 32; scan += gridDim.x) {
    const float* Mg = p.MC + (size_t)scan * NCH * 4096;
    const float* Ng = p.NC + (size_t)scan * NCH * 4096;
    float* Sg = p.SS + (size_t)scan * NCH * 4096;
    struct MN { f32x4 m0, m1, n[2]; };
    auto ldmn = [&](MN& r, int c) {
      const int cc = (c < NCH) ? c : (NCH - 1);
      r.m0 = *(const f32x4*)(Mg + (size_t)cc * 4096 + tid * 8); r.m1 = *(const f32x4*)(Mg + (size_t)cc * 4096 + tid * 8 + 4);
#pragma unroll
      for (int q = 0; q < 2; ++q)
#pragma unroll
        for (int r4 = 0; r4 < 4; ++r4) r.n[q][r4] = Ng[(size_t)cc * 4096 + (ti * 16 + lq * 4 + r4) * 64 + (tj0 + q) * 16 + l15];
    };
    f32x4 sacc[2];
    sacc[0] = f32x4{0.f, 0.f, 0.f, 0.f}; sacc[1] = sacc[0];
    auto step = [&](int c, const MN& r) {
      __syncthreads();
#pragma unroll
      for (int q = 0; q < 2; ++q)
#pragma unroll
        for (int r4 = 0; r4 < 4; ++r4) {
          const int row = ti * 16 + lq * 4 + r4, col = (tj0 + q) * 16 + l15;
          const float x = sacc[q][r4];
          Sg[(size_t)c * 4096 + row * 64 + col] = x;
          const u16 h = f2bf(x); Sh[row * LS + col] = h; Sl[row * LS + col] = f2bf(x - bf2f(h));
        }
      {
        const int mr = tid >> 3, mc = (tid & 7) * 8;
        float xh[8], xl[8];
#pragma unroll
        for (int i = 0; i < 8; ++i) { const float x = (i < 4) ? r.m0[i & 3] : r.m1[i & 3]; const float h = bf2f(f2bf(x)); xh[i] = h; xl[i] = x - h; }
        *(u32x4*)(Mh + mr * LS + mc) = u32x4{pk2(xh[0], xh[1]), pk2(xh[2], xh[3]), pk2(xh[4], xh[5]), pk2(xh[6], xh[7])};
        *(u32x4*)(Ml + mr * LS + mc) = u32x4{pk2(xl[0], xl[1]), pk2(xl[2], xl[3]), pk2(xl[4], xl[5]), pk2(xl[6], xl[7])};
      }
      f32x4 acc[2] = {r.n[0], r.n[1]};
      __syncthreads();
#pragma unroll
      for (int ks = 0; ks < 2; ++ks) {
        const bf16x8 ah = *(const bf16x8*)(Sh + (ti * 16 + l15) * LS + ks * 32 + 8 * lq);
        const bf16x8 al = *(const bf16x8*)(Sl + (ti * 16 + l15) * LS + ks * 32 + 8 * lq);
#pragma unroll
        for (int q = 0; q < 2; ++q) {
          const int kb = ks * 32 + 8 * lq, tq = l15 >> 2, tp = l15 & 3, co = (tj0 + q) * 16 + 4 * tp;
          const bf16x8 bh = __builtin_shufflevector(tr_read((const short*)Mh + (kb + tq) * LS + co), tr_read((const short*)Mh + (kb + 4 + tq) * LS + co), 0, 1, 2, 3, 4, 5, 6, 7);
          const bf16x8 bl = __builtin_shufflevector(tr_read((const short*)Ml + (kb + tq) * LS + co), tr_read((const short*)Ml + (kb + 4 + tq) * LS + co), 0, 1, 2, 3, 4, 5, 6, 7);
          acc[q] = __builtin_amdgcn_mfma_f32_16x16x32_bf16(ah, bh, acc[q], 0, 0, 0);
          acc[q] = __builtin_amdgcn_mfma_f32_16x16x32_bf16(ah, bl, acc[q], 0, 0, 0);
          acc[q] = __builtin_amdgcn_mfma_f32_16x16x32_bf16(al, bh, acc[q], 0, 0, 0);
        }
      }
      sacc[0] = acc[0]; sacc[1] = acc[1];
    };
    MN r0, r1, r2, r3;
    ldmn(r0, 0); ldmn(r1, 1); ldmn(r2, 2);
    for (int c = 0; c < NCH; c += 4) {
      ldmn(r3, c + 3); step(c, r0);
      ldmn(r0, c + 4); step(c + 1, r1);
      ldmn(r1, c + 5); step(c + 2, r2);
      ldmn(r2, c + 6); step(c + 3, r3);
    }
    __syncthreads();
  }
}

DI void ph_scan3(const P& p, int layer, char* smem) {
  constexpr int NI = 4;
  const int tid = tidx(), lane = tid & 63, w = tid >> 6;
  const int jl = lane & 31, hi = lane >> 5;
  const int it = w >> 1, vt = w & 1, ws = w & 1;
  float* sm = (float*)smem + it * (SBUF + 2048);
  float* slw = sm + SBUF; float* so = slw + 1024;
  const float* lwp = p.rw_lnx_w + layer * RWW; const float* lbp = p.rw_lnx_b + layer * RWW; const float* rkp = p.rw_r_k + layer * RWW;
  constexpr int TQ = 2 * SC;
  for (int quad = blockIdx.x; quad < NB * NH * (T / TQ); quad += gridDim.x) {
    const int bh = quad / (T / TQ), tb = quad % (T / TQ);
    const int d = it >> 1, kch = 2 * tb + (it & 1), c = d ? (NCH - 1 - kch) : kch;
    const int h = bh % NH, b = bh / NH, scan = bh * 2 + d;
    const float kkc = p.rw_k_k[layer * RWW + h * 64 + lane], kac = p.rw_k_a[layer * RWW + h * 64 + lane];
    u16* Od = p.O2 + (size_t)d * NTOK * RWW;
    f32x16s acc[2];
    {
      const float* Sg = p.SS + ((size_t)scan * NCH + c) * 4096 + (size_t)(32 * vt + jl) * 64;
#pragma unroll
      for (int tk = 0; tk < 2; ++tk)
#pragma unroll
        for (int q = 0; q < 4; ++q) {
          const f32x4 sv = *(const f32x4*)(Sg + 32 * tk + 8 * q + 4 * hi);
#pragma unroll
          for (int e = 0; e < 4; ++e) acc[tk][4 * q + e] = sv[e];
        }
    }
    ScanRegsN<NI> g;
    scan_load_n<NI>(p, b, h, d, c * SC, lane, ws, g);
    for (int sub = 0; sub < SC / 16; ++sub) {
      const int n0 = c * SC + sub * 16;
      __syncthreads();
      scan_put_n<NI>(g, kkc, kac, sm, slw, lane, ws);
      __syncthreads();
      if (sub + 1 < SC / 16) scan_load_n<NI>(p, b, h, d, n0 + 16, lane, ws, g);
      const float* vrow = sm + 4096 + 32 * vt + jl;
      f32x4 kc[8]; scan_ld8(kc, sm, hi);
      float a0 = sm[1024 + hi * 1024 + jl], a1 = sm[1024 + hi * 1024 + 32 + jl], vc = vrow[0];
#pragma unroll 4
      for (int j = 0; j < 16; ++j) {
        const int jn = (j + 1) & 15;
        f32x4 kn[8]; scan_ld8(kn, sm + jn * 64, hi);
        const float an0 = sm[1024 + hi * 1024 + jn * 64 + jl], an1 = sm[1024 + hi * 1024 + jn * 64 + 32 + jl], vn = vrow[jn * 64];
        SBAR();
        const float sa = scan_dot8(acc, kc);
        const float bop = hi ? vc : sa;
        acc[0] = __builtin_amdgcn_mfma_f32_32x32x2f32(a0, bop, acc[0], 0, 0, 0);
        acc[1] = __builtin_amdgcn_mfma_f32_32x32x2f32(a1, bop, acc[1], 0, 0, 0);
        f32x4 rc[8]; scan_ld8(rc, sm + 3072 + j * 64, hi);
        SBAR();
        const float o = scan_dot8(acc, rc);
        if (hi == 0) so[j * 64 + 32 * vt + jl] = o;
        SBAR();
#pragma unroll
        for (int i = 0; i < 8; ++i) kc[i] = kn[i];
        a0 = an0; a1 = an1; vc = vn;
      }
#pragma unroll
      for (int tk = 0; tk < 2; ++tk)
#pragma unroll
        for (int q = 0; q < 4; ++q) {
          const f32x4 pv = *(const f32x4*)(sm + 5120 + 32 * tk + 8 * q + 4 * hi);
#pragma unroll
          for (int e = 0; e < 4; ++e) acc[tk][4 * q + e] *= pv[e];
        }
      __syncthreads();
#pragma unroll
      for (int jj = 0; jj < 8; ++jj) {
        const int j = ws + 2 * jj; const int n = n0 + j; const int t = d ? (T - 1 - n) : n;
        Od[((size_t)(b * T + t)) * RWW + h * 64 + lane] = f2bf(so[j * 64 + lane]);
      }
    }
    asm volatile("s_waitcnt vmcnt(0)" ::: "memory");
    __syncthreads();
    {
      const int ch = h * 64 + lane;
      const float plw = lwp[ch], plb = lbp[ch], prk = rkp[ch];
      for (int i0 = 0; i0 < TQ / 8; i0 += 2) {
        float o[2], k[2], r[2], vv[2], a0[2], a1[2], gg[2];
#pragma unroll
        for (int u = 0; u < 2; ++u) {
          const size_t off = (size_t)(b * T + tb * TQ + w * (TQ / 8) + i0 + u) * RWW + ch;
          o[u] = bf2f(p.O2[off]) + bf2f(p.O2[(size_t)NTOK * RWW + off]);
          k[u] = p.K[off]; r[u] = p.R[off]; vv[u] = p.V[off];
          a0[u] = bf2f(p.AA[off]); a1[u] = bf2f(p.AA[(size_t)NTOK * RWW + off]); gg[u] = bf2f(p.G[off]);
        }
#pragma unroll
        for (int u = 0; u < 2; ++u) {
          const float mean = wave_sum(o[u]) * (1.f / 64);
          const float dv = o[u] - mean;
          const float var = wave_sum(dv * dv) * (1.f / 64);
          const float kb = 0.5f * (k[u] * (1.f + (a0[u] - 1.f) * kac) + k[u] * (1.f + (a1[u] - 1.f) * kac));
          const float sb = wave_sum(r[u] * kb * prk);
          const float on_ = dv * frsq(var + GN_EPS) * plw + plb;
          p.H[(size_t)(b * T + tb * TQ + w * (TQ / 8) + i0 + u) * DM + ch] = f2bf((on_ + sb * vv[u]) * gg[u]);
        }
      }
    }
  }
}
DI void ph_mla_norm(const P& p, int layer) {
  const int tid_ = tidx(); const int lane = tid_ & 63, w = tid_ >> 6;
  const float* on = p.mla_o_norm + layer * 512;
  const f32x4 g0 = *(const f32x4*)(on + lane * 4), g1 = *(const f32x4*)(on + 256 + lane * 4);
  for (int tok = blockIdx.x * 8 + w; tok < NTOK; tok += gridDim.x * 8) {
    const float* ao = p.AO + (size_t)tok * 512;
    const f32x4 v0 = *(const f32x4*)(ao + lane * 4), v1 = *(const f32x4*)(ao + 256 + lane * 4);
    float ss = v0[0] * v0[0] + v0[1] * v0[1] + v0[2] * v0[2] + v0[3] * v0[3] + v1[0] * v1[0] + v1[1] * v1[1] + v1[2] * v1[2] + v1[3] * v1[3];
    ss = wave_sum(ss);
    const float rstd = frsq(ss * (1.f / 512) + NORM_EPS);
    *(u32x2*)(p.H + (size_t)tok * DM + 512 + lane * 4) = u32x2{pk2(v0[0] * rstd * g0[0], v0[1] * rstd * g0[1]), pk2(v0[2] * rstd * g0[2], v0[3] * rstd * g0[3])};
    *(u32x2*)(p.H + (size_t)tok * DM + 768 + lane * 4) = u32x2{pk2(v1[0] * rstd * g1[0], v1[1] * rstd * g1[1]), pk2(v1[2] * rstd * g1[2], v1[3] * rstd * g1[3])};
  }
}


DI void ph_mixfinish(const P& p, int layer) {
  const int tid_ = tidx(); const int lane = tid_ & 63, w = tid_ >> 6;
  const float* lw = p.rw_lnx_w + layer * RWW; const float* lb = p.rw_lnx_b + layer * RWW;
  const float* kac = p.rw_k_a + layer * RWW; const float* rk = p.rw_r_k + layer * RWW;
  const float* on = p.mla_o_norm + layer * 512;
  float plw[8], plb[8], pka[8], prk[8];
#pragma unroll
  for (int h = 0; h < NH; ++h) { int c = h * 64 + lane; plw[h] = lw[c]; plb[h] = lb[c]; pka[h] = kac[c]; prk[h] = rk[c]; }
  const f32x4 g0 = *(const f32x4*)(on + lane * 4), g1 = *(const f32x4*)(on + 256 + lane * 4);
  for (int tok = blockIdx.x * 8 + w; tok < NTOK; tok += gridDim.x * 8) {
    float o[8], k[8], r[8], vv[8], a0[8], a1[8], gg[8];
#pragma unroll
    for (int h = 0; h < NH; ++h) {
      size_t off = (size_t)tok * RWW + h * 64 + lane;
      o[h] = bf2f(p.O2[off]) + bf2f(p.O2[(size_t)NTOK * RWW + off]);
      k[h] = p.K[off]; r[h] = p.R[off]; vv[h] = p.V[off];
      a0[h] = bf2f(p.AA[off]); a1[h] = bf2f(p.AA[(size_t)NTOK * RWW + off]); gg[h] = bf2f(p.G[off]);
    }
    const float* ao = p.AO + (size_t)tok * 512;
    const f32x4 v0 = *(const f32x4*)(ao + lane * 4), v1 = *(const f32x4*)(ao + 256 + lane * 4);
    float mean[8], var[8], sb[8];
#pragma unroll
    for (int h = 0; h < NH; ++h) mean[h] = wave_sum(o[h]) * (1.f / 64);
#pragma unroll
    for (int h = 0; h < NH; ++h) { float dv = o[h] - mean[h]; o[h] = dv; var[h] = wave_sum(dv * dv) * (1.f / 64); }
#pragma unroll
    for (int h = 0; h < NH; ++h) {
      float kb = 0.5f * (k[h] * (1.f + (a0[h] - 1.f) * pka[h]) + k[h] * (1.f + (a1[h] - 1.f) * pka[h]));
      sb[h] = wave_sum(r[h] * kb * prk[h]);
    }
#pragma unroll
    for (int h = 0; h < NH; ++h) {
      float on_ = o[h] * frsq(var[h] + GN_EPS) * plw[h] + plb[h];
      float y = (on_ + sb[h] * vv[h]) * gg[h];
      p.H[(size_t)tok * DM + h * 64 + lane] = f2bf(y);
    }
    float ss = v0[0] * v0[0] + v0[1] * v0[1] + v0[2] * v0[2] + v0[3] * v0[3] + v1[0] * v1[0] + v1[1] * v1[1] + v1[2] * v1[2] + v1[3] * v1[3];
    ss = wave_sum(ss);
    float rstd = frsq(ss * (1.f / 512) + NORM_EPS);
    *(u32x2*)(p.H + (size_t)tok * DM + 512 + lane * 4) = u32x2{pk2(v0[0] * rstd * g0[0], v0[1] * rstd * g0[1]), pk2(v0[2] * rstd * g0[2], v0[3] * rstd * g0[3])};
    *(u32x2*)(p.H + (size_t)tok * DM + 768 + lane * 4) = u32x2{pk2(v1[0] * rstd * g1[0], v1[1] * rstd * g1[1]), pk2(v1[2] * rstd * g1[2], v1[3] * rstd * g1[3])};
  }
}

DI void ph_norm_router(const P& p, int layer, char* smem) {
  const int tid_ = tidx(); const int lane = tid_ & 63, w = tid_ >> 6;
  float* rtl = (float*)smem;
  float* hl = (float*)(smem + 65536) + w * 1024;
  const float* g = p.ffn_norm + layer * DM;
  const float* rt = p.router + (size_t)layer * DM * NE;
  __syncthreads();
#pragma unroll
  for (int i = 0; i < 8; ++i) *(f32x4*)(rtl + (tid_ + i * NTH) * 4) = *(const f32x4*)(rt + (tid_ + i * NTH) * 4);
  __syncthreads();
  const int cg = lane >> 2, eq = lane & 3;
  for (int tok = blockIdx.x * 8 + w; tok < NTOK; tok += gridDim.x * 8) {
    const f32x4* xr = (const f32x4*)(p.out + (size_t)tok * DM);
    f32x4 v[4]; float ss = 0.f;
#pragma unroll
    for (int j = 0; j < 4; ++j) { v[j] = xr[lane + 64 * j]; ss += v[j][0] * v[j][0] + v[j][1] * v[j][1] + v[j][2] * v[j][2] + v[j][3] * v[j][3]; }
    ss = wave_sum(ss);
    const float rstd = frsq(ss * (1.f / DM) + NORM_EPS);
#pragma unroll
    for (int j = 0; j < 4; ++j) {
      const int c0 = (lane + 64 * j) * 4;
      const f32x4 gg = *(const f32x4*)(g + c0);
      const f32x4 hv = v[j] * rstd * gg;
      *(u32x2*)(p.H + (size_t)tok * DM + c0) = u32x2{pk2(hv[0], hv[1]), pk2(hv[2], hv[3])};
      *(f32x4*)(hl + c0) = hv;
    }
    f32x4 acc = f32x4{0.f, 0.f, 0.f, 0.f};
#pragma unroll 16
    for (int i = 0; i < 64; ++i) {
      const float hv = hl[cg + 16 * i];
      const f32x4 r4 = *(const f32x4*)(rtl + (cg + 16 * i) * 16 + eq * 4);
      acc += hv * r4;
    }
#pragma unroll
    for (int e = 0; e < 4; ++e) {
      float a = acc[e];
      a += dpp_f<0x124>(a); a += dpp_f<0x128>(a);
      a = red_x32(red_x16(a));
      acc[e] = a;
    }
    float mx = fmaxf(fmaxf(acc[0], acc[1]), fmaxf(acc[2], acc[3]));
    mx = fmaxf(mx, dpp_f<0xB1>(mx)); mx = fmaxf(mx, dpp_f<0x4E>(mx));
    f32x4 ex; float se = 0.f;
#pragma unroll
    for (int e = 0; e < 4; ++e) { ex[e] = fexp(acc[e] - mx); se += ex[e]; }
    se = red_x2(red_x1(se));
    const float inv = frcp(se);
    const int b = tok / T, t = tok % T;
    if (lane < 4) {
#pragma unroll
      for (int e = 0; e < 4; ++e) p.AFF[((size_t)(b * NE + eq * 4 + e)) * T + t] = ex[e] * inv;
    }
  }
}

DI void ph_topk(const P& p, char* smem) {
  unsigned* hist = (unsigned*)smem;
  unsigned* sc = hist + 256;
  unsigned* bc = sc + 2048;
  const int tid = tidx();
  for (int item = blockIdx.x; item < NB * NE; item += gridDim.x) {
    const float* a = p.AFF + (size_t)item * T;
    unsigned key[16];
#pragma unroll
    for (int i = 0; i < 4; ++i) {
      uint4 v = *(const uint4*)(a + tid * 16 + i * 4);
      key[i * 4 + 0] = v.x; key[i * 4 + 1] = v.y; key[i * 4 + 2] = v.z; key[i * 4 + 3] = v.w;
    }
    unsigned prefix = 0, mask = 0, need = CAP;
    for (int pass = 0; pass < 4; ++pass) {
      int shift = 24 - 8 * pass;
      __syncthreads();
      if (tid < 256) hist[tid] = 0;
      __syncthreads();
#pragma unroll
      for (int i = 0; i < 16; ++i)
        if ((key[i] & mask) == prefix) atomicAdd(&hist[(key[i] >> shift) & 255u], 1u);
      __syncthreads();
      if (tid == 0) {
        unsigned cum = 0; int bsel = 0; unsigned nd = need;
        for (int bb = 255; bb >= 0; --bb) {
          unsigned hc = hist[bb];
          if (cum + hc >= need) { bsel = bb; nd = need - cum; break; }
          cum += hc;
        }
        bc[0] = prefix | ((unsigned)bsel << shift); bc[1] = nd;
      }
      __syncthreads();
      prefix = bc[0]; need = bc[1]; mask |= (255u << shift);
    }
    unsigned ngt = 0, neq = 0;
#pragma unroll
    for (int i = 0; i < 16; ++i) { ngt += key[i] > prefix; neq += key[i] == prefix; }
    __syncthreads();
    unsigned* sA = sc; unsigned* sB = sc + 512; unsigned* eA = sc + 1024; unsigned* eB = sc + 1536;
    sA[tid] = ngt; eA[tid] = neq;
    __syncthreads();
    for (int off = 1; off < NTH; off <<= 1) {
      unsigned x = sA[tid] + ((tid >= off) ? sA[tid - off] : 0u);
      unsigned y = eA[tid] + ((tid >= off) ? eA[tid - off] : 0u);
      sB[tid] = x; eB[tid] = y;
      __syncthreads();
      unsigned* tmp = sA; sA = sB; sB = tmp; tmp = eA; eA = eB; eB = tmp;
    }
    unsigned gt_excl = sA[tid] - ngt, eq_excl = eA[tid] - neq;
    unsigned gt_total = sA[NTH - 1];
    int* idx = p.IDX + (size_t)item * CAP; float* gate = p.GATE + (size_t)item * CAP;
#pragma unroll
    for (int i = 0; i < 16; ++i) {
      int slot = -1;
      if (key[i] > prefix) { slot = (int)gt_excl; ++gt_excl; }
      else if (key[i] == prefix) { if (eq_excl < need) slot = (int)(gt_total + eq_excl); ++eq_excl; }
      if (slot >= 0) {
        const int tokl = tid * 16 + i;
        idx[slot] = tokl; gate[slot] = __uint_as_float(key[i]);
        const int tokg = (item / NE) * T + tokl;
        const int pos = atomicAdd(&p.TCNT[tokg], 1);
        p.TLIST[(size_t)tokg * 16 + pos] = item * CAP + slot;
      }
    }
    __syncthreads();
  }
}

DI void ph_exp1(const P& p, int layer, char* smem) {
  for (int t = blockIdx.x; t < 32 * 4 * 16; t += gridDim.x) {
    int grp = t / 64, r = t % 64, tm = r / 16, tn = r % 16;
    int b = grp / NE, e = grp % NE;
    const int* gi = p.IDX + (size_t)grp * CAP + tm * GBM;
    const u16* Hb = p.H + (size_t)b * T * DM;
    const float* Wg = p.exp_w_gate + ((size_t)layer * NE + e) * DM * 1024;
    const float* Wu = p.exp_w_up + ((size_t)layer * NE + e) * DM * 1024;
    u16* hid = p.HID + ((size_t)grp * CAP + tm * GBM) * 1024;
    auto arow = [&](int row) -> const void* { return Hb + (size_t)gi[row] * DM; };
    gemm_tile<false, 1>(arow, Wg, Wu, 1024, DM, tn * 64, 1024, smem, [&](int row, int col, float g, float u) {
      float sv = g * frcp(1.f + fexp(-g));
      hid[(size_t)row * 1024 + col] = f2bf(sv * u);
    });
    __syncthreads();
  }
}
DI void ph_exp2(const P& p, int layer, char* smem) {
  for (int t = blockIdx.x; t < 32 * 4 * 8; t += gridDim.x) {
    int grp = t / 32, r = t % 32, tm = r / 8, tn = r % 8;
    int b = grp / NE, e = grp % NE;
    const int* gi = p.IDX + (size_t)grp * CAP + tm * GBM;
    const float* gt = p.GATE + (size_t)grp * CAP + tm * GBM;
    const u16* hid = p.HID + ((size_t)grp * CAP + tm * GBM) * 1024;
    const float* Wd = p.exp_w_down + ((size_t)layer * NE + e) * 1024 * DM;
    float* xb = p.out + (size_t)b * T * DM;
    auto arow = [&](int row) -> const void* { return hid + (size_t)row * 1024; };
    gemm_tile<false, 0>(arow, Wd, nullptr, DM, 1024, tn * GBN, DM, smem, [&](int row, int col, float v, float) {
      unsafeAtomicAdd(xb + (size_t)gi[row] * DM + col, v * gt[row]);
    });
    __syncthreads();
  }
}

namespace g8 {
constexpr int BM = 256, BK = 64, HALF = 128, HTB = HALF * BK * 2, STAGE_BYTES = 8 * HTB, NXCD = 8, WGM = 8;
DI int lds_byte(int r, int c) { const int st = (r >> 4) * 2 + (c >> 5), rr = r & 15, cc = c & 31, ob = rr * 64 + cc * 2; return st * 1024 + (ob ^ (((ob >> 9) & 1) << 5)); }
DI void stage_rc(int b, int& R, int& C) { const int st = b / 1024, sb = b % 1024, swz = sb ^ (((sb >> 9) & 1) << 5); R = (st >> 1) * 16 + swz / 64; C = (st & 1) * 32 + (swz % 64) / 2; }
DI int perm32(int rho) { const int n = rho >> 4, i = rho & 15; return 8 * (i >> 2) + 4 * n + (i & 3); }
struct Unit { int pm, pn; };
struct Sched {
  int nM, nN, nwg, G, c;
  const char* A; const char* Bt; size_t a_tstep, b_tstep; int gdiv, gmod; size_t gstride;
  DI void init(int nM_, int nN_, int G_, int c_, const void* A_, const void* Bt_, int K) {
    nM = nM_; nN = nN_; nwg = nM * nN; G = G_; c = c_; A = (const char*)uni_ptr(A_); Bt = (const char*)uni_ptr(Bt_);
    a_tstep = (size_t)BM * K * 2; b_tstep = (size_t)BM * K * 2; gdiv = 1 << 30; gmod = 1; gstride = 0;
  }
  DI void group(int gdiv_, int gmod_, size_t gstride_) { gdiv = gdiv_; gmod = gmod_; gstride = gstride_; }
  DI bool next(int i, Unit& u) const {
    const long L = (long)i * G + c; if (L >= nwg) return false;
    int wgid = (int)L; { const int q = nwg / NXCD, r = nwg % NXCD, xcd = wgid % NXCD, off = wgid / NXCD; wgid = (xcd < r ? xcd * (q + 1) : r * (q + 1) + (xcd - r) * q) + off; }
    const int nig = WGM * nN, gid = wgid / nig, fm = gid * WGM, gsz = (nM - fm) < WGM ? (nM - fm) : WGM;
    u.pm = fm + ((wgid % nig) % gsz); u.pn = (wgid % nig) / gsz; return true;
  }
  DI const char* a_ptr(const Unit& u) const { return A + (size_t)u.pm * a_tstep; }
  DI const char* b_ptr(const Unit& u) const { return Bt + (size_t)((u.pm / gdiv) % gmod) * gstride + (size_t)u.pn * b_tstep; }
};
using Acc = f32x4[2][2][4][2];

template <class Epi>
DI void gemm_phase(LAS unsigned char* lds, const int K, const Sched& S, const Epi& E) {
  const int tid = tidx(), wid = __builtin_amdgcn_readfirstlane(tid >> 6), lane = tid & 63, wr = wid >> 2, wc = wid & 3, fr = lane & 15, fq = lane >> 4;
  const int nt = K / BK;
  unsigned voffA[2], voffB[2];
#pragma unroll
  for (int i = 0; i < 2; ++i) { int R, C; stage_rc(tid * 16 + i * 8192, R, C); const int Rb = Epi::PERM ? ((R & ~31) + perm32(R & 31)) : R;
    voffA[i] = (unsigned)(R * K + C) * 2u; voffB[i] = (unsigned)(Rb * K + C) * 2u; }
  const size_t kstep = (size_t)(BK * 2);
  const size_t hstep = (size_t)HALF * K * 2;
  const unsigned ldsw = (unsigned)wid * 1024u;
  const int aoff = lds_byte(wr * 64 + fr, fq * 8), boff = lds_byte(wc * 32 + fr, fq * 8);
#define G8_SA(b, h) (((b) * 2 + (h)) * HTB)
#define G8_SB(b, h) ((4 + (b) * 2 + (h)) * HTB)
#define G8_STAGE(bufoff, gbase, voff) do { _Pragma("unroll") for (int _i = 0; _i < 2; ++_i) \
    __builtin_amdgcn_global_load_lds((const unsigned*)((const char*)(gbase) + (voff)[_i]), (LAS unsigned*)(lds + (bufoff) + ldsw + _i * 8192), 16, 0, 0); } while (0)
#define G8_LDA(dst, b, h) do { _Pragma("unroll") for (int m = 0; m < 4; ++m) _Pragma("unroll") for (int k = 0; k < 2; ++k) dst[m][k] = *(const LAS bf16x8*)(lds + G8_SA(b, h) + aoff + m * 2048 + k * 1024); } while (0)
#define G8_LDB(dst, b, h) do { _Pragma("unroll") for (int n = 0; n < 2; ++n) _Pragma("unroll") for (int k = 0; k < 2; ++k) dst[n][k] = *(const LAS bf16x8*)(lds + G8_SB(b, h) + boff + n * 2048 + k * 1024); } while (0)
#define G8_MMA(ai, bj, At, Bt) do { __builtin_amdgcn_s_setprio(1); _Pragma("unroll") for (int m = 0; m < 4; ++m) _Pragma("unroll") for (int n = 0; n < 2; ++n) _Pragma("unroll") for (int k = 0; k < 2; ++k) \
    acc[ai][bj][m][n] = __builtin_amdgcn_mfma_f32_16x16x32_bf16(Bt[n][k], At[m][k], acc[ai][bj][m][n], 0, 0, 0); __builtin_amdgcn_s_setprio(0); } while (0)
#define G8_WAIT_V(n) asm volatile("s_waitcnt vmcnt(" #n ")" ::: "memory")
#define G8_WAIT_L(n) asm volatile("s_waitcnt lgkmcnt(" #n ")" ::: "memory")
#define G8_BAR __builtin_amdgcn_s_barrier()
#define G8_SCHED __builtin_amdgcn_sched_barrier(0)
  Unit cur, nxt; int ui = 0;
  if (!S.next(0, cur)) return;
  f32x4 acc[2][2][4][2];
#pragma unroll
  for (int a = 0; a < 2; ++a)
#pragma unroll
    for (int b = 0; b < 2; ++b)
#pragma unroll
      for (int m = 0; m < 4; ++m)
#pragma unroll
        for (int n = 0; n < 2; ++n) acc[a][b][m][n] = (f32x4){0.f, 0.f, 0.f, 0.f};
  bf16x8 At[4][2], B0[2][2], B1[2][2];
  const char* cA = S.a_ptr(cur); const char* cB = S.b_ptr(cur);
  G8_STAGE(G8_SB(0, 0), cB, voffB); G8_STAGE(G8_SA(0, 0), cA, voffA); G8_STAGE(G8_SB(0, 1), cB + hstep, voffB); G8_STAGE(G8_SA(0, 1), cA + hstep, voffA);
  if (wr == 1) G8_BAR;
  G8_WAIT_V(4); G8_BAR;
  G8_STAGE(G8_SB(1, 0), cB + kstep, voffB); G8_STAGE(G8_SA(1, 0), cA + kstep, voffA); G8_STAGE(G8_SB(1, 1), cB + hstep + kstep, voffB);
  G8_WAIT_V(6); G8_BAR;
  for (;;) {
    const bool has_next = S.next(ui + 1, nxt);
    const char* nA = has_next ? S.a_ptr(nxt) : cA; const char* nB = has_next ? S.b_ptr(nxt) : cB;
    for (int t = 0; t < nt; t += 2) {
      const bool last = (t == nt - 2);
      const char* a1 = cA + (size_t)(t + 1) * kstep;
      const char* a2 = last ? nA : cA + (size_t)(t + 2) * kstep; const char* b2 = last ? nB : cB + (size_t)(t + 2) * kstep;
      const char* a3 = a2 + kstep; const char* b3 = b2 + kstep;
      G8_LDB(B0, 0, 0); G8_SCHED; G8_LDA(At, 0, 0); G8_STAGE(G8_SA(1, 1), a1 + hstep, voffA);
      G8_WAIT_L(8); G8_BAR; G8_WAIT_L(0); G8_MMA(0, 0, At, B0); G8_BAR; G8_SCHED;
      G8_LDB(B1, 0, 1); G8_STAGE(G8_SB(0, 0), b2, voffB);
      G8_BAR; G8_WAIT_L(0); G8_MMA(0, 1, At, B1); G8_BAR;
      G8_LDA(At, 0, 1); G8_STAGE(G8_SA(0, 0), a2, voffA);
      G8_BAR; G8_WAIT_L(0); G8_MMA(1, 0, At, B0); G8_BAR; G8_SCHED;
      G8_STAGE(G8_SB(0, 1), b2 + hstep, voffB);
      G8_WAIT_V(6); G8_BAR; G8_MMA(1, 1, At, B1); G8_BAR;
      G8_LDB(B0, 1, 0); G8_SCHED; G8_LDA(At, 1, 0); G8_STAGE(G8_SA(0, 1), a2 + hstep, voffA);
      G8_WAIT_L(8); G8_BAR; G8_WAIT_L(0); G8_MMA(0, 0, At, B0); G8_BAR; G8_SCHED;
      G8_LDB(B1, 1, 1); G8_STAGE(G8_SB(1, 0), b3, voffB);
      G8_BAR; G8_WAIT_L(0); G8_MMA(0, 1, At, B1); G8_BAR;
      G8_LDA(At, 1, 1); G8_STAGE(G8_SA(1, 0), a3, voffA);
      G8_BAR; G8_WAIT_L(0); G8_MMA(1, 0, At, B0); G8_BAR; G8_SCHED;
      G8_STAGE(G8_SB(1, 1), b3 + hstep, voffB);
      G8_WAIT_V(6); G8_BAR; G8_MMA(1, 1, At, B1); G8_BAR;
    }
    {
      const int t2 = tidx(); const int w2 = __builtin_amdgcn_readfirstlane(t2 >> 6), l2 = t2 & 63;
      E(acc, cur, w2 >> 2, w2 & 3, l2 & 15, l2 >> 4);
    }
    if (!has_next) break;
#pragma unroll
    for (int a = 0; a < 2; ++a)
#pragma unroll
      for (int b = 0; b < 2; ++b)
#pragma unroll
        for (int m = 0; m < 4; ++m)
#pragma unroll
          for (int n = 0; n < 2; ++n) acc[a][b][m][n] = (f32x4){0.f, 0.f, 0.f, 0.f};
    cur = nxt; cA = nA; cB = nB; ++ui;
  }
  G8_WAIT_V(0);
  if (wr == 0) G8_BAR;
  G8_BAR;
#undef G8_SA
#undef G8_SB
#undef G8_STAGE
#undef G8_LDA
#undef G8_LDB
#undef G8_MMA
#undef G8_WAIT_V
#undef G8_WAIT_L
#undef G8_BAR
#undef G8_SCHED
}

struct EpiZ {
  static constexpr bool PERM = false; float* Z;
  DI void operator()(const Acc& acc, const Unit& u, int wr, int wc, int fr, int fq) const {
    const int row0 = u.pm * BM + wr * 64 + fr, col0 = u.pn * BM + wc * 32 + 4 * fq;
#pragma unroll
    for (int ai = 0; ai < 2; ++ai)
#pragma unroll
      for (int m = 0; m < 4; ++m) { float* rowp = Z + (size_t)(row0 + ai * HALF + m * 16) * INC;
#pragma unroll
        for (int bj = 0; bj < 2; ++bj)
#pragma unroll
          for (int n = 0; n < 2; ++n) { const int col = col0 + bj * HALF + n * 16; if (col < INC) *(f32x4*)(rowp + col) = acc[ai][bj][m][n]; } }
  }
};
struct EpiRes {
  static constexpr bool PERM = false; const float* xs; float* xo;
  DI void operator()(const Acc& acc, const Unit& u, int wr, int wc, int fr, int fq) const {
    const int row0 = u.pm * BM + wr * 64 + fr, col0 = u.pn * BM + wc * 32 + 4 * fq;
#pragma unroll
    for (int ai = 0; ai < 2; ++ai)
#pragma unroll
      for (int m = 0; m < 4; ++m) { const size_t ro = (size_t)(row0 + ai * HALF + m * 16) * DM + col0;
#pragma unroll
        for (int bj = 0; bj < 2; ++bj)
#pragma unroll
          for (int n = 0; n < 2; ++n) { const size_t o = ro + bj * HALF + n * 16; *(f32x4*)(xo + o) = *(const f32x4*)(xs + o) + acc[ai][bj][m][n]; } }
  }
};
struct EpiSig {
  static constexpr bool PERM = true; u16* PG;
  DI void operator()(const Acc& acc, const Unit& u, int wr, int wc, int fr, int fq) const {
    const int row0 = u.pm * BM + wr * 64 + fr, col0 = u.pn * BM + wc * 32 + 8 * fq;
#pragma unroll
    for (int ai = 0; ai < 2; ++ai)
#pragma unroll
      for (int m = 0; m < 4; ++m) { u16* rowp = PG + (size_t)(row0 + ai * HALF + m * 16) * DM + col0;
#pragma unroll
        for (int bj = 0; bj < 2; ++bj) { const f32x4 v0 = acc[ai][bj][m][0], v1 = acc[ai][bj][m][1];
          u32x4 wv = {pk2(sigmoidf_(v0[0]), sigmoidf_(v0[1])), pk2(sigmoidf_(v0[2]), sigmoidf_(v0[3])), pk2(sigmoidf_(v1[0]), sigmoidf_(v1[1])), pk2(sigmoidf_(v1[2]), sigmoidf_(v1[3]))};
          *(u32x4*)(rowp + bj * HALF) = wv; } }
  }
};
struct EpiPle {
  static constexpr bool PERM = false; float* xo; const u16* PG;
  DI void operator()(const Acc& acc, const Unit& u, int wr, int wc, int fr, int fq) const {
    const int row0 = u.pm * BM + wr * 64 + fr, col0 = u.pn * BM + wc * 32 + 4 * fq;
#pragma unroll
    for (int ai = 0; ai < 2; ++ai)
#pragma unroll
      for (int m = 0; m < 4; ++m) { const size_t ro = (size_t)(row0 + ai * HALF + m * 16) * DM + col0;
#pragma unroll
        for (int bj = 0; bj < 2; ++bj)
#pragma unroll
          for (int n = 0; n < 2; ++n) { const size_t o = ro + bj * HALF + n * 16; const u32x2 g = *(const u32x2*)(PG + o);
            f32x4 gv = {__uint_as_float(g[0] << 16), __uint_as_float(g[0] & 0xffff0000u), __uint_as_float(g[1] << 16), __uint_as_float(g[1] & 0xffff0000u)};
            *(f32x4*)(xo + o) = *(const f32x4*)(xo + o) + acc[ai][bj][m][n] * gv; } }
  }
};
struct EpiSwi {
  static constexpr bool PERM = true; u16* HID;
  DI void operator()(const Acc& acc, const Unit& u, int wr, int wc, int fr, int fq) const {
    const int row0 = u.pm * BM + wr * 64 + fr, col0 = u.pn * HALF + wc * 32 + 8 * fq;
#pragma unroll
    for (int ai = 0; ai < 2; ++ai)
#pragma unroll
      for (int m = 0; m < 4; ++m) { u16* rowp = HID + (size_t)(row0 + ai * HALF + m * 16) * 1024 + col0;
        float h[8];
#pragma unroll
        for (int n = 0; n < 2; ++n)
#pragma unroll
          for (int j = 0; j < 4; ++j) { const float gt = acc[ai][0][m][n][j], up = acc[ai][1][m][n][j]; h[n * 4 + j] = gt * frcp(1.f + fexp(-gt)) * up; }
        *(u32x4*)rowp = u32x4{pk2(h[0], h[1]), pk2(h[2], h[3]), pk2(h[4], h[5]), pk2(h[6], h[7])}; }
  }
};
struct EpiYE {
  static constexpr bool PERM = true; u16* YE; const float* GATE;
  DI void operator()(const Acc& acc, const Unit& u, int wr, int wc, int fr, int fq) const {
    const int row0 = u.pm * BM + wr * 64 + fr, col0 = u.pn * BM + wc * 32 + 8 * fq;
#pragma unroll
    for (int ai = 0; ai < 2; ++ai)
#pragma unroll
      for (int m = 0; m < 4; ++m) { const int row = row0 + ai * HALF + m * 16; const float gt = GATE[row]; u16* rowp = YE + (size_t)row * 1024 + col0;
#pragma unroll
        for (int bj = 0; bj < 2; ++bj) { const f32x4 v0 = acc[ai][bj][m][0] * gt, v1 = acc[ai][bj][m][1] * gt;
          *(u32x4*)(rowp + bj * HALF) = u32x4{pk2(v0[0], v0[1]), pk2(v0[2], v0[3]), pk2(v1[0], v1[1]), pk2(v1[2], v1[3])}; } }
  }
};
}

DI void cvt_tile_T(const float* __restrict__ src, int ldsrc, int N, int K, u16* __restrict__ dst, int k0, int n0, int drow0, char* smem, int tid) {
  short* tl = (short*)smem;
  __syncthreads();
#pragma unroll
  for (int i = 0; i < 2; ++i) {
    int u = tid + i * NTH; int kr = u >> 4, nq = u & 15; int n = n0 + nq * 4;
    f32x4 v = f32x4{0.f, 0.f, 0.f, 0.f};
    if (n < N) v = *(const f32x4*)(src + (size_t)(k0 + kr) * ldsrc + n);
#pragma unroll
    for (int e = 0; e < 4; ++e) tl[(nq * 4 + e) * 72 + kr] = (short)f2bf(v[e]);
  }
  __syncthreads();
  { int n = tid >> 3, kc = tid & 7;
    *(u32x4*)(dst + (size_t)(drow0 + n) * K + k0 + kc * 8) = *(const u32x4*)(tl + n * 72 + kc * 8); }
}
constexpr int WIN_PAD = 2560;
DI void ph_cvt_small(const P& p, int layer, char* smem) {
  const int tid = tidx();
  const int t0 = 16 * 40, t1 = t0 + 256, t2 = t1 + 256, t3 = t2 + 64;
  for (int t = blockIdx.x; t < t3; t += gridDim.x) {
    if (t < t0) cvt_tile_T(p.w_in + (size_t)layer * DM * INC, INC, INC, DM, p.WIN, (t / 40) * 64, (t % 40) * 64, (t % 40) * 64, smem, tid);
    else if (t < t1) { int q = t - t0; cvt_tile_T(p.w_out + (size_t)layer * DM * DM, DM, DM, DM, p.WOUT, (q / 16) * 64, (q % 16) * 64, (q % 16) * 64, smem, tid); }
    else if (t < t2) { int q = t - t1; cvt_tile_T(p.ple_gate + (size_t)layer * DM * DM, DM, DM, DM, p.WPG, (q / 16) * 64, (q % 16) * 64, (q % 16) * 64, smem, tid); }
    else { int q = t - t2; cvt_tile_T(p.ple_proj + (size_t)layer * DPLE * DM, DM, DM, DPLE, p.WPP, (q / 16) * 64, (q % 16) * 64, (q % 16) * 64, smem, tid); }
  }
  const float* ps = p.p + (size_t)layer * NTOK * DPLE;
  for (int i = blockIdx.x * NTH + tid; i < NTOK * DPLE / 8; i += gridDim.x * NTH) {
    f32x4 a = *(const f32x4*)(ps + (size_t)i * 8), b = *(const f32x4*)(ps + (size_t)i * 8 + 4);
    *(u32x4*)(p.PB + (size_t)i * 8) = u32x4{pk2(a[0], a[1]), pk2(a[2], a[3]), pk2(b[0], b[1]), pk2(b[2], b[3])};
  }
}

struct CvtJob { const float* src; u16* dst; int k0, n0, drow0; };
DI bool cvt_job(const P& p, int layer, int t, CvtJob& j) {
  if (t >= NE * 3 * 128) return false;
  const int e = t / 384, r = t % 384, mat = r / 128, q = r % 128;
  j.k0 = (q / 8) * 64; j.n0 = (q % 8) * 128;
  const size_t eo = ((size_t)layer * NE + e) * 1024 * 1024;
  if (mat == 0) { j.src = p.exp_w_gate + eo; j.dst = p.EW1 + (size_t)e * 2048 * 1024; j.drow0 = (j.n0 >> 7) * 256; }
  else if (mat == 1) { j.src = p.exp_w_up + eo; j.dst = p.EW1 + (size_t)e * 2048 * 1024; j.drow0 = (j.n0 >> 7) * 256 + 128; }
  else { j.src = p.exp_w_down + eo; j.dst = p.EW2 + (size_t)e * 1024 * 1024; j.drow0 = j.n0; }
  return true;
}
DI void ph_cvt_experts(const P& p, int layer, char* smem, unsigned* ctr) {
  const int tid = tidx();
  short* tl = (short*)smem;
  int* sitem = (int*)(smem + 32768);
  __syncthreads();
  if (tid == 0) sitem[0] = (int)atomicAdd(ctr, 1u);
  __syncthreads();
  CvtJob cur; bool has = cvt_job(p, layer, sitem[0], cur);
  f32x4 v[4];
  const int kr = tid >> 5, nq = tid & 31;
  if (has) {
#pragma unroll
    for (int i = 0; i < 4; ++i) v[i] = *(const f32x4*)(cur.src + (size_t)(cur.k0 + kr + 16 * i) * 1024 + cur.n0 + nq * 4);
  }
  int par = 0;
  while (has) {
    if (tid == 0) sitem[1 + par] = (int)atomicAdd(ctr, 1u);
    __syncthreads();
#pragma unroll
    for (int i = 0; i < 4; ++i)
#pragma unroll
      for (int e = 0; e < 4; ++e) tl[(nq * 4 + e) * 72 + kr + 16 * i] = (short)f2bf(v[i][e]);
    __syncthreads();
    CvtJob nxt; const bool hn = cvt_job(p, layer, sitem[1 + par], nxt);
    if (hn) {
#pragma unroll
      for (int i = 0; i < 4; ++i) v[i] = *(const f32x4*)(nxt.src + (size_t)(nxt.k0 + kr + 16 * i) * 1024 + nxt.n0 + nq * 4);
    }
#pragma unroll
    for (int i = 0; i < 2; ++i) {
      int u = tid + i * NTH; int n = u >> 3, kc = u & 7;
      *(u32x4*)(cur.dst + (size_t)(cur.drow0 + n) * 1024 + cur.k0 + kc * 8) = *(const u32x4*)(tl + n * 72 + kc * 8);
    }
    cur = nxt; has = hn; par ^= 1;
  }
}
DI void ph_gather(const P& p) {
  const int tid_ = tidx(); const int lane = tid_ & 63, w = tid_ >> 6;
  for (int row = blockIdx.x * 8 + w; row < NB * NE * CAP; row += gridDim.x * 8) {
    const int b = row / (NE * CAP);
    const int tok = b * T + p.IDX[row];
    const u32x4* src = (const u32x4*)(p.H + (size_t)tok * DM);
    u32x4* dst = (u32x4*)(p.XE + (size_t)row * DM);
    u32x4 a = src[lane], c = src[lane + 64];
    dst[lane] = a; dst[lane + 64] = c;
  }
}
DI void ph_combine_norm(const P& p, int layer) {
  const int tid_ = tidx(); const int lane = tid_ & 63, w = tid_ >> 6;
  const float* g = p.ple_norm + layer * DM;
  for (int tok = blockIdx.x * 8 + w; tok < NTOK; tok += gridDim.x * 8) {
    f32x4* xr = (f32x4*)(p.out + (size_t)tok * DM);
    f32x4 v[4];
#pragma unroll
    for (int j = 0; j < 4; ++j) v[j] = xr[lane * 4 + j];
    const int cnt = p.TCNT[tok];
    for (int q = 0; q < cnt; ++q) {
      const int yrow = p.TLIST[(size_t)tok * 16 + q];
      const u32x4* yr = (const u32x4*)(p.YE + (size_t)yrow * DM + lane * 16);
      u32x4 a = yr[0], c = yr[1];
#pragma unroll
      for (int e = 0; e < 4; ++e) {
        v[e >> 1][(e & 1) * 2] += __uint_as_float(a[e] << 16); v[e >> 1][(e & 1) * 2 + 1] += __uint_as_float(a[e] & 0xffff0000u);
        v[2 + (e >> 1)][(e & 1) * 2] += __uint_as_float(c[e] << 16); v[2 + (e >> 1)][(e & 1) * 2 + 1] += __uint_as_float(c[e] & 0xffff0000u);
      }
    }
    float ss = 0.f;
#pragma unroll
    for (int j = 0; j < 4; ++j) { xr[lane * 4 + j] = v[j]; ss += v[j][0] * v[j][0] + v[j][1] * v[j][1] + v[j][2] * v[j][2] + v[j][3] * v[j][3]; }
    ss = wave_sum(ss);
    const float rstd = frsq(ss * (1.f / DM) + NORM_EPS);
    u32x4 o0, o1;
#pragma unroll
    for (int j = 0; j < 4; ++j) {
      f32x4 gg = *(const f32x4*)(g + lane * 16 + j * 4);
      unsigned lo = pk2(v[j][0] * rstd * gg[0], v[j][1] * rstd * gg[1]), hi = pk2(v[j][2] * rstd * gg[2], v[j][3] * rstd * gg[3]);
      if (j < 2) { o0[j * 2] = lo; o0[j * 2 + 1] = hi; } else { o1[(j - 2) * 2] = lo; o1[(j - 2) * 2 + 1] = hi; }
    }
    *(u32x4*)(p.H + (size_t)tok * DM + lane * 16) = o0; *(u32x4*)(p.H + (size_t)tok * DM + lane * 16 + 8) = o1;
  }
}

#define XB_TMO      128
#define XB_XCNT(j)  (256  + 64 * (j))
#define XB_XSUB(j)  (1280 + 64 * (j))
#define XB_XGEN(j)  (2304 + 64 * (j))
#define XB_TOP      3328
#define XB_TOPGEN   3392
#define XCD_BAR_WORDS 3456
#define XB_SPIN_CAP (1u << 20)
DI unsigned xb_ld(unsigned* p) { return __hip_atomic_load(p, __ATOMIC_RELAXED, __HIP_MEMORY_SCOPE_AGENT); }
DI unsigned xb_add(unsigned* p, unsigned v) { return __hip_atomic_fetch_add(p, v, __ATOMIC_RELAXED, __HIP_MEMORY_SCOPE_AGENT); }
DI unsigned xb_xcc_id() { return (unsigned)__builtin_amdgcn_s_getreg((3 << 11) | 20) & 0xFu; }
#define XB_SPIN(cond, bar) do { unsigned _sp = 0; while (cond) { __builtin_amdgcn_s_sleep(1); \
    if ((++_sp & 255u) == 0u) { if (xb_ld(&(bar)[XB_TMO])) break; if (_sp > XB_SPIN_CAP) { atomicAdd(&(bar)[XB_TMO], 1u); break; } } } } while (0)
struct XcdBarrier { unsigned* bar; unsigned x; volatile LAS unsigned* st; };
DI XcdBarrier xcd_barrier_post(unsigned* bar, volatile LAS unsigned* st) {
  XcdBarrier b; b.bar = bar; b.x = xb_xcc_id(); b.st = st;
  if (threadIdx.x == 0) (void)xb_add(&bar[XB_XCNT(b.x)], 1u);
  return b;
}
DI void xcd_barrier_complete(unsigned* bar, unsigned x, unsigned& nloc, unsigned& nx) {
  const unsigned G = gridDim.x * gridDim.y * gridDim.z;
  unsigned sum, cnt, mine, sp = 0u;
  for (;;) {
    sum = 0u; cnt = 0u; mine = 0u;
#pragma unroll
    for (unsigned j = 0; j < 16; ++j) { const unsigned c = xb_ld(&bar[XB_XCNT(j)]); sum += c; cnt += (c > 0u) ? 1u : 0u; mine = (j == x) ? c : mine; }
    if (sum == G) break;
    __builtin_amdgcn_s_sleep(1);
    if ((++sp & 255u) == 0u) { if (xb_ld(&bar[XB_TMO])) break; if (sp > XB_SPIN_CAP) { atomicAdd(&bar[XB_TMO], 1u); break; } }
  }
  nloc = mine > 0u ? mine : 1u; nx = cnt > 0u ? cnt : 1u;
}
DI void xcd_barrier(const XcdBarrier& b) {
  asm volatile("s_waitcnt vmcnt(0)" ::: "memory");
  __syncthreads();
  if (threadIdx.x == 0) {
    unsigned* bar = b.bar;
    __builtin_amdgcn_s_waitcnt(0);
    unsigned nloc = b.st[0], nx = b.st[1];
    if (nloc == 0u) { xcd_barrier_complete(bar, b.x, nloc, nx); b.st[0] = nloc; b.st[1] = nx; }
    const unsigned old = xb_add(&bar[XB_XSUB(b.x)], 1u);
    const unsigned gen = old / nloc;
    if (old + 1u == (gen + 1u) * nloc) {
      __builtin_amdgcn_fence(__ATOMIC_RELEASE, "agent");
      asm volatile("s_waitcnt vmcnt(0)" ::: "memory");
      const unsigned og = xb_add(&bar[XB_TOP], 1u);
      const unsigned tg = og / nx;
      if (og + 1u == (tg + 1u) * nx) xb_add(&bar[XB_TOPGEN], 1u);
      else XB_SPIN(xb_ld(&bar[XB_TOPGEN]) == tg, bar);
      __builtin_amdgcn_fence(__ATOMIC_ACQUIRE, "agent");
      xb_add(&bar[XB_XGEN(b.x)], 1u);
      asm volatile("s_waitcnt vmcnt(0)" ::: "memory");
    } else {
      XB_SPIN(xb_ld(&bar[XB_XGEN(b.x)]) == gen, bar);
      __builtin_amdgcn_fence(__ATOMIC_ACQUIRE, "agent");
      asm volatile("s_waitcnt vmcnt(0)" ::: "memory");
    }
  }
  __syncthreads();
}

#define TAKE(bytes) (ws + off); off += (((size_t)(bytes)) + 255) & ~(size_t)255
__host__ __device__ inline size_t fill_ws(P& p, char* ws) {
  size_t off = 0;
  char* regA = TAKE((size_t)NTOK * INC * 4);
  p.Z = (float*)regA;
  p.LW = (u16*)regA; p.AA = (u16*)(regA + (size_t)2 * NTOK * RWW * 2); p.G = (u16*)(regA + (size_t)4 * NTOK * RWW * 2);
  p.MC = (float*)(regA + (size_t)5 * NTOK * RWW * 2); p.NC = p.MC + (size_t)32 * NCH * 4096;
  p.HID = (u16*)regA;
  char* regB = TAKE((size_t)3 * NTOK * RWW * 4);
  p.R = (float*)regB; p.K = p.R + (size_t)NTOK * RWW; p.V = p.K + (size_t)NTOK * RWW;
  p.PG = (float*)regB;
  char* regC = TAKE((size_t)NTOK * (768 + 1024) * 4);
  p.QRAW = (float*)regC; p.KVRAW = p.QRAW + (size_t)NTOK * 768;
  p.AO = (float*)regC; p.O2 = (u16*)(p.AO + (size_t)NTOK * 512); p.SS = (float*)(p.O2 + (size_t)2 * NTOK * 512);
  p.TWD = (u16*)TAKE((size_t)2 * NTOK * 64 * 2); p.AD = (u16*)TAKE((size_t)2 * NTOK * 64 * 2);
  p.SGD = (u16*)TAKE((size_t)NTOK * 128 * 2); p.QDN = (u16*)TAKE((size_t)NTOK * 256 * 2);
  p.KVDN = (u16*)TAKE((size_t)NTOK * 128 * 2); p.KR = (float*)TAKE((size_t)NTOK * 32 * 4);
  p.ROPE = (float*)TAKE((size_t)NTOK * 32 * 4);
  p.Q = (u16*)TAKE((size_t)NTOK * NH * 96 * 2); p.Kc = (u16*)TAKE((size_t)NTOK * NH * 96 * 2);
  p.Vv = (u16*)TAKE((size_t)NTOK * NH * 64 * 2);
  p.H = (u16*)TAKE((size_t)NTOK * DM * 2);
  p.AFF = (float*)TAKE((size_t)NB * NE * T * 4);
  p.IDX = (int*)TAKE((size_t)NB * NE * CAP * 4);
  p.GATE = (float*)TAKE((size_t)NB * NE * CAP * 4);

  p.WIN = (u16*)TAKE((size_t)WIN_PAD * DM * 2); p.WOUT = (u16*)TAKE((size_t)DM * DM * 2); p.WPG = (u16*)TAKE((size_t)DM * DM * 2);
  p.WPP = (u16*)TAKE((size_t)DM * DPLE * 2); p.PB = (u16*)TAKE((size_t)NTOK * DPLE * 2);
  p.PGb = (u16*)regB;
  p.EW1 = (u16*)regB; p.EW2 = p.EW1 + (size_t)NE * 2048 * 1024;
  p.XE = (u16*)regA; p.HID = (u16*)(regA + (size_t)32 * 1024 * 1024 * 2);
  p.YE = (u16*)regC;
  p.TCNT = (int*)TAKE((size_t)NTOK * 4); p.TLIST = (int*)TAKE((size_t)NTOK * 16 * 4);
  p.CTR = (unsigned*)TAKE(256);
  p.BAR = (unsigned*)TAKE(XCD_BAR_WORDS * 4);
  return off;
}
#undef TAKE
constexpr int DSM_BYTES = g8::STAGE_BYTES + 64;
extern __shared__ __attribute__((aligned(16))) char dsm[];
struct PK { const void* in[31]; float* out; char* ws; };
DI void build_params(P& p, const PK& k) {
  p.x = (const float*)k.in[0]; p.p = (const float*)k.in[1]; p.pos = (const int*)k.in[2];
  p.attn_norm = (const float*)k.in[3]; p.w_in = (const float*)k.in[4]; p.rw_mu = (const float*)k.in[5];
  p.rw_w0 = (const float*)k.in[6]; p.rw_w_up = (const float*)k.in[7]; p.rw_a0 = (const float*)k.in[8];
  p.rw_a_up = (const float*)k.in[9]; p.rw_g_up = (const float*)k.in[10]; p.rw_k_k = (const float*)k.in[11];
  p.rw_k_a = (const float*)k.in[12]; p.rw_r_k = (const float*)k.in[13]; p.rw_lnx_w = (const float*)k.in[14];
  p.rw_lnx_b = (const float*)k.in[15]; p.mla_q_norm = (const float*)k.in[16]; p.mla_q_up = (const float*)k.in[17];
  p.mla_kv_norm = (const float*)k.in[18]; p.mla_kv_up = (const float*)k.in[19]; p.mla_o_norm = (const float*)k.in[20];
  p.w_out = (const float*)k.in[21]; p.ffn_norm = (const float*)k.in[22]; p.router = (const float*)k.in[23];
  p.exp_w_gate = (const float*)k.in[24]; p.exp_w_up = (const float*)k.in[25]; p.exp_w_down = (const float*)k.in[26];
  p.ple_norm = (const float*)k.in[27]; p.ple_proj = (const float*)k.in[28]; p.ple_gate = (const float*)k.in[29];
  p.final_norm = (const float*)k.in[30];
  p.out = k.out;
  (void)fill_ws(p, k.ws);
}
__global__ void __launch_bounds__(NTH) mega(PK pk) {
  P p; build_params(p, pk);
  char* smem = dsm;
  LAS unsigned char* glds = (LAS unsigned char*)dsm;
  uint4* xbw = (uint4*)(dsm + g8::STAGE_BYTES);
  cg::grid_group grid = cg::this_grid();
  if (threadIdx.x == 0) *xbw = make_uint4(0u, 0u, 0u, 0u);
  if (pk.ws == nullptr) grid.sync();
  const XcdBarrier xb = xcd_barrier_post(p.BAR, (volatile LAS unsigned*)xbw);
#define GSYNC() xcd_barrier(xb)
#ifndef PROBE_MASK
#define PROBE_MASK 0u
#endif
#if PROBE_MASK
  unsigned long long pt0 = __builtin_amdgcn_s_memrealtime();
#define PSYNC(id) do { GSYNC(); if (PROBE_MASK & (1u << (id))) { unsigned long long t1_ = __builtin_amdgcn_s_memrealtime(); unsigned long long dt_ = t1_ - pt0; \
    while (__builtin_amdgcn_s_memrealtime() - t1_ < dt_) __builtin_amdgcn_s_sleep(8); } pt0 = __builtin_amdgcn_s_memrealtime(); } while (0)
#else
#define PSYNC(id) GSYNC()
#endif
  for (int layer_ = 0; layer_ < NL; ++layer_) {
    int layer = layer_; asm volatile("" : "+s"(layer));
    if (layer_ == 0) ph_rope_table(p);
    ph_cvt_small(p, layer, smem);
    ph_norm(layer == 0 ? p.x : p.out, p.attn_norm + layer * DM, p.H);
    PSYNC(0);
    {
      g8::Sched S; S.init(NTOK / 256, WIN_PAD / 256, gridDim.x, bidx(), p.H, p.WIN, DM);
      g8::EpiZ E{p.Z};
      g8::gemm_phase(glds, DM, S, E);
    }
    PSYNC(1);
    ph_rwshift(p, layer);
    ph_mlaprep1(p, layer);
    PSYNC(2);
    for (int d = 0; d < 2; ++d) {
      u16* LW = p.LW + (size_t)d * NTOK * RWW; const float* w0 = p.rw_w0 + (layer * 2 + d) * RWW;
      ph_gemm<false>(p.TWD + (size_t)d * NTOK * 64, 64, p.rw_w_up + ((size_t)(layer * 2 + d)) * 64 * RWW, RWW, NTOK, RWW, 64, smem,
                     [&](int row, int col, float v) { LW[(size_t)row * RWW + col] = f2bf(-0.6065306597126334f * sigmoidf_(v + w0[col])); });
      u16* AA = p.AA + (size_t)d * NTOK * RWW; const float* a0 = p.rw_a0 + (layer * 2 + d) * RWW;
      ph_gemm<false>(p.AD + (size_t)d * NTOK * 64, 64, p.rw_a_up + ((size_t)(layer * 2 + d)) * 64 * RWW, RWW, NTOK, RWW, 64, smem,
                     [&](int row, int col, float v) { AA[(size_t)row * RWW + col] = f2bf(sigmoidf_(v + a0[col])); });
    }
    {
      u16* G = p.G;
      ph_gemm<false>(p.SGD, 128, p.rw_g_up + (size_t)layer * 128 * RWW, RWW, NTOK, RWW, 128, smem,
                     [&](int row, int col, float v) { G[(size_t)row * RWW + col] = f2bf(v); });
      {
        u16* Qo = p.Q; const float* rope = p.ROPE;
        ph_gemm_t(p.QDN, 256, p.mla_q_up + (size_t)layer * 256 * 768, 768, NTOK, 768, 256, smem,
                  [&](const f32x4 (&acc)[4][4], int m0, int n0, int wm, int wn, int lq, int l15) {
          const float qs = 0.10206207261596577f * 1.4426950408889634f;
#pragma unroll
          for (int mi = 0; mi < 4; ++mi)
#pragma unroll
            for (int r = 0; r < 4; ++r) {
              const int tok = m0 + wm * 64 + mi * 16 + lq * 4 + r; const int b = tok / T, t = tok % T;
#pragma unroll
              for (int ni = 0; ni < 4; ++ni) {
                const int col0 = n0 + wn * 64 + ni * 16; const int h = col0 / 96, c0 = col0 % 96;
                u16* qo = Qo + ((size_t)(b * NH + h) * T + t) * 96;
                if (c0 < 64) qo[c0 + l15] = f2bf(acc[mi][ni][r] * qs);
                else if (c0 == 64) {
                  const f32x2 csn = *(const f32x2*)(rope + (size_t)tok * 32 + l15 * 2);
                  const float u1 = acc[mi][ni][r], u2 = acc[mi][(ni + 1) & 3][r];
                  qo[64 + l15] = f2bf((u1 * csn[0] - u2 * csn[1]) * qs);
                  qo[80 + l15] = f2bf((u1 * csn[1] + u2 * csn[0]) * qs);
                }
              }
            }
        });
      }
      {
        u16* Ko = p.Kc; u16* Vo = p.Vv;
        ph_gemm_t(p.KVDN, 128, p.mla_kv_up + (size_t)layer * 128 * 1024, 1024, NTOK, 1024, 128, smem,
                  [&](const f32x4 (&acc)[4][4], int m0, int n0, int wm, int wn, int lq, int l15) {
#pragma unroll
          for (int mi = 0; mi < 4; ++mi)
#pragma unroll
            for (int r = 0; r < 4; ++r) {
              const int tok = m0 + wm * 64 + mi * 16 + lq * 4 + r; const int b = tok / T, t = tok % T;
#pragma unroll
              for (int ni = 0; ni < 4; ++ni) {
                const int col0 = n0 + wn * 64 + ni * 16; const int h = col0 >> 7, c0 = col0 & 127;
                const size_t rowi = (size_t)(b * NH + h) * T + t;
                if (c0 < 64) Ko[rowi * 96 + c0 + l15] = f2bf(acc[mi][ni][r]);
                else Vo[rowi * 64 + (c0 - 64) + l15] = f2bf(acc[mi][ni][r]);
              }
            }
        });
      }
    }
    PSYNC(3);
    ph_scan1(p, layer, smem);
    PSYNC(4);
    ph_scan2(p, smem);
    ph_attn(p, smem, p.CTR + layer);
    PSYNC(5);
    ph_mla_norm(p, layer);
    ph_scan3(p, layer, smem);
    PSYNC(6);
    {
      for (int i = blockIdx.x * NTH + tidx(); i < NTOK; i += gridDim.x * NTH) p.TCNT[i] = 0;
      g8::Sched S; S.init(NTOK / 256, DM / 256, gridDim.x, bidx(), p.H, p.WOUT, DM);
      g8::EpiRes E{(layer == 0) ? p.x : p.out, p.out};
      g8::gemm_phase(glds, DM, S, E);
    }
    PSYNC(8);
    ph_norm_router(p, layer, smem);
    PSYNC(9);
    ph_topk(p, smem);
    ph_cvt_experts(p, layer, smem, p.CTR + 4 + layer);
    PSYNC(10);
    ph_gather(p);
    PSYNC(11);
    {
      g8::Sched S; S.init(NB * NE * CAP / 256, 2048 / 256, gridDim.x, bidx(), p.XE, p.EW1, DM);
      S.group(4, NE, (size_t)2048 * 1024 * 2);
      g8::EpiSwi E{p.HID};
      g8::gemm_phase(glds, DM, S, E);
    }
    PSYNC(12);
    {
      g8::Sched S; S.init(NB * NE * CAP / 256, DM / 256, gridDim.x, bidx(), p.HID, p.EW2, 1024);
      S.group(4, NE, (size_t)1024 * 1024 * 2);
      g8::EpiYE E{p.YE, p.GATE};
      g8::gemm_phase(glds, 1024, S, E);
    }
    PSYNC(13);
    ph_combine_norm(p, layer);
    PSYNC(16);
    {
      g8::Sched S; S.init(NTOK / 256, DM / 256, gridDim.x, bidx(), p.H, p.WPG, DM);
      g8::EpiSig E{p.PGb};
      g8::gemm_phase(glds, DM, S, E);
    }
    {
      g8::Sched S; S.init(NTOK / 256, DM / 256, gridDim.x, bidx(), p.PB, p.WPP, DPLE);
      g8::EpiPle E{p.out, p.PGb};
      g8::gemm_phase(glds, DPLE, S, E);
    }
    PSYNC(15);
  }
  ph_final_norm(p.out, p.final_norm);
}

extern "C" void kernel_launch(void* const* d_in, const int* in_sizes, int n_in, void* d_out, int out_size, void* d_ws,
                              size_t ws_size, hipStream_t stream) {
  (void)in_sizes; (void)n_in; (void)out_size;
  PK pk{};
  for (int i = 0; i < 31; ++i) pk.in[i] = d_in[i];
  pk.out = (float*)d_out; pk.ws = (char*)d_ws;
  P p{};
  const size_t off = fill_ws(p, (char*)d_ws);
  if (off > ws_size) { fprintf(stderr, "workspace too small: need %zu have %zu\n", off, ws_size); return; }
  static int grid_blocks = 0;
  if (!grid_blocks) {
    int dev = 0, cus = 0, per_cu = 0;
    hipGetDevice(&dev);
    hipDeviceGetAttribute(&cus, hipDeviceAttributeMultiprocessorCount, dev);
    hipFuncSetAttribute((const void*)mega, hipFuncAttributeMaxDynamicSharedMemorySize, DSM_BYTES);
    hipOccupancyMaxActiveBlocksPerMultiprocessor(&per_cu, mega, NTH, DSM_BYTES);
    if (per_cu > 1) per_cu = 1;
    grid_blocks = cus * per_cu;
  }
  hipMemsetAsync(p.CTR, 0, 256 + (size_t)XCD_BAR_WORDS * 4, stream);
  void* args[] = {&pk};
  hipError_t e = hipLaunchCooperativeKernel((void*)mega, dim3(grid_blocks), dim3(NTH), args, DSM_BYTES, stream);
  if (e != hipSuccess) fprintf(stderr, "cooperative launch failed: %s (grid %d)\n", hipGetErrorString(e), grid_blocks);
}
```

```cpp
#include <hip/hip_runtime.h>
#include <hip/hip_bf16.h>
#include <cstdio>
#include <cstdint>
#include <hip/hip_cooperative_groups.h>
namespace cg = cooperative_groups;

#define DI __device__ __forceinline__
#define LAS __attribute__((address_space(3)))

constexpr int NB = 2, T = 8192, NTOK = NB * T, DM = 1024, NL = 2;
constexpr int RWW = 512, RWC = 1920, INC = 2336;
constexpr int NH = 8;
constexpr int NE = 16, CAP = 1024;
constexpr int DPLE = 256;
constexpr int NTH = 512;
constexpr float NORM_EPS = 1e-6f, GN_EPS = 64e-5f;

using bf16x8 = __attribute__((ext_vector_type(8))) short;
using s16x4  = __attribute__((ext_vector_type(4))) short;
using f32x4  = __attribute__((ext_vector_type(4))) float;
using u32x4  = __attribute__((ext_vector_type(4))) unsigned;
using f32x2  = __attribute__((ext_vector_type(2))) float;
using u32x2  = __attribute__((ext_vector_type(2))) unsigned;
typedef __bf16 bf2_t __attribute__((ext_vector_type(2)));
typedef unsigned short u16;

DI unsigned pk2(float a, float b) { bf2_t v = {(__bf16)a, (__bf16)b}; return __builtin_bit_cast(unsigned, v); }
DI u16 f2bf(float a) { return (u16)(pk2(a, 0.f) & 0xffffu); }
DI float bf2f(u16 u) { return __uint_as_float(((unsigned)u) << 16); }
DI const void* uni_ptr(const void* q) {
  unsigned long long v = (unsigned long long)q;
  unsigned lo = __builtin_amdgcn_readfirstlane((unsigned)v), hi = __builtin_amdgcn_readfirstlane((unsigned)(v >> 32));
  return (const void*)(((unsigned long long)hi << 32) | lo);
}
DI int tidx() { int t = threadIdx.x; asm volatile("" : "+v"(t)); return t; }
DI int bidx() { int b = blockIdx.x; asm volatile("" : "+s"(b)); return b; }
template <int CTRL> DI float dpp_f(float v) {
  return __int_as_float(__builtin_amdgcn_update_dpp(__float_as_int(v), __float_as_int(v), CTRL, 0xF, 0xF, true));
}
DI float red_x1(float v) { return v + dpp_f<0xB1>(v); }
DI float red_x2(float v) { return v + dpp_f<0x4E>(v); }
DI float red_x4(float v) { return v + dpp_f<0x141>(v); }
DI float red_x8(float v) { return v + dpp_f<0x140>(v); }
DI float red_x16(float v) { auto r = __builtin_amdgcn_permlane16_swap(__float_as_uint(v), __float_as_uint(v), false, false); return __uint_as_float(r[0]) + __uint_as_float(r[1]); }
DI float red_x32(float v) { auto r = __builtin_amdgcn_permlane32_swap(__float_as_uint(v), __float_as_uint(v), false, false); return __uint_as_float(r[0]) + __uint_as_float(r[1]); }
DI float red16(float v) { return red_x8(red_x4(red_x2(red_x1(v)))); }
DI float wave_sum(float v) { return red_x32(red_x16(red16(v))); }
DI float frcp(float x) { return __builtin_amdgcn_rcpf(x); }
DI float frsq(float x) { return __builtin_amdgcn_rsqf(x); }
DI float fexp(float x) { return __builtin_amdgcn_exp2f(x * 1.4426950408889634f); }
DI float sigmoidf_(float x) { return frcp(1.f + fexp(-x)); }
DI float ftanh(float x) { return 1.f - 2.f * frcp(1.f + fexp(2.f * x)); }
DI s16x4 tr_read(const short* p) {
  return __builtin_amdgcn_ds_read_tr16_b64_v4i16((LAS s16x4*)(p));
}

struct P {
  const float* x; const float* p; const int* pos;
  const float* attn_norm; const float* w_in; const float* rw_mu; const float* rw_w0; const float* rw_w_up;
  const float* rw_a0; const float* rw_a_up; const float* rw_g_up; const float* rw_k_k; const float* rw_k_a;
  const float* rw_r_k; const float* rw_lnx_w; const float* rw_lnx_b; const float* mla_q_norm; const float* mla_q_up;
  const float* mla_kv_norm; const float* mla_kv_up; const float* mla_o_norm; const float* w_out; const float* ffn_norm;
  const float* router; const float* exp_w_gate; const float* exp_w_up; const float* exp_w_down; const float* ple_norm;
  const float* ple_proj; const float* ple_gate; const float* final_norm;
  float* out;
  float* Z;
  u16* LW;
  u16* AA;
  float* MC; float* NC;
  float* SS;
  u16*   G;
  u16*   HID;
  float* R; float* K; float* V;
  float* PG;
  float* QRAW;
  float* KVRAW;
  float* AO;
  u16* O2;
  u16* TWD; u16* AD; u16* SGD; u16* QDN; u16* KVDN; float* KR;
  float* ROPE;
  u16* Q; u16* Kc; u16* Vv;
  u16* H;
  float* AFF;
  int* IDX;
  float* GATE;
  u16* WIN; u16* WOUT; u16* WPG; u16* WPP; u16* PB;
  u16* PGb;
  u16* EW1; u16* EW2;
  u16* XE; u16* YE;
  int* TCNT; int* TLIST;
  unsigned* CTR;
  unsigned* BAR;
};

constexpr int GBM = 256, GBN = 128, GBK = 64;
constexpr int AS_STRIDE = 72, BS_STRIDE = 136;
constexpr int AS_BYTES = GBM * AS_STRIDE * 2;
constexpr int BS_BYTES = GBK * BS_STRIDE * 2;
constexpr int SMEM_BYTES = 57344;

template <bool A_F32, int MODE, class ARow, class Epi>
DI void gemm_tile(ARow arow, const float* __restrict__ B, const float* __restrict__ B2, int ldb, int K, int n0, int Nvalid,
                  char* smem, Epi epi) {
  short* As = (short*)smem;
  short* Bs = (short*)(smem + AS_BYTES);
  const int tid = tidx(), lane = tid & 63, w = tid >> 6;
  const int wm = w >> 1, wn = w & 1;
  const int l15 = lane & 15, lq = lane >> 4;

  const char* ap[4];
#pragma unroll
  for (int i = 0; i < 4; ++i) {
    int u = tid + i * NTH; int row = u >> 3, kc = u & 7;
    ap[i] = (const char*)arow(row) + (size_t)kc * 8 * (A_F32 ? 4 : 2);
  }
  const float* bp[4]; bool bok[4];
#pragma unroll
  for (int i = 0; i < 4; ++i) {
    int u = tid + i * NTH; int k = u >> 5, nq = u & 31;
    int col; const float* base;
    if (MODE != 1) { col = n0 + nq * 4; base = B; }
    else { col = n0 + (nq & 15) * 4; base = (nq < 16) ? B : B2; }
    bok[i] = col < Nvalid;
    bp[i] = base + (size_t)k * ldb + (bok[i] ? col : 0);
  }

  f32x4 acc[4][4];
#pragma unroll
  for (int i = 0; i < 4; ++i)
#pragma unroll
    for (int j = 0; j < 4; ++j) acc[i][j] = f32x4{0.f, 0.f, 0.f, 0.f};

  u32x4 areg[4]; f32x4 breg[4];
#define GLOAD(kt_)                                                                                   \
  {                                                                                                  \
    _Pragma("unroll") for (int i = 0; i < 4; ++i) {                                                  \
      if (A_F32) {                                                                                   \
        const float4* q = (const float4*)(ap[i] + (size_t)(kt_) * GBK * 4);                          \
        float4 v0 = q[0], v1 = q[1];                                                                 \
        areg[i] = u32x4{pk2(v0.x, v0.y), pk2(v0.z, v0.w), pk2(v1.x, v1.y), pk2(v1.z, v1.w)};         \
      } else {                                                                                       \
        areg[i] = *(const u32x4*)(ap[i] + (size_t)(kt_) * GBK * 2);                                  \
      }                                                                                              \
    }                                                                                                \
    _Pragma("unroll") for (int i = 0; i < 4; ++i) {                                                  \
      if (bok[i]) breg[i] = *(const f32x4*)(bp[i] + (size_t)(kt_) * GBK * ldb);                      \
      else breg[i] = f32x4{0.f, 0.f, 0.f, 0.f};                                                      \
    }                                                                                                \
  }
  const int nk = K / GBK;
  GLOAD(0)
  for (int kt = 0; kt < nk; ++kt) {
    __syncthreads();
#pragma unroll
    for (int i = 0; i < 4; ++i) {
      int u = tid + i * NTH; int row = u >> 3, kc = u & 7;
      *(u32x4*)(As + row * AS_STRIDE + kc * 8) = areg[i];
    }
#pragma unroll
    for (int i = 0; i < 4; ++i) {
      int u = tid + i * NTH; int k = u >> 5, nq = u & 31;
      u32x2 v = u32x2{pk2(breg[i][0], breg[i][1]), pk2(breg[i][2], breg[i][3])};
      *(u32x2*)(Bs + k * BS_STRIDE + nq * 4) = v;
    }
    __syncthreads();
    if (kt + 1 < nk) GLOAD(kt + 1)
#pragma unroll
    for (int ks = 0; ks < 2; ++ks) {
      bf16x8 a[4], b[4];
#pragma unroll
      for (int mi = 0; mi < 4; ++mi)
        a[mi] = *(const bf16x8*)(As + (wm * 64 + mi * 16 + l15) * AS_STRIDE + ks * 32 + 8 * lq);
#pragma unroll
      for (int ni = 0; ni < 4; ++ni) {
        int col0 = (MODE != 1) ? (wn * 64 + ni * 16) : ((ni < 2) ? (wn * 32 + ni * 16) : (64 + wn * 32 + (ni - 2) * 16));
        int kb = ks * 32 + 8 * lq; int q = l15 >> 2, pp = l15 & 3;
        s16x4 lo = tr_read(Bs + (kb + q) * BS_STRIDE + col0 + 4 * pp);
        s16x4 hi = tr_read(Bs + (kb + 4 + q) * BS_STRIDE + col0 + 4 * pp);
        b[ni] = __builtin_shufflevector(lo, hi, 0, 1, 2, 3, 4, 5, 6, 7);
      }
#pragma unroll
      for (int mi = 0; mi < 4; ++mi)
#pragma unroll
        for (int ni = 0; ni < 4; ++ni)
          acc[mi][ni] = __builtin_amdgcn_mfma_f32_16x16x32_bf16(a[mi], b[ni], acc[mi][ni], 0, 0, 0);
    }
  }
  if constexpr (MODE == 2) { epi(acc, wm, wn, lq, l15); return; }
  else {
#pragma unroll
  for (int mi = 0; mi < 4; ++mi)
#pragma unroll
    for (int r = 0; r < 4; ++r) {
      int row = wm * 64 + mi * 16 + lq * 4 + r;
      if (MODE == 0) {
#pragma unroll
        for (int ni = 0; ni < 4; ++ni) {
          int col = n0 + wn * 64 + ni * 16 + l15;
          if (col < Nvalid) epi(row, col, acc[mi][ni][r], 0.f);
        }
      } else {
#pragma unroll
        for (int ni = 0; ni < 2; ++ni) {
          int col = n0 + wn * 32 + ni * 16 + l15;
          epi(row, col, acc[mi][ni][r], acc[mi][ni + 2][r]);
        }
      }
    }
  }
}

DI void ph_norm(const float* __restrict__ X, const float* __restrict__ g, u16* __restrict__ Hout) {
  const int tid_ = tidx(); const int lane = tid_ & 63, w = tid_ >> 6;
  for (int tok = blockIdx.x * 8 + w; tok < NTOK; tok += gridDim.x * 8) {
    const float4* xr = (const float4*)(X + (size_t)tok * DM);
    float4 v[4]; float ss = 0.f;
#pragma unroll
    for (int j = 0; j < 4; ++j) { v[j] = xr[lane + 64 * j]; ss += v[j].x * v[j].x + v[j].y * v[j].y + v[j].z * v[j].z + v[j].w * v[j].w; }
    ss = wave_sum(ss);
    float rstd = frsq(ss * (1.f / DM) + NORM_EPS);
#pragma unroll
    for (int j = 0; j < 4; ++j) {
      float4 gg = ((const float4*)g)[lane + 64 * j];
      uint2 o = uint2{pk2(v[j].x * rstd * gg.x, v[j].y * rstd * gg.y), pk2(v[j].z * rstd * gg.z, v[j].w * rstd * gg.w)};
      *(uint2*)(Hout + (size_t)tok * DM + (lane + 64 * j) * 4) = o;
    }
  }
}

DI void ph_final_norm(float* __restrict__ X, const float* __restrict__ g) {
  const int tid_ = tidx(); const int lane = tid_ & 63, w = tid_ >> 6;
  for (int tok = blockIdx.x * 8 + w; tok < NTOK; tok += gridDim.x * 8) {
    float4* xr = (float4*)(X + (size_t)tok * DM);
    float4 v[4]; float ss = 0.f;
#pragma unroll
    for (int j = 0; j < 4; ++j) { v[j] = xr[lane + 64 * j]; ss += v[j].x * v[j].x + v[j].y * v[j].y + v[j].z * v[j].z + v[j].w * v[j].w; }
    ss = wave_sum(ss);
    float rstd = frsq(ss * (1.f / DM) + NORM_EPS);
#pragma unroll
    for (int j = 0; j < 4; ++j) {
      float4 gg = ((const float4*)g)[lane + 64 * j];
      xr[lane + 64 * j] = float4{v[j].x * rstd * gg.x, v[j].y * rstd * gg.y, v[j].z * rstd * gg.z, v[j].w * rstd * gg.w};
    }
  }
}

template <bool A_F32, class Epi>
DI void ph_gemm(const void* A, int lda, const float* B, int ldb, int M, int N, int K, char* smem, Epi epi) {
  const int ntn = (N + GBN - 1) / GBN, ntm = M / GBM;
  for (int t = blockIdx.x; t < ntm * ntn; t += gridDim.x) {
    int tm = t / ntn, tn = t % ntn;
    int m0 = tm * GBM, n0 = tn * GBN;
    auto arow = [&](int r) -> const void* { return (const char*)A + (size_t)(m0 + r) * lda * (A_F32 ? 4 : 2); };
    gemm_tile<A_F32, 0>(arow, B, nullptr, ldb, K, n0, N, smem, [&](int row, int col, float v, float) { epi(m0 + row, col, v); });
    __syncthreads();
  }
}

template <class Epi>
DI void ph_gemm_t(const void* A, int lda, const float* B, int ldb, int M, int N, int K, char* smem, Epi epi) {
  const int ntn = (N + GBN - 1) / GBN, ntm = M / GBM;
  for (int t = blockIdx.x; t < ntm * ntn; t += gridDim.x) {
    int tm = t / ntn, tn = t % ntn;
    int m0 = tm * GBM, n0 = tn * GBN;
    auto arow = [&](int r) -> const void* { return (const char*)A + (size_t)(m0 + r) * lda * 2; };
    gemm_tile<false, 2>(arow, B, nullptr, ldb, K, n0, N, smem,
                        [&](const f32x4 (&acc)[4][4], int wm, int wn, int lq, int l15) { epi(acc, m0, n0, wm, wn, lq, l15); });
    __syncthreads();
  }
}

DI void ph_rwshift(const P& p, int layer) {
  const float* mu = p.rw_mu + layer * RWC;
  const int total = NTOK * (RWC / 4);
  const int tid_ = tidx();
  for (int i = blockIdx.x * NTH + tid_; i < total; i += gridDim.x * NTH) {
    int tok = i / (RWC / 4), c = (i % (RWC / 4)) * 4;
    int t = tok % T;
    const float* zr = p.Z + (size_t)tok * INC + c;
    float4 z = *(const float4*)zr;
    float4 zm = (t > 0) ? *(const float4*)(zr - INC) : float4{0.f, 0.f, 0.f, 0.f};
    float4 zp = (t < T - 1) ? *(const float4*)(zr + INC) : float4{0.f, 0.f, 0.f, 0.f};
    float4 m = *(const float4*)(mu + c);
    float4 o;
    o.x = z.x + m.x * (0.5f * (zm.x + zp.x) - z.x);
    o.y = z.y + m.y * (0.5f * (zm.y + zp.y) - z.y);
    o.z = z.z + m.z * (0.5f * (zm.z + zp.z) - z.z);
    o.w = z.w + m.w * (0.5f * (zm.w + zp.w) - z.w);
    if (c < 512) *(float4*)(p.R + (size_t)tok * RWW + c) = o;
    else if (c < 1024) *(float4*)(p.K + (size_t)tok * RWW + (c - 512)) = o;
    else if (c < 1536) *(float4*)(p.V + (size_t)tok * RWW + (c - 1024)) = o;
    else if (c < 1664) {
      int d = (c - 1536) >> 6, l = (c - 1536) & 63;
      *(uint2*)(p.TWD + ((size_t)d * NTOK + tok) * 64 + l) = uint2{pk2(ftanh(o.x), ftanh(o.y)), pk2(ftanh(o.z), ftanh(o.w))};
    } else if (c < 1792) {
      int d = (c - 1664) >> 6, l = (c - 1664) & 63;
      *(uint2*)(p.AD + ((size_t)d * NTOK + tok) * 64 + l) = uint2{pk2(o.x, o.y), pk2(o.z, o.w)};
    } else {
      int l = c - 1792;
      *(uint2*)(p.SGD + (size_t)tok * 128 + l) = uint2{pk2(sigmoidf_(o.x), sigmoidf_(o.y)), pk2(sigmoidf_(o.z), sigmoidf_(o.w))};
    }
  }
}

DI void rope_cs(int pos, int i, float& cs, float& sn) {
  const int i3 = i & 3, i2 = i >> 2;
  const float c4 = (i3 == 0) ? 1.0f : (i3 == 1) ? 0.5623413251903491f : (i3 == 2) ? 0.31622776601683794f : 0.1778279410038923f;
  const float p10 = (i2 == 0) ? 1.0f : (i2 == 1) ? 0.1f : (i2 == 2) ? 0.01f : 0.001f;
  float inv = c4 * p10;
  float ang = (float)pos * inv;
  double rev = (double)ang * 0.15915494309189535;
  rev -= floor(rev);
  float rf = (float)rev;
  sn = __builtin_amdgcn_sinf(rf);
  cs = __builtin_amdgcn_cosf(rf);
}

DI void ph_rope_table(const P& p) {
  for (int i = blockIdx.x * NTH + tidx(); i < NTOK * 16; i += gridDim.x * NTH) {
    float cs, sn; rope_cs(p.pos[i >> 4], i & 15, cs, sn);
    *(f32x2*)(p.ROPE + (size_t)i * 2) = f32x2{cs, sn};
  }
}
DI void ph_mlaprep1(const P& p, int layer) {
  const int tid_ = tidx(); const int lane = tid_ & 63, w = tid_ >> 6;
  const float* qn = p.mla_q_norm + layer * 256;
  const float* kvn = p.mla_kv_norm + layer * 128;
  for (int tok = blockIdx.x * 8 + w; tok < NTOK; tok += gridDim.x * 8) {
    const float* zr = p.Z + (size_t)tok * INC + RWC;
    float4 q = *(const float4*)(zr + lane * 4);
    float ss = wave_sum(q.x * q.x + q.y * q.y + q.z * q.z + q.w * q.w);
    float rstd = frsq(ss * (1.f / 256) + NORM_EPS);
    float4 g = *(const float4*)(qn + lane * 4);
    *(uint2*)(p.QDN + (size_t)tok * 256 + lane * 4) = uint2{pk2(q.x * rstd * g.x, q.y * rstd * g.y), pk2(q.z * rstd * g.z, q.w * rstd * g.w)};
    float2 kv = *(const float2*)(zr + 256 + lane * 2);
    float ss2 = wave_sum(kv.x * kv.x + kv.y * kv.y);
    float rstd2 = frsq(ss2 * (1.f / 128) + NORM_EPS);
    float2 g2 = *(const float2*)(kvn + lane * 2);
    *(unsigned*)(p.KVDN + (size_t)tok * 128 + lane * 2) = pk2(kv.x * rstd2 * g2.x, kv.y * rstd2 * g2.y);
    if (lane < 16) {
      float u1 = zr[384 + lane], u2 = zr[384 + 16 + lane];
      const f32x2 csn = *(const f32x2*)(p.ROPE + (size_t)tok * 32 + lane * 2);
      const u16 k1 = f2bf(u1 * csn[0] - u2 * csn[1]), k2 = f2bf(u1 * csn[1] + u2 * csn[0]);
      const int bb = tok / T, tt = tok % T;
#pragma unroll
      for (int h = 0; h < NH; ++h) {
        u16* ko = p.Kc + ((size_t)(bb * NH + h) * T + tt) * 96 + 64;
        ko[lane] = k1; ko[16 + lane] = k2;
      }
    }
  }
}

DI void ph_mlafinish(const P& p) {
  const int tid_ = tidx(); const int lane = tid_ & 63, w = tid_ >> 6;
  const float qs = 0.10206207261596577f * 1.4426950408889634f;
  for (int tok = blockIdx.x * 8 + w; tok < NTOK; tok += gridDim.x * 8) {
    int b = tok / T, t = tok % T;
    float cs = 0.f, sn = 0.f;
    if (lane < 16) rope_cs(p.pos[tok], lane, cs, sn);
    const float* qr = p.QRAW + (size_t)tok * 768;
    const float* kvr = p.KVRAW + (size_t)tok * 1024;
    const float* kr = p.KR + (size_t)tok * 32;
#pragma unroll
    for (int h = 0; h < NH; ++h) {
      size_t row = ((size_t)(b * NH + h) * T + t);
      u16* qo = p.Q + row * 96; u16* ko = p.Kc + row * 96; u16* vo = p.Vv + row * 64;
      qo[lane] = f2bf(qr[h * 96 + lane] * qs);
      ko[lane] = f2bf(kvr[h * 128 + lane]);
      vo[lane] = f2bf(kvr[h * 128 + 64 + lane]);
      if (lane < 16) {
        float u1 = qr[h * 96 + 64 + lane], u2 = qr[h * 96 + 80 + lane];
        qo[64 + lane] = f2bf((u1 * cs - u2 * sn) * qs);
        qo[80 + lane] = f2bf((u1 * sn + u2 * cs) * qs);
      }
      if (lane < 32) ko[64 + lane] = f2bf(kr[lane]);
    }
  }
}

using f32x16 = __attribute__((ext_vector_type(16))) float;
#define SBAR() __builtin_amdgcn_sched_barrier(0)
constexpr int AT_KSTR = 104;
constexpr int AT_KBYTES = 64 * AT_KSTR * 2;
constexpr int AT_VBYTES = 64 * 64 * 2;
constexpr float AT_THR = 8.f;
DI int crow(int r, int hi) { return (r & 3) + 8 * (r >> 2) + 4 * hi; }
DI int v_st(int k, int c) { const int kk = (k & ~0xC) | ((k & 4) << 1) | ((k & 8) >> 1); return ((kk >> 3) * 2 + (c >> 5)) * 512 + ((kk & 7) * 32 + (c & 31)) * 2; }
DI int v_rd_base(int lane) { return ((lane & 3) << 3) | (((lane >> 2) & 3) << 6) | (((lane >> 4) & 1) << 5) | (((lane >> 5) & 1) << 8); }
constexpr int v_rd_off(int d0, int ks, int half) { return d0 * 512 + ks * 2048 + half * 1024; }

DI void at_partialSM(f32x16& p0, f32x16& p1, float& m_reg, float& mn, float& alpha) {
  float pmax = p0[0];
#pragma unroll
  for (int r = 1; r < 16; ++r) pmax = fmaxf(pmax, p0[r]);
#pragma unroll
  for (int r = 0; r < 16; ++r) pmax = fmaxf(pmax, p1[r]);
  { auto rr = __builtin_amdgcn_permlane32_swap(__float_as_uint(pmax), __float_as_uint(pmax), false, false);
    pmax = fmaxf(__uint_as_float(rr[0]), __uint_as_float(rr[1])); }
  if (__builtin_expect(__all(pmax - m_reg <= AT_THR), 1)) { mn = m_reg; alpha = 1.f; }
  else { mn = fmaxf(m_reg, pmax); alpha = __builtin_amdgcn_exp2f(m_reg - mn); m_reg = mn; }
#pragma unroll
  for (int r = 0; r < 16; ++r) { p0[r] = p0[r] - mn; p1[r] = p1[r] - mn; }
#pragma unroll
  for (int r = 0; r < 16; ++r) p0[r] = __builtin_amdgcn_exp2f(p0[r]);
}
DI void at_finishSM(f32x16& p0, f32x16& p1, float alpha, float& l_reg, bf16x8& pa0, bf16x8& pa1, bf16x8& pa2, bf16x8& pa3) {
#pragma unroll
  for (int r = 0; r < 16; ++r) p1[r] = __builtin_amdgcn_exp2f(p1[r]);
  float ps = 0;
#pragma unroll
  for (int r = 0; r < 16; ++r) ps += p0[r];
#pragma unroll
  for (int r = 0; r < 16; ++r) ps += p1[r];
  { auto rr = __builtin_amdgcn_permlane32_swap(__float_as_uint(ps), __float_as_uint(ps), false, false);
    ps = __uint_as_float(rr[0]) + __uint_as_float(rr[1]); }
  l_reg = l_reg * alpha + ps;
#define PK4(PP, BASE, OUT) do { unsigned a0 = pk2(PP[BASE + 0], PP[BASE + 1]), a1 = pk2(PP[BASE + 2], PP[BASE + 3]);   \
    unsigned b0 = pk2(PP[BASE + 4], PP[BASE + 5]), b1 = pk2(PP[BASE + 6], PP[BASE + 7]);                              \
    auto r0 = __builtin_amdgcn_permlane32_swap(a0, b0, false, false); auto r1 = __builtin_amdgcn_permlane32_swap(a1, b1, false, false); \
    u32x4 wv = {r0[0], r1[0], r0[1], r1[1]}; OUT = __builtin_bit_cast(bf16x8, wv); } while (0)
  PK4(p0, 0, pa0); PK4(p0, 8, pa1); PK4(p1, 0, pa2); PK4(p1, 8, pa3);
#undef PK4
}
DI void at_qkt(f32x16& p0, f32x16& p1, const char* Kb, const bf16x8* qr, int r32, int hi) {
#pragma unroll
  for (int r = 0; r < 16; ++r) { p0[r] = 0.f; p1[r] = 0.f; }
#pragma unroll
  for (int d0 = 0; d0 < 6; ++d0) {
    bf16x8 b0 = *(const bf16x8*)(Kb + (r32 * AT_KSTR + d0 * 16 + hi * 8) * 2);
    bf16x8 b1 = *(const bf16x8*)(Kb + ((32 + r32) * AT_KSTR + d0 * 16 + hi * 8) * 2);
    __builtin_amdgcn_s_setprio(1);
    p0 = __builtin_amdgcn_mfma_f32_32x32x16_bf16(b0, qr[d0], p0, 0, 0, 0);
    p1 = __builtin_amdgcn_mfma_f32_32x32x16_bf16(b1, qr[d0], p1, 0, 0, 0);
    __builtin_amdgcn_s_setprio(0);
  }
}
template <int D0> DI void at_pv_one(f32x16& od, const char* vb, bf16x8 pa0, bf16x8 pa1, bf16x8 pa2, bf16x8 pa3) {
#define TRR(ks, half) tr_read((const short*)(vb + v_rd_off(D0, ks, half)))
  const s16x4 l0 = TRR(0, 0), h0 = TRR(0, 1), l1 = TRR(1, 0), h1 = TRR(1, 1), l2 = TRR(2, 0), h2 = TRR(2, 1), l3 = TRR(3, 0), h3 = TRR(3, 1);
#undef TRR
#define PKV(L, H) __builtin_shufflevector(L, H, 0, 1, 2, 3, 4, 5, 6, 7)
  __builtin_amdgcn_s_setprio(1);
  od = __builtin_amdgcn_mfma_f32_32x32x16_bf16(pa0, PKV(l0, h0), od, 0, 0, 0);
  od = __builtin_amdgcn_mfma_f32_32x32x16_bf16(pa1, PKV(l1, h1), od, 0, 0, 0);
  od = __builtin_amdgcn_mfma_f32_32x32x16_bf16(pa2, PKV(l2, h2), od, 0, 0, 0);
  od = __builtin_amdgcn_mfma_f32_32x32x16_bf16(pa3, PKV(l3, h3), od, 0, 0, 0);
  __builtin_amdgcn_s_setprio(0);
#undef PKV
}
DI void at_pv(f32x16* o, const char* vb, bf16x8 pa0, bf16x8 pa1, bf16x8 pa2, bf16x8 pa3) {
  at_pv_one<0>(o[0], vb, pa0, pa1, pa2, pa3); at_pv_one<1>(o[1], vb, pa0, pa1, pa2, pa3);
}

DI void attn_body(const u16* __restrict__ Qb, const u16* __restrict__ Kh, const u16* __restrict__ Vh, float* __restrict__ Ob, char* lds, int tid) {
  const int wid = tid >> 6, lane = tid & 63, r32 = lane & 31, hi = lane >> 5;
  char* V_lds = lds; char* K_lds = lds + 2 * AT_VBYTES;
  float* wsp = (float*)(lds + 2 * AT_VBYTES + 2 * AT_KBYTES) + wid * 64; float* li_l = wsp; float* al_l = wsp + 32;
  float m_reg = -1e30f, l_reg = 0.f; f32x16 o[2]; bf16x8 qr[6];
#pragma unroll
  for (int r = 0; r < 16; ++r) { o[0][r] = 0.f; o[1][r] = 0.f; }
  const u16* Qw = Qb + (size_t)(wid * 32 + r32) * 96 + hi * 8;
#pragma unroll
  for (int d0 = 0; d0 < 6; ++d0) qr[d0] = *(const bf16x8*)(Qw + d0 * 16);
  const int kid1 = (tid < 256) ? tid + 512 : tid;
  const int kst0 = ((tid / 12) * AT_KSTR + (tid % 12) * 8) * 2, kst1 = ((kid1 / 12) * AT_KSTR + (kid1 % 12) * 8) * 2;
  const int vst = v_st(tid >> 3, (tid & 7) * 8);
  const char* vb0 = V_lds + v_rd_base(lane);
  u32x4 sk0[2], sk1[2], sv0[2];
#define SLOAD(i, k0) do { sk0[i] = *(const u32x4*)(Kh + (size_t)(k0) * 96 + tid * 8); sk1[i] = *(const u32x4*)(Kh + (size_t)(k0) * 96 + kid1 * 8); \
    sv0[i] = *(const u32x4*)(Vh + (size_t)(k0) * 64 + tid * 8); } while (0)
#define SWRITE(b, i) do { *(u32x4*)(K_lds + (b) * AT_KBYTES + kst0) = sk0[i]; if (tid < 256) *(u32x4*)(K_lds + (b) * AT_KBYTES + kst1) = sk1[i]; \
    *(u32x4*)(V_lds + (b) * AT_VBYTES + vst) = sv0[i]; } while (0)
#define SWAIT() asm volatile("s_waitcnt vmcnt(3)" ::: "memory")
#define RESC(a) do { if (__any((a) < 1.f)) { if (hi == 0) al_l[r32] = (a); asm volatile("s_waitcnt lgkmcnt(0)" ::: "memory"); \
    _Pragma("unroll") for (int r = 0; r < 16; ++r) { float al = al_l[crow(r, hi)]; o[0][r] *= al; o[1][r] *= al; } } } while (0)
  f32x16 pA0, pA1, pB0, pB1; float mnA, mnB, alA, alB; bf16x8 pa0, pa1, pa2, pa3; constexpr int NT = T / 64;
  SLOAD(0, 0); SWRITE(0, 0); __syncthreads();
  at_qkt(pA0, pA1, K_lds, qr, r32, hi); at_partialSM(pA0, pA1, m_reg, mnA, alA);
  SLOAD(1, 64); SLOAD(0, 128);
  SWAIT(); SWRITE(1, 1); __syncthreads();
  for (int j = 1; j + 1 < NT; j += 2) {
    SBAR(); at_qkt(pB0, pB1, K_lds + AT_KBYTES, qr, r32, hi);
    at_finishSM(pA0, pA1, alA, l_reg, pa0, pa1, pa2, pa3); SBAR();
    SLOAD(1, (j + 2) * 64); SBAR();
    at_pv(o, vb0, pa0, pa1, pa2, pa3); at_partialSM(pB0, pB1, m_reg, mnB, alB);
    __syncthreads(); SWAIT(); SWRITE(0, 0);
    RESC(alB); __syncthreads();
    SBAR(); at_qkt(pA0, pA1, K_lds, qr, r32, hi);
    at_finishSM(pB0, pB1, alB, l_reg, pa0, pa1, pa2, pa3); SBAR();
    if (j + 3 < NT) SLOAD(0, (j + 3) * 64); SBAR();
    at_pv(o, vb0 + AT_VBYTES, pa0, pa1, pa2, pa3); at_partialSM(pA0, pA1, m_reg, mnA, alA);
    __syncthreads(); SWAIT(); SWRITE(1, 1);
    RESC(alA); __syncthreads();
  }
  SBAR(); at_qkt(pB0, pB1, K_lds + AT_KBYTES, qr, r32, hi);
  at_finishSM(pA0, pA1, alA, l_reg, pa0, pa1, pa2, pa3); SBAR();
  at_pv(o, vb0, pa0, pa1, pa2, pa3); at_partialSM(pB0, pB1, m_reg, mnB, alB);
  __syncthreads(); RESC(alB);
  at_finishSM(pB0, pB1, alB, l_reg, pa0, pa1, pa2, pa3); SBAR();
  at_pv(o, vb0 + AT_VBYTES, pa0, pa1, pa2, pa3);
  if (hi == 0) li_l[r32] = l_reg;
  asm volatile("s_waitcnt lgkmcnt(0)" ::: "memory");
  float* Ow = Ob + (size_t)(wid * 32) * 512;
#pragma unroll
  for (int r = 0; r < 16; ++r) {
    int orow = crow(r, hi); float rl = __builtin_amdgcn_rcpf(li_l[orow]);
    Ow[(size_t)orow * 512 + r32] = o[0][r] * rl; Ow[(size_t)orow * 512 + 32 + r32] = o[1][r] * rl;
  }
#undef SLOAD
#undef SWRITE
#undef SWAIT
#undef RESC
}

DI void ph_attn(const P& p, char* smem, unsigned* ctr) {
  const int tid = tidx();
  int* sitem = (int*)(smem + SMEM_BYTES - 16);
  for (;;) {
    __syncthreads();
    if (tid == 0) *sitem = (int)atomicAdd(ctr, 1u);
    __syncthreads();
    const int item = *sitem;
    if (item >= NB * NH * (T / 256)) break;
    const int bh = item / (T / 256), qb = item % (T / 256);
    const int b = bh / NH, h = bh % NH;
    attn_body(p.Q + ((size_t)bh * T + qb * 256) * 96, p.Kc + (size_t)bh * T * 96, p.Vv + (size_t)bh * T * 64,
              p.AO + ((size_t)(b * T + qb * 256)) * 512 + h * 64, smem, tid);
  }
}

constexpr int SC = 256, NCH = T / SC;
constexpr int SBUF = 5184;
template <int NI> struct ScanRegsN { float k[2 * NI], r[2 * NI], v[2 * NI]; u16 lw[2 * NI], a[2 * NI]; };
template <int NI>
DI void scan_load_n(const P& p, int b, int h, int d, int n0, int lane, int ws, ScanRegsN<NI>& g) {
  constexpr int WPI = 8 / NI;
  const u16* LWd = p.LW + (size_t)d * NTOK * RWW;
  const u16* AAd = p.AA + (size_t)d * NTOK * RWW;
  const int ch = h * 64 + lane;
#pragma unroll
  for (int jj = 0; jj < 2 * NI; ++jj) {
    int n = n0 + ws + WPI * jj; int t = d ? (T - 1 - n) : n;
    size_t off = ((size_t)(b * T + t)) * RWW + ch;
    g.k[jj] = p.K[off]; g.r[jj] = p.R[off]; g.v[jj] = p.V[off]; g.lw[jj] = LWd[off]; g.a[jj] = AAd[off];
  }
}
template <int NI>
DI void scan_put_n(const ScanRegsN<NI>& g, float kkc, float kac, float* sm, float* slw, int lane, int ws) {
  constexpr int WPI = 8 / NI;
#pragma unroll
  for (int jj = 0; jj < 2 * NI; ++jj) slw[(ws + WPI * jj) * 64 + lane] = bf2f(g.lw[jj]);
  __syncthreads();
  float Lj[2 * NI];
#pragma unroll
  for (int jj = 0; jj < 2 * NI; ++jj) Lj[jj] = 0.f;
#pragma unroll
  for (int i = 0; i < 16; ++i) {
    const float x = slw[i * 64 + lane];
#pragma unroll
    for (int jj = 0; jj < 2 * NI; ++jj) Lj[jj] += (i <= ws + WPI * jj) ? x : 0.f;
  }
#pragma unroll
  for (int jj = 0; jj < 2 * NI; ++jj) {
    const int j = ws + WPI * jj;
    const float L = Lj[jj], lwj = bf2f(g.lw[jj]);
    const float Pt = fexp(L), Pm = fexp(L - lwj), iP = fexp(-L);
    const float kv = g.k[jj];
    const float kx = kv * kkc;
    const float nrm = __builtin_amdgcn_sqrtf(wave_sum(kx * kx));
    const float kkv = kx * frcp(fmaxf(nrm, 1e-12f));
    const float a = bf2f(g.a[jj]);
    sm[j * 64 + lane] = -kkv * Pm;
    sm[1024 + j * 64 + lane] = a * kkv * iP;
    sm[2048 + j * 64 + lane] = kv * (1.f + (a - 1.f) * kac) * iP;
    sm[3072 + j * 64 + lane] = g.r[jj] * Pt;
    sm[4096 + j * 64 + lane] = g.v[jj];
    if (j == 15) sm[5120 + lane] = Pt;
  }
}
using f32x16s = __attribute__((ext_vector_type(16))) float;
DI void scan_ld8(f32x4 (&kv)[8], const float* vec, int hi) {
#pragma unroll
  for (int tk = 0; tk < 2; ++tk)
#pragma unroll
    for (int q = 0; q < 4; ++q) kv[tk * 4 + q] = *(const f32x4*)(vec + 32 * tk + 8 * q + 4 * hi);
}
DI float scan_dot8(const f32x16s (&acc)[2], const f32x4 (&kv)[8]) {
  float pq[4] = {0.f, 0.f, 0.f, 0.f};
#pragma unroll
  for (int tk = 0; tk < 2; ++tk)
#pragma unroll
    for (int e = 0; e < 4; ++e)
#pragma unroll
      for (int q = 0; q < 4; ++q) { pq[q] = __builtin_fmaf(acc[tk][4 * q + e], kv[tk * 4 + q][e], pq[q]); asm("" : "+v"(pq[q])); }
  return red_x32((pq[0] + pq[1]) + (pq[2] + pq[3]));
}

DI void ph_scan1(const P& p, int layer, char* smem) {
  constexpr int NI = 2;
  const int tid = tidx(), lane = tid & 63, w = tid >> 6;
  const int jl = lane & 31, hi = lane >> 5;
  const int it = w >> 2, vt = w & 3, ws = w & 3;
  float* smi = (float*)smem + it * (2 * SBUF + 1024);
  float* slw = smi + 2 * SBUF;
  for (int pair = blockIdx.x; pair < 32 * NCH / 2; pair += gridDim.x) {
    const int item = pair * 2 + it; const int scan = item / NCH, c = item % NCH;
    const int d = scan & 1, h = (scan >> 1) % NH, b = scan / (2 * NH);
    const float kkc = p.rw_k_k[layer * RWW + h * 64 + lane], kac = p.rw_k_a[layer * RWW + h * 64 + lane];
    f32x16s acc[2];
#pragma unroll
    for (int tk = 0; tk < 2; ++tk)
#pragma unroll
      for (int r = 0; r < 16; ++r) acc[tk][r] = (32 * tk + (r & 3) + 8 * (r >> 2) + 4 * hi == 32 * vt + jl) ? 1.f : 0.f;
    ScanRegsN<NI> g;
    scan_load_n<NI>(p, b, h, d, c * SC, lane, ws, g);
    __syncthreads();
    scan_put_n<NI>(g, kkc, kac, smi, slw, lane, ws);
    __syncthreads();
    for (int sub = 0; sub < SC / 16; ++sub) {
      const float* sm = smi + (sub & 1) * SBUF;
      if (sub + 1 < SC / 16) scan_load_n<NI>(p, b, h, d, c * SC + (sub + 1) * 16, lane, ws, g);
      const float* vrow = sm + 4096 + ((vt >= 2) ? 32 * (vt - 2) : 0) + jl;
      f32x4 kc[8]; scan_ld8(kc, sm, hi);
      float a0 = sm[1024 + hi * 1024 + jl], a1 = sm[1024 + hi * 1024 + 32 + jl], vc = vrow[0];
#pragma unroll 4
      for (int j = 0; j < 16; ++j) {
        const int jn = (j + 1) & 15;
        f32x4 kn[8]; scan_ld8(kn, sm + jn * 64, hi);
        const float an0 = sm[1024 + hi * 1024 + jn * 64 + jl], an1 = sm[1024 + hi * 1024 + jn * 64 + 32 + jl], vn = vrow[jn * 64];
        SBAR();
        const float sa = scan_dot8(acc, kc);
        const float bop = hi ? ((vt >= 2) ? vc : 0.f) : sa;
        acc[0] = __builtin_amdgcn_mfma_f32_32x32x2f32(a0, bop, acc[0], 0, 0, 0);
        acc[1] = __builtin_amdgcn_mfma_f32_32x32x2f32(a1, bop, acc[1], 0, 0, 0);
        SBAR();
#pragma unroll
        for (int i = 0; i < 8; ++i) kc[i] = kn[i];
        a0 = an0; a1 = an1; vc = vn;
      }
#pragma unroll
      for (int tk = 0; tk < 2; ++tk)
#pragma unroll
        for (int q = 0; q < 4; ++q) {
          const f32x4 pv = *(const f32x4*)(sm + 5120 + 32 * tk + 8 * q + 4 * hi);
#pragma unroll
          for (int e = 0; e < 4; ++e) acc[tk][4 * q + e] *= pv[e];
        }
      if (sub + 1 < SC / 16) scan_put_n<NI>(g, kkc, kac, smi + ((sub + 1) & 1) * SBUF, slw, lane, ws);
      __syncthreads();
    }
    {
      const int v = 32 * vt + jl;
      float* dst = ((v < 64) ? p.MC : p.NC) + (((size_t)scan * NCH + c) * 64 + (v & 63)) * 64;
#pragma unroll
      for (int tk = 0; tk < 2; ++tk)
#pragma unroll
        for (int q = 0; q < 4; ++q)
          *(f32x4*)(dst + 32 * tk + 8 * q + 4 * hi) = f32x4{acc[tk][4 * q], acc[tk][4 * q + 1], acc[tk][4 * q + 2], acc[tk][4 * q + 3]};
    }
  }
}


DI void ph_scan2(const P& p, char* smem) {
  constexpr int LS = 72;
  u16* Sh = (u16*)smem; u16* Sl = Sh + 64 * LS; u16* Mh = Sl + 64 * LS; u16* Ml = Mh + 64 * LS;
  const int tid = tidx(), lane = tid & 63, w = tid >> 6;
  const int l15 = lane & 15, lq = lane >> 4;
  const int ti = w >> 1, tj0 = (w & 1) * 2;
  for (int scan = blockIdx.x; scan < 32; scan += gridDim.x) {
    const float* Mg = p.MC + (size_t)scan * NCH * 4096;
    const float* Ng = p.NC + (size_t)scan * NCH * 4096;
    float* Sg = p.SS + (size_t)scan * NCH * 4096;
    struct MN { f32x4 m0, m1, n[2]; };
    auto ldmn = [&](MN& r, int c) {
      const int cc = (c < NCH) ? c : (NCH - 1);
      r.m0 = *(const f32x4*)(Mg + (size_t)cc * 4096 + tid * 8); r.m1 = *(const f32x4*)(Mg + (size_t)cc * 4096 + tid * 8 + 4);
#pragma unroll
      for (int q = 0; q < 2; ++q)
#pragma unroll
        for (int r4 = 0; r4 < 4; ++r4) r.n[q][r4] = Ng[(size_t)cc * 4096 + (ti * 16 + lq * 4 + r4) * 64 + (tj0 + q) * 16 + l15];
    };
    f32x4 sacc[2];
    sacc[0] = f32x4{0.f, 0.f, 0.f, 0.f}; sacc[1] = sacc[0];
    auto step = [&](int c, const MN& r) {
      __syncthreads();
#pragma unroll
      for (int q = 0; q < 2; ++q)
#pragma unroll
        for (int r4 = 0; r4 < 4; ++r4) {
          const int row = ti * 16 + lq * 4 + r4, col = (tj0 + q) * 16 + l15;
          const float x = sacc[q][r4];
          Sg[(size_t)c * 4096 + row * 64 + col] = x;
          const u16 h = f2bf(x); Sh[row * LS + col] = h; Sl[row * LS + col] = f2bf(x - bf2f(h));
        }
      {
        const int mr = tid >> 3, mc = (tid & 7) * 8;
        float xh[8], xl[8];
#pragma unroll
        for (int i = 0; i < 8; ++i) { const float x = (i < 4) ? r.m0[i & 3] : r.m1[i & 3]; const float h = bf2f(f2bf(x)); xh[i] = h; xl[i] = x - h; }
        *(u32x4*)(Mh + mr * LS + mc) = u32x4{pk2(xh[0], xh[1]), pk2(xh[2], xh[3]), pk2(xh[4], xh[5]), pk2(xh[6], xh[7])};
        *(u32x4*)(Ml + mr * LS + mc) = u32x4{pk2(xl[0], xl[1]), pk2(xl[2], xl[3]), pk2(xl[4], xl[5]), pk2(xl[6], xl[7])};
      }
      f32x4 acc[2] = {r.n[0], r.n[1]};
      __syncthreads();
#pragma unroll
      for (int ks = 0; ks < 2; ++ks) {
        const bf16x8 ah = *(const bf16x8*)(Sh + (ti * 16 + l15) * LS + ks * 32 + 8 * lq);
        const bf16x8 al = *(const bf16x8*)(Sl + (ti * 16 + l15) * LS + ks * 32 + 8 * lq);
#pragma unroll
        for (int q = 0; q < 2; ++q) {
          const int kb = ks * 32 + 8 * lq, tq = l15 >> 2, tp = l15 & 3, co = (tj0 + q) * 16 + 4 * tp;
          const bf16x8 bh = __builtin_shufflevector(tr_read((const short*)Mh + (kb + tq) * LS + co), tr_read((const short*)Mh + (kb + 4 + tq) * LS + co), 0, 1, 2, 3, 4, 5, 6, 7);
          const bf16x8 bl = __builtin_shufflevector(tr_read((const short*)Ml + (kb + tq) * LS + co), tr_read((const short*)Ml + (kb + 4 + tq) * LS + co), 0, 1, 2, 3, 4, 5, 6, 7);
          acc[q] = __builtin_amdgcn_mfma_f32_16x16x32_bf16(ah, bh, acc[q], 0, 0, 0);
          acc[q] = __builtin_amdgcn_mfma_f32_16x16x32_bf16(ah, bl, acc[q], 0, 0, 0);
          acc[q] = __builtin_amdgcn_mfma_f32_16x16x32_bf16(al, bh, acc[q], 0, 0, 0);
        }
      }
      sacc[0] = acc[0]; sacc[1] = acc[1];
    };
    MN r0, r1, r2, r3;
    ldmn(r0, 0); ldmn(r1, 1); ldmn(r2, 2);
    for (int c = 0; c < NCH; c += 4) {
      ldmn(r3, c + 3); step(c, r0);
      ldmn(r0, c + 4); step(c + 1, r1);
      ldmn(r1, c + 5); step(c + 2, r2);
      ldmn(r2, c + 6); step(c + 3, r3);
    }
    __syncthreads();
  }
}

DI void ph_scan3(const P& p, int layer, char* smem) {
  constexpr int NI = 4;
  const int tid = tidx(), lane = tid & 63, w = tid >> 6;
  const int jl = lane & 31, hi = lane >> 5;
  const int it = w >> 1, vt = w & 1, ws = w & 1;
  float* sm = (float*)smem + it * (SBUF + 2048);
  float* slw = sm + SBUF; float* so = slw + 1024;
  const float* lwp = p.rw_lnx_w + layer * RWW; const float* lbp = p.rw_lnx_b + layer * RWW; const float* rkp = p.rw_r_k + layer * RWW;
  constexpr int TQ = 2 * SC;
  for (int quad = blockIdx.x; quad < NB * NH * (T / TQ); quad += gridDim.x) {
    const int bh = quad / (T / TQ), tb = quad % (T / TQ);
    const int d = it >> 1, kch = 2 * tb + (it & 1), c = d ? (NCH - 1 - kch) : kch;
    const int h = bh % NH, b = bh / NH, scan = bh * 2 + d;
    const float kkc = p.rw_k_k[layer * RWW + h * 64 + lane], kac = p.rw_k_a[layer * RWW + h * 64 + lane];
    u16* Od = p.O2 + (size_t)d * NTOK * RWW;
    f32x16s acc[2];
    {
      const float* Sg = p.SS + ((size_t)scan * NCH + c) * 4096 + (size_t)(32 * vt + jl) * 64;
#pragma unroll
      for (int tk = 0; tk < 2; ++tk)
#pragma unroll
        for (int q = 0; q < 4; ++q) {
          const f32x4 sv = *(const f32x4*)(Sg + 32 * tk + 8 * q + 4 * hi);
#pragma unroll
          for (int e = 0; e < 4; ++e) acc[tk][4 * q + e] = sv[e];
        }
    }
    ScanRegsN<NI> g;
    scan_load_n<NI>(p, b, h, d, c * SC, lane, ws, g);
    for (int sub = 0; sub < SC / 16; ++sub) {
      const int n0 = c * SC + sub * 16;
      __syncthreads();
      scan_put_n<NI>(g, kkc, kac, sm, slw, lane, ws);
      __syncthreads();
      if (sub + 1 < SC / 16) scan_load_n<NI>(p, b, h, d, n0 + 16, lane, ws, g);
      const float* vrow = sm + 4096 + 32 * vt + jl;
      f32x4 kc[8]; scan_ld8(kc, sm, hi);
      float a0 = sm[1024 + hi * 1024 + jl], a1 = sm[1024 + hi * 1024 + 32 + jl], vc = vrow[0];
#pragma unroll 4
      for (int j = 0; j < 16; ++j) {
        const int jn = (j + 1) & 15;
        f32x4 kn[8]; scan_ld8(kn, sm + jn * 64, hi);
        const float an0 = sm[1024 + hi * 1024 + jn * 64 + jl], an1 = sm[1024 + hi * 1024 + jn * 64 + 32 + jl], vn = vrow[jn * 64];
        SBAR();
        const float sa = scan_dot8(acc, kc);
        const float bop = hi ? vc : sa;
        acc[0] = __builtin_amdgcn_mfma_f32_32x32x2f32(a0, bop, acc[0], 0, 0, 0);
        acc[1] = __builtin_amdgcn_mfma_f32_32x32x2f32(a1, bop, acc[1], 0, 0, 0);
        f32x4 rc[8]; scan_ld8(rc, sm + 3072 + j * 64, hi);
        SBAR();
        const float o = scan_dot8(acc, rc);
        if (hi == 0) so[j * 64 + 32 * vt + jl] = o;
        SBAR();
#pragma unroll
        for (int i = 0; i < 8; ++i) kc[i] = kn[i];
        a0 = an0; a1 = an1; vc = vn;
      }
#pragma unroll
      for (int tk = 0; tk < 2; ++tk)
#pragma unroll
        for (int q = 0; q < 4; ++q) {
          const f32x4 pv = *(const f32x4*)(sm + 5120 + 32 * tk + 8 * q + 4 * hi);
#pragma unroll
          for (int e = 0; e < 4; ++e) acc[tk][4 * q + e] *= pv[e];
        }
      __syncthreads();
#pragma unroll
      for (int jj = 0; jj < 8; ++jj) {
        const int j = ws + 2 * jj; const int n = n0 + j; const int t = d ? (T - 1 - n) : n;
        Od[((size_t)(b * T + t)) * RWW + h * 64 + lane] = f2bf(so[j * 64 + lane]);
      }
    }
    asm volatile("s_waitcnt vmcnt(0)" ::: "memory");
    __syncthreads();
    {
      const int ch = h * 64 + lane;
      const float plw = lwp[ch], plb = lbp[ch], prk = rkp[ch];
      for (int i0 = 0; i0 < TQ / 8; i0 += 2) {
        float o[2], k[2], r[2], vv[2], a0[2], a1[2], gg[2];
#pragma unroll
        for (int u = 0; u < 2; ++u) {
          const size_t off = (size_t)(b * T + tb * TQ + w * (TQ / 8) + i0 + u) * RWW + ch;
          o[u] = bf2f(p.O2[off]) + bf2f(p.O2[(size_t)NTOK * RWW + off]);
          k[u] = p.K[off]; r[u] = p.R[off]; vv[u] = p.V[off];
          a0[u] = bf2f(p.AA[off]); a1[u] = bf2f(p.AA[(size_t)NTOK * RWW + off]); gg[u] = bf2f(p.G[off]);
        }
#pragma unroll
        for (int u = 0; u < 2; ++u) {
          const float mean = wave_sum(o[u]) * (1.f / 64);
          const float dv = o[u] - mean;
          const float var = wave_sum(dv * dv) * (1.f / 64);
          const float kb = 0.5f * (k[u] * (1.f + (a0[u] - 1.f) * kac) + k[u] * (1.f + (a1[u] - 1.f) * kac));
          const float sb = wave_sum(r[u] * kb * prk);
          const float on_ = dv * frsq(var + GN_EPS) * plw + plb;
          p.H[(size_t)(b * T + tb * TQ + w * (TQ / 8) + i0 + u) * DM + ch] = f2bf((on_ + sb * vv[u]) * gg[u]);
        }
      }
    }
  }
}
DI void ph_mla_norm(const P& p, int layer) {
  const int tid_ = tidx(); const int lane = tid_ & 63, w = tid_ >> 6;
  const float* on = p.mla_o_norm + layer * 512;
  const f32x4 g0 = *(const f32x4*)(on + lane * 4), g1 = *(const f32x4*)(on + 256 + lane * 4);
  for (int tok = blockIdx.x * 8 + w; tok < NTOK; tok += gridDim.x * 8) {
    const float* ao = p.AO + (size_t)tok * 512;
    const f32x4 v0 = *(const f32x4*)(ao + lane * 4), v1 = *(const f32x4*)(ao + 256 + lane * 4);
    float ss = v0[0] * v0[0] + v0[1] * v0[1] + v0[2] * v0[2] + v0[3] * v0[3] + v1[0] * v1[0] + v1[1] * v1[1] + v1[2] * v1[2] + v1[3] * v1[3];
    ss = wave_sum(ss);
    const float rstd = frsq(ss * (1.f / 512) + NORM_EPS);
    *(u32x2*)(p.H + (size_t)tok * DM + 512 + lane * 4) = u32x2{pk2(v0[0] * rstd * g0[0], v0[1] * rstd * g0[1]), pk2(v0[2] * rstd * g0[2], v0[3] * rstd * g0[3])};
    *(u32x2*)(p.H + (size_t)tok * DM + 768 + lane * 4) = u32x2{pk2(v1[0] * rstd * g1[0], v1[1] * rstd * g1[1]), pk2(v1[2] * rstd * g1[2], v1[3] * rstd * g1[3])};
  }
}


DI void ph_mixfinish(const P& p, int layer) {
  const int tid_ = tidx(); const int lane = tid_ & 63, w = tid_ >> 6;
  const float* lw = p.rw_lnx_w + layer * RWW; const float* lb = p.rw_lnx_b + layer * RWW;
  const float* kac = p.rw_k_a + layer * RWW; const float* rk = p.rw_r_k + layer * RWW;
  const float* on = p.mla_o_norm + layer * 512;
  float plw[8], plb[8], pka[8], prk[8];
#pragma unroll
  for (int h = 0; h < NH; ++h) { int c = h * 64 + lane; plw[h] = lw[c]; plb[h] = lb[c]; pka[h] = kac[c]; prk[h] = rk[c]; }
  const f32x4 g0 = *(const f32x4*)(on + lane * 4), g1 = *(const f32x4*)(on + 256 + lane * 4);
  for (int tok = blockIdx.x * 8 + w; tok < NTOK; tok += gridDim.x * 8) {
    float o[8], k[8], r[8], vv[8], a0[8], a1[8], gg[8];
#pragma unroll
    for (int h = 0; h < NH; ++h) {
      size_t off = (size_t)tok * RWW + h * 64 + lane;
      o[h] = bf2f(p.O2[off]) + bf2f(p.O2[(size_t)NTOK * RWW + off]);
      k[h] = p.K[off]; r[h] = p.R[off]; vv[h] = p.V[off];
      a0[h] = bf2f(p.AA[off]); a1[h] = bf2f(p.AA[(size_t)NTOK * RWW + off]); gg[h] = bf2f(p.G[off]);
    }
    const float* ao = p.AO + (size_t)tok * 512;
    const f32x4 v0 = *(const f32x4*)(ao + lane * 4), v1 = *(const f32x4*)(ao + 256 + lane * 4);
    float mean[8], var[8], sb[8];
#pragma unroll
    for (int h = 0; h < NH; ++h) mean[h] = wave_sum(o[h]) * (1.f / 64);
#pragma unroll
    for (int h = 0; h < NH; ++h) { float dv = o[h] - mean[h]; o[h] = dv; var[h] = wave_sum(dv * dv) * (1.f / 64); }
#pragma unroll
    for (int h = 0; h < NH; ++h) {
      float kb = 0.5f * (k[h] * (1.f + (a0[h] - 1.f) * pka[h]) + k[h] * (1.f + (a1[h] - 1.f) * pka[h]));
      sb[h] = wave_sum(r[h] * kb * prk[h]);
    }
#pragma unroll
    for (int h = 0; h < NH; ++h) {
      float on_ = o[h] * frsq(var[h] + GN_EPS) * plw[h] + plb[h];
      float y = (on_ + sb[h] * vv[h]) * gg[h];
      p.H[(size_t)tok * DM + h * 64 + lane] = f2bf(y);
    }
    float ss = v0[0] * v0[0] + v0[1] * v0[1] + v0[2] * v0[2] + v0[3] * v0[3] + v1[0] * v1[0] + v1[1] * v1[1] + v1[2] * v1[2] + v1[3] * v1[3];
    ss = wave_sum(ss);
    float rstd = frsq(ss * (1.f / 512) + NORM_EPS);
    *(u32x2*)(p.H + (size_t)tok * DM + 512 + lane * 4) = u32x2{pk2(v0[0] * rstd * g0[0], v0[1] * rstd * g0[1]), pk2(v0[2] * rstd * g0[2], v0[3] * rstd * g0[3])};
    *(u32x2*)(p.H + (size_t)tok * DM + 768 + lane * 4) = u32x2{pk2(v1[0] * rstd * g1[0], v1[1] * rstd * g1[1]), pk2(v1[2] * rstd * g1[2], v1[3] * rstd * g1[3])};
  }
}

DI void ph_norm_router(const P& p, int layer, char* smem) {
  const int tid_ = tidx(); const int lane = tid_ & 63, w = tid_ >> 6;
  float* rtl = (float*)smem;
  float* hl = (float*)(smem + 65536) + w * 1024;
  const float* g = p.ffn_norm + layer * DM;
  const float* rt = p.router + (size_t)layer * DM * NE;
  __syncthreads();
#pragma unroll
  for (int i = 0; i < 8; ++i) *(f32x4*)(rtl + (tid_ + i * NTH) * 4) = *(const f32x4*)(rt + (tid_ + i * NTH) * 4);
  __syncthreads();
  const int cg = lane >> 2, eq = lane & 3;
  for (int tok = blockIdx.x * 8 + w; tok < NTOK; tok += gridDim.x * 8) {
    const f32x4* xr = (const f32x4*)(p.out + (size_t)tok * DM);
    f32x4 v[4]; float ss = 0.f;
#pragma unroll
    for (int j = 0; j < 4; ++j) { v[j] = xr[lane + 64 * j]; ss += v[j][0] * v[j][0] + v[j][1] * v[j][1] + v[j][2] * v[j][2] + v[j][3] * v[j][3]; }
    ss = wave_sum(ss);
    const float rstd = frsq(ss * (1.f / DM) + NORM_EPS);
#pragma unroll
    for (int j = 0; j < 4; ++j) {
      const int c0 = (lane + 64 * j) * 4;
      const f32x4 gg = *(const f32x4*)(g + c0);
      const f32x4 hv = v[j] * rstd * gg;
      *(u32x2*)(p.H + (size_t)tok * DM + c0) = u32x2{pk2(hv[0], hv[1]), pk2(hv[2], hv[3])};
      *(f32x4*)(hl + c0) = hv;
    }
    f32x4 acc = f32x4{0.f, 0.f, 0.f, 0.f};
#pragma unroll 16
    for (int i = 0; i < 64; ++i) {
      const float hv = hl[cg + 16 * i];
      const f32x4 r4 = *(const f32x4*)(rtl + (cg + 16 * i) * 16 + eq * 4);
      acc += hv * r4;
    }
#pragma unroll
    for (int e = 0; e < 4; ++e) {
      float a = acc[e];
      a += dpp_f<0x124>(a); a += dpp_f<0x128>(a);
      a = red_x32(red_x16(a));
      acc[e] = a;
    }
    float mx = fmaxf(fmaxf(acc[0], acc[1]), fmaxf(acc[2], acc[3]));
    mx = fmaxf(mx, dpp_f<0xB1>(mx)); mx = fmaxf(mx, dpp_f<0x4E>(mx));
    f32x4 ex; float se = 0.f;
#pragma unroll
    for (int e = 0; e < 4; ++e) { ex[e] = fexp(acc[e] - mx); se += ex[e]; }
    se = red_x2(red_x1(se));
    const float inv = frcp(se);
    const int b = tok / T, t = tok % T;
    if (lane < 4) {
#pragma unroll
      for (int e = 0; e < 4; ++e) p.AFF[((size_t)(b * NE + eq * 4 + e)) * T + t] = ex[e] * inv;
    }
  }
}

DI void ph_topk(const P& p, char* smem) {
  unsigned* hist = (unsigned*)smem;
  unsigned* sc = hist + 256;
  unsigned* bc = sc + 2048;
  const int tid = tidx();
  for (int item = blockIdx.x; item < NB * NE; item += gridDim.x) {
    const float* a = p.AFF + (size_t)item * T;
    unsigned key[16];
#pragma unroll
    for (int i = 0; i < 4; ++i) {
      uint4 v = *(const uint4*)(a + tid * 16 + i * 4);
      key[i * 4 + 0] = v.x; key[i * 4 + 1] = v.y; key[i * 4 + 2] = v.z; key[i * 4 + 3] = v.w;
    }
    unsigned prefix = 0, mask = 0, need = CAP;
    for (int pass = 0; pass < 4; ++pass) {
      int shift = 24 - 8 * pass;
      __syncthreads();
      if (tid < 256) hist[tid] = 0;
      __syncthreads();
#pragma unroll
      for (int i = 0; i < 16; ++i)
        if ((key[i] & mask) == prefix) atomicAdd(&hist[(key[i] >> shift) & 255u], 1u);
      __syncthreads();
      if (tid == 0) {
        unsigned cum = 0; int bsel = 0; unsigned nd = need;
        for (int bb = 255; bb >= 0; --bb) {
          unsigned hc = hist[bb];
          if (cum + hc >= need) { bsel = bb; nd = need - cum; break; }
          cum += hc;
        }
        bc[0] = prefix | ((unsigned)bsel << shift); bc[1] = nd;
      }
      __syncthreads();
      prefix = bc[0]; need = bc[1]; mask |= (255u << shift);
    }
    unsigned ngt = 0, neq = 0;
#pragma unroll
    for (int i = 0; i < 16; ++i) { ngt += key[i] > prefix; neq += key[i] == prefix; }
    __syncthreads();
    unsigned* sA = sc; unsigned* sB = sc + 512; unsigned* eA = sc + 1024; unsigned* eB = sc + 1536;
    sA[tid] = ngt; eA[tid] = neq;
    __syncthreads();
    for (int off = 1; off < NTH; off <<= 1) {
      unsigned x = sA[tid] + ((tid >= off) ? sA[tid - off] : 0u);
      unsigned y = eA[tid] + ((tid >= off) ? eA[tid - off] : 0u);
      sB[tid] = x; eB[tid] = y;
      __syncthreads();
      unsigned* tmp = sA; sA = sB; sB = tmp; tmp = eA; eA = eB; eB = tmp;
    }
    unsigned gt_excl = sA[tid] - ngt, eq_excl = eA[tid] - neq;
    unsigned gt_total = sA[NTH - 1];
    int* idx = p.IDX + (size_t)item * CAP; float* gate = p.GATE + (size_t)item * CAP;
#pragma unroll
    for (int i = 0; i < 16; ++i) {
      int slot = -1;
      if (key[i] > prefix) { slot = (int)gt_excl; ++gt_excl; }
      else if (key[i] == prefix) { if (eq_excl < need) slot = (int)(gt_total + eq_excl); ++eq_excl; }
      if (slot >= 0) {
        const int tokl = tid * 16 + i;
        idx[slot] = tokl; gate[slot] = __uint_as_float(key[i]);
        const int tokg = (item / NE) * T + tokl;
        const int pos = atomicAdd(&p.TCNT[tokg], 1);
        p.TLIST[(size_t)tokg * 16 + pos] = item * CAP + slot;
      }
    }
    __syncthreads();
  }
}

DI void ph_exp1(const P& p, int layer, char* smem) {
  for (int t = blockIdx.x; t < 32 * 4 * 16; t += gridDim.x) {
    int grp = t / 64, r = t % 64, tm = r / 16, tn = r % 16;
    int b = grp / NE, e = grp % NE;
    const int* gi = p.IDX + (size_t)grp * CAP + tm * GBM;
    const u16* Hb = p.H + (size_t)b * T * DM;
    const float* Wg = p.exp_w_gate + ((size_t)layer * NE + e) * DM * 1024;
    const float* Wu = p.exp_w_up + ((size_t)layer * NE + e) * DM * 1024;
    u16* hid = p.HID + ((size_t)grp * CAP + tm * GBM) * 1024;
    auto arow = [&](int row) -> const void* { return Hb + (size_t)gi[row] * DM; };
    gemm_tile<false, 1>(arow, Wg, Wu, 1024, DM, tn * 64, 1024, smem, [&](int row, int col, float g, float u) {
      float sv = g * frcp(1.f + fexp(-g));
      hid[(size_t)row * 1024 + col] = f2bf(sv * u);
    });
    __syncthreads();
  }
}
DI void ph_exp2(const P& p, int layer, char* smem) {
  for (int t = blockIdx.x; t < 32 * 4 * 8; t += gridDim.x) {
    int grp = t / 32, r = t % 32, tm = r / 8, tn = r % 8;
    int b = grp / NE, e = grp % NE;
    const int* gi = p.IDX + (size_t)grp * CAP + tm * GBM;
    const float* gt = p.GATE + (size_t)grp * CAP + tm * GBM;
    const u16* hid = p.HID + ((size_t)grp * CAP + tm * GBM) * 1024;
    const float* Wd = p.exp_w_down + ((size_t)layer * NE + e) * 1024 * DM;
    float* xb = p.out + (size_t)b * T * DM;
    auto arow = [&](int row) -> const void* { return hid + (size_t)row * 1024; };
    gemm_tile<false, 0>(arow, Wd, nullptr, DM, 1024, tn * GBN, DM, smem, [&](int row, int col, float v, float) {
      unsafeAtomicAdd(xb + (size_t)gi[row] * DM + col, v * gt[row]);
    });
    __syncthreads();
  }
}

namespace g8 {
constexpr int BM = 256, BK = 64, HALF = 128, HTB = HALF * BK * 2, STAGE_BYTES = 8 * HTB, NXCD = 8, WGM = 8;
DI int lds_byte(int r, int c) { const int st = (r >> 4) * 2 + (c >> 5), rr = r & 15, cc = c & 31, ob = rr * 64 + cc * 2; return st * 1024 + (ob ^ (((ob >> 9) & 1) << 5)); }
DI void stage_rc(int b, int& R, int& C) { const int st = b / 1024, sb = b % 1024, swz = sb ^ (((sb >> 9) & 1) << 5); R = (st >> 1) * 16 + swz / 64; C = (st & 1) * 32 + (swz % 64) / 2; }
DI int perm32(int rho) { const int n = rho >> 4, i = rho & 15; return 8 * (i >> 2) + 4 * n + (i & 3); }
struct Unit { int pm, pn; };
struct Sched {
  int nM, nN, nwg, G, c;
  const char* A; const char* Bt; size_t a_tstep, b_tstep; int gdiv, gmod; size_t gstride;
  DI void init(int nM_, int nN_, int G_, int c_, const void* A_, const void* Bt_, int K) {
    nM = nM_; nN = nN_; nwg = nM * nN; G = G_; c = c_; A = (const char*)uni_ptr(A_); Bt = (const char*)uni_ptr(Bt_);
    a_tstep = (size_t)BM * K * 2; b_tstep = (size_t)BM * K * 2; gdiv = 1 << 30; gmod = 1; gstride = 0;
  }
  DI void group(int gdiv_, int gmod_, size_t gstride_) { gdiv = gdiv_; gmod = gmod_; gstride = gstride_; }
  DI bool next(int i, Unit& u) const {
    const long L = (long)i * G + c; if (L >= nwg) return false;
    int wgid = (int)L; { const int q = nwg / NXCD, r = nwg % NXCD, xcd = wgid % NXCD, off = wgid / NXCD; wgid = (xcd < r ? xcd * (q + 1) : r * (q + 1) + (xcd - r) * q) + off; }
    const int nig = WGM * nN, gid = wgid / nig, fm = gid * WGM, gsz = (nM - fm) < WGM ? (nM - fm) : WGM;
    u.pm = fm + ((wgid % nig) % gsz); u.pn = (wgid % nig) / gsz; return true;
  }
  DI const char* a_ptr(const Unit& u) const { return A + (size_t)u.pm * a_tstep; }
  DI const char* b_ptr(const Unit& u) const { return Bt + (size_t)((u.pm / gdiv) % gmod) * gstride + (size_t)u.pn * b_tstep; }
};
using Acc = f32x4[2][2][4][2];

template <class Epi, bool GATHER = false>
DI void gemm_phase(LAS unsigned char* lds, const int K, const Sched& S, const Epi& E, const int* gidx = nullptr, LAS unsigned* gtab = nullptr) {
  const int tid = tidx(), wid = __builtin_amdgcn_readfirstlane(tid >> 6), lane = tid & 63, wr = wid >> 2, wc = wid & 3, fr = lane & 15, fq = lane >> 4;
  const int nt = K / BK;
  unsigned voffA[2], voffB[2];
#pragma unroll
  for (int i = 0; i < 2; ++i) { int R, C; stage_rc(tid * 16 + i * 8192, R, C); const int Rb = Epi::PERM ? ((R & ~31) + perm32(R & 31)) : R;
    voffA[i] = GATHER ? (unsigned)(R | (C << 16)) : (unsigned)(R * K + C) * 2u; voffB[i] = (unsigned)(Rb * K + C) * 2u; }
  unsigned gc[2][2], gn[2][2];
  auto gget = [&](int ui_, unsigned (&g)[2][2]) {
    if constexpr (GATHER) {
      Unit u_; const bool ok = S.next(ui_, u_);
#pragma unroll
      for (int h = 0; h < 2; ++h)
#pragma unroll
        for (int i = 0; i < 2; ++i) {
          const int r = h * HALF + (int)(voffA[i] & 0xffffu); const unsigned cb = (voffA[i] >> 16) * 2u;
          if (ui_ < 16) g[h][i] = gtab[ui_ * 256 + r] + cb;
          else { const int row = (ok ? u_.pm : 0) * BM + r; g[h][i] = (unsigned)((row / (NE * CAP)) * T + gidx[row]) * (unsigned)K * 2u + cb; }
        }
      asm volatile("" : "+v"(g[0][0]), "+v"(g[0][1]), "+v"(g[1][0]), "+v"(g[1][1]));
    }
  };
  if constexpr (GATHER) {
    for (int i0 = 0; i0 < 16; i0 += 2) {
      Unit u_; const int i = i0 + (tid >> 8);
      if (S.next(i, u_)) { const int row = u_.pm * BM + (tid & 255); gtab[i * 256 + (tid & 255)] = (unsigned)((row / (NE * CAP)) * T + gidx[row]) * (unsigned)K * 2u; }
      if (!S.next(i0 + 2, u_)) break;
    }
    __syncthreads();
  }
  const size_t kstep = (size_t)(BK * 2);
  const size_t hstep = (size_t)HALF * K * 2;
  const unsigned ldsw = (unsigned)wid * 1024u;
  const int aoff = lds_byte(wr * 64 + fr, fq * 8), boff = lds_byte(wc * 32 + fr, fq * 8);
#define G8_SA(b, h) (((b) * 2 + (h)) * HTB)
#define G8_SB(b, h) ((4 + (b) * 2 + (h)) * HTB)
#define G8_STAGE(bufoff, gbase, voff) do { _Pragma("unroll") for (int _i = 0; _i < 2; ++_i) \
    __builtin_amdgcn_global_load_lds((const unsigned*)((const char*)(gbase) + (voff)[_i]), (LAS unsigned*)(lds + (bufoff) + ldsw + _i * 8192), 16, 0, 0); } while (0)
#define G8_STAGE_A(bufoff, base, h, kb, Gv) do { if constexpr (GATHER) { G8_STAGE(bufoff, S.A + (kb), Gv[h]); } else { G8_STAGE(bufoff, (base) + (h) * hstep + (kb), voffA); } } while (0)
#define G8_LDA(dst, b, h) do { _Pragma("unroll") for (int m = 0; m < 4; ++m) _Pragma("unroll") for (int k = 0; k < 2; ++k) dst[m][k] = *(const LAS bf16x8*)(lds + G8_SA(b, h) + aoff + m * 2048 + k * 1024); } while (0)
#define G8_LDB(dst, b, h) do { _Pragma("unroll") for (int n = 0; n < 2; ++n) _Pragma("unroll") for (int k = 0; k < 2; ++k) dst[n][k] = *(const LAS bf16x8*)(lds + G8_SB(b, h) + boff + n * 2048 + k * 1024); } while (0)
#define G8_MMA(ai, bj, At, Bt) do { __builtin_amdgcn_s_setprio(1); _Pragma("unroll") for (int m = 0; m < 4; ++m) _Pragma("unroll") for (int n = 0; n < 2; ++n) _Pragma("unroll") for (int k = 0; k < 2; ++k) \
    acc[ai][bj][m][n] = __builtin_amdgcn_mfma_f32_16x16x32_bf16(Bt[n][k], At[m][k], acc[ai][bj][m][n], 0, 0, 0); __builtin_amdgcn_s_setprio(0); } while (0)
#define G8_WAIT_V(n) asm volatile("s_waitcnt vmcnt(" #n ")" ::: "memory")
#define G8_WAIT_L(n) asm volatile("s_waitcnt lgkmcnt(" #n ")" ::: "memory")
#define G8_BAR __builtin_amdgcn_s_barrier()
#define G8_SCHED __builtin_amdgcn_sched_barrier(0)
  Unit cur, nxt; int ui = 0;
  if (!S.next(0, cur)) return;
  f32x4 acc[2][2][4][2];
#pragma unroll
  for (int a = 0; a < 2; ++a)
#pragma unroll
    for (int b = 0; b < 2; ++b)
#pragma unroll
      for (int m = 0; m < 4; ++m)
#pragma unroll
        for (int n = 0; n < 2; ++n) acc[a][b][m][n] = (f32x4){0.f, 0.f, 0.f, 0.f};
  bf16x8 At[4][2], B0[2][2], B1[2][2];
  const char* cA = S.a_ptr(cur); const char* cB = S.b_ptr(cur);
  gget(0, gc);
  G8_STAGE(G8_SB(0, 0), cB, voffB); G8_STAGE_A(G8_SA(0, 0), cA, 0, 0, gc); G8_STAGE(G8_SB(0, 1), cB + hstep, voffB); G8_STAGE_A(G8_SA(0, 1), cA, 1, 0, gc);
  if (wr == 1) G8_BAR;
  G8_WAIT_V(4); G8_BAR;
  G8_STAGE(G8_SB(1, 0), cB + kstep, voffB); G8_STAGE_A(G8_SA(1, 0), cA, 0, kstep, gc); G8_STAGE(G8_SB(1, 1), cB + hstep + kstep, voffB);
  G8_WAIT_V(6); G8_BAR;
  for (;;) {
    const bool has_next = S.next(ui + 1, nxt);
    const char* nA = has_next ? S.a_ptr(nxt) : cA; const char* nB = has_next ? S.b_ptr(nxt) : cB;
    gget(has_next ? ui + 1 : ui, gn);
    for (int t = 0; t < nt; t += 2) {
      const bool last = (t == nt - 2);
      const size_t k1 = (size_t)(t + 1) * kstep, k2 = last ? (size_t)0 : (size_t)(t + 2) * kstep, k3 = k2 + kstep;
      const char* u2 = last ? nA : cA; const char* b2 = (last ? nB : cB) + k2;
      const char* b3 = b2 + kstep;
      unsigned g2[2][2];
      if constexpr (GATHER) {
#pragma unroll
        for (int h = 0; h < 2; ++h)
#pragma unroll
          for (int i = 0; i < 2; ++i) g2[h][i] = last ? gn[h][i] : gc[h][i];
      }
      G8_LDB(B0, 0, 0); G8_SCHED; G8_LDA(At, 0, 0); G8_STAGE_A(G8_SA(1, 1), cA, 1, k1, gc);
      G8_WAIT_L(8); G8_BAR; G8_WAIT_L(0); G8_MMA(0, 0, At, B0); G8_BAR; G8_SCHED;
      G8_LDB(B1, 0, 1); G8_STAGE(G8_SB(0, 0), b2, voffB);
      G8_BAR; G8_WAIT_L(0); G8_MMA(0, 1, At, B1); G8_BAR;
      G8_LDA(At, 0, 1); G8_STAGE_A(G8_SA(0, 0), u2, 0, k2, g2);
      G8_BAR; G8_WAIT_L(0); G8_MMA(1, 0, At, B0); G8_BAR; G8_SCHED;
      G8_STAGE(G8_SB(0, 1), b2 + hstep, voffB);
      G8_WAIT_V(6); G8_BAR; G8_MMA(1, 1, At, B1); G8_BAR;
      G8_LDB(B0, 1, 0); G8_SCHED; G8_LDA(At, 1, 0); G8_STAGE_A(G8_SA(0, 1), u2, 1, k2, g2);
      G8_WAIT_L(8); G8_BAR; G8_WAIT_L(0); G8_MMA(0, 0, At, B0); G8_BAR; G8_SCHED;
      G8_LDB(B1, 1, 1); G8_STAGE(G8_SB(1, 0), b3, voffB);
      G8_BAR; G8_WAIT_L(0); G8_MMA(0, 1, At, B1); G8_BAR;
      G8_LDA(At, 1, 1); G8_STAGE_A(G8_SA(1, 0), u2, 0, k3, g2);
      G8_BAR; G8_WAIT_L(0); G8_MMA(1, 0, At, B0); G8_BAR; G8_SCHED;
      G8_STAGE(G8_SB(1, 1), b3 + hstep, voffB);
      G8_WAIT_V(6); G8_BAR; G8_MMA(1, 1, At, B1); G8_BAR;
    }
    {
      const int t2 = tidx(); const int w2 = __builtin_amdgcn_readfirstlane(t2 >> 6), l2 = t2 & 63;
      E(acc, cur, w2 >> 2, w2 & 3, l2 & 15, l2 >> 4);
    }
    if (!has_next) break;
#pragma unroll
    for (int a = 0; a < 2; ++a)
#pragma unroll
      for (int b = 0; b < 2; ++b)
#pragma unroll
        for (int m = 0; m < 4; ++m)
#pragma unroll
          for (int n = 0; n < 2; ++n) acc[a][b][m][n] = (f32x4){0.f, 0.f, 0.f, 0.f};
    cur = nxt; cA = nA; cB = nB; ++ui;
    if constexpr (GATHER) {
#pragma unroll
      for (int h = 0; h < 2; ++h)
#pragma unroll
        for (int i = 0; i < 2; ++i) gc[h][i] = gn[h][i];
    }
  }
  G8_WAIT_V(0);
  if (wr == 0) G8_BAR;
  G8_BAR;
#undef G8_SA
#undef G8_SB
#undef G8_STAGE
#undef G8_STAGE_A
#undef G8_LDA
#undef G8_LDB
#undef G8_MMA
#undef G8_WAIT_V
#undef G8_WAIT_L
#undef G8_BAR
#undef G8_SCHED
}

struct EpiZ {
  static constexpr bool PERM = false; float* Z;
  DI void operator()(const Acc& acc, const Unit& u, int wr, int wc, int fr, int fq) const {
    const int row0 = u.pm * BM + wr * 64 + fr, col0 = u.pn * BM + wc * 32 + 4 * fq;
#pragma unroll
    for (int ai = 0; ai < 2; ++ai)
#pragma unroll
      for (int m = 0; m < 4; ++m) { float* rowp = Z + (size_t)(row0 + ai * HALF + m * 16) * INC;
#pragma unroll
        for (int bj = 0; bj < 2; ++bj)
#pragma unroll
          for (int n = 0; n < 2; ++n) { const int col = col0 + bj * HALF + n * 16; if (col < INC) *(f32x4*)(rowp + col) = acc[ai][bj][m][n]; } }
  }
};
struct EpiRes {
  static constexpr bool PERM = false; const float* xs; float* xo;
  DI void operator()(const Acc& acc, const Unit& u, int wr, int wc, int fr, int fq) const {
    const int row0 = u.pm * BM + wr * 64 + fr, col0 = u.pn * BM + wc * 32 + 4 * fq;
#pragma unroll
    for (int ai = 0; ai < 2; ++ai)
#pragma unroll
      for (int m = 0; m < 4; ++m) { const size_t ro = (size_t)(row0 + ai * HALF + m * 16) * DM + col0;
#pragma unroll
        for (int bj = 0; bj < 2; ++bj)
#pragma unroll
          for (int n = 0; n < 2; ++n) { const size_t o = ro + bj * HALF + n * 16; *(f32x4*)(xo + o) = *(const f32x4*)(xs + o) + acc[ai][bj][m][n]; } }
  }
};
struct EpiSig {
  static constexpr bool PERM = true; u16* PG;
  DI void operator()(const Acc& acc, const Unit& u, int wr, int wc, int fr, int fq) const {
    const int row0 = u.pm * BM + wr * 64 + fr, col0 = u.pn * BM + wc * 32 + 8 * fq;
#pragma unroll
    for (int ai = 0; ai < 2; ++ai)
#pragma unroll
      for (int m = 0; m < 4; ++m) { u16* rowp = PG + (size_t)(row0 + ai * HALF + m * 16) * DM + col0;
#pragma unroll
        for (int bj = 0; bj < 2; ++bj) { const f32x4 v0 = acc[ai][bj][m][0], v1 = acc[ai][bj][m][1];
          u32x4 wv = {pk2(sigmoidf_(v0[0]), sigmoidf_(v0[1])), pk2(sigmoidf_(v0[2]), sigmoidf_(v0[3])), pk2(sigmoidf_(v1[0]), sigmoidf_(v1[1])), pk2(sigmoidf_(v1[2]), sigmoidf_(v1[3]))};
          *(u32x4*)(rowp + bj * HALF) = wv; } }
  }
};
struct EpiPle {
  static constexpr bool PERM = false; float* xo; const u16* PG;
  DI void operator()(const Acc& acc, const Unit& u, int wr, int wc, int fr, int fq) const {
    const int row0 = u.pm * BM + wr * 64 + fr, col0 = u.pn * BM + wc * 32 + 4 * fq;
#pragma unroll
    for (int ai = 0; ai < 2; ++ai)
#pragma unroll
      for (int m = 0; m < 4; ++m) { const size_t ro = (size_t)(row0 + ai * HALF + m * 16) * DM + col0;
#pragma unroll
        for (int bj = 0; bj < 2; ++bj)
#pragma unroll
          for (int n = 0; n < 2; ++n) { const size_t o = ro + bj * HALF + n * 16; const u32x2 g = *(const u32x2*)(PG + o);
            f32x4 gv = {__uint_as_float(g[0] << 16), __uint_as_float(g[0] & 0xffff0000u), __uint_as_float(g[1] << 16), __uint_as_float(g[1] & 0xffff0000u)};
            *(f32x4*)(xo + o) = *(const f32x4*)(xo + o) + acc[ai][bj][m][n] * gv; } }
  }
};
struct EpiSwi {
  static constexpr bool PERM = true; u16* HID;
  DI void operator()(const Acc& acc, const Unit& u, int wr, int wc, int fr, int fq) const {
    const int row0 = u.pm * BM + wr * 64 + fr, col0 = u.pn * HALF + wc * 32 + 8 * fq;
#pragma unroll
    for (int ai = 0; ai < 2; ++ai)
#pragma unroll
      for (int m = 0; m < 4; ++m) { u16* rowp = HID + (size_t)(row0 + ai * HALF + m * 16) * 1024 + col0;
        float h[8];
#pragma unroll
        for (int n = 0; n < 2; ++n)
#pragma unroll
          for (int j = 0; j < 4; ++j) { const float gt = acc[ai][0][m][n][j], up = acc[ai][1][m][n][j]; h[n * 4 + j] = gt * frcp(1.f + fexp(-gt)) * up; }
        *(u32x4*)rowp = u32x4{pk2(h[0], h[1]), pk2(h[2], h[3]), pk2(h[4], h[5]), pk2(h[6], h[7])}; }
  }
};
struct EpiYE {
  static constexpr bool PERM = true; u16* YE; const float* GATE;
  DI void operator()(const Acc& acc, const Unit& u, int wr, int wc, int fr, int fq) const {
    const int row0 = u.pm * BM + wr * 64 + fr, col0 = u.pn * BM + wc * 32 + 8 * fq;
#pragma unroll
    for (int ai = 0; ai < 2; ++ai)
#pragma unroll
      for (int m = 0; m < 4; ++m) { const int row = row0 + ai * HALF + m * 16; const float gt = GATE[row]; u16* rowp = YE + (size_t)row * 1024 + col0;
#pragma unroll
        for (int bj = 0; bj < 2; ++bj) { const f32x4 v0 = acc[ai][bj][m][0] * gt, v1 = acc[ai][bj][m][1] * gt;
          *(u32x4*)(rowp + bj * HALF) = u32x4{pk2(v0[0], v0[1]), pk2(v0[2], v0[3]), pk2(v1[0], v1[1]), pk2(v1[2], v1[3])}; } }
  }
};
}

DI void cvt_tile_T(const float* __restrict__ src, int ldsrc, int N, int K, u16* __restrict__ dst, int k0, int n0, int drow0, char* smem, int tid) {
  short* tl = (short*)smem;
  __syncthreads();
#pragma unroll
  for (int i = 0; i < 2; ++i) {
    int u = tid + i * NTH; int kr = u >> 4, nq = u & 15; int n = n0 + nq * 4;
    f32x4 v = f32x4{0.f, 0.f, 0.f, 0.f};
    if (n < N) v = *(const f32x4*)(src + (size_t)(k0 + kr) * ldsrc + n);
#pragma unroll
    for (int e = 0; e < 4; ++e) tl[(nq * 4 + e) * 72 + kr] = (short)f2bf(v[e]);
  }
  __syncthreads();
  { int n = tid >> 3, kc = tid & 7;
    *(u32x4*)(dst + (size_t)(drow0 + n) * K + k0 + kc * 8) = *(const u32x4*)(tl + n * 72 + kc * 8); }
}
constexpr int WIN_PAD = 2560;
DI void ph_cvt_small(const P& p, int layer, char* smem) {
  const int tid = tidx();
  const int t0 = 16 * 40, t1 = t0 + 256, t2 = t1 + 256, t3 = t2 + 64;
  for (int t = blockIdx.x; t < t3; t += gridDim.x) {
    if (t < t0) cvt_tile_T(p.w_in + (size_t)layer * DM * INC, INC, INC, DM, p.WIN, (t / 40) * 64, (t % 40) * 64, (t % 40) * 64, smem, tid);
    else if (t < t1) { int q = t - t0; cvt_tile_T(p.w_out + (size_t)layer * DM * DM, DM, DM, DM, p.WOUT, (q / 16) * 64, (q % 16) * 64, (q % 16) * 64, smem, tid); }
    else if (t < t2) { int q = t - t1; cvt_tile_T(p.ple_gate + (size_t)layer * DM * DM, DM, DM, DM, p.WPG, (q / 16) * 64, (q % 16) * 64, (q % 16) * 64, smem, tid); }
    else { int q = t - t2; cvt_tile_T(p.ple_proj + (size_t)layer * DPLE * DM, DM, DM, DPLE, p.WPP, (q / 16) * 64, (q % 16) * 64, (q % 16) * 64, smem, tid); }
  }
  const float* ps = p.p + (size_t)layer * NTOK * DPLE;
  for (int i = blockIdx.x * NTH + tid; i < NTOK * DPLE / 8; i += gridDim.x * NTH) {
    f32x4 a = *(const f32x4*)(ps + (size_t)i * 8), b = *(const f32x4*)(ps + (size_t)i * 8 + 4);
    *(u32x4*)(p.PB + (size_t)i * 8) = u32x4{pk2(a[0], a[1]), pk2(a[2], a[3]), pk2(b[0], b[1]), pk2(b[2], b[3])};
  }
}

struct CvtJob { const float* src; u16* dst; int k0, n0, drow0; };
DI bool cvt_job(const P& p, int layer, int t, CvtJob& j) {
  if (t >= NE * 3 * 128) return false;
  const int e = t / 384, r = t % 384, mat = r / 128, q = r % 128;
  j.k0 = (q / 8) * 64; j.n0 = (q % 8) * 128;
  const size_t eo = ((size_t)layer * NE + e) * 1024 * 1024;
  if (mat == 0) { j.src = p.exp_w_gate + eo; j.dst = p.EW1 + (size_t)e * 2048 * 1024; j.drow0 = (j.n0 >> 7) * 256; }
  else if (mat == 1) { j.src = p.exp_w_up + eo; j.dst = p.EW1 + (size_t)e * 2048 * 1024; j.drow0 = (j.n0 >> 7) * 256 + 128; }
  else { j.src = p.exp_w_down + eo; j.dst = p.EW2 + (size_t)e * 1024 * 1024; j.drow0 = j.n0; }
  return true;
}
DI void ph_cvt_experts(const P& p, int layer, char* smem, unsigned* ctr) {
  const int tid = tidx();
  short* tl = (short*)smem;
  int* sitem = (int*)(smem + 32768);
  __syncthreads();
  if (tid == 0) sitem[0] = (int)atomicAdd(ctr, 1u);
  __syncthreads();
  CvtJob cur; bool has = cvt_job(p, layer, sitem[0], cur);
  f32x4 v[4];
  const int kr = tid >> 5, nq = tid & 31;
  if (has) {
#pragma unroll
    for (int i = 0; i < 4; ++i) v[i] = *(const f32x4*)(cur.src + (size_t)(cur.k0 + kr + 16 * i) * 1024 + cur.n0 + nq * 4);
  }
  int par = 0;
  while (has) {
    if (tid == 0) sitem[1 + par] = (int)atomicAdd(ctr, 1u);
    __syncthreads();
#pragma unroll
    for (int i = 0; i < 4; ++i)
#pragma unroll
      for (int e = 0; e < 4; ++e) tl[(nq * 4 + e) * 72 + kr + 16 * i] = (short)f2bf(v[i][e]);
    __syncthreads();
    CvtJob nxt; const bool hn = cvt_job(p, layer, sitem[1 + par], nxt);
    if (hn) {
#pragma unroll
      for (int i = 0; i < 4; ++i) v[i] = *(const f32x4*)(nxt.src + (size_t)(nxt.k0 + kr + 16 * i) * 1024 + nxt.n0 + nq * 4);
    }
#pragma unroll
    for (int i = 0; i < 2; ++i) {
      int u = tid + i * NTH; int n = u >> 3, kc = u & 7;
      *(u32x4*)(cur.dst + (size_t)(cur.drow0 + n) * 1024 + cur.k0 + kc * 8) = *(const u32x4*)(tl + n * 72 + kc * 8);
    }
    cur = nxt; has = hn; par ^= 1;
  }
}
DI void ph_gather(const P& p) {
  const int tid_ = tidx(); const int lane = tid_ & 63, w = tid_ >> 6;
  for (int row = blockIdx.x * 8 + w; row < NB * NE * CAP; row += gridDim.x * 8) {
    const int b = row / (NE * CAP);
    const int tok = b * T + p.IDX[row];
    const u32x4* src = (const u32x4*)(p.H + (size_t)tok * DM);
    u32x4* dst = (u32x4*)(p.XE + (size_t)row * DM);
    u32x4 a = src[lane], c = src[lane + 64];
    dst[lane] = a; dst[lane + 64] = c;
  }
}
DI void ph_combine_norm(const P& p, int layer) {
  const int tid_ = tidx(); const int lane = tid_ & 63, w = tid_ >> 6;
  const float* g = p.ple_norm + layer * DM;
  for (int tok = blockIdx.x * 8 + w; tok < NTOK; tok += gridDim.x * 8) {
    f32x4* xr = (f32x4*)(p.out + (size_t)tok * DM);
    f32x4 v[4];
#pragma unroll
    for (int j = 0; j < 4; ++j) v[j] = xr[lane * 4 + j];
    const int cnt = p.TCNT[tok];
    for (int q = 0; q < cnt; ++q) {
      const int yrow = p.TLIST[(size_t)tok * 16 + q];
      const u32x4* yr = (const u32x4*)(p.YE + (size_t)yrow * DM + lane * 16);
      u32x4 a = yr[0], c = yr[1];
#pragma unroll
      for (int e = 0; e < 4; ++e) {
        v[e >> 1][(e & 1) * 2] += __uint_as_float(a[e] << 16); v[e >> 1][(e & 1) * 2 + 1] += __uint_as_float(a[e] & 0xffff0000u);
        v[2 + (e >> 1)][(e & 1) * 2] += __uint_as_float(c[e] << 16); v[2 + (e >> 1)][(e & 1) * 2 + 1] += __uint_as_float(c[e] & 0xffff0000u);
      }
    }
    float ss = 0.f;
#pragma unroll
    for (int j = 0; j < 4; ++j) { xr[lane * 4 + j] = v[j]; ss += v[j][0] * v[j][0] + v[j][1] * v[j][1] + v[j][2] * v[j][2] + v[j][3] * v[j][3]; }
    ss = wave_sum(ss);
    const float rstd = frsq(ss * (1.f / DM) + NORM_EPS);
    u32x4 o0, o1;
#pragma unroll
    for (int j = 0; j < 4; ++j) {
      f32x4 gg = *(const f32x4*)(g + lane * 16 + j * 4);
      unsigned lo = pk2(v[j][0] * rstd * gg[0], v[j][1] * rstd * gg[1]), hi = pk2(v[j][2] * rstd * gg[2], v[j][3] * rstd * gg[3]);
      if (j < 2) { o0[j * 2] = lo; o0[j * 2 + 1] = hi; } else { o1[(j - 2) * 2] = lo; o1[(j - 2) * 2 + 1] = hi; }
    }
    *(u32x4*)(p.H + (size_t)tok * DM + lane * 16) = o0; *(u32x4*)(p.H + (size_t)tok * DM + lane * 16 + 8) = o1;
  }
}

#define XB_TMO      128
#define XB_XCNT(j)  (256  + 64 * (j))
#define XB_XSUB(j)  (1280 + 64 * (j))
#define XB_XGEN(j)  (2304 + 64 * (j))
#define XB_TOP      3328
#define XB_TOPGEN   3392
#define XCD_BAR_WORDS 3456
#define XB_SPIN_CAP (1u << 20)
DI unsigned xb_ld(unsigned* p) { return __hip_atomic_load(p, __ATOMIC_RELAXED, __HIP_MEMORY_SCOPE_AGENT); }
DI unsigned xb_add(unsigned* p, unsigned v) { return __hip_atomic_fetch_add(p, v, __ATOMIC_RELAXED, __HIP_MEMORY_SCOPE_AGENT); }
DI unsigned xb_xcc_id() { return (unsigned)__builtin_amdgcn_s_getreg((3 << 11) | 20) & 0xFu; }
#define XB_SPIN(cond, bar) do { unsigned _sp = 0; while (cond) { __builtin_amdgcn_s_sleep(1); \
    if ((++_sp & 255u) == 0u) { if (xb_ld(&(bar)[XB_TMO])) break; if (_sp > XB_SPIN_CAP) { atomicAdd(&(bar)[XB_TMO], 1u); break; } } } } while (0)
struct XcdBarrier { unsigned* bar; unsigned x; volatile LAS unsigned* st; };
DI XcdBarrier xcd_barrier_post(unsigned* bar, volatile LAS unsigned* st) {
  XcdBarrier b; b.bar = bar; b.x = xb_xcc_id(); b.st = st;
  if (threadIdx.x == 0) (void)xb_add(&bar[XB_XCNT(b.x)], 1u);
  return b;
}
DI void xcd_barrier_complete(unsigned* bar, unsigned x, unsigned& nloc, unsigned& nx) {
  const unsigned G = gridDim.x * gridDim.y * gridDim.z;
  unsigned sum, cnt, mine, sp = 0u;
  for (;;) {
    sum = 0u; cnt = 0u; mine = 0u;
#pragma unroll
    for (unsigned j = 0; j < 16; ++j) { const unsigned c = xb_ld(&bar[XB_XCNT(j)]); sum += c; cnt += (c > 0u) ? 1u : 0u; mine = (j == x) ? c : mine; }
    if (sum == G) break;
    __builtin_amdgcn_s_sleep(1);
    if ((++sp & 255u) == 0u) { if (xb_ld(&bar[XB_TMO])) break; if (sp > XB_SPIN_CAP) { atomicAdd(&bar[XB_TMO], 1u); break; } }
  }
  nloc = mine > 0u ? mine : 1u; nx = cnt > 0u ? cnt : 1u;
}
DI void xcd_barrier(const XcdBarrier& b) {
  asm volatile("s_waitcnt vmcnt(0)" ::: "memory");
  __syncthreads();
  if (threadIdx.x == 0) {
    unsigned* bar = b.bar;
    __builtin_amdgcn_s_waitcnt(0);
    unsigned nloc = b.st[0], nx = b.st[1];
    if (nloc == 0u) { xcd_barrier_complete(bar, b.x, nloc, nx); b.st[0] = nloc; b.st[1] = nx; }
    const unsigned old = xb_add(&bar[XB_XSUB(b.x)], 1u);
    const unsigned gen = old / nloc;
    if (old + 1u == (gen + 1u) * nloc) {
      __builtin_amdgcn_fence(__ATOMIC_RELEASE, "agent");
      asm volatile("s_waitcnt vmcnt(0)" ::: "memory");
      const unsigned og = xb_add(&bar[XB_TOP], 1u);
      const unsigned tg = og / nx;
      if (og + 1u == (tg + 1u) * nx) xb_add(&bar[XB_TOPGEN], 1u);
      else XB_SPIN(xb_ld(&bar[XB_TOPGEN]) == tg, bar);
      __builtin_amdgcn_fence(__ATOMIC_ACQUIRE, "agent");
      xb_add(&bar[XB_XGEN(b.x)], 1u);
      asm volatile("s_waitcnt vmcnt(0)" ::: "memory");
    } else {
      XB_SPIN(xb_ld(&bar[XB_XGEN(b.x)]) == gen, bar);
      __builtin_amdgcn_fence(__ATOMIC_ACQUIRE, "agent");
      asm volatile("s_waitcnt vmcnt(0)" ::: "memory");
    }
  }
  __syncthreads();
}

#define TAKE(bytes) (ws + off); off += (((size_t)(bytes)) + 255) & ~(size_t)255
__host__ __device__ inline size_t fill_ws(P& p, char* ws) {
  size_t off = 0;
  char* regA = TAKE((size_t)NTOK * INC * 4);
  p.Z = (float*)regA;
  p.LW = (u16*)regA; p.AA = (u16*)(regA + (size_t)2 * NTOK * RWW * 2); p.G = (u16*)(regA + (size_t)4 * NTOK * RWW * 2);
  p.MC = (float*)(regA + (size_t)5 * NTOK * RWW * 2); p.NC = p.MC + (size_t)32 * NCH * 4096;
  p.HID = (u16*)regA;
  char* regB = TAKE((size_t)3 * NTOK * RWW * 4);
  p.R = (float*)regB; p.K = p.R + (size_t)NTOK * RWW; p.V = p.K + (size_t)NTOK * RWW;
  p.PG = (float*)regB;
  char* regC = TAKE((size_t)NTOK * (768 + 1024) * 4);
  p.QRAW = (float*)regC; p.KVRAW = p.QRAW + (size_t)NTOK * 768;
  p.AO = (float*)regC; p.O2 = (u16*)(p.AO + (size_t)NTOK * 512); p.SS = (float*)(p.O2 + (size_t)2 * NTOK * 512);
  p.TWD = (u16*)TAKE((size_t)2 * NTOK * 64 * 2); p.AD = (u16*)TAKE((size_t)2 * NTOK * 64 * 2);
  p.SGD = (u16*)TAKE((size_t)NTOK * 128 * 2); p.QDN = (u16*)TAKE((size_t)NTOK * 256 * 2);
  p.KVDN = (u16*)TAKE((size_t)NTOK * 128 * 2); p.KR = (float*)TAKE((size_t)NTOK * 32 * 4);
  p.ROPE = (float*)TAKE((size_t)NTOK * 32 * 4);
  p.Q = (u16*)TAKE((size_t)NTOK * NH * 96 * 2); p.Kc = (u16*)TAKE((size_t)NTOK * NH * 96 * 2);
  p.Vv = (u16*)TAKE((size_t)NTOK * NH * 64 * 2);
  p.H = (u16*)TAKE((size_t)NTOK * DM * 2);
  p.AFF = (float*)TAKE((size_t)NB * NE * T * 4);
  p.IDX = (int*)TAKE((size_t)NB * NE * CAP * 4);
  p.GATE = (float*)TAKE((size_t)NB * NE * CAP * 4);

  p.WIN = (u16*)TAKE((size_t)WIN_PAD * DM * 2); p.WOUT = (u16*)TAKE((size_t)DM * DM * 2); p.WPG = (u16*)TAKE((size_t)DM * DM * 2);
  p.WPP = (u16*)TAKE((size_t)DM * DPLE * 2); p.PB = (u16*)TAKE((size_t)NTOK * DPLE * 2);
  p.PGb = (u16*)regB;
  p.EW1 = (u16*)regB; p.EW2 = p.EW1 + (size_t)NE * 2048 * 1024;
  p.XE = (u16*)regA; p.HID = (u16*)(regA + (size_t)32 * 1024 * 1024 * 2);
  p.YE = (u16*)regC;
  p.TCNT = (int*)TAKE((size_t)NTOK * 4); p.TLIST = (int*)TAKE((size_t)NTOK * 16 * 4);
  p.CTR = (unsigned*)TAKE(256);
  p.BAR = (unsigned*)TAKE(XCD_BAR_WORDS * 4);
  return off;
}
#undef TAKE
constexpr int DSM_BYTES = g8::STAGE_BYTES + 64 + 16 * 256 * 4;
extern __shared__ __attribute__((aligned(16))) char dsm[];
struct PK { const void* in[31]; float* out; char* ws; };
DI void build_params(P& p, const PK& k) {
  p.x = (const float*)k.in[0]; p.p = (const float*)k.in[1]; p.pos = (const int*)k.in[2];
  p.attn_norm = (const float*)k.in[3]; p.w_in = (const float*)k.in[4]; p.rw_mu = (const float*)k.in[5];
  p.rw_w0 = (const float*)k.in[6]; p.rw_w_up = (const float*)k.in[7]; p.rw_a0 = (const float*)k.in[8];
  p.rw_a_up = (const float*)k.in[9]; p.rw_g_up = (const float*)k.in[10]; p.rw_k_k = (const float*)k.in[11];
  p.rw_k_a = (const float*)k.in[12]; p.rw_r_k = (const float*)k.in[13]; p.rw_lnx_w = (const float*)k.in[14];
  p.rw_lnx_b = (const float*)k.in[15]; p.mla_q_norm = (const float*)k.in[16]; p.mla_q_up = (const float*)k.in[17];
  p.mla_kv_norm = (const float*)k.in[18]; p.mla_kv_up = (const float*)k.in[19]; p.mla_o_norm = (const float*)k.in[20];
  p.w_out = (const float*)k.in[21]; p.ffn_norm = (const float*)k.in[22]; p.router = (const float*)k.in[23];
  p.exp_w_gate = (const float*)k.in[24]; p.exp_w_up = (const float*)k.in[25]; p.exp_w_down = (const float*)k.in[26];
  p.ple_norm = (const float*)k.in[27]; p.ple_proj = (const float*)k.in[28]; p.ple_gate = (const float*)k.in[29];
  p.final_norm = (const float*)k.in[30];
  p.out = k.out;
  (void)fill_ws(p, k.ws);
}
__global__ void __launch_bounds__(NTH) mega(PK pk) {
  P p; build_params(p, pk);
  char* smem = dsm;
  LAS unsigned char* glds = (LAS unsigned char*)dsm;
  uint4* xbw = (uint4*)(dsm + g8::STAGE_BYTES);
  cg::grid_group grid = cg::this_grid();
  if (threadIdx.x == 0) *xbw = make_uint4(0u, 0u, 0u, 0u);
  if (pk.ws == nullptr) grid.sync();
  const XcdBarrier xb = xcd_barrier_post(p.BAR, (volatile LAS unsigned*)xbw);
#define GSYNC() xcd_barrier(xb)
#ifndef PROBE_MASK
#define PROBE_MASK 0u
#endif
#if PROBE_MASK
  unsigned long long pt0 = __builtin_amdgcn_s_memrealtime();
#define PSYNC(id) do { GSYNC(); if (PROBE_MASK & (1u << (id))) { unsigned long long t1_ = __builtin_amdgcn_s_memrealtime(); unsigned long long dt_ = t1_ - pt0; \
    while (__builtin_amdgcn_s_memrealtime() - t1_ < dt_) __builtin_amdgcn_s_sleep(8); } pt0 = __builtin_amdgcn_s_memrealtime(); } while (0)
#else
#define PSYNC(id) GSYNC()
#endif
  for (int layer_ = 0; layer_ < NL; ++layer_) {
    int layer = layer_; asm volatile("" : "+s"(layer));
    if (layer_ == 0) ph_rope_table(p);
    ph_cvt_small(p, layer, smem);
    ph_norm(layer == 0 ? p.x : p.out, p.attn_norm + layer * DM, p.H);
    PSYNC(0);
    {
      g8::Sched S; S.init(NTOK / 256, WIN_PAD / 256, gridDim.x, bidx(), p.H, p.WIN, DM);
      g8::EpiZ E{p.Z};
      g8::gemm_phase(glds, DM, S, E);
    }
    PSYNC(1);
    ph_rwshift(p, layer);
    ph_mlaprep1(p, layer);
    PSYNC(2);
    for (int d = 0; d < 2; ++d) {
      u16* LW = p.LW + (size_t)d * NTOK * RWW; const float* w0 = p.rw_w0 + (layer * 2 + d) * RWW;
      ph_gemm<false>(p.TWD + (size_t)d * NTOK * 64, 64, p.rw_w_up + ((size_t)(layer * 2 + d)) * 64 * RWW, RWW, NTOK, RWW, 64, smem,
                     [&](int row, int col, float v) { LW[(size_t)row * RWW + col] = f2bf(-0.6065306597126334f * sigmoidf_(v + w0[col])); });
      u16* AA = p.AA + (size_t)d * NTOK * RWW; const float* a0 = p.rw_a0 + (layer * 2 + d) * RWW;
      ph_gemm<false>(p.AD + (size_t)d * NTOK * 64, 64, p.rw_a_up + ((size_t)(layer * 2 + d)) * 64 * RWW, RWW, NTOK, RWW, 64, smem,
                     [&](int row, int col, float v) { AA[(size_t)row * RWW + col] = f2bf(sigmoidf_(v + a0[col])); });
    }
    {
      u16* G = p.G;
      ph_gemm<false>(p.SGD, 128, p.rw_g_up + (size_t)layer * 128 * RWW, RWW, NTOK, RWW, 128, smem,
                     [&](int row, int col, float v) { G[(size_t)row * RWW + col] = f2bf(v); });
      {
        u16* Qo = p.Q; const float* rope = p.ROPE;
        ph_gemm_t(p.QDN, 256, p.mla_q_up + (size_t)layer * 256 * 768, 768, NTOK, 768, 256, smem,
                  [&](const f32x4 (&acc)[4][4], int m0, int n0, int wm, int wn, int lq, int l15) {
          const float qs = 0.10206207261596577f * 1.4426950408889634f;
#pragma unroll
          for (int mi = 0; mi < 4; ++mi)
#pragma unroll
            for (int r = 0; r < 4; ++r) {
              const int tok = m0 + wm * 64 + mi * 16 + lq * 4 + r; const int b = tok / T, t = tok % T;
#pragma unroll
              for (int ni = 0; ni < 4; ++ni) {
                const int col0 = n0 + wn * 64 + ni * 16; const int h = col0 / 96, c0 = col0 % 96;
                u16* qo = Qo + ((size_t)(b * NH + h) * T + t) * 96;
                if (c0 < 64) qo[c0 + l15] = f2bf(acc[mi][ni][r] * qs);
                else if (c0 == 64) {
                  const f32x2 csn = *(const f32x2*)(rope + (size_t)tok * 32 + l15 * 2);
                  const float u1 = acc[mi][ni][r], u2 = acc[mi][(ni + 1) & 3][r];
                  qo[64 + l15] = f2bf((u1 * csn[0] - u2 * csn[1]) * qs);
                  qo[80 + l15] = f2bf((u1 * csn[1] + u2 * csn[0]) * qs);
                }
              }
            }
        });
      }
      {
        u16* Ko = p.Kc; u16* Vo = p.Vv;
        ph_gemm_t(p.KVDN, 128, p.mla_kv_up + (size_t)layer * 128 * 1024, 1024, NTOK, 1024, 128, smem,
                  [&](const f32x4 (&acc)[4][4], int m0, int n0, int wm, int wn, int lq, int l15) {
#pragma unroll
          for (int mi = 0; mi < 4; ++mi)
#pragma unroll
            for (int r = 0; r < 4; ++r) {
              const int tok = m0 + wm * 64 + mi * 16 + lq * 4 + r; const int b = tok / T, t = tok % T;
#pragma unroll
              for (int ni = 0; ni < 4; ++ni) {
                const int col0 = n0 + wn * 64 + ni * 16; const int h = col0 >> 7, c0 = col0 & 127;
                const size_t rowi = (size_t)(b * NH + h) * T + t;
                if (c0 < 64) Ko[rowi * 96 + c0 + l15] = f2bf(acc[mi][ni][r]);
                else Vo[rowi * 64 + (c0 - 64) + l15] = f2bf(acc[mi][ni][r]);
              }
            }
        });
      }
    }
    PSYNC(3);
    ph_scan1(p, layer, smem);
    PSYNC(4);
    ph_scan2(p, smem);
    ph_attn(p, smem, p.CTR + layer);
    PSYNC(5);
    ph_mla_norm(p, layer);
    ph_scan3(p, layer, smem);
    PSYNC(6);
    {
      for (int i = blockIdx.x * NTH + tidx(); i < NTOK; i += gridDim.x * NTH) p.TCNT[i] = 0;
      g8::Sched S; S.init(NTOK / 256, DM / 256, gridDim.x, bidx(), p.H, p.WOUT, DM);
      g8::EpiRes E{(layer == 0) ? p.x : p.out, p.out};
      g8::gemm_phase(glds, DM, S, E);
    }
    PSYNC(8);
    ph_norm_router(p, layer, smem);
    PSYNC(9);
    ph_topk(p, smem);
    ph_cvt_experts(p, layer, smem, p.CTR + 4 + layer);
    PSYNC(10);
    {
      g8::Sched S; S.init(NB * NE * CAP / 256, 2048 / 256, gridDim.x, bidx(), p.H, p.EW1, DM);
      S.group(4, NE, (size_t)2048 * 1024 * 2);
      g8::EpiSwi E{p.HID};
      g8::gemm_phase<g8::EpiSwi, true>(glds, DM, S, E, p.IDX, (LAS unsigned*)(dsm + g8::STAGE_BYTES + 64));
    }
    PSYNC(12);
    {
      g8::Sched S; S.init(NB * NE * CAP / 256, DM / 256, gridDim.x, bidx(), p.HID, p.EW2, 1024);
      S.group(4, NE, (size_t)1024 * 1024 * 2);
      g8::EpiYE E{p.YE, p.GATE};
      g8::gemm_phase(glds, 1024, S, E);
    }
    PSYNC(13);
    ph_combine_norm(p, layer);
    PSYNC(16);
    {
      g8::Sched S; S.init(NTOK / 256, DM / 256, gridDim.x, bidx(), p.H, p.WPG, DM);
      g8::EpiSig E{p.PGb};
      g8::gemm_phase(glds, DM, S, E);
    }
    {
      g8::Sched S; S.init(NTOK / 256, DM / 256, gridDim.x, bidx(), p.PB, p.WPP, DPLE);
      g8::EpiPle E{p.out, p.PGb};
      g8::gemm_phase(glds, DPLE, S, E);
    }
    PSYNC(15);
  }
  ph_final_norm(p.out, p.final_norm);
}

extern "C" void kernel_launch(void* const* d_in, const int* in_sizes, int n_in, void* d_out, int out_size, void* d_ws,
                              size_t ws_size, hipStream_t stream) {
  (void)in_sizes; (void)n_in; (void)out_size;
  PK pk{};
  for (int i = 0; i < 31; ++i) pk.in[i] = d_in[i];
  pk.out = (float*)d_out; pk.ws = (char*)d_ws;
  P p{};
  const size_t off = fill_ws(p, (char*)d_ws);
  if (off > ws_size) { fprintf(stderr, "workspace too small: need %zu have %zu\n", off, ws_size); return; }
  static int grid_blocks = 0;
  if (!grid_blocks) {
    int dev = 0, cus = 0, per_cu = 0;
    hipGetDevice(&dev);
    hipDeviceGetAttribute(&cus, hipDeviceAttributeMultiprocessorCount, dev);
    hipFuncSetAttribute((const void*)mega, hipFuncAttributeMaxDynamicSharedMemorySize, DSM_BYTES);
    hipOccupancyMaxActiveBlocksPerMultiprocessor(&per_cu, mega, NTH, DSM_BYTES);
    if (per_cu > 1) per_cu = 1;
    grid_blocks = cus * per_cu;
  }
  hipMemsetAsync(p.CTR, 0, 256 + (size_t)XCD_BAR_WORDS * 4, stream);
  void* args[] = {&pk};
  hipError_t e = hipLaunchCooperativeKernel((void*)mega, dim3(grid_blocks), dim3(NTH), args, DSM_BYTES, stream);
  if (e != hipSuccess) fprintf(stderr, "cooperative launch failed: %s (grid %d)\n", hipGetErrorString(e), grid_blocks);
}
```

```cpp
#include <hip/hip_runtime.h>
#include <hip/hip_bf16.h>
#include <cstdio>
#include <cstdint>
#include <hip/hip_cooperative_groups.h>
namespace cg = cooperative_groups;

#define DI __device__ __forceinline__
#define LAS __attribute__((address_space(3)))

constexpr int NB = 2, T = 8192, NTOK = NB * T, DM = 1024, NL = 2;
constexpr int RWW = 512, RWC = 1920, INC = 2336;
constexpr int NH = 8;
constexpr int NE = 16, CAP = 1024;
constexpr int DPLE = 256;
constexpr int NTH = 512;
constexpr float NORM_EPS = 1e-6f, GN_EPS = 64e-5f;

using bf16x8 = __attribute__((ext_vector_type(8))) short;
using s16x4  = __attribute__((ext_vector_type(4))) short;
using f32x4  = __attribute__((ext_vector_type(4))) float;
using u32x4  = __attribute__((ext_vector_type(4))) unsigned;
using f32x2  = __attribute__((ext_vector_type(2))) float;
using u32x2  = __attribute__((ext_vector_type(2))) unsigned;
typedef __bf16 bf2_t __attribute__((ext_vector_type(2)));
typedef unsigned short u16;

DI unsigned pk2(float a, float b) { bf2_t v = {(__bf16)a, (__bf16)b}; return __builtin_bit_cast(unsigned, v); }
DI u16 f2bf(float a) { return (u16)(pk2(a, 0.f) & 0xffffu); }
DI float bf2f(u16 u) { return __uint_as_float(((unsigned)u) << 16); }
DI const void* uni_ptr(const void* q) {
  unsigned long long v = (unsigned long long)q;
  unsigned lo = __builtin_amdgcn_readfirstlane((unsigned)v), hi = __builtin_amdgcn_readfirstlane((unsigned)(v >> 32));
  return (const void*)(((unsigned long long)hi << 32) | lo);
}
DI int tidx() { int t = threadIdx.x; asm volatile("" : "+v"(t)); return t; }
DI int bidx() { int b = blockIdx.x; asm volatile("" : "+s"(b)); return b; }
template <int CTRL> DI float dpp_f(float v) {
  return __int_as_float(__builtin_amdgcn_update_dpp(__float_as_int(v), __float_as_int(v), CTRL, 0xF, 0xF, true));
}
DI float red_x1(float v) { return v + dpp_f<0xB1>(v); }
DI float red_x2(float v) { return v + dpp_f<0x4E>(v); }
DI float red_x4(float v) { return v + dpp_f<0x141>(v); }
DI float red_x8(float v) { return v + dpp_f<0x140>(v); }
DI float red_x16(float v) { auto r = __builtin_amdgcn_permlane16_swap(__float_as_uint(v), __float_as_uint(v), false, false); return __uint_as_float(r[0]) + __uint_as_float(r[1]); }
DI float red_x32(float v) { auto r = __builtin_amdgcn_permlane32_swap(__float_as_uint(v), __float_as_uint(v), false, false); return __uint_as_float(r[0]) + __uint_as_float(r[1]); }
DI float red16(float v) { return red_x8(red_x4(red_x2(red_x1(v)))); }
DI float wave_sum(float v) { return red_x32(red_x16(red16(v))); }
DI float frcp(float x) { return __builtin_amdgcn_rcpf(x); }
DI float frsq(float x) { return __builtin_amdgcn_rsqf(x); }
DI float fexp(float x) { return __builtin_amdgcn_exp2f(x * 1.4426950408889634f); }
DI float sigmoidf_(float x) { return frcp(1.f + fexp(-x)); }
DI float ftanh(float x) { return 1.f - 2.f * frcp(1.f + fexp(2.f * x)); }
DI s16x4 tr_read(const short* p) {
  return __builtin_amdgcn_ds_read_tr16_b64_v4i16((LAS s16x4*)(p));
}

struct P {
  const float* x; const float* p; const int* pos;
  const float* attn_norm; const float* w_in; const float* rw_mu; const float* rw_w0; const float* rw_w_up;
  const float* rw_a0; const float* rw_a_up; const float* rw_g_up; const float* rw_k_k; const float* rw_k_a;
  const float* rw_r_k; const float* rw_lnx_w; const float* rw_lnx_b; const float* mla_q_norm; const float* mla_q_up;
  const float* mla_kv_norm; const float* mla_kv_up; const float* mla_o_norm; const float* w_out; const float* ffn_norm;
  const float* router; const float* exp_w_gate; const float* exp_w_up; const float* exp_w_down; const float* ple_norm;
  const float* ple_proj; const float* ple_gate; const float* final_norm;
  float* out;
  float* Z;
  u16* LW;
  u16* AA;
  float* MC; float* NC;
  float* SS;
  u16*   G;
  u16*   HID;
  float* R; float* K; float* V;
  float* PG;
  float* QRAW;
  float* KVRAW;
  float* AO;
  u16* O2;
  u16* TWD; u16* AD; u16* SGD; u16* QDN; u16* KVDN; float* KR;
  float* ROPE;
  u16* Q; u16* Kc; u16* Vv;
  u16* H;
  float* AFF;
  int* IDX;
  float* GATE;
  u16* WIN; u16* WOUT; u16* WPG; u16* WPP; u16* PB;
  u16* PGb;
  u16* EW1; u16* EW2;
  u16* XE; u16* YE;
  int* TCNT; int* TLIST;
  unsigned* CTR;
  unsigned* BAR;
};

constexpr int GBM = 256, GBN = 128, GBK = 64;
constexpr int AS_STRIDE = 72, BS_STRIDE = 136;
constexpr int AS_BYTES = GBM * AS_STRIDE * 2;
constexpr int BS_BYTES = GBK * BS_STRIDE * 2;
constexpr int SMEM_BYTES = 57344;

template <bool A_F32, int MODE, class ARow, class Epi>
DI void gemm_tile(ARow arow, const float* __restrict__ B, const float* __restrict__ B2, int ldb, int K, int n0, int Nvalid,
                  char* smem, Epi epi) {
  short* As = (short*)smem;
  short* Bs = (short*)(smem + AS_BYTES);
  const int tid = tidx(), lane = tid & 63, w = tid >> 6;
  const int wm = w >> 1, wn = w & 1;
  const int l15 = lane & 15, lq = lane >> 4;

  const char* ap[4];
#pragma unroll
  for (int i = 0; i < 4; ++i) {
    int u = tid + i * NTH; int row = u >> 3, kc = u & 7;
    ap[i] = (const char*)arow(row) + (size_t)kc * 8 * (A_F32 ? 4 : 2);
  }
  const float* bp[4]; bool bok[4];
#pragma unroll
  for (int i = 0; i < 4; ++i) {
    int u = tid + i * NTH; int k = u >> 5, nq = u & 31;
    int col; const float* base;
    if (MODE != 1) { col = n0 + nq * 4; base = B; }
    else { col = n0 + (nq & 15) * 4; base = (nq < 16) ? B : B2; }
    bok[i] = col < Nvalid;
    bp[i] = base + (size_t)k * ldb + (bok[i] ? col : 0);
  }

  f32x4 acc[4][4];
#pragma unroll
  for (int i = 0; i < 4; ++i)
#pragma unroll
    for (int j = 0; j < 4; ++j) acc[i][j] = f32x4{0.f, 0.f, 0.f, 0.f};

  u32x4 areg[4]; f32x4 breg[4];
#define GLOAD(kt_)                                                                                   \
  {                                                                                                  \
    _Pragma("unroll") for (int i = 0; i < 4; ++i) {                                                  \
      if (A_F32) {                                                                                   \
        const float4* q = (const float4*)(ap[i] + (size_t)(kt_) * GBK * 4);                          \
        float4 v0 = q[0], v1 = q[1];                                                                 \
        areg[i] = u32x4{pk2(v0.x, v0.y), pk2(v0.z, v0.w), pk2(v1.x, v1.y), pk2(v1.z, v1.w)};         \
      } else {                                                                                       \
        areg[i] = *(const u32x4*)(ap[i] + (size_t)(kt_) * GBK * 2);                                  \
      }                                                                                              \
    }                                                                                                \
    _Pragma("unroll") for (int i = 0; i < 4; ++i) {                                                  \
      if (bok[i]) breg[i] = *(const f32x4*)(bp[i] + (size_t)(kt_) * GBK * ldb);                      \
      else breg[i] = f32x4{0.f, 0.f, 0.f, 0.f};                                                      \
    }                                                                                                \
  }
  const int nk = K / GBK;
  GLOAD(0)
  for (int kt = 0; kt < nk; ++kt) {
    __syncthreads();
#pragma unroll
    for (int i = 0; i < 4; ++i) {
      int u = tid + i * NTH; int row = u >> 3, kc = u & 7;
      *(u32x4*)(As + row * AS_STRIDE + kc * 8) = areg[i];
    }
#pragma unroll
    for (int i = 0; i < 4; ++i) {
      int u = tid + i * NTH; int k = u >> 5, nq = u & 31;
      u32x2 v = u32x2{pk2(breg[i][0], breg[i][1]), pk2(breg[i][2], breg[i][3])};
      *(u32x2*)(Bs + k * BS_STRIDE + nq * 4) = v;
    }
    __syncthreads();
    if (kt + 1 < nk) GLOAD(kt + 1)
#pragma unroll
    for (int ks = 0; ks < 2; ++ks) {
      bf16x8 a[4], b[4];
#pragma unroll
      for (int mi = 0; mi < 4; ++mi)
        a[mi] = *(const bf16x8*)(As + (wm * 64 + mi * 16 + l15) * AS_STRIDE + ks * 32 + 8 * lq);
#pragma unroll
      for (int ni = 0; ni < 4; ++ni) {
        int col0 = (MODE != 1) ? (wn * 64 + ni * 16) : ((ni < 2) ? (wn * 32 + ni * 16) : (64 + wn * 32 + (ni - 2) * 16));
        int kb = ks * 32 + 8 * lq; int q = l15 >> 2, pp = l15 & 3;
        s16x4 lo = tr_read(Bs + (kb + q) * BS_STRIDE + col0 + 4 * pp);
        s16x4 hi = tr_read(Bs + (kb + 4 + q) * BS_STRIDE + col0 + 4 * pp);
        b[ni] = __builtin_shufflevector(lo, hi, 0, 1, 2, 3, 4, 5, 6, 7);
      }
#pragma unroll
      for (int mi = 0; mi < 4; ++mi)
#pragma unroll
        for (int ni = 0; ni < 4; ++ni)
          acc[mi][ni] = __builtin_amdgcn_mfma_f32_16x16x32_bf16(a[mi], b[ni], acc[mi][ni], 0, 0, 0);
    }
  }
  if constexpr (MODE == 2) { epi(acc, wm, wn, lq, l15); return; }
  else {
#pragma unroll
  for (int mi = 0; mi < 4; ++mi)
#pragma unroll
    for (int r = 0; r < 4; ++r) {
      int row = wm * 64 + mi * 16 + lq * 4 + r;
      if (MODE == 0) {
#pragma unroll
        for (int ni = 0; ni < 4; ++ni) {
          int col = n0 + wn * 64 + ni * 16 + l15;
          if (col < Nvalid) epi(row, col, acc[mi][ni][r], 0.f);
        }
      } else {
#pragma unroll
        for (int ni = 0; ni < 2; ++ni) {
          int col = n0 + wn * 32 + ni * 16 + l15;
          epi(row, col, acc[mi][ni][r], acc[mi][ni + 2][r]);
        }
      }
    }
  }
}

DI void ph_norm(const float* __restrict__ X, const float* __restrict__ g, u16* __restrict__ Hout) {
  const int tid_ = tidx(); const int lane = tid_ & 63, w = tid_ >> 6;
  for (int tok = blockIdx.x * 8 + w; tok < NTOK; tok += gridDim.x * 8) {
    const float4* xr = (const float4*)(X + (size_t)tok * DM);
    float4 v[4]; float ss = 0.f;
#pragma unroll
    for (int j = 0; j < 4; ++j) { v[j] = xr[lane + 64 * j]; ss += v[j].x * v[j].x + v[j].y * v[j].y + v[j].z * v[j].z + v[j].w * v[j].w; }
    ss = wave_sum(ss);
    float rstd = frsq(ss * (1.f / DM) + NORM_EPS);
#pragma unroll
    for (int j = 0; j < 4; ++j) {
      float4 gg = ((const float4*)g)[lane + 64 * j];
      uint2 o = uint2{pk2(v[j].x * rstd * gg.x, v[j].y * rstd * gg.y), pk2(v[j].z * rstd * gg.z, v[j].w * rstd * gg.w)};
      *(uint2*)(Hout + (size_t)tok * DM + (lane + 64 * j) * 4) = o;
    }
  }
}

DI void ph_final_norm(float* __restrict__ X, const float* __restrict__ g) {
  const int tid_ = tidx(); const int lane = tid_ & 63, w = tid_ >> 6;
  for (int tok = blockIdx.x * 8 + w; tok < NTOK; tok += gridDim.x * 8) {
    float4* xr = (float4*)(X + (size_t)tok * DM);
    float4 v[4]; float ss = 0.f;
#pragma unroll
    for (int j = 0; j < 4; ++j) { v[j] = xr[lane + 64 * j]; ss += v[j].x * v[j].x + v[j].y * v[j].y + v[j].z * v[j].z + v[j].w * v[j].w; }
    ss = wave_sum(ss);
    float rstd = frsq(ss * (1.f / DM) + NORM_EPS);
#pragma unroll
    for (int j = 0; j < 4; ++j) {
      float4 gg = ((const float4*)g)[lane + 64 * j];
      xr[lane + 64 * j] = float4{v[j].x * rstd * gg.x, v[j].y * rstd * gg.y, v[j].z * rstd * gg.z, v[j].w * rstd * gg.w};
    }
  }
}

template <bool A_F32, class Epi>
DI void ph_gemm(const void* A, int lda, const float* B, int ldb, int M, int N, int K, char* smem, Epi epi, int tfirst, int tstride) {
  const int ntn = (N + GBN - 1) / GBN, ntm = M / GBM;
  for (int t = tfirst; t < ntm * ntn; t += tstride) {
    int tm = t / ntn, tn = t % ntn;
    int m0 = tm * GBM, n0 = tn * GBN;
    auto arow = [&](int r) -> const void* { return (const char*)A + (size_t)(m0 + r) * lda * (A_F32 ? 4 : 2); };
    gemm_tile<A_F32, 0>(arow, B, nullptr, ldb, K, n0, N, smem, [&](int row, int col, float v, float) { epi(m0 + row, col, v); });
    __syncthreads();
  }
}

template <class Epi>
DI void ph_gemm_t(const void* A, int lda, const float* B, int ldb, int M, int N, int K, char* smem, Epi epi, int tfirst, int tstride) {
  const int ntn = (N + GBN - 1) / GBN, ntm = M / GBM;
  for (int t = tfirst; t < ntm * ntn; t += tstride) {
    int tm = t / ntn, tn = t % ntn;
    int m0 = tm * GBM, n0 = tn * GBN;
    auto arow = [&](int r) -> const void* { return (const char*)A + (size_t)(m0 + r) * lda * 2; };
    gemm_tile<false, 2>(arow, B, nullptr, ldb, K, n0, N, smem,
                        [&](const f32x4 (&acc)[4][4], int wm, int wn, int lq, int l15) { epi(acc, m0, n0, wm, wn, lq, l15); });
    __syncthreads();
  }
}

DI void ph_rwshift(const P& p, int layer) {
  const int tid_ = tidx();
  const int per = (NTOK + (int)gridDim.x - 1) / (int)gridDim.x;
  const int t0 = (int)blockIdx.x * per, t1 = (t0 + per < NTOK) ? t0 + per : NTOK;
  if (tid_ < RWC / 4 && t0 < t1) {
    const int c = tid_ * 4;
    const f32x4 m = *(const f32x4*)(p.rw_mu + layer * RWC + c);
    const float* zc = p.Z + c;
    const f32x4 zero = f32x4{0.f, 0.f, 0.f, 0.f};
    constexpr int U = 8;
    f32x4 w[U + 2];
    w[0] = (t0 > 0) ? *(const f32x4*)(zc + (size_t)(t0 - 1) * INC) : zero;
    w[1] = *(const f32x4*)(zc + (size_t)t0 * INC);
    for (int tb = t0; tb < t1; tb += U) {
#pragma unroll
      for (int u = 0; u < U; ++u) { const int tn = tb + u + 1; w[u + 2] = (tn < NTOK && tn <= t1) ? *(const f32x4*)(zc + (size_t)tn * INC) : zero; }
#pragma unroll
      for (int u = 0; u < U; ++u) {
        const int tok = tb + u;
        if (tok < t1) {
          const int t = tok % T;
          const f32x4 zm = (t > 0) ? w[u] : zero, zp = (t < T - 1) ? w[u + 2] : zero, z = w[u + 1];
          const f32x4 o = z + m * (0.5f * (zm + zp) - z);
          if (c < 512) *(f32x4*)(p.R + (size_t)tok * RWW + c) = o;
          else if (c < 1024) *(f32x4*)(p.K + (size_t)tok * RWW + (c - 512)) = o;
          else if (c < 1536) *(f32x4*)(p.V + (size_t)tok * RWW + (c - 1024)) = o;
          else if (c < 1664) {
            const int d = (c - 1536) >> 6, l = (c - 1536) & 63;
            *(u32x2*)(p.TWD + ((size_t)d * NTOK + tok) * 64 + l) = u32x2{pk2(ftanh(o[0]), ftanh(o[1])), pk2(ftanh(o[2]), ftanh(o[3]))};
          } else if (c < 1792) {
            const int d = (c - 1664) >> 6, l = (c - 1664) & 63;
            *(u32x2*)(p.AD + ((size_t)d * NTOK + tok) * 64 + l) = u32x2{pk2(o[0], o[1]), pk2(o[2], o[3])};
          } else {
            const int l = c - 1792;
            *(u32x2*)(p.SGD + (size_t)tok * 128 + l) = u32x2{pk2(sigmoidf_(o[0]), sigmoidf_(o[1])), pk2(sigmoidf_(o[2]), sigmoidf_(o[3]))};
          }
        }
      }
      w[0] = w[U]; w[1] = w[U + 1];
    }
  }
}

DI void rope_cs(int pos, int i, float& cs, float& sn) {
  const int i3 = i & 3, i2 = i >> 2;
  const float c4 = (i3 == 0) ? 1.0f : (i3 == 1) ? 0.5623413251903491f : (i3 == 2) ? 0.31622776601683794f : 0.1778279410038923f;
  const float p10 = (i2 == 0) ? 1.0f : (i2 == 1) ? 0.1f : (i2 == 2) ? 0.01f : 0.001f;
  float inv = c4 * p10;
  float ang = (float)pos * inv;
  double rev = (double)ang * 0.15915494309189535;
  rev -= floor(rev);
  float rf = (float)rev;
  sn = __builtin_amdgcn_sinf(rf);
  cs = __builtin_amdgcn_cosf(rf);
}

DI void ph_rope_table(const P& p) {
  for (int i = blockIdx.x * NTH + tidx(); i < NTOK * 16; i += gridDim.x * NTH) {
    float cs, sn; rope_cs(p.pos[i >> 4], i & 15, cs, sn);
    *(f32x2*)(p.ROPE + (size_t)i * 2) = f32x2{cs, sn};
  }
}
DI void ph_mlaprep1(const P& p, int layer) {
  const int tid_ = tidx(); const int lane = tid_ & 63, w = tid_ >> 6;
  const float* qn = p.mla_q_norm + layer * 256;
  const float* kvn = p.mla_kv_norm + layer * 128;
  for (int tok = blockIdx.x * 8 + w; tok < NTOK; tok += gridDim.x * 8) {
    const float* zr = p.Z + (size_t)tok * INC + RWC;
    float4 q = *(const float4*)(zr + lane * 4);
    float ss = wave_sum(q.x * q.x + q.y * q.y + q.z * q.z + q.w * q.w);
    float rstd = frsq(ss * (1.f / 256) + NORM_EPS);
    float4 g = *(const float4*)(qn + lane * 4);
    *(uint2*)(p.QDN + (size_t)tok * 256 + lane * 4) = uint2{pk2(q.x * rstd * g.x, q.y * rstd * g.y), pk2(q.z * rstd * g.z, q.w * rstd * g.w)};
    float2 kv = *(const float2*)(zr + 256 + lane * 2);
    float ss2 = wave_sum(kv.x * kv.x + kv.y * kv.y);
    float rstd2 = frsq(ss2 * (1.f / 128) + NORM_EPS);
    float2 g2 = *(const float2*)(kvn + lane * 2);
    *(unsigned*)(p.KVDN + (size_t)tok * 128 + lane * 2) = pk2(kv.x * rstd2 * g2.x, kv.y * rstd2 * g2.y);
    if (lane < 16) {
      float u1 = zr[384 + lane], u2 = zr[384 + 16 + lane];
      const f32x2 csn = *(const f32x2*)(p.ROPE + (size_t)tok * 32 + lane * 2);
      const u16 k1 = f2bf(u1 * csn[0] - u2 * csn[1]), k2 = f2bf(u1 * csn[1] + u2 * csn[0]);
      const int bb = tok / T, tt = tok % T;
#pragma unroll
      for (int h = 0; h < NH; ++h) {
        u16* ko = p.Kc + ((size_t)(bb * NH + h) * T + tt) * 96 + 64;
        ko[lane] = k1; ko[16 + lane] = k2;
      }
    }
  }
}

DI void ph_mlafinish(const P& p) {
  const int tid_ = tidx(); const int lane = tid_ & 63, w = tid_ >> 6;
  const float qs = 0.10206207261596577f * 1.4426950408889634f;
  for (int tok = blockIdx.x * 8 + w; tok < NTOK; tok += gridDim.x * 8) {
    int b = tok / T, t = tok % T;
    float cs = 0.f, sn = 0.f;
    if (lane < 16) rope_cs(p.pos[tok], lane, cs, sn);
    const float* qr = p.QRAW + (size_t)tok * 768;
    const float* kvr = p.KVRAW + (size_t)tok * 1024;
    const float* kr = p.KR + (size_t)tok * 32;
#pragma unroll
    for (int h = 0; h < NH; ++h) {
      size_t row = ((size_t)(b * NH + h) * T + t);
      u16* qo = p.Q + row * 96; u16* ko = p.Kc + row * 96; u16* vo = p.Vv + row * 64;
      qo[lane] = f2bf(qr[h * 96 + lane] * qs);
      ko[lane] = f2bf(kvr[h * 128 + lane]);
      vo[lane] = f2bf(kvr[h * 128 + 64 + lane]);
      if (lane < 16) {
        float u1 = qr[h * 96 + 64 + lane], u2 = qr[h * 96 + 80 + lane];
        qo[64 + lane] = f2bf((u1 * cs - u2 * sn) * qs);
        qo[80 + lane] = f2bf((u1 * sn + u2 * cs) * qs);
      }
      if (lane < 32) ko[64 + lane] = f2bf(kr[lane]);
    }
  }
}

using f32x16 = __attribute__((ext_vector_type(16))) float;
#define SBAR() __builtin_amdgcn_sched_barrier(0)
constexpr int AT_KSTR = 104;
constexpr int AT_KBYTES = 64 * AT_KSTR * 2;
constexpr int AT_VBYTES = 64 * 64 * 2;
constexpr float AT_THR = 8.f;
DI int crow(int r, int hi) { return (r & 3) + 8 * (r >> 2) + 4 * hi; }
DI int v_st(int k, int c) { const int kk = (k & ~0xC) | ((k & 4) << 1) | ((k & 8) >> 1); return ((kk >> 3) * 2 + (c >> 5)) * 512 + ((kk & 7) * 32 + (c & 31)) * 2; }
DI int v_rd_base(int lane) { return ((lane & 3) << 3) | (((lane >> 2) & 3) << 6) | (((lane >> 4) & 1) << 5) | (((lane >> 5) & 1) << 8); }
constexpr int v_rd_off(int d0, int ks, int half) { return d0 * 512 + ks * 2048 + half * 1024; }

DI void at_partialSM(f32x16& p0, f32x16& p1, float& m_reg, float& mn, float& alpha) {
  float pmax = p0[0];
#pragma unroll
  for (int r = 1; r < 16; ++r) pmax = fmaxf(pmax, p0[r]);
#pragma unroll
  for (int r = 0; r < 16; ++r) pmax = fmaxf(pmax, p1[r]);
  { auto rr = __builtin_amdgcn_permlane32_swap(__float_as_uint(pmax), __float_as_uint(pmax), false, false);
    pmax = fmaxf(__uint_as_float(rr[0]), __uint_as_float(rr[1])); }
  if (__builtin_expect(__all(pmax - m_reg <= AT_THR), 1)) { mn = m_reg; alpha = 1.f; }
  else { mn = fmaxf(m_reg, pmax); alpha = __builtin_amdgcn_exp2f(m_reg - mn); m_reg = mn; }
#pragma unroll
  for (int r = 0; r < 16; ++r) { p0[r] = p0[r] - mn; p1[r] = p1[r] - mn; }
#pragma unroll
  for (int r = 0; r < 16; ++r) p0[r] = __builtin_amdgcn_exp2f(p0[r]);
}
DI void at_finishSM(f32x16& p0, f32x16& p1, float alpha, float& l_reg, bf16x8& pa0, bf16x8& pa1, bf16x8& pa2, bf16x8& pa3) {
#pragma unroll
  for (int r = 0; r < 16; ++r) p1[r] = __builtin_amdgcn_exp2f(p1[r]);
  float ps = 0;
#pragma unroll
  for (int r = 0; r < 16; ++r) ps += p0[r];
#pragma unroll
  for (int r = 0; r < 16; ++r) ps += p1[r];
  { auto rr = __builtin_amdgcn_permlane32_swap(__float_as_uint(ps), __float_as_uint(ps), false, false);
    ps = __uint_as_float(rr[0]) + __uint_as_float(rr[1]); }
  l_reg = l_reg * alpha + ps;
#define PK4(PP, BASE, OUT) do { unsigned a0 = pk2(PP[BASE + 0], PP[BASE + 1]), a1 = pk2(PP[BASE + 2], PP[BASE + 3]);   \
    unsigned b0 = pk2(PP[BASE + 4], PP[BASE + 5]), b1 = pk2(PP[BASE + 6], PP[BASE + 7]);                              \
    auto r0 = __builtin_amdgcn_permlane32_swap(a0, b0, false, false); auto r1 = __builtin_amdgcn_permlane32_swap(a1, b1, false, false); \
    u32x4 wv = {r0[0], r1[0], r0[1], r1[1]}; OUT = __builtin_bit_cast(bf16x8, wv); } while (0)
  PK4(p0, 0, pa0); PK4(p0, 8, pa1); PK4(p1, 0, pa2); PK4(p1, 8, pa3);
#undef PK4
}
DI void at_qkt(f32x16& p0, f32x16& p1, const char* Kb, const bf16x8* qr, int r32, int hi) {
#pragma unroll
  for (int r = 0; r < 16; ++r) { p0[r] = 0.f; p1[r] = 0.f; }
#pragma unroll
  for (int d0 = 0; d0 < 6; ++d0) {
    bf16x8 b0 = *(const bf16x8*)(Kb + (r32 * AT_KSTR + d0 * 16 + hi * 8) * 2);
    bf16x8 b1 = *(const bf16x8*)(Kb + ((32 + r32) * AT_KSTR + d0 * 16 + hi * 8) * 2);
    __builtin_amdgcn_s_setprio(1);
    p0 = __builtin_amdgcn_mfma_f32_32x32x16_bf16(b0, qr[d0], p0, 0, 0, 0);
    p1 = __builtin_amdgcn_mfma_f32_32x32x16_bf16(b1, qr[d0], p1, 0, 0, 0);
    __builtin_amdgcn_s_setprio(0);
  }
}
template <int D0> DI void at_pv_one(f32x16& od, const char* vb, bf16x8 pa0, bf16x8 pa1, bf16x8 pa2, bf16x8 pa3) {
#define TRR(ks, half) tr_read((const short*)(vb + v_rd_off(D0, ks, half)))
  const s16x4 l0 = TRR(0, 0), h0 = TRR(0, 1), l1 = TRR(1, 0), h1 = TRR(1, 1), l2 = TRR(2, 0), h2 = TRR(2, 1), l3 = TRR(3, 0), h3 = TRR(3, 1);
#undef TRR
#define PKV(L, H) __builtin_shufflevector(L, H, 0, 1, 2, 3, 4, 5, 6, 7)
  __builtin_amdgcn_s_setprio(1);
  od = __builtin_amdgcn_mfma_f32_32x32x16_bf16(pa0, PKV(l0, h0), od, 0, 0, 0);
  od = __builtin_amdgcn_mfma_f32_32x32x16_bf16(pa1, PKV(l1, h1), od, 0, 0, 0);
  od = __builtin_amdgcn_mfma_f32_32x32x16_bf16(pa2, PKV(l2, h2), od, 0, 0, 0);
  od = __builtin_amdgcn_mfma_f32_32x32x16_bf16(pa3, PKV(l3, h3), od, 0, 0, 0);
  __builtin_amdgcn_s_setprio(0);
#undef PKV
}
DI void at_pv(f32x16* o, const char* vb, bf16x8 pa0, bf16x8 pa1, bf16x8 pa2, bf16x8 pa3) {
  at_pv_one<0>(o[0], vb, pa0, pa1, pa2, pa3); at_pv_one<1>(o[1], vb, pa0, pa1, pa2, pa3);
}

DI void attn_body(const u16* __restrict__ Qb, const u16* __restrict__ Kh, const u16* __restrict__ Vh, float* __restrict__ Ob, char* lds, int tid) {
  const int wid = tid >> 6, lane = tid & 63, r32 = lane & 31, hi = lane >> 5;
  char* V_lds = lds; char* K_lds = lds + 2 * AT_VBYTES;
  float* wsp = (float*)(lds + 2 * AT_VBYTES + 2 * AT_KBYTES) + wid * 64; float* li_l = wsp; float* al_l = wsp + 32;
  float m_reg = -1e30f, l_reg = 0.f; f32x16 o[2]; bf16x8 qr[6];
#pragma unroll
  for (int r = 0; r < 16; ++r) { o[0][r] = 0.f; o[1][r] = 0.f; }
  const u16* Qw = Qb + (size_t)(wid * 32 + r32) * 96 + hi * 8;
#pragma unroll
  for (int d0 = 0; d0 < 6; ++d0) qr[d0] = *(const bf16x8*)(Qw + d0 * 16);
  const int kid1 = (tid < 256) ? tid + 512 : tid;
  const int kst0 = ((tid / 12) * AT_KSTR + (tid % 12) * 8) * 2, kst1 = ((kid1 / 12) * AT_KSTR + (kid1 % 12) * 8) * 2;
  const int vst = v_st(tid >> 3, (tid & 7) * 8);
  const char* vb0 = V_lds + v_rd_base(lane);
  u32x4 sk0[2], sk1[2], sv0[2];
#define SLOAD(i, k0) do { sk0[i] = *(const u32x4*)(Kh + (size_t)(k0) * 96 + tid * 8); sk1[i] = *(const u32x4*)(Kh + (size_t)(k0) * 96 + kid1 * 8); \
    sv0[i] = *(const u32x4*)(Vh + (size_t)(k0) * 64 + tid * 8); } while (0)
#define SWRITE(b, i) do { *(u32x4*)(K_lds + (b) * AT_KBYTES + kst0) = sk0[i]; if (tid < 256) *(u32x4*)(K_lds + (b) * AT_KBYTES + kst1) = sk1[i]; \
    *(u32x4*)(V_lds + (b) * AT_VBYTES + vst) = sv0[i]; } while (0)
#define SWAIT() asm volatile("s_waitcnt vmcnt(3)" ::: "memory")
#define RESC(a) do { if (__any((a) < 1.f)) { if (hi == 0) al_l[r32] = (a); asm volatile("s_waitcnt lgkmcnt(0)" ::: "memory"); \
    _Pragma("unroll") for (int r = 0; r < 16; ++r) { float al = al_l[crow(r, hi)]; o[0][r] *= al; o[1][r] *= al; } } } while (0)
  f32x16 pA0, pA1, pB0, pB1; float mnA, mnB, alA, alB; bf16x8 pa0, pa1, pa2, pa3; constexpr int NT = T / 64;
  SLOAD(0, 0); SWRITE(0, 0); __syncthreads();
  at_qkt(pA0, pA1, K_lds, qr, r32, hi); at_partialSM(pA0, pA1, m_reg, mnA, alA);
  SLOAD(1, 64); SLOAD(0, 128);
  SWAIT(); SWRITE(1, 1); __syncthreads();
  for (int j = 1; j + 1 < NT; j += 2) {
    SBAR(); at_qkt(pB0, pB1, K_lds + AT_KBYTES, qr, r32, hi);
    at_finishSM(pA0, pA1, alA, l_reg, pa0, pa1, pa2, pa3); SBAR();
    SLOAD(1, (j + 2) * 64); SBAR();
    at_pv(o, vb0, pa0, pa1, pa2, pa3); at_partialSM(pB0, pB1, m_reg, mnB, alB);
    __syncthreads(); SWAIT(); SWRITE(0, 0);
    RESC(alB); __syncthreads();
    SBAR(); at_qkt(pA0, pA1, K_lds, qr, r32, hi);
    at_finishSM(pB0, pB1, alB, l_reg, pa0, pa1, pa2, pa3); SBAR();
    if (j + 3 < NT) SLOAD(0, (j + 3) * 64); SBAR();
    at_pv(o, vb0 + AT_VBYTES, pa0, pa1, pa2, pa3); at_partialSM(pA0, pA1, m_reg, mnA, alA);
    __syncthreads(); SWAIT(); SWRITE(1, 1);
    RESC(alA); __syncthreads();
  }
  SBAR(); at_qkt(pB0, pB1, K_lds + AT_KBYTES, qr, r32, hi);
  at_finishSM(pA0, pA1, alA, l_reg, pa0, pa1, pa2, pa3); SBAR();
  at_pv(o, vb0, pa0, pa1, pa2, pa3); at_partialSM(pB0, pB1, m_reg, mnB, alB);
  __syncthreads(); RESC(alB);
  at_finishSM(pB0, pB1, alB, l_reg, pa0, pa1, pa2, pa3); SBAR();
  at_pv(o, vb0 + AT_VBYTES, pa0, pa1, pa2, pa3);
  if (hi == 0) li_l[r32] = l_reg;
  asm volatile("s_waitcnt lgkmcnt(0)" ::: "memory");
  float* Ow = Ob + (size_t)(wid * 32) * 512;
#pragma unroll
  for (int r = 0; r < 16; ++r) {
    int orow = crow(r, hi); float rl = __builtin_amdgcn_rcpf(li_l[orow]);
    Ow[(size_t)orow * 512 + r32] = o[0][r] * rl; Ow[(size_t)orow * 512 + 32 + r32] = o[1][r] * rl;
  }
#undef SLOAD
#undef SWRITE
#undef SWAIT
#undef RESC
}

DI void ph_attn(const P& p, char* smem, unsigned* ctr) {
  const int tid = tidx();
  int* sitem = (int*)(smem + SMEM_BYTES - 16);
  for (;;) {
    __syncthreads();
    if (tid == 0) *sitem = (int)atomicAdd(ctr, 1u);
    __syncthreads();
    const int item = *sitem;
    if (item >= NB * NH * (T / 256)) break;
    const int bh = item / (T / 256), qb = item % (T / 256);
    const int b = bh / NH, h = bh % NH;
    attn_body(p.Q + ((size_t)bh * T + qb * 256) * 96, p.Kc + (size_t)bh * T * 96, p.Vv + (size_t)bh * T * 64,
              p.AO + ((size_t)(b * T + qb * 256)) * 512 + h * 64, smem, tid);
  }
}

constexpr int SC = 256, NCH = T / SC;
constexpr int SBUF = 5184;
template <int NI> struct ScanRegsN { float k[2 * NI], r[2 * NI], v[2 * NI]; u16 lw[2 * NI], a[2 * NI]; };
template <int NI>
DI void scan_load_n(const P& p, int b, int h, int d, int n0, int lane, int ws, ScanRegsN<NI>& g) {
  constexpr int WPI = 8 / NI;
  const u16* LWd = p.LW + (size_t)d * NTOK * RWW;
  const u16* AAd = p.AA + (size_t)d * NTOK * RWW;
  const int ch = h * 64 + lane;
#pragma unroll
  for (int jj = 0; jj < 2 * NI; ++jj) {
    int n = n0 + ws + WPI * jj; int t = d ? (T - 1 - n) : n;
    size_t off = ((size_t)(b * T + t)) * RWW + ch;
    g.k[jj] = p.K[off]; g.r[jj] = p.R[off]; g.v[jj] = p.V[off]; g.lw[jj] = LWd[off]; g.a[jj] = AAd[off];
  }
}
template <int NI>
DI void scan_put_n(const ScanRegsN<NI>& g, float kkc, float kac, float* sm, float* slw, int lane, int ws) {
  constexpr int WPI = 8 / NI;
#pragma unroll
  for (int jj = 0; jj < 2 * NI; ++jj) slw[(ws + WPI * jj) * 64 + lane] = bf2f(g.lw[jj]);
  __syncthreads();
  float Lj[2 * NI];
#pragma unroll
  for (int jj = 0; jj < 2 * NI; ++jj) Lj[jj] = 0.f;
#pragma unroll
  for (int i = 0; i < 16; ++i) {
    const float x = slw[i * 64 + lane];
#pragma unroll
    for (int jj = 0; jj < 2 * NI; ++jj) Lj[jj] += (i <= ws + WPI * jj) ? x : 0.f;
  }
#pragma unroll
  for (int jj = 0; jj < 2 * NI; ++jj) {
    const int j = ws + WPI * jj;
    const float L = Lj[jj], lwj = bf2f(g.lw[jj]);
    const float Pt = fexp(L), Pm = fexp(L - lwj), iP = fexp(-L);
    const float kv = g.k[jj];
    const float kx = kv * kkc;
    const float nrm = __builtin_amdgcn_sqrtf(wave_sum(kx * kx));
    const float kkv = kx * frcp(fmaxf(nrm, 1e-12f));
    const float a = bf2f(g.a[jj]);
    sm[j * 64 + lane] = -kkv * Pm;
    sm[1024 + j * 64 + lane] = a * kkv * iP;
    sm[2048 + j * 64 + lane] = kv * (1.f + (a - 1.f) * kac) * iP;
    sm[3072 + j * 64 + lane] = g.r[jj] * Pt;
    sm[4096 + j * 64 + lane] = g.v[jj];
    if (j == 15) sm[5120 + lane] = Pt;
  }
}
using f32x16s = __attribute__((ext_vector_type(16))) float;
DI void scan_ld8(f32x4 (&kv)[8], const float* vec, int hi) {
#pragma unroll
  for (int tk = 0; tk < 2; ++tk)
#pragma unroll
    for (int q = 0; q < 4; ++q) kv[tk * 4 + q] = *(const f32x4*)(vec + 32 * tk + 8 * q + 4 * hi);
}
DI float scan_dot8(const f32x16s (&acc)[2], const f32x4 (&kv)[8]) {
  float pq[4] = {0.f, 0.f, 0.f, 0.f};
#pragma unroll
  for (int tk = 0; tk < 2; ++tk)
#pragma unroll
    for (int e = 0; e < 4; ++e)
#pragma unroll
      for (int q = 0; q < 4; ++q) { pq[q] = __builtin_fmaf(acc[tk][4 * q + e], kv[tk * 4 + q][e], pq[q]); asm("" : "+v"(pq[q])); }
  return red_x32((pq[0] + pq[1]) + (pq[2] + pq[3]));
}

DI void ph_scan1(const P& p, int layer, char* smem) {
  constexpr int NI = 2;
  const int tid = tidx(), lane = tid & 63, w = tid >> 6;
  const int jl = lane & 31, hi = lane >> 5;
  const int it = w >> 2, vt = w & 3, ws = w & 3;
  float* smi = (float*)smem + it * (2 * SBUF + 1024);
  float* slw = smi + 2 * SBUF;
  for (int pair = blockIdx.x; pair < 32 * NCH / 2; pair += gridDim.x) {
    const int item = pair * 2 + it; const int scan = item / NCH, c = item % NCH;
    const int d = scan & 1, h = (scan >> 1) % NH, b = scan / (2 * NH);
    const float kkc = p.rw_k_k[layer * RWW + h * 64 + lane], kac = p.rw_k_a[layer * RWW + h * 64 + lane];
    f32x16s acc[2];
#pragma unroll
    for (int tk = 0; tk < 2; ++tk)
#pragma unroll
      for (int r = 0; r < 16; ++r) acc[tk][r] = (32 * tk + (r & 3) + 8 * (r >> 2) + 4 * hi == 32 * vt + jl) ? 1.f : 0.f;
    ScanRegsN<NI> g;
    scan_load_n<NI>(p, b, h, d, c * SC, lane, ws, g);
    __syncthreads();
    scan_put_n<NI>(g, kkc, kac, smi, slw, lane, ws);
    __syncthreads();
    for (int sub = 0; sub < SC / 16; ++sub) {
      const float* sm = smi + (sub & 1) * SBUF;
      if (sub + 1 < SC / 16) scan_load_n<NI>(p, b, h, d, c * SC + (sub + 1) * 16, lane, ws, g);
      const float* vrow = sm + 4096 + ((vt >= 2) ? 32 * (vt - 2) : 0) + jl;
      f32x4 kc[8]; scan_ld8(kc, sm, hi);
      float a0 = sm[1024 + hi * 1024 + jl], a1 = sm[1024 + hi * 1024 + 32 + jl], vc = vrow[0];
#pragma unroll 4
      for (int j = 0; j < 16; ++j) {
        const int jn = (j + 1) & 15;
        f32x4 kn[8]; scan_ld8(kn, sm + jn * 64, hi);
        const float an0 = sm[1024 + hi * 1024 + jn * 64 + jl], an1 = sm[1024 + hi * 1024 + jn * 64 + 32 + jl], vn = vrow[jn * 64];
        SBAR();
        const float sa = scan_dot8(acc, kc);
        const float bop = hi ? ((vt >= 2) ? vc : 0.f) : sa;
        acc[0] = __builtin_amdgcn_mfma_f32_32x32x2f32(a0, bop, acc[0], 0, 0, 0);
        acc[1] = __builtin_amdgcn_mfma_f32_32x32x2f32(a1, bop, acc[1], 0, 0, 0);
        SBAR();
#pragma unroll
        for (int i = 0; i < 8; ++i) kc[i] = kn[i];
        a0 = an0; a1 = an1; vc = vn;
      }
#pragma unroll
      for (int tk = 0; tk < 2; ++tk)
#pragma unroll
        for (int q = 0; q < 4; ++q) {
          const f32x4 pv = *(const f32x4*)(sm + 5120 + 32 * tk + 8 * q + 4 * hi);
#pragma unroll
          for (int e = 0; e < 4; ++e) acc[tk][4 * q + e] *= pv[e];
        }
      if (sub + 1 < SC / 16) scan_put_n<NI>(g, kkc, kac, smi + ((sub + 1) & 1) * SBUF, slw, lane, ws);
      __syncthreads();
    }
    {
      const int v = 32 * vt + jl;
      float* dst = ((v < 64) ? p.MC : p.NC) + (((size_t)scan * NCH + c) * 64 + (v & 63)) * 64;
#pragma unroll
      for (int tk = 0; tk < 2; ++tk)
#pragma unroll
        for (int q = 0; q < 4; ++q)
          *(f32x4*)(dst + 32 * tk + 8 * q + 4 * hi) = f32x4{acc[tk][4 * q], acc[tk][4 * q + 1], acc[tk][4 * q + 2], acc[tk][4 * q + 3]};
    }
  }
}


DI void ph_scan2(const P& p, char* smem) {
  constexpr int LS = 72;
  u16* Sh = (u16*)smem; u16* Sl = Sh + 64 * LS; u16* Mh = Sl + 64 * LS; u16* Ml = Mh + 64 * LS;
  const int tid = tidx(), lane = tid & 63, w = tid >> 6;
  const int l15 = lane & 15, lq = lane >> 4;
  const int ti = w >> 1, tj0 = (w & 1) * 2;
  for (int scan = blockIdx.x; scan < 32; scan += gridDim.x) {
    const float* Mg = p.MC + (size_t)scan * NCH * 4096;
    const float* Ng = p.NC + (size_t)scan * NCH * 4096;
    float* Sg = p.SS + (size_t)scan * NCH * 4096;
    struct MN { f32x4 m0, m1, n[2]; };
    auto ldmn = [&](MN& r, int c) {
      const int cc = (c < NCH) ? c : (NCH - 1);
      r.m0 = *(const f32x4*)(Mg + (size_t)cc * 4096 + tid * 8); r.m1 = *(const f32x4*)(Mg + (size_t)cc * 4096 + tid * 8 + 4);
#pragma unroll
      for (int q = 0; q < 2; ++q)
#pragma unroll
        for (int r4 = 0; r4 < 4; ++r4) r.n[q][r4] = Ng[(size_t)cc * 4096 + (ti * 16 + lq * 4 + r4) * 64 + (tj0 + q) * 16 + l15];
    };
    f32x4 sacc[2];
    sacc[0] = f32x4{0.f, 0.f, 0.f, 0.f}; sacc[1] = sacc[0];
    auto step = [&](int c, const MN& r) {
      __syncthreads();
#pragma unroll
      for (int q = 0; q < 2; ++q)
#pragma unroll
        for (int r4 = 0; r4 < 4; ++r4) {
          const int row = ti * 16 + lq * 4 + r4, col = (tj0 + q) * 16 + l15;
          const float x = sacc[q][r4];
          Sg[(size_t)c * 4096 + row * 64 + col] = x;
          const u16 h = f2bf(x); Sh[row * LS + col] = h; Sl[row * LS + col] = f2bf(x - bf2f(h));
        }
      {
        const int mr = tid >> 3, mc = (tid & 7) * 8;
        float xh[8], xl[8];
#pragma unroll
        for (int i = 0; i < 8; ++i) { const float x = (i < 4) ? r.m0[i & 3] : r.m1[i & 3]; const float h = bf2f(f2bf(x)); xh[i] = h; xl[i] = x - h; }
        *(u32x4*)(Mh + mr * LS + mc) = u32x4{pk2(xh[0], xh[1]), pk2(xh[2], xh[3]), pk2(xh[4], xh[5]), pk2(xh[6], xh[7])};
        *(u32x4*)(Ml + mr * LS + mc) = u32x4{pk2(xl[0], xl[1]), pk2(xl[2], xl[3]), pk2(xl[4], xl[5]), pk2(xl[6], xl[7])};
      }
      f32x4 acc[2] = {r.n[0], r.n[1]};
      __syncthreads();
#pragma unroll
      for (int ks = 0; ks < 2; ++ks) {
        const bf16x8 ah = *(const bf16x8*)(Sh + (ti * 16 + l15) * LS + ks * 32 + 8 * lq);
        const bf16x8 al = *(const bf16x8*)(Sl + (ti * 16 + l15) * LS + ks * 32 + 8 * lq);
#pragma unroll
        for (int q = 0; q < 2; ++q) {
          const int kb = ks * 32 + 8 * lq, tq = l15 >> 2, tp = l15 & 3, co = (tj0 + q) * 16 + 4 * tp;
          const bf16x8 bh = __builtin_shufflevector(tr_read((const short*)Mh + (kb + tq) * LS + co), tr_read((const short*)Mh + (kb + 4 + tq) * LS + co), 0, 1, 2, 3, 4, 5, 6, 7);
          const bf16x8 bl = __builtin_shufflevector(tr_read((const short*)Ml + (kb + tq) * LS + co), tr_read((const short*)Ml + (kb + 4 + tq) * LS + co), 0, 1, 2, 3, 4, 5, 6, 7);
          acc[q] = __builtin_amdgcn_mfma_f32_16x16x32_bf16(ah, bh, acc[q], 0, 0, 0);
          acc[q] = __builtin_amdgcn_mfma_f32_16x16x32_bf16(ah, bl, acc[q], 0, 0, 0);
          acc[q] = __builtin_amdgcn_mfma_f32_16x16x32_bf16(al, bh, acc[q], 0, 0, 0);
        }
      }
      sacc[0] = acc[0]; sacc[1] = acc[1];
    };
    MN r0, r1, r2, r3;
    ldmn(r0, 0); ldmn(r1, 1); ldmn(r2, 2);
    for (int c = 0; c < NCH; c += 4) {
      ldmn(r3, c + 3); step(c, r0);
      ldmn(r0, c + 4); step(c + 1, r1);
      ldmn(r1, c + 5); step(c + 2, r2);
      ldmn(r2, c + 6); step(c + 3, r3);
    }
    __syncthreads();
  }
}

DI void ph_scan3(const P& p, int layer, char* smem) {
  constexpr int NI = 4;
  const int tid = tidx(), lane = tid & 63, w = tid >> 6;
  const int jl = lane & 31, hi = lane >> 5;
  const int it = w >> 1, vt = w & 1, ws = w & 1;
  float* sm = (float*)smem + it * (SBUF + 2048);
  float* slw = sm + SBUF; float* so = slw + 1024;
  const float* lwp = p.rw_lnx_w + layer * RWW; const float* lbp = p.rw_lnx_b + layer * RWW; const float* rkp = p.rw_r_k + layer * RWW;
  constexpr int TQ = 2 * SC;
  for (int quad = blockIdx.x; quad < NB * NH * (T / TQ); quad += gridDim.x) {
    const int bh = quad / (T / TQ), tb = quad % (T / TQ);
    const int d = it >> 1, kch = 2 * tb + (it & 1), c = d ? (NCH - 1 - kch) : kch;
    const int h = bh % NH, b = bh / NH, scan = bh * 2 + d;
    const float kkc = p.rw_k_k[layer * RWW + h * 64 + lane], kac = p.rw_k_a[layer * RWW + h * 64 + lane];
    u16* Od = p.O2 + (size_t)d * NTOK * RWW;
    f32x16s acc[2];
    {
      const float* Sg = p.SS + ((size_t)scan * NCH + c) * 4096 + (size_t)(32 * vt + jl) * 64;
#pragma unroll
      for (int tk = 0; tk < 2; ++tk)
#pragma unroll
        for (int q = 0; q < 4; ++q) {
          const f32x4 sv = *(const f32x4*)(Sg + 32 * tk + 8 * q + 4 * hi);
#pragma unroll
          for (int e = 0; e < 4; ++e) acc[tk][4 * q + e] = sv[e];
        }
    }
    ScanRegsN<NI> g;
    scan_load_n<NI>(p, b, h, d, c * SC, lane, ws, g);
    for (int sub = 0; sub < SC / 16; ++sub) {
      const int n0 = c * SC + sub * 16;
      __syncthreads();
      scan_put_n<NI>(g, kkc, kac, sm, slw, lane, ws);
      __syncthreads();
      if (sub + 1 < SC / 16) scan_load_n<NI>(p, b, h, d, n0 + 16, lane, ws, g);
      const float* vrow = sm + 4096 + 32 * vt + jl;
      f32x4 kc[8]; scan_ld8(kc, sm, hi);
      float a0 = sm[1024 + hi * 1024 + jl], a1 = sm[1024 + hi * 1024 + 32 + jl], vc = vrow[0];
#pragma unroll 4
      for (int j = 0; j < 16; ++j) {
        const int jn = (j + 1) & 15;
        f32x4 kn[8]; scan_ld8(kn, sm + jn * 64, hi);
        const float an0 = sm[1024 + hi * 1024 + jn * 64 + jl], an1 = sm[1024 + hi * 1024 + jn * 64 + 32 + jl], vn = vrow[jn * 64];
        SBAR();
        const float sa = scan_dot8(acc, kc);
        const float bop = hi ? vc : sa;
        acc[0] = __builtin_amdgcn_mfma_f32_32x32x2f32(a0, bop, acc[0], 0, 0, 0);
        acc[1] = __builtin_amdgcn_mfma_f32_32x32x2f32(a1, bop, acc[1], 0, 0, 0);
        f32x4 rc[8]; scan_ld8(rc, sm + 3072 + j * 64, hi);
        SBAR();
        const float o = scan_dot8(acc, rc);
        if (hi == 0) so[j * 64 + 32 * vt + jl] = o;
        SBAR();
#pragma unroll
        for (int i = 0; i < 8; ++i) kc[i] = kn[i];
        a0 = an0; a1 = an1; vc = vn;
      }
#pragma unroll
      for (int tk = 0; tk < 2; ++tk)
#pragma unroll
        for (int q = 0; q < 4; ++q) {
          const f32x4 pv = *(const f32x4*)(sm + 5120 + 32 * tk + 8 * q + 4 * hi);
#pragma unroll
          for (int e = 0; e < 4; ++e) acc[tk][4 * q + e] *= pv[e];
        }
      __syncthreads();
#pragma unroll
      for (int jj = 0; jj < 8; ++jj) {
        const int j = ws + 2 * jj; const int n = n0 + j; const int t = d ? (T - 1 - n) : n;
        Od[((size_t)(b * T + t)) * RWW + h * 64 + lane] = f2bf(so[j * 64 + lane]);
      }
    }
    asm volatile("s_waitcnt vmcnt(0)" ::: "memory");
    __syncthreads();
    {
      const int ch = h * 64 + lane;
      const float plw = lwp[ch], plb = lbp[ch], prk = rkp[ch];
      for (int i0 = 0; i0 < TQ / 8; i0 += 2) {
        float o[2], k[2], r[2], vv[2], a0[2], a1[2], gg[2];
#pragma unroll
        for (int u = 0; u < 2; ++u) {
          const size_t off = (size_t)(b * T + tb * TQ + w * (TQ / 8) + i0 + u) * RWW + ch;
          o[u] = bf2f(p.O2[off]) + bf2f(p.O2[(size_t)NTOK * RWW + off]);
          k[u] = p.K[off]; r[u] = p.R[off]; vv[u] = p.V[off];
          a0[u] = bf2f(p.AA[off]); a1[u] = bf2f(p.AA[(size_t)NTOK * RWW + off]); gg[u] = bf2f(p.G[off]);
        }
#pragma unroll
        for (int u = 0; u < 2; ++u) {
          const float mean = wave_sum(o[u]) * (1.f / 64);
          const float dv = o[u] - mean;
          const float var = wave_sum(dv * dv) * (1.f / 64);
          const float kb = 0.5f * (k[u] * (1.f + (a0[u] - 1.f) * kac) + k[u] * (1.f + (a1[u] - 1.f) * kac));
          const float sb = wave_sum(r[u] * kb * prk);
          const float on_ = dv * frsq(var + GN_EPS) * plw + plb;
          p.H[(size_t)(b * T + tb * TQ + w * (TQ / 8) + i0 + u) * DM + ch] = f2bf((on_ + sb * vv[u]) * gg[u]);
        }
      }
    }
  }
}
DI void ph_mla_norm(const P& p, int layer) {
  const int tid_ = tidx(); const int lane = tid_ & 63, w = tid_ >> 6;
  const float* on = p.mla_o_norm + layer * 512;
  const f32x4 g0 = *(const f32x4*)(on + lane * 4), g1 = *(const f32x4*)(on + 256 + lane * 4);
  for (int tok = blockIdx.x * 8 + w; tok < NTOK; tok += gridDim.x * 8) {
    const float* ao = p.AO + (size_t)tok * 512;
    const f32x4 v0 = *(const f32x4*)(ao + lane * 4), v1 = *(const f32x4*)(ao + 256 + lane * 4);
    float ss = v0[0] * v0[0] + v0[1] * v0[1] + v0[2] * v0[2] + v0[3] * v0[3] + v1[0] * v1[0] + v1[1] * v1[1] + v1[2] * v1[2] + v1[3] * v1[3];
    ss = wave_sum(ss);
    const float rstd = frsq(ss * (1.f / 512) + NORM_EPS);
    *(u32x2*)(p.H + (size_t)tok * DM + 512 + lane * 4) = u32x2{pk2(v0[0] * rstd * g0[0], v0[1] * rstd * g0[1]), pk2(v0[2] * rstd * g0[2], v0[3] * rstd * g0[3])};
    *(u32x2*)(p.H + (size_t)tok * DM + 768 + lane * 4) = u32x2{pk2(v1[0] * rstd * g1[0], v1[1] * rstd * g1[1]), pk2(v1[2] * rstd * g1[2], v1[3] * rstd * g1[3])};
  }
}


DI void ph_mixfinish(const P& p, int layer) {
  const int tid_ = tidx(); const int lane = tid_ & 63, w = tid_ >> 6;
  const float* lw = p.rw_lnx_w + layer * RWW; const float* lb = p.rw_lnx_b + layer * RWW;
  const float* kac = p.rw_k_a + layer * RWW; const float* rk = p.rw_r_k + layer * RWW;
  const float* on = p.mla_o_norm + layer * 512;
  float plw[8], plb[8], pka[8], prk[8];
#pragma unroll
  for (int h = 0; h < NH; ++h) { int c = h * 64 + lane; plw[h] = lw[c]; plb[h] = lb[c]; pka[h] = kac[c]; prk[h] = rk[c]; }
  const f32x4 g0 = *(const f32x4*)(on + lane * 4), g1 = *(const f32x4*)(on + 256 + lane * 4);
  for (int tok = blockIdx.x * 8 + w; tok < NTOK; tok += gridDim.x * 8) {
    float o[8], k[8], r[8], vv[8], a0[8], a1[8], gg[8];
#pragma unroll
    for (int h = 0; h < NH; ++h) {
      size_t off = (size_t)tok * RWW + h * 64 + lane;
      o[h] = bf2f(p.O2[off]) + bf2f(p.O2[(size_t)NTOK * RWW + off]);
      k[h] = p.K[off]; r[h] = p.R[off]; vv[h] = p.V[off];
      a0[h] = bf2f(p.AA[off]); a1[h] = bf2f(p.AA[(size_t)NTOK * RWW + off]); gg[h] = bf2f(p.G[off]);
    }
    const float* ao = p.AO + (size_t)tok * 512;
    const f32x4 v0 = *(const f32x4*)(ao + lane * 4), v1 = *(const f32x4*)(ao + 256 + lane * 4);
    float mean[8], var[8], sb[8];
#pragma unroll
    for (int h = 0; h < NH; ++h) mean[h] = wave_sum(o[h]) * (1.f / 64);
#pragma unroll
    for (int h = 0; h < NH; ++h) { float dv = o[h] - mean[h]; o[h] = dv; var[h] = wave_sum(dv * dv) * (1.f / 64); }
#pragma unroll
    for (int h = 0; h < NH; ++h) {
      float kb = 0.5f * (k[h] * (1.f + (a0[h] - 1.f) * pka[h]) + k[h] * (1.f + (a1[h] - 1.f) * pka[h]));
      sb[h] = wave_sum(r[h] * kb * prk[h]);
    }
#pragma unroll
    for (int h = 0; h < NH; ++h) {
      float on_ = o[h] * frsq(var[h] + GN_EPS) * plw[h] + plb[h];
      float y = (on_ + sb[h] * vv[h]) * gg[h];
      p.H[(size_t)tok * DM + h * 64 + lane] = f2bf(y);
    }
    float ss = v0[0] * v0[0] + v0[1] * v0[1] + v0[2] * v0[2] + v0[3] * v0[3] + v1[0] * v1[0] + v1[1] * v1[1] + v1[2] * v1[2] + v1[3] * v1[3];
    ss = wave_sum(ss);
    float rstd = frsq(ss * (1.f / 512) + NORM_EPS);
    *(u32x2*)(p.H + (size_t)tok * DM + 512 + lane * 4) = u32x2{pk2(v0[0] * rstd * g0[0], v0[1] * rstd * g0[1]), pk2(v0[2] * rstd * g0[2], v0[3] * rstd * g0[3])};
    *(u32x2*)(p.H + (size_t)tok * DM + 768 + lane * 4) = u32x2{pk2(v1[0] * rstd * g1[0], v1[1] * rstd * g1[1]), pk2(v1[2] * rstd * g1[2], v1[3] * rstd * g1[3])};
  }
}

DI void ph_norm_router(const P& p, int layer, char* smem) {
  const int tid_ = tidx(); const int lane = tid_ & 63, w = tid_ >> 6;
  float* rtl = (float*)smem;
  float* hl = (float*)(smem + 65536) + w * 1024;
  const float* g = p.ffn_norm + layer * DM;
  const float* rt = p.router + (size_t)layer * DM * NE;
  __syncthreads();
#pragma unroll
  for (int i = 0; i < 8; ++i) *(f32x4*)(rtl + (tid_ + i * NTH) * 4) = *(const f32x4*)(rt + (tid_ + i * NTH) * 4);
  __syncthreads();
  const int cg = lane >> 2, eq = lane & 3;
  for (int tok = blockIdx.x * 8 + w; tok < NTOK; tok += gridDim.x * 8) {
    const f32x4* xr = (const f32x4*)(p.out + (size_t)tok * DM);
    f32x4 v[4]; float ss = 0.f;
#pragma unroll
    for (int j = 0; j < 4; ++j) { v[j] = xr[lane + 64 * j]; ss += v[j][0] * v[j][0] + v[j][1] * v[j][1] + v[j][2] * v[j][2] + v[j][3] * v[j][3]; }
    ss = wave_sum(ss);
    const float rstd = frsq(ss * (1.f / DM) + NORM_EPS);
#pragma unroll
    for (int j = 0; j < 4; ++j) {
      const int c0 = (lane + 64 * j) * 4;
      const f32x4 gg = *(const f32x4*)(g + c0);
      const f32x4 hv = v[j] * rstd * gg;
      *(u32x2*)(p.H + (size_t)tok * DM + c0) = u32x2{pk2(hv[0], hv[1]), pk2(hv[2], hv[3])};
      *(f32x4*)(hl + c0) = hv;
    }
    f32x4 acc = f32x4{0.f, 0.f, 0.f, 0.f};
#pragma unroll 16
    for (int i = 0; i < 64; ++i) {
      const float hv = hl[cg + 16 * i];
      const f32x4 r4 = *(const f32x4*)(rtl + (cg + 16 * i) * 16 + eq * 4);
      acc += hv * r4;
    }
#pragma unroll
    for (int e = 0; e < 4; ++e) {
      float a = acc[e];
      a += dpp_f<0x124>(a); a += dpp_f<0x128>(a);
      a = red_x32(red_x16(a));
      acc[e] = a;
    }
    float mx = fmaxf(fmaxf(acc[0], acc[1]), fmaxf(acc[2], acc[3]));
    mx = fmaxf(mx, dpp_f<0xB1>(mx)); mx = fmaxf(mx, dpp_f<0x4E>(mx));
    f32x4 ex; float se = 0.f;
#pragma unroll
    for (int e = 0; e < 4; ++e) { ex[e] = fexp(acc[e] - mx); se += ex[e]; }
    se = red_x2(red_x1(se));
    const float inv = frcp(se);
    const int b = tok / T, t = tok % T;
    if (lane < 4) {
#pragma unroll
      for (int e = 0; e < 4; ++e) p.AFF[((size_t)(b * NE + eq * 4 + e)) * T + t] = ex[e] * inv;
    }
  }
}

DI void ph_topk(const P& p, char* smem) {
  unsigned* hist = (unsigned*)smem;
  unsigned* sc = hist + 256;
  unsigned* bc = sc + 2048;
  const int tid = tidx();
  for (int item = blockIdx.x; item < NB * NE; item += gridDim.x) {
    const float* a = p.AFF + (size_t)item * T;
    unsigned key[16];
#pragma unroll
    for (int i = 0; i < 4; ++i) {
      uint4 v = *(const uint4*)(a + tid * 16 + i * 4);
      key[i * 4 + 0] = v.x; key[i * 4 + 1] = v.y; key[i * 4 + 2] = v.z; key[i * 4 + 3] = v.w;
    }
    unsigned prefix = 0, mask = 0, need = CAP;
    for (int pass = 0; pass < 4; ++pass) {
      int shift = 24 - 8 * pass;
      __syncthreads();
      if (tid < 256) hist[tid] = 0;
      __syncthreads();
#pragma unroll
      for (int i = 0; i < 16; ++i)
        if ((key[i] & mask) == prefix) atomicAdd(&hist[(key[i] >> shift) & 255u], 1u);
      __syncthreads();
      if (tid == 0) {
        unsigned cum = 0; int bsel = 0; unsigned nd = need;
        for (int bb = 255; bb >= 0; --bb) {
          unsigned hc = hist[bb];
          if (cum + hc >= need) { bsel = bb; nd = need - cum; break; }
          cum += hc;
        }
        bc[0] = prefix | ((unsigned)bsel << shift); bc[1] = nd;
      }
      __syncthreads();
      prefix = bc[0]; need = bc[1]; mask |= (255u << shift);
    }
    unsigned ngt = 0, neq = 0;
#pragma unroll
    for (int i = 0; i < 16; ++i) { ngt += key[i] > prefix; neq += key[i] == prefix; }
    __syncthreads();
    unsigned* sA = sc; unsigned* sB = sc + 512; unsigned* eA = sc + 1024; unsigned* eB = sc + 1536;
    sA[tid] = ngt; eA[tid] = neq;
    __syncthreads();
    for (int off = 1; off < NTH; off <<= 1) {
      unsigned x = sA[tid] + ((tid >= off) ? sA[tid - off] : 0u);
      unsigned y = eA[tid] + ((tid >= off) ? eA[tid - off] : 0u);
      sB[tid] = x; eB[tid] = y;
      __syncthreads();
      unsigned* tmp = sA; sA = sB; sB = tmp; tmp = eA; eA = eB; eB = tmp;
    }
    unsigned gt_excl = sA[tid] - ngt, eq_excl = eA[tid] - neq;
    unsigned gt_total = sA[NTH - 1];
    int* idx = p.IDX + (size_t)item * CAP; float* gate = p.GATE + (size_t)item * CAP;
#pragma unroll
    for (int i = 0; i < 16; ++i) {
      int slot = -1;
      if (key[i] > prefix) { slot = (int)gt_excl; ++gt_excl; }
      else if (key[i] == prefix) { if (eq_excl < need) slot = (int)(gt_total + eq_excl); ++eq_excl; }
      if (slot >= 0) {
        const int tokl = tid * 16 + i;
        idx[slot] = tokl; gate[slot] = __uint_as_float(key[i]);
        const int tokg = (item / NE) * T + tokl;
        const int pos = atomicAdd(&p.TCNT[tokg], 1);
        p.TLIST[(size_t)tokg * 16 + pos] = item * CAP + slot;
      }
    }
    __syncthreads();
  }
}

DI void ph_exp1(const P& p, int layer, char* smem) {
  for (int t = blockIdx.x; t < 32 * 4 * 16; t += gridDim.x) {
    int grp = t / 64, r = t % 64, tm = r / 16, tn = r % 16;
    int b = grp / NE, e = grp % NE;
    const int* gi = p.IDX + (size_t)grp * CAP + tm * GBM;
    const u16* Hb = p.H + (size_t)b * T * DM;
    const float* Wg = p.exp_w_gate + ((size_t)layer * NE + e) * DM * 1024;
    const float* Wu = p.exp_w_up + ((size_t)layer * NE + e) * DM * 1024;
    u16* hid = p.HID + ((size_t)grp * CAP + tm * GBM) * 1024;
    auto arow = [&](int row) -> const void* { return Hb + (size_t)gi[row] * DM; };
    gemm_tile<false, 1>(arow, Wg, Wu, 1024, DM, tn * 64, 1024, smem, [&](int row, int col, float g, float u) {
      float sv = g * frcp(1.f + fexp(-g));
      hid[(size_t)row * 1024 + col] = f2bf(sv * u);
    });
    __syncthreads();
  }
}
DI void ph_exp2(const P& p, int layer, char* smem) {
  for (int t = blockIdx.x; t < 32 * 4 * 8; t += gridDim.x) {
    int grp = t / 32, r = t % 32, tm = r / 8, tn = r % 8;
    int b = grp / NE, e = grp % NE;
    const int* gi = p.IDX + (size_t)grp * CAP + tm * GBM;
    const float* gt = p.GATE + (size_t)grp * CAP + tm * GBM;
    const u16* hid = p.HID + ((size_t)grp * CAP + tm * GBM) * 1024;
    const float* Wd = p.exp_w_down + ((size_t)layer * NE + e) * 1024 * DM;
    float* xb = p.out + (size_t)b * T * DM;
    auto arow = [&](int row) -> const void* { return hid + (size_t)row * 1024; };
    gemm_tile<false, 0>(arow, Wd, nullptr, DM, 1024, tn * GBN, DM, smem, [&](int row, int col, float v, float) {
      unsafeAtomicAdd(xb + (size_t)gi[row] * DM + col, v * gt[row]);
    });
    __syncthreads();
  }
}

namespace g8 {
constexpr int BM = 256, BK = 64, HALF = 128, HTB = HALF * BK * 2, STAGE_BYTES = 8 * HTB, NXCD = 8, WGM = 8;
DI int lds_byte(int r, int c) { const int st = (r >> 4) * 2 + (c >> 5), rr = r & 15, cc = c & 31, ob = rr * 64 + cc * 2; return st * 1024 + (ob ^ (((ob >> 9) & 1) << 5)); }
DI void stage_rc(int b, int& R, int& C) { const int st = b / 1024, sb = b % 1024, swz = sb ^ (((sb >> 9) & 1) << 5); R = (st >> 1) * 16 + swz / 64; C = (st & 1) * 32 + (swz % 64) / 2; }
DI int perm32(int rho) { const int n = rho >> 4, i = rho & 15; return 8 * (i >> 2) + 4 * n + (i & 3); }
struct Unit { int pm, pn; };
struct Sched {
  int nM, nN, nwg, G, c;
  const char* A; const char* Bt; size_t a_tstep, b_tstep; int gdiv, gmod; size_t gstride;
  DI void init(int nM_, int nN_, int G_, int c_, const void* A_, const void* Bt_, int K) {
    nM = nM_; nN = nN_; nwg = nM * nN; G = G_; c = c_; A = (const char*)uni_ptr(A_); Bt = (const char*)uni_ptr(Bt_);
    a_tstep = (size_t)BM * K * 2; b_tstep = (size_t)BM * K * 2; gdiv = 1 << 30; gmod = 1; gstride = 0;
  }
  DI void group(int gdiv_, int gmod_, size_t gstride_) { gdiv = gdiv_; gmod = gmod_; gstride = gstride_; }
  DI bool next(int i, Unit& u) const {
    const long L = (long)i * G + c; if (L >= nwg) return false;
    int wgid = (int)L; { const int q = nwg / NXCD, r = nwg % NXCD, xcd = wgid % NXCD, off = wgid / NXCD; wgid = (xcd < r ? xcd * (q + 1) : r * (q + 1) + (xcd - r) * q) + off; }
    const int nig = WGM * nN, gid = wgid / nig, fm = gid * WGM, gsz = (nM - fm) < WGM ? (nM - fm) : WGM;
    u.pm = fm + ((wgid % nig) % gsz); u.pn = (wgid % nig) / gsz; return true;
  }
  DI const char* a_ptr(const Unit& u) const { return A + (size_t)u.pm * a_tstep; }
  DI const char* b_ptr(const Unit& u) const { return Bt + (size_t)((u.pm / gdiv) % gmod) * gstride + (size_t)u.pn * b_tstep; }
};
using Acc = f32x4[2][2][4][2];

template <class Epi, bool GATHER = false>
DI void gemm_phase(LAS unsigned char* lds, const int K, const Sched& S, const Epi& E, const int* gidx = nullptr, LAS unsigned* gtab = nullptr) {
  const int tid = tidx(), wid = __builtin_amdgcn_readfirstlane(tid >> 6), lane = tid & 63, wr = wid >> 2, wc = wid & 3, fr = lane & 15, fq = lane >> 4;
  const int nt = K / BK;
  unsigned voffA[2], voffB[2];
#pragma unroll
  for (int i = 0; i < 2; ++i) { int R, C; stage_rc(tid * 16 + i * 8192, R, C); const int Rb = Epi::PERM ? ((R & ~31) + perm32(R & 31)) : R;
    voffA[i] = GATHER ? (unsigned)(R | (C << 16)) : (unsigned)(R * K + C) * 2u; voffB[i] = (unsigned)(Rb * K + C) * 2u; }
  unsigned gc[2][2], gn[2][2];
  auto gget = [&](int ui_, unsigned (&g)[2][2]) {
    if constexpr (GATHER) {
      Unit u_; const bool ok = S.next(ui_, u_);
#pragma unroll
      for (int h = 0; h < 2; ++h)
#pragma unroll
        for (int i = 0; i < 2; ++i) {
          const int r = h * HALF + (int)(voffA[i] & 0xffffu); const unsigned cb = (voffA[i] >> 16) * 2u;
          if (ui_ < 16) g[h][i] = gtab[ui_ * 256 + r] + cb;
          else { const int row = (ok ? u_.pm : 0) * BM + r; g[h][i] = (unsigned)((row / (NE * CAP)) * T + gidx[row]) * (unsigned)K * 2u + cb; }
        }
      asm volatile("" : "+v"(g[0][0]), "+v"(g[0][1]), "+v"(g[1][0]), "+v"(g[1][1]));
    }
  };
  if constexpr (GATHER) {
    for (int i0 = 0; i0 < 16; i0 += 2) {
      Unit u_; const int i = i0 + (tid >> 8);
      if (S.next(i, u_)) { const int row = u_.pm * BM + (tid & 255); gtab[i * 256 + (tid & 255)] = (unsigned)((row / (NE * CAP)) * T + gidx[row]) * (unsigned)K * 2u; }
      if (!S.next(i0 + 2, u_)) break;
    }
    __syncthreads();
  }
  const size_t kstep = (size_t)(BK * 2);
  const size_t hstep = (size_t)HALF * K * 2;
  const unsigned ldsw = (unsigned)wid * 1024u;
  const int aoff = lds_byte(wr * 64 + fr, fq * 8), boff = lds_byte(wc * 32 + fr, fq * 8);
#define G8_SA(b, h) (((b) * 2 + (h)) * HTB)
#define G8_SB(b, h) ((4 + (b) * 2 + (h)) * HTB)
#define G8_STAGE(bufoff, gbase, voff) do { _Pragma("unroll") for (int _i = 0; _i < 2; ++_i) \
    __builtin_amdgcn_global_load_lds((const unsigned*)((const char*)(gbase) + (voff)[_i]), (LAS unsigned*)(lds + (bufoff) + ldsw + _i * 8192), 16, 0, 0); } while (0)
#define G8_STAGE_A(bufoff, base, h, kb, Gv) do { if constexpr (GATHER) { G8_STAGE(bufoff, S.A + (kb), Gv[h]); } else { G8_STAGE(bufoff, (base) + (h) * hstep + (kb), voffA); } } while (0)
#define G8_LDA(dst, b, h) do { _Pragma("unroll") for (int m = 0; m < 4; ++m) _Pragma("unroll") for (int k = 0; k < 2; ++k) dst[m][k] = *(const LAS bf16x8*)(lds + G8_SA(b, h) + aoff + m * 2048 + k * 1024); } while (0)
#define G8_LDB(dst, b, h) do { _Pragma("unroll") for (int n = 0; n < 2; ++n) _Pragma("unroll") for (int k = 0; k < 2; ++k) dst[n][k] = *(const LAS bf16x8*)(lds + G8_SB(b, h) + boff + n * 2048 + k * 1024); } while (0)
#define G8_MMA(ai, bj, At, Bt) do { __builtin_amdgcn_s_setprio(1); _Pragma("unroll") for (int m = 0; m < 4; ++m) _Pragma("unroll") for (int n = 0; n < 2; ++n) _Pragma("unroll") for (int k = 0; k < 2; ++k) \
    acc[ai][bj][m][n] = __builtin_amdgcn_mfma_f32_16x16x32_bf16(Bt[n][k], At[m][k], acc[ai][bj][m][n], 0, 0, 0); __builtin_amdgcn_s_setprio(0); } while (0)
#define G8_WAIT_V(n) asm volatile("s_waitcnt vmcnt(" #n ")" ::: "memory")
#define G8_WAIT_L(n) asm volatile("s_waitcnt lgkmcnt(" #n ")" ::: "memory")
#define G8_BAR __builtin_amdgcn_s_barrier()
#define G8_SCHED __builtin_amdgcn_sched_barrier(0)
  Unit cur, nxt; int ui = 0;
  if (!S.next(0, cur)) return;
  f32x4 acc[2][2][4][2];
#pragma unroll
  for (int a = 0; a < 2; ++a)
#pragma unroll
    for (int b = 0; b < 2; ++b)
#pragma unroll
      for (int m = 0; m < 4; ++m)
#pragma unroll
        for (int n = 0; n < 2; ++n) acc[a][b][m][n] = (f32x4){0.f, 0.f, 0.f, 0.f};
  bf16x8 At[4][2], B0[2][2], B1[2][2];
  const char* cA = S.a_ptr(cur); const char* cB = S.b_ptr(cur);
  gget(0, gc);
  G8_STAGE(G8_SB(0, 0), cB, voffB); G8_STAGE_A(G8_SA(0, 0), cA, 0, 0, gc); G8_STAGE(G8_SB(0, 1), cB + hstep, voffB); G8_STAGE_A(G8_SA(0, 1), cA, 1, 0, gc);
  if (wr == 1) G8_BAR;
  G8_WAIT_V(4); G8_BAR;
  G8_STAGE(G8_SB(1, 0), cB + kstep, voffB); G8_STAGE_A(G8_SA(1, 0), cA, 0, kstep, gc); G8_STAGE(G8_SB(1, 1), cB + hstep + kstep, voffB);
  G8_WAIT_V(6); G8_BAR;
  for (;;) {
    const bool has_next = S.next(ui + 1, nxt);
    const char* nA = has_next ? S.a_ptr(nxt) : cA; const char* nB = has_next ? S.b_ptr(nxt) : cB;
    gget(has_next ? ui + 1 : ui, gn);
    for (int t = 0; t < nt; t += 2) {
      const bool last = (t == nt - 2);
      const size_t k1 = (size_t)(t + 1) * kstep, k2 = last ? (size_t)0 : (size_t)(t + 2) * kstep, k3 = k2 + kstep;
      const char* u2 = last ? nA : cA; const char* b2 = (last ? nB : cB) + k2;
      const char* b3 = b2 + kstep;
      unsigned g2[2][2];
      if constexpr (GATHER) {
#pragma unroll
        for (int h = 0; h < 2; ++h)
#pragma unroll
          for (int i = 0; i < 2; ++i) g2[h][i] = last ? gn[h][i] : gc[h][i];
      }
      G8_LDB(B0, 0, 0); G8_SCHED; G8_LDA(At, 0, 0); G8_STAGE_A(G8_SA(1, 1), cA, 1, k1, gc);
      G8_WAIT_L(8); G8_BAR; G8_WAIT_L(0); G8_MMA(0, 0, At, B0); G8_BAR; G8_SCHED;
      G8_LDB(B1, 0, 1); G8_STAGE(G8_SB(0, 0), b2, voffB);
      G8_BAR; G8_WAIT_L(0); G8_MMA(0, 1, At, B1); G8_BAR;
      G8_LDA(At, 0, 1); G8_STAGE_A(G8_SA(0, 0), u2, 0, k2, g2);
      G8_BAR; G8_WAIT_L(0); G8_MMA(1, 0, At, B0); G8_BAR; G8_SCHED;
      G8_STAGE(G8_SB(0, 1), b2 + hstep, voffB);
      G8_WAIT_V(6); G8_BAR; G8_MMA(1, 1, At, B1); G8_BAR;
      G8_LDB(B0, 1, 0); G8_SCHED; G8_LDA(At, 1, 0); G8_STAGE_A(G8_SA(0, 1), u2, 1, k2, g2);
      G8_WAIT_L(8); G8_BAR; G8_WAIT_L(0); G8_MMA(0, 0, At, B0); G8_BAR; G8_SCHED;
      G8_LDB(B1, 1, 1); G8_STAGE(G8_SB(1, 0), b3, voffB);
      G8_BAR; G8_WAIT_L(0); G8_MMA(0, 1, At, B1); G8_BAR;
      G8_LDA(At, 1, 1); G8_STAGE_A(G8_SA(1, 0), u2, 0, k3, g2);
      G8_BAR; G8_WAIT_L(0); G8_MMA(1, 0, At, B0); G8_BAR; G8_SCHED;
      G8_STAGE(G8_SB(1, 1), b3 + hstep, voffB);
      G8_WAIT_V(6); G8_BAR; G8_MMA(1, 1, At, B1); G8_BAR;
    }
    {
      const int t2 = tidx(); const int w2 = __builtin_amdgcn_readfirstlane(t2 >> 6), l2 = t2 & 63;
      E(acc, cur, w2 >> 2, w2 & 3, l2 & 15, l2 >> 4);
    }
    if (!has_next) break;
#pragma unroll
    for (int a = 0; a < 2; ++a)
#pragma unroll
      for (int b = 0; b < 2; ++b)
#pragma unroll
        for (int m = 0; m < 4; ++m)
#pragma unroll
          for (int n = 0; n < 2; ++n) acc[a][b][m][n] = (f32x4){0.f, 0.f, 0.f, 0.f};
    cur = nxt; cA = nA; cB = nB; ++ui;
    if constexpr (GATHER) {
#pragma unroll
      for (int h = 0; h < 2; ++h)
#pragma unroll
        for (int i = 0; i < 2; ++i) gc[h][i] = gn[h][i];
    }
  }
  G8_WAIT_V(0);
  if (wr == 0) G8_BAR;
  G8_BAR;
#undef G8_SA
#undef G8_SB
#undef G8_STAGE
#undef G8_STAGE_A
#undef G8_LDA
#undef G8_LDB
#undef G8_MMA
#undef G8_WAIT_V
#undef G8_WAIT_L
#undef G8_BAR
#undef G8_SCHED
}

struct EpiZ {
  static constexpr bool PERM = false; float* Z;
  DI void operator()(const Acc& acc, const Unit& u, int wr, int wc, int fr, int fq) const {
    const int row0 = u.pm * BM + wr * 64 + fr, col0 = u.pn * BM + wc * 32 + 4 * fq;
#pragma unroll
    for (int ai = 0; ai < 2; ++ai)
#pragma unroll
      for (int m = 0; m < 4; ++m) { float* rowp = Z + (size_t)(row0 + ai * HALF + m * 16) * INC;
#pragma unroll
        for (int bj = 0; bj < 2; ++bj)
#pragma unroll
          for (int n = 0; n < 2; ++n) { const int col = col0 + bj * HALF + n * 16; if (col < INC) *(f32x4*)(rowp + col) = acc[ai][bj][m][n]; } }
  }
};
struct EpiRes {
  static constexpr bool PERM = false; const float* xs; float* xo;
  DI void operator()(const Acc& acc, const Unit& u, int wr, int wc, int fr, int fq) const {
    const int row0 = u.pm * BM + wr * 64 + fr, col0 = u.pn * BM + wc * 32 + 4 * fq;
#pragma unroll
    for (int ai = 0; ai < 2; ++ai)
#pragma unroll
      for (int m = 0; m < 4; ++m) { const size_t ro = (size_t)(row0 + ai * HALF + m * 16) * DM + col0;
#pragma unroll
        for (int bj = 0; bj < 2; ++bj)
#pragma unroll
          for (int n = 0; n < 2; ++n) { const size_t o = ro + bj * HALF + n * 16; *(f32x4*)(xo + o) = *(const f32x4*)(xs + o) + acc[ai][bj][m][n]; } }
  }
};
struct EpiSig {
  static constexpr bool PERM = true; u16* PG;
  DI void operator()(const Acc& acc, const Unit& u, int wr, int wc, int fr, int fq) const {
    const int row0 = u.pm * BM + wr * 64 + fr, col0 = u.pn * BM + wc * 32 + 8 * fq;
#pragma unroll
    for (int ai = 0; ai < 2; ++ai)
#pragma unroll
      for (int m = 0; m < 4; ++m) { u16* rowp = PG + (size_t)(row0 + ai * HALF + m * 16) * DM + col0;
#pragma unroll
        for (int bj = 0; bj < 2; ++bj) { const f32x4 v0 = acc[ai][bj][m][0], v1 = acc[ai][bj][m][1];
          u32x4 wv = {pk2(sigmoidf_(v0[0]), sigmoidf_(v0[1])), pk2(sigmoidf_(v0[2]), sigmoidf_(v0[3])), pk2(sigmoidf_(v1[0]), sigmoidf_(v1[1])), pk2(sigmoidf_(v1[2]), sigmoidf_(v1[3]))};
          *(u32x4*)(rowp + bj * HALF) = wv; } }
  }
};
struct EpiPle {
  static constexpr bool PERM = false; float* xo; const u16* PG;
  DI void operator()(const Acc& acc, const Unit& u, int wr, int wc, int fr, int fq) const {
    const int row0 = u.pm * BM + wr * 64 + fr, col0 = u.pn * BM + wc * 32 + 4 * fq;
#pragma unroll
    for (int ai = 0; ai < 2; ++ai)
#pragma unroll
      for (int m = 0; m < 4; ++m) { const size_t ro = (size_t)(row0 + ai * HALF + m * 16) * DM + col0;
#pragma unroll
        for (int bj = 0; bj < 2; ++bj)
#pragma unroll
          for (int n = 0; n < 2; ++n) { const size_t o = ro + bj * HALF + n * 16; const u32x2 g = *(const u32x2*)(PG + o);
            f32x4 gv = {__uint_as_float(g[0] << 16), __uint_as_float(g[0] & 0xffff0000u), __uint_as_float(g[1] << 16), __uint_as_float(g[1] & 0xffff0000u)};
            *(f32x4*)(xo + o) = *(const f32x4*)(xo + o) + acc[ai][bj][m][n] * gv; } }
  }
};
struct EpiSwi {
  static constexpr bool PERM = true; u16* HID;
  DI void operator()(const Acc& acc, const Unit& u, int wr, int wc, int fr, int fq) const {
    const int row0 = u.pm * BM + wr * 64 + fr, col0 = u.pn * HALF + wc * 32 + 8 * fq;
#pragma unroll
    for (int ai = 0; ai < 2; ++ai)
#pragma unroll
      for (int m = 0; m < 4; ++m) { u16* rowp = HID + (size_t)(row0 + ai * HALF + m * 16) * 1024 + col0;
        float h[8];
#pragma unroll
        for (int n = 0; n < 2; ++n)
#pragma unroll
          for (int j = 0; j < 4; ++j) { const float gt = acc[ai][0][m][n][j], up = acc[ai][1][m][n][j]; h[n * 4 + j] = gt * frcp(1.f + fexp(-gt)) * up; }
        *(u32x4*)rowp = u32x4{pk2(h[0], h[1]), pk2(h[2], h[3]), pk2(h[4], h[5]), pk2(h[6], h[7])}; }
  }
};
struct EpiYE {
  static constexpr bool PERM = true; u16* YE; const float* GATE;
  DI void operator()(const Acc& acc, const Unit& u, int wr, int wc, int fr, int fq) const {
    const int row0 = u.pm * BM + wr * 64 + fr, col0 = u.pn * BM + wc * 32 + 8 * fq;
#pragma unroll
    for (int ai = 0; ai < 2; ++ai)
#pragma unroll
      for (int m = 0; m < 4; ++m) { const int row = row0 + ai * HALF + m * 16; const float gt = GATE[row]; u16* rowp = YE + (size_t)row * 1024 + col0;
#pragma unroll
        for (int bj = 0; bj < 2; ++bj) { const f32x4 v0 = acc[ai][bj][m][0] * gt, v1 = acc[ai][bj][m][1] * gt;
          *(u32x4*)(rowp + bj * HALF) = u32x4{pk2(v0[0], v0[1]), pk2(v0[2], v0[3]), pk2(v1[0], v1[1]), pk2(v1[2], v1[3])}; } }
  }
};
}

DI void cvt_tile_T(const float* __restrict__ src, int ldsrc, int N, int K, u16* __restrict__ dst, int k0, int n0, int drow0, char* smem, int tid) {
  short* tl = (short*)smem;
  __syncthreads();
#pragma unroll
  for (int i = 0; i < 2; ++i) {
    int u = tid + i * NTH; int kr = u >> 4, nq = u & 15; int n = n0 + nq * 4;
    f32x4 v = f32x4{0.f, 0.f, 0.f, 0.f};
    if (n < N) v = *(const f32x4*)(src + (size_t)(k0 + kr) * ldsrc + n);
#pragma unroll
    for (int e = 0; e < 4; ++e) tl[(nq * 4 + e) * 72 + kr] = (short)f2bf(v[e]);
  }
  __syncthreads();
  { int n = tid >> 3, kc = tid & 7;
    *(u32x4*)(dst + (size_t)(drow0 + n) * K + k0 + kc * 8) = *(const u32x4*)(tl + n * 72 + kc * 8); }
}
constexpr int WIN_PAD = 2560;
DI void ph_cvt_small(const P& p, int layer, char* smem) {
  const int tid = tidx();
  const int t0 = 16 * 40, t1 = t0 + 256, t2 = t1 + 256, t3 = t2 + 64;
  for (int t = blockIdx.x; t < t3; t += gridDim.x) {
    if (t < t0) cvt_tile_T(p.w_in + (size_t)layer * DM * INC, INC, INC, DM, p.WIN, (t / 40) * 64, (t % 40) * 64, (t % 40) * 64, smem, tid);
    else if (t < t1) { int q = t - t0; cvt_tile_T(p.w_out + (size_t)layer * DM * DM, DM, DM, DM, p.WOUT, (q / 16) * 64, (q % 16) * 64, (q % 16) * 64, smem, tid); }
    else if (t < t2) { int q = t - t1; cvt_tile_T(p.ple_gate + (size_t)layer * DM * DM, DM, DM, DM, p.WPG, (q / 16) * 64, (q % 16) * 64, (q % 16) * 64, smem, tid); }
    else { int q = t - t2; cvt_tile_T(p.ple_proj + (size_t)layer * DPLE * DM, DM, DM, DPLE, p.WPP, (q / 16) * 64, (q % 16) * 64, (q % 16) * 64, smem, tid); }
  }
  const float* ps = p.p + (size_t)layer * NTOK * DPLE;
  for (int i = blockIdx.x * NTH + tid; i < NTOK * DPLE / 8; i += gridDim.x * NTH) {
    f32x4 a = *(const f32x4*)(ps + (size_t)i * 8), b = *(const f32x4*)(ps + (size_t)i * 8 + 4);
    *(u32x4*)(p.PB + (size_t)i * 8) = u32x4{pk2(a[0], a[1]), pk2(a[2], a[3]), pk2(b[0], b[1]), pk2(b[2], b[3])};
  }
}

struct CvtJob { const float* src; u16* dst; int k0, n0, drow0; };
DI bool cvt_job(const P& p, int layer, int t, CvtJob& j) {
  if (t >= NE * 3 * 128) return false;
  const int e = t / 384, r = t % 384, mat = r / 128, q = r % 128;
  j.k0 = (q / 8) * 64; j.n0 = (q % 8) * 128;
  const size_t eo = ((size_t)layer * NE + e) * 1024 * 1024;
  if (mat == 0) { j.src = p.exp_w_gate + eo; j.dst = p.EW1 + (size_t)e * 2048 * 1024; j.drow0 = (j.n0 >> 7) * 256; }
  else if (mat == 1) { j.src = p.exp_w_up + eo; j.dst = p.EW1 + (size_t)e * 2048 * 1024; j.drow0 = (j.n0 >> 7) * 256 + 128; }
  else { j.src = p.exp_w_down + eo; j.dst = p.EW2 + (size_t)e * 1024 * 1024; j.drow0 = j.n0; }
  return true;
}
DI void ph_cvt_experts(const P& p, int layer, char* smem, unsigned* ctr) {
  const int tid = tidx();
  short* tl = (short*)smem;
  int* sitem = (int*)(smem + 32768);
  __syncthreads();
  if (tid == 0) sitem[0] = (int)atomicAdd(ctr, 1u);
  __syncthreads();
  CvtJob cur; bool has = cvt_job(p, layer, sitem[0], cur);
  f32x4 v[4];
  const int kr = tid >> 5, nq = tid & 31;
  if (has) {
#pragma unroll
    for (int i = 0; i < 4; ++i) v[i] = *(const f32x4*)(cur.src + (size_t)(cur.k0 + kr + 16 * i) * 1024 + cur.n0 + nq * 4);
  }
  int par = 0;
  while (has) {
    if (tid == 0) sitem[1 + par] = (int)atomicAdd(ctr, 1u);
    __syncthreads();
#pragma unroll
    for (int i = 0; i < 4; ++i)
#pragma unroll
      for (int e = 0; e < 4; ++e) tl[(nq * 4 + e) * 72 + kr + 16 * i] = (short)f2bf(v[i][e]);
    __syncthreads();
    CvtJob nxt; const bool hn = cvt_job(p, layer, sitem[1 + par], nxt);
    if (hn) {
#pragma unroll
      for (int i = 0; i < 4; ++i) v[i] = *(const f32x4*)(nxt.src + (size_t)(nxt.k0 + kr + 16 * i) * 1024 + nxt.n0 + nq * 4);
    }
#pragma unroll
    for (int i = 0; i < 2; ++i) {
      int u = tid + i * NTH; int n = u >> 3, kc = u & 7;
      *(u32x4*)(cur.dst + (size_t)(cur.drow0 + n) * 1024 + cur.k0 + kc * 8) = *(const u32x4*)(tl + n * 72 + kc * 8);
    }
    cur = nxt; has = hn; par ^= 1;
  }
}
DI void ph_gather(const P& p) {
  const int tid_ = tidx(); const int lane = tid_ & 63, w = tid_ >> 6;
  for (int row = blockIdx.x * 8 + w; row < NB * NE * CAP; row += gridDim.x * 8) {
    const int b = row / (NE * CAP);
    const int tok = b * T + p.IDX[row];
    const u32x4* src = (const u32x4*)(p.H + (size_t)tok * DM);
    u32x4* dst = (u32x4*)(p.XE + (size_t)row * DM);
    u32x4 a = src[lane], c = src[lane + 64];
    dst[lane] = a; dst[lane + 64] = c;
  }
}
DI void ph_combine_norm(const P& p, int layer) {
  const int tid_ = tidx(); const int lane = tid_ & 63, w = tid_ >> 6;
  const float* g = p.ple_norm + layer * DM;
  for (int tok = blockIdx.x * 8 + w; tok < NTOK; tok += gridDim.x * 8) {
    f32x4* xr = (f32x4*)(p.out + (size_t)tok * DM);
    f32x4 v[4];
#pragma unroll
    for (int j = 0; j < 4; ++j) v[j] = xr[lane * 4 + j];
    const int cnt = p.TCNT[tok];
    for (int q = 0; q < cnt; ++q) {
      const int yrow = p.TLIST[(size_t)tok * 16 + q];
      const u32x4* yr = (const u32x4*)(p.YE + (size_t)yrow * DM + lane * 16);
      u32x4 a = yr[0], c = yr[1];
#pragma unroll
      for (int e = 0; e < 4; ++e) {
        v[e >> 1][(e & 1) * 2] += __uint_as_float(a[e] << 16); v[e >> 1][(e & 1) * 2 + 1] += __uint_as_float(a[e] & 0xffff0000u);
        v[2 + (e >> 1)][(e & 1) * 2] += __uint_as_float(c[e] << 16); v[2 + (e >> 1)][(e & 1) * 2 + 1] += __uint_as_float(c[e] & 0xffff0000u);
      }
    }
    float ss = 0.f;
#pragma unroll
    for (int j = 0; j < 4; ++j) { xr[lane * 4 + j] = v[j]; ss += v[j][0] * v[j][0] + v[j][1] * v[j][1] + v[j][2] * v[j][2] + v[j][3] * v[j][3]; }
    ss = wave_sum(ss);
    const float rstd = frsq(ss * (1.f / DM) + NORM_EPS);
    u32x4 o0, o1;
#pragma unroll
    for (int j = 0; j < 4; ++j) {
      f32x4 gg = *(const f32x4*)(g + lane * 16 + j * 4);
      unsigned lo = pk2(v[j][0] * rstd * gg[0], v[j][1] * rstd * gg[1]), hi = pk2(v[j][2] * rstd * gg[2], v[j][3] * rstd * gg[3]);
      if (j < 2) { o0[j * 2] = lo; o0[j * 2 + 1] = hi; } else { o1[(j - 2) * 2] = lo; o1[(j - 2) * 2 + 1] = hi; }
    }
    *(u32x4*)(p.H + (size_t)tok * DM + lane * 16) = o0; *(u32x4*)(p.H + (size_t)tok * DM + lane * 16 + 8) = o1;
  }
}

#define XB_TMO      128
#define XB_XCNT(j)  (256  + 64 * (j))
#define XB_XSUB(j)  (1280 + 64 * (j))
#define XB_XGEN(j)  (2304 + 64 * (j))
#define XB_TOP      3328
#define XB_TOPGEN   3392
#define XCD_BAR_WORDS 3456
#define XB_SPIN_CAP (1u << 20)
DI unsigned xb_ld(unsigned* p) { return __hip_atomic_load(p, __ATOMIC_RELAXED, __HIP_MEMORY_SCOPE_AGENT); }
DI unsigned xb_add(unsigned* p, unsigned v) { return __hip_atomic_fetch_add(p, v, __ATOMIC_RELAXED, __HIP_MEMORY_SCOPE_AGENT); }
DI unsigned xb_xcc_id() { return (unsigned)__builtin_amdgcn_s_getreg((3 << 11) | 20) & 0xFu; }
#define XB_SPIN(cond, bar) do { unsigned _sp = 0; while (cond) { __builtin_amdgcn_s_sleep(1); \
    if ((++_sp & 255u) == 0u) { if (xb_ld(&(bar)[XB_TMO])) break; if (_sp > XB_SPIN_CAP) { atomicAdd(&(bar)[XB_TMO], 1u); break; } } } } while (0)
struct XcdBarrier { unsigned* bar; unsigned x; volatile LAS unsigned* st; };
DI XcdBarrier xcd_barrier_post(unsigned* bar, volatile LAS unsigned* st) {
  XcdBarrier b; b.bar = bar; b.x = xb_xcc_id(); b.st = st;
  if (threadIdx.x == 0) (void)xb_add(&bar[XB_XCNT(b.x)], 1u);
  return b;
}
DI void xcd_barrier_complete(unsigned* bar, unsigned x, unsigned& nloc, unsigned& nx) {
  const unsigned G = gridDim.x * gridDim.y * gridDim.z;
  unsigned sum, cnt, mine, sp = 0u;
  for (;;) {
    sum = 0u; cnt = 0u; mine = 0u;
#pragma unroll
    for (unsigned j = 0; j < 16; ++j) { const unsigned c = xb_ld(&bar[XB_XCNT(j)]); sum += c; cnt += (c > 0u) ? 1u : 0u; mine = (j == x) ? c : mine; }
    if (sum == G) break;
    __builtin_amdgcn_s_sleep(1);
    if ((++sp & 255u) == 0u) { if (xb_ld(&bar[XB_TMO])) break; if (sp > XB_SPIN_CAP) { atomicAdd(&bar[XB_TMO], 1u); break; } }
  }
  nloc = mine > 0u ? mine : 1u; nx = cnt > 0u ? cnt : 1u;
}
DI void xcd_barrier(const XcdBarrier& b) {
  asm volatile("s_waitcnt vmcnt(0)" ::: "memory");
  __syncthreads();
  if (threadIdx.x == 0) {
    unsigned* bar = b.bar;
    __builtin_amdgcn_s_waitcnt(0);
    unsigned nloc = b.st[0], nx = b.st[1];
    if (nloc == 0u) { xcd_barrier_complete(bar, b.x, nloc, nx); b.st[0] = nloc; b.st[1] = nx; }
    const unsigned old = xb_add(&bar[XB_XSUB(b.x)], 1u);
    const unsigned gen = old / nloc;
    if (old + 1u == (gen + 1u) * nloc) {
      __builtin_amdgcn_fence(__ATOMIC_RELEASE, "agent");
      asm volatile("s_waitcnt vmcnt(0)" ::: "memory");
      const unsigned og = xb_add(&bar[XB_TOP], 1u);
      const unsigned tg = og / nx;
      if (og + 1u == (tg + 1u) * nx) xb_add(&bar[XB_TOPGEN], 1u);
      else XB_SPIN(xb_ld(&bar[XB_TOPGEN]) == tg, bar);
      __builtin_amdgcn_fence(__ATOMIC_ACQUIRE, "agent");
      xb_add(&bar[XB_XGEN(b.x)], 1u);
      asm volatile("s_waitcnt vmcnt(0)" ::: "memory");
    } else {
      XB_SPIN(xb_ld(&bar[XB_XGEN(b.x)]) == gen, bar);
      __builtin_amdgcn_fence(__ATOMIC_ACQUIRE, "agent");
      asm volatile("s_waitcnt vmcnt(0)" ::: "memory");
    }
  }
  __syncthreads();
}

#define TAKE(bytes) (ws + off); off += (((size_t)(bytes)) + 255) & ~(size_t)255
__host__ __device__ inline size_t fill_ws(P& p, char* ws) {
  size_t off = 0;
  char* regA = TAKE((size_t)NTOK * INC * 4);
  p.Z = (float*)regA;
  p.LW = (u16*)regA; p.AA = (u16*)(regA + (size_t)2 * NTOK * RWW * 2); p.G = (u16*)(regA + (size_t)4 * NTOK * RWW * 2);
  p.MC = (float*)(regA + (size_t)5 * NTOK * RWW * 2); p.NC = p.MC + (size_t)32 * NCH * 4096;
  p.HID = (u16*)regA;
  char* regB = TAKE((size_t)3 * NTOK * RWW * 4);
  p.R = (float*)regB; p.K = p.R + (size_t)NTOK * RWW; p.V = p.K + (size_t)NTOK * RWW;
  p.PG = (float*)regB;
  char* regC = TAKE((size_t)NTOK * (768 + 1024) * 4);
  p.QRAW = (float*)regC; p.KVRAW = p.QRAW + (size_t)NTOK * 768;
  p.AO = (float*)regC; p.O2 = (u16*)(p.AO + (size_t)NTOK * 512); p.SS = (float*)(p.O2 + (size_t)2 * NTOK * 512);
  p.TWD = (u16*)TAKE((size_t)2 * NTOK * 64 * 2); p.AD = (u16*)TAKE((size_t)2 * NTOK * 64 * 2);
  p.SGD = (u16*)TAKE((size_t)NTOK * 128 * 2); p.QDN = (u16*)TAKE((size_t)NTOK * 256 * 2);
  p.KVDN = (u16*)TAKE((size_t)NTOK * 128 * 2); p.KR = (float*)TAKE((size_t)NTOK * 32 * 4);
  p.ROPE = (float*)TAKE((size_t)NTOK * 32 * 4);
  p.Q = (u16*)TAKE((size_t)NTOK * NH * 96 * 2); p.Kc = (u16*)TAKE((size_t)NTOK * NH * 96 * 2);
  p.Vv = (u16*)TAKE((size_t)NTOK * NH * 64 * 2);
  p.H = (u16*)TAKE((size_t)NTOK * DM * 2);
  p.AFF = (float*)TAKE((size_t)NB * NE * T * 4);
  p.IDX = (int*)TAKE((size_t)NB * NE * CAP * 4);
  p.GATE = (float*)TAKE((size_t)NB * NE * CAP * 4);

  p.WIN = (u16*)TAKE((size_t)WIN_PAD * DM * 2); p.WOUT = (u16*)TAKE((size_t)DM * DM * 2); p.WPG = (u16*)TAKE((size_t)DM * DM * 2);
  p.WPP = (u16*)TAKE((size_t)DM * DPLE * 2); p.PB = (u16*)TAKE((size_t)NTOK * DPLE * 2);
  p.PGb = (u16*)regB;
  p.EW1 = (u16*)regB; p.EW2 = p.EW1 + (size_t)NE * 2048 * 1024;
  p.XE = (u16*)regA; p.HID = (u16*)(regA + (size_t)32 * 1024 * 1024 * 2);
  p.YE = (u16*)regC;
  p.TCNT = (int*)TAKE((size_t)NTOK * 4); p.TLIST = (int*)TAKE((size_t)NTOK * 16 * 4);
  p.CTR = (unsigned*)TAKE(256);
  p.BAR = (unsigned*)TAKE(XCD_BAR_WORDS * 4);
  return off;
}
#undef TAKE
constexpr int DSM_BYTES = g8::STAGE_BYTES + 64 + 16 * 256 * 4;
extern __shared__ __attribute__((aligned(16))) char dsm[];
struct PK { const void* in[31]; float* out; char* ws; };
DI void build_params(P& p, const PK& k) {
  p.x = (const float*)k.in[0]; p.p = (const float*)k.in[1]; p.pos = (const int*)k.in[2];
  p.attn_norm = (const float*)k.in[3]; p.w_in = (const float*)k.in[4]; p.rw_mu = (const float*)k.in[5];
  p.rw_w0 = (const float*)k.in[6]; p.rw_w_up = (const float*)k.in[7]; p.rw_a0 = (const float*)k.in[8];
  p.rw_a_up = (const float*)k.in[9]; p.rw_g_up = (const float*)k.in[10]; p.rw_k_k = (const float*)k.in[11];
  p.rw_k_a = (const float*)k.in[12]; p.rw_r_k = (const float*)k.in[13]; p.rw_lnx_w = (const float*)k.in[14];
  p.rw_lnx_b = (const float*)k.in[15]; p.mla_q_norm = (const float*)k.in[16]; p.mla_q_up = (const float*)k.in[17];
  p.mla_kv_norm = (const float*)k.in[18]; p.mla_kv_up = (const float*)k.in[19]; p.mla_o_norm = (const float*)k.in[20];
  p.w_out = (const float*)k.in[21]; p.ffn_norm = (const float*)k.in[22]; p.router = (const float*)k.in[23];
  p.exp_w_gate = (const float*)k.in[24]; p.exp_w_up = (const float*)k.in[25]; p.exp_w_down = (const float*)k.in[26];
  p.ple_norm = (const float*)k.in[27]; p.ple_proj = (const float*)k.in[28]; p.ple_gate = (const float*)k.in[29];
  p.final_norm = (const float*)k.in[30];
  p.out = k.out;
  (void)fill_ws(p, k.ws);
}
__global__ void __launch_bounds__(NTH) mega(PK pk) {
  P p; build_params(p, pk);
  char* smem = dsm;
  LAS unsigned char* glds = (LAS unsigned char*)dsm;
  uint4* xbw = (uint4*)(dsm + g8::STAGE_BYTES);
  cg::grid_group grid = cg::this_grid();
  if (threadIdx.x == 0) *xbw = make_uint4(0u, 0u, 0u, 0u);
  if (pk.ws == nullptr) grid.sync();
  const XcdBarrier xb = xcd_barrier_post(p.BAR, (volatile LAS unsigned*)xbw);
#define GSYNC() xcd_barrier(xb)
#ifndef PROBE_MASK
#define PROBE_MASK 0u
#endif
#if PROBE_MASK
  unsigned long long pt0 = __builtin_amdgcn_s_memrealtime();
#define PSYNC(id) do { GSYNC(); if (PROBE_MASK & (1u << (id))) { unsigned long long t1_ = __builtin_amdgcn_s_memrealtime(); unsigned long long dt_ = t1_ - pt0; \
    while (__builtin_amdgcn_s_memrealtime() - t1_ < dt_) __builtin_amdgcn_s_sleep(8); } pt0 = __builtin_amdgcn_s_memrealtime(); } while (0)
#else
#define PSYNC(id) GSYNC()
#endif
  for (int layer_ = 0; layer_ < NL; ++layer_) {
    int layer = layer_; asm volatile("" : "+s"(layer));
    if (layer_ == 0) ph_rope_table(p);
    ph_cvt_small(p, layer, smem);
    ph_norm(layer == 0 ? p.x : p.out, p.attn_norm + layer * DM, p.H);
    PSYNC(0);
    {
      g8::Sched S; S.init(NTOK / 256, WIN_PAD / 256, gridDim.x, bidx(), p.H, p.WIN, DM);
      g8::EpiZ E{p.Z};
      g8::gemm_phase(glds, DM, S, E);
    }
    PSYNC(1);
    ph_rwshift(p, layer);
    ph_mlaprep1(p, layer);
    PSYNC(2);
    for (int d = 0; d < 2; ++d) {
      u16* LW = p.LW + (size_t)d * NTOK * RWW; const float* w0 = p.rw_w0 + (layer * 2 + d) * RWW;
      ph_gemm<false>(p.TWD + (size_t)d * NTOK * 64, 64, p.rw_w_up + ((size_t)(layer * 2 + d)) * 64 * RWW, RWW, NTOK, RWW, 64, smem,
                     [&](int row, int col, float v) { LW[(size_t)row * RWW + col] = f2bf(-0.6065306597126334f * sigmoidf_(v + w0[col])); }, (int)blockIdx.x, (int)gridDim.x);
      u16* AA = p.AA + (size_t)d * NTOK * RWW; const float* a0 = p.rw_a0 + (layer * 2 + d) * RWW;
      ph_gemm<false>(p.AD + (size_t)d * NTOK * 64, 64, p.rw_a_up + ((size_t)(layer * 2 + d)) * 64 * RWW, RWW, NTOK, RWW, 64, smem,
                     [&](int row, int col, float v) { AA[(size_t)row * RWW + col] = f2bf(sigmoidf_(v + a0[col])); }, (int)blockIdx.x, (int)gridDim.x);
    }
    PSYNC(3);
    ph_scan1(p, layer, smem);
    PSYNC(4);
    ph_scan2(p, smem);
    const bool split_ = gridDim.x >= 64;
    const int gw = split_ ? (int)blockIdx.x - 32 : (int)blockIdx.x, gstride = split_ ? (int)gridDim.x - 32 : (int)gridDim.x;
    if (gw >= 0)
    {
      u16* G = p.G;
      ph_gemm<false>(p.SGD, 128, p.rw_g_up + (size_t)layer * 128 * RWW, RWW, NTOK, RWW, 128, smem,
                     [&](int row, int col, float v) { G[(size_t)row * RWW + col] = f2bf(v); }, gw, gstride);
      {
        u16* Qo = p.Q; const float* rope = p.ROPE;
        ph_gemm_t(p.QDN, 256, p.mla_q_up + (size_t)layer * 256 * 768, 768, NTOK, 768, 256, smem,
                  [&](const f32x4 (&acc)[4][4], int m0, int n0, int wm, int wn, int lq, int l15) {
          const float qs = 0.10206207261596577f * 1.4426950408889634f;
#pragma unroll
          for (int mi = 0; mi < 4; ++mi)
#pragma unroll
            for (int r = 0; r < 4; ++r) {
              const int tok = m0 + wm * 64 + mi * 16 + lq * 4 + r; const int b = tok / T, t = tok % T;
#pragma unroll
              for (int ni = 0; ni < 4; ++ni) {
                const int col0 = n0 + wn * 64 + ni * 16; const int h = col0 / 96, c0 = col0 % 96;
                u16* qo = Qo + ((size_t)(b * NH + h) * T + t) * 96;
                if (c0 < 64) qo[c0 + l15] = f2bf(acc[mi][ni][r] * qs);
                else if (c0 == 64) {
                  const f32x2 csn = *(const f32x2*)(rope + (size_t)tok * 32 + l15 * 2);
                  const float u1 = acc[mi][ni][r], u2 = acc[mi][(ni + 1) & 3][r];
                  qo[64 + l15] = f2bf((u1 * csn[0] - u2 * csn[1]) * qs);
                  qo[80 + l15] = f2bf((u1 * csn[1] + u2 * csn[0]) * qs);
                }
              }
            }
        }, (gw + gstride - 32 % gstride) % gstride, gstride);
      }
      {
        u16* Ko = p.Kc; u16* Vo = p.Vv;
        ph_gemm_t(p.KVDN, 128, p.mla_kv_up + (size_t)layer * 128 * 1024, 1024, NTOK, 1024, 128, smem,
                  [&](const f32x4 (&acc)[4][4], int m0, int n0, int wm, int wn, int lq, int l15) {
#pragma unroll
          for (int mi = 0; mi < 4; ++mi)
#pragma unroll
            for (int r = 0; r < 4; ++r) {
              const int tok = m0 + wm * 64 + mi * 16 + lq * 4 + r; const int b = tok / T, t = tok % T;
#pragma unroll
              for (int ni = 0; ni < 4; ++ni) {
                const int col0 = n0 + wn * 64 + ni * 16; const int h = col0 >> 7, c0 = col0 & 127;
                const size_t rowi = (size_t)(b * NH + h) * T + t;
                if (c0 < 64) Ko[rowi * 96 + c0 + l15] = f2bf(acc[mi][ni][r]);
                else Vo[rowi * 64 + (c0 - 64) + l15] = f2bf(acc[mi][ni][r]);
              }
            }
        }, (gw + gstride - 192 % gstride) % gstride, gstride);
      }
    }
    PSYNC(7);
    ph_attn(p, smem, p.CTR + layer);
    PSYNC(5);
    ph_mla_norm(p, layer);
    ph_scan3(p, layer, smem);
    PSYNC(6);
    {
      for (int i = blockIdx.x * NTH + tidx(); i < NTOK; i += gridDim.x * NTH) p.TCNT[i] = 0;
      g8::Sched S; S.init(NTOK / 256, DM / 256, gridDim.x, bidx(), p.H, p.WOUT, DM);
      g8::EpiRes E{(layer == 0) ? p.x : p.out, p.out};
      g8::gemm_phase(glds, DM, S, E);
    }
    PSYNC(8);
    ph_norm_router(p, layer, smem);
    PSYNC(9);
    ph_topk(p, smem);
    ph_cvt_experts(p, layer, smem, p.CTR + 4 + layer);
    PSYNC(10);
    {
      g8::Sched S; S.init(NB * NE * CAP / 256, 2048 / 256, gridDim.x, bidx(), p.H, p.EW1, DM);
      S.group(4, NE, (size_t)2048 * 1024 * 2);
      g8::EpiSwi E{p.HID};
      g8::gemm_phase<g8::EpiSwi, true>(glds, DM, S, E, p.IDX, (LAS unsigned*)(dsm + g8::STAGE_BYTES + 64));
    }
    PSYNC(12);
    {
      g8::Sched S; S.init(NB * NE * CAP / 256, DM / 256, gridDim.x, bidx(), p.HID, p.EW2, 1024);
      S.group(4, NE, (size_t)1024 * 1024 * 2);
      g8::EpiYE E{p.YE, p.GATE};
      g8::gemm_phase(glds, 1024, S, E);
    }
    PSYNC(13);
    ph_combine_norm(p, layer);
    PSYNC(16);
    {
      g8::Sched S; S.init(NTOK / 256, DM / 256, gridDim.x, bidx(), p.H, p.WPG, DM);
      g8::EpiSig E{p.PGb};
      g8::gemm_phase(glds, DM, S, E);
    }
    {
      g8::Sched S; S.init(NTOK / 256, DM / 256, gridDim.x, bidx(), p.PB, p.WPP, DPLE);
      g8::EpiPle E{p.out, p.PGb};
      g8::gemm_phase(glds, DPLE, S, E);
    }
    PSYNC(15);
  }
  ph_final_norm(p.out, p.final_norm);
}

extern "C" void kernel_launch(void* const* d_in, const int* in_sizes, int n_in, void* d_out, int out_size, void* d_ws,
                              size_t ws_size, hipStream_t stream) {
  (void)in_sizes; (void)n_in; (void)out_size;
  PK pk{};
  for (int i = 0; i < 31; ++i) pk.in[i] = d_in[i];
  pk.out = (float*)d_out; pk.ws = (char*)d_ws;
  P p{};
  const size_t off = fill_ws(p, (char*)d_ws);
  if (off > ws_size) { fprintf(stderr, "workspace too small: need %zu have %zu\n", off, ws_size); return; }
  static int grid_blocks = 0;
  if (!grid_blocks) {
    int dev = 0, cus = 0, per_cu = 0;
    hipGetDevice(&dev);
    hipDeviceGetAttribute(&cus, hipDeviceAttributeMultiprocessorCount, dev);
    hipFuncSetAttribute((const void*)mega, hipFuncAttributeMaxDynamicSharedMemorySize, DSM_BYTES);
    hipOccupancyMaxActiveBlocksPerMultiprocessor(&per_cu, mega, NTH, DSM_BYTES);
    if (per_cu > 1) per_cu = 1;
    grid_blocks = cus * per_cu;
  }
  hipMemsetAsync(p.CTR, 0, 256 + (size_t)XCD_BAR_WORDS * 4, stream);
  void* args[] = {&pk};
  hipError_t e = hipLaunchCooperativeKernel((void*)mega, dim3(grid_blocks), dim3(NTH), args, DSM_BYTES, stream);
  if (e != hipSuccess) fprintf(stderr, "cooperative launch failed: %s (grid %d)\n", hipGetErrorString(e), grid_blocks);
}
```

```cpp
#include <hip/hip_runtime.h>
#include <hip/hip_bf16.h>
#include <cstdio>
#include <cstdint>
#include <hip/hip_cooperative_groups.h>
namespace cg = cooperative_groups;

#define DI __device__ __forceinline__
#define LAS __attribute__((address_space(3)))

constexpr int NB = 2, T = 8192, NTOK = NB * T, DM = 1024, NL = 2;
constexpr int RWW = 512, RWC = 1920, INC = 2336;
constexpr int NH = 8;
constexpr int NE = 16, CAP = 1024;
constexpr int DPLE = 256;
constexpr int NTH = 512;
constexpr float NORM_EPS = 1e-6f, GN_EPS = 64e-5f;

using bf16x8 = __attribute__((ext_vector_type(8))) short;
using s16x4  = __attribute__((ext_vector_type(4))) short;
using f32x4  = __attribute__((ext_vector_type(4))) float;
using u32x4  = __attribute__((ext_vector_type(4))) unsigned;
using f32x2  = __attribute__((ext_vector_type(2))) float;
using u32x2  = __attribute__((ext_vector_type(2))) unsigned;
typedef __bf16 bf2_t __attribute__((ext_vector_type(2)));
typedef unsigned short u16;

DI unsigned pk2(float a, float b) { bf2_t v = {(__bf16)a, (__bf16)b}; return __builtin_bit_cast(unsigned, v); }
DI u16 f2bf(float a) { return (u16)(pk2(a, 0.f) & 0xffffu); }
DI float bf2f(u16 u) { return __uint_as_float(((unsigned)u) << 16); }
DI const void* uni_ptr(const void* q) {
  unsigned long long v = (unsigned long long)q;
  unsigned lo = __builtin_amdgcn_readfirstlane((unsigned)v), hi = __builtin_amdgcn_readfirstlane((unsigned)(v >> 32));
  return (const void*)(((unsigned long long)hi << 32) | lo);
}
DI int tidx() { int t = threadIdx.x; asm volatile("" : "+v"(t)); return t; }
DI int bidx() { int b = blockIdx.x; asm volatile("" : "+s"(b)); return b; }
template <int CTRL> DI float dpp_f(float v) {
  return __int_as_float(__builtin_amdgcn_update_dpp(__float_as_int(v), __float_as_int(v), CTRL, 0xF, 0xF, true));
}
DI float red_x1(float v) { return v + dpp_f<0xB1>(v); }
DI float red_x2(float v) { return v + dpp_f<0x4E>(v); }
DI float red_x4(float v) { return v + dpp_f<0x141>(v); }
DI float red_x8(float v) { return v + dpp_f<0x140>(v); }
DI float red_x16(float v) { auto r = __builtin_amdgcn_permlane16_swap(__float_as_uint(v), __float_as_uint(v), false, false); return __uint_as_float(r[0]) + __uint_as_float(r[1]); }
DI float red_x32(float v) { auto r = __builtin_amdgcn_permlane32_swap(__float_as_uint(v), __float_as_uint(v), false, false); return __uint_as_float(r[0]) + __uint_as_float(r[1]); }
DI float red16(float v) { return red_x8(red_x4(red_x2(red_x1(v)))); }
DI float wave_sum(float v) { return red_x32(red_x16(red16(v))); }
DI float frcp(float x) { return __builtin_amdgcn_rcpf(x); }
DI float frsq(float x) { return __builtin_amdgcn_rsqf(x); }
DI float fexp(float x) { return __builtin_amdgcn_exp2f(x * 1.4426950408889634f); }
DI float sigmoidf_(float x) { return frcp(1.f + fexp(-x)); }
DI float ftanh(float x) { return 1.f - 2.f * frcp(1.f + fexp(2.f * x)); }
DI s16x4 tr_read(const short* p) {
  return __builtin_amdgcn_ds_read_tr16_b64_v4i16((LAS s16x4*)(p));
}

struct P {
  const float* x; const float* p; const int* pos;
  const float* attn_norm; const float* w_in; const float* rw_mu; const float* rw_w0; const float* rw_w_up;
  const float* rw_a0; const float* rw_a_up; const float* rw_g_up; const float* rw_k_k; const float* rw_k_a;
  const float* rw_r_k; const float* rw_lnx_w; const float* rw_lnx_b; const float* mla_q_norm; const float* mla_q_up;
  const float* mla_kv_norm; const float* mla_kv_up; const float* mla_o_norm; const float* w_out; const float* ffn_norm;
  const float* router; const float* exp_w_gate; const float* exp_w_up; const float* exp_w_down; const float* ple_norm;
  const float* ple_proj; const float* ple_gate; const float* final_norm;
  float* out;
  float* Z;
  u16* LW;
  u16* AA;
  float* MC; float* NC;
  float* SS;
  u16*   G;
  u16*   HID;
  float* R; float* K; float* V;
  float* PG;
  float* QRAW;
  float* KVRAW;
  float* AO;
  u16* O2;
  u16* TWD; u16* AD; u16* SGD; u16* QDN; u16* KVDN; float* KR;
  float* ROPE;
  u16* Q; u16* Kc; u16* Vv;
  u16* H;
  float* AFF;
  int* IDX;
  float* GATE;
  u16* WIN; u16* WOUT; u16* WPG; u16* WPP; u16* PB;
  u16* PGb;
  u16* EW1; u16* EW2;
  u16* XE; u16* YE;
  int* TCNT; int* TLIST;
  unsigned* CTR;
  unsigned* BAR;
};

constexpr int GBM = 256, GBN = 128, GBK = 64;
constexpr int AS_STRIDE = 72, BS_STRIDE = 136;
constexpr int AS_BYTES = GBM * AS_STRIDE * 2;
constexpr int BS_BYTES = GBK * BS_STRIDE * 2;
constexpr int SMEM_BYTES = 57344;

template <bool A_F32, int MODE, class ARow, class Epi>
DI void gemm_tile(ARow arow, const float* __restrict__ B, const float* __restrict__ B2, int ldb, int K, int n0, int Nvalid,
                  char* smem, Epi epi) {
  short* As = (short*)smem;
  short* Bs = (short*)(smem + AS_BYTES);
  const int tid = tidx(), lane = tid & 63, w = tid >> 6;
  const int wm = w >> 1, wn = w & 1;
  const int l15 = lane & 15, lq = lane >> 4;

  const char* ap[4];
#pragma unroll
  for (int i = 0; i < 4; ++i) {
    int u = tid + i * NTH; int row = u >> 3, kc = u & 7;
    ap[i] = (const char*)arow(row) + (size_t)kc * 8 * (A_F32 ? 4 : 2);
  }
  const float* bp[4]; bool bok[4];
#pragma unroll
  for (int i = 0; i < 4; ++i) {
    int u = tid + i * NTH; int k = u >> 5, nq = u & 31;
    int col; const float* base;
    if (MODE != 1) { col = n0 + nq * 4; base = B; }
    else { col = n0 + (nq & 15) * 4; base = (nq < 16) ? B : B2; }
    bok[i] = col < Nvalid;
    bp[i] = base + (size_t)k * ldb + (bok[i] ? col : 0);
  }

  f32x4 acc[4][4];
#pragma unroll
  for (int i = 0; i < 4; ++i)
#pragma unroll
    for (int j = 0; j < 4; ++j) acc[i][j] = f32x4{0.f, 0.f, 0.f, 0.f};

  u32x4 areg[4]; f32x4 breg[4];
#define GLOAD(kt_)                                                                                   \
  {                                                                                                  \
    _Pragma("unroll") for (int i = 0; i < 4; ++i) {                                                  \
      if (A_F32) {                                                                                   \
        const float4* q = (const float4*)(ap[i] + (size_t)(kt_) * GBK * 4);                          \
        float4 v0 = q[0], v1 = q[1];                                                                 \
        areg[i] = u32x4{pk2(v0.x, v0.y), pk2(v0.z, v0.w), pk2(v1.x, v1.y), pk2(v1.z, v1.w)};         \
      } else {                                                                                       \
        areg[i] = *(const u32x4*)(ap[i] + (size_t)(kt_) * GBK * 2);                                  \
      }                                                                                              \
    }                                                                                                \
    _Pragma("unroll") for (int i = 0; i < 4; ++i) {                                                  \
      if (bok[i]) breg[i] = *(const f32x4*)(bp[i] + (size_t)(kt_) * GBK * ldb);                      \
      else breg[i] = f32x4{0.f, 0.f, 0.f, 0.f};                                                      \
    }                                                                                                \
  }
  const int nk = K / GBK;
  GLOAD(0)
  for (int kt = 0; kt < nk; ++kt) {
    __syncthreads();
#pragma unroll
    for (int i = 0; i < 4; ++i) {
      int u = tid + i * NTH; int row = u >> 3, kc = u & 7;
      *(u32x4*)(As + row * AS_STRIDE + kc * 8) = areg[i];
    }
#pragma unroll
    for (int i = 0; i < 4; ++i) {
      int u = tid + i * NTH; int k = u >> 5, nq = u & 31;
      u32x2 v = u32x2{pk2(breg[i][0], breg[i][1]), pk2(breg[i][2], breg[i][3])};
      *(u32x2*)(Bs + k * BS_STRIDE + nq * 4) = v;
    }
    __syncthreads();
    if (kt + 1 < nk) GLOAD(kt + 1)
#pragma unroll
    for (int ks = 0; ks < 2; ++ks) {
      bf16x8 a[4], b[4];
#pragma unroll
      for (int mi = 0; mi < 4; ++mi)
        a[mi] = *(const bf16x8*)(As + (wm * 64 + mi * 16 + l15) * AS_STRIDE + ks * 32 + 8 * lq);
#pragma unroll
      for (int ni = 0; ni < 4; ++ni) {
        int col0 = (MODE != 1) ? (wn * 64 + ni * 16) : ((ni < 2) ? (wn * 32 + ni * 16) : (64 + wn * 32 + (ni - 2) * 16));
        int kb = ks * 32 + 8 * lq; int q = l15 >> 2, pp = l15 & 3;
        s16x4 lo = tr_read(Bs + (kb + q) * BS_STRIDE + col0 + 4 * pp);
        s16x4 hi = tr_read(Bs + (kb + 4 + q) * BS_STRIDE + col0 + 4 * pp);
        b[ni] = __builtin_shufflevector(lo, hi, 0, 1, 2, 3, 4, 5, 6, 7);
      }
#pragma unroll
      for (int mi = 0; mi < 4; ++mi)
#pragma unroll
        for (int ni = 0; ni < 4; ++ni)
          acc[mi][ni] = __builtin_amdgcn_mfma_f32_16x16x32_bf16(a[mi], b[ni], acc[mi][ni], 0, 0, 0);
    }
  }
  if constexpr (MODE == 2) { epi(acc, wm, wn, lq, l15); return; }
  else {
#pragma unroll
  for (int mi = 0; mi < 4; ++mi)
#pragma unroll
    for (int r = 0; r < 4; ++r) {
      int row = wm * 64 + mi * 16 + lq * 4 + r;
      if (MODE == 0) {
#pragma unroll
        for (int ni = 0; ni < 4; ++ni) {
          int col = n0 + wn * 64 + ni * 16 + l15;
          if (col < Nvalid) epi(row, col, acc[mi][ni][r], 0.f);
        }
      } else {
#pragma unroll
        for (int ni = 0; ni < 2; ++ni) {
          int col = n0 + wn * 32 + ni * 16 + l15;
          epi(row, col, acc[mi][ni][r], acc[mi][ni + 2][r]);
        }
      }
    }
  }
}

DI void ph_norm(const float* __restrict__ X, const float* __restrict__ g, u16* __restrict__ Hout) {
  const int tid_ = tidx(); const int lane = tid_ & 63, w = tid_ >> 6;
  for (int tok = blockIdx.x * 8 + w; tok < NTOK; tok += gridDim.x * 8) {
    const float4* xr = (const float4*)(X + (size_t)tok * DM);
    float4 v[4]; float ss = 0.f;
#pragma unroll
    for (int j = 0; j < 4; ++j) { v[j] = xr[lane + 64 * j]; ss += v[j].x * v[j].x + v[j].y * v[j].y + v[j].z * v[j].z + v[j].w * v[j].w; }
    ss = wave_sum(ss);
    float rstd = frsq(ss * (1.f / DM) + NORM_EPS);
#pragma unroll
    for (int j = 0; j < 4; ++j) {
      float4 gg = ((const float4*)g)[lane + 64 * j];
      uint2 o = uint2{pk2(v[j].x * rstd * gg.x, v[j].y * rstd * gg.y), pk2(v[j].z * rstd * gg.z, v[j].w * rstd * gg.w)};
      *(uint2*)(Hout + (size_t)tok * DM + (lane + 64 * j) * 4) = o;
    }
  }
}

DI void ph_final_norm(float* __restrict__ X, const float* __restrict__ g) {
  const int tid_ = tidx(); const int lane = tid_ & 63, w = tid_ >> 6;
  for (int tok = blockIdx.x * 8 + w; tok < NTOK; tok += gridDim.x * 8) {
    float4* xr = (float4*)(X + (size_t)tok * DM);
    float4 v[4]; float ss = 0.f;
#pragma unroll
    for (int j = 0; j < 4; ++j) { v[j] = xr[lane + 64 * j]; ss += v[j].x * v[j].x + v[j].y * v[j].y + v[j].z * v[j].z + v[j].w * v[j].w; }
    ss = wave_sum(ss);
    float rstd = frsq(ss * (1.f / DM) + NORM_EPS);
#pragma unroll
    for (int j = 0; j < 4; ++j) {
      float4 gg = ((const float4*)g)[lane + 64 * j];
      xr[lane + 64 * j] = float4{v[j].x * rstd * gg.x, v[j].y * rstd * gg.y, v[j].z * rstd * gg.z, v[j].w * rstd * gg.w};
    }
  }
}

template <bool A_F32, class Epi>
DI void ph_gemm(const void* A, int lda, const float* B, int ldb, int M, int N, int K, char* smem, Epi epi, int tfirst, int tstride) {
  const int ntn = (N + GBN - 1) / GBN, ntm = M / GBM;
  for (int t = tfirst; t < ntm * ntn; t += tstride) {
    int tm = t / ntn, tn = t % ntn;
    int m0 = tm * GBM, n0 = tn * GBN;
    auto arow = [&](int r) -> const void* { return (const char*)A + (size_t)(m0 + r) * lda * (A_F32 ? 4 : 2); };
    gemm_tile<A_F32, 0>(arow, B, nullptr, ldb, K, n0, N, smem, [&](int row, int col, float v, float) { epi(m0 + row, col, v); });
    __syncthreads();
  }
}

template <class Epi>
DI void ph_gemm_t(const void* A, int lda, const float* B, int ldb, int M, int N, int K, char* smem, Epi epi, int tfirst, int tstride) {
  const int ntn = (N + GBN - 1) / GBN, ntm = M / GBM;
  for (int t = tfirst; t < ntm * ntn; t += tstride) {
    int tm = t / ntn, tn = t % ntn;
    int m0 = tm * GBM, n0 = tn * GBN;
    auto arow = [&](int r) -> const void* { return (const char*)A + (size_t)(m0 + r) * lda * 2; };
    gemm_tile<false, 2>(arow, B, nullptr, ldb, K, n0, N, smem,
                        [&](const f32x4 (&acc)[4][4], int wm, int wn, int lq, int l15) { epi(acc, m0, n0, wm, wn, lq, l15); });
    __syncthreads();
  }
}

DI void ph_rwshift(const P& p, int layer) {
  const int tid_ = tidx();
  const int per = (NTOK + (int)gridDim.x - 1) / (int)gridDim.x;
  const int t0 = (int)blockIdx.x * per, t1 = (t0 + per < NTOK) ? t0 + per : NTOK;
  if (tid_ < RWC / 4 && t0 < t1) {
    const int c = tid_ * 4;
    const f32x4 m = *(const f32x4*)(p.rw_mu + layer * RWC + c);
    const float* zc = p.Z + c;
    const f32x4 zero = f32x4{0.f, 0.f, 0.f, 0.f};
    constexpr int U = 8;
    f32x4 w[U + 2];
    w[0] = (t0 > 0) ? *(const f32x4*)(zc + (size_t)(t0 - 1) * INC) : zero;
    w[1] = *(const f32x4*)(zc + (size_t)t0 * INC);
    for (int tb = t0; tb < t1; tb += U) {
#pragma unroll
      for (int u = 0; u < U; ++u) { const int tn = tb + u + 1; w[u + 2] = (tn < NTOK && tn <= t1) ? *(const f32x4*)(zc + (size_t)tn * INC) : zero; }
#pragma unroll
      for (int u = 0; u < U; ++u) {
        const int tok = tb + u;
        if (tok < t1) {
          const int t = tok % T;
          const f32x4 zm = (t > 0) ? w[u] : zero, zp = (t < T - 1) ? w[u + 2] : zero, z = w[u + 1];
          const f32x4 o = z + m * (0.5f * (zm + zp) - z);
          if (c < 512) *(f32x4*)(p.R + (size_t)tok * RWW + c) = o;
          else if (c < 1024) *(f32x4*)(p.K + (size_t)tok * RWW + (c - 512)) = o;
          else if (c < 1536) *(f32x4*)(p.V + (size_t)tok * RWW + (c - 1024)) = o;
          else if (c < 1664) {
            const int d = (c - 1536) >> 6, l = (c - 1536) & 63;
            *(u32x2*)(p.TWD + ((size_t)d * NTOK + tok) * 64 + l) = u32x2{pk2(ftanh(o[0]), ftanh(o[1])), pk2(ftanh(o[2]), ftanh(o[3]))};
          } else if (c < 1792) {
            const int d = (c - 1664) >> 6, l = (c - 1664) & 63;
            *(u32x2*)(p.AD + ((size_t)d * NTOK + tok) * 64 + l) = u32x2{pk2(o[0], o[1]), pk2(o[2], o[3])};
          } else {
            const int l = c - 1792;
            *(u32x2*)(p.SGD + (size_t)tok * 128 + l) = u32x2{pk2(sigmoidf_(o[0]), sigmoidf_(o[1])), pk2(sigmoidf_(o[2]), sigmoidf_(o[3]))};
          }
        }
      }
      w[0] = w[U]; w[1] = w[U + 1];
    }
  }
}

DI void rope_cs(int pos, int i, float& cs, float& sn) {
  const int i3 = i & 3, i2 = i >> 2;
  const float c4 = (i3 == 0) ? 1.0f : (i3 == 1) ? 0.5623413251903491f : (i3 == 2) ? 0.31622776601683794f : 0.1778279410038923f;
  const float p10 = (i2 == 0) ? 1.0f : (i2 == 1) ? 0.1f : (i2 == 2) ? 0.01f : 0.001f;
  float inv = c4 * p10;
  float ang = (float)pos * inv;
  double rev = (double)ang * 0.15915494309189535;
  rev -= floor(rev);
  float rf = (float)rev;
  sn = __builtin_amdgcn_sinf(rf);
  cs = __builtin_amdgcn_cosf(rf);
}

DI void ph_rope_table(const P& p) {
  for (int i = blockIdx.x * NTH + tidx(); i < NTOK * 16; i += gridDim.x * NTH) {
    float cs, sn; rope_cs(p.pos[i >> 4], i & 15, cs, sn);
    *(f32x2*)(p.ROPE + (size_t)i * 2) = f32x2{cs, sn};
  }
}
DI void ph_mlaprep1(const P& p, int layer) {
  const int tid_ = tidx(); const int lane = tid_ & 63, w = tid_ >> 6;
  const f32x4 g = *(const f32x4*)(p.mla_q_norm + layer * 256 + lane * 4);
  const f32x2 g2 = *(const f32x2*)(p.mla_kv_norm + layer * 128 + lane * 2);
  const int per = (NTOK + (int)gridDim.x - 1) / (int)gridDim.x;
  const int t0 = (int)blockIdx.x * per, t1 = (t0 + per < NTOK) ? t0 + per : NTOK;
  constexpr int U = 4;
  for (int tb = t0 + w * U; tb < t1; tb += 8 * U) {
    f32x4 q[U]; f32x2 kv[U]; float u1[U], u2[U]; f32x2 csn[U];
#pragma unroll
    for (int u = 0; u < U; ++u) {
      const int tok = (tb + u < t1) ? tb + u : t1 - 1;
      const float* zr = p.Z + (size_t)tok * INC + RWC;
      q[u] = *(const f32x4*)(zr + lane * 4); kv[u] = *(const f32x2*)(zr + 256 + lane * 2);
      u1[u] = zr[384 + (lane & 15)]; u2[u] = zr[384 + 16 + (lane & 15)];
      csn[u] = *(const f32x2*)(p.ROPE + (size_t)tok * 32 + (lane & 15) * 2);
    }
#pragma unroll
    for (int u = 0; u < U; ++u) {
      const int tok = tb + u;
      const float ss = wave_sum(q[u][0] * q[u][0] + q[u][1] * q[u][1] + q[u][2] * q[u][2] + q[u][3] * q[u][3]);
      const float rstd = frsq(ss * (1.f / 256) + NORM_EPS);
      const float ss2 = wave_sum(kv[u][0] * kv[u][0] + kv[u][1] * kv[u][1]);
      const float rstd2 = frsq(ss2 * (1.f / 128) + NORM_EPS);
      if (tok < t1) {
        *(u32x2*)(p.QDN + (size_t)tok * 256 + lane * 4) = u32x2{pk2(q[u][0] * rstd * g[0], q[u][1] * rstd * g[1]), pk2(q[u][2] * rstd * g[2], q[u][3] * rstd * g[3])};
        *(unsigned*)(p.KVDN + (size_t)tok * 128 + lane * 2) = pk2(kv[u][0] * rstd2 * g2[0], kv[u][1] * rstd2 * g2[1]);
        if (lane < 16) {
          const u16 k1 = f2bf(u1[u] * csn[u][0] - u2[u] * csn[u][1]), k2 = f2bf(u1[u] * csn[u][1] + u2[u] * csn[u][0]);
          const int bb = tok / T, tt = tok % T;
#pragma unroll
          for (int h = 0; h < NH; ++h) {
            u16* ko = p.Kc + ((size_t)(bb * NH + h) * T + tt) * 96 + 64;
            ko[lane] = k1; ko[16 + lane] = k2;
          }
        }
      }
    }
  }
}

DI void ph_mlafinish(const P& p) {
  const int tid_ = tidx(); const int lane = tid_ & 63, w = tid_ >> 6;
  const float qs = 0.10206207261596577f * 1.4426950408889634f;
  for (int tok = blockIdx.x * 8 + w; tok < NTOK; tok += gridDim.x * 8) {
    int b = tok / T, t = tok % T;
    float cs = 0.f, sn = 0.f;
    if (lane < 16) rope_cs(p.pos[tok], lane, cs, sn);
    const float* qr = p.QRAW + (size_t)tok * 768;
    const float* kvr = p.KVRAW + (size_t)tok * 1024;
    const float* kr = p.KR + (size_t)tok * 32;
#pragma unroll
    for (int h = 0; h < NH; ++h) {
      size_t row = ((size_t)(b * NH + h) * T + t);
      u16* qo = p.Q + row * 96; u16* ko = p.Kc + row * 96; u16* vo = p.Vv + row * 64;
      qo[lane] = f2bf(qr[h * 96 + lane] * qs);
      ko[lane] = f2bf(kvr[h * 128 + lane]);
      vo[lane] = f2bf(kvr[h * 128 + 64 + lane]);
      if (lane < 16) {
        float u1 = qr[h * 96 + 64 + lane], u2 = qr[h * 96 + 80 + lane];
        qo[64 + lane] = f2bf((u1 * cs - u2 * sn) * qs);
        qo[80 + lane] = f2bf((u1 * sn + u2 * cs) * qs);
      }
      if (lane < 32) ko[64 + lane] = f2bf(kr[lane]);
    }
  }
}

using f32x16 = __attribute__((ext_vector_type(16))) float;
#define SBAR() __builtin_amdgcn_sched_barrier(0)
constexpr int AT_KSTR = 104;
constexpr int AT_KBYTES = 64 * AT_KSTR * 2;
constexpr int AT_VBYTES = 64 * 64 * 2;
constexpr float AT_THR = 8.f;
DI int crow(int r, int hi) { return (r & 3) + 8 * (r >> 2) + 4 * hi; }
DI int v_st(int k, int c) { const int kk = (k & ~0xC) | ((k & 4) << 1) | ((k & 8) >> 1); return ((kk >> 3) * 2 + (c >> 5)) * 512 + ((kk & 7) * 32 + (c & 31)) * 2; }
DI int v_rd_base(int lane) { return ((lane & 3) << 3) | (((lane >> 2) & 3) << 6) | (((lane >> 4) & 1) << 5) | (((lane >> 5) & 1) << 8); }
constexpr int v_rd_off(int d0, int ks, int half) { return d0 * 512 + ks * 2048 + half * 1024; }

DI void at_partialSM(f32x16& p0, f32x16& p1, float& m_reg, float& mn, float& alpha) {
  float pmax = p0[0];
#pragma unroll
  for (int r = 1; r < 16; ++r) pmax = fmaxf(pmax, p0[r]);
#pragma unroll
  for (int r = 0; r < 16; ++r) pmax = fmaxf(pmax, p1[r]);
  { auto rr = __builtin_amdgcn_permlane32_swap(__float_as_uint(pmax), __float_as_uint(pmax), false, false);
    pmax = fmaxf(__uint_as_float(rr[0]), __uint_as_float(rr[1])); }
  if (__builtin_expect(__all(pmax - m_reg <= AT_THR), 1)) { mn = m_reg; alpha = 1.f; }
  else { mn = fmaxf(m_reg, pmax); alpha = __builtin_amdgcn_exp2f(m_reg - mn); m_reg = mn; }
#pragma unroll
  for (int r = 0; r < 16; ++r) { p0[r] = p0[r] - mn; p1[r] = p1[r] - mn; }
#pragma unroll
  for (int r = 0; r < 16; ++r) p0[r] = __builtin_amdgcn_exp2f(p0[r]);
}
DI void at_finishSM(f32x16& p0, f32x16& p1, float alpha, float& l_reg, bf16x8& pa0, bf16x8& pa1, bf16x8& pa2, bf16x8& pa3) {
#pragma unroll
  for (int r = 0; r < 16; ++r) p1[r] = __builtin_amdgcn_exp2f(p1[r]);
  float ps = 0;
#pragma unroll
  for (int r = 0; r < 16; ++r) ps += p0[r];
#pragma unroll
  for (int r = 0; r < 16; ++r) ps += p1[r];
  { auto rr = __builtin_amdgcn_permlane32_swap(__float_as_uint(ps), __float_as_uint(ps), false, false);
    ps = __uint_as_float(rr[0]) + __uint_as_float(rr[1]); }
  l_reg = l_reg * alpha + ps;
#define PK4(PP, BASE, OUT) do { unsigned a0 = pk2(PP[BASE + 0], PP[BASE + 1]), a1 = pk2(PP[BASE + 2], PP[BASE + 3]);   \
    unsigned b0 = pk2(PP[BASE + 4], PP[BASE + 5]), b1 = pk2(PP[BASE + 6], PP[BASE + 7]);                              \
    auto r0 = __builtin_amdgcn_permlane32_swap(a0, b0, false, false); auto r1 = __builtin_amdgcn_permlane32_swap(a1, b1, false, false); \
    u32x4 wv = {r0[0], r1[0], r0[1], r1[1]}; OUT = __builtin_bit_cast(bf16x8, wv); } while (0)
  PK4(p0, 0, pa0); PK4(p0, 8, pa1); PK4(p1, 0, pa2); PK4(p1, 8, pa3);
#undef PK4
}
DI void at_qkt(f32x16& p0, f32x16& p1, const char* Kb, const bf16x8* qr, int r32, int hi) {
#pragma unroll
  for (int r = 0; r < 16; ++r) { p0[r] = 0.f; p1[r] = 0.f; }
#pragma unroll
  for (int d0 = 0; d0 < 6; ++d0) {
    bf16x8 b0 = *(const bf16x8*)(Kb + (r32 * AT_KSTR + d0 * 16 + hi * 8) * 2);
    bf16x8 b1 = *(const bf16x8*)(Kb + ((32 + r32) * AT_KSTR + d0 * 16 + hi * 8) * 2);
    __builtin_amdgcn_s_setprio(1);
    p0 = __builtin_amdgcn_mfma_f32_32x32x16_bf16(b0, qr[d0], p0, 0, 0, 0);
    p1 = __builtin_amdgcn_mfma_f32_32x32x16_bf16(b1, qr[d0], p1, 0, 0, 0);
    __builtin_amdgcn_s_setprio(0);
  }
}
template <int D0> DI void at_pv_one(f32x16& od, const char* vb, bf16x8 pa0, bf16x8 pa1, bf16x8 pa2, bf16x8 pa3) {
#define TRR(ks, half) tr_read((const short*)(vb + v_rd_off(D0, ks, half)))
  const s16x4 l0 = TRR(0, 0), h0 = TRR(0, 1), l1 = TRR(1, 0), h1 = TRR(1, 1), l2 = TRR(2, 0), h2 = TRR(2, 1), l3 = TRR(3, 0), h3 = TRR(3, 1);
#undef TRR
#define PKV(L, H) __builtin_shufflevector(L, H, 0, 1, 2, 3, 4, 5, 6, 7)
  __builtin_amdgcn_s_setprio(1);
  od = __builtin_amdgcn_mfma_f32_32x32x16_bf16(pa0, PKV(l0, h0), od, 0, 0, 0);
  od = __builtin_amdgcn_mfma_f32_32x32x16_bf16(pa1, PKV(l1, h1), od, 0, 0, 0);
  od = __builtin_amdgcn_mfma_f32_32x32x16_bf16(pa2, PKV(l2, h2), od, 0, 0, 0);
  od = __builtin_amdgcn_mfma_f32_32x32x16_bf16(pa3, PKV(l3, h3), od, 0, 0, 0);
  __builtin_amdgcn_s_setprio(0);
#undef PKV
}
DI void at_pv(f32x16* o, const char* vb, bf16x8 pa0, bf16x8 pa1, bf16x8 pa2, bf16x8 pa3) {
  at_pv_one<0>(o[0], vb, pa0, pa1, pa2, pa3); at_pv_one<1>(o[1], vb, pa0, pa1, pa2, pa3);
}

DI void attn_body(const u16* __restrict__ Qb, const u16* __restrict__ Kh, const u16* __restrict__ Vh, float* __restrict__ Ob, char* lds, int tid) {
  const int wid = tid >> 6, lane = tid & 63, r32 = lane & 31, hi = lane >> 5;
  char* V_lds = lds; char* K_lds = lds + 2 * AT_VBYTES;
  float* wsp = (float*)(lds + 2 * AT_VBYTES + 2 * AT_KBYTES) + wid * 64; float* li_l = wsp; float* al_l = wsp + 32;
  float m_reg = -1e30f, l_reg = 0.f; f32x16 o[2]; bf16x8 qr[6];
#pragma unroll
  for (int r = 0; r < 16; ++r) { o[0][r] = 0.f; o[1][r] = 0.f; }
  const u16* Qw = Qb + (size_t)(wid * 32 + r32) * 96 + hi * 8;
#pragma unroll
  for (int d0 = 0; d0 < 6; ++d0) qr[d0] = *(const bf16x8*)(Qw + d0 * 16);
  const int kid1 = (tid < 256) ? tid + 512 : tid;
  const int kst0 = ((tid / 12) * AT_KSTR + (tid % 12) * 8) * 2, kst1 = ((kid1 / 12) * AT_KSTR + (kid1 % 12) * 8) * 2;
  const int vst = v_st(tid >> 3, (tid & 7) * 8);
  const char* vb0 = V_lds + v_rd_base(lane);
  u32x4 sk0[2], sk1[2], sv0[2];
#define SLOAD(i, k0) do { sk0[i] = *(const u32x4*)(Kh + (size_t)(k0) * 96 + tid * 8); sk1[i] = *(const u32x4*)(Kh + (size_t)(k0) * 96 + kid1 * 8); \
    sv0[i] = *(const u32x4*)(Vh + (size_t)(k0) * 64 + tid * 8); } while (0)
#define SWRITE(b, i) do { *(u32x4*)(K_lds + (b) * AT_KBYTES + kst0) = sk0[i]; if (tid < 256) *(u32x4*)(K_lds + (b) * AT_KBYTES + kst1) = sk1[i]; \
    *(u32x4*)(V_lds + (b) * AT_VBYTES + vst) = sv0[i]; } while (0)
#define SWAIT() asm volatile("s_waitcnt vmcnt(3)" ::: "memory")
#define RESC(a) do { if (__any((a) < 1.f)) { if (hi == 0) al_l[r32] = (a); asm volatile("s_waitcnt lgkmcnt(0)" ::: "memory"); \
    _Pragma("unroll") for (int r = 0; r < 16; ++r) { float al = al_l[crow(r, hi)]; o[0][r] *= al; o[1][r] *= al; } } } while (0)
  f32x16 pA0, pA1, pB0, pB1; float mnA, mnB, alA, alB; bf16x8 pa0, pa1, pa2, pa3; constexpr int NT = T / 64;
  SLOAD(0, 0); SWRITE(0, 0); __syncthreads();
  at_qkt(pA0, pA1, K_lds, qr, r32, hi); at_partialSM(pA0, pA1, m_reg, mnA, alA);
  SLOAD(1, 64); SLOAD(0, 128);
  SWAIT(); SWRITE(1, 1); __syncthreads();
  for (int j = 1; j + 1 < NT; j += 2) {
    SBAR(); at_qkt(pB0, pB1, K_lds + AT_KBYTES, qr, r32, hi);
    at_finishSM(pA0, pA1, alA, l_reg, pa0, pa1, pa2, pa3); SBAR();
    SLOAD(1, (j + 2) * 64); SBAR();
    at_pv(o, vb0, pa0, pa1, pa2, pa3); at_partialSM(pB0, pB1, m_reg, mnB, alB);
    __syncthreads(); SWAIT(); SWRITE(0, 0);
    RESC(alB); __syncthreads();
    SBAR(); at_qkt(pA0, pA1, K_lds, qr, r32, hi);
    at_finishSM(pB0, pB1, alB, l_reg, pa0, pa1, pa2, pa3); SBAR();
    if (j + 3 < NT) SLOAD(0, (j + 3) * 64); SBAR();
    at_pv(o, vb0 + AT_VBYTES, pa0, pa1, pa2, pa3); at_partialSM(pA0, pA1, m_reg, mnA, alA);
    __syncthreads(); SWAIT(); SWRITE(1, 1);
    RESC(alA); __syncthreads();
  }
  SBAR(); at_qkt(pB0, pB1, K_lds + AT_KBYTES, qr, r32, hi);
  at_finishSM(pA0, pA1, alA, l_reg, pa0, pa1, pa2, pa3); SBAR();
  at_pv(o, vb0, pa0, pa1, pa2, pa3); at_partialSM(pB0, pB1, m_reg, mnB, alB);
  __syncthreads(); RESC(alB);
  at_finishSM(pB0, pB1, alB, l_reg, pa0, pa1, pa2, pa3); SBAR();
  at_pv(o, vb0 + AT_VBYTES, pa0, pa1, pa2, pa3);
  if (hi == 0) li_l[r32] = l_reg;
  asm volatile("s_waitcnt lgkmcnt(0)" ::: "memory");
  float* Ow = Ob + (size_t)(wid * 32) * 512;
#pragma unroll
  for (int r = 0; r < 16; ++r) {
    int orow = crow(r, hi); float rl = __builtin_amdgcn_rcpf(li_l[orow]);
    Ow[(size_t)orow * 512 + r32] = o[0][r] * rl; Ow[(size_t)orow * 512 + 32 + r32] = o[1][r] * rl;
  }
#undef SLOAD
#undef SWRITE
#undef SWAIT
#undef RESC
}

DI void ph_attn(const P& p, char* smem, unsigned* ctr) {
  const int tid = tidx();
  int* sitem = (int*)(smem + SMEM_BYTES - 16);
  for (;;) {
    __syncthreads();
    if (tid == 0) *sitem = (int)atomicAdd(ctr, 1u);
    __syncthreads();
    const int item = *sitem;
    if (item >= NB * NH * (T / 256)) break;
    const int bh = item / (T / 256), qb = item % (T / 256);
    const int b = bh / NH, h = bh % NH;
    attn_body(p.Q + ((size_t)bh * T + qb * 256) * 96, p.Kc + (size_t)bh * T * 96, p.Vv + (size_t)bh * T * 64,
              p.AO + ((size_t)(b * T + qb * 256)) * 512 + h * 64, smem, tid);
  }
}

constexpr int SC = 256, NCH = T / SC;
constexpr int SBUF = 5184;
template <int NI> struct ScanRegsN { float k[2 * NI], r[2 * NI], v[2 * NI]; u16 lw[2 * NI], a[2 * NI]; };
template <int NI>
DI void scan_load_n(const P& p, int b, int h, int d, int n0, int lane, int ws, ScanRegsN<NI>& g) {
  constexpr int WPI = 8 / NI;
  const u16* LWd = p.LW + (size_t)d * NTOK * RWW;
  const u16* AAd = p.AA + (size_t)d * NTOK * RWW;
  const int ch = h * 64 + lane;
#pragma unroll
  for (int jj = 0; jj < 2 * NI; ++jj) {
    int n = n0 + ws + WPI * jj; int t = d ? (T - 1 - n) : n;
    size_t off = ((size_t)(b * T + t)) * RWW + ch;
    g.k[jj] = p.K[off]; g.r[jj] = p.R[off]; g.v[jj] = p.V[off]; g.lw[jj] = LWd[off]; g.a[jj] = AAd[off];
  }
}
template <int NI>
DI void scan_put_n(const ScanRegsN<NI>& g, float kkc, float kac, float* sm, float* slw, int lane, int ws) {
  constexpr int WPI = 8 / NI;
#pragma unroll
  for (int jj = 0; jj < 2 * NI; ++jj) slw[(ws + WPI * jj) * 64 + lane] = bf2f(g.lw[jj]);
  __syncthreads();
  float Lj[2 * NI];
#pragma unroll
  for (int jj = 0; jj < 2 * NI; ++jj) Lj[jj] = 0.f;
#pragma unroll
  for (int i = 0; i < 16; ++i) {
    const float x = slw[i * 64 + lane];
#pragma unroll
    for (int jj = 0; jj < 2 * NI; ++jj) Lj[jj] += (i <= ws + WPI * jj) ? x : 0.f;
  }
#pragma unroll
  for (int jj = 0; jj < 2 * NI; ++jj) {
    const int j = ws + WPI * jj;
    const float L = Lj[jj], lwj = bf2f(g.lw[jj]);
    const float Pt = fexp(L), Pm = fexp(L - lwj), iP = fexp(-L);
    const float kv = g.k[jj];
    const float kx = kv * kkc;
    const float nrm = __builtin_amdgcn_sqrtf(wave_sum(kx * kx));
    const float kkv = kx * frcp(fmaxf(nrm, 1e-12f));
    const float a = bf2f(g.a[jj]);
    sm[j * 64 + lane] = -kkv * Pm;
    sm[1024 + j * 64 + lane] = a * kkv * iP;
    sm[2048 + j * 64 + lane] = kv * (1.f + (a - 1.f) * kac) * iP;
    sm[3072 + j * 64 + lane] = g.r[jj] * Pt;
    sm[4096 + j * 64 + lane] = g.v[jj];
    if (j == 15) sm[5120 + lane] = Pt;
  }
}
using f32x16s = __attribute__((ext_vector_type(16))) float;
DI void scan_ld8(f32x4 (&kv)[8], const float* vec, int hi) {
#pragma unroll
  for (int tk = 0; tk < 2; ++tk)
#pragma unroll
    for (int q = 0; q < 4; ++q) kv[tk * 4 + q] = *(const f32x4*)(vec + 32 * tk + 8 * q + 4 * hi);
}
DI float scan_dot8(const f32x16s (&acc)[2], const f32x4 (&kv)[8]) {
  float pq[4] = {0.f, 0.f, 0.f, 0.f};
#pragma unroll
  for (int tk = 0; tk < 2; ++tk)
#pragma unroll
    for (int e = 0; e < 4; ++e)
#pragma unroll
      for (int q = 0; q < 4; ++q) { pq[q] = __builtin_fmaf(acc[tk][4 * q + e], kv[tk * 4 + q][e], pq[q]); asm("" : "+v"(pq[q])); }
  return red_x32((pq[0] + pq[1]) + (pq[2] + pq[3]));
}

DI void ph_scan1(const P& p, int layer, char* smem) {
  constexpr int NI = 2;
  const int tid = tidx(), lane = tid & 63, w = tid >> 6;
  const int jl = lane & 31, hi = lane >> 5;
  const int it = w >> 2, vt = w & 3, ws = w & 3;
  float* smi = (float*)smem + it * (2 * SBUF + 1024);
  float* slw = smi + 2 * SBUF;
  for (int pair = blockIdx.x; pair < 32 * NCH / 2; pair += gridDim.x) {
    const int item = pair * 2 + it; const int scan = item / NCH, c = item % NCH;
    const int d = scan & 1, h = (scan >> 1) % NH, b = scan / (2 * NH);
    const float kkc = p.rw_k_k[layer * RWW + h * 64 + lane], kac = p.rw_k_a[layer * RWW + h * 64 + lane];
    f32x16s acc[2];
#pragma unroll
    for (int tk = 0; tk < 2; ++tk)
#pragma unroll
      for (int r = 0; r < 16; ++r) acc[tk][r] = (32 * tk + (r & 3) + 8 * (r >> 2) + 4 * hi == 32 * vt + jl) ? 1.f : 0.f;
    ScanRegsN<NI> g;
    scan_load_n<NI>(p, b, h, d, c * SC, lane, ws, g);
    __syncthreads();
    scan_put_n<NI>(g, kkc, kac, smi, slw, lane, ws);
    __syncthreads();
    for (int sub = 0; sub < SC / 16; ++sub) {
      const float* sm = smi + (sub & 1) * SBUF;
      if (sub + 1 < SC / 16) scan_load_n<NI>(p, b, h, d, c * SC + (sub + 1) * 16, lane, ws, g);
      const float* vrow = sm + 4096 + ((vt >= 2) ? 32 * (vt - 2) : 0) + jl;
      f32x4 kc[8]; scan_ld8(kc, sm, hi);
      float a0 = sm[1024 + hi * 1024 + jl], a1 = sm[1024 + hi * 1024 + 32 + jl], vc = vrow[0];
#pragma unroll 4
      for (int j = 0; j < 16; ++j) {
        const int jn = (j + 1) & 15;
        f32x4 kn[8]; scan_ld8(kn, sm + jn * 64, hi);
        const float an0 = sm[1024 + hi * 1024 + jn * 64 + jl], an1 = sm[1024 + hi * 1024 + jn * 64 + 32 + jl], vn = vrow[jn * 64];
        SBAR();
        const float sa = scan_dot8(acc, kc);
        const float bop = hi ? ((vt >= 2) ? vc : 0.f) : sa;
        acc[0] = __builtin_amdgcn_mfma_f32_32x32x2f32(a0, bop, acc[0], 0, 0, 0);
        acc[1] = __builtin_amdgcn_mfma_f32_32x32x2f32(a1, bop, acc[1], 0, 0, 0);
        SBAR();
#pragma unroll
        for (int i = 0; i < 8; ++i) kc[i] = kn[i];
        a0 = an0; a1 = an1; vc = vn;
      }
#pragma unroll
      for (int tk = 0; tk < 2; ++tk)
#pragma unroll
        for (int q = 0; q < 4; ++q) {
          const f32x4 pv = *(const f32x4*)(sm + 5120 + 32 * tk + 8 * q + 4 * hi);
#pragma unroll
          for (int e = 0; e < 4; ++e) acc[tk][4 * q + e] *= pv[e];
        }
      if (sub + 1 < SC / 16) scan_put_n<NI>(g, kkc, kac, smi + ((sub + 1) & 1) * SBUF, slw, lane, ws);
      __syncthreads();
    }
    {
      const int v = 32 * vt + jl;
      float* dst = ((v < 64) ? p.MC : p.NC) + (((size_t)scan * NCH + c) * 64 + (v & 63)) * 64;
#pragma unroll
      for (int tk = 0; tk < 2; ++tk)
#pragma unroll
        for (int q = 0; q < 4; ++q)
          *(f32x4*)(dst + 32 * tk + 8 * q + 4 * hi) = f32x4{acc[tk][4 * q], acc[tk][4 * q + 1], acc[tk][4 * q + 2], acc[tk][4 * q + 3]};
    }
  }
}


DI void ph_scan2(const P& p, char* smem) {
  constexpr int LS = 72;
  u16* Sh = (u16*)smem; u16* Sl = Sh + 64 * LS; u16* Mh = Sl + 64 * LS; u16* Ml = Mh + 64 * LS;
  const int tid = tidx(), lane = tid & 63, w = tid >> 6;
  const int l15 = lane & 15, lq = lane >> 4;
  const int ti = w >> 1, tj0 = (w & 1) * 2;
  for (int scan = blockIdx.x; scan < 32; scan += gridDim.x) {
    const float* Mg = p.MC + (size_t)scan * NCH * 4096;
    const float* Ng = p.NC + (size_t)scan * NCH * 4096;
    float* Sg = p.SS + (size_t)scan * NCH * 4096;
    struct MN { f32x4 m0, m1, n[2]; };
    auto ldmn = [&](MN& r, int c) {
      const int cc = (c < NCH) ? c : (NCH - 1);
      r.m0 = *(const f32x4*)(Mg + (size_t)cc * 4096 + tid * 8); r.m1 = *(const f32x4*)(Mg + (size_t)cc * 4096 + tid * 8 + 4);
#pragma unroll
      for (int q = 0; q < 2; ++q)
#pragma unroll
        for (int r4 = 0; r4 < 4; ++r4) r.n[q][r4] = Ng[(size_t)cc * 4096 + (ti * 16 + lq * 4 + r4) * 64 + (tj0 + q) * 16 + l15];
    };
    f32x4 sacc[2];
    sacc[0] = f32x4{0.f, 0.f, 0.f, 0.f}; sacc[1] = sacc[0];
    auto step = [&](int c, const MN& r) {
      __syncthreads();
#pragma unroll
      for (int q = 0; q < 2; ++q)
#pragma unroll
        for (int r4 = 0; r4 < 4; ++r4) {
          const int row = ti * 16 + lq * 4 + r4, col = (tj0 + q) * 16 + l15;
          const float x = sacc[q][r4];
          Sg[(size_t)c * 4096 + row * 64 + col] = x;
          const u16 h = f2bf(x); Sh[row * LS + col] = h; Sl[row * LS + col] = f2bf(x - bf2f(h));
        }
      {
        const int mr = tid >> 3, mc = (tid & 7) * 8;
        float xh[8], xl[8];
#pragma unroll
        for (int i = 0; i < 8; ++i) { const float x = (i < 4) ? r.m0[i & 3] : r.m1[i & 3]; const float h = bf2f(f2bf(x)); xh[i] = h; xl[i] = x - h; }
        *(u32x4*)(Mh + mr * LS + mc) = u32x4{pk2(xh[0], xh[1]), pk2(xh[2], xh[3]), pk2(xh[4], xh[5]), pk2(xh[6], xh[7])};
        *(u32x4*)(Ml + mr * LS + mc) = u32x4{pk2(xl[0], xl[1]), pk2(xl[2], xl[3]), pk2(xl[4], xl[5]), pk2(xl[6], xl[7])};
      }
      f32x4 acc[2] = {r.n[0], r.n[1]};
      __syncthreads();
#pragma unroll
      for (int ks = 0; ks < 2; ++ks) {
        const bf16x8 ah = *(const bf16x8*)(Sh + (ti * 16 + l15) * LS + ks * 32 + 8 * lq);
        const bf16x8 al = *(const bf16x8*)(Sl + (ti * 16 + l15) * LS + ks * 32 + 8 * lq);
#pragma unroll
        for (int q = 0; q < 2; ++q) {
          const int kb = ks * 32 + 8 * lq, tq = l15 >> 2, tp = l15 & 3, co = (tj0 + q) * 16 + 4 * tp;
          const bf16x8 bh = __builtin_shufflevector(tr_read((const short*)Mh + (kb + tq) * LS + co), tr_read((const short*)Mh + (kb + 4 + tq) * LS + co), 0, 1, 2, 3, 4, 5, 6, 7);
          const bf16x8 bl = __builtin_shufflevector(tr_read((const short*)Ml + (kb + tq) * LS + co), tr_read((const short*)Ml + (kb + 4 + tq) * LS + co), 0, 1, 2, 3, 4, 5, 6, 7);
          acc[q] = __builtin_amdgcn_mfma_f32_16x16x32_bf16(ah, bh, acc[q], 0, 0, 0);
          acc[q] = __builtin_amdgcn_mfma_f32_16x16x32_bf16(ah, bl, acc[q], 0, 0, 0);
          acc[q] = __builtin_amdgcn_mfma_f32_16x16x32_bf16(al, bh, acc[q], 0, 0, 0);
        }
      }
      sacc[0] = acc[0]; sacc[1] = acc[1];
    };
    MN r0, r1, r2, r3;
    ldmn(r0, 0); ldmn(r1, 1); ldmn(r2, 2);
    for (int c = 0; c < NCH; c += 4) {
      ldmn(r3, c + 3); step(c, r0);
      ldmn(r0, c + 4); step(c + 1, r1);
      ldmn(r1, c + 5); step(c + 2, r2);
      ldmn(r2, c + 6); step(c + 3, r3);
    }
    __syncthreads();
  }
}

DI void ph_scan3(const P& p, int layer, char* smem) {
  constexpr int NI = 4;
  const int tid = tidx(), lane = tid & 63, w = tid >> 6;
  const int jl = lane & 31, hi = lane >> 5;
  const int it = w >> 1, vt = w & 1, ws = w & 1;
  float* sm = (float*)smem + it * (SBUF + 2048);
  float* slw = sm + SBUF; float* so = slw + 1024;
  const float* lwp = p.rw_lnx_w + layer * RWW; const float* lbp = p.rw_lnx_b + layer * RWW; const float* rkp = p.rw_r_k + layer * RWW;
  constexpr int TQ = 2 * SC;
  for (int quad = blockIdx.x; quad < NB * NH * (T / TQ); quad += gridDim.x) {
    const int bh = quad / (T / TQ), tb = quad % (T / TQ);
    const int d = it >> 1, kch = 2 * tb + (it & 1), c = d ? (NCH - 1 - kch) : kch;
    const int h = bh % NH, b = bh / NH, scan = bh * 2 + d;
    const float kkc = p.rw_k_k[layer * RWW + h * 64 + lane], kac = p.rw_k_a[layer * RWW + h * 64 + lane];
    u16* Od = p.O2 + (size_t)d * NTOK * RWW;
    f32x16s acc[2];
    {
      const float* Sg = p.SS + ((size_t)scan * NCH + c) * 4096 + (size_t)(32 * vt + jl) * 64;
#pragma unroll
      for (int tk = 0; tk < 2; ++tk)
#pragma unroll
        for (int q = 0; q < 4; ++q) {
          const f32x4 sv = *(const f32x4*)(Sg + 32 * tk + 8 * q + 4 * hi);
#pragma unroll
          for (int e = 0; e < 4; ++e) acc[tk][4 * q + e] = sv[e];
        }
    }
    ScanRegsN<NI> g;
    scan_load_n<NI>(p, b, h, d, c * SC, lane, ws, g);
    for (int sub = 0; sub < SC / 16; ++sub) {
      const int n0 = c * SC + sub * 16;
      __syncthreads();
      scan_put_n<NI>(g, kkc, kac, sm, slw, lane, ws);
      __syncthreads();
      if (sub + 1 < SC / 16) scan_load_n<NI>(p, b, h, d, n0 + 16, lane, ws, g);
      const float* vrow = sm + 4096 + 32 * vt + jl;
      f32x4 kc[8]; scan_ld8(kc, sm, hi);
      float a0 = sm[1024 + hi * 1024 + jl], a1 = sm[1024 + hi * 1024 + 32 + jl], vc = vrow[0];
#pragma unroll 4
      for (int j = 0; j < 16; ++j) {
        const int jn = (j + 1) & 15;
        f32x4 kn[8]; scan_ld8(kn, sm + jn * 64, hi);
        const float an0 = sm[1024 + hi * 1024 + jn * 64 + jl], an1 = sm[1024 + hi * 1024 + jn * 64 + 32 + jl], vn = vrow[jn * 64];
        SBAR();
        const float sa = scan_dot8(acc, kc);
        const float bop = hi ? vc : sa;
        acc[0] = __builtin_amdgcn_mfma_f32_32x32x2f32(a0, bop, acc[0], 0, 0, 0);
        acc[1] = __builtin_amdgcn_mfma_f32_32x32x2f32(a1, bop, acc[1], 0, 0, 0);
        f32x4 rc[8]; scan_ld8(rc, sm + 3072 + j * 64, hi);
        SBAR();
        const float o = scan_dot8(acc, rc);
        if (hi == 0) so[j * 64 + 32 * vt + jl] = o;
        SBAR();
#pragma unroll
        for (int i = 0; i < 8; ++i) kc[i] = kn[i];
        a0 = an0; a1 = an1; vc = vn;
      }
#pragma unroll
      for (int tk = 0; tk < 2; ++tk)
#pragma unroll
        for (int q = 0; q < 4; ++q) {
          const f32x4 pv = *(const f32x4*)(sm + 5120 + 32 * tk + 8 * q + 4 * hi);
#pragma unroll
          for (int e = 0; e < 4; ++e) acc[tk][4 * q + e] *= pv[e];
        }
      __syncthreads();
#pragma unroll
      for (int jj = 0; jj < 8; ++jj) {
        const int j = ws + 2 * jj; const int n = n0 + j; const int t = d ? (T - 1 - n) : n;
        Od[((size_t)(b * T + t)) * RWW + h * 64 + lane] = f2bf(so[j * 64 + lane]);
      }
    }
    asm volatile("s_waitcnt vmcnt(0)" ::: "memory");
    __syncthreads();
    {
      const int ch = h * 64 + lane;
      const float plw = lwp[ch], plb = lbp[ch], prk = rkp[ch];
      for (int i0 = 0; i0 < TQ / 8; i0 += 2) {
        float o[2], k[2], r[2], vv[2], a0[2], a1[2], gg[2];
#pragma unroll
        for (int u = 0; u < 2; ++u) {
          const size_t off = (size_t)(b * T + tb * TQ + w * (TQ / 8) + i0 + u) * RWW + ch;
          o[u] = bf2f(p.O2[off]) + bf2f(p.O2[(size_t)NTOK * RWW + off]);
          k[u] = p.K[off]; r[u] = p.R[off]; vv[u] = p.V[off];
          a0[u] = bf2f(p.AA[off]); a1[u] = bf2f(p.AA[(size_t)NTOK * RWW + off]); gg[u] = bf2f(p.G[off]);
        }
#pragma unroll
        for (int u = 0; u < 2; ++u) {
          const float mean = wave_sum(o[u]) * (1.f / 64);
          const float dv = o[u] - mean;
          const float var = wave_sum(dv * dv) * (1.f / 64);
          const float kb = 0.5f * (k[u] * (1.f + (a0[u] - 1.f) * kac) + k[u] * (1.f + (a1[u] - 1.f) * kac));
          const float sb = wave_sum(r[u] * kb * prk);
          const float on_ = dv * frsq(var + GN_EPS) * plw + plb;
          p.H[(size_t)(b * T + tb * TQ + w * (TQ / 8) + i0 + u) * DM + ch] = f2bf((on_ + sb * vv[u]) * gg[u]);
        }
      }
    }
  }
}
DI void ph_mla_norm(const P& p, int layer) {
  const int tid_ = tidx(); const int lane = tid_ & 63, w = tid_ >> 6;
  const float* on = p.mla_o_norm + layer * 512;
  const f32x4 g0 = *(const f32x4*)(on + lane * 4), g1 = *(const f32x4*)(on + 256 + lane * 4);
  for (int tok = blockIdx.x * 8 + w; tok < NTOK; tok += gridDim.x * 8) {
    const float* ao = p.AO + (size_t)tok * 512;
    const f32x4 v0 = *(const f32x4*)(ao + lane * 4), v1 = *(const f32x4*)(ao + 256 + lane * 4);
    float ss = v0[0] * v0[0] + v0[1] * v0[1] + v0[2] * v0[2] + v0[3] * v0[3] + v1[0] * v1[0] + v1[1] * v1[1] + v1[2] * v1[2] + v1[3] * v1[3];
    ss = wave_sum(ss);
    const float rstd = frsq(ss * (1.f / 512) + NORM_EPS);
    *(u32x2*)(p.H + (size_t)tok * DM + 512 + lane * 4) = u32x2{pk2(v0[0] * rstd * g0[0], v0[1] * rstd * g0[1]), pk2(v0[2] * rstd * g0[2], v0[3] * rstd * g0[3])};
    *(u32x2*)(p.H + (size_t)tok * DM + 768 + lane * 4) = u32x2{pk2(v1[0] * rstd * g1[0], v1[1] * rstd * g1[1]), pk2(v1[2] * rstd * g1[2], v1[3] * rstd * g1[3])};
  }
}


DI void ph_mixfinish(const P& p, int layer) {
  const int tid_ = tidx(); const int lane = tid_ & 63, w = tid_ >> 6;
  const float* lw = p.rw_lnx_w + layer * RWW; const float* lb = p.rw_lnx_b + layer * RWW;
  const float* kac = p.rw_k_a + layer * RWW; const float* rk = p.rw_r_k + layer * RWW;
  const float* on = p.mla_o_norm + layer * 512;
  float plw[8], plb[8], pka[8], prk[8];
#pragma unroll
  for (int h = 0; h < NH; ++h) { int c = h * 64 + lane; plw[h] = lw[c]; plb[h] = lb[c]; pka[h] = kac[c]; prk[h] = rk[c]; }
  const f32x4 g0 = *(const f32x4*)(on + lane * 4), g1 = *(const f32x4*)(on + 256 + lane * 4);
  for (int tok = blockIdx.x * 8 + w; tok < NTOK; tok += gridDim.x * 8) {
    float o[8], k[8], r[8], vv[8], a0[8], a1[8], gg[8];
#pragma unroll
    for (int h = 0; h < NH; ++h) {
      size_t off = (size_t)tok * RWW + h * 64 + lane;
      o[h] = bf2f(p.O2[off]) + bf2f(p.O2[(size_t)NTOK * RWW + off]);
      k[h] = p.K[off]; r[h] = p.R[off]; vv[h] = p.V[off];
      a0[h] = bf2f(p.AA[off]); a1[h] = bf2f(p.AA[(size_t)NTOK * RWW + off]); gg[h] = bf2f(p.G[off]);
    }
    const float* ao = p.AO + (size_t)tok * 512;
    const f32x4 v0 = *(const f32x4*)(ao + lane * 4), v1 = *(const f32x4*)(ao + 256 + lane * 4);
    float mean[8], var[8], sb[8];
#pragma unroll
    for (int h = 0; h < NH; ++h) mean[h] = wave_sum(o[h]) * (1.f / 64);
#pragma unroll
    for (int h = 0; h < NH; ++h) { float dv = o[h] - mean[h]; o[h] = dv; var[h] = wave_sum(dv * dv) * (1.f / 64); }
#pragma unroll
    for (int h = 0; h < NH; ++h) {
      float kb = 0.5f * (k[h] * (1.f + (a0[h] - 1.f) * pka[h]) + k[h] * (1.f + (a1[h] - 1.f) * pka[h]));
      sb[h] = wave_sum(r[h] * kb * prk[h]);
    }
#pragma unroll
    for (int h = 0; h < NH; ++h) {
      float on_ = o[h] * frsq(var[h] + GN_EPS) * plw[h] + plb[h];
      float y = (on_ + sb[h] * vv[h]) * gg[h];
      p.H[(size_t)tok * DM + h * 64 + lane] = f2bf(y);
    }
    float ss = v0[0] * v0[0] + v0[1] * v0[1] + v0[2] * v0[2] + v0[3] * v0[3] + v1[0] * v1[0] + v1[1] * v1[1] + v1[2] * v1[2] + v1[3] * v1[3];
    ss = wave_sum(ss);
    float rstd = frsq(ss * (1.f / 512) + NORM_EPS);
    *(u32x2*)(p.H + (size_t)tok * DM + 512 + lane * 4) = u32x2{pk2(v0[0] * rstd * g0[0], v0[1] * rstd * g0[1]), pk2(v0[2] * rstd * g0[2], v0[3] * rstd * g0[3])};
    *(u32x2*)(p.H + (size_t)tok * DM + 768 + lane * 4) = u32x2{pk2(v1[0] * rstd * g1[0], v1[1] * rstd * g1[1]), pk2(v1[2] * rstd * g1[2], v1[3] * rstd * g1[3])};
  }
}

DI void ph_norm_router(const P& p, int layer, char* smem) {
  const int tid_ = tidx(); const int lane = tid_ & 63, w = tid_ >> 6;
  float* rtl = (float*)smem;
  float* hl = (float*)(smem + 65536) + w * 1024;
  const float* g = p.ffn_norm + layer * DM;
  const float* rt = p.router + (size_t)layer * DM * NE;
  __syncthreads();
#pragma unroll
  for (int i = 0; i < 8; ++i) *(f32x4*)(rtl + (tid_ + i * NTH) * 4) = *(const f32x4*)(rt + (tid_ + i * NTH) * 4);
  __syncthreads();
  const int cg = lane >> 2, eq = lane & 3;
  for (int tok = blockIdx.x * 8 + w; tok < NTOK; tok += gridDim.x * 8) {
    const f32x4* xr = (const f32x4*)(p.out + (size_t)tok * DM);
    f32x4 v[4]; float ss = 0.f;
#pragma unroll
    for (int j = 0; j < 4; ++j) { v[j] = xr[lane + 64 * j]; ss += v[j][0] * v[j][0] + v[j][1] * v[j][1] + v[j][2] * v[j][2] + v[j][3] * v[j][3]; }
    ss = wave_sum(ss);
    const float rstd = frsq(ss * (1.f / DM) + NORM_EPS);
#pragma unroll
    for (int j = 0; j < 4; ++j) {
      const int c0 = (lane + 64 * j) * 4;
      const f32x4 gg = *(const f32x4*)(g + c0);
      const f32x4 hv = v[j] * rstd * gg;
      *(u32x2*)(p.H + (size_t)tok * DM + c0) = u32x2{pk2(hv[0], hv[1]), pk2(hv[2], hv[3])};
      *(f32x4*)(hl + c0) = hv;
    }
    f32x4 acc = f32x4{0.f, 0.f, 0.f, 0.f};
#pragma unroll 16
    for (int i = 0; i < 64; ++i) {
      const float hv = hl[cg + 16 * i];
      const f32x4 r4 = *(const f32x4*)(rtl + (cg + 16 * i) * 16 + eq * 4);
      acc += hv * r4;
    }
#pragma unroll
    for (int e = 0; e < 4; ++e) {
      float a = acc[e];
      a += dpp_f<0x124>(a); a += dpp_f<0x128>(a);
      a = red_x32(red_x16(a));
      acc[e] = a;
    }
    float mx = fmaxf(fmaxf(acc[0], acc[1]), fmaxf(acc[2], acc[3]));
    mx = fmaxf(mx, dpp_f<0xB1>(mx)); mx = fmaxf(mx, dpp_f<0x4E>(mx));
    f32x4 ex; float se = 0.f;
#pragma unroll
    for (int e = 0; e < 4; ++e) { ex[e] = fexp(acc[e] - mx); se += ex[e]; }
    se = red_x2(red_x1(se));
    const float inv = frcp(se);
    const int b = tok / T, t = tok % T;
    if (lane < 4) {
#pragma unroll
      for (int e = 0; e < 4; ++e) p.AFF[((size_t)(b * NE + eq * 4 + e)) * T + t] = ex[e] * inv;
    }
  }
}

DI void ph_topk(const P& p, char* smem) {
  unsigned* hist = (unsigned*)smem;
  unsigned* sc = hist + 256;
  unsigned* bc = sc + 2048;
  const int tid = tidx();
  for (int item = blockIdx.x; item < NB * NE; item += gridDim.x) {
    const float* a = p.AFF + (size_t)item * T;
    unsigned key[16];
#pragma unroll
    for (int i = 0; i < 4; ++i) {
      uint4 v = *(const uint4*)(a + tid * 16 + i * 4);
      key[i * 4 + 0] = v.x; key[i * 4 + 1] = v.y; key[i * 4 + 2] = v.z; key[i * 4 + 3] = v.w;
    }
    unsigned prefix = 0, mask = 0, need = CAP;
    for (int pass = 0; pass < 4; ++pass) {
      int shift = 24 - 8 * pass;
      __syncthreads();
      if (tid < 256) hist[tid] = 0;
      __syncthreads();
#pragma unroll
      for (int i = 0; i < 16; ++i)
        if ((key[i] & mask) == prefix) atomicAdd(&hist[(key[i] >> shift) & 255u], 1u);
      __syncthreads();
      if (tid == 0) {
        unsigned cum = 0; int bsel = 0; unsigned nd = need;
        for (int bb = 255; bb >= 0; --bb) {
          unsigned hc = hist[bb];
          if (cum + hc >= need) { bsel = bb; nd = need - cum; break; }
          cum += hc;
        }
        bc[0] = prefix | ((unsigned)bsel << shift); bc[1] = nd;
      }
      __syncthreads();
      prefix = bc[0]; need = bc[1]; mask |= (255u << shift);
    }
    unsigned ngt = 0, neq = 0;
#pragma unroll
    for (int i = 0; i < 16; ++i) { ngt += key[i] > prefix; neq += key[i] == prefix; }
    __syncthreads();
    unsigned* sA = sc; unsigned* sB = sc + 512; unsigned* eA = sc + 1024; unsigned* eB = sc + 1536;
    sA[tid] = ngt; eA[tid] = neq;
    __syncthreads();
    for (int off = 1; off < NTH; off <<= 1) {
      unsigned x = sA[tid] + ((tid >= off) ? sA[tid - off] : 0u);
      unsigned y = eA[tid] + ((tid >= off) ? eA[tid - off] : 0u);
      sB[tid] = x; eB[tid] = y;
      __syncthreads();
      unsigned* tmp = sA; sA = sB; sB = tmp; tmp = eA; eA = eB; eB = tmp;
    }
    unsigned gt_excl = sA[tid] - ngt, eq_excl = eA[tid] - neq;
    unsigned gt_total = sA[NTH - 1];
    int* idx = p.IDX + (size_t)item * CAP; float* gate = p.GATE + (size_t)item * CAP;
#pragma unroll
    for (int i = 0; i < 16; ++i) {
      int slot = -1;
      if (key[i] > prefix) { slot = (int)gt_excl; ++gt_excl; }
      else if (key[i] == prefix) { if (eq_excl < need) slot = (int)(gt_total + eq_excl); ++eq_excl; }
      if (slot >= 0) {
        const int tokl = tid * 16 + i;
        idx[slot] = tokl; gate[slot] = __uint_as_float(key[i]);
        const int tokg = (item / NE) * T + tokl;
        const int pos = atomicAdd(&p.TCNT[tokg], 1);
        p.TLIST[(size_t)tokg * 16 + pos] = item * CAP + slot;
      }
    }
    __syncthreads();
  }
}

DI void ph_exp1(const P& p, int layer, char* smem) {
  for (int t = blockIdx.x; t < 32 * 4 * 16; t += gridDim.x) {
    int grp = t / 64, r = t % 64, tm = r / 16, tn = r % 16;
    int b = grp / NE, e = grp % NE;
    const int* gi = p.IDX + (size_t)grp * CAP + tm * GBM;
    const u16* Hb = p.H + (size_t)b * T * DM;
    const float* Wg = p.exp_w_gate + ((size_t)layer * NE + e) * DM * 1024;
    const float* Wu = p.exp_w_up + ((size_t)layer * NE + e) * DM * 1024;
    u16* hid = p.HID + ((size_t)grp * CAP + tm * GBM) * 1024;
    auto arow = [&](int row) -> const void* { return Hb + (size_t)gi[row] * DM; };
    gemm_tile<false, 1>(arow, Wg, Wu, 1024, DM, tn * 64, 1024, smem, [&](int row, int col, float g, float u) {
      float sv = g * frcp(1.f + fexp(-g));
      hid[(size_t)row * 1024 + col] = f2bf(sv * u);
    });
    __syncthreads();
  }
}
DI void ph_exp2(const P& p, int layer, char* smem) {
  for (int t = blockIdx.x; t < 32 * 4 * 8; t += gridDim.x) {
    int grp = t / 32, r = t % 32, tm = r / 8, tn = r % 8;
    int b = grp / NE, e = grp % NE;
    const int* gi = p.IDX + (size_t)grp * CAP + tm * GBM;
    const float* gt = p.GATE + (size_t)grp * CAP + tm * GBM;
    const u16* hid = p.HID + ((size_t)grp * CAP + tm * GBM) * 1024;
    const float* Wd = p.exp_w_down + ((size_t)layer * NE + e) * 1024 * DM;
    float* xb = p.out + (size_t)b * T * DM;
    auto arow = [&](int row) -> const void* { return hid + (size_t)row * 1024; };
    gemm_tile<false, 0>(arow, Wd, nullptr, DM, 1024, tn * GBN, DM, smem, [&](int row, int col, float v, float) {
      unsafeAtomicAdd(xb + (size_t)gi[row] * DM + col, v * gt[row]);
    });
    __syncthreads();
  }
}

namespace g8 {
constexpr int BM = 256, BK = 64, HALF = 128, HTB = HALF * BK * 2, STAGE_BYTES = 8 * HTB, NXCD = 8, WGM = 8;
DI int lds_byte(int r, int c) { const int st = (r >> 4) * 2 + (c >> 5), rr = r & 15, cc = c & 31, ob = rr * 64 + cc * 2; return st * 1024 + (ob ^ (((ob >> 9) & 1) << 5)); }
DI void stage_rc(int b, int& R, int& C) { const int st = b / 1024, sb = b % 1024, swz = sb ^ (((sb >> 9) & 1) << 5); R = (st >> 1) * 16 + swz / 64; C = (st & 1) * 32 + (swz % 64) / 2; }
DI int perm32(int rho) { const int n = rho >> 4, i = rho & 15; return 8 * (i >> 2) + 4 * n + (i & 3); }
struct Unit { int pm, pn; };
struct Sched {
  int nM, nN, nwg, G, c;
  const char* A; const char* Bt; size_t a_tstep, b_tstep; int gdiv, gmod; size_t gstride;
  DI void init(int nM_, int nN_, int G_, int c_, const void* A_, const void* Bt_, int K) {
    nM = nM_; nN = nN_; nwg = nM * nN; G = G_; c = c_; A = (const char*)uni_ptr(A_); Bt = (const char*)uni_ptr(Bt_);
    a_tstep = (size_t)BM * K * 2; b_tstep = (size_t)BM * K * 2; gdiv = 1 << 30; gmod = 1; gstride = 0;
  }
  DI void group(int gdiv_, int gmod_, size_t gstride_) { gdiv = gdiv_; gmod = gmod_; gstride = gstride_; }
  DI bool next(int i, Unit& u) const {
    const long L = (long)i * G + c; if (L >= nwg) return false;
    int wgid = (int)L; { const int q = nwg / NXCD, r = nwg % NXCD, xcd = wgid % NXCD, off = wgid / NXCD; wgid = (xcd < r ? xcd * (q + 1) : r * (q + 1) + (xcd - r) * q) + off; }
    const int nig = WGM * nN, gid = wgid / nig, fm = gid * WGM, gsz = (nM - fm) < WGM ? (nM - fm) : WGM;
    u.pm = fm + ((wgid % nig) % gsz); u.pn = (wgid % nig) / gsz; return true;
  }
  DI const char* a_ptr(const Unit& u) const { return A + (size_t)u.pm * a_tstep; }
  DI const char* b_ptr(const Unit& u) const { return Bt + (size_t)((u.pm / gdiv) % gmod) * gstride + (size_t)u.pn * b_tstep; }
};
using Acc = f32x4[2][2][4][2];

template <class Epi, bool GATHER = false>
DI void gemm_phase(LAS unsigned char* lds, const int K, const Sched& S, const Epi& E, const int* gidx = nullptr, LAS unsigned* gtab = nullptr) {
  const int tid = tidx(), wid = __builtin_amdgcn_readfirstlane(tid >> 6), lane = tid & 63, wr = wid >> 2, wc = wid & 3, fr = lane & 15, fq = lane >> 4;
  const int nt = K / BK;
  unsigned voffA[2], voffB[2];
#pragma unroll
  for (int i = 0; i < 2; ++i) { int R, C; stage_rc(tid * 16 + i * 8192, R, C); const int Rb = Epi::PERM ? ((R & ~31) + perm32(R & 31)) : R;
    voffA[i] = GATHER ? (unsigned)(R | (C << 16)) : (unsigned)(R * K + C) * 2u; voffB[i] = (unsigned)(Rb * K + C) * 2u; }
  unsigned gc[2][2], gn[2][2];
  auto gget = [&](int ui_, unsigned (&g)[2][2]) {
    if constexpr (GATHER) {
      Unit u_; const bool ok = S.next(ui_, u_);
#pragma unroll
      for (int h = 0; h < 2; ++h)
#pragma unroll
        for (int i = 0; i < 2; ++i) {
          const int r = h * HALF + (int)(voffA[i] & 0xffffu); const unsigned cb = (voffA[i] >> 16) * 2u;
          if (ui_ < 16) g[h][i] = gtab[ui_ * 256 + r] + cb;
          else { const int row = (ok ? u_.pm : 0) * BM + r; g[h][i] = (unsigned)((row / (NE * CAP)) * T + gidx[row]) * (unsigned)K * 2u + cb; }
        }
      asm volatile("" : "+v"(g[0][0]), "+v"(g[0][1]), "+v"(g[1][0]), "+v"(g[1][1]));
    }
  };
  if constexpr (GATHER) {
    for (int i0 = 0; i0 < 16; i0 += 2) {
      Unit u_; const int i = i0 + (tid >> 8);
      if (S.next(i, u_)) { const int row = u_.pm * BM + (tid & 255); gtab[i * 256 + (tid & 255)] = (unsigned)((row / (NE * CAP)) * T + gidx[row]) * (unsigned)K * 2u; }
      if (!S.next(i0 + 2, u_)) break;
    }
    __syncthreads();
  }
  const size_t kstep = (size_t)(BK * 2);
  const size_t hstep = (size_t)HALF * K * 2;
  const unsigned ldsw = (unsigned)wid * 1024u;
  const int aoff = lds_byte(wr * 64 + fr, fq * 8), boff = lds_byte(wc * 32 + fr, fq * 8);
#define G8_SA(b, h) (((b) * 2 + (h)) * HTB)
#define G8_SB(b, h) ((4 + (b) * 2 + (h)) * HTB)
#define G8_STAGE(bufoff, gbase, voff) do { _Pragma("unroll") for (int _i = 0; _i < 2; ++_i) \
    __builtin_amdgcn_global_load_lds((const unsigned*)((const char*)(gbase) + (voff)[_i]), (LAS unsigned*)(lds + (bufoff) + ldsw + _i * 8192), 16, 0, 0); } while (0)
#define G8_STAGE_A(bufoff, base, h, kb, Gv) do { if constexpr (GATHER) { G8_STAGE(bufoff, S.A + (kb), Gv[h]); } else { G8_STAGE(bufoff, (base) + (h) * hstep + (kb), voffA); } } while (0)
#define G8_LDA(dst, b, h) do { _Pragma("unroll") for (int m = 0; m < 4; ++m) _Pragma("unroll") for (int k = 0; k < 2; ++k) dst[m][k] = *(const LAS bf16x8*)(lds + G8_SA(b, h) + aoff + m * 2048 + k * 1024); } while (0)
#define G8_LDB(dst, b, h) do { _Pragma("unroll") for (int n = 0; n < 2; ++n) _Pragma("unroll") for (int k = 0; k < 2; ++k) dst[n][k] = *(const LAS bf16x8*)(lds + G8_SB(b, h) + boff + n * 2048 + k * 1024); } while (0)
#define G8_MMA(ai, bj, At, Bt) do { __builtin_amdgcn_s_setprio(1); _Pragma("unroll") for (int m = 0; m < 4; ++m) _Pragma("unroll") for (int n = 0; n < 2; ++n) _Pragma("unroll") for (int k = 0; k < 2; ++k) \
    acc[ai][bj][m][n] = __builtin_amdgcn_mfma_f32_16x16x32_bf16(Bt[n][k], At[m][k], acc[ai][bj][m][n], 0, 0, 0); __builtin_amdgcn_s_setprio(0); } while (0)
#define G8_WAIT_V(n) asm volatile("s_waitcnt vmcnt(" #n ")" ::: "memory")
#define G8_WAIT_L(n) asm volatile("s_waitcnt lgkmcnt(" #n ")" ::: "memory")
#define G8_BAR __builtin_amdgcn_s_barrier()
#define G8_SCHED __builtin_amdgcn_sched_barrier(0)
  Unit cur, nxt; int ui = 0;
  if (!S.next(0, cur)) return;
  f32x4 acc[2][2][4][2];
#pragma unroll
  for (int a = 0; a < 2; ++a)
#pragma unroll
    for (int b = 0; b < 2; ++b)
#pragma unroll
      for (int m = 0; m < 4; ++m)
#pragma unroll
        for (int n = 0; n < 2; ++n) acc[a][b][m][n] = (f32x4){0.f, 0.f, 0.f, 0.f};
  bf16x8 At[4][2], B0[2][2], B1[2][2];
  const char* cA = S.a_ptr(cur); const char* cB = S.b_ptr(cur);
  gget(0, gc);
  G8_STAGE(G8_SB(0, 0), cB, voffB); G8_STAGE_A(G8_SA(0, 0), cA, 0, 0, gc); G8_STAGE(G8_SB(0, 1), cB + hstep, voffB); G8_STAGE_A(G8_SA(0, 1), cA, 1, 0, gc);
  if (wr == 1) G8_BAR;
  G8_WAIT_V(4); G8_BAR;
  G8_STAGE(G8_SB(1, 0), cB + kstep, voffB); G8_STAGE_A(G8_SA(1, 0), cA, 0, kstep, gc); G8_STAGE(G8_SB(1, 1), cB + hstep + kstep, voffB);
  G8_WAIT_V(6); G8_BAR;
  for (;;) {
    const bool has_next = S.next(ui + 1, nxt);
    const char* nA = has_next ? S.a_ptr(nxt) : cA; const char* nB = has_next ? S.b_ptr(nxt) : cB;
    gget(has_next ? ui + 1 : ui, gn);
    for (int t = 0; t < nt; t += 2) {
      const bool last = (t == nt - 2);
      const size_t k1 = (size_t)(t + 1) * kstep, k2 = last ? (size_t)0 : (size_t)(t + 2) * kstep, k3 = k2 + kstep;
      const char* u2 = last ? nA : cA; const char* b2 = (last ? nB : cB) + k2;
      const char* b3 = b2 + kstep;
      unsigned g2[2][2];
      if constexpr (GATHER) {
#pragma unroll
        for (int h = 0; h < 2; ++h)
#pragma unroll
          for (int i = 0; i < 2; ++i) g2[h][i] = last ? gn[h][i] : gc[h][i];
      }
      G8_LDB(B0, 0, 0); G8_SCHED; G8_LDA(At, 0, 0); G8_STAGE_A(G8_SA(1, 1), cA, 1, k1, gc);
      G8_WAIT_L(8); G8_BAR; G8_WAIT_L(0); G8_MMA(0, 0, At, B0); G8_BAR; G8_SCHED;
      G8_LDB(B1, 0, 1); G8_STAGE(G8_SB(0, 0), b2, voffB);
      G8_BAR; G8_WAIT_L(0); G8_MMA(0, 1, At, B1); G8_BAR;
      G8_LDA(At, 0, 1); G8_STAGE_A(G8_SA(0, 0), u2, 0, k2, g2);
      G8_BAR; G8_WAIT_L(0); G8_MMA(1, 0, At, B0); G8_BAR; G8_SCHED;
      G8_STAGE(G8_SB(0, 1), b2 + hstep, voffB);
      G8_WAIT_V(6); G8_BAR; G8_MMA(1, 1, At, B1); G8_BAR;
      G8_LDB(B0, 1, 0); G8_SCHED; G8_LDA(At, 1, 0); G8_STAGE_A(G8_SA(0, 1), u2, 1, k2, g2);
      G8_WAIT_L(8); G8_BAR; G8_WAIT_L(0); G8_MMA(0, 0, At, B0); G8_BAR; G8_SCHED;
      G8_LDB(B1, 1, 1); G8_STAGE(G8_SB(1, 0), b3, voffB);
      G8_BAR; G8_WAIT_L(0); G8_MMA(0, 1, At, B1); G8_BAR;
      G8_LDA(At, 1, 1); G8_STAGE_A(G8_SA(1, 0), u2, 0, k3, g2);
      G8_BAR; G8_WAIT_L(0); G8_MMA(1, 0, At, B0); G8_BAR; G8_SCHED;
      G8_STAGE(G8_SB(1, 1), b3 + hstep, voffB);
      G8_WAIT_V(6); G8_BAR; G8_MMA(1, 1, At, B1); G8_BAR;
    }
    {
      const int t2 = tidx(); const int w2 = __builtin_amdgcn_readfirstlane(t2 >> 6), l2 = t2 & 63;
      E(acc, cur, w2 >> 2, w2 & 3, l2 & 15, l2 >> 4);
    }
    if (!has_next) break;
#pragma unroll
    for (int a = 0; a < 2; ++a)
#pragma unroll
      for (int b = 0; b < 2; ++b)
#pragma unroll
        for (int m = 0; m < 4; ++m)
#pragma unroll
          for (int n = 0; n < 2; ++n) acc[a][b][m][n] = (f32x4){0.f, 0.f, 0.f, 0.f};
    cur = nxt; cA = nA; cB = nB; ++ui;
    if constexpr (GATHER) {
#pragma unroll
      for (int h = 0; h < 2; ++h)
#pragma unroll
        for (int i = 0; i < 2; ++i) gc[h][i] = gn[h][i];
    }
  }
  G8_WAIT_V(0);
  if (wr == 0) G8_BAR;
  G8_BAR;
#undef G8_SA
#undef G8_SB
#undef G8_STAGE
#undef G8_STAGE_A
#undef G8_LDA
#undef G8_LDB
#undef G8_MMA
#undef G8_WAIT_V
#undef G8_WAIT_L
#undef G8_BAR
#undef G8_SCHED
}

struct EpiZ {
  static constexpr bool PERM = false; float* Z;
  DI void operator()(const Acc& acc, const Unit& u, int wr, int wc, int fr, int fq) const {
    const int row0 = u.pm * BM + wr * 64 + fr, col0 = u.pn * BM + wc * 32 + 4 * fq;
#pragma unroll
    for (int ai = 0; ai < 2; ++ai)
#pragma unroll
      for (int m = 0; m < 4; ++m) { float* rowp = Z + (size_t)(row0 + ai * HALF + m * 16) * INC;
#pragma unroll
        for (int bj = 0; bj < 2; ++bj)
#pragma unroll
          for (int n = 0; n < 2; ++n) { const int col = col0 + bj * HALF + n * 16; if (col < INC) *(f32x4*)(rowp + col) = acc[ai][bj][m][n]; } }
  }
};
struct EpiRes {
  static constexpr bool PERM = false; const float* xs; float* xo;
  DI void operator()(const Acc& acc, const Unit& u, int wr, int wc, int fr, int fq) const {
    const int row0 = u.pm * BM + wr * 64 + fr, col0 = u.pn * BM + wc * 32 + 4 * fq;
#pragma unroll
    for (int ai = 0; ai < 2; ++ai)
#pragma unroll
      for (int m = 0; m < 4; ++m) { const size_t ro = (size_t)(row0 + ai * HALF + m * 16) * DM + col0;
#pragma unroll
        for (int bj = 0; bj < 2; ++bj)
#pragma unroll
          for (int n = 0; n < 2; ++n) { const size_t o = ro + bj * HALF + n * 16; *(f32x4*)(xo + o) = *(const f32x4*)(xs + o) + acc[ai][bj][m][n]; } }
  }
};
struct EpiSig {
  static constexpr bool PERM = true; u16* PG;
  DI void operator()(const Acc& acc, const Unit& u, int wr, int wc, int fr, int fq) const {
    const int row0 = u.pm * BM + wr * 64 + fr, col0 = u.pn * BM + wc * 32 + 8 * fq;
#pragma unroll
    for (int ai = 0; ai < 2; ++ai)
#pragma unroll
      for (int m = 0; m < 4; ++m) { u16* rowp = PG + (size_t)(row0 + ai * HALF + m * 16) * DM + col0;
#pragma unroll
        for (int bj = 0; bj < 2; ++bj) { const f32x4 v0 = acc[ai][bj][m][0], v1 = acc[ai][bj][m][1];
          u32x4 wv = {pk2(sigmoidf_(v0[0]), sigmoidf_(v0[1])), pk2(sigmoidf_(v0[2]), sigmoidf_(v0[3])), pk2(sigmoidf_(v1[0]), sigmoidf_(v1[1])), pk2(sigmoidf_(v1[2]), sigmoidf_(v1[3]))};
          *(u32x4*)(rowp + bj * HALF) = wv; } }
  }
};
struct EpiPle {
  static constexpr bool PERM = false; float* xo; const u16* PG;
  DI void operator()(const Acc& acc, const Unit& u, int wr, int wc, int fr, int fq) const {
    const int row0 = u.pm * BM + wr * 64 + fr, col0 = u.pn * BM + wc * 32 + 4 * fq;
#pragma unroll
    for (int ai = 0; ai < 2; ++ai)
#pragma unroll
      for (int m = 0; m < 4; ++m) { const size_t ro = (size_t)(row0 + ai * HALF + m * 16) * DM + col0;
#pragma unroll
        for (int bj = 0; bj < 2; ++bj)
#pragma unroll
          for (int n = 0; n < 2; ++n) { const size_t o = ro + bj * HALF + n * 16; const u32x2 g = *(const u32x2*)(PG + o);
            f32x4 gv = {__uint_as_float(g[0] << 16), __uint_as_float(g[0] & 0xffff0000u), __uint_as_float(g[1] << 16), __uint_as_float(g[1] & 0xffff0000u)};
            *(f32x4*)(xo + o) = *(const f32x4*)(xo + o) + acc[ai][bj][m][n] * gv; } }
  }
};
struct EpiSwi {
  static constexpr bool PERM = true; u16* HID;
  DI void operator()(const Acc& acc, const Unit& u, int wr, int wc, int fr, int fq) const {
    const int row0 = u.pm * BM + wr * 64 + fr, col0 = u.pn * HALF + wc * 32 + 8 * fq;
#pragma unroll
    for (int ai = 0; ai < 2; ++ai)
#pragma unroll
      for (int m = 0; m < 4; ++m) { u16* rowp = HID + (size_t)(row0 + ai * HALF + m * 16) * 1024 + col0;
        float h[8];
#pragma unroll
        for (int n = 0; n < 2; ++n)
#pragma unroll
          for (int j = 0; j < 4; ++j) { const float gt = acc[ai][0][m][n][j], up = acc[ai][1][m][n][j]; h[n * 4 + j] = gt * frcp(1.f + fexp(-gt)) * up; }
        *(u32x4*)rowp = u32x4{pk2(h[0], h[1]), pk2(h[2], h[3]), pk2(h[4], h[5]), pk2(h[6], h[7])}; }
  }
};
struct EpiYE {
  static constexpr bool PERM = true; u16* YE; const float* GATE;
  DI void operator()(const Acc& acc, const Unit& u, int wr, int wc, int fr, int fq) const {
    const int row0 = u.pm * BM + wr * 64 + fr, col0 = u.pn * BM + wc * 32 + 8 * fq;
#pragma unroll
    for (int ai = 0; ai < 2; ++ai)
#pragma unroll
      for (int m = 0; m < 4; ++m) { const int row = row0 + ai * HALF + m * 16; const float gt = GATE[row]; u16* rowp = YE + (size_t)row * 1024 + col0;
#pragma unroll
        for (int bj = 0; bj < 2; ++bj) { const f32x4 v0 = acc[ai][bj][m][0] * gt, v1 = acc[ai][bj][m][1] * gt;
          *(u32x4*)(rowp + bj * HALF) = u32x4{pk2(v0[0], v0[1]), pk2(v0[2], v0[3]), pk2(v1[0], v1[1]), pk2(v1[2], v1[3])}; } }
  }
};
}

DI void cvt_tile_T(const float* __restrict__ src, int ldsrc, int N, int K, u16* __restrict__ dst, int k0, int n0, int drow0, char* smem, int tid) {
  short* tl = (short*)smem;
  __syncthreads();
#pragma unroll
  for (int i = 0; i < 2; ++i) {
    int u = tid + i * NTH; int kr = u >> 4, nq = u & 15; int n = n0 + nq * 4;
    f32x4 v = f32x4{0.f, 0.f, 0.f, 0.f};
    if (n < N) v = *(const f32x4*)(src + (size_t)(k0 + kr) * ldsrc + n);
#pragma unroll
    for (int e = 0; e < 4; ++e) tl[(nq * 4 + e) * 72 + kr] = (short)f2bf(v[e]);
  }
  __syncthreads();
  { int n = tid >> 3, kc = tid & 7;
    *(u32x4*)(dst + (size_t)(drow0 + n) * K + k0 + kc * 8) = *(const u32x4*)(tl + n * 72 + kc * 8); }
}
constexpr int WIN_PAD = 2560;
DI void ph_cvt_small(const P& p, int layer, char* smem) {
  const int tid = tidx();
  const int t0 = 16 * 40, t1 = t0 + 256, t2 = t1 + 256, t3 = t2 + 64;
  for (int t = blockIdx.x; t < t3; t += gridDim.x) {
    if (t < t0) cvt_tile_T(p.w_in + (size_t)layer * DM * INC, INC, INC, DM, p.WIN, (t / 40) * 64, (t % 40) * 64, (t % 40) * 64, smem, tid);
    else if (t < t1) { int q = t - t0; cvt_tile_T(p.w_out + (size_t)layer * DM * DM, DM, DM, DM, p.WOUT, (q / 16) * 64, (q % 16) * 64, (q % 16) * 64, smem, tid); }
    else if (t < t2) { int q = t - t1; cvt_tile_T(p.ple_gate + (size_t)layer * DM * DM, DM, DM, DM, p.WPG, (q / 16) * 64, (q % 16) * 64, (q % 16) * 64, smem, tid); }
    else { int q = t - t2; cvt_tile_T(p.ple_proj + (size_t)layer * DPLE * DM, DM, DM, DPLE, p.WPP, (q / 16) * 64, (q % 16) * 64, (q % 16) * 64, smem, tid); }
  }
  const float* ps = p.p + (size_t)layer * NTOK * DPLE;
  for (int i = blockIdx.x * NTH + tid; i < NTOK * DPLE / 8; i += gridDim.x * NTH) {
    f32x4 a = *(const f32x4*)(ps + (size_t)i * 8), b = *(const f32x4*)(ps + (size_t)i * 8 + 4);
    *(u32x4*)(p.PB + (size_t)i * 8) = u32x4{pk2(a[0], a[1]), pk2(a[2], a[3]), pk2(b[0], b[1]), pk2(b[2], b[3])};
  }
}

struct CvtJob { const float* src; u16* dst; int k0, n0, drow0; };
DI bool cvt_job(const P& p, int layer, int t, CvtJob& j) {
  if (t >= NE * 3 * 128) return false;
  const int e = t / 384, r = t % 384, mat = r / 128, q = r % 128;
  j.k0 = (q / 8) * 64; j.n0 = (q % 8) * 128;
  const size_t eo = ((size_t)layer * NE + e) * 1024 * 1024;
  if (mat == 0) { j.src = p.exp_w_gate + eo; j.dst = p.EW1 + (size_t)e * 2048 * 1024; j.drow0 = (j.n0 >> 7) * 256; }
  else if (mat == 1) { j.src = p.exp_w_up + eo; j.dst = p.EW1 + (size_t)e * 2048 * 1024; j.drow0 = (j.n0 >> 7) * 256 + 128; }
  else { j.src = p.exp_w_down + eo; j.dst = p.EW2 + (size_t)e * 1024 * 1024; j.drow0 = j.n0; }
  return true;
}
DI void ph_cvt_experts(const P& p, int layer, char* smem, unsigned* ctr) {
  const int tid = tidx();
  short* tl = (short*)smem;
  int* sitem = (int*)(smem + 32768);
  __syncthreads();
  if (tid == 0) sitem[0] = (int)atomicAdd(ctr, 1u);
  __syncthreads();
  CvtJob cur; bool has = cvt_job(p, layer, sitem[0], cur);
  f32x4 v[4];
  const int kr = tid >> 5, nq = tid & 31;
  if (has) {
#pragma unroll
    for (int i = 0; i < 4; ++i) v[i] = *(const f32x4*)(cur.src + (size_t)(cur.k0 + kr + 16 * i) * 1024 + cur.n0 + nq * 4);
  }
  int par = 0;
  while (has) {
    if (tid == 0) sitem[1 + par] = (int)atomicAdd(ctr, 1u);
    __syncthreads();
#pragma unroll
    for (int i = 0; i < 4; ++i)
#pragma unroll
      for (int e = 0; e < 4; ++e) tl[(nq * 4 + e) * 72 + kr + 16 * i] = (short)f2bf(v[i][e]);
    __syncthreads();
    CvtJob nxt; const bool hn = cvt_job(p, layer, sitem[1 + par], nxt);
    if (hn) {
#pragma unroll
      for (int i = 0; i < 4; ++i) v[i] = *(const f32x4*)(nxt.src + (size_t)(nxt.k0 + kr + 16 * i) * 1024 + nxt.n0 + nq * 4);
    }
#pragma unroll
    for (int i = 0; i < 2; ++i) {
      int u = tid + i * NTH; int n = u >> 3, kc = u & 7;
      *(u32x4*)(cur.dst + (size_t)(cur.drow0 + n) * 1024 + cur.k0 + kc * 8) = *(const u32x4*)(tl + n * 72 + kc * 8);
    }
    cur = nxt; has = hn; par ^= 1;
  }
}
DI void ph_gather(const P& p) {
  const int tid_ = tidx(); const int lane = tid_ & 63, w = tid_ >> 6;
  for (int row = blockIdx.x * 8 + w; row < NB * NE * CAP; row += gridDim.x * 8) {
    const int b = row / (NE * CAP);
    const int tok = b * T + p.IDX[row];
    const u32x4* src = (const u32x4*)(p.H + (size_t)tok * DM);
    u32x4* dst = (u32x4*)(p.XE + (size_t)row * DM);
    u32x4 a = src[lane], c = src[lane + 64];
    dst[lane] = a; dst[lane + 64] = c;
  }
}
DI void ph_combine_norm(const P& p, int layer) {
  const int tid_ = tidx(); const int lane = tid_ & 63, w = tid_ >> 6;
  const float* g = p.ple_norm + layer * DM;
  for (int tok = blockIdx.x * 8 + w; tok < NTOK; tok += gridDim.x * 8) {
    f32x4* xr = (f32x4*)(p.out + (size_t)tok * DM);
    f32x4 v[4];
#pragma unroll
    for (int j = 0; j < 4; ++j) v[j] = xr[lane * 4 + j];
    const int cnt = p.TCNT[tok];
    for (int q = 0; q < cnt; ++q) {
      const int yrow = p.TLIST[(size_t)tok * 16 + q];
      const u32x4* yr = (const u32x4*)(p.YE + (size_t)yrow * DM + lane * 16);
      u32x4 a = yr[0], c = yr[1];
#pragma unroll
      for (int e = 0; e < 4; ++e) {
        v[e >> 1][(e & 1) * 2] += __uint_as_float(a[e] << 16); v[e >> 1][(e & 1) * 2 + 1] += __uint_as_float(a[e] & 0xffff0000u);
        v[2 + (e >> 1)][(e & 1) * 2] += __uint_as_float(c[e] << 16); v[2 + (e >> 1)][(e & 1) * 2 + 1] += __uint_as_float(c[e] & 0xffff0000u);
      }
    }
    float ss = 0.f;
#pragma unroll
    for (int j = 0; j < 4; ++j) { xr[lane * 4 + j] = v[j]; ss += v[j][0] * v[j][0] + v[j][1] * v[j][1] + v[j][2] * v[j][2] + v[j][3] * v[j][3]; }
    ss = wave_sum(ss);
    const float rstd = frsq(ss * (1.f / DM) + NORM_EPS);
    u32x4 o0, o1;
#pragma unroll
    for (int j = 0; j < 4; ++j) {
      f32x4 gg = *(const f32x4*)(g + lane * 16 + j * 4);
      unsigned lo = pk2(v[j][0] * rstd * gg[0], v[j][1] * rstd * gg[1]), hi = pk2(v[j][2] * rstd * gg[2], v[j][3] * rstd * gg[3]);
      if (j < 2) { o0[j * 2] = lo; o0[j * 2 + 1] = hi; } else { o1[(j - 2) * 2] = lo; o1[(j - 2) * 2 + 1] = hi; }
    }
    *(u32x4*)(p.H + (size_t)tok * DM + lane * 16) = o0; *(u32x4*)(p.H + (size_t)tok * DM + lane * 16 + 8) = o1;
  }
}

#define XB_TMO      128
#define XB_XCNT(j)  (256  + 64 * (j))
#define XB_XSUB(j)  (1280 + 64 * (j))
#define XB_XGEN(j)  (2304 + 64 * (j))
#define XB_TOP      3328
#define XB_TOPGEN   3392
#define XCD_BAR_WORDS 3456
#define XB_SPIN_CAP (1u << 20)
DI unsigned xb_ld(unsigned* p) { return __hip_atomic_load(p, __ATOMIC_RELAXED, __HIP_MEMORY_SCOPE_AGENT); }
DI unsigned xb_add(unsigned* p, unsigned v) { return __hip_atomic_fetch_add(p, v, __ATOMIC_RELAXED, __HIP_MEMORY_SCOPE_AGENT); }
DI unsigned xb_xcc_id() { return (unsigned)__builtin_amdgcn_s_getreg((3 << 11) | 20) & 0xFu; }
#define XB_SPIN(cond, bar) do { unsigned _sp = 0; while (cond) { __builtin_amdgcn_s_sleep(1); \
    if ((++_sp & 255u) == 0u) { if (xb_ld(&(bar)[XB_TMO])) break; if (_sp > XB_SPIN_CAP) { atomicAdd(&(bar)[XB_TMO], 1u); break; } } } } while (0)
struct XcdBarrier { unsigned* bar; unsigned x; volatile LAS unsigned* st; };
DI XcdBarrier xcd_barrier_post(unsigned* bar, volatile LAS unsigned* st) {
  XcdBarrier b; b.bar = bar; b.x = xb_xcc_id(); b.st = st;
  if (threadIdx.x == 0) (void)xb_add(&bar[XB_XCNT(b.x)], 1u);
  return b;
}
DI void xcd_barrier_complete(unsigned* bar, unsigned x, unsigned& nloc, unsigned& nx) {
  const unsigned G = gridDim.x * gridDim.y * gridDim.z;
  unsigned sum, cnt, mine, sp = 0u;
  for (;;) {
    sum = 0u; cnt = 0u; mine = 0u;
#pragma unroll
    for (unsigned j = 0; j < 16; ++j) { const unsigned c = xb_ld(&bar[XB_XCNT(j)]); sum += c; cnt += (c > 0u) ? 1u : 0u; mine = (j == x) ? c : mine; }
    if (sum == G) break;
    __builtin_amdgcn_s_sleep(1);
    if ((++sp & 255u) == 0u) { if (xb_ld(&bar[XB_TMO])) break; if (sp > XB_SPIN_CAP) { atomicAdd(&bar[XB_TMO], 1u); break; } }
  }
  nloc = mine > 0u ? mine : 1u; nx = cnt > 0u ? cnt : 1u;
}
DI void xcd_barrier(const XcdBarrier& b) {
  asm volatile("s_waitcnt vmcnt(0)" ::: "memory");
  __syncthreads();
  if (threadIdx.x == 0) {
    unsigned* bar = b.bar;
    __builtin_amdgcn_s_waitcnt(0);
    unsigned nloc = b.st[0], nx = b.st[1];
    if (nloc == 0u) { xcd_barrier_complete(bar, b.x, nloc, nx); b.st[0] = nloc; b.st[1] = nx; }
    const unsigned old = xb_add(&bar[XB_XSUB(b.x)], 1u);
    const unsigned gen = old / nloc;
    if (old + 1u == (gen + 1u) * nloc) {
      __builtin_amdgcn_fence(__ATOMIC_RELEASE, "agent");
      asm volatile("s_waitcnt vmcnt(0)" ::: "memory");
      const unsigned og = xb_add(&bar[XB_TOP], 1u);
      const unsigned tg = og / nx;
      if (og + 1u == (tg + 1u) * nx) xb_add(&bar[XB_TOPGEN], 1u);
      else XB_SPIN(xb_ld(&bar[XB_TOPGEN]) == tg, bar);
      __builtin_amdgcn_fence(__ATOMIC_ACQUIRE, "agent");
      xb_add(&bar[XB_XGEN(b.x)], 1u);
      asm volatile("s_waitcnt vmcnt(0)" ::: "memory");
    } else {
      XB_SPIN(xb_ld(&bar[XB_XGEN(b.x)]) == gen, bar);
      __builtin_amdgcn_fence(__ATOMIC_ACQUIRE, "agent");
      asm volatile("s_waitcnt vmcnt(0)" ::: "memory");
    }
  }
  __syncthreads();
}

#define TAKE(bytes) (ws + off); off += (((size_t)(bytes)) + 255) & ~(size_t)255
__host__ __device__ inline size_t fill_ws(P& p, char* ws) {
  size_t off = 0;
  char* regA = TAKE((size_t)NTOK * INC * 4);
  p.Z = (float*)regA;
  p.LW = (u16*)regA; p.AA = (u16*)(regA + (size_t)2 * NTOK * RWW * 2); p.G = (u16*)(regA + (size_t)4 * NTOK * RWW * 2);
  p.MC = (float*)(regA + (size_t)5 * NTOK * RWW * 2); p.NC = p.MC + (size_t)32 * NCH * 4096;
  p.HID = (u16*)regA;
  char* regB = TAKE((size_t)3 * NTOK * RWW * 4);
  p.R = (float*)regB; p.K = p.R + (size_t)NTOK * RWW; p.V = p.K + (size_t)NTOK * RWW;
  p.PG = (float*)regB;
  char* regC = TAKE((size_t)NTOK * (768 + 1024) * 4);
  p.QRAW = (float*)regC; p.KVRAW = p.QRAW + (size_t)NTOK * 768;
  p.AO = (float*)regC; p.O2 = (u16*)(p.AO + (size_t)NTOK * 512); p.SS = (float*)(p.O2 + (size_t)2 * NTOK * 512);
  p.TWD = (u16*)TAKE((size_t)2 * NTOK * 64 * 2); p.AD = (u16*)TAKE((size_t)2 * NTOK * 64 * 2);
  p.SGD = (u16*)TAKE((size_t)NTOK * 128 * 2); p.QDN = (u16*)TAKE((size_t)NTOK * 256 * 2);
  p.KVDN = (u16*)TAKE((size_t)NTOK * 128 * 2); p.KR = (float*)TAKE((size_t)NTOK * 32 * 4);
  p.ROPE = (float*)TAKE((size_t)NTOK * 32 * 4);
  p.Q = (u16*)TAKE((size_t)NTOK * NH * 96 * 2); p.Kc = (u16*)TAKE((size_t)NTOK * NH * 96 * 2);
  p.Vv = (u16*)TAKE((size_t)NTOK * NH * 64 * 2);
  p.H = (u16*)TAKE((size_t)NTOK * DM * 2);
  p.AFF = (float*)TAKE((size_t)NB * NE * T * 4);
  p.IDX = (int*)TAKE((size_t)NB * NE * CAP * 4);
  p.GATE = (float*)TAKE((size_t)NB * NE * CAP * 4);

  p.WIN = (u16*)TAKE((size_t)WIN_PAD * DM * 2); p.WOUT = (u16*)TAKE((size_t)DM * DM * 2); p.WPG = (u16*)TAKE((size_t)DM * DM * 2);
  p.WPP = (u16*)TAKE((size_t)DM * DPLE * 2); p.PB = (u16*)TAKE((size_t)NTOK * DPLE * 2);
  p.PGb = (u16*)regB;
  p.EW1 = (u16*)regB; p.EW2 = p.EW1 + (size_t)NE * 2048 * 1024;
  p.XE = (u16*)regA; p.HID = (u16*)(regA + (size_t)32 * 1024 * 1024 * 2);
  p.YE = (u16*)regC;
  p.TCNT = (int*)TAKE((size_t)NTOK * 4); p.TLIST = (int*)TAKE((size_t)NTOK * 16 * 4);
  p.CTR = (unsigned*)TAKE(256);
  p.BAR = (unsigned*)TAKE(XCD_BAR_WORDS * 4);
  return off;
}
#undef TAKE
constexpr int DSM_BYTES = g8::STAGE_BYTES + 64 + 16 * 256 * 4;
extern __shared__ __attribute__((aligned(16))) char dsm[];
struct PK { const void* in[31]; float* out; char* ws; };
DI void build_params(P& p, const PK& k) {
  p.x = (const float*)k.in[0]; p.p = (const float*)k.in[1]; p.pos = (const int*)k.in[2];
  p.attn_norm = (const float*)k.in[3]; p.w_in = (const float*)k.in[4]; p.rw_mu = (const float*)k.in[5];
  p.rw_w0 = (const float*)k.in[6]; p.rw_w_up = (const float*)k.in[7]; p.rw_a0 = (const float*)k.in[8];
  p.rw_a_up = (const float*)k.in[9]; p.rw_g_up = (const float*)k.in[10]; p.rw_k_k = (const float*)k.in[11];
  p.rw_k_a = (const float*)k.in[12]; p.rw_r_k = (const float*)k.in[13]; p.rw_lnx_w = (const float*)k.in[14];
  p.rw_lnx_b = (const float*)k.in[15]; p.mla_q_norm = (const float*)k.in[16]; p.mla_q_up = (const float*)k.in[17];
  p.mla_kv_norm = (const float*)k.in[18]; p.mla_kv_up = (const float*)k.in[19]; p.mla_o_norm = (const float*)k.in[20];
  p.w_out = (const float*)k.in[21]; p.ffn_norm = (const float*)k.in[22]; p.router = (const float*)k.in[23];
  p.exp_w_gate = (const float*)k.in[24]; p.exp_w_up = (const float*)k.in[25]; p.exp_w_down = (const float*)k.in[26];
  p.ple_norm = (const float*)k.in[27]; p.ple_proj = (const float*)k.in[28]; p.ple_gate = (const float*)k.in[29];
  p.final_norm = (const float*)k.in[30];
  p.out = k.out;
  (void)fill_ws(p, k.ws);
}
__global__ void __launch_bounds__(NTH) mega(PK pk) {
  P p; build_params(p, pk);
  char* smem = dsm;
  LAS unsigned char* glds = (LAS unsigned char*)dsm;
  uint4* xbw = (uint4*)(dsm + g8::STAGE_BYTES);
  cg::grid_group grid = cg::this_grid();
  if (threadIdx.x == 0) *xbw = make_uint4(0u, 0u, 0u, 0u);
  if (pk.ws == nullptr) grid.sync();
  const XcdBarrier xb = xcd_barrier_post(p.BAR, (volatile LAS unsigned*)xbw);
#define GSYNC() xcd_barrier(xb)
#ifndef PROBE_MASK
#define PROBE_MASK 0u
#endif
#if PROBE_MASK
  unsigned long long pt0 = __builtin_amdgcn_s_memrealtime();
#define PSYNC(id) do { GSYNC(); if (PROBE_MASK & (1u << (id))) { unsigned long long t1_ = __builtin_amdgcn_s_memrealtime(); unsigned long long dt_ = t1_ - pt0; \
    while (__builtin_amdgcn_s_memrealtime() - t1_ < dt_) __builtin_amdgcn_s_sleep(8); } pt0 = __builtin_amdgcn_s_memrealtime(); } while (0)
#else
#define PSYNC(id) GSYNC()
#endif
  for (int layer_ = 0; layer_ < NL; ++layer_) {
    int layer = layer_; asm volatile("" : "+s"(layer));
    if (layer_ == 0) ph_rope_table(p);
    ph_cvt_small(p, layer, smem);
    ph_norm(layer == 0 ? p.x : p.out, p.attn_norm + layer * DM, p.H);
    PSYNC(0);
    {
      g8::Sched S; S.init(NTOK / 256, WIN_PAD / 256, gridDim.x, bidx(), p.H, p.WIN, DM);
      g8::EpiZ E{p.Z};
      g8::gemm_phase(glds, DM, S, E);
    }
    PSYNC(1);
    ph_rwshift(p, layer);
    ph_mlaprep1(p, layer);
    PSYNC(2);
    for (int d = 0; d < 2; ++d) {
      u16* LW = p.LW + (size_t)d * NTOK * RWW; const float* w0 = p.rw_w0 + (layer * 2 + d) * RWW;
      ph_gemm<false>(p.TWD + (size_t)d * NTOK * 64, 64, p.rw_w_up + ((size_t)(layer * 2 + d)) * 64 * RWW, RWW, NTOK, RWW, 64, smem,
                     [&](int row, int col, float v) { LW[(size_t)row * RWW + col] = f2bf(-0.6065306597126334f * sigmoidf_(v + w0[col])); }, (int)blockIdx.x, (int)gridDim.x);
      u16* AA = p.AA + (size_t)d * NTOK * RWW; const float* a0 = p.rw_a0 + (layer * 2 + d) * RWW;
      ph_gemm<false>(p.AD + (size_t)d * NTOK * 64, 64, p.rw_a_up + ((size_t)(layer * 2 + d)) * 64 * RWW, RWW, NTOK, RWW, 64, smem,
                     [&](int row, int col, float v) { AA[(size_t)row * RWW + col] = f2bf(sigmoidf_(v + a0[col])); }, (int)blockIdx.x, (int)gridDim.x);
    }
    PSYNC(3);
    ph_scan1(p, layer, smem);
    PSYNC(4);
    ph_scan2(p, smem);
    const bool split_ = gridDim.x >= 64;
    const int gw = split_ ? (int)blockIdx.x - 32 : (int)blockIdx.x, gstride = split_ ? (int)gridDim.x - 32 : (int)gridDim.x;
    if (gw >= 0)
    {
      u16* G = p.G;
      ph_gemm<false>(p.SGD, 128, p.rw_g_up + (size_t)layer * 128 * RWW, RWW, NTOK, RWW, 128, smem,
                     [&](int row, int col, float v) { G[(size_t)row * RWW + col] = f2bf(v); }, gw, gstride);
      {
        u16* Qo = p.Q; const float* rope = p.ROPE;
        ph_gemm_t(p.QDN, 256, p.mla_q_up + (size_t)layer * 256 * 768, 768, NTOK, 768, 256, smem,
                  [&](const f32x4 (&acc)[4][4], int m0, int n0, int wm, int wn, int lq, int l15) {
          const float qs = 0.10206207261596577f * 1.4426950408889634f;
#pragma unroll
          for (int mi = 0; mi < 4; ++mi)
#pragma unroll
            for (int r = 0; r < 4; ++r) {
              const int tok = m0 + wm * 64 + mi * 16 + lq * 4 + r; const int b = tok / T, t = tok % T;
#pragma unroll
              for (int ni = 0; ni < 4; ++ni) {
                const int col0 = n0 + wn * 64 + ni * 16; const int h = col0 / 96, c0 = col0 % 96;
                u16* qo = Qo + ((size_t)(b * NH + h) * T + t) * 96;
                if (c0 < 64) qo[c0 + l15] = f2bf(acc[mi][ni][r] * qs);
                else if (c0 == 64) {
                  const f32x2 csn = *(const f32x2*)(rope + (size_t)tok * 32 + l15 * 2);
                  const float u1 = acc[mi][ni][r], u2 = acc[mi][(ni + 1) & 3][r];
                  qo[64 + l15] = f2bf((u1 * csn[0] - u2 * csn[1]) * qs);
                  qo[80 + l15] = f2bf((u1 * csn[1] + u2 * csn[0]) * qs);
                }
              }
            }
        }, (gw + gstride - 32 % gstride) % gstride, gstride);
      }
      {
        u16* Ko = p.Kc; u16* Vo = p.Vv;
        ph_gemm_t(p.KVDN, 128, p.mla_kv_up + (size_t)layer * 128 * 1024, 1024, NTOK, 1024, 128, smem,
                  [&](const f32x4 (&acc)[4][4], int m0, int n0, int wm, int wn, int lq, int l15) {
#pragma unroll
          for (int mi = 0; mi < 4; ++mi)
#pragma unroll
            for (int r = 0; r < 4; ++r) {
              const int tok = m0 + wm * 64 + mi * 16 + lq * 4 + r; const int b = tok / T, t = tok % T;
#pragma unroll
              for (int ni = 0; ni < 4; ++ni) {
                const int col0 = n0 + wn * 64 + ni * 16; const int h = col0 >> 7, c0 = col0 & 127;
                const size_t rowi = (size_t)(b * NH + h) * T + t;
                if (c0 < 64) Ko[rowi * 96 + c0 + l15] = f2bf(acc[mi][ni][r]);
                else Vo[rowi * 64 + (c0 - 64) + l15] = f2bf(acc[mi][ni][r]);
              }
            }
        }, (gw + gstride - 192 % gstride) % gstride, gstride);
      }
    }
    PSYNC(7);
    ph_attn(p, smem, p.CTR + layer);
    PSYNC(5);
    ph_mla_norm(p, layer);
    ph_scan3(p, layer, smem);
    PSYNC(6);
    {
      for (int i = blockIdx.x * NTH + tidx(); i < NTOK; i += gridDim.x * NTH) p.TCNT[i] = 0;
      g8::Sched S; S.init(NTOK / 256, DM / 256, gridDim.x, bidx(), p.H, p.WOUT, DM);
      g8::EpiRes E{(layer == 0) ? p.x : p.out, p.out};
      g8::gemm_phase(glds, DM, S, E);
    }
    PSYNC(8);
    ph_norm_router(p, layer, smem);
    PSYNC(9);
    ph_topk(p, smem);
    ph_cvt_experts(p, layer, smem, p.CTR + 4 + layer);
    PSYNC(10);
    {
      g8::Sched S; S.init(NB * NE * CAP / 256, 2048 / 256, gridDim.x, bidx(), p.H, p.EW1, DM);
      S.group(4, NE, (size_t)2048 * 1024 * 2);
      g8::EpiSwi E{p.HID};
      g8::gemm_phase<g8::EpiSwi, true>(glds, DM, S, E, p.IDX, (LAS unsigned*)(dsm + g8::STAGE_BYTES + 64));
    }
    PSYNC(12);
    {
      g8::Sched S; S.init(NB * NE * CAP / 256, DM / 256, gridDim.x, bidx(), p.HID, p.EW2, 1024);
      S.group(4, NE, (size_t)1024 * 1024 * 2);
      g8::EpiYE E{p.YE, p.GATE};
      g8::gemm_phase(glds, 1024, S, E);
    }
    PSYNC(13);
    ph_combine_norm(p, layer);
    PSYNC(16);
    {
      g8::Sched S; S.init(NTOK / 256, DM / 256, gridDim.x, bidx(), p.H, p.WPG, DM);
      g8::EpiSig E{p.PGb};
      g8::gemm_phase(glds, DM, S, E);
    }
    {
      g8::Sched S; S.init(NTOK / 256, DM / 256, gridDim.x, bidx(), p.PB, p.WPP, DPLE);
      g8::EpiPle E{p.out, p.PGb};
      g8::gemm_phase(glds, DPLE, S, E);
    }
    PSYNC(15);
  }
  ph_final_norm(p.out, p.final_norm);
}

extern "C" void kernel_launch(void* const* d_in, const int* in_sizes, int n_in, void* d_out, int out_size, void* d_ws,
                              size_t ws_size, hipStream_t stream) {
  (void)in_sizes; (void)n_in; (void)out_size;
  PK pk{};
  for (int i = 0; i < 31; ++i) pk.in[i] = d_in[i];
  pk.out = (float*)d_out; pk.ws = (char*)d_ws;
  P p{};
  const size_t off = fill_ws(p, (char*)d_ws);
  if (off > ws_size) { fprintf(stderr, "workspace too small: need %zu have %zu\n", off, ws_size); return; }
  static int grid_blocks = 0;
  if (!grid_blocks) {
    int dev = 0, cus = 0, per_cu = 0;
    hipGetDevice(&dev);
    hipDeviceGetAttribute(&cus, hipDeviceAttributeMultiprocessorCount, dev);
    hipFuncSetAttribute((const void*)mega, hipFuncAttributeMaxDynamicSharedMemorySize, DSM_BYTES);
    hipOccupancyMaxActiveBlocksPerMultiprocessor(&per_cu, mega, NTH, DSM_BYTES);
    if (per_cu > 1) per_cu = 1;
    grid_blocks = cus * per_cu;
  }
  hipMemsetAsync(p.CTR, 0, 256 + (size_t)XCD_BAR_WORDS * 4, stream);
  void* args[] = {&pk};
  hipError_t e = hipLaunchCooperativeKernel((void*)mega, dim3(grid_blocks), dim3(NTH), args, DSM_BYTES, stream);
  if (e != hipSuccess) fprintf(stderr, "cooperative launch failed: %s (grid %d)\n", hipGetErrorString(e), grid_blocks);
}
```

```cpp
#include <hip/hip_runtime.h>
#include <hip/hip_bf16.h>
#include <cstdio>
#include <cstdint>
#include <hip/hip_cooperative_groups.h>
namespace cg = cooperative_groups;

#define DI __device__ __forceinline__
#define LAS __attribute__((address_space(3)))

constexpr int NB = 2, T = 8192, NTOK = NB * T, DM = 1024, NL = 2;
constexpr int RWW = 512, RWC = 1920, INC = 2336;
constexpr int NH = 8;
constexpr int NE = 16, CAP = 1024;
constexpr int DPLE = 256;
constexpr int NTH = 512;
constexpr float NORM_EPS = 1e-6f, GN_EPS = 64e-5f;

using bf16x8 = __attribute__((ext_vector_type(8))) short;
using s16x4  = __attribute__((ext_vector_type(4))) short;
using f32x4  = __attribute__((ext_vector_type(4))) float;
using u32x4  = __attribute__((ext_vector_type(4))) unsigned;
using f32x2  = __attribute__((ext_vector_type(2))) float;
using u32x2  = __attribute__((ext_vector_type(2))) unsigned;
typedef __bf16 bf2_t __attribute__((ext_vector_type(2)));
typedef unsigned short u16;

DI unsigned pk2(float a, float b) { bf2_t v = {(__bf16)a, (__bf16)b}; return __builtin_bit_cast(unsigned, v); }
DI u16 f2bf(float a) { return (u16)(pk2(a, 0.f) & 0xffffu); }
DI float bf2f(u16 u) { return __uint_as_float(((unsigned)u) << 16); }
DI const void* uni_ptr(const void* q) {
  unsigned long long v = (unsigned long long)q;
  unsigned lo = __builtin_amdgcn_readfirstlane((unsigned)v), hi = __builtin_amdgcn_readfirstlane((unsigned)(v >> 32));
  return (const void*)(((unsigned long long)hi << 32) | lo);
}
DI int tidx() { int t = threadIdx.x; asm volatile("" : "+v"(t)); return t; }
DI int bidx() { int b = blockIdx.x; asm volatile("" : "+s"(b)); return b; }
template <int CTRL> DI float dpp_f(float v) {
  return __int_as_float(__builtin_amdgcn_update_dpp(__float_as_int(v), __float_as_int(v), CTRL, 0xF, 0xF, true));
}
DI float red_x1(float v) { return v + dpp_f<0xB1>(v); }
DI float red_x2(float v) { return v + dpp_f<0x4E>(v); }
DI float red_x4(float v) { return v + dpp_f<0x141>(v); }
DI float red_x8(float v) { return v + dpp_f<0x140>(v); }
DI float red_x16(float v) { auto r = __builtin_amdgcn_permlane16_swap(__float_as_uint(v), __float_as_uint(v), false, false); return __uint_as_float(r[0]) + __uint_as_float(r[1]); }
DI float red_x32(float v) { auto r = __builtin_amdgcn_permlane32_swap(__float_as_uint(v), __float_as_uint(v), false, false); return __uint_as_float(r[0]) + __uint_as_float(r[1]); }
DI float red16(float v) { return red_x8(red_x4(red_x2(red_x1(v)))); }
DI float wave_sum(float v) { return red_x32(red_x16(red16(v))); }
DI float frcp(float x) { return __builtin_amdgcn_rcpf(x); }
DI float frsq(float x) { return __builtin_amdgcn_rsqf(x); }
DI float fexp(float x) { return __builtin_amdgcn_exp2f(x * 1.4426950408889634f); }
DI float sigmoidf_(float x) { return frcp(1.f + fexp(-x)); }
DI float ftanh(float x) { return 1.f - 2.f * frcp(1.f + fexp(2.f * x)); }
DI s16x4 tr_read(const short* p) {
  return __builtin_amdgcn_ds_read_tr16_b64_v4i16((LAS s16x4*)(p));
}

struct P {
  const float* x; const float* p; const int* pos;
  const float* attn_norm; const float* w_in; const float* rw_mu; const float* rw_w0; const float* rw_w_up;
  const float* rw_a0; const float* rw_a_up; const float* rw_g_up; const float* rw_k_k; const float* rw_k_a;
  const float* rw_r_k; const float* rw_lnx_w; const float* rw_lnx_b; const float* mla_q_norm; const float* mla_q_up;
  const float* mla_kv_norm; const float* mla_kv_up; const float* mla_o_norm; const float* w_out; const float* ffn_norm;
  const float* router; const float* exp_w_gate; const float* exp_w_up; const float* exp_w_down; const float* ple_norm;
  const float* ple_proj; const float* ple_gate; const float* final_norm;
  float* out;
  float* Z;
  u16* LW;
  u16* AA;
  float* MC; float* NC;
  float* SS;
  u16*   G;
  u16*   HID;
  float* R; float* K; float* V;
  float* PG;
  float* QRAW;
  float* KVRAW;
  float* AO;
  u16* O2;
  u16* TWD; u16* AD; u16* SGD; u16* QDN; u16* KVDN; float* KR;
  float* ROPE;
  u16* Q; u16* Kc; u16* Vv;
  u16* H;
  float* AFF;
  int* IDX;
  float* GATE;
  u16* WIN; u16* WOUT; u16* WPG; u16* WPP; u16* PB;
  u16* PGb;
  u16* EW1; u16* EW2;
  u16* XE; u16* YE;
  int* TCNT; int* TLIST;
  unsigned* CTR;
  unsigned* BAR;
};

constexpr int GBM = 256, GBN = 128, GBK = 64;
constexpr int AS_STRIDE = 72, BS_STRIDE = 136;
constexpr int AS_BYTES = GBM * AS_STRIDE * 2;
constexpr int BS_BYTES = GBK * BS_STRIDE * 2;
constexpr int SMEM_BYTES = 57344;

template <bool A_F32, int MODE, class ARow, class Epi>
DI void gemm_tile(ARow arow, const float* __restrict__ B, const float* __restrict__ B2, int ldb, int K, int n0, int Nvalid,
                  char* smem, Epi epi) {
  short* As = (short*)smem;
  short* Bs = (short*)(smem + AS_BYTES);
  const int tid = tidx(), lane = tid & 63, w = tid >> 6;
  const int wm = w >> 1, wn = w & 1;
  const int l15 = lane & 15, lq = lane >> 4;

  const char* ap[4];
#pragma unroll
  for (int i = 0; i < 4; ++i) {
    int u = tid + i * NTH; int row = u >> 3, kc = u & 7;
    ap[i] = (const char*)arow(row) + (size_t)kc * 8 * (A_F32 ? 4 : 2);
  }
  const float* bp[4]; bool bok[4];
#pragma unroll
  for (int i = 0; i < 4; ++i) {
    int u = tid + i * NTH; int k = u >> 5, nq = u & 31;
    int col; const float* base;
    if (MODE != 1) { col = n0 + nq * 4; base = B; }
    else { col = n0 + (nq & 15) * 4; base = (nq < 16) ? B : B2; }
    bok[i] = col < Nvalid;
    bp[i] = base + (size_t)k * ldb + (bok[i] ? col : 0);
  }

  f32x4 acc[4][4];
#pragma unroll
  for (int i = 0; i < 4; ++i)
#pragma unroll
    for (int j = 0; j < 4; ++j) acc[i][j] = f32x4{0.f, 0.f, 0.f, 0.f};

  u32x4 areg[4]; f32x4 breg[4];
#define GLOAD(kt_)                                                                                   \
  {                                                                                                  \
    _Pragma("unroll") for (int i = 0; i < 4; ++i) {                                                  \
      if (A_F32) {                                                                                   \
        const float4* q = (const float4*)(ap[i] + (size_t)(kt_) * GBK * 4);                          \
        float4 v0 = q[0], v1 = q[1];                                                                 \
        areg[i] = u32x4{pk2(v0.x, v0.y), pk2(v0.z, v0.w), pk2(v1.x, v1.y), pk2(v1.z, v1.w)};         \
      } else {                                                                                       \
        areg[i] = *(const u32x4*)(ap[i] + (size_t)(kt_) * GBK * 2);                                  \
      }                                                                                              \
    }                                                                                                \
    _Pragma("unroll") for (int i = 0; i < 4; ++i) {                                                  \
      if (bok[i]) breg[i] = *(const f32x4*)(bp[i] + (size_t)(kt_) * GBK * ldb);                      \
      else breg[i] = f32x4{0.f, 0.f, 0.f, 0.f};                                                      \
    }                                                                                                \
  }
  const int nk = K / GBK;
  GLOAD(0)
  for (int kt = 0; kt < nk; ++kt) {
    __syncthreads();
#pragma unroll
    for (int i = 0; i < 4; ++i) {
      int u = tid + i * NTH; int row = u >> 3, kc = u & 7;
      *(u32x4*)(As + row * AS_STRIDE + kc * 8) = areg[i];
    }
#pragma unroll
    for (int i = 0; i < 4; ++i) {
      int u = tid + i * NTH; int k = u >> 5, nq = u & 31;
      u32x2 v = u32x2{pk2(breg[i][0], breg[i][1]), pk2(breg[i][2], breg[i][3])};
      *(u32x2*)(Bs + k * BS_STRIDE + nq * 4) = v;
    }
    __syncthreads();
    if (kt + 1 < nk) GLOAD(kt + 1)
#pragma unroll
    for (int ks = 0; ks < 2; ++ks) {
      bf16x8 a[4], b[4];
#pragma unroll
      for (int mi = 0; mi < 4; ++mi)
        a[mi] = *(const bf16x8*)(As + (wm * 64 + mi * 16 + l15) * AS_STRIDE + ks * 32 + 8 * lq);
#pragma unroll
      for (int ni = 0; ni < 4; ++ni) {
        int col0 = (MODE != 1) ? (wn * 64 + ni * 16) : ((ni < 2) ? (wn * 32 + ni * 16) : (64 + wn * 32 + (ni - 2) * 16));
        int kb = ks * 32 + 8 * lq; int q = l15 >> 2, pp = l15 & 3;
        s16x4 lo = tr_read(Bs + (kb + q) * BS_STRIDE + col0 + 4 * pp);
        s16x4 hi = tr_read(Bs + (kb + 4 + q) * BS_STRIDE + col0 + 4 * pp);
        b[ni] = __builtin_shufflevector(lo, hi, 0, 1, 2, 3, 4, 5, 6, 7);
      }
#pragma unroll
      for (int mi = 0; mi < 4; ++mi)
#pragma unroll
        for (int ni = 0; ni < 4; ++ni)
          acc[mi][ni] = __builtin_amdgcn_mfma_f32_16x16x32_bf16(a[mi], b[ni], acc[mi][ni], 0, 0, 0);
    }
  }
  if constexpr (MODE == 2) { epi(acc, wm, wn, lq, l15); return; }
  else {
#pragma unroll
  for (int mi = 0; mi < 4; ++mi)
#pragma unroll
    for (int r = 0; r < 4; ++r) {
      int row = wm * 64 + mi * 16 + lq * 4 + r;
      if (MODE == 0) {
#pragma unroll
        for (int ni = 0; ni < 4; ++ni) {
          int col = n0 + wn * 64 + ni * 16 + l15;
          if (col < Nvalid) epi(row, col, acc[mi][ni][r], 0.f);
        }
      } else {
#pragma unroll
        for (int ni = 0; ni < 2; ++ni) {
          int col = n0 + wn * 32 + ni * 16 + l15;
          epi(row, col, acc[mi][ni][r], acc[mi][ni + 2][r]);
        }
      }
    }
  }
}

DI void wg_tokens(int& t0, int& t1) {
  const int per = (NTOK + (int)gridDim.x - 1) / (int)gridDim.x;
  t0 = (int)blockIdx.x * per; t1 = (t0 + per < NTOK) ? t0 + per : NTOK;
}
template <bool F32OUT>
DI void ph_norm_t(const float* X, const float* __restrict__ g, void* Out) {
  const int tid_ = tidx(); const int lane = tid_ & 63, w = tid_ >> 6;
  int t0, t1; wg_tokens(t0, t1);
  f32x4 gg[4];
#pragma unroll
  for (int j = 0; j < 4; ++j) gg[j] = ((const f32x4*)g)[lane + 64 * j];
  constexpr int U = 2;
  for (int tb = t0 + w * U; tb < t1; tb += 8 * U) {
    f32x4 v[U][4];
#pragma unroll
    for (int u = 0; u < U; ++u) {
      const int tok = (tb + u < t1) ? tb + u : t1 - 1;
      const f32x4* xr = (const f32x4*)(X + (size_t)tok * DM);
#pragma unroll
      for (int j = 0; j < 4; ++j) v[u][j] = xr[lane + 64 * j];
    }
#pragma unroll
    for (int u = 0; u < U; ++u) {
      float ss = 0.f;
#pragma unroll
      for (int j = 0; j < 4; ++j) ss += v[u][j][0] * v[u][j][0] + v[u][j][1] * v[u][j][1] + v[u][j][2] * v[u][j][2] + v[u][j][3] * v[u][j][3];
      ss = wave_sum(ss);
      const float rstd = frsq(ss * (1.f / DM) + NORM_EPS);
      if (tb + u < t1) {
#pragma unroll
        for (int j = 0; j < 4; ++j) {
          const f32x4 o = v[u][j] * rstd * gg[j];
          if constexpr (F32OUT) ((f32x4*)Out)[(size_t)(tb + u) * (DM / 4) + lane + 64 * j] = o;
          else *(u32x2*)((u16*)Out + (size_t)(tb + u) * DM + (lane + 64 * j) * 4) = u32x2{pk2(o[0], o[1]), pk2(o[2], o[3])};
        }
      }
    }
  }
}
DI void ph_norm(const float* X, const float* g, u16* Hout) { ph_norm_t<false>(X, g, Hout); }
DI void ph_final_norm(float* X, const float* g) { ph_norm_t<true>(X, g, X); }

template <bool A_F32, class Epi>
DI void ph_gemm(const void* A, int lda, const float* B, int ldb, int M, int N, int K, char* smem, Epi epi, int tfirst, int tstride) {
  const int ntn = (N + GBN - 1) / GBN, ntm = M / GBM;
  for (int t = tfirst; t < ntm * ntn; t += tstride) {
    int tm = t / ntn, tn = t % ntn;
    int m0 = tm * GBM, n0 = tn * GBN;
    auto arow = [&](int r) -> const void* { return (const char*)A + (size_t)(m0 + r) * lda * (A_F32 ? 4 : 2); };
    gemm_tile<A_F32, 0>(arow, B, nullptr, ldb, K, n0, N, smem, [&](int row, int col, float v, float) { epi(m0 + row, col, v); });
    __syncthreads();
  }
}

template <class Epi>
DI void ph_gemm_t(const void* A, int lda, const float* B, int ldb, int M, int N, int K, char* smem, Epi epi, int tfirst, int tstride) {
  const int ntn = (N + GBN - 1) / GBN, ntm = M / GBM;
  for (int t = tfirst; t < ntm * ntn; t += tstride) {
    int tm = t / ntn, tn = t % ntn;
    int m0 = tm * GBM, n0 = tn * GBN;
    auto arow = [&](int r) -> const void* { return (const char*)A + (size_t)(m0 + r) * lda * 2; };
    gemm_tile<false, 2>(arow, B, nullptr, ldb, K, n0, N, smem,
                        [&](const f32x4 (&acc)[4][4], int wm, int wn, int lq, int l15) { epi(acc, m0, n0, wm, wn, lq, l15); });
    __syncthreads();
  }
}

DI void ph_rwshift(const P& p, int layer) {
  const int tid_ = tidx();
  const int per = (NTOK + (int)gridDim.x - 1) / (int)gridDim.x;
  const int t0 = (int)blockIdx.x * per, t1 = (t0 + per < NTOK) ? t0 + per : NTOK;
  if (tid_ < RWC / 4 && t0 < t1) {
    const int c = tid_ * 4;
    const f32x4 m = *(const f32x4*)(p.rw_mu + layer * RWC + c);
    const float* zc = p.Z + c;
    const f32x4 zero = f32x4{0.f, 0.f, 0.f, 0.f};
    constexpr int U = 8;
    f32x4 w[U + 2];
    w[0] = (t0 > 0) ? *(const f32x4*)(zc + (size_t)(t0 - 1) * INC) : zero;
    w[1] = *(const f32x4*)(zc + (size_t)t0 * INC);
    for (int tb = t0; tb < t1; tb += U) {
#pragma unroll
      for (int u = 0; u < U; ++u) { const int tn = tb + u + 1; w[u + 2] = (tn < NTOK && tn <= t1) ? *(const f32x4*)(zc + (size_t)tn * INC) : zero; }
#pragma unroll
      for (int u = 0; u < U; ++u) {
        const int tok = tb + u;
        if (tok < t1) {
          const int t = tok % T;
          const f32x4 zm = (t > 0) ? w[u] : zero, zp = (t < T - 1) ? w[u + 2] : zero, z = w[u + 1];
          const f32x4 o = z + m * (0.5f * (zm + zp) - z);
          if (c < 512) *(f32x4*)(p.R + (size_t)tok * RWW + c) = o;
          else if (c < 1024) *(f32x4*)(p.K + (size_t)tok * RWW + (c - 512)) = o;
          else if (c < 1536) *(f32x4*)(p.V + (size_t)tok * RWW + (c - 1024)) = o;
          else if (c < 1664) {
            const int d = (c - 1536) >> 6, l = (c - 1536) & 63;
            *(u32x2*)(p.TWD + ((size_t)d * NTOK + tok) * 64 + l) = u32x2{pk2(ftanh(o[0]), ftanh(o[1])), pk2(ftanh(o[2]), ftanh(o[3]))};
          } else if (c < 1792) {
            const int d = (c - 1664) >> 6, l = (c - 1664) & 63;
            *(u32x2*)(p.AD + ((size_t)d * NTOK + tok) * 64 + l) = u32x2{pk2(o[0], o[1]), pk2(o[2], o[3])};
          } else {
            const int l = c - 1792;
            *(u32x2*)(p.SGD + (size_t)tok * 128 + l) = u32x2{pk2(sigmoidf_(o[0]), sigmoidf_(o[1])), pk2(sigmoidf_(o[2]), sigmoidf_(o[3]))};
          }
        }
      }
      w[0] = w[U]; w[1] = w[U + 1];
    }
  }
}

DI void rope_cs(int pos, int i, float& cs, float& sn) {
  const int i3 = i & 3, i2 = i >> 2;
  const float c4 = (i3 == 0) ? 1.0f : (i3 == 1) ? 0.5623413251903491f : (i3 == 2) ? 0.31622776601683794f : 0.1778279410038923f;
  const float p10 = (i2 == 0) ? 1.0f : (i2 == 1) ? 0.1f : (i2 == 2) ? 0.01f : 0.001f;
  float inv = c4 * p10;
  float ang = (float)pos * inv;
  double rev = (double)ang * 0.15915494309189535;
  rev -= floor(rev);
  float rf = (float)rev;
  sn = __builtin_amdgcn_sinf(rf);
  cs = __builtin_amdgcn_cosf(rf);
}

DI void ph_rope_table(const P& p) {
  for (int i = blockIdx.x * NTH + tidx(); i < NTOK * 16; i += gridDim.x * NTH) {
    float cs, sn; rope_cs(p.pos[i >> 4], i & 15, cs, sn);
    *(f32x2*)(p.ROPE + (size_t)i * 2) = f32x2{cs, sn};
  }
}
DI void ph_mlaprep1(const P& p, int layer) {
  const int tid_ = tidx(); const int lane = tid_ & 63, w = tid_ >> 6;
  const f32x4 g = *(const f32x4*)(p.mla_q_norm + layer * 256 + lane * 4);
  const f32x2 g2 = *(const f32x2*)(p.mla_kv_norm + layer * 128 + lane * 2);
  const int per = (NTOK + (int)gridDim.x - 1) / (int)gridDim.x;
  const int t0 = (int)blockIdx.x * per, t1 = (t0 + per < NTOK) ? t0 + per : NTOK;
  constexpr int U = 4;
  for (int tb = t0 + w * U; tb < t1; tb += 8 * U) {
    f32x4 q[U]; f32x2 kv[U]; float u1[U], u2[U]; f32x2 csn[U];
#pragma unroll
    for (int u = 0; u < U; ++u) {
      const int tok = (tb + u < t1) ? tb + u : t1 - 1;
      const float* zr = p.Z + (size_t)tok * INC + RWC;
      q[u] = *(const f32x4*)(zr + lane * 4); kv[u] = *(const f32x2*)(zr + 256 + lane * 2);
      u1[u] = zr[384 + (lane & 15)]; u2[u] = zr[384 + 16 + (lane & 15)];
      csn[u] = *(const f32x2*)(p.ROPE + (size_t)tok * 32 + (lane & 15) * 2);
    }
#pragma unroll
    for (int u = 0; u < U; ++u) {
      const int tok = tb + u;
      const float ss = wave_sum(q[u][0] * q[u][0] + q[u][1] * q[u][1] + q[u][2] * q[u][2] + q[u][3] * q[u][3]);
      const float rstd = frsq(ss * (1.f / 256) + NORM_EPS);
      const float ss2 = wave_sum(kv[u][0] * kv[u][0] + kv[u][1] * kv[u][1]);
      const float rstd2 = frsq(ss2 * (1.f / 128) + NORM_EPS);
      if (tok < t1) {
        *(u32x2*)(p.QDN + (size_t)tok * 256 + lane * 4) = u32x2{pk2(q[u][0] * rstd * g[0], q[u][1] * rstd * g[1]), pk2(q[u][2] * rstd * g[2], q[u][3] * rstd * g[3])};
        *(unsigned*)(p.KVDN + (size_t)tok * 128 + lane * 2) = pk2(kv[u][0] * rstd2 * g2[0], kv[u][1] * rstd2 * g2[1]);
        if (lane < 16) {
          const u16 k1 = f2bf(u1[u] * csn[u][0] - u2[u] * csn[u][1]), k2 = f2bf(u1[u] * csn[u][1] + u2[u] * csn[u][0]);
          const int bb = tok / T, tt = tok % T;
#pragma unroll
          for (int h = 0; h < NH; ++h) {
            u16* ko = p.Kc + ((size_t)(bb * NH + h) * T + tt) * 96 + 64;
            ko[lane] = k1; ko[16 + lane] = k2;
          }
        }
      }
    }
  }
}

DI void ph_mlafinish(const P& p) {
  const int tid_ = tidx(); const int lane = tid_ & 63, w = tid_ >> 6;
  const float qs = 0.10206207261596577f * 1.4426950408889634f;
  for (int tok = blockIdx.x * 8 + w; tok < NTOK; tok += gridDim.x * 8) {
    int b = tok / T, t = tok % T;
    float cs = 0.f, sn = 0.f;
    if (lane < 16) rope_cs(p.pos[tok], lane, cs, sn);
    const float* qr = p.QRAW + (size_t)tok * 768;
    const float* kvr = p.KVRAW + (size_t)tok * 1024;
    const float* kr = p.KR + (size_t)tok * 32;
#pragma unroll
    for (int h = 0; h < NH; ++h) {
      size_t row = ((size_t)(b * NH + h) * T + t);
      u16* qo = p.Q + row * 96; u16* ko = p.Kc + row * 96; u16* vo = p.Vv + row * 64;
      qo[lane] = f2bf(qr[h * 96 + lane] * qs);
      ko[lane] = f2bf(kvr[h * 128 + lane]);
      vo[lane] = f2bf(kvr[h * 128 + 64 + lane]);
      if (lane < 16) {
        float u1 = qr[h * 96 + 64 + lane], u2 = qr[h * 96 + 80 + lane];
        qo[64 + lane] = f2bf((u1 * cs - u2 * sn) * qs);
        qo[80 + lane] = f2bf((u1 * sn + u2 * cs) * qs);
      }
      if (lane < 32) ko[64 + lane] = f2bf(kr[lane]);
    }
  }
}

using f32x16 = __attribute__((ext_vector_type(16))) float;
#define SBAR() __builtin_amdgcn_sched_barrier(0)
constexpr int AT_KSTR = 104;
constexpr int AT_KBYTES = 64 * AT_KSTR * 2;
constexpr int AT_VBYTES = 64 * 64 * 2;
constexpr float AT_THR = 8.f;
DI int crow(int r, int hi) { return (r & 3) + 8 * (r >> 2) + 4 * hi; }
DI int v_st(int k, int c) { const int kk = (k & ~0xC) | ((k & 4) << 1) | ((k & 8) >> 1); return ((kk >> 3) * 2 + (c >> 5)) * 512 + ((kk & 7) * 32 + (c & 31)) * 2; }
DI int v_rd_base(int lane) { return ((lane & 3) << 3) | (((lane >> 2) & 3) << 6) | (((lane >> 4) & 1) << 5) | (((lane >> 5) & 1) << 8); }
constexpr int v_rd_off(int d0, int ks, int half) { return d0 * 512 + ks * 2048 + half * 1024; }

DI void at_partialSM(f32x16& p0, f32x16& p1, float& m_reg, float& mn, float& alpha) {
  float pmax = p0[0];
#pragma unroll
  for (int r = 1; r < 16; ++r) pmax = fmaxf(pmax, p0[r]);
#pragma unroll
  for (int r = 0; r < 16; ++r) pmax = fmaxf(pmax, p1[r]);
  { auto rr = __builtin_amdgcn_permlane32_swap(__float_as_uint(pmax), __float_as_uint(pmax), false, false);
    pmax = fmaxf(__uint_as_float(rr[0]), __uint_as_float(rr[1])); }
  if (__builtin_expect(__all(pmax - m_reg <= AT_THR), 1)) { mn = m_reg; alpha = 1.f; }
  else { mn = fmaxf(m_reg, pmax); alpha = __builtin_amdgcn_exp2f(m_reg - mn); m_reg = mn; }
#pragma unroll
  for (int r = 0; r < 16; ++r) { p0[r] = p0[r] - mn; p1[r] = p1[r] - mn; }
#pragma unroll
  for (int r = 0; r < 16; ++r) p0[r] = __builtin_amdgcn_exp2f(p0[r]);
}
DI void at_finishSM(f32x16& p0, f32x16& p1, float alpha, float& l_reg, bf16x8& pa0, bf16x8& pa1, bf16x8& pa2, bf16x8& pa3) {
#pragma unroll
  for (int r = 0; r < 16; ++r) p1[r] = __builtin_amdgcn_exp2f(p1[r]);
  float ps = 0;
#pragma unroll
  for (int r = 0; r < 16; ++r) ps += p0[r];
#pragma unroll
  for (int r = 0; r < 16; ++r) ps += p1[r];
  { auto rr = __builtin_amdgcn_permlane32_swap(__float_as_uint(ps), __float_as_uint(ps), false, false);
    ps = __uint_as_float(rr[0]) + __uint_as_float(rr[1]); }
  l_reg = l_reg * alpha + ps;
#define PK4(PP, BASE, OUT) do { unsigned a0 = pk2(PP[BASE + 0], PP[BASE + 1]), a1 = pk2(PP[BASE + 2], PP[BASE + 3]);   \
    unsigned b0 = pk2(PP[BASE + 4], PP[BASE + 5]), b1 = pk2(PP[BASE + 6], PP[BASE + 7]);                              \
    auto r0 = __builtin_amdgcn_permlane32_swap(a0, b0, false, false); auto r1 = __builtin_amdgcn_permlane32_swap(a1, b1, false, false); \
    u32x4 wv = {r0[0], r1[0], r0[1], r1[1]}; OUT = __builtin_bit_cast(bf16x8, wv); } while (0)
  PK4(p0, 0, pa0); PK4(p0, 8, pa1); PK4(p1, 0, pa2); PK4(p1, 8, pa3);
#undef PK4
}
DI void at_qkt(f32x16& p0, f32x16& p1, const char* Kb, const bf16x8* qr, int r32, int hi) {
#pragma unroll
  for (int r = 0; r < 16; ++r) { p0[r] = 0.f; p1[r] = 0.f; }
#pragma unroll
  for (int d0 = 0; d0 < 6; ++d0) {
    bf16x8 b0 = *(const bf16x8*)(Kb + (r32 * AT_KSTR + d0 * 16 + hi * 8) * 2);
    bf16x8 b1 = *(const bf16x8*)(Kb + ((32 + r32) * AT_KSTR + d0 * 16 + hi * 8) * 2);
    __builtin_amdgcn_s_setprio(1);
    p0 = __builtin_amdgcn_mfma_f32_32x32x16_bf16(b0, qr[d0], p0, 0, 0, 0);
    p1 = __builtin_amdgcn_mfma_f32_32x32x16_bf16(b1, qr[d0], p1, 0, 0, 0);
    __builtin_amdgcn_s_setprio(0);
  }
}
template <int D0> DI void at_pv_one(f32x16& od, const char* vb, bf16x8 pa0, bf16x8 pa1, bf16x8 pa2, bf16x8 pa3) {
#define TRR(ks, half) tr_read((const short*)(vb + v_rd_off(D0, ks, half)))
  const s16x4 l0 = TRR(0, 0), h0 = TRR(0, 1), l1 = TRR(1, 0), h1 = TRR(1, 1), l2 = TRR(2, 0), h2 = TRR(2, 1), l3 = TRR(3, 0), h3 = TRR(3, 1);
#undef TRR
#define PKV(L, H) __builtin_shufflevector(L, H, 0, 1, 2, 3, 4, 5, 6, 7)
  __builtin_amdgcn_s_setprio(1);
  od = __builtin_amdgcn_mfma_f32_32x32x16_bf16(pa0, PKV(l0, h0), od, 0, 0, 0);
  od = __builtin_amdgcn_mfma_f32_32x32x16_bf16(pa1, PKV(l1, h1), od, 0, 0, 0);
  od = __builtin_amdgcn_mfma_f32_32x32x16_bf16(pa2, PKV(l2, h2), od, 0, 0, 0);
  od = __builtin_amdgcn_mfma_f32_32x32x16_bf16(pa3, PKV(l3, h3), od, 0, 0, 0);
  __builtin_amdgcn_s_setprio(0);
#undef PKV
}
DI void at_pv(f32x16* o, const char* vb, bf16x8 pa0, bf16x8 pa1, bf16x8 pa2, bf16x8 pa3) {
  at_pv_one<0>(o[0], vb, pa0, pa1, pa2, pa3); at_pv_one<1>(o[1], vb, pa0, pa1, pa2, pa3);
}

DI void attn_body(const u16* __restrict__ Qb, const u16* __restrict__ Kh, const u16* __restrict__ Vh, float* __restrict__ Ob, char* lds, int tid) {
  const int wid = tid >> 6, lane = tid & 63, r32 = lane & 31, hi = lane >> 5;
  char* V_lds = lds; char* K_lds = lds + 2 * AT_VBYTES;
  float* wsp = (float*)(lds + 2 * AT_VBYTES + 2 * AT_KBYTES) + wid * 64; float* li_l = wsp; float* al_l = wsp + 32;
  float m_reg = -1e30f, l_reg = 0.f; f32x16 o[2]; bf16x8 qr[6];
#pragma unroll
  for (int r = 0; r < 16; ++r) { o[0][r] = 0.f; o[1][r] = 0.f; }
  const u16* Qw = Qb + (size_t)(wid * 32 + r32) * 96 + hi * 8;
#pragma unroll
  for (int d0 = 0; d0 < 6; ++d0) qr[d0] = *(const bf16x8*)(Qw + d0 * 16);
  const int kid1 = (tid < 256) ? tid + 512 : tid;
  const int kst0 = ((tid / 12) * AT_KSTR + (tid % 12) * 8) * 2, kst1 = ((kid1 / 12) * AT_KSTR + (kid1 % 12) * 8) * 2;
  const int vst = v_st(tid >> 3, (tid & 7) * 8);
  const char* vb0 = V_lds + v_rd_base(lane);
  u32x4 sk0[2], sk1[2], sv0[2];
#define SLOAD(i, k0) do { sk0[i] = *(const u32x4*)(Kh + (size_t)(k0) * 96 + tid * 8); sk1[i] = *(const u32x4*)(Kh + (size_t)(k0) * 96 + kid1 * 8); \
    sv0[i] = *(const u32x4*)(Vh + (size_t)(k0) * 64 + tid * 8); } while (0)
#define SWRITE(b, i) do { *(u32x4*)(K_lds + (b) * AT_KBYTES + kst0) = sk0[i]; if (tid < 256) *(u32x4*)(K_lds + (b) * AT_KBYTES + kst1) = sk1[i]; \
    *(u32x4*)(V_lds + (b) * AT_VBYTES + vst) = sv0[i]; } while (0)
#define SWAIT() asm volatile("s_waitcnt vmcnt(3)" ::: "memory")
#define RESC(a) do { if (__any((a) < 1.f)) { if (hi == 0) al_l[r32] = (a); asm volatile("s_waitcnt lgkmcnt(0)" ::: "memory"); \
    _Pragma("unroll") for (int r = 0; r < 16; ++r) { float al = al_l[crow(r, hi)]; o[0][r] *= al; o[1][r] *= al; } } } while (0)
  f32x16 pA0, pA1, pB0, pB1; float mnA, mnB, alA, alB; bf16x8 pa0, pa1, pa2, pa3; constexpr int NT = T / 64;
  SLOAD(0, 0); SWRITE(0, 0); __syncthreads();
  at_qkt(pA0, pA1, K_lds, qr, r32, hi); at_partialSM(pA0, pA1, m_reg, mnA, alA);
  SLOAD(1, 64); SLOAD(0, 128);
  SWAIT(); SWRITE(1, 1); __syncthreads();
  for (int j = 1; j + 1 < NT; j += 2) {
    SBAR(); at_qkt(pB0, pB1, K_lds + AT_KBYTES, qr, r32, hi);
    at_finishSM(pA0, pA1, alA, l_reg, pa0, pa1, pa2, pa3); SBAR();
    SLOAD(1, (j + 2) * 64); SBAR();
    at_pv(o, vb0, pa0, pa1, pa2, pa3); at_partialSM(pB0, pB1, m_reg, mnB, alB);
    __syncthreads(); SWAIT(); SWRITE(0, 0);
    RESC(alB); __syncthreads();
    SBAR(); at_qkt(pA0, pA1, K_lds, qr, r32, hi);
    at_finishSM(pB0, pB1, alB, l_reg, pa0, pa1, pa2, pa3); SBAR();
    if (j + 3 < NT) SLOAD(0, (j + 3) * 64); SBAR();
    at_pv(o, vb0 + AT_VBYTES, pa0, pa1, pa2, pa3); at_partialSM(pA0, pA1, m_reg, mnA, alA);
    __syncthreads(); SWAIT(); SWRITE(1, 1);
    RESC(alA); __syncthreads();
  }
  SBAR(); at_qkt(pB0, pB1, K_lds + AT_KBYTES, qr, r32, hi);
  at_finishSM(pA0, pA1, alA, l_reg, pa0, pa1, pa2, pa3); SBAR();
  at_pv(o, vb0, pa0, pa1, pa2, pa3); at_partialSM(pB0, pB1, m_reg, mnB, alB);
  __syncthreads(); RESC(alB);
  at_finishSM(pB0, pB1, alB, l_reg, pa0, pa1, pa2, pa3); SBAR();
  at_pv(o, vb0 + AT_VBYTES, pa0, pa1, pa2, pa3);
  if (hi == 0) li_l[r32] = l_reg;
  asm volatile("s_waitcnt lgkmcnt(0)" ::: "memory");
  float* Ow = Ob + (size_t)(wid * 32) * 512;
#pragma unroll
  for (int r = 0; r < 16; ++r) {
    int orow = crow(r, hi); float rl = __builtin_amdgcn_rcpf(li_l[orow]);
    Ow[(size_t)orow * 512 + r32] = o[0][r] * rl; Ow[(size_t)orow * 512 + 32 + r32] = o[1][r] * rl;
  }
#undef SLOAD
#undef SWRITE
#undef SWAIT
#undef RESC
}

DI void ph_attn(const P& p, char* smem, unsigned* ctr) {
  const int tid = tidx();
  int* sitem = (int*)(smem + SMEM_BYTES - 16);
  for (;;) {
    __syncthreads();
    if (tid == 0) *sitem = (int)atomicAdd(ctr, 1u);
    __syncthreads();
    const int item = *sitem;
    if (item >= NB * NH * (T / 256)) break;
    const int bh = item / (T / 256), qb = item % (T / 256);
    const int b = bh / NH, h = bh % NH;
    attn_body(p.Q + ((size_t)bh * T + qb * 256) * 96, p.Kc + (size_t)bh * T * 96, p.Vv + (size_t)bh * T * 64,
              p.AO + ((size_t)(b * T + qb * 256)) * 512 + h * 64, smem, tid);
  }
}

constexpr int SC = 256, NCH = T / SC;
constexpr int SBUF = 5184;
template <int NI> struct ScanRegsN { float k[2 * NI], r[2 * NI], v[2 * NI]; u16 lw[2 * NI], a[2 * NI]; };
template <int NI>
DI void scan_load_n(const P& p, int b, int h, int d, int n0, int lane, int ws, ScanRegsN<NI>& g) {
  constexpr int WPI = 8 / NI;
  const u16* LWd = p.LW + (size_t)d * NTOK * RWW;
  const u16* AAd = p.AA + (size_t)d * NTOK * RWW;
  const int ch = h * 64 + lane;
#pragma unroll
  for (int jj = 0; jj < 2 * NI; ++jj) {
    int n = n0 + ws + WPI * jj; int t = d ? (T - 1 - n) : n;
    size_t off = ((size_t)(b * T + t)) * RWW + ch;
    g.k[jj] = p.K[off]; g.r[jj] = p.R[off]; g.v[jj] = p.V[off]; g.lw[jj] = LWd[off]; g.a[jj] = AAd[off];
  }
}
template <int NI>
DI void scan_put_n(const ScanRegsN<NI>& g, float kkc, float kac, float* sm, float* slw, int lane, int ws) {
  constexpr int WPI = 8 / NI;
#pragma unroll
  for (int jj = 0; jj < 2 * NI; ++jj) slw[(ws + WPI * jj) * 64 + lane] = bf2f(g.lw[jj]);
  __syncthreads();
  float Lj[2 * NI];
#pragma unroll
  for (int jj = 0; jj < 2 * NI; ++jj) Lj[jj] = 0.f;
#pragma unroll
  for (int i = 0; i < 16; ++i) {
    const float x = slw[i * 64 + lane];
#pragma unroll
    for (int jj = 0; jj < 2 * NI; ++jj) Lj[jj] += (i <= ws + WPI * jj) ? x : 0.f;
  }
#pragma unroll
  for (int jj = 0; jj < 2 * NI; ++jj) {
    const int j = ws + WPI * jj;
    const float L = Lj[jj], lwj = bf2f(g.lw[jj]);
    const float Pt = fexp(L), Pm = fexp(L - lwj), iP = fexp(-L);
    const float kv = g.k[jj];
    const float kx = kv * kkc;
    const float nrm = __builtin_amdgcn_sqrtf(wave_sum(kx * kx));
    const float kkv = kx * frcp(fmaxf(nrm, 1e-12f));
    const float a = bf2f(g.a[jj]);
    sm[j * 64 + lane] = -kkv * Pm;
    sm[1024 + j * 64 + lane] = a * kkv * iP;
    sm[2048 + j * 64 + lane] = kv * (1.f + (a - 1.f) * kac) * iP;
    sm[3072 + j * 64 + lane] = g.r[jj] * Pt;
    sm[4096 + j * 64 + lane] = g.v[jj];
    if (j == 15) sm[5120 + lane] = Pt;
  }
}
using f32x16s = __attribute__((ext_vector_type(16))) float;
DI void scan_ld8(f32x4 (&kv)[8], const float* vec, int hi) {
#pragma unroll
  for (int tk = 0; tk < 2; ++tk)
#pragma unroll
    for (int q = 0; q < 4; ++q) kv[tk * 4 + q] = *(const f32x4*)(vec + 32 * tk + 8 * q + 4 * hi);
}
DI float scan_dot8(const f32x16s (&acc)[2], const f32x4 (&kv)[8]) {
  float pq[4] = {0.f, 0.f, 0.f, 0.f};
#pragma unroll
  for (int tk = 0; tk < 2; ++tk)
#pragma unroll
    for (int e = 0; e < 4; ++e)
#pragma unroll
      for (int q = 0; q < 4; ++q) { pq[q] = __builtin_fmaf(acc[tk][4 * q + e], kv[tk * 4 + q][e], pq[q]); asm("" : "+v"(pq[q])); }
  return red_x32((pq[0] + pq[1]) + (pq[2] + pq[3]));
}

DI void ph_scan1(const P& p, int layer, char* smem) {
  constexpr int NI = 2;
  const int tid = tidx(), lane = tid & 63, w = tid >> 6;
  const int jl = lane & 31, hi = lane >> 5;
  const int it = w >> 2, vt = w & 3, ws = w & 3;
  float* smi = (float*)smem + it * (2 * SBUF + 1024);
  float* slw = smi + 2 * SBUF;
  for (int pair = blockIdx.x; pair < 32 * NCH / 2; pair += gridDim.x) {
    const int item = pair * 2 + it; const int scan = item / NCH, c = item % NCH;
    const int d = scan & 1, h = (scan >> 1) % NH, b = scan / (2 * NH);
    const float kkc = p.rw_k_k[layer * RWW + h * 64 + lane], kac = p.rw_k_a[layer * RWW + h * 64 + lane];
    f32x16s acc[2];
#pragma unroll
    for (int tk = 0; tk < 2; ++tk)
#pragma unroll
      for (int r = 0; r < 16; ++r) acc[tk][r] = (32 * tk + (r & 3) + 8 * (r >> 2) + 4 * hi == 32 * vt + jl) ? 1.f : 0.f;
    ScanRegsN<NI> g;
    scan_load_n<NI>(p, b, h, d, c * SC, lane, ws, g);
    __syncthreads();
    scan_put_n<NI>(g, kkc, kac, smi, slw, lane, ws);
    __syncthreads();
    for (int sub = 0; sub < SC / 16; ++sub) {
      const float* sm = smi + (sub & 1) * SBUF;
      if (sub + 1 < SC / 16) scan_load_n<NI>(p, b, h, d, c * SC + (sub + 1) * 16, lane, ws, g);
      const float* vrow = sm + 4096 + ((vt >= 2) ? 32 * (vt - 2) : 0) + jl;
      f32x4 kc[8]; scan_ld8(kc, sm, hi);
      float a0 = sm[1024 + hi * 1024 + jl], a1 = sm[1024 + hi * 1024 + 32 + jl], vc = vrow[0];
#pragma unroll 4
      for (int j = 0; j < 16; ++j) {
        const int jn = (j + 1) & 15;
        f32x4 kn[8]; scan_ld8(kn, sm + jn * 64, hi);
        const float an0 = sm[1024 + hi * 1024 + jn * 64 + jl], an1 = sm[1024 + hi * 1024 + jn * 64 + 32 + jl], vn = vrow[jn * 64];
        SBAR();
        const float sa = scan_dot8(acc, kc);
        const float bop = hi ? ((vt >= 2) ? vc : 0.f) : sa;
        acc[0] = __builtin_amdgcn_mfma_f32_32x32x2f32(a0, bop, acc[0], 0, 0, 0);
        acc[1] = __builtin_amdgcn_mfma_f32_32x32x2f32(a1, bop, acc[1], 0, 0, 0);
        SBAR();
#pragma unroll
        for (int i = 0; i < 8; ++i) kc[i] = kn[i];
        a0 = an0; a1 = an1; vc = vn;
      }
#pragma unroll
      for (int tk = 0; tk < 2; ++tk)
#pragma unroll
        for (int q = 0; q < 4; ++q) {
          const f32x4 pv = *(const f32x4*)(sm + 5120 + 32 * tk + 8 * q + 4 * hi);
#pragma unroll
          for (int e = 0; e < 4; ++e) acc[tk][4 * q + e] *= pv[e];
        }
      if (sub + 1 < SC / 16) scan_put_n<NI>(g, kkc, kac, smi + ((sub + 1) & 1) * SBUF, slw, lane, ws);
      __syncthreads();
    }
    {
      const int v = 32 * vt + jl;
      float* dst = ((v < 64) ? p.MC : p.NC) + (((size_t)scan * NCH + c) * 64 + (v & 63)) * 64;
#pragma unroll
      for (int tk = 0; tk < 2; ++tk)
#pragma unroll
        for (int q = 0; q < 4; ++q)
          *(f32x4*)(dst + 32 * tk + 8 * q + 4 * hi) = f32x4{acc[tk][4 * q], acc[tk][4 * q + 1], acc[tk][4 * q + 2], acc[tk][4 * q + 3]};
    }
  }
}


DI void ph_scan2(const P& p, char* smem) {
  constexpr int LS = 72;
  u16* Sh = (u16*)smem; u16* Sl = Sh + 64 * LS; u16* Mh = Sl + 64 * LS; u16* Ml = Mh + 64 * LS;
  const int tid = tidx(), lane = tid & 63, w = tid >> 6;
  const int l15 = lane & 15, lq = lane >> 4;
  const int ti = w >> 1, tj0 = (w & 1) * 2;
  for (int scan = blockIdx.x; scan < 32; scan += gridDim.x) {
    const float* Mg = p.MC + (size_t)scan * NCH * 4096;
    const float* Ng = p.NC + (size_t)scan * NCH * 4096;
    float* Sg = p.SS + (size_t)scan * NCH * 4096;
    struct MN { f32x4 m0, m1, n[2]; };
    auto ldmn = [&](MN& r, int c) {
      const int cc = (c < NCH) ? c : (NCH - 1);
      r.m0 = *(const f32x4*)(Mg + (size_t)cc * 4096 + tid * 8); r.m1 = *(const f32x4*)(Mg + (size_t)cc * 4096 + tid * 8 + 4);
#pragma unroll
      for (int q = 0; q < 2; ++q)
#pragma unroll
        for (int r4 = 0; r4 < 4; ++r4) r.n[q][r4] = Ng[(size_t)cc * 4096 + (ti * 16 + lq * 4 + r4) * 64 + (tj0 + q) * 16 + l15];
    };
    f32x4 sacc[2];
    sacc[0] = f32x4{0.f, 0.f, 0.f, 0.f}; sacc[1] = sacc[0];
    auto step = [&](int c, const MN& r) {
      __syncthreads();
#pragma unroll
      for (int q = 0; q < 2; ++q)
#pragma unroll
        for (int r4 = 0; r4 < 4; ++r4) {
          const int row = ti * 16 + lq * 4 + r4, col = (tj0 + q) * 16 + l15;
          const float x = sacc[q][r4];
          Sg[(size_t)c * 4096 + row * 64 + col] = x;
          const u16 h = f2bf(x); Sh[row * LS + col] = h; Sl[row * LS + col] = f2bf(x - bf2f(h));
        }
      {
        const int mr = tid >> 3, mc = (tid & 7) * 8;
        float xh[8], xl[8];
#pragma unroll
        for (int i = 0; i < 8; ++i) { const float x = (i < 4) ? r.m0[i & 3] : r.m1[i & 3]; const float h = bf2f(f2bf(x)); xh[i] = h; xl[i] = x - h; }
        *(u32x4*)(Mh + mr * LS + mc) = u32x4{pk2(xh[0], xh[1]), pk2(xh[2], xh[3]), pk2(xh[4], xh[5]), pk2(xh[6], xh[7])};
        *(u32x4*)(Ml + mr * LS + mc) = u32x4{pk2(xl[0], xl[1]), pk2(xl[2], xl[3]), pk2(xl[4], xl[5]), pk2(xl[6], xl[7])};
      }
      f32x4 acc[2] = {r.n[0], r.n[1]};
      __syncthreads();
#pragma unroll
      for (int ks = 0; ks < 2; ++ks) {
        const bf16x8 ah = *(const bf16x8*)(Sh + (ti * 16 + l15) * LS + ks * 32 + 8 * lq);
        const bf16x8 al = *(const bf16x8*)(Sl + (ti * 16 + l15) * LS + ks * 32 + 8 * lq);
#pragma unroll
        for (int q = 0; q < 2; ++q) {
          const int kb = ks * 32 + 8 * lq, tq = l15 >> 2, tp = l15 & 3, co = (tj0 + q) * 16 + 4 * tp;
          const bf16x8 bh = __builtin_shufflevector(tr_read((const short*)Mh + (kb + tq) * LS + co), tr_read((const short*)Mh + (kb + 4 + tq) * LS + co), 0, 1, 2, 3, 4, 5, 6, 7);
          const bf16x8 bl = __builtin_shufflevector(tr_read((const short*)Ml + (kb + tq) * LS + co), tr_read((const short*)Ml + (kb + 4 + tq) * LS + co), 0, 1, 2, 3, 4, 5, 6, 7);
          acc[q] = __builtin_amdgcn_mfma_f32_16x16x32_bf16(ah, bh, acc[q], 0, 0, 0);
          acc[q] = __builtin_amdgcn_mfma_f32_16x16x32_bf16(ah, bl, acc[q], 0, 0, 0);
          acc[q] = __builtin_amdgcn_mfma_f32_16x16x32_bf16(al, bh, acc[q], 0, 0, 0);
        }
      }
      sacc[0] = acc[0]; sacc[1] = acc[1];
    };
    MN r0, r1, r2, r3;
    ldmn(r0, 0); ldmn(r1, 1); ldmn(r2, 2);
    for (int c = 0; c < NCH; c += 4) {
      ldmn(r3, c + 3); step(c, r0);
      ldmn(r0, c + 4); step(c + 1, r1);
      ldmn(r1, c + 5); step(c + 2, r2);
      ldmn(r2, c + 6); step(c + 3, r3);
    }
    __syncthreads();
  }
}

DI void ph_scan3(const P& p, int layer, char* smem) {
  constexpr int NI = 4;
  const int tid = tidx(), lane = tid & 63, w = tid >> 6;
  const int jl = lane & 31, hi = lane >> 5;
  const int it = w >> 1, vt = w & 1, ws = w & 1;
  float* sm = (float*)smem + it * (SBUF + 2048);
  float* slw = sm + SBUF; float* so = slw + 1024;
  const float* lwp = p.rw_lnx_w + layer * RWW; const float* lbp = p.rw_lnx_b + layer * RWW; const float* rkp = p.rw_r_k + layer * RWW;
  constexpr int TQ = 2 * SC;
  for (int quad = blockIdx.x; quad < NB * NH * (T / TQ); quad += gridDim.x) {
    const int bh = quad / (T / TQ), tb = quad % (T / TQ);
    const int d = it >> 1, kch = 2 * tb + (it & 1), c = d ? (NCH - 1 - kch) : kch;
    const int h = bh % NH, b = bh / NH, scan = bh * 2 + d;
    const float kkc = p.rw_k_k[layer * RWW + h * 64 + lane], kac = p.rw_k_a[layer * RWW + h * 64 + lane];
    u16* Od = p.O2 + (size_t)d * NTOK * RWW;
    f32x16s acc[2];
    {
      const float* Sg = p.SS + ((size_t)scan * NCH + c) * 4096 + (size_t)(32 * vt + jl) * 64;
#pragma unroll
      for (int tk = 0; tk < 2; ++tk)
#pragma unroll
        for (int q = 0; q < 4; ++q) {
          const f32x4 sv = *(const f32x4*)(Sg + 32 * tk + 8 * q + 4 * hi);
#pragma unroll
          for (int e = 0; e < 4; ++e) acc[tk][4 * q + e] = sv[e];
        }
    }
    ScanRegsN<NI> g;
    scan_load_n<NI>(p, b, h, d, c * SC, lane, ws, g);
    for (int sub = 0; sub < SC / 16; ++sub) {
      const int n0 = c * SC + sub * 16;
      __syncthreads();
      scan_put_n<NI>(g, kkc, kac, sm, slw, lane, ws);
      __syncthreads();
      if (sub + 1 < SC / 16) scan_load_n<NI>(p, b, h, d, n0 + 16, lane, ws, g);
      const float* vrow = sm + 4096 + 32 * vt + jl;
      f32x4 kc[8]; scan_ld8(kc, sm, hi);
      float a0 = sm[1024 + hi * 1024 + jl], a1 = sm[1024 + hi * 1024 + 32 + jl], vc = vrow[0];
#pragma unroll 4
      for (int j = 0; j < 16; ++j) {
        const int jn = (j + 1) & 15;
        f32x4 kn[8]; scan_ld8(kn, sm + jn * 64, hi);
        const float an0 = sm[1024 + hi * 1024 + jn * 64 + jl], an1 = sm[1024 + hi * 1024 + jn * 64 + 32 + jl], vn = vrow[jn * 64];
        SBAR();
        const float sa = scan_dot8(acc, kc);
        const float bop = hi ? vc : sa;
        acc[0] = __builtin_amdgcn_mfma_f32_32x32x2f32(a0, bop, acc[0], 0, 0, 0);
        acc[1] = __builtin_amdgcn_mfma_f32_32x32x2f32(a1, bop, acc[1], 0, 0, 0);
        f32x4 rc[8]; scan_ld8(rc, sm + 3072 + j * 64, hi);
        SBAR();
        const float o = scan_dot8(acc, rc);
        if (hi == 0) so[j * 64 + 32 * vt + jl] = o;
        SBAR();
#pragma unroll
        for (int i = 0; i < 8; ++i) kc[i] = kn[i];
        a0 = an0; a1 = an1; vc = vn;
      }
#pragma unroll
      for (int tk = 0; tk < 2; ++tk)
#pragma unroll
        for (int q = 0; q < 4; ++q) {
          const f32x4 pv = *(const f32x4*)(sm + 5120 + 32 * tk + 8 * q + 4 * hi);
#pragma unroll
          for (int e = 0; e < 4; ++e) acc[tk][4 * q + e] *= pv[e];
        }
      __syncthreads();
#pragma unroll
      for (int jj = 0; jj < 8; ++jj) {
        const int j = ws + 2 * jj; const int n = n0 + j; const int t = d ? (T - 1 - n) : n;
        Od[((size_t)(b * T + t)) * RWW + h * 64 + lane] = f2bf(so[j * 64 + lane]);
      }
    }
    asm volatile("s_waitcnt vmcnt(0)" ::: "memory");
    __syncthreads();
    {
      const int ch = h * 64 + lane;
      const float plw = lwp[ch], plb = lbp[ch], prk = rkp[ch];
      for (int i0 = 0; i0 < TQ / 8; i0 += 2) {
        float o[2], k[2], r[2], vv[2], a0[2], a1[2], gg[2];
#pragma unroll
        for (int u = 0; u < 2; ++u) {
          const size_t off = (size_t)(b * T + tb * TQ + w * (TQ / 8) + i0 + u) * RWW + ch;
          o[u] = bf2f(p.O2[off]) + bf2f(p.O2[(size_t)NTOK * RWW + off]);
          k[u] = p.K[off]; r[u] = p.R[off]; vv[u] = p.V[off];
          a0[u] = bf2f(p.AA[off]); a1[u] = bf2f(p.AA[(size_t)NTOK * RWW + off]); gg[u] = bf2f(p.G[off]);
        }
#pragma unroll
        for (int u = 0; u < 2; ++u) {
          const float mean = wave_sum(o[u]) * (1.f / 64);
          const float dv = o[u] - mean;
          const float var = wave_sum(dv * dv) * (1.f / 64);
          const float kb = 0.5f * (k[u] * (1.f + (a0[u] - 1.f) * kac) + k[u] * (1.f + (a1[u] - 1.f) * kac));
          const float sb = wave_sum(r[u] * kb * prk);
          const float on_ = dv * frsq(var + GN_EPS) * plw + plb;
          p.H[(size_t)(b * T + tb * TQ + w * (TQ / 8) + i0 + u) * DM + ch] = f2bf((on_ + sb * vv[u]) * gg[u]);
        }
      }
    }
  }
}
DI void ph_mla_norm(const P& p, int layer) {
  const int tid_ = tidx(); const int lane = tid_ & 63, w = tid_ >> 6;
  const float* on = p.mla_o_norm + layer * 512;
  const f32x4 g0 = *(const f32x4*)(on + lane * 4), g1 = *(const f32x4*)(on + 256 + lane * 4);
  int t0, t1; wg_tokens(t0, t1);
  constexpr int U = 4;
  for (int tb = t0 + w * U; tb < t1; tb += 8 * U) {
    f32x4 v0[U], v1[U];
#pragma unroll
    for (int u = 0; u < U; ++u) {
      const int tok = (tb + u < t1) ? tb + u : t1 - 1;
      const float* ao = p.AO + (size_t)tok * 512;
      v0[u] = *(const f32x4*)(ao + lane * 4); v1[u] = *(const f32x4*)(ao + 256 + lane * 4);
    }
#pragma unroll
    for (int u = 0; u < U; ++u) {
      float ss = v0[u][0] * v0[u][0] + v0[u][1] * v0[u][1] + v0[u][2] * v0[u][2] + v0[u][3] * v0[u][3] + v1[u][0] * v1[u][0] + v1[u][1] * v1[u][1] + v1[u][2] * v1[u][2] + v1[u][3] * v1[u][3];
      ss = wave_sum(ss);
      const float rstd = frsq(ss * (1.f / 512) + NORM_EPS);
      if (tb + u < t1) {
        const f32x4 a = v0[u] * rstd * g0, c = v1[u] * rstd * g1;
        *(u32x2*)(p.H + (size_t)(tb + u) * DM + 512 + lane * 4) = u32x2{pk2(a[0], a[1]), pk2(a[2], a[3])};
        *(u32x2*)(p.H + (size_t)(tb + u) * DM + 768 + lane * 4) = u32x2{pk2(c[0], c[1]), pk2(c[2], c[3])};
      }
    }
  }
}


DI void ph_mixfinish(const P& p, int layer) {
  const int tid_ = tidx(); const int lane = tid_ & 63, w = tid_ >> 6;
  const float* lw = p.rw_lnx_w + layer * RWW; const float* lb = p.rw_lnx_b + layer * RWW;
  const float* kac = p.rw_k_a + layer * RWW; const float* rk = p.rw_r_k + layer * RWW;
  const float* on = p.mla_o_norm + layer * 512;
  float plw[8], plb[8], pka[8], prk[8];
#pragma unroll
  for (int h = 0; h < NH; ++h) { int c = h * 64 + lane; plw[h] = lw[c]; plb[h] = lb[c]; pka[h] = kac[c]; prk[h] = rk[c]; }
  const f32x4 g0 = *(const f32x4*)(on + lane * 4), g1 = *(const f32x4*)(on + 256 + lane * 4);
  for (int tok = blockIdx.x * 8 + w; tok < NTOK; tok += gridDim.x * 8) {
    float o[8], k[8], r[8], vv[8], a0[8], a1[8], gg[8];
#pragma unroll
    for (int h = 0; h < NH; ++h) {
      size_t off = (size_t)tok * RWW + h * 64 + lane;
      o[h] = bf2f(p.O2[off]) + bf2f(p.O2[(size_t)NTOK * RWW + off]);
      k[h] = p.K[off]; r[h] = p.R[off]; vv[h] = p.V[off];
      a0[h] = bf2f(p.AA[off]); a1[h] = bf2f(p.AA[(size_t)NTOK * RWW + off]); gg[h] = bf2f(p.G[off]);
    }
    const float* ao = p.AO + (size_t)tok * 512;
    const f32x4 v0 = *(const f32x4*)(ao + lane * 4), v1 = *(const f32x4*)(ao + 256 + lane * 4);
    float mean[8], var[8], sb[8];
#pragma unroll
    for (int h = 0; h < NH; ++h) mean[h] = wave_sum(o[h]) * (1.f / 64);
#pragma unroll
    for (int h = 0; h < NH; ++h) { float dv = o[h] - mean[h]; o[h] = dv; var[h] = wave_sum(dv * dv) * (1.f / 64); }
#pragma unroll
    for (int h = 0; h < NH; ++h) {
      float kb = 0.5f * (k[h] * (1.f + (a0[h] - 1.f) * pka[h]) + k[h] * (1.f + (a1[h] - 1.f) * pka[h]));
      sb[h] = wave_sum(r[h] * kb * prk[h]);
    }
#pragma unroll
    for (int h = 0; h < NH; ++h) {
      float on_ = o[h] * frsq(var[h] + GN_EPS) * plw[h] + plb[h];
      float y = (on_ + sb[h] * vv[h]) * gg[h];
      p.H[(size_t)tok * DM + h * 64 + lane] = f2bf(y);
    }
    float ss = v0[0] * v0[0] + v0[1] * v0[1] + v0[2] * v0[2] + v0[3] * v0[3] + v1[0] * v1[0] + v1[1] * v1[1] + v1[2] * v1[2] + v1[3] * v1[3];
    ss = wave_sum(ss);
    float rstd = frsq(ss * (1.f / 512) + NORM_EPS);
    *(u32x2*)(p.H + (size_t)tok * DM + 512 + lane * 4) = u32x2{pk2(v0[0] * rstd * g0[0], v0[1] * rstd * g0[1]), pk2(v0[2] * rstd * g0[2], v0[3] * rstd * g0[3])};
    *(u32x2*)(p.H + (size_t)tok * DM + 768 + lane * 4) = u32x2{pk2(v1[0] * rstd * g1[0], v1[1] * rstd * g1[1]), pk2(v1[2] * rstd * g1[2], v1[3] * rstd * g1[3])};
  }
}

DI void ph_norm_router(const P& p, int layer, char* smem) {
  const int tid_ = tidx(); const int lane = tid_ & 63, w = tid_ >> 6;
  float* rtl = (float*)smem;
  float* hl = (float*)(smem + 65536) + w * 1024;
  const float* g = p.ffn_norm + layer * DM;
  const float* rt = p.router + (size_t)layer * DM * NE;
  __syncthreads();
#pragma unroll
  for (int i = 0; i < 8; ++i) *(f32x4*)(rtl + (tid_ + i * NTH) * 4) = *(const f32x4*)(rt + (tid_ + i * NTH) * 4);
  __syncthreads();
  const int cg = lane >> 2, eq = lane & 3;
  for (int tok = blockIdx.x * 8 + w; tok < NTOK; tok += gridDim.x * 8) {
    const f32x4* xr = (const f32x4*)(p.out + (size_t)tok * DM);
    f32x4 v[4]; float ss = 0.f;
#pragma unroll
    for (int j = 0; j < 4; ++j) { v[j] = xr[lane + 64 * j]; ss += v[j][0] * v[j][0] + v[j][1] * v[j][1] + v[j][2] * v[j][2] + v[j][3] * v[j][3]; }
    ss = wave_sum(ss);
    const float rstd = frsq(ss * (1.f / DM) + NORM_EPS);
#pragma unroll
    for (int j = 0; j < 4; ++j) {
      const int c0 = (lane + 64 * j) * 4;
      const f32x4 gg = *(const f32x4*)(g + c0);
      const f32x4 hv = v[j] * rstd * gg;
      *(u32x2*)(p.H + (size_t)tok * DM + c0) = u32x2{pk2(hv[0], hv[1]), pk2(hv[2], hv[3])};
      *(f32x4*)(hl + c0) = hv;
    }
    f32x4 acc = f32x4{0.f, 0.f, 0.f, 0.f};
#pragma unroll 16
    for (int i = 0; i < 64; ++i) {
      const float hv = hl[cg + 16 * i];
      const f32x4 r4 = *(const f32x4*)(rtl + (cg + 16 * i) * 16 + eq * 4);
      acc += hv * r4;
    }
#pragma unroll
    for (int e = 0; e < 4; ++e) {
      float a = acc[e];
      a += dpp_f<0x124>(a); a += dpp_f<0x128>(a);
      a = red_x32(red_x16(a));
      acc[e] = a;
    }
    float mx = fmaxf(fmaxf(acc[0], acc[1]), fmaxf(acc[2], acc[3]));
    mx = fmaxf(mx, dpp_f<0xB1>(mx)); mx = fmaxf(mx, dpp_f<0x4E>(mx));
    f32x4 ex; float se = 0.f;
#pragma unroll
    for (int e = 0; e < 4; ++e) { ex[e] = fexp(acc[e] - mx); se += ex[e]; }
    se = red_x2(red_x1(se));
    const float inv = frcp(se);
    const int b = tok / T, t = tok % T;
    if (lane < 4) {
#pragma unroll
      for (int e = 0; e < 4; ++e) p.AFF[((size_t)(b * NE + eq * 4 + e)) * T + t] = ex[e] * inv;
    }
  }
}

DI void ph_topk(const P& p, char* smem) {
  unsigned* hist = (unsigned*)smem;
  unsigned* sc = hist + 256;
  unsigned* bc = sc + 2048;
  const int tid = tidx();
  for (int item = blockIdx.x; item < NB * NE; item += gridDim.x) {
    const float* a = p.AFF + (size_t)item * T;
    unsigned key[16];
#pragma unroll
    for (int i = 0; i < 4; ++i) {
      uint4 v = *(const uint4*)(a + tid * 16 + i * 4);
      key[i * 4 + 0] = v.x; key[i * 4 + 1] = v.y; key[i * 4 + 2] = v.z; key[i * 4 + 3] = v.w;
    }
    unsigned prefix = 0, mask = 0, need = CAP;
    for (int pass = 0; pass < 4; ++pass) {
      int shift = 24 - 8 * pass;
      __syncthreads();
      if (tid < 256) hist[tid] = 0;
      __syncthreads();
#pragma unroll
      for (int i = 0; i < 16; ++i)
        if ((key[i] & mask) == prefix) atomicAdd(&hist[(key[i] >> shift) & 255u], 1u);
      __syncthreads();
      if (tid == 0) {
        unsigned cum = 0; int bsel = 0; unsigned nd = need;
        for (int bb = 255; bb >= 0; --bb) {
          unsigned hc = hist[bb];
          if (cum + hc >= need) { bsel = bb; nd = need - cum; break; }
          cum += hc;
        }
        bc[0] = prefix | ((unsigned)bsel << shift); bc[1] = nd;
      }
      __syncthreads();
      prefix = bc[0]; need = bc[1]; mask |= (255u << shift);
    }
    unsigned ngt = 0, neq = 0;
#pragma unroll
    for (int i = 0; i < 16; ++i) { ngt += key[i] > prefix; neq += key[i] == prefix; }
    __syncthreads();
    unsigned* sA = sc; unsigned* sB = sc + 512; unsigned* eA = sc + 1024; unsigned* eB = sc + 1536;
    sA[tid] = ngt; eA[tid] = neq;
    __syncthreads();
    for (int off = 1; off < NTH; off <<= 1) {
      unsigned x = sA[tid] + ((tid >= off) ? sA[tid - off] : 0u);
      unsigned y = eA[tid] + ((tid >= off) ? eA[tid - off] : 0u);
      sB[tid] = x; eB[tid] = y;
      __syncthreads();
      unsigned* tmp = sA; sA = sB; sB = tmp; tmp = eA; eA = eB; eB = tmp;
    }
    unsigned gt_excl = sA[tid] - ngt, eq_excl = eA[tid] - neq;
    unsigned gt_total = sA[NTH - 1];
    int* idx = p.IDX + (size_t)item * CAP; float* gate = p.GATE + (size_t)item * CAP;
#pragma unroll
    for (int i = 0; i < 16; ++i) {
      int slot = -1;
      if (key[i] > prefix) { slot = (int)gt_excl; ++gt_excl; }
      else if (key[i] == prefix) { if (eq_excl < need) slot = (int)(gt_total + eq_excl); ++eq_excl; }
      if (slot >= 0) {
        const int tokl = tid * 16 + i;
        idx[slot] = tokl; gate[slot] = __uint_as_float(key[i]);
        const int tokg = (item / NE) * T + tokl;
        const int pos = atomicAdd(&p.TCNT[tokg], 1);
        p.TLIST[(size_t)tokg * 16 + pos] = item * CAP + slot;
      }
    }
    __syncthreads();
  }
}

DI void ph_exp1(const P& p, int layer, char* smem) {
  for (int t = blockIdx.x; t < 32 * 4 * 16; t += gridDim.x) {
    int grp = t / 64, r = t % 64, tm = r / 16, tn = r % 16;
    int b = grp / NE, e = grp % NE;
    const int* gi = p.IDX + (size_t)grp * CAP + tm * GBM;
    const u16* Hb = p.H + (size_t)b * T * DM;
    const float* Wg = p.exp_w_gate + ((size_t)layer * NE + e) * DM * 1024;
    const float* Wu = p.exp_w_up + ((size_t)layer * NE + e) * DM * 1024;
    u16* hid = p.HID + ((size_t)grp * CAP + tm * GBM) * 1024;
    auto arow = [&](int row) -> const void* { return Hb + (size_t)gi[row] * DM; };
    gemm_tile<false, 1>(arow, Wg, Wu, 1024, DM, tn * 64, 1024, smem, [&](int row, int col, float g, float u) {
      float sv = g * frcp(1.f + fexp(-g));
      hid[(size_t)row * 1024 + col] = f2bf(sv * u);
    });
    __syncthreads();
  }
}
DI void ph_exp2(const P& p, int layer, char* smem) {
  for (int t = blockIdx.x; t < 32 * 4 * 8; t += gridDim.x) {
    int grp = t / 32, r = t % 32, tm = r / 8, tn = r % 8;
    int b = grp / NE, e = grp % NE;
    const int* gi = p.IDX + (size_t)grp * CAP + tm * GBM;
    const float* gt = p.GATE + (size_t)grp * CAP + tm * GBM;
    const u16* hid = p.HID + ((size_t)grp * CAP + tm * GBM) * 1024;
    const float* Wd = p.exp_w_down + ((size_t)layer * NE + e) * 1024 * DM;
    float* xb = p.out + (size_t)b * T * DM;
    auto arow = [&](int row) -> const void* { return hid + (size_t)row * 1024; };
    gemm_tile<false, 0>(arow, Wd, nullptr, DM, 1024, tn * GBN, DM, smem, [&](int row, int col, float v, float) {
      unsafeAtomicAdd(xb + (size_t)gi[row] * DM + col, v * gt[row]);
    });
    __syncthreads();
  }
}

namespace g8 {
constexpr int BM = 256, BK = 64, HALF = 128, HTB = HALF * BK * 2, STAGE_BYTES = 8 * HTB, NXCD = 8, WGM = 8;
DI int lds_byte(int r, int c) { const int st = (r >> 4) * 2 + (c >> 5), rr = r & 15, cc = c & 31, ob = rr * 64 + cc * 2; return st * 1024 + (ob ^ (((ob >> 9) & 1) << 5)); }
DI void stage_rc(int b, int& R, int& C) { const int st = b / 1024, sb = b % 1024, swz = sb ^ (((sb >> 9) & 1) << 5); R = (st >> 1) * 16 + swz / 64; C = (st & 1) * 32 + (swz % 64) / 2; }
DI int perm32(int rho) { const int n = rho >> 4, i = rho & 15; return 8 * (i >> 2) + 4 * n + (i & 3); }
struct Unit { int pm, pn; };
struct Sched {
  int nM, nN, nwg, G, c;
  const char* A; const char* Bt; size_t a_tstep, b_tstep; int gdiv, gmod; size_t gstride;
  DI void init(int nM_, int nN_, int G_, int c_, const void* A_, const void* Bt_, int K) {
    nM = nM_; nN = nN_; nwg = nM * nN; G = G_; c = c_; A = (const char*)uni_ptr(A_); Bt = (const char*)uni_ptr(Bt_);
    a_tstep = (size_t)BM * K * 2; b_tstep = (size_t)BM * K * 2; gdiv = 1 << 30; gmod = 1; gstride = 0;
  }
  DI void group(int gdiv_, int gmod_, size_t gstride_) { gdiv = gdiv_; gmod = gmod_; gstride = gstride_; }
  DI bool next(int i, Unit& u) const {
    const long L = (long)i * G + c; if (L >= nwg) return false;
    int wgid = (int)L; { const int q = nwg / NXCD, r = nwg % NXCD, xcd = wgid % NXCD, off = wgid / NXCD; wgid = (xcd < r ? xcd * (q + 1) : r * (q + 1) + (xcd - r) * q) + off; }
    const int nig = WGM * nN, gid = wgid / nig, fm = gid * WGM, gsz = (nM - fm) < WGM ? (nM - fm) : WGM;
    u.pm = fm + ((wgid % nig) % gsz); u.pn = (wgid % nig) / gsz; return true;
  }
  DI const char* a_ptr(const Unit& u) const { return A + (size_t)u.pm * a_tstep; }
  DI const char* b_ptr(const Unit& u) const { return Bt + (size_t)((u.pm / gdiv) % gmod) * gstride + (size_t)u.pn * b_tstep; }
};
using Acc = f32x4[2][2][4][2];

template <class Epi, bool GATHER = false>
DI void gemm_phase(LAS unsigned char* lds, const int K, const Sched& S, const Epi& E, const int* gidx = nullptr, LAS unsigned* gtab = nullptr) {
  const int tid = tidx(), wid = __builtin_amdgcn_readfirstlane(tid >> 6), lane = tid & 63, wr = wid >> 2, wc = wid & 3, fr = lane & 15, fq = lane >> 4;
  const int nt = K / BK;
  unsigned voffA[2], voffB[2];
#pragma unroll
  for (int i = 0; i < 2; ++i) { int R, C; stage_rc(tid * 16 + i * 8192, R, C); const int Rb = Epi::PERM ? ((R & ~31) + perm32(R & 31)) : R;
    voffA[i] = GATHER ? (unsigned)(R | (C << 16)) : (unsigned)(R * K + C) * 2u; voffB[i] = (unsigned)(Rb * K + C) * 2u; }
  unsigned gc[2][2], gn[2][2];
  auto gget = [&](int ui_, unsigned (&g)[2][2]) {
    if constexpr (GATHER) {
      Unit u_; const bool ok = S.next(ui_, u_);
#pragma unroll
      for (int h = 0; h < 2; ++h)
#pragma unroll
        for (int i = 0; i < 2; ++i) {
          const int r = h * HALF + (int)(voffA[i] & 0xffffu); const unsigned cb = (voffA[i] >> 16) * 2u;
          if (ui_ < 16) g[h][i] = gtab[ui_ * 256 + r] + cb;
          else { const int row = (ok ? u_.pm : 0) * BM + r; g[h][i] = (unsigned)((row / (NE * CAP)) * T + gidx[row]) * (unsigned)K * 2u + cb; }
        }
      asm volatile("" : "+v"(g[0][0]), "+v"(g[0][1]), "+v"(g[1][0]), "+v"(g[1][1]));
    }
  };
  if constexpr (GATHER) {
    for (int i0 = 0; i0 < 16; i0 += 2) {
      Unit u_; const int i = i0 + (tid >> 8);
      if (S.next(i, u_)) { const int row = u_.pm * BM + (tid & 255); gtab[i * 256 + (tid & 255)] = (unsigned)((row / (NE * CAP)) * T + gidx[row]) * (unsigned)K * 2u; }
      if (!S.next(i0 + 2, u_)) break;
    }
    __syncthreads();
  }
  const size_t kstep = (size_t)(BK * 2);
  const size_t hstep = (size_t)HALF * K * 2;
  const unsigned ldsw = (unsigned)wid * 1024u;
  const int aoff = lds_byte(wr * 64 + fr, fq * 8), boff = lds_byte(wc * 32 + fr, fq * 8);
#define G8_SA(b, h) (((b) * 2 + (h)) * HTB)
#define G8_SB(b, h) ((4 + (b) * 2 + (h)) * HTB)
#define G8_STAGE(bufoff, gbase, voff) do { _Pragma("unroll") for (int _i = 0; _i < 2; ++_i) \
    __builtin_amdgcn_global_load_lds((const unsigned*)((const char*)(gbase) + (voff)[_i]), (LAS unsigned*)(lds + (bufoff) + ldsw + _i * 8192), 16, 0, 0); } while (0)
#define G8_STAGE_A(bufoff, base, h, kb, Gv) do { if constexpr (GATHER) { G8_STAGE(bufoff, S.A + (kb), Gv[h]); } else { G8_STAGE(bufoff, (base) + (h) * hstep + (kb), voffA); } } while (0)
#define G8_LDA(dst, b, h) do { _Pragma("unroll") for (int m = 0; m < 4; ++m) _Pragma("unroll") for (int k = 0; k < 2; ++k) dst[m][k] = *(const LAS bf16x8*)(lds + G8_SA(b, h) + aoff + m * 2048 + k * 1024); } while (0)
#define G8_LDB(dst, b, h) do { _Pragma("unroll") for (int n = 0; n < 2; ++n) _Pragma("unroll") for (int k = 0; k < 2; ++k) dst[n][k] = *(const LAS bf16x8*)(lds + G8_SB(b, h) + boff + n * 2048 + k * 1024); } while (0)
#define G8_MMA(ai, bj, At, Bt) do { __builtin_amdgcn_s_setprio(1); _Pragma("unroll") for (int m = 0; m < 4; ++m) _Pragma("unroll") for (int n = 0; n < 2; ++n) _Pragma("unroll") for (int k = 0; k < 2; ++k) \
    acc[ai][bj][m][n] = __builtin_amdgcn_mfma_f32_16x16x32_bf16(Bt[n][k], At[m][k], acc[ai][bj][m][n], 0, 0, 0); __builtin_amdgcn_s_setprio(0); } while (0)
#define G8_WAIT_V(n) asm volatile("s_waitcnt vmcnt(" #n ")" ::: "memory")
#define G8_WAIT_L(n) asm volatile("s_waitcnt lgkmcnt(" #n ")" ::: "memory")
#define G8_BAR __builtin_amdgcn_s_barrier()
#define G8_SCHED __builtin_amdgcn_sched_barrier(0)
  Unit cur, nxt; int ui = 0;
  if (!S.next(0, cur)) return;
  f32x4 acc[2][2][4][2];
#pragma unroll
  for (int a = 0; a < 2; ++a)
#pragma unroll
    for (int b = 0; b < 2; ++b)
#pragma unroll
      for (int m = 0; m < 4; ++m)
#pragma unroll
        for (int n = 0; n < 2; ++n) acc[a][b][m][n] = (f32x4){0.f, 0.f, 0.f, 0.f};
  bf16x8 At[4][2], B0[2][2], B1[2][2];
  const char* cA = S.a_ptr(cur); const char* cB = S.b_ptr(cur);
  gget(0, gc);
  G8_STAGE(G8_SB(0, 0), cB, voffB); G8_STAGE_A(G8_SA(0, 0), cA, 0, 0, gc); G8_STAGE(G8_SB(0, 1), cB + hstep, voffB); G8_STAGE_A(G8_SA(0, 1), cA, 1, 0, gc);
  if (wr == 1) G8_BAR;
  G8_WAIT_V(4); G8_BAR;
  G8_STAGE(G8_SB(1, 0), cB + kstep, voffB); G8_STAGE_A(G8_SA(1, 0), cA, 0, kstep, gc); G8_STAGE(G8_SB(1, 1), cB + hstep + kstep, voffB);
  G8_WAIT_V(6); G8_BAR;
  for (;;) {
    const bool has_next = S.next(ui + 1, nxt);
    const char* nA = has_next ? S.a_ptr(nxt) : cA; const char* nB = has_next ? S.b_ptr(nxt) : cB;
    gget(has_next ? ui + 1 : ui, gn);
    for (int t = 0; t < nt; t += 2) {
      const bool last = (t == nt - 2);
      const size_t k1 = (size_t)(t + 1) * kstep, k2 = last ? (size_t)0 : (size_t)(t + 2) * kstep, k3 = k2 + kstep;
      const char* u2 = last ? nA : cA; const char* b2 = (last ? nB : cB) + k2;
      const char* b3 = b2 + kstep;
      unsigned g2[2][2];
      if constexpr (GATHER) {
#pragma unroll
        for (int h = 0; h < 2; ++h)
#pragma unroll
          for (int i = 0; i < 2; ++i) g2[h][i] = last ? gn[h][i] : gc[h][i];
      }
      G8_LDB(B0, 0, 0); G8_SCHED; G8_LDA(At, 0, 0); G8_STAGE_A(G8_SA(1, 1), cA, 1, k1, gc);
      G8_WAIT_L(8); G8_BAR; G8_WAIT_L(0); G8_MMA(0, 0, At, B0); G8_BAR; G8_SCHED;
      G8_LDB(B1, 0, 1); G8_STAGE(G8_SB(0, 0), b2, voffB);
      G8_BAR; G8_WAIT_L(0); G8_MMA(0, 1, At, B1); G8_BAR;
      G8_LDA(At, 0, 1); G8_STAGE_A(G8_SA(0, 0), u2, 0, k2, g2);
      G8_BAR; G8_WAIT_L(0); G8_MMA(1, 0, At, B0); G8_BAR; G8_SCHED;
      G8_STAGE(G8_SB(0, 1), b2 + hstep, voffB);
      G8_WAIT_V(6); G8_BAR; G8_MMA(1, 1, At, B1); G8_BAR;
      G8_LDB(B0, 1, 0); G8_SCHED; G8_LDA(At, 1, 0); G8_STAGE_A(G8_SA(0, 1), u2, 1, k2, g2);
      G8_WAIT_L(8); G8_BAR; G8_WAIT_L(0); G8_MMA(0, 0, At, B0); G8_BAR; G8_SCHED;
      G8_LDB(B1, 1, 1); G8_STAGE(G8_SB(1, 0), b3, voffB);
      G8_BAR; G8_WAIT_L(0); G8_MMA(0, 1, At, B1); G8_BAR;
      G8_LDA(At, 1, 1); G8_STAGE_A(G8_SA(1, 0), u2, 0, k3, g2);
      G8_BAR; G8_WAIT_L(0); G8_MMA(1, 0, At, B0); G8_BAR; G8_SCHED;
      G8_STAGE(G8_SB(1, 1), b3 + hstep, voffB);
      G8_WAIT_V(6); G8_BAR; G8_MMA(1, 1, At, B1); G8_BAR;
    }
    {
      const int t2 = tidx(); const int w2 = __builtin_amdgcn_readfirstlane(t2 >> 6), l2 = t2 & 63;
      E(acc, cur, w2 >> 2, w2 & 3, l2 & 15, l2 >> 4);
    }
    if (!has_next) break;
#pragma unroll
    for (int a = 0; a < 2; ++a)
#pragma unroll
      for (int b = 0; b < 2; ++b)
#pragma unroll
        for (int m = 0; m < 4; ++m)
#pragma unroll
          for (int n = 0; n < 2; ++n) acc[a][b][m][n] = (f32x4){0.f, 0.f, 0.f, 0.f};
    cur = nxt; cA = nA; cB = nB; ++ui;
    if constexpr (GATHER) {
#pragma unroll
      for (int h = 0; h < 2; ++h)
#pragma unroll
        for (int i = 0; i < 2; ++i) gc[h][i] = gn[h][i];
    }
  }
  G8_WAIT_V(0);
  if (wr == 0) G8_BAR;
  G8_BAR;
#undef G8_SA
#undef G8_SB
#undef G8_STAGE
#undef G8_STAGE_A
#undef G8_LDA
#undef G8_LDB
#undef G8_MMA
#undef G8_WAIT_V
#undef G8_WAIT_L
#undef G8_BAR
#undef G8_SCHED
}

struct EpiZ {
  static constexpr bool PERM = false; float* Z;
  DI void operator()(const Acc& acc, const Unit& u, int wr, int wc, int fr, int fq) const {
    const int row0 = u.pm * BM + wr * 64 + fr, col0 = u.pn * BM + wc * 32 + 4 * fq;
#pragma unroll
    for (int ai = 0; ai < 2; ++ai)
#pragma unroll
      for (int m = 0; m < 4; ++m) { float* rowp = Z + (size_t)(row0 + ai * HALF + m * 16) * INC;
#pragma unroll
        for (int bj = 0; bj < 2; ++bj)
#pragma unroll
          for (int n = 0; n < 2; ++n) { const int col = col0 + bj * HALF + n * 16; if (col < INC) *(f32x4*)(rowp + col) = acc[ai][bj][m][n]; } }
  }
};
struct EpiRes {
  static constexpr bool PERM = false; const float* xs; float* xo;
  DI void operator()(const Acc& acc, const Unit& u, int wr, int wc, int fr, int fq) const {
    const int row0 = u.pm * BM + wr * 64 + fr, col0 = u.pn * BM + wc * 32 + 4 * fq;
#pragma unroll
    for (int ai = 0; ai < 2; ++ai)
#pragma unroll
      for (int m = 0; m < 4; ++m) { const size_t ro = (size_t)(row0 + ai * HALF + m * 16) * DM + col0;
#pragma unroll
        for (int bj = 0; bj < 2; ++bj)
#pragma unroll
          for (int n = 0; n < 2; ++n) { const size_t o = ro + bj * HALF + n * 16; *(f32x4*)(xo + o) = *(const f32x4*)(xs + o) + acc[ai][bj][m][n]; } }
  }
};
struct EpiSig {
  static constexpr bool PERM = true; u16* PG;
  DI void operator()(const Acc& acc, const Unit& u, int wr, int wc, int fr, int fq) const {
    const int row0 = u.pm * BM + wr * 64 + fr, col0 = u.pn * BM + wc * 32 + 8 * fq;
#pragma unroll
    for (int ai = 0; ai < 2; ++ai)
#pragma unroll
      for (int m = 0; m < 4; ++m) { u16* rowp = PG + (size_t)(row0 + ai * HALF + m * 16) * DM + col0;
#pragma unroll
        for (int bj = 0; bj < 2; ++bj) { const f32x4 v0 = acc[ai][bj][m][0], v1 = acc[ai][bj][m][1];
          u32x4 wv = {pk2(sigmoidf_(v0[0]), sigmoidf_(v0[1])), pk2(sigmoidf_(v0[2]), sigmoidf_(v0[3])), pk2(sigmoidf_(v1[0]), sigmoidf_(v1[1])), pk2(sigmoidf_(v1[2]), sigmoidf_(v1[3]))};
          *(u32x4*)(rowp + bj * HALF) = wv; } }
  }
};
struct EpiPle {
  static constexpr bool PERM = false; float* xo; const u16* PG;
  DI void operator()(const Acc& acc, const Unit& u, int wr, int wc, int fr, int fq) const {
    const int row0 = u.pm * BM + wr * 64 + fr, col0 = u.pn * BM + wc * 32 + 4 * fq;
#pragma unroll
    for (int ai = 0; ai < 2; ++ai)
#pragma unroll
      for (int m = 0; m < 4; ++m) { const size_t ro = (size_t)(row0 + ai * HALF + m * 16) * DM + col0;
#pragma unroll
        for (int bj = 0; bj < 2; ++bj)
#pragma unroll
          for (int n = 0; n < 2; ++n) { const size_t o = ro + bj * HALF + n * 16; const u32x2 g = *(const u32x2*)(PG + o);
            f32x4 gv = {__uint_as_float(g[0] << 16), __uint_as_float(g[0] & 0xffff0000u), __uint_as_float(g[1] << 16), __uint_as_float(g[1] & 0xffff0000u)};
            *(f32x4*)(xo + o) = *(const f32x4*)(xo + o) + acc[ai][bj][m][n] * gv; } }
  }
};
struct EpiSwi {
  static constexpr bool PERM = true; u16* HID;
  DI void operator()(const Acc& acc, const Unit& u, int wr, int wc, int fr, int fq) const {
    const int row0 = u.pm * BM + wr * 64 + fr, col0 = u.pn * HALF + wc * 32 + 8 * fq;
#pragma unroll
    for (int ai = 0; ai < 2; ++ai)
#pragma unroll
      for (int m = 0; m < 4; ++m) { u16* rowp = HID + (size_t)(row0 + ai * HALF + m * 16) * 1024 + col0;
        float h[8];
#pragma unroll
        for (int n = 0; n < 2; ++n)
#pragma unroll
          for (int j = 0; j < 4; ++j) { const float gt = acc[ai][0][m][n][j], up = acc[ai][1][m][n][j]; h[n * 4 + j] = gt * frcp(1.f + fexp(-gt)) * up; }
        *(u32x4*)rowp = u32x4{pk2(h[0], h[1]), pk2(h[2], h[3]), pk2(h[4], h[5]), pk2(h[6], h[7])}; }
  }
};
struct EpiYE {
  static constexpr bool PERM = true; u16* YE; const float* GATE;
  DI void operator()(const Acc& acc, const Unit& u, int wr, int wc, int fr, int fq) const {
    const int row0 = u.pm * BM + wr * 64 + fr, col0 = u.pn * BM + wc * 32 + 8 * fq;
#pragma unroll
    for (int ai = 0; ai < 2; ++ai)
#pragma unroll
      for (int m = 0; m < 4; ++m) { const int row = row0 + ai * HALF + m * 16; const float gt = GATE[row]; u16* rowp = YE + (size_t)row * 1024 + col0;
#pragma unroll
        for (int bj = 0; bj < 2; ++bj) { const f32x4 v0 = acc[ai][bj][m][0] * gt, v1 = acc[ai][bj][m][1] * gt;
          *(u32x4*)(rowp + bj * HALF) = u32x4{pk2(v0[0], v0[1]), pk2(v0[2], v0[3]), pk2(v1[0], v1[1]), pk2(v1[2], v1[3])}; } }
  }
};
}

DI void cvt_tile_T(const float* __restrict__ src, int ldsrc, int N, int K, u16* __restrict__ dst, int k0, int n0, int drow0, char* smem, int tid) {
  short* tl = (short*)smem;
  __syncthreads();
#pragma unroll
  for (int i = 0; i < 2; ++i) {
    int u = tid + i * NTH; int kr = u >> 4, nq = u & 15; int n = n0 + nq * 4;
    f32x4 v = f32x4{0.f, 0.f, 0.f, 0.f};
    if (n < N) v = *(const f32x4*)(src + (size_t)(k0 + kr) * ldsrc + n);
#pragma unroll
    for (int e = 0; e < 4; ++e) tl[(nq * 4 + e) * 72 + kr] = (short)f2bf(v[e]);
  }
  __syncthreads();
  { int n = tid >> 3, kc = tid & 7;
    *(u32x4*)(dst + (size_t)(drow0 + n) * K + k0 + kc * 8) = *(const u32x4*)(tl + n * 72 + kc * 8); }
}
constexpr int WIN_PAD = 2560;
DI void ph_cvt_small(const P& p, int layer, char* smem) {
  const int tid = tidx();
  const int t0 = 16 * 40, t1 = t0 + 256, t2 = t1 + 256, t3 = t2 + 64;
  for (int t = blockIdx.x; t < t3; t += gridDim.x) {
    if (t < t0) cvt_tile_T(p.w_in + (size_t)layer * DM * INC, INC, INC, DM, p.WIN, (t / 40) * 64, (t % 40) * 64, (t % 40) * 64, smem, tid);
    else if (t < t1) { int q = t - t0; cvt_tile_T(p.w_out + (size_t)layer * DM * DM, DM, DM, DM, p.WOUT, (q / 16) * 64, (q % 16) * 64, (q % 16) * 64, smem, tid); }
    else if (t < t2) { int q = t - t1; cvt_tile_T(p.ple_gate + (size_t)layer * DM * DM, DM, DM, DM, p.WPG, (q / 16) * 64, (q % 16) * 64, (q % 16) * 64, smem, tid); }
    else { int q = t - t2; cvt_tile_T(p.ple_proj + (size_t)layer * DPLE * DM, DM, DM, DPLE, p.WPP, (q / 16) * 64, (q % 16) * 64, (q % 16) * 64, smem, tid); }
  }
  const float* ps = p.p + (size_t)layer * NTOK * DPLE;
  for (int i = blockIdx.x * NTH + tid; i < NTOK * DPLE / 8; i += gridDim.x * NTH) {
    f32x4 a = *(const f32x4*)(ps + (size_t)i * 8), b = *(const f32x4*)(ps + (size_t)i * 8 + 4);
    *(u32x4*)(p.PB + (size_t)i * 8) = u32x4{pk2(a[0], a[1]), pk2(a[2], a[3]), pk2(b[0], b[1]), pk2(b[2], b[3])};
  }
}

struct CvtJob { const float* src; u16* dst; int k0, n0, drow0; };
DI bool cvt_job(const P& p, int layer, int t, CvtJob& j) {
  if (t >= NE * 3 * 128) return false;
  const int e = t / 384, r = t % 384, mat = r / 128, q = r % 128;
  j.k0 = (q / 8) * 64; j.n0 = (q % 8) * 128;
  const size_t eo = ((size_t)layer * NE + e) * 1024 * 1024;
  if (mat == 0) { j.src = p.exp_w_gate + eo; j.dst = p.EW1 + (size_t)e * 2048 * 1024; j.drow0 = (j.n0 >> 7) * 256; }
  else if (mat == 1) { j.src = p.exp_w_up + eo; j.dst = p.EW1 + (size_t)e * 2048 * 1024; j.drow0 = (j.n0 >> 7) * 256 + 128; }
  else { j.src = p.exp_w_down + eo; j.dst = p.EW2 + (size_t)e * 1024 * 1024; j.drow0 = j.n0; }
  return true;
}
DI void ph_cvt_experts(const P& p, int layer, char* smem, unsigned* ctr) {
  const int tid = tidx();
  short* tl = (short*)smem;
  int* sitem = (int*)(smem + 32768);
  __syncthreads();
  if (tid == 0) sitem[0] = (int)atomicAdd(ctr, 1u);
  __syncthreads();
  CvtJob cur; bool has = cvt_job(p, layer, sitem[0], cur);
  f32x4 v[4];
  const int kr = tid >> 5, nq = tid & 31;
  if (has) {
#pragma unroll
    for (int i = 0; i < 4; ++i) v[i] = *(const f32x4*)(cur.src + (size_t)(cur.k0 + kr + 16 * i) * 1024 + cur.n0 + nq * 4);
  }
  int par = 0;
  while (has) {
    if (tid == 0) sitem[1 + par] = (int)atomicAdd(ctr, 1u);
    __syncthreads();
#pragma unroll
    for (int i = 0; i < 4; ++i)
#pragma unroll
      for (int e = 0; e < 4; ++e) tl[(nq * 4 + e) * 72 + kr + 16 * i] = (short)f2bf(v[i][e]);
    __syncthreads();
    CvtJob nxt; const bool hn = cvt_job(p, layer, sitem[1 + par], nxt);
    if (hn) {
#pragma unroll
      for (int i = 0; i < 4; ++i) v[i] = *(const f32x4*)(nxt.src + (size_t)(nxt.k0 + kr + 16 * i) * 1024 + nxt.n0 + nq * 4);
    }
#pragma unroll
    for (int i = 0; i < 2; ++i) {
      int u = tid + i * NTH; int n = u >> 3, kc = u & 7;
      *(u32x4*)(cur.dst + (size_t)(cur.drow0 + n) * 1024 + cur.k0 + kc * 8) = *(const u32x4*)(tl + n * 72 + kc * 8);
    }
    cur = nxt; has = hn; par ^= 1;
  }
}
DI void ph_gather(const P& p) {
  const int tid_ = tidx(); const int lane = tid_ & 63, w = tid_ >> 6;
  for (int row = blockIdx.x * 8 + w; row < NB * NE * CAP; row += gridDim.x * 8) {
    const int b = row / (NE * CAP);
    const int tok = b * T + p.IDX[row];
    const u32x4* src = (const u32x4*)(p.H + (size_t)tok * DM);
    u32x4* dst = (u32x4*)(p.XE + (size_t)row * DM);
    u32x4 a = src[lane], c = src[lane + 64];
    dst[lane] = a; dst[lane + 64] = c;
  }
}
DI void acc_bf16x16(f32x4 (&v)[4], const u32x4& a, const u32x4& c) {
#pragma unroll
  for (int e = 0; e < 4; ++e) {
    v[e >> 1][(e & 1) * 2] += __uint_as_float(a[e] << 16); v[e >> 1][(e & 1) * 2 + 1] += __uint_as_float(a[e] & 0xffff0000u);
    v[2 + (e >> 1)][(e & 1) * 2] += __uint_as_float(c[e] << 16); v[2 + (e >> 1)][(e & 1) * 2 + 1] += __uint_as_float(c[e] & 0xffff0000u);
  }
}
DI void ph_combine_norm(const P& p, int layer) {
  const int tid_ = tidx(); const int lane = tid_ & 63, w = tid_ >> 6;
  const float* g = p.ple_norm + layer * DM;
  int t0, t1; wg_tokens(t0, t1);
  constexpr int U = 4;
  const u32x4 zero4 = u32x4{0u, 0u, 0u, 0u};
  for (int tb = t0 + w * U; tb < t1; tb += 8 * U) {
    f32x4 v[U][4]; int cnt[U]; u32x4 tl[U];
#pragma unroll
    for (int u = 0; u < U; ++u) {
      const int tok = (tb + u < t1) ? tb + u : t1 - 1;
      cnt[u] = (tb + u < t1) ? p.TCNT[tok] : 0; tl[u] = *(const u32x4*)(p.TLIST + (size_t)tok * 16);
      const f32x4* xr = (const f32x4*)(p.out + (size_t)tok * DM);
#pragma unroll
      for (int j = 0; j < 4; ++j) v[u][j] = xr[lane * 4 + j];
    }
#pragma unroll
    for (int qq = 0; qq < 4; qq += 2) {
      u32x4 ya[U][2], yc[U][2];
#pragma unroll
      for (int u = 0; u < U; ++u)
#pragma unroll
        for (int q2 = 0; q2 < 2; ++q2) {
          ya[u][q2] = zero4; yc[u][q2] = zero4;
          if (qq + q2 < cnt[u]) {
            const u32x4* yr = (const u32x4*)(p.YE + (size_t)tl[u][qq + q2] * DM + lane * 16);
            ya[u][q2] = yr[0]; yc[u][q2] = yr[1];
          }
        }
#pragma unroll
      for (int u = 0; u < U; ++u)
#pragma unroll
        for (int q2 = 0; q2 < 2; ++q2) acc_bf16x16(v[u], ya[u][q2], yc[u][q2]);
    }
#pragma unroll
    for (int u = 0; u < U; ++u) {
      for (int q = 4; q < cnt[u]; ++q) {
        const int yrow = p.TLIST[(size_t)(tb + u) * 16 + q];
        const u32x4* yr = (const u32x4*)(p.YE + (size_t)yrow * DM + lane * 16);
        const u32x4 a = yr[0], c = yr[1];
        acc_bf16x16(v[u], a, c);
      }
      if (tb + u < t1) {
        const int tok = tb + u;
        f32x4* xr = (f32x4*)(p.out + (size_t)tok * DM);
        float ss = 0.f;
#pragma unroll
        for (int j = 0; j < 4; ++j) { xr[lane * 4 + j] = v[u][j]; ss += v[u][j][0] * v[u][j][0] + v[u][j][1] * v[u][j][1] + v[u][j][2] * v[u][j][2] + v[u][j][3] * v[u][j][3]; }
        ss = wave_sum(ss);
        const float rstd = frsq(ss * (1.f / DM) + NORM_EPS);
        u32x4 o0, o1;
#pragma unroll
        for (int j = 0; j < 4; ++j) {
          const f32x4 gg = *(const f32x4*)(g + lane * 16 + j * 4);
          const unsigned lo = pk2(v[u][j][0] * rstd * gg[0], v[u][j][1] * rstd * gg[1]), hi = pk2(v[u][j][2] * rstd * gg[2], v[u][j][3] * rstd * gg[3]);
          if (j < 2) { o0[j * 2] = lo; o0[j * 2 + 1] = hi; } else { o1[(j - 2) * 2] = lo; o1[(j - 2) * 2 + 1] = hi; }
        }
        *(u32x4*)(p.H + (size_t)tok * DM + lane * 16) = o0; *(u32x4*)(p.H + (size_t)tok * DM + lane * 16 + 8) = o1;
      }
    }
  }
}

#define XB_TMO      128
#define XB_XCNT(j)  (256  + 64 * (j))
#define XB_XSUB(j)  (1280 + 64 * (j))
#define XB_XGEN(j)  (2304 + 64 * (j))
#define XB_TOP      3328
#define XB_TOPGEN   3392
#define XCD_BAR_WORDS 3456
#define XB_SPIN_CAP (1u << 20)
DI unsigned xb_ld(unsigned* p) { return __hip_atomic_load(p, __ATOMIC_RELAXED, __HIP_MEMORY_SCOPE_AGENT); }
DI unsigned xb_add(unsigned* p, unsigned v) { return __hip_atomic_fetch_add(p, v, __ATOMIC_RELAXED, __HIP_MEMORY_SCOPE_AGENT); }
DI unsigned xb_xcc_id() { return (unsigned)__builtin_amdgcn_s_getreg((3 << 11) | 20) & 0xFu; }
#define XB_SPIN(cond, bar) do { unsigned _sp = 0; while (cond) { __builtin_amdgcn_s_sleep(1); \
    if ((++_sp & 255u) == 0u) { if (xb_ld(&(bar)[XB_TMO])) break; if (_sp > XB_SPIN_CAP) { atomicAdd(&(bar)[XB_TMO], 1u); break; } } } } while (0)
struct XcdBarrier { unsigned* bar; unsigned x; volatile LAS unsigned* st; };
DI XcdBarrier xcd_barrier_post(unsigned* bar, volatile LAS unsigned* st) {
  XcdBarrier b; b.bar = bar; b.x = xb_xcc_id(); b.st = st;
  if (threadIdx.x == 0) (void)xb_add(&bar[XB_XCNT(b.x)], 1u);
  return b;
}
DI void xcd_barrier_complete(unsigned* bar, unsigned x, unsigned& nloc, unsigned& nx) {
  const unsigned G = gridDim.x * gridDim.y * gridDim.z;
  unsigned sum, cnt, mine, sp = 0u;
  for (;;) {
    sum = 0u; cnt = 0u; mine = 0u;
#pragma unroll
    for (unsigned j = 0; j < 16; ++j) { const unsigned c = xb_ld(&bar[XB_XCNT(j)]); sum += c; cnt += (c > 0u) ? 1u : 0u; mine = (j == x) ? c : mine; }
    if (sum == G) break;
    __builtin_amdgcn_s_sleep(1);
    if ((++sp & 255u) == 0u) { if (xb_ld(&bar[XB_TMO])) break; if (sp > XB_SPIN_CAP) { atomicAdd(&bar[XB_TMO], 1u); break; } }
  }
  nloc = mine > 0u ? mine : 1u; nx = cnt > 0u ? cnt : 1u;
}
DI void xcd_barrier(const XcdBarrier& b) {
  asm volatile("s_waitcnt vmcnt(0)" ::: "memory");
  __syncthreads();
  if (threadIdx.x == 0) {
    unsigned* bar = b.bar;
    __builtin_amdgcn_s_waitcnt(0);
    unsigned nloc = b.st[0], nx = b.st[1];
    if (nloc == 0u) { xcd_barrier_complete(bar, b.x, nloc, nx); b.st[0] = nloc; b.st[1] = nx; }
    const unsigned old = xb_add(&bar[XB_XSUB(b.x)], 1u);
    const unsigned gen = old / nloc;
    if (old + 1u == (gen + 1u) * nloc) {
      __builtin_amdgcn_fence(__ATOMIC_RELEASE, "agent");
      asm volatile("s_waitcnt vmcnt(0)" ::: "memory");
      const unsigned og = xb_add(&bar[XB_TOP], 1u);
      const unsigned tg = og / nx;
      if (og + 1u == (tg + 1u) * nx) xb_add(&bar[XB_TOPGEN], 1u);
      else XB_SPIN(xb_ld(&bar[XB_TOPGEN]) == tg, bar);
      __builtin_amdgcn_fence(__ATOMIC_ACQUIRE, "agent");
      xb_add(&bar[XB_XGEN(b.x)], 1u);
      asm volatile("s_waitcnt vmcnt(0)" ::: "memory");
    } else {
      XB_SPIN(xb_ld(&bar[XB_XGEN(b.x)]) == gen, bar);
      __builtin_amdgcn_fence(__ATOMIC_ACQUIRE, "agent");
      asm volatile("s_waitcnt vmcnt(0)" ::: "memory");
    }
  }
  __syncthreads();
}

#define TAKE(bytes) (ws + off); off += (((size_t)(bytes)) + 255) & ~(size_t)255
__host__ __device__ inline size_t fill_ws(P& p, char* ws) {
  size_t off = 0;
  char* regA = TAKE((size_t)NTOK * INC * 4);
  p.Z = (float*)regA;
  p.LW = (u16*)regA; p.AA = (u16*)(regA + (size_t)2 * NTOK * RWW * 2); p.G = (u16*)(regA + (size_t)4 * NTOK * RWW * 2);
  p.MC = (float*)(regA + (size_t)5 * NTOK * RWW * 2); p.NC = p.MC + (size_t)32 * NCH * 4096;
  p.HID = (u16*)regA;
  char* regB = TAKE((size_t)3 * NTOK * RWW * 4);
  p.R = (float*)regB; p.K = p.R + (size_t)NTOK * RWW; p.V = p.K + (size_t)NTOK * RWW;
  p.PG = (float*)regB;
  char* regC = TAKE((size_t)NTOK * (768 + 1024) * 4);
  p.QRAW = (float*)regC; p.KVRAW = p.QRAW + (size_t)NTOK * 768;
  p.AO = (float*)regC; p.O2 = (u16*)(p.AO + (size_t)NTOK * 512); p.SS = (float*)(p.O2 + (size_t)2 * NTOK * 512);
  p.TWD = (u16*)TAKE((size_t)2 * NTOK * 64 * 2); p.AD = (u16*)TAKE((size_t)2 * NTOK * 64 * 2);
  p.SGD = (u16*)TAKE((size_t)NTOK * 128 * 2); p.QDN = (u16*)TAKE((size_t)NTOK * 256 * 2);
  p.KVDN = (u16*)TAKE((size_t)NTOK * 128 * 2); p.KR = (float*)TAKE((size_t)NTOK * 32 * 4);
  p.ROPE = (float*)TAKE((size_t)NTOK * 32 * 4);
  p.Q = (u16*)TAKE((size_t)NTOK * NH * 96 * 2); p.Kc = (u16*)TAKE((size_t)NTOK * NH * 96 * 2);
  p.Vv = (u16*)TAKE((size_t)NTOK * NH * 64 * 2);
  p.H = (u16*)TAKE((size_t)NTOK * DM * 2);
  p.AFF = (float*)TAKE((size_t)NB * NE * T * 4);
  p.IDX = (int*)TAKE((size_t)NB * NE * CAP * 4);
  p.GATE = (float*)TAKE((size_t)NB * NE * CAP * 4);

  p.WIN = (u16*)TAKE((size_t)WIN_PAD * DM * 2); p.WOUT = (u16*)TAKE((size_t)DM * DM * 2); p.WPG = (u16*)TAKE((size_t)DM * DM * 2);
  p.WPP = (u16*)TAKE((size_t)DM * DPLE * 2); p.PB = (u16*)TAKE((size_t)NTOK * DPLE * 2);
  p.PGb = (u16*)regB;
  p.EW1 = (u16*)regB; p.EW2 = p.EW1 + (size_t)NE * 2048 * 1024;
  p.XE = (u16*)regA; p.HID = (u16*)(regA + (size_t)32 * 1024 * 1024 * 2);
  p.YE = (u16*)regC;
  p.TCNT = (int*)TAKE((size_t)NTOK * 4); p.TLIST = (int*)TAKE((size_t)NTOK * 16 * 4);
  p.CTR = (unsigned*)TAKE(256);
  p.BAR = (unsigned*)TAKE(XCD_BAR_WORDS * 4);
  return off;
}
#undef TAKE
constexpr int DSM_BYTES = g8::STAGE_BYTES + 64 + 16 * 256 * 4;
extern __shared__ __attribute__((aligned(16))) char dsm[];
struct PK { const void* in[31]; float* out; char* ws; };
DI void build_params(P& p, const PK& k) {
  p.x = (const float*)k.in[0]; p.p = (const float*)k.in[1]; p.pos = (const int*)k.in[2];
  p.attn_norm = (const float*)k.in[3]; p.w_in = (const float*)k.in[4]; p.rw_mu = (const float*)k.in[5];
  p.rw_w0 = (const float*)k.in[6]; p.rw_w_up = (const float*)k.in[7]; p.rw_a0 = (const float*)k.in[8];
  p.rw_a_up = (const float*)k.in[9]; p.rw_g_up = (const float*)k.in[10]; p.rw_k_k = (const float*)k.in[11];
  p.rw_k_a = (const float*)k.in[12]; p.rw_r_k = (const float*)k.in[13]; p.rw_lnx_w = (const float*)k.in[14];
  p.rw_lnx_b = (const float*)k.in[15]; p.mla_q_norm = (const float*)k.in[16]; p.mla_q_up = (const float*)k.in[17];
  p.mla_kv_norm = (const float*)k.in[18]; p.mla_kv_up = (const float*)k.in[19]; p.mla_o_norm = (const float*)k.in[20];
  p.w_out = (const float*)k.in[21]; p.ffn_norm = (const float*)k.in[22]; p.router = (const float*)k.in[23];
  p.exp_w_gate = (const float*)k.in[24]; p.exp_w_up = (const float*)k.in[25]; p.exp_w_down = (const float*)k.in[26];
  p.ple_norm = (const float*)k.in[27]; p.ple_proj = (const float*)k.in[28]; p.ple_gate = (const float*)k.in[29];
  p.final_norm = (const float*)k.in[30];
  p.out = k.out;
  (void)fill_ws(p, k.ws);
}
__global__ void __launch_bounds__(NTH) mega(PK pk) {
  P p; build_params(p, pk);
  char* smem = dsm;
  LAS unsigned char* glds = (LAS unsigned char*)dsm;
  uint4* xbw = (uint4*)(dsm + g8::STAGE_BYTES);
  cg::grid_group grid = cg::this_grid();
  if (threadIdx.x == 0) *xbw = make_uint4(0u, 0u, 0u, 0u);
  if (pk.ws == nullptr) grid.sync();
  const XcdBarrier xb = xcd_barrier_post(p.BAR, (volatile LAS unsigned*)xbw);
#define GSYNC() xcd_barrier(xb)
#ifndef PROBE_MASK
#define PROBE_MASK 0u
#endif
#if PROBE_MASK
  unsigned long long pt0 = __builtin_amdgcn_s_memrealtime();
#define PSYNC(id) do { GSYNC(); if (PROBE_MASK & (1u << (id))) { unsigned long long t1_ = __builtin_amdgcn_s_memrealtime(); unsigned long long dt_ = t1_ - pt0; \
    while (__builtin_amdgcn_s_memrealtime() - t1_ < dt_) __builtin_amdgcn_s_sleep(8); } pt0 = __builtin_amdgcn_s_memrealtime(); } while (0)
#else
#define PSYNC(id) GSYNC()
#endif
  for (int layer_ = 0; layer_ < NL; ++layer_) {
    int layer = layer_; asm volatile("" : "+s"(layer));
    if (layer_ == 0) ph_rope_table(p);
    ph_cvt_small(p, layer, smem);
    ph_norm(layer == 0 ? p.x : p.out, p.attn_norm + layer * DM, p.H);
    PSYNC(0);
    {
      g8::Sched S; S.init(NTOK / 256, WIN_PAD / 256, gridDim.x, bidx(), p.H, p.WIN, DM);
      g8::EpiZ E{p.Z};
      g8::gemm_phase(glds, DM, S, E);
    }
    PSYNC(1);
    ph_rwshift(p, layer);
    ph_mlaprep1(p, layer);
    PSYNC(2);
    for (int d = 0; d < 2; ++d) {
      u16* LW = p.LW + (size_t)d * NTOK * RWW; const float* w0 = p.rw_w0 + (layer * 2 + d) * RWW;
      ph_gemm<false>(p.TWD + (size_t)d * NTOK * 64, 64, p.rw_w_up + ((size_t)(layer * 2 + d)) * 64 * RWW, RWW, NTOK, RWW, 64, smem,
                     [&](int row, int col, float v) { LW[(size_t)row * RWW + col] = f2bf(-0.6065306597126334f * sigmoidf_(v + w0[col])); }, (int)blockIdx.x, (int)gridDim.x);
      u16* AA = p.AA + (size_t)d * NTOK * RWW; const float* a0 = p.rw_a0 + (layer * 2 + d) * RWW;
      ph_gemm<false>(p.AD + (size_t)d * NTOK * 64, 64, p.rw_a_up + ((size_t)(layer * 2 + d)) * 64 * RWW, RWW, NTOK, RWW, 64, smem,
                     [&](int row, int col, float v) { AA[(size_t)row * RWW + col] = f2bf(sigmoidf_(v + a0[col])); }, (int)blockIdx.x, (int)gridDim.x);
    }
    PSYNC(3);
    ph_scan1(p, layer, smem);
    PSYNC(4);
    ph_scan2(p, smem);
    const bool split_ = gridDim.x >= 64;
    const int gw = split_ ? (int)blockIdx.x - 32 : (int)blockIdx.x, gstride = split_ ? (int)gridDim.x - 32 : (int)gridDim.x;
    if (gw >= 0)
    {
      u16* G = p.G;
      ph_gemm<false>(p.SGD, 128, p.rw_g_up + (size_t)layer * 128 * RWW, RWW, NTOK, RWW, 128, smem,
                     [&](int row, int col, float v) { G[(size_t)row * RWW + col] = f2bf(v); }, gw, gstride);
      {
        u16* Qo = p.Q; const float* rope = p.ROPE;
        ph_gemm_t(p.QDN, 256, p.mla_q_up + (size_t)layer * 256 * 768, 768, NTOK, 768, 256, smem,
                  [&](const f32x4 (&acc)[4][4], int m0, int n0, int wm, int wn, int lq, int l15) {
          const float qs = 0.10206207261596577f * 1.4426950408889634f;
#pragma unroll
          for (int mi = 0; mi < 4; ++mi)
#pragma unroll
            for (int r = 0; r < 4; ++r) {
              const int tok = m0 + wm * 64 + mi * 16 + lq * 4 + r; const int b = tok / T, t = tok % T;
#pragma unroll
              for (int ni = 0; ni < 4; ++ni) {
                const int col0 = n0 + wn * 64 + ni * 16; const int h = col0 / 96, c0 = col0 % 96;
                u16* qo = Qo + ((size_t)(b * NH + h) * T + t) * 96;
                if (c0 < 64) qo[c0 + l15] = f2bf(acc[mi][ni][r] * qs);
                else if (c0 == 64) {
                  const f32x2 csn = *(const f32x2*)(rope + (size_t)tok * 32 + l15 * 2);
                  const float u1 = acc[mi][ni][r], u2 = acc[mi][(ni + 1) & 3][r];
                  qo[64 + l15] = f2bf((u1 * csn[0] - u2 * csn[1]) * qs);
                  qo[80 + l15] = f2bf((u1 * csn[1] + u2 * csn[0]) * qs);
                }
              }
            }
        }, (gw + gstride - 32 % gstride) % gstride, gstride);
      }
      {
        u16* Ko = p.Kc; u16* Vo = p.Vv;
        ph_gemm_t(p.KVDN, 128, p.mla_kv_up + (size_t)layer * 128 * 1024, 1024, NTOK, 1024, 128, smem,
                  [&](const f32x4 (&acc)[4][4], int m0, int n0, int wm, int wn, int lq, int l15) {
#pragma unroll
          for (int mi = 0; mi < 4; ++mi)
#pragma unroll
            for (int r = 0; r < 4; ++r) {
              const int tok = m0 + wm * 64 + mi * 16 + lq * 4 + r; const int b = tok / T, t = tok % T;
#pragma unroll
              for (int ni = 0; ni < 4; ++ni) {
                const int col0 = n0 + wn * 64 + ni * 16; const int h = col0 >> 7, c0 = col0 & 127;
                const size_t rowi = (size_t)(b * NH + h) * T + t;
                if (c0 < 64) Ko[rowi * 96 + c0 + l15] = f2bf(acc[mi][ni][r]);
                else Vo[rowi * 64 + (c0 - 64) + l15] = f2bf(acc[mi][ni][r]);
              }
            }
        }, (gw + gstride - 192 % gstride) % gstride, gstride);
      }
    }
    PSYNC(7);
    ph_attn(p, smem, p.CTR + layer);
    PSYNC(5);
    ph_mla_norm(p, layer);
    ph_scan3(p, layer, smem);
    PSYNC(6);
    {
      for (int i = blockIdx.x * NTH + tidx(); i < NTOK; i += gridDim.x * NTH) p.TCNT[i] = 0;
      g8::Sched S; S.init(NTOK / 256, DM / 256, gridDim.x, bidx(), p.H, p.WOUT, DM);
      g8::EpiRes E{(layer == 0) ? p.x : p.out, p.out};
      g8::gemm_phase(glds, DM, S, E);
    }
    PSYNC(8);
    ph_norm_router(p, layer, smem);
    PSYNC(9);
    ph_topk(p, smem);
    ph_cvt_experts(p, layer, smem, p.CTR + 4 + layer);
    PSYNC(10);
    {
      g8::Sched S; S.init(NB * NE * CAP / 256, 2048 / 256, gridDim.x, bidx(), p.H, p.EW1, DM);
      S.group(4, NE, (size_t)2048 * 1024 * 2);
      g8::EpiSwi E{p.HID};
      g8::gemm_phase<g8::EpiSwi, true>(glds, DM, S, E, p.IDX, (LAS unsigned*)(dsm + g8::STAGE_BYTES + 64));
    }
    PSYNC(12);
    {
      g8::Sched S; S.init(NB * NE * CAP / 256, DM / 256, gridDim.x, bidx(), p.HID, p.EW2, 1024);
      S.group(4, NE, (size_t)1024 * 1024 * 2);
      g8::EpiYE E{p.YE, p.GATE};
      g8::gemm_phase(glds, 1024, S, E);
    }
    PSYNC(13);
    ph_combine_norm(p, layer);
    PSYNC(16);
    {
      g8::Sched S; S.init(NTOK / 256, DM / 256, gridDim.x, bidx(), p.H, p.WPG, DM);
      g8::EpiSig E{p.PGb};
      g8::gemm_phase(glds, DM, S, E);
    }
    {
      g8::Sched S; S.init(NTOK / 256, DM / 256, gridDim.x, bidx(), p.PB, p.WPP, DPLE);
      g8::EpiPle E{p.out, p.PGb};
      g8::gemm_phase(glds, DPLE, S, E);
    }
    PSYNC(15);
  }
  ph_final_norm(p.out, p.final_norm);
}

extern "C" void kernel_launch(void* const* d_in, const int* in_sizes, int n_in, void* d_out, int out_size, void* d_ws,
                              size_t ws_size, hipStream_t stream) {
  (void)in_sizes; (void)n_in; (void)out_size;
  PK pk{};
  for (int i = 0; i < 31; ++i) pk.in[i] = d_in[i];
  pk.out = (float*)d_out; pk.ws = (char*)d_ws;
  P p{};
  const size_t off = fill_ws(p, (char*)d_ws);
  if (off > ws_size) { fprintf(stderr, "workspace too small: need %zu have %zu\n", off, ws_size); return; }
  static int grid_blocks = 0;
  if (!grid_blocks) {
    int dev = 0, cus = 0, per_cu = 0;
    hipGetDevice(&dev);
    hipDeviceGetAttribute(&cus, hipDeviceAttributeMultiprocessorCount, dev);
    hipFuncSetAttribute((const void*)mega, hipFuncAttributeMaxDynamicSharedMemorySize, DSM_BYTES);
    hipOccupancyMaxActiveBlocksPerMultiprocessor(&per_cu, mega, NTH, DSM_BYTES);
    if (per_cu > 1) per_cu = 1;
    grid_blocks = cus * per_cu;
  }
  hipMemsetAsync(p.CTR, 0, 256 + (size_t)XCD_BAR_WORDS * 4, stream);
  void* args[] = {&pk};
  hipError_t e = hipLaunchCooperativeKernel((void*)mega, dim3(grid_blocks), dim3(NTH), args, DSM_BYTES, stream);
  if (e != hipSuccess) fprintf(stderr, "cooperative launch failed: %s (grid %d)\n", hipGetErrorString(e), grid_blocks);
}
```

```cpp
#include <hip/hip_runtime.h>
#include <hip/hip_bf16.h>
#include <cstdio>
#include <cstdint>
#include <hip/hip_cooperative_groups.h>
namespace cg = cooperative_groups;

#define DI __device__ __forceinline__
#define LAS __attribute__((address_space(3)))

constexpr int NB = 2, T = 8192, NTOK = NB * T, DM = 1024, NL = 2;
constexpr int RWW = 512, RWC = 1920, INC = 2336;
constexpr int NH = 8;
constexpr int NE = 16, CAP = 1024;
constexpr int DPLE = 256;
constexpr int NTH = 512;
constexpr float NORM_EPS = 1e-6f, GN_EPS = 64e-5f;

using bf16x8 = __attribute__((ext_vector_type(8))) short;
using s16x4  = __attribute__((ext_vector_type(4))) short;
using f32x4  = __attribute__((ext_vector_type(4))) float;
using u32x4  = __attribute__((ext_vector_type(4))) unsigned;
using f32x2  = __attribute__((ext_vector_type(2))) float;
using u32x2  = __attribute__((ext_vector_type(2))) unsigned;
typedef __bf16 bf2_t __attribute__((ext_vector_type(2)));
typedef unsigned short u16;

DI unsigned pk2(float a, float b) { bf2_t v = {(__bf16)a, (__bf16)b}; return __builtin_bit_cast(unsigned, v); }
DI u16 f2bf(float a) { return (u16)(pk2(a, 0.f) & 0xffffu); }
DI float bf2f(u16 u) { return __uint_as_float(((unsigned)u) << 16); }
DI const void* uni_ptr(const void* q) {
  unsigned long long v = (unsigned long long)q;
  unsigned lo = __builtin_amdgcn_readfirstlane((unsigned)v), hi = __builtin_amdgcn_readfirstlane((unsigned)(v >> 32));
  return (const void*)(((unsigned long long)hi << 32) | lo);
}
DI int tidx() { int t = threadIdx.x; asm volatile("" : "+v"(t)); return t; }
DI int bidx() { int b = blockIdx.x; asm volatile("" : "+s"(b)); return b; }
template <int CTRL> DI float dpp_f(float v) {
  return __int_as_float(__builtin_amdgcn_update_dpp(__float_as_int(v), __float_as_int(v), CTRL, 0xF, 0xF, true));
}
DI float red_x1(float v) { return v + dpp_f<0xB1>(v); }
DI float red_x2(float v) { return v + dpp_f<0x4E>(v); }
DI float red_x4(float v) { return v + dpp_f<0x141>(v); }
DI float red_x8(float v) { return v + dpp_f<0x140>(v); }
DI float red_x16(float v) { auto r = __builtin_amdgcn_permlane16_swap(__float_as_uint(v), __float_as_uint(v), false, false); return __uint_as_float(r[0]) + __uint_as_float(r[1]); }
DI float red_x32(float v) { auto r = __builtin_amdgcn_permlane32_swap(__float_as_uint(v), __float_as_uint(v), false, false); return __uint_as_float(r[0]) + __uint_as_float(r[1]); }
DI float red16(float v) { return red_x8(red_x4(red_x2(red_x1(v)))); }
DI float wave_sum(float v) { return red_x32(red_x16(red16(v))); }
DI float frcp(float x) { return __builtin_amdgcn_rcpf(x); }
DI float frsq(float x) { return __builtin_amdgcn_rsqf(x); }
DI float fexp(float x) { return __builtin_amdgcn_exp2f(x * 1.4426950408889634f); }
DI float sigmoidf_(float x) { return frcp(1.f + fexp(-x)); }
DI float ftanh(float x) { return 1.f - 2.f * frcp(1.f + fexp(2.f * x)); }
DI s16x4 tr_read(const short* p) {
  return __builtin_amdgcn_ds_read_tr16_b64_v4i16((LAS s16x4*)(p));
}

struct P {
  const float* x; const float* p; const int* pos;
  const float* attn_norm; const float* w_in; const float* rw_mu; const float* rw_w0; const float* rw_w_up;
  const float* rw_a0; const float* rw_a_up; const float* rw_g_up; const float* rw_k_k; const float* rw_k_a;
  const float* rw_r_k; const float* rw_lnx_w; const float* rw_lnx_b; const float* mla_q_norm; const float* mla_q_up;
  const float* mla_kv_norm; const float* mla_kv_up; const float* mla_o_norm; const float* w_out; const float* ffn_norm;
  const float* router; const float* exp_w_gate; const float* exp_w_up; const float* exp_w_down; const float* ple_norm;
  const float* ple_proj; const float* ple_gate; const float* final_norm;
  float* out;
  float* Z;
  u16* LW;
  u16* AA;
  float* MC; float* NC;
  float* SS;
  u16*   G;
  u16*   HID;
  float* R; float* K; float* V;
  float* PG;
  float* QRAW;
  float* KVRAW;
  float* AO;
  u16* O2;
  u16* TWD; u16* AD; u16* SGD; u16* QDN; u16* KVDN; float* KR;
  float* ROPE;
  u16* Q; u16* Kc; u16* Vv;
  u16* H;
  float* AFF;
  int* IDX;
  float* GATE;
  u16* WIN; u16* WOUT; u16* WPG; u16* WPP; u16* PB;
  u16* PGb;
  u16* EW1; u16* EW2;
  u16* XE; u16* YE;
  int* TCNT; int* TLIST;
  unsigned* CTR;
  unsigned* BAR;
};

constexpr int GBM = 256, GBN = 128, GBK = 64;
constexpr int AS_STRIDE = 72, BS_STRIDE = 136;
constexpr int AS_BYTES = GBM * AS_STRIDE * 2;
constexpr int BS_BYTES = GBK * BS_STRIDE * 2;
constexpr int SMEM_BYTES = 57344;

template <bool A_F32, int MODE, class ARow, class Epi>
DI void gemm_tile(ARow arow, const float* __restrict__ B, const float* __restrict__ B2, int ldb, int K, int n0, int Nvalid,
                  char* smem, Epi epi) {
  short* As = (short*)smem;
  short* Bs = (short*)(smem + AS_BYTES);
  const int tid = tidx(), lane = tid & 63, w = tid >> 6;
  const int wm = w >> 1, wn = w & 1;
  const int l15 = lane & 15, lq = lane >> 4;

  const char* ap[4];
#pragma unroll
  for (int i = 0; i < 4; ++i) {
    int u = tid + i * NTH; int row = u >> 3, kc = u & 7;
    ap[i] = (const char*)arow(row) + (size_t)kc * 8 * (A_F32 ? 4 : 2);
  }
  const float* bp[4]; bool bok[4];
#pragma unroll
  for (int i = 0; i < 4; ++i) {
    int u = tid + i * NTH; int k = u >> 5, nq = u & 31;
    int col; const float* base;
    if (MODE != 1) { col = n0 + nq * 4; base = B; }
    else { col = n0 + (nq & 15) * 4; base = (nq < 16) ? B : B2; }
    bok[i] = col < Nvalid;
    bp[i] = base + (size_t)k * ldb + (bok[i] ? col : 0);
  }

  f32x4 acc[4][4];
#pragma unroll
  for (int i = 0; i < 4; ++i)
#pragma unroll
    for (int j = 0; j < 4; ++j) acc[i][j] = f32x4{0.f, 0.f, 0.f, 0.f};

  u32x4 areg[4]; f32x4 breg[4];
#define GLOAD(kt_)                                                                                   \
  {                                                                                                  \
    _Pragma("unroll") for (int i = 0; i < 4; ++i) {                                                  \
      if (A_F32) {                                                                                   \
        const float4* q = (const float4*)(ap[i] + (size_t)(kt_) * GBK * 4);                          \
        float4 v0 = q[0], v1 = q[1];                                                                 \
        areg[i] = u32x4{pk2(v0.x, v0.y), pk2(v0.z, v0.w), pk2(v1.x, v1.y), pk2(v1.z, v1.w)};         \
      } else {                                                                                       \
        areg[i] = *(const u32x4*)(ap[i] + (size_t)(kt_) * GBK * 2);                                  \
      }                                                                                              \
    }                                                                                                \
    _Pragma("unroll") for (int i = 0; i < 4; ++i) {                                                  \
      if (bok[i]) breg[i] = *(const f32x4*)(bp[i] + (size_t)(kt_) * GBK * ldb);                      \
      else breg[i] = f32x4{0.f, 0.f, 0.f, 0.f};                                                      \
    }                                                                                                \
  }
  const int nk = K / GBK;
  GLOAD(0)
  for (int kt = 0; kt < nk; ++kt) {
    __syncthreads();
#pragma unroll
    for (int i = 0; i < 4; ++i) {
      int u = tid + i * NTH; int row = u >> 3, kc = u & 7;
      *(u32x4*)(As + row * AS_STRIDE + kc * 8) = areg[i];
    }
#pragma unroll
    for (int i = 0; i < 4; ++i) {
      int u = tid + i * NTH; int k = u >> 5, nq = u & 31;
      u32x2 v = u32x2{pk2(breg[i][0], breg[i][1]), pk2(breg[i][2], breg[i][3])};
      *(u32x2*)(Bs + k * BS_STRIDE + nq * 4) = v;
    }
    __syncthreads();
    if (kt + 1 < nk) GLOAD(kt + 1)
#pragma unroll
    for (int ks = 0; ks < 2; ++ks) {
      bf16x8 a[4], b[4];
#pragma unroll
      for (int mi = 0; mi < 4; ++mi)
        a[mi] = *(const bf16x8*)(As + (wm * 64 + mi * 16 + l15) * AS_STRIDE + ks * 32 + 8 * lq);
#pragma unroll
      for (int ni = 0; ni < 4; ++ni) {
        int col0 = (MODE != 1) ? (wn * 64 + ni * 16) : ((ni < 2) ? (wn * 32 + ni * 16) : (64 + wn * 32 + (ni - 2) * 16));
        int kb = ks * 32 + 8 * lq; int q = l15 >> 2, pp = l15 & 3;
        s16x4 lo = tr_read(Bs + (kb + q) * BS_STRIDE + col0 + 4 * pp);
        s16x4 hi = tr_read(Bs + (kb + 4 + q) * BS_STRIDE + col0 + 4 * pp);
        b[ni] = __builtin_shufflevector(lo, hi, 0, 1, 2, 3, 4, 5, 6, 7);
      }
#pragma unroll
      for (int mi = 0; mi < 4; ++mi)
#pragma unroll
        for (int ni = 0; ni < 4; ++ni)
          if constexpr (MODE == 1) acc[mi][ni] = __builtin_amdgcn_mfma_f32_16x16x32_bf16(a[mi], b[ni], acc[mi][ni], 0, 0, 0);
          else acc[mi][ni] = __builtin_amdgcn_mfma_f32_16x16x32_bf16(b[ni], a[mi], acc[mi][ni], 0, 0, 0);
    }
  }
  if constexpr (MODE == 2) { epi(acc, wm, wn, lq, l15); return; }
  else if constexpr (MODE == 0) {
#pragma unroll
    for (int mi = 0; mi < 4; ++mi)
#pragma unroll
      for (int ni = 0; ni < 4; ++ni) {
        const int row = wm * 64 + mi * 16 + l15, col = n0 + wn * 64 + ni * 16 + lq * 4;
        if (col < Nvalid) epi(row, col, acc[mi][ni]);
      }
  } else {
#pragma unroll
  for (int mi = 0; mi < 4; ++mi)
#pragma unroll
    for (int r = 0; r < 4; ++r) {
      int row = wm * 64 + mi * 16 + lq * 4 + r;
#pragma unroll
        for (int ni = 0; ni < 2; ++ni) {
          int col = n0 + wn * 32 + ni * 16 + l15;
          epi(row, col, acc[mi][ni][r], acc[mi][ni + 2][r]);
        }
    }
  }
}

DI void ph_norm(const float* __restrict__ X, const float* __restrict__ g, u16* __restrict__ Hout) {
  const int tid_ = tidx(); const int lane = tid_ & 63, w = tid_ >> 6;
  for (int tok = blockIdx.x * 8 + w; tok < NTOK; tok += gridDim.x * 8) {
    const float4* xr = (const float4*)(X + (size_t)tok * DM);
    float4 v[4]; float ss = 0.f;
#pragma unroll
    for (int j = 0; j < 4; ++j) { v[j] = xr[lane + 64 * j]; ss += v[j].x * v[j].x + v[j].y * v[j].y + v[j].z * v[j].z + v[j].w * v[j].w; }
    ss = wave_sum(ss);
    float rstd = frsq(ss * (1.f / DM) + NORM_EPS);
#pragma unroll
    for (int j = 0; j < 4; ++j) {
      float4 gg = ((const float4*)g)[lane + 64 * j];
      uint2 o = uint2{pk2(v[j].x * rstd * gg.x, v[j].y * rstd * gg.y), pk2(v[j].z * rstd * gg.z, v[j].w * rstd * gg.w)};
      *(uint2*)(Hout + (size_t)tok * DM + (lane + 64 * j) * 4) = o;
    }
  }
}

DI void ph_final_norm(float* __restrict__ X, const float* __restrict__ g) {
  const int tid_ = tidx(); const int lane = tid_ & 63, w = tid_ >> 6;
  for (int tok = blockIdx.x * 8 + w; tok < NTOK; tok += gridDim.x * 8) {
    float4* xr = (float4*)(X + (size_t)tok * DM);
    float4 v[4]; float ss = 0.f;
#pragma unroll
    for (int j = 0; j < 4; ++j) { v[j] = xr[lane + 64 * j]; ss += v[j].x * v[j].x + v[j].y * v[j].y + v[j].z * v[j].z + v[j].w * v[j].w; }
    ss = wave_sum(ss);
    float rstd = frsq(ss * (1.f / DM) + NORM_EPS);
#pragma unroll
    for (int j = 0; j < 4; ++j) {
      float4 gg = ((const float4*)g)[lane + 64 * j];
      xr[lane + 64 * j] = float4{v[j].x * rstd * gg.x, v[j].y * rstd * gg.y, v[j].z * rstd * gg.z, v[j].w * rstd * gg.w};
    }
  }
}

template <bool A_F32, class Epi>
DI void ph_gemm(const void* A, int lda, const float* B, int ldb, int M, int N, int K, char* smem, Epi epi, int tfirst, int tstride) {
  const int ntn = (N + GBN - 1) / GBN, ntm = M / GBM;
  for (int t = tfirst; t < ntm * ntn; t += tstride) {
    int tm = t / ntn, tn = t % ntn;
    int m0 = tm * GBM, n0 = tn * GBN;
    auto arow = [&](int r) -> const void* { return (const char*)A + (size_t)(m0 + r) * lda * (A_F32 ? 4 : 2); };
    gemm_tile<A_F32, 0>(arow, B, nullptr, ldb, K, n0, N, smem, [&](int row, int col, const f32x4& v) { epi(m0 + row, col, v); });
    __syncthreads();
  }
}

template <class Epi>
DI void ph_gemm_t(const void* A, int lda, const float* B, int ldb, int M, int N, int K, char* smem, Epi epi, int tfirst, int tstride) {
  const int ntn = (N + GBN - 1) / GBN, ntm = M / GBM;
  for (int t = tfirst; t < ntm * ntn; t += tstride) {
    int tm = t / ntn, tn = t % ntn;
    int m0 = tm * GBM, n0 = tn * GBN;
    auto arow = [&](int r) -> const void* { return (const char*)A + (size_t)(m0 + r) * lda * 2; };
    gemm_tile<false, 2>(arow, B, nullptr, ldb, K, n0, N, smem,
                        [&](const f32x4 (&acc)[4][4], int wm, int wn, int lq, int l15) { epi(acc, m0, n0, wm, wn, lq, l15); });
    __syncthreads();
  }
}

DI void ph_rwshift(const P& p, int layer) {
  const int tid_ = tidx();
  const int per = (NTOK + (int)gridDim.x - 1) / (int)gridDim.x;
  const int t0 = (int)blockIdx.x * per, t1 = (t0 + per < NTOK) ? t0 + per : NTOK;
  if (tid_ < RWC / 4 && t0 < t1) {
    const int c = tid_ * 4;
    const f32x4 m = *(const f32x4*)(p.rw_mu + layer * RWC + c);
    const float* zc = p.Z + c;
    const f32x4 zero = f32x4{0.f, 0.f, 0.f, 0.f};
    constexpr int U = 8;
    f32x4 w[U + 2];
    w[0] = (t0 > 0) ? *(const f32x4*)(zc + (size_t)(t0 - 1) * INC) : zero;
    w[1] = *(const f32x4*)(zc + (size_t)t0 * INC);
    for (int tb = t0; tb < t1; tb += U) {
#pragma unroll
      for (int u = 0; u < U; ++u) { const int tn = tb + u + 1; w[u + 2] = (tn < NTOK && tn <= t1) ? *(const f32x4*)(zc + (size_t)tn * INC) : zero; }
#pragma unroll
      for (int u = 0; u < U; ++u) {
        const int tok = tb + u;
        if (tok < t1) {
          const int t = tok % T;
          const f32x4 zm = (t > 0) ? w[u] : zero, zp = (t < T - 1) ? w[u + 2] : zero, z = w[u + 1];
          const f32x4 o = z + m * (0.5f * (zm + zp) - z);
          if (c < 512) *(f32x4*)(p.R + (size_t)tok * RWW + c) = o;
          else if (c < 1024) *(f32x4*)(p.K + (size_t)tok * RWW + (c - 512)) = o;
          else if (c < 1536) *(f32x4*)(p.V + (size_t)tok * RWW + (c - 1024)) = o;
          else if (c < 1664) {
            const int d = (c - 1536) >> 6, l = (c - 1536) & 63;
            *(u32x2*)(p.TWD + ((size_t)d * NTOK + tok) * 64 + l) = u32x2{pk2(ftanh(o[0]), ftanh(o[1])), pk2(ftanh(o[2]), ftanh(o[3]))};
          } else if (c < 1792) {
            const int d = (c - 1664) >> 6, l = (c - 1664) & 63;
            *(u32x2*)(p.AD + ((size_t)d * NTOK + tok) * 64 + l) = u32x2{pk2(o[0], o[1]), pk2(o[2], o[3])};
          } else {
            const int l = c - 1792;
            *(u32x2*)(p.SGD + (size_t)tok * 128 + l) = u32x2{pk2(sigmoidf_(o[0]), sigmoidf_(o[1])), pk2(sigmoidf_(o[2]), sigmoidf_(o[3]))};
          }
        }
      }
      w[0] = w[U]; w[1] = w[U + 1];
    }
  }
}

DI void rope_cs(int pos, int i, float& cs, float& sn) {
  const int i3 = i & 3, i2 = i >> 2;
  const float c4 = (i3 == 0) ? 1.0f : (i3 == 1) ? 0.5623413251903491f : (i3 == 2) ? 0.31622776601683794f : 0.1778279410038923f;
  const float p10 = (i2 == 0) ? 1.0f : (i2 == 1) ? 0.1f : (i2 == 2) ? 0.01f : 0.001f;
  float inv = c4 * p10;
  float ang = (float)pos * inv;
  double rev = (double)ang * 0.15915494309189535;
  rev -= floor(rev);
  float rf = (float)rev;
  sn = __builtin_amdgcn_sinf(rf);
  cs = __builtin_amdgcn_cosf(rf);
}

DI void ph_rope_table(const P& p) {
  for (int i = blockIdx.x * NTH + tidx(); i < NTOK * 16; i += gridDim.x * NTH) {
    float cs, sn; rope_cs(p.pos[i >> 4], i & 15, cs, sn);
    *(f32x2*)(p.ROPE + (size_t)i * 2) = f32x2{cs, sn};
  }
}
DI void ph_mlaprep1(const P& p, int layer) {
  const int tid_ = tidx(); const int lane = tid_ & 63, w = tid_ >> 6;
  const f32x4 g = *(const f32x4*)(p.mla_q_norm + layer * 256 + lane * 4);
  const f32x2 g2 = *(const f32x2*)(p.mla_kv_norm + layer * 128 + lane * 2);
  const int per = (NTOK + (int)gridDim.x - 1) / (int)gridDim.x;
  const int t0 = (int)blockIdx.x * per, t1 = (t0 + per < NTOK) ? t0 + per : NTOK;
  constexpr int U = 4;
  for (int tb = t0 + w * U; tb < t1; tb += 8 * U) {
    f32x4 q[U]; f32x2 kv[U]; float u1[U], u2[U]; f32x2 csn[U];
#pragma unroll
    for (int u = 0; u < U; ++u) {
      const int tok = (tb + u < t1) ? tb + u : t1 - 1;
      const float* zr = p.Z + (size_t)tok * INC + RWC;
      q[u] = *(const f32x4*)(zr + lane * 4); kv[u] = *(const f32x2*)(zr + 256 + lane * 2);
      u1[u] = zr[384 + (lane & 15)]; u2[u] = zr[384 + 16 + (lane & 15)];
      csn[u] = *(const f32x2*)(p.ROPE + (size_t)tok * 32 + (lane & 15) * 2);
    }
#pragma unroll
    for (int u = 0; u < U; ++u) {
      const int tok = tb + u;
      const float ss = wave_sum(q[u][0] * q[u][0] + q[u][1] * q[u][1] + q[u][2] * q[u][2] + q[u][3] * q[u][3]);
      const float rstd = frsq(ss * (1.f / 256) + NORM_EPS);
      const float ss2 = wave_sum(kv[u][0] * kv[u][0] + kv[u][1] * kv[u][1]);
      const float rstd2 = frsq(ss2 * (1.f / 128) + NORM_EPS);
      if (tok < t1) {
        *(u32x2*)(p.QDN + (size_t)tok * 256 + lane * 4) = u32x2{pk2(q[u][0] * rstd * g[0], q[u][1] * rstd * g[1]), pk2(q[u][2] * rstd * g[2], q[u][3] * rstd * g[3])};
        *(unsigned*)(p.KVDN + (size_t)tok * 128 + lane * 2) = pk2(kv[u][0] * rstd2 * g2[0], kv[u][1] * rstd2 * g2[1]);
        if (lane < 16) {
          const u16 k1 = f2bf(u1[u] * csn[u][0] - u2[u] * csn[u][1]), k2 = f2bf(u1[u] * csn[u][1] + u2[u] * csn[u][0]);
          const int bb = tok / T, tt = tok % T;
#pragma unroll
          for (int h = 0; h < NH; ++h) {
            u16* ko = p.Kc + ((size_t)(bb * NH + h) * T + tt) * 96 + 64;
            ko[lane] = k1; ko[16 + lane] = k2;
          }
        }
      }
    }
  }
}

DI void ph_mlafinish(const P& p) {
  const int tid_ = tidx(); const int lane = tid_ & 63, w = tid_ >> 6;
  const float qs = 0.10206207261596577f * 1.4426950408889634f;
  for (int tok = blockIdx.x * 8 + w; tok < NTOK; tok += gridDim.x * 8) {
    int b = tok / T, t = tok % T;
    float cs = 0.f, sn = 0.f;
    if (lane < 16) rope_cs(p.pos[tok], lane, cs, sn);
    const float* qr = p.QRAW + (size_t)tok * 768;
    const float* kvr = p.KVRAW + (size_t)tok * 1024;
    const float* kr = p.KR + (size_t)tok * 32;
#pragma unroll
    for (int h = 0; h < NH; ++h) {
      size_t row = ((size_t)(b * NH + h) * T + t);
      u16* qo = p.Q + row * 96; u16* ko = p.Kc + row * 96; u16* vo = p.Vv + row * 64;
      qo[lane] = f2bf(qr[h * 96 + lane] * qs);
      ko[lane] = f2bf(kvr[h * 128 + lane]);
      vo[lane] = f2bf(kvr[h * 128 + 64 + lane]);
      if (lane < 16) {
        float u1 = qr[h * 96 + 64 + lane], u2 = qr[h * 96 + 80 + lane];
        qo[64 + lane] = f2bf((u1 * cs - u2 * sn) * qs);
        qo[80 + lane] = f2bf((u1 * sn + u2 * cs) * qs);
      }
      if (lane < 32) ko[64 + lane] = f2bf(kr[lane]);
    }
  }
}

using f32x16 = __attribute__((ext_vector_type(16))) float;
#define SBAR() __builtin_amdgcn_sched_barrier(0)
constexpr int AT_KSTR = 104;
constexpr int AT_KBYTES = 64 * AT_KSTR * 2;
constexpr int AT_VBYTES = 64 * 64 * 2;
constexpr float AT_THR = 8.f;
DI int crow(int r, int hi) { return (r & 3) + 8 * (r >> 2) + 4 * hi; }
DI int v_st(int k, int c) { const int kk = (k & ~0xC) | ((k & 4) << 1) | ((k & 8) >> 1); return ((kk >> 3) * 2 + (c >> 5)) * 512 + ((kk & 7) * 32 + (c & 31)) * 2; }
DI int v_rd_base(int lane) { return ((lane & 3) << 3) | (((lane >> 2) & 3) << 6) | (((lane >> 4) & 1) << 5) | (((lane >> 5) & 1) << 8); }
constexpr int v_rd_off(int d0, int ks, int half) { return d0 * 512 + ks * 2048 + half * 1024; }

DI void at_partialSM(f32x16& p0, f32x16& p1, float& m_reg, float& mn, float& alpha) {
  float pmax = p0[0];
#pragma unroll
  for (int r = 1; r < 16; ++r) pmax = fmaxf(pmax, p0[r]);
#pragma unroll
  for (int r = 0; r < 16; ++r) pmax = fmaxf(pmax, p1[r]);
  { auto rr = __builtin_amdgcn_permlane32_swap(__float_as_uint(pmax), __float_as_uint(pmax), false, false);
    pmax = fmaxf(__uint_as_float(rr[0]), __uint_as_float(rr[1])); }
  if (__builtin_expect(__all(pmax - m_reg <= AT_THR), 1)) { mn = m_reg; alpha = 1.f; }
  else { mn = fmaxf(m_reg, pmax); alpha = __builtin_amdgcn_exp2f(m_reg - mn); m_reg = mn; }
#pragma unroll
  for (int r = 0; r < 16; ++r) { p0[r] = p0[r] - mn; p1[r] = p1[r] - mn; }
#pragma unroll
  for (int r = 0; r < 16; ++r) p0[r] = __builtin_amdgcn_exp2f(p0[r]);
}
DI void at_finishSM(f32x16& p0, f32x16& p1, float alpha, float& l_reg, bf16x8& pa0, bf16x8& pa1, bf16x8& pa2, bf16x8& pa3) {
#pragma unroll
  for (int r = 0; r < 16; ++r) p1[r] = __builtin_amdgcn_exp2f(p1[r]);
  float ps = 0;
#pragma unroll
  for (int r = 0; r < 16; ++r) ps += p0[r];
#pragma unroll
  for (int r = 0; r < 16; ++r) ps += p1[r];
  { auto rr = __builtin_amdgcn_permlane32_swap(__float_as_uint(ps), __float_as_uint(ps), false, false);
    ps = __uint_as_float(rr[0]) + __uint_as_float(rr[1]); }
  l_reg = l_reg * alpha + ps;
#define PK4(PP, BASE, OUT) do { unsigned a0 = pk2(PP[BASE + 0], PP[BASE + 1]), a1 = pk2(PP[BASE + 2], PP[BASE + 3]);   \
    unsigned b0 = pk2(PP[BASE + 4], PP[BASE + 5]), b1 = pk2(PP[BASE + 6], PP[BASE + 7]);                              \
    auto r0 = __builtin_amdgcn_permlane32_swap(a0, b0, false, false); auto r1 = __builtin_amdgcn_permlane32_swap(a1, b1, false, false); \
    u32x4 wv = {r0[0], r1[0], r0[1], r1[1]}; OUT = __builtin_bit_cast(bf16x8, wv); } while (0)
  PK4(p0, 0, pa0); PK4(p0, 8, pa1); PK4(p1, 0, pa2); PK4(p1, 8, pa3);
#undef PK4
}
DI void at_qkt(f32x16& p0, f32x16& p1, const char* Kb, const bf16x8* qr, int r32, int hi) {
#pragma unroll
  for (int r = 0; r < 16; ++r) { p0[r] = 0.f; p1[r] = 0.f; }
#pragma unroll
  for (int d0 = 0; d0 < 6; ++d0) {
    bf16x8 b0 = *(const bf16x8*)(Kb + (r32 * AT_KSTR + d0 * 16 + hi * 8) * 2);
    bf16x8 b1 = *(const bf16x8*)(Kb + ((32 + r32) * AT_KSTR + d0 * 16 + hi * 8) * 2);
    __builtin_amdgcn_s_setprio(1);
    p0 = __builtin_amdgcn_mfma_f32_32x32x16_bf16(b0, qr[d0], p0, 0, 0, 0);
    p1 = __builtin_amdgcn_mfma_f32_32x32x16_bf16(b1, qr[d0], p1, 0, 0, 0);
    __builtin_amdgcn_s_setprio(0);
  }
}
template <int D0> DI void at_pv_one(f32x16& od, const char* vb, bf16x8 pa0, bf16x8 pa1, bf16x8 pa2, bf16x8 pa3) {
#define TRR(ks, half) tr_read((const short*)(vb + v_rd_off(D0, ks, half)))
  const s16x4 l0 = TRR(0, 0), h0 = TRR(0, 1), l1 = TRR(1, 0), h1 = TRR(1, 1), l2 = TRR(2, 0), h2 = TRR(2, 1), l3 = TRR(3, 0), h3 = TRR(3, 1);
#undef TRR
#define PKV(L, H) __builtin_shufflevector(L, H, 0, 1, 2, 3, 4, 5, 6, 7)
  __builtin_amdgcn_s_setprio(1);
  od = __builtin_amdgcn_mfma_f32_32x32x16_bf16(pa0, PKV(l0, h0), od, 0, 0, 0);
  od = __builtin_amdgcn_mfma_f32_32x32x16_bf16(pa1, PKV(l1, h1), od, 0, 0, 0);
  od = __builtin_amdgcn_mfma_f32_32x32x16_bf16(pa2, PKV(l2, h2), od, 0, 0, 0);
  od = __builtin_amdgcn_mfma_f32_32x32x16_bf16(pa3, PKV(l3, h3), od, 0, 0, 0);
  __builtin_amdgcn_s_setprio(0);
#undef PKV
}
DI void at_pv(f32x16* o, const char* vb, bf16x8 pa0, bf16x8 pa1, bf16x8 pa2, bf16x8 pa3) {
  at_pv_one<0>(o[0], vb, pa0, pa1, pa2, pa3); at_pv_one<1>(o[1], vb, pa0, pa1, pa2, pa3);
}

DI void attn_body(const u16* __restrict__ Qb, const u16* __restrict__ Kh, const u16* __restrict__ Vh, float* __restrict__ Ob, char* lds, int tid) {
  const int wid = tid >> 6, lane = tid & 63, r32 = lane & 31, hi = lane >> 5;
  char* V_lds = lds; char* K_lds = lds + 2 * AT_VBYTES;
  float* wsp = (float*)(lds + 2 * AT_VBYTES + 2 * AT_KBYTES) + wid * 64; float* li_l = wsp; float* al_l = wsp + 32;
  float m_reg = -1e30f, l_reg = 0.f; f32x16 o[2]; bf16x8 qr[6];
#pragma unroll
  for (int r = 0; r < 16; ++r) { o[0][r] = 0.f; o[1][r] = 0.f; }
  const u16* Qw = Qb + (size_t)(wid * 32 + r32) * 96 + hi * 8;
#pragma unroll
  for (int d0 = 0; d0 < 6; ++d0) qr[d0] = *(const bf16x8*)(Qw + d0 * 16);
  const int kid1 = (tid < 256) ? tid + 512 : tid;
  const int kst0 = ((tid / 12) * AT_KSTR + (tid % 12) * 8) * 2, kst1 = ((kid1 / 12) * AT_KSTR + (kid1 % 12) * 8) * 2;
  const int vst = v_st(tid >> 3, (tid & 7) * 8);
  const char* vb0 = V_lds + v_rd_base(lane);
  u32x4 sk0[2], sk1[2], sv0[2];
#define SLOAD(i, k0) do { sk0[i] = *(const u32x4*)(Kh + (size_t)(k0) * 96 + tid * 8); sk1[i] = *(const u32x4*)(Kh + (size_t)(k0) * 96 + kid1 * 8); \
    sv0[i] = *(const u32x4*)(Vh + (size_t)(k0) * 64 + tid * 8); } while (0)
#define SWRITE(b, i) do { *(u32x4*)(K_lds + (b) * AT_KBYTES + kst0) = sk0[i]; if (tid < 256) *(u32x4*)(K_lds + (b) * AT_KBYTES + kst1) = sk1[i]; \
    *(u32x4*)(V_lds + (b) * AT_VBYTES + vst) = sv0[i]; } while (0)
#define SWAIT() asm volatile("s_waitcnt vmcnt(3)" ::: "memory")
#define RESC(a) do { if (__any((a) < 1.f)) { if (hi == 0) al_l[r32] = (a); asm volatile("s_waitcnt lgkmcnt(0)" ::: "memory"); \
    _Pragma("unroll") for (int r = 0; r < 16; ++r) { float al = al_l[crow(r, hi)]; o[0][r] *= al; o[1][r] *= al; } } } while (0)
  f32x16 pA0, pA1, pB0, pB1; float mnA, mnB, alA, alB; bf16x8 pa0, pa1, pa2, pa3; constexpr int NT = T / 64;
  SLOAD(0, 0); SWRITE(0, 0); __syncthreads();
  at_qkt(pA0, pA1, K_lds, qr, r32, hi); at_partialSM(pA0, pA1, m_reg, mnA, alA);
  SLOAD(1, 64); SLOAD(0, 128);
  SWAIT(); SWRITE(1, 1); __syncthreads();
  for (int j = 1; j + 1 < NT; j += 2) {
    SBAR(); at_qkt(pB0, pB1, K_lds + AT_KBYTES, qr, r32, hi);
    at_finishSM(pA0, pA1, alA, l_reg, pa0, pa1, pa2, pa3); SBAR();
    SLOAD(1, (j + 2) * 64); SBAR();
    at_pv(o, vb0, pa0, pa1, pa2, pa3); at_partialSM(pB0, pB1, m_reg, mnB, alB);
    __syncthreads(); SWAIT(); SWRITE(0, 0);
    RESC(alB); __syncthreads();
    SBAR(); at_qkt(pA0, pA1, K_lds, qr, r32, hi);
    at_finishSM(pB0, pB1, alB, l_reg, pa0, pa1, pa2, pa3); SBAR();
    if (j + 3 < NT) SLOAD(0, (j + 3) * 64); SBAR();
    at_pv(o, vb0 + AT_VBYTES, pa0, pa1, pa2, pa3); at_partialSM(pA0, pA1, m_reg, mnA, alA);
    __syncthreads(); SWAIT(); SWRITE(1, 1);
    RESC(alA); __syncthreads();
  }
  SBAR(); at_qkt(pB0, pB1, K_lds + AT_KBYTES, qr, r32, hi);
  at_finishSM(pA0, pA1, alA, l_reg, pa0, pa1, pa2, pa3); SBAR();
  at_pv(o, vb0, pa0, pa1, pa2, pa3); at_partialSM(pB0, pB1, m_reg, mnB, alB);
  __syncthreads(); RESC(alB);
  at_finishSM(pB0, pB1, alB, l_reg, pa0, pa1, pa2, pa3); SBAR();
  at_pv(o, vb0 + AT_VBYTES, pa0, pa1, pa2, pa3);
  if (hi == 0) li_l[r32] = l_reg;
  asm volatile("s_waitcnt lgkmcnt(0)" ::: "memory");
  float* Ow = Ob + (size_t)(wid * 32) * 512;
#pragma unroll
  for (int r = 0; r < 16; ++r) {
    int orow = crow(r, hi); float rl = __builtin_amdgcn_rcpf(li_l[orow]);
    Ow[(size_t)orow * 512 + r32] = o[0][r] * rl; Ow[(size_t)orow * 512 + 32 + r32] = o[1][r] * rl;
  }
#undef SLOAD
#undef SWRITE
#undef SWAIT
#undef RESC
}

DI void ph_attn(const P& p, char* smem, unsigned* ctr) {
  const int tid = tidx();
  int* sitem = (int*)(smem + SMEM_BYTES - 16);
  for (;;) {
    __syncthreads();
    if (tid == 0) *sitem = (int)atomicAdd(ctr, 1u);
    __syncthreads();
    const int item = *sitem;
    if (item >= NB * NH * (T / 256)) break;
    const int bh = item / (T / 256), qb = item % (T / 256);
    const int b = bh / NH, h = bh % NH;
    attn_body(p.Q + ((size_t)bh * T + qb * 256) * 96, p.Kc + (size_t)bh * T * 96, p.Vv + (size_t)bh * T * 64,
              p.AO + ((size_t)(b * T + qb * 256)) * 512 + h * 64, smem, tid);
  }
}

constexpr int SC = 256, NCH = T / SC;
constexpr int SBUF = 5184;
template <int NI> struct ScanRegsN { float k[2 * NI], r[2 * NI], v[2 * NI]; u16 lw[2 * NI], a[2 * NI]; };
template <int NI>
DI void scan_load_n(const P& p, int b, int h, int d, int n0, int lane, int ws, ScanRegsN<NI>& g) {
  constexpr int WPI = 8 / NI;
  const u16* LWd = p.LW + (size_t)d * NTOK * RWW;
  const u16* AAd = p.AA + (size_t)d * NTOK * RWW;
  const int ch = h * 64 + lane;
#pragma unroll
  for (int jj = 0; jj < 2 * NI; ++jj) {
    int n = n0 + ws + WPI * jj; int t = d ? (T - 1 - n) : n;
    size_t off = ((size_t)(b * T + t)) * RWW + ch;
    g.k[jj] = p.K[off]; g.r[jj] = p.R[off]; g.v[jj] = p.V[off]; g.lw[jj] = LWd[off]; g.a[jj] = AAd[off];
  }
}
template <int NI>
DI void scan_put_n(const ScanRegsN<NI>& g, float kkc, float kac, float* sm, float* slw, int lane, int ws) {
  constexpr int WPI = 8 / NI;
#pragma unroll
  for (int jj = 0; jj < 2 * NI; ++jj) slw[(ws + WPI * jj) * 64 + lane] = bf2f(g.lw[jj]);
  __syncthreads();
  float Lj[2 * NI];
#pragma unroll
  for (int jj = 0; jj < 2 * NI; ++jj) Lj[jj] = 0.f;
#pragma unroll
  for (int i = 0; i < 16; ++i) {
    const float x = slw[i * 64 + lane];
#pragma unroll
    for (int jj = 0; jj < 2 * NI; ++jj) Lj[jj] += (i <= ws + WPI * jj) ? x : 0.f;
  }
#pragma unroll
  for (int jj = 0; jj < 2 * NI; ++jj) {
    const int j = ws + WPI * jj;
    const float L = Lj[jj], lwj = bf2f(g.lw[jj]);
    const float Pt = fexp(L), Pm = fexp(L - lwj), iP = fexp(-L);
    const float kv = g.k[jj];
    const float kx = kv * kkc;
    const float nrm = __builtin_amdgcn_sqrtf(wave_sum(kx * kx));
    const float kkv = kx * frcp(fmaxf(nrm, 1e-12f));
    const float a = bf2f(g.a[jj]);
    sm[j * 64 + lane] = -kkv * Pm;
    sm[1024 + j * 64 + lane] = a * kkv * iP;
    sm[2048 + j * 64 + lane] = kv * (1.f + (a - 1.f) * kac) * iP;
    sm[3072 + j * 64 + lane] = g.r[jj] * Pt;
    sm[4096 + j * 64 + lane] = g.v[jj];
    if (j == 15) sm[5120 + lane] = Pt;
  }
}
using f32x16s = __attribute__((ext_vector_type(16))) float;
DI void scan_ld8(f32x4 (&kv)[8], const float* vec, int hi) {
#pragma unroll
  for (int tk = 0; tk < 2; ++tk)
#pragma unroll
    for (int q = 0; q < 4; ++q) kv[tk * 4 + q] = *(const f32x4*)(vec + 32 * tk + 8 * q + 4 * hi);
}
DI float scan_dot8(const f32x16s (&acc)[2], const f32x4 (&kv)[8]) {
  float pq[4] = {0.f, 0.f, 0.f, 0.f};
#pragma unroll
  for (int tk = 0; tk < 2; ++tk)
#pragma unroll
    for (int e = 0; e < 4; ++e)
#pragma unroll
      for (int q = 0; q < 4; ++q) { pq[q] = __builtin_fmaf(acc[tk][4 * q + e], kv[tk * 4 + q][e], pq[q]); asm("" : "+v"(pq[q])); }
  return red_x32((pq[0] + pq[1]) + (pq[2] + pq[3]));
}

DI void ph_scan1(const P& p, int layer, char* smem) {
  constexpr int NI = 2;
  const int tid = tidx(), lane = tid & 63, w = tid >> 6;
  const int jl = lane & 31, hi = lane >> 5;
  const int it = w >> 2, vt = w & 3, ws = w & 3;
  float* smi = (float*)smem + it * (2 * SBUF + 1024);
  float* slw = smi + 2 * SBUF;
  for (int pair = blockIdx.x; pair < 32 * NCH / 2; pair += gridDim.x) {
    const int item = pair * 2 + it; const int scan = item / NCH, c = item % NCH;
    const int d = scan & 1, h = (scan >> 1) % NH, b = scan / (2 * NH);
    const float kkc = p.rw_k_k[layer * RWW + h * 64 + lane], kac = p.rw_k_a[layer * RWW + h * 64 + lane];
    f32x16s acc[2];
#pragma unroll
    for (int tk = 0; tk < 2; ++tk)
#pragma unroll
      for (int r = 0; r < 16; ++r) acc[tk][r] = (32 * tk + (r & 3) + 8 * (r >> 2) + 4 * hi == 32 * vt + jl) ? 1.f : 0.f;
    ScanRegsN<NI> g;
    scan_load_n<NI>(p, b, h, d, c * SC, lane, ws, g);
    __syncthreads();
    scan_put_n<NI>(g, kkc, kac, smi, slw, lane, ws);
    __syncthreads();
    for (int sub = 0; sub < SC / 16; ++sub) {
      const float* sm = smi + (sub & 1) * SBUF;
      if (sub + 1 < SC / 16) scan_load_n<NI>(p, b, h, d, c * SC + (sub + 1) * 16, lane, ws, g);
      const float* vrow = sm + 4096 + ((vt >= 2) ? 32 * (vt - 2) : 0) + jl;
      f32x4 kc[8]; scan_ld8(kc, sm, hi);
      float a0 = sm[1024 + hi * 1024 + jl], a1 = sm[1024 + hi * 1024 + 32 + jl], vc = vrow[0];
#pragma unroll 4
      for (int j = 0; j < 16; ++j) {
        const int jn = (j + 1) & 15;
        f32x4 kn[8]; scan_ld8(kn, sm + jn * 64, hi);
        const float an0 = sm[1024 + hi * 1024 + jn * 64 + jl], an1 = sm[1024 + hi * 1024 + jn * 64 + 32 + jl], vn = vrow[jn * 64];
        SBAR();
        const float sa = scan_dot8(acc, kc);
        const float bop = hi ? ((vt >= 2) ? vc : 0.f) : sa;
        acc[0] = __builtin_amdgcn_mfma_f32_32x32x2f32(a0, bop, acc[0], 0, 0, 0);
        acc[1] = __builtin_amdgcn_mfma_f32_32x32x2f32(a1, bop, acc[1], 0, 0, 0);
        SBAR();
#pragma unroll
        for (int i = 0; i < 8; ++i) kc[i] = kn[i];
        a0 = an0; a1 = an1; vc = vn;
      }
#pragma unroll
      for (int tk = 0; tk < 2; ++tk)
#pragma unroll
        for (int q = 0; q < 4; ++q) {
          const f32x4 pv = *(const f32x4*)(sm + 5120 + 32 * tk + 8 * q + 4 * hi);
#pragma unroll
          for (int e = 0; e < 4; ++e) acc[tk][4 * q + e] *= pv[e];
        }
      if (sub + 1 < SC / 16) scan_put_n<NI>(g, kkc, kac, smi + ((sub + 1) & 1) * SBUF, slw, lane, ws);
      __syncthreads();
    }
    {
      const int v = 32 * vt + jl;
      float* dst = ((v < 64) ? p.MC : p.NC) + (((size_t)scan * NCH + c) * 64 + (v & 63)) * 64;
#pragma unroll
      for (int tk = 0; tk < 2; ++tk)
#pragma unroll
        for (int q = 0; q < 4; ++q)
          *(f32x4*)(dst + 32 * tk + 8 * q + 4 * hi) = f32x4{acc[tk][4 * q], acc[tk][4 * q + 1], acc[tk][4 * q + 2], acc[tk][4 * q + 3]};
    }
  }
}


DI void ph_scan2(const P& p, char* smem) {
  constexpr int LS = 72;
  u16* Sh = (u16*)smem; u16* Sl = Sh + 64 * LS; u16* Mh = Sl + 64 * LS; u16* Ml = Mh + 64 * LS;
  const int tid = tidx(), lane = tid & 63, w = tid >> 6;
  const int l15 = lane & 15, lq = lane >> 4;
  const int ti = w >> 1, tj0 = (w & 1) * 2;
  for (int scan = blockIdx.x; scan < 32; scan += gridDim.x) {
    const float* Mg = p.MC + (size_t)scan * NCH * 4096;
    const float* Ng = p.NC + (size_t)scan * NCH * 4096;
    float* Sg = p.SS + (size_t)scan * NCH * 4096;
    struct MN { f32x4 m0, m1, n[2]; };
    auto ldmn = [&](MN& r, int c) {
      const int cc = (c < NCH) ? c : (NCH - 1);
      r.m0 = *(const f32x4*)(Mg + (size_t)cc * 4096 + tid * 8); r.m1 = *(const f32x4*)(Mg + (size_t)cc * 4096 + tid * 8 + 4);
#pragma unroll
      for (int q = 0; q < 2; ++q)
#pragma unroll
        for (int r4 = 0; r4 < 4; ++r4) r.n[q][r4] = Ng[(size_t)cc * 4096 + (ti * 16 + lq * 4 + r4) * 64 + (tj0 + q) * 16 + l15];
    };
    f32x4 sacc[2];
    sacc[0] = f32x4{0.f, 0.f, 0.f, 0.f}; sacc[1] = sacc[0];
    auto step = [&](int c, const MN& r) {
      __syncthreads();
#pragma unroll
      for (int q = 0; q < 2; ++q)
#pragma unroll
        for (int r4 = 0; r4 < 4; ++r4) {
          const int row = ti * 16 + lq * 4 + r4, col = (tj0 + q) * 16 + l15;
          const float x = sacc[q][r4];
          Sg[(size_t)c * 4096 + row * 64 + col] = x;
          const u16 h = f2bf(x); Sh[row * LS + col] = h; Sl[row * LS + col] = f2bf(x - bf2f(h));
        }
      {
        const int mr = tid >> 3, mc = (tid & 7) * 8;
        float xh[8], xl[8];
#pragma unroll
        for (int i = 0; i < 8; ++i) { const float x = (i < 4) ? r.m0[i & 3] : r.m1[i & 3]; const float h = bf2f(f2bf(x)); xh[i] = h; xl[i] = x - h; }
        *(u32x4*)(Mh + mr * LS + mc) = u32x4{pk2(xh[0], xh[1]), pk2(xh[2], xh[3]), pk2(xh[4], xh[5]), pk2(xh[6], xh[7])};
        *(u32x4*)(Ml + mr * LS + mc) = u32x4{pk2(xl[0], xl[1]), pk2(xl[2], xl[3]), pk2(xl[4], xl[5]), pk2(xl[6], xl[7])};
      }
      f32x4 acc[2] = {r.n[0], r.n[1]};
      __syncthreads();
#pragma unroll
      for (int ks = 0; ks < 2; ++ks) {
        const bf16x8 ah = *(const bf16x8*)(Sh + (ti * 16 + l15) * LS + ks * 32 + 8 * lq);
        const bf16x8 al = *(const bf16x8*)(Sl + (ti * 16 + l15) * LS + ks * 32 + 8 * lq);
#pragma unroll
        for (int q = 0; q < 2; ++q) {
          const int kb = ks * 32 + 8 * lq, tq = l15 >> 2, tp = l15 & 3, co = (tj0 + q) * 16 + 4 * tp;
          const bf16x8 bh = __builtin_shufflevector(tr_read((const short*)Mh + (kb + tq) * LS + co), tr_read((const short*)Mh + (kb + 4 + tq) * LS + co), 0, 1, 2, 3, 4, 5, 6, 7);
          const bf16x8 bl = __builtin_shufflevector(tr_read((const short*)Ml + (kb + tq) * LS + co), tr_read((const short*)Ml + (kb + 4 + tq) * LS + co), 0, 1, 2, 3, 4, 5, 6, 7);
          acc[q] = __builtin_amdgcn_mfma_f32_16x16x32_bf16(ah, bh, acc[q], 0, 0, 0);
          acc[q] = __builtin_amdgcn_mfma_f32_16x16x32_bf16(ah, bl, acc[q], 0, 0, 0);
          acc[q] = __builtin_amdgcn_mfma_f32_16x16x32_bf16(al, bh, acc[q], 0, 0, 0);
        }
      }
      sacc[0] = acc[0]; sacc[1] = acc[1];
    };
    MN r0, r1, r2, r3;
    ldmn(r0, 0); ldmn(r1, 1); ldmn(r2, 2);
    for (int c = 0; c < NCH; c += 4) {
      ldmn(r3, c + 3); step(c, r0);
      ldmn(r0, c + 4); step(c + 1, r1);
      ldmn(r1, c + 5); step(c + 2, r2);
      ldmn(r2, c + 6); step(c + 3, r3);
    }
    __syncthreads();
  }
}

DI void ph_scan3(const P& p, int layer, char* smem) {
  constexpr int NI = 4;
  const int tid = tidx(), lane = tid & 63, w = tid >> 6;
  const int jl = lane & 31, hi = lane >> 5;
  const int it = w >> 1, vt = w & 1, ws = w & 1;
  float* sm = (float*)smem + it * (SBUF + 2048);
  float* slw = sm + SBUF; float* so = slw + 1024;
  const float* lwp = p.rw_lnx_w + layer * RWW; const float* lbp = p.rw_lnx_b + layer * RWW; const float* rkp = p.rw_r_k + layer * RWW;
  constexpr int TQ = 2 * SC;
  for (int quad = blockIdx.x; quad < NB * NH * (T / TQ); quad += gridDim.x) {
    const int bh = quad / (T / TQ), tb = quad % (T / TQ);
    const int d = it >> 1, kch = 2 * tb + (it & 1), c = d ? (NCH - 1 - kch) : kch;
    const int h = bh % NH, b = bh / NH, scan = bh * 2 + d;
    const float kkc = p.rw_k_k[layer * RWW + h * 64 + lane], kac = p.rw_k_a[layer * RWW + h * 64 + lane];
    u16* Od = p.O2 + (size_t)d * NTOK * RWW;
    f32x16s acc[2];
    {
      const float* Sg = p.SS + ((size_t)scan * NCH + c) * 4096 + (size_t)(32 * vt + jl) * 64;
#pragma unroll
      for (int tk = 0; tk < 2; ++tk)
#pragma unroll
        for (int q = 0; q < 4; ++q) {
          const f32x4 sv = *(const f32x4*)(Sg + 32 * tk + 8 * q + 4 * hi);
#pragma unroll
          for (int e = 0; e < 4; ++e) acc[tk][4 * q + e] = sv[e];
        }
    }
    ScanRegsN<NI> g;
    scan_load_n<NI>(p, b, h, d, c * SC, lane, ws, g);
    for (int sub = 0; sub < SC / 16; ++sub) {
      const int n0 = c * SC + sub * 16;
      __syncthreads();
      scan_put_n<NI>(g, kkc, kac, sm, slw, lane, ws);
      __syncthreads();
      if (sub + 1 < SC / 16) scan_load_n<NI>(p, b, h, d, n0 + 16, lane, ws, g);
      const float* vrow = sm + 4096 + 32 * vt + jl;
      f32x4 kc[8]; scan_ld8(kc, sm, hi);
      float a0 = sm[1024 + hi * 1024 + jl], a1 = sm[1024 + hi * 1024 + 32 + jl], vc = vrow[0];
#pragma unroll 4
      for (int j = 0; j < 16; ++j) {
        const int jn = (j + 1) & 15;
        f32x4 kn[8]; scan_ld8(kn, sm + jn * 64, hi);
        const float an0 = sm[1024 + hi * 1024 + jn * 64 + jl], an1 = sm[1024 + hi * 1024 + jn * 64 + 32 + jl], vn = vrow[jn * 64];
        SBAR();
        const float sa = scan_dot8(acc, kc);
        const float bop = hi ? vc : sa;
        acc[0] = __builtin_amdgcn_mfma_f32_32x32x2f32(a0, bop, acc[0], 0, 0, 0);
        acc[1] = __builtin_amdgcn_mfma_f32_32x32x2f32(a1, bop, acc[1], 0, 0, 0);
        f32x4 rc[8]; scan_ld8(rc, sm + 3072 + j * 64, hi);
        SBAR();
        const float o = scan_dot8(acc, rc);
        if (hi == 0) so[j * 64 + 32 * vt + jl] = o;
        SBAR();
#pragma unroll
        for (int i = 0; i < 8; ++i) kc[i] = kn[i];
        a0 = an0; a1 = an1; vc = vn;
      }
#pragma unroll
      for (int tk = 0; tk < 2; ++tk)
#pragma unroll
        for (int q = 0; q < 4; ++q) {
          const f32x4 pv = *(const f32x4*)(sm + 5120 + 32 * tk + 8 * q + 4 * hi);
#pragma unroll
          for (int e = 0; e < 4; ++e) acc[tk][4 * q + e] *= pv[e];
        }
      __syncthreads();
#pragma unroll
      for (int jj = 0; jj < 8; ++jj) {
        const int j = ws + 2 * jj; const int n = n0 + j; const int t = d ? (T - 1 - n) : n;
        Od[((size_t)(b * T + t)) * RWW + h * 64 + lane] = f2bf(so[j * 64 + lane]);
      }
    }
    asm volatile("s_waitcnt vmcnt(0)" ::: "memory");
    __syncthreads();
    {
      const int ch = h * 64 + lane;
      const float plw = lwp[ch], plb = lbp[ch], prk = rkp[ch];
      for (int i0 = 0; i0 < TQ / 8; i0 += 2) {
        float o[2], k[2], r[2], vv[2], a0[2], a1[2], gg[2];
#pragma unroll
        for (int u = 0; u < 2; ++u) {
          const size_t off = (size_t)(b * T + tb * TQ + w * (TQ / 8) + i0 + u) * RWW + ch;
          o[u] = bf2f(p.O2[off]) + bf2f(p.O2[(size_t)NTOK * RWW + off]);
          k[u] = p.K[off]; r[u] = p.R[off]; vv[u] = p.V[off];
          a0[u] = bf2f(p.AA[off]); a1[u] = bf2f(p.AA[(size_t)NTOK * RWW + off]); gg[u] = bf2f(p.G[off]);
        }
#pragma unroll
        for (int u = 0; u < 2; ++u) {
          const float mean = wave_sum(o[u]) * (1.f / 64);
          const float dv = o[u] - mean;
          const float var = wave_sum(dv * dv) * (1.f / 64);
          const float kb = 0.5f * (k[u] * (1.f + (a0[u] - 1.f) * kac) + k[u] * (1.f + (a1[u] - 1.f) * kac));
          const float sb = wave_sum(r[u] * kb * prk);
          const float on_ = dv * frsq(var + GN_EPS) * plw + plb;
          p.H[(size_t)(b * T + tb * TQ + w * (TQ / 8) + i0 + u) * DM + ch] = f2bf((on_ + sb * vv[u]) * gg[u]);
        }
      }
    }
  }
}
DI void ph_mla_norm(const P& p, int layer) {
  const int tid_ = tidx(); const int lane = tid_ & 63, w = tid_ >> 6;
  const float* on = p.mla_o_norm + layer * 512;
  const f32x4 g0 = *(const f32x4*)(on + lane * 4), g1 = *(const f32x4*)(on + 256 + lane * 4);
  for (int tok = blockIdx.x * 8 + w; tok < NTOK; tok += gridDim.x * 8) {
    const float* ao = p.AO + (size_t)tok * 512;
    const f32x4 v0 = *(const f32x4*)(ao + lane * 4), v1 = *(const f32x4*)(ao + 256 + lane * 4);
    float ss = v0[0] * v0[0] + v0[1] * v0[1] + v0[2] * v0[2] + v0[3] * v0[3] + v1[0] * v1[0] + v1[1] * v1[1] + v1[2] * v1[2] + v1[3] * v1[3];
    ss = wave_sum(ss);
    const float rstd = frsq(ss * (1.f / 512) + NORM_EPS);
    *(u32x2*)(p.H + (size_t)tok * DM + 512 + lane * 4) = u32x2{pk2(v0[0] * rstd * g0[0], v0[1] * rstd * g0[1]), pk2(v0[2] * rstd * g0[2], v0[3] * rstd * g0[3])};
    *(u32x2*)(p.H + (size_t)tok * DM + 768 + lane * 4) = u32x2{pk2(v1[0] * rstd * g1[0], v1[1] * rstd * g1[1]), pk2(v1[2] * rstd * g1[2], v1[3] * rstd * g1[3])};
  }
}


DI void ph_mixfinish(const P& p, int layer) {
  const int tid_ = tidx(); const int lane = tid_ & 63, w = tid_ >> 6;
  const float* lw = p.rw_lnx_w + layer * RWW; const float* lb = p.rw_lnx_b + layer * RWW;
  const float* kac = p.rw_k_a + layer * RWW; const float* rk = p.rw_r_k + layer * RWW;
  const float* on = p.mla_o_norm + layer * 512;
  float plw[8], plb[8], pka[8], prk[8];
#pragma unroll
  for (int h = 0; h < NH; ++h) { int c = h * 64 + lane; plw[h] = lw[c]; plb[h] = lb[c]; pka[h] = kac[c]; prk[h] = rk[c]; }
  const f32x4 g0 = *(const f32x4*)(on + lane * 4), g1 = *(const f32x4*)(on + 256 + lane * 4);
  for (int tok = blockIdx.x * 8 + w; tok < NTOK; tok += gridDim.x * 8) {
    float o[8], k[8], r[8], vv[8], a0[8], a1[8], gg[8];
#pragma unroll
    for (int h = 0; h < NH; ++h) {
      size_t off = (size_t)tok * RWW + h * 64 + lane;
      o[h] = bf2f(p.O2[off]) + bf2f(p.O2[(size_t)NTOK * RWW + off]);
      k[h] = p.K[off]; r[h] = p.R[off]; vv[h] = p.V[off];
      a0[h] = bf2f(p.AA[off]); a1[h] = bf2f(p.AA[(size_t)NTOK * RWW + off]); gg[h] = bf2f(p.G[off]);
    }
    const float* ao = p.AO + (size_t)tok * 512;
    const f32x4 v0 = *(const f32x4*)(ao + lane * 4), v1 = *(const f32x4*)(ao + 256 + lane * 4);
    float mean[8], var[8], sb[8];
#pragma unroll
    for (int h = 0; h < NH; ++h) mean[h] = wave_sum(o[h]) * (1.f / 64);
#pragma unroll
    for (int h = 0; h < NH; ++h) { float dv = o[h] - mean[h]; o[h] = dv; var[h] = wave_sum(dv * dv) * (1.f / 64); }
#pragma unroll
    for (int h = 0; h < NH; ++h) {
      float kb = 0.5f * (k[h] * (1.f + (a0[h] - 1.f) * pka[h]) + k[h] * (1.f + (a1[h] - 1.f) * pka[h]));
      sb[h] = wave_sum(r[h] * kb * prk[h]);
    }
#pragma unroll
    for (int h = 0; h < NH; ++h) {
      float on_ = o[h] * frsq(var[h] + GN_EPS) * plw[h] + plb[h];
      float y = (on_ + sb[h] * vv[h]) * gg[h];
      p.H[(size_t)tok * DM + h * 64 + lane] = f2bf(y);
    }
    float ss = v0[0] * v0[0] + v0[1] * v0[1] + v0[2] * v0[2] + v0[3] * v0[3] + v1[0] * v1[0] + v1[1] * v1[1] + v1[2] * v1[2] + v1[3] * v1[3];
    ss = wave_sum(ss);
    float rstd = frsq(ss * (1.f / 512) + NORM_EPS);
    *(u32x2*)(p.H + (size_t)tok * DM + 512 + lane * 4) = u32x2{pk2(v0[0] * rstd * g0[0], v0[1] * rstd * g0[1]), pk2(v0[2] * rstd * g0[2], v0[3] * rstd * g0[3])};
    *(u32x2*)(p.H + (size_t)tok * DM + 768 + lane * 4) = u32x2{pk2(v1[0] * rstd * g1[0], v1[1] * rstd * g1[1]), pk2(v1[2] * rstd * g1[2], v1[3] * rstd * g1[3])};
  }
}

DI void ph_norm_router(const P& p, int layer, char* smem) {
  const int tid_ = tidx(); const int lane = tid_ & 63, w = tid_ >> 6;
  float* rtl = (float*)smem;
  float* hl = (float*)(smem + 65536) + w * 1024;
  const float* g = p.ffn_norm + layer * DM;
  const float* rt = p.router + (size_t)layer * DM * NE;
  __syncthreads();
#pragma unroll
  for (int i = 0; i < 8; ++i) *(f32x4*)(rtl + (tid_ + i * NTH) * 4) = *(const f32x4*)(rt + (tid_ + i * NTH) * 4);
  __syncthreads();
  const int cg = lane >> 2, eq = lane & 3;
  for (int tok = blockIdx.x * 8 + w; tok < NTOK; tok += gridDim.x * 8) {
    const f32x4* xr = (const f32x4*)(p.out + (size_t)tok * DM);
    f32x4 v[4]; float ss = 0.f;
#pragma unroll
    for (int j = 0; j < 4; ++j) { v[j] = xr[lane + 64 * j]; ss += v[j][0] * v[j][0] + v[j][1] * v[j][1] + v[j][2] * v[j][2] + v[j][3] * v[j][3]; }
    ss = wave_sum(ss);
    const float rstd = frsq(ss * (1.f / DM) + NORM_EPS);
#pragma unroll
    for (int j = 0; j < 4; ++j) {
      const int c0 = (lane + 64 * j) * 4;
      const f32x4 gg = *(const f32x4*)(g + c0);
      const f32x4 hv = v[j] * rstd * gg;
      *(u32x2*)(p.H + (size_t)tok * DM + c0) = u32x2{pk2(hv[0], hv[1]), pk2(hv[2], hv[3])};
      *(f32x4*)(hl + c0) = hv;
    }
    f32x4 acc = f32x4{0.f, 0.f, 0.f, 0.f};
#pragma unroll 16
    for (int i = 0; i < 64; ++i) {
      const float hv = hl[cg + 16 * i];
      const f32x4 r4 = *(const f32x4*)(rtl + (cg + 16 * i) * 16 + eq * 4);
      acc += hv * r4;
    }
#pragma unroll
    for (int e = 0; e < 4; ++e) {
      float a = acc[e];
      a += dpp_f<0x124>(a); a += dpp_f<0x128>(a);
      a = red_x32(red_x16(a));
      acc[e] = a;
    }
    float mx = fmaxf(fmaxf(acc[0], acc[1]), fmaxf(acc[2], acc[3]));
    mx = fmaxf(mx, dpp_f<0xB1>(mx)); mx = fmaxf(mx, dpp_f<0x4E>(mx));
    f32x4 ex; float se = 0.f;
#pragma unroll
    for (int e = 0; e < 4; ++e) { ex[e] = fexp(acc[e] - mx); se += ex[e]; }
    se = red_x2(red_x1(se));
    const float inv = frcp(se);
    const int b = tok / T, t = tok % T;
    if (lane < 4) {
#pragma unroll
      for (int e = 0; e < 4; ++e) p.AFF[((size_t)(b * NE + eq * 4 + e)) * T + t] = ex[e] * inv;
    }
  }
}

DI void ph_topk(const P& p, char* smem) {
  unsigned* hist = (unsigned*)smem;
  unsigned* sc = hist + 256;
  unsigned* bc = sc + 2048;
  const int tid = tidx();
  for (int item = blockIdx.x; item < NB * NE; item += gridDim.x) {
    const float* a = p.AFF + (size_t)item * T;
    unsigned key[16];
#pragma unroll
    for (int i = 0; i < 4; ++i) {
      uint4 v = *(const uint4*)(a + tid * 16 + i * 4);
      key[i * 4 + 0] = v.x; key[i * 4 + 1] = v.y; key[i * 4 + 2] = v.z; key[i * 4 + 3] = v.w;
    }
    unsigned prefix = 0, mask = 0, need = CAP;
    for (int pass = 0; pass < 4; ++pass) {
      int shift = 24 - 8 * pass;
      __syncthreads();
      if (tid < 256) hist[tid] = 0;
      __syncthreads();
#pragma unroll
      for (int i = 0; i < 16; ++i)
        if ((key[i] & mask) == prefix) atomicAdd(&hist[(key[i] >> shift) & 255u], 1u);
      __syncthreads();
      if (tid == 0) {
        unsigned cum = 0; int bsel = 0; unsigned nd = need;
        for (int bb = 255; bb >= 0; --bb) {
          unsigned hc = hist[bb];
          if (cum + hc >= need) { bsel = bb; nd = need - cum; break; }
          cum += hc;
        }
        bc[0] = prefix | ((unsigned)bsel << shift); bc[1] = nd;
      }
      __syncthreads();
      prefix = bc[0]; need = bc[1]; mask |= (255u << shift);
    }
    unsigned ngt = 0, neq = 0;
#pragma unroll
    for (int i = 0; i < 16; ++i) { ngt += key[i] > prefix; neq += key[i] == prefix; }
    __syncthreads();
    unsigned* sA = sc; unsigned* sB = sc + 512; unsigned* eA = sc + 1024; unsigned* eB = sc + 1536;
    sA[tid] = ngt; eA[tid] = neq;
    __syncthreads();
    for (int off = 1; off < NTH; off <<= 1) {
      unsigned x = sA[tid] + ((tid >= off) ? sA[tid - off] : 0u);
      unsigned y = eA[tid] + ((tid >= off) ? eA[tid - off] : 0u);
      sB[tid] = x; eB[tid] = y;
      __syncthreads();
      unsigned* tmp = sA; sA = sB; sB = tmp; tmp = eA; eA = eB; eB = tmp;
    }
    unsigned gt_excl = sA[tid] - ngt, eq_excl = eA[tid] - neq;
    unsigned gt_total = sA[NTH - 1];
    int* idx = p.IDX + (size_t)item * CAP; float* gate = p.GATE + (size_t)item * CAP;
#pragma unroll
    for (int i = 0; i < 16; ++i) {
      int slot = -1;
      if (key[i] > prefix) { slot = (int)gt_excl; ++gt_excl; }
      else if (key[i] == prefix) { if (eq_excl < need) slot = (int)(gt_total + eq_excl); ++eq_excl; }
      if (slot >= 0) {
        const int tokl = tid * 16 + i;
        idx[slot] = tokl; gate[slot] = __uint_as_float(key[i]);
        const int tokg = (item / NE) * T + tokl;
        const int pos = atomicAdd(&p.TCNT[tokg], 1);
        p.TLIST[(size_t)tokg * 16 + pos] = item * CAP + slot;
      }
    }
    __syncthreads();
  }
}

namespace g8 {
constexpr int BM = 256, BK = 64, HALF = 128, HTB = HALF * BK * 2, STAGE_BYTES = 8 * HTB, NXCD = 8, WGM = 8;
DI int lds_byte(int r, int c) { const int st = (r >> 4) * 2 + (c >> 5), rr = r & 15, cc = c & 31, ob = rr * 64 + cc * 2; return st * 1024 + (ob ^ (((ob >> 9) & 1) << 5)); }
DI void stage_rc(int b, int& R, int& C) { const int st = b / 1024, sb = b % 1024, swz = sb ^ (((sb >> 9) & 1) << 5); R = (st >> 1) * 16 + swz / 64; C = (st & 1) * 32 + (swz % 64) / 2; }
DI int perm32(int rho) { const int n = rho >> 4, i = rho & 15; return 8 * (i >> 2) + 4 * n + (i & 3); }
struct Unit { int pm, pn; };
struct Sched {
  int nM, nN, nwg, G, c;
  const char* A; const char* Bt; size_t a_tstep, b_tstep; int gdiv, gmod; size_t gstride;
  DI void init(int nM_, int nN_, int G_, int c_, const void* A_, const void* Bt_, int K) {
    nM = nM_; nN = nN_; nwg = nM * nN; G = G_; c = c_; A = (const char*)uni_ptr(A_); Bt = (const char*)uni_ptr(Bt_);
    a_tstep = (size_t)BM * K * 2; b_tstep = (size_t)BM * K * 2; gdiv = 1 << 30; gmod = 1; gstride = 0;
  }
  DI void group(int gdiv_, int gmod_, size_t gstride_) { gdiv = gdiv_; gmod = gmod_; gstride = gstride_; }
  DI bool next(int i, Unit& u) const {
    const long L = (long)i * G + c; if (L >= nwg) return false;
    int wgid = (int)L; { const int q = nwg / NXCD, r = nwg % NXCD, xcd = wgid % NXCD, off = wgid / NXCD; wgid = (xcd < r ? xcd * (q + 1) : r * (q + 1) + (xcd - r) * q) + off; }
    const int nig = WGM * nN, gid = wgid / nig, fm = gid * WGM, gsz = (nM - fm) < WGM ? (nM - fm) : WGM;
    u.pm = fm + ((wgid % nig) % gsz); u.pn = (wgid % nig) / gsz; return true;
  }
  DI const char* a_ptr(const Unit& u) const { return A + (size_t)u.pm * a_tstep; }
  DI const char* b_ptr(const Unit& u) const { return Bt + (size_t)((u.pm / gdiv) % gmod) * gstride + (size_t)u.pn * b_tstep; }
};
using Acc = f32x4[2][2][4][2];

template <class Epi, bool GATHER = false>
DI void gemm_phase(LAS unsigned char* lds, const int K, const Sched& S, const Epi& E, const int* gidx = nullptr, LAS unsigned* gtab = nullptr) {
  const int tid = tidx(), wid = __builtin_amdgcn_readfirstlane(tid >> 6), lane = tid & 63, wr = wid >> 2, wc = wid & 3, fr = lane & 15, fq = lane >> 4;
  const int nt = K / BK;
  unsigned voffA[2], voffB[2];
#pragma unroll
  for (int i = 0; i < 2; ++i) { int R, C; stage_rc(tid * 16 + i * 8192, R, C); const int Rb = Epi::PERM ? ((R & ~31) + perm32(R & 31)) : R;
    voffA[i] = GATHER ? (unsigned)(R | (C << 16)) : (unsigned)(R * K + C) * 2u; voffB[i] = (unsigned)(Rb * K + C) * 2u; }
  unsigned gc[2][2], gn[2][2];
  auto gget = [&](int ui_, unsigned (&g)[2][2]) {
    if constexpr (GATHER) {
      Unit u_; const bool ok = S.next(ui_, u_);
#pragma unroll
      for (int h = 0; h < 2; ++h)
#pragma unroll
        for (int i = 0; i < 2; ++i) {
          const int r = h * HALF + (int)(voffA[i] & 0xffffu); const unsigned cb = (voffA[i] >> 16) * 2u;
          if (ui_ < 16) g[h][i] = gtab[ui_ * 256 + r] + cb;
          else { const int row = (ok ? u_.pm : 0) * BM + r; g[h][i] = (unsigned)((row / (NE * CAP)) * T + gidx[row]) * (unsigned)K * 2u + cb; }
        }
      asm volatile("" : "+v"(g[0][0]), "+v"(g[0][1]), "+v"(g[1][0]), "+v"(g[1][1]));
    }
  };
  if constexpr (GATHER) {
    for (int i0 = 0; i0 < 16; i0 += 2) {
      Unit u_; const int i = i0 + (tid >> 8);
      if (S.next(i, u_)) { const int row = u_.pm * BM + (tid & 255); gtab[i * 256 + (tid & 255)] = (unsigned)((row / (NE * CAP)) * T + gidx[row]) * (unsigned)K * 2u; }
      if (!S.next(i0 + 2, u_)) break;
    }
    __syncthreads();
  }
  const size_t kstep = (size_t)(BK * 2);
  const size_t hstep = (size_t)HALF * K * 2;
  const unsigned ldsw = (unsigned)wid * 1024u;
  const int aoff = lds_byte(wr * 64 + fr, fq * 8), boff = lds_byte(wc * 32 + fr, fq * 8);
#define G8_SA(b, h) (((b) * 2 + (h)) * HTB)
#define G8_SB(b, h) ((4 + (b) * 2 + (h)) * HTB)
#define G8_STAGE(bufoff, gbase, voff) do { _Pragma("unroll") for (int _i = 0; _i < 2; ++_i) \
    __builtin_amdgcn_global_load_lds((const unsigned*)((const char*)(gbase) + (voff)[_i]), (LAS unsigned*)(lds + (bufoff) + ldsw + _i * 8192), 16, 0, 0); } while (0)
#define G8_STAGE_A(bufoff, base, h, kb, Gv) do { if constexpr (GATHER) { G8_STAGE(bufoff, S.A + (kb), Gv[h]); } else { G8_STAGE(bufoff, (base) + (h) * hstep + (kb), voffA); } } while (0)
#define G8_LDA(dst, b, h) do { _Pragma("unroll") for (int m = 0; m < 4; ++m) _Pragma("unroll") for (int k = 0; k < 2; ++k) dst[m][k] = *(const LAS bf16x8*)(lds + G8_SA(b, h) + aoff + m * 2048 + k * 1024); } while (0)
#define G8_LDB(dst, b, h) do { _Pragma("unroll") for (int n = 0; n < 2; ++n) _Pragma("unroll") for (int k = 0; k < 2; ++k) dst[n][k] = *(const LAS bf16x8*)(lds + G8_SB(b, h) + boff + n * 2048 + k * 1024); } while (0)
#define G8_MMA(ai, bj, At, Bt) do { __builtin_amdgcn_s_setprio(1); _Pragma("unroll") for (int m = 0; m < 4; ++m) _Pragma("unroll") for (int n = 0; n < 2; ++n) _Pragma("unroll") for (int k = 0; k < 2; ++k) \
    acc[ai][bj][m][n] = __builtin_amdgcn_mfma_f32_16x16x32_bf16(Bt[n][k], At[m][k], acc[ai][bj][m][n], 0, 0, 0); __builtin_amdgcn_s_setprio(0); } while (0)
#define G8_WAIT_V(n) asm volatile("s_waitcnt vmcnt(" #n ")" ::: "memory")
#define G8_WAIT_L(n) asm volatile("s_waitcnt lgkmcnt(" #n ")" ::: "memory")
#define G8_BAR __builtin_amdgcn_s_barrier()
#define G8_SCHED __builtin_amdgcn_sched_barrier(0)
  Unit cur, nxt; int ui = 0;
  if (!S.next(0, cur)) return;
  f32x4 acc[2][2][4][2];
#pragma unroll
  for (int a = 0; a < 2; ++a)
#pragma unroll
    for (int b = 0; b < 2; ++b)
#pragma unroll
      for (int m = 0; m < 4; ++m)
#pragma unroll
        for (int n = 0; n < 2; ++n) acc[a][b][m][n] = (f32x4){0.f, 0.f, 0.f, 0.f};
  bf16x8 At[4][2], B0[2][2], B1[2][2];
  const char* cA = S.a_ptr(cur); const char* cB = S.b_ptr(cur);
  gget(0, gc);
  G8_STAGE(G8_SB(0, 0), cB, voffB); G8_STAGE_A(G8_SA(0, 0), cA, 0, 0, gc); G8_STAGE(G8_SB(0, 1), cB + hstep, voffB); G8_STAGE_A(G8_SA(0, 1), cA, 1, 0, gc);
  if (wr == 1) G8_BAR;
  G8_WAIT_V(4); G8_BAR;
  G8_STAGE(G8_SB(1, 0), cB + kstep, voffB); G8_STAGE_A(G8_SA(1, 0), cA, 0, kstep, gc); G8_STAGE(G8_SB(1, 1), cB + hstep + kstep, voffB);
  G8_WAIT_V(6); G8_BAR;
  for (;;) {
    const bool has_next = S.next(ui + 1, nxt);
    const char* nA = has_next ? S.a_ptr(nxt) : cA; const char* nB = has_next ? S.b_ptr(nxt) : cB;
    gget(has_next ? ui + 1 : ui, gn);
    for (int t = 0; t < nt; t += 2) {
      const bool last = (t == nt - 2);
      const size_t k1 = (size_t)(t + 1) * kstep, k2 = last ? (size_t)0 : (size_t)(t + 2) * kstep, k3 = k2 + kstep;
      const char* u2 = last ? nA : cA; const char* b2 = (last ? nB : cB) + k2;
      const char* b3 = b2 + kstep;
      unsigned g2[2][2];
      if constexpr (GATHER) {
#pragma unroll
        for (int h = 0; h < 2; ++h)
#pragma unroll
          for (int i = 0; i < 2; ++i) g2[h][i] = last ? gn[h][i] : gc[h][i];
      }
      G8_LDB(B0, 0, 0); G8_SCHED; G8_LDA(At, 0, 0); G8_STAGE_A(G8_SA(1, 1), cA, 1, k1, gc);
      G8_WAIT_L(8); G8_BAR; G8_WAIT_L(0); G8_MMA(0, 0, At, B0); G8_BAR; G8_SCHED;
      G8_LDB(B1, 0, 1); G8_STAGE(G8_SB(0, 0), b2, voffB);
      G8_BAR; G8_WAIT_L(0); G8_MMA(0, 1, At, B1); G8_BAR;
      G8_LDA(At, 0, 1); G8_STAGE_A(G8_SA(0, 0), u2, 0, k2, g2);
      G8_BAR; G8_WAIT_L(0); G8_MMA(1, 0, At, B0); G8_BAR; G8_SCHED;
      G8_STAGE(G8_SB(0, 1), b2 + hstep, voffB);
      G8_WAIT_V(6); G8_BAR; G8_MMA(1, 1, At, B1); G8_BAR;
      G8_LDB(B0, 1, 0); G8_SCHED; G8_LDA(At, 1, 0); G8_STAGE_A(G8_SA(0, 1), u2, 1, k2, g2);
      G8_WAIT_L(8); G8_BAR; G8_WAIT_L(0); G8_MMA(0, 0, At, B0); G8_BAR; G8_SCHED;
      G8_LDB(B1, 1, 1); G8_STAGE(G8_SB(1, 0), b3, voffB);
      G8_BAR; G8_WAIT_L(0); G8_MMA(0, 1, At, B1); G8_BAR;
      G8_LDA(At, 1, 1); G8_STAGE_A(G8_SA(1, 0), u2, 0, k3, g2);
      G8_BAR; G8_WAIT_L(0); G8_MMA(1, 0, At, B0); G8_BAR; G8_SCHED;
      G8_STAGE(G8_SB(1, 1), b3 + hstep, voffB);
      G8_WAIT_V(6); G8_BAR; G8_MMA(1, 1, At, B1); G8_BAR;
    }
    {
      const int t2 = tidx(); const int w2 = __builtin_amdgcn_readfirstlane(t2 >> 6), l2 = t2 & 63;
      E(acc, cur, w2 >> 2, w2 & 3, l2 & 15, l2 >> 4);
    }
    if (!has_next) break;
#pragma unroll
    for (int a = 0; a < 2; ++a)
#pragma unroll
      for (int b = 0; b < 2; ++b)
#pragma unroll
        for (int m = 0; m < 4; ++m)
#pragma unroll
          for (int n = 0; n < 2; ++n) acc[a][b][m][n] = (f32x4){0.f, 0.f, 0.f, 0.f};
    cur = nxt; cA = nA; cB = nB; ++ui;
    if constexpr (GATHER) {
#pragma unroll
      for (int h = 0; h < 2; ++h)
#pragma unroll
        for (int i = 0; i < 2; ++i) gc[h][i] = gn[h][i];
    }
  }
  G8_WAIT_V(0);
  if (wr == 0) G8_BAR;
  G8_BAR;
#undef G8_SA
#undef G8_SB
#undef G8_STAGE
#undef G8_STAGE_A
#undef G8_LDA
#undef G8_LDB
#undef G8_MMA
#undef G8_WAIT_V
#undef G8_WAIT_L
#undef G8_BAR
#undef G8_SCHED
}

struct EpiZ {
  static constexpr bool PERM = false; float* Z;
  DI void operator()(const Acc& acc, const Unit& u, int wr, int wc, int fr, int fq) const {
    const int row0 = u.pm * BM + wr * 64 + fr, col0 = u.pn * BM + wc * 32 + 4 * fq;
#pragma unroll
    for (int ai = 0; ai < 2; ++ai)
#pragma unroll
      for (int m = 0; m < 4; ++m) { float* rowp = Z + (size_t)(row0 + ai * HALF + m * 16) * INC;
#pragma unroll
        for (int bj = 0; bj < 2; ++bj)
#pragma unroll
          for (int n = 0; n < 2; ++n) { const int col = col0 + bj * HALF + n * 16; if (col < INC) *(f32x4*)(rowp + col) = acc[ai][bj][m][n]; } }
  }
};
struct EpiRes {
  static constexpr bool PERM = false; const float* xs; float* xo;
  DI void operator()(const Acc& acc, const Unit& u, int wr, int wc, int fr, int fq) const {
    const int row0 = u.pm * BM + wr * 64 + fr, col0 = u.pn * BM + wc * 32 + 4 * fq;
#pragma unroll
    for (int ai = 0; ai < 2; ++ai)
#pragma unroll
      for (int m = 0; m < 4; ++m) { const size_t ro = (size_t)(row0 + ai * HALF + m * 16) * DM + col0;
#pragma unroll
        for (int bj = 0; bj < 2; ++bj)
#pragma unroll
          for (int n = 0; n < 2; ++n) { const size_t o = ro + bj * HALF + n * 16; *(f32x4*)(xo + o) = *(const f32x4*)(xs + o) + acc[ai][bj][m][n]; } }
  }
};
struct EpiSig {
  static constexpr bool PERM = true; u16* PG;
  DI void operator()(const Acc& acc, const Unit& u, int wr, int wc, int fr, int fq) const {
    const int row0 = u.pm * BM + wr * 64 + fr, col0 = u.pn * BM + wc * 32 + 8 * fq;
#pragma unroll
    for (int ai = 0; ai < 2; ++ai)
#pragma unroll
      for (int m = 0; m < 4; ++m) { u16* rowp = PG + (size_t)(row0 + ai * HALF + m * 16) * DM + col0;
#pragma unroll
        for (int bj = 0; bj < 2; ++bj) { const f32x4 v0 = acc[ai][bj][m][0], v1 = acc[ai][bj][m][1];
          u32x4 wv = {pk2(sigmoidf_(v0[0]), sigmoidf_(v0[1])), pk2(sigmoidf_(v0[2]), sigmoidf_(v0[3])), pk2(sigmoidf_(v1[0]), sigmoidf_(v1[1])), pk2(sigmoidf_(v1[2]), sigmoidf_(v1[3]))};
          *(u32x4*)(rowp + bj * HALF) = wv; } }
  }
};
struct EpiPle {
  static constexpr bool PERM = false; float* xo; const u16* PG;
  DI void operator()(const Acc& acc, const Unit& u, int wr, int wc, int fr, int fq) const {
    const int row0 = u.pm * BM + wr * 64 + fr, col0 = u.pn * BM + wc * 32 + 4 * fq;
#pragma unroll
    for (int ai = 0; ai < 2; ++ai)
#pragma unroll
      for (int m = 0; m < 4; ++m) { const size_t ro = (size_t)(row0 + ai * HALF + m * 16) * DM + col0;
#pragma unroll
        for (int bj = 0; bj < 2; ++bj)
#pragma unroll
          for (int n = 0; n < 2; ++n) { const size_t o = ro + bj * HALF + n * 16; const u32x2 g = *(const u32x2*)(PG + o);
            f32x4 gv = {__uint_as_float(g[0] << 16), __uint_as_float(g[0] & 0xffff0000u), __uint_as_float(g[1] << 16), __uint_as_float(g[1] & 0xffff0000u)};
            *(f32x4*)(xo + o) = *(const f32x4*)(xo + o) + acc[ai][bj][m][n] * gv; } }
  }
};
struct EpiSwi {
  static constexpr bool PERM = true; u16* HID;
  DI void operator()(const Acc& acc, const Unit& u, int wr, int wc, int fr, int fq) const {
    const int row0 = u.pm * BM + wr * 64 + fr, col0 = u.pn * HALF + wc * 32 + 8 * fq;
#pragma unroll
    for (int ai = 0; ai < 2; ++ai)
#pragma unroll
      for (int m = 0; m < 4; ++m) { u16* rowp = HID + (size_t)(row0 + ai * HALF + m * 16) * 1024 + col0;
        float h[8];
#pragma unroll
        for (int n = 0; n < 2; ++n)
#pragma unroll
          for (int j = 0; j < 4; ++j) { const float gt = acc[ai][0][m][n][j], up = acc[ai][1][m][n][j]; h[n * 4 + j] = gt * frcp(1.f + fexp(-gt)) * up; }
        *(u32x4*)rowp = u32x4{pk2(h[0], h[1]), pk2(h[2], h[3]), pk2(h[4], h[5]), pk2(h[6], h[7])}; }
  }
};
struct EpiYE {
  static constexpr bool PERM = true; u16* YE; const float* GATE;
  DI void operator()(const Acc& acc, const Unit& u, int wr, int wc, int fr, int fq) const {
    const int row0 = u.pm * BM + wr * 64 + fr, col0 = u.pn * BM + wc * 32 + 8 * fq;
#pragma unroll
    for (int ai = 0; ai < 2; ++ai)
#pragma unroll
      for (int m = 0; m < 4; ++m) { const int row = row0 + ai * HALF + m * 16; const float gt = GATE[row]; u16* rowp = YE + (size_t)row * 1024 + col0;
#pragma unroll
        for (int bj = 0; bj < 2; ++bj) { const f32x4 v0 = acc[ai][bj][m][0] * gt, v1 = acc[ai][bj][m][1] * gt;
          *(u32x4*)(rowp + bj * HALF) = u32x4{pk2(v0[0], v0[1]), pk2(v0[2], v0[3]), pk2(v1[0], v1[1]), pk2(v1[2], v1[3])}; } }
  }
};
}

DI void cvt_tile_T(const float* __restrict__ src, int ldsrc, int N, int K, u16* __restrict__ dst, int k0, int n0, int drow0, char* smem, int tid) {
  short* tl = (short*)smem;
  __syncthreads();
#pragma unroll
  for (int i = 0; i < 2; ++i) {
    int u = tid + i * NTH; int kr = u >> 4, nq = u & 15; int n = n0 + nq * 4;
    f32x4 v = f32x4{0.f, 0.f, 0.f, 0.f};
    if (n < N) v = *(const f32x4*)(src + (size_t)(k0 + kr) * ldsrc + n);
#pragma unroll
    for (int e = 0; e < 4; ++e) tl[(nq * 4 + e) * 72 + kr] = (short)f2bf(v[e]);
  }
  __syncthreads();
  { int n = tid >> 3, kc = tid & 7;
    *(u32x4*)(dst + (size_t)(drow0 + n) * K + k0 + kc * 8) = *(const u32x4*)(tl + n * 72 + kc * 8); }
}
constexpr int WIN_PAD = 2560;
DI void ph_cvt_small(const P& p, int layer, char* smem) {
  const int tid = tidx();
  const int t0 = 16 * 40, t1 = t0 + 256, t2 = t1 + 256, t3 = t2 + 64;
  for (int t = blockIdx.x; t < t3; t += gridDim.x) {
    if (t < t0) cvt_tile_T(p.w_in + (size_t)layer * DM * INC, INC, INC, DM, p.WIN, (t / 40) * 64, (t % 40) * 64, (t % 40) * 64, smem, tid);
    else if (t < t1) { int q = t - t0; cvt_tile_T(p.w_out + (size_t)layer * DM * DM, DM, DM, DM, p.WOUT, (q / 16) * 64, (q % 16) * 64, (q % 16) * 64, smem, tid); }
    else if (t < t2) { int q = t - t1; cvt_tile_T(p.ple_gate + (size_t)layer * DM * DM, DM, DM, DM, p.WPG, (q / 16) * 64, (q % 16) * 64, (q % 16) * 64, smem, tid); }
    else { int q = t - t2; cvt_tile_T(p.ple_proj + (size_t)layer * DPLE * DM, DM, DM, DPLE, p.WPP, (q / 16) * 64, (q % 16) * 64, (q % 16) * 64, smem, tid); }
  }
  const float* ps = p.p + (size_t)layer * NTOK * DPLE;
  for (int i = blockIdx.x * NTH + tid; i < NTOK * DPLE / 8; i += gridDim.x * NTH) {
    f32x4 a = *(const f32x4*)(ps + (size_t)i * 8), b = *(const f32x4*)(ps + (size_t)i * 8 + 4);
    *(u32x4*)(p.PB + (size_t)i * 8) = u32x4{pk2(a[0], a[1]), pk2(a[2], a[3]), pk2(b[0], b[1]), pk2(b[2], b[3])};
  }
}

struct CvtJob { const float* src; u16* dst; int k0, n0, drow0; };
DI bool cvt_job(const P& p, int layer, int t, CvtJob& j) {
  if (t >= NE * 3 * 128) return false;
  const int e = t / 384, r = t % 384, mat = r / 128, q = r % 128;
  j.k0 = (q / 8) * 64; j.n0 = (q % 8) * 128;
  const size_t eo = ((size_t)layer * NE + e) * 1024 * 1024;
  if (mat == 0) { j.src = p.exp_w_gate + eo; j.dst = p.EW1 + (size_t)e * 2048 * 1024; j.drow0 = (j.n0 >> 7) * 256; }
  else if (mat == 1) { j.src = p.exp_w_up + eo; j.dst = p.EW1 + (size_t)e * 2048 * 1024; j.drow0 = (j.n0 >> 7) * 256 + 128; }
  else { j.src = p.exp_w_down + eo; j.dst = p.EW2 + (size_t)e * 1024 * 1024; j.drow0 = j.n0; }
  return true;
}
DI void ph_cvt_experts(const P& p, int layer, char* smem, unsigned* ctr) {
  const int tid = tidx();
  short* tl = (short*)smem;
  int* sitem = (int*)(smem + 32768);
  __syncthreads();
  if (tid == 0) sitem[0] = (int)atomicAdd(ctr, 1u);
  __syncthreads();
  CvtJob cur; bool has = cvt_job(p, layer, sitem[0], cur);
  f32x4 v[4];
  const int kr = tid >> 5, nq = tid & 31;
  if (has) {
#pragma unroll
    for (int i = 0; i < 4; ++i) v[i] = *(const f32x4*)(cur.src + (size_t)(cur.k0 + kr + 16 * i) * 1024 + cur.n0 + nq * 4);
  }
  int par = 0;
  while (has) {
    if (tid == 0) sitem[1 + par] = (int)atomicAdd(ctr, 1u);
    __syncthreads();
#pragma unroll
    for (int i = 0; i < 4; ++i)
#pragma unroll
      for (int e = 0; e < 4; ++e) tl[(nq * 4 + e) * 72 + kr + 16 * i] = (short)f2bf(v[i][e]);
    __syncthreads();
    CvtJob nxt; const bool hn = cvt_job(p, layer, sitem[1 + par], nxt);
    if (hn) {
#pragma unroll
      for (int i = 0; i < 4; ++i) v[i] = *(const f32x4*)(nxt.src + (size_t)(nxt.k0 + kr + 16 * i) * 1024 + nxt.n0 + nq * 4);
    }
#pragma unroll
    for (int i = 0; i < 2; ++i) {
      int u = tid + i * NTH; int n = u >> 3, kc = u & 7;
      *(u32x4*)(cur.dst + (size_t)(cur.drow0 + n) * 1024 + cur.k0 + kc * 8) = *(const u32x4*)(tl + n * 72 + kc * 8);
    }
    cur = nxt; has = hn; par ^= 1;
  }
}
DI void ph_gather(const P& p) {
  const int tid_ = tidx(); const int lane = tid_ & 63, w = tid_ >> 6;
  for (int row = blockIdx.x * 8 + w; row < NB * NE * CAP; row += gridDim.x * 8) {
    const int b = row / (NE * CAP);
    const int tok = b * T + p.IDX[row];
    const u32x4* src = (const u32x4*)(p.H + (size_t)tok * DM);
    u32x4* dst = (u32x4*)(p.XE + (size_t)row * DM);
    u32x4 a = src[lane], c = src[lane + 64];
    dst[lane] = a; dst[lane + 64] = c;
  }
}
DI void ph_combine_norm(const P& p, int layer) {
  const int tid_ = tidx(); const int lane = tid_ & 63, w = tid_ >> 6;
  const float* g = p.ple_norm + layer * DM;
  for (int tok = blockIdx.x * 8 + w; tok < NTOK; tok += gridDim.x * 8) {
    f32x4* xr = (f32x4*)(p.out + (size_t)tok * DM);
    f32x4 v[4];
#pragma unroll
    for (int j = 0; j < 4; ++j) v[j] = xr[lane * 4 + j];
    const int cnt = p.TCNT[tok];
    for (int q = 0; q < cnt; ++q) {
      const int yrow = p.TLIST[(size_t)tok * 16 + q];
      const u32x4* yr = (const u32x4*)(p.YE + (size_t)yrow * DM + lane * 16);
      u32x4 a = yr[0], c = yr[1];
#pragma unroll
      for (int e = 0; e < 4; ++e) {
        v[e >> 1][(e & 1) * 2] += __uint_as_float(a[e] << 16); v[e >> 1][(e & 1) * 2 + 1] += __uint_as_float(a[e] & 0xffff0000u);
        v[2 + (e >> 1)][(e & 1) * 2] += __uint_as_float(c[e] << 16); v[2 + (e >> 1)][(e & 1) * 2 + 1] += __uint_as_float(c[e] & 0xffff0000u);
      }
    }
    float ss = 0.f;
#pragma unroll
    for (int j = 0; j < 4; ++j) { xr[lane * 4 + j] = v[j]; ss += v[j][0] * v[j][0] + v[j][1] * v[j][1] + v[j][2] * v[j][2] + v[j][3] * v[j][3]; }
    ss = wave_sum(ss);
    const float rstd = frsq(ss * (1.f / DM) + NORM_EPS);
    u32x4 o0, o1;
#pragma unroll
    for (int j = 0; j < 4; ++j) {
      f32x4 gg = *(const f32x4*)(g + lane * 16 + j * 4);
      unsigned lo = pk2(v[j][0] * rstd * gg[0], v[j][1] * rstd * gg[1]), hi = pk2(v[j][2] * rstd * gg[2], v[j][3] * rstd * gg[3]);
      if (j < 2) { o0[j * 2] = lo; o0[j * 2 + 1] = hi; } else { o1[(j - 2) * 2] = lo; o1[(j - 2) * 2 + 1] = hi; }
    }
    *(u32x4*)(p.H + (size_t)tok * DM + lane * 16) = o0; *(u32x4*)(p.H + (size_t)tok * DM + lane * 16 + 8) = o1;
  }
}

#define XB_TMO      128
#define XB_XCNT(j)  (256  + 64 * (j))
#define XB_XSUB(j)  (1280 + 64 * (j))
#define XB_XGEN(j)  (2304 + 64 * (j))
#define XB_TOP      3328
#define XB_TOPGEN   3392
#define XCD_BAR_WORDS 3456
#define XB_SPIN_CAP (1u << 20)
DI unsigned xb_ld(unsigned* p) { return __hip_atomic_load(p, __ATOMIC_RELAXED, __HIP_MEMORY_SCOPE_AGENT); }
DI unsigned xb_add(unsigned* p, unsigned v) { return __hip_atomic_fetch_add(p, v, __ATOMIC_RELAXED, __HIP_MEMORY_SCOPE_AGENT); }
DI unsigned xb_xcc_id() { return (unsigned)__builtin_amdgcn_s_getreg((3 << 11) | 20) & 0xFu; }
#define XB_SPIN(cond, bar) do { unsigned _sp = 0; while (cond) { __builtin_amdgcn_s_sleep(1); \
    if ((++_sp & 255u) == 0u) { if (xb_ld(&(bar)[XB_TMO])) break; if (_sp > XB_SPIN_CAP) { atomicAdd(&(bar)[XB_TMO], 1u); break; } } } } while (0)
struct XcdBarrier { unsigned* bar; unsigned x; volatile LAS unsigned* st; };
DI XcdBarrier xcd_barrier_post(unsigned* bar, volatile LAS unsigned* st) {
  XcdBarrier b; b.bar = bar; b.x = xb_xcc_id(); b.st = st;
  if (threadIdx.x == 0) (void)xb_add(&bar[XB_XCNT(b.x)], 1u);
  return b;
}
DI void xcd_barrier_complete(unsigned* bar, unsigned x, unsigned& nloc, unsigned& nx) {
  const unsigned G = gridDim.x * gridDim.y * gridDim.z;
  unsigned sum, cnt, mine, sp = 0u;
  for (;;) {
    sum = 0u; cnt = 0u; mine = 0u;
#pragma unroll
    for (unsigned j = 0; j < 16; ++j) { const unsigned c = xb_ld(&bar[XB_XCNT(j)]); sum += c; cnt += (c > 0u) ? 1u : 0u; mine = (j == x) ? c : mine; }
    if (sum == G) break;
    __builtin_amdgcn_s_sleep(1);
    if ((++sp & 255u) == 0u) { if (xb_ld(&bar[XB_TMO])) break; if (sp > XB_SPIN_CAP) { atomicAdd(&bar[XB_TMO], 1u); break; } }
  }
  nloc = mine > 0u ? mine : 1u; nx = cnt > 0u ? cnt : 1u;
}
DI void xcd_barrier(const XcdBarrier& b) {
  asm volatile("s_waitcnt vmcnt(0)" ::: "memory");
  __syncthreads();
  if (threadIdx.x == 0) {
    unsigned* bar = b.bar;
    __builtin_amdgcn_s_waitcnt(0);
    unsigned nloc = b.st[0], nx = b.st[1];
    if (nloc == 0u) { xcd_barrier_complete(bar, b.x, nloc, nx); b.st[0] = nloc; b.st[1] = nx; }
    const unsigned old = xb_add(&bar[XB_XSUB(b.x)], 1u);
    const unsigned gen = old / nloc;
    if (old + 1u == (gen + 1u) * nloc) {
      __builtin_amdgcn_fence(__ATOMIC_RELEASE, "agent");
      asm volatile("s_waitcnt vmcnt(0)" ::: "memory");
      const unsigned og = xb_add(&bar[XB_TOP], 1u);
      const unsigned tg = og / nx;
      if (og + 1u == (tg + 1u) * nx) xb_add(&bar[XB_TOPGEN], 1u);
      else XB_SPIN(xb_ld(&bar[XB_TOPGEN]) == tg, bar);
      __builtin_amdgcn_fence(__ATOMIC_ACQUIRE, "agent");
      xb_add(&bar[XB_XGEN(b.x)], 1u);
      asm volatile("s_waitcnt vmcnt(0)" ::: "memory");
    } else {
      XB_SPIN(xb_ld(&bar[XB_XGEN(b.x)]) == gen, bar);
      __builtin_amdgcn_fence(__ATOMIC_ACQUIRE, "agent");
      asm volatile("s_waitcnt vmcnt(0)" ::: "memory");
    }
  }
  __syncthreads();
}

#define TAKE(bytes) (ws + off); off += (((size_t)(bytes)) + 255) & ~(size_t)255
__host__ __device__ inline size_t fill_ws(P& p, char* ws) {
  size_t off = 0;
  char* regA = TAKE((size_t)NTOK * INC * 4);
  p.Z = (float*)regA;
  p.LW = (u16*)regA; p.AA = (u16*)(regA + (size_t)2 * NTOK * RWW * 2); p.G = (u16*)(regA + (size_t)4 * NTOK * RWW * 2);
  p.MC = (float*)(regA + (size_t)5 * NTOK * RWW * 2); p.NC = p.MC + (size_t)32 * NCH * 4096;
  p.HID = (u16*)regA;
  char* regB = TAKE((size_t)3 * NTOK * RWW * 4);
  p.R = (float*)regB; p.K = p.R + (size_t)NTOK * RWW; p.V = p.K + (size_t)NTOK * RWW;
  p.PG = (float*)regB;
  char* regC = TAKE((size_t)NTOK * (768 + 1024) * 4);
  p.QRAW = (float*)regC; p.KVRAW = p.QRAW + (size_t)NTOK * 768;
  p.AO = (float*)regC; p.O2 = (u16*)(p.AO + (size_t)NTOK * 512); p.SS = (float*)(p.O2 + (size_t)2 * NTOK * 512);
  p.TWD = (u16*)TAKE((size_t)2 * NTOK * 64 * 2); p.AD = (u16*)TAKE((size_t)2 * NTOK * 64 * 2);
  p.SGD = (u16*)TAKE((size_t)NTOK * 128 * 2); p.QDN = (u16*)TAKE((size_t)NTOK * 256 * 2);
  p.KVDN = (u16*)TAKE((size_t)NTOK * 128 * 2); p.KR = (float*)TAKE((size_t)NTOK * 32 * 4);
  p.ROPE = (float*)TAKE((size_t)NTOK * 32 * 4);
  p.Q = (u16*)TAKE((size_t)NTOK * NH * 96 * 2); p.Kc = (u16*)TAKE((size_t)NTOK * NH * 96 * 2);
  p.Vv = (u16*)TAKE((size_t)NTOK * NH * 64 * 2);
  p.H = (u16*)TAKE((size_t)NTOK * DM * 2);
  p.AFF = (float*)TAKE((size_t)NB * NE * T * 4);
  p.IDX = (int*)TAKE((size_t)NB * NE * CAP * 4);
  p.GATE = (float*)TAKE((size_t)NB * NE * CAP * 4);

  p.WIN = (u16*)TAKE((size_t)WIN_PAD * DM * 2); p.WOUT = (u16*)TAKE((size_t)DM * DM * 2); p.WPG = (u16*)TAKE((size_t)DM * DM * 2);
  p.WPP = (u16*)TAKE((size_t)DM * DPLE * 2); p.PB = (u16*)TAKE((size_t)NTOK * DPLE * 2);
  p.PGb = (u16*)regB;
  p.EW1 = (u16*)regB; p.EW2 = p.EW1 + (size_t)NE * 2048 * 1024;
  p.XE = (u16*)regA; p.HID = (u16*)(regA + (size_t)32 * 1024 * 1024 * 2);
  p.YE = (u16*)regC;
  p.TCNT = (int*)TAKE((size_t)NTOK * 4); p.TLIST = (int*)TAKE((size_t)NTOK * 16 * 4);
  p.CTR = (unsigned*)TAKE(256);
  p.BAR = (unsigned*)TAKE(XCD_BAR_WORDS * 4);
  return off;
}
#undef TAKE
constexpr int DSM_BYTES = g8::STAGE_BYTES + 64 + 16 * 256 * 4;
extern __shared__ __attribute__((aligned(16))) char dsm[];
struct PK { const void* in[31]; float* out; char* ws; };
DI void build_params(P& p, const PK& k) {
  p.x = (const float*)k.in[0]; p.p = (const float*)k.in[1]; p.pos = (const int*)k.in[2];
  p.attn_norm = (const float*)k.in[3]; p.w_in = (const float*)k.in[4]; p.rw_mu = (const float*)k.in[5];
  p.rw_w0 = (const float*)k.in[6]; p.rw_w_up = (const float*)k.in[7]; p.rw_a0 = (const float*)k.in[8];
  p.rw_a_up = (const float*)k.in[9]; p.rw_g_up = (const float*)k.in[10]; p.rw_k_k = (const float*)k.in[11];
  p.rw_k_a = (const float*)k.in[12]; p.rw_r_k = (const float*)k.in[13]; p.rw_lnx_w = (const float*)k.in[14];
  p.rw_lnx_b = (const float*)k.in[15]; p.mla_q_norm = (const float*)k.in[16]; p.mla_q_up = (const float*)k.in[17];
  p.mla_kv_norm = (const float*)k.in[18]; p.mla_kv_up = (const float*)k.in[19]; p.mla_o_norm = (const float*)k.in[20];
  p.w_out = (const float*)k.in[21]; p.ffn_norm = (const float*)k.in[22]; p.router = (const float*)k.in[23];
  p.exp_w_gate = (const float*)k.in[24]; p.exp_w_up = (const float*)k.in[25]; p.exp_w_down = (const float*)k.in[26];
  p.ple_norm = (const float*)k.in[27]; p.ple_proj = (const float*)k.in[28]; p.ple_gate = (const float*)k.in[29];
  p.final_norm = (const float*)k.in[30];
  p.out = k.out;
  (void)fill_ws(p, k.ws);
}
__global__ void __launch_bounds__(NTH) mega(PK pk) {
  P p; build_params(p, pk);
  char* smem = dsm;
  LAS unsigned char* glds = (LAS unsigned char*)dsm;
  uint4* xbw = (uint4*)(dsm + g8::STAGE_BYTES);
  cg::grid_group grid = cg::this_grid();
  if (threadIdx.x == 0) *xbw = make_uint4(0u, 0u, 0u, 0u);
  if (pk.ws == nullptr) grid.sync();
  const XcdBarrier xb = xcd_barrier_post(p.BAR, (volatile LAS unsigned*)xbw);
#define GSYNC() xcd_barrier(xb)
#ifndef PROBE_MASK
#define PROBE_MASK 0u
#endif
#if PROBE_MASK
  unsigned long long pt0 = __builtin_amdgcn_s_memrealtime();
#define PSYNC(id) do { GSYNC(); if (PROBE_MASK & (1u << (id))) { unsigned long long t1_ = __builtin_amdgcn_s_memrealtime(); unsigned long long dt_ = t1_ - pt0; \
    while (__builtin_amdgcn_s_memrealtime() - t1_ < dt_) __builtin_amdgcn_s_sleep(8); } pt0 = __builtin_amdgcn_s_memrealtime(); } while (0)
#else
#define PSYNC(id) GSYNC()
#endif
  for (int layer_ = 0; layer_ < NL; ++layer_) {
    int layer = layer_; asm volatile("" : "+s"(layer));
    if (layer_ == 0) ph_rope_table(p);
    ph_cvt_small(p, layer, smem);
    ph_norm(layer == 0 ? p.x : p.out, p.attn_norm + layer * DM, p.H);
    PSYNC(0);
    {
      g8::Sched S; S.init(NTOK / 256, WIN_PAD / 256, gridDim.x, bidx(), p.H, p.WIN, DM);
      g8::EpiZ E{p.Z};
      g8::gemm_phase(glds, DM, S, E);
    }
    PSYNC(1);
    ph_rwshift(p, layer);
    ph_mlaprep1(p, layer);
    PSYNC(2);
    for (int d = 0; d < 2; ++d) {
      u16* LW = p.LW + (size_t)d * NTOK * RWW; const float* w0 = p.rw_w0 + (layer * 2 + d) * RWW;
      ph_gemm<false>(p.TWD + (size_t)d * NTOK * 64, 64, p.rw_w_up + ((size_t)(layer * 2 + d)) * 64 * RWW, RWW, NTOK, RWW, 64, smem,
                     [&](int row, int col, const f32x4& v) { const f32x4 bb = *(const f32x4*)(w0 + col);
                       *(u32x2*)(LW + (size_t)row * RWW + col) = u32x2{pk2(-0.6065306597126334f * sigmoidf_(v[0] + bb[0]), -0.6065306597126334f * sigmoidf_(v[1] + bb[1])),
                                                                       pk2(-0.6065306597126334f * sigmoidf_(v[2] + bb[2]), -0.6065306597126334f * sigmoidf_(v[3] + bb[3]))}; }, (int)blockIdx.x, (int)gridDim.x);
      u16* AA = p.AA + (size_t)d * NTOK * RWW; const float* a0 = p.rw_a0 + (layer * 2 + d) * RWW;
      ph_gemm<false>(p.AD + (size_t)d * NTOK * 64, 64, p.rw_a_up + ((size_t)(layer * 2 + d)) * 64 * RWW, RWW, NTOK, RWW, 64, smem,
                     [&](int row, int col, const f32x4& v) { const f32x4 bb = *(const f32x4*)(a0 + col);
                       *(u32x2*)(AA + (size_t)row * RWW + col) = u32x2{pk2(sigmoidf_(v[0] + bb[0]), sigmoidf_(v[1] + bb[1])), pk2(sigmoidf_(v[2] + bb[2]), sigmoidf_(v[3] + bb[3]))}; }, (int)blockIdx.x, (int)gridDim.x);
    }
    PSYNC(3);
    ph_scan1(p, layer, smem);
    PSYNC(4);
    ph_scan2(p, smem);
    const bool split_ = gridDim.x >= 64;
    const int gw = split_ ? (int)blockIdx.x - 32 : (int)blockIdx.x, gstride = split_ ? (int)gridDim.x - 32 : (int)gridDim.x;
    if (gw >= 0)
    {
      u16* G = p.G;
      ph_gemm<false>(p.SGD, 128, p.rw_g_up + (size_t)layer * 128 * RWW, RWW, NTOK, RWW, 128, smem,
                     [&](int row, int col, const f32x4& v) { *(u32x2*)(G + (size_t)row * RWW + col) = u32x2{pk2(v[0], v[1]), pk2(v[2], v[3])}; }, gw, gstride);
      {
        u16* Qo = p.Q; const float* rope = p.ROPE;
        ph_gemm_t(p.QDN, 256, p.mla_q_up + (size_t)layer * 256 * 768, 768, NTOK, 768, 256, smem,
                  [&](const f32x4 (&acc)[4][4], int m0, int n0, int wm, int wn, int lq, int l15) {
          const float qs = 0.10206207261596577f * 1.4426950408889634f;
#pragma unroll
          for (int mi = 0; mi < 4; ++mi) {
            const int tok = m0 + wm * 64 + mi * 16 + l15; const int b = tok / T, t = tok % T;
#pragma unroll
            for (int ni = 0; ni < 4; ++ni) {
              const int col0 = n0 + wn * 64 + ni * 16; const int h = col0 / 96, c0 = col0 % 96;
              u16* qo = Qo + ((size_t)(b * NH + h) * T + t) * 96;
              const f32x4 u1 = acc[mi][ni];
              if (c0 < 64) *(u32x2*)(qo + c0 + lq * 4) = u32x2{pk2(u1[0] * qs, u1[1] * qs), pk2(u1[2] * qs, u1[3] * qs)};
              else if (c0 == 64) {
                const f32x4 u2 = acc[mi][(ni + 1) & 3];
                const f32x4 cA = *(const f32x4*)(rope + (size_t)tok * 32 + lq * 8), cB = *(const f32x4*)(rope + (size_t)tok * 32 + lq * 8 + 4);
                *(u32x2*)(qo + 64 + lq * 4) = u32x2{pk2((u1[0] * cA[0] - u2[0] * cA[1]) * qs, (u1[1] * cA[2] - u2[1] * cA[3]) * qs),
                                                    pk2((u1[2] * cB[0] - u2[2] * cB[1]) * qs, (u1[3] * cB[2] - u2[3] * cB[3]) * qs)};
                *(u32x2*)(qo + 80 + lq * 4) = u32x2{pk2((u1[0] * cA[1] + u2[0] * cA[0]) * qs, (u1[1] * cA[3] + u2[1] * cA[2]) * qs),
                                                    pk2((u1[2] * cB[1] + u2[2] * cB[0]) * qs, (u1[3] * cB[3] + u2[3] * cB[2]) * qs)};
              }
            }
          }
        }, (gw + gstride - 32 % gstride) % gstride, gstride);
      }
      {
        u16* Ko = p.Kc; u16* Vo = p.Vv;
        ph_gemm_t(p.KVDN, 128, p.mla_kv_up + (size_t)layer * 128 * 1024, 1024, NTOK, 1024, 128, smem,
                  [&](const f32x4 (&acc)[4][4], int m0, int n0, int wm, int wn, int lq, int l15) {
#pragma unroll
          for (int mi = 0; mi < 4; ++mi) {
            const int tok = m0 + wm * 64 + mi * 16 + l15; const int b = tok / T, t = tok % T;
#pragma unroll
            for (int ni = 0; ni < 4; ++ni) {
              const int col0 = n0 + wn * 64 + ni * 16; const int h = col0 >> 7, c0 = col0 & 127;
              const size_t rowi = (size_t)(b * NH + h) * T + t;
              const f32x4 v = acc[mi][ni];
              const u32x2 pv = u32x2{pk2(v[0], v[1]), pk2(v[2], v[3])};
              if (c0 < 64) *(u32x2*)(Ko + rowi * 96 + c0 + lq * 4) = pv;
              else *(u32x2*)(Vo + rowi * 64 + (c0 - 64) + lq * 4) = pv;
            }
          }
        }, (gw + gstride - 192 % gstride) % gstride, gstride);
      }
    }
    PSYNC(7);
    ph_attn(p, smem, p.CTR + layer);
    PSYNC(5);
    ph_mla_norm(p, layer);
    ph_scan3(p, layer, smem);
    PSYNC(6);
    {
      for (int i = blockIdx.x * NTH + tidx(); i < NTOK; i += gridDim.x * NTH) p.TCNT[i] = 0;
      g8::Sched S; S.init(NTOK / 256, DM / 256, gridDim.x, bidx(), p.H, p.WOUT, DM);
      g8::EpiRes E{(layer == 0) ? p.x : p.out, p.out};
      g8::gemm_phase(glds, DM, S, E);
    }
    PSYNC(8);
    ph_norm_router(p, layer, smem);
    PSYNC(9);
    ph_topk(p, smem);
    ph_cvt_experts(p, layer, smem, p.CTR + 4 + layer);
    PSYNC(10);
    {
      g8::Sched S; S.init(NB * NE * CAP / 256, 2048 / 256, gridDim.x, bidx(), p.H, p.EW1, DM);
      S.group(4, NE, (size_t)2048 * 1024 * 2);
      g8::EpiSwi E{p.HID};
      g8::gemm_phase<g8::EpiSwi, true>(glds, DM, S, E, p.IDX, (LAS unsigned*)(dsm + g8::STAGE_BYTES + 64));
    }
    PSYNC(12);
    {
      g8::Sched S; S.init(NB * NE * CAP / 256, DM / 256, gridDim.x, bidx(), p.HID, p.EW2, 1024);
      S.group(4, NE, (size_t)1024 * 1024 * 2);
      g8::EpiYE E{p.YE, p.GATE};
      g8::gemm_phase(glds, 1024, S, E);
    }
    PSYNC(13);
    ph_combine_norm(p, layer);
    PSYNC(16);
    {
      g8::Sched S; S.init(NTOK / 256, DM / 256, gridDim.x, bidx(), p.H, p.WPG, DM);
      g8::EpiSig E{p.PGb};
      g8::gemm_phase(glds, DM, S, E);
    }
    {
      g8::Sched S; S.init(NTOK / 256, DM / 256, gridDim.x, bidx(), p.PB, p.WPP, DPLE);
      g8::EpiPle E{p.out, p.PGb};
      g8::gemm_phase(glds, DPLE, S, E);
    }
    PSYNC(15);
  }
  ph_final_norm(p.out, p.final_norm);
}

extern "C" void kernel_launch(void* const* d_in, const int* in_sizes, int n_in, void* d_out, int out_size, void* d_ws,
                              size_t ws_size, hipStream_t stream) {
  (void)in_sizes; (void)n_in; (void)out_size;
  PK pk{};
  for (int i = 0; i < 31; ++i) pk.in[i] = d_in[i];
  pk.out = (float*)d_out; pk.ws = (char*)d_ws;
  P p{};
  const size_t off = fill_ws(p, (char*)d_ws);
  if (off > ws_size) { fprintf(stderr, "workspace too small: need %zu have %zu\n", off, ws_size); return; }
  static int grid_blocks = 0;
  if (!grid_blocks) {
    int dev = 0, cus = 0, per_cu = 0;
    hipGetDevice(&dev);
    hipDeviceGetAttribute(&cus, hipDeviceAttributeMultiprocessorCount, dev);
    hipFuncSetAttribute((const void*)mega, hipFuncAttributeMaxDynamicSharedMemorySize, DSM_BYTES);
    hipOccupancyMaxActiveBlocksPerMultiprocessor(&per_cu, mega, NTH, DSM_BYTES);
    if (per_cu > 1) per_cu = 1;
    grid_blocks = cus * per_cu;
  }
  hipMemsetAsync(p.CTR, 0, 256 + (size_t)XCD_BAR_WORDS * 4, stream);
  void* args[] = {&pk};
  hipError_t e = hipLaunchCooperativeKernel((void*)mega, dim3(grid_blocks), dim3(NTH), args, DSM_BYTES, stream);
  if (e != hipSuccess) fprintf(stderr, "cooperative launch failed: %s (grid %d)\n", hipGetErrorString(e), grid_blocks);
}
```

```cpp
#include <hip/hip_runtime.h>
#include <hip/hip_bf16.h>
#include <cstdio>
#include <cstdint>
#include <hip/hip_cooperative_groups.h>
namespace cg = cooperative_groups;

#define DI __device__ __forceinline__
#define LAS __attribute__((address_space(3)))

constexpr int NB = 2, T = 8192, NTOK = NB * T, DM = 1024, NL = 2;
constexpr int RWW = 512, RWC = 1920, INC = 2336;
constexpr int NH = 8;
constexpr int NE = 16, CAP = 1024;
constexpr int DPLE = 256;
constexpr int NTH = 512;
constexpr float NORM_EPS = 1e-6f, GN_EPS = 64e-5f;

using bf16x8 = __attribute__((ext_vector_type(8))) short;
using s16x4  = __attribute__((ext_vector_type(4))) short;
using f32x4  = __attribute__((ext_vector_type(4))) float;
using u32x4  = __attribute__((ext_vector_type(4))) unsigned;
using f32x2  = __attribute__((ext_vector_type(2))) float;
using u32x2  = __attribute__((ext_vector_type(2))) unsigned;
typedef __bf16 bf2_t __attribute__((ext_vector_type(2)));
typedef unsigned short u16;

DI unsigned pk2(float a, float b) { bf2_t v = {(__bf16)a, (__bf16)b}; return __builtin_bit_cast(unsigned, v); }
DI u16 f2bf(float a) { return (u16)(pk2(a, 0.f) & 0xffffu); }
DI float bf2f(u16 u) { return __uint_as_float(((unsigned)u) << 16); }
DI f32x4 ld4bf(const u16* q) { const u32x2 x = *(const u32x2*)q; return f32x4{__uint_as_float(x[0] << 16), __uint_as_float(x[0] & 0xffff0000u), __uint_as_float(x[1] << 16), __uint_as_float(x[1] & 0xffff0000u)}; }
DI const void* uni_ptr(const void* q) {
  unsigned long long v = (unsigned long long)q;
  unsigned lo = __builtin_amdgcn_readfirstlane((unsigned)v), hi = __builtin_amdgcn_readfirstlane((unsigned)(v >> 32));
  return (const void*)(((unsigned long long)hi << 32) | lo);
}
DI int tidx() { int t = threadIdx.x; asm volatile("" : "+v"(t)); return t; }
DI size_t hmx(int tok, int col) { const int b = tok / 8192, t = tok % 8192; return ((size_t)(b * 8 + (col >> 6)) * 8192 + t) * 64 + (col & 63); }
DI int bidx() { int b = blockIdx.x; asm volatile("" : "+s"(b)); return b; }
template <int CTRL> DI float dpp_f(float v) {
  return __int_as_float(__builtin_amdgcn_update_dpp(__float_as_int(v), __float_as_int(v), CTRL, 0xF, 0xF, true));
}
DI float red_x1(float v) { return v + dpp_f<0xB1>(v); }
DI float red_x2(float v) { return v + dpp_f<0x4E>(v); }
DI float red_x4(float v) { return v + dpp_f<0x141>(v); }
DI float red_x8(float v) { return v + dpp_f<0x140>(v); }
DI float red_x16(float v) { auto r = __builtin_amdgcn_permlane16_swap(__float_as_uint(v), __float_as_uint(v), false, false); return __uint_as_float(r[0]) + __uint_as_float(r[1]); }
DI float red_x32(float v) { auto r = __builtin_amdgcn_permlane32_swap(__float_as_uint(v), __float_as_uint(v), false, false); return __uint_as_float(r[0]) + __uint_as_float(r[1]); }
DI float red16(float v) { return red_x8(red_x4(red_x2(red_x1(v)))); }
DI float wave_sum(float v) { return red_x32(red_x16(red16(v))); }
DI float frcp(float x) { return __builtin_amdgcn_rcpf(x); }
DI float frsq(float x) { return __builtin_amdgcn_rsqf(x); }
DI float fexp(float x) { return __builtin_amdgcn_exp2f(x * 1.4426950408889634f); }
DI float sigmoidf_(float x) { return frcp(1.f + fexp(-x)); }
DI float ftanh(float x) { return 1.f - 2.f * frcp(1.f + fexp(2.f * x)); }
DI s16x4 tr_read(const short* p) {
  return __builtin_amdgcn_ds_read_tr16_b64_v4i16((LAS s16x4*)(p));
}

struct P {
  const float* x; const float* p; const int* pos;
  const float* attn_norm; const float* w_in; const float* rw_mu; const float* rw_w0; const float* rw_w_up;
  const float* rw_a0; const float* rw_a_up; const float* rw_g_up; const float* rw_k_k; const float* rw_k_a;
  const float* rw_r_k; const float* rw_lnx_w; const float* rw_lnx_b; const float* mla_q_norm; const float* mla_q_up;
  const float* mla_kv_norm; const float* mla_kv_up; const float* mla_o_norm; const float* w_out; const float* ffn_norm;
  const float* router; const float* exp_w_gate; const float* exp_w_up; const float* exp_w_down; const float* ple_norm;
  const float* ple_proj; const float* ple_gate; const float* final_norm;
  float* out;
  u16* Z;
  u16* LW;
  u16* AA;
  float* MC; float* NC;
  float* SS;
  u16*   G;
  u16*   HID;
  u16* R; u16* K; u16* V;
  float* PG;
  float* QRAW;
  float* KVRAW;
  u16* AO;
  u16* O2;
  u16* TWD; u16* AD; u16* SGD; u16* QDN; u16* KVDN; float* KR;
  float* ROPE;
  u16* Q; u16* Kc; u16* Vv;
  u16* H;
  float* AFF;
  int* IDX;
  float* GATE;
  u16* WIN; u16* WOUT; u16* WPG; u16* WPP; u16* PB;
  u16* XB;
  u16* PGb;
  u16* EW1; u16* EW2;
  u16* XE; u16* YE;
  int* TCNT; int* TLIST;
  unsigned* CTR;
  unsigned* BAR;
};

constexpr int GBM = 256, GBN = 128, GBK = 64;
constexpr int AS_STRIDE = 72, BS_STRIDE = 136;
constexpr int AS_BYTES = GBM * AS_STRIDE * 2;
constexpr int BS_BYTES = GBK * BS_STRIDE * 2;
constexpr int SMEM_BYTES = 57344;

struct GtNext { const char* A0; int n0; bool has; };
template <int MODE, class Epi>
DI void gemm_tile(const char* A0, size_t lda_b, const float* __restrict__ B, int ldb, int K, int n0, int Nvalid,
                  char* smem, u32x4 (&areg)[4], f32x4 (&breg)[4], bool preloaded, GtNext nx, Epi epi) {
  short* As = (short*)smem;
  short* Bs = (short*)(smem + AS_BYTES);
  const int tid = tidx(), lane = tid & 63, w = tid >> 6;
  const int wm = w >> 1, wn = w & 1;
  const int l15 = lane & 15, lq = lane >> 4;

  f32x4 acc[4][4];
#pragma unroll
  for (int i = 0; i < 4; ++i)
#pragma unroll
    for (int j = 0; j < 4; ++j) acc[i][j] = f32x4{0.f, 0.f, 0.f, 0.f};

#define GLOADX(A0_, n0_, kt_)                                                                        \
  {                                                                                                  \
    _Pragma("unroll") for (int i = 0; i < 4; ++i) {                                                  \
      const int u_ = tid + i * NTH;                                                                  \
      areg[i] = *(const u32x4*)((A0_) + (size_t)(u_ >> 3) * lda_b + (size_t)(u_ & 7) * 16 + (size_t)(kt_) * GBK * 2); \
    }                                                                                                \
    _Pragma("unroll") for (int i = 0; i < 4; ++i) {                                                  \
      const int u_ = tid + i * NTH; const int col_ = (n0_) + (u_ & 31) * 4;                          \
      if (col_ < Nvalid) breg[i] = *(const f32x4*)(B + (size_t)((u_ >> 5) + (kt_) * GBK) * ldb + col_); \
      else breg[i] = f32x4{0.f, 0.f, 0.f, 0.f};                                                      \
    }                                                                                                \
  }
  const int nk = K / GBK;
  if (!preloaded) GLOADX(A0, n0, 0)
  for (int kt = 0; kt < nk; ++kt) {
    __syncthreads();
#pragma unroll
    for (int i = 0; i < 4; ++i) {
      int u = tid + i * NTH; int row = u >> 3, kc = u & 7;
      *(u32x4*)(As + row * AS_STRIDE + kc * 8) = areg[i];
    }
#pragma unroll
    for (int i = 0; i < 4; ++i) {
      int u = tid + i * NTH; int k = u >> 5, nq = u & 31;
      u32x2 v = u32x2{pk2(breg[i][0], breg[i][1]), pk2(breg[i][2], breg[i][3])};
      *(u32x2*)(Bs + k * BS_STRIDE + nq * 4) = v;
    }
    __syncthreads();
    if (kt + 1 < nk) GLOADX(A0, n0, kt + 1)
    else if (nx.has) GLOADX(nx.A0, nx.n0, 0)
#pragma unroll
    for (int ks = 0; ks < 2; ++ks) {
      bf16x8 a[4], b[4];
#pragma unroll
      for (int mi = 0; mi < 4; ++mi)
        a[mi] = *(const bf16x8*)(As + (wm * 64 + mi * 16 + l15) * AS_STRIDE + ks * 32 + 8 * lq);
#pragma unroll
      for (int ni = 0; ni < 4; ++ni) {
        int col0 = wn * 64 + ni * 16;
        int kb = ks * 32 + 8 * lq; int q = l15 >> 2, pp = l15 & 3;
        s16x4 lo = tr_read(Bs + (kb + q) * BS_STRIDE + col0 + 4 * pp);
        s16x4 hi = tr_read(Bs + (kb + 4 + q) * BS_STRIDE + col0 + 4 * pp);
        b[ni] = __builtin_shufflevector(lo, hi, 0, 1, 2, 3, 4, 5, 6, 7);
      }
#pragma unroll
      for (int mi = 0; mi < 4; ++mi)
#pragma unroll
        for (int ni = 0; ni < 4; ++ni)
          acc[mi][ni] = __builtin_amdgcn_mfma_f32_16x16x32_bf16(b[ni], a[mi], acc[mi][ni], 0, 0, 0);
    }
  }
#undef GLOADX
  if constexpr (MODE == 2) { epi(acc, wm, wn, lq, l15); return; }
  else {
#pragma unroll
    for (int mi = 0; mi < 4; ++mi)
#pragma unroll
      for (int ni = 0; ni < 4; ++ni) {
        const int row = wm * 64 + mi * 16 + l15, col = n0 + wn * 64 + ni * 16 + lq * 4;
        if (col < Nvalid) epi(row, col, acc[mi][ni]);
      }
  }
}

DI f32x4 ldx4(const float* p) { return *(const f32x4*)p; }
DI f32x4 ldx4(const u16* p) { return ld4bf(p); }
template <class TX>
DI void ph_norm(const TX* __restrict__ X, const float* __restrict__ g, u16* __restrict__ Hout) {
  const int tid_ = tidx(); const int lane = tid_ & 63, w = tid_ >> 6;
  const int tstr = (int)gridDim.x * 8;
  f32x4 nx[4];
  { const int tok0 = (int)blockIdx.x * 8 + w;
    if (tok0 < NTOK) {
#pragma unroll
      for (int j = 0; j < 4; ++j) nx[j] = ldx4(X + (size_t)tok0 * DM + (lane + 64 * j) * 4); } }
  for (int tok = blockIdx.x * 8 + w; tok < NTOK; tok += tstr) {
    f32x4 v[4]; float ss = 0.f;
#pragma unroll
    for (int j = 0; j < 4; ++j) { v[j] = nx[j]; ss += v[j][0] * v[j][0] + v[j][1] * v[j][1] + v[j][2] * v[j][2] + v[j][3] * v[j][3]; }
    if (tok + tstr < NTOK) {
#pragma unroll
      for (int j = 0; j < 4; ++j) nx[j] = ldx4(X + (size_t)(tok + tstr) * DM + (lane + 64 * j) * 4);
    }
    ss = wave_sum(ss);
    const float rstd = frsq(ss * (1.f / DM) + NORM_EPS);
#pragma unroll
    for (int j = 0; j < 4; ++j) {
      const f32x4 o = v[j] * rstd * ((const f32x4*)g)[lane + 64 * j];
      *(u32x2*)(Hout + (size_t)tok * DM + (lane + 64 * j) * 4) = u32x2{pk2(o[0], o[1]), pk2(o[2], o[3])};
    }
  }
}

DI void ph_final_norm(const u16* __restrict__ X, const float* __restrict__ g, float* __restrict__ out) {
  const int tid_ = tidx(); const int lane = tid_ & 63, w = tid_ >> 6;
  const int tstr = (int)gridDim.x * 8;
  f32x4 nx[4];
  { const int tok0 = (int)blockIdx.x * 8 + w;
    if (tok0 < NTOK) {
#pragma unroll
      for (int j = 0; j < 4; ++j) nx[j] = ld4bf(X + (size_t)tok0 * DM + (lane + 64 * j) * 4); } }
  for (int tok = blockIdx.x * 8 + w; tok < NTOK; tok += tstr) {
    f32x4 v[4]; float ss = 0.f;
#pragma unroll
    for (int j = 0; j < 4; ++j) { v[j] = nx[j]; ss += v[j][0] * v[j][0] + v[j][1] * v[j][1] + v[j][2] * v[j][2] + v[j][3] * v[j][3]; }
    if (tok + tstr < NTOK) {
#pragma unroll
      for (int j = 0; j < 4; ++j) nx[j] = ld4bf(X + (size_t)(tok + tstr) * DM + (lane + 64 * j) * 4);
    }
    ss = wave_sum(ss);
    const float rstd = frsq(ss * (1.f / DM) + NORM_EPS);
#pragma unroll
    for (int j = 0; j < 4; ++j) ((f32x4*)(out + (size_t)tok * DM))[lane + 64 * j] = v[j] * rstd * ((const f32x4*)g)[lane + 64 * j];
  }
}

struct GtMap {
  int ntn, ntm, tfirst, tstride; bool xcd;
  DI void init(int ntn_, int ntm_, int tfirst_, int tstride_) {
    ntn = ntn_; ntm = ntm_; tfirst = tfirst_; tstride = tstride_; xcd = (tstride_ % 8 == 0) && (ntm_ % 8 == 0) && tstride_ >= 8;
  }
  DI bool at(int i, int& tm, int& tn) const {
    if (xcd) {
      const int x = tfirst & 7, e = (tfirst >> 3) + i * (tstride >> 3);
      if (e >= (ntm >> 3) * ntn) return false;
      tm = x + 8 * (e / ntn); tn = e % ntn; return true;
    }
    const int t = tfirst + i * tstride;
    if (t >= ntm * ntn) return false;
    tm = t / ntn; tn = t % ntn; return true;
  }
};
template <bool A_F32, class Epi>
DI void ph_gemm(const void* A, int lda, const float* B, int ldb, int M, int N, int K, char* smem, Epi epi, int tfirst, int tstride) {
  static_assert(!A_F32, "bf16 A only");
  GtMap mp; mp.init((N + GBN - 1) / GBN, M / GBM, tfirst, tstride);
  u32x4 areg[4]; f32x4 breg[4]; bool pre = false;
  int tm, tn;
  bool has = mp.at(0, tm, tn);
  for (int i = 0; has; ++i) {
    const int m0 = tm * GBM, n0 = tn * GBN;
    int tm2 = 0, tn2 = 0; const bool hn = mp.at(i + 1, tm2, tn2);
    const GtNext nx{(const char*)A + (size_t)(tm2 * GBM) * lda * 2, tn2 * GBN, hn};
    gemm_tile<0>((const char*)A + (size_t)m0 * lda * 2, (size_t)lda * 2, B, ldb, K, n0, N, smem, areg, breg, pre, nx,
                 [&](int row, int col, const f32x4& v) { epi(m0 + row, col, v); });
    pre = hn; has = hn; tm = tm2; tn = tn2;
    __syncthreads();
  }
}

template <class Epi>
DI void ph_gemm_t(const void* A, int lda, const float* B, int ldb, int M, int N, int K, char* smem, Epi epi, int tfirst, int tstride) {
  GtMap mp; mp.init((N + GBN - 1) / GBN, M / GBM, tfirst, tstride);
  u32x4 areg[4]; f32x4 breg[4]; bool pre = false;
  int tm, tn;
  bool has = mp.at(0, tm, tn);
  for (int i = 0; has; ++i) {
    const int m0 = tm * GBM, n0 = tn * GBN;
    int tm2 = 0, tn2 = 0; const bool hn = mp.at(i + 1, tm2, tn2);
    const GtNext nx{(const char*)A + (size_t)(tm2 * GBM) * lda * 2, tn2 * GBN, hn};
    gemm_tile<2>((const char*)A + (size_t)m0 * lda * 2, (size_t)lda * 2, B, ldb, K, n0, N, smem, areg, breg, pre, nx,
                 [&](const f32x4 (&acc)[4][4], int wm, int wn, int lq, int l15) { epi(acc, m0, n0, wm, wn, lq, l15); });
    pre = hn; has = hn; tm = tm2; tn = tn2;
    __syncthreads();
  }
}

DI void ph_rwshift(const P& p, int layer) {
  const int tid_ = tidx();
  const int per = (NTOK + (int)gridDim.x - 1) / (int)gridDim.x;
  const int t0 = (int)blockIdx.x * per, t1 = (t0 + per < NTOK) ? t0 + per : NTOK;
  if (tid_ < RWC / 4 && t0 < t1) {
    const int c = tid_ * 4;
    const f32x4 m = *(const f32x4*)(p.rw_mu + layer * RWC + c);
    const u16* zc = p.Z + c;
    const f32x4 zero = f32x4{0.f, 0.f, 0.f, 0.f};
    constexpr int U = 8;
    f32x4 w[U + 2];
    w[0] = (t0 > 0) ? ld4bf(zc + (size_t)(t0 - 1) * INC) : zero;
    w[1] = ld4bf(zc + (size_t)t0 * INC);
    u32x2 nr[U];
#pragma unroll
    for (int u = 0; u < U; ++u) { const int tn = t0 + u + 1; nr[u] = (tn < NTOK && tn <= t1) ? *(const u32x2*)(zc + (size_t)tn * INC) : u32x2{0u, 0u}; }
    for (int tb = t0; tb < t1; tb += U) {
#pragma unroll
      for (int u = 0; u < U; ++u)
        w[u + 2] = f32x4{__uint_as_float(nr[u][0] << 16), __uint_as_float(nr[u][0] & 0xffff0000u), __uint_as_float(nr[u][1] << 16), __uint_as_float(nr[u][1] & 0xffff0000u)};
      if (tb + U < t1) {
#pragma unroll
        for (int u = 0; u < U; ++u) { const int tn = tb + U + u + 1; nr[u] = (tn < NTOK && tn <= t1) ? *(const u32x2*)(zc + (size_t)tn * INC) : u32x2{0u, 0u}; }
      }
#pragma unroll
      for (int u = 0; u < U; ++u) {
        const int tok = tb + u;
        if (tok < t1) {
          const int t = tok % T;
          const f32x4 zm = (t > 0) ? w[u] : zero, zp = (t < T - 1) ? w[u + 2] : zero, z = w[u + 1];
          const f32x4 o = z + m * (0.5f * (zm + zp) - z);
          const u32x2 ob = u32x2{pk2(o[0], o[1]), pk2(o[2], o[3])};
          if (c < 512) *(u32x2*)(p.R + hmx(tok, c)) = ob;
          else if (c < 1024) *(u32x2*)(p.K + hmx(tok, c - 512)) = ob;
          else if (c < 1536) *(u32x2*)(p.V + hmx(tok, c - 1024)) = ob;
          else if (c < 1664) {
            const int d = (c - 1536) >> 6, l = (c - 1536) & 63;
            *(u32x2*)(p.TWD + ((size_t)d * NTOK + tok) * 64 + l) = u32x2{pk2(ftanh(o[0]), ftanh(o[1])), pk2(ftanh(o[2]), ftanh(o[3]))};
          } else if (c < 1792) {
            const int d = (c - 1664) >> 6, l = (c - 1664) & 63;
            *(u32x2*)(p.AD + ((size_t)d * NTOK + tok) * 64 + l) = u32x2{pk2(o[0], o[1]), pk2(o[2], o[3])};
          } else {
            const int l = c - 1792;
            *(u32x2*)(p.SGD + (size_t)tok * 128 + l) = u32x2{pk2(sigmoidf_(o[0]), sigmoidf_(o[1])), pk2(sigmoidf_(o[2]), sigmoidf_(o[3]))};
          }
        }
      }
      w[0] = w[U]; w[1] = w[U + 1];
    }
  }
}

DI void rope_cs(int pos, int i, float& cs, float& sn) {
  const int i3 = i & 3, i2 = i >> 2;
  const float c4 = (i3 == 0) ? 1.0f : (i3 == 1) ? 0.5623413251903491f : (i3 == 2) ? 0.31622776601683794f : 0.1778279410038923f;
  const float p10 = (i2 == 0) ? 1.0f : (i2 == 1) ? 0.1f : (i2 == 2) ? 0.01f : 0.001f;
  float inv = c4 * p10;
  float ang = (float)pos * inv;
  double rev = (double)ang * 0.15915494309189535;
  rev -= floor(rev);
  float rf = (float)rev;
  sn = __builtin_amdgcn_sinf(rf);
  cs = __builtin_amdgcn_cosf(rf);
}

DI void ph_rope_table(const P& p) {
  for (int i = blockIdx.x * NTH + tidx(); i < NTOK * 16; i += gridDim.x * NTH) {
    float cs, sn; rope_cs(p.pos[i >> 4], i & 15, cs, sn);
    *(f32x2*)(p.ROPE + (size_t)i * 2) = f32x2{cs, sn};
  }
}
DI void ph_mlaprep1(const P& p, int layer) {
  const int tid_ = tidx(); const int lane = tid_ & 63, w = tid_ >> 6;
  const f32x4 g = *(const f32x4*)(p.mla_q_norm + layer * 256 + lane * 4);
  const f32x2 g2 = *(const f32x2*)(p.mla_kv_norm + layer * 128 + lane * 2);
  const int per = (NTOK + (int)gridDim.x - 1) / (int)gridDim.x;
  const int t0 = (int)blockIdx.x * per, t1 = (t0 + per < NTOK) ? t0 + per : NTOK;
  constexpr int U = 4;
  struct In { u32x2 q; unsigned kv; u16 u1, u2; f32x2 csn; };
  auto ld = [&](int tb, In (&x)[U]) {
#pragma unroll
    for (int u = 0; u < U; ++u) {
      const int tok = (tb + u < t1) ? tb + u : t1 - 1;
      const u16* zr = p.Z + (size_t)tok * INC + RWC;
      x[u].q = *(const u32x2*)(zr + lane * 4); x[u].kv = *(const unsigned*)(zr + 256 + lane * 2);
      x[u].u1 = zr[384 + (lane & 15)]; x[u].u2 = zr[384 + 16 + (lane & 15)];
      x[u].csn = *(const f32x2*)(p.ROPE + (size_t)tok * 32 + (lane & 15) * 2);
    }
  };
  auto fin = [&](int tb, const In (&x)[U]) {
#pragma unroll
    for (int u = 0; u < U; ++u) {
      const int tok = tb + u;
      const f32x4 q = f32x4{__uint_as_float(x[u].q[0] << 16), __uint_as_float(x[u].q[0] & 0xffff0000u), __uint_as_float(x[u].q[1] << 16), __uint_as_float(x[u].q[1] & 0xffff0000u)};
      const f32x2 kv = f32x2{__uint_as_float(x[u].kv << 16), __uint_as_float(x[u].kv & 0xffff0000u)};
      const float ss = wave_sum(q[0] * q[0] + q[1] * q[1] + q[2] * q[2] + q[3] * q[3]);
      const float rstd = frsq(ss * (1.f / 256) + NORM_EPS);
      const float ss2 = wave_sum(kv[0] * kv[0] + kv[1] * kv[1]);
      const float rstd2 = frsq(ss2 * (1.f / 128) + NORM_EPS);
      if (tok < t1) {
        *(u32x2*)(p.QDN + (size_t)tok * 256 + lane * 4) = u32x2{pk2(q[0] * rstd * g[0], q[1] * rstd * g[1]), pk2(q[2] * rstd * g[2], q[3] * rstd * g[3])};
        *(unsigned*)(p.KVDN + (size_t)tok * 128 + lane * 2) = pk2(kv[0] * rstd2 * g2[0], kv[1] * rstd2 * g2[1]);
        if (lane < 32) {
          const float u1 = bf2f(x[u].u1), u2 = bf2f(x[u].u2);
          const u16 kk = (lane < 16) ? f2bf(u1 * x[u].csn[0] - u2 * x[u].csn[1]) : f2bf(u1 * x[u].csn[1] + u2 * x[u].csn[0]);
          const int bb = tok / T, tt = tok % T;
#pragma unroll
          for (int h = 0; h < NH; ++h) {
            u16* ko = p.Kc + ((size_t)(bb * NH + h) * T + tt) * 96 + 64;
            ko[lane] = kk;
          }
        }
      }
    }
  };
  In xa[U], xb[U];
  const int tb0 = t0 + w * U;
  if (tb0 < t1) ld(tb0, xa);
  for (int tb = tb0; tb < t1; tb += 16 * U) {
    if (tb + 8 * U < t1) ld(tb + 8 * U, xb);
    fin(tb, xa);
    if (tb + 8 * U < t1) {
      if (tb + 16 * U < t1) ld(tb + 16 * U, xa);
      fin(tb + 8 * U, xb);
    }
  }
}

DI void ph_mlafinish(const P& p) {
  const int tid_ = tidx(); const int lane = tid_ & 63, w = tid_ >> 6;
  const float qs = 0.10206207261596577f * 1.4426950408889634f;
  for (int tok = blockIdx.x * 8 + w; tok < NTOK; tok += gridDim.x * 8) {
    int b = tok / T, t = tok % T;
    float cs = 0.f, sn = 0.f;
    if (lane < 16) rope_cs(p.pos[tok], lane, cs, sn);
    const float* qr = p.QRAW + (size_t)tok * 768;
    const float* kvr = p.KVRAW + (size_t)tok * 1024;
    const float* kr = p.KR + (size_t)tok * 32;
#pragma unroll
    for (int h = 0; h < NH; ++h) {
      size_t row = ((size_t)(b * NH + h) * T + t);
      u16* qo = p.Q + row * 96; u16* ko = p.Kc + row * 96; u16* vo = p.Vv + row * 64;
      qo[lane] = f2bf(qr[h * 96 + lane] * qs);
      ko[lane] = f2bf(kvr[h * 128 + lane]);
      vo[lane] = f2bf(kvr[h * 128 + 64 + lane]);
      if (lane < 16) {
        float u1 = qr[h * 96 + 64 + lane], u2 = qr[h * 96 + 80 + lane];
        qo[64 + lane] = f2bf((u1 * cs - u2 * sn) * qs);
        qo[80 + lane] = f2bf((u1 * sn + u2 * cs) * qs);
      }
      if (lane < 32) ko[64 + lane] = f2bf(kr[lane]);
    }
  }
}

using f32x16 = __attribute__((ext_vector_type(16))) float;
#define SBAR() __builtin_amdgcn_sched_barrier(0)
constexpr int AT_KSTR = 104;
constexpr int AT_KBYTES = 64 * AT_KSTR * 2;
constexpr int AT_VBYTES = 64 * 64 * 2;
constexpr float AT_THR = 8.f;
DI int crow(int r, int hi) { return (r & 3) + 8 * (r >> 2) + 4 * hi; }
DI int v_st(int k, int c) { return ((k >> 3) * 2 + (c >> 5)) * 512 + ((k & 7) * 32 + (c & 31)) * 2; }
DI int v_rd_base(int lane) { return ((lane & 3) << 3) | (((lane >> 2) & 3) << 6) | (((lane >> 4) & 1) << 5) | (((lane >> 5) & 1) << 8); }
constexpr int v_rd_off(int d0, int ks, int half) { return d0 * 512 + ks * 2048 + half * 1024; }

DI void at_partialSM(f32x16& p0, f32x16& p1, float& m_reg, float& mn, float& alpha) {
  float pmax = p0[0];
#pragma unroll
  for (int r = 1; r < 16; ++r) pmax = fmaxf(pmax, p0[r]);
#pragma unroll
  for (int r = 0; r < 16; ++r) pmax = fmaxf(pmax, p1[r]);
  { auto rr = __builtin_amdgcn_permlane32_swap(__float_as_uint(pmax), __float_as_uint(pmax), false, false);
    pmax = fmaxf(__uint_as_float(rr[0]), __uint_as_float(rr[1])); }
  if (__builtin_expect(__all(pmax - m_reg <= AT_THR), 1)) { mn = m_reg; alpha = 1.f; }
  else { mn = fmaxf(m_reg, pmax); alpha = __builtin_amdgcn_exp2f(m_reg - mn); m_reg = mn; }
#pragma unroll
  for (int r = 0; r < 16; ++r) { p0[r] = p0[r] - mn; p1[r] = p1[r] - mn; }
#pragma unroll
  for (int r = 0; r < 16; ++r) p0[r] = __builtin_amdgcn_exp2f(p0[r]);
}
DI void at_partialSM_b(f32x16& p0, f32x16& p1, float& m_reg, f32x16& cb, float& alpha) {
  float pmax = p0[0];
#pragma unroll
  for (int r = 1; r < 16; ++r) pmax = fmaxf(pmax, p0[r]);
#pragma unroll
  for (int r = 0; r < 16; ++r) pmax = fmaxf(pmax, p1[r]);
  { auto rr = __builtin_amdgcn_permlane32_swap(__float_as_uint(pmax), __float_as_uint(pmax), false, false);
    pmax = fmaxf(__uint_as_float(rr[0]), __uint_as_float(rr[1])); }
  alpha = 1.f;
  if (__builtin_expect(!__all(pmax <= AT_THR), 0)) {
    const float dm = fmaxf(pmax, 0.f);
    alpha = __builtin_amdgcn_exp2f(-dm); m_reg += dm;
#pragma unroll
    for (int r = 0; r < 16; ++r) { p0[r] -= dm; p1[r] -= dm; cb[r] = -m_reg; }
  }
#pragma unroll
  for (int r = 0; r < 16; ++r) p0[r] = __builtin_amdgcn_exp2f(p0[r]);
}
DI void at_finishSM(f32x16& p0, f32x16& p1, float alpha, float& l_reg, bf16x8& pa0, bf16x8& pa1, bf16x8& pa2, bf16x8& pa3) {
#pragma unroll
  for (int r = 0; r < 16; ++r) p1[r] = __builtin_amdgcn_exp2f(p1[r]);
  float ps = 0;
#pragma unroll
  for (int r = 0; r < 16; ++r) ps += p0[r];
#pragma unroll
  for (int r = 0; r < 16; ++r) ps += p1[r];
  { auto rr = __builtin_amdgcn_permlane32_swap(__float_as_uint(ps), __float_as_uint(ps), false, false);
    ps = __uint_as_float(rr[0]) + __uint_as_float(rr[1]); }
  l_reg = l_reg * alpha + ps;
#define PK4(PP, BASE, OUT) do { u32x4 wv = {pk2(PP[BASE + 0], PP[BASE + 1]), pk2(PP[BASE + 2], PP[BASE + 3]),                \
    pk2(PP[BASE + 4], PP[BASE + 5]), pk2(PP[BASE + 6], PP[BASE + 7])}; OUT = __builtin_bit_cast(bf16x8, wv); } while (0)
  PK4(p0, 0, pa0); PK4(p0, 8, pa1); PK4(p1, 0, pa2); PK4(p1, 8, pa3);
#undef PK4
}
DI void at_qkt(f32x16& p0, f32x16& p1, const char* Kb, const bf16x8* qr, int r32, int hi, const f32x16& cb) {
#pragma unroll
  for (int d0 = 0; d0 < 6; ++d0) {
    bf16x8 b0 = *(const bf16x8*)(Kb + (r32 * AT_KSTR + d0 * 16 + hi * 8) * 2);
    bf16x8 b1 = *(const bf16x8*)(Kb + ((32 + r32) * AT_KSTR + d0 * 16 + hi * 8) * 2);
    p0 = __builtin_amdgcn_mfma_f32_32x32x16_bf16(b0, qr[d0], d0 == 0 ? cb : p0, 0, 0, 0);
    p1 = __builtin_amdgcn_mfma_f32_32x32x16_bf16(b1, qr[d0], d0 == 0 ? cb : p1, 0, 0, 0);
  }
}
template <int D0> DI void at_pv_one(f32x16& od, const char* vb, bf16x8 pa0, bf16x8 pa1, bf16x8 pa2, bf16x8 pa3) {
#define TRR(ks, half) tr_read((const short*)(vb + v_rd_off(D0, ks, half)))
  const s16x4 l0 = TRR(0, 0), h0 = TRR(0, 1), l1 = TRR(1, 0), h1 = TRR(1, 1), l2 = TRR(2, 0), h2 = TRR(2, 1), l3 = TRR(3, 0), h3 = TRR(3, 1);
#undef TRR
#define PKV(L, H) __builtin_shufflevector(L, H, 0, 1, 2, 3, 4, 5, 6, 7)
  od = __builtin_amdgcn_mfma_f32_32x32x16_bf16(PKV(l0, h0), pa0, od, 0, 0, 0);
  od = __builtin_amdgcn_mfma_f32_32x32x16_bf16(PKV(l1, h1), pa1, od, 0, 0, 0);
  od = __builtin_amdgcn_mfma_f32_32x32x16_bf16(PKV(l2, h2), pa2, od, 0, 0, 0);
  od = __builtin_amdgcn_mfma_f32_32x32x16_bf16(PKV(l3, h3), pa3, od, 0, 0, 0);
#undef PKV
}
DI void at_pv(f32x16* o, const char* vb, bf16x8 pa0, bf16x8 pa1, bf16x8 pa2, bf16x8 pa3) {
  at_pv_one<0>(o[0], vb, pa0, pa1, pa2, pa3); at_pv_one<1>(o[1], vb, pa0, pa1, pa2, pa3);
}

DI void attn_body(const u16* __restrict__ Qb, const u16* __restrict__ Kh, const u16* __restrict__ Vh, u16* __restrict__ Ob, char* lds, int tid) {
  const int wid = tid >> 6, lane = tid & 63, r32 = lane & 31, hi = lane >> 5;
  char* V_lds = lds; char* K_lds = lds + 2 * AT_VBYTES;
  float* wsp = (float*)(lds + 2 * AT_VBYTES + 2 * AT_KBYTES) + wid * 64; float* li_l = wsp; float* al_l = wsp + 32;
  float m_reg = -1e30f, l_reg = 0.f; f32x16 o[2]; bf16x8 qr[6];
  if (wid >= 4) __builtin_amdgcn_s_setprio(1);
#pragma unroll
  for (int r = 0; r < 16; ++r) { o[0][r] = 0.f; o[1][r] = 0.f; }
  const u16* Qw = Qb + (size_t)(wid * 32 + r32) * 96 + hi * 8;
#pragma unroll
  for (int d0 = 0; d0 < 6; ++d0) qr[d0] = *(const bf16x8*)(Qw + d0 * 16);
  const int kid1 = (tid < 256) ? tid + 512 : tid;
  const int kst0 = ((tid / 12) * AT_KSTR + (tid % 12) * 8) * 2, kst1 = ((kid1 / 12) * AT_KSTR + (kid1 % 12) * 8) * 2;
  const int vst = v_st(tid >> 3, (tid & 7) * 8);
  const char* vb0 = V_lds + v_rd_base(lane);
  u32x4 sk0[2], sk1[2], sv0[2];
#define SLOAD(i, k0) do { sk0[i] = *(const u32x4*)(Kh + (size_t)(k0) * 96 + tid * 8); sk1[i] = *(const u32x4*)(Kh + (size_t)(k0) * 96 + kid1 * 8); \
    sv0[i] = *(const u32x4*)(Vh + (size_t)(k0) * 64 + tid * 8); } while (0)
#define SWRITE(b, i) do { *(u32x4*)(K_lds + (b) * AT_KBYTES + kst0) = sk0[i]; if (tid < 256) *(u32x4*)(K_lds + (b) * AT_KBYTES + kst1) = sk1[i]; \
    *(u32x4*)(V_lds + (b) * AT_VBYTES + vst) = sv0[i]; } while (0)
#define SWAIT() asm volatile("s_waitcnt vmcnt(3)" ::: "memory")
#define RESC(a) do { if (__any((a) < 1.f)) { _Pragma("unroll") for (int r = 0; r < 16; ++r) { o[0][r] *= (a); o[1][r] *= (a); } } } while (0)
  f32x16 pA0, pA1, pB0, pB1; float mnA, alA, alB; bf16x8 pa0, pa1, pa2, pa3; constexpr int NT = T / 64;
  SLOAD(0, 0); SWRITE(0, 0); __syncthreads();
  f32x16 cb;
#pragma unroll
  for (int r = 0; r < 16; ++r) cb[r] = 0.f;
  at_qkt(pA0, pA1, K_lds, qr, r32, hi, cb); at_partialSM(pA0, pA1, m_reg, mnA, alA);
#pragma unroll
  for (int r = 0; r < 16; ++r) cb[r] = -m_reg;
  SLOAD(1, 64); SLOAD(0, 128);
  SWAIT(); SWRITE(1, 1); __syncthreads();
  for (int j = 1; j + 1 < NT; j += 2) {
    SBAR(); at_qkt(pB0, pB1, K_lds + AT_KBYTES, qr, r32, hi, cb);
    at_finishSM(pA0, pA1, alA, l_reg, pa0, pa1, pa2, pa3); SBAR();
    SLOAD(1, (j + 2) * 64); SBAR();
    at_pv(o, vb0, pa0, pa1, pa2, pa3); at_partialSM_b(pB0, pB1, m_reg, cb, alB);
    __syncthreads(); SWAIT(); SWRITE(0, 0);
    RESC(alB); __syncthreads();
    SBAR(); at_qkt(pA0, pA1, K_lds, qr, r32, hi, cb);
    at_finishSM(pB0, pB1, alB, l_reg, pa0, pa1, pa2, pa3); SBAR();
    if (j + 3 < NT) SLOAD(0, (j + 3) * 64); SBAR();
    at_pv(o, vb0 + AT_VBYTES, pa0, pa1, pa2, pa3); at_partialSM_b(pA0, pA1, m_reg, cb, alA);
    __syncthreads(); SWAIT(); SWRITE(1, 1);
    RESC(alA); __syncthreads();
  }
  SBAR(); at_qkt(pB0, pB1, K_lds + AT_KBYTES, qr, r32, hi, cb);
  at_finishSM(pA0, pA1, alA, l_reg, pa0, pa1, pa2, pa3); SBAR();
  at_pv(o, vb0, pa0, pa1, pa2, pa3); at_partialSM_b(pB0, pB1, m_reg, cb, alB);
  __syncthreads(); RESC(alB);
  at_finishSM(pB0, pB1, alB, l_reg, pa0, pa1, pa2, pa3); SBAR();
  at_pv(o, vb0 + AT_VBYTES, pa0, pa1, pa2, pa3);
  __builtin_amdgcn_s_setprio(0);
  {
    const float rl = __builtin_amdgcn_rcpf(l_reg);
    u16* Ow = Ob + (size_t)(wid * 32 + r32) * 512 + 4 * hi;
#pragma unroll
    for (int d0 = 0; d0 < 2; ++d0)
#pragma unroll
      for (int g = 0; g < 4; ++g)
        *(u32x2*)(Ow + 32 * d0 + 8 * g) = u32x2{pk2(o[d0][4 * g] * rl, o[d0][4 * g + 1] * rl), pk2(o[d0][4 * g + 2] * rl, o[d0][4 * g + 3] * rl)};
  }
#undef SLOAD
#undef SWRITE
#undef SWAIT
#undef RESC
}

DI void ph_attn(const P& p, char* smem, unsigned* ctr) {
  const int tid = tidx();
  int* sitem = (int*)(smem + SMEM_BYTES - 16);
  for (;;) {
    __syncthreads();
    if (tid == 0) *sitem = (int)atomicAdd(ctr, 1u);
    __syncthreads();
    const int item = *sitem;
    if (item >= NB * NH * (T / 256)) break;
    const int bh = item / (T / 256), qb = item % (T / 256);
    const int b = bh / NH, h = bh % NH;
    attn_body(p.Q + ((size_t)bh * T + qb * 256) * 96, p.Kc + (size_t)bh * T * 96, p.Vv + (size_t)bh * T * 64,
              p.AO + ((size_t)(b * T + qb * 256)) * 512 + h * 64, smem, tid);
  }
}

constexpr int SC = 256, NCH = T / SC;
constexpr int SBUF = 6208;
template <int NI> struct ScanRegsN { float k[2 * NI], r[2 * NI], v[2 * NI]; u16 lw[2 * NI], a[2 * NI]; };
template <int NI>
DI void scan_load_n(const P& p, int b, int h, int d, int n0, int lane, int ws, ScanRegsN<NI>& g) {
  constexpr int WPI = 8 / NI;
  const u16* LWd = p.LW + (size_t)d * NTOK * RWW;
  const u16* AAd = p.AA + (size_t)d * NTOK * RWW;
  const int ch = h * 64 + lane;
#pragma unroll
  for (int jj = 0; jj < 2 * NI; ++jj) {
    int n = n0 + ws + WPI * jj; int t = d ? (T - 1 - n) : n;
    size_t off = ((size_t)(b * NH + h) * T + t) * 64 + lane;
    g.k[jj] = bf2f(p.K[off]); g.r[jj] = bf2f(p.R[off]); g.v[jj] = bf2f(p.V[off]); g.lw[jj] = LWd[off]; g.a[jj] = AAd[off];
  }
}
template <int NI>
DI void scan_put_n(const ScanRegsN<NI>& g, float kkc, float kac, float* sm, float* slw, int lane, int ws) {
  constexpr int WPI = 8 / NI;
#pragma unroll
  for (int jj = 0; jj < 2 * NI; ++jj) slw[(ws + WPI * jj) * 64 + lane] = bf2f(g.lw[jj]);
  __syncthreads();
  float Lj[2 * NI];
#pragma unroll
  for (int jj = 0; jj < 2 * NI; ++jj) Lj[jj] = 0.f;
#pragma unroll
  for (int i = 0; i < 16; ++i) {
    const float x = slw[i * 64 + lane];
#pragma unroll
    for (int jj = 0; jj < 2 * NI; ++jj) Lj[jj] += (i <= ws + WPI * jj) ? x : 0.f;
  }
#pragma unroll
  for (int jj = 0; jj < 2 * NI; ++jj) {
    const int j = ws + WPI * jj;
    const float L = Lj[jj], lwj = bf2f(g.lw[jj]);
    const float Pt = fexp(L), Pm = fexp(L - lwj), iP = fexp(-L);
    const float kv = g.k[jj];
    const float kx = kv * kkc;
    const float nrm = __builtin_amdgcn_sqrtf(wave_sum(kx * kx));
    const float kkv = kx * frcp(fmaxf(nrm, 1e-12f));
    const float a = bf2f(g.a[jj]);
    sm[j * 64 + lane] = -kkv * Pm;
    const float bt = a * kkv * iP, dt = kv * (1.f + (a - 1.f) * kac) * iP, vt_ = g.v[jj];
    const unsigned bh = f2bf(bt), dh = f2bf(dt), vh = f2bf(vt_);
    const unsigned bl = f2bf(bt - bf2f((u16)bh)), dl = f2bf(dt - bf2f((u16)dh)), vl = f2bf(vt_ - bf2f((u16)vh));
    *(u32x2*)(sm + 1024 + 2 * (j * 64 + lane)) = u32x2{bh | (bl << 16), dh | (dl << 16)};
    sm[3072 + j * 64 + lane] = g.r[jj] * Pt;
    ((unsigned*)sm)[4096 + j * 64 + lane] = vh | (vh << 16);
    ((unsigned*)sm)[5184 + j * 64 + lane] = vl | (vl << 16);
    if (j == 15) sm[5120 + lane] = Pt;
  }
}
using f32x16s = __attribute__((ext_vector_type(16))) float;
DI void scan_ld8(f32x4 (&kv)[8], const float* vec, int hi) {
#pragma unroll
  for (int tk = 0; tk < 2; ++tk)
#pragma unroll
    for (int q = 0; q < 4; ++q) kv[tk * 4 + q] = *(const f32x4*)(vec + 32 * tk + 8 * q + 4 * hi);
}
DI void scan_update(f32x16s (&acc)[2], const u32x2& aw0, const u32x2& aw1, float sa, unsigned vw, int hi) {
  const unsigned H = pk2(sa, sa);
  const float lo = sa - __uint_as_float(H & 0xffff0000u);
  const unsigned L = pk2(lo, lo);
  const u32x2 bw = u32x2{hi ? L : H, vw};
  const s16x4 B = __builtin_bit_cast(s16x4, bw);
  acc[0] = __builtin_amdgcn_mfma_f32_32x32x8bf16_1k(__builtin_bit_cast(s16x4, aw0), B, acc[0], 0, 0, 0);
  acc[1] = __builtin_amdgcn_mfma_f32_32x32x8bf16_1k(__builtin_bit_cast(s16x4, aw1), B, acc[1], 0, 0, 0);
}
DI float scan_dot8(const f32x16s (&acc)[2], const f32x4 (&kv)[8]) {
  float pq[4] = {0.f, 0.f, 0.f, 0.f};
#pragma unroll
  for (int tk = 0; tk < 2; ++tk)
#pragma unroll
    for (int e = 0; e < 4; ++e)
#pragma unroll
      for (int q = 0; q < 4; ++q) { pq[q] = __builtin_fmaf(acc[tk][4 * q + e], kv[tk * 4 + q][e], pq[q]); if (q) asm("" : "+v"(pq[q])); }
  return red_x32((pq[0] + pq[1]) + (pq[2] + pq[3]));
}

DI void ph_scan1(const P& p, int layer, char* smem) {
  constexpr int NI = 2;
  const int tid = tidx(), lane = tid & 63, w = tid >> 6;
  const int jl = lane & 31, hi = lane >> 5;
  const int it = w >> 2, vt = w & 3, ws = w & 3;
  float* smi = (float*)smem + it * (2 * SBUF + 1024);
  float* slw = smi + 2 * SBUF;
  for (int pair = blockIdx.x; pair < 32 * NCH / 2; pair += gridDim.x) {
    const int item = pair * 2 + it; const int scan = item / NCH, c = item % NCH;
    const int d = scan & 1, h = (scan >> 1) % NH, b = scan / (2 * NH);
    const float kkc = p.rw_k_k[layer * RWW + h * 64 + lane], kac = p.rw_k_a[layer * RWW + h * 64 + lane];
    f32x16s acc[2];
#pragma unroll
    for (int tk = 0; tk < 2; ++tk)
#pragma unroll
      for (int r = 0; r < 16; ++r) acc[tk][r] = (32 * tk + (r & 3) + 8 * (r >> 2) + 4 * hi == 32 * vt + jl) ? 1.f : 0.f;
    ScanRegsN<NI> g;
    scan_load_n<NI>(p, b, h, d, c * SC, lane, ws, g);
    __syncthreads();
    scan_put_n<NI>(g, kkc, kac, smi, slw, lane, ws);
    __syncthreads();
    for (int sub = 0; sub < SC / 16; ++sub) {
      const float* sm = smi + (sub & 1) * SBUF;
      if (sub + 1 < SC / 16) scan_load_n<NI>(p, b, h, d, c * SC + (sub + 1) * 16, lane, ws, g);
      const unsigned* vrow = (const unsigned*)sm + (hi ? 5184 : 4096) + ((vt >= 2) ? 32 * (vt - 2) : 0) + jl;
      const u32x2* arow = (const u32x2*)(sm + 1024) + jl;
      f32x4 kc[8]; scan_ld8(kc, sm, hi);
      u32x2 a0 = arow[0], a1 = arow[32]; unsigned vc = vrow[0];
#pragma unroll 4
      for (int j = 0; j < 16; ++j) {
        const int jn = (j + 1) & 15;
        f32x4 kn[8]; scan_ld8(kn, sm + jn * 64, hi);
        const u32x2 an0 = arow[jn * 64], an1 = arow[jn * 64 + 32]; const unsigned vn = vrow[jn * 64];
        SBAR();
        const float sa = scan_dot8(acc, kc);
        scan_update(acc, a0, a1, sa, (vt >= 2) ? vc : 0u, hi);
        SBAR();
#pragma unroll
        for (int i = 0; i < 8; ++i) kc[i] = kn[i];
        a0 = an0; a1 = an1; vc = vn;
      }
#pragma unroll
      for (int tk = 0; tk < 2; ++tk)
#pragma unroll
        for (int q = 0; q < 4; ++q) {
          const f32x4 pv = *(const f32x4*)(sm + 5120 + 32 * tk + 8 * q + 4 * hi);
#pragma unroll
          for (int e = 0; e < 4; ++e) acc[tk][4 * q + e] *= pv[e];
        }
      if (sub + 1 < SC / 16) scan_put_n<NI>(g, kkc, kac, smi + ((sub + 1) & 1) * SBUF, slw, lane, ws);
      __syncthreads();
    }
    {
      const int v = 32 * vt + jl;
      float* dst = ((v < 64) ? p.MC : p.NC) + (((size_t)scan * NCH + c) * 64 + (v & 63)) * 64;
#pragma unroll
      for (int tk = 0; tk < 2; ++tk)
#pragma unroll
        for (int q = 0; q < 4; ++q)
          *(f32x4*)(dst + 32 * tk + 8 * q + 4 * hi) = f32x4{acc[tk][4 * q], acc[tk][4 * q + 1], acc[tk][4 * q + 2], acc[tk][4 * q + 3]};
    }
  }
}


DI void ph_scan2(const P& p, char* smem) {
  constexpr int LS = 72;
  u16* Sh = (u16*)smem; u16* Sl = Sh + 64 * LS; u16* Mh = Sl + 64 * LS; u16* Ml = Mh + 64 * LS;
  const int tid = tidx(), lane = tid & 63, w = tid >> 6;
  const int l15 = lane & 15, lq = lane >> 4;
  const int ti = w >> 1, tj0 = (w & 1) * 2;
  for (int scan = blockIdx.x; scan < 32; scan += gridDim.x) {
    const float* Mg = p.MC + (size_t)scan * NCH * 4096;
    const float* Ng = p.NC + (size_t)scan * NCH * 4096;
    float* Sg = p.SS + (size_t)scan * NCH * 4096;
    struct MN { f32x4 m0, m1, n[2]; };
    auto ldmn = [&](MN& r, int c) {
      const int cc = (c < NCH) ? c : (NCH - 1);
      r.m0 = *(const f32x4*)(Mg + (size_t)cc * 4096 + tid * 8); r.m1 = *(const f32x4*)(Mg + (size_t)cc * 4096 + tid * 8 + 4);
#pragma unroll
      for (int q = 0; q < 2; ++q)
#pragma unroll
        for (int r4 = 0; r4 < 4; ++r4) r.n[q][r4] = Ng[(size_t)cc * 4096 + (ti * 16 + lq * 4 + r4) * 64 + (tj0 + q) * 16 + l15];
    };
    f32x4 sacc[2];
    sacc[0] = f32x4{0.f, 0.f, 0.f, 0.f}; sacc[1] = sacc[0];
    auto step = [&](int c, const MN& r) {
      __syncthreads();
#pragma unroll
      for (int q = 0; q < 2; ++q)
#pragma unroll
        for (int r4 = 0; r4 < 4; ++r4) {
          const int row = ti * 16 + lq * 4 + r4, col = (tj0 + q) * 16 + l15;
          const float x = sacc[q][r4];
          Sg[(size_t)c * 4096 + row * 64 + col] = x;
          const u16 h = f2bf(x); Sh[row * LS + col] = h; Sl[row * LS + col] = f2bf(x - bf2f(h));
        }
      {
        const int mr = tid >> 3, mc = (tid & 7) * 8;
        float xh[8], xl[8];
#pragma unroll
        for (int i = 0; i < 8; ++i) { const float x = (i < 4) ? r.m0[i & 3] : r.m1[i & 3]; const float h = bf2f(f2bf(x)); xh[i] = h; xl[i] = x - h; }
        *(u32x4*)(Mh + mr * LS + mc) = u32x4{pk2(xh[0], xh[1]), pk2(xh[2], xh[3]), pk2(xh[4], xh[5]), pk2(xh[6], xh[7])};
        *(u32x4*)(Ml + mr * LS + mc) = u32x4{pk2(xl[0], xl[1]), pk2(xl[2], xl[3]), pk2(xl[4], xl[5]), pk2(xl[6], xl[7])};
      }
      f32x4 acc[2] = {r.n[0], r.n[1]};
      __syncthreads();
#pragma unroll
      for (int ks = 0; ks < 2; ++ks) {
        const bf16x8 ah = *(const bf16x8*)(Sh + (ti * 16 + l15) * LS + ks * 32 + 8 * lq);
        const bf16x8 al = *(const bf16x8*)(Sl + (ti * 16 + l15) * LS + ks * 32 + 8 * lq);
#pragma unroll
        for (int q = 0; q < 2; ++q) {
          const int kb = ks * 32 + 8 * lq, tq = l15 >> 2, tp = l15 & 3, co = (tj0 + q) * 16 + 4 * tp;
          const bf16x8 bh = __builtin_shufflevector(tr_read((const short*)Mh + (kb + tq) * LS + co), tr_read((const short*)Mh + (kb + 4 + tq) * LS + co), 0, 1, 2, 3, 4, 5, 6, 7);
          const bf16x8 bl = __builtin_shufflevector(tr_read((const short*)Ml + (kb + tq) * LS + co), tr_read((const short*)Ml + (kb + 4 + tq) * LS + co), 0, 1, 2, 3, 4, 5, 6, 7);
          acc[q] = __builtin_amdgcn_mfma_f32_16x16x32_bf16(ah, bh, acc[q], 0, 0, 0);
          acc[q] = __builtin_amdgcn_mfma_f32_16x16x32_bf16(ah, bl, acc[q], 0, 0, 0);
          acc[q] = __builtin_amdgcn_mfma_f32_16x16x32_bf16(al, bh, acc[q], 0, 0, 0);
        }
      }
      sacc[0] = acc[0]; sacc[1] = acc[1];
    };
    MN r0, r1, r2, r3;
    ldmn(r0, 0); ldmn(r1, 1); ldmn(r2, 2);
    for (int c = 0; c < NCH; c += 4) {
      ldmn(r3, c + 3); step(c, r0);
      ldmn(r0, c + 4); step(c + 1, r1);
      ldmn(r1, c + 5); step(c + 2, r2);
      ldmn(r2, c + 6); step(c + 3, r3);
    }
    __syncthreads();
  }
}

DI void ph_scan3(const P& p, int layer, char* smem) {
  constexpr int NI = 4;
  const int tid = tidx(), lane = tid & 63, w = tid >> 6;
  const int jl = lane & 31, hi = lane >> 5;
  const int it = w >> 1, vt = w & 1, ws = w & 1;
  float* sm = (float*)smem + it * (SBUF + 2048);
  float* slw = sm + SBUF; float* so = slw + 1024;
  const float* lwp = p.rw_lnx_w + layer * RWW; const float* lbp = p.rw_lnx_b + layer * RWW; const float* rkp = p.rw_r_k + layer * RWW;
  constexpr int TQ = 2 * SC;
  for (int quad = blockIdx.x; quad < NB * NH * (T / TQ); quad += gridDim.x) {
    const int bh = quad / (T / TQ), tb = quad % (T / TQ);
    const int d = it >> 1, kch = 2 * tb + (it & 1), c = d ? (NCH - 1 - kch) : kch;
    const int h = bh % NH, b = bh / NH, scan = bh * 2 + d;
    const float kkc = p.rw_k_k[layer * RWW + h * 64 + lane], kac = p.rw_k_a[layer * RWW + h * 64 + lane];
    u16* Od = p.O2 + (size_t)d * NTOK * RWW;
    f32x16s acc[2];
    {
      const float* Sg = p.SS + ((size_t)scan * NCH + c) * 4096 + (size_t)(32 * vt + jl) * 64;
#pragma unroll
      for (int tk = 0; tk < 2; ++tk)
#pragma unroll
        for (int q = 0; q < 4; ++q) {
          const f32x4 sv = *(const f32x4*)(Sg + 32 * tk + 8 * q + 4 * hi);
#pragma unroll
          for (int e = 0; e < 4; ++e) acc[tk][4 * q + e] = sv[e];
        }
    }
    ScanRegsN<NI> g;
    scan_load_n<NI>(p, b, h, d, c * SC, lane, ws, g);
    for (int sub = 0; sub < SC / 16; ++sub) {
      const int n0 = c * SC + sub * 16;
      __syncthreads();
      scan_put_n<NI>(g, kkc, kac, sm, slw, lane, ws);
      __syncthreads();
      if (sub + 1 < SC / 16) scan_load_n<NI>(p, b, h, d, n0 + 16, lane, ws, g);
      const unsigned* vrow = (const unsigned*)sm + (hi ? 5184 : 4096) + 32 * vt + jl;
      const u32x2* arow = (const u32x2*)(sm + 1024) + jl;
      f32x4 kc[8]; scan_ld8(kc, sm, hi);
      u32x2 a0 = arow[0], a1 = arow[32]; unsigned vc = vrow[0];
#pragma unroll 4
      for (int j = 0; j < 16; ++j) {
        const int jn = (j + 1) & 15;
        f32x4 kn[8]; scan_ld8(kn, sm + jn * 64, hi);
        const u32x2 an0 = arow[jn * 64], an1 = arow[jn * 64 + 32]; const unsigned vn = vrow[jn * 64];
        SBAR();
        const float sa = scan_dot8(acc, kc);
        scan_update(acc, a0, a1, sa, vc, hi);
        f32x4 rc[8]; scan_ld8(rc, sm + 3072 + j * 64, hi);
        SBAR();
        const float o = scan_dot8(acc, rc);
        if (hi == 0) so[j * 64 + 32 * vt + jl] = o;
        SBAR();
#pragma unroll
        for (int i = 0; i < 8; ++i) kc[i] = kn[i];
        a0 = an0; a1 = an1; vc = vn;
      }
#pragma unroll
      for (int tk = 0; tk < 2; ++tk)
#pragma unroll
        for (int q = 0; q < 4; ++q) {
          const f32x4 pv = *(const f32x4*)(sm + 5120 + 32 * tk + 8 * q + 4 * hi);
#pragma unroll
          for (int e = 0; e < 4; ++e) acc[tk][4 * q + e] *= pv[e];
        }
      __syncthreads();
#pragma unroll
      for (int jj = 0; jj < 8; ++jj) {
        const int j = ws + 2 * jj; const int n = n0 + j; const int t = d ? (T - 1 - n) : n;
        Od[((size_t)(b * NH + h) * T + t) * 64 + lane] = f2bf(so[j * 64 + lane]);
      }
    }
    asm volatile("s_waitcnt vmcnt(0)" ::: "memory");
    __syncthreads();
    {
      const int ch = h * 64 + lane;
      const float plw = lwp[ch], plb = lbp[ch], prk = rkp[ch];
      struct Tok { u16 o0, o1, a0, a1, gg; float k, r, vv; };
      auto ld = [&](int i, Tok (&t)[2]) {
#pragma unroll
        for (int u = 0; u < 2; ++u) {
          const size_t off = ((size_t)(b * NH + h) * T + tb * TQ + w * (TQ / 8) + i + u) * 64 + lane;
          t[u].o0 = p.O2[off]; t[u].o1 = p.O2[(size_t)NTOK * RWW + off];
          t[u].k = bf2f(p.K[off]); t[u].r = bf2f(p.R[off]); t[u].vv = bf2f(p.V[off]);
          t[u].a0 = p.AA[off]; t[u].a1 = p.AA[(size_t)NTOK * RWW + off]; t[u].gg = p.G[off];
        }
      };
      auto fin = [&](int i, const Tok (&t)[2]) {
#pragma unroll
        for (int u = 0; u < 2; ++u) {
          const float o = bf2f(t[u].o0) + bf2f(t[u].o1);
          const float mean = wave_sum(o) * (1.f / 64);
          const float dv = o - mean;
          const float var = wave_sum(dv * dv) * (1.f / 64);
          const float kb = 0.5f * (t[u].k * (1.f + (bf2f(t[u].a0) - 1.f) * kac) + t[u].k * (1.f + (bf2f(t[u].a1) - 1.f) * kac));
          const float sb = wave_sum(t[u].r * kb * prk);
          const float on_ = dv * frsq(var + GN_EPS) * plw + plb;
          p.H[(size_t)(b * T + tb * TQ + w * (TQ / 8) + i + u) * DM + ch] = f2bf((on_ + sb * t[u].vv) * bf2f(t[u].gg));
        }
      };
      Tok ta[2], tb2[2];
      ld(0, ta);
      for (int i0 = 0; i0 < TQ / 8; i0 += 4) {
        ld(i0 + 2, tb2);
        fin(i0, ta);
        if (i0 + 4 < TQ / 8) ld(i0 + 4, ta);
        fin(i0 + 2, tb2);
      }
    }
  }
}
DI void ph_mla_norm(const P& p, int layer) {
  const int tid_ = tidx(); const int lane = tid_ & 63, w = tid_ >> 6;
  const float* on = p.mla_o_norm + layer * 512;
  const f32x4 g0 = *(const f32x4*)(on + lane * 4), g1 = *(const f32x4*)(on + 256 + lane * 4);
  const int tstr = (int)gridDim.x * 8;
  u32x2 r0 = u32x2{0u, 0u}, r1 = u32x2{0u, 0u};
  { const int tok0 = (int)blockIdx.x * 8 + w;
    if (tok0 < NTOK) { r0 = *(const u32x2*)(p.AO + (size_t)tok0 * 512 + lane * 4); r1 = *(const u32x2*)(p.AO + (size_t)tok0 * 512 + 256 + lane * 4); } }
  for (int tok = blockIdx.x * 8 + w; tok < NTOK; tok += tstr) {
    const f32x4 v0 = f32x4{__uint_as_float(r0[0] << 16), __uint_as_float(r0[0] & 0xffff0000u), __uint_as_float(r0[1] << 16), __uint_as_float(r0[1] & 0xffff0000u)};
    const f32x4 v1 = f32x4{__uint_as_float(r1[0] << 16), __uint_as_float(r1[0] & 0xffff0000u), __uint_as_float(r1[1] << 16), __uint_as_float(r1[1] & 0xffff0000u)};
    if (tok + tstr < NTOK) { r0 = *(const u32x2*)(p.AO + (size_t)(tok + tstr) * 512 + lane * 4); r1 = *(const u32x2*)(p.AO + (size_t)(tok + tstr) * 512 + 256 + lane * 4); }
    float ss = v0[0] * v0[0] + v0[1] * v0[1] + v0[2] * v0[2] + v0[3] * v0[3] + v1[0] * v1[0] + v1[1] * v1[1] + v1[2] * v1[2] + v1[3] * v1[3];
    ss = wave_sum(ss);
    const float rstd = frsq(ss * (1.f / 512) + NORM_EPS);
    *(u32x2*)(p.H + (size_t)tok * DM + 512 + lane * 4) = u32x2{pk2(v0[0] * rstd * g0[0], v0[1] * rstd * g0[1]), pk2(v0[2] * rstd * g0[2], v0[3] * rstd * g0[3])};
    *(u32x2*)(p.H + (size_t)tok * DM + 768 + lane * 4) = u32x2{pk2(v1[0] * rstd * g1[0], v1[1] * rstd * g1[1]), pk2(v1[2] * rstd * g1[2], v1[3] * rstd * g1[3])};
  }
}


DI void ph_mixfinish(const P& p, int layer) {
  const int tid_ = tidx(); const int lane = tid_ & 63, w = tid_ >> 6;
  const float* lw = p.rw_lnx_w + layer * RWW; const float* lb = p.rw_lnx_b + layer * RWW;
  const float* kac = p.rw_k_a + layer * RWW; const float* rk = p.rw_r_k + layer * RWW;
  const float* on = p.mla_o_norm + layer * 512;
  float plw[8], plb[8], pka[8], prk[8];
#pragma unroll
  for (int h = 0; h < NH; ++h) { int c = h * 64 + lane; plw[h] = lw[c]; plb[h] = lb[c]; pka[h] = kac[c]; prk[h] = rk[c]; }
  const f32x4 g0 = *(const f32x4*)(on + lane * 4), g1 = *(const f32x4*)(on + 256 + lane * 4);
  for (int tok = blockIdx.x * 8 + w; tok < NTOK; tok += gridDim.x * 8) {
    float o[8], k[8], r[8], vv[8], a0[8], a1[8], gg[8];
#pragma unroll
    for (int h = 0; h < NH; ++h) {
      size_t off = (size_t)tok * RWW + h * 64 + lane;
      o[h] = bf2f(p.O2[off]) + bf2f(p.O2[(size_t)NTOK * RWW + off]);
      k[h] = bf2f(p.K[off]); r[h] = bf2f(p.R[off]); vv[h] = bf2f(p.V[off]);
      a0[h] = bf2f(p.AA[off]); a1[h] = bf2f(p.AA[(size_t)NTOK * RWW + off]); gg[h] = bf2f(p.G[off]);
    }
    const u16* ao = p.AO + (size_t)tok * 512;
    const f32x4 v0 = ld4bf(ao + lane * 4), v1 = ld4bf(ao + 256 + lane * 4);
    float mean[8], var[8], sb[8];
#pragma unroll
    for (int h = 0; h < NH; ++h) mean[h] = wave_sum(o[h]) * (1.f / 64);
#pragma unroll
    for (int h = 0; h < NH; ++h) { float dv = o[h] - mean[h]; o[h] = dv; var[h] = wave_sum(dv * dv) * (1.f / 64); }
#pragma unroll
    for (int h = 0; h < NH; ++h) {
      float kb = 0.5f * (k[h] * (1.f + (a0[h] - 1.f) * pka[h]) + k[h] * (1.f + (a1[h] - 1.f) * pka[h]));
      sb[h] = wave_sum(r[h] * kb * prk[h]);
    }
#pragma unroll
    for (int h = 0; h < NH; ++h) {
      float on_ = o[h] * frsq(var[h] + GN_EPS) * plw[h] + plb[h];
      float y = (on_ + sb[h] * vv[h]) * gg[h];
      p.H[(size_t)tok * DM + h * 64 + lane] = f2bf(y);
    }
    float ss = v0[0] * v0[0] + v0[1] * v0[1] + v0[2] * v0[2] + v0[3] * v0[3] + v1[0] * v1[0] + v1[1] * v1[1] + v1[2] * v1[2] + v1[3] * v1[3];
    ss = wave_sum(ss);
    float rstd = frsq(ss * (1.f / 512) + NORM_EPS);
    *(u32x2*)(p.H + (size_t)tok * DM + 512 + lane * 4) = u32x2{pk2(v0[0] * rstd * g0[0], v0[1] * rstd * g0[1]), pk2(v0[2] * rstd * g0[2], v0[3] * rstd * g0[3])};
    *(u32x2*)(p.H + (size_t)tok * DM + 768 + lane * 4) = u32x2{pk2(v1[0] * rstd * g1[0], v1[1] * rstd * g1[1]), pk2(v1[2] * rstd * g1[2], v1[3] * rstd * g1[3])};
  }
}

DI void ph_norm_router(const P& p, int layer, char* smem) {
  const int tid_ = tidx(); const int lane = tid_ & 63, w = tid_ >> 6;
  float* rtl = (float*)smem;
  float* hl = (float*)(smem + 65536) + w * 1024;
  const float* g = p.ffn_norm + layer * DM;
  const float* rt = p.router + (size_t)layer * DM * NE;
  __syncthreads();
#pragma unroll
  for (int i = 0; i < 8; ++i) *(f32x4*)(rtl + (tid_ + i * NTH) * 4) = *(const f32x4*)(rt + (tid_ + i * NTH) * 4);
  __syncthreads();
  const int cg = lane >> 2, eq = lane & 3;
  f32x4 gg4[4];
#pragma unroll
  for (int j = 0; j < 4; ++j) gg4[j] = *(const f32x4*)(g + (lane + 64 * j) * 4);
  const int tstr = (int)gridDim.x * 8;
  u32x2 raw[4];
  { const int tok0 = (int)blockIdx.x * 8 + w;
    if (tok0 < NTOK) {
#pragma unroll
      for (int j = 0; j < 4; ++j) raw[j] = *(const u32x2*)(p.XB + (size_t)tok0 * DM + (lane + 64 * j) * 4); } }
  for (int tok = blockIdx.x * 8 + w; tok < NTOK; tok += tstr) {
    f32x4 v[4]; float ss = 0.f;
#pragma unroll
    for (int j = 0; j < 4; ++j) {
      v[j] = f32x4{__uint_as_float(raw[j][0] << 16), __uint_as_float(raw[j][0] & 0xffff0000u), __uint_as_float(raw[j][1] << 16), __uint_as_float(raw[j][1] & 0xffff0000u)};
      ss += v[j][0] * v[j][0] + v[j][1] * v[j][1] + v[j][2] * v[j][2] + v[j][3] * v[j][3]; }
    if (tok + tstr < NTOK) {
#pragma unroll
      for (int j = 0; j < 4; ++j) raw[j] = *(const u32x2*)(p.XB + (size_t)(tok + tstr) * DM + (lane + 64 * j) * 4);
    }
    ss = wave_sum(ss);
    const float rstd = frsq(ss * (1.f / DM) + NORM_EPS);
#pragma unroll
    for (int j = 0; j < 4; ++j) {
      const int c0 = (lane + 64 * j) * 4;
      const f32x4 gg = gg4[j];
      const f32x4 hv = v[j] * rstd * gg;
      *(u32x2*)(p.H + (size_t)tok * DM + c0) = u32x2{pk2(hv[0], hv[1]), pk2(hv[2], hv[3])};
      *(f32x4*)(hl + c0) = hv;
    }
    f32x4 acc = f32x4{0.f, 0.f, 0.f, 0.f};
#pragma unroll 16
    for (int i = 0; i < 64; ++i) {
      const float hv = hl[cg + 16 * i];
      const f32x4 r4 = *(const f32x4*)(rtl + (cg + 16 * i) * 16 + eq * 4);
      acc += hv * r4;
    }
#pragma unroll
    for (int e = 0; e < 4; ++e) {
      float a = acc[e];
      a += dpp_f<0x124>(a); a += dpp_f<0x128>(a);
      a = red_x32(red_x16(a));
      acc[e] = a;
    }
    float mx = fmaxf(fmaxf(acc[0], acc[1]), fmaxf(acc[2], acc[3]));
    mx = fmaxf(mx, dpp_f<0xB1>(mx)); mx = fmaxf(mx, dpp_f<0x4E>(mx));
    f32x4 ex; float se = 0.f;
#pragma unroll
    for (int e = 0; e < 4; ++e) { ex[e] = fexp(acc[e] - mx); se += ex[e]; }
    se = red_x2(red_x1(se));
    const float inv = frcp(se);
    const int b = tok / T, t = tok % T;
    if (lane < 4) {
#pragma unroll
      for (int e = 0; e < 4; ++e) p.AFF[((size_t)(b * NE + eq * 4 + e)) * T + t] = ex[e] * inv;
    }
  }
}

DI void ph_topk(const P& p, char* smem) {
  unsigned* hist = (unsigned*)smem;
  unsigned* sc = hist + 256;
  unsigned* bc = sc + 2048;
  const int tid = tidx();
  for (int item = blockIdx.x; item < NB * NE; item += gridDim.x) {
    const float* a = p.AFF + (size_t)item * T;
    unsigned key[16];
#pragma unroll
    for (int i = 0; i < 4; ++i) {
      uint4 v = *(const uint4*)(a + tid * 16 + i * 4);
      key[i * 4 + 0] = v.x; key[i * 4 + 1] = v.y; key[i * 4 + 2] = v.z; key[i * 4 + 3] = v.w;
    }
    unsigned prefix = 0, mask = 0, need = CAP;
    for (int pass = 0; pass < 4; ++pass) {
      int shift = 24 - 8 * pass;
      __syncthreads();
      if (tid < 256) hist[tid] = 0;
      __syncthreads();
#pragma unroll
      for (int i = 0; i < 16; ++i)
        if ((key[i] & mask) == prefix) atomicAdd(&hist[(key[i] >> shift) & 255u], 1u);
      __syncthreads();
      if (tid == 0) {
        unsigned cum = 0; int bsel = 0; unsigned nd = need;
        for (int bb = 255; bb >= 0; --bb) {
          unsigned hc = hist[bb];
          if (cum + hc >= need) { bsel = bb; nd = need - cum; break; }
          cum += hc;
        }
        bc[0] = prefix | ((unsigned)bsel << shift); bc[1] = nd;
      }
      __syncthreads();
      prefix = bc[0]; need = bc[1]; mask |= (255u << shift);
    }
    unsigned ngt = 0, neq = 0;
#pragma unroll
    for (int i = 0; i < 16; ++i) { ngt += key[i] > prefix; neq += key[i] == prefix; }
    __syncthreads();
    unsigned* sA = sc; unsigned* sB = sc + 512; unsigned* eA = sc + 1024; unsigned* eB = sc + 1536;
    sA[tid] = ngt; eA[tid] = neq;
    __syncthreads();
    for (int off = 1; off < NTH; off <<= 1) {
      unsigned x = sA[tid] + ((tid >= off) ? sA[tid - off] : 0u);
      unsigned y = eA[tid] + ((tid >= off) ? eA[tid - off] : 0u);
      sB[tid] = x; eB[tid] = y;
      __syncthreads();
      unsigned* tmp = sA; sA = sB; sB = tmp; tmp = eA; eA = eB; eB = tmp;
    }
    unsigned gt_excl = sA[tid] - ngt, eq_excl = eA[tid] - neq;
    unsigned gt_total = sA[NTH - 1];
    int* idx = p.IDX + (size_t)item * CAP; float* gate = p.GATE + (size_t)item * CAP;
#pragma unroll
    for (int i = 0; i < 16; ++i) {
      int slot = -1;
      if (key[i] > prefix) { slot = (int)gt_excl; ++gt_excl; }
      else if (key[i] == prefix) { if (eq_excl < need) slot = (int)(gt_total + eq_excl); ++eq_excl; }
      if (slot >= 0) {
        const int tokl = tid * 16 + i;
        idx[slot] = tokl; gate[slot] = __uint_as_float(key[i]);
        const int tokg = (item / NE) * T + tokl;
        const int pos = atomicAdd(&p.TCNT[tokg], 1);
        p.TLIST[(size_t)tokg * 16 + pos] = item * CAP + slot;
      }
    }
    __syncthreads();
  }
}

namespace g8 {
constexpr int BM = 256, BK = 64, HALF = 128, HTB = HALF * BK * 2, STAGE_BYTES = 8 * HTB, NXCD = 8, WGM = 8;
DI int lds_byte(int r, int c) { const int st = (r >> 4) * 2 + (c >> 5), rr = r & 15, cc = c & 31, ob = rr * 64 + cc * 2; return st * 1024 + (ob ^ (((ob >> 9) & 1) << 5)); }
DI void stage_rc(int b, int& R, int& C) { const int st = b / 1024, sb = b % 1024, swz = sb ^ (((sb >> 9) & 1) << 5); R = (st >> 1) * 16 + swz / 64; C = (st & 1) * 32 + (swz % 64) / 2; }
DI int perm32(int rho) { const int n = rho >> 4, i = rho & 15; return 8 * (i >> 2) + 4 * n + (i & 3); }
struct Unit { int pm, pn; };
struct Sched {
  int nM, nN, nwg, G, c;
  const char* A; const char* Bt; size_t a_tstep, b_tstep; int gdiv, gmod; size_t gstride;
  DI void init(int nM_, int nN_, int G_, int c_, const void* A_, const void* Bt_, int K) {
    nM = nM_; nN = nN_; nwg = nM * nN; G = G_; c = c_; A = (const char*)uni_ptr(A_); Bt = (const char*)uni_ptr(Bt_);
    a_tstep = (size_t)BM * K * 2; b_tstep = (size_t)BM * K * 2; gdiv = 1 << 30; gmod = 1; gstride = 0;
  }
  DI void group(int gdiv_, int gmod_, size_t gstride_) { gdiv = gdiv_; gmod = gmod_; gstride = gstride_; }
  DI bool next(int i, Unit& u) const {
    const long L = (long)i * G + c; if (L >= nwg) return false;
    int wgid = (int)L; { const int q = nwg / NXCD, r = nwg % NXCD, xcd = wgid % NXCD, off = wgid / NXCD; wgid = (xcd < r ? xcd * (q + 1) : r * (q + 1) + (xcd - r) * q) + off; }
    const int nig = WGM * nN, gid = wgid / nig, fm = gid * WGM, gsz = (nM - fm) < WGM ? (nM - fm) : WGM;
    u.pm = fm + ((wgid % nig) % gsz); u.pn = (wgid % nig) / gsz; return true;
  }
  DI const char* a_ptr(const Unit& u) const { return A + (size_t)u.pm * a_tstep; }
  DI const char* b_ptr(const Unit& u) const { return Bt + (size_t)((u.pm / gdiv) % gmod) * gstride + (size_t)u.pn * b_tstep; }
};
using Acc = f32x4[2][2][4][2];
template <class E, class = void> struct epi_preload { static constexpr bool value = false; };
template <class E> struct epi_preload<E, decltype((void)E::PRELOAD)> { static constexpr bool value = E::PRELOAD; };
DI void acc_touch(Acc& acc) {
#pragma unroll
  for (int a = 0; a < 2; ++a)
#pragma unroll
    for (int b = 0; b < 2; ++b)
      asm volatile("" : "+v"(acc[a][b][0][0]), "+v"(acc[a][b][0][1]), "+v"(acc[a][b][1][0]), "+v"(acc[a][b][1][1]),
                        "+v"(acc[a][b][2][0]), "+v"(acc[a][b][2][1]), "+v"(acc[a][b][3][0]), "+v"(acc[a][b][3][1]));
}

template <class Epi, bool GATHER = false>
DI void gemm_phase(LAS unsigned char* lds, const int K, const Sched& S, const Epi& E, const int* gidx = nullptr, LAS unsigned* gtab = nullptr) {
  const int tid = tidx(), wid = __builtin_amdgcn_readfirstlane(tid >> 6), lane = tid & 63, wr = wid >> 2, wc = wid & 3, fr = lane & 15, fq = lane >> 4;
  const int nt = K / BK;
  unsigned voffA[2], voffB[2];
#pragma unroll
  for (int i = 0; i < 2; ++i) { int R, C; stage_rc(tid * 16 + i * 8192, R, C); const int Rb = Epi::PERM ? ((R & ~31) + perm32(R & 31)) : R;
    voffA[i] = GATHER ? (unsigned)(R | (C << 16)) : (unsigned)(R * K + C) * 2u; voffB[i] = (unsigned)(Rb * K + C) * 2u; }
  unsigned gc[2][2], gn[2][2];
  auto gget = [&](int ui_, unsigned (&g)[2][2]) {
    if constexpr (GATHER) {
      Unit u_; const bool ok = S.next(ui_, u_);
#pragma unroll
      for (int h = 0; h < 2; ++h)
#pragma unroll
        for (int i = 0; i < 2; ++i) {
          const int r = h * HALF + (int)(voffA[i] & 0xffffu); const unsigned cb = (voffA[i] >> 16) * 2u;
          if (ui_ < 16) g[h][i] = gtab[ui_ * 256 + r] + cb;
          else { const int row = (ok ? u_.pm : 0) * BM + r; g[h][i] = (unsigned)((row / (NE * CAP)) * T + gidx[row]) * (unsigned)K * 2u + cb; }
        }
      asm volatile("" : "+v"(g[0][0]), "+v"(g[0][1]), "+v"(g[1][0]), "+v"(g[1][1]));
    }
  };
  if constexpr (GATHER) {
    for (int i0 = 0; i0 < 16; i0 += 2) {
      Unit u_; const int i = i0 + (tid >> 8);
      if (S.next(i, u_)) { const int row = u_.pm * BM + (tid & 255); gtab[i * 256 + (tid & 255)] = (unsigned)((row / (NE * CAP)) * T + gidx[row]) * (unsigned)K * 2u; }
      if (!S.next(i0 + 2, u_)) break;
    }
    __syncthreads();
  }
  const size_t kstep = (size_t)(BK * 2);
  const size_t hstep = (size_t)HALF * K * 2;
  const unsigned ldsw = (unsigned)wid * 1024u;
  const int aoff = lds_byte(wr * 64 + fr, fq * 8), boff = lds_byte(wc * 32 + fr, fq * 8);
#define G8_SA(b, h) (((b) * 2 + (h)) * HTB)
#define G8_SB(b, h) ((4 + (b) * 2 + (h)) * HTB)
#define G8_STAGE(bufoff, gbase, voff) do { _Pragma("unroll") for (int _i = 0; _i < 2; ++_i) \
    __builtin_amdgcn_global_load_lds((const unsigned*)((const char*)(gbase) + (voff)[_i]), (LAS unsigned*)(lds + (bufoff) + ldsw + _i * 8192), 16, 0, 0); } while (0)
#define G8_STAGE_A(bufoff, base, h, kb, Gv) do { if constexpr (GATHER) { G8_STAGE(bufoff, S.A + (kb), Gv[h]); } else { G8_STAGE(bufoff, (base) + (h) * hstep + (kb), voffA); } } while (0)
#define G8_LDA(dst, b, h) do { _Pragma("unroll") for (int m = 0; m < 4; ++m) _Pragma("unroll") for (int k = 0; k < 2; ++k) dst[m][k] = *(const LAS bf16x8*)(lds + G8_SA(b, h) + aoff + m * 2048 + k * 1024); } while (0)
#define G8_LDB(dst, b, h) do { _Pragma("unroll") for (int n = 0; n < 2; ++n) _Pragma("unroll") for (int k = 0; k < 2; ++k) dst[n][k] = *(const LAS bf16x8*)(lds + G8_SB(b, h) + boff + n * 2048 + k * 1024); } while (0)
#define G8_MMA(ai, bj, At, Bt) do { __builtin_amdgcn_s_setprio(1); _Pragma("unroll") for (int m = 0; m < 4; ++m) _Pragma("unroll") for (int n = 0; n < 2; ++n) _Pragma("unroll") for (int k = 0; k < 2; ++k) \
    acc[ai][bj][m][n] = __builtin_amdgcn_mfma_f32_16x16x32_bf16(Bt[n][k], At[m][k], acc[ai][bj][m][n], 0, 0, 0); __builtin_amdgcn_s_setprio(0); } while (0)
#define G8_WAIT_V(n) asm volatile("s_waitcnt vmcnt(" #n ")" ::: "memory")
#define G8_WAIT_L(n) asm volatile("s_waitcnt lgkmcnt(" #n ")" ::: "memory")
#define G8_BAR __builtin_amdgcn_s_barrier()
#define G8_SCHED __builtin_amdgcn_sched_barrier(0)
  Unit cur, nxt; int ui = 0;
  if (!S.next(0, cur)) return;
  f32x4 acc[2][2][4][2];
  constexpr bool PRE = epi_preload<Epi>::value;
  if constexpr (PRE) E.preload(acc, cur, wr, wc, fr, fq);
  else {
#pragma unroll
  for (int a = 0; a < 2; ++a)
#pragma unroll
    for (int b = 0; b < 2; ++b)
#pragma unroll
      for (int m = 0; m < 4; ++m)
#pragma unroll
        for (int n = 0; n < 2; ++n) acc[a][b][m][n] = (f32x4){0.f, 0.f, 0.f, 0.f};
  }
  bf16x8 At[4][2], B0[2][2], B1[2][2];
  const char* cA = S.a_ptr(cur); const char* cB = S.b_ptr(cur);
  gget(0, gc);
  G8_STAGE(G8_SB(0, 0), cB, voffB); G8_STAGE_A(G8_SA(0, 0), cA, 0, 0, gc); G8_STAGE(G8_SB(0, 1), cB + hstep, voffB); G8_STAGE_A(G8_SA(0, 1), cA, 1, 0, gc);
  if (wr == 1) G8_BAR;
  G8_WAIT_V(4); G8_BAR;
  G8_STAGE(G8_SB(1, 0), cB + kstep, voffB); G8_STAGE_A(G8_SA(1, 0), cA, 0, kstep, gc); G8_STAGE(G8_SB(1, 1), cB + hstep + kstep, voffB);
  G8_WAIT_V(6); G8_BAR;
  if constexpr (PRE) acc_touch(acc);
  for (;;) {
    const bool has_next = S.next(ui + 1, nxt);
    const char* nA = has_next ? S.a_ptr(nxt) : cA; const char* nB = has_next ? S.b_ptr(nxt) : cB;
    gget(has_next ? ui + 1 : ui, gn);
    for (int t = 0; t < nt; t += 2) {
      const bool last = (t == nt - 2);
      const size_t k1 = (size_t)(t + 1) * kstep, k2 = last ? (size_t)0 : (size_t)(t + 2) * kstep, k3 = k2 + kstep;
      const char* u2 = last ? nA : cA; const char* b2 = (last ? nB : cB) + k2;
      const char* b3 = b2 + kstep;
      unsigned g2[2][2];
      if constexpr (GATHER) {
#pragma unroll
        for (int h = 0; h < 2; ++h)
#pragma unroll
          for (int i = 0; i < 2; ++i) g2[h][i] = last ? gn[h][i] : gc[h][i];
      }
      G8_LDB(B0, 0, 0); G8_SCHED; G8_LDA(At, 0, 0); G8_STAGE_A(G8_SA(1, 1), cA, 1, k1, gc);
      G8_WAIT_L(8); G8_BAR; G8_WAIT_L(0); G8_MMA(0, 0, At, B0); G8_BAR; G8_SCHED;
      G8_LDB(B1, 0, 1); G8_STAGE(G8_SB(0, 0), b2, voffB);
      G8_BAR; G8_WAIT_L(0); G8_MMA(0, 1, At, B1); G8_BAR;
      G8_LDA(At, 0, 1); G8_STAGE_A(G8_SA(0, 0), u2, 0, k2, g2);
      G8_BAR; G8_WAIT_L(0); G8_MMA(1, 0, At, B0); G8_BAR; G8_SCHED;
      G8_STAGE(G8_SB(0, 1), b2 + hstep, voffB);
      G8_WAIT_V(6); G8_BAR; G8_MMA(1, 1, At, B1); G8_BAR;
      G8_LDB(B0, 1, 0); G8_SCHED; G8_LDA(At, 1, 0); G8_STAGE_A(G8_SA(0, 1), u2, 1, k2, g2);
      G8_WAIT_L(8); G8_BAR; G8_WAIT_L(0); G8_MMA(0, 0, At, B0); G8_BAR; G8_SCHED;
      G8_LDB(B1, 1, 1); G8_STAGE(G8_SB(1, 0), b3, voffB);
      G8_BAR; G8_WAIT_L(0); G8_MMA(0, 1, At, B1); G8_BAR;
      G8_LDA(At, 1, 1); G8_STAGE_A(G8_SA(1, 0), u2, 0, k3, g2);
      G8_BAR; G8_WAIT_L(0); G8_MMA(1, 0, At, B0); G8_BAR; G8_SCHED;
      G8_STAGE(G8_SB(1, 1), b3 + hstep, voffB);
      G8_WAIT_V(6); G8_BAR; G8_MMA(1, 1, At, B1); G8_BAR;
    }
    {
      const int t2 = tidx(); const int w2 = __builtin_amdgcn_readfirstlane(t2 >> 6), l2 = t2 & 63;
      E(acc, cur, w2 >> 2, w2 & 3, l2 & 15, l2 >> 4);
    }
    if (!has_next) break;
    if constexpr (PRE) {
      const int t3 = tidx(); const int w3 = __builtin_amdgcn_readfirstlane(t3 >> 6), l3 = t3 & 63;
      E.preload(acc, nxt, w3 >> 2, w3 & 3, l3 & 15, l3 >> 4); acc_touch(acc);
    } else {
#pragma unroll
    for (int a = 0; a < 2; ++a)
#pragma unroll
      for (int b = 0; b < 2; ++b)
#pragma unroll
        for (int m = 0; m < 4; ++m)
#pragma unroll
          for (int n = 0; n < 2; ++n) acc[a][b][m][n] = (f32x4){0.f, 0.f, 0.f, 0.f};
    }
    cur = nxt; cA = nA; cB = nB; ++ui;
    if constexpr (GATHER) {
#pragma unroll
      for (int h = 0; h < 2; ++h)
#pragma unroll
        for (int i = 0; i < 2; ++i) gc[h][i] = gn[h][i];
    }
  }
  G8_WAIT_V(0);
  if (wr == 0) G8_BAR;
  G8_BAR;
#undef G8_SA
#undef G8_SB
#undef G8_STAGE
#undef G8_STAGE_A
#undef G8_LDA
#undef G8_LDB
#undef G8_MMA
#undef G8_WAIT_V
#undef G8_WAIT_L
#undef G8_BAR
#undef G8_SCHED
}

struct EpiZ {
  static constexpr bool PERM = true; u16* Z;
  DI void operator()(const Acc& acc, const Unit& u, int wr, int wc, int fr, int fq) const {
    const int row0 = u.pm * BM + wr * 64 + fr, col0 = u.pn * BM + wc * 32 + 8 * fq;
#pragma unroll
    for (int ai = 0; ai < 2; ++ai)
#pragma unroll
      for (int m = 0; m < 4; ++m) { u16* rowp = Z + (size_t)(row0 + ai * HALF + m * 16) * INC;
#pragma unroll
        for (int bj = 0; bj < 2; ++bj) { const int col = col0 + bj * HALF; const f32x4 v0 = acc[ai][bj][m][0], v1 = acc[ai][bj][m][1];
          if (col < INC) *(u32x4*)(rowp + col) = u32x4{pk2(v0[0], v0[1]), pk2(v0[2], v0[3]), pk2(v1[0], v1[1]), pk2(v1[2], v1[3])}; } }
  }
};
struct EpiRes {
  static constexpr bool PERM = false; static constexpr bool PRELOAD = true; const float* xs32; const u16* xs16; u16* xo;
  DI void preload(Acc& acc, const Unit& u, int wr, int wc, int fr, int fq) const {
    const int row0 = u.pm * BM + wr * 64 + fr, col0 = u.pn * BM + wc * 32 + 4 * fq;
#pragma unroll
    for (int ai = 0; ai < 2; ++ai)
#pragma unroll
      for (int m = 0; m < 4; ++m) { const size_t ro = (size_t)(row0 + ai * HALF + m * 16) * DM + col0;
#pragma unroll
        for (int bj = 0; bj < 2; ++bj)
#pragma unroll
          for (int n = 0; n < 2; ++n) { const size_t o = ro + bj * HALF + n * 16; acc[ai][bj][m][n] = xs32 ? *(const f32x4*)(xs32 + o) : ld4bf(xs16 + o); } }
  }
  DI void operator()(const Acc& acc, const Unit& u, int wr, int wc, int fr, int fq) const {
    const int row0 = u.pm * BM + wr * 64 + fr, col0 = u.pn * BM + wc * 32 + 4 * fq;
#pragma unroll
    for (int ai = 0; ai < 2; ++ai)
#pragma unroll
      for (int m = 0; m < 4; ++m) { const size_t ro = (size_t)(row0 + ai * HALF + m * 16) * DM + col0;
#pragma unroll
        for (int bj = 0; bj < 2; ++bj)
#pragma unroll
          for (int n = 0; n < 2; ++n) { const f32x4 v = acc[ai][bj][m][n]; *(u32x2*)(xo + ro + bj * HALF + n * 16) = u32x2{pk2(v[0], v[1]), pk2(v[2], v[3])}; } }
  }
};
struct EpiSig {
  static constexpr bool PERM = true; u16* PG;
  DI void operator()(const Acc& acc, const Unit& u, int wr, int wc, int fr, int fq) const {
    const int row0 = u.pm * BM + wr * 64 + fr, col0 = u.pn * BM + wc * 32 + 8 * fq;
#pragma unroll
    for (int ai = 0; ai < 2; ++ai)
#pragma unroll
      for (int m = 0; m < 4; ++m) { u16* rowp = PG + (size_t)(row0 + ai * HALF + m * 16) * DM + col0;
#pragma unroll
        for (int bj = 0; bj < 2; ++bj) { const f32x4 v0 = acc[ai][bj][m][0], v1 = acc[ai][bj][m][1];
          u32x4 wv = {pk2(sigmoidf_(v0[0]), sigmoidf_(v0[1])), pk2(sigmoidf_(v0[2]), sigmoidf_(v0[3])), pk2(sigmoidf_(v1[0]), sigmoidf_(v1[1])), pk2(sigmoidf_(v1[2]), sigmoidf_(v1[3]))};
          *(u32x4*)(rowp + bj * HALF) = wv; } }
  }
};
struct EpiPle {
  static constexpr bool PERM = false; u16* xo; const u16* PG;
  DI void operator()(const Acc& acc, const Unit& u, int wr, int wc, int fr, int fq) const {
    const int row0 = u.pm * BM + wr * 64 + fr, col0 = u.pn * BM + wc * 32 + 4 * fq;
#pragma unroll
    for (int ai = 0; ai < 2; ++ai)
#pragma unroll
      for (int m = 0; m < 4; ++m) { const size_t ro = (size_t)(row0 + ai * HALF + m * 16) * DM + col0;
#pragma unroll
        for (int bj = 0; bj < 2; ++bj)
#pragma unroll
          for (int n = 0; n < 2; ++n) { const size_t o = ro + bj * HALF + n * 16; const u32x2 g = *(const u32x2*)(PG + o);
            f32x4 gv = {__uint_as_float(g[0] << 16), __uint_as_float(g[0] & 0xffff0000u), __uint_as_float(g[1] << 16), __uint_as_float(g[1] & 0xffff0000u)};
            const f32x4 y = ld4bf(xo + o) + acc[ai][bj][m][n] * gv; *(u32x2*)(xo + o) = u32x2{pk2(y[0], y[1]), pk2(y[2], y[3])}; } }
  }
};
struct EpiSwi {
  static constexpr bool PERM = true; u16* HID;
  DI void operator()(const Acc& acc, const Unit& u, int wr, int wc, int fr, int fq) const {
    const int row0 = u.pm * BM + wr * 64 + fr, col0 = u.pn * HALF + wc * 32 + 8 * fq;
#pragma unroll
    for (int ai = 0; ai < 2; ++ai)
#pragma unroll
      for (int m = 0; m < 4; ++m) { u16* rowp = HID + (size_t)(row0 + ai * HALF + m * 16) * 1024 + col0;
        float h[8];
#pragma unroll
        for (int n = 0; n < 2; ++n)
#pragma unroll
          for (int j = 0; j < 4; ++j) { const float gt = acc[ai][0][m][n][j], up = acc[ai][1][m][n][j]; h[n * 4 + j] = gt * frcp(1.f + fexp(-gt)) * up; }
        *(u32x4*)rowp = u32x4{pk2(h[0], h[1]), pk2(h[2], h[3]), pk2(h[4], h[5]), pk2(h[6], h[7])}; }
  }
};
struct EpiYE {
  static constexpr bool PERM = true; u16* YE; const float* GATE;
  DI void operator()(const Acc& acc, const Unit& u, int wr, int wc, int fr, int fq) const {
    const int row0 = u.pm * BM + wr * 64 + fr, col0 = u.pn * BM + wc * 32 + 8 * fq;
#pragma unroll
    for (int ai = 0; ai < 2; ++ai)
#pragma unroll
      for (int m = 0; m < 4; ++m) { const int row = row0 + ai * HALF + m * 16; const float gt = GATE[row]; u16* rowp = YE + (size_t)row * 1024 + col0;
#pragma unroll
        for (int bj = 0; bj < 2; ++bj) { const f32x4 v0 = acc[ai][bj][m][0] * gt, v1 = acc[ai][bj][m][1] * gt;
          *(u32x4*)(rowp + bj * HALF) = u32x4{pk2(v0[0], v0[1]), pk2(v0[2], v0[3]), pk2(v1[0], v1[1]), pk2(v1[2], v1[3])}; } }
  }
};
}

DI void cvt_tile_T(const float* __restrict__ src, int ldsrc, int N, int K, u16* __restrict__ dst, int k0, int n0, int drow0, char* smem, int tid) {
  short* tl = (short*)smem;
  __syncthreads();
#pragma unroll
  for (int i = 0; i < 2; ++i) {
    int u = tid + i * NTH; int kr = u >> 4, nq = u & 15; int n = n0 + nq * 4;
    f32x4 v = f32x4{0.f, 0.f, 0.f, 0.f};
    if (n < N) v = *(const f32x4*)(src + (size_t)(k0 + kr) * ldsrc + n);
#pragma unroll
    for (int e = 0; e < 4; ++e) tl[(nq * 4 + e) * 72 + kr] = (short)f2bf(v[e]);
  }
  __syncthreads();
  { int n = tid >> 3, kc = tid & 7;
    *(u32x4*)(dst + (size_t)(drow0 + n) * K + k0 + kc * 8) = *(const u32x4*)(tl + n * 72 + kc * 8); }
}
constexpr int WIN_PAD = 2560;
DI void ph_cvt_small_a(const P& p, int layer, char* smem) {
  const int tid = tidx();
  for (int t = blockIdx.x; t < 16 * 40; t += gridDim.x)
    cvt_tile_T(p.w_in + (size_t)layer * DM * INC, INC, INC, DM, p.WIN, (t / 40) * 64, (t % 40) * 64, (t % 40) * 64, smem, tid);
}
DI void ph_cvt_small_b(const P& p, int layer, char* smem, int wfirst, int wstride) {
  const int tid = tidx();
  const int t1 = 256, t2 = t1 + 256, t3 = t2 + 64;
  for (int t = wfirst; t < t3; t += wstride) {
    if (t < t1) { int q = t; cvt_tile_T(p.w_out + (size_t)layer * DM * DM, DM, DM, DM, p.WOUT, (q / 16) * 64, (q % 16) * 64, (q % 16) * 64, smem, tid); }
    else if (t < t2) { int q = t - t1; cvt_tile_T(p.ple_gate + (size_t)layer * DM * DM, DM, DM, DM, p.WPG, (q / 16) * 64, (q % 16) * 64, (q % 16) * 64, smem, tid); }
    else { int q = t - t2; cvt_tile_T(p.ple_proj + (size_t)layer * DPLE * DM, DM, DM, DPLE, p.WPP, (q / 16) * 64, (q % 16) * 64, (q % 16) * 64, smem, tid); }
  }
  const float* ps = p.p + (size_t)layer * NTOK * DPLE;
  for (int i = wfirst * NTH + tid; i < NTOK * DPLE / 8; i += wstride * NTH) {
    f32x4 a = *(const f32x4*)(ps + (size_t)i * 8), b = *(const f32x4*)(ps + (size_t)i * 8 + 4);
    *(u32x4*)(p.PB + (size_t)i * 8) = u32x4{pk2(a[0], a[1]), pk2(a[2], a[3]), pk2(b[0], b[1]), pk2(b[2], b[3])};
  }
}

struct CvtJob { const float* src; u16* dst; int k0, n0, drow0; };
DI bool cvt_job(const P& p, int layer, int t, CvtJob& j) {
  if (t >= NE * 3 * 128) return false;
  const int e = t / 384, r = t % 384, mat = r / 128, q = r % 128;
  j.k0 = (q / 8) * 64; j.n0 = (q % 8) * 128;
  const size_t eo = ((size_t)layer * NE + e) * 1024 * 1024;
  if (mat == 0) { j.src = p.exp_w_gate + eo; j.dst = p.EW1 + (size_t)e * 2048 * 1024; j.drow0 = (j.n0 >> 7) * 256; }
  else if (mat == 1) { j.src = p.exp_w_up + eo; j.dst = p.EW1 + (size_t)e * 2048 * 1024; j.drow0 = (j.n0 >> 7) * 256 + 128; }
  else { j.src = p.exp_w_down + eo; j.dst = p.EW2 + (size_t)e * 1024 * 1024; j.drow0 = j.n0; }
  return true;
}
DI void ph_cvt_experts(const P& p, int layer, char* smem, unsigned* ctr) {
  const int tid = tidx();
  short* tlA = (short*)smem;
  short* tlB = (short*)(smem + 18432);
  int* sitem = (int*)(smem + 40960);
  __syncthreads();
  if (tid == 0) sitem[0] = (int)atomicAdd(ctr, 1u);
  __syncthreads();
  CvtJob ca, cb; bool has = cvt_job(p, layer, 2 * sitem[0], ca); cvt_job(p, layer, 2 * sitem[0] + 1, cb);
  f32x4 va[4], vb[4];
  const int kr = tid >> 5, nq = tid & 31;
  if (has) {
#pragma unroll
    for (int i = 0; i < 4; ++i) va[i] = *(const f32x4*)(ca.src + (size_t)(ca.k0 + kr + 16 * i) * 1024 + ca.n0 + nq * 4);
#pragma unroll
    for (int i = 0; i < 4; ++i) vb[i] = *(const f32x4*)(cb.src + (size_t)(cb.k0 + kr + 16 * i) * 1024 + cb.n0 + nq * 4);
  }
  int par = 0;
  while (has) {
    if (tid == 0) sitem[1 + par] = (int)atomicAdd(ctr, 1u);
    __syncthreads();
#pragma unroll
    for (int i = 0; i < 4; ++i)
#pragma unroll
      for (int e = 0; e < 4; ++e) { tlA[(nq * 4 + e) * 72 + kr + 16 * i] = (short)f2bf(va[i][e]); tlB[(nq * 4 + e) * 72 + kr + 16 * i] = (short)f2bf(vb[i][e]); }
    __syncthreads();
    CvtJob na, nb; const bool hn = cvt_job(p, layer, 2 * sitem[1 + par], na); cvt_job(p, layer, 2 * sitem[1 + par] + 1, nb);
    if (hn) {
#pragma unroll
      for (int i = 0; i < 4; ++i) va[i] = *(const f32x4*)(na.src + (size_t)(na.k0 + kr + 16 * i) * 1024 + na.n0 + nq * 4);
#pragma unroll
      for (int i = 0; i < 4; ++i) vb[i] = *(const f32x4*)(nb.src + (size_t)(nb.k0 + kr + 16 * i) * 1024 + nb.n0 + nq * 4);
    }
#pragma unroll
    for (int i = 0; i < 2; ++i) {
      int u = tid + i * NTH; int n = u >> 3, kc = u & 7;
      *(u32x4*)(ca.dst + (size_t)(ca.drow0 + n) * 1024 + ca.k0 + kc * 8) = *(const u32x4*)(tlA + n * 72 + kc * 8);
      *(u32x4*)(cb.dst + (size_t)(cb.drow0 + n) * 1024 + cb.k0 + kc * 8) = *(const u32x4*)(tlB + n * 72 + kc * 8);
    }
    ca = na; cb = nb; has = hn; par ^= 1;
  }
}
DI void ph_gather(const P& p) {
  const int tid_ = tidx(); const int lane = tid_ & 63, w = tid_ >> 6;
  for (int row = blockIdx.x * 8 + w; row < NB * NE * CAP; row += gridDim.x * 8) {
    const int b = row / (NE * CAP);
    const int tok = b * T + p.IDX[row];
    const u32x4* src = (const u32x4*)(p.H + (size_t)tok * DM);
    u32x4* dst = (u32x4*)(p.XE + (size_t)row * DM);
    u32x4 a = src[lane], c = src[lane + 64];
    dst[lane] = a; dst[lane + 64] = c;
  }
}
DI void ph_combine_norm(const P& p, int layer) {
  const int tid_ = tidx(); const int lane = tid_ & 63, w = tid_ >> 6;
  const float* g = p.ple_norm + layer * DM;
  f32x4 gg[4];
#pragma unroll
  for (int j = 0; j < 4; ++j) gg[j] = ((const f32x4*)g)[lane + 64 * j];
  const int tstr = (int)gridDim.x * 8;
  u32x2 raw[4]; int cnt = 0; u32x4 tl = u32x4{0u, 0u, 0u, 0u};
  { const int tok0 = (int)blockIdx.x * 8 + w;
    if (tok0 < NTOK) {
#pragma unroll
      for (int j = 0; j < 4; ++j) raw[j] = *(const u32x2*)(p.XB + (size_t)tok0 * DM + (lane + 64 * j) * 4);
      cnt = p.TCNT[tok0]; tl = *(const u32x4*)(p.TLIST + (size_t)tok0 * 16); } }
  for (int tok = blockIdx.x * 8 + w; tok < NTOK; tok += tstr) {
    u16* xr = p.XB + (size_t)tok * DM;
    f32x4 v[4];
#pragma unroll
    for (int j = 0; j < 4; ++j)
      v[j] = f32x4{__uint_as_float(raw[j][0] << 16), __uint_as_float(raw[j][0] & 0xffff0000u), __uint_as_float(raw[j][1] << 16), __uint_as_float(raw[j][1] & 0xffff0000u)};
    const int ccnt = cnt; const u32x4 ctl = tl;
    u32x2 y[4][4];
#pragma unroll
    for (int q = 0; q < 4; ++q)
      if (q < ccnt) {
        const u32x2* yr = (const u32x2*)(p.YE + (size_t)ctl[q] * DM);
#pragma unroll
        for (int j = 0; j < 4; ++j) y[q][j] = yr[lane + 64 * j];
      }
    if (tok + tstr < NTOK) {
#pragma unroll
      for (int j = 0; j < 4; ++j) raw[j] = *(const u32x2*)(p.XB + (size_t)(tok + tstr) * DM + (lane + 64 * j) * 4);
      cnt = p.TCNT[tok + tstr]; tl = *(const u32x4*)(p.TLIST + (size_t)(tok + tstr) * 16);
    }
#pragma unroll
    for (int q = 0; q < 4; ++q)
      if (q < ccnt) {
#pragma unroll
        for (int j = 0; j < 4; ++j) {
          v[j][0] += __uint_as_float(y[q][j][0] << 16); v[j][1] += __uint_as_float(y[q][j][0] & 0xffff0000u);
          v[j][2] += __uint_as_float(y[q][j][1] << 16); v[j][3] += __uint_as_float(y[q][j][1] & 0xffff0000u);
        }
      }
    for (int q = 4; q < ccnt; ++q) {
      const int yrow = p.TLIST[(size_t)tok * 16 + q];
      const u32x2* yr = (const u32x2*)(p.YE + (size_t)yrow * DM);
      u32x2 yy[4];
#pragma unroll
      for (int j = 0; j < 4; ++j) yy[j] = yr[lane + 64 * j];
#pragma unroll
      for (int j = 0; j < 4; ++j) {
        v[j][0] += __uint_as_float(yy[j][0] << 16); v[j][1] += __uint_as_float(yy[j][0] & 0xffff0000u);
        v[j][2] += __uint_as_float(yy[j][1] << 16); v[j][3] += __uint_as_float(yy[j][1] & 0xffff0000u);
      }
    }
    float ss = 0.f;
#pragma unroll
    for (int j = 0; j < 4; ++j) { *(u32x2*)(xr + (lane + 64 * j) * 4) = u32x2{pk2(v[j][0], v[j][1]), pk2(v[j][2], v[j][3])}; ss += v[j][0] * v[j][0] + v[j][1] * v[j][1] + v[j][2] * v[j][2] + v[j][3] * v[j][3]; }
    ss = wave_sum(ss);
    const float rstd = frsq(ss * (1.f / DM) + NORM_EPS);
#pragma unroll
    for (int j = 0; j < 4; ++j) {
      const f32x4 o = v[j] * rstd * gg[j];
      *(u32x2*)(p.H + (size_t)tok * DM + (lane + 64 * j) * 4) = u32x2{pk2(o[0], o[1]), pk2(o[2], o[3])};
    }
  }
}

#define XB_TMO      128
#define XB_XCNT(j)  (256  + 64 * (j))
#define XB_XSUB(j)  (1280 + 64 * (j))
#define XB_XGEN(j)  (2304 + 64 * (j))
#define XB_TOP      3328
#define XB_TOPGEN   3392
#define XCD_BAR_WORDS 3456
#define XB_SPIN_CAP (1u << 20)
DI unsigned xb_ld(unsigned* p) { return __hip_atomic_load(p, __ATOMIC_RELAXED, __HIP_MEMORY_SCOPE_AGENT); }
DI unsigned xb_add(unsigned* p, unsigned v) { return __hip_atomic_fetch_add(p, v, __ATOMIC_RELAXED, __HIP_MEMORY_SCOPE_AGENT); }
DI unsigned xb_xcc_id() { return (unsigned)__builtin_amdgcn_s_getreg((3 << 11) | 20) & 0xFu; }
#define XB_SPIN(cond, bar) do { unsigned _sp = 0; while (cond) { __builtin_amdgcn_s_sleep(1); \
    if ((++_sp & 255u) == 0u) { if (xb_ld(&(bar)[XB_TMO])) break; if (_sp > XB_SPIN_CAP) { atomicAdd(&(bar)[XB_TMO], 1u); break; } } } } while (0)
struct XcdBarrier { unsigned* bar; unsigned x; volatile LAS unsigned* st; };
DI XcdBarrier xcd_barrier_post(unsigned* bar, volatile LAS unsigned* st) {
  XcdBarrier b; b.bar = bar; b.x = xb_xcc_id(); b.st = st;
  if (threadIdx.x == 0) (void)xb_add(&bar[XB_XCNT(b.x)], 1u);
  return b;
}
DI void xcd_barrier_complete(unsigned* bar, unsigned x, unsigned& nloc, unsigned& nx) {
  const unsigned G = gridDim.x * gridDim.y * gridDim.z;
  unsigned sum, cnt, mine, sp = 0u;
  for (;;) {
    sum = 0u; cnt = 0u; mine = 0u;
#pragma unroll
    for (unsigned j = 0; j < 16; ++j) { const unsigned c = xb_ld(&bar[XB_XCNT(j)]); sum += c; cnt += (c > 0u) ? 1u : 0u; mine = (j == x) ? c : mine; }
    if (sum == G) break;
    __builtin_amdgcn_s_sleep(1);
    if ((++sp & 255u) == 0u) { if (xb_ld(&bar[XB_TMO])) break; if (sp > XB_SPIN_CAP) { atomicAdd(&bar[XB_TMO], 1u); break; } }
  }
  nloc = mine > 0u ? mine : 1u; nx = cnt > 0u ? cnt : 1u;
}
DI void xcd_barrier(const XcdBarrier& b) {
  asm volatile("s_waitcnt vmcnt(0)" ::: "memory");
  __syncthreads();
  if (threadIdx.x == 0) {
    unsigned* bar = b.bar;
    __builtin_amdgcn_s_waitcnt(0);
    unsigned nloc = b.st[0], nx = b.st[1];
    if (nloc == 0u) { xcd_barrier_complete(bar, b.x, nloc, nx); b.st[0] = nloc; b.st[1] = nx; }
    const unsigned old = xb_add(&bar[XB_XSUB(b.x)], 1u);
    const unsigned gen = old / nloc;
    if (old + 1u == (gen + 1u) * nloc) {
      __builtin_amdgcn_fence(__ATOMIC_RELEASE, "agent");
      asm volatile("s_waitcnt vmcnt(0)" ::: "memory");
      const unsigned og = xb_add(&bar[XB_TOP], 1u);
      const unsigned tg = og / nx;
      if (og + 1u == (tg + 1u) * nx) xb_add(&bar[XB_TOPGEN], 1u);
      else XB_SPIN(xb_ld(&bar[XB_TOPGEN]) == tg, bar);
      __builtin_amdgcn_fence(__ATOMIC_ACQUIRE, "agent");
      xb_add(&bar[XB_XGEN(b.x)], 1u);
      asm volatile("s_waitcnt vmcnt(0)" ::: "memory");
    } else {
      XB_SPIN(xb_ld(&bar[XB_XGEN(b.x)]) == gen, bar);
      __builtin_amdgcn_fence(__ATOMIC_ACQUIRE, "agent");
      asm volatile("s_waitcnt vmcnt(0)" ::: "memory");
    }
  }
  __syncthreads();
}

#define TAKE(bytes) (ws + off); off += (((size_t)(bytes)) + 255) & ~(size_t)255
__host__ __device__ inline size_t fill_ws(P& p, char* ws) {
  size_t off = 0;
  char* regA = TAKE((size_t)128 * 1024 * 1024);
  p.Z = (u16*)regA;
  p.LW = (u16*)regA; p.AA = (u16*)(regA + (size_t)2 * NTOK * RWW * 2); p.G = (u16*)(regA + (size_t)4 * NTOK * RWW * 2);
  p.MC = (float*)(regA + (size_t)5 * NTOK * RWW * 2); p.NC = p.MC + (size_t)32 * NCH * 4096;
  p.HID = (u16*)regA;
  char* regB = TAKE((size_t)3 * NTOK * RWW * 4);
  p.R = (u16*)regB; p.K = p.R + (size_t)NTOK * RWW; p.V = p.K + (size_t)NTOK * RWW;
  p.PG = (float*)regB;
  char* regC = TAKE((size_t)80 * 1024 * 1024);
  p.QRAW = (float*)regC; p.KVRAW = p.QRAW + (size_t)NTOK * 768;
  p.AO = (u16*)regC; p.O2 = (u16*)(regC + (size_t)NTOK * 512 * 4); p.SS = (float*)(p.O2 + (size_t)2 * NTOK * 512);
  p.TWD = (u16*)TAKE((size_t)2 * NTOK * 64 * 2); p.AD = (u16*)TAKE((size_t)2 * NTOK * 64 * 2);
  p.SGD = (u16*)TAKE((size_t)NTOK * 128 * 2); p.QDN = (u16*)TAKE((size_t)NTOK * 256 * 2);
  p.KVDN = (u16*)TAKE((size_t)NTOK * 128 * 2); p.KR = (float*)TAKE((size_t)NTOK * 32 * 4);
  p.ROPE = (float*)TAKE((size_t)NTOK * 32 * 4);
  p.Q = (u16*)TAKE((size_t)NTOK * NH * 96 * 2); p.Kc = (u16*)TAKE((size_t)NTOK * NH * 96 * 2);
  p.Vv = (u16*)TAKE((size_t)NTOK * NH * 64 * 2);
  p.H = (u16*)TAKE((size_t)NTOK * DM * 2);
  p.AFF = (float*)TAKE((size_t)NB * NE * T * 4);
  p.IDX = (int*)TAKE((size_t)NB * NE * CAP * 4);
  p.GATE = (float*)TAKE((size_t)NB * NE * CAP * 4);

  p.WIN = (u16*)TAKE((size_t)WIN_PAD * DM * 2); p.WOUT = (u16*)TAKE((size_t)DM * DM * 2); p.WPG = (u16*)TAKE((size_t)DM * DM * 2);
  p.WPP = (u16*)TAKE((size_t)DM * DPLE * 2); p.PB = (u16*)TAKE((size_t)NTOK * DPLE * 2);
  p.XB = (u16*)TAKE((size_t)NTOK * DM * 2);
  p.PGb = (u16*)regB;
  p.EW1 = (u16*)regB; p.EW2 = p.EW1 + (size_t)NE * 2048 * 1024;
  p.XE = (u16*)regA; p.HID = (u16*)(regA + (size_t)32 * 1024 * 1024 * 2);
  p.YE = (u16*)regC;
  p.TCNT = (int*)TAKE((size_t)NTOK * 4); p.TLIST = (int*)TAKE((size_t)NTOK * 16 * 4);
  p.CTR = (unsigned*)TAKE(256);
  p.BAR = (unsigned*)TAKE(XCD_BAR_WORDS * 4);
  return off;
}
#undef TAKE
constexpr int DSM_BYTES = g8::STAGE_BYTES + 16 * 256 * 4 + 64;
extern __shared__ __attribute__((aligned(16))) char dsm[];
struct PK { const void* in[31]; float* out; char* ws; };
DI void build_params(P& p, const PK& k) {
  p.x = (const float*)k.in[0]; p.p = (const float*)k.in[1]; p.pos = (const int*)k.in[2];
  p.attn_norm = (const float*)k.in[3]; p.w_in = (const float*)k.in[4]; p.rw_mu = (const float*)k.in[5];
  p.rw_w0 = (const float*)k.in[6]; p.rw_w_up = (const float*)k.in[7]; p.rw_a0 = (const float*)k.in[8];
  p.rw_a_up = (const float*)k.in[9]; p.rw_g_up = (const float*)k.in[10]; p.rw_k_k = (const float*)k.in[11];
  p.rw_k_a = (const float*)k.in[12]; p.rw_r_k = (const float*)k.in[13]; p.rw_lnx_w = (const float*)k.in[14];
  p.rw_lnx_b = (const float*)k.in[15]; p.mla_q_norm = (const float*)k.in[16]; p.mla_q_up = (const float*)k.in[17];
  p.mla_kv_norm = (const float*)k.in[18]; p.mla_kv_up = (const float*)k.in[19]; p.mla_o_norm = (const float*)k.in[20];
  p.w_out = (const float*)k.in[21]; p.ffn_norm = (const float*)k.in[22]; p.router = (const float*)k.in[23];
  p.exp_w_gate = (const float*)k.in[24]; p.exp_w_up = (const float*)k.in[25]; p.exp_w_down = (const float*)k.in[26];
  p.ple_norm = (const float*)k.in[27]; p.ple_proj = (const float*)k.in[28]; p.ple_gate = (const float*)k.in[29];
  p.final_norm = (const float*)k.in[30];
  p.out = k.out;
  (void)fill_ws(p, k.ws);
}
__global__ void __launch_bounds__(NTH) mega(PK pk) {
  P p; build_params(p, pk);
  char* smem = dsm;
  LAS unsigned char* glds = (LAS unsigned char*)dsm;
  uint4* xbw = (uint4*)(dsm + g8::STAGE_BYTES + 16 * 256 * 4);
  cg::grid_group grid = cg::this_grid();
  if (threadIdx.x == 0) *xbw = make_uint4(0u, 0u, 0u, 0u);
  if (pk.ws == nullptr) grid.sync();
  const XcdBarrier xb = xcd_barrier_post(p.BAR, (volatile LAS unsigned*)xbw);
#define GSYNC() xcd_barrier(xb)
#ifndef PROBE_MASK
#define PROBE_MASK 0u
#endif
#if PROBE_MASK
  unsigned long long pt0 = __builtin_amdgcn_s_memrealtime();
#define PSYNC(id) do { GSYNC(); if (PROBE_MASK & (1u << (id))) { unsigned long long t1_ = __builtin_amdgcn_s_memrealtime(); unsigned long long dt_ = t1_ - pt0; \
    while (__builtin_amdgcn_s_memrealtime() - t1_ < dt_) __builtin_amdgcn_s_sleep(8); } pt0 = __builtin_amdgcn_s_memrealtime(); } while (0)
#else
#define PSYNC(id) GSYNC()
#endif
  for (int layer_ = 0; layer_ < NL; ++layer_) {
    int layer = layer_; asm volatile("" : "+s"(layer));
    if (layer_ == 0) ph_rope_table(p);
    ph_cvt_small_a(p, layer, smem);
    if (layer_ == 0) ph_norm(p.x, p.attn_norm + layer * DM, p.H); else ph_norm(p.XB, p.attn_norm + layer * DM, p.H);
    PSYNC(0);
    {
      g8::Sched S; S.init(NTOK / 256, WIN_PAD / 256, gridDim.x, bidx(), p.H, p.WIN, DM);
      g8::EpiZ E{p.Z};
      g8::gemm_phase(glds, DM, S, E);
      const int ntile = (NTOK / 256) * (WIN_PAD / 256), rem = ntile % (int)gridDim.x, c = (int)blockIdx.x;
      if (rem == 0) ph_cvt_small_b(p, layer, smem, c, (int)gridDim.x);
      else if (c >= rem) ph_cvt_small_b(p, layer, smem, c - rem, (int)gridDim.x - rem);
    }
    PSYNC(1);
    ph_rwshift(p, layer);
    ph_mlaprep1(p, layer);
    PSYNC(2);
    for (int d = 0; d < 2; ++d) {
      u16* LW = p.LW + (size_t)d * NTOK * RWW; const float* w0 = p.rw_w0 + (layer * 2 + d) * RWW;
      ph_gemm<false>(p.TWD + (size_t)d * NTOK * 64, 64, p.rw_w_up + ((size_t)(layer * 2 + d)) * 64 * RWW, RWW, NTOK, RWW, 64, smem,
                     [&](int row, int col, const f32x4& v) { const f32x4 bb = *(const f32x4*)(w0 + col);
                       *(u32x2*)(LW + hmx(row, col)) = u32x2{pk2(-0.6065306597126334f * sigmoidf_(v[0] + bb[0]), -0.6065306597126334f * sigmoidf_(v[1] + bb[1])),
                                                                       pk2(-0.6065306597126334f * sigmoidf_(v[2] + bb[2]), -0.6065306597126334f * sigmoidf_(v[3] + bb[3]))}; }, (int)blockIdx.x, (int)gridDim.x);
      u16* AA = p.AA + (size_t)d * NTOK * RWW; const float* a0 = p.rw_a0 + (layer * 2 + d) * RWW;
      ph_gemm<false>(p.AD + (size_t)d * NTOK * 64, 64, p.rw_a_up + ((size_t)(layer * 2 + d)) * 64 * RWW, RWW, NTOK, RWW, 64, smem,
                     [&](int row, int col, const f32x4& v) { const f32x4 bb = *(const f32x4*)(a0 + col);
                       *(u32x2*)(AA + hmx(row, col)) = u32x2{pk2(sigmoidf_(v[0] + bb[0]), sigmoidf_(v[1] + bb[1])), pk2(sigmoidf_(v[2] + bb[2]), sigmoidf_(v[3] + bb[3]))}; }, (int)blockIdx.x, (int)gridDim.x);
    }
    PSYNC(3);
    ph_scan1(p, layer, smem);
    PSYNC(4);
    ph_scan2(p, smem);
    const bool split_ = gridDim.x >= 64;
    const int gw = split_ ? (int)blockIdx.x - 32 : (int)blockIdx.x, gstride = split_ ? (int)gridDim.x - 32 : (int)gridDim.x;
    if (gw >= 0)
    {
      u16* G = p.G;
      ph_gemm<false>(p.SGD, 128, p.rw_g_up + (size_t)layer * 128 * RWW, RWW, NTOK, RWW, 128, smem,
                     [&](int row, int col, const f32x4& v) { *(u32x2*)(G + hmx(row, col)) = u32x2{pk2(v[0], v[1]), pk2(v[2], v[3])}; }, gw, gstride);
      {
        u16* Qo = p.Q; const float* rope = p.ROPE;
        ph_gemm_t(p.QDN, 256, p.mla_q_up + (size_t)layer * 256 * 768, 768, NTOK, 768, 256, smem,
                  [&](const f32x4 (&acc)[4][4], int m0, int n0, int wm, int wn, int lq, int l15) {
          const float qs = 0.10206207261596577f * 1.4426950408889634f;
#pragma unroll
          for (int mi = 0; mi < 4; ++mi) {
            const int tok = m0 + wm * 64 + mi * 16 + l15; const int b = tok / T, t = tok % T;
#pragma unroll
            for (int ni = 0; ni < 4; ++ni) {
              const int col0 = n0 + wn * 64 + ni * 16; const int h = col0 / 96, c0 = col0 % 96;
              u16* qo = Qo + ((size_t)(b * NH + h) * T + t) * 96;
              const f32x4 u1 = acc[mi][ni];
              if (c0 < 64) *(u32x2*)(qo + c0 + lq * 4) = u32x2{pk2(u1[0] * qs, u1[1] * qs), pk2(u1[2] * qs, u1[3] * qs)};
              else if (c0 == 64) {
                const f32x4 u2 = acc[mi][(ni + 1) & 3];
                const f32x4 cA = *(const f32x4*)(rope + (size_t)tok * 32 + lq * 8), cB = *(const f32x4*)(rope + (size_t)tok * 32 + lq * 8 + 4);
                *(u32x2*)(qo + 64 + lq * 4) = u32x2{pk2((u1[0] * cA[0] - u2[0] * cA[1]) * qs, (u1[1] * cA[2] - u2[1] * cA[3]) * qs),
                                                    pk2((u1[2] * cB[0] - u2[2] * cB[1]) * qs, (u1[3] * cB[2] - u2[3] * cB[3]) * qs)};
                *(u32x2*)(qo + 80 + lq * 4) = u32x2{pk2((u1[0] * cA[1] + u2[0] * cA[0]) * qs, (u1[1] * cA[3] + u2[1] * cA[2]) * qs),
                                                    pk2((u1[2] * cB[1] + u2[2] * cB[0]) * qs, (u1[3] * cB[3] + u2[3] * cB[2]) * qs)};
              }
            }
          }
        }, (gw + gstride - 32 % gstride) % gstride, gstride);
      }
      {
        u16* Ko = p.Kc; u16* Vo = p.Vv;
        ph_gemm_t(p.KVDN, 128, p.mla_kv_up + (size_t)layer * 128 * 1024, 1024, NTOK, 1024, 128, smem,
                  [&](const f32x4 (&acc)[4][4], int m0, int n0, int wm, int wn, int lq, int l15) {
#pragma unroll
          for (int mi = 0; mi < 4; ++mi) {
            const int tok = m0 + wm * 64 + mi * 16 + l15; const int b = tok / T, t = tok % T;
#pragma unroll
            for (int ni = 0; ni < 4; ++ni) {
              const int col0 = n0 + wn * 64 + ni * 16; const int h = col0 >> 7, c0 = col0 & 127;
              const size_t rowi = (size_t)(b * NH + h) * T + t;
              const f32x4 v = acc[mi][ni];
              const u32x2 pv = u32x2{pk2(v[0], v[1]), pk2(v[2], v[3])};
              if (c0 < 64) *(u32x2*)(Ko + rowi * 96 + c0 + lq * 4) = pv;
              else *(u32x2*)(Vo + rowi * 64 + (c0 - 64) + lq * 4) = pv;
            }
          }
        }, (gw + gstride - 192 % gstride) % gstride, gstride);
      }
    }
    PSYNC(7);
    ph_attn(p, smem, p.CTR + layer);
    PSYNC(5);
    ph_mla_norm(p, layer);
    ph_scan3(p, layer, smem);
    PSYNC(6);
    {
      for (int i = blockIdx.x * NTH + tidx(); i < NTOK; i += gridDim.x * NTH) p.TCNT[i] = 0;
      g8::Sched S; S.init(NTOK / 256, DM / 256, gridDim.x, bidx(), p.H, p.WOUT, DM);
      g8::EpiRes E{(layer == 0) ? p.x : nullptr, p.XB, p.XB};
      g8::gemm_phase(glds, DM, S, E);
    }
    PSYNC(8);
    ph_norm_router(p, layer, smem);
    PSYNC(9);
    ph_topk(p, smem);
    ph_cvt_experts(p, layer, smem, p.CTR + 4 + layer);
    PSYNC(10);
    {
      g8::Sched S; S.init(NB * NE * CAP / 256, 2048 / 256, gridDim.x, bidx(), p.H, p.EW1, DM);
      S.group(4, NE, (size_t)2048 * 1024 * 2);
      g8::EpiSwi E{p.HID};
      g8::gemm_phase<g8::EpiSwi, true>(glds, DM, S, E, p.IDX, (LAS unsigned*)(dsm + g8::STAGE_BYTES));
    }
    PSYNC(12);
    {
      g8::Sched S; S.init(NB * NE * CAP / 256, DM / 256, gridDim.x, bidx(), p.HID, p.EW2, 1024);
      S.group(4, NE, (size_t)1024 * 1024 * 2);
      g8::EpiYE E{p.YE, p.GATE};
      g8::gemm_phase(glds, 1024, S, E);
    }
    PSYNC(13);
    ph_combine_norm(p, layer);
    PSYNC(16);
    {
      g8::Sched S; S.init(NTOK / 256, DM / 256, gridDim.x, bidx(), p.H, p.WPG, DM);
      g8::EpiSig E{p.PGb};
      g8::gemm_phase(glds, DM, S, E);
    }
    {
      g8::Sched S; S.init(NTOK / 256, DM / 256, gridDim.x, bidx(), p.PB, p.WPP, DPLE);
      g8::EpiPle E{p.XB, p.PGb};
      g8::gemm_phase(glds, DPLE, S, E);
    }
    PSYNC(15);
  }
  ph_final_norm(p.XB, p.final_norm, p.out);
}

extern "C" void kernel_launch(void* const* d_in, const int* in_sizes, int n_in, void* d_out, int out_size, void* d_ws,
                              size_t ws_size, hipStream_t stream) {
  (void)in_sizes; (void)n_in; (void)out_size;
  PK pk{};
  for (int i = 0; i < 31; ++i) pk.in[i] = d_in[i];
  pk.out = (float*)d_out; pk.ws = (char*)d_ws;
  P p{};
  const size_t off = fill_ws(p, (char*)d_ws);
  if (off > ws_size) { fprintf(stderr, "workspace too small: need %zu have %zu\n", off, ws_size); return; }
  static int grid_blocks = 0;
  if (!grid_blocks) {
    int dev = 0, cus = 0, per_cu = 0;
    hipGetDevice(&dev);
    hipDeviceGetAttribute(&cus, hipDeviceAttributeMultiprocessorCount, dev);
    hipFuncSetAttribute((const void*)mega, hipFuncAttributeMaxDynamicSharedMemorySize, DSM_BYTES);
    hipOccupancyMaxActiveBlocksPerMultiprocessor(&per_cu, mega, NTH, DSM_BYTES);
    if (per_cu > 1) per_cu = 1;
    grid_blocks = cus * per_cu;
  }
  hipMemsetAsync(p.CTR, 0, 256 + (size_t)XCD_BAR_WORDS * 4, stream);
  void* args[] = {&pk};
  hipError_t e = hipLaunchCooperativeKernel((void*)mega, dim3(grid_blocks), dim3(NTH), args, DSM_BYTES, stream);
  if (e != hipSuccess) fprintf(stderr, "cooperative launch failed: %s (grid %d)\n", hipGetErrorString(e), grid_blocks);
}
```
